# Optimizing an MI355X kernel written in HIP

```python
import jax, jax.numpy as jnp
from jax import lax
import numpy as np

D_MODEL = 2048
BATCH = 8
SEQ = 4096
DEPTH = 1
DEC_BATCH = 4
DEC_SEQ = 8192
PAST_LEN = 128

N_META = 16
GRID_W = 64
HEAD_DIM = 128
N_Q_HEADS = (D_MODEL // 2) // HEAD_DIM
N_KV_HEADS = N_Q_HEADS // 4
ATTN_WIDTH = N_Q_HEADS * HEAD_DIM
KV_WIDTH = N_KV_HEADS * HEAD_DIM
LRU_WIDTH = D_MODEL - ATTN_WIDTH
LRU_BLOCKS = 8
LRU_BLOCK = LRU_WIDTH // LRU_BLOCKS
LRU_CONV_W = 4
LRU_C = 8.0
MIX_WIDTH = ATTN_WIDTH + LRU_WIDTH
IN_WIDTH = ATTN_WIDTH + 2 * KV_WIDTH + 2 * LRU_WIDTH
FFN_DIM = 5632
FFN_CONV_W = 3
Q_BLOCK = 128
ROPE_THETA = 10000.0
EPS = 1e-6

kernel_name = 'hymba_axial_gqa_rglru_encoder'


def rms_norm(x, g):
    xf = x.astype(jnp.float32)
    y = xf * lax.rsqrt(jnp.mean(xf * xf, axis=-1, keepdims=True) + EPS)
    return (y * g.astype(jnp.float32)).astype(x.dtype)


def dwconv(x, w, b, pad_left):
    K = w.shape[0]
    L = x.shape[1]
    xp = jnp.pad(x, ((0, 0), (pad_left, K - 1 - pad_left), (0, 0)))
    out = xp[:, 0:L] * w[0]
    for k in range(1, K):
        out = out + xp[:, k:k + L] * w[k]
    return out + b


def axial_rope_tables(n_tokens):
    rows = n_tokens // GRID_W
    t_row = jnp.repeat(jnp.arange(rows), GRID_W).astype(jnp.float32)
    t_col = jnp.tile(jnp.arange(GRID_W), rows).astype(jnp.float32)
    half = HEAD_DIM // 2
    inv = ROPE_THETA ** (-jnp.arange(0, half, 2, dtype=jnp.float32) / half)
    ang = jnp.concatenate([t_row[:, None] * inv, t_col[:, None] * inv], axis=-1)
    ang = jnp.concatenate([jnp.zeros((N_META, half), jnp.float32), ang], axis=0)
    return jnp.cos(ang), jnp.sin(ang)


def apply_axial_rope(x, cos, sin):
    B, L, H, D = x.shape
    q = D // 4
    xf = x.astype(jnp.float32).reshape(B, L, H, 2, 2, q)
    x1 = xf[..., 0, :]
    x2 = xf[..., 1, :]
    c = cos.reshape(L, 1, 2, q)
    s = sin.reshape(L, 1, 2, q)
    out = jnp.stack([x1 * c - x2 * s, x2 * c + x1 * s], axis=-2)
    return out.reshape(B, L, H, D).astype(x.dtype)


def gqa_block_attention(q, k, v):
    B, L = q.shape[0], q.shape[1]
    G = N_Q_HEADS // N_KV_HEADS
    nblk = -(-L // Q_BLOCK)
    qp = jnp.pad(q, ((0, 0), (0, nblk * Q_BLOCK - L), (0, 0), (0, 0)))
    qb = qp.reshape(B, nblk, Q_BLOCK, N_KV_HEADS, G, HEAD_DIM).transpose(1, 0, 2, 3, 4, 5)
    scale = HEAD_DIM ** -0.5

    def block(qi):
        s = jnp.einsum('bqkgd,bskd->bkgqs', qi, k).astype(jnp.float32) * scale
        p = jax.nn.softmax(s, axis=-1).astype(v.dtype)
        return jnp.einsum('bkgqs,bskd->bqkgd', p, v)

    o = lax.map(block, qb)
    o = o.transpose(1, 0, 2, 3, 4, 5).reshape(B, nblk * Q_BLOCK, ATTN_WIDTH)
    return o[:, :L]


def rg_lru(x, w_r, b_r, w_i, b_i, lam, reverse):
    B, L, C = x.shape
    xb = x.reshape(B, L, LRU_BLOCKS, LRU_BLOCK)
    r = jax.nn.sigmoid((jnp.einsum('blnc,ncd->blnd', xb, w_r).reshape(B, L, C) + b_r).astype(jnp.float32))
    i = jax.nn.sigmoid((jnp.einsum('blnc,ncd->blnd', xb, w_i).reshape(B, L, C) + b_i).astype(jnp.float32))
    log_a = -LRU_C * r * jax.nn.softplus(-lam.astype(jnp.float32))
    a = jnp.exp(log_a)
    u = jnp.sqrt(-jnp.expm1(2.0 * log_a)) * (i * x.astype(jnp.float32))

    def combine(e1, e2):
        a1, b1 = e1
        a2, b2 = e2
        return a1 * a2, a2 * b1 + b2

    _, h = lax.associative_scan(combine, (a, u), reverse=reverse, axis=1)
    return h


def encoder_layer(h, norm_pre_mix, w_in, q_norm, k_norm, lru_conv_w, lru_conv_b, lru_w_r, lru_b_r,
                  lru_w_i, lru_b_i, lru_lambda, attn_out_norm, lru_out_norm, w_out, norm_post_mix,
                  norm_pre_ffn, w_up, ffn_conv_w, ffn_conv_b, w_down, norm_post_ffn):
    B, L, _ = h.shape
    z = rms_norm(h, norm_pre_mix) @ w_in
    o1 = ATTN_WIDTH
    o2 = o1 + KV_WIDTH
    o3 = o2 + KV_WIDTH
    o4 = o3 + LRU_WIDTH
    q = z[..., :o1].reshape(B, L, N_Q_HEADS, HEAD_DIM)
    k = z[..., o1:o2].reshape(B, L, N_KV_HEADS, HEAD_DIM)
    v = z[..., o2:o3].reshape(B, L, N_KV_HEADS, HEAD_DIM)
    xr = z[..., o3:o4]
    gy = z[..., o4:]
    cos, sin = axial_rope_tables(L - N_META)
    q = apply_axial_rope(rms_norm(q, q_norm), cos, sin)
    k = apply_axial_rope(rms_norm(k, k_norm), cos, sin)
    attn = gqa_block_attention(q, k, v)
    xc = dwconv(xr, lru_conv_w, lru_conv_b, LRU_CONV_W // 2)
    hr = (rg_lru(xc, lru_w_r[0], lru_b_r[0], lru_w_i[0], lru_b_i[0], lru_lambda[0], False)
          + rg_lru(xc, lru_w_r[1], lru_b_r[1], lru_w_i[1], lru_b_i[1], lru_lambda[1], True))
    lru = (hr * jax.nn.gelu(gy.astype(jnp.float32))).astype(h.dtype)
    mixed = jnp.concatenate([rms_norm(attn, attn_out_norm), rms_norm(lru, lru_out_norm)], axis=-1)
    h = h + rms_norm(mixed @ w_out, norm_post_mix)
    up = rms_norm(h, norm_pre_ffn) @ w_up
    g = dwconv(up[..., :FFN_DIM], ffn_conv_w, ffn_conv_b, FFN_CONV_W // 2)
    f = (jax.nn.silu(g) * up[..., FFN_DIM:]) @ w_down
    return h + rms_norm(f, norm_post_ffn)


def run_trunk(x, meta_tokens, weights):
    B = x.shape[0]
    meta = jnp.broadcast_to(meta_tokens.astype(x.dtype)[None], (B, N_META, D_MODEL))
    h = jnp.concatenate([meta, x], axis=1)
    for l in range(DEPTH):
        h = encoder_layer(h, *[w[l] for w in weights])
    return h[:, N_META:]


def setup_inputs(seed: int = 0) -> dict:
    key = jax.random.key(seed)
    ks = jax.random.split(key, 24)
    f32 = jnp.float32

    def nrm(k, shape, scale):
        return jax.random.normal(k, shape, f32) * scale

    def gain(k, n):
        return 1.0 + 0.05 * jax.random.normal(k, (DEPTH, n), f32)

    u = jax.random.uniform(ks[13], (DEPTH, 2, LRU_WIDTH), f32, 0.9, 0.999)
    a = u ** (1.0 / LRU_C)
    lam = jnp.log(a) - jnp.log1p(-a)
    return {
        'x_prompt': nrm(ks[0], (BATCH, SEQ, D_MODEL), 1.0),
        'x_sample': nrm(ks[1], (DEC_BATCH, DEC_SEQ, D_MODEL), 1.0),
        'meta_tokens': nrm(ks[2], (N_META, D_MODEL), 1.0),
        'norm_pre_mix': gain(ks[3], D_MODEL),
        'w_in': nrm(ks[4], (DEPTH, D_MODEL, IN_WIDTH), D_MODEL ** -0.5),
        'q_norm': gain(ks[5], HEAD_DIM),
        'k_norm': gain(ks[6], HEAD_DIM),
        'lru_conv_w': nrm(ks[7], (DEPTH, LRU_CONV_W, LRU_WIDTH), LRU_CONV_W ** -0.5),
        'lru_conv_b': nrm(ks[8], (DEPTH, LRU_WIDTH), 0.02),
        'lru_w_r': nrm(ks[9], (DEPTH, 2, LRU_BLOCKS, LRU_BLOCK, LRU_BLOCK), LRU_BLOCK ** -0.5),
        'lru_b_r': nrm(ks[10], (DEPTH, 2, LRU_WIDTH), 0.02),
        'lru_w_i': nrm(ks[11], (DEPTH, 2, LRU_BLOCKS, LRU_BLOCK, LRU_BLOCK), LRU_BLOCK ** -0.5),
        'lru_b_i': nrm(ks[12], (DEPTH, 2, LRU_WIDTH), 0.02),
        'lru_lambda': lam,
        'attn_out_norm': gain(ks[14], ATTN_WIDTH),
        'lru_out_norm': gain(ks[15], LRU_WIDTH),
        'w_out': nrm(ks[16], (DEPTH, MIX_WIDTH, D_MODEL), MIX_WIDTH ** -0.5),
        'norm_post_mix': gain(ks[17], D_MODEL),
        'norm_pre_ffn': gain(ks[18], D_MODEL),
        'w_up': nrm(ks[19], (DEPTH, D_MODEL, 2 * FFN_DIM), D_MODEL ** -0.5),
        'ffn_conv_w': nrm(ks[20], (DEPTH, FFN_CONV_W, FFN_DIM), FFN_CONV_W ** -0.5),
        'ffn_conv_b': nrm(ks[21], (DEPTH, FFN_DIM), 0.02),
        'w_down': nrm(ks[22], (DEPTH, FFN_DIM, D_MODEL), FFN_DIM ** -0.5),
        'norm_post_ffn': gain(ks[23], D_MODEL),
    }


def reference(x_prompt, x_sample, meta_tokens, norm_pre_mix, w_in, q_norm, k_norm, lru_conv_w, lru_conv_b,
              lru_w_r, lru_b_r, lru_w_i, lru_b_i, lru_lambda, attn_out_norm, lru_out_norm, w_out,
              norm_post_mix, norm_pre_ffn, w_up, ffn_conv_w, ffn_conv_b, w_down, norm_post_ffn):
    weights = (norm_pre_mix, w_in, q_norm, k_norm, lru_conv_w, lru_conv_b, lru_w_r, lru_b_r,
               lru_w_i, lru_b_i, lru_lambda, attn_out_norm, lru_out_norm, w_out, norm_post_mix,
               norm_pre_ffn, w_up, ffn_conv_w, ffn_conv_b, w_down, norm_post_ffn)
    y_prompt = run_trunk(x_prompt, meta_tokens, weights)
    y_sample = run_trunk(x_sample, meta_tokens, weights)
    return (y_prompt, y_sample)
```

```cpp
#include <hip/hip_runtime.h>
#include <cstdio>
#include <cstdint>
#include <cmath>
#ifndef MK_PHASE_MASK
#define MK_PHASE_MASK 0xfff
#endif
#ifndef MK_MULTI
#define MK_MULTI 1
#endif
namespace pg8 {
#define PG8_LAS __attribute__((address_space(3)))
typedef unsigned short bf16_t;
typedef short bf16x8 __attribute__((ext_vector_type(8)));
typedef float f32x4 __attribute__((ext_vector_type(4)));
typedef unsigned u32x4 __attribute__((ext_vector_type(4)));
constexpr int BM = 256, BK = 64, HALF = 128, HTB = HALF * BK * 2  , STAGE_BYTES = 8 * HTB, NXCD = 8, WGM = 8;

__host__ __device__ __forceinline__ int lds_byte(int r, int c) { const int st = (r >> 4) * 2 + (c >> 5), rr = r & 15, cc = c & 31, ob = rr * 64 + cc * 2; return st * 1024 + (ob ^ (((ob >> 9) & 1) << 5)); }
__host__ __device__ __forceinline__ void stage_rc(int b, int& R, int& C) { const int st = b / 1024, sb = b % 1024, swz = sb ^ (((sb >> 9) & 1) << 5); R = (st >> 1) * 16 + swz / 64; C = (st & 1) * 32 + (swz % 64) / 2; }
__host__ __device__ __forceinline__ int perm32(int rho) { const int n = rho >> 4, i = rho & 15; return 8 * (i >> 2) + 4 * n + (i & 3); }

struct Unit { int pm, pn; };
struct Gemm { const bf16_t* A; const bf16_t* Bt; int M, N, K; };

struct StaticOrder {
    int nM, nN, nwg, G, c;
    __host__ __device__ void init(int M, int N, int G_, int c_) { nM = M / BM; nN = N / BM; nwg = nM * nN; G = G_; c = c_; }
    __host__ __device__ bool next(int i, Unit& u) const {
        const long L = (long)i * G + c; if (L >= nwg) return false;
        int wgid = (int)L; { const int q = nwg / NXCD, r = nwg % NXCD, xcd = wgid % NXCD, off = wgid / NXCD; wgid = (xcd < r ? xcd * (q + 1) : r * (q + 1) + (xcd - r) * q) + off; }
        const int nig = WGM * nN, gid = wgid / nig, fm = gid * WGM, gsz = (nM - fm) < WGM ? (nM - fm) : WGM;
        u.pm = fm + ((wgid % nig) % gsz); u.pn = (wgid % nig) / gsz; return true;
    }
    __device__ __forceinline__ void a_ready(const Unit&) const {}
    __device__ __forceinline__ void done(const Unit&) const {}
};

__device__ __forceinline__ unsigned cvt_pk_bf16(float lo, float hi) { unsigned r; asm volatile("v_cvt_pk_bf16_f32 %0, %1, %2" : "=v"(r) : "v"(lo), "v"(hi)); return r; }
struct EpiRoute {
    static constexpr bool PERM = true, AFTER_DRAIN = false;
    bf16_t* O; int ldc; int mode; bf16_t *Qp, *Kp, *Vp, *XRp, *GYp;
    __device__ __forceinline__ void operator()(const f32x4 (&acc)[2][2][4][2], const Unit& u, int wr, int wc, int fr, int fq) const {
        bf16_t* base = O; int ld = ldc; int colt = u.pn * BM; int rowadd = 0;
        if (mode == 1) {
            const int pn = u.pn;
            if (pn < 4) { base = Qp; ld = 1024; colt = pn * 256; }
            else if (pn == 4) { base = Kp; ld = 256; colt = 0; }
            else if (pn == 5) { base = Vp; ld = 256; colt = 0; }
            else if (pn < 10) { base = XRp; ld = 1024; colt = (pn - 6) * 256; const int seq = u.pm < 128 ? (u.pm >> 4) : 8 + ((u.pm - 128) >> 5); rowadd = 64 * (seq + 1); }
            else { base = GYp; ld = 1024; colt = (pn - 10) * 256; }
        }
        const int row0 = u.pm * BM + wr * 64 + fr + rowadd; const int col0 = colt + wc * 32 + 8 * fq;
#pragma unroll
        for (int ai = 0; ai < 2; ++ai)
#pragma unroll
            for (int m = 0; m < 4; ++m) { bf16_t* rowp = base + (size_t)(row0 + ai * HALF + m * 16) * ld + col0;
#pragma unroll
                for (int bj = 0; bj < 2; ++bj) { const f32x4 v0 = acc[ai][bj][m][0], v1 = acc[ai][bj][m][1];
                    u32x4 w; w.x = cvt_pk_bf16(v0[0], v0[1]); w.y = cvt_pk_bf16(v0[2], v0[3]); w.z = cvt_pk_bf16(v1[0], v1[1]); w.w = cvt_pk_bf16(v1[2], v1[3]);
                    *(u32x4*)(rowp + bj * HALF) = w; } }
    }
};

template <class Epi, class Sched, bool ALIGN_EPI = false, bool SP2 = false>
__device__ __forceinline__ void gemm_phase(PG8_LAS unsigned char* lds, const Gemm g, const Sched& S, const Epi& E) {
    const int tid = threadIdx.x, wid = __builtin_amdgcn_readfirstlane(tid >> 6), lane = tid & 63, wr = wid >> 2, wc = wid & 3, fr = lane & 15, fq = lane >> 4;
    const int K = g.K, nt = K / BK;
    unsigned voffA[2], voffB[2];
#pragma unroll
    for (int i = 0; i < 2; ++i) { int R, C; stage_rc(tid * 16 + i * 8192, R, C); const int Rb = Epi::PERM ? ((R & ~31) + perm32(R & 31)) : R;
        voffA[i] = (unsigned)(R * K + C) * 2u; voffB[i] = (unsigned)(Rb * K + C) * 2u; }
    const size_t kstep = (size_t)(BK * 2);
    const size_t hstep = (size_t)HALF * K * 2;
    const size_t tstep = 2 * hstep;
    const unsigned ldsw = (unsigned)wid * 1024u;
    const int aoff = lds_byte(wr * 64 + fr, fq * 8), boff = lds_byte(wc * 32 + fr, fq * 8);
#define PG8_SA(b, h) (((b) * 2 + (h)) * HTB)
#define PG8_SB(b, h) ((4 + (b) * 2 + (h)) * HTB)
#define PG8_STAGE(bufoff, gbase, voff) do { _Pragma("unroll") for (int _i = 0; _i < 2; ++_i) \
        __builtin_amdgcn_global_load_lds((const unsigned*)((const char*)(gbase) + (voff)[_i]), (PG8_LAS unsigned*)(lds + (bufoff) + ldsw + _i * 8192), 16, 0, 0); } while (0)
#define PG8_LDA(dst, b, h) do { _Pragma("unroll") for (int m = 0; m < 4; ++m) _Pragma("unroll") for (int k = 0; k < 2; ++k) dst[m][k] = *(const PG8_LAS bf16x8*)(lds + PG8_SA(b, h) + aoff + m * 2048 + k * 1024); } while (0)
#define PG8_LDB(dst, b, h) do { _Pragma("unroll") for (int n = 0; n < 2; ++n) _Pragma("unroll") for (int k = 0; k < 2; ++k) dst[n][k] = *(const PG8_LAS bf16x8*)(lds + PG8_SB(b, h) + boff + n * 2048 + k * 1024); } while (0)
#define PG8_MMA(ai, bj, At, Bt) do { __builtin_amdgcn_s_setprio(1); _Pragma("unroll") for (int m = 0; m < 4; ++m) _Pragma("unroll") for (int n = 0; n < 2; ++n) _Pragma("unroll") for (int k = 0; k < 2; ++k) \
        acc[ai][bj][m][n] = __builtin_amdgcn_mfma_f32_16x16x32_bf16(Bt[n][k], At[m][k], acc[ai][bj][m][n], 0, 0, 0); __builtin_amdgcn_s_setprio(0); } while (0)
#define PG8_WAIT_V(n) asm volatile("s_waitcnt vmcnt(" #n ")" ::: "memory")
#define PG8_WAIT_L(n) asm volatile("s_waitcnt lgkmcnt(" #n ")" ::: "memory")
#define PG8_BAR __builtin_amdgcn_s_barrier()
#define PG8_SCHED __builtin_amdgcn_sched_barrier(0)
    Unit cur, nxt; int ui = 0;
    if (!S.next(0, cur)) return;
    f32x4 acc[2][2][4][2];
#pragma unroll
    for (int a = 0; a < 2; ++a)
#pragma unroll
        for (int b = 0; b < 2; ++b)
#pragma unroll
            for (int m = 0; m < 4; ++m)
#pragma unroll
                for (int n = 0; n < 2; ++n) acc[a][b][m][n] = (f32x4){0.f, 0.f, 0.f, 0.f};
    bf16x8 At[4][2], B0[2][2], B1[2][2];
    const char* cA = (const char*)g.A + (size_t)cur.pm * tstep; const char* cB = (const char*)g.Bt + (size_t)cur.pn * tstep;
    S.a_ready(cur);
    if constexpr (SP2) {
        PG8_STAGE(PG8_SB(0, 0), cB, voffB); PG8_STAGE(PG8_SB(0, 1), cB + hstep, voffB); PG8_STAGE(PG8_SA(0, 0), cA, voffA); PG8_STAGE(PG8_SA(0, 1), cA + hstep, voffA);
        if (wr == 1) PG8_BAR;
        PG8_WAIT_V(2); PG8_BAR;
        PG8_STAGE(PG8_SB(1, 0), cB + kstep, voffB); PG8_STAGE(PG8_SA(1, 0), cA + kstep, voffA); PG8_STAGE(PG8_SB(1, 1), cB + hstep + kstep, voffB);
        PG8_WAIT_V(6); PG8_BAR;
    } else {
        PG8_STAGE(PG8_SB(0, 0), cB, voffB); PG8_STAGE(PG8_SA(0, 0), cA, voffA); PG8_STAGE(PG8_SB(0, 1), cB + hstep, voffB); PG8_STAGE(PG8_SA(0, 1), cA + hstep, voffA);
        if (wr == 1) PG8_BAR;
        PG8_WAIT_V(4); PG8_BAR;
        PG8_STAGE(PG8_SB(1, 0), cB + kstep, voffB); PG8_STAGE(PG8_SA(1, 0), cA + kstep, voffA); PG8_STAGE(PG8_SB(1, 1), cB + hstep + kstep, voffB);
        PG8_WAIT_V(6); PG8_BAR;
    }
    for (;;) {
        const bool has_next = S.next(ui + 1, nxt);
        const char* nA = has_next ? (const char*)g.A + (size_t)nxt.pm * tstep : cA; const char* nB = has_next ? (const char*)g.Bt + (size_t)nxt.pn * tstep : cB;
        for (int t = 0; t < nt; t += 2) {
            const bool last = (t == nt - 2);
            const char* a1 = cA + (size_t)(t + 1) * kstep;
            const char* a2 = last ? nA : cA + (size_t)(t + 2) * kstep; const char* b2 = last ? nB : cB + (size_t)(t + 2) * kstep;
            const char* a3 = a2 + kstep; const char* b3 = b2 + kstep;
            if (last && has_next) S.a_ready(nxt);
            if constexpr (SP2) {
            PG8_LDB(B0, 0, 0); PG8_LDB(B1, 0, 1); PG8_SCHED; PG8_LDA(At, 0, 0); PG8_STAGE(PG8_SA(1, 1), a1 + hstep, voffA);
            PG8_WAIT_V(8); PG8_WAIT_L(0); PG8_BAR; PG8_MMA(0, 0, At, B0); PG8_MMA(0, 1, At, B1); PG8_BAR; PG8_SCHED;
            PG8_LDA(At, 0, 1); PG8_STAGE(PG8_SB(0, 0), b2, voffB); PG8_STAGE(PG8_SB(0, 1), b2 + hstep, voffB); PG8_STAGE(PG8_SA(0, 0), a2, voffA);
            PG8_WAIT_V(8); PG8_WAIT_L(0); PG8_BAR; PG8_MMA(1, 0, At, B0); PG8_MMA(1, 1, At, B1); PG8_BAR; PG8_SCHED;
            PG8_LDB(B0, 1, 0); PG8_LDB(B1, 1, 1); PG8_SCHED; PG8_LDA(At, 1, 0); PG8_STAGE(PG8_SA(0, 1), a2 + hstep, voffA);
            PG8_WAIT_V(8); PG8_WAIT_L(0); PG8_BAR; PG8_MMA(0, 0, At, B0); PG8_MMA(0, 1, At, B1); PG8_BAR; PG8_SCHED;
            PG8_LDA(At, 1, 1); PG8_STAGE(PG8_SB(1, 0), b3, voffB); PG8_STAGE(PG8_SB(1, 1), b3 + hstep, voffB); PG8_STAGE(PG8_SA(1, 0), a3, voffA);
            PG8_WAIT_V(8); PG8_WAIT_L(0); PG8_BAR; PG8_MMA(1, 0, At, B0); PG8_MMA(1, 1, At, B1); PG8_BAR; PG8_SCHED;
            } else {
            PG8_LDB(B0, 0, 0); PG8_SCHED; PG8_LDA(At, 0, 0); PG8_STAGE(PG8_SA(1, 1), a1 + hstep, voffA);
            PG8_WAIT_L(8); PG8_BAR; PG8_WAIT_L(0); PG8_MMA(0, 0, At, B0); PG8_BAR; PG8_SCHED;
            PG8_LDB(B1, 0, 1); PG8_STAGE(PG8_SB(0, 0), b2, voffB);
            PG8_BAR; PG8_WAIT_L(0); PG8_MMA(0, 1, At, B1); PG8_BAR;
            PG8_LDA(At, 0, 1); PG8_STAGE(PG8_SA(0, 0), a2, voffA);
            PG8_BAR; PG8_WAIT_L(0); PG8_MMA(1, 0, At, B0); PG8_BAR; PG8_SCHED;
            PG8_STAGE(PG8_SB(0, 1), b2 + hstep, voffB);
            PG8_WAIT_V(6); PG8_BAR; PG8_MMA(1, 1, At, B1); PG8_BAR;
            PG8_LDB(B0, 1, 0); PG8_SCHED; PG8_LDA(At, 1, 0); PG8_STAGE(PG8_SA(0, 1), a2 + hstep, voffA);
            PG8_WAIT_L(8); PG8_BAR; PG8_WAIT_L(0); PG8_MMA(0, 0, At, B0); PG8_BAR; PG8_SCHED;
            PG8_LDB(B1, 1, 1); PG8_STAGE(PG8_SB(1, 0), b3, voffB);
            PG8_BAR; PG8_WAIT_L(0); PG8_MMA(0, 1, At, B1); PG8_BAR;
            PG8_LDA(At, 1, 1); PG8_STAGE(PG8_SA(1, 0), a3, voffA);
            PG8_BAR; PG8_WAIT_L(0); PG8_MMA(1, 0, At, B0); PG8_BAR; PG8_SCHED;
            PG8_STAGE(PG8_SB(1, 1), b3 + hstep, voffB);
            PG8_WAIT_V(6); PG8_BAR; PG8_MMA(1, 1, At, B1); PG8_BAR;
            }
        }
        if constexpr (ALIGN_EPI) { if (wr == 0) PG8_BAR; }
        if constexpr (!Epi::AFTER_DRAIN) { E(acc, cur, wr, wc, fr, fq); S.done(cur); }
        if (!has_next) break;
#pragma unroll
        for (int a = 0; a < 2; ++a)
#pragma unroll
            for (int b = 0; b < 2; ++b)
#pragma unroll
                for (int m = 0; m < 4; ++m)
#pragma unroll
                    for (int n = 0; n < 2; ++n) acc[a][b][m][n] = (f32x4){0.f, 0.f, 0.f, 0.f};
        cur = nxt; cA = nA; cB = nB; ++ui;
        if constexpr (ALIGN_EPI) { if (wr == 1) PG8_BAR; }
    }
    PG8_WAIT_V(0);
    if constexpr (!ALIGN_EPI) { if (wr == 0) PG8_BAR; }
    PG8_BAR;
    if constexpr (Epi::AFTER_DRAIN) { E.fused(acc, cur, wr, wc, fr, fq, lds, wid, lane); S.done(cur); }
#undef PG8_SA
#undef PG8_SB
#undef PG8_STAGE
#undef PG8_LDA
#undef PG8_LDB
#undef PG8_MMA
#undef PG8_WAIT_V
#undef PG8_WAIT_L
#undef PG8_BAR
#undef PG8_SCHED
}
}
namespace attn {
typedef unsigned short bf16r;
constexpr int   D = 128, NW = 8, QBLK = 32, KVBLK = 64;
constexpr float SCALE = 0.088388347648318440f;
constexpr float THR = 8.f;
constexpr int LDQ = 1024, LDK = 256, LDO = 1024;
constexpr size_t SHM_V = KVBLK * D * 2, SHM_K = KVBLK * D * 2, SHM_ATTN = 2 * SHM_V + 2 * SHM_K + NW * 64 * 4;
using bf16x8 = __attribute__((ext_vector_type(8))) short;
using s16x4  = __attribute__((ext_vector_type(4))) short;
using f32x16 = __attribute__((ext_vector_type(16))) float;
using f32x8  = __attribute__((ext_vector_type(8))) float;
using u32x4  = __attribute__((ext_vector_type(4))) unsigned;
#define KSWZ(row, colB) ((row) * 256 + ((colB) ^ (((row) & 7) << 4)))
#define SBAR() __builtin_amdgcn_sched_barrier(0)
__device__ __forceinline__ int crow(int r, int hi) { return (r & 3) + 8 * (r >> 2) + 4 * hi; }
__device__ __forceinline__ unsigned cvtpk(float lo, float hi) {
  unsigned r; asm volatile("v_cvt_pk_bf16_f32 %0, %1, %2" : "=v"(r) : "v"(lo), "v"(hi)); return r;
}
__device__ __forceinline__ void partialSM(f32x16& p0, f32x16& p1, float& m_reg, float& mn, float& alpha) {
  constexpr float C = SCALE * 1.4426950408889634f;
  float pmax = p0[0]; for (int r = 1; r < 16; ++r) pmax = fmaxf(pmax, p0[r]); for (int r = 0; r < 16; ++r) pmax = fmaxf(pmax, p1[r]);
  { auto rr = __builtin_amdgcn_permlane32_swap(__float_as_uint(pmax), __float_as_uint(pmax), false, false);
    pmax = fmaxf(__uint_as_float(rr[0]), __uint_as_float(rr[1])); }
  if (__builtin_expect(__all(pmax - m_reg <= THR / SCALE), 1)) { mn = m_reg; alpha = 1.f; }
  else { mn = fmaxf(m_reg, pmax); alpha = __builtin_amdgcn_exp2f((m_reg - mn) * C); m_reg = mn; }
  float mnC = -mn * C;
  for (int r = 0; r < 16; ++r) p0[r] = fmaf(p0[r], C, mnC); for (int r = 0; r < 16; ++r) p1[r] = fmaf(p1[r], C, mnC);
  for (int r = 0; r < 16; ++r) p0[r] = __builtin_amdgcn_exp2f(p0[r]);
}
__device__ __forceinline__ void finishSM(f32x16& p0, f32x16& p1, float alpha, float& l_reg, bf16x8& pa0, bf16x8& pa1, bf16x8& pa2, bf16x8& pa3) {
  for (int r = 0; r < 16; ++r) p1[r] = __builtin_amdgcn_exp2f(p1[r]);
  float ps = 0; for (int r = 0; r < 16; ++r) ps += p0[r]; for (int r = 0; r < 16; ++r) ps += p1[r];
  { auto rr = __builtin_amdgcn_permlane32_swap(__float_as_uint(ps), __float_as_uint(ps), false, false);
    ps = __uint_as_float(rr[0]) + __uint_as_float(rr[1]); }
  l_reg = l_reg * alpha + ps;
#define PK4(P, BASE, OUT) do { unsigned a0 = cvtpk(P[BASE + 0], P[BASE + 1]), a1 = cvtpk(P[BASE + 2], P[BASE + 3]);   \
    unsigned b0 = cvtpk(P[BASE + 4], P[BASE + 5]), b1 = cvtpk(P[BASE + 6], P[BASE + 7]);                              \
    auto r0 = __builtin_amdgcn_permlane32_swap(a0, b0, false, false); auto r1 = __builtin_amdgcn_permlane32_swap(a1, b1, false, false); \
    u32x4 w = {r0[0], r1[0], r0[1], r1[1]}; OUT = *reinterpret_cast<bf16x8*>(&w); } while (0)
  PK4(p0, 0, pa0); PK4(p0, 8, pa1); PK4(p1, 0, pa2); PK4(p1, 8, pa3);
#undef PK4
}
__device__ __forceinline__ void qkt(f32x16& p0, f32x16& p1, const bf16r* Ks, const bf16x8* qr, int r32, int hi) {
  p0 = f32x16{}; p1 = f32x16{};
  for (int d0 = 0; d0 < 8; ++d0) { int cb = (d0 * 16 + hi * 8) * 2;
    bf16x8 b0 = *reinterpret_cast<const bf16x8*>((const char*)Ks + KSWZ(r32, cb));
    bf16x8 b1 = *reinterpret_cast<const bf16x8*>((const char*)Ks + KSWZ(32 + r32, cb));
    p0 = __builtin_amdgcn_mfma_f32_32x32x16_bf16(b0, qr[d0], p0, 0, 0, 0);
    p1 = __builtin_amdgcn_mfma_f32_32x32x16_bf16(b1, qr[d0], p1, 0, 0, 0); }
}
__device__ __forceinline__ int v_st(int k, int c) { const int kk = (k & ~0xC) | ((k & 4) << 1) | ((k & 8) >> 1); return ((kk >> 3) * 4 + (c >> 5)) * 512 + ((kk & 7) * 32 + (c & 31)) * 2; }
__device__ __forceinline__ int v_rd_base(int lane) { return ((lane & 3) << 3) | (((lane >> 2) & 3) << 6) | (((lane >> 4) & 1) << 5) | (((lane >> 5) & 1) << 8); }
constexpr int v_rd_off(int d0, int ks, int half) { return d0 * 512 + ks * 4096 + half * 2048; }
template <int OFF> __device__ __forceinline__ s16x4 tr_read(int vb) {
  s16x4 r; asm volatile("ds_read_b64_tr_b16 %0, %1 offset:%2" : "=&v"(r) : "v"(vb), "i"(OFF) : "memory"); return r;
}
template <int D0> __device__ __forceinline__ void pv_one(f32x16& od, int vb, bf16x8 pa0, bf16x8 pa1, bf16x8 pa2, bf16x8 pa3) {
  const s16x4 l0 = tr_read<v_rd_off(D0, 0, 0)>(vb), h0 = tr_read<v_rd_off(D0, 0, 1)>(vb), l1 = tr_read<v_rd_off(D0, 1, 0)>(vb), h1 = tr_read<v_rd_off(D0, 1, 1)>(vb);
  const s16x4 l2 = tr_read<v_rd_off(D0, 2, 0)>(vb), h2 = tr_read<v_rd_off(D0, 2, 1)>(vb), l3 = tr_read<v_rd_off(D0, 3, 0)>(vb), h3 = tr_read<v_rd_off(D0, 3, 1)>(vb);
  asm volatile("s_waitcnt lgkmcnt(0)" ::: "memory"); SBAR();
#define PK(L, H) (bf16x8){L[0], L[1], L[2], L[3], H[0], H[1], H[2], H[3]}
  od = __builtin_amdgcn_mfma_f32_32x32x16_bf16(pa0, PK(l0, h0), od, 0, 0, 0);
  od = __builtin_amdgcn_mfma_f32_32x32x16_bf16(pa1, PK(l1, h1), od, 0, 0, 0);
  od = __builtin_amdgcn_mfma_f32_32x32x16_bf16(pa2, PK(l2, h2), od, 0, 0, 0);
  od = __builtin_amdgcn_mfma_f32_32x32x16_bf16(pa3, PK(l3, h3), od, 0, 0, 0);
#undef PK
}
__device__ __forceinline__ void pv_d0(f32x16* o, int vb, bf16x8 pa0, bf16x8 pa1, bf16x8 pa2, bf16x8 pa3) {
  pv_one<0>(o[0], vb, pa0, pa1, pa2, pa3); pv_one<1>(o[1], vb, pa0, pa1, pa2, pa3); pv_one<2>(o[2], vb, pa0, pa1, pa2, pa3); pv_one<3>(o[3], vb, pa0, pa1, pa2, pa3);
}
__device__ __forceinline__ void mask_meta(f32x16& p0, f32x16& p1) {
  const float NEG = -INFINITY;
#pragma unroll
  for (int r = 8; r < 16; ++r) p0[r] = NEG;
#pragma unroll
  for (int r = 0; r < 16; ++r) p1[r] = NEG;
}
__device__ __forceinline__ unsigned short f2bf_rne(float f) { unsigned u = __builtin_bit_cast(unsigned, f); return (unsigned short)((u + 0x7fffu + ((u >> 16) & 1u)) >> 16); }

__device__ __forceinline__ void attn_unit(const bf16r* Qb, const bf16r* __restrict__ Kh, const bf16r* __restrict__ Vh,
                                          const bf16r* __restrict__ KMh, const bf16r* __restrict__ VMh, bf16r* Ob, int NT, char* lds) {
  const int tid = threadIdx.x, wid = tid >> 6, lane = tid & 63, r32 = lane & 31, hi = lane >> 5;
  bf16r* V_lds = (bf16r*)lds; bf16r* K_lds = (bf16r*)(lds + 2 * SHM_V);
  float* ws = (float*)(lds + 2 * SHM_V + 2 * SHM_K) + wid * 64; float* li_l = ws; float* al_l = ws + 32;
  float m_reg = -1e30f, l_reg = 0; f32x16 o[4] = {}; bf16x8 qr[8];
  const bf16r* Qw = Qb + (long)(wid * QBLK + r32) * LDQ + hi * 8;
#pragma unroll
  for (int d0 = 0; d0 < 8; ++d0) qr[d0] = *reinterpret_cast<const bf16x8*>(Qw + d0 * 16);
  const int sr = tid >> 4, sc = (tid & 15) * 8, vst0 = v_st(sr, sc), vst1 = v_st(32 + sr, sc);
  const int vb0 = (int)(uintptr_t)V_lds + v_rd_base(lane);
  struct { bf16x8 vs0, vs1, ks0, ks1; } sr_[2];
#define LD8(p) (*reinterpret_cast<const bf16x8*>(p))
#define SLOAD(i, t) do { const bool last_ = ((t) == NT - 1); const bf16r* kp_ = last_ ? KMh : Kh + (long)(t) * KVBLK * LDK; const bf16r* vp_ = last_ ? VMh : Vh + (long)(t) * KVBLK * LDK; \
    sr_[i].vs0 = LD8(&vp_[(long)(sr) * LDK + sc]); sr_[i].vs1 = LD8(&vp_[(long)(32 + sr) * LDK + sc]); \
    sr_[i].ks0 = LD8(&kp_[(long)(sr) * LDK + sc]); sr_[i].ks1 = LD8(&kp_[(long)(32 + sr) * LDK + sc]); } while (0)
#define SWRITE(b, i) do { *(bf16x8*)((char*)V_lds + (b) * SHM_V + vst0) = sr_[i].vs0;          \
    *(bf16x8*)((char*)V_lds + (b) * SHM_V + vst1) = sr_[i].vs1; int kc = sc * 2;               \
    *(bf16x8*)((char*)K_lds + (b) * SHM_K + KSWZ(sr, kc)) = sr_[i].ks0;                       \
    *(bf16x8*)((char*)K_lds + (b) * SHM_K + KSWZ(32 + sr, kc)) = sr_[i].ks1; } while (0)
#define SWAIT() asm volatile("s_waitcnt vmcnt(4)" ::: "memory")
#define RESC(a) do { if (__any((a) < 1.f)) { if (hi == 0) al_l[r32] = (a); asm volatile("s_waitcnt lgkmcnt(0)" ::: "memory"); \
    for (int d = 0; d < 4; ++d) for (int r = 0; r < 16; ++r) o[d][r] *= al_l[crow(r, hi)]; } } while (0)
  f32x16 pA0, pA1, pB0, pB1; float mnA, mnB, alA, alB; bf16x8 pa0, pa1, pa2, pa3;
  constexpr int SE = 0, SO = 1;
  SLOAD(SE, 0); asm volatile("s_waitcnt vmcnt(0)" ::: "memory"); SWRITE(0, SE); __syncthreads();
  qkt(pA0, pA1, K_lds, qr, r32, hi); partialSM(pA0, pA1, m_reg, mnA, alA);
  SLOAD(SO, 1); SLOAD(SE, 2);
  SWAIT(); SWRITE(1, SO); __syncthreads();
  for (int j = 1; j + 1 < NT; j += 2) {
    SBAR(); qkt(pB0, pB1, (bf16r*)((char*)K_lds + SHM_K), qr, r32, hi);
    finishSM(pA0, pA1, alA, l_reg, pa0, pa1, pa2, pa3); SBAR();
    if (j + 2 < NT) SLOAD(SO, j + 2); SBAR();
    pv_d0(o, vb0, pa0, pa1, pa2, pa3); partialSM(pB0, pB1, m_reg, mnB, alB);
    __syncthreads(); SWAIT(); SWRITE(0, SE);
    RESC(alB); __syncthreads();
    SBAR(); qkt(pA0, pA1, K_lds, qr, r32, hi);
    if (j + 2 == NT) mask_meta(pA0, pA1);
    finishSM(pB0, pB1, alB, l_reg, pa0, pa1, pa2, pa3); SBAR();
    if (j + 3 < NT) SLOAD(SE, j + 3); SBAR();
    pv_d0(o, vb0 + (int)SHM_V, pa0, pa1, pa2, pa3); partialSM(pA0, pA1, m_reg, mnA, alA);
    __syncthreads(); SWAIT(); if (j + 2 < NT) SWRITE(1, SO);
    RESC(alA); __syncthreads();
  }
  finishSM(pA0, pA1, alA, l_reg, pa0, pa1, pa2, pa3); SBAR();
  pv_d0(o, vb0, pa0, pa1, pa2, pa3);
  if (hi == 0) li_l[r32] = l_reg; asm volatile("s_waitcnt lgkmcnt(0)" ::: "memory");
  float rli[16];
#pragma unroll
  for (int r = 0; r < 16; ++r) rli[r] = __builtin_amdgcn_rcpf(li_l[crow(r, hi)]);
  bf16r* Ow = Ob + (long)(wid * QBLK) * LDO;
#pragma unroll
  for (int r = 0; r < 16; ++r) { const int orow = crow(r, hi);
#pragma unroll
    for (int d0 = 0; d0 < 4; ++d0) Ow[(long)orow * LDO + d0 * 32 + r32] = f2bf_rne(o[d0][r] * rli[r]); }
  __syncthreads();
#undef LD8
#undef SLOAD
#undef SWRITE
#undef SWAIT
#undef RESC
}
#undef KSWZ
#undef SBAR
}

constexpr int NWAVES = 8;
constexpr int DM = 2048, NTOK = 65536, INW = 3584, FFN = 5632, UPW = 2 * FFN;
constexpr float EPS = 1e-6f;
constexpr int XR_ROWS = 8 * 4160 + 4 * 8256;
constexpr int NCHUNK = 8 * 65 + 4 * 129;
constexpr int QROWS = 16384;
__host__ __device__ __forceinline__ int seq_first_row(int s) { return s < 8 ? s * 4096 : 32768 + (s - 8) * 8192; }
__host__ __device__ __forceinline__ int seq_len(int s) { return s < 8 ? 4096 : 8192; }
__host__ __device__ __forceinline__ int xr_base(int s) { return s < 8 ? s * 4160 : 33280 + (s - 8) * 8256; }
__host__ __device__ __forceinline__ int chunk_base(int s) { return s < 8 ? s * 65 : 520 + (s - 8) * 129; }
__host__ __device__ __forceinline__ int row_seq(int row) { return row < 32768 ? (row >> 12) : 8 + ((row - 32768) >> 13); }

constexpr size_t MiB = 1u << 20, KiB = 1u << 10;
constexpr size_t WS_CTL = 0, CTL_ZERO_BYTES = 1 * MiB;
constexpr size_t WS_SMALL = 1 * MiB;
constexpr size_t WS_XNMETA = WS_SMALL + 0, WS_ZM = WS_SMALL + 64 * KiB, WS_KM = WS_SMALL + 320 * KiB, WS_VM = WS_SMALL + 352 * KiB, WS_Q15 = WS_SMALL + 384 * KiB, WS_GY15 = WS_SMALL + 388 * KiB,
                 WS_LO15 = WS_SMALL + 392 * KiB, WS_MIXED15 = WS_SMALL + 448 * KiB, WS_Y15 = WS_SMALL + 544 * KiB, WS_G15 = WS_SMALL + 640 * KiB, WS_MQP = WS_SMALL + 1024 * KiB;
constexpr size_t WS_WIN = 5 * MiB, WS_WOUT = 19 * MiB, WS_WUP = 27 * MiB, WS_WDOWN = 71 * MiB, WS_WG = 93 * MiB;
constexpr size_t WS_CAR = 94 * MiB, WS_CIN = 111 * MiB;
constexpr size_t WS_A = 120 * MiB;
constexpr size_t WS_B = 376 * MiB;
constexpr size_t WS_Q = WS_B, WS_K = WS_B + 128 * MiB, WS_V = WS_B + 160 * MiB, WS_XR = WS_B + 192 * MiB, WS_GY = WS_B + 322 * MiB;
constexpr size_t WS_Y1 = WS_B, WS_UP = WS_B, WS_ACT = WS_B + 352 * MiB;
constexpr size_t WS_END = WS_B + 528 * MiB;
static_assert(WS_ZM + 16 * INW * 4 <= WS_KM && WS_G15 + 12 * FFN * 4 <= WS_MQP && WS_MQP + 512 * 4 * 132 * 4 <= WS_WIN, "small map");
static_assert(WS_WIN + (size_t)INW * DM * 2 <= WS_WOUT && WS_WOUT + (size_t)DM * DM * 2 <= WS_WUP && WS_WUP + (size_t)UPW * DM * 2 <= WS_WDOWN && WS_WDOWN + (size_t)DM * FFN * 2 <= WS_WG && WS_WG + 32 * 16384 * 2 <= WS_CAR, "weights map");
static_assert(WS_CAR + (size_t)NCHUNK * 2 * 1024 * 8 <= WS_CIN && WS_CIN + (size_t)NCHUNK * 2 * 1024 * 4 <= WS_A && WS_A + (size_t)NTOK * DM * 2 <= WS_B, "carry map");
static_assert(WS_XR + (size_t)(XR_ROWS + 64) * 1024 * 2 <= WS_GY && WS_GY + (size_t)NTOK * 1024 * 2 <= WS_END && WS_UP + (size_t)QROWS * UPW * 2 <= WS_ACT && WS_ACT + (size_t)QROWS * FFN * 2 <= WS_END, "B map");
constexpr int CW_BAR = 4096;

constexpr int RING_BYTES = 131072;
constexpr int LDSCTL_OFF = RING_BYTES, MISC_OFF = LDSCTL_OFF + 320;
constexpr int LDS_BYTES = 147456;

#define GAS __attribute__((address_space(1)))
#define LAS __attribute__((address_space(3)))
typedef unsigned short bf16;
typedef unsigned v4u __attribute__((ext_vector_type(4)));
typedef float f32x4 __attribute__((ext_vector_type(4)));
typedef short bf16x8 __attribute__((ext_vector_type(8)));
typedef GAS unsigned gu32;
typedef GAS unsigned long long gu64;
#define RLX_AGENT __ATOMIC_RELAXED, __HIP_MEMORY_SCOPE_AGENT
#define LDS_WAIT() asm volatile("s_waitcnt lgkmcnt(0)" ::: "memory")
#define VM_WAIT() asm volatile("s_waitcnt vmcnt(0)" ::: "memory")
__device__ __forceinline__ unsigned long long rt() { return __builtin_amdgcn_s_memrealtime(); }
__device__ __forceinline__ unsigned f2bf(float f) { unsigned u = __builtin_bit_cast(unsigned, f); return (u + 0x7fffu + ((u >> 16) & 1u)) >> 16; }
__device__ __forceinline__ unsigned pk2(float lo, float hi) { return f2bf(lo) | (f2bf(hi) << 16); }

#define XB_TMO      128
#define XB_XCNT(j)  (256  + 64 * (j))
#define XB_XSUB(j)  (1280 + 64 * (j))
#define XB_XGEN(j)  (2304 + 64 * (j))
#define XB_TOP      3328
#define XB_TOPGEN   3392
#define XCD_BAR_WORDS 3456
#define XB_SPIN_CAP (1u << 18)

__device__ __forceinline__ unsigned xb_ld(unsigned* p)              { return __hip_atomic_load(p, __ATOMIC_RELAXED, __HIP_MEMORY_SCOPE_AGENT); }
__device__ __forceinline__ unsigned xb_add(unsigned* p, unsigned v) { return __hip_atomic_fetch_add(p, v, __ATOMIC_RELAXED, __HIP_MEMORY_SCOPE_AGENT); }
__device__ __forceinline__ unsigned xb_xcc_id() { return (unsigned)__builtin_amdgcn_s_getreg((3 << 11) | 20) & 0xFu; }
#define XB_SPIN(cond, bar) do { unsigned _sp = 0; while (cond) { __builtin_amdgcn_s_sleep(1); \
    if ((++_sp & 255u) == 0u) { if (xb_ld(&(bar)[XB_TMO])) break; if (_sp > XB_SPIN_CAP) { atomicAdd(&(bar)[XB_TMO], 1u); break; } } } } while (0)

struct XcdBarrier {
    unsigned* bar; unsigned x;
    volatile LAS unsigned* st;
};

__device__ __forceinline__ XcdBarrier xcd_barrier_post(unsigned* bar, volatile LAS unsigned* st) {
    XcdBarrier b; b.bar = bar; b.x = xb_xcc_id(); b.st = st;
    if (threadIdx.x == 0) (void)xb_add(&bar[XB_XCNT(b.x)], 1u);
    return b;
}
__device__ __forceinline__ void xcd_barrier_complete(unsigned* bar, unsigned x, unsigned& nloc, unsigned& nx) {
    const unsigned G = gridDim.x * gridDim.y * gridDim.z;
    unsigned sum, cnt, mine, sp = 0u;
    for (;;) {
        sum = 0u; cnt = 0u; mine = 0u;
#pragma unroll
        for (unsigned j = 0; j < 16; ++j) { const unsigned c = xb_ld(&bar[XB_XCNT(j)]); sum += c; cnt += (c > 0u) ? 1u : 0u; mine = (j == x) ? c : mine; }
        if (sum == G) break;
        __builtin_amdgcn_s_sleep(1);
        if ((++sp & 255u) == 0u) { if (xb_ld(&bar[XB_TMO])) break; if (sp > XB_SPIN_CAP) { atomicAdd(&bar[XB_TMO], 1u); break; } }
    }
    nloc = mine > 0u ? mine : 1u; nx = cnt > 0u ? cnt : 1u;
}

__device__ __forceinline__ void xcd_barrier(const XcdBarrier& b) {
    asm volatile("s_waitcnt vmcnt(0)" ::: "memory");
    __syncthreads();
    if (threadIdx.x == 0) {
        unsigned* bar = b.bar;
        __builtin_amdgcn_s_waitcnt(0);
        unsigned nloc = b.st[0], nx = b.st[1];
        if (nloc == 0u) { xcd_barrier_complete(bar, b.x, nloc, nx); b.st[0] = nloc; b.st[1] = nx; }
        const unsigned old = xb_add(&bar[XB_XSUB(b.x)], 1u);
        const unsigned gen = old / nloc;
        if (old + 1u == (gen + 1u) * nloc) {
            __builtin_amdgcn_fence(__ATOMIC_RELEASE, "agent");
            asm volatile("s_waitcnt vmcnt(0)" ::: "memory");
            const unsigned og = xb_add(&bar[XB_TOP], 1u);
            const unsigned tg = og / nx;
            if (og + 1u == (tg + 1u) * nx) xb_add(&bar[XB_TOPGEN], 1u);
            else XB_SPIN(xb_ld(&bar[XB_TOPGEN]) == tg, bar);
            __builtin_amdgcn_fence(__ATOMIC_ACQUIRE, "agent");
            xb_add(&bar[XB_XGEN(b.x)], 1u);
            asm volatile("s_waitcnt vmcnt(0)" ::: "memory");
        } else {
            XB_SPIN(xb_ld(&bar[XB_XGEN(b.x)]) == gen, bar);
            __builtin_amdgcn_fence(__ATOMIC_ACQUIRE, "agent");
            asm volatile("s_waitcnt vmcnt(0)" ::: "memory");
        }
    }
    __syncthreads();
}

__device__ __forceinline__ float bf2f(unsigned short b) { return __builtin_bit_cast(float, (unsigned)b << 16); }
__device__ __forceinline__ float bf2f(short b) { return __builtin_bit_cast(float, (unsigned)(unsigned short)b << 16); }
__device__ __forceinline__ float wave_sum(float v) {
#pragma unroll
    for (int o = 1; o < 64; o <<= 1) v += __shfl_xor(v, o);
    return v;
}
__device__ __forceinline__ float wave_max(float v) {
#pragma unroll
    for (int o = 1; o < 64; o <<= 1) v = fmaxf(v, __shfl_xor(v, o));
    return v;
}
__device__ __forceinline__ float fast_exp(float x) { return __builtin_amdgcn_exp2f(x * 1.4426950408889634f); }
__device__ __forceinline__ float sigmoidf_(float x) { return __builtin_amdgcn_rcpf(1.f + fast_exp(-x)); }
__device__ __forceinline__ float gelu_tanh(float x) {
    const float z = 0.7978845608028654f * (x + 0.044715f * x * x * x);
    return x * sigmoidf_(2.f * z);
}
__device__ __forceinline__ float neg_expm1(float x) {
    const float p = x * (1.f + x * (0.5f + x * (0.16666667f + x * (0.041666668f + x * (0.0083333338f + x * 0.0013888889f)))));
    const float e = fast_exp(x) - 1.f;
    return -(fabsf(x) < 0.25f ? p : e);
}
__device__ __forceinline__ v4u pack8(const float (&v)[8]) { v4u o; o.x = pk2(v[0], v[1]); o.y = pk2(v[2], v[3]); o.z = pk2(v[4], v[5]); o.w = pk2(v[6], v[7]); return o; }

struct Frame {
    LAS unsigned char* lds;
    volatile LAS unsigned* MISC;
    gu32* ctl;
    int tid, lane, wave, vcu, G;
    const float *x_prompt, *x_sample, *meta, *g_pre_mix, *w_in, *q_norm, *k_norm, *lru_conv_w, *lru_conv_b, *lru_w_r, *lru_b_r, *lru_w_i, *lru_b_i, *lru_lambda,
                *g_attn_out, *g_lru_out, *w_out, *g_post_mix, *g_pre_ffn, *w_up, *ffn_conv_w, *ffn_conv_b, *w_down, *g_post_ffn;
    float* out;
    unsigned char* ws;
#define WSP(T, NAME, OFF) __device__ __forceinline__ T* NAME() const { return (T*)(ws + (OFF)); }
    WSP(bf16, WIN_T, WS_WIN) WSP(bf16, WOUT_T, WS_WOUT) WSP(bf16, WUP_T, WS_WUP) WSP(bf16, WDOWN_T, WS_WDOWN) WSP(bf16, WG, WS_WG) WSP(bf16, XN, WS_A) WSP(bf16, Q, WS_Q) WSP(bf16, K, WS_K) WSP(bf16, V, WS_V)
    WSP(bf16, XR, WS_XR) WSP(bf16, GY, WS_GY) WSP(bf16, Y1, WS_Y1) WSP(bf16, UP, WS_UP) WSP(bf16, ACT, WS_ACT) WSP(bf16, XNMETA, WS_XNMETA) WSP(bf16, KM, WS_KM) WSP(bf16, VM, WS_VM)
    WSP(float, ZM, WS_ZM) WSP(float, Q15, WS_Q15) WSP(float, GY15, WS_GY15) WSP(float, LO15, WS_LO15) WSP(float, MIXED15, WS_MIXED15) WSP(float, Y15, WS_Y15) WSP(float, G15, WS_G15) WSP(float, MQP, WS_MQP)
    WSP(float, CIN, WS_CIN) WSP(float2, CAR, WS_CAR)
#undef WSP
};

__device__ __forceinline__ void p0_transpose_item(const float* W, int K, int N, bf16* WT, int row_off, LAS float* scr, int item, int lane) {
    const int nblk = N / 32, kb = item / nblk, nb = item % nblk, k0 = 64 * kb, n0 = 32 * nb;
#pragma unroll 8
    for (int i = 0; i < 32; ++i) { const int kk = 2 * i + (lane >> 5); scr[kk * 33 + (lane & 31)] = W[(size_t)(k0 + kk) * N + n0 + (lane & 31)]; }
    LDS_WAIT(); asm volatile("" ::: "memory");
    const int c = lane & 7;
#pragma unroll
    for (int j = 0; j < 4; ++j) { const int n = (lane >> 3) + 8 * j; const LAS float* s = scr + (8 * c) * 33 + n;
        v4u o; o.x = pk2(s[0 * 33], s[1 * 33]); o.y = pk2(s[2 * 33], s[3 * 33]); o.z = pk2(s[4 * 33], s[5 * 33]); o.w = pk2(s[6 * 33], s[7 * 33]);
        *(GAS v4u*)(WT + (size_t)(row_off + n0 + n) * K + k0 + 8 * c) = o; }
    LDS_WAIT(); asm volatile("" ::: "memory");
}
__device__ __forceinline__ void rms_row_to_bf16(const float* xrow, const float* g, bf16* orow, int lane) {
    const GAS f32x4* xr = (const GAS f32x4*)xrow + lane;
    f32x4 v[8]; float s = 0.f;
#pragma unroll
    for (int j = 0; j < 8; ++j) { v[j] = xr[64 * j]; s += (v[j].x * v[j].x + v[j].y * v[j].y) + (v[j].z * v[j].z + v[j].w * v[j].w); }
    const float r = 1.f / sqrtf(wave_sum(s) * (1.f / DM) + EPS);
    const GAS f32x4* gr = (const GAS f32x4*)g + lane;
    GAS unsigned long long* o8 = (GAS unsigned long long*)orow + lane;
#pragma unroll
    for (int j = 0; j < 8; ++j) { const f32x4 gg = gr[64 * j];
        o8[64 * j] = (unsigned long long)pk2(v[j].x * r * gg.x, v[j].y * r * gg.y) | ((unsigned long long)pk2(v[j].z * r * gg.z, v[j].w * r * gg.w) << 32); }
}
__device__ __forceinline__ void p0_prologue(Frame& F) {
    LAS float* scr = (LAS float*)(F.lds + F.wave * 16384);
    const int gw = F.vcu * NWAVES + F.wave, NGW = F.G * NWAVES;
    constexpr int I_IN = (DM / 64) * (INW / 32), I_OUT = (DM / 64) * (DM / 32), I_UP = (DM / 64) * (UPW / 32), I_DN = (FFN / 64) * (DM / 32), I_G = 32 * 8;
    constexpr int NITEMS = I_IN + I_OUT + I_UP + I_DN + I_G;
    for (int it = gw; it < NITEMS; it += NGW) {
        int r = it;
        if (r < I_IN) { p0_transpose_item(F.w_in, DM, INW, F.WIN_T(), 0, scr, r, F.lane); continue; } r -= I_IN;
        if (r < I_OUT) { p0_transpose_item(F.w_out, DM, DM, F.WOUT_T(), 0, scr, r, F.lane); continue; } r -= I_OUT;
        if (r < I_UP) { p0_transpose_item(F.w_up, DM, UPW, F.WUP_T(), 0, scr, r, F.lane); continue; } r -= I_UP;
        if (r < I_DN) { p0_transpose_item(F.w_down, FFN, DM, F.WDOWN_T(), 0, scr, r, F.lane); continue; } r -= I_DN;
        {
            const int mi = r >> 3, sub = r & 7, gate = mi >> 4, dir = (mi >> 3) & 1, blk = mi & 7;
            const float* W = (gate ? F.lru_w_i : F.lru_w_r) + (size_t)(dir * 8 + blk) * 16384;
            bf16* WT = F.WG() + (size_t)((dir * 2 + gate) * 8 + blk) * 16384;
            p0_transpose_item(W, 128, 128, WT, 0, scr, sub, F.lane);
        }
    }
    for (int m = gw; m < NTOK; m += NGW) {
        const float* xr = m < 32768 ? F.x_prompt + (size_t)m * DM : F.x_sample + (size_t)(m - 32768) * DM;
        rms_row_to_bf16(xr, F.g_pre_mix, F.XN() + (size_t)m * DM, F.lane);
    }
    for (int m = gw; m < 16; m += NGW) rms_row_to_bf16(F.meta + (size_t)m * DM, F.g_pre_mix, F.XNMETA() + (size_t)m * DM, F.lane);
    const int gt = F.vcu * 512 + F.tid, NGT = F.G * 512; const v4u z4 = {0u, 0u, 0u, 0u};
    for (int i = gt; i < 12 * 48 * 128; i += NGT) { const int s = i / (48 * 128), rem = i % (48 * 128); ((GAS v4u*)(F.XR() + (size_t)xr_base(s) * 1024))[rem] = z4; }
    for (int i = gt; i < 64 * 128; i += NGT) ((GAS v4u*)(F.XR() + (size_t)XR_ROWS * 1024))[i] = z4;
    for (int i = gt; i < 2048; i += NGT) { ((GAS v4u*)F.KM())[i] = z4; ((GAS v4u*)F.VM())[i] = z4; }
}

template <int R, class Out>
__device__ __forceinline__ void small_gemm(const LAS float* X, int K, const bf16* Wt, int N, int gw, int NGW, int lane, const Out& out) {
    for (int n = gw; n < N; n += NGW) {
        float acc[R];
#pragma unroll
        for (int r = 0; r < R; ++r) acc[r] = 0.f;
        const GAS bf16x8* wrow = (const GAS bf16x8*)(Wt + (size_t)n * K);
        for (int k8 = lane; k8 < K / 8; k8 += 64) {
            const bf16x8 w = wrow[k8]; float wf[8];
#pragma unroll
            for (int j = 0; j < 8; ++j) wf[j] = bf2f(w[j]);
#pragma unroll
            for (int r = 0; r < R; ++r) { const LAS f32x4* xp = (const LAS f32x4*)(X + r * K + k8 * 8); const f32x4 a = xp[0], b = xp[1];
                acc[r] += (a.x * wf[0] + a.y * wf[1]) + (a.z * wf[2] + a.w * wf[3]) + (b.x * wf[4] + b.y * wf[5]) + (b.z * wf[6] + b.w * wf[7]); }
        }
        float v = 0.f;
#pragma unroll
        for (int r = 0; r < R; ++r) { const float s = wave_sum(acc[r]); v = (lane == r) ? s : v; }
        out(n, lane, v);
    }
}
struct OutMetaZ { float* ZM; bf16* XR;
    __device__ __forceinline__ void operator()(int n, int lane, float v) const {
        if (lane < 16) { ZM[lane * INW + n] = v;
            if (n >= 1536 && n < 2560) { const unsigned short b = (unsigned short)f2bf(v); const int c = n - 1536;
                for (int s = 0; s < 12; ++s) XR[(size_t)(xr_base(s) + 48 + lane) * 1024 + c] = b; } }
    } };
struct OutRows { float* Y; int ld; int R;
    __device__ __forceinline__ void operator()(int n, int lane, float v) const { if (lane < R) Y[(size_t)lane * ld + n] = v; } };

__device__ __forceinline__ void p1_meta_z(Frame& F) {
    LAS float* X = (LAS float*)F.lds;
    for (int i = F.tid; i < 16 * DM / 8; i += 512) { const bf16x8 v = ((const GAS bf16x8*)F.XNMETA())[i];
        ((LAS f32x4*)X)[2 * i] = (f32x4){bf2f(v[0]), bf2f(v[1]), bf2f(v[2]), bf2f(v[3])}; ((LAS f32x4*)X)[2 * i + 1] = (f32x4){bf2f(v[4]), bf2f(v[5]), bf2f(v[6]), bf2f(v[7])}; }
    __syncthreads();
    const OutMetaZ o{F.ZM(), F.XR()};
    small_gemm<16, OutMetaZ>(X, DM, F.WIN_T(), INW, F.vcu * NWAVES + F.wave, F.G * NWAVES, F.lane, o);
    __syncthreads();
}
typedef float f32x16 __attribute__((ext_vector_type(16)));
constexpr int LRU_XCB = 0, LRU_XCB_STRIDE = 272;
constexpr int LRU_XCF = 17408;
constexpr int LRU_HF = LRU_XCF + 32768, LRU_HB = LRU_HF + 32768;
__device__ __forceinline__ int crow16(int r, int hi) { return (r & 3) + 8 * (r >> 2) + 4 * hi; }

template <int DIR>
__device__ __forceinline__ void scan_tile(const float (&a)[16], const float (&u)[16], float& carry, float& ptot, float (&h)[16], bool up) {
    float HL[16], PL[16], As[4], Hs[4];
#pragma unroll
    for (int j = 0; j < 4; ++j) {
        float hl = 0.f, p = 1.f;
#pragma unroll
        for (int ii = 0; ii < 4; ++ii) { const int idx = 4 * j + (DIR == 0 ? ii : 3 - ii); hl = a[idx] * hl + u[idx]; p *= a[idx]; HL[idx] = hl; PL[idx] = p; }
        As[j] = p; Hs[j] = hl;
    }
    float Alo[4], Ahi[4], Hlo[4], Hhi[4];
#pragma unroll
    for (int j = 0; j < 4; ++j) {
        { const unsigned x = __float_as_uint(As[j]); auto rr = __builtin_amdgcn_permlane32_swap(x, x, false, false); Alo[j] = __uint_as_float(rr[0]); Ahi[j] = __uint_as_float(rr[1]); }
        { const unsigned x = __float_as_uint(Hs[j]); auto rr = __builtin_amdgcn_permlane32_swap(x, x, false, false); Hlo[j] = __uint_as_float(rr[0]); Hhi[j] = __uint_as_float(rr[1]); }
    }
    float cin[4]; float c = carry;
    if (DIR == 0) {
#pragma unroll
        for (int j = 0; j < 4; ++j) { const float c_lo = c; c = Alo[j] * c + Hlo[j]; const float c_hi = c; c = Ahi[j] * c + Hhi[j]; cin[j] = up ? c_hi : c_lo; }
    } else {
#pragma unroll
        for (int j = 3; j >= 0; --j) { const float c_hi = c; c = Ahi[j] * c + Hhi[j]; const float c_lo = c; c = Alo[j] * c + Hlo[j]; cin[j] = up ? c_hi : c_lo; }
    }
    carry = c;
#pragma unroll
    for (int j = 0; j < 4; ++j) ptot *= Alo[j] * Ahi[j];
#pragma unroll
    for (int idx = 0; idx < 16; ++idx) h[idx] = HL[idx] + PL[idx] * cin[idx >> 2];
}

template <int PASS>
__device__ __forceinline__ void lru_unit(Frame& F, int seq, int c, int n, int cg) {
    LAS unsigned char* L = F.lds;
    const int tid = F.tid, lane = F.lane, wave = F.wave;
    const int xb = xr_base(seq);
    for (int it = tid; it < 1024; it += 512) {
        const int tau = it >> 4, co = (it & 15) * 8, pp = c * 64 + tau, chg = n * 128 + co;
        float xc[8];
        { const GAS f32x4* cb = (const GAS f32x4*)(F.lru_conv_b + chg); const f32x4 b0 = cb[0], b1 = cb[1];
          xc[0] = b0.x; xc[1] = b0.y; xc[2] = b0.z; xc[3] = b0.w; xc[4] = b1.x; xc[5] = b1.y; xc[6] = b1.z; xc[7] = b1.w; }
#pragma unroll
        for (int k = 0; k < 4; ++k) {
            int row = xb + pp + k - 2; row = row < 0 ? 0 : row;
            const bf16x8 xv = *(const GAS bf16x8*)(F.XR() + (size_t)row * 1024 + chg);
            const GAS f32x4* wp = (const GAS f32x4*)(F.lru_conv_w + k * 1024 + chg); const f32x4 w0 = wp[0], w1 = wp[1];
            xc[0] += w0.x * bf2f(xv[0]); xc[1] += w0.y * bf2f(xv[1]); xc[2] += w0.z * bf2f(xv[2]); xc[3] += w0.w * bf2f(xv[3]);
            xc[4] += w1.x * bf2f(xv[4]); xc[5] += w1.y * bf2f(xv[5]); xc[6] += w1.z * bf2f(xv[6]); xc[7] += w1.w * bf2f(xv[7]);
        }
        if (c == 0 && tau < 48) {
#pragma unroll
            for (int j = 0; j < 8; ++j) xc[j] = 0.f;
        }
        LAS f32x4* xf = (LAS f32x4*)(L + LRU_XCF + (tau * 128 + co) * 4);
        xf[0] = (f32x4){xc[0], xc[1], xc[2], xc[3]}; xf[1] = (f32x4){xc[4], xc[5], xc[6], xc[7]};
        *(LAS v4u*)(L + LRU_XCB + tau * LRU_XCB_STRIDE + co * 2) = pack8(xc);
    }
    __syncthreads();
    {
        const int d = wave >> 2, g4 = wave & 3, r32 = lane & 31, hi = lane >> 5;
        const int chl = g4 * 32 + r32, chg = n * 128 + chl;
        const bf16* wr_ = F.WG() + (size_t)((d * 2 + 0) * 8 + n) * 16384 + chl * 128 + hi * 8;
        const bf16* wi_ = F.WG() + (size_t)((d * 2 + 1) * 8 + n) * 16384 + chl * 128 + hi * 8;
        bf16x8 br[8], bi[8];
#pragma unroll
        for (int ks = 0; ks < 8; ++ks) { br[ks] = *(const GAS bf16x8*)(wr_ + ks * 16); bi[ks] = *(const GAS bf16x8*)(wi_ + ks * 16); }
        const float b_r = F.lru_b_r[d * 1024 + chg], b_i = F.lru_b_i[d * 1024 + chg];
        const float sp8 = 8.f * log1pf(expf(-F.lru_lambda[d * 1024 + chg]));
        float carry = 0.f, ptot = 1.f;
        if (PASS == 2) carry = F.CIN()[((size_t)cg * 2 + d) * 1024 + chg];
#pragma unroll
        for (int tt = 0; tt < 2; ++tt) {
            const int tile = d ? 1 - tt : tt;
            f32x16 ar = {}, ai = {};
#pragma unroll
            for (int ks = 0; ks < 8; ++ks) {
                const bf16x8 a = *(const LAS bf16x8*)(L + LRU_XCB + (tile * 32 + r32) * LRU_XCB_STRIDE + (ks * 16 + hi * 8) * 2);
                ar = __builtin_amdgcn_mfma_f32_32x32x16_bf16(a, br[ks], ar, 0, 0, 0);
                ai = __builtin_amdgcn_mfma_f32_32x32x16_bf16(a, bi[ks], ai, 0, 0, 0);
            }
            float av[16], uv[16], hv[16];
#pragma unroll
            for (int r = 0; r < 16; ++r) {
                const int tau = tile * 32 + crow16(r, hi);
                const float xcv = *(const LAS float*)(L + LRU_XCF + (tau * 128 + chl) * 4);
                const float rg = sigmoidf_(ar[r] + b_r), ig = sigmoidf_(ai[r] + b_i);
                const float la = -sp8 * rg;
                av[r] = fast_exp(la);
                uv[r] = sqrtf(neg_expm1(2.f * la)) * (ig * xcv);
            }
            if (d == 0) scan_tile<0>(av, uv, carry, ptot, hv, hi != 0); else scan_tile<1>(av, uv, carry, ptot, hv, hi != 0);
            if (PASS == 2) {
#pragma unroll
                for (int r = 0; r < 16; ++r) { const int tau = tile * 32 + crow16(r, hi); *(LAS float*)(L + (d ? LRU_HB : LRU_HF) + (tau * 128 + chl) * 4) = hv[r]; }
            }
        }
        if (PASS == 1) { if (hi == 0) F.CAR()[((size_t)cg * 2 + d) * 1024 + chg] = make_float2(ptot, carry); }
    }
    if (PASS == 2) {
        __syncthreads();
        if (c > 0) {
            const int row0 = seq_first_row(seq) + 64 * (c - 1);
            for (int it = tid; it < 1024; it += 512) {
                const int tau = it >> 4, co = (it & 15) * 8;
                bf16* gp = F.GY() + (size_t)(row0 + tau) * 1024 + n * 128 + co;
                const bf16x8 gv = *(const GAS bf16x8*)gp;
                const LAS f32x4* hf = (const LAS f32x4*)(L + LRU_HF + (tau * 128 + co) * 4); const LAS f32x4* hb = (const LAS f32x4*)(L + LRU_HB + (tau * 128 + co) * 4);
                const f32x4 f0 = hf[0], f1 = hf[1], b0 = hb[0], b1 = hb[1];
                float o[8];
                o[0] = (f0.x + b0.x) * gelu_tanh(bf2f(gv[0])); o[1] = (f0.y + b0.y) * gelu_tanh(bf2f(gv[1])); o[2] = (f0.z + b0.z) * gelu_tanh(bf2f(gv[2])); o[3] = (f0.w + b0.w) * gelu_tanh(bf2f(gv[3]));
                o[4] = (f1.x + b1.x) * gelu_tanh(bf2f(gv[4])); o[5] = (f1.y + b1.y) * gelu_tanh(bf2f(gv[5])); o[6] = (f1.z + b1.z) * gelu_tanh(bf2f(gv[6])); o[7] = (f1.w + b1.w) * gelu_tanh(bf2f(gv[7]));
                *(GAS v4u*)gp = pack8(o);
            }
        } else if (tid < 128) {
            const float hf = *(const LAS float*)(L + LRU_HF + (63 * 128 + tid) * 4), hb = *(const LAS float*)(L + LRU_HB + (63 * 128 + tid) * 4);
            F.LO15()[seq * 1024 + n * 128 + tid] = (hf + hb) * gelu_tanh(F.GY15()[n * 128 + tid]);
        }
    }
    __syncthreads();
}
template <int PASS>
__device__ __forceinline__ void lru_phase(Frame& F) {
    for (int uid = F.vcu; uid < NCHUNK * 8; uid += F.G) {
        const int cg = uid >> 3, n = uid & 7; int seq, c;
        if (cg < 520) { seq = cg / 65; c = cg - seq * 65; } else { const int c2 = cg - 520; seq = c2 / 129; c = c2 - seq * 129; seq += 8; }
        lru_unit<PASS>(F, seq, c, n, cg);
    }
}
__device__ __forceinline__ void lru_propagate(Frame& F) {
    const int gid = F.vcu * 512 + F.tid;
    if (gid < 12 * 2048) {
        const int s = gid >> 11, d = (gid >> 10) & 1, ch = gid & 1023; const int nch = s < 8 ? 65 : 129, cb = chunk_base(s);
        float cin = 0.f;
        if (d == 0) {
#pragma unroll 8
            for (int c = 0; c < nch; ++c) { const size_t idx = ((size_t)(cb + c) * 2 + 0) * 1024 + ch; F.CIN()[idx] = cin; const float2 ph = F.CAR()[idx]; cin = ph.x * cin + ph.y; }
        } else {
#pragma unroll 8
            for (int c = nch - 1; c >= 0; --c) { const size_t idx = ((size_t)(cb + c) * 2 + 1) * 1024 + ch; F.CIN()[idx] = cin; const float2 ph = F.CAR()[idx]; cin = ph.x * cin + ph.y; }
        }
    }
}

__device__ __forceinline__ void qk_rope_row(Frame& F, int row, int lane) {
    const int s = row_seq(row), t = row - seq_first_row(s);
    const int p = lane >> 5, i = lane & 31;
    const float pos = (float)(p ? (t & 63) : (t >> 6));
    const float inv = __builtin_amdgcn_exp2f(-(float)i * (13.287712379549449f / 32.f));
    float rev = pos * inv * 0.15915494309189535f; rev -= floorf(rev);
    const float sn = __builtin_amdgcn_sinf(rev), cs = __builtin_amdgcn_cosf(rev);
    const int d1 = p * 64 + i, d2 = d1 + 32;
#pragma unroll
    for (int h = 0; h < 10; ++h) {
        bf16* base = h < 8 ? F.Q() + (size_t)row * 1024 + h * 128 : F.K() + (size_t)row * 256 + (h - 8) * 128;
        const float* gn = h < 8 ? F.q_norm : F.k_norm;
        float x1 = bf2f(base[d1]), x2 = bf2f(base[d2]);
        const float r = 1.f / sqrtf(wave_sum(x1 * x1 + x2 * x2) * (1.f / 128.f) + EPS);
        x1 *= r * gn[d1]; x2 *= r * gn[d2];
        base[d1] = (bf16)f2bf(x1 * cs - x2 * sn); base[d2] = (bf16)f2bf(x2 * cs + x1 * sn);
    }
}
__device__ __forceinline__ void p3_meta_job(Frame& F) {
    for (int pr = F.wave; pr < 32; pr += 8) { const int r = pr >> 1, hk = pr & 1; const float* z = F.ZM() + r * INW + 1024 + hk * 128;
        const float a = z[F.lane], b = z[F.lane + 64]; const float rs = 1.f / sqrtf(wave_sum(a * a + b * b) * (1.f / 128.f) + EPS);
        F.KM()[r * 256 + hk * 128 + F.lane] = (bf16)f2bf(a * rs * F.k_norm[F.lane]); F.KM()[r * 256 + hk * 128 + F.lane + 64] = (bf16)f2bf(b * rs * F.k_norm[F.lane + 64]); }
    for (int i = F.tid; i < 16 * 256; i += 512) F.VM()[i] = (bf16)f2bf(F.ZM()[(i >> 8) * INW + 1280 + (i & 255)]);
    { const int h = F.wave; const float* z = F.ZM() + 15 * INW + h * 128; const float a = z[F.lane], b = z[F.lane + 64];
      const float rs = 1.f / sqrtf(wave_sum(a * a + b * b) * (1.f / 128.f) + EPS);
      F.Q15()[h * 128 + F.lane] = a * rs * F.q_norm[F.lane]; F.Q15()[h * 128 + F.lane + 64] = b * rs * F.q_norm[F.lane + 64]; }
    for (int i = F.tid; i < 1024; i += 512) F.GY15()[i] = F.ZM()[15 * INW + 2560 + i];
}

__device__ __forceinline__ void metaq_item(Frame& F, int it) {
    int s, kvh, j; if (it < 256) { s = it >> 5; kvh = (it >> 4) & 1; j = it & 15; } else { const int t2 = it - 256; s = 8 + (t2 >> 6); kvh = (t2 >> 5) & 1; j = t2 & 31; }
    LAS float* q4 = (LAS float*)F.lds;
    LAS float* sc = q4 + 512;
    LAS float* red = sc + 4 * 288;
    const int tid = F.tid, nk = 256 + (j == 0 ? 16 : 0), row0 = seq_first_row(s) + 256 * j;
    q4[tid] = F.Q15()[kvh * 512 + tid];
    __syncthreads();
    if (tid < nk) {
        const bf16* kp = tid < 256 ? F.K() + (size_t)(row0 + tid) * 256 + kvh * 128 : F.KM() + (tid - 256) * 256 + kvh * 128;
        float d0 = 0.f, d1 = 0.f, d2 = 0.f, d3 = 0.f;
#pragma unroll 4
        for (int cc = 0; cc < 16; ++cc) { const bf16x8 kv = ((const GAS bf16x8*)kp)[cc];
#pragma unroll
            for (int e = 0; e < 8; ++e) { const float kf = bf2f(kv[e]); d0 += kf * q4[cc * 8 + e]; d1 += kf * q4[128 + cc * 8 + e]; d2 += kf * q4[256 + cc * 8 + e]; d3 += kf * q4[384 + cc * 8 + e]; } }
        const float SC = 0.088388347648318440f;
        sc[tid] = d0 * SC; sc[288 + tid] = d1 * SC; sc[576 + tid] = d2 * SC; sc[864 + tid] = d3 * SC;
    }
    __syncthreads();
    if (F.wave < 4) { LAS float* sh = sc + F.wave * 288; float m = -INFINITY;
        for (int k = F.lane; k < nk; k += 64) m = fmaxf(m, sh[k]);
        m = wave_max(m); float l = 0.f;
        for (int k = F.lane; k < nk; k += 64) { const float p = __expf(sh[k] - m); sh[k] = p; l += p; }
        l = wave_sum(l);
        if (F.lane == 0) { red[F.wave * 2] = m; red[F.wave * 2 + 1] = l; } }
    __syncthreads();
    { const int h = tid >> 7, d = tid & 127; float o = 0.f; const LAS float* sh = sc + h * 288;
      const bf16* vp = F.V() + (size_t)row0 * 256 + kvh * 128 + d;
#pragma unroll 8
      for (int k = 0; k < 256; ++k) o += sh[k] * bf2f(vp[(size_t)k * 256]);
      if (j == 0) for (int k = 0; k < 16; ++k) o += sh[256 + k] * bf2f(F.VM()[k * 256 + kvh * 128 + d]);
      float* dst = F.MQP() + ((size_t)it * 4 + h) * 132; dst[2 + d] = o; if (d == 0) { dst[0] = red[h * 2]; dst[1] = red[h * 2 + 1]; } }
    __syncthreads();
}
__device__ __forceinline__ void attn_phase(Frame& F, char* lds_generic) {
    for (int r = 0; r < 8; ++r) {
        int s, kvh, hq, qb, S;
        if (F.G == 256) {
            const int x = F.vcu >> 5, i = F.vcu & 31;
            if (r < 4) { const int pair = 2 * x + (r >> 1); s = pair >> 1; kvh = pair & 1; const int u = (r & 1) * 32 + i; hq = u >> 4; qb = u & 15; S = 4096; }
            else { const int pair = x; s = 8 + (pair >> 1); kvh = pair & 1; const int u = (r - 4) * 32 + i; hq = u >> 5; qb = u & 31; S = 8192; }
        } else { s = 0; kvh = 0; hq = 0; qb = 0; S = 0; }
        if (S == 0) continue;
        const int row0 = seq_first_row(s), h = kvh * 4 + hq;
        bf16* qp = F.Q() + (size_t)(row0 + qb * 256) * 1024 + h * 128;
        attn::attn_unit(qp, F.K() + (size_t)row0 * 256 + kvh * 128, F.V() + (size_t)row0 * 256 + kvh * 128, F.KM() + kvh * 128, F.VM() + kvh * 128, qp, S / 64 + 1, lds_generic);
    }
}

__device__ __forceinline__ void p5_mixed_row(Frame& F, int row, int lane) {
    const GAS bf16x8* a = (const GAS bf16x8*)(F.Q() + (size_t)row * 1024);
    const GAS bf16x8* l = (const GAS bf16x8*)(F.GY() + (size_t)row * 1024);
    const bf16x8 a0 = a[lane], a1 = a[lane + 64], l0 = l[lane], l1 = l[lane + 64];
    float sa = 0.f, sl = 0.f;
#pragma unroll
    for (int j = 0; j < 8; ++j) { const float x0 = bf2f(a0[j]), x1 = bf2f(a1[j]), y0 = bf2f(l0[j]), y1 = bf2f(l1[j]); sa += x0 * x0 + x1 * x1; sl += y0 * y0 + y1 * y1; }
    const float ra = 1.f / sqrtf(wave_sum(sa) * (1.f / 1024.f) + EPS), rl = 1.f / sqrtf(wave_sum(sl) * (1.f / 1024.f) + EPS);
    GAS v4u* o = (GAS v4u*)(F.XN() + (size_t)row * DM);
#pragma unroll
    for (int i = 0; i < 2; ++i) {
        const int e0 = (lane + 64 * i) * 8; const bf16x8 av = i ? a1 : a0, lv = i ? l1 : l0;
        const GAS f32x4* ga = (const GAS f32x4*)(F.g_attn_out + e0); const GAS f32x4* gl = (const GAS f32x4*)(F.g_lru_out + e0);
        const f32x4 ga0 = ga[0], ga1 = ga[1], gl0 = gl[0], gl1 = gl[1];
        float oa[8], ol[8];
        oa[0] = bf2f(av[0]) * ra * ga0.x; oa[1] = bf2f(av[1]) * ra * ga0.y; oa[2] = bf2f(av[2]) * ra * ga0.z; oa[3] = bf2f(av[3]) * ra * ga0.w;
        oa[4] = bf2f(av[4]) * ra * ga1.x; oa[5] = bf2f(av[5]) * ra * ga1.y; oa[6] = bf2f(av[6]) * ra * ga1.z; oa[7] = bf2f(av[7]) * ra * ga1.w;
        ol[0] = bf2f(lv[0]) * rl * gl0.x; ol[1] = bf2f(lv[1]) * rl * gl0.y; ol[2] = bf2f(lv[2]) * rl * gl0.z; ol[3] = bf2f(lv[3]) * rl * gl0.w;
        ol[4] = bf2f(lv[4]) * rl * gl1.x; ol[5] = bf2f(lv[5]) * rl * gl1.y; ol[6] = bf2f(lv[6]) * rl * gl1.z; ol[7] = bf2f(lv[7]) * rl * gl1.w;
        o[lane + 64 * i] = pack8(oa); o[128 + lane + 64 * i] = pack8(ol);
    }
}
__device__ __forceinline__ void p5_meta_job(Frame& F) {
    LAS float* buf = (LAS float*)F.lds; LAS float* red = buf + 2048; const int tid = F.tid;
    for (int s = 0; s < 12; ++s) {
        const int nj = s < 8 ? 16 : 32;
        for (int e = tid; e < 1024; e += 512) { const int h = e >> 7, d = e & 127, kvh = h >> 2, hq = h & 3;
            const int it0 = s < 8 ? s * 32 + kvh * 16 : 256 + (s - 8) * 64 + kvh * 32;
            float M = -INFINITY; for (int j = 0; j < nj; ++j) M = fmaxf(M, F.MQP()[((size_t)(it0 + j) * 4 + hq) * 132]);
            float Ls = 0.f, O = 0.f;
            for (int j = 0; j < nj; ++j) { const float* p = F.MQP() + ((size_t)(it0 + j) * 4 + hq) * 132; const float w = __expf(p[0] - M); Ls += p[1] * w; O += p[2 + d] * w; }
            buf[e] = O / Ls; }
        for (int e = tid; e < 1024; e += 512) buf[1024 + e] = F.LO15()[s * 1024 + e];
        __syncthreads();
        { float ss = 0.f; for (int k = F.lane; k < 256; k += 64) { const float v = buf[F.wave * 256 + k]; ss += v * v; } ss = wave_sum(ss); if (F.lane == 0) red[F.wave] = ss; }
        __syncthreads();
        const float ra = 1.f / sqrtf((red[0] + red[1] + red[2] + red[3]) * (1.f / 1024.f) + EPS), rl = 1.f / sqrtf((red[4] + red[5] + red[6] + red[7]) * (1.f / 1024.f) + EPS);
        for (int e = tid; e < 2048; e += 512) F.MIXED15()[s * 2048 + e] = e < 1024 ? buf[e] * ra * F.g_attn_out[e] : buf[e] * rl * F.g_lru_out[e - 1024];
        __syncthreads();
    }
}
__device__ __forceinline__ void p6_meta_y(Frame& F) {
    LAS float* X = (LAS float*)F.lds;
    for (int i = F.tid; i < 12 * DM / 4; i += 512) ((LAS f32x4*)X)[i] = ((const GAS f32x4*)F.MIXED15())[i];
    __syncthreads();
    const OutRows o{F.Y15(), DM, 12};
    small_gemm<12, OutRows>(X, DM, F.WOUT_T(), DM, F.vcu * NWAVES + F.wave, F.G * NWAVES, F.lane, o);
    __syncthreads();
}

__device__ __forceinline__ void p7_row(Frame& F, int row, int lane) {
    const GAS bf16x8* y = (const GAS bf16x8*)(F.Y1() + (size_t)row * DM);
    const float* xr = row < 32768 ? F.x_prompt + (size_t)row * DM : F.x_sample + (size_t)(row - 32768) * DM;
    float hv[32]; float ss = 0.f;
#pragma unroll
    for (int i = 0; i < 4; ++i) { const bf16x8 v = y[lane + 64 * i];
#pragma unroll
        for (int j = 0; j < 8; ++j) { hv[8 * i + j] = bf2f(v[j]); ss += hv[8 * i + j] * hv[8 * i + j]; } }
    const float r1 = 1.f / sqrtf(wave_sum(ss) * (1.f / DM) + EPS); float s2 = 0.f;
#pragma unroll
    for (int i = 0; i < 4; ++i) { const int e0 = (lane + 64 * i) * 8;
        const GAS f32x4* xp = (const GAS f32x4*)(xr + e0); const GAS f32x4* gp = (const GAS f32x4*)(F.g_post_mix + e0);
        const f32x4 x0 = xp[0], x1 = xp[1], g0 = gp[0], g1 = gp[1];
        f32x4 h0, h1;
        h0.x = x0.x + hv[8 * i + 0] * r1 * g0.x; h0.y = x0.y + hv[8 * i + 1] * r1 * g0.y; h0.z = x0.z + hv[8 * i + 2] * r1 * g0.z; h0.w = x0.w + hv[8 * i + 3] * r1 * g0.w;
        h1.x = x1.x + hv[8 * i + 4] * r1 * g1.x; h1.y = x1.y + hv[8 * i + 5] * r1 * g1.y; h1.z = x1.z + hv[8 * i + 6] * r1 * g1.z; h1.w = x1.w + hv[8 * i + 7] * r1 * g1.w;
        GAS f32x4* op = (GAS f32x4*)(F.out + (size_t)row * DM + e0); op[0] = h0; op[1] = h1;
        hv[8 * i + 0] = h0.x; hv[8 * i + 1] = h0.y; hv[8 * i + 2] = h0.z; hv[8 * i + 3] = h0.w; hv[8 * i + 4] = h1.x; hv[8 * i + 5] = h1.y; hv[8 * i + 6] = h1.z; hv[8 * i + 7] = h1.w;
        s2 += (h0.x * h0.x + h0.y * h0.y) + (h0.z * h0.z + h0.w * h0.w) + (h1.x * h1.x + h1.y * h1.y) + (h1.z * h1.z + h1.w * h1.w); }
    const float r2 = 1.f / sqrtf(wave_sum(s2) * (1.f / DM) + EPS);
    GAS v4u* o = (GAS v4u*)(F.XN() + (size_t)row * DM);
#pragma unroll
    for (int i = 0; i < 4; ++i) { const int e0 = (lane + 64 * i) * 8; const GAS f32x4* gp = (const GAS f32x4*)(F.g_pre_ffn + e0); const f32x4 g0 = gp[0], g1 = gp[1];
        float t[8]; t[0] = hv[8 * i + 0] * r2 * g0.x; t[1] = hv[8 * i + 1] * r2 * g0.y; t[2] = hv[8 * i + 2] * r2 * g0.z; t[3] = hv[8 * i + 3] * r2 * g0.w;
        t[4] = hv[8 * i + 4] * r2 * g1.x; t[5] = hv[8 * i + 5] * r2 * g1.y; t[6] = hv[8 * i + 6] * r2 * g1.z; t[7] = hv[8 * i + 7] * r2 * g1.w;
        o[lane + 64 * i] = pack8(t); }
}
__device__ __forceinline__ void p7_meta_g(Frame& F) {
    LAS float* X = (LAS float*)F.lds;
    for (int r = F.wave; r < 12; r += 8) {
        const float* y = F.Y15() + r * DM; const float* xm = F.meta + 15 * DM;
        float hv[32]; float ss = 0.f;
#pragma unroll
        for (int i = 0; i < 32; ++i) { hv[i] = y[F.lane + 64 * i]; ss += hv[i] * hv[i]; }
        const float r1 = 1.f / sqrtf(wave_sum(ss) * (1.f / DM) + EPS); float s2 = 0.f;
#pragma unroll
        for (int i = 0; i < 32; ++i) { const int e = F.lane + 64 * i; hv[i] = xm[e] + hv[i] * r1 * F.g_post_mix[e]; s2 += hv[i] * hv[i]; }
        const float r2 = 1.f / sqrtf(wave_sum(s2) * (1.f / DM) + EPS);
#pragma unroll
        for (int i = 0; i < 32; ++i) { const int e = F.lane + 64 * i; X[r * DM + e] = hv[i] * r2 * F.g_pre_ffn[e]; }
    }
    __syncthreads();
    const OutRows o{F.G15(), FFN, 12};
    small_gemm<12, OutRows>(X, DM, F.WUP_T(), FFN, F.vcu * NWAVES + F.wave, F.G * NWAVES, F.lane, o);
    __syncthreads();
}

__device__ __forceinline__ void p9_act(Frame& F, int q) {
    constexpr int NOCT = FFN / 8;
    const int total = QROWS * NOCT;
    for (int it = F.vcu * 512 + F.tid; it < total; it += F.G * 512) {
        const int lr = it / NOCT, co = (it - lr * NOCT) * 8;
        const int row = q * QROWS + lr, s = row_seq(row), t = row - seq_first_row(s), S = seq_len(s);
        const bf16* up = F.UP() + (size_t)lr * UPW;
        const bf16x8 g1 = *(const GAS bf16x8*)(up + co), uu = *(const GAS bf16x8*)(up + FFN + co);
        float g0f[8], g2f[8];
        if (t > 0) { const bf16x8 g0 = *(const GAS bf16x8*)(up - UPW + co);
#pragma unroll
            for (int j = 0; j < 8; ++j) g0f[j] = bf2f(g0[j]); }
        else { const GAS f32x4* gp = (const GAS f32x4*)(F.G15() + (size_t)s * FFN + co); const f32x4 a = gp[0], b = gp[1];
            g0f[0] = a.x; g0f[1] = a.y; g0f[2] = a.z; g0f[3] = a.w; g0f[4] = b.x; g0f[5] = b.y; g0f[6] = b.z; g0f[7] = b.w; }
        if (t < S - 1) { const bf16x8 g2 = *(const GAS bf16x8*)(up + UPW + co);
#pragma unroll
            for (int j = 0; j < 8; ++j) g2f[j] = bf2f(g2[j]); }
        else {
#pragma unroll
            for (int j = 0; j < 8; ++j) g2f[j] = 0.f; }
        float w0[8], w1[8], w2[8], bb[8];
        { const GAS f32x4* p0 = (const GAS f32x4*)(F.ffn_conv_w + co); const GAS f32x4* p1 = (const GAS f32x4*)(F.ffn_conv_w + FFN + co); const GAS f32x4* p2 = (const GAS f32x4*)(F.ffn_conv_w + 2 * FFN + co);
          const GAS f32x4* pb = (const GAS f32x4*)(F.ffn_conv_b + co);
          const f32x4 a0 = p0[0], a1 = p0[1], b0 = p1[0], b1 = p1[1], c0 = p2[0], c1 = p2[1], d0 = pb[0], d1 = pb[1];
          w0[0] = a0.x; w0[1] = a0.y; w0[2] = a0.z; w0[3] = a0.w; w0[4] = a1.x; w0[5] = a1.y; w0[6] = a1.z; w0[7] = a1.w;
          w1[0] = b0.x; w1[1] = b0.y; w1[2] = b0.z; w1[3] = b0.w; w1[4] = b1.x; w1[5] = b1.y; w1[6] = b1.z; w1[7] = b1.w;
          w2[0] = c0.x; w2[1] = c0.y; w2[2] = c0.z; w2[3] = c0.w; w2[4] = c1.x; w2[5] = c1.y; w2[6] = c1.z; w2[7] = c1.w;
          bb[0] = d0.x; bb[1] = d0.y; bb[2] = d0.z; bb[3] = d0.w; bb[4] = d1.x; bb[5] = d1.y; bb[6] = d1.z; bb[7] = d1.w; }
        float o[8];
#pragma unroll
        for (int j = 0; j < 8; ++j) { const float x = bb[j] + w0[j] * g0f[j] + w1[j] * bf2f(g1[j]) + w2[j] * g2f[j]; o[j] = x * sigmoidf_(x) * bf2f(uu[j]); }
        *(GAS v4u*)(F.ACT() + (size_t)lr * FFN + co) = pack8(o);
    }
}
__device__ __forceinline__ void p11_row(Frame& F, int row, int lane) {
    const GAS bf16x8* f = (const GAS bf16x8*)(F.XN() + (size_t)row * DM);
    float fv[32]; float ss = 0.f;
#pragma unroll
    for (int i = 0; i < 4; ++i) { const bf16x8 v = f[lane + 64 * i];
#pragma unroll
        for (int j = 0; j < 8; ++j) { fv[8 * i + j] = bf2f(v[j]); ss += fv[8 * i + j] * fv[8 * i + j]; } }
    const float r1 = 1.f / sqrtf(wave_sum(ss) * (1.f / DM) + EPS);
#pragma unroll
    for (int i = 0; i < 4; ++i) { const int e0 = (lane + 64 * i) * 8;
        GAS f32x4* op = (GAS f32x4*)(F.out + (size_t)row * DM + e0); const GAS f32x4* gp = (const GAS f32x4*)(F.g_post_ffn + e0);
        f32x4 h0 = op[0], h1 = op[1]; const f32x4 g0 = gp[0], g1 = gp[1];
        h0.x += fv[8 * i + 0] * r1 * g0.x; h0.y += fv[8 * i + 1] * r1 * g0.y; h0.z += fv[8 * i + 2] * r1 * g0.z; h0.w += fv[8 * i + 3] * r1 * g0.w;
        h1.x += fv[8 * i + 4] * r1 * g1.x; h1.y += fv[8 * i + 5] * r1 * g1.y; h1.z += fv[8 * i + 6] * r1 * g1.z; h1.w += fv[8 * i + 7] * r1 * g1.w;
        op[0] = h0; op[1] = h1; }
}
struct Args { const float* in[24]; float* out; unsigned char* ws; int ph_lo, ph_hi, q_lo, q_hi, use_bar, pad; };
constexpr int N_PHASES = 12;
__global__ void __launch_bounds__(NWAVES * 64, 2) mk_fwd(Args args) {
    extern __shared__ __attribute__((aligned(16))) unsigned char lds[];
    Frame F;
    F.lds = (LAS unsigned char*)lds;
    F.MISC = (volatile LAS unsigned*)(F.lds + MISC_OFF);
    F.tid = threadIdx.x; F.lane = F.tid & 63; F.wave = __builtin_amdgcn_readfirstlane(F.tid >> 6);
    F.G = gridDim.x; { const int bx = blockIdx.x; F.vcu = (F.G % 8 == 0) ? (bx % 8) * (F.G / 8) + bx / 8 : bx; }
    unsigned char* ws = args.ws;
    F.ctl = (gu32*)(ws + WS_CTL);
    F.x_prompt = args.in[0]; F.x_sample = args.in[1]; F.meta = args.in[2]; F.g_pre_mix = args.in[3]; F.w_in = args.in[4]; F.q_norm = args.in[5]; F.k_norm = args.in[6];
    F.lru_conv_w = args.in[7]; F.lru_conv_b = args.in[8]; F.lru_w_r = args.in[9]; F.lru_b_r = args.in[10]; F.lru_w_i = args.in[11]; F.lru_b_i = args.in[12]; F.lru_lambda = args.in[13];
    F.g_attn_out = args.in[14]; F.g_lru_out = args.in[15]; F.w_out = args.in[16]; F.g_post_mix = args.in[17]; F.g_pre_ffn = args.in[18]; F.w_up = args.in[19];
    F.ffn_conv_w = args.in[20]; F.ffn_conv_b = args.in[21]; F.w_down = args.in[22]; F.g_post_ffn = args.in[23]; F.out = args.out;
    F.ws = ws;
    for (int u = F.tid; u < (LDS_BYTES - LDSCTL_OFF) / 4; u += NWAVES * 64) ((LAS unsigned*)(F.lds + LDSCTL_OFF))[u] = 0u;
    __syncthreads();
    XcdBarrier bar; bar.bar = (unsigned*)(F.ctl + CW_BAR); bar.x = 0; bar.st = nullptr;
    if (args.use_bar) bar = xcd_barrier_post((unsigned*)(F.ctl + CW_BAR), F.MISC + 8);
    const int lo = args.ph_lo, hi = args.ph_hi;
#define IN(k) (((MK_PHASE_MASK >> (k)) & 1) && lo <= (k) && (k) < hi)
#define PH_BAR() do { if (args.use_bar) xcd_barrier(bar); } while (0)
    const int gw = F.vcu * NWAVES + F.wave, NGW = F.G * NWAVES;

    if (IN(0)) { p0_prologue(F); PH_BAR(); }
    if (IN(1)) {
        p1_meta_z(F);
        pg8::Gemm g{F.XN(), F.WIN_T(), NTOK, INW, DM}; pg8::StaticOrder S; S.init(NTOK, INW, F.G, (int)blockIdx.x);
        pg8::EpiRoute E{nullptr, 0, 1, F.Q(), F.K(), F.V(), F.XR(), F.GY()};
        pg8::gemm_phase<pg8::EpiRoute, pg8::StaticOrder, true, true>(F.lds, g, S, E);
        PH_BAR();
    }
    if (IN(2)) { lru_phase<1>(F); PH_BAR(); }
    if (IN(3)) {
        for (int row = gw; row < NTOK; row += NGW) qk_rope_row(F, row, F.lane);
        lru_propagate(F);
        if (F.vcu == F.G - 1) p3_meta_job(F);
        PH_BAR();
    }
    if (IN(4)) {
        lru_phase<2>(F);
        for (int it = F.vcu; it < 512; it += F.G) metaq_item(F, it);
        attn_phase(F, (char*)lds);
        PH_BAR();
    }
    if (IN(5)) {
        for (int row = gw; row < NTOK; row += NGW) p5_mixed_row(F, row, F.lane);
        if (F.vcu == F.G - 1) p5_meta_job(F);
        PH_BAR();
    }
    if (IN(6)) {
        p6_meta_y(F);
        pg8::Gemm g{F.XN(), F.WOUT_T(), NTOK, DM, DM}; pg8::StaticOrder S; S.init(NTOK, DM, F.G, (int)blockIdx.x);
        pg8::EpiRoute E{F.Y1(), DM, 0, nullptr, nullptr, nullptr, nullptr, nullptr};
        pg8::gemm_phase<pg8::EpiRoute, pg8::StaticOrder, true, true>(F.lds, g, S, E);
        PH_BAR();
    }
    if (IN(7)) {
        for (int row = gw; row < NTOK; row += NGW) p7_row(F, row, F.lane);
        p7_meta_g(F);
        PH_BAR();
    }
#if MK_MULTI
    { const int q = args.q_lo;
#else
#pragma unroll
    for (int q = 0; q < 4; ++q) {
#endif
        if (IN(8)) {
            pg8::Gemm g{F.XN() + (size_t)q * QROWS * DM, F.WUP_T(), QROWS, UPW, DM}; pg8::StaticOrder S; S.init(QROWS, UPW, F.G, (int)blockIdx.x);
            pg8::EpiRoute E{F.UP(), UPW, 0, nullptr, nullptr, nullptr, nullptr, nullptr};
            pg8::gemm_phase<pg8::EpiRoute, pg8::StaticOrder, true, true>(F.lds, g, S, E);
            PH_BAR();
        }
        if (IN(9)) { p9_act(F, q); PH_BAR(); }
        if (IN(10)) {
            pg8::Gemm g{F.ACT(), F.WDOWN_T(), QROWS, DM, FFN}; pg8::StaticOrder S; S.init(QROWS, DM, F.G, (int)blockIdx.x);
            pg8::EpiRoute E{F.XN() + (size_t)q * QROWS * DM, DM, 0, nullptr, nullptr, nullptr, nullptr, nullptr};
            pg8::gemm_phase<pg8::EpiRoute, pg8::StaticOrder, true, true>(F.lds, g, S, E);
        }
    }
    if (IN(10) && IN(11)) PH_BAR();
    if (IN(11)) { for (int row = gw; row < NTOK; row += NGW) p11_row(F, row, F.lane); }
#undef IN
#undef PH_BAR
}

extern "C" void kernel_launch(void* const* d_in, const int* in_sizes, int n_in, void* d_out, int out_size, void* d_ws, size_t ws_size, hipStream_t stream) {
    static int grid = 0;
    if (grid == 0) {
        if (n_in != 24 || out_size != NTOK * DM || ws_size < WS_END) { fprintf(stderr, "kernel_launch: unexpected shapes (n_in %d out %d ws %zu, need ws >= %zu); nothing launched\n", n_in, out_size, ws_size, (size_t)WS_END); grid = -1; return; }
        int dev = 0, cus = 0;
        if (hipGetDevice(&dev) != hipSuccess || hipDeviceGetAttribute(&cus, hipDeviceAttributeMultiprocessorCount, dev) != hipSuccess) { grid = -1; return; }
        if (hipFuncSetAttribute((const void*)mk_fwd, hipFuncAttributeMaxDynamicSharedMemorySize, LDS_BYTES) != hipSuccess) { fprintf(stderr, "kernel_launch: hipFuncSetAttribute failed\n"); grid = -1; return; }
        int per_cu = 0;
        if (hipOccupancyMaxActiveBlocksPerMultiprocessor(&per_cu, (const void*)mk_fwd, NWAVES * 64, LDS_BYTES) != hipSuccess || per_cu < 1) fprintf(stderr, "kernel_launch: occupancy query reports %d\n", per_cu);
        (void)hipGetLastError();
        grid = cus;
    }
    if (grid < 0) return;
    if (hipMemsetAsync((char*)d_ws + WS_CTL, 0, CTL_ZERO_BYTES, stream) != hipSuccess) return;
    Args a{};
    for (int i = 0; i < 24; ++i) a.in[i] = (const float*)d_in[i];
    a.out = (float*)d_out; a.ws = (unsigned char*)d_ws;
#if MK_MULTI
    a.use_bar = 0;
    for (int ph = 0; ph < 8; ++ph) { a.ph_lo = ph; a.ph_hi = ph + 1; a.q_lo = 0; a.q_hi = 0; hipLaunchKernelGGL(mk_fwd, dim3(grid), dim3(NWAVES * 64), LDS_BYTES, stream, a); }
    for (int q = 0; q < 4; ++q) for (int ph = 8; ph < 11; ++ph) { a.ph_lo = ph; a.ph_hi = ph + 1; a.q_lo = q; a.q_hi = q + 1; hipLaunchKernelGGL(mk_fwd, dim3(grid), dim3(NWAVES * 64), LDS_BYTES, stream, a); }
    a.ph_lo = 11; a.ph_hi = 12; a.q_lo = 0; a.q_hi = 0; hipLaunchKernelGGL(mk_fwd, dim3(grid), dim3(NWAVES * 64), LDS_BYTES, stream, a);
#else
    a.use_bar = 1; a.ph_lo = 0; a.ph_hi = N_PHASES; a.q_lo = 0; a.q_hi = 4;
    hipLaunchKernelGGL(mk_fwd, dim3(grid), dim3(NWAVES * 64), LDS_BYTES, stream, a);
#endif
    const hipError_t le = hipPeekAtLastError();
    if (le != hipSuccess) fprintf(stderr, "kernel_launch: launch failed: %s\n", hipGetErrorName(le));
}
```

```cpp
#include <hip/hip_runtime.h>
#include <cstdio>
#include <cstdint>
#include <cmath>
#ifndef MK_PHASE_MASK
#define MK_PHASE_MASK 0xfff
#endif
#ifndef MK_MULTI
#define MK_MULTI 0
#endif
namespace pg8 {
#define PG8_LAS __attribute__((address_space(3)))
typedef unsigned short bf16_t;
typedef short bf16x8 __attribute__((ext_vector_type(8)));
typedef float f32x4 __attribute__((ext_vector_type(4)));
typedef unsigned u32x4 __attribute__((ext_vector_type(4)));
constexpr int BM = 256, BK = 64, HALF = 128, HTB = HALF * BK * 2  , STAGE_BYTES = 8 * HTB, NXCD = 8, WGM = 8;

__host__ __device__ __forceinline__ int lds_byte(int r, int c) { const int st = (r >> 4) * 2 + (c >> 5), rr = r & 15, cc = c & 31, ob = rr * 64 + cc * 2; return st * 1024 + (ob ^ (((ob >> 9) & 1) << 5)); }
__host__ __device__ __forceinline__ void stage_rc(int b, int& R, int& C) { const int st = b / 1024, sb = b % 1024, swz = sb ^ (((sb >> 9) & 1) << 5); R = (st >> 1) * 16 + swz / 64; C = (st & 1) * 32 + (swz % 64) / 2; }
__host__ __device__ __forceinline__ int perm32(int rho) { const int n = rho >> 4, i = rho & 15; return 8 * (i >> 2) + 4 * n + (i & 3); }

struct Unit { int pm, pn; };
struct Gemm { const bf16_t* A; const bf16_t* Bt; int M, N, K; };

struct StaticOrder {
    int nM, nN, nwg, G, c;
    __host__ __device__ void init(int M, int N, int G_, int c_) { nM = M / BM; nN = N / BM; nwg = nM * nN; G = G_; c = c_; }
    __host__ __device__ bool next(int i, Unit& u) const {
        const long L = (long)i * G + c; if (L >= nwg) return false;
        int wgid = (int)L; { const int q = nwg / NXCD, r = nwg % NXCD, xcd = wgid % NXCD, off = wgid / NXCD; wgid = (xcd < r ? xcd * (q + 1) : r * (q + 1) + (xcd - r) * q) + off; }
        const int nig = WGM * nN, gid = wgid / nig, fm = gid * WGM, gsz = (nM - fm) < WGM ? (nM - fm) : WGM;
        u.pm = fm + ((wgid % nig) % gsz); u.pn = (wgid % nig) / gsz; return true;
    }
    __device__ __forceinline__ void a_ready(const Unit&) const {}
    __device__ __forceinline__ void done(const Unit&) const {}
};

__device__ __forceinline__ unsigned cvt_pk_bf16(float lo, float hi) { unsigned r; asm volatile("v_cvt_pk_bf16_f32 %0, %1, %2" : "=v"(r) : "v"(lo), "v"(hi)); return r; }
struct EpiRoute {
    static constexpr bool PERM = true, AFTER_DRAIN = false;
    bf16_t* O; int ldc; int mode; bf16_t *Qp, *Kp, *Vp, *XRp, *GYp;
    __device__ __forceinline__ void operator()(const f32x4 (&acc)[2][2][4][2], const Unit& u, int wr, int wc, int fr, int fq) const {
        bf16_t* base = O; int ld = ldc; int colt = u.pn * BM; int rowadd = 0;
        if (mode == 1) {
            const int pn = u.pn;
            if (pn < 4) { base = Qp; ld = 1024; colt = pn * 256; }
            else if (pn == 4) { base = Kp; ld = 256; colt = 0; }
            else if (pn == 5) { base = Vp; ld = 256; colt = 0; }
            else if (pn < 10) { base = XRp; ld = 1024; colt = (pn - 6) * 256; const int seq = u.pm < 128 ? (u.pm >> 4) : 8 + ((u.pm - 128) >> 5); rowadd = 64 * (seq + 1); }
            else { base = GYp; ld = 1024; colt = (pn - 10) * 256; }
        }
        const int row0 = u.pm * BM + wr * 64 + fr + rowadd; const int col0 = colt + wc * 32 + 8 * fq;
#pragma unroll
        for (int ai = 0; ai < 2; ++ai)
#pragma unroll
            for (int m = 0; m < 4; ++m) { bf16_t* rowp = base + (size_t)(row0 + ai * HALF + m * 16) * ld + col0;
#pragma unroll
                for (int bj = 0; bj < 2; ++bj) { const f32x4 v0 = acc[ai][bj][m][0], v1 = acc[ai][bj][m][1];
                    u32x4 w; w.x = cvt_pk_bf16(v0[0], v0[1]); w.y = cvt_pk_bf16(v0[2], v0[3]); w.z = cvt_pk_bf16(v1[0], v1[1]); w.w = cvt_pk_bf16(v1[2], v1[3]);
                    *(u32x4*)(rowp + bj * HALF) = w; } }
    }
};

template <class Epi, class Sched, bool ALIGN_EPI = false, bool SP2 = false>
__device__ __forceinline__ void gemm_phase(PG8_LAS unsigned char* lds, const Gemm g, const Sched& S, const Epi& E) {
    const int tid = threadIdx.x, wid = __builtin_amdgcn_readfirstlane(tid >> 6), lane = tid & 63, wr = wid >> 2, wc = wid & 3, fr = lane & 15, fq = lane >> 4;
    const int K = g.K, nt = K / BK;
    unsigned voffA[2], voffB[2];
#pragma unroll
    for (int i = 0; i < 2; ++i) { int R, C; stage_rc(tid * 16 + i * 8192, R, C); const int Rb = Epi::PERM ? ((R & ~31) + perm32(R & 31)) : R;
        voffA[i] = (unsigned)(R * K + C) * 2u; voffB[i] = (unsigned)(Rb * K + C) * 2u; }
    const size_t kstep = (size_t)(BK * 2);
    const size_t hstep = (size_t)HALF * K * 2;
    const size_t tstep = 2 * hstep;
    const unsigned ldsw = (unsigned)wid * 1024u;
    const int aoff = lds_byte(wr * 64 + fr, fq * 8), boff = lds_byte(wc * 32 + fr, fq * 8);
#define PG8_SA(b, h) (((b) * 2 + (h)) * HTB)
#define PG8_SB(b, h) ((4 + (b) * 2 + (h)) * HTB)
#define PG8_STAGE(bufoff, gbase, voff) do { _Pragma("unroll") for (int _i = 0; _i < 2; ++_i) \
        __builtin_amdgcn_global_load_lds((const unsigned*)((const char*)(gbase) + (voff)[_i]), (PG8_LAS unsigned*)(lds + (bufoff) + ldsw + _i * 8192), 16, 0, 0); } while (0)
#define PG8_LDA(dst, b, h) do { _Pragma("unroll") for (int m = 0; m < 4; ++m) _Pragma("unroll") for (int k = 0; k < 2; ++k) dst[m][k] = *(const PG8_LAS bf16x8*)(lds + PG8_SA(b, h) + aoff + m * 2048 + k * 1024); } while (0)
#define PG8_LDB(dst, b, h) do { _Pragma("unroll") for (int n = 0; n < 2; ++n) _Pragma("unroll") for (int k = 0; k < 2; ++k) dst[n][k] = *(const PG8_LAS bf16x8*)(lds + PG8_SB(b, h) + boff + n * 2048 + k * 1024); } while (0)
#define PG8_MMA(ai, bj, At, Bt) do { __builtin_amdgcn_s_setprio(1); _Pragma("unroll") for (int m = 0; m < 4; ++m) _Pragma("unroll") for (int n = 0; n < 2; ++n) _Pragma("unroll") for (int k = 0; k < 2; ++k) \
        acc[ai][bj][m][n] = __builtin_amdgcn_mfma_f32_16x16x32_bf16(Bt[n][k], At[m][k], acc[ai][bj][m][n], 0, 0, 0); __builtin_amdgcn_s_setprio(0); } while (0)
#define PG8_WAIT_V(n) asm volatile("s_waitcnt vmcnt(" #n ")" ::: "memory")
#define PG8_WAIT_L(n) asm volatile("s_waitcnt lgkmcnt(" #n ")" ::: "memory")
#define PG8_BAR __builtin_amdgcn_s_barrier()
#define PG8_SCHED __builtin_amdgcn_sched_barrier(0)
    Unit cur, nxt; int ui = 0;
    if (!S.next(0, cur)) return;
    f32x4 acc[2][2][4][2];
#pragma unroll
    for (int a = 0; a < 2; ++a)
#pragma unroll
        for (int b = 0; b < 2; ++b)
#pragma unroll
            for (int m = 0; m < 4; ++m)
#pragma unroll
                for (int n = 0; n < 2; ++n) acc[a][b][m][n] = (f32x4){0.f, 0.f, 0.f, 0.f};
    bf16x8 At[4][2], B0[2][2], B1[2][2];
    const char* cA = (const char*)g.A + (size_t)cur.pm * tstep; const char* cB = (const char*)g.Bt + (size_t)cur.pn * tstep;
    S.a_ready(cur);
    if constexpr (SP2) {
        PG8_STAGE(PG8_SB(0, 0), cB, voffB); PG8_STAGE(PG8_SB(0, 1), cB + hstep, voffB); PG8_STAGE(PG8_SA(0, 0), cA, voffA); PG8_STAGE(PG8_SA(0, 1), cA + hstep, voffA);
        if (wr == 1) PG8_BAR;
        PG8_WAIT_V(2); PG8_BAR;
        PG8_STAGE(PG8_SB(1, 0), cB + kstep, voffB); PG8_STAGE(PG8_SA(1, 0), cA + kstep, voffA); PG8_STAGE(PG8_SB(1, 1), cB + hstep + kstep, voffB);
        PG8_WAIT_V(6); PG8_BAR;
    } else {
        PG8_STAGE(PG8_SB(0, 0), cB, voffB); PG8_STAGE(PG8_SA(0, 0), cA, voffA); PG8_STAGE(PG8_SB(0, 1), cB + hstep, voffB); PG8_STAGE(PG8_SA(0, 1), cA + hstep, voffA);
        if (wr == 1) PG8_BAR;
        PG8_WAIT_V(4); PG8_BAR;
        PG8_STAGE(PG8_SB(1, 0), cB + kstep, voffB); PG8_STAGE(PG8_SA(1, 0), cA + kstep, voffA); PG8_STAGE(PG8_SB(1, 1), cB + hstep + kstep, voffB);
        PG8_WAIT_V(6); PG8_BAR;
    }
    for (;;) {
        const bool has_next = S.next(ui + 1, nxt);
        const char* nA = has_next ? (const char*)g.A + (size_t)nxt.pm * tstep : cA; const char* nB = has_next ? (const char*)g.Bt + (size_t)nxt.pn * tstep : cB;
        for (int t = 0; t < nt; t += 2) {
            const bool last = (t == nt - 2);
            const char* a1 = cA + (size_t)(t + 1) * kstep;
            const char* a2 = last ? nA : cA + (size_t)(t + 2) * kstep; const char* b2 = last ? nB : cB + (size_t)(t + 2) * kstep;
            const char* a3 = a2 + kstep; const char* b3 = b2 + kstep;
            if (last && has_next) S.a_ready(nxt);
            if constexpr (SP2) {
            PG8_LDB(B0, 0, 0); PG8_LDB(B1, 0, 1); PG8_SCHED; PG8_LDA(At, 0, 0); PG8_STAGE(PG8_SA(1, 1), a1 + hstep, voffA);
            PG8_WAIT_V(8); PG8_WAIT_L(0); PG8_BAR; PG8_MMA(0, 0, At, B0); PG8_MMA(0, 1, At, B1); PG8_BAR; PG8_SCHED;
            PG8_LDA(At, 0, 1); PG8_STAGE(PG8_SB(0, 0), b2, voffB); PG8_STAGE(PG8_SB(0, 1), b2 + hstep, voffB); PG8_STAGE(PG8_SA(0, 0), a2, voffA);
            PG8_WAIT_V(8); PG8_WAIT_L(0); PG8_BAR; PG8_MMA(1, 0, At, B0); PG8_MMA(1, 1, At, B1); PG8_BAR; PG8_SCHED;
            PG8_LDB(B0, 1, 0); PG8_LDB(B1, 1, 1); PG8_SCHED; PG8_LDA(At, 1, 0); PG8_STAGE(PG8_SA(0, 1), a2 + hstep, voffA);
            PG8_WAIT_V(8); PG8_WAIT_L(0); PG8_BAR; PG8_MMA(0, 0, At, B0); PG8_MMA(0, 1, At, B1); PG8_BAR; PG8_SCHED;
            PG8_LDA(At, 1, 1); PG8_STAGE(PG8_SB(1, 0), b3, voffB); PG8_STAGE(PG8_SB(1, 1), b3 + hstep, voffB); PG8_STAGE(PG8_SA(1, 0), a3, voffA);
            PG8_WAIT_V(8); PG8_WAIT_L(0); PG8_BAR; PG8_MMA(1, 0, At, B0); PG8_MMA(1, 1, At, B1); PG8_BAR; PG8_SCHED;
            } else {
            PG8_LDB(B0, 0, 0); PG8_SCHED; PG8_LDA(At, 0, 0); PG8_STAGE(PG8_SA(1, 1), a1 + hstep, voffA);
            PG8_WAIT_L(8); PG8_BAR; PG8_WAIT_L(0); PG8_MMA(0, 0, At, B0); PG8_BAR; PG8_SCHED;
            PG8_LDB(B1, 0, 1); PG8_STAGE(PG8_SB(0, 0), b2, voffB);
            PG8_BAR; PG8_WAIT_L(0); PG8_MMA(0, 1, At, B1); PG8_BAR;
            PG8_LDA(At, 0, 1); PG8_STAGE(PG8_SA(0, 0), a2, voffA);
            PG8_BAR; PG8_WAIT_L(0); PG8_MMA(1, 0, At, B0); PG8_BAR; PG8_SCHED;
            PG8_STAGE(PG8_SB(0, 1), b2 + hstep, voffB);
            PG8_WAIT_V(6); PG8_BAR; PG8_MMA(1, 1, At, B1); PG8_BAR;
            PG8_LDB(B0, 1, 0); PG8_SCHED; PG8_LDA(At, 1, 0); PG8_STAGE(PG8_SA(0, 1), a2 + hstep, voffA);
            PG8_WAIT_L(8); PG8_BAR; PG8_WAIT_L(0); PG8_MMA(0, 0, At, B0); PG8_BAR; PG8_SCHED;
            PG8_LDB(B1, 1, 1); PG8_STAGE(PG8_SB(1, 0), b3, voffB);
            PG8_BAR; PG8_WAIT_L(0); PG8_MMA(0, 1, At, B1); PG8_BAR;
            PG8_LDA(At, 1, 1); PG8_STAGE(PG8_SA(1, 0), a3, voffA);
            PG8_BAR; PG8_WAIT_L(0); PG8_MMA(1, 0, At, B0); PG8_BAR; PG8_SCHED;
            PG8_STAGE(PG8_SB(1, 1), b3 + hstep, voffB);
            PG8_WAIT_V(6); PG8_BAR; PG8_MMA(1, 1, At, B1); PG8_BAR;
            }
        }
        if constexpr (ALIGN_EPI) { if (wr == 0) PG8_BAR; }
        if constexpr (!Epi::AFTER_DRAIN) { E(acc, cur, wr, wc, fr, fq); S.done(cur); }
        if (!has_next) break;
#pragma unroll
        for (int a = 0; a < 2; ++a)
#pragma unroll
            for (int b = 0; b < 2; ++b)
#pragma unroll
                for (int m = 0; m < 4; ++m)
#pragma unroll
                    for (int n = 0; n < 2; ++n) acc[a][b][m][n] = (f32x4){0.f, 0.f, 0.f, 0.f};
        cur = nxt; cA = nA; cB = nB; ++ui;
        if constexpr (ALIGN_EPI) { if (wr == 1) PG8_BAR; }
    }
    PG8_WAIT_V(0);
    if constexpr (!ALIGN_EPI) { if (wr == 0) PG8_BAR; }
    PG8_BAR;
    if constexpr (Epi::AFTER_DRAIN) { E.fused(acc, cur, wr, wc, fr, fq, lds, wid, lane); S.done(cur); }
#undef PG8_SA
#undef PG8_SB
#undef PG8_STAGE
#undef PG8_LDA
#undef PG8_LDB
#undef PG8_MMA
#undef PG8_WAIT_V
#undef PG8_WAIT_L
#undef PG8_BAR
#undef PG8_SCHED
}
}
namespace attn {
typedef unsigned short bf16r;
constexpr int   D = 128, NW = 8, QBLK = 32, KVBLK = 64;
constexpr float SCALE = 0.088388347648318440f;
constexpr float THR = 8.f;
constexpr int LDQ = 1024, LDK = 256, LDO = 1024;
constexpr size_t SHM_V = KVBLK * D * 2, SHM_K = KVBLK * D * 2, SHM_ATTN = 2 * SHM_V + 2 * SHM_K + NW * 64 * 4;
using bf16x8 = __attribute__((ext_vector_type(8))) short;
using s16x4  = __attribute__((ext_vector_type(4))) short;
using f32x16 = __attribute__((ext_vector_type(16))) float;
using f32x8  = __attribute__((ext_vector_type(8))) float;
using u32x4  = __attribute__((ext_vector_type(4))) unsigned;
#define KSWZ(row, colB) ((row) * 256 + ((colB) ^ (((row) & 7) << 4)))
#define SBAR() __builtin_amdgcn_sched_barrier(0)
__device__ __forceinline__ int crow(int r, int hi) { return (r & 3) + 8 * (r >> 2) + 4 * hi; }
__device__ __forceinline__ unsigned cvtpk(float lo, float hi) {
  unsigned r; asm volatile("v_cvt_pk_bf16_f32 %0, %1, %2" : "=v"(r) : "v"(lo), "v"(hi)); return r;
}
__device__ __forceinline__ void partialSM(f32x16& p0, f32x16& p1, float& m_reg, float& mn, float& alpha) {
  constexpr float C = SCALE * 1.4426950408889634f;
  float pmax = p0[0]; for (int r = 1; r < 16; ++r) pmax = fmaxf(pmax, p0[r]); for (int r = 0; r < 16; ++r) pmax = fmaxf(pmax, p1[r]);
  { auto rr = __builtin_amdgcn_permlane32_swap(__float_as_uint(pmax), __float_as_uint(pmax), false, false);
    pmax = fmaxf(__uint_as_float(rr[0]), __uint_as_float(rr[1])); }
  if (__builtin_expect(__all(pmax - m_reg <= THR / SCALE), 1)) { mn = m_reg; alpha = 1.f; }
  else { mn = fmaxf(m_reg, pmax); alpha = __builtin_amdgcn_exp2f((m_reg - mn) * C); m_reg = mn; }
  float mnC = -mn * C;
  for (int r = 0; r < 16; ++r) p0[r] = fmaf(p0[r], C, mnC); for (int r = 0; r < 16; ++r) p1[r] = fmaf(p1[r], C, mnC);
  for (int r = 0; r < 16; ++r) p0[r] = __builtin_amdgcn_exp2f(p0[r]);
}
__device__ __forceinline__ void finishSM(f32x16& p0, f32x16& p1, float alpha, float& l_reg, bf16x8& pa0, bf16x8& pa1, bf16x8& pa2, bf16x8& pa3) {
  for (int r = 0; r < 16; ++r) p1[r] = __builtin_amdgcn_exp2f(p1[r]);
  float ps = 0; for (int r = 0; r < 16; ++r) ps += p0[r]; for (int r = 0; r < 16; ++r) ps += p1[r];
  { auto rr = __builtin_amdgcn_permlane32_swap(__float_as_uint(ps), __float_as_uint(ps), false, false);
    ps = __uint_as_float(rr[0]) + __uint_as_float(rr[1]); }
  l_reg = l_reg * alpha + ps;
#define PK4(P, BASE, OUT) do { unsigned a0 = cvtpk(P[BASE + 0], P[BASE + 1]), a1 = cvtpk(P[BASE + 2], P[BASE + 3]);   \
    unsigned b0 = cvtpk(P[BASE + 4], P[BASE + 5]), b1 = cvtpk(P[BASE + 6], P[BASE + 7]);                              \
    auto r0 = __builtin_amdgcn_permlane32_swap(a0, b0, false, false); auto r1 = __builtin_amdgcn_permlane32_swap(a1, b1, false, false); \
    u32x4 w = {r0[0], r1[0], r0[1], r1[1]}; OUT = *reinterpret_cast<bf16x8*>(&w); } while (0)
  PK4(p0, 0, pa0); PK4(p0, 8, pa1); PK4(p1, 0, pa2); PK4(p1, 8, pa3);
#undef PK4
}
__device__ __forceinline__ void qkt(f32x16& p0, f32x16& p1, const bf16r* Ks, const bf16x8* qr, int r32, int hi) {
  p0 = f32x16{}; p1 = f32x16{};
  for (int d0 = 0; d0 < 8; ++d0) { int cb = (d0 * 16 + hi * 8) * 2;
    bf16x8 b0 = *reinterpret_cast<const bf16x8*>((const char*)Ks + KSWZ(r32, cb));
    bf16x8 b1 = *reinterpret_cast<const bf16x8*>((const char*)Ks + KSWZ(32 + r32, cb));
    p0 = __builtin_amdgcn_mfma_f32_32x32x16_bf16(b0, qr[d0], p0, 0, 0, 0);
    p1 = __builtin_amdgcn_mfma_f32_32x32x16_bf16(b1, qr[d0], p1, 0, 0, 0); }
}
__device__ __forceinline__ int v_st(int k, int c) { const int kk = (k & ~0xC) | ((k & 4) << 1) | ((k & 8) >> 1); return ((kk >> 3) * 4 + (c >> 5)) * 512 + ((kk & 7) * 32 + (c & 31)) * 2; }
__device__ __forceinline__ int v_rd_base(int lane) { return ((lane & 3) << 3) | (((lane >> 2) & 3) << 6) | (((lane >> 4) & 1) << 5) | (((lane >> 5) & 1) << 8); }
constexpr int v_rd_off(int d0, int ks, int half) { return d0 * 512 + ks * 4096 + half * 2048; }
template <int OFF> __device__ __forceinline__ s16x4 tr_read(int vb) {
  s16x4 r; asm volatile("ds_read_b64_tr_b16 %0, %1 offset:%2" : "=&v"(r) : "v"(vb), "i"(OFF) : "memory"); return r;
}
template <int D0> __device__ __forceinline__ void pv_one(f32x16& od, int vb, bf16x8 pa0, bf16x8 pa1, bf16x8 pa2, bf16x8 pa3) {
  const s16x4 l0 = tr_read<v_rd_off(D0, 0, 0)>(vb), h0 = tr_read<v_rd_off(D0, 0, 1)>(vb), l1 = tr_read<v_rd_off(D0, 1, 0)>(vb), h1 = tr_read<v_rd_off(D0, 1, 1)>(vb);
  const s16x4 l2 = tr_read<v_rd_off(D0, 2, 0)>(vb), h2 = tr_read<v_rd_off(D0, 2, 1)>(vb), l3 = tr_read<v_rd_off(D0, 3, 0)>(vb), h3 = tr_read<v_rd_off(D0, 3, 1)>(vb);
  asm volatile("s_waitcnt lgkmcnt(0)" ::: "memory"); SBAR();
#define PK(L, H) (bf16x8){L[0], L[1], L[2], L[3], H[0], H[1], H[2], H[3]}
  od = __builtin_amdgcn_mfma_f32_32x32x16_bf16(pa0, PK(l0, h0), od, 0, 0, 0);
  od = __builtin_amdgcn_mfma_f32_32x32x16_bf16(pa1, PK(l1, h1), od, 0, 0, 0);
  od = __builtin_amdgcn_mfma_f32_32x32x16_bf16(pa2, PK(l2, h2), od, 0, 0, 0);
  od = __builtin_amdgcn_mfma_f32_32x32x16_bf16(pa3, PK(l3, h3), od, 0, 0, 0);
#undef PK
}
__device__ __forceinline__ void pv_d0(f32x16* o, int vb, bf16x8 pa0, bf16x8 pa1, bf16x8 pa2, bf16x8 pa3) {
  pv_one<0>(o[0], vb, pa0, pa1, pa2, pa3); pv_one<1>(o[1], vb, pa0, pa1, pa2, pa3); pv_one<2>(o[2], vb, pa0, pa1, pa2, pa3); pv_one<3>(o[3], vb, pa0, pa1, pa2, pa3);
}
__device__ __forceinline__ void mask_meta(f32x16& p0, f32x16& p1) {
  const float NEG = -INFINITY;
#pragma unroll
  for (int r = 8; r < 16; ++r) p0[r] = NEG;
#pragma unroll
  for (int r = 0; r < 16; ++r) p1[r] = NEG;
}
__device__ __forceinline__ unsigned short f2bf_rne(float f) { unsigned u = __builtin_bit_cast(unsigned, f); return (unsigned short)((u + 0x7fffu + ((u >> 16) & 1u)) >> 16); }

__device__ __forceinline__ void attn_unit(const bf16r* Qb, const bf16r* __restrict__ Kh, const bf16r* __restrict__ Vh,
                                          const bf16r* __restrict__ KMh, const bf16r* __restrict__ VMh, bf16r* Ob, int NT, char* lds) {
  const int tid = threadIdx.x, wid = tid >> 6, lane = tid & 63, r32 = lane & 31, hi = lane >> 5;
  bf16r* V_lds = (bf16r*)lds; bf16r* K_lds = (bf16r*)(lds + 2 * SHM_V);
  float* ws = (float*)(lds + 2 * SHM_V + 2 * SHM_K) + wid * 64; float* li_l = ws; float* al_l = ws + 32;
  float m_reg = -1e30f, l_reg = 0; f32x16 o[4] = {}; bf16x8 qr[8];
  const bf16r* Qw = Qb + (long)(wid * QBLK + r32) * LDQ + hi * 8;
#pragma unroll
  for (int d0 = 0; d0 < 8; ++d0) qr[d0] = *reinterpret_cast<const bf16x8*>(Qw + d0 * 16);
  const int sr = tid >> 4, sc = (tid & 15) * 8, vst0 = v_st(sr, sc), vst1 = v_st(32 + sr, sc);
  const int vb0 = (int)(uintptr_t)V_lds + v_rd_base(lane);
  struct { bf16x8 vs0, vs1, ks0, ks1; } sr_[2];
#define LD8(p) (*reinterpret_cast<const bf16x8*>(p))
#define SLOAD(i, t) do { const bool last_ = ((t) == NT - 1); const bf16r* kp_ = last_ ? KMh : Kh + (long)(t) * KVBLK * LDK; const bf16r* vp_ = last_ ? VMh : Vh + (long)(t) * KVBLK * LDK; \
    sr_[i].vs0 = LD8(&vp_[(long)(sr) * LDK + sc]); sr_[i].vs1 = LD8(&vp_[(long)(32 + sr) * LDK + sc]); \
    sr_[i].ks0 = LD8(&kp_[(long)(sr) * LDK + sc]); sr_[i].ks1 = LD8(&kp_[(long)(32 + sr) * LDK + sc]); } while (0)
#define SWRITE(b, i) do { *(bf16x8*)((char*)V_lds + (b) * SHM_V + vst0) = sr_[i].vs0;          \
    *(bf16x8*)((char*)V_lds + (b) * SHM_V + vst1) = sr_[i].vs1; int kc = sc * 2;               \
    *(bf16x8*)((char*)K_lds + (b) * SHM_K + KSWZ(sr, kc)) = sr_[i].ks0;                       \
    *(bf16x8*)((char*)K_lds + (b) * SHM_K + KSWZ(32 + sr, kc)) = sr_[i].ks1; } while (0)
#define SWAIT() asm volatile("s_waitcnt vmcnt(4)" ::: "memory")
#define RESC(a) do { if (__any((a) < 1.f)) { if (hi == 0) al_l[r32] = (a); asm volatile("s_waitcnt lgkmcnt(0)" ::: "memory"); \
    for (int d = 0; d < 4; ++d) for (int r = 0; r < 16; ++r) o[d][r] *= al_l[crow(r, hi)]; } } while (0)
  f32x16 pA0, pA1, pB0, pB1; float mnA, mnB, alA, alB; bf16x8 pa0, pa1, pa2, pa3;
  constexpr int SE = 0, SO = 1;
  SLOAD(SE, 0); asm volatile("s_waitcnt vmcnt(0)" ::: "memory"); SWRITE(0, SE); __syncthreads();
  qkt(pA0, pA1, K_lds, qr, r32, hi); partialSM(pA0, pA1, m_reg, mnA, alA);
  SLOAD(SO, 1); SLOAD(SE, 2);
  SWAIT(); SWRITE(1, SO); __syncthreads();
  for (int j = 1; j + 1 < NT; j += 2) {
    SBAR(); qkt(pB0, pB1, (bf16r*)((char*)K_lds + SHM_K), qr, r32, hi);
    finishSM(pA0, pA1, alA, l_reg, pa0, pa1, pa2, pa3); SBAR();
    if (j + 2 < NT) SLOAD(SO, j + 2); SBAR();
    pv_d0(o, vb0, pa0, pa1, pa2, pa3); partialSM(pB0, pB1, m_reg, mnB, alB);
    __syncthreads(); SWAIT(); SWRITE(0, SE);
    RESC(alB); __syncthreads();
    SBAR(); qkt(pA0, pA1, K_lds, qr, r32, hi);
    if (j + 2 == NT) mask_meta(pA0, pA1);
    finishSM(pB0, pB1, alB, l_reg, pa0, pa1, pa2, pa3); SBAR();
    if (j + 3 < NT) SLOAD(SE, j + 3); SBAR();
    pv_d0(o, vb0 + (int)SHM_V, pa0, pa1, pa2, pa3); partialSM(pA0, pA1, m_reg, mnA, alA);
    __syncthreads(); SWAIT(); if (j + 2 < NT) SWRITE(1, SO);
    RESC(alA); __syncthreads();
  }
  finishSM(pA0, pA1, alA, l_reg, pa0, pa1, pa2, pa3); SBAR();
  pv_d0(o, vb0, pa0, pa1, pa2, pa3);
  if (hi == 0) li_l[r32] = l_reg; asm volatile("s_waitcnt lgkmcnt(0)" ::: "memory");
  float rli[16];
#pragma unroll
  for (int r = 0; r < 16; ++r) rli[r] = __builtin_amdgcn_rcpf(li_l[crow(r, hi)]);
  bf16r* Ow = Ob + (long)(wid * QBLK) * LDO;
#pragma unroll
  for (int r = 0; r < 16; ++r) { const int orow = crow(r, hi);
#pragma unroll
    for (int d0 = 0; d0 < 4; ++d0) Ow[(long)orow * LDO + d0 * 32 + r32] = f2bf_rne(o[d0][r] * rli[r]); }
  __syncthreads();
#undef LD8
#undef SLOAD
#undef SWRITE
#undef SWAIT
#undef RESC
}
#undef KSWZ
#undef SBAR
}

constexpr int NWAVES = 8;
constexpr int DM = 2048, NTOK = 65536, INW = 3584, FFN = 5632, UPW = 2 * FFN;
constexpr float EPS = 1e-6f;
constexpr int XR_ROWS = 8 * 4160 + 4 * 8256;
constexpr int NCHUNK = 8 * 65 + 4 * 129;
constexpr int QROWS = 16384;
__host__ __device__ __forceinline__ int seq_first_row(int s) { return s < 8 ? s * 4096 : 32768 + (s - 8) * 8192; }
__host__ __device__ __forceinline__ int seq_len(int s) { return s < 8 ? 4096 : 8192; }
__host__ __device__ __forceinline__ int xr_base(int s) { return s < 8 ? s * 4160 : 33280 + (s - 8) * 8256; }
__host__ __device__ __forceinline__ int chunk_base(int s) { return s < 8 ? s * 65 : 520 + (s - 8) * 129; }
__host__ __device__ __forceinline__ int row_seq(int row) { return row < 32768 ? (row >> 12) : 8 + ((row - 32768) >> 13); }

constexpr size_t MiB = 1u << 20, KiB = 1u << 10;
constexpr size_t WS_CTL = 0, CTL_ZERO_BYTES = 1 * MiB;
constexpr size_t WS_SMALL = 1 * MiB;
constexpr size_t WS_XNMETA = WS_SMALL + 0, WS_ZM = WS_SMALL + 64 * KiB, WS_KM = WS_SMALL + 320 * KiB, WS_VM = WS_SMALL + 352 * KiB, WS_Q15 = WS_SMALL + 384 * KiB, WS_GY15 = WS_SMALL + 388 * KiB,
                 WS_LO15 = WS_SMALL + 392 * KiB, WS_MIXED15 = WS_SMALL + 448 * KiB, WS_Y15 = WS_SMALL + 544 * KiB, WS_G15 = WS_SMALL + 640 * KiB, WS_MQP = WS_SMALL + 1024 * KiB;
constexpr size_t WS_WIN = 5 * MiB, WS_WOUT = 19 * MiB, WS_WUP = 27 * MiB, WS_WDOWN = 71 * MiB, WS_WG = 93 * MiB;
constexpr size_t WS_CAR = 94 * MiB, WS_CIN = 111 * MiB;
constexpr size_t WS_A = 120 * MiB;
constexpr size_t WS_B = 376 * MiB;
constexpr size_t WS_Q = WS_B, WS_K = WS_B + 128 * MiB, WS_V = WS_B + 160 * MiB, WS_XR = WS_B + 192 * MiB, WS_GY = WS_B + 322 * MiB;
constexpr size_t WS_Y1 = WS_B, WS_UP = WS_B, WS_ACT = WS_B + 352 * MiB;
constexpr size_t WS_END = WS_B + 528 * MiB;
static_assert(WS_ZM + 16 * INW * 4 <= WS_KM && WS_G15 + 12 * FFN * 4 <= WS_MQP && WS_MQP + 512 * 4 * 132 * 4 <= WS_WIN, "small map");
static_assert(WS_WIN + (size_t)INW * DM * 2 <= WS_WOUT && WS_WOUT + (size_t)DM * DM * 2 <= WS_WUP && WS_WUP + (size_t)UPW * DM * 2 <= WS_WDOWN && WS_WDOWN + (size_t)DM * FFN * 2 <= WS_WG && WS_WG + 32 * 16384 * 2 <= WS_CAR, "weights map");
static_assert(WS_CAR + (size_t)NCHUNK * 2 * 1024 * 8 <= WS_CIN && WS_CIN + (size_t)NCHUNK * 2 * 1024 * 4 <= WS_A && WS_A + (size_t)NTOK * DM * 2 <= WS_B, "carry map");
static_assert(WS_XR + (size_t)(XR_ROWS + 64) * 1024 * 2 <= WS_GY && WS_GY + (size_t)NTOK * 1024 * 2 <= WS_END && WS_UP + (size_t)QROWS * UPW * 2 <= WS_ACT && WS_ACT + (size_t)QROWS * FFN * 2 <= WS_END, "B map");
constexpr int CW_BAR = 4096;

constexpr int RING_BYTES = 131072;
constexpr int LDSCTL_OFF = RING_BYTES, MISC_OFF = LDSCTL_OFF + 320;
constexpr int LDS_BYTES = 147456;

#define GAS __attribute__((address_space(1)))
#define LAS __attribute__((address_space(3)))
typedef unsigned short bf16;
typedef unsigned v4u __attribute__((ext_vector_type(4)));
typedef float f32x4 __attribute__((ext_vector_type(4)));
typedef short bf16x8 __attribute__((ext_vector_type(8)));
typedef GAS unsigned gu32;
typedef GAS unsigned long long gu64;
#define RLX_AGENT __ATOMIC_RELAXED, __HIP_MEMORY_SCOPE_AGENT
#define LDS_WAIT() asm volatile("s_waitcnt lgkmcnt(0)" ::: "memory")
#define VM_WAIT() asm volatile("s_waitcnt vmcnt(0)" ::: "memory")
__device__ __forceinline__ unsigned long long rt() { return __builtin_amdgcn_s_memrealtime(); }
__device__ __forceinline__ unsigned f2bf(float f) { unsigned u = __builtin_bit_cast(unsigned, f); return (u + 0x7fffu + ((u >> 16) & 1u)) >> 16; }
__device__ __forceinline__ unsigned pk2(float lo, float hi) { return f2bf(lo) | (f2bf(hi) << 16); }

#define XB_TMO      128
#define XB_XCNT(j)  (256  + 64 * (j))
#define XB_XSUB(j)  (1280 + 64 * (j))
#define XB_XGEN(j)  (2304 + 64 * (j))
#define XB_TOP      3328
#define XB_TOPGEN   3392
#define XCD_BAR_WORDS 3456
#define XB_SPIN_CAP (1u << 18)

__device__ __forceinline__ unsigned xb_ld(unsigned* p)              { return __hip_atomic_load(p, __ATOMIC_RELAXED, __HIP_MEMORY_SCOPE_AGENT); }
__device__ __forceinline__ unsigned xb_add(unsigned* p, unsigned v) { return __hip_atomic_fetch_add(p, v, __ATOMIC_RELAXED, __HIP_MEMORY_SCOPE_AGENT); }
__device__ __forceinline__ unsigned xb_xcc_id() { return (unsigned)__builtin_amdgcn_s_getreg((3 << 11) | 20) & 0xFu; }
#define XB_SPIN(cond, bar) do { unsigned _sp = 0; while (cond) { __builtin_amdgcn_s_sleep(1); \
    if ((++_sp & 255u) == 0u) { if (xb_ld(&(bar)[XB_TMO])) break; if (_sp > XB_SPIN_CAP) { atomicAdd(&(bar)[XB_TMO], 1u); break; } } } } while (0)

struct XcdBarrier {
    unsigned* bar; unsigned x;
    volatile LAS unsigned* st;
};

__device__ __forceinline__ XcdBarrier xcd_barrier_post(unsigned* bar, volatile LAS unsigned* st) {
    XcdBarrier b; b.bar = bar; b.x = xb_xcc_id(); b.st = st;
    if (threadIdx.x == 0) (void)xb_add(&bar[XB_XCNT(b.x)], 1u);
    return b;
}
__device__ __forceinline__ void xcd_barrier_complete(unsigned* bar, unsigned x, unsigned& nloc, unsigned& nx) {
    const unsigned G = gridDim.x * gridDim.y * gridDim.z;
    unsigned sum, cnt, mine, sp = 0u;
    for (;;) {
        sum = 0u; cnt = 0u; mine = 0u;
#pragma unroll
        for (unsigned j = 0; j < 16; ++j) { const unsigned c = xb_ld(&bar[XB_XCNT(j)]); sum += c; cnt += (c > 0u) ? 1u : 0u; mine = (j == x) ? c : mine; }
        if (sum == G) break;
        __builtin_amdgcn_s_sleep(1);
        if ((++sp & 255u) == 0u) { if (xb_ld(&bar[XB_TMO])) break; if (sp > XB_SPIN_CAP) { atomicAdd(&bar[XB_TMO], 1u); break; } }
    }
    nloc = mine > 0u ? mine : 1u; nx = cnt > 0u ? cnt : 1u;
}

__device__ __forceinline__ void xcd_barrier(const XcdBarrier& b) {
    asm volatile("s_waitcnt vmcnt(0)" ::: "memory");
    __syncthreads();
    if (threadIdx.x == 0) {
        unsigned* bar = b.bar;
        __builtin_amdgcn_s_waitcnt(0);
        unsigned nloc = b.st[0], nx = b.st[1];
        if (nloc == 0u) { xcd_barrier_complete(bar, b.x, nloc, nx); b.st[0] = nloc; b.st[1] = nx; }
        const unsigned old = xb_add(&bar[XB_XSUB(b.x)], 1u);
        const unsigned gen = old / nloc;
        if (old + 1u == (gen + 1u) * nloc) {
            __builtin_amdgcn_fence(__ATOMIC_RELEASE, "agent");
            asm volatile("s_waitcnt vmcnt(0)" ::: "memory");
            const unsigned og = xb_add(&bar[XB_TOP], 1u);
            const unsigned tg = og / nx;
            if (og + 1u == (tg + 1u) * nx) xb_add(&bar[XB_TOPGEN], 1u);
            else XB_SPIN(xb_ld(&bar[XB_TOPGEN]) == tg, bar);
            __builtin_amdgcn_fence(__ATOMIC_ACQUIRE, "agent");
            xb_add(&bar[XB_XGEN(b.x)], 1u);
            asm volatile("s_waitcnt vmcnt(0)" ::: "memory");
        } else {
            XB_SPIN(xb_ld(&bar[XB_XGEN(b.x)]) == gen, bar);
            __builtin_amdgcn_fence(__ATOMIC_ACQUIRE, "agent");
            asm volatile("s_waitcnt vmcnt(0)" ::: "memory");
        }
    }
    __syncthreads();
}

__device__ __forceinline__ float bf2f(unsigned short b) { return __builtin_bit_cast(float, (unsigned)b << 16); }
__device__ __forceinline__ float bf2f(short b) { return __builtin_bit_cast(float, (unsigned)(unsigned short)b << 16); }
__device__ __forceinline__ float wave_sum(float v) {
#pragma unroll
    for (int o = 1; o < 64; o <<= 1) v += __shfl_xor(v, o);
    return v;
}
__device__ __forceinline__ float wave_max(float v) {
#pragma unroll
    for (int o = 1; o < 64; o <<= 1) v = fmaxf(v, __shfl_xor(v, o));
    return v;
}
__device__ __forceinline__ float fast_exp(float x) { return __builtin_amdgcn_exp2f(x * 1.4426950408889634f); }
__device__ __forceinline__ float sigmoidf_(float x) { return __builtin_amdgcn_rcpf(1.f + fast_exp(-x)); }
__device__ __forceinline__ float gelu_tanh(float x) {
    const float z = 0.7978845608028654f * (x + 0.044715f * x * x * x);
    return x * sigmoidf_(2.f * z);
}
__device__ __forceinline__ float neg_expm1(float x) {
    const float p = x * (1.f + x * (0.5f + x * (0.16666667f + x * (0.041666668f + x * (0.0083333338f + x * 0.0013888889f)))));
    const float e = fast_exp(x) - 1.f;
    return -(fabsf(x) < 0.25f ? p : e);
}
__device__ __forceinline__ v4u pack8(const float (&v)[8]) { v4u o; o.x = pk2(v[0], v[1]); o.y = pk2(v[2], v[3]); o.z = pk2(v[4], v[5]); o.w = pk2(v[6], v[7]); return o; }

struct Frame {
    LAS unsigned char* lds;
    volatile LAS unsigned* MISC;
    gu32* ctl;
    int tid, lane, wave, vcu, G;
    const float *x_prompt, *x_sample, *meta, *g_pre_mix, *w_in, *q_norm, *k_norm, *lru_conv_w, *lru_conv_b, *lru_w_r, *lru_b_r, *lru_w_i, *lru_b_i, *lru_lambda,
                *g_attn_out, *g_lru_out, *w_out, *g_post_mix, *g_pre_ffn, *w_up, *ffn_conv_w, *ffn_conv_b, *w_down, *g_post_ffn;
    float* out;
    unsigned char* ws;
#define WSP(T, NAME, OFF) __device__ __forceinline__ T* NAME() const { return (T*)(ws + (OFF)); }
    WSP(bf16, WIN_T, WS_WIN) WSP(bf16, WOUT_T, WS_WOUT) WSP(bf16, WUP_T, WS_WUP) WSP(bf16, WDOWN_T, WS_WDOWN) WSP(bf16, WG, WS_WG) WSP(bf16, XN, WS_A) WSP(bf16, Q, WS_Q) WSP(bf16, K, WS_K) WSP(bf16, V, WS_V)
    WSP(bf16, XR, WS_XR) WSP(bf16, GY, WS_GY) WSP(bf16, Y1, WS_Y1) WSP(bf16, UP, WS_UP) WSP(bf16, ACT, WS_ACT) WSP(bf16, XNMETA, WS_XNMETA) WSP(bf16, KM, WS_KM) WSP(bf16, VM, WS_VM)
    WSP(float, ZM, WS_ZM) WSP(float, Q15, WS_Q15) WSP(float, GY15, WS_GY15) WSP(float, LO15, WS_LO15) WSP(float, MIXED15, WS_MIXED15) WSP(float, Y15, WS_Y15) WSP(float, G15, WS_G15) WSP(float, MQP, WS_MQP)
    WSP(float, CIN, WS_CIN) WSP(float2, CAR, WS_CAR)
#undef WSP
};

__device__ __forceinline__ void p0_transpose_item(const float* W, int K, int N, bf16* WT, int row_off, LAS float* scr, int item, int lane) {
    const int nblk = N / 32, kb = item / nblk, nb = item % nblk, k0 = 64 * kb, n0 = 32 * nb;
#pragma unroll 8
    for (int i = 0; i < 32; ++i) { const int kk = 2 * i + (lane >> 5); scr[kk * 33 + (lane & 31)] = W[(size_t)(k0 + kk) * N + n0 + (lane & 31)]; }
    LDS_WAIT(); asm volatile("" ::: "memory");
    const int c = lane & 7;
#pragma unroll
    for (int j = 0; j < 4; ++j) { const int n = (lane >> 3) + 8 * j; const LAS float* s = scr + (8 * c) * 33 + n;
        v4u o; o.x = pk2(s[0 * 33], s[1 * 33]); o.y = pk2(s[2 * 33], s[3 * 33]); o.z = pk2(s[4 * 33], s[5 * 33]); o.w = pk2(s[6 * 33], s[7 * 33]);
        *(GAS v4u*)(WT + (size_t)(row_off + n0 + n) * K + k0 + 8 * c) = o; }
    LDS_WAIT(); asm volatile("" ::: "memory");
}
__device__ __forceinline__ void rms_row_to_bf16(const float* xrow, const float* g, bf16* orow, int lane) {
    const GAS f32x4* xr = (const GAS f32x4*)xrow + lane;
    f32x4 v[8]; float s = 0.f;
#pragma unroll
    for (int j = 0; j < 8; ++j) { v[j] = xr[64 * j]; s += (v[j].x * v[j].x + v[j].y * v[j].y) + (v[j].z * v[j].z + v[j].w * v[j].w); }
    const float r = 1.f / sqrtf(wave_sum(s) * (1.f / DM) + EPS);
    const GAS f32x4* gr = (const GAS f32x4*)g + lane;
    GAS unsigned long long* o8 = (GAS unsigned long long*)orow + lane;
#pragma unroll
    for (int j = 0; j < 8; ++j) { const f32x4 gg = gr[64 * j];
        o8[64 * j] = (unsigned long long)pk2(v[j].x * r * gg.x, v[j].y * r * gg.y) | ((unsigned long long)pk2(v[j].z * r * gg.z, v[j].w * r * gg.w) << 32); }
}
__device__ __forceinline__ void p0_prologue(Frame& F) {
    LAS float* scr = (LAS float*)(F.lds + F.wave * 16384);
    const int gw = F.vcu * NWAVES + F.wave, NGW = F.G * NWAVES;
    constexpr int I_IN = (DM / 64) * (INW / 32), I_OUT = (DM / 64) * (DM / 32), I_UP = (DM / 64) * (UPW / 32), I_DN = (FFN / 64) * (DM / 32), I_G = 32 * 8;
    constexpr int NITEMS = I_IN + I_OUT + I_UP + I_DN + I_G;
    for (int it = gw; it < NITEMS; it += NGW) {
        int r = it;
        if (r < I_IN) { p0_transpose_item(F.w_in, DM, INW, F.WIN_T(), 0, scr, r, F.lane); continue; } r -= I_IN;
        if (r < I_OUT) { p0_transpose_item(F.w_out, DM, DM, F.WOUT_T(), 0, scr, r, F.lane); continue; } r -= I_OUT;
        if (r < I_UP) { p0_transpose_item(F.w_up, DM, UPW, F.WUP_T(), 0, scr, r, F.lane); continue; } r -= I_UP;
        if (r < I_DN) { p0_transpose_item(F.w_down, FFN, DM, F.WDOWN_T(), 0, scr, r, F.lane); continue; } r -= I_DN;
        {
            const int mi = r >> 3, sub = r & 7, gate = mi >> 4, dir = (mi >> 3) & 1, blk = mi & 7;
            const float* W = (gate ? F.lru_w_i : F.lru_w_r) + (size_t)(dir * 8 + blk) * 16384;
            bf16* WT = F.WG() + (size_t)((dir * 2 + gate) * 8 + blk) * 16384;
            p0_transpose_item(W, 128, 128, WT, 0, scr, sub, F.lane);
        }
    }
    for (int m = gw; m < NTOK; m += NGW) {
        const float* xr = m < 32768 ? F.x_prompt + (size_t)m * DM : F.x_sample + (size_t)(m - 32768) * DM;
        rms_row_to_bf16(xr, F.g_pre_mix, F.XN() + (size_t)m * DM, F.lane);
    }
    for (int m = gw; m < 16; m += NGW) rms_row_to_bf16(F.meta + (size_t)m * DM, F.g_pre_mix, F.XNMETA() + (size_t)m * DM, F.lane);
    const int gt = F.vcu * 512 + F.tid, NGT = F.G * 512; const v4u z4 = {0u, 0u, 0u, 0u};
    for (int i = gt; i < 12 * 48 * 128; i += NGT) { const int s = i / (48 * 128), rem = i % (48 * 128); ((GAS v4u*)(F.XR() + (size_t)xr_base(s) * 1024))[rem] = z4; }
    for (int i = gt; i < 64 * 128; i += NGT) ((GAS v4u*)(F.XR() + (size_t)XR_ROWS * 1024))[i] = z4;
    for (int i = gt; i < 2048; i += NGT) { ((GAS v4u*)F.KM())[i] = z4; ((GAS v4u*)F.VM())[i] = z4; }
}

template <int R, class Out>
__device__ __forceinline__ void small_gemm(const LAS float* X, int K, const bf16* Wt, int N, int gw, int NGW, int lane, const Out& out) {
    for (int n = gw; n < N; n += NGW) {
        float acc[R];
#pragma unroll
        for (int r = 0; r < R; ++r) acc[r] = 0.f;
        const GAS bf16x8* wrow = (const GAS bf16x8*)(Wt + (size_t)n * K);
        for (int k8 = lane; k8 < K / 8; k8 += 64) {
            const bf16x8 w = wrow[k8]; float wf[8];
#pragma unroll
            for (int j = 0; j < 8; ++j) wf[j] = bf2f(w[j]);
#pragma unroll
            for (int r = 0; r < R; ++r) { const LAS f32x4* xp = (const LAS f32x4*)(X + r * K + k8 * 8); const f32x4 a = xp[0], b = xp[1];
                acc[r] += (a.x * wf[0] + a.y * wf[1]) + (a.z * wf[2] + a.w * wf[3]) + (b.x * wf[4] + b.y * wf[5]) + (b.z * wf[6] + b.w * wf[7]); }
        }
        float v = 0.f;
#pragma unroll
        for (int r = 0; r < R; ++r) { const float s = wave_sum(acc[r]); v = (lane == r) ? s : v; }
        out(n, lane, v);
    }
}
struct OutMetaZ { float* ZM; bf16* XR;
    __device__ __forceinline__ void operator()(int n, int lane, float v) const {
        if (lane < 16) { ZM[lane * INW + n] = v;
            if (n >= 1536 && n < 2560) { const unsigned short b = (unsigned short)f2bf(v); const int c = n - 1536;
                for (int s = 0; s < 12; ++s) XR[(size_t)(xr_base(s) + 48 + lane) * 1024 + c] = b; } }
    } };
struct OutRows { float* Y; int ld; int R;
    __device__ __forceinline__ void operator()(int n, int lane, float v) const { if (lane < R) Y[(size_t)lane * ld + n] = v; } };

__device__ __forceinline__ void p1_meta_z(Frame& F) {
    LAS float* X = (LAS float*)F.lds;
    for (int i = F.tid; i < 16 * DM / 8; i += 512) { const bf16x8 v = ((const GAS bf16x8*)F.XNMETA())[i];
        ((LAS f32x4*)X)[2 * i] = (f32x4){bf2f(v[0]), bf2f(v[1]), bf2f(v[2]), bf2f(v[3])}; ((LAS f32x4*)X)[2 * i + 1] = (f32x4){bf2f(v[4]), bf2f(v[5]), bf2f(v[6]), bf2f(v[7])}; }
    __syncthreads();
    const OutMetaZ o{F.ZM(), F.XR()};
    small_gemm<16, OutMetaZ>(X, DM, F.WIN_T(), INW, F.vcu * NWAVES + F.wave, F.G * NWAVES, F.lane, o);
    __syncthreads();
}
typedef float f32x16 __attribute__((ext_vector_type(16)));
constexpr int LRU_XCB = 0, LRU_XCB_STRIDE = 272;
constexpr int LRU_XCF = 17408;
constexpr int LRU_HF = LRU_XCF + 32768, LRU_HB = LRU_HF + 32768;
__device__ __forceinline__ int crow16(int r, int hi) { return (r & 3) + 8 * (r >> 2) + 4 * hi; }

template <int DIR>
__device__ __forceinline__ void scan_tile(const float (&a)[16], const float (&u)[16], float& carry, float& ptot, float (&h)[16], bool up) {
    float HL[16], PL[16], As[4], Hs[4];
#pragma unroll
    for (int j = 0; j < 4; ++j) {
        float hl = 0.f, p = 1.f;
#pragma unroll
        for (int ii = 0; ii < 4; ++ii) { const int idx = 4 * j + (DIR == 0 ? ii : 3 - ii); hl = a[idx] * hl + u[idx]; p *= a[idx]; HL[idx] = hl; PL[idx] = p; }
        As[j] = p; Hs[j] = hl;
    }
    float Alo[4], Ahi[4], Hlo[4], Hhi[4];
#pragma unroll
    for (int j = 0; j < 4; ++j) {
        { const unsigned x = __float_as_uint(As[j]); auto rr = __builtin_amdgcn_permlane32_swap(x, x, false, false); Alo[j] = __uint_as_float(rr[0]); Ahi[j] = __uint_as_float(rr[1]); }
        { const unsigned x = __float_as_uint(Hs[j]); auto rr = __builtin_amdgcn_permlane32_swap(x, x, false, false); Hlo[j] = __uint_as_float(rr[0]); Hhi[j] = __uint_as_float(rr[1]); }
    }
    float cin[4]; float c = carry;
    if (DIR == 0) {
#pragma unroll
        for (int j = 0; j < 4; ++j) { const float c_lo = c; c = Alo[j] * c + Hlo[j]; const float c_hi = c; c = Ahi[j] * c + Hhi[j]; cin[j] = up ? c_hi : c_lo; }
    } else {
#pragma unroll
        for (int j = 3; j >= 0; --j) { const float c_hi = c; c = Ahi[j] * c + Hhi[j]; const float c_lo = c; c = Alo[j] * c + Hlo[j]; cin[j] = up ? c_hi : c_lo; }
    }
    carry = c;
#pragma unroll
    for (int j = 0; j < 4; ++j) ptot *= Alo[j] * Ahi[j];
#pragma unroll
    for (int idx = 0; idx < 16; ++idx) h[idx] = HL[idx] + PL[idx] * cin[idx >> 2];
}

template <int PASS>
__device__ __forceinline__ void lru_unit(Frame& F, int seq, int c, int n, int cg) {
    LAS unsigned char* L = F.lds;
    const int tid = F.tid, lane = F.lane, wave = F.wave;
    const int xb = xr_base(seq);
    for (int it = tid; it < 1024; it += 512) {
        const int tau = it >> 4, co = (it & 15) * 8, pp = c * 64 + tau, chg = n * 128 + co;
        float xc[8];
        { const GAS f32x4* cb = (const GAS f32x4*)(F.lru_conv_b + chg); const f32x4 b0 = cb[0], b1 = cb[1];
          xc[0] = b0.x; xc[1] = b0.y; xc[2] = b0.z; xc[3] = b0.w; xc[4] = b1.x; xc[5] = b1.y; xc[6] = b1.z; xc[7] = b1.w; }
#pragma unroll
        for (int k = 0; k < 4; ++k) {
            int row = xb + pp + k - 2; row = row < 0 ? 0 : row;
            const bf16x8 xv = *(const GAS bf16x8*)(F.XR() + (size_t)row * 1024 + chg);
            const GAS f32x4* wp = (const GAS f32x4*)(F.lru_conv_w + k * 1024 + chg); const f32x4 w0 = wp[0], w1 = wp[1];
            xc[0] += w0.x * bf2f(xv[0]); xc[1] += w0.y * bf2f(xv[1]); xc[2] += w0.z * bf2f(xv[2]); xc[3] += w0.w * bf2f(xv[3]);
            xc[4] += w1.x * bf2f(xv[4]); xc[5] += w1.y * bf2f(xv[5]); xc[6] += w1.z * bf2f(xv[6]); xc[7] += w1.w * bf2f(xv[7]);
        }
        if (c == 0 && tau < 48) {
#pragma unroll
            for (int j = 0; j < 8; ++j) xc[j] = 0.f;
        }
        LAS f32x4* xf = (LAS f32x4*)(L + LRU_XCF + (tau * 128 + co) * 4);
        xf[0] = (f32x4){xc[0], xc[1], xc[2], xc[3]}; xf[1] = (f32x4){xc[4], xc[5], xc[6], xc[7]};
        *(LAS v4u*)(L + LRU_XCB + tau * LRU_XCB_STRIDE + co * 2) = pack8(xc);
    }
    __syncthreads();
    {
        const int d = wave >> 2, g4 = wave & 3, r32 = lane & 31, hi = lane >> 5;
        const int chl = g4 * 32 + r32, chg = n * 128 + chl;
        const bf16* wr_ = F.WG() + (size_t)((d * 2 + 0) * 8 + n) * 16384 + chl * 128 + hi * 8;
        const bf16* wi_ = F.WG() + (size_t)((d * 2 + 1) * 8 + n) * 16384 + chl * 128 + hi * 8;
        bf16x8 br[8], bi[8];
#pragma unroll
        for (int ks = 0; ks < 8; ++ks) { br[ks] = *(const GAS bf16x8*)(wr_ + ks * 16); bi[ks] = *(const GAS bf16x8*)(wi_ + ks * 16); }
        const float b_r = F.lru_b_r[d * 1024 + chg], b_i = F.lru_b_i[d * 1024 + chg];
        const float sp8 = 8.f * log1pf(expf(-F.lru_lambda[d * 1024 + chg]));
        float carry = 0.f, ptot = 1.f;
        if (PASS == 2) carry = F.CIN()[((size_t)cg * 2 + d) * 1024 + chg];
#pragma unroll
        for (int tt = 0; tt < 2; ++tt) {
            const int tile = d ? 1 - tt : tt;
            f32x16 ar = {}, ai = {};
#pragma unroll
            for (int ks = 0; ks < 8; ++ks) {
                const bf16x8 a = *(const LAS bf16x8*)(L + LRU_XCB + (tile * 32 + r32) * LRU_XCB_STRIDE + (ks * 16 + hi * 8) * 2);
                ar = __builtin_amdgcn_mfma_f32_32x32x16_bf16(a, br[ks], ar, 0, 0, 0);
                ai = __builtin_amdgcn_mfma_f32_32x32x16_bf16(a, bi[ks], ai, 0, 0, 0);
            }
            float av[16], uv[16], hv[16];
#pragma unroll
            for (int r = 0; r < 16; ++r) {
                const int tau = tile * 32 + crow16(r, hi);
                const float xcv = *(const LAS float*)(L + LRU_XCF + (tau * 128 + chl) * 4);
                const float rg = sigmoidf_(ar[r] + b_r), ig = sigmoidf_(ai[r] + b_i);
                const float la = -sp8 * rg;
                av[r] = fast_exp(la);
                uv[r] = sqrtf(neg_expm1(2.f * la)) * (ig * xcv);
            }
            if (d == 0) scan_tile<0>(av, uv, carry, ptot, hv, hi != 0); else scan_tile<1>(av, uv, carry, ptot, hv, hi != 0);
            if (PASS == 2) {
#pragma unroll
                for (int r = 0; r < 16; ++r) { const int tau = tile * 32 + crow16(r, hi); *(LAS float*)(L + (d ? LRU_HB : LRU_HF) + (tau * 128 + chl) * 4) = hv[r]; }
            }
        }
        if (PASS == 1) { if (hi == 0) F.CAR()[((size_t)cg * 2 + d) * 1024 + chg] = make_float2(ptot, carry); }
    }
    if (PASS == 2) {
        __syncthreads();
        if (c > 0) {
            const int row0 = seq_first_row(seq) + 64 * (c - 1);
            for (int it = tid; it < 1024; it += 512) {
                const int tau = it >> 4, co = (it & 15) * 8;
                bf16* gp = F.GY() + (size_t)(row0 + tau) * 1024 + n * 128 + co;
                const bf16x8 gv = *(const GAS bf16x8*)gp;
                const LAS f32x4* hf = (const LAS f32x4*)(L + LRU_HF + (tau * 128 + co) * 4); const LAS f32x4* hb = (const LAS f32x4*)(L + LRU_HB + (tau * 128 + co) * 4);
                const f32x4 f0 = hf[0], f1 = hf[1], b0 = hb[0], b1 = hb[1];
                float o[8];
                o[0] = (f0.x + b0.x) * gelu_tanh(bf2f(gv[0])); o[1] = (f0.y + b0.y) * gelu_tanh(bf2f(gv[1])); o[2] = (f0.z + b0.z) * gelu_tanh(bf2f(gv[2])); o[3] = (f0.w + b0.w) * gelu_tanh(bf2f(gv[3]));
                o[4] = (f1.x + b1.x) * gelu_tanh(bf2f(gv[4])); o[5] = (f1.y + b1.y) * gelu_tanh(bf2f(gv[5])); o[6] = (f1.z + b1.z) * gelu_tanh(bf2f(gv[6])); o[7] = (f1.w + b1.w) * gelu_tanh(bf2f(gv[7]));
                *(GAS v4u*)gp = pack8(o);
            }
        } else if (tid < 128) {
            const float hf = *(const LAS float*)(L + LRU_HF + (63 * 128 + tid) * 4), hb = *(const LAS float*)(L + LRU_HB + (63 * 128 + tid) * 4);
            F.LO15()[seq * 1024 + n * 128 + tid] = (hf + hb) * gelu_tanh(F.GY15()[n * 128 + tid]);
        }
    }
    __syncthreads();
}
template <int PASS>
__device__ __forceinline__ void lru_phase(Frame& F) {
    for (int uid = F.vcu; uid < NCHUNK * 8; uid += F.G) {
        const int cg = uid >> 3, n = uid & 7; int seq, c;
        if (cg < 520) { seq = cg / 65; c = cg - seq * 65; } else { const int c2 = cg - 520; seq = c2 / 129; c = c2 - seq * 129; seq += 8; }
        lru_unit<PASS>(F, seq, c, n, cg);
    }
}
__device__ __forceinline__ void lru_propagate(Frame& F) {
    const int gid = F.vcu * 512 + F.tid;
    if (gid < 12 * 2048) {
        const int s = gid >> 11, d = (gid >> 10) & 1, ch = gid & 1023; const int nch = s < 8 ? 65 : 129, cb = chunk_base(s);
        float cin = 0.f;
        if (d == 0) {
#pragma unroll 8
            for (int c = 0; c < nch; ++c) { const size_t idx = ((size_t)(cb + c) * 2 + 0) * 1024 + ch; F.CIN()[idx] = cin; const float2 ph = F.CAR()[idx]; cin = ph.x * cin + ph.y; }
        } else {
#pragma unroll 8
            for (int c = nch - 1; c >= 0; --c) { const size_t idx = ((size_t)(cb + c) * 2 + 1) * 1024 + ch; F.CIN()[idx] = cin; const float2 ph = F.CAR()[idx]; cin = ph.x * cin + ph.y; }
        }
    }
}

__device__ __forceinline__ void qk_rope_row(Frame& F, int row, int lane) {
    const int s = row_seq(row), t = row - seq_first_row(s);
    const int p = lane >> 5, i = lane & 31;
    const float pos = (float)(p ? (t & 63) : (t >> 6));
    const float inv = __builtin_amdgcn_exp2f(-(float)i * (13.287712379549449f / 32.f));
    float rev = pos * inv * 0.15915494309189535f; rev -= floorf(rev);
    const float sn = __builtin_amdgcn_sinf(rev), cs = __builtin_amdgcn_cosf(rev);
    const int d1 = p * 64 + i, d2 = d1 + 32;
#pragma unroll
    for (int h = 0; h < 10; ++h) {
        bf16* base = h < 8 ? F.Q() + (size_t)row * 1024 + h * 128 : F.K() + (size_t)row * 256 + (h - 8) * 128;
        const float* gn = h < 8 ? F.q_norm : F.k_norm;
        float x1 = bf2f(base[d1]), x2 = bf2f(base[d2]);
        const float r = 1.f / sqrtf(wave_sum(x1 * x1 + x2 * x2) * (1.f / 128.f) + EPS);
        x1 *= r * gn[d1]; x2 *= r * gn[d2];
        base[d1] = (bf16)f2bf(x1 * cs - x2 * sn); base[d2] = (bf16)f2bf(x2 * cs + x1 * sn);
    }
}
__device__ __forceinline__ void p3_meta_job(Frame& F) {
    for (int pr = F.wave; pr < 32; pr += 8) { const int r = pr >> 1, hk = pr & 1; const float* z = F.ZM() + r * INW + 1024 + hk * 128;
        const float a = z[F.lane], b = z[F.lane + 64]; const float rs = 1.f / sqrtf(wave_sum(a * a + b * b) * (1.f / 128.f) + EPS);
        F.KM()[r * 256 + hk * 128 + F.lane] = (bf16)f2bf(a * rs * F.k_norm[F.lane]); F.KM()[r * 256 + hk * 128 + F.lane + 64] = (bf16)f2bf(b * rs * F.k_norm[F.lane + 64]); }
    for (int i = F.tid; i < 16 * 256; i += 512) F.VM()[i] = (bf16)f2bf(F.ZM()[(i >> 8) * INW + 1280 + (i & 255)]);
    { const int h = F.wave; const float* z = F.ZM() + 15 * INW + h * 128; const float a = z[F.lane], b = z[F.lane + 64];
      const float rs = 1.f / sqrtf(wave_sum(a * a + b * b) * (1.f / 128.f) + EPS);
      F.Q15()[h * 128 + F.lane] = a * rs * F.q_norm[F.lane]; F.Q15()[h * 128 + F.lane + 64] = b * rs * F.q_norm[F.lane + 64]; }
    for (int i = F.tid; i < 1024; i += 512) F.GY15()[i] = F.ZM()[15 * INW + 2560 + i];
}

__device__ __forceinline__ void metaq_item(Frame& F, int it) {
    int s, kvh, j; if (it < 256) { s = it >> 5; kvh = (it >> 4) & 1; j = it & 15; } else { const int t2 = it - 256; s = 8 + (t2 >> 6); kvh = (t2 >> 5) & 1; j = t2 & 31; }
    LAS float* q4 = (LAS float*)F.lds;
    LAS float* sc = q4 + 512;
    LAS float* red = sc + 4 * 288;
    const int tid = F.tid, nk = 256 + (j == 0 ? 16 : 0), row0 = seq_first_row(s) + 256 * j;
    q4[tid] = F.Q15()[kvh * 512 + tid];
    __syncthreads();
    if (tid < nk) {
        const bf16* kp = tid < 256 ? F.K() + (size_t)(row0 + tid) * 256 + kvh * 128 : F.KM() + (tid - 256) * 256 + kvh * 128;
        float d0 = 0.f, d1 = 0.f, d2 = 0.f, d3 = 0.f;
#pragma unroll 4
        for (int cc = 0; cc < 16; ++cc) { const bf16x8 kv = ((const GAS bf16x8*)kp)[cc];
#pragma unroll
            for (int e = 0; e < 8; ++e) { const float kf = bf2f(kv[e]); d0 += kf * q4[cc * 8 + e]; d1 += kf * q4[128 + cc * 8 + e]; d2 += kf * q4[256 + cc * 8 + e]; d3 += kf * q4[384 + cc * 8 + e]; } }
        const float SC = 0.088388347648318440f;
        sc[tid] = d0 * SC; sc[288 + tid] = d1 * SC; sc[576 + tid] = d2 * SC; sc[864 + tid] = d3 * SC;
    }
    __syncthreads();
    if (F.wave < 4) { LAS float* sh = sc + F.wave * 288; float m = -INFINITY;
        for (int k = F.lane; k < nk; k += 64) m = fmaxf(m, sh[k]);
        m = wave_max(m); float l = 0.f;
        for (int k = F.lane; k < nk; k += 64) { const float p = __expf(sh[k] - m); sh[k] = p; l += p; }
        l = wave_sum(l);
        if (F.lane == 0) { red[F.wave * 2] = m; red[F.wave * 2 + 1] = l; } }
    __syncthreads();
    { const int h = tid >> 7, d = tid & 127; float o = 0.f; const LAS float* sh = sc + h * 288;
      const bf16* vp = F.V() + (size_t)row0 * 256 + kvh * 128 + d;
#pragma unroll 8
      for (int k = 0; k < 256; ++k) o += sh[k] * bf2f(vp[(size_t)k * 256]);
      if (j == 0) for (int k = 0; k < 16; ++k) o += sh[256 + k] * bf2f(F.VM()[k * 256 + kvh * 128 + d]);
      float* dst = F.MQP() + ((size_t)it * 4 + h) * 132; dst[2 + d] = o; if (d == 0) { dst[0] = red[h * 2]; dst[1] = red[h * 2 + 1]; } }
    __syncthreads();
}
__device__ __forceinline__ void attn_phase(Frame& F, char* lds_generic) {
    for (int r = 0; r < 8; ++r) {
        int s, kvh, hq, qb, S;
        if (F.G == 256) {
            const int x = F.vcu >> 5, i = F.vcu & 31;
            if (r < 4) { const int pair = 2 * x + (r >> 1); s = pair >> 1; kvh = pair & 1; const int u = (r & 1) * 32 + i; hq = u >> 4; qb = u & 15; S = 4096; }
            else { const int pair = x; s = 8 + (pair >> 1); kvh = pair & 1; const int u = (r - 4) * 32 + i; hq = u >> 5; qb = u & 31; S = 8192; }
        } else { s = 0; kvh = 0; hq = 0; qb = 0; S = 0; }
        if (S == 0) continue;
        const int row0 = seq_first_row(s), h = kvh * 4 + hq;
        bf16* qp = F.Q() + (size_t)(row0 + qb * 256) * 1024 + h * 128;
        attn::attn_unit(qp, F.K() + (size_t)row0 * 256 + kvh * 128, F.V() + (size_t)row0 * 256 + kvh * 128, F.KM() + kvh * 128, F.VM() + kvh * 128, qp, S / 64 + 1, lds_generic);
    }
}

__device__ __forceinline__ void p5_mixed_row(Frame& F, int row, int lane) {
    const GAS bf16x8* a = (const GAS bf16x8*)(F.Q() + (size_t)row * 1024);
    const GAS bf16x8* l = (const GAS bf16x8*)(F.GY() + (size_t)row * 1024);
    const bf16x8 a0 = a[lane], a1 = a[lane + 64], l0 = l[lane], l1 = l[lane + 64];
    float sa = 0.f, sl = 0.f;
#pragma unroll
    for (int j = 0; j < 8; ++j) { const float x0 = bf2f(a0[j]), x1 = bf2f(a1[j]), y0 = bf2f(l0[j]), y1 = bf2f(l1[j]); sa += x0 * x0 + x1 * x1; sl += y0 * y0 + y1 * y1; }
    const float ra = 1.f / sqrtf(wave_sum(sa) * (1.f / 1024.f) + EPS), rl = 1.f / sqrtf(wave_sum(sl) * (1.f / 1024.f) + EPS);
    GAS v4u* o = (GAS v4u*)(F.XN() + (size_t)row * DM);
#pragma unroll
    for (int i = 0; i < 2; ++i) {
        const int e0 = (lane + 64 * i) * 8; const bf16x8 av = i ? a1 : a0, lv = i ? l1 : l0;
        const GAS f32x4* ga = (const GAS f32x4*)(F.g_attn_out + e0); const GAS f32x4* gl = (const GAS f32x4*)(F.g_lru_out + e0);
        const f32x4 ga0 = ga[0], ga1 = ga[1], gl0 = gl[0], gl1 = gl[1];
        float oa[8], ol[8];
        oa[0] = bf2f(av[0]) * ra * ga0.x; oa[1] = bf2f(av[1]) * ra * ga0.y; oa[2] = bf2f(av[2]) * ra * ga0.z; oa[3] = bf2f(av[3]) * ra * ga0.w;
        oa[4] = bf2f(av[4]) * ra * ga1.x; oa[5] = bf2f(av[5]) * ra * ga1.y; oa[6] = bf2f(av[6]) * ra * ga1.z; oa[7] = bf2f(av[7]) * ra * ga1.w;
        ol[0] = bf2f(lv[0]) * rl * gl0.x; ol[1] = bf2f(lv[1]) * rl * gl0.y; ol[2] = bf2f(lv[2]) * rl * gl0.z; ol[3] = bf2f(lv[3]) * rl * gl0.w;
        ol[4] = bf2f(lv[4]) * rl * gl1.x; ol[5] = bf2f(lv[5]) * rl * gl1.y; ol[6] = bf2f(lv[6]) * rl * gl1.z; ol[7] = bf2f(lv[7]) * rl * gl1.w;
        o[lane + 64 * i] = pack8(oa); o[128 + lane + 64 * i] = pack8(ol);
    }
}
__device__ __forceinline__ void p5_meta_job(Frame& F) {
    LAS float* buf = (LAS float*)F.lds; LAS float* red = buf + 2048; const int tid = F.tid;
    for (int s = 0; s < 12; ++s) {
        const int nj = s < 8 ? 16 : 32;
        for (int e = tid; e < 1024; e += 512) { const int h = e >> 7, d = e & 127, kvh = h >> 2, hq = h & 3;
            const int it0 = s < 8 ? s * 32 + kvh * 16 : 256 + (s - 8) * 64 + kvh * 32;
            float M = -INFINITY; for (int j = 0; j < nj; ++j) M = fmaxf(M, F.MQP()[((size_t)(it0 + j) * 4 + hq) * 132]);
            float Ls = 0.f, O = 0.f;
            for (int j = 0; j < nj; ++j) { const float* p = F.MQP() + ((size_t)(it0 + j) * 4 + hq) * 132; const float w = __expf(p[0] - M); Ls += p[1] * w; O += p[2 + d] * w; }
            buf[e] = O / Ls; }
        for (int e = tid; e < 1024; e += 512) buf[1024 + e] = F.LO15()[s * 1024 + e];
        __syncthreads();
        { float ss = 0.f; for (int k = F.lane; k < 256; k += 64) { const float v = buf[F.wave * 256 + k]; ss += v * v; } ss = wave_sum(ss); if (F.lane == 0) red[F.wave] = ss; }
        __syncthreads();
        const float ra = 1.f / sqrtf((red[0] + red[1] + red[2] + red[3]) * (1.f / 1024.f) + EPS), rl = 1.f / sqrtf((red[4] + red[5] + red[6] + red[7]) * (1.f / 1024.f) + EPS);
        for (int e = tid; e < 2048; e += 512) F.MIXED15()[s * 2048 + e] = e < 1024 ? buf[e] * ra * F.g_attn_out[e] : buf[e] * rl * F.g_lru_out[e - 1024];
        __syncthreads();
    }
}
__device__ __forceinline__ void p6_meta_y(Frame& F) {
    LAS float* X = (LAS float*)F.lds;
    for (int i = F.tid; i < 12 * DM / 4; i += 512) ((LAS f32x4*)X)[i] = ((const GAS f32x4*)F.MIXED15())[i];
    __syncthreads();
    const OutRows o{F.Y15(), DM, 12};
    small_gemm<12, OutRows>(X, DM, F.WOUT_T(), DM, F.vcu * NWAVES + F.wave, F.G * NWAVES, F.lane, o);
    __syncthreads();
}

__device__ __forceinline__ void p7_row(Frame& F, int row, int lane) {
    const GAS bf16x8* y = (const GAS bf16x8*)(F.Y1() + (size_t)row * DM);
    const float* xr = row < 32768 ? F.x_prompt + (size_t)row * DM : F.x_sample + (size_t)(row - 32768) * DM;
    float hv[32]; float ss = 0.f;
#pragma unroll
    for (int i = 0; i < 4; ++i) { const bf16x8 v = y[lane + 64 * i];
#pragma unroll
        for (int j = 0; j < 8; ++j) { hv[8 * i + j] = bf2f(v[j]); ss += hv[8 * i + j] * hv[8 * i + j]; } }
    const float r1 = 1.f / sqrtf(wave_sum(ss) * (1.f / DM) + EPS); float s2 = 0.f;
#pragma unroll
    for (int i = 0; i < 4; ++i) { const int e0 = (lane + 64 * i) * 8;
        const GAS f32x4* xp = (const GAS f32x4*)(xr + e0); const GAS f32x4* gp = (const GAS f32x4*)(F.g_post_mix + e0);
        const f32x4 x0 = xp[0], x1 = xp[1], g0 = gp[0], g1 = gp[1];
        f32x4 h0, h1;
        h0.x = x0.x + hv[8 * i + 0] * r1 * g0.x; h0.y = x0.y + hv[8 * i + 1] * r1 * g0.y; h0.z = x0.z + hv[8 * i + 2] * r1 * g0.z; h0.w = x0.w + hv[8 * i + 3] * r1 * g0.w;
        h1.x = x1.x + hv[8 * i + 4] * r1 * g1.x; h1.y = x1.y + hv[8 * i + 5] * r1 * g1.y; h1.z = x1.z + hv[8 * i + 6] * r1 * g1.z; h1.w = x1.w + hv[8 * i + 7] * r1 * g1.w;
        GAS f32x4* op = (GAS f32x4*)(F.out + (size_t)row * DM + e0); op[0] = h0; op[1] = h1;
        hv[8 * i + 0] = h0.x; hv[8 * i + 1] = h0.y; hv[8 * i + 2] = h0.z; hv[8 * i + 3] = h0.w; hv[8 * i + 4] = h1.x; hv[8 * i + 5] = h1.y; hv[8 * i + 6] = h1.z; hv[8 * i + 7] = h1.w;
        s2 += (h0.x * h0.x + h0.y * h0.y) + (h0.z * h0.z + h0.w * h0.w) + (h1.x * h1.x + h1.y * h1.y) + (h1.z * h1.z + h1.w * h1.w); }
    const float r2 = 1.f / sqrtf(wave_sum(s2) * (1.f / DM) + EPS);
    GAS v4u* o = (GAS v4u*)(F.XN() + (size_t)row * DM);
#pragma unroll
    for (int i = 0; i < 4; ++i) { const int e0 = (lane + 64 * i) * 8; const GAS f32x4* gp = (const GAS f32x4*)(F.g_pre_ffn + e0); const f32x4 g0 = gp[0], g1 = gp[1];
        float t[8]; t[0] = hv[8 * i + 0] * r2 * g0.x; t[1] = hv[8 * i + 1] * r2 * g0.y; t[2] = hv[8 * i + 2] * r2 * g0.z; t[3] = hv[8 * i + 3] * r2 * g0.w;
        t[4] = hv[8 * i + 4] * r2 * g1.x; t[5] = hv[8 * i + 5] * r2 * g1.y; t[6] = hv[8 * i + 6] * r2 * g1.z; t[7] = hv[8 * i + 7] * r2 * g1.w;
        o[lane + 64 * i] = pack8(t); }
}
__device__ __forceinline__ void p7_meta_g(Frame& F) {
    LAS float* X = (LAS float*)F.lds;
    for (int r = F.wave; r < 12; r += 8) {
        const float* y = F.Y15() + r * DM; const float* xm = F.meta + 15 * DM;
        float hv[32]; float ss = 0.f;
#pragma unroll
        for (int i = 0; i < 32; ++i) { hv[i] = y[F.lane + 64 * i]; ss += hv[i] * hv[i]; }
        const float r1 = 1.f / sqrtf(wave_sum(ss) * (1.f / DM) + EPS); float s2 = 0.f;
#pragma unroll
        for (int i = 0; i < 32; ++i) { const int e = F.lane + 64 * i; hv[i] = xm[e] + hv[i] * r1 * F.g_post_mix[e]; s2 += hv[i] * hv[i]; }
        const float r2 = 1.f / sqrtf(wave_sum(s2) * (1.f / DM) + EPS);
#pragma unroll
        for (int i = 0; i < 32; ++i) { const int e = F.lane + 64 * i; X[r * DM + e] = hv[i] * r2 * F.g_pre_ffn[e]; }
    }
    __syncthreads();
    const OutRows o{F.G15(), FFN, 12};
    small_gemm<12, OutRows>(X, DM, F.WUP_T(), FFN, F.vcu * NWAVES + F.wave, F.G * NWAVES, F.lane, o);
    __syncthreads();
}

__device__ __forceinline__ void p9_act(Frame& F, int q) {
    constexpr int NOCT = FFN / 8;
    const int total = QROWS * NOCT;
    for (int it = F.vcu * 512 + F.tid; it < total; it += F.G * 512) {
        const int lr = it / NOCT, co = (it - lr * NOCT) * 8;
        const int row = q * QROWS + lr, s = row_seq(row), t = row - seq_first_row(s), S = seq_len(s);
        const bf16* up = F.UP() + (size_t)lr * UPW;
        const bf16x8 g1 = *(const GAS bf16x8*)(up + co), uu = *(const GAS bf16x8*)(up + FFN + co);
        float g0f[8], g2f[8];
        if (t > 0) { const bf16x8 g0 = *(const GAS bf16x8*)(up - UPW + co);
#pragma unroll
            for (int j = 0; j < 8; ++j) g0f[j] = bf2f(g0[j]); }
        else { const GAS f32x4* gp = (const GAS f32x4*)(F.G15() + (size_t)s * FFN + co); const f32x4 a = gp[0], b = gp[1];
            g0f[0] = a.x; g0f[1] = a.y; g0f[2] = a.z; g0f[3] = a.w; g0f[4] = b.x; g0f[5] = b.y; g0f[6] = b.z; g0f[7] = b.w; }
        if (t < S - 1) { const bf16x8 g2 = *(const GAS bf16x8*)(up + UPW + co);
#pragma unroll
            for (int j = 0; j < 8; ++j) g2f[j] = bf2f(g2[j]); }
        else {
#pragma unroll
            for (int j = 0; j < 8; ++j) g2f[j] = 0.f; }
        float w0[8], w1[8], w2[8], bb[8];
        { const GAS f32x4* p0 = (const GAS f32x4*)(F.ffn_conv_w + co); const GAS f32x4* p1 = (const GAS f32x4*)(F.ffn_conv_w + FFN + co); const GAS f32x4* p2 = (const GAS f32x4*)(F.ffn_conv_w + 2 * FFN + co);
          const GAS f32x4* pb = (const GAS f32x4*)(F.ffn_conv_b + co);
          const f32x4 a0 = p0[0], a1 = p0[1], b0 = p1[0], b1 = p1[1], c0 = p2[0], c1 = p2[1], d0 = pb[0], d1 = pb[1];
          w0[0] = a0.x; w0[1] = a0.y; w0[2] = a0.z; w0[3] = a0.w; w0[4] = a1.x; w0[5] = a1.y; w0[6] = a1.z; w0[7] = a1.w;
          w1[0] = b0.x; w1[1] = b0.y; w1[2] = b0.z; w1[3] = b0.w; w1[4] = b1.x; w1[5] = b1.y; w1[6] = b1.z; w1[7] = b1.w;
          w2[0] = c0.x; w2[1] = c0.y; w2[2] = c0.z; w2[3] = c0.w; w2[4] = c1.x; w2[5] = c1.y; w2[6] = c1.z; w2[7] = c1.w;
          bb[0] = d0.x; bb[1] = d0.y; bb[2] = d0.z; bb[3] = d0.w; bb[4] = d1.x; bb[5] = d1.y; bb[6] = d1.z; bb[7] = d1.w; }
        float o[8];
#pragma unroll
        for (int j = 0; j < 8; ++j) { const float x = bb[j] + w0[j] * g0f[j] + w1[j] * bf2f(g1[j]) + w2[j] * g2f[j]; o[j] = x * sigmoidf_(x) * bf2f(uu[j]); }
        *(GAS v4u*)(F.ACT() + (size_t)lr * FFN + co) = pack8(o);
    }
}
__device__ __forceinline__ void p11_row(Frame& F, int row, int lane) {
    const GAS bf16x8* f = (const GAS bf16x8*)(F.XN() + (size_t)row * DM);
    float fv[32]; float ss = 0.f;
#pragma unroll
    for (int i = 0; i < 4; ++i) { const bf16x8 v = f[lane + 64 * i];
#pragma unroll
        for (int j = 0; j < 8; ++j) { fv[8 * i + j] = bf2f(v[j]); ss += fv[8 * i + j] * fv[8 * i + j]; } }
    const float r1 = 1.f / sqrtf(wave_sum(ss) * (1.f / DM) + EPS);
#pragma unroll
    for (int i = 0; i < 4; ++i) { const int e0 = (lane + 64 * i) * 8;
        GAS f32x4* op = (GAS f32x4*)(F.out + (size_t)row * DM + e0); const GAS f32x4* gp = (const GAS f32x4*)(F.g_post_ffn + e0);
        f32x4 h0 = op[0], h1 = op[1]; const f32x4 g0 = gp[0], g1 = gp[1];
        h0.x += fv[8 * i + 0] * r1 * g0.x; h0.y += fv[8 * i + 1] * r1 * g0.y; h0.z += fv[8 * i + 2] * r1 * g0.z; h0.w += fv[8 * i + 3] * r1 * g0.w;
        h1.x += fv[8 * i + 4] * r1 * g1.x; h1.y += fv[8 * i + 5] * r1 * g1.y; h1.z += fv[8 * i + 6] * r1 * g1.z; h1.w += fv[8 * i + 7] * r1 * g1.w;
        op[0] = h0; op[1] = h1; }
}
struct Args { const float* in[24]; float* out; unsigned char* ws; int ph_lo, ph_hi, q_lo, q_hi, use_bar, pad; };
constexpr int N_PHASES = 12;
__global__ void __launch_bounds__(NWAVES * 64, 2) mk_fwd(Args args) {
    extern __shared__ __attribute__((aligned(16))) unsigned char lds[];
    Frame F;
    F.lds = (LAS unsigned char*)lds;
    F.MISC = (volatile LAS unsigned*)(F.lds + MISC_OFF);
    F.tid = threadIdx.x; F.lane = F.tid & 63; F.wave = __builtin_amdgcn_readfirstlane(F.tid >> 6);
    F.G = gridDim.x; { const int bx = blockIdx.x; F.vcu = (F.G % 8 == 0) ? (bx % 8) * (F.G / 8) + bx / 8 : bx; }
    unsigned char* ws = args.ws;
    F.ctl = (gu32*)(ws + WS_CTL);
    F.x_prompt = args.in[0]; F.x_sample = args.in[1]; F.meta = args.in[2]; F.g_pre_mix = args.in[3]; F.w_in = args.in[4]; F.q_norm = args.in[5]; F.k_norm = args.in[6];
    F.lru_conv_w = args.in[7]; F.lru_conv_b = args.in[8]; F.lru_w_r = args.in[9]; F.lru_b_r = args.in[10]; F.lru_w_i = args.in[11]; F.lru_b_i = args.in[12]; F.lru_lambda = args.in[13];
    F.g_attn_out = args.in[14]; F.g_lru_out = args.in[15]; F.w_out = args.in[16]; F.g_post_mix = args.in[17]; F.g_pre_ffn = args.in[18]; F.w_up = args.in[19];
    F.ffn_conv_w = args.in[20]; F.ffn_conv_b = args.in[21]; F.w_down = args.in[22]; F.g_post_ffn = args.in[23]; F.out = args.out;
    F.ws = ws;
    for (int u = F.tid; u < (LDS_BYTES - LDSCTL_OFF) / 4; u += NWAVES * 64) ((LAS unsigned*)(F.lds + LDSCTL_OFF))[u] = 0u;
    __syncthreads();
    XcdBarrier bar; bar.bar = (unsigned*)(F.ctl + CW_BAR); bar.x = 0; bar.st = nullptr;
    if (args.use_bar) bar = xcd_barrier_post((unsigned*)(F.ctl + CW_BAR), F.MISC + 8);
    const int lo = args.ph_lo, hi = args.ph_hi;
#define IN(k) (((MK_PHASE_MASK >> (k)) & 1) && lo <= (k) && (k) < hi)
#define PH_BAR() do { if (args.use_bar) xcd_barrier(bar); } while (0)
    const int gw = F.vcu * NWAVES + F.wave, NGW = F.G * NWAVES;

    if (IN(0)) { p0_prologue(F); PH_BAR(); }
    if (IN(1)) {
        p1_meta_z(F);
        pg8::Gemm g{F.XN(), F.WIN_T(), NTOK, INW, DM}; pg8::StaticOrder S; S.init(NTOK, INW, F.G, (int)blockIdx.x);
        pg8::EpiRoute E{nullptr, 0, 1, F.Q(), F.K(), F.V(), F.XR(), F.GY()};
        pg8::gemm_phase<pg8::EpiRoute, pg8::StaticOrder, true, true>(F.lds, g, S, E);
        PH_BAR();
    }
    if (IN(2)) { lru_phase<1>(F); PH_BAR(); }
    if (IN(3)) {
        for (int row = gw; row < NTOK; row += NGW) qk_rope_row(F, row, F.lane);
        lru_propagate(F);
        if (F.vcu == F.G - 1) p3_meta_job(F);
        PH_BAR();
    }
    if (IN(4)) {
        lru_phase<2>(F);
        for (int it = F.vcu; it < 512; it += F.G) metaq_item(F, it);
        attn_phase(F, (char*)lds);
        PH_BAR();
    }
    if (IN(5)) {
        for (int row = gw; row < NTOK; row += NGW) p5_mixed_row(F, row, F.lane);
        if (F.vcu == F.G - 1) p5_meta_job(F);
        PH_BAR();
    }
    if (IN(6)) {
        p6_meta_y(F);
        pg8::Gemm g{F.XN(), F.WOUT_T(), NTOK, DM, DM}; pg8::StaticOrder S; S.init(NTOK, DM, F.G, (int)blockIdx.x);
        pg8::EpiRoute E{F.Y1(), DM, 0, nullptr, nullptr, nullptr, nullptr, nullptr};
        pg8::gemm_phase<pg8::EpiRoute, pg8::StaticOrder, true, true>(F.lds, g, S, E);
        PH_BAR();
    }
    if (IN(7)) {
        for (int row = gw; row < NTOK; row += NGW) p7_row(F, row, F.lane);
        p7_meta_g(F);
        PH_BAR();
    }
#if MK_MULTI
    { const int q = args.q_lo;
#else
#pragma unroll
    for (int q = 0; q < 4; ++q) {
#endif
        if (IN(8)) {
            pg8::Gemm g{F.XN() + (size_t)q * QROWS * DM, F.WUP_T(), QROWS, UPW, DM}; pg8::StaticOrder S; S.init(QROWS, UPW, F.G, (int)blockIdx.x);
            pg8::EpiRoute E{F.UP(), UPW, 0, nullptr, nullptr, nullptr, nullptr, nullptr};
            pg8::gemm_phase<pg8::EpiRoute, pg8::StaticOrder, true, true>(F.lds, g, S, E);
            PH_BAR();
        }
        if (IN(9)) { p9_act(F, q); PH_BAR(); }
        if (IN(10)) {
            pg8::Gemm g{F.ACT(), F.WDOWN_T(), QROWS, DM, FFN}; pg8::StaticOrder S; S.init(QROWS, DM, F.G, (int)blockIdx.x);
            pg8::EpiRoute E{F.XN() + (size_t)q * QROWS * DM, DM, 0, nullptr, nullptr, nullptr, nullptr, nullptr};
            pg8::gemm_phase<pg8::EpiRoute, pg8::StaticOrder, true, true>(F.lds, g, S, E);
        }
    }
    if (IN(10) && IN(11)) PH_BAR();
    if (IN(11)) { for (int row = gw; row < NTOK; row += NGW) p11_row(F, row, F.lane); }
#undef IN
#undef PH_BAR
}

extern "C" void kernel_launch(void* const* d_in, const int* in_sizes, int n_in, void* d_out, int out_size, void* d_ws, size_t ws_size, hipStream_t stream) {
    static int grid = 0;
    if (grid == 0) {
        if (n_in != 24 || out_size != NTOK * DM || ws_size < WS_END) { fprintf(stderr, "kernel_launch: unexpected shapes (n_in %d out %d ws %zu, need ws >= %zu); nothing launched\n", n_in, out_size, ws_size, (size_t)WS_END); grid = -1; return; }
        int dev = 0, cus = 0;
        if (hipGetDevice(&dev) != hipSuccess || hipDeviceGetAttribute(&cus, hipDeviceAttributeMultiprocessorCount, dev) != hipSuccess) { grid = -1; return; }
        if (hipFuncSetAttribute((const void*)mk_fwd, hipFuncAttributeMaxDynamicSharedMemorySize, LDS_BYTES) != hipSuccess) { fprintf(stderr, "kernel_launch: hipFuncSetAttribute failed\n"); grid = -1; return; }
        int per_cu = 0;
        if (hipOccupancyMaxActiveBlocksPerMultiprocessor(&per_cu, (const void*)mk_fwd, NWAVES * 64, LDS_BYTES) != hipSuccess || per_cu < 1) fprintf(stderr, "kernel_launch: occupancy query reports %d\n", per_cu);
        (void)hipGetLastError();
        grid = cus;
    }
    if (grid < 0) return;
    if (hipMemsetAsync((char*)d_ws + WS_CTL, 0, CTL_ZERO_BYTES, stream) != hipSuccess) return;
    Args a{};
    for (int i = 0; i < 24; ++i) a.in[i] = (const float*)d_in[i];
    a.out = (float*)d_out; a.ws = (unsigned char*)d_ws;
#if MK_MULTI
    a.use_bar = 0;
    for (int ph = 0; ph < 8; ++ph) { a.ph_lo = ph; a.ph_hi = ph + 1; a.q_lo = 0; a.q_hi = 0; hipLaunchKernelGGL(mk_fwd, dim3(grid), dim3(NWAVES * 64), LDS_BYTES, stream, a); }
    for (int q = 0; q < 4; ++q) for (int ph = 8; ph < 11; ++ph) { a.ph_lo = ph; a.ph_hi = ph + 1; a.q_lo = q; a.q_hi = q + 1; hipLaunchKernelGGL(mk_fwd, dim3(grid), dim3(NWAVES * 64), LDS_BYTES, stream, a); }
    a.ph_lo = 11; a.ph_hi = 12; a.q_lo = 0; a.q_hi = 0; hipLaunchKernelGGL(mk_fwd, dim3(grid), dim3(NWAVES * 64), LDS_BYTES, stream, a);
#else
    a.use_bar = 1; a.ph_lo = 0; a.ph_hi = N_PHASES; a.q_lo = 0; a.q_hi = 4;
    hipLaunchKernelGGL(mk_fwd, dim3(grid), dim3(NWAVES * 64), LDS_BYTES, stream, a);
#endif
    const hipError_t le = hipPeekAtLastError();
    if (le != hipSuccess) fprintf(stderr, "kernel_launch: launch failed: %s\n", hipGetErrorName(le));
}
```

```cpp
#include <hip/hip_runtime.h>
#include <cstdio>
#include <cstdint>
#include <cmath>
#ifndef MK_PHASE_MASK
#define MK_PHASE_MASK 0xfff
#endif
#ifndef MK_REPEAT_MASK
#define MK_REPEAT_MASK 0
#endif
#ifndef MK_MULTI
#define MK_MULTI 0
#endif
namespace pg8 {
#define PG8_LAS __attribute__((address_space(3)))
typedef unsigned short bf16_t;
typedef short bf16x8 __attribute__((ext_vector_type(8)));
typedef float f32x4 __attribute__((ext_vector_type(4)));
typedef unsigned u32x4 __attribute__((ext_vector_type(4)));
constexpr int BM = 256, BK = 64, HALF = 128, HTB = HALF * BK * 2  , STAGE_BYTES = 8 * HTB, NXCD = 8, WGM = 8;

__host__ __device__ __forceinline__ int lds_byte(int r, int c) { const int st = (r >> 4) * 2 + (c >> 5), rr = r & 15, cc = c & 31, ob = rr * 64 + cc * 2; return st * 1024 + (ob ^ (((ob >> 9) & 1) << 5)); }
__host__ __device__ __forceinline__ void stage_rc(int b, int& R, int& C) { const int st = b / 1024, sb = b % 1024, swz = sb ^ (((sb >> 9) & 1) << 5); R = (st >> 1) * 16 + swz / 64; C = (st & 1) * 32 + (swz % 64) / 2; }
__host__ __device__ __forceinline__ int perm32(int rho) { const int n = rho >> 4, i = rho & 15; return 8 * (i >> 2) + 4 * n + (i & 3); }

struct Unit { int pm, pn; };
struct Gemm { const bf16_t* A; const bf16_t* Bt; int M, N, K; };

struct StaticOrder {
    int nM, nN, nwg, G, c;
    __host__ __device__ void init(int M, int N, int G_, int c_) { nM = M / BM; nN = N / BM; nwg = nM * nN; G = G_; c = c_; }
    __host__ __device__ bool next(int i, Unit& u) const {
        const long L = (long)i * G + c; if (L >= nwg) return false;
        int wgid = (int)L; { const int q = nwg / NXCD, r = nwg % NXCD, xcd = wgid % NXCD, off = wgid / NXCD; wgid = (xcd < r ? xcd * (q + 1) : r * (q + 1) + (xcd - r) * q) + off; }
        const int nig = WGM * nN, gid = wgid / nig, fm = gid * WGM, gsz = (nM - fm) < WGM ? (nM - fm) : WGM;
        u.pm = fm + ((wgid % nig) % gsz); u.pn = (wgid % nig) / gsz; return true;
    }
    __device__ __forceinline__ void a_ready(const Unit&) const {}
    __device__ __forceinline__ void done(const Unit&) const {}
};

__device__ __forceinline__ unsigned cvt_pk_bf16(float lo, float hi) { unsigned r; asm volatile("v_cvt_pk_bf16_f32 %0, %1, %2" : "=v"(r) : "v"(lo), "v"(hi)); return r; }
struct EpiRoute {
    static constexpr bool PERM = true, AFTER_DRAIN = false;
    bf16_t* O; int ldc; int mode; bf16_t *Qp, *Kp, *Vp, *XRp, *GYp;
    __device__ __forceinline__ void operator()(const f32x4 (&acc)[2][2][4][2], const Unit& u, int wr, int wc, int fr, int fq) const {
        bf16_t* base = O; int ld = ldc; int colt = u.pn * BM; int rowadd = 0;
        if (mode == 1) {
            const int pn = u.pn;
            if (pn < 4) { base = Qp; ld = 1024; colt = pn * 256; }
            else if (pn == 4) { base = Kp; ld = 256; colt = 0; }
            else if (pn == 5) { base = Vp; ld = 256; colt = 0; }
            else if (pn < 10) { base = XRp; ld = 1024; colt = (pn - 6) * 256; const int seq = u.pm < 128 ? (u.pm >> 4) : 8 + ((u.pm - 128) >> 5); rowadd = 64 * (seq + 1); }
            else { base = GYp; ld = 1024; colt = (pn - 10) * 256; }
        }
        const int row0 = u.pm * BM + wr * 64 + fr + rowadd; const int col0 = colt + wc * 32 + 8 * fq;
#pragma unroll
        for (int ai = 0; ai < 2; ++ai)
#pragma unroll
            for (int m = 0; m < 4; ++m) { bf16_t* rowp = base + (size_t)(row0 + ai * HALF + m * 16) * ld + col0;
#pragma unroll
                for (int bj = 0; bj < 2; ++bj) { const f32x4 v0 = acc[ai][bj][m][0], v1 = acc[ai][bj][m][1];
                    u32x4 w; w.x = cvt_pk_bf16(v0[0], v0[1]); w.y = cvt_pk_bf16(v0[2], v0[3]); w.z = cvt_pk_bf16(v1[0], v1[1]); w.w = cvt_pk_bf16(v1[2], v1[3]);
                    *(u32x4*)(rowp + bj * HALF) = w; } }
    }
};

template <class Epi, class Sched, bool ALIGN_EPI = false, bool SP2 = false>
__device__ __forceinline__ void gemm_phase(PG8_LAS unsigned char* lds, const Gemm g, const Sched& S, const Epi& E) {
    const int tid = threadIdx.x, wid = __builtin_amdgcn_readfirstlane(tid >> 6), lane = tid & 63, wr = wid >> 2, wc = wid & 3, fr = lane & 15, fq = lane >> 4;
    const int K = g.K, nt = K / BK;
    unsigned voffA[2], voffB[2];
#pragma unroll
    for (int i = 0; i < 2; ++i) { int R, C; stage_rc(tid * 16 + i * 8192, R, C); const int Rb = Epi::PERM ? ((R & ~31) + perm32(R & 31)) : R;
        voffA[i] = (unsigned)(R * K + C) * 2u; voffB[i] = (unsigned)(Rb * K + C) * 2u; }
    const size_t kstep = (size_t)(BK * 2);
    const size_t hstep = (size_t)HALF * K * 2;
    const size_t tstep = 2 * hstep;
    const unsigned ldsw = (unsigned)wid * 1024u;
    const int aoff = lds_byte(wr * 64 + fr, fq * 8), boff = lds_byte(wc * 32 + fr, fq * 8);
#define PG8_SA(b, h) (((b) * 2 + (h)) * HTB)
#define PG8_SB(b, h) ((4 + (b) * 2 + (h)) * HTB)
#define PG8_STAGE(bufoff, gbase, voff) do { _Pragma("unroll") for (int _i = 0; _i < 2; ++_i) \
        __builtin_amdgcn_global_load_lds((const unsigned*)((const char*)(gbase) + (voff)[_i]), (PG8_LAS unsigned*)(lds + (bufoff) + ldsw + _i * 8192), 16, 0, 0); } while (0)
#define PG8_LDA(dst, b, h) do { _Pragma("unroll") for (int m = 0; m < 4; ++m) _Pragma("unroll") for (int k = 0; k < 2; ++k) dst[m][k] = *(const PG8_LAS bf16x8*)(lds + PG8_SA(b, h) + aoff + m * 2048 + k * 1024); } while (0)
#define PG8_LDB(dst, b, h) do { _Pragma("unroll") for (int n = 0; n < 2; ++n) _Pragma("unroll") for (int k = 0; k < 2; ++k) dst[n][k] = *(const PG8_LAS bf16x8*)(lds + PG8_SB(b, h) + boff + n * 2048 + k * 1024); } while (0)
#define PG8_MMA(ai, bj, At, Bt) do { __builtin_amdgcn_s_setprio(1); _Pragma("unroll") for (int m = 0; m < 4; ++m) _Pragma("unroll") for (int n = 0; n < 2; ++n) _Pragma("unroll") for (int k = 0; k < 2; ++k) \
        acc[ai][bj][m][n] = __builtin_amdgcn_mfma_f32_16x16x32_bf16(Bt[n][k], At[m][k], acc[ai][bj][m][n], 0, 0, 0); __builtin_amdgcn_s_setprio(0); } while (0)
#define PG8_WAIT_V(n) asm volatile("s_waitcnt vmcnt(" #n ")" ::: "memory")
#define PG8_WAIT_L(n) asm volatile("s_waitcnt lgkmcnt(" #n ")" ::: "memory")
#define PG8_BAR __builtin_amdgcn_s_barrier()
#define PG8_SCHED __builtin_amdgcn_sched_barrier(0)
    Unit cur, nxt; int ui = 0;
    if (!S.next(0, cur)) return;
    f32x4 acc[2][2][4][2];
#pragma unroll
    for (int a = 0; a < 2; ++a)
#pragma unroll
        for (int b = 0; b < 2; ++b)
#pragma unroll
            for (int m = 0; m < 4; ++m)
#pragma unroll
                for (int n = 0; n < 2; ++n) acc[a][b][m][n] = (f32x4){0.f, 0.f, 0.f, 0.f};
    bf16x8 At[4][2], B0[2][2], B1[2][2];
    const char* cA = (const char*)g.A + (size_t)cur.pm * tstep; const char* cB = (const char*)g.Bt + (size_t)cur.pn * tstep;
    S.a_ready(cur);
    if constexpr (SP2) {
        PG8_STAGE(PG8_SB(0, 0), cB, voffB); PG8_STAGE(PG8_SB(0, 1), cB + hstep, voffB); PG8_STAGE(PG8_SA(0, 0), cA, voffA); PG8_STAGE(PG8_SA(0, 1), cA + hstep, voffA);
        if (wr == 1) PG8_BAR;
        PG8_WAIT_V(2); PG8_BAR;
        PG8_STAGE(PG8_SB(1, 0), cB + kstep, voffB); PG8_STAGE(PG8_SA(1, 0), cA + kstep, voffA); PG8_STAGE(PG8_SB(1, 1), cB + hstep + kstep, voffB);
        PG8_WAIT_V(6); PG8_BAR;
    } else {
        PG8_STAGE(PG8_SB(0, 0), cB, voffB); PG8_STAGE(PG8_SA(0, 0), cA, voffA); PG8_STAGE(PG8_SB(0, 1), cB + hstep, voffB); PG8_STAGE(PG8_SA(0, 1), cA + hstep, voffA);
        if (wr == 1) PG8_BAR;
        PG8_WAIT_V(4); PG8_BAR;
        PG8_STAGE(PG8_SB(1, 0), cB + kstep, voffB); PG8_STAGE(PG8_SA(1, 0), cA + kstep, voffA); PG8_STAGE(PG8_SB(1, 1), cB + hstep + kstep, voffB);
        PG8_WAIT_V(6); PG8_BAR;
    }
    for (;;) {
        const bool has_next = S.next(ui + 1, nxt);
        const char* nA = has_next ? (const char*)g.A + (size_t)nxt.pm * tstep : cA; const char* nB = has_next ? (const char*)g.Bt + (size_t)nxt.pn * tstep : cB;
        for (int t = 0; t < nt; t += 2) {
            const bool last = (t == nt - 2);
            const char* a1 = cA + (size_t)(t + 1) * kstep;
            const char* a2 = last ? nA : cA + (size_t)(t + 2) * kstep; const char* b2 = last ? nB : cB + (size_t)(t + 2) * kstep;
            const char* a3 = a2 + kstep; const char* b3 = b2 + kstep;
            if (last && has_next) S.a_ready(nxt);
            if constexpr (SP2) {
            PG8_LDB(B0, 0, 0); PG8_LDB(B1, 0, 1); PG8_SCHED; PG8_LDA(At, 0, 0); PG8_STAGE(PG8_SA(1, 1), a1 + hstep, voffA);
            PG8_WAIT_V(8); PG8_WAIT_L(0); PG8_BAR; PG8_MMA(0, 0, At, B0); PG8_MMA(0, 1, At, B1); PG8_BAR; PG8_SCHED;
            PG8_LDA(At, 0, 1); PG8_STAGE(PG8_SB(0, 0), b2, voffB); PG8_STAGE(PG8_SB(0, 1), b2 + hstep, voffB); PG8_STAGE(PG8_SA(0, 0), a2, voffA);
            PG8_WAIT_V(8); PG8_WAIT_L(0); PG8_BAR; PG8_MMA(1, 0, At, B0); PG8_MMA(1, 1, At, B1); PG8_BAR; PG8_SCHED;
            PG8_LDB(B0, 1, 0); PG8_LDB(B1, 1, 1); PG8_SCHED; PG8_LDA(At, 1, 0); PG8_STAGE(PG8_SA(0, 1), a2 + hstep, voffA);
            PG8_WAIT_V(8); PG8_WAIT_L(0); PG8_BAR; PG8_MMA(0, 0, At, B0); PG8_MMA(0, 1, At, B1); PG8_BAR; PG8_SCHED;
            PG8_LDA(At, 1, 1); PG8_STAGE(PG8_SB(1, 0), b3, voffB); PG8_STAGE(PG8_SB(1, 1), b3 + hstep, voffB); PG8_STAGE(PG8_SA(1, 0), a3, voffA);
            PG8_WAIT_V(8); PG8_WAIT_L(0); PG8_BAR; PG8_MMA(1, 0, At, B0); PG8_MMA(1, 1, At, B1); PG8_BAR; PG8_SCHED;
            } else {
            PG8_LDB(B0, 0, 0); PG8_SCHED; PG8_LDA(At, 0, 0); PG8_STAGE(PG8_SA(1, 1), a1 + hstep, voffA);
            PG8_WAIT_L(8); PG8_BAR; PG8_WAIT_L(0); PG8_MMA(0, 0, At, B0); PG8_BAR; PG8_SCHED;
            PG8_LDB(B1, 0, 1); PG8_STAGE(PG8_SB(0, 0), b2, voffB);
            PG8_BAR; PG8_WAIT_L(0); PG8_MMA(0, 1, At, B1); PG8_BAR;
            PG8_LDA(At, 0, 1); PG8_STAGE(PG8_SA(0, 0), a2, voffA);
            PG8_BAR; PG8_WAIT_L(0); PG8_MMA(1, 0, At, B0); PG8_BAR; PG8_SCHED;
            PG8_STAGE(PG8_SB(0, 1), b2 + hstep, voffB);
            PG8_WAIT_V(6); PG8_BAR; PG8_MMA(1, 1, At, B1); PG8_BAR;
            PG8_LDB(B0, 1, 0); PG8_SCHED; PG8_LDA(At, 1, 0); PG8_STAGE(PG8_SA(0, 1), a2 + hstep, voffA);
            PG8_WAIT_L(8); PG8_BAR; PG8_WAIT_L(0); PG8_MMA(0, 0, At, B0); PG8_BAR; PG8_SCHED;
            PG8_LDB(B1, 1, 1); PG8_STAGE(PG8_SB(1, 0), b3, voffB);
            PG8_BAR; PG8_WAIT_L(0); PG8_MMA(0, 1, At, B1); PG8_BAR;
            PG8_LDA(At, 1, 1); PG8_STAGE(PG8_SA(1, 0), a3, voffA);
            PG8_BAR; PG8_WAIT_L(0); PG8_MMA(1, 0, At, B0); PG8_BAR; PG8_SCHED;
            PG8_STAGE(PG8_SB(1, 1), b3 + hstep, voffB);
            PG8_WAIT_V(6); PG8_BAR; PG8_MMA(1, 1, At, B1); PG8_BAR;
            }
        }
        if constexpr (ALIGN_EPI) { if (wr == 0) PG8_BAR; }
        if constexpr (!Epi::AFTER_DRAIN) { E(acc, cur, wr, wc, fr, fq); S.done(cur); }
        if (!has_next) break;
#pragma unroll
        for (int a = 0; a < 2; ++a)
#pragma unroll
            for (int b = 0; b < 2; ++b)
#pragma unroll
                for (int m = 0; m < 4; ++m)
#pragma unroll
                    for (int n = 0; n < 2; ++n) acc[a][b][m][n] = (f32x4){0.f, 0.f, 0.f, 0.f};
        cur = nxt; cA = nA; cB = nB; ++ui;
        if constexpr (ALIGN_EPI) { if (wr == 1) PG8_BAR; }
    }
    PG8_WAIT_V(0);
    if constexpr (!ALIGN_EPI) { if (wr == 0) PG8_BAR; }
    PG8_BAR;
    if constexpr (Epi::AFTER_DRAIN) { E.fused(acc, cur, wr, wc, fr, fq, lds, wid, lane); S.done(cur); }
#undef PG8_SA
#undef PG8_SB
#undef PG8_STAGE
#undef PG8_LDA
#undef PG8_LDB
#undef PG8_MMA
#undef PG8_WAIT_V
#undef PG8_WAIT_L
#undef PG8_BAR
#undef PG8_SCHED
}
}
namespace attn {
typedef unsigned short bf16r;
constexpr int   D = 128, NW = 8, QBLK = 32, KVBLK = 64;
constexpr float SCALE = 0.088388347648318440f;
constexpr float THR = 8.f;
constexpr int LDQ = 1024, LDK = 256, LDO = 1024;
constexpr size_t SHM_V = KVBLK * D * 2, SHM_K = KVBLK * D * 2, SHM_ATTN = 2 * SHM_V + 2 * SHM_K + NW * 64 * 4;
using bf16x8 = __attribute__((ext_vector_type(8))) short;
using s16x4  = __attribute__((ext_vector_type(4))) short;
using f32x16 = __attribute__((ext_vector_type(16))) float;
using f32x8  = __attribute__((ext_vector_type(8))) float;
using u32x4  = __attribute__((ext_vector_type(4))) unsigned;
#define KSWZ(row, colB) ((row) * 256 + ((colB) ^ (((row) & 7) << 4)))
#define SBAR() __builtin_amdgcn_sched_barrier(0)
__device__ __forceinline__ int crow(int r, int hi) { return (r & 3) + 8 * (r >> 2) + 4 * hi; }
__device__ __forceinline__ unsigned cvtpk(float lo, float hi) {
  unsigned r; asm volatile("v_cvt_pk_bf16_f32 %0, %1, %2" : "=v"(r) : "v"(lo), "v"(hi)); return r;
}
__device__ __forceinline__ void partialSM(f32x16& p0, f32x16& p1, float& m_reg, float& mn, float& alpha) {
  constexpr float C = SCALE * 1.4426950408889634f;
  float pmax = p0[0]; for (int r = 1; r < 16; ++r) pmax = fmaxf(pmax, p0[r]); for (int r = 0; r < 16; ++r) pmax = fmaxf(pmax, p1[r]);
  { auto rr = __builtin_amdgcn_permlane32_swap(__float_as_uint(pmax), __float_as_uint(pmax), false, false);
    pmax = fmaxf(__uint_as_float(rr[0]), __uint_as_float(rr[1])); }
  if (__builtin_expect(__all(pmax - m_reg <= THR / SCALE), 1)) { mn = m_reg; alpha = 1.f; }
  else { mn = fmaxf(m_reg, pmax); alpha = __builtin_amdgcn_exp2f((m_reg - mn) * C); m_reg = mn; }
  float mnC = -mn * C;
  for (int r = 0; r < 16; ++r) p0[r] = fmaf(p0[r], C, mnC); for (int r = 0; r < 16; ++r) p1[r] = fmaf(p1[r], C, mnC);
  for (int r = 0; r < 16; ++r) p0[r] = __builtin_amdgcn_exp2f(p0[r]);
}
__device__ __forceinline__ void finishSM(f32x16& p0, f32x16& p1, float alpha, float& l_reg, bf16x8& pa0, bf16x8& pa1, bf16x8& pa2, bf16x8& pa3) {
  for (int r = 0; r < 16; ++r) p1[r] = __builtin_amdgcn_exp2f(p1[r]);
  float ps = 0; for (int r = 0; r < 16; ++r) ps += p0[r]; for (int r = 0; r < 16; ++r) ps += p1[r];
  { auto rr = __builtin_amdgcn_permlane32_swap(__float_as_uint(ps), __float_as_uint(ps), false, false);
    ps = __uint_as_float(rr[0]) + __uint_as_float(rr[1]); }
  l_reg = l_reg * alpha + ps;
#define PK4(P, BASE, OUT) do { unsigned a0 = cvtpk(P[BASE + 0], P[BASE + 1]), a1 = cvtpk(P[BASE + 2], P[BASE + 3]);   \
    unsigned b0 = cvtpk(P[BASE + 4], P[BASE + 5]), b1 = cvtpk(P[BASE + 6], P[BASE + 7]);                              \
    auto r0 = __builtin_amdgcn_permlane32_swap(a0, b0, false, false); auto r1 = __builtin_amdgcn_permlane32_swap(a1, b1, false, false); \
    u32x4 w = {r0[0], r1[0], r0[1], r1[1]}; OUT = *reinterpret_cast<bf16x8*>(&w); } while (0)
  PK4(p0, 0, pa0); PK4(p0, 8, pa1); PK4(p1, 0, pa2); PK4(p1, 8, pa3);
#undef PK4
}
__device__ __forceinline__ void qkt(f32x16& p0, f32x16& p1, const bf16r* Ks, const bf16x8* qr, int r32, int hi) {
  p0 = f32x16{}; p1 = f32x16{};
  for (int d0 = 0; d0 < 8; ++d0) { int cb = (d0 * 16 + hi * 8) * 2;
    bf16x8 b0 = *reinterpret_cast<const bf16x8*>((const char*)Ks + KSWZ(r32, cb));
    bf16x8 b1 = *reinterpret_cast<const bf16x8*>((const char*)Ks + KSWZ(32 + r32, cb));
    p0 = __builtin_amdgcn_mfma_f32_32x32x16_bf16(b0, qr[d0], p0, 0, 0, 0);
    p1 = __builtin_amdgcn_mfma_f32_32x32x16_bf16(b1, qr[d0], p1, 0, 0, 0); }
}
__device__ __forceinline__ int v_st(int k, int c) { const int kk = (k & ~0xC) | ((k & 4) << 1) | ((k & 8) >> 1); return ((kk >> 3) * 4 + (c >> 5)) * 512 + ((kk & 7) * 32 + (c & 31)) * 2; }
__device__ __forceinline__ int v_rd_base(int lane) { return ((lane & 3) << 3) | (((lane >> 2) & 3) << 6) | (((lane >> 4) & 1) << 5) | (((lane >> 5) & 1) << 8); }
constexpr int v_rd_off(int d0, int ks, int half) { return d0 * 512 + ks * 4096 + half * 2048; }
template <int OFF> __device__ __forceinline__ s16x4 tr_read(int vb) {
  s16x4 r; asm volatile("ds_read_b64_tr_b16 %0, %1 offset:%2" : "=&v"(r) : "v"(vb), "i"(OFF) : "memory"); return r;
}
template <int D0> __device__ __forceinline__ void pv_one(f32x16& od, int vb, bf16x8 pa0, bf16x8 pa1, bf16x8 pa2, bf16x8 pa3) {
  const s16x4 l0 = tr_read<v_rd_off(D0, 0, 0)>(vb), h0 = tr_read<v_rd_off(D0, 0, 1)>(vb), l1 = tr_read<v_rd_off(D0, 1, 0)>(vb), h1 = tr_read<v_rd_off(D0, 1, 1)>(vb);
  const s16x4 l2 = tr_read<v_rd_off(D0, 2, 0)>(vb), h2 = tr_read<v_rd_off(D0, 2, 1)>(vb), l3 = tr_read<v_rd_off(D0, 3, 0)>(vb), h3 = tr_read<v_rd_off(D0, 3, 1)>(vb);
  asm volatile("s_waitcnt lgkmcnt(0)" ::: "memory"); SBAR();
#define PK(L, H) (bf16x8){L[0], L[1], L[2], L[3], H[0], H[1], H[2], H[3]}
  od = __builtin_amdgcn_mfma_f32_32x32x16_bf16(pa0, PK(l0, h0), od, 0, 0, 0);
  od = __builtin_amdgcn_mfma_f32_32x32x16_bf16(pa1, PK(l1, h1), od, 0, 0, 0);
  od = __builtin_amdgcn_mfma_f32_32x32x16_bf16(pa2, PK(l2, h2), od, 0, 0, 0);
  od = __builtin_amdgcn_mfma_f32_32x32x16_bf16(pa3, PK(l3, h3), od, 0, 0, 0);
#undef PK
}
__device__ __forceinline__ void pv_d0(f32x16* o, int vb, bf16x8 pa0, bf16x8 pa1, bf16x8 pa2, bf16x8 pa3) {
  pv_one<0>(o[0], vb, pa0, pa1, pa2, pa3); pv_one<1>(o[1], vb, pa0, pa1, pa2, pa3); pv_one<2>(o[2], vb, pa0, pa1, pa2, pa3); pv_one<3>(o[3], vb, pa0, pa1, pa2, pa3);
}
__device__ __forceinline__ void mask_meta(f32x16& p0, f32x16& p1) {
  const float NEG = -INFINITY;
#pragma unroll
  for (int r = 8; r < 16; ++r) p0[r] = NEG;
#pragma unroll
  for (int r = 0; r < 16; ++r) p1[r] = NEG;
}
__device__ __forceinline__ unsigned short f2bf_rne(float f) { unsigned u = __builtin_bit_cast(unsigned, f); return (unsigned short)((u + 0x7fffu + ((u >> 16) & 1u)) >> 16); }

__device__ __forceinline__ void attn_unit(const bf16r* Qb, const bf16r* __restrict__ Kh, const bf16r* __restrict__ Vh,
                                          const bf16r* __restrict__ KMh, const bf16r* __restrict__ VMh, bf16r* Ob, int NT, char* lds,
                                          const float* __restrict__ qnorm, int t0) {
  int tid_ = threadIdx.x; asm volatile("" : "+v"(tid_));
  const int tid = tid_, wid = tid >> 6, lane = tid & 63, r32 = lane & 31, hi = lane >> 5;
  bf16r* V_lds = (bf16r*)lds; bf16r* K_lds = (bf16r*)(lds + 2 * SHM_V);
  float* ws = (float*)(lds + 2 * SHM_V + 2 * SHM_K) + wid * 64; float* li_l = ws; float* al_l = ws + 32;
  float m_reg = -1e30f, l_reg = 0; f32x16 o[4] = {}; bf16x8 qr[8];
  const bf16r* Qw = Qb + (long)(wid * QBLK + r32) * LDQ + hi * 8;
#pragma unroll
  for (int d0 = 0; d0 < 8; ++d0) qr[d0] = *reinterpret_cast<const bf16x8*>(Qw + d0 * 16);
  {
    float ss = 0.f;
#pragma unroll
    for (int d0 = 0; d0 < 8; ++d0)
#pragma unroll
      for (int j = 0; j < 8; ++j) { const float x = __builtin_bit_cast(float, (unsigned)(unsigned short)qr[d0][j] << 16); ss += x * x; }
    { auto rr = __builtin_amdgcn_permlane32_swap(__float_as_uint(ss), __float_as_uint(ss), false, false); ss = __uint_as_float(rr[0]) + __uint_as_float(rr[1]); }
    const float rs = 1.f / sqrtf(ss * (1.f / 128.f) + 1e-6f);
    int t = t0 + wid * QBLK + r32; int hio = hi; asm volatile("" : "+v"(t), "+v"(hio));
#pragma unroll
    for (int g = 0; g < 4; ++g) {
      const int p = g >> 1, dd = g & 1, fa = 4 * p + dd, fb = fa + 2; const float pos = (float)(p ? (t & 63) : (t >> 6));
      const float4 ga0 = *reinterpret_cast<const float4*>(qnorm + fa * 16 + hi * 8), ga1 = *reinterpret_cast<const float4*>(qnorm + fa * 16 + hi * 8 + 4);
      const float4 gb0 = *reinterpret_cast<const float4*>(qnorm + fb * 16 + hi * 8), gb1 = *reinterpret_cast<const float4*>(qnorm + fb * 16 + hi * 8 + 4);
      const float gaf[8] = {ga0.x, ga0.y, ga0.z, ga0.w, ga1.x, ga1.y, ga1.z, ga1.w}, gbf[8] = {gb0.x, gb0.y, gb0.z, gb0.w, gb1.x, gb1.y, gb1.z, gb1.w};
      float oa[8], ob[8];
#pragma unroll
      for (int j = 0; j < 8; ++j) { const int i = 16 * dd + 8 * hio + j;
        float rev = pos * __builtin_amdgcn_exp2f(-(float)i * (13.287712379549449f / 32.f)) * 0.15915494309189535f; rev -= floorf(rev);
        const float sn = __builtin_amdgcn_sinf(rev), cs = __builtin_amdgcn_cosf(rev);
        const float x1 = __builtin_bit_cast(float, (unsigned)(unsigned short)qr[fa][j] << 16) * rs * gaf[j], x2 = __builtin_bit_cast(float, (unsigned)(unsigned short)qr[fb][j] << 16) * rs * gbf[j];
        oa[j] = x1 * cs - x2 * sn; ob[j] = x2 * cs + x1 * sn; }
      { u32x4 w = {cvtpk(oa[0], oa[1]), cvtpk(oa[2], oa[3]), cvtpk(oa[4], oa[5]), cvtpk(oa[6], oa[7])}; qr[fa] = *reinterpret_cast<bf16x8*>(&w); }
      { u32x4 w = {cvtpk(ob[0], ob[1]), cvtpk(ob[2], ob[3]), cvtpk(ob[4], ob[5]), cvtpk(ob[6], ob[7])}; qr[fb] = *reinterpret_cast<bf16x8*>(&w); }
      SBAR();
    }
  }
  const int sr = tid >> 4, sc = (tid & 15) * 8, vst0 = v_st(sr, sc), vst1 = v_st(32 + sr, sc);
  const int vb0 = (int)(uintptr_t)V_lds + v_rd_base(lane);
  struct { bf16x8 vs0, vs1, ks0, ks1; } sr_[2];
#define LD8(p) (*reinterpret_cast<const bf16x8*>(p))
#define SLOAD(i, t) do { const bool last_ = ((t) == NT - 1); const bf16r* kp_ = last_ ? KMh : Kh + (long)(t) * KVBLK * LDK; const bf16r* vp_ = last_ ? VMh : Vh + (long)(t) * KVBLK * LDK; \
    sr_[i].vs0 = LD8(&vp_[(long)(sr) * LDK + sc]); sr_[i].vs1 = LD8(&vp_[(long)(32 + sr) * LDK + sc]); \
    sr_[i].ks0 = LD8(&kp_[(long)(sr) * LDK + sc]); sr_[i].ks1 = LD8(&kp_[(long)(32 + sr) * LDK + sc]); } while (0)
#define SWRITE(b, i) do { *(bf16x8*)((char*)V_lds + (b) * SHM_V + vst0) = sr_[i].vs0;          \
    *(bf16x8*)((char*)V_lds + (b) * SHM_V + vst1) = sr_[i].vs1; int kc = sc * 2;               \
    *(bf16x8*)((char*)K_lds + (b) * SHM_K + KSWZ(sr, kc)) = sr_[i].ks0;                       \
    *(bf16x8*)((char*)K_lds + (b) * SHM_K + KSWZ(32 + sr, kc)) = sr_[i].ks1; } while (0)
#define SWAIT() asm volatile("s_waitcnt vmcnt(4)" ::: "memory")
#define RESC(a) do { if (__any((a) < 1.f)) { if (hi == 0) al_l[r32] = (a); asm volatile("s_waitcnt lgkmcnt(0)" ::: "memory"); \
    for (int d = 0; d < 4; ++d) for (int r = 0; r < 16; ++r) o[d][r] *= al_l[crow(r, hi)]; } } while (0)
  f32x16 pA0, pA1, pB0, pB1; float mnA, mnB, alA, alB; bf16x8 pa0, pa1, pa2, pa3;
  constexpr int SE = 0, SO = 1;
  SLOAD(SE, 0); asm volatile("s_waitcnt vmcnt(0)" ::: "memory"); SWRITE(0, SE); __syncthreads();
  qkt(pA0, pA1, K_lds, qr, r32, hi); partialSM(pA0, pA1, m_reg, mnA, alA);
  SLOAD(SO, 1); SLOAD(SE, 2);
  SWAIT(); SWRITE(1, SO); __syncthreads();
  for (int j = 1; j + 1 < NT; j += 2) {
    SBAR(); qkt(pB0, pB1, (bf16r*)((char*)K_lds + SHM_K), qr, r32, hi);
    finishSM(pA0, pA1, alA, l_reg, pa0, pa1, pa2, pa3); SBAR();
    if (j + 2 < NT) SLOAD(SO, j + 2); SBAR();
    pv_d0(o, vb0, pa0, pa1, pa2, pa3); partialSM(pB0, pB1, m_reg, mnB, alB);
    __syncthreads(); SWAIT(); SWRITE(0, SE);
    RESC(alB); __syncthreads();
    SBAR(); qkt(pA0, pA1, K_lds, qr, r32, hi);
    if (j + 2 == NT) mask_meta(pA0, pA1);
    finishSM(pB0, pB1, alB, l_reg, pa0, pa1, pa2, pa3); SBAR();
    if (j + 3 < NT) SLOAD(SE, j + 3); SBAR();
    pv_d0(o, vb0 + (int)SHM_V, pa0, pa1, pa2, pa3); partialSM(pA0, pA1, m_reg, mnA, alA);
    __syncthreads(); SWAIT(); if (j + 2 < NT) SWRITE(1, SO);
    RESC(alA); __syncthreads();
  }
  finishSM(pA0, pA1, alA, l_reg, pa0, pa1, pa2, pa3); SBAR();
  pv_d0(o, vb0, pa0, pa1, pa2, pa3);
  if (hi == 0) li_l[r32] = l_reg; asm volatile("s_waitcnt lgkmcnt(0)" ::: "memory");
  float rli[16];
#pragma unroll
  for (int r = 0; r < 16; ++r) rli[r] = __builtin_amdgcn_rcpf(li_l[crow(r, hi)]);
  bf16r* Ow = Ob + (long)(wid * QBLK) * LDO;
#pragma unroll
  for (int r = 0; r < 16; ++r) { const int orow = crow(r, hi);
#pragma unroll
    for (int d0 = 0; d0 < 4; ++d0) Ow[(long)orow * LDO + d0 * 32 + r32] = f2bf_rne(o[d0][r] * rli[r]); }
  __syncthreads();
#undef LD8
#undef SLOAD
#undef SWRITE
#undef SWAIT
#undef RESC
}
#undef KSWZ
#undef SBAR
}

constexpr int NWAVES = 8;
constexpr int DM = 2048, NTOK = 65536, INW = 3584, FFN = 5632, UPW = 2 * FFN;
constexpr float EPS = 1e-6f;
constexpr int XR_ROWS = 8 * 4160 + 4 * 8256;
constexpr int NCHUNK = 8 * 65 + 4 * 129;
constexpr int QROWS = 16384;
__host__ __device__ __forceinline__ int seq_first_row(int s) { return s < 8 ? s * 4096 : 32768 + (s - 8) * 8192; }
__host__ __device__ __forceinline__ int seq_len(int s) { return s < 8 ? 4096 : 8192; }
__host__ __device__ __forceinline__ int xr_base(int s) { return s < 8 ? s * 4160 : 33280 + (s - 8) * 8256; }
__host__ __device__ __forceinline__ int chunk_base(int s) { return s < 8 ? s * 65 : 520 + (s - 8) * 129; }
__host__ __device__ __forceinline__ int row_seq(int row) { return row < 32768 ? (row >> 12) : 8 + ((row - 32768) >> 13); }

constexpr size_t MiB = 1u << 20, KiB = 1u << 10;
constexpr size_t WS_CTL = 0, CTL_ZERO_BYTES = 1 * MiB;
constexpr size_t WS_SMALL = 1 * MiB;
constexpr size_t WS_XNMETA = WS_SMALL + 0, WS_ZM = WS_SMALL + 64 * KiB, WS_KM = WS_SMALL + 320 * KiB, WS_VM = WS_SMALL + 352 * KiB, WS_Q15 = WS_SMALL + 384 * KiB, WS_GY15 = WS_SMALL + 388 * KiB,
                 WS_LO15 = WS_SMALL + 392 * KiB, WS_MIXED15 = WS_SMALL + 448 * KiB, WS_Y15 = WS_SMALL + 544 * KiB, WS_G15 = WS_SMALL + 640 * KiB, WS_MQP = WS_SMALL + 1024 * KiB;
constexpr size_t WS_WIN = 5 * MiB, WS_WOUT = 19 * MiB, WS_WUP = 27 * MiB, WS_WDOWN = 71 * MiB, WS_WG = 93 * MiB;
constexpr size_t WS_CAR = 94 * MiB, WS_CIN = 111 * MiB;
constexpr size_t WS_A = 120 * MiB;
constexpr size_t WS_B = 376 * MiB;
constexpr size_t WS_Q = WS_B, WS_K = WS_B + 128 * MiB, WS_V = WS_B + 160 * MiB, WS_XR = WS_B + 192 * MiB, WS_GY = WS_B + 322 * MiB;
constexpr size_t WS_Y1 = WS_B, WS_UP = WS_B, WS_ACT = WS_B + 352 * MiB;
constexpr size_t WS_END = WS_B + 528 * MiB;
static_assert(WS_ZM + 16 * INW * 4 <= WS_KM && WS_G15 + 12 * FFN * 4 <= WS_MQP && WS_MQP + 512 * 4 * 132 * 4 <= WS_WIN, "small map");
static_assert(WS_WIN + (size_t)INW * DM * 2 <= WS_WOUT && WS_WOUT + (size_t)DM * DM * 2 <= WS_WUP && WS_WUP + (size_t)UPW * DM * 2 <= WS_WDOWN && WS_WDOWN + (size_t)DM * FFN * 2 <= WS_WG && WS_WG + 32 * 16384 * 2 <= WS_CAR, "weights map");
static_assert(WS_CAR + (size_t)NCHUNK * 2 * 1024 * 8 <= WS_CIN && WS_CIN + (size_t)NCHUNK * 2 * 1024 * 4 <= WS_A && WS_A + (size_t)NTOK * DM * 2 <= WS_B, "carry map");
static_assert(WS_XR + (size_t)(XR_ROWS + 64) * 1024 * 2 <= WS_GY && WS_GY + (size_t)NTOK * 1024 * 2 <= WS_END && WS_UP + (size_t)QROWS * UPW * 2 <= WS_ACT && WS_ACT + (size_t)QROWS * FFN * 2 <= WS_END, "B map");
constexpr int CW_BAR = 4096;

constexpr int RING_BYTES = 131072;
constexpr int LDSCTL_OFF = RING_BYTES, MISC_OFF = LDSCTL_OFF + 320;
constexpr int LDS_BYTES = 147456;

#define GAS __attribute__((address_space(1)))
#define LAS __attribute__((address_space(3)))
typedef unsigned short bf16;
typedef unsigned v4u __attribute__((ext_vector_type(4)));
typedef float f32x4 __attribute__((ext_vector_type(4)));
typedef short bf16x8 __attribute__((ext_vector_type(8)));
typedef GAS unsigned gu32;
typedef GAS unsigned long long gu64;
#define RLX_AGENT __ATOMIC_RELAXED, __HIP_MEMORY_SCOPE_AGENT
#define LDS_WAIT() asm volatile("s_waitcnt lgkmcnt(0)" ::: "memory")
#define VM_WAIT() asm volatile("s_waitcnt vmcnt(0)" ::: "memory")
__device__ __forceinline__ unsigned long long rt() { return __builtin_amdgcn_s_memrealtime(); }
__device__ __forceinline__ unsigned f2bf(float f) { unsigned u = __builtin_bit_cast(unsigned, f); return (u + 0x7fffu + ((u >> 16) & 1u)) >> 16; }
__device__ __forceinline__ unsigned pk2(float lo, float hi) { return f2bf(lo) | (f2bf(hi) << 16); }

#define XB_TMO      128
#define XB_XCNT(j)  (256  + 64 * (j))
#define XB_XSUB(j)  (1280 + 64 * (j))
#define XB_XGEN(j)  (2304 + 64 * (j))
#define XB_TOP      3328
#define XB_TOPGEN   3392
#define XCD_BAR_WORDS 3456
#define XB_SPIN_CAP (1u << 18)

__device__ __forceinline__ unsigned xb_ld(unsigned* p)              { return __hip_atomic_load(p, __ATOMIC_RELAXED, __HIP_MEMORY_SCOPE_AGENT); }
__device__ __forceinline__ unsigned xb_add(unsigned* p, unsigned v) { return __hip_atomic_fetch_add(p, v, __ATOMIC_RELAXED, __HIP_MEMORY_SCOPE_AGENT); }
__device__ __forceinline__ unsigned xb_xcc_id() { return (unsigned)__builtin_amdgcn_s_getreg((3 << 11) | 20) & 0xFu; }
#define XB_SPIN(cond, bar) do { unsigned _sp = 0; while (cond) { __builtin_amdgcn_s_sleep(1); \
    if ((++_sp & 255u) == 0u) { if (xb_ld(&(bar)[XB_TMO])) break; if (_sp > XB_SPIN_CAP) { atomicAdd(&(bar)[XB_TMO], 1u); break; } } } } while (0)

struct XcdBarrier {
    unsigned* bar; unsigned x;
    volatile LAS unsigned* st;
};

__device__ __forceinline__ XcdBarrier xcd_barrier_post(unsigned* bar, volatile LAS unsigned* st) {
    XcdBarrier b; b.bar = bar; b.x = xb_xcc_id(); b.st = st;
    if (threadIdx.x == 0) (void)xb_add(&bar[XB_XCNT(b.x)], 1u);
    return b;
}
__device__ __forceinline__ void xcd_barrier_complete(unsigned* bar, unsigned x, unsigned& nloc, unsigned& nx) {
    const unsigned G = gridDim.x * gridDim.y * gridDim.z;
    unsigned sum, cnt, mine, sp = 0u;
    for (;;) {
        sum = 0u; cnt = 0u; mine = 0u;
#pragma unroll
        for (unsigned j = 0; j < 16; ++j) { const unsigned c = xb_ld(&bar[XB_XCNT(j)]); sum += c; cnt += (c > 0u) ? 1u : 0u; mine = (j == x) ? c : mine; }
        if (sum == G) break;
        __builtin_amdgcn_s_sleep(1);
        if ((++sp & 255u) == 0u) { if (xb_ld(&bar[XB_TMO])) break; if (sp > XB_SPIN_CAP) { atomicAdd(&bar[XB_TMO], 1u); break; } }
    }
    nloc = mine > 0u ? mine : 1u; nx = cnt > 0u ? cnt : 1u;
}

__device__ __forceinline__ void xcd_barrier(const XcdBarrier& b) {
    asm volatile("s_waitcnt vmcnt(0)" ::: "memory");
    __syncthreads();
    if (threadIdx.x == 0) {
        unsigned* bar = b.bar;
        __builtin_amdgcn_s_waitcnt(0);
        unsigned nloc = b.st[0], nx = b.st[1];
        if (nloc == 0u) { xcd_barrier_complete(bar, b.x, nloc, nx); b.st[0] = nloc; b.st[1] = nx; }
        const unsigned old = xb_add(&bar[XB_XSUB(b.x)], 1u);
        const unsigned gen = old / nloc;
        if (old + 1u == (gen + 1u) * nloc) {
            __builtin_amdgcn_fence(__ATOMIC_RELEASE, "agent");
            asm volatile("s_waitcnt vmcnt(0)" ::: "memory");
            const unsigned og = xb_add(&bar[XB_TOP], 1u);
            const unsigned tg = og / nx;
            if (og + 1u == (tg + 1u) * nx) xb_add(&bar[XB_TOPGEN], 1u);
            else XB_SPIN(xb_ld(&bar[XB_TOPGEN]) == tg, bar);
            __builtin_amdgcn_fence(__ATOMIC_ACQUIRE, "agent");
            xb_add(&bar[XB_XGEN(b.x)], 1u);
            asm volatile("s_waitcnt vmcnt(0)" ::: "memory");
        } else {
            XB_SPIN(xb_ld(&bar[XB_XGEN(b.x)]) == gen, bar);
            __builtin_amdgcn_fence(__ATOMIC_ACQUIRE, "agent");
            asm volatile("s_waitcnt vmcnt(0)" ::: "memory");
        }
    }
    __syncthreads();
}

__device__ __forceinline__ float bf2f(unsigned short b) { return __builtin_bit_cast(float, (unsigned)b << 16); }
__device__ __forceinline__ float bf2f(short b) { return __builtin_bit_cast(float, (unsigned)(unsigned short)b << 16); }
__device__ __forceinline__ float wave_sum(float v) {
#pragma unroll
    for (int o = 1; o < 64; o <<= 1) v += __shfl_xor(v, o);
    return v;
}
__device__ __forceinline__ float wave_max(float v) {
#pragma unroll
    for (int o = 1; o < 64; o <<= 1) v = fmaxf(v, __shfl_xor(v, o));
    return v;
}
__device__ __forceinline__ float fast_exp(float x) { return __builtin_amdgcn_exp2f(x * 1.4426950408889634f); }
__device__ __forceinline__ float sigmoidf_(float x) { return __builtin_amdgcn_rcpf(1.f + fast_exp(-x)); }
__device__ __forceinline__ float gelu_tanh(float x) {
    const float z = 0.7978845608028654f * (x + 0.044715f * x * x * x);
    return x * sigmoidf_(2.f * z);
}
__device__ __forceinline__ float neg_expm1(float x) {
    const float p = x * (1.f + x * (0.5f + x * (0.16666667f + x * (0.041666668f + x * (0.0083333338f + x * 0.0013888889f)))));
    const float e = fast_exp(x) - 1.f;
    return -(fabsf(x) < 0.25f ? p : e);
}
__device__ __forceinline__ v4u pack8(const float (&v)[8]) { v4u o; o.x = pk2(v[0], v[1]); o.y = pk2(v[2], v[3]); o.z = pk2(v[4], v[5]); o.w = pk2(v[6], v[7]); return o; }

#define FIN(F, idx) ({ const __attribute__((address_space(1))) float* p_; asm("s_load_dwordx2 %0, %1, %2 ; tag %3\n\ts_waitcnt lgkmcnt(0)" : "=s"(p_) : "s"((F).kargs), "i"((idx) * 8), "s"((F).ptag)); (const float*)p_; })
struct Frame {
    LAS unsigned char* lds;
    volatile LAS unsigned* MISC;
    gu32* ctl;
    int tid, lane, wave, vcu, G;
    const __attribute__((address_space(4))) void* kargs; int ptag;
    float* out;
    unsigned char* ws;
#define WSP(T, NAME, OFF) __device__ __forceinline__ T* NAME() const { return (T*)(ws + (OFF)); }
    WSP(bf16, WIN_T, WS_WIN) WSP(bf16, WOUT_T, WS_WOUT) WSP(bf16, WUP_T, WS_WUP) WSP(bf16, WDOWN_T, WS_WDOWN) WSP(bf16, WG, WS_WG) WSP(bf16, XN, WS_A) WSP(bf16, Q, WS_Q) WSP(bf16, K, WS_K) WSP(bf16, V, WS_V)
    WSP(bf16, XR, WS_XR) WSP(bf16, GY, WS_GY) WSP(bf16, Y1, WS_Y1) WSP(bf16, UP, WS_UP) WSP(bf16, ACT, WS_ACT) WSP(bf16, XNMETA, WS_XNMETA) WSP(bf16, KM, WS_KM) WSP(bf16, VM, WS_VM)
    WSP(float, ZM, WS_ZM) WSP(float, Q15, WS_Q15) WSP(float, GY15, WS_GY15) WSP(float, LO15, WS_LO15) WSP(float, MIXED15, WS_MIXED15) WSP(float, Y15, WS_Y15) WSP(float, G15, WS_G15) WSP(float, MQP, WS_MQP)
    WSP(float, CIN, WS_CIN) WSP(float2, CAR, WS_CAR)
#undef WSP
};

__device__ __forceinline__ void p0_transpose_item(const float* W, int K, int N, bf16* WT, int row_off, LAS float* scr, int item, int lane) {
    const int nblk = N / 32, kb = item / nblk, nb = item % nblk, k0 = 64 * kb, n0 = 32 * nb;
#pragma unroll 8
    for (int i = 0; i < 32; ++i) { const int kk = 2 * i + (lane >> 5); scr[kk * 33 + (lane & 31)] = W[(size_t)(k0 + kk) * N + n0 + (lane & 31)]; }
    LDS_WAIT(); asm volatile("" ::: "memory");
    const int c = lane & 7;
#pragma unroll
    for (int j = 0; j < 4; ++j) { const int n = (lane >> 3) + 8 * j; const LAS float* s = scr + (8 * c) * 33 + n;
        v4u o; o.x = pk2(s[0 * 33], s[1 * 33]); o.y = pk2(s[2 * 33], s[3 * 33]); o.z = pk2(s[4 * 33], s[5 * 33]); o.w = pk2(s[6 * 33], s[7 * 33]);
        *(GAS v4u*)(WT + (size_t)(row_off + n0 + n) * K + k0 + 8 * c) = o; }
    LDS_WAIT(); asm volatile("" ::: "memory");
}
__device__ __forceinline__ void rms_row_to_bf16(const float* xrow, const float* g, bf16* orow, int lane) {
    const GAS f32x4* xr = (const GAS f32x4*)xrow + lane;
    f32x4 v[8]; float s = 0.f;
#pragma unroll
    for (int j = 0; j < 8; ++j) { v[j] = xr[64 * j]; s += (v[j].x * v[j].x + v[j].y * v[j].y) + (v[j].z * v[j].z + v[j].w * v[j].w); }
    const float r = 1.f / sqrtf(wave_sum(s) * (1.f / DM) + EPS);
    const GAS f32x4* gr = (const GAS f32x4*)g + lane;
    GAS unsigned long long* o8 = (GAS unsigned long long*)orow + lane;
#pragma unroll
    for (int j = 0; j < 8; ++j) { const f32x4 gg = gr[64 * j];
        o8[64 * j] = (unsigned long long)pk2(v[j].x * r * gg.x, v[j].y * r * gg.y) | ((unsigned long long)pk2(v[j].z * r * gg.z, v[j].w * r * gg.w) << 32); }
}
__device__ __forceinline__ void p0_prologue(Frame& F) {
    LAS float* scr = (LAS float*)(F.lds + F.wave * 16384);
    const int gw = F.vcu * NWAVES + F.wave, NGW = F.G * NWAVES;
    constexpr int I_IN = (DM / 64) * (INW / 32), I_OUT = (DM / 64) * (DM / 32), I_UP = (DM / 64) * (UPW / 32), I_DN = (FFN / 64) * (DM / 32), I_G = 32 * 8;
    constexpr int NITEMS = I_IN + I_OUT + I_UP + I_DN + I_G;
    for (int it = gw; it < NITEMS; it += NGW) {
        int r = it;
        if (r < I_IN) { p0_transpose_item(FIN(F, 4  ), DM, INW, F.WIN_T(), 0, scr, r, F.lane); continue; } r -= I_IN;
        if (r < I_OUT) { p0_transpose_item(FIN(F, 16  ), DM, DM, F.WOUT_T(), 0, scr, r, F.lane); continue; } r -= I_OUT;
        if (r < I_UP) { p0_transpose_item(FIN(F, 19  ), DM, UPW, F.WUP_T(), 0, scr, r, F.lane); continue; } r -= I_UP;
        if (r < I_DN) { p0_transpose_item(FIN(F, 22  ), FFN, DM, F.WDOWN_T(), 0, scr, r, F.lane); continue; } r -= I_DN;
        {
            const int mi = r >> 3, sub = r & 7, gate = mi >> 4, dir = (mi >> 3) & 1, blk = mi & 7;
            const float* W = (gate ? FIN(F, 11  ) : FIN(F, 9  )) + (size_t)(dir * 8 + blk) * 16384;
            bf16* WT = F.WG() + (size_t)((dir * 2 + gate) * 8 + blk) * 16384;
            p0_transpose_item(W, 128, 128, WT, 0, scr, sub, F.lane);
        }
    }
    for (int m = gw; m < NTOK; m += NGW) {
        const float* xr = m < 32768 ? FIN(F, 0  ) + (size_t)m * DM : FIN(F, 1  ) + (size_t)(m - 32768) * DM;
        rms_row_to_bf16(xr, FIN(F, 3  ), F.XN() + (size_t)m * DM, F.lane);
    }
    for (int m = gw; m < 16; m += NGW) rms_row_to_bf16(FIN(F, 2  ) + (size_t)m * DM, FIN(F, 3  ), F.XNMETA() + (size_t)m * DM, F.lane);
    const int gt = F.vcu * 512 + F.tid, NGT = F.G * 512; const v4u z4 = {0u, 0u, 0u, 0u};
    for (int i = gt; i < 12 * 48 * 128; i += NGT) { const int s = i / (48 * 128), rem = i % (48 * 128); ((GAS v4u*)(F.XR() + (size_t)xr_base(s) * 1024))[rem] = z4; }
    for (int i = gt; i < 64 * 128; i += NGT) ((GAS v4u*)(F.XR() + (size_t)XR_ROWS * 1024))[i] = z4;
    for (int i = gt; i < 2048; i += NGT) { ((GAS v4u*)F.KM())[i] = z4; ((GAS v4u*)F.VM())[i] = z4; }
}

template <int R, class Out>
__device__ __forceinline__ void small_gemm(const LAS float* X, int K, const bf16* Wt, int N, int gw, int NGW, int lane, const Out& out) {
    for (int n = gw; n < N; n += NGW) {
        float acc[R];
#pragma unroll
        for (int r = 0; r < R; ++r) acc[r] = 0.f;
        const GAS bf16x8* wrow = (const GAS bf16x8*)(Wt + (size_t)n * K);
        for (int k8 = lane; k8 < K / 8; k8 += 64) {
            const bf16x8 w = wrow[k8]; float wf[8];
#pragma unroll
            for (int j = 0; j < 8; ++j) wf[j] = bf2f(w[j]);
#pragma unroll
            for (int r = 0; r < R; ++r) { const LAS f32x4* xp = (const LAS f32x4*)(X + r * K + k8 * 8); const f32x4 a = xp[0], b = xp[1];
                acc[r] += (a.x * wf[0] + a.y * wf[1]) + (a.z * wf[2] + a.w * wf[3]) + (b.x * wf[4] + b.y * wf[5]) + (b.z * wf[6] + b.w * wf[7]); }
        }
        float v = 0.f;
#pragma unroll
        for (int r = 0; r < R; ++r) { const float s = wave_sum(acc[r]); v = (lane == r) ? s : v; }
        out(n, lane, v);
    }
}
struct OutMetaZ { float* ZM; bf16* XR;
    __device__ __forceinline__ void operator()(int n, int lane, float v) const {
        if (lane < 16) { ZM[lane * INW + n] = v;
            if (n >= 1536 && n < 2560) { const unsigned short b = (unsigned short)f2bf(v); const int c = n - 1536;
                for (int s = 0; s < 12; ++s) XR[(size_t)(xr_base(s) + 48 + lane) * 1024 + c] = b; } }
    } };
struct OutRows { float* Y; int ld; int R;
    __device__ __forceinline__ void operator()(int n, int lane, float v) const { if (lane < R) Y[(size_t)lane * ld + n] = v; } };

__device__ __forceinline__ void p1_meta_z(Frame& F) {
    LAS float* X = (LAS float*)F.lds;
    for (int i = F.tid; i < 16 * DM / 8; i += 512) { const bf16x8 v = ((const GAS bf16x8*)F.XNMETA())[i];
        ((LAS f32x4*)X)[2 * i] = (f32x4){bf2f(v[0]), bf2f(v[1]), bf2f(v[2]), bf2f(v[3])}; ((LAS f32x4*)X)[2 * i + 1] = (f32x4){bf2f(v[4]), bf2f(v[5]), bf2f(v[6]), bf2f(v[7])}; }
    __syncthreads();
    const OutMetaZ o{F.ZM(), F.XR()};
    small_gemm<16, OutMetaZ>(X, DM, F.WIN_T(), INW, F.vcu * NWAVES + F.wave, F.G * NWAVES, F.lane, o);
    __syncthreads();
}
typedef float f32x16 __attribute__((ext_vector_type(16)));
constexpr int LRU_XC0 = 0, LRU_XC_BUF = 17408, LRU_XC_STRIDE = 272;
constexpr int LRU_CW = 34816;
constexpr int LRU_HF = 37376, LRU_HB = LRU_HF + 32768;
__device__ __forceinline__ int crow16(int r, int hi) { return (r & 3) + 8 * (r >> 2) + 4 * hi; }

template <int DIR>
__device__ __forceinline__ void scan_tile(const float (&a)[16], const float (&u)[16], float& carry, float& ptot, float (&h)[16], bool up) {
    float HL[16], PL[16], As[4], Hs[4];
#pragma unroll
    for (int j = 0; j < 4; ++j) {
        float hl = 0.f, p = 1.f;
#pragma unroll
        for (int ii = 0; ii < 4; ++ii) { const int idx = 4 * j + (DIR == 0 ? ii : 3 - ii); hl = a[idx] * hl + u[idx]; p *= a[idx]; HL[idx] = hl; PL[idx] = p; }
        As[j] = p; Hs[j] = hl;
    }
    float Alo[4], Ahi[4], Hlo[4], Hhi[4];
#pragma unroll
    for (int j = 0; j < 4; ++j) {
        { const unsigned x = __float_as_uint(As[j]); auto rr = __builtin_amdgcn_permlane32_swap(x, x, false, false); Alo[j] = __uint_as_float(rr[0]); Ahi[j] = __uint_as_float(rr[1]); }
        { const unsigned x = __float_as_uint(Hs[j]); auto rr = __builtin_amdgcn_permlane32_swap(x, x, false, false); Hlo[j] = __uint_as_float(rr[0]); Hhi[j] = __uint_as_float(rr[1]); }
    }
    float cin[4]; float c = carry;
    if (DIR == 0) {
#pragma unroll
        for (int j = 0; j < 4; ++j) { const float c_lo = c; c = Alo[j] * c + Hlo[j]; const float c_hi = c; c = Ahi[j] * c + Hhi[j]; cin[j] = up ? c_hi : c_lo; }
    } else {
#pragma unroll
        for (int j = 3; j >= 0; --j) { const float c_hi = c; c = Ahi[j] * c + Hhi[j]; const float c_lo = c; c = Alo[j] * c + Hlo[j]; cin[j] = up ? c_hi : c_lo; }
    }
    carry = c;
#pragma unroll
    for (int j = 0; j < 4; ++j) ptot *= Alo[j] * Ahi[j];
#pragma unroll
    for (int idx = 0; idx < 16; ++idx) h[idx] = HL[idx] + PL[idx] * cin[idx >> 2];
}

__device__ __forceinline__ void lru_decode(int cg, int& seq, int& c) { if (cg < 520) { seq = cg / 65; c = cg - seq * 65; } else { const int c2 = cg - 520; seq = c2 / 129; c = c2 - seq * 129; seq += 8; } }
template <int PASS>
__device__ __forceinline__ void lru_phase(Frame& F, bf16* gout) {
    LAS unsigned char* L = F.lds;
    const int tid = F.tid, lane = F.lane, wave = F.wave;
    const int n = F.vcu & 7, ngrp = F.G >> 3;
    { const float* cw = FIN(F, 7  ); const float* cb = FIN(F, 8  );
      for (int i = tid; i < 640; i += 512) { const int k = i >> 7, ch = i & 127; ((LAS float*)(L + LRU_CW))[i] = k < 4 ? cw[k * 1024 + n * 128 + ch] : cb[n * 128 + ch]; } }
    const int d = wave >> 2, g4 = wave & 3, r32 = lane & 31, hi = lane >> 5, chl = g4 * 32 + r32, chg = n * 128 + chl;
    bf16x8 br[8], bi[8];
    { const bf16* wr_ = F.WG() + (size_t)((d * 2 + 0) * 8 + n) * 16384 + chl * 128 + hi * 8;
      const bf16* wi_ = F.WG() + (size_t)((d * 2 + 1) * 8 + n) * 16384 + chl * 128 + hi * 8;
#pragma unroll
      for (int ks = 0; ks < 8; ++ks) { br[ks] = *(const GAS bf16x8*)(wr_ + ks * 16); bi[ks] = *(const GAS bf16x8*)(wi_ + ks * 16); } }
    constexpr float L2E = 1.4426950408889634f;
    const float nb_r = -L2E * FIN(F, 10  )[d * 1024 + chg], nb_i = -L2E * FIN(F, 12  )[d * 1024 + chg];
    const float spl = 8.f * L2E * log1pf(expf(-FIN(F, 13  )[d * 1024 + chg]));
    const int tau0 = tid >> 4, co = (tid & 15) * 8;
    bf16x8 xv[2][4];
#define LRU_PREFETCH(cgx) do { int s_, c_; lru_decode((cgx), s_, c_); const int xb_ = xr_base(s_); \
        _Pragma("unroll") for (int it_ = 0; it_ < 2; ++it_) _Pragma("unroll") for (int k_ = 0; k_ < 4; ++k_) { int row_ = xb_ + c_ * 64 + tau0 + 32 * it_ + k_ - 2; row_ = row_ < 0 ? 0 : row_; \
            xv[it_][k_] = *(const GAS bf16x8*)(F.XR() + (size_t)row_ * 1024 + n * 128 + co); } } while (0)
    int cg = F.vcu >> 3;
    if (cg < NCHUNK) LRU_PREFETCH(cg);
    __syncthreads();
    for (int ui = 0; cg < NCHUNK; cg += ngrp, ++ui) {
        int seq, c; lru_decode(cg, seq, c);
        LAS unsigned char* XC = L + LRU_XC0 + (ui & 1) * LRU_XC_BUF;
        float carry = 0.f, ptot = 1.f;
        if (PASS == 2) carry = F.CIN()[((size_t)cg * 2 + d) * 1024 + chg];
#pragma unroll
        for (int it = 0; it < 2; ++it) {
            const int tau = tau0 + 32 * it; float xc[8];
            { const LAS f32x4* cb = (const LAS f32x4*)(L + LRU_CW + (4 * 128 + co) * 4); const f32x4 b0 = cb[0], b1 = cb[1];
              xc[0] = b0.x; xc[1] = b0.y; xc[2] = b0.z; xc[3] = b0.w; xc[4] = b1.x; xc[5] = b1.y; xc[6] = b1.z; xc[7] = b1.w; }
#pragma unroll
            for (int k = 0; k < 4; ++k) { const LAS f32x4* wp = (const LAS f32x4*)(L + LRU_CW + (k * 128 + co) * 4); const f32x4 w0 = wp[0], w1 = wp[1]; const bf16x8 v = xv[it][k];
                xc[0] += w0.x * bf2f(v[0]); xc[1] += w0.y * bf2f(v[1]); xc[2] += w0.z * bf2f(v[2]); xc[3] += w0.w * bf2f(v[3]);
                xc[4] += w1.x * bf2f(v[4]); xc[5] += w1.y * bf2f(v[5]); xc[6] += w1.z * bf2f(v[6]); xc[7] += w1.w * bf2f(v[7]); }
            if (c == 0 && tau < 48) {
#pragma unroll
                for (int j = 0; j < 8; ++j) xc[j] = 0.f;
            }
            *(LAS v4u*)(XC + tau * LRU_XC_STRIDE + co * 2) = pack8(xc);
        }
        bf16x8 gv[2];
        const int row0 = seq_first_row(seq) + 64 * (c - 1);
        if (PASS == 2) { if (c > 0) {
#pragma unroll
            for (int it = 0; it < 2; ++it) gv[it] = *(const GAS bf16x8*)(F.GY() + (size_t)(row0 + tau0 + 32 * it) * 1024 + n * 128 + co); } }
        __syncthreads();
        if (cg + ngrp < NCHUNK) LRU_PREFETCH(cg + ngrp);
#pragma unroll
        for (int tt = 0; tt < 2; ++tt) {
            const int tile = d ? 1 - tt : tt;
            f32x16 ar = {}, ai = {};
#pragma unroll
            for (int ks = 0; ks < 8; ++ks) {
                const bf16x8 a = *(const LAS bf16x8*)(XC + (tile * 32 + r32) * LRU_XC_STRIDE + (ks * 16 + hi * 8) * 2);
                ar = __builtin_amdgcn_mfma_f32_32x32x16_bf16(a, br[ks], ar, 0, 0, 0);
                ai = __builtin_amdgcn_mfma_f32_32x32x16_bf16(a, bi[ks], ai, 0, 0, 0);
            }
            float av[16], uv[16], hv[16];
#pragma unroll
            for (int r = 0; r < 16; ++r) {
                const int tau = tile * 32 + crow16(r, hi);
                const float xcv = bf2f(*(const LAS unsigned short*)(XC + tau * LRU_XC_STRIDE + chl * 2));
                const float rg = __builtin_amdgcn_rcpf(1.f + __builtin_amdgcn_exp2f(fmaf(ar[r], -L2E, nb_r)));
                const float ig = __builtin_amdgcn_rcpf(1.f + __builtin_amdgcn_exp2f(fmaf(ai[r], -L2E, nb_i)));
                const float a = __builtin_amdgcn_exp2f(-spl * rg);
                av[r] = a;
                uv[r] = __builtin_amdgcn_sqrtf(fmaf(-a, a, 1.f)) * (ig * xcv);
            }
            if (d == 0) scan_tile<0>(av, uv, carry, ptot, hv, hi != 0); else scan_tile<1>(av, uv, carry, ptot, hv, hi != 0);
            if (PASS == 2) {
#pragma unroll
                for (int r = 0; r < 16; ++r) { const int tau = tile * 32 + crow16(r, hi); *(LAS float*)(L + (d ? LRU_HB : LRU_HF) + (tau * 128 + chl) * 4) = hv[r]; }
            }
        }
        if (PASS == 1) { if (hi == 0) F.CAR()[((size_t)cg * 2 + d) * 1024 + chg] = make_float2(ptot, carry); }
        if (PASS == 2) {
            __syncthreads();
            if (c > 0) {
#pragma unroll
                for (int it = 0; it < 2; ++it) {
                    const int tau = tau0 + 32 * it; const bf16x8 g8 = gv[it];
                    const LAS f32x4* hf = (const LAS f32x4*)(L + LRU_HF + (tau * 128 + co) * 4); const LAS f32x4* hb = (const LAS f32x4*)(L + LRU_HB + (tau * 128 + co) * 4);
                    const f32x4 f0 = hf[0], f1 = hf[1], b0 = hb[0], b1 = hb[1];
                    float o[8];
                    o[0] = (f0.x + b0.x) * gelu_tanh(bf2f(g8[0])); o[1] = (f0.y + b0.y) * gelu_tanh(bf2f(g8[1])); o[2] = (f0.z + b0.z) * gelu_tanh(bf2f(g8[2])); o[3] = (f0.w + b0.w) * gelu_tanh(bf2f(g8[3]));
                    o[4] = (f1.x + b1.x) * gelu_tanh(bf2f(g8[4])); o[5] = (f1.y + b1.y) * gelu_tanh(bf2f(g8[5])); o[6] = (f1.z + b1.z) * gelu_tanh(bf2f(g8[6])); o[7] = (f1.w + b1.w) * gelu_tanh(bf2f(g8[7]));
                    *(GAS v4u*)(gout + (size_t)(row0 + tau) * 1024 + n * 128 + co) = pack8(o);
                }
            } else if (tid < 128) {
                const float hf = *(const LAS float*)(L + LRU_HF + (63 * 128 + tid) * 4), hb = *(const LAS float*)(L + LRU_HB + (63 * 128 + tid) * 4);
                F.LO15()[seq * 1024 + n * 128 + tid] = (hf + hb) * gelu_tanh(F.GY15()[n * 128 + tid]);
            }
        }
    }
    __syncthreads();
#undef LRU_PREFETCH
}
__device__ __forceinline__ void lru_propagate(Frame& F) {
    const int gid = F.vcu * 512 + F.tid;
    if (gid < 12 * 2048) {
        const int s = gid >> 11, d = (gid >> 10) & 1, ch = gid & 1023; const int nch = s < 8 ? 65 : 129, cb = chunk_base(s);
        float cin = 0.f;
        if (d == 0) {
#pragma unroll 8
            for (int c = 0; c < nch; ++c) { const size_t idx = ((size_t)(cb + c) * 2 + 0) * 1024 + ch; F.CIN()[idx] = cin; const float2 ph = F.CAR()[idx]; cin = ph.x * cin + ph.y; }
        } else {
#pragma unroll 8
            for (int c = nch - 1; c >= 0; --c) { const size_t idx = ((size_t)(cb + c) * 2 + 1) * 1024 + ch; F.CIN()[idx] = cin; const float2 ph = F.CAR()[idx]; cin = ph.x * cin + ph.y; }
        }
    }
}

__device__ __forceinline__ void k_rope_pass(Frame& F, bf16* Kout) {
    const int gw = F.vcu * NWAVES + F.wave, NGW = F.G * NWAVES, sub = F.lane >> 4, l16 = F.lane & 15;
    const int c0 = 8 * l16, p = l16 >> 3, half = (l16 >> 2) & 1, i0 = 8 * (l16 & 3);
    float inv[8], gk[8];
#pragma unroll
    for (int j = 0; j < 8; ++j) { inv[j] = __builtin_amdgcn_exp2f(-(float)(i0 + j) * (13.287712379549449f / 32.f)) * 0.15915494309189535f; gk[j] = FIN(F, 6  )[c0 + j]; }
    for (int it = gw; it < NTOK * 2 / 4; it += NGW) {
        const int item = it * 4 + sub, row = item >> 1, hk = item & 1;
        const int s = row_seq(row), t = row - seq_first_row(s); const float pos = (float)(p ? (t & 63) : (t >> 6));
        bf16* kp = F.K() + (size_t)row * 256 + hk * 128 + c0;
        const bf16x8 v = *(const GAS bf16x8*)kp; float x[8]; float ss = 0.f;
#pragma unroll
        for (int j = 0; j < 8; ++j) { x[j] = bf2f(v[j]); ss += x[j] * x[j]; }
        ss += __shfl_xor(ss, 1); ss += __shfl_xor(ss, 2); ss += __shfl_xor(ss, 4); ss += __shfl_xor(ss, 8);
        const float rs = 1.f / sqrtf(ss * (1.f / 128.f) + EPS); float o[8];
#pragma unroll
        for (int j = 0; j < 8; ++j) { x[j] *= rs * gk[j]; const float pr = __shfl_xor(x[j], 4);
            float rev = pos * inv[j]; rev -= floorf(rev); const float sn = __builtin_amdgcn_sinf(rev), cs = __builtin_amdgcn_cosf(rev);
            o[j] = half ? x[j] * cs + pr * sn : x[j] * cs - pr * sn; }
        *(GAS v4u*)(Kout + (size_t)row * 256 + hk * 128 + c0) = pack8(o);
    }
}
__device__ __forceinline__ void p3_meta_job(Frame& F) {
    for (int pr = F.wave; pr < 32; pr += 8) { const int r = pr >> 1, hk = pr & 1; const float* z = F.ZM() + r * INW + 1024 + hk * 128;
        const float a = z[F.lane], b = z[F.lane + 64]; const float rs = 1.f / sqrtf(wave_sum(a * a + b * b) * (1.f / 128.f) + EPS);
        F.KM()[r * 256 + hk * 128 + F.lane] = (bf16)f2bf(a * rs * FIN(F, 6  )[F.lane]); F.KM()[r * 256 + hk * 128 + F.lane + 64] = (bf16)f2bf(b * rs * FIN(F, 6  )[F.lane + 64]); }
    for (int i = F.tid; i < 16 * 256; i += 512) F.VM()[i] = (bf16)f2bf(F.ZM()[(i >> 8) * INW + 1280 + (i & 255)]);
    { const int h = F.wave; const float* z = F.ZM() + 15 * INW + h * 128; const float a = z[F.lane], b = z[F.lane + 64];
      const float rs = 1.f / sqrtf(wave_sum(a * a + b * b) * (1.f / 128.f) + EPS);
      F.Q15()[h * 128 + F.lane] = a * rs * FIN(F, 5  )[F.lane]; F.Q15()[h * 128 + F.lane + 64] = b * rs * FIN(F, 5  )[F.lane + 64]; }
    for (int i = F.tid; i < 1024; i += 512) F.GY15()[i] = F.ZM()[15 * INW + 2560 + i];
}

__device__ __forceinline__ void metaq_item(Frame& F, int it) {
    int s, kvh, j; if (it < 256) { s = it >> 5; kvh = (it >> 4) & 1; j = it & 15; } else { const int t2 = it - 256; s = 8 + (t2 >> 6); kvh = (t2 >> 5) & 1; j = t2 & 31; }
    LAS float* q4 = (LAS float*)F.lds;
    LAS float* sc = q4 + 512;
    LAS float* red = sc + 4 * 288;
    const int tid = F.tid, nk = 256 + (j == 0 ? 16 : 0), row0 = seq_first_row(s) + 256 * j;
    q4[tid] = F.Q15()[kvh * 512 + tid];
    __syncthreads();
    if (tid < nk) {
        const bf16* kp = tid < 256 ? F.K() + (size_t)(row0 + tid) * 256 + kvh * 128 : F.KM() + (tid - 256) * 256 + kvh * 128;
        float d0 = 0.f, d1 = 0.f, d2 = 0.f, d3 = 0.f;
#pragma unroll 4
        for (int cc = 0; cc < 16; ++cc) { const bf16x8 kv = ((const GAS bf16x8*)kp)[cc];
#pragma unroll
            for (int e = 0; e < 8; ++e) { const float kf = bf2f(kv[e]); d0 += kf * q4[cc * 8 + e]; d1 += kf * q4[128 + cc * 8 + e]; d2 += kf * q4[256 + cc * 8 + e]; d3 += kf * q4[384 + cc * 8 + e]; } }
        const float SC = 0.088388347648318440f;
        sc[tid] = d0 * SC; sc[288 + tid] = d1 * SC; sc[576 + tid] = d2 * SC; sc[864 + tid] = d3 * SC;
    }
    __syncthreads();
    if (F.wave < 4) { LAS float* sh = sc + F.wave * 288; float m = -INFINITY;
        for (int k = F.lane; k < nk; k += 64) m = fmaxf(m, sh[k]);
        m = wave_max(m); float l = 0.f;
        for (int k = F.lane; k < nk; k += 64) { const float p = __expf(sh[k] - m); sh[k] = p; l += p; }
        l = wave_sum(l);
        if (F.lane == 0) { red[F.wave * 2] = m; red[F.wave * 2 + 1] = l; } }
    __syncthreads();
    { const int h = tid >> 7, d = tid & 127; float o = 0.f; const LAS float* sh = sc + h * 288;
      const bf16* vp = F.V() + (size_t)row0 * 256 + kvh * 128 + d;
#pragma unroll 8
      for (int k = 0; k < 256; ++k) o += sh[k] * bf2f(vp[(size_t)k * 256]);
      if (j == 0) for (int k = 0; k < 16; ++k) o += sh[256 + k] * bf2f(F.VM()[k * 256 + kvh * 128 + d]);
      float* dst = F.MQP() + ((size_t)it * 4 + h) * 132; dst[2 + d] = o; if (d == 0) { dst[0] = red[h * 2]; dst[1] = red[h * 2 + 1]; } }
    __syncthreads();
}
__device__ __forceinline__ void attn_phase(Frame& F, char* lds_generic, bf16* obase) {
    for (int r = 0; r < 8; ++r) {
        int s, kvh, hq, qb, S;
        if (F.G == 256) {
            const int x = F.vcu >> 5, i = F.vcu & 31;
            if (r < 4) { const int pair = 2 * x + (r >> 1); s = pair >> 1; kvh = pair & 1; const int u = (r & 1) * 32 + i; hq = u >> 4; qb = u & 15; S = 4096; }
            else { const int pair = x; s = 8 + (pair >> 1); kvh = pair & 1; const int u = (r - 4) * 32 + i; hq = u >> 5; qb = u & 31; S = 8192; }
        } else { s = 0; kvh = 0; hq = 0; qb = 0; S = 0; }
        if (S == 0) continue;
        const int row0 = seq_first_row(s), h = kvh * 4 + hq;
        bf16* qp = F.Q() + (size_t)(row0 + qb * 256) * 1024 + h * 128;
        attn::attn_unit(qp, F.K() + (size_t)row0 * 256 + kvh * 128, F.V() + (size_t)row0 * 256 + kvh * 128, F.KM() + kvh * 128, F.VM() + kvh * 128, obase + (size_t)(row0 + qb * 256) * 1024 + h * 128, S / 64 + 1, lds_generic, FIN(F, 5  ), qb * 256);
    }
}

__device__ __forceinline__ void p5_mixed_row(Frame& F, int row, int lane) {
    const GAS bf16x8* a = (const GAS bf16x8*)(F.Q() + (size_t)row * 1024);
    const GAS bf16x8* l = (const GAS bf16x8*)(F.GY() + (size_t)row * 1024);
    const bf16x8 a0 = a[lane], a1 = a[lane + 64], l0 = l[lane], l1 = l[lane + 64];
    float sa = 0.f, sl = 0.f;
#pragma unroll
    for (int j = 0; j < 8; ++j) { const float x0 = bf2f(a0[j]), x1 = bf2f(a1[j]), y0 = bf2f(l0[j]), y1 = bf2f(l1[j]); sa += x0 * x0 + x1 * x1; sl += y0 * y0 + y1 * y1; }
    const float ra = 1.f / sqrtf(wave_sum(sa) * (1.f / 1024.f) + EPS), rl = 1.f / sqrtf(wave_sum(sl) * (1.f / 1024.f) + EPS);
    GAS v4u* o = (GAS v4u*)(F.XN() + (size_t)row * DM);
#pragma unroll
    for (int i = 0; i < 2; ++i) {
        const int e0 = (lane + 64 * i) * 8; const bf16x8 av = i ? a1 : a0, lv = i ? l1 : l0;
        const GAS f32x4* ga = (const GAS f32x4*)(FIN(F, 14  ) + e0); const GAS f32x4* gl = (const GAS f32x4*)(FIN(F, 15  ) + e0);
        const f32x4 ga0 = ga[0], ga1 = ga[1], gl0 = gl[0], gl1 = gl[1];
        float oa[8], ol[8];
        oa[0] = bf2f(av[0]) * ra * ga0.x; oa[1] = bf2f(av[1]) * ra * ga0.y; oa[2] = bf2f(av[2]) * ra * ga0.z; oa[3] = bf2f(av[3]) * ra * ga0.w;
        oa[4] = bf2f(av[4]) * ra * ga1.x; oa[5] = bf2f(av[5]) * ra * ga1.y; oa[6] = bf2f(av[6]) * ra * ga1.z; oa[7] = bf2f(av[7]) * ra * ga1.w;
        ol[0] = bf2f(lv[0]) * rl * gl0.x; ol[1] = bf2f(lv[1]) * rl * gl0.y; ol[2] = bf2f(lv[2]) * rl * gl0.z; ol[3] = bf2f(lv[3]) * rl * gl0.w;
        ol[4] = bf2f(lv[4]) * rl * gl1.x; ol[5] = bf2f(lv[5]) * rl * gl1.y; ol[6] = bf2f(lv[6]) * rl * gl1.z; ol[7] = bf2f(lv[7]) * rl * gl1.w;
        o[lane + 64 * i] = pack8(oa); o[128 + lane + 64 * i] = pack8(ol);
    }
}
__device__ __forceinline__ void p5_meta_job(Frame& F, int s) {
    LAS float* buf = (LAS float*)F.lds; LAS float* red = buf + 2048; const int tid = F.tid;
    {
        const int nj = s < 8 ? 16 : 32;
        for (int e = tid; e < 1024; e += 512) { const int h = e >> 7, d = e & 127, kvh = h >> 2, hq = h & 3;
            const int it0 = s < 8 ? s * 32 + kvh * 16 : 256 + (s - 8) * 64 + kvh * 32;
            float M = -INFINITY; for (int j = 0; j < nj; ++j) M = fmaxf(M, F.MQP()[((size_t)(it0 + j) * 4 + hq) * 132]);
            float Ls = 0.f, O = 0.f;
            for (int j = 0; j < nj; ++j) { const float* p = F.MQP() + ((size_t)(it0 + j) * 4 + hq) * 132; const float w = __expf(p[0] - M); Ls += p[1] * w; O += p[2 + d] * w; }
            buf[e] = O / Ls; }
        for (int e = tid; e < 1024; e += 512) buf[1024 + e] = F.LO15()[s * 1024 + e];
        __syncthreads();
        { float ss = 0.f; for (int k = F.lane; k < 256; k += 64) { const float v = buf[F.wave * 256 + k]; ss += v * v; } ss = wave_sum(ss); if (F.lane == 0) red[F.wave] = ss; }
        __syncthreads();
        const float ra = 1.f / sqrtf((red[0] + red[1] + red[2] + red[3]) * (1.f / 1024.f) + EPS), rl = 1.f / sqrtf((red[4] + red[5] + red[6] + red[7]) * (1.f / 1024.f) + EPS);
        for (int e = tid; e < 2048; e += 512) F.MIXED15()[s * 2048 + e] = e < 1024 ? buf[e] * ra * FIN(F, 14  )[e] : buf[e] * rl * FIN(F, 15  )[e - 1024];
        __syncthreads();
    }
}
__device__ __forceinline__ void p6_meta_y(Frame& F) {
    LAS float* X = (LAS float*)F.lds;
    for (int i = F.tid; i < 12 * DM / 4; i += 512) ((LAS f32x4*)X)[i] = ((const GAS f32x4*)F.MIXED15())[i];
    __syncthreads();
    const OutRows o{F.Y15(), DM, 12};
    small_gemm<12, OutRows>(X, DM, F.WOUT_T(), DM, F.vcu * NWAVES + F.wave, F.G * NWAVES, F.lane, o);
    __syncthreads();
}

__device__ __forceinline__ void p7_row(Frame& F, int row, int lane) {
    const GAS bf16x8* y = (const GAS bf16x8*)(F.Y1() + (size_t)row * DM);
    const float* xr = row < 32768 ? FIN(F, 0  ) + (size_t)row * DM : FIN(F, 1  ) + (size_t)(row - 32768) * DM;
    float hv[32]; float ss = 0.f;
#pragma unroll
    for (int i = 0; i < 4; ++i) { const bf16x8 v = y[lane + 64 * i];
#pragma unroll
        for (int j = 0; j < 8; ++j) { hv[8 * i + j] = bf2f(v[j]); ss += hv[8 * i + j] * hv[8 * i + j]; } }
    const float r1 = 1.f / sqrtf(wave_sum(ss) * (1.f / DM) + EPS); float s2 = 0.f;
#pragma unroll
    for (int i = 0; i < 4; ++i) { const int e0 = (lane + 64 * i) * 8;
        const GAS f32x4* xp = (const GAS f32x4*)(xr + e0); const GAS f32x4* gp = (const GAS f32x4*)(FIN(F, 17  ) + e0);
        const f32x4 x0 = xp[0], x1 = xp[1], g0 = gp[0], g1 = gp[1];
        f32x4 h0, h1;
        h0.x = x0.x + hv[8 * i + 0] * r1 * g0.x; h0.y = x0.y + hv[8 * i + 1] * r1 * g0.y; h0.z = x0.z + hv[8 * i + 2] * r1 * g0.z; h0.w = x0.w + hv[8 * i + 3] * r1 * g0.w;
        h1.x = x1.x + hv[8 * i + 4] * r1 * g1.x; h1.y = x1.y + hv[8 * i + 5] * r1 * g1.y; h1.z = x1.z + hv[8 * i + 6] * r1 * g1.z; h1.w = x1.w + hv[8 * i + 7] * r1 * g1.w;
        GAS f32x4* op = (GAS f32x4*)(F.out + (size_t)row * DM + e0); op[0] = h0; op[1] = h1;
        hv[8 * i + 0] = h0.x; hv[8 * i + 1] = h0.y; hv[8 * i + 2] = h0.z; hv[8 * i + 3] = h0.w; hv[8 * i + 4] = h1.x; hv[8 * i + 5] = h1.y; hv[8 * i + 6] = h1.z; hv[8 * i + 7] = h1.w;
        s2 += (h0.x * h0.x + h0.y * h0.y) + (h0.z * h0.z + h0.w * h0.w) + (h1.x * h1.x + h1.y * h1.y) + (h1.z * h1.z + h1.w * h1.w); }
    const float r2 = 1.f / sqrtf(wave_sum(s2) * (1.f / DM) + EPS);
    GAS v4u* o = (GAS v4u*)(F.XN() + (size_t)row * DM);
#pragma unroll
    for (int i = 0; i < 4; ++i) { const int e0 = (lane + 64 * i) * 8; const GAS f32x4* gp = (const GAS f32x4*)(FIN(F, 18  ) + e0); const f32x4 g0 = gp[0], g1 = gp[1];
        float t[8]; t[0] = hv[8 * i + 0] * r2 * g0.x; t[1] = hv[8 * i + 1] * r2 * g0.y; t[2] = hv[8 * i + 2] * r2 * g0.z; t[3] = hv[8 * i + 3] * r2 * g0.w;
        t[4] = hv[8 * i + 4] * r2 * g1.x; t[5] = hv[8 * i + 5] * r2 * g1.y; t[6] = hv[8 * i + 6] * r2 * g1.z; t[7] = hv[8 * i + 7] * r2 * g1.w;
        o[lane + 64 * i] = pack8(t); }
}
__device__ __forceinline__ void p7_meta_g(Frame& F) {
    LAS float* X = (LAS float*)F.lds;
    for (int r = F.wave; r < 12; r += 8) {
        const float* y = F.Y15() + r * DM; const float* xm = FIN(F, 2  ) + 15 * DM;
        float hv[32]; float ss = 0.f;
#pragma unroll
        for (int i = 0; i < 32; ++i) { hv[i] = y[F.lane + 64 * i]; ss += hv[i] * hv[i]; }
        const float r1 = 1.f / sqrtf(wave_sum(ss) * (1.f / DM) + EPS); float s2 = 0.f;
#pragma unroll
        for (int i = 0; i < 32; ++i) { const int e = F.lane + 64 * i; hv[i] = xm[e] + hv[i] * r1 * FIN(F, 17  )[e]; s2 += hv[i] * hv[i]; }
        const float r2 = 1.f / sqrtf(wave_sum(s2) * (1.f / DM) + EPS);
#pragma unroll
        for (int i = 0; i < 32; ++i) { const int e = F.lane + 64 * i; X[r * DM + e] = hv[i] * r2 * FIN(F, 18  )[e]; }
    }
    __syncthreads();
    const OutRows o{F.G15(), FFN, 12};
    small_gemm<12, OutRows>(X, DM, F.WUP_T(), FFN, F.vcu * NWAVES + F.wave, F.G * NWAVES, F.lane, o);
    __syncthreads();
}

__device__ __forceinline__ void p9_act(Frame& F, int q) {
    constexpr int NOCT = FFN / 8;
    const int total = QROWS * NOCT;
    for (int it = F.vcu * 512 + F.tid; it < total; it += F.G * 512) {
        const int lr = it / NOCT, co = (it - lr * NOCT) * 8;
        const int row = q * QROWS + lr, s = row_seq(row), t = row - seq_first_row(s), S = seq_len(s);
        const bf16* up = F.UP() + (size_t)lr * UPW;
        const bf16x8 g1 = *(const GAS bf16x8*)(up + co), uu = *(const GAS bf16x8*)(up + FFN + co);
        float g0f[8], g2f[8];
        if (t > 0) { const bf16x8 g0 = *(const GAS bf16x8*)(up - UPW + co);
#pragma unroll
            for (int j = 0; j < 8; ++j) g0f[j] = bf2f(g0[j]); }
        else { const GAS f32x4* gp = (const GAS f32x4*)(F.G15() + (size_t)s * FFN + co); const f32x4 a = gp[0], b = gp[1];
            g0f[0] = a.x; g0f[1] = a.y; g0f[2] = a.z; g0f[3] = a.w; g0f[4] = b.x; g0f[5] = b.y; g0f[6] = b.z; g0f[7] = b.w; }
        if (t < S - 1) { const bf16x8 g2 = *(const GAS bf16x8*)(up + UPW + co);
#pragma unroll
            for (int j = 0; j < 8; ++j) g2f[j] = bf2f(g2[j]); }
        else {
#pragma unroll
            for (int j = 0; j < 8; ++j) g2f[j] = 0.f; }
        float w0[8], w1[8], w2[8], bb[8];
        { const GAS f32x4* p0 = (const GAS f32x4*)(FIN(F, 20  ) + co); const GAS f32x4* p1 = (const GAS f32x4*)(FIN(F, 20  ) + FFN + co); const GAS f32x4* p2 = (const GAS f32x4*)(FIN(F, 20  ) + 2 * FFN + co);
          const GAS f32x4* pb = (const GAS f32x4*)(FIN(F, 21  ) + co);
          const f32x4 a0 = p0[0], a1 = p0[1], b0 = p1[0], b1 = p1[1], c0 = p2[0], c1 = p2[1], d0 = pb[0], d1 = pb[1];
          w0[0] = a0.x; w0[1] = a0.y; w0[2] = a0.z; w0[3] = a0.w; w0[4] = a1.x; w0[5] = a1.y; w0[6] = a1.z; w0[7] = a1.w;
          w1[0] = b0.x; w1[1] = b0.y; w1[2] = b0.z; w1[3] = b0.w; w1[4] = b1.x; w1[5] = b1.y; w1[6] = b1.z; w1[7] = b1.w;
          w2[0] = c0.x; w2[1] = c0.y; w2[2] = c0.z; w2[3] = c0.w; w2[4] = c1.x; w2[5] = c1.y; w2[6] = c1.z; w2[7] = c1.w;
          bb[0] = d0.x; bb[1] = d0.y; bb[2] = d0.z; bb[3] = d0.w; bb[4] = d1.x; bb[5] = d1.y; bb[6] = d1.z; bb[7] = d1.w; }
        float o[8];
#pragma unroll
        for (int j = 0; j < 8; ++j) { const float x = bb[j] + w0[j] * g0f[j] + w1[j] * bf2f(g1[j]) + w2[j] * g2f[j]; o[j] = x * sigmoidf_(x) * bf2f(uu[j]); }
        *(GAS v4u*)(F.ACT() + (size_t)lr * FFN + co) = pack8(o);
    }
}
__device__ __forceinline__ void p11_row(Frame& F, int row, int lane, float* obase) {
    const GAS bf16x8* f = (const GAS bf16x8*)(F.XN() + (size_t)row * DM);
    float fv[32]; float ss = 0.f;
#pragma unroll
    for (int i = 0; i < 4; ++i) { const bf16x8 v = f[lane + 64 * i];
#pragma unroll
        for (int j = 0; j < 8; ++j) { fv[8 * i + j] = bf2f(v[j]); ss += fv[8 * i + j] * fv[8 * i + j]; } }
    const float r1 = 1.f / sqrtf(wave_sum(ss) * (1.f / DM) + EPS);
#pragma unroll
    for (int i = 0; i < 4; ++i) { const int e0 = (lane + 64 * i) * 8;
        GAS f32x4* op = (GAS f32x4*)(F.out + (size_t)row * DM + e0); const GAS f32x4* gp = (const GAS f32x4*)(FIN(F, 23  ) + e0);
        f32x4 h0 = op[0], h1 = op[1]; const f32x4 g0 = gp[0], g1 = gp[1];
        h0.x += fv[8 * i + 0] * r1 * g0.x; h0.y += fv[8 * i + 1] * r1 * g0.y; h0.z += fv[8 * i + 2] * r1 * g0.z; h0.w += fv[8 * i + 3] * r1 * g0.w;
        h1.x += fv[8 * i + 4] * r1 * g1.x; h1.y += fv[8 * i + 5] * r1 * g1.y; h1.z += fv[8 * i + 6] * r1 * g1.z; h1.w += fv[8 * i + 7] * r1 * g1.w;
        GAS f32x4* wp = (GAS f32x4*)(obase + (size_t)row * DM + e0); wp[0] = h0; wp[1] = h1; }
}
struct Args { const float* in[24]; float* out; unsigned char* ws; int ph_lo, ph_hi, q_lo, q_hi, use_bar, dummy; };
constexpr int N_PHASES = 12;
__global__ void __launch_bounds__(NWAVES * 64, 2) mk_fwd(Args args) {
    extern __shared__ __attribute__((aligned(16))) unsigned char lds[];
    Frame F;
    F.lds = (LAS unsigned char*)lds;
    F.MISC = (volatile LAS unsigned*)(F.lds + MISC_OFF);
    F.tid = threadIdx.x; F.lane = F.tid & 63; F.wave = __builtin_amdgcn_readfirstlane(F.tid >> 6);
    F.G = gridDim.x; { const int bx = blockIdx.x; F.vcu = (F.G % 8 == 0) ? (bx % 8) * (F.G / 8) + bx / 8 : bx; }
    unsigned char* ws = args.ws;
    F.ctl = (gu32*)(ws + WS_CTL);
    F.kargs = (const __attribute__((address_space(4))) void*)__builtin_amdgcn_kernarg_segment_ptr(); F.ptag = 0; F.out = args.out;
    F.ws = ws;
    for (int u = F.tid; u < (LDS_BYTES - LDSCTL_OFF) / 4; u += NWAVES * 64) ((LAS unsigned*)(F.lds + LDSCTL_OFF))[u] = 0u;
    __syncthreads();
    XcdBarrier bar; bar.bar = (unsigned*)(F.ctl + CW_BAR); bar.x = 0; bar.st = nullptr;
    if (args.use_bar) bar = xcd_barrier_post((unsigned*)(F.ctl + CW_BAR), F.MISC + 8);
    const int lo = args.ph_lo, hi = args.ph_hi;
#define IN(k) (((MK_PHASE_MASK >> (k)) & 1) && lo <= (k) && (k) < hi)
#define PH_BEGIN(k) do { F.ptag = (k); int t_ = F.tid; asm volatile("" : "+v"(t_)); F.tid = t_; F.lane = t_ & 63; } while (0)
#define PH_BAR() do { if (args.use_bar) xcd_barrier(bar); } while (0)
    const int gw = F.vcu * NWAVES + F.wave, NGW = F.G * NWAVES;

    if (IN(0)) { PH_BEGIN(0); { p0_prologue(F); PH_BAR(); } }
    if (IN(1)) { PH_BEGIN(1); {
        p1_meta_z(F);
        pg8::Gemm g{F.XN(), F.WIN_T(), NTOK, INW, DM}; pg8::StaticOrder S; S.init(NTOK, INW, F.G, (int)blockIdx.x);
        pg8::EpiRoute E{nullptr, 0, 1, F.Q(), F.K(), F.V(), F.XR(), F.GY()};
        pg8::gemm_phase<pg8::EpiRoute, pg8::StaticOrder, true, true>(F.lds, g, S, E);
        PH_BAR();
    } }
    if (IN(2)) { PH_BEGIN(2); { lru_phase<1>(F, nullptr); PH_BAR(); } }
    if (IN(3)) { PH_BEGIN(3); {
        k_rope_pass(F, args.dummy ? (bf16*)F.out : F.K());
        lru_propagate(F);
        if (F.vcu == F.G - 1) p3_meta_job(F);
        PH_BAR();
    } }
    if (IN(4)) { PH_BEGIN(4); {
        lru_phase<2>(F, args.dummy ? (bf16*)F.out + (size_t)NTOK * 1024 : F.GY());
        for (int it = F.vcu; it < 512; it += F.G) metaq_item(F, it);
        attn_phase(F, (char*)lds, args.dummy ? (bf16*)F.out : F.Q());
        PH_BAR();
    } }
    if (IN(5)) { PH_BEGIN(5); {
        for (int row = gw; row < NTOK; row += NGW) p5_mixed_row(F, row, F.lane);
        if (F.vcu >= F.G - 12) p5_meta_job(F, F.G - 1 - F.vcu);
        PH_BAR();
    } }
    if (IN(6)) { PH_BEGIN(6); {
        p6_meta_y(F);
        pg8::Gemm g{F.XN(), F.WOUT_T(), NTOK, DM, DM}; pg8::StaticOrder S; S.init(NTOK, DM, F.G, (int)blockIdx.x);
        pg8::EpiRoute E{F.Y1(), DM, 0, nullptr, nullptr, nullptr, nullptr, nullptr};
        pg8::gemm_phase<pg8::EpiRoute, pg8::StaticOrder, true, true>(F.lds, g, S, E);
        PH_BAR();
    } }
    if (IN(7)) { PH_BEGIN(7); {
        for (int row = gw; row < NTOK; row += NGW) p7_row(F, row, F.lane);
        p7_meta_g(F);
        PH_BAR();
    } }
#if MK_MULTI
    { const int q = args.q_lo;
#else
#pragma unroll
    for (int q = 0; q < 4; ++q) {
#endif
        if (IN(8)) { PH_BEGIN(8); {
            pg8::Gemm g{F.XN() + (size_t)q * QROWS * DM, F.WUP_T(), QROWS, UPW, DM}; pg8::StaticOrder S; S.init(QROWS, UPW, F.G, (int)blockIdx.x);
            pg8::EpiRoute E{F.UP(), UPW, 0, nullptr, nullptr, nullptr, nullptr, nullptr};
            pg8::gemm_phase<pg8::EpiRoute, pg8::StaticOrder, true, true>(F.lds, g, S, E);
            PH_BAR();
        } }
        if (IN(9)) { PH_BEGIN(9); { p9_act(F, q); PH_BAR(); } }
        if (IN(10)) { PH_BEGIN(10); {
            pg8::Gemm g{F.ACT(), F.WDOWN_T(), QROWS, DM, FFN}; pg8::StaticOrder S; S.init(QROWS, DM, F.G, (int)blockIdx.x);
            pg8::EpiRoute E{F.XN() + (size_t)q * QROWS * DM, DM, 0, nullptr, nullptr, nullptr, nullptr, nullptr};
            pg8::gemm_phase<pg8::EpiRoute, pg8::StaticOrder, true, true>(F.lds, g, S, E);
        } }
    }
    if (IN(10) && IN(11)) PH_BAR();
    if (IN(11)) { PH_BEGIN(11); { for (int row = gw; row < NTOK; row += NGW) p11_row(F, row, F.lane, args.dummy ? (float*)(F.ws + WS_B) : F.out); } }
#undef IN
#undef PH_BAR
}

extern "C" void kernel_launch(void* const* d_in, const int* in_sizes, int n_in, void* d_out, int out_size, void* d_ws, size_t ws_size, hipStream_t stream) {
    static int grid = 0;
    if (grid == 0) {
        if (n_in != 24 || out_size != NTOK * DM || ws_size < WS_END) { fprintf(stderr, "kernel_launch: unexpected shapes (n_in %d out %d ws %zu, need ws >= %zu); nothing launched\n", n_in, out_size, ws_size, (size_t)WS_END); grid = -1; return; }
        int dev = 0, cus = 0;
        if (hipGetDevice(&dev) != hipSuccess || hipDeviceGetAttribute(&cus, hipDeviceAttributeMultiprocessorCount, dev) != hipSuccess) { grid = -1; return; }
        if (hipFuncSetAttribute((const void*)mk_fwd, hipFuncAttributeMaxDynamicSharedMemorySize, LDS_BYTES) != hipSuccess) { fprintf(stderr, "kernel_launch: hipFuncSetAttribute failed\n"); grid = -1; return; }
        int per_cu = 0;
        if (hipOccupancyMaxActiveBlocksPerMultiprocessor(&per_cu, (const void*)mk_fwd, NWAVES * 64, LDS_BYTES) != hipSuccess || per_cu < 1) fprintf(stderr, "kernel_launch: occupancy query reports %d\n", per_cu);
        (void)hipGetLastError();
        grid = cus;
    }
    if (grid < 0) return;
    if (hipMemsetAsync((char*)d_ws + WS_CTL, 0, CTL_ZERO_BYTES, stream) != hipSuccess) return;
    Args a{};
    for (int i = 0; i < 24; ++i) a.in[i] = (const float*)d_in[i];
    a.out = (float*)d_out; a.ws = (unsigned char*)d_ws;
#if MK_MULTI
    a.use_bar = 0;
#define LAUNCH_PH(ph, q) do { a.ph_lo = (ph); a.ph_hi = (ph) + 1; a.q_lo = (q); a.q_hi = (q) + 1; \
        if ((MK_REPEAT_MASK >> (ph)) & 1) { a.dummy = 1; hipLaunchKernelGGL(mk_fwd, dim3(grid), dim3(NWAVES * 64), LDS_BYTES, stream, a); } \
        a.dummy = 0; hipLaunchKernelGGL(mk_fwd, dim3(grid), dim3(NWAVES * 64), LDS_BYTES, stream, a); } while (0)
    for (int ph = 0; ph < 8; ++ph) LAUNCH_PH(ph, 0);
    for (int q = 0; q < 4; ++q) for (int ph = 8; ph < 11; ++ph) LAUNCH_PH(ph, q);
    LAUNCH_PH(11, 0);
#else
    a.use_bar = 1; a.ph_lo = 0; a.ph_hi = N_PHASES; a.q_lo = 0; a.q_hi = 4;
    hipLaunchKernelGGL(mk_fwd, dim3(grid), dim3(NWAVES * 64), LDS_BYTES, stream, a);
#endif
    const hipError_t le = hipPeekAtLastError();
    if (le != hipSuccess) fprintf(stderr, "kernel_launch: launch failed: %s\n", hipGetErrorName(le));
}
```

```cpp
#include <hip/hip_runtime.h>
#include <cstdio>
#include <cstdint>
#include <cmath>
#ifndef MK_PHASE_MASK
#define MK_PHASE_MASK 0xfff
#endif
#ifndef MK_REPEAT_MASK
#define MK_REPEAT_MASK 0
#endif
#ifndef MK_DUMMY_MODE
#define MK_DUMMY_MODE 1
#endif
#ifndef MK_MULTI
#define MK_MULTI 0
#endif
namespace pg8 {
#define PG8_LAS __attribute__((address_space(3)))
typedef unsigned short bf16_t;
typedef short bf16x8 __attribute__((ext_vector_type(8)));
typedef float f32x4 __attribute__((ext_vector_type(4)));
typedef unsigned u32x4 __attribute__((ext_vector_type(4)));
constexpr int BM = 256, BK = 64, HALF = 128, HTB = HALF * BK * 2  , STAGE_BYTES = 8 * HTB, NXCD = 8, WGM = 8;

__host__ __device__ __forceinline__ int lds_byte(int r, int c) { const int st = (r >> 4) * 2 + (c >> 5), rr = r & 15, cc = c & 31, ob = rr * 64 + cc * 2; return st * 1024 + (ob ^ (((ob >> 9) & 1) << 5)); }
__host__ __device__ __forceinline__ void stage_rc(int b, int& R, int& C) { const int st = b / 1024, sb = b % 1024, swz = sb ^ (((sb >> 9) & 1) << 5); R = (st >> 1) * 16 + swz / 64; C = (st & 1) * 32 + (swz % 64) / 2; }
__host__ __device__ __forceinline__ int perm32(int rho) { const int n = rho >> 4, i = rho & 15; return 8 * (i >> 2) + 4 * n + (i & 3); }

struct Unit { int pm, pn; };
struct Gemm { const bf16_t* A; const bf16_t* Bt; int M, N, K; };

struct StaticOrder {
    int nM, nN, nwg, G, c;
    __host__ __device__ void init(int M, int N, int G_, int c_) { nM = M / BM; nN = N / BM; nwg = nM * nN; G = G_; c = c_; }
    __host__ __device__ bool next(int i, Unit& u) const {
        const long L = (long)i * G + c; if (L >= nwg) return false;
        int wgid = (int)L; { const int q = nwg / NXCD, r = nwg % NXCD, xcd = wgid % NXCD, off = wgid / NXCD; wgid = (xcd < r ? xcd * (q + 1) : r * (q + 1) + (xcd - r) * q) + off; }
        const int nig = WGM * nN, gid = wgid / nig, fm = gid * WGM, gsz = (nM - fm) < WGM ? (nM - fm) : WGM;
        u.pm = fm + ((wgid % nig) % gsz); u.pn = (wgid % nig) / gsz; return true;
    }
    __device__ __forceinline__ void a_ready(const Unit&) const {}
    __device__ __forceinline__ void done(const Unit&) const {}
};

__device__ __forceinline__ unsigned cvt_pk_bf16(float lo, float hi) { unsigned r; asm volatile("v_cvt_pk_bf16_f32 %0, %1, %2" : "=v"(r) : "v"(lo), "v"(hi)); return r; }
struct EpiRoute {
    static constexpr bool PERM = true, AFTER_DRAIN = false;
    bf16_t* O; int ldc; int mode; bf16_t *Qp, *Kp, *Vp, *XRp, *GYp;
    __device__ __forceinline__ void operator()(const f32x4 (&acc)[2][2][4][2], const Unit& u, int wr, int wc, int fr, int fq) const {
        bf16_t* base = O; int ld = ldc; int colt = u.pn * BM; int rowadd = 0;
        if (mode == 1) {
            const int pn = u.pn;
            if (pn < 4) { base = Qp; ld = 1024; colt = pn * 256; }
            else if (pn == 4) { base = Kp; ld = 256; colt = 0; }
            else if (pn == 5) { base = Vp; ld = 256; colt = 0; }
            else if (pn < 10) { base = XRp; ld = 1024; colt = (pn - 6) * 256; const int seq = u.pm < 128 ? (u.pm >> 4) : 8 + ((u.pm - 128) >> 5); rowadd = 64 * (seq + 1); }
            else { base = GYp; ld = 1024; colt = (pn - 10) * 256; }
        }
        const int row0 = u.pm * BM + wr * 64 + fr + rowadd; const int col0 = colt + wc * 32 + 8 * fq;
#pragma unroll
        for (int ai = 0; ai < 2; ++ai)
#pragma unroll
            for (int m = 0; m < 4; ++m) { bf16_t* rowp = base + (size_t)(row0 + ai * HALF + m * 16) * ld + col0;
#pragma unroll
                for (int bj = 0; bj < 2; ++bj) { const f32x4 v0 = acc[ai][bj][m][0], v1 = acc[ai][bj][m][1];
                    u32x4 w; w.x = cvt_pk_bf16(v0[0], v0[1]); w.y = cvt_pk_bf16(v0[2], v0[3]); w.z = cvt_pk_bf16(v1[0], v1[1]); w.w = cvt_pk_bf16(v1[2], v1[3]);
                    *(u32x4*)(rowp + bj * HALF) = w; } }
    }
};

__device__ __forceinline__ float dpp_shr1(float old, float src) { return __builtin_bit_cast(float, __builtin_amdgcn_update_dpp(__builtin_bit_cast(int, old), __builtin_bit_cast(int, src), 0x111, 0xF, 0xF, false)); }
__device__ __forceinline__ float dpp_shl1(float old, float src) { return __builtin_bit_cast(float, __builtin_amdgcn_update_dpp(__builtin_bit_cast(int, old), __builtin_bit_cast(int, src), 0x101, 0xF, 0xF, false)); }
__device__ __forceinline__ float dpp_ror1(float src)  { return __builtin_bit_cast(float, __builtin_amdgcn_update_dpp(0, __builtin_bit_cast(int, src), 0x121, 0xF, 0xF, false)); }
__device__ __forceinline__ float dpp_ror15(float src) { return __builtin_bit_cast(float, __builtin_amdgcn_update_dpp(0, __builtin_bit_cast(int, src), 0x12F, 0xF, 0xF, false)); }
struct EpiAct {
    static constexpr bool PERM = true, AFTER_DRAIN = false;
    bf16_t* ACT; float* EDGE; const float* cw; const float* cb; int nch;
    __device__ __forceinline__ void operator()(const f32x4 (&acc)[2][2][4][2], const Unit& u, int wr, int wc, int fr, int fq) const {
        const int ch0 = u.pn * 128 + wc * 32 + 8 * fq;
        float w0[8], w1[8], w2[8], bb[8];
        { const f32x4 a0 = *(const f32x4*)(cw + ch0), a1 = *(const f32x4*)(cw + ch0 + 4), b0 = *(const f32x4*)(cw + nch + ch0), b1 = *(const f32x4*)(cw + nch + ch0 + 4),
                      c0 = *(const f32x4*)(cw + 2 * nch + ch0), c1 = *(const f32x4*)(cw + 2 * nch + ch0 + 4), d0 = *(const f32x4*)(cb + ch0), d1 = *(const f32x4*)(cb + ch0 + 4);
#pragma unroll
          for (int k = 0; k < 4; ++k) { w0[k] = a0[k]; w0[4 + k] = a1[k]; w1[k] = b0[k]; w1[4 + k] = b1[k]; w2[k] = c0[k]; w2[4 + k] = c1[k]; bb[k] = d0[k]; bb[4 + k] = d1[k]; } }
        const int rowb = u.pm * BM + wr * 64;
#pragma unroll
        for (int ai = 0; ai < 2; ++ai) {
            float ein0[8], ein1[8];
#pragma unroll
            for (int m = 0; m < 4; ++m) {
                float o[8];
#pragma unroll
                for (int n = 0; n < 2; ++n)
#pragma unroll
                    for (int k = 0; k < 4; ++k) {
                        const int j = 4 * n + k; const float cur = acc[ai][0][m][n][k];
                        float pold = 0.f, nold = 0.f;
                        if (m > 0) pold = dpp_ror1(acc[ai][0][m > 0 ? m - 1 : 0][n][k]);
                        if (m < 3) nold = dpp_ror15(acc[ai][0][m < 3 ? m + 1 : 3][n][k]);
                        const float prv = dpp_shr1(pold, cur), nxt = dpp_shl1(nold, cur);
                        const float x = bb[j] + w0[j] * prv + w1[j] * cur + w2[j] * nxt;
                        o[j] = x * __builtin_amdgcn_rcpf(1.f + __builtin_amdgcn_exp2f(-1.4426950408889634f * x)) * acc[ai][1][m][n][k];
                        if (m == 0) ein0[j] = nxt;
                        if (m == 3) ein1[j] = prv;
                    }
                u32x4 w; w.x = cvt_pk_bf16(o[0], o[1]); w.y = cvt_pk_bf16(o[2], o[3]); w.z = cvt_pk_bf16(o[4], o[5]); w.w = cvt_pk_bf16(o[6], o[7]);
                *(u32x4*)(ACT + (size_t)(rowb + ai * HALF + m * 16 + fr) * nch + ch0) = w;
            }
            const int blk = (rowb + ai * HALF) >> 6;
            if (fr == 0 || fr == 15) {
                const bool last = fr == 15; float* e = EDGE + (size_t)((blk * 2 + (last ? 1 : 0)) * 3) * nch + ch0;
                f32x4 i0v, i1v, s0v, s1v, u0v, u1v;
#pragma unroll
                for (int k = 0; k < 4; ++k) { i0v[k] = last ? ein1[k] : ein0[k]; i1v[k] = last ? ein1[4 + k] : ein0[4 + k];
                    s0v[k] = last ? acc[ai][0][3][0][k] : acc[ai][0][0][0][k]; s1v[k] = last ? acc[ai][0][3][1][k] : acc[ai][0][0][1][k];
                    u0v[k] = last ? acc[ai][1][3][0][k] : acc[ai][1][0][0][k]; u1v[k] = last ? acc[ai][1][3][1][k] : acc[ai][1][0][1][k]; }
                *(f32x4*)(e) = i0v; *(f32x4*)(e + 4) = i1v; *(f32x4*)(e + nch) = s0v; *(f32x4*)(e + nch + 4) = s1v; *(f32x4*)(e + 2 * nch) = u0v; *(f32x4*)(e + 2 * nch + 4) = u1v;
            }
        }
    }
};

struct ProbeOrder : StaticOrder { int pmask;
    __host__ __device__ bool next(int i, Unit& u) const { const bool r = StaticOrder::next(i, u); u.pm &= pmask; return r; } };

template <class Epi, class Sched, bool ALIGN_EPI = false, bool SP2 = false>
__device__ __forceinline__ void gemm_phase(PG8_LAS unsigned char* lds, const Gemm g, const Sched& S, const Epi& E) {
    const int tid = threadIdx.x, wid = __builtin_amdgcn_readfirstlane(tid >> 6), lane = tid & 63, wr = wid >> 2, wc = wid & 3, fr = lane & 15, fq = lane >> 4;
    const int K = g.K, nt = K / BK;
    unsigned voffA[2], voffB[2];
#pragma unroll
    for (int i = 0; i < 2; ++i) { int R, C; stage_rc(tid * 16 + i * 8192, R, C); const int Rb = Epi::PERM ? ((R & ~31) + perm32(R & 31)) : R;
        voffA[i] = (unsigned)(R * K + C) * 2u; voffB[i] = (unsigned)(Rb * K + C) * 2u; }
    const size_t kstep = (size_t)(BK * 2);
    const size_t hstep = (size_t)HALF * K * 2;
    const size_t tstep = 2 * hstep;
    const unsigned ldsw = (unsigned)wid * 1024u;
    const int aoff = lds_byte(wr * 64 + fr, fq * 8), boff = lds_byte(wc * 32 + fr, fq * 8);
#define PG8_SA(b, h) (((b) * 2 + (h)) * HTB)
#define PG8_SB(b, h) ((4 + (b) * 2 + (h)) * HTB)
#define PG8_STAGE(bufoff, gbase, voff) do { _Pragma("unroll") for (int _i = 0; _i < 2; ++_i) \
        __builtin_amdgcn_global_load_lds((const unsigned*)((const char*)(gbase) + (voff)[_i]), (PG8_LAS unsigned*)(lds + (bufoff) + ldsw + _i * 8192), 16, 0, 0); } while (0)
#define PG8_LDA(dst, b, h) do { _Pragma("unroll") for (int m = 0; m < 4; ++m) _Pragma("unroll") for (int k = 0; k < 2; ++k) dst[m][k] = *(const PG8_LAS bf16x8*)(lds + PG8_SA(b, h) + aoff + m * 2048 + k * 1024); } while (0)
#define PG8_LDB(dst, b, h) do { _Pragma("unroll") for (int n = 0; n < 2; ++n) _Pragma("unroll") for (int k = 0; k < 2; ++k) dst[n][k] = *(const PG8_LAS bf16x8*)(lds + PG8_SB(b, h) + boff + n * 2048 + k * 1024); } while (0)
#define PG8_MMA(ai, bj, At, Bt) do { __builtin_amdgcn_s_setprio(1); _Pragma("unroll") for (int m = 0; m < 4; ++m) _Pragma("unroll") for (int n = 0; n < 2; ++n) _Pragma("unroll") for (int k = 0; k < 2; ++k) \
        acc[ai][bj][m][n] = __builtin_amdgcn_mfma_f32_16x16x32_bf16(Bt[n][k], At[m][k], acc[ai][bj][m][n], 0, 0, 0); __builtin_amdgcn_s_setprio(0); } while (0)
#define PG8_WAIT_V(n) asm volatile("s_waitcnt vmcnt(" #n ")" ::: "memory")
#define PG8_WAIT_L(n) asm volatile("s_waitcnt lgkmcnt(" #n ")" ::: "memory")
#define PG8_BAR __builtin_amdgcn_s_barrier()
#define PG8_SCHED __builtin_amdgcn_sched_barrier(0)
    Unit cur, nxt; int ui = 0;
    if (!S.next(0, cur)) return;
    f32x4 acc[2][2][4][2];
#pragma unroll
    for (int a = 0; a < 2; ++a)
#pragma unroll
        for (int b = 0; b < 2; ++b)
#pragma unroll
            for (int m = 0; m < 4; ++m)
#pragma unroll
                for (int n = 0; n < 2; ++n) acc[a][b][m][n] = (f32x4){0.f, 0.f, 0.f, 0.f};
    bf16x8 At[4][2], B0[2][2], B1[2][2];
    const char* cA = (const char*)g.A + (size_t)cur.pm * tstep; const char* cB = (const char*)g.Bt + (size_t)cur.pn * tstep;
    S.a_ready(cur);
    if constexpr (SP2) {
        PG8_STAGE(PG8_SB(0, 0), cB, voffB); PG8_STAGE(PG8_SB(0, 1), cB + hstep, voffB); PG8_STAGE(PG8_SA(0, 0), cA, voffA); PG8_STAGE(PG8_SA(0, 1), cA + hstep, voffA);
        if (wr == 1) PG8_BAR;
        PG8_WAIT_V(2); PG8_BAR;
        PG8_STAGE(PG8_SB(1, 0), cB + kstep, voffB); PG8_STAGE(PG8_SA(1, 0), cA + kstep, voffA); PG8_STAGE(PG8_SB(1, 1), cB + hstep + kstep, voffB);
        PG8_WAIT_V(6); PG8_BAR;
    } else {
        PG8_STAGE(PG8_SB(0, 0), cB, voffB); PG8_STAGE(PG8_SA(0, 0), cA, voffA); PG8_STAGE(PG8_SB(0, 1), cB + hstep, voffB); PG8_STAGE(PG8_SA(0, 1), cA + hstep, voffA);
        if (wr == 1) PG8_BAR;
        PG8_WAIT_V(4); PG8_BAR;
        PG8_STAGE(PG8_SB(1, 0), cB + kstep, voffB); PG8_STAGE(PG8_SA(1, 0), cA + kstep, voffA); PG8_STAGE(PG8_SB(1, 1), cB + hstep + kstep, voffB);
        PG8_WAIT_V(6); PG8_BAR;
    }
    for (;;) {
        const bool has_next = S.next(ui + 1, nxt);
        const char* nA = has_next ? (const char*)g.A + (size_t)nxt.pm * tstep : cA; const char* nB = has_next ? (const char*)g.Bt + (size_t)nxt.pn * tstep : cB;
        for (int t = 0; t < nt; t += 2) {
            const bool last = (t == nt - 2);
            const char* a1 = cA + (size_t)(t + 1) * kstep;
            const char* a2 = last ? nA : cA + (size_t)(t + 2) * kstep; const char* b2 = last ? nB : cB + (size_t)(t + 2) * kstep;
            const char* a3 = a2 + kstep; const char* b3 = b2 + kstep;
            if (last && has_next) S.a_ready(nxt);
            if constexpr (SP2) {
            PG8_LDB(B0, 0, 0); PG8_LDB(B1, 0, 1); PG8_SCHED; PG8_LDA(At, 0, 0); PG8_STAGE(PG8_SA(1, 1), a1 + hstep, voffA);
            PG8_WAIT_V(8); PG8_WAIT_L(0); PG8_BAR; PG8_MMA(0, 0, At, B0); PG8_MMA(0, 1, At, B1); PG8_BAR; PG8_SCHED;
            PG8_LDA(At, 0, 1); PG8_STAGE(PG8_SB(0, 0), b2, voffB); PG8_STAGE(PG8_SB(0, 1), b2 + hstep, voffB); PG8_STAGE(PG8_SA(0, 0), a2, voffA);
            PG8_WAIT_V(8); PG8_WAIT_L(0); PG8_BAR; PG8_MMA(1, 0, At, B0); PG8_MMA(1, 1, At, B1); PG8_BAR; PG8_SCHED;
            PG8_LDB(B0, 1, 0); PG8_LDB(B1, 1, 1); PG8_SCHED; PG8_LDA(At, 1, 0); PG8_STAGE(PG8_SA(0, 1), a2 + hstep, voffA);
            PG8_WAIT_V(8); PG8_WAIT_L(0); PG8_BAR; PG8_MMA(0, 0, At, B0); PG8_MMA(0, 1, At, B1); PG8_BAR; PG8_SCHED;
            PG8_LDA(At, 1, 1); PG8_STAGE(PG8_SB(1, 0), b3, voffB); PG8_STAGE(PG8_SB(1, 1), b3 + hstep, voffB); PG8_STAGE(PG8_SA(1, 0), a3, voffA);
            PG8_WAIT_V(8); PG8_WAIT_L(0); PG8_BAR; PG8_MMA(1, 0, At, B0); PG8_MMA(1, 1, At, B1); PG8_BAR; PG8_SCHED;
            } else {
            PG8_LDB(B0, 0, 0); PG8_SCHED; PG8_LDA(At, 0, 0); PG8_STAGE(PG8_SA(1, 1), a1 + hstep, voffA);
            PG8_WAIT_L(8); PG8_BAR; PG8_WAIT_L(0); PG8_MMA(0, 0, At, B0); PG8_BAR; PG8_SCHED;
            PG8_LDB(B1, 0, 1); PG8_STAGE(PG8_SB(0, 0), b2, voffB);
            PG8_BAR; PG8_WAIT_L(0); PG8_MMA(0, 1, At, B1); PG8_BAR;
            PG8_LDA(At, 0, 1); PG8_STAGE(PG8_SA(0, 0), a2, voffA);
            PG8_BAR; PG8_WAIT_L(0); PG8_MMA(1, 0, At, B0); PG8_BAR; PG8_SCHED;
            PG8_STAGE(PG8_SB(0, 1), b2 + hstep, voffB);
            PG8_WAIT_V(6); PG8_BAR; PG8_MMA(1, 1, At, B1); PG8_BAR;
            PG8_LDB(B0, 1, 0); PG8_SCHED; PG8_LDA(At, 1, 0); PG8_STAGE(PG8_SA(0, 1), a2 + hstep, voffA);
            PG8_WAIT_L(8); PG8_BAR; PG8_WAIT_L(0); PG8_MMA(0, 0, At, B0); PG8_BAR; PG8_SCHED;
            PG8_LDB(B1, 1, 1); PG8_STAGE(PG8_SB(1, 0), b3, voffB);
            PG8_BAR; PG8_WAIT_L(0); PG8_MMA(0, 1, At, B1); PG8_BAR;
            PG8_LDA(At, 1, 1); PG8_STAGE(PG8_SA(1, 0), a3, voffA);
            PG8_BAR; PG8_WAIT_L(0); PG8_MMA(1, 0, At, B0); PG8_BAR; PG8_SCHED;
            PG8_STAGE(PG8_SB(1, 1), b3 + hstep, voffB);
            PG8_WAIT_V(6); PG8_BAR; PG8_MMA(1, 1, At, B1); PG8_BAR;
            }
        }
        if constexpr (ALIGN_EPI) { if (wr == 0) PG8_BAR; }
        if constexpr (!Epi::AFTER_DRAIN) { E(acc, cur, wr, wc, fr, fq); S.done(cur); }
        if (!has_next) break;
#pragma unroll
        for (int a = 0; a < 2; ++a)
#pragma unroll
            for (int b = 0; b < 2; ++b)
#pragma unroll
                for (int m = 0; m < 4; ++m)
#pragma unroll
                    for (int n = 0; n < 2; ++n) acc[a][b][m][n] = (f32x4){0.f, 0.f, 0.f, 0.f};
        cur = nxt; cA = nA; cB = nB; ++ui;
        if constexpr (ALIGN_EPI) { if (wr == 1) PG8_BAR; }
    }
    PG8_WAIT_V(0);
    if constexpr (!ALIGN_EPI) { if (wr == 0) PG8_BAR; }
    PG8_BAR;
    if constexpr (Epi::AFTER_DRAIN) { E.fused(acc, cur, wr, wc, fr, fq, lds, wid, lane); S.done(cur); }
#undef PG8_SA
#undef PG8_SB
#undef PG8_STAGE
#undef PG8_LDA
#undef PG8_LDB
#undef PG8_MMA
#undef PG8_WAIT_V
#undef PG8_WAIT_L
#undef PG8_BAR
#undef PG8_SCHED
}
}
namespace attn {
typedef unsigned short bf16r;
constexpr int   D = 128, NW = 8, QBLK = 32, KVBLK = 64;
constexpr float SCALE = 0.088388347648318440f;
constexpr float THR = 8.f;
constexpr int LDQ = 1024, LDK = 256, LDO = 1024;
constexpr size_t SHM_V = KVBLK * D * 2, SHM_K = KVBLK * D * 2, SHM_ATTN = 2 * SHM_V + 2 * SHM_K + NW * 64 * 4;
using bf16x8 = __attribute__((ext_vector_type(8))) short;
using s16x4  = __attribute__((ext_vector_type(4))) short;
using f32x16 = __attribute__((ext_vector_type(16))) float;
using f32x8  = __attribute__((ext_vector_type(8))) float;
using u32x4  = __attribute__((ext_vector_type(4))) unsigned;
#define KSWZ(row, colB) ((row) * 256 + ((colB) ^ (((row) & 7) << 4)))
#define SBAR() __builtin_amdgcn_sched_barrier(0)
__device__ __forceinline__ int crow(int r, int hi) { return (r & 3) + 8 * (r >> 2) + 4 * hi; }
__device__ __forceinline__ unsigned cvtpk(float lo, float hi) {
  unsigned r; asm volatile("v_cvt_pk_bf16_f32 %0, %1, %2" : "=v"(r) : "v"(lo), "v"(hi)); return r;
}
__device__ __forceinline__ void partialSM(f32x16& p0, f32x16& p1, float& m_reg, float& mn, float& alpha) {
  constexpr float C = SCALE * 1.4426950408889634f;
  float pmax = p0[0]; for (int r = 1; r < 16; ++r) pmax = fmaxf(pmax, p0[r]); for (int r = 0; r < 16; ++r) pmax = fmaxf(pmax, p1[r]);
  { auto rr = __builtin_amdgcn_permlane32_swap(__float_as_uint(pmax), __float_as_uint(pmax), false, false);
    pmax = fmaxf(__uint_as_float(rr[0]), __uint_as_float(rr[1])); }
  if (__builtin_expect(__all(pmax - m_reg <= THR / SCALE), 1)) { mn = m_reg; alpha = 1.f; }
  else { mn = fmaxf(m_reg, pmax); alpha = __builtin_amdgcn_exp2f((m_reg - mn) * C); m_reg = mn; }
  float mnC = -mn * C;
  for (int r = 0; r < 16; ++r) p0[r] = fmaf(p0[r], C, mnC); for (int r = 0; r < 16; ++r) p1[r] = fmaf(p1[r], C, mnC);
  for (int r = 0; r < 16; ++r) p0[r] = __builtin_amdgcn_exp2f(p0[r]);
}
__device__ __forceinline__ void finishSM(f32x16& p0, f32x16& p1, float alpha, float& l_reg, bf16x8& pa0, bf16x8& pa1, bf16x8& pa2, bf16x8& pa3) {
  for (int r = 0; r < 16; ++r) p1[r] = __builtin_amdgcn_exp2f(p1[r]);
  float ps = 0; for (int r = 0; r < 16; ++r) ps += p0[r]; for (int r = 0; r < 16; ++r) ps += p1[r];
  { auto rr = __builtin_amdgcn_permlane32_swap(__float_as_uint(ps), __float_as_uint(ps), false, false);
    ps = __uint_as_float(rr[0]) + __uint_as_float(rr[1]); }
  l_reg = l_reg * alpha + ps;
#define PK4(P, BASE, OUT) do { unsigned a0 = cvtpk(P[BASE + 0], P[BASE + 1]), a1 = cvtpk(P[BASE + 2], P[BASE + 3]);   \
    unsigned b0 = cvtpk(P[BASE + 4], P[BASE + 5]), b1 = cvtpk(P[BASE + 6], P[BASE + 7]);                              \
    auto r0 = __builtin_amdgcn_permlane32_swap(a0, b0, false, false); auto r1 = __builtin_amdgcn_permlane32_swap(a1, b1, false, false); \
    u32x4 w = {r0[0], r1[0], r0[1], r1[1]}; OUT = *reinterpret_cast<bf16x8*>(&w); } while (0)
  PK4(p0, 0, pa0); PK4(p0, 8, pa1); PK4(p1, 0, pa2); PK4(p1, 8, pa3);
#undef PK4
}
__device__ __forceinline__ void qkt(f32x16& p0, f32x16& p1, const bf16r* Ks, const bf16x8* qr, int r32, int hi) {
  p0 = f32x16{}; p1 = f32x16{};
  for (int d0 = 0; d0 < 8; ++d0) { int cb = (d0 * 16 + hi * 8) * 2;
    bf16x8 b0 = *reinterpret_cast<const bf16x8*>((const char*)Ks + KSWZ(r32, cb));
    bf16x8 b1 = *reinterpret_cast<const bf16x8*>((const char*)Ks + KSWZ(32 + r32, cb));
    p0 = __builtin_amdgcn_mfma_f32_32x32x16_bf16(b0, qr[d0], p0, 0, 0, 0);
    p1 = __builtin_amdgcn_mfma_f32_32x32x16_bf16(b1, qr[d0], p1, 0, 0, 0); }
}
__device__ __forceinline__ int v_st(int k, int c) { const int kk = (k & ~0xC) | ((k & 4) << 1) | ((k & 8) >> 1); return ((kk >> 3) * 4 + (c >> 5)) * 512 + ((kk & 7) * 32 + (c & 31)) * 2; }
__device__ __forceinline__ int v_rd_base(int lane) { return ((lane & 3) << 3) | (((lane >> 2) & 3) << 6) | (((lane >> 4) & 1) << 5) | (((lane >> 5) & 1) << 8); }
constexpr int v_rd_off(int d0, int ks, int half) { return d0 * 512 + ks * 4096 + half * 2048; }
template <int OFF> __device__ __forceinline__ s16x4 tr_read(int vb) {
  s16x4 r; asm volatile("ds_read_b64_tr_b16 %0, %1 offset:%2" : "=&v"(r) : "v"(vb), "i"(OFF) : "memory"); return r;
}
template <int D0> __device__ __forceinline__ void pv_one(f32x16& od, int vb, bf16x8 pa0, bf16x8 pa1, bf16x8 pa2, bf16x8 pa3) {
  const s16x4 l0 = tr_read<v_rd_off(D0, 0, 0)>(vb), h0 = tr_read<v_rd_off(D0, 0, 1)>(vb), l1 = tr_read<v_rd_off(D0, 1, 0)>(vb), h1 = tr_read<v_rd_off(D0, 1, 1)>(vb);
  const s16x4 l2 = tr_read<v_rd_off(D0, 2, 0)>(vb), h2 = tr_read<v_rd_off(D0, 2, 1)>(vb), l3 = tr_read<v_rd_off(D0, 3, 0)>(vb), h3 = tr_read<v_rd_off(D0, 3, 1)>(vb);
  asm volatile("s_waitcnt lgkmcnt(0)" ::: "memory"); SBAR();
#define PK(L, H) (bf16x8){L[0], L[1], L[2], L[3], H[0], H[1], H[2], H[3]}
  od = __builtin_amdgcn_mfma_f32_32x32x16_bf16(pa0, PK(l0, h0), od, 0, 0, 0);
  od = __builtin_amdgcn_mfma_f32_32x32x16_bf16(pa1, PK(l1, h1), od, 0, 0, 0);
  od = __builtin_amdgcn_mfma_f32_32x32x16_bf16(pa2, PK(l2, h2), od, 0, 0, 0);
  od = __builtin_amdgcn_mfma_f32_32x32x16_bf16(pa3, PK(l3, h3), od, 0, 0, 0);
#undef PK
}
__device__ __forceinline__ void pv_d0(f32x16* o, int vb, bf16x8 pa0, bf16x8 pa1, bf16x8 pa2, bf16x8 pa3) {
  pv_one<0>(o[0], vb, pa0, pa1, pa2, pa3); pv_one<1>(o[1], vb, pa0, pa1, pa2, pa3); pv_one<2>(o[2], vb, pa0, pa1, pa2, pa3); pv_one<3>(o[3], vb, pa0, pa1, pa2, pa3);
}
constexpr float THRL = 8.f;
__device__ __forceinline__ void qkt2(f32x16& p0, f32x16& p1, const bf16r* Ks, const bf16x8* qr, float nm, int r32, int hi) {
  f32x16 negm;
#pragma unroll
  for (int r = 0; r < 16; ++r) negm[r] = nm;
#pragma unroll
  for (int d0 = 0; d0 < 8; ++d0) { int cb = (d0 * 16 + hi * 8) * 2;
    bf16x8 b0 = *reinterpret_cast<const bf16x8*>((const char*)Ks + KSWZ(r32, cb));
    bf16x8 b1 = *reinterpret_cast<const bf16x8*>((const char*)Ks + KSWZ(32 + r32, cb));
    if (d0 == 0) { p1 = __builtin_amdgcn_mfma_f32_32x32x16_bf16(b1, qr[0], negm, 0, 0, 0); p0 = __builtin_amdgcn_mfma_f32_32x32x16_bf16(b0, qr[0], negm, 0, 0, 0); }
    else { p0 = __builtin_amdgcn_mfma_f32_32x32x16_bf16(b0, qr[d0], p0, 0, 0, 0); p1 = __builtin_amdgcn_mfma_f32_32x32x16_bf16(b1, qr[d0], p1, 0, 0, 0); } }
}
__device__ __forceinline__ void partialSM2(f32x16& p0, f32x16& p1, float& mhat, float& alpha, bool first) {
  float a = __builtin_fmaxf(__builtin_fmaxf(p0[0], p0[1]), p1[0]), b = __builtin_fmaxf(__builtin_fmaxf(p0[2], p0[3]), p1[1]); a = __builtin_fmaxf(__builtin_fmaxf(a, p1[2]), p1[3]);
#pragma unroll
  for (int r = 4; r < 16; r += 4) { a = __builtin_fmaxf(__builtin_fmaxf(a, p0[r]), p0[r + 1]); b = __builtin_fmaxf(__builtin_fmaxf(b, p0[r + 2]), p0[r + 3]); a = __builtin_fmaxf(__builtin_fmaxf(a, p1[r]), p1[r + 1]); b = __builtin_fmaxf(__builtin_fmaxf(b, p1[r + 2]), p1[r + 3]); }
  float pmax = __builtin_fmaxf(a, b);
  { auto rr = __builtin_amdgcn_permlane32_swap(__float_as_uint(pmax), __float_as_uint(pmax), false, false); pmax = __builtin_fmaxf(__uint_as_float(rr[0]), __uint_as_float(rr[1])); }
  alpha = 1.f;
  if (first || __builtin_expect(__any(pmax > THRL), 0)) {
    const float dl = first ? pmax : __builtin_fmaxf(pmax, 0.f);
    mhat += dl;
#pragma unroll
    for (int r = 0; r < 16; ++r) { p0[r] -= dl; p1[r] -= dl; }
    if (!first) alpha = __builtin_amdgcn_exp2f(-dl);
  }
#pragma unroll
  for (int r = 0; r < 16; ++r) p0[r] = __builtin_amdgcn_exp2f(p0[r]);
}
__device__ __forceinline__ void mask_meta(f32x16& p0, f32x16& p1) {
  const float NEG = -INFINITY;
#pragma unroll
  for (int r = 8; r < 16; ++r) p0[r] = NEG;
#pragma unroll
  for (int r = 0; r < 16; ++r) p1[r] = NEG;
}
__device__ __forceinline__ unsigned short f2bf_rne(float f) { unsigned u = __builtin_bit_cast(unsigned, f); return (unsigned short)((u + 0x7fffu + ((u >> 16) & 1u)) >> 16); }

__device__ __forceinline__ void attn_unit(const bf16r* Qb, const bf16r* __restrict__ Kh, const bf16r* __restrict__ Vh,
                                          const bf16r* __restrict__ KMh, const bf16r* __restrict__ VMh, bf16r* Ob, int NT, char* lds,
                                          const float* __restrict__ qnorm, int t0) {
  int tid_ = threadIdx.x; asm volatile("" : "+v"(tid_));
  const int tid = tid_, wid = tid >> 6, lane = tid & 63, r32 = lane & 31, hi = lane >> 5;
  bf16r* V_lds = (bf16r*)lds; bf16r* K_lds = (bf16r*)(lds + 2 * SHM_V);
  float* ws = (float*)(lds + 2 * SHM_V + 2 * SHM_K) + wid * 64; float* li_l = ws; float* al_l = ws + 32;
  float mhat = 0.f, l_reg = 0; f32x16 o[4] = {}; bf16x8 qr[8];
  const bf16r* Qw = Qb + (long)(wid * QBLK + r32) * LDQ + hi * 8;
#pragma unroll
  for (int d0 = 0; d0 < 8; ++d0) qr[d0] = *reinterpret_cast<const bf16x8*>(Qw + d0 * 16);
  {
    float ss = 0.f;
#pragma unroll
    for (int d0 = 0; d0 < 8; ++d0)
#pragma unroll
      for (int j = 0; j < 8; ++j) { const float x = __builtin_bit_cast(float, (unsigned)(unsigned short)qr[d0][j] << 16); ss += x * x; }
    { auto rr = __builtin_amdgcn_permlane32_swap(__float_as_uint(ss), __float_as_uint(ss), false, false); ss = __uint_as_float(rr[0]) + __uint_as_float(rr[1]); }
    const float rs = (SCALE * 1.4426950408889634f) / sqrtf(ss * (1.f / 128.f) + 1e-6f);
    int t = t0 + wid * QBLK + r32; int hio = hi; asm volatile("" : "+v"(t), "+v"(hio));
#pragma unroll
    for (int g = 0; g < 4; ++g) {
      const int p = g >> 1, dd = g & 1, fa = 4 * p + dd, fb = fa + 2; const float pos = (float)(p ? (t & 63) : (t >> 6));
      const float4 ga0 = *reinterpret_cast<const float4*>(qnorm + fa * 16 + hi * 8), ga1 = *reinterpret_cast<const float4*>(qnorm + fa * 16 + hi * 8 + 4);
      const float4 gb0 = *reinterpret_cast<const float4*>(qnorm + fb * 16 + hi * 8), gb1 = *reinterpret_cast<const float4*>(qnorm + fb * 16 + hi * 8 + 4);
      const float gaf[8] = {ga0.x, ga0.y, ga0.z, ga0.w, ga1.x, ga1.y, ga1.z, ga1.w}, gbf[8] = {gb0.x, gb0.y, gb0.z, gb0.w, gb1.x, gb1.y, gb1.z, gb1.w};
      float oa[8], ob[8];
#pragma unroll
      for (int j = 0; j < 8; ++j) { const int i = 16 * dd + 8 * hio + j;
        float rev = pos * __builtin_amdgcn_exp2f(-(float)i * (13.287712379549449f / 32.f)) * 0.15915494309189535f; rev -= floorf(rev);
        const float sn = __builtin_amdgcn_sinf(rev), cs = __builtin_amdgcn_cosf(rev);
        const float x1 = __builtin_bit_cast(float, (unsigned)(unsigned short)qr[fa][j] << 16) * rs * gaf[j], x2 = __builtin_bit_cast(float, (unsigned)(unsigned short)qr[fb][j] << 16) * rs * gbf[j];
        oa[j] = x1 * cs - x2 * sn; ob[j] = x2 * cs + x1 * sn; }
      { u32x4 w = {cvtpk(oa[0], oa[1]), cvtpk(oa[2], oa[3]), cvtpk(oa[4], oa[5]), cvtpk(oa[6], oa[7])}; qr[fa] = *reinterpret_cast<bf16x8*>(&w); }
      { u32x4 w = {cvtpk(ob[0], ob[1]), cvtpk(ob[2], ob[3]), cvtpk(ob[4], ob[5]), cvtpk(ob[6], ob[7])}; qr[fb] = *reinterpret_cast<bf16x8*>(&w); }
      SBAR();
    }
  }
  const int sr = tid >> 4, sc = (tid & 15) * 8, vst0 = v_st(sr, sc), vst1 = v_st(32 + sr, sc);
  const int vb0 = (int)(uintptr_t)V_lds + v_rd_base(lane);
  struct { bf16x8 vs0, vs1, ks0, ks1; } sr_[2];
#define LD8(p) (*reinterpret_cast<const bf16x8*>(p))
#define SLOAD(i, t) do { const bool last_ = ((t) == NT - 1); const bf16r* kp_ = last_ ? KMh : Kh + (long)(t) * KVBLK * LDK; const bf16r* vp_ = last_ ? VMh : Vh + (long)(t) * KVBLK * LDK; \
    sr_[i].vs0 = LD8(&vp_[(long)(sr) * LDK + sc]); sr_[i].vs1 = LD8(&vp_[(long)(32 + sr) * LDK + sc]); \
    sr_[i].ks0 = LD8(&kp_[(long)(sr) * LDK + sc]); sr_[i].ks1 = LD8(&kp_[(long)(32 + sr) * LDK + sc]); } while (0)
#define SWRITE(b, i) do { *(bf16x8*)((char*)V_lds + (b) * SHM_V + vst0) = sr_[i].vs0;          \
    *(bf16x8*)((char*)V_lds + (b) * SHM_V + vst1) = sr_[i].vs1; int kc = sc * 2;               \
    *(bf16x8*)((char*)K_lds + (b) * SHM_K + KSWZ(sr, kc)) = sr_[i].ks0;                       \
    *(bf16x8*)((char*)K_lds + (b) * SHM_K + KSWZ(32 + sr, kc)) = sr_[i].ks1; } while (0)
#define SWAIT() asm volatile("s_waitcnt vmcnt(4)" ::: "memory")
#define RESC(a) do { if (__any((a) < 1.f)) { if (hi == 0) al_l[r32] = (a); asm volatile("s_waitcnt lgkmcnt(0)" ::: "memory"); \
    _Pragma("unroll") for (int r = 0; r < 16; ++r) { const float a_ = al_l[crow(r, hi)]; o[0][r] *= a_; o[1][r] *= a_; o[2][r] *= a_; o[3][r] *= a_; asm volatile("" : "+v"(o[0][r]), "+v"(o[1][r]), "+v"(o[2][r]), "+v"(o[3][r])); } } } while (0)
  f32x16 pA0, pA1, pB0, pB1; float alA, alB; bf16x8 pa0, pa1, pa2, pa3;
  constexpr int SE = 0, SO = 1;
  SLOAD(SE, 0); asm volatile("s_waitcnt vmcnt(0)" ::: "memory"); SWRITE(0, SE); __syncthreads();
  qkt2(pA0, pA1, K_lds, qr, -mhat, r32, hi); partialSM2(pA0, pA1, mhat, alA, true);
  SLOAD(SO, 1); SLOAD(SE, 2);
  SWAIT(); SWRITE(1, SO); __syncthreads();
  for (int j = 1; j + 1 < NT; j += 2) {
    SBAR(); qkt2(pB0, pB1, (bf16r*)((char*)K_lds + SHM_K), qr, -mhat, r32, hi);
    finishSM(pA0, pA1, alA, l_reg, pa0, pa1, pa2, pa3); SBAR();
    if (j + 2 < NT) SLOAD(SO, j + 2); SBAR();
    pv_d0(o, vb0, pa0, pa1, pa2, pa3); partialSM2(pB0, pB1, mhat, alB, false);
    __syncthreads(); SWAIT(); SWRITE(0, SE);
    RESC(alB); __syncthreads();
    SBAR(); qkt2(pA0, pA1, K_lds, qr, -mhat, r32, hi);
    if (j + 2 == NT) mask_meta(pA0, pA1);
    finishSM(pB0, pB1, alB, l_reg, pa0, pa1, pa2, pa3); SBAR();
    if (j + 3 < NT) SLOAD(SE, j + 3); SBAR();
    pv_d0(o, vb0 + (int)SHM_V, pa0, pa1, pa2, pa3); partialSM2(pA0, pA1, mhat, alA, false);
    __syncthreads(); SWAIT(); if (j + 2 < NT) SWRITE(1, SO);
    RESC(alA); __syncthreads();
  }
  finishSM(pA0, pA1, alA, l_reg, pa0, pa1, pa2, pa3); SBAR();
  pv_d0(o, vb0, pa0, pa1, pa2, pa3);
  if (hi == 0) li_l[r32] = l_reg; asm volatile("s_waitcnt lgkmcnt(0)" ::: "memory");
  float rli[16];
#pragma unroll
  for (int r = 0; r < 16; ++r) rli[r] = __builtin_amdgcn_rcpf(li_l[crow(r, hi)]);
  bf16r* Ow = Ob + (long)(wid * QBLK) * LDO;
#pragma unroll
  for (int r = 0; r < 16; ++r) { const int orow = crow(r, hi);
#pragma unroll
    for (int d0 = 0; d0 < 4; ++d0) Ow[(long)orow * LDO + d0 * 32 + r32] = f2bf_rne(o[d0][r] * rli[r]); }
  __syncthreads();
#undef LD8
#undef SLOAD
#undef SWRITE
#undef SWAIT
#undef RESC
}
#undef KSWZ
#undef SBAR
}

constexpr int NWAVES = 8;
constexpr int DM = 2048, NTOK = 65536, INW = 3584, FFN = 5632, UPW = 2 * FFN;
constexpr float EPS = 1e-6f;
constexpr int XR_ROWS = 8 * 4160 + 4 * 8256;
constexpr int NCHUNK = 8 * 65 + 4 * 129;
constexpr int HROWS = 32768;
__host__ __device__ __forceinline__ int seq_first_row(int s) { return s < 8 ? s * 4096 : 32768 + (s - 8) * 8192; }
__host__ __device__ __forceinline__ int seq_len(int s) { return s < 8 ? 4096 : 8192; }
__host__ __device__ __forceinline__ int xr_base(int s) { return s < 8 ? s * 4160 : 33280 + (s - 8) * 8256; }
__host__ __device__ __forceinline__ int chunk_base(int s) { return s < 8 ? s * 65 : 520 + (s - 8) * 129; }
__host__ __device__ __forceinline__ int row_seq(int row) { return row < 32768 ? (row >> 12) : 8 + ((row - 32768) >> 13); }

constexpr size_t MiB = 1u << 20, KiB = 1u << 10;
constexpr size_t WS_CTL = 0, CTL_ZERO_BYTES = 1 * MiB;
constexpr size_t WS_SMALL = 1 * MiB;
constexpr size_t WS_XNMETA = WS_SMALL + 0, WS_ZM = WS_SMALL + 64 * KiB, WS_KM = WS_SMALL + 320 * KiB, WS_VM = WS_SMALL + 352 * KiB, WS_Q15 = WS_SMALL + 384 * KiB, WS_GY15 = WS_SMALL + 388 * KiB,
                 WS_LO15 = WS_SMALL + 392 * KiB, WS_MIXED15 = WS_SMALL + 448 * KiB, WS_Y15 = WS_SMALL + 544 * KiB, WS_G15 = WS_SMALL + 640 * KiB, WS_MQP = WS_SMALL + 1024 * KiB;
constexpr size_t WS_WIN = 5 * MiB, WS_WOUT = 19 * MiB, WS_WUP = 27 * MiB, WS_WDOWN = 71 * MiB, WS_WG = 93 * MiB;
constexpr size_t WS_CAR = 94 * MiB, WS_CIN = 111 * MiB;
constexpr size_t WS_A = 120 * MiB;
constexpr size_t WS_B = 376 * MiB;
constexpr size_t WS_Q = WS_B, WS_K = WS_B + 128 * MiB, WS_V = WS_B + 160 * MiB, WS_XR = WS_B + 192 * MiB, WS_GY = WS_B + 322 * MiB;
constexpr size_t WS_Y1 = WS_B, WS_ACT = WS_B, WS_EDGE = WS_B + 352 * MiB;
constexpr size_t WS_END = WS_B + 528 * MiB;
static_assert(WS_ZM + 16 * INW * 4 <= WS_KM && WS_G15 + 12 * FFN * 4 <= WS_MQP && WS_MQP + 512 * 4 * 132 * 4 <= WS_WIN, "small map");
static_assert(WS_WIN + (size_t)INW * DM * 2 <= WS_WOUT && WS_WOUT + (size_t)DM * DM * 2 <= WS_WUP && WS_WUP + (size_t)UPW * DM * 2 <= WS_WDOWN && WS_WDOWN + (size_t)DM * FFN * 2 <= WS_WG && WS_WG + 32 * 16384 * 2 <= WS_CAR, "weights map");
static_assert(WS_CAR + (size_t)NCHUNK * 2 * 1024 * 8 <= WS_CIN && WS_CIN + (size_t)NCHUNK * 2 * 1024 * 4 <= WS_A && WS_A + (size_t)NTOK * DM * 2 <= WS_B, "carry map");
static_assert(WS_XR + (size_t)(XR_ROWS + 64) * 1024 * 2 <= WS_GY && WS_GY + (size_t)NTOK * 1024 * 2 <= WS_END && WS_ACT + (size_t)HROWS * FFN * 2 <= WS_EDGE && WS_EDGE + (size_t)512 * 2 * 3 * FFN * 4 <= WS_END, "B map");
constexpr int CW_BAR = 4096;

constexpr int RING_BYTES = 131072;
constexpr int LDSCTL_OFF = RING_BYTES, MISC_OFF = LDSCTL_OFF + 320;
constexpr int LDS_BYTES = 147456;

#define GAS __attribute__((address_space(1)))
#define LAS __attribute__((address_space(3)))
typedef unsigned short bf16;
typedef unsigned v4u __attribute__((ext_vector_type(4)));
typedef float f32x4 __attribute__((ext_vector_type(4)));
typedef short bf16x8 __attribute__((ext_vector_type(8)));
typedef GAS unsigned gu32;
typedef GAS unsigned long long gu64;
#define RLX_AGENT __ATOMIC_RELAXED, __HIP_MEMORY_SCOPE_AGENT
#define LDS_WAIT() asm volatile("s_waitcnt lgkmcnt(0)" ::: "memory")
#define VM_WAIT() asm volatile("s_waitcnt vmcnt(0)" ::: "memory")
__device__ __forceinline__ unsigned long long rt() { return __builtin_amdgcn_s_memrealtime(); }
__device__ __forceinline__ unsigned f2bf(float f) { unsigned u = __builtin_bit_cast(unsigned, f); return (u + 0x7fffu + ((u >> 16) & 1u)) >> 16; }
__device__ __forceinline__ unsigned pk2(float lo, float hi) { return f2bf(lo) | (f2bf(hi) << 16); }

#define XB_TMO      128
#define XB_XCNT(j)  (256  + 64 * (j))
#define XB_XSUB(j)  (1280 + 64 * (j))
#define XB_XGEN(j)  (2304 + 64 * (j))
#define XB_TOP      3328
#define XB_TOPGEN   3392
#define XCD_BAR_WORDS 3456
#define XB_SPIN_CAP (1u << 18)

__device__ __forceinline__ unsigned xb_ld(unsigned* p)              { return __hip_atomic_load(p, __ATOMIC_RELAXED, __HIP_MEMORY_SCOPE_AGENT); }
__device__ __forceinline__ unsigned xb_add(unsigned* p, unsigned v) { return __hip_atomic_fetch_add(p, v, __ATOMIC_RELAXED, __HIP_MEMORY_SCOPE_AGENT); }
__device__ __forceinline__ unsigned xb_xcc_id() { return (unsigned)__builtin_amdgcn_s_getreg((3 << 11) | 20) & 0xFu; }
#define XB_SPIN(cond, bar) do { unsigned _sp = 0; while (cond) { __builtin_amdgcn_s_sleep(1); \
    if ((++_sp & 255u) == 0u) { if (xb_ld(&(bar)[XB_TMO])) break; if (_sp > XB_SPIN_CAP) { atomicAdd(&(bar)[XB_TMO], 1u); break; } } } } while (0)

struct XcdBarrier {
    unsigned* bar; unsigned x;
    volatile LAS unsigned* st;
};

__device__ __forceinline__ XcdBarrier xcd_barrier_post(unsigned* bar, volatile LAS unsigned* st) {
    XcdBarrier b; b.bar = bar; b.x = xb_xcc_id(); b.st = st;
    if (threadIdx.x == 0) (void)xb_add(&bar[XB_XCNT(b.x)], 1u);
    return b;
}
__device__ __forceinline__ void xcd_barrier_complete(unsigned* bar, unsigned x, unsigned& nloc, unsigned& nx) {
    const unsigned G = gridDim.x * gridDim.y * gridDim.z;
    unsigned sum, cnt, mine, sp = 0u;
    for (;;) {
        sum = 0u; cnt = 0u; mine = 0u;
#pragma unroll
        for (unsigned j = 0; j < 16; ++j) { const unsigned c = xb_ld(&bar[XB_XCNT(j)]); sum += c; cnt += (c > 0u) ? 1u : 0u; mine = (j == x) ? c : mine; }
        if (sum == G) break;
        __builtin_amdgcn_s_sleep(1);
        if ((++sp & 255u) == 0u) { if (xb_ld(&bar[XB_TMO])) break; if (sp > XB_SPIN_CAP) { atomicAdd(&bar[XB_TMO], 1u); break; } }
    }
    nloc = mine > 0u ? mine : 1u; nx = cnt > 0u ? cnt : 1u;
}

__device__ __forceinline__ void xcd_barrier(const XcdBarrier& b) {
    asm volatile("s_waitcnt vmcnt(0)" ::: "memory");
    __syncthreads();
    if (threadIdx.x == 0) {
        unsigned* bar = b.bar;
        __builtin_amdgcn_s_waitcnt(0);
        unsigned nloc = b.st[0], nx = b.st[1];
        if (nloc == 0u) { xcd_barrier_complete(bar, b.x, nloc, nx); b.st[0] = nloc; b.st[1] = nx; }
        const unsigned old = xb_add(&bar[XB_XSUB(b.x)], 1u);
        const unsigned gen = old / nloc;
        if (old + 1u == (gen + 1u) * nloc) {
            __builtin_amdgcn_fence(__ATOMIC_RELEASE, "agent");
            asm volatile("s_waitcnt vmcnt(0)" ::: "memory");
            const unsigned og = xb_add(&bar[XB_TOP], 1u);
            const unsigned tg = og / nx;
            if (og + 1u == (tg + 1u) * nx) xb_add(&bar[XB_TOPGEN], 1u);
            else XB_SPIN(xb_ld(&bar[XB_TOPGEN]) == tg, bar);
            __builtin_amdgcn_fence(__ATOMIC_ACQUIRE, "agent");
            xb_add(&bar[XB_XGEN(b.x)], 1u);
            asm volatile("s_waitcnt vmcnt(0)" ::: "memory");
        } else {
            XB_SPIN(xb_ld(&bar[XB_XGEN(b.x)]) == gen, bar);
            __builtin_amdgcn_fence(__ATOMIC_ACQUIRE, "agent");
            asm volatile("s_waitcnt vmcnt(0)" ::: "memory");
        }
    }
    __syncthreads();
}

__device__ __forceinline__ float bf2f(unsigned short b) { return __builtin_bit_cast(float, (unsigned)b << 16); }
__device__ __forceinline__ float bf2f(short b) { return __builtin_bit_cast(float, (unsigned)(unsigned short)b << 16); }
__device__ __forceinline__ float wave_sum(float v) {
#pragma unroll
    for (int o = 1; o < 64; o <<= 1) v += __shfl_xor(v, o);
    return v;
}
__device__ __forceinline__ float wave_max(float v) {
#pragma unroll
    for (int o = 1; o < 64; o <<= 1) v = fmaxf(v, __shfl_xor(v, o));
    return v;
}
__device__ __forceinline__ float fast_exp(float x) { return __builtin_amdgcn_exp2f(x * 1.4426950408889634f); }
__device__ __forceinline__ float sigmoidf_(float x) { return __builtin_amdgcn_rcpf(1.f + fast_exp(-x)); }
__device__ __forceinline__ float gelu_tanh(float x) {
    const float z = 0.7978845608028654f * (x + 0.044715f * x * x * x);
    return x * sigmoidf_(2.f * z);
}
__device__ __forceinline__ float neg_expm1(float x) {
    const float p = x * (1.f + x * (0.5f + x * (0.16666667f + x * (0.041666668f + x * (0.0083333338f + x * 0.0013888889f)))));
    const float e = fast_exp(x) - 1.f;
    return -(fabsf(x) < 0.25f ? p : e);
}
__device__ __forceinline__ v4u pack8(const float (&v)[8]) { v4u o; o.x = pk2(v[0], v[1]); o.y = pk2(v[2], v[3]); o.z = pk2(v[4], v[5]); o.w = pk2(v[6], v[7]); return o; }

#define FIN(F, idx) ({ const __attribute__((address_space(1))) float* p_; asm("s_load_dwordx2 %0, %1, %2 ; tag %3\n\ts_waitcnt lgkmcnt(0)" : "=s"(p_) : "s"((F).kargs), "i"((idx) * 8), "s"((F).ptag)); (const float*)p_; })
struct Frame {
    LAS unsigned char* lds;
    volatile LAS unsigned* MISC;
    gu32* ctl;
    int tid, lane, wave, vcu, G;
    const __attribute__((address_space(4))) void* kargs; int ptag;
    float* out;
    unsigned char* ws;
#define WSP(T, NAME, OFF) __device__ __forceinline__ T* NAME() const { return (T*)(ws + (OFF)); }
    WSP(bf16, WIN_T, WS_WIN) WSP(bf16, WOUT_T, WS_WOUT) WSP(bf16, WUP_T, WS_WUP) WSP(bf16, WDOWN_T, WS_WDOWN) WSP(bf16, WG, WS_WG) WSP(bf16, XN, WS_A) WSP(bf16, Q, WS_Q) WSP(bf16, K, WS_K) WSP(bf16, V, WS_V)
    WSP(bf16, XR, WS_XR) WSP(bf16, GY, WS_GY) WSP(bf16, Y1, WS_Y1) WSP(bf16, ACT, WS_ACT) WSP(float, EDGE, WS_EDGE) WSP(bf16, XNMETA, WS_XNMETA) WSP(bf16, KM, WS_KM) WSP(bf16, VM, WS_VM)
    WSP(float, ZM, WS_ZM) WSP(float, Q15, WS_Q15) WSP(float, GY15, WS_GY15) WSP(float, LO15, WS_LO15) WSP(float, MIXED15, WS_MIXED15) WSP(float, Y15, WS_Y15) WSP(float, G15, WS_G15) WSP(float, MQP, WS_MQP)
    WSP(float, CIN, WS_CIN) WSP(float2, CAR, WS_CAR)
#undef WSP
};

template <bool UPMAP>
__device__ __forceinline__ void p0_transpose_item(const float* W, int K, int N, bf16* WT, int row_off, LAS float* scr, int item, int lane) {
    const int nblk = N / 32, kb = item / nblk, nb = item % nblk, k0 = 64 * kb, n0 = 32 * nb;
    const int orow0 = UPMAP ? (((n0 % FFN) >> 7) << 8) + 128 * (n0 / FFN) + ((n0 % FFN) & 127) : row_off + n0;
#pragma unroll 8
    for (int i = 0; i < 32; ++i) { const int kk = 2 * i + (lane >> 5); scr[kk * 33 + (lane & 31)] = W[(size_t)(k0 + kk) * N + n0 + (lane & 31)]; }
    LDS_WAIT(); asm volatile("" ::: "memory");
    const int c = lane & 7;
#pragma unroll
    for (int j = 0; j < 4; ++j) { const int n = (lane >> 3) + 8 * j; const LAS float* s = scr + (8 * c) * 33 + n;
        v4u o; o.x = pk2(s[0 * 33], s[1 * 33]); o.y = pk2(s[2 * 33], s[3 * 33]); o.z = pk2(s[4 * 33], s[5 * 33]); o.w = pk2(s[6 * 33], s[7 * 33]);
        *(GAS v4u*)(WT + (size_t)(orow0 + n) * K + k0 + 8 * c) = o; }
    LDS_WAIT(); asm volatile("" ::: "memory");
}
__device__ __forceinline__ void rms_row_to_bf16(const float* xrow, const float* g, bf16* orow, int lane) {
    const GAS f32x4* xr = (const GAS f32x4*)xrow + lane;
    f32x4 v[8]; float s = 0.f;
#pragma unroll
    for (int j = 0; j < 8; ++j) { v[j] = xr[64 * j]; s += (v[j].x * v[j].x + v[j].y * v[j].y) + (v[j].z * v[j].z + v[j].w * v[j].w); }
    const float r = 1.f / sqrtf(wave_sum(s) * (1.f / DM) + EPS);
    const GAS f32x4* gr = (const GAS f32x4*)g + lane;
    GAS unsigned long long* o8 = (GAS unsigned long long*)orow + lane;
#pragma unroll
    for (int j = 0; j < 8; ++j) { const f32x4 gg = gr[64 * j];
        o8[64 * j] = (unsigned long long)pk2(v[j].x * r * gg.x, v[j].y * r * gg.y) | ((unsigned long long)pk2(v[j].z * r * gg.z, v[j].w * r * gg.w) << 32); }
}
__device__ __forceinline__ void p0_prologue(Frame& F) {
    LAS float* scr = (LAS float*)(F.lds + F.wave * 16384);
    const int gw = F.vcu * NWAVES + F.wave, NGW = F.G * NWAVES;
    constexpr int I_IN = (DM / 64) * (INW / 32), I_OUT = (DM / 64) * (DM / 32), I_UP = (DM / 64) * (UPW / 32), I_DN = (FFN / 64) * (DM / 32), I_G = 32 * 8;
    constexpr int NITEMS = I_IN + I_OUT + I_UP + I_DN + I_G;
    for (int it = gw; it < NITEMS; it += NGW) {
        int r = it;
        if (r < I_IN) { p0_transpose_item<false>(FIN(F, 4  ), DM, INW, F.WIN_T(), 0, scr, r, F.lane); continue; } r -= I_IN;
        if (r < I_OUT) { p0_transpose_item<false>(FIN(F, 16  ), DM, DM, F.WOUT_T(), 0, scr, r, F.lane); continue; } r -= I_OUT;
        if (r < I_UP) { p0_transpose_item<true>(FIN(F, 19  ), DM, UPW, F.WUP_T(), 0, scr, r, F.lane); continue; } r -= I_UP;
        if (r < I_DN) { p0_transpose_item<false>(FIN(F, 22  ), FFN, DM, F.WDOWN_T(), 0, scr, r, F.lane); continue; } r -= I_DN;
        {
            const int mi = r >> 3, sub = r & 7, gate = mi >> 4, dir = (mi >> 3) & 1, blk = mi & 7;
            const float* W = (gate ? FIN(F, 11  ) : FIN(F, 9  )) + (size_t)(dir * 8 + blk) * 16384;
            bf16* WT = F.WG() + (size_t)((dir * 2 + gate) * 8 + blk) * 16384;
            p0_transpose_item<false>(W, 128, 128, WT, 0, scr, sub, F.lane);
        }
    }
    for (int m = gw; m < NTOK; m += NGW) {
        const float* xr = m < 32768 ? FIN(F, 0  ) + (size_t)m * DM : FIN(F, 1  ) + (size_t)(m - 32768) * DM;
        rms_row_to_bf16(xr, FIN(F, 3  ), F.XN() + (size_t)m * DM, F.lane);
    }
    for (int m = gw; m < 16; m += NGW) rms_row_to_bf16(FIN(F, 2  ) + (size_t)m * DM, FIN(F, 3  ), F.XNMETA() + (size_t)m * DM, F.lane);
    const int gt = F.vcu * 512 + F.tid, NGT = F.G * 512; const v4u z4 = {0u, 0u, 0u, 0u};
    for (int i = gt; i < 12 * 48 * 128; i += NGT) { const int s = i / (48 * 128), rem = i % (48 * 128); ((GAS v4u*)(F.XR() + (size_t)xr_base(s) * 1024))[rem] = z4; }
    for (int i = gt; i < 64 * 128; i += NGT) ((GAS v4u*)(F.XR() + (size_t)XR_ROWS * 1024))[i] = z4;
    for (int i = gt; i < 2048; i += NGT) { ((GAS v4u*)F.KM())[i] = z4; ((GAS v4u*)F.VM())[i] = z4; }
}

template <int R, class Out, bool GMAP = false>
__device__ __forceinline__ void small_gemm(const LAS float* X, int K, const bf16* Wt, int N, int gw, int NGW, int lane, const Out& out) {
    for (int n = gw; n < N; n += NGW) {
        float acc[R];
#pragma unroll
        for (int r = 0; r < R; ++r) acc[r] = 0.f;
        const GAS bf16x8* wrow = (const GAS bf16x8*)(Wt + (size_t)(GMAP ? ((n >> 7) << 8) + (n & 127) : n) * K);
        for (int k8 = lane; k8 < K / 8; k8 += 64) {
            const bf16x8 w = wrow[k8]; float wf[8];
#pragma unroll
            for (int j = 0; j < 8; ++j) wf[j] = bf2f(w[j]);
#pragma unroll
            for (int r = 0; r < R; ++r) { const LAS f32x4* xp = (const LAS f32x4*)(X + r * K + k8 * 8); const f32x4 a = xp[0], b = xp[1];
                acc[r] += (a.x * wf[0] + a.y * wf[1]) + (a.z * wf[2] + a.w * wf[3]) + (b.x * wf[4] + b.y * wf[5]) + (b.z * wf[6] + b.w * wf[7]); }
        }
        float v = 0.f;
#pragma unroll
        for (int r = 0; r < R; ++r) { const float s = wave_sum(acc[r]); v = (lane == r) ? s : v; }
        out(n, lane, v);
    }
}
struct OutMetaZ { float* ZM; bf16* XR;
    __device__ __forceinline__ void operator()(int n, int lane, float v) const {
        if (lane < 16) { ZM[lane * INW + n] = v;
            if (n >= 1536 && n < 2560) { const unsigned short b = (unsigned short)f2bf(v); const int c = n - 1536;
                for (int s = 0; s < 12; ++s) XR[(size_t)(xr_base(s) + 48 + lane) * 1024 + c] = b; } }
    } };
struct OutRows { float* Y; int ld; int R;
    __device__ __forceinline__ void operator()(int n, int lane, float v) const { if (lane < R) Y[(size_t)lane * ld + n] = v; } };

__device__ __forceinline__ void p1_meta_z(Frame& F) {
    LAS float* X = (LAS float*)F.lds;
    for (int i = F.tid; i < 16 * DM / 8; i += 512) { const bf16x8 v = ((const GAS bf16x8*)F.XNMETA())[i];
        ((LAS f32x4*)X)[2 * i] = (f32x4){bf2f(v[0]), bf2f(v[1]), bf2f(v[2]), bf2f(v[3])}; ((LAS f32x4*)X)[2 * i + 1] = (f32x4){bf2f(v[4]), bf2f(v[5]), bf2f(v[6]), bf2f(v[7])}; }
    __syncthreads();
    const OutMetaZ o{F.ZM(), F.XR()};
    small_gemm<16, OutMetaZ>(X, DM, F.WIN_T(), INW, F.vcu * NWAVES + F.wave, F.G * NWAVES, F.lane, o);
    __syncthreads();
}
typedef float f32x16 __attribute__((ext_vector_type(16)));
constexpr int LRU_XC0 = 0, LRU_XC_BUF = 17408, LRU_XC_STRIDE = 272;
constexpr int LRU_CW = 34816;
constexpr int LRU_HF = 37376, LRU_HB = LRU_HF + 32768;
__device__ __forceinline__ int crow16(int r, int hi) { return (r & 3) + 8 * (r >> 2) + 4 * hi; }

template <int DIR>
__device__ __forceinline__ void scan_tile(const float (&a)[16], const float (&u)[16], float& carry, float& ptot, float (&h)[16], bool up) {
    float HL[16], PL[16], As[4], Hs[4];
#pragma unroll
    for (int j = 0; j < 4; ++j) {
        float hl = 0.f, p = 1.f;
#pragma unroll
        for (int ii = 0; ii < 4; ++ii) { const int idx = 4 * j + (DIR == 0 ? ii : 3 - ii); hl = a[idx] * hl + u[idx]; p *= a[idx]; HL[idx] = hl; PL[idx] = p; }
        As[j] = p; Hs[j] = hl;
    }
    float Alo[4], Ahi[4], Hlo[4], Hhi[4];
#pragma unroll
    for (int j = 0; j < 4; ++j) {
        { const unsigned x = __float_as_uint(As[j]); auto rr = __builtin_amdgcn_permlane32_swap(x, x, false, false); Alo[j] = __uint_as_float(rr[0]); Ahi[j] = __uint_as_float(rr[1]); }
        { const unsigned x = __float_as_uint(Hs[j]); auto rr = __builtin_amdgcn_permlane32_swap(x, x, false, false); Hlo[j] = __uint_as_float(rr[0]); Hhi[j] = __uint_as_float(rr[1]); }
    }
    float cin[4]; float c = carry;
    if (DIR == 0) {
#pragma unroll
        for (int j = 0; j < 4; ++j) { const float c_lo = c; c = Alo[j] * c + Hlo[j]; const float c_hi = c; c = Ahi[j] * c + Hhi[j]; cin[j] = up ? c_hi : c_lo; }
    } else {
#pragma unroll
        for (int j = 3; j >= 0; --j) { const float c_hi = c; c = Ahi[j] * c + Hhi[j]; const float c_lo = c; c = Alo[j] * c + Hlo[j]; cin[j] = up ? c_hi : c_lo; }
    }
    carry = c;
#pragma unroll
    for (int j = 0; j < 4; ++j) ptot *= Alo[j] * Ahi[j];
#pragma unroll
    for (int idx = 0; idx < 16; ++idx) h[idx] = HL[idx] + PL[idx] * cin[idx >> 2];
}

__device__ __forceinline__ void lru_decode(int cg, int& seq, int& c) { if (cg < 520) { seq = cg / 65; c = cg - seq * 65; } else { const int c2 = cg - 520; seq = c2 / 129; c = c2 - seq * 129; seq += 8; } }
template <int PASS>
__device__ __forceinline__ void lru_phase(Frame& F, bf16* gout) {
    LAS unsigned char* L = F.lds;
    const int tid = F.tid, lane = F.lane, wave = F.wave;
    const int n = F.vcu & 7, ngrp = F.G >> 3;
    { const float* cw = FIN(F, 7  ); const float* cb = FIN(F, 8  );
      for (int i = tid; i < 640; i += 512) { const int k = i >> 7, ch = i & 127; ((LAS float*)(L + LRU_CW))[i] = k < 4 ? cw[k * 1024 + n * 128 + ch] : cb[n * 128 + ch]; } }
    const int d = wave >> 2, g4 = wave & 3, r32 = lane & 31, hi = lane >> 5, chl = g4 * 32 + r32, chg = n * 128 + chl;
    bf16x8 br[8], bi[8];
    { const bf16* wr_ = F.WG() + (size_t)((d * 2 + 0) * 8 + n) * 16384 + chl * 128 + hi * 8;
      const bf16* wi_ = F.WG() + (size_t)((d * 2 + 1) * 8 + n) * 16384 + chl * 128 + hi * 8;
#pragma unroll
      for (int ks = 0; ks < 8; ++ks) { br[ks] = *(const GAS bf16x8*)(wr_ + ks * 16); bi[ks] = *(const GAS bf16x8*)(wi_ + ks * 16); } }
    constexpr float L2E = 1.4426950408889634f;
    const float nb_r = -L2E * FIN(F, 10  )[d * 1024 + chg], nb_i = -L2E * FIN(F, 12  )[d * 1024 + chg];
    const float spl = 8.f * L2E * log1pf(expf(-FIN(F, 13  )[d * 1024 + chg]));
    const int tau0 = tid >> 4, co = (tid & 15) * 8;
    bf16x8 xv[2][4];
#define LRU_PREFETCH(cgx) do { int s_, c_; lru_decode((cgx), s_, c_); const int xb_ = xr_base(s_); \
        _Pragma("unroll") for (int it_ = 0; it_ < 2; ++it_) _Pragma("unroll") for (int k_ = 0; k_ < 4; ++k_) { int row_ = xb_ + c_ * 64 + tau0 + 32 * it_ + k_ - 2; row_ = row_ < 0 ? 0 : row_; \
            xv[it_][k_] = *(const GAS bf16x8*)(F.XR() + (size_t)row_ * 1024 + n * 128 + co); } } while (0)
    int cg = F.vcu >> 3;
    if (cg < NCHUNK) LRU_PREFETCH(cg);
    __syncthreads();
    for (int ui = 0; cg < NCHUNK; cg += ngrp, ++ui) {
        int seq, c; lru_decode(cg, seq, c);
        LAS unsigned char* XC = L + LRU_XC0 + (ui & 1) * LRU_XC_BUF;
        float carry = 0.f, ptot = 1.f;
        if (PASS == 2) carry = F.CIN()[((size_t)cg * 2 + d) * 1024 + chg];
#pragma unroll
        for (int it = 0; it < 2; ++it) {
            const int tau = tau0 + 32 * it; float xc[8];
            { const LAS f32x4* cb = (const LAS f32x4*)(L + LRU_CW + (4 * 128 + co) * 4); const f32x4 b0 = cb[0], b1 = cb[1];
              xc[0] = b0.x; xc[1] = b0.y; xc[2] = b0.z; xc[3] = b0.w; xc[4] = b1.x; xc[5] = b1.y; xc[6] = b1.z; xc[7] = b1.w; }
#pragma unroll
            for (int k = 0; k < 4; ++k) { const LAS f32x4* wp = (const LAS f32x4*)(L + LRU_CW + (k * 128 + co) * 4); const f32x4 w0 = wp[0], w1 = wp[1]; const bf16x8 v = xv[it][k];
                xc[0] += w0.x * bf2f(v[0]); xc[1] += w0.y * bf2f(v[1]); xc[2] += w0.z * bf2f(v[2]); xc[3] += w0.w * bf2f(v[3]);
                xc[4] += w1.x * bf2f(v[4]); xc[5] += w1.y * bf2f(v[5]); xc[6] += w1.z * bf2f(v[6]); xc[7] += w1.w * bf2f(v[7]); }
            if (c == 0 && tau < 48) {
#pragma unroll
                for (int j = 0; j < 8; ++j) xc[j] = 0.f;
            }
            *(LAS v4u*)(XC + tau * LRU_XC_STRIDE + co * 2) = pack8(xc);
        }
        bf16x8 gv[2];
        const int row0 = seq_first_row(seq) + 64 * (c - 1);
        if (PASS == 2) { if (c > 0) {
#pragma unroll
            for (int it = 0; it < 2; ++it) gv[it] = *(const GAS bf16x8*)(F.GY() + (size_t)(row0 + tau0 + 32 * it) * 1024 + n * 128 + co); } }
        __syncthreads();
        if (cg + ngrp < NCHUNK) LRU_PREFETCH(cg + ngrp);
#pragma unroll
        for (int tt = 0; tt < 2; ++tt) {
            const int tile = d ? 1 - tt : tt;
            f32x16 ar = {}, ai = {};
#pragma unroll
            for (int ks = 0; ks < 8; ++ks) {
                const bf16x8 a = *(const LAS bf16x8*)(XC + (tile * 32 + r32) * LRU_XC_STRIDE + (ks * 16 + hi * 8) * 2);
                ar = __builtin_amdgcn_mfma_f32_32x32x16_bf16(a, br[ks], ar, 0, 0, 0);
                ai = __builtin_amdgcn_mfma_f32_32x32x16_bf16(a, bi[ks], ai, 0, 0, 0);
            }
            float av[16], uv[16], hv[16];
#pragma unroll
            for (int r = 0; r < 16; ++r) {
                const int tau = tile * 32 + crow16(r, hi);
                const float xcv = bf2f(*(const LAS unsigned short*)(XC + tau * LRU_XC_STRIDE + chl * 2));
                const float rg = __builtin_amdgcn_rcpf(1.f + __builtin_amdgcn_exp2f(fmaf(ar[r], -L2E, nb_r)));
                const float ig = __builtin_amdgcn_rcpf(1.f + __builtin_amdgcn_exp2f(fmaf(ai[r], -L2E, nb_i)));
                const float a = __builtin_amdgcn_exp2f(-spl * rg);
                av[r] = a;
                uv[r] = __builtin_amdgcn_sqrtf(fmaf(-a, a, 1.f)) * (ig * xcv);
            }
            if (d == 0) scan_tile<0>(av, uv, carry, ptot, hv, hi != 0); else scan_tile<1>(av, uv, carry, ptot, hv, hi != 0);
            if (PASS == 2) {
#pragma unroll
                for (int r = 0; r < 16; ++r) { const int tau = tile * 32 + crow16(r, hi); *(LAS float*)(L + (d ? LRU_HB : LRU_HF) + (tau * 128 + chl) * 4) = hv[r]; }
            }
        }
        if (PASS == 1) { if (hi == 0) F.CAR()[((size_t)cg * 2 + d) * 1024 + chg] = make_float2(ptot, carry); }
        if (PASS == 2) {
            __syncthreads();
            if (c > 0) {
#pragma unroll
                for (int it = 0; it < 2; ++it) {
                    const int tau = tau0 + 32 * it; const bf16x8 g8 = gv[it];
                    const LAS f32x4* hf = (const LAS f32x4*)(L + LRU_HF + (tau * 128 + co) * 4); const LAS f32x4* hb = (const LAS f32x4*)(L + LRU_HB + (tau * 128 + co) * 4);
                    const f32x4 f0 = hf[0], f1 = hf[1], b0 = hb[0], b1 = hb[1];
                    float o[8];
                    o[0] = (f0.x + b0.x) * gelu_tanh(bf2f(g8[0])); o[1] = (f0.y + b0.y) * gelu_tanh(bf2f(g8[1])); o[2] = (f0.z + b0.z) * gelu_tanh(bf2f(g8[2])); o[3] = (f0.w + b0.w) * gelu_tanh(bf2f(g8[3]));
                    o[4] = (f1.x + b1.x) * gelu_tanh(bf2f(g8[4])); o[5] = (f1.y + b1.y) * gelu_tanh(bf2f(g8[5])); o[6] = (f1.z + b1.z) * gelu_tanh(bf2f(g8[6])); o[7] = (f1.w + b1.w) * gelu_tanh(bf2f(g8[7]));
                    *(GAS v4u*)(gout + (size_t)(row0 + tau) * 1024 + n * 128 + co) = pack8(o);
                }
            } else if (tid < 128) {
                const float hf = *(const LAS float*)(L + LRU_HF + (63 * 128 + tid) * 4), hb = *(const LAS float*)(L + LRU_HB + (63 * 128 + tid) * 4);
                F.LO15()[seq * 1024 + n * 128 + tid] = (hf + hb) * gelu_tanh(F.GY15()[n * 128 + tid]);
            }
        }
    }
    __syncthreads();
#undef LRU_PREFETCH
}
__device__ __forceinline__ void lru_propagate(Frame& F) {
    const int gid = F.vcu * 512 + F.tid;
    if (gid < 12 * 2048) {
        const int s = gid >> 11, d = (gid >> 10) & 1, ch = gid & 1023; const int nch = s < 8 ? 65 : 129, cb = chunk_base(s);
        const float2* car = F.CAR() + (size_t)d * 1024 + ch; float* cinp = F.CIN() + (size_t)d * 1024 + ch;
        float cin = 0.f;
        for (int b0 = 0; b0 < nch; b0 += 16) {
            float2 ph[16];
#pragma unroll
            for (int i = 0; i < 16; ++i) { const int cc = b0 + i; const int c = d ? nch - 1 - cc : cc; if (cc < nch) ph[i] = car[(size_t)(cb + c) * 2048]; }
#pragma unroll
            for (int i = 0; i < 16; ++i) { const int cc = b0 + i; const int c = d ? nch - 1 - cc : cc; if (cc < nch) { cinp[(size_t)(cb + c) * 2048] = cin; cin = ph[i].x * cin + ph[i].y; } }
        }
    }
}

__device__ __forceinline__ void k_rope_pass(Frame& F, bf16* Kout) {
    const int gw = F.vcu * NWAVES + F.wave, NGW = F.G * NWAVES, sub = F.lane >> 4, l16 = F.lane & 15;
    const int c0 = 8 * l16, p = l16 >> 3, half = (l16 >> 2) & 1, i0 = 8 * (l16 & 3);
    float inv[8], gk[8];
#pragma unroll
    for (int j = 0; j < 8; ++j) { inv[j] = __builtin_amdgcn_exp2f(-(float)(i0 + j) * (13.287712379549449f / 32.f)) * 0.15915494309189535f; gk[j] = FIN(F, 6  )[c0 + j]; }
    for (int it = gw; it < NTOK * 2 / 4; it += NGW) {
        const int item = it * 4 + sub, row = item >> 1, hk = item & 1;
        const int s = row_seq(row), t = row - seq_first_row(s); const float pos = (float)(p ? (t & 63) : (t >> 6));
        bf16* kp = F.K() + (size_t)row * 256 + hk * 128 + c0;
        const bf16x8 v = *(const GAS bf16x8*)kp; float x[8]; float ss = 0.f;
#pragma unroll
        for (int j = 0; j < 8; ++j) { x[j] = bf2f(v[j]); ss += x[j] * x[j]; }
        ss += __shfl_xor(ss, 1); ss += __shfl_xor(ss, 2); ss += __shfl_xor(ss, 4); ss += __shfl_xor(ss, 8);
        const float rs = 1.f / sqrtf(ss * (1.f / 128.f) + EPS); float o[8];
#pragma unroll
        for (int j = 0; j < 8; ++j) { x[j] *= rs * gk[j]; const float pr = __shfl_xor(x[j], 4);
            float rev = pos * inv[j]; rev -= floorf(rev); const float sn = __builtin_amdgcn_sinf(rev), cs = __builtin_amdgcn_cosf(rev);
            o[j] = half ? x[j] * cs + pr * sn : x[j] * cs - pr * sn; }
        *(GAS v4u*)(Kout + (size_t)row * 256 + hk * 128 + c0) = pack8(o);
    }
}
__device__ __forceinline__ void p3_meta_job(Frame& F) {
    for (int pr = F.wave; pr < 32; pr += 8) { const int r = pr >> 1, hk = pr & 1; const float* z = F.ZM() + r * INW + 1024 + hk * 128;
        const float a = z[F.lane], b = z[F.lane + 64]; const float rs = 1.f / sqrtf(wave_sum(a * a + b * b) * (1.f / 128.f) + EPS);
        F.KM()[r * 256 + hk * 128 + F.lane] = (bf16)f2bf(a * rs * FIN(F, 6  )[F.lane]); F.KM()[r * 256 + hk * 128 + F.lane + 64] = (bf16)f2bf(b * rs * FIN(F, 6  )[F.lane + 64]); }
    for (int i = F.tid; i < 16 * 256; i += 512) F.VM()[i] = (bf16)f2bf(F.ZM()[(i >> 8) * INW + 1280 + (i & 255)]);
    { const int h = F.wave; const float* z = F.ZM() + 15 * INW + h * 128; const float a = z[F.lane], b = z[F.lane + 64];
      const float rs = 1.f / sqrtf(wave_sum(a * a + b * b) * (1.f / 128.f) + EPS);
      F.Q15()[h * 128 + F.lane] = a * rs * FIN(F, 5  )[F.lane]; F.Q15()[h * 128 + F.lane + 64] = b * rs * FIN(F, 5  )[F.lane + 64]; }
    for (int i = F.tid; i < 1024; i += 512) F.GY15()[i] = F.ZM()[15 * INW + 2560 + i];
}

__device__ __forceinline__ void metaq_item(Frame& F, int it) {
    int s, kvh, j; if (it < 256) { s = it >> 5; kvh = (it >> 4) & 1; j = it & 15; } else { const int t2 = it - 256; s = 8 + (t2 >> 6); kvh = (t2 >> 5) & 1; j = t2 & 31; }
    LAS float* q4 = (LAS float*)F.lds;
    LAS float* sc = q4 + 512;
    LAS float* red = sc + 4 * 288;
    const int tid = F.tid, nk = 256 + (j == 0 ? 16 : 0), row0 = seq_first_row(s) + 256 * j;
    q4[tid] = F.Q15()[kvh * 512 + tid];
    __syncthreads();
    if (tid < nk) {
        const bf16* kp = tid < 256 ? F.K() + (size_t)(row0 + tid) * 256 + kvh * 128 : F.KM() + (tid - 256) * 256 + kvh * 128;
        float d0 = 0.f, d1 = 0.f, d2 = 0.f, d3 = 0.f;
#pragma unroll 4
        for (int cc = 0; cc < 16; ++cc) { const bf16x8 kv = ((const GAS bf16x8*)kp)[cc];
#pragma unroll
            for (int e = 0; e < 8; ++e) { const float kf = bf2f(kv[e]); d0 += kf * q4[cc * 8 + e]; d1 += kf * q4[128 + cc * 8 + e]; d2 += kf * q4[256 + cc * 8 + e]; d3 += kf * q4[384 + cc * 8 + e]; } }
        const float SC = 0.088388347648318440f;
        sc[tid] = d0 * SC; sc[288 + tid] = d1 * SC; sc[576 + tid] = d2 * SC; sc[864 + tid] = d3 * SC;
    }
    __syncthreads();
    if (F.wave < 4) { LAS float* sh = sc + F.wave * 288; float m = -INFINITY;
        for (int k = F.lane; k < nk; k += 64) m = fmaxf(m, sh[k]);
        m = wave_max(m); float l = 0.f;
        for (int k = F.lane; k < nk; k += 64) { const float p = __expf(sh[k] - m); sh[k] = p; l += p; }
        l = wave_sum(l);
        if (F.lane == 0) { red[F.wave * 2] = m; red[F.wave * 2 + 1] = l; } }
    __syncthreads();
    {
        const int kg = tid >> 4, oc = tid & 15; float o[4][8];
#pragma unroll
        for (int h = 0; h < 4; ++h)
#pragma unroll
            for (int e = 0; e < 8; ++e) o[h][e] = 0.f;
        const bf16* vp = F.V() + (size_t)(row0 + kg * 8) * 256 + kvh * 128 + oc * 8;
        bf16x8 vv[8];
#pragma unroll
        for (int k = 0; k < 8; ++k) vv[k] = *(const GAS bf16x8*)(vp + (size_t)k * 256);
#pragma unroll
        for (int k = 0; k < 8; ++k) { const float p0 = sc[kg * 8 + k], p1 = sc[288 + kg * 8 + k], p2 = sc[576 + kg * 8 + k], p3 = sc[864 + kg * 8 + k];
#pragma unroll
            for (int e = 0; e < 8; ++e) { const float vf = bf2f(vv[k][e]); o[0][e] += p0 * vf; o[1][e] += p1 * vf; o[2][e] += p2 * vf; o[3][e] += p3 * vf; } }
        if (j == 0 && kg < 16) { const int k = kg; const bf16x8 v1 = *(const GAS bf16x8*)(F.VM() + k * 256 + kvh * 128 + oc * 8);
            const float p0 = sc[256 + k], p1 = sc[288 + 256 + k], p2 = sc[576 + 256 + k], p3 = sc[864 + 256 + k];
#pragma unroll
            for (int e = 0; e < 8; ++e) { const float vf = bf2f(v1[e]); o[0][e] += p0 * vf; o[1][e] += p1 * vf; o[2][e] += p2 * vf; o[3][e] += p3 * vf; } }
        LAS float* part = sc + 4 * 288 + 16;
#pragma unroll
        for (int h = 0; h < 4; ++h) { LAS f32x4* pp = (LAS f32x4*)(part + (kg * 4 + h) * 128 + oc * 8); pp[0] = (f32x4){o[h][0], o[h][1], o[h][2], o[h][3]}; pp[1] = (f32x4){o[h][4], o[h][5], o[h][6], o[h][7]}; }
        __syncthreads();
        const int h = tid >> 7, d = tid & 127; float os = 0.f;
#pragma unroll 8
        for (int g = 0; g < 32; ++g) os += part[(g * 4 + h) * 128 + d];
        float* dst = F.MQP() + ((size_t)it * 4 + h) * 132; dst[2 + d] = os; if (d == 0) { dst[0] = red[h * 2]; dst[1] = red[h * 2 + 1]; } }
    __syncthreads();
}
__device__ __forceinline__ void attn_phase(Frame& F, char* lds_generic, bf16* obase) {
    for (int r = 0; r < 8; ++r) {
        int s, kvh, hq, qb, S;
        if (F.G == 256) {
            const int x = F.vcu >> 5, i = F.vcu & 31;
            if (r < 4) { const int pair = 2 * x + (r >> 1); s = pair >> 1; kvh = pair & 1; const int u = (r & 1) * 32 + i; hq = u >> 4; qb = u & 15; S = 4096; }
            else { const int pair = x; s = 8 + (pair >> 1); kvh = pair & 1; const int u = (r - 4) * 32 + i; hq = u >> 5; qb = u & 31; S = 8192; }
        } else { s = 0; kvh = 0; hq = 0; qb = 0; S = 0; }
        if (S == 0) continue;
        const int row0 = seq_first_row(s), h = kvh * 4 + hq;
        bf16* qp = F.Q() + (size_t)(row0 + qb * 256) * 1024 + h * 128;
        attn::attn_unit(qp, F.K() + (size_t)row0 * 256 + kvh * 128, F.V() + (size_t)row0 * 256 + kvh * 128, F.KM() + kvh * 128, F.VM() + kvh * 128, obase + (size_t)(row0 + qb * 256) * 1024 + h * 128, S / 64 + 1, lds_generic, FIN(F, 5  ), qb * 256);
    }
}

__device__ __forceinline__ void p5_mixed_row(Frame& F, int row, int lane) {
    const GAS bf16x8* a = (const GAS bf16x8*)(F.Q() + (size_t)row * 1024);
    const GAS bf16x8* l = (const GAS bf16x8*)(F.GY() + (size_t)row * 1024);
    const bf16x8 a0 = a[lane], a1 = a[lane + 64], l0 = l[lane], l1 = l[lane + 64];
    float sa = 0.f, sl = 0.f;
#pragma unroll
    for (int j = 0; j < 8; ++j) { const float x0 = bf2f(a0[j]), x1 = bf2f(a1[j]), y0 = bf2f(l0[j]), y1 = bf2f(l1[j]); sa += x0 * x0 + x1 * x1; sl += y0 * y0 + y1 * y1; }
    const float ra = 1.f / sqrtf(wave_sum(sa) * (1.f / 1024.f) + EPS), rl = 1.f / sqrtf(wave_sum(sl) * (1.f / 1024.f) + EPS);
    GAS v4u* o = (GAS v4u*)(F.XN() + (size_t)row * DM);
#pragma unroll
    for (int i = 0; i < 2; ++i) {
        const int e0 = (lane + 64 * i) * 8; const bf16x8 av = i ? a1 : a0, lv = i ? l1 : l0;
        const GAS f32x4* ga = (const GAS f32x4*)(FIN(F, 14  ) + e0); const GAS f32x4* gl = (const GAS f32x4*)(FIN(F, 15  ) + e0);
        const f32x4 ga0 = ga[0], ga1 = ga[1], gl0 = gl[0], gl1 = gl[1];
        float oa[8], ol[8];
        oa[0] = bf2f(av[0]) * ra * ga0.x; oa[1] = bf2f(av[1]) * ra * ga0.y; oa[2] = bf2f(av[2]) * ra * ga0.z; oa[3] = bf2f(av[3]) * ra * ga0.w;
        oa[4] = bf2f(av[4]) * ra * ga1.x; oa[5] = bf2f(av[5]) * ra * ga1.y; oa[6] = bf2f(av[6]) * ra * ga1.z; oa[7] = bf2f(av[7]) * ra * ga1.w;
        ol[0] = bf2f(lv[0]) * rl * gl0.x; ol[1] = bf2f(lv[1]) * rl * gl0.y; ol[2] = bf2f(lv[2]) * rl * gl0.z; ol[3] = bf2f(lv[3]) * rl * gl0.w;
        ol[4] = bf2f(lv[4]) * rl * gl1.x; ol[5] = bf2f(lv[5]) * rl * gl1.y; ol[6] = bf2f(lv[6]) * rl * gl1.z; ol[7] = bf2f(lv[7]) * rl * gl1.w;
        o[lane + 64 * i] = pack8(oa); o[128 + lane + 64 * i] = pack8(ol);
    }
}
__device__ __forceinline__ void p5_meta_job(Frame& F, int s) {
    LAS float* buf = (LAS float*)F.lds; LAS float* red = buf + 2048; const int tid = F.tid;
    {
        const int nj = s < 8 ? 16 : 32;
        for (int e = tid; e < 1024; e += 512) { const int h = e >> 7, d = e & 127, kvh = h >> 2, hq = h & 3;
            const int it0 = s < 8 ? s * 32 + kvh * 16 : 256 + (s - 8) * 64 + kvh * 32;
            float M = -INFINITY; for (int j = 0; j < nj; ++j) M = fmaxf(M, F.MQP()[((size_t)(it0 + j) * 4 + hq) * 132]);
            float Ls = 0.f, O = 0.f;
            for (int j = 0; j < nj; ++j) { const float* p = F.MQP() + ((size_t)(it0 + j) * 4 + hq) * 132; const float w = __expf(p[0] - M); Ls += p[1] * w; O += p[2 + d] * w; }
            buf[e] = O / Ls; }
        for (int e = tid; e < 1024; e += 512) buf[1024 + e] = F.LO15()[s * 1024 + e];
        __syncthreads();
        { float ss = 0.f; for (int k = F.lane; k < 256; k += 64) { const float v = buf[F.wave * 256 + k]; ss += v * v; } ss = wave_sum(ss); if (F.lane == 0) red[F.wave] = ss; }
        __syncthreads();
        const float ra = 1.f / sqrtf((red[0] + red[1] + red[2] + red[3]) * (1.f / 1024.f) + EPS), rl = 1.f / sqrtf((red[4] + red[5] + red[6] + red[7]) * (1.f / 1024.f) + EPS);
        for (int e = tid; e < 2048; e += 512) F.MIXED15()[s * 2048 + e] = e < 1024 ? buf[e] * ra * FIN(F, 14  )[e] : buf[e] * rl * FIN(F, 15  )[e - 1024];
        __syncthreads();
    }
}
__device__ __forceinline__ void p6_meta_y(Frame& F) {
    LAS float* X = (LAS float*)F.lds;
    for (int i = F.tid; i < 12 * DM / 4; i += 512) ((LAS f32x4*)X)[i] = ((const GAS f32x4*)F.MIXED15())[i];
    __syncthreads();
    const OutRows o{F.Y15(), DM, 12};
    small_gemm<12, OutRows>(X, DM, F.WOUT_T(), DM, F.vcu * NWAVES + F.wave, F.G * NWAVES, F.lane, o);
    __syncthreads();
}

__device__ __forceinline__ void p7_row(Frame& F, int row, int lane) {
    const GAS bf16x8* y = (const GAS bf16x8*)(F.Y1() + (size_t)row * DM);
    const float* xr = row < 32768 ? FIN(F, 0  ) + (size_t)row * DM : FIN(F, 1  ) + (size_t)(row - 32768) * DM;
    float hv[32]; float ss = 0.f;
#pragma unroll
    for (int i = 0; i < 4; ++i) { const bf16x8 v = y[lane + 64 * i];
#pragma unroll
        for (int j = 0; j < 8; ++j) { hv[8 * i + j] = bf2f(v[j]); ss += hv[8 * i + j] * hv[8 * i + j]; } }
    const float r1 = 1.f / sqrtf(wave_sum(ss) * (1.f / DM) + EPS); float s2 = 0.f;
#pragma unroll
    for (int i = 0; i < 4; ++i) { const int e0 = (lane + 64 * i) * 8;
        const GAS f32x4* xp = (const GAS f32x4*)(xr + e0); const GAS f32x4* gp = (const GAS f32x4*)(FIN(F, 17  ) + e0);
        const f32x4 x0 = xp[0], x1 = xp[1], g0 = gp[0], g1 = gp[1];
        f32x4 h0, h1;
        h0.x = x0.x + hv[8 * i + 0] * r1 * g0.x; h0.y = x0.y + hv[8 * i + 1] * r1 * g0.y; h0.z = x0.z + hv[8 * i + 2] * r1 * g0.z; h0.w = x0.w + hv[8 * i + 3] * r1 * g0.w;
        h1.x = x1.x + hv[8 * i + 4] * r1 * g1.x; h1.y = x1.y + hv[8 * i + 5] * r1 * g1.y; h1.z = x1.z + hv[8 * i + 6] * r1 * g1.z; h1.w = x1.w + hv[8 * i + 7] * r1 * g1.w;
        { float hb[8] = {h0.x, h0.y, h0.z, h0.w, h1.x, h1.y, h1.z, h1.w}; ((GAS v4u*)((bf16*)(F.out + (size_t)row * DM) + DM))[lane + 64 * i] = pack8(hb); }
        hv[8 * i + 0] = h0.x; hv[8 * i + 1] = h0.y; hv[8 * i + 2] = h0.z; hv[8 * i + 3] = h0.w; hv[8 * i + 4] = h1.x; hv[8 * i + 5] = h1.y; hv[8 * i + 6] = h1.z; hv[8 * i + 7] = h1.w;
        s2 += (h0.x * h0.x + h0.y * h0.y) + (h0.z * h0.z + h0.w * h0.w) + (h1.x * h1.x + h1.y * h1.y) + (h1.z * h1.z + h1.w * h1.w); }
    const float r2 = 1.f / sqrtf(wave_sum(s2) * (1.f / DM) + EPS);
    GAS v4u* o = (GAS v4u*)(F.XN() + (size_t)row * DM);
#pragma unroll
    for (int i = 0; i < 4; ++i) { const int e0 = (lane + 64 * i) * 8; const GAS f32x4* gp = (const GAS f32x4*)(FIN(F, 18  ) + e0); const f32x4 g0 = gp[0], g1 = gp[1];
        float t[8]; t[0] = hv[8 * i + 0] * r2 * g0.x; t[1] = hv[8 * i + 1] * r2 * g0.y; t[2] = hv[8 * i + 2] * r2 * g0.z; t[3] = hv[8 * i + 3] * r2 * g0.w;
        t[4] = hv[8 * i + 4] * r2 * g1.x; t[5] = hv[8 * i + 5] * r2 * g1.y; t[6] = hv[8 * i + 6] * r2 * g1.z; t[7] = hv[8 * i + 7] * r2 * g1.w;
        o[lane + 64 * i] = pack8(t); }
}
__device__ __forceinline__ void p7_meta_g(Frame& F) {
    LAS float* X = (LAS float*)F.lds;
    for (int r = F.wave; r < 12; r += 8) {
        const float* y = F.Y15() + r * DM; const float* xm = FIN(F, 2  ) + 15 * DM;
        float hv[32]; float ss = 0.f;
#pragma unroll
        for (int i = 0; i < 32; ++i) { hv[i] = y[F.lane + 64 * i]; ss += hv[i] * hv[i]; }
        const float r1 = 1.f / sqrtf(wave_sum(ss) * (1.f / DM) + EPS); float s2 = 0.f;
#pragma unroll
        for (int i = 0; i < 32; ++i) { const int e = F.lane + 64 * i; hv[i] = xm[e] + hv[i] * r1 * FIN(F, 17  )[e]; s2 += hv[i] * hv[i]; }
        const float r2 = 1.f / sqrtf(wave_sum(s2) * (1.f / DM) + EPS);
#pragma unroll
        for (int i = 0; i < 32; ++i) { const int e = F.lane + 64 * i; X[r * DM + e] = hv[i] * r2 * FIN(F, 18  )[e]; }
    }
    __syncthreads();
    const OutRows o{F.G15(), FFN, 12};
    small_gemm<12, OutRows, true>(X, DM, F.WUP_T(), FFN, F.vcu * NWAVES + F.wave, F.G * NWAVES, F.lane, o);
    __syncthreads();
}

__device__ __forceinline__ void p9_fix(Frame& F, int h) {
    constexpr int NOCT = FFN / 8; const int total = 512 * 2 * NOCT;
    const float* cw = FIN(F, 20  ); const float* cb = FIN(F, 21  );
    for (int it = F.vcu * 512 + F.tid; it < total; it += F.G * 512) {
        const int bw = it / NOCT, co = (it - bw * NOCT) * 8, which = bw & 1, B = bw >> 1;
        const int lrow = B * 64 + (which ? 63 : 0), row = h * HROWS + lrow, s = row_seq(row), t = row - seq_first_row(s), S = seq_len(s);
        const float* e = F.EDGE() + (size_t)((B * 2 + which) * 3) * FFN + co;
        float inner[8], self[8], uu[8], outer[8], w0[8], w1[8], w2[8], bb[8];
#define LD8F(dst, p) do { const GAS f32x4* p_ = (const GAS f32x4*)(p); const f32x4 a_ = p_[0], b_ = p_[1]; dst[0] = a_.x; dst[1] = a_.y; dst[2] = a_.z; dst[3] = a_.w; dst[4] = b_.x; dst[5] = b_.y; dst[6] = b_.z; dst[7] = b_.w; } while (0)
        LD8F(inner, e); LD8F(self, e + FFN); LD8F(uu, e + 2 * FFN);
        LD8F(w0, cw + co); LD8F(w1, cw + FFN + co); LD8F(w2, cw + 2 * FFN + co); LD8F(bb, cb + co);
        if (which == 0) { if (t == 0) LD8F(outer, F.G15() + (size_t)s * FFN + co); else LD8F(outer, F.EDGE() + (size_t)(((B - 1) * 2 + 1) * 3 + 1) * FFN + co); }
        else { if (t == S - 1) {
#pragma unroll
                for (int j = 0; j < 8; ++j) outer[j] = 0.f; }
            else LD8F(outer, F.EDGE() + (size_t)(((B + 1) * 2 + 0) * 3 + 1) * FFN + co); }
#undef LD8F
        float o[8];
#pragma unroll
        for (int j = 0; j < 8; ++j) { const float x = which == 0 ? bb[j] + w0[j] * outer[j] + w1[j] * self[j] + w2[j] * inner[j] : bb[j] + w0[j] * inner[j] + w1[j] * self[j] + w2[j] * outer[j];
            o[j] = x * sigmoidf_(x) * uu[j]; }
        *(GAS v4u*)(F.ACT() + (size_t)lrow * FFN + co) = pack8(o);
    }
}
__device__ __forceinline__ void p11_row(Frame& F, int row, int lane, float* obase) {
    const GAS bf16x8* f = (const GAS bf16x8*)(F.XN() + (size_t)row * DM);
    const GAS bf16x8* hp = (const GAS bf16x8*)((const bf16*)(F.out + (size_t)row * DM) + DM);
    bf16x8 hv[4], fq[4];
#pragma unroll
    for (int i = 0; i < 4; ++i) { hv[i] = hp[lane + 64 * i]; fq[i] = f[lane + 64 * i]; }
    asm volatile("s_waitcnt vmcnt(0)" ::: "memory");
    float fv[32]; float ss = 0.f;
#pragma unroll
    for (int i = 0; i < 4; ++i)
#pragma unroll
        for (int j = 0; j < 8; ++j) { fv[8 * i + j] = bf2f(fq[i][j]); ss += fv[8 * i + j] * fv[8 * i + j]; }
    const float r1 = 1.f / sqrtf(wave_sum(ss) * (1.f / DM) + EPS);
#pragma unroll
    for (int i = 0; i < 4; ++i) { const int e0 = (lane + 64 * i) * 8;
        const GAS f32x4* gp = (const GAS f32x4*)(FIN(F, 23  ) + e0); const f32x4 g0 = gp[0], g1 = gp[1];
        f32x4 h0, h1;
        h0.x = bf2f(hv[i][0]) + fv[8 * i + 0] * r1 * g0.x; h0.y = bf2f(hv[i][1]) + fv[8 * i + 1] * r1 * g0.y; h0.z = bf2f(hv[i][2]) + fv[8 * i + 2] * r1 * g0.z; h0.w = bf2f(hv[i][3]) + fv[8 * i + 3] * r1 * g0.w;
        h1.x = bf2f(hv[i][4]) + fv[8 * i + 4] * r1 * g1.x; h1.y = bf2f(hv[i][5]) + fv[8 * i + 5] * r1 * g1.y; h1.z = bf2f(hv[i][6]) + fv[8 * i + 6] * r1 * g1.z; h1.w = bf2f(hv[i][7]) + fv[8 * i + 7] * r1 * g1.w;
        GAS f32x4* wp = (GAS f32x4*)(obase + (size_t)row * DM + e0); wp[0] = h0; wp[1] = h1; }
}
struct Args { const float* in[24]; float* out; unsigned char* ws; int ph_lo, ph_hi, q_lo, q_hi, use_bar, dummy; };
constexpr int N_PHASES = 12;
__global__ void __launch_bounds__(NWAVES * 64, 2) mk_fwd(Args args) {
    extern __shared__ __attribute__((aligned(16))) unsigned char lds[];
    Frame F;
    F.lds = (LAS unsigned char*)lds;
    F.MISC = (volatile LAS unsigned*)(F.lds + MISC_OFF);
    F.tid = threadIdx.x; F.lane = F.tid & 63; F.wave = __builtin_amdgcn_readfirstlane(F.tid >> 6);
    F.G = gridDim.x; { const int bx = blockIdx.x; F.vcu = (F.G % 8 == 0) ? (bx % 8) * (F.G / 8) + bx / 8 : bx; }
    unsigned char* ws = args.ws;
    F.ctl = (gu32*)(ws + WS_CTL);
    F.kargs = (const __attribute__((address_space(4))) void*)__builtin_amdgcn_kernarg_segment_ptr(); F.ptag = 0; F.out = args.out;
    F.ws = ws;
    for (int u = F.tid; u < (LDS_BYTES - LDSCTL_OFF) / 4; u += NWAVES * 64) ((LAS unsigned*)(F.lds + LDSCTL_OFF))[u] = 0u;
    __syncthreads();
    XcdBarrier bar; bar.bar = (unsigned*)(F.ctl + CW_BAR); bar.x = 0; bar.st = nullptr;
    if (args.use_bar) bar = xcd_barrier_post((unsigned*)(F.ctl + CW_BAR), F.MISC + 8);
    const int lo = args.ph_lo, hi = args.ph_hi;
#define IN(k) (((MK_PHASE_MASK >> (k)) & 1) && lo <= (k) && (k) < hi)
#define PH_BEGIN(k) do { F.ptag = (k); int t_ = F.tid; asm volatile("" : "+v"(t_)); F.tid = t_; F.lane = t_ & 63; } while (0)
#define PH_BAR() do { if (args.use_bar) xcd_barrier(bar); } while (0)
    const int gw = F.vcu * NWAVES + F.wave, NGW = F.G * NWAVES;

    if (IN(0)) { PH_BEGIN(0); { p0_prologue(F); PH_BAR(); } }
    if (IN(1)) { PH_BEGIN(1); {
        p1_meta_z(F);
        pg8::Gemm g{F.XN(), F.WIN_T(), NTOK, INW, DM}; pg8::StaticOrder S; S.init(NTOK, INW, F.G, (int)blockIdx.x);
        pg8::EpiRoute E{nullptr, 0, 1, F.Q(), F.K(), F.V(), F.XR(), F.GY()};
        pg8::gemm_phase<pg8::EpiRoute, pg8::StaticOrder, true, true>(F.lds, g, S, E);
        PH_BAR();
    } }
    if (IN(2)) { PH_BEGIN(2); { lru_phase<1>(F, nullptr); PH_BAR(); } }
    if (IN(3)) { PH_BEGIN(3); {
        k_rope_pass(F, args.dummy ? (bf16*)F.out : F.K());
        lru_propagate(F);
        if (F.vcu == F.G - 1) p3_meta_job(F);
        PH_BAR();
    } }
    if (IN(4)) { PH_BEGIN(4); {
        const int dm = args.dummy;
        if (dm < 2 || dm == 2) lru_phase<2>(F, dm ? (bf16*)F.out + (size_t)NTOK * 1024 : F.GY());
        if (dm < 2 || dm == 3) for (int it = F.vcu; it < 512; it += F.G) metaq_item(F, it);
        if (dm < 2 || dm == 4) attn_phase(F, (char*)lds, dm ? (bf16*)F.out : F.Q());
        PH_BAR();
    } }
    if (IN(5)) { PH_BEGIN(5); {
        for (int row = gw; row < NTOK; row += NGW) p5_mixed_row(F, row, F.lane);
        if (F.vcu >= F.G - 12) p5_meta_job(F, F.G - 1 - F.vcu);
        PH_BAR();
    } }
    if (IN(6)) { PH_BEGIN(6); {
        p6_meta_y(F);
        pg8::Gemm g{F.XN(), F.WOUT_T(), NTOK, DM, DM}; pg8::StaticOrder S; S.init(NTOK, DM, F.G, (int)blockIdx.x);
        pg8::EpiRoute E{F.Y1(), DM, 0, nullptr, nullptr, nullptr, nullptr, nullptr};
        pg8::gemm_phase<pg8::EpiRoute, pg8::StaticOrder, true, true>(F.lds, g, S, E);
        PH_BAR();
    } }
    if (IN(7)) { PH_BEGIN(7); {
        for (int row = gw; row < NTOK; row += NGW) p7_row(F, row, F.lane);
        p7_meta_g(F);
        PH_BAR();
    } }
#if MK_MULTI
    { const int q = args.q_lo;
#else
#pragma unroll
    for (int q = 0; q < 2; ++q) {
#endif
        if (IN(8)) { PH_BEGIN(8); {
            pg8::Gemm g{F.XN() + (size_t)q * HROWS * DM, F.WUP_T(), HROWS, UPW, DM}; pg8::StaticOrder S; S.init(HROWS, UPW, F.G, (int)blockIdx.x);
            pg8::EpiAct E{F.ACT(), F.EDGE(), FIN(F, 20  ), FIN(F, 21  ), FFN};
            pg8::gemm_phase<pg8::EpiAct, pg8::StaticOrder, true, true>(F.lds, g, S, E);
            PH_BAR();
        } }
        if (IN(9)) { PH_BEGIN(9); { p9_fix(F, q); PH_BAR(); } }
        if (IN(10)) { PH_BEGIN(10); {
            pg8::Gemm g{F.ACT(), F.WDOWN_T(), HROWS, DM, FFN}; pg8::ProbeOrder S; S.init(HROWS, DM, F.G, (int)blockIdx.x); S.pmask = args.dummy == 5 ? 7 : -1;
            pg8::EpiRoute E{F.XN() + (size_t)q * HROWS * DM, DM, 0, nullptr, nullptr, nullptr, nullptr, nullptr};
            pg8::gemm_phase<pg8::EpiRoute, pg8::ProbeOrder, true, true>(F.lds, g, S, E);
            if (q == 0) PH_BAR();
        } }
    }
    if (IN(10) && IN(11)) PH_BAR();
    if (IN(11)) { PH_BEGIN(11); { for (int row = gw; row < NTOK; row += NGW) p11_row(F, row, F.lane, args.dummy ? (float*)(F.ws + WS_B) : F.out); } }
#undef IN
#undef PH_BAR
}

extern "C" void kernel_launch(void* const* d_in, const int* in_sizes, int n_in, void* d_out, int out_size, void* d_ws, size_t ws_size, hipStream_t stream) {
    static int grid = 0;
    if (grid == 0) {
        if (n_in != 24 || out_size != NTOK * DM || ws_size < WS_END) { fprintf(stderr, "kernel_launch: unexpected shapes (n_in %d out %d ws %zu, need ws >= %zu); nothing launched\n", n_in, out_size, ws_size, (size_t)WS_END); grid = -1; return; }
        int dev = 0, cus = 0;
        if (hipGetDevice(&dev) != hipSuccess || hipDeviceGetAttribute(&cus, hipDeviceAttributeMultiprocessorCount, dev) != hipSuccess) { grid = -1; return; }
        if (hipFuncSetAttribute((const void*)mk_fwd, hipFuncAttributeMaxDynamicSharedMemorySize, LDS_BYTES) != hipSuccess) { fprintf(stderr, "kernel_launch: hipFuncSetAttribute failed\n"); grid = -1; return; }
        int per_cu = 0;
        if (hipOccupancyMaxActiveBlocksPerMultiprocessor(&per_cu, (const void*)mk_fwd, NWAVES * 64, LDS_BYTES) != hipSuccess || per_cu < 1) fprintf(stderr, "kernel_launch: occupancy query reports %d\n", per_cu);
        (void)hipGetLastError();
        grid = cus;
    }
    if (grid < 0) return;
    if (hipMemsetAsync((char*)d_ws + WS_CTL, 0, CTL_ZERO_BYTES, stream) != hipSuccess) return;
    Args a{};
    for (int i = 0; i < 24; ++i) a.in[i] = (const float*)d_in[i];
    a.out = (float*)d_out; a.ws = (unsigned char*)d_ws;
#if MK_MULTI
    a.use_bar = 0;
#define LAUNCH_PH(ph, q) do { a.ph_lo = (ph); a.ph_hi = (ph) + 1; a.q_lo = (q); a.q_hi = (q) + 1; \
        if ((MK_REPEAT_MASK >> (ph)) & 1) { a.dummy = MK_DUMMY_MODE; hipLaunchKernelGGL(mk_fwd, dim3(grid), dim3(NWAVES * 64), LDS_BYTES, stream, a); } \
        a.dummy = 0; hipLaunchKernelGGL(mk_fwd, dim3(grid), dim3(NWAVES * 64), LDS_BYTES, stream, a); } while (0)
    for (int ph = 0; ph < 8; ++ph) LAUNCH_PH(ph, 0);
    for (int q = 0; q < 2; ++q) for (int ph = 8; ph < 11; ++ph) LAUNCH_PH(ph, q);
    LAUNCH_PH(11, 0);
#else
    a.use_bar = 1; a.ph_lo = 0; a.ph_hi = N_PHASES; a.q_lo = 0; a.q_hi = 2;
    hipLaunchKernelGGL(mk_fwd, dim3(grid), dim3(NWAVES * 64), LDS_BYTES, stream, a);
#endif
    const hipError_t le = hipPeekAtLastError();
    if (le != hipSuccess) fprintf(stderr, "kernel_launch: launch failed: %s\n", hipGetErrorName(le));
}
```

```cpp
#include <hip/hip_runtime.h>
#include <cstdio>
#include <cstdint>
#include <cmath>
#ifndef MK_PHASE_MASK
#define MK_PHASE_MASK 0xfff
#endif
#ifndef MK_REPEAT_MASK
#define MK_REPEAT_MASK 0
#endif
#ifndef MK_DUMMY_MODE
#define MK_DUMMY_MODE 1
#endif
#ifndef MK_MULTI
#define MK_MULTI 0
#endif
namespace pg8 {
#define PG8_LAS __attribute__((address_space(3)))
typedef unsigned short bf16_t;
typedef short bf16x8 __attribute__((ext_vector_type(8)));
typedef float f32x4 __attribute__((ext_vector_type(4)));
typedef unsigned u32x4 __attribute__((ext_vector_type(4)));
constexpr int BM = 256, BK = 64, HALF = 128, HTB = HALF * BK * 2  , STAGE_BYTES = 8 * HTB, NXCD = 8, WGM = 8;

__host__ __device__ __forceinline__ int lds_byte(int r, int c) { const int st = (r >> 4) * 2 + (c >> 5), rr = r & 15, cc = c & 31, ob = rr * 64 + cc * 2; return st * 1024 + (ob ^ (((ob >> 9) & 1) << 5)); }
__host__ __device__ __forceinline__ void stage_rc(int b, int& R, int& C) { const int st = b / 1024, sb = b % 1024, swz = sb ^ (((sb >> 9) & 1) << 5); R = (st >> 1) * 16 + swz / 64; C = (st & 1) * 32 + (swz % 64) / 2; }
__host__ __device__ __forceinline__ int perm32(int rho) { const int n = rho >> 4, i = rho & 15; return 8 * (i >> 2) + 4 * n + (i & 3); }

struct Unit { int pm, pn; };
struct Gemm { const bf16_t* A; const bf16_t* Bt; int M, N, K; };

struct StaticOrder {
    int nM, nN, nwg, G, c;
    __host__ __device__ void init(int M, int N, int G_, int c_) { nM = M / BM; nN = N / BM; nwg = nM * nN; G = G_; c = c_; }
    __host__ __device__ bool next(int i, Unit& u) const {
        const long L = (long)i * G + c; if (L >= nwg) return false;
        int wgid = (int)L; { const int q = nwg / NXCD, r = nwg % NXCD, xcd = wgid % NXCD, off = wgid / NXCD; wgid = (xcd < r ? xcd * (q + 1) : r * (q + 1) + (xcd - r) * q) + off; }
        const int nig = WGM * nN, gid = wgid / nig, fm = gid * WGM, gsz = (nM - fm) < WGM ? (nM - fm) : WGM;
        u.pm = fm + ((wgid % nig) % gsz); u.pn = (wgid % nig) / gsz; return true;
    }
    __device__ __forceinline__ void a_ready(const Unit&) const {}
    __device__ __forceinline__ void done(const Unit&) const {}
};

__device__ __forceinline__ unsigned cvt_pk_bf16(float lo, float hi) { unsigned r; asm volatile("v_cvt_pk_bf16_f32 %0, %1, %2" : "=v"(r) : "v"(lo), "v"(hi)); return r; }
struct EpiRoute {
    static constexpr bool PERM = true, AFTER_DRAIN = false, MIDK = false;
    bf16_t* O; int ldc; int mode; bf16_t *QGp, *Kp, *Vp, *XRp;
    __device__ __forceinline__ void operator()(const f32x4 (&acc)[2][2][4][2], const Unit& u, int wr, int wc, int fr, int fq) const {
        bf16_t* base = O; int ld = ldc; int colt = u.pn * BM; int rowadd = 0;
        if (mode == 1) {
            const int pn = u.pn;
            if (pn < 4) { base = QGp; ld = 2048; colt = pn * 256; }
            else if (pn == 4) { base = Kp; ld = 256; colt = 0; }
            else if (pn == 5) { base = Vp; ld = 256; colt = 0; }
            else if (pn < 10) { base = XRp; ld = 1024; colt = (pn - 6) * 256; const int seq = u.pm < 128 ? (u.pm >> 4) : 8 + ((u.pm - 128) >> 5); rowadd = 64 * (seq + 1); }
            else { base = QGp; ld = 2048; colt = 1024 + (pn - 10) * 256; }
        }
        const int row0 = u.pm * BM + wr * 64 + fr + rowadd; const int col0 = colt + wc * 32 + 8 * fq;
#pragma unroll
        for (int ai = 0; ai < 2; ++ai)
#pragma unroll
            for (int m = 0; m < 4; ++m) { bf16_t* rowp = base + (size_t)(row0 + ai * HALF + m * 16) * ld + col0;
#pragma unroll
                for (int bj = 0; bj < 2; ++bj) { const f32x4 v0 = acc[ai][bj][m][0], v1 = acc[ai][bj][m][1];
                    u32x4 w; w.x = cvt_pk_bf16(v0[0], v0[1]); w.y = cvt_pk_bf16(v0[2], v0[3]); w.z = cvt_pk_bf16(v1[0], v1[1]); w.w = cvt_pk_bf16(v1[2], v1[3]);
                    *(u32x4*)(rowp + bj * HALF) = w; } }
    }
};

__device__ __forceinline__ float dpp_shr1(float old, float src) { return __builtin_bit_cast(float, __builtin_amdgcn_update_dpp(__builtin_bit_cast(int, old), __builtin_bit_cast(int, src), 0x111, 0xF, 0xF, false)); }
__device__ __forceinline__ float dpp_shl1(float old, float src) { return __builtin_bit_cast(float, __builtin_amdgcn_update_dpp(__builtin_bit_cast(int, old), __builtin_bit_cast(int, src), 0x101, 0xF, 0xF, false)); }
__device__ __forceinline__ float dpp_ror1(float src)  { return __builtin_bit_cast(float, __builtin_amdgcn_update_dpp(0, __builtin_bit_cast(int, src), 0x121, 0xF, 0xF, false)); }
__device__ __forceinline__ float dpp_ror15(float src) { return __builtin_bit_cast(float, __builtin_amdgcn_update_dpp(0, __builtin_bit_cast(int, src), 0x12F, 0xF, 0xF, false)); }
struct EpiAct {
    static constexpr bool PERM = true, AFTER_DRAIN = false, MIDK = false;
    bf16_t* ACT; float* EDGE; const float* cw; const float* cb; int nch;
    __device__ __forceinline__ void operator()(const f32x4 (&acc)[2][2][4][2], const Unit& u, int wr, int wc, int fr, int fq) const {
        const int ch0 = u.pn * 128 + wc * 32 + 8 * fq;
        float w0[8], w1[8], w2[8], bb[8];
        { const f32x4 a0 = *(const f32x4*)(cw + ch0), a1 = *(const f32x4*)(cw + ch0 + 4), b0 = *(const f32x4*)(cw + nch + ch0), b1 = *(const f32x4*)(cw + nch + ch0 + 4),
                      c0 = *(const f32x4*)(cw + 2 * nch + ch0), c1 = *(const f32x4*)(cw + 2 * nch + ch0 + 4), d0 = *(const f32x4*)(cb + ch0), d1 = *(const f32x4*)(cb + ch0 + 4);
#pragma unroll
          for (int k = 0; k < 4; ++k) { w0[k] = a0[k]; w0[4 + k] = a1[k]; w1[k] = b0[k]; w1[4 + k] = b1[k]; w2[k] = c0[k]; w2[4 + k] = c1[k]; bb[k] = d0[k]; bb[4 + k] = d1[k]; } }
        const int rowb = u.pm * BM + wr * 64;
#pragma unroll
        for (int ai = 0; ai < 2; ++ai) {
            float ein0[8], ein1[8];
#pragma unroll
            for (int m = 0; m < 4; ++m) {
                float o[8];
#pragma unroll
                for (int n = 0; n < 2; ++n)
#pragma unroll
                    for (int k = 0; k < 4; ++k) {
                        const int j = 4 * n + k; const float cur = acc[ai][0][m][n][k];
                        float pold = 0.f, nold = 0.f;
                        if (m > 0) pold = dpp_ror1(acc[ai][0][m > 0 ? m - 1 : 0][n][k]);
                        if (m < 3) nold = dpp_ror15(acc[ai][0][m < 3 ? m + 1 : 3][n][k]);
                        const float prv = dpp_shr1(pold, cur), nxt = dpp_shl1(nold, cur);
                        const float x = bb[j] + w0[j] * prv + w1[j] * cur + w2[j] * nxt;
                        o[j] = x * __builtin_amdgcn_rcpf(1.f + __builtin_amdgcn_exp2f(-1.4426950408889634f * x)) * acc[ai][1][m][n][k];
                        if (m == 0) ein0[j] = nxt;
                        if (m == 3) ein1[j] = prv;
                    }
                u32x4 w; w.x = cvt_pk_bf16(o[0], o[1]); w.y = cvt_pk_bf16(o[2], o[3]); w.z = cvt_pk_bf16(o[4], o[5]); w.w = cvt_pk_bf16(o[6], o[7]);
                *(u32x4*)(ACT + (size_t)(rowb + ai * HALF + m * 16 + fr) * nch + ch0) = w;
            }
            const int blk = (rowb + ai * HALF) >> 6;
            if (fr == 0 || fr == 15) {
                const bool last = fr == 15; float* e = EDGE + (size_t)((blk * 2 + (last ? 1 : 0)) * 3) * nch + ch0;
                f32x4 i0v, i1v, s0v, s1v, u0v, u1v;
#pragma unroll
                for (int k = 0; k < 4; ++k) { i0v[k] = last ? ein1[k] : ein0[k]; i1v[k] = last ? ein1[4 + k] : ein0[4 + k];
                    s0v[k] = last ? acc[ai][0][3][0][k] : acc[ai][0][0][0][k]; s1v[k] = last ? acc[ai][0][3][1][k] : acc[ai][0][0][1][k];
                    u0v[k] = last ? acc[ai][1][3][0][k] : acc[ai][1][0][0][k]; u1v[k] = last ? acc[ai][1][3][1][k] : acc[ai][1][0][1][k]; }
                *(f32x4*)(e) = i0v; *(f32x4*)(e + 4) = i1v; *(f32x4*)(e + nch) = s0v; *(f32x4*)(e + nch + 4) = s1v; *(f32x4*)(e + 2 * nch) = u0v; *(f32x4*)(e + 2 * nch + 4) = u1v;
            }
        }
    }
};

struct ProbeOrder : StaticOrder { int pmask;
    __host__ __device__ bool next(int i, Unit& u) const { const bool r = StaticOrder::next(i, u); u.pm &= pmask; return r; } };

struct EpiScaled {
    static constexpr bool PERM = true, AFTER_DRAIN = false, MIDK = true;
    bf16_t* O; int ldc; const float* ratio; const float* rl; int kt;
    __device__ __forceinline__ void midk(f32x4 (&acc)[2][2][4][2], const Unit& u, int wr, int fr) const {
        asm volatile("" ::: "memory");
        const float* rp = ratio + (u.pm * BM + wr * 64 + fr);
        float s[2][4];
#pragma unroll
        for (int ai = 0; ai < 2; ++ai)
#pragma unroll
            for (int m = 0; m < 4; ++m) s[ai][m] = rp[ai * HALF + m * 16];
#pragma unroll
        for (int ai = 0; ai < 2; ++ai)
#pragma unroll
            for (int m = 0; m < 4; ++m)
#pragma unroll
                for (int bj = 0; bj < 2; ++bj)
#pragma unroll
                    for (int n = 0; n < 2; ++n) acc[ai][bj][m][n] = acc[ai][bj][m][n] * s[ai][m];
        asm volatile("" ::: "memory");
    }
    __device__ __forceinline__ void operator()(const f32x4 (&acc)[2][2][4][2], const Unit& u, int wr, int wc, int fr, int fq) const {
        const int row0 = u.pm * BM + wr * 64 + fr, col0 = u.pn * BM + wc * 32 + 8 * fq;
#pragma unroll
        for (int ai = 0; ai < 2; ++ai)
#pragma unroll
            for (int m = 0; m < 4; ++m) { const int row = row0 + ai * HALF + m * 16; const float s = rl[row]; bf16_t* rowp = O + (size_t)row * ldc + col0;
#pragma unroll
                for (int bj = 0; bj < 2; ++bj) { const f32x4 v0 = acc[ai][bj][m][0] * s, v1 = acc[ai][bj][m][1] * s;
                    u32x4 w; w.x = cvt_pk_bf16(v0[0], v0[1]); w.y = cvt_pk_bf16(v0[2], v0[3]); w.z = cvt_pk_bf16(v1[0], v1[1]); w.w = cvt_pk_bf16(v1[2], v1[3]);
                    *(u32x4*)(rowp + bj * HALF) = w; } }
    }
};

template <class Epi, class Sched, bool ALIGN_EPI = false, bool SP2 = false>
__device__ __forceinline__ void gemm_phase(PG8_LAS unsigned char* lds, const Gemm g, const Sched& S, const Epi& E) {
    const int tid = threadIdx.x, wid = __builtin_amdgcn_readfirstlane(tid >> 6), lane = tid & 63, wr = wid >> 2, wc = wid & 3, fr = lane & 15, fq = lane >> 4;
    const int K = g.K, nt = K / BK;
    unsigned voffA[2], voffB[2];
#pragma unroll
    for (int i = 0; i < 2; ++i) { int R, C; stage_rc(tid * 16 + i * 8192, R, C); const int Rb = Epi::PERM ? ((R & ~31) + perm32(R & 31)) : R;
        voffA[i] = (unsigned)(R * K + C) * 2u; voffB[i] = (unsigned)(Rb * K + C) * 2u; }
    const size_t kstep = (size_t)(BK * 2);
    const size_t hstep = (size_t)HALF * K * 2;
    const size_t tstep = 2 * hstep;
    const unsigned ldsw = (unsigned)wid * 1024u;
    const int aoff = lds_byte(wr * 64 + fr, fq * 8), boff = lds_byte(wc * 32 + fr, fq * 8);
#define PG8_SA(b, h) (((b) * 2 + (h)) * HTB)
#define PG8_SB(b, h) ((4 + (b) * 2 + (h)) * HTB)
#define PG8_STAGE(bufoff, gbase, voff) do { _Pragma("unroll") for (int _i = 0; _i < 2; ++_i) \
        __builtin_amdgcn_global_load_lds((const unsigned*)((const char*)(gbase) + (voff)[_i]), (PG8_LAS unsigned*)(lds + (bufoff) + ldsw + _i * 8192), 16, 0, 0); } while (0)
#define PG8_LDA(dst, b, h) do { _Pragma("unroll") for (int m = 0; m < 4; ++m) _Pragma("unroll") for (int k = 0; k < 2; ++k) dst[m][k] = *(const PG8_LAS bf16x8*)(lds + PG8_SA(b, h) + aoff + m * 2048 + k * 1024); } while (0)
#define PG8_LDB(dst, b, h) do { _Pragma("unroll") for (int n = 0; n < 2; ++n) _Pragma("unroll") for (int k = 0; k < 2; ++k) dst[n][k] = *(const PG8_LAS bf16x8*)(lds + PG8_SB(b, h) + boff + n * 2048 + k * 1024); } while (0)
#define PG8_MMA(ai, bj, At, Bt) do { __builtin_amdgcn_s_setprio(1); _Pragma("unroll") for (int m = 0; m < 4; ++m) _Pragma("unroll") for (int n = 0; n < 2; ++n) _Pragma("unroll") for (int k = 0; k < 2; ++k) \
        acc[ai][bj][m][n] = __builtin_amdgcn_mfma_f32_16x16x32_bf16(Bt[n][k], At[m][k], acc[ai][bj][m][n], 0, 0, 0); __builtin_amdgcn_s_setprio(0); } while (0)
#define PG8_WAIT_V(n) asm volatile("s_waitcnt vmcnt(" #n ")" ::: "memory")
#define PG8_WAIT_L(n) asm volatile("s_waitcnt lgkmcnt(" #n ")" ::: "memory")
#define PG8_BAR __builtin_amdgcn_s_barrier()
#define PG8_SCHED __builtin_amdgcn_sched_barrier(0)
    Unit cur, nxt; int ui = 0;
    if (!S.next(0, cur)) return;
    f32x4 acc[2][2][4][2];
#pragma unroll
    for (int a = 0; a < 2; ++a)
#pragma unroll
        for (int b = 0; b < 2; ++b)
#pragma unroll
            for (int m = 0; m < 4; ++m)
#pragma unroll
                for (int n = 0; n < 2; ++n) acc[a][b][m][n] = (f32x4){0.f, 0.f, 0.f, 0.f};
    bf16x8 At[4][2], B0[2][2], B1[2][2];
    const char* cA = (const char*)g.A + (size_t)cur.pm * tstep; const char* cB = (const char*)g.Bt + (size_t)cur.pn * tstep;
    S.a_ready(cur);
    if constexpr (SP2) {
        PG8_STAGE(PG8_SB(0, 0), cB, voffB); PG8_STAGE(PG8_SB(0, 1), cB + hstep, voffB); PG8_STAGE(PG8_SA(0, 0), cA, voffA); PG8_STAGE(PG8_SA(0, 1), cA + hstep, voffA);
        if (wr == 1) PG8_BAR;
        PG8_WAIT_V(2); PG8_BAR;
        PG8_STAGE(PG8_SB(1, 0), cB + kstep, voffB); PG8_STAGE(PG8_SA(1, 0), cA + kstep, voffA); PG8_STAGE(PG8_SB(1, 1), cB + hstep + kstep, voffB);
        PG8_WAIT_V(6); PG8_BAR;
    } else {
        PG8_STAGE(PG8_SB(0, 0), cB, voffB); PG8_STAGE(PG8_SA(0, 0), cA, voffA); PG8_STAGE(PG8_SB(0, 1), cB + hstep, voffB); PG8_STAGE(PG8_SA(0, 1), cA + hstep, voffA);
        if (wr == 1) PG8_BAR;
        PG8_WAIT_V(4); PG8_BAR;
        PG8_STAGE(PG8_SB(1, 0), cB + kstep, voffB); PG8_STAGE(PG8_SA(1, 0), cA + kstep, voffA); PG8_STAGE(PG8_SB(1, 1), cB + hstep + kstep, voffB);
        PG8_WAIT_V(6); PG8_BAR;
    }
    for (;;) {
        const bool has_next = S.next(ui + 1, nxt);
        const char* nA = has_next ? (const char*)g.A + (size_t)nxt.pm * tstep : cA; const char* nB = has_next ? (const char*)g.Bt + (size_t)nxt.pn * tstep : cB;
        for (int t = 0; t < nt; t += 2) {
            if constexpr (Epi::MIDK) { if (t == E.kt) E.midk(acc, cur, wr, fr); }
            const bool last = (t == nt - 2);
            const char* a1 = cA + (size_t)(t + 1) * kstep;
            const char* a2 = last ? nA : cA + (size_t)(t + 2) * kstep; const char* b2 = last ? nB : cB + (size_t)(t + 2) * kstep;
            const char* a3 = a2 + kstep; const char* b3 = b2 + kstep;
            if (last && has_next) S.a_ready(nxt);
            if constexpr (SP2) {
            PG8_LDB(B0, 0, 0); PG8_LDB(B1, 0, 1); PG8_SCHED; PG8_LDA(At, 0, 0); PG8_STAGE(PG8_SA(1, 1), a1 + hstep, voffA);
            PG8_WAIT_V(8); PG8_WAIT_L(0); PG8_BAR; PG8_MMA(0, 0, At, B0); PG8_MMA(0, 1, At, B1); PG8_BAR; PG8_SCHED;
            PG8_LDA(At, 0, 1); PG8_STAGE(PG8_SB(0, 0), b2, voffB); PG8_STAGE(PG8_SB(0, 1), b2 + hstep, voffB); PG8_STAGE(PG8_SA(0, 0), a2, voffA);
            PG8_WAIT_V(8); PG8_WAIT_L(0); PG8_BAR; PG8_MMA(1, 0, At, B0); PG8_MMA(1, 1, At, B1); PG8_BAR; PG8_SCHED;
            PG8_LDB(B0, 1, 0); PG8_LDB(B1, 1, 1); PG8_SCHED; PG8_LDA(At, 1, 0); PG8_STAGE(PG8_SA(0, 1), a2 + hstep, voffA);
            PG8_WAIT_V(8); PG8_WAIT_L(0); PG8_BAR; PG8_MMA(0, 0, At, B0); PG8_MMA(0, 1, At, B1); PG8_BAR; PG8_SCHED;
            PG8_LDA(At, 1, 1); PG8_STAGE(PG8_SB(1, 0), b3, voffB); PG8_STAGE(PG8_SB(1, 1), b3 + hstep, voffB); PG8_STAGE(PG8_SA(1, 0), a3, voffA);
            PG8_WAIT_V(8); PG8_WAIT_L(0); PG8_BAR; PG8_MMA(1, 0, At, B0); PG8_MMA(1, 1, At, B1); PG8_BAR; PG8_SCHED;
            } else {
            PG8_LDB(B0, 0, 0); PG8_SCHED; PG8_LDA(At, 0, 0); PG8_STAGE(PG8_SA(1, 1), a1 + hstep, voffA);
            PG8_WAIT_L(8); PG8_BAR; PG8_WAIT_L(0); PG8_MMA(0, 0, At, B0); PG8_BAR; PG8_SCHED;
            PG8_LDB(B1, 0, 1); PG8_STAGE(PG8_SB(0, 0), b2, voffB);
            PG8_BAR; PG8_WAIT_L(0); PG8_MMA(0, 1, At, B1); PG8_BAR;
            PG8_LDA(At, 0, 1); PG8_STAGE(PG8_SA(0, 0), a2, voffA);
            PG8_BAR; PG8_WAIT_L(0); PG8_MMA(1, 0, At, B0); PG8_BAR; PG8_SCHED;
            PG8_STAGE(PG8_SB(0, 1), b2 + hstep, voffB);
            PG8_WAIT_V(6); PG8_BAR; PG8_MMA(1, 1, At, B1); PG8_BAR;
            PG8_LDB(B0, 1, 0); PG8_SCHED; PG8_LDA(At, 1, 0); PG8_STAGE(PG8_SA(0, 1), a2 + hstep, voffA);
            PG8_WAIT_L(8); PG8_BAR; PG8_WAIT_L(0); PG8_MMA(0, 0, At, B0); PG8_BAR; PG8_SCHED;
            PG8_LDB(B1, 1, 1); PG8_STAGE(PG8_SB(1, 0), b3, voffB);
            PG8_BAR; PG8_WAIT_L(0); PG8_MMA(0, 1, At, B1); PG8_BAR;
            PG8_LDA(At, 1, 1); PG8_STAGE(PG8_SA(1, 0), a3, voffA);
            PG8_BAR; PG8_WAIT_L(0); PG8_MMA(1, 0, At, B0); PG8_BAR; PG8_SCHED;
            PG8_STAGE(PG8_SB(1, 1), b3 + hstep, voffB);
            PG8_WAIT_V(6); PG8_BAR; PG8_MMA(1, 1, At, B1); PG8_BAR;
            }
        }
        if constexpr (ALIGN_EPI) { if (wr == 0) PG8_BAR; }
        if constexpr (!Epi::AFTER_DRAIN) { E(acc, cur, wr, wc, fr, fq); S.done(cur); }
        if (!has_next) break;
#pragma unroll
        for (int a = 0; a < 2; ++a)
#pragma unroll
            for (int b = 0; b < 2; ++b)
#pragma unroll
                for (int m = 0; m < 4; ++m)
#pragma unroll
                    for (int n = 0; n < 2; ++n) acc[a][b][m][n] = (f32x4){0.f, 0.f, 0.f, 0.f};
        cur = nxt; cA = nA; cB = nB; ++ui;
        if constexpr (ALIGN_EPI) { if (wr == 1) PG8_BAR; }
    }
    PG8_WAIT_V(0);
    if constexpr (!ALIGN_EPI) { if (wr == 0) PG8_BAR; }
    PG8_BAR;
    if constexpr (Epi::AFTER_DRAIN) { E.fused(acc, cur, wr, wc, fr, fq, lds, wid, lane); S.done(cur); }
#undef PG8_SA
#undef PG8_SB
#undef PG8_STAGE
#undef PG8_LDA
#undef PG8_LDB
#undef PG8_MMA
#undef PG8_WAIT_V
#undef PG8_WAIT_L
#undef PG8_BAR
#undef PG8_SCHED
}
}
namespace attn {
typedef unsigned short bf16r;
constexpr int   D = 128, NW = 8, QBLK = 32, KVBLK = 64;
constexpr float SCALE = 0.088388347648318440f;
constexpr float THR = 8.f;
constexpr int LDQ = 2048, LDK = 256, LDO = 2048;
constexpr size_t SHM_V = KVBLK * D * 2, SHM_K = KVBLK * D * 2, SHM_ATTN = 2 * SHM_V + 2 * SHM_K + NW * 64 * 4;
using bf16x8 = __attribute__((ext_vector_type(8))) short;
using s16x4  = __attribute__((ext_vector_type(4))) short;
using f32x16 = __attribute__((ext_vector_type(16))) float;
using f32x8  = __attribute__((ext_vector_type(8))) float;
using u32x4  = __attribute__((ext_vector_type(4))) unsigned;
#define KSWZ(row, colB) ((row) * 256 + ((colB) ^ (((row) & 7) << 4)))
#define SBAR() __builtin_amdgcn_sched_barrier(0)
__device__ __forceinline__ int crow(int r, int hi) { return (r & 3) + 8 * (r >> 2) + 4 * hi; }
__device__ __forceinline__ unsigned cvtpk(float lo, float hi) {
  unsigned r; asm volatile("v_cvt_pk_bf16_f32 %0, %1, %2" : "=v"(r) : "v"(lo), "v"(hi)); return r;
}
__device__ __forceinline__ void partialSM(f32x16& p0, f32x16& p1, float& m_reg, float& mn, float& alpha) {
  constexpr float C = SCALE * 1.4426950408889634f;
  float pmax = p0[0]; for (int r = 1; r < 16; ++r) pmax = fmaxf(pmax, p0[r]); for (int r = 0; r < 16; ++r) pmax = fmaxf(pmax, p1[r]);
  { auto rr = __builtin_amdgcn_permlane32_swap(__float_as_uint(pmax), __float_as_uint(pmax), false, false);
    pmax = fmaxf(__uint_as_float(rr[0]), __uint_as_float(rr[1])); }
  if (__builtin_expect(__all(pmax - m_reg <= THR / SCALE), 1)) { mn = m_reg; alpha = 1.f; }
  else { mn = fmaxf(m_reg, pmax); alpha = __builtin_amdgcn_exp2f((m_reg - mn) * C); m_reg = mn; }
  float mnC = -mn * C;
  for (int r = 0; r < 16; ++r) p0[r] = fmaf(p0[r], C, mnC); for (int r = 0; r < 16; ++r) p1[r] = fmaf(p1[r], C, mnC);
  for (int r = 0; r < 16; ++r) p0[r] = __builtin_amdgcn_exp2f(p0[r]);
}
__device__ __forceinline__ void finishSM(f32x16& p0, f32x16& p1, float alpha, float& l_reg, bf16x8& pa0, bf16x8& pa1, bf16x8& pa2, bf16x8& pa3) {
  for (int r = 0; r < 16; ++r) p1[r] = __builtin_amdgcn_exp2f(p1[r]);
  float ps = 0; for (int r = 0; r < 16; ++r) ps += p0[r]; for (int r = 0; r < 16; ++r) ps += p1[r];
  { auto rr = __builtin_amdgcn_permlane32_swap(__float_as_uint(ps), __float_as_uint(ps), false, false);
    ps = __uint_as_float(rr[0]) + __uint_as_float(rr[1]); }
  l_reg = l_reg * alpha + ps;
#define PK4(P, BASE, OUT) do { unsigned a0 = cvtpk(P[BASE + 0], P[BASE + 1]), a1 = cvtpk(P[BASE + 2], P[BASE + 3]);   \
    unsigned b0 = cvtpk(P[BASE + 4], P[BASE + 5]), b1 = cvtpk(P[BASE + 6], P[BASE + 7]);                              \
    auto r0 = __builtin_amdgcn_permlane32_swap(a0, b0, false, false); auto r1 = __builtin_amdgcn_permlane32_swap(a1, b1, false, false); \
    u32x4 w = {r0[0], r1[0], r0[1], r1[1]}; OUT = *reinterpret_cast<bf16x8*>(&w); } while (0)
  PK4(p0, 0, pa0); PK4(p0, 8, pa1); PK4(p1, 0, pa2); PK4(p1, 8, pa3);
#undef PK4
}
__device__ __forceinline__ void qkt(f32x16& p0, f32x16& p1, const bf16r* Ks, const bf16x8* qr, int r32, int hi) {
  p0 = f32x16{}; p1 = f32x16{};
  for (int d0 = 0; d0 < 8; ++d0) { int cb = (d0 * 16 + hi * 8) * 2;
    bf16x8 b0 = *reinterpret_cast<const bf16x8*>((const char*)Ks + KSWZ(r32, cb));
    bf16x8 b1 = *reinterpret_cast<const bf16x8*>((const char*)Ks + KSWZ(32 + r32, cb));
    p0 = __builtin_amdgcn_mfma_f32_32x32x16_bf16(b0, qr[d0], p0, 0, 0, 0);
    p1 = __builtin_amdgcn_mfma_f32_32x32x16_bf16(b1, qr[d0], p1, 0, 0, 0); }
}
__device__ __forceinline__ int v_st(int k, int c) { const int kk = (k & ~0xC) | ((k & 4) << 1) | ((k & 8) >> 1); return ((kk >> 3) * 4 + (c >> 5)) * 512 + ((kk & 7) * 32 + (c & 31)) * 2; }
__device__ __forceinline__ int v_rd_base(int lane) { return ((lane & 3) << 3) | (((lane >> 2) & 3) << 6) | (((lane >> 4) & 1) << 5) | (((lane >> 5) & 1) << 8); }
constexpr int v_rd_off(int d0, int ks, int half) { return d0 * 512 + ks * 4096 + half * 2048; }
template <int OFF> __device__ __forceinline__ s16x4 tr_read(int vb) {
  s16x4 r; asm volatile("ds_read_b64_tr_b16 %0, %1 offset:%2" : "=&v"(r) : "v"(vb), "i"(OFF) : "memory"); return r;
}
template <int D0> __device__ __forceinline__ void pv_one(f32x16& od, int vb, bf16x8 pa0, bf16x8 pa1, bf16x8 pa2, bf16x8 pa3) {
  const s16x4 l0 = tr_read<v_rd_off(D0, 0, 0)>(vb), h0 = tr_read<v_rd_off(D0, 0, 1)>(vb), l1 = tr_read<v_rd_off(D0, 1, 0)>(vb), h1 = tr_read<v_rd_off(D0, 1, 1)>(vb);
  const s16x4 l2 = tr_read<v_rd_off(D0, 2, 0)>(vb), h2 = tr_read<v_rd_off(D0, 2, 1)>(vb), l3 = tr_read<v_rd_off(D0, 3, 0)>(vb), h3 = tr_read<v_rd_off(D0, 3, 1)>(vb);
  asm volatile("s_waitcnt lgkmcnt(0)" ::: "memory"); SBAR();
#define PK(L, H) (bf16x8){L[0], L[1], L[2], L[3], H[0], H[1], H[2], H[3]}
  od = __builtin_amdgcn_mfma_f32_32x32x16_bf16(pa0, PK(l0, h0), od, 0, 0, 0);
  od = __builtin_amdgcn_mfma_f32_32x32x16_bf16(pa1, PK(l1, h1), od, 0, 0, 0);
  od = __builtin_amdgcn_mfma_f32_32x32x16_bf16(pa2, PK(l2, h2), od, 0, 0, 0);
  od = __builtin_amdgcn_mfma_f32_32x32x16_bf16(pa3, PK(l3, h3), od, 0, 0, 0);
#undef PK
}
__device__ __forceinline__ void pv_d0(f32x16* o, int vb, bf16x8 pa0, bf16x8 pa1, bf16x8 pa2, bf16x8 pa3) {
  pv_one<0>(o[0], vb, pa0, pa1, pa2, pa3); pv_one<1>(o[1], vb, pa0, pa1, pa2, pa3); pv_one<2>(o[2], vb, pa0, pa1, pa2, pa3); pv_one<3>(o[3], vb, pa0, pa1, pa2, pa3);
}
constexpr float THRL = 8.f;
__device__ __forceinline__ void qkt2(f32x16& p0, f32x16& p1, const bf16r* Ks, const bf16x8* qr, float nm, int r32, int hi) {
  f32x16 negm;
#pragma unroll
  for (int r = 0; r < 16; ++r) negm[r] = nm;
#pragma unroll
  for (int d0 = 0; d0 < 8; ++d0) { int cb = (d0 * 16 + hi * 8) * 2;
    bf16x8 b0 = *reinterpret_cast<const bf16x8*>((const char*)Ks + KSWZ(r32, cb));
    bf16x8 b1 = *reinterpret_cast<const bf16x8*>((const char*)Ks + KSWZ(32 + r32, cb));
    if (d0 == 0) { p1 = __builtin_amdgcn_mfma_f32_32x32x16_bf16(b1, qr[0], negm, 0, 0, 0); p0 = __builtin_amdgcn_mfma_f32_32x32x16_bf16(b0, qr[0], negm, 0, 0, 0); }
    else { p0 = __builtin_amdgcn_mfma_f32_32x32x16_bf16(b0, qr[d0], p0, 0, 0, 0); p1 = __builtin_amdgcn_mfma_f32_32x32x16_bf16(b1, qr[d0], p1, 0, 0, 0); } }
}
__device__ __forceinline__ void partialSM2(f32x16& p0, f32x16& p1, float& mhat, float& alpha, bool first) {
  float a = __builtin_fmaxf(__builtin_fmaxf(p0[0], p0[1]), p1[0]), b = __builtin_fmaxf(__builtin_fmaxf(p0[2], p0[3]), p1[1]); a = __builtin_fmaxf(__builtin_fmaxf(a, p1[2]), p1[3]);
#pragma unroll
  for (int r = 4; r < 16; r += 4) { a = __builtin_fmaxf(__builtin_fmaxf(a, p0[r]), p0[r + 1]); b = __builtin_fmaxf(__builtin_fmaxf(b, p0[r + 2]), p0[r + 3]); a = __builtin_fmaxf(__builtin_fmaxf(a, p1[r]), p1[r + 1]); b = __builtin_fmaxf(__builtin_fmaxf(b, p1[r + 2]), p1[r + 3]); }
  float pmax = __builtin_fmaxf(a, b);
  { auto rr = __builtin_amdgcn_permlane32_swap(__float_as_uint(pmax), __float_as_uint(pmax), false, false); pmax = __builtin_fmaxf(__uint_as_float(rr[0]), __uint_as_float(rr[1])); }
  alpha = 1.f;
  if (first || __builtin_expect(__any(pmax > THRL), 0)) {
    const float dl = first ? pmax : __builtin_fmaxf(pmax, 0.f);
    mhat += dl;
#pragma unroll
    for (int r = 0; r < 16; ++r) { p0[r] -= dl; p1[r] -= dl; }
    if (!first) alpha = __builtin_amdgcn_exp2f(-dl);
  }
#pragma unroll
  for (int r = 0; r < 16; ++r) p0[r] = __builtin_amdgcn_exp2f(p0[r]);
}
__device__ __forceinline__ void mask_meta(f32x16& p0, f32x16& p1) {
  const float NEG = -INFINITY;
#pragma unroll
  for (int r = 8; r < 16; ++r) p0[r] = NEG;
#pragma unroll
  for (int r = 0; r < 16; ++r) p1[r] = NEG;
}
__device__ __forceinline__ unsigned short f2bf_rne(float f) { unsigned u = __builtin_bit_cast(unsigned, f); return (unsigned short)((u + 0x7fffu + ((u >> 16) & 1u)) >> 16); }

__device__ __forceinline__ void attn_unit(const bf16r* Qb, const bf16r* __restrict__ Kh, const bf16r* __restrict__ Vh,
                                          const bf16r* __restrict__ KMh, const bf16r* __restrict__ VMh, bf16r* Ob, int NT, char* lds,
                                          const float* __restrict__ qnorm, int t0, float* ssq) {
  int tid_ = threadIdx.x; asm volatile("" : "+v"(tid_));
  const int tid = tid_, wid = tid >> 6, lane = tid & 63, r32 = lane & 31, hi = lane >> 5;
  bf16r* V_lds = (bf16r*)lds; bf16r* K_lds = (bf16r*)(lds + 2 * SHM_V);
  float* ws = (float*)(lds + 2 * SHM_V + 2 * SHM_K) + wid * 64; float* li_l = ws; float* al_l = ws + 32;
  float mhat = 0.f, l_reg = 0; f32x16 o[4] = {}; bf16x8 qr[8];
  const bf16r* Qw = Qb + (long)(wid * QBLK + r32) * LDQ + hi * 8;
#pragma unroll
  for (int d0 = 0; d0 < 8; ++d0) qr[d0] = *reinterpret_cast<const bf16x8*>(Qw + d0 * 16);
  {
    float ss = 0.f;
#pragma unroll
    for (int d0 = 0; d0 < 8; ++d0)
#pragma unroll
      for (int j = 0; j < 8; ++j) { const float x = __builtin_bit_cast(float, (unsigned)(unsigned short)qr[d0][j] << 16); ss += x * x; }
    { auto rr = __builtin_amdgcn_permlane32_swap(__float_as_uint(ss), __float_as_uint(ss), false, false); ss = __uint_as_float(rr[0]) + __uint_as_float(rr[1]); }
    const float rs = (SCALE * 1.4426950408889634f) / sqrtf(ss * (1.f / 128.f) + 1e-6f);
    int t = t0 + wid * QBLK + r32; int hio = hi; asm volatile("" : "+v"(t), "+v"(hio));
#pragma unroll
    for (int g = 0; g < 4; ++g) {
      const int p = g >> 1, dd = g & 1, fa = 4 * p + dd, fb = fa + 2; const float pos = (float)(p ? (t & 63) : (t >> 6));
      const float4 ga0 = *reinterpret_cast<const float4*>(qnorm + fa * 16 + hi * 8), ga1 = *reinterpret_cast<const float4*>(qnorm + fa * 16 + hi * 8 + 4);
      const float4 gb0 = *reinterpret_cast<const float4*>(qnorm + fb * 16 + hi * 8), gb1 = *reinterpret_cast<const float4*>(qnorm + fb * 16 + hi * 8 + 4);
      const float gaf[8] = {ga0.x, ga0.y, ga0.z, ga0.w, ga1.x, ga1.y, ga1.z, ga1.w}, gbf[8] = {gb0.x, gb0.y, gb0.z, gb0.w, gb1.x, gb1.y, gb1.z, gb1.w};
      float oa[8], ob[8];
#pragma unroll
      for (int j = 0; j < 8; ++j) { const int i = 16 * dd + 8 * hio + j;
        float rev = pos * __builtin_amdgcn_exp2f(-(float)i * (13.287712379549449f / 32.f)) * 0.15915494309189535f; rev -= floorf(rev);
        const float sn = __builtin_amdgcn_sinf(rev), cs = __builtin_amdgcn_cosf(rev);
        const float x1 = __builtin_bit_cast(float, (unsigned)(unsigned short)qr[fa][j] << 16) * rs * gaf[j], x2 = __builtin_bit_cast(float, (unsigned)(unsigned short)qr[fb][j] << 16) * rs * gbf[j];
        oa[j] = x1 * cs - x2 * sn; ob[j] = x2 * cs + x1 * sn; }
      { u32x4 w = {cvtpk(oa[0], oa[1]), cvtpk(oa[2], oa[3]), cvtpk(oa[4], oa[5]), cvtpk(oa[6], oa[7])}; qr[fa] = *reinterpret_cast<bf16x8*>(&w); }
      { u32x4 w = {cvtpk(ob[0], ob[1]), cvtpk(ob[2], ob[3]), cvtpk(ob[4], ob[5]), cvtpk(ob[6], ob[7])}; qr[fb] = *reinterpret_cast<bf16x8*>(&w); }
      SBAR();
    }
  }
  const int sr = tid >> 4, sc = (tid & 15) * 8, vst0 = v_st(sr, sc), vst1 = v_st(32 + sr, sc);
  const int vb0 = (int)(uintptr_t)V_lds + v_rd_base(lane);
  struct { bf16x8 vs0, vs1, ks0, ks1; } sr_[2];
#define LD8(p) (*reinterpret_cast<const bf16x8*>(p))
#define SLOAD(i, t) do { const bool meta_ = ((t) == 0); const bf16r* kp_ = meta_ ? KMh : Kh + (long)((t) - 1) * KVBLK * LDK; const bf16r* vp_ = meta_ ? VMh : Vh + (long)((t) - 1) * KVBLK * LDK; \
    sr_[i].vs0 = LD8(&vp_[(long)(sr) * LDK + sc]); sr_[i].vs1 = LD8(&vp_[(long)(32 + sr) * LDK + sc]); \
    sr_[i].ks0 = LD8(&kp_[(long)(sr) * LDK + sc]); sr_[i].ks1 = LD8(&kp_[(long)(32 + sr) * LDK + sc]); } while (0)
#define SWRITE(b, i) do { *(bf16x8*)((char*)V_lds + (b) * SHM_V + vst0) = sr_[i].vs0;          \
    *(bf16x8*)((char*)V_lds + (b) * SHM_V + vst1) = sr_[i].vs1; int kc = sc * 2;               \
    *(bf16x8*)((char*)K_lds + (b) * SHM_K + KSWZ(sr, kc)) = sr_[i].ks0;                       \
    *(bf16x8*)((char*)K_lds + (b) * SHM_K + KSWZ(32 + sr, kc)) = sr_[i].ks1; } while (0)
#define SWAIT() asm volatile("s_waitcnt vmcnt(4)" ::: "memory")
#define RESC(a) do { if (__any((a) < 1.f)) { if (hi == 0) al_l[r32] = (a); asm volatile("s_waitcnt lgkmcnt(0)" ::: "memory"); \
    _Pragma("unroll") for (int r = 0; r < 16; ++r) { const float a_ = al_l[crow(r, hi)]; o[0][r] *= a_; o[1][r] *= a_; o[2][r] *= a_; o[3][r] *= a_; asm volatile("" : "+v"(o[0][r]), "+v"(o[1][r]), "+v"(o[2][r]), "+v"(o[3][r])); } } } while (0)
  f32x16 pA0, pA1, pB0, pB1; float alA, alB; bf16x8 pa0, pa1, pa2, pa3;
  constexpr int SE = 0, SO = 1;
  SLOAD(SE, 0); asm volatile("s_waitcnt vmcnt(0)" ::: "memory"); SWRITE(0, SE); __syncthreads();
  qkt2(pA0, pA1, K_lds, qr, -mhat, r32, hi); mask_meta(pA0, pA1); partialSM2(pA0, pA1, mhat, alA, true);
  SLOAD(SO, 1); SLOAD(SE, 2);
  SWAIT(); SWRITE(1, SO); __syncthreads();
  for (int j = 1; j + 1 < NT; j += 2) {
    SBAR(); qkt2(pB0, pB1, (bf16r*)((char*)K_lds + SHM_K), qr, -mhat, r32, hi);
    finishSM(pA0, pA1, alA, l_reg, pa0, pa1, pa2, pa3); SBAR();
    if (j + 2 < NT) SLOAD(SO, j + 2); SBAR();
    pv_d0(o, vb0, pa0, pa1, pa2, pa3); partialSM2(pB0, pB1, mhat, alB, false);
    __syncthreads(); SWAIT(); SWRITE(0, SE);
    RESC(alB); __syncthreads();
    SBAR(); qkt2(pA0, pA1, K_lds, qr, -mhat, r32, hi);
    finishSM(pB0, pB1, alB, l_reg, pa0, pa1, pa2, pa3); SBAR();
    if (j + 3 < NT) SLOAD(SE, j + 3); SBAR();
    pv_d0(o, vb0 + (int)SHM_V, pa0, pa1, pa2, pa3); partialSM2(pA0, pA1, mhat, alA, false);
    __syncthreads(); SWAIT(); if (j + 2 < NT) SWRITE(1, SO);
    RESC(alA); __syncthreads();
  }
  finishSM(pA0, pA1, alA, l_reg, pa0, pa1, pa2, pa3); SBAR();
  pv_d0(o, vb0, pa0, pa1, pa2, pa3);
  if (hi == 0) li_l[r32] = l_reg; asm volatile("s_waitcnt lgkmcnt(0)" ::: "memory");
  float rli[16];
#pragma unroll
  for (int r = 0; r < 16; ++r) rli[r] = __builtin_amdgcn_rcpf(li_l[crow(r, hi)]);
  bf16r* Ow = Ob + (long)(wid * QBLK) * LDO;
#pragma unroll
  for (int r = 0; r < 16; ++r) { const int orow = crow(r, hi);
    float sq = 0.f;
#pragma unroll
    for (int d0 = 0; d0 < 4; ++d0) { const float v = o[d0][r] * rli[r]; sq += v * v; Ow[(long)orow * LDO + d0 * 32 + r32] = f2bf_rne(v); }
    sq += __shfl_xor(sq, 1); sq += __shfl_xor(sq, 2); sq += __shfl_xor(sq, 4); sq += __shfl_xor(sq, 8); sq += __shfl_xor(sq, 16);
    if (r32 == 0) ssq[(long)(wid * QBLK + orow) * 8] = sq; }
  __syncthreads();
#undef LD8
#undef SLOAD
#undef SWRITE
#undef SWAIT
#undef RESC
}
#undef KSWZ
#undef SBAR
}

constexpr int NWAVES = 8;
constexpr int DM = 2048, NTOK = 65536, INW = 3584, FFN = 5632, UPW = 2 * FFN;
constexpr float EPS = 1e-6f;
constexpr int XR_ROWS = 8 * 4160 + 4 * 8256;
constexpr int NCHUNK = 8 * 65 + 4 * 129;
constexpr int HROWS = 32768;
__host__ __device__ __forceinline__ int seq_first_row(int s) { return s < 8 ? s * 4096 : 32768 + (s - 8) * 8192; }
__host__ __device__ __forceinline__ int seq_len(int s) { return s < 8 ? 4096 : 8192; }
__host__ __device__ __forceinline__ int xr_base(int s) { return s < 8 ? s * 4160 : 33280 + (s - 8) * 8256; }
__host__ __device__ __forceinline__ int chunk_base(int s) { return s < 8 ? s * 65 : 520 + (s - 8) * 129; }
__host__ __device__ __forceinline__ int row_seq(int row) { return row < 32768 ? (row >> 12) : 8 + ((row - 32768) >> 13); }

constexpr size_t MiB = 1u << 20, KiB = 1u << 10;
constexpr size_t WS_CTL = 0, CTL_ZERO_BYTES = 1 * MiB;
constexpr size_t WS_SMALL = 1 * MiB;
constexpr size_t WS_XNMETA = WS_SMALL + 0, WS_ZM = WS_SMALL + 64 * KiB, WS_KM = WS_SMALL + 320 * KiB, WS_VM = WS_SMALL + 352 * KiB, WS_Q15 = WS_SMALL + 384 * KiB, WS_GY15 = WS_SMALL + 388 * KiB,
                 WS_LO15 = WS_SMALL + 392 * KiB, WS_MIXED15 = WS_SMALL + 448 * KiB, WS_Y15 = WS_SMALL + 544 * KiB, WS_G15 = WS_SMALL + 640 * KiB, WS_MQP = WS_SMALL + 1024 * KiB;
constexpr size_t WS_WIN = 5 * MiB, WS_WOUT = 19 * MiB, WS_WUP = 27 * MiB, WS_WDOWN = 71 * MiB, WS_WG = 93 * MiB;
constexpr size_t WS_CAR = 94 * MiB, WS_CIN = 111 * MiB;
constexpr size_t WS_R0 = 120 * MiB, WS_RATIO = 120 * MiB + 256 * KiB, WS_RL = 120 * MiB + 512 * KiB, WS_SSQA = 121 * MiB, WS_SSQL = 123 * MiB;
constexpr size_t WS_A = 128 * MiB;
constexpr size_t WS_B = 384 * MiB;
constexpr size_t WS_QG = WS_B, WS_K = WS_B + 256 * MiB, WS_V = WS_B + 288 * MiB, WS_XR = WS_B + 320 * MiB;
constexpr size_t WS_ACT = WS_B, WS_EDGE = WS_B + 352 * MiB;
constexpr size_t WS_END = WS_B + 450 * MiB;
static_assert(WS_ZM + 16 * INW * 4 <= WS_KM && WS_G15 + 12 * FFN * 4 <= WS_MQP && WS_MQP + 512 * 4 * 132 * 4 <= WS_WIN, "small map");
static_assert(WS_WIN + (size_t)INW * DM * 2 <= WS_WOUT && WS_WOUT + (size_t)DM * DM * 2 <= WS_WUP && WS_WUP + (size_t)UPW * DM * 2 <= WS_WDOWN && WS_WDOWN + (size_t)DM * FFN * 2 <= WS_WG && WS_WG + 32 * 16384 * 2 <= WS_CAR, "weights map");
static_assert(WS_CAR + (size_t)NCHUNK * 2 * 1024 * 8 <= WS_CIN && WS_A + (size_t)NTOK * DM * 2 <= WS_B, "carry map");
static_assert(WS_QG + (size_t)NTOK * DM * 2 <= WS_K && WS_XR + (size_t)(XR_ROWS + 64) * 1024 * 2 <= WS_END && WS_EDGE + (size_t)512 * 2 * 3 * FFN * 4 <= WS_END && WS_CIN + (size_t)NCHUNK * 2 * 1024 * 4 <= WS_R0 && WS_SSQL + (size_t)NTOK * 8 * 4 <= WS_A && WS_ACT + (size_t)HROWS * FFN * 2 <= WS_EDGE && WS_EDGE + (size_t)512 * 2 * 3 * FFN * 4 <= WS_END, "B map");
constexpr int CW_BAR = 4096;

constexpr int RING_BYTES = 131072;
constexpr int LDSCTL_OFF = RING_BYTES, MISC_OFF = LDSCTL_OFF + 320;
constexpr int LDS_BYTES = 147456;

#define GAS __attribute__((address_space(1)))
#define LAS __attribute__((address_space(3)))
typedef unsigned short bf16;
typedef unsigned v4u __attribute__((ext_vector_type(4)));
typedef float f32x4 __attribute__((ext_vector_type(4)));
typedef short bf16x8 __attribute__((ext_vector_type(8)));
typedef GAS unsigned gu32;
typedef GAS unsigned long long gu64;
#define RLX_AGENT __ATOMIC_RELAXED, __HIP_MEMORY_SCOPE_AGENT
#define LDS_WAIT() asm volatile("s_waitcnt lgkmcnt(0)" ::: "memory")
#define VM_WAIT() asm volatile("s_waitcnt vmcnt(0)" ::: "memory")
__device__ __forceinline__ unsigned long long rt() { return __builtin_amdgcn_s_memrealtime(); }
__device__ __forceinline__ unsigned f2bf(float f) { unsigned u = __builtin_bit_cast(unsigned, f); return (u + 0x7fffu + ((u >> 16) & 1u)) >> 16; }
__device__ __forceinline__ unsigned pk2(float lo, float hi) { return f2bf(lo) | (f2bf(hi) << 16); }

#define XB_TMO      128
#define XB_XCNT(j)  (256  + 64 * (j))
#define XB_XSUB(j)  (1280 + 64 * (j))
#define XB_XGEN(j)  (2304 + 64 * (j))
#define XB_TOP      3328
#define XB_TOPGEN   3392
#define XCD_BAR_WORDS 3456
#define XB_SPIN_CAP (1u << 18)

__device__ __forceinline__ unsigned xb_ld(unsigned* p)              { return __hip_atomic_load(p, __ATOMIC_RELAXED, __HIP_MEMORY_SCOPE_AGENT); }
__device__ __forceinline__ unsigned xb_add(unsigned* p, unsigned v) { return __hip_atomic_fetch_add(p, v, __ATOMIC_RELAXED, __HIP_MEMORY_SCOPE_AGENT); }
__device__ __forceinline__ unsigned xb_xcc_id() { return (unsigned)__builtin_amdgcn_s_getreg((3 << 11) | 20) & 0xFu; }
#define XB_SPIN(cond, bar) do { unsigned _sp = 0; while (cond) { __builtin_amdgcn_s_sleep(1); \
    if ((++_sp & 255u) == 0u) { if (xb_ld(&(bar)[XB_TMO])) break; if (_sp > XB_SPIN_CAP) { atomicAdd(&(bar)[XB_TMO], 1u); break; } } } } while (0)

struct XcdBarrier {
    unsigned* bar; unsigned x;
    volatile LAS unsigned* st;
};

__device__ __forceinline__ XcdBarrier xcd_barrier_post(unsigned* bar, volatile LAS unsigned* st) {
    XcdBarrier b; b.bar = bar; b.x = xb_xcc_id(); b.st = st;
    if (threadIdx.x == 0) (void)xb_add(&bar[XB_XCNT(b.x)], 1u);
    return b;
}
__device__ __forceinline__ void xcd_barrier_complete(unsigned* bar, unsigned x, unsigned& nloc, unsigned& nx) {
    const unsigned G = gridDim.x * gridDim.y * gridDim.z;
    unsigned sum, cnt, mine, sp = 0u;
    for (;;) {
        sum = 0u; cnt = 0u; mine = 0u;
#pragma unroll
        for (unsigned j = 0; j < 16; ++j) { const unsigned c = xb_ld(&bar[XB_XCNT(j)]); sum += c; cnt += (c > 0u) ? 1u : 0u; mine = (j == x) ? c : mine; }
        if (sum == G) break;
        __builtin_amdgcn_s_sleep(1);
        if ((++sp & 255u) == 0u) { if (xb_ld(&bar[XB_TMO])) break; if (sp > XB_SPIN_CAP) { atomicAdd(&bar[XB_TMO], 1u); break; } }
    }
    nloc = mine > 0u ? mine : 1u; nx = cnt > 0u ? cnt : 1u;
}

__device__ __forceinline__ void xcd_barrier(const XcdBarrier& b) {
    asm volatile("s_waitcnt vmcnt(0)" ::: "memory");
    __syncthreads();
    if (threadIdx.x == 0) {
        unsigned* bar = b.bar;
        __builtin_amdgcn_s_waitcnt(0);
        unsigned nloc = b.st[0], nx = b.st[1];
        if (nloc == 0u) { xcd_barrier_complete(bar, b.x, nloc, nx); b.st[0] = nloc; b.st[1] = nx; }
        const unsigned old = xb_add(&bar[XB_XSUB(b.x)], 1u);
        const unsigned gen = old / nloc;
        if (old + 1u == (gen + 1u) * nloc) {
            __builtin_amdgcn_fence(__ATOMIC_RELEASE, "agent");
            asm volatile("s_waitcnt vmcnt(0)" ::: "memory");
            const unsigned og = xb_add(&bar[XB_TOP], 1u);
            const unsigned tg = og / nx;
            if (og + 1u == (tg + 1u) * nx) xb_add(&bar[XB_TOPGEN], 1u);
            else XB_SPIN(xb_ld(&bar[XB_TOPGEN]) == tg, bar);
            __builtin_amdgcn_fence(__ATOMIC_ACQUIRE, "agent");
            xb_add(&bar[XB_XGEN(b.x)], 1u);
            asm volatile("s_waitcnt vmcnt(0)" ::: "memory");
        } else {
            XB_SPIN(xb_ld(&bar[XB_XGEN(b.x)]) == gen, bar);
            __builtin_amdgcn_fence(__ATOMIC_ACQUIRE, "agent");
            asm volatile("s_waitcnt vmcnt(0)" ::: "memory");
        }
    }
    __syncthreads();
}

__device__ __forceinline__ float bf2f(unsigned short b) { return __builtin_bit_cast(float, (unsigned)b << 16); }
__device__ __forceinline__ float bf2f(short b) { return __builtin_bit_cast(float, (unsigned)(unsigned short)b << 16); }
__device__ __forceinline__ float wave_sum(float v) {
#pragma unroll
    for (int o = 1; o < 64; o <<= 1) v += __shfl_xor(v, o);
    return v;
}
__device__ __forceinline__ float wave_max(float v) {
#pragma unroll
    for (int o = 1; o < 64; o <<= 1) v = fmaxf(v, __shfl_xor(v, o));
    return v;
}
__device__ __forceinline__ float fast_exp(float x) { return __builtin_amdgcn_exp2f(x * 1.4426950408889634f); }
__device__ __forceinline__ float sigmoidf_(float x) { return __builtin_amdgcn_rcpf(1.f + fast_exp(-x)); }
__device__ __forceinline__ float gelu_tanh(float x) {
    const float z = 0.7978845608028654f * (x + 0.044715f * x * x * x);
    return x * sigmoidf_(2.f * z);
}
__device__ __forceinline__ float neg_expm1(float x) {
    const float p = x * (1.f + x * (0.5f + x * (0.16666667f + x * (0.041666668f + x * (0.0083333338f + x * 0.0013888889f)))));
    const float e = fast_exp(x) - 1.f;
    return -(fabsf(x) < 0.25f ? p : e);
}
__device__ __forceinline__ v4u pack8(const float (&v)[8]) { v4u o; o.x = pk2(v[0], v[1]); o.y = pk2(v[2], v[3]); o.z = pk2(v[4], v[5]); o.w = pk2(v[6], v[7]); return o; }

#define FIN(F, idx) ({ const __attribute__((address_space(1))) float* p_; asm("s_load_dwordx2 %0, %1, %2 ; tag %3\n\ts_waitcnt lgkmcnt(0)" : "=s"(p_) : "s"((F).kargs), "i"((idx) * 8), "s"((F).ptag)); (const float*)p_; })
struct Frame {
    LAS unsigned char* lds;
    volatile LAS unsigned* MISC;
    gu32* ctl;
    int tid, lane, wave, vcu, G;
    const __attribute__((address_space(4))) void* kargs; int ptag;
    float* out;
    unsigned char* ws;
#define WSP(T, NAME, OFF) __device__ __forceinline__ T* NAME() const { return (T*)(ws + (OFF)); }
    WSP(bf16, WIN_T, WS_WIN) WSP(bf16, WOUT_T, WS_WOUT) WSP(bf16, WUP_T, WS_WUP) WSP(bf16, WDOWN_T, WS_WDOWN) WSP(bf16, WG, WS_WG) WSP(bf16, XN, WS_A) WSP(bf16, QG, WS_QG) WSP(bf16, K, WS_K) WSP(bf16, V, WS_V)
    WSP(bf16, XR, WS_XR) WSP(bf16, ACT, WS_ACT) WSP(float, EDGE, WS_EDGE) WSP(bf16, XNMETA, WS_XNMETA) WSP(bf16, KM, WS_KM) WSP(bf16, VM, WS_VM)
    WSP(float, ZM, WS_ZM) WSP(float, Q15, WS_Q15) WSP(float, GY15, WS_GY15) WSP(float, LO15, WS_LO15) WSP(float, MIXED15, WS_MIXED15) WSP(float, Y15, WS_Y15) WSP(float, G15, WS_G15) WSP(float, MQP, WS_MQP)
    WSP(float, CIN, WS_CIN) WSP(float2, CAR, WS_CAR) WSP(float, R0, WS_R0) WSP(float, RATIO, WS_RATIO) WSP(float, RL, WS_RL) WSP(float, SSQA, WS_SSQA) WSP(float, SSQL, WS_SSQL)
#undef WSP
};

template <bool UPMAP, int GAIN = 0>
__device__ __forceinline__ void p0_transpose_item(const float* W, int K, int N, bf16* WT, int row_off, LAS float* scr, int item, int lane, const float* g0 = nullptr, const float* g1 = nullptr) {
    const int nblk = N / 32, kb = item / nblk, nb = item % nblk, k0 = 64 * kb, n0 = 32 * nb;
    const int orow0 = UPMAP ? (((n0 % FFN) >> 7) << 8) + 128 * (n0 / FFN) + ((n0 % FFN) & 127) : row_off + n0;
#pragma unroll 8
    for (int i = 0; i < 32; ++i) { const int kk = 2 * i + (lane >> 5); float gv = 1.f; if (GAIN == 1) gv = g0[k0 + kk]; if (GAIN == 2) gv = (k0 + kk) < 1024 ? g0[k0 + kk] : g1[k0 + kk - 1024];
        scr[kk * 33 + (lane & 31)] = W[(size_t)(k0 + kk) * N + n0 + (lane & 31)] * gv; }
    LDS_WAIT(); asm volatile("" ::: "memory");
    const int c = lane & 7;
#pragma unroll
    for (int j = 0; j < 4; ++j) { const int n = (lane >> 3) + 8 * j; const LAS float* s = scr + (8 * c) * 33 + n;
        v4u o; o.x = pk2(s[0 * 33], s[1 * 33]); o.y = pk2(s[2 * 33], s[3 * 33]); o.z = pk2(s[4 * 33], s[5 * 33]); o.w = pk2(s[6 * 33], s[7 * 33]);
        *(GAS v4u*)(WT + (size_t)(orow0 + n) * K + k0 + 8 * c) = o; }
    LDS_WAIT(); asm volatile("" ::: "memory");
}
__device__ __forceinline__ void rms_row_to_bf16(const float* xrow, bf16* orow, int lane, float* rout) {
    const GAS f32x4* xr = (const GAS f32x4*)xrow + lane;
    f32x4 v[8]; float s = 0.f;
#pragma unroll
    for (int j = 0; j < 8; ++j) { v[j] = xr[64 * j]; s += (v[j].x * v[j].x + v[j].y * v[j].y) + (v[j].z * v[j].z + v[j].w * v[j].w); }
    const float r = 1.f / sqrtf(wave_sum(s) * (1.f / DM) + EPS);
    GAS unsigned long long* o8 = (GAS unsigned long long*)orow + lane;
#pragma unroll
    for (int j = 0; j < 8; ++j) o8[64 * j] = (unsigned long long)pk2(v[j].x * r, v[j].y * r) | ((unsigned long long)pk2(v[j].z * r, v[j].w * r) << 32);
    if (rout && lane == 0) *rout = r;
}
__device__ __forceinline__ void p0_prologue(Frame& F) {
    LAS float* scr = (LAS float*)(F.lds + F.wave * 16384);
    const int gw = F.vcu * NWAVES + F.wave, NGW = F.G * NWAVES;
    constexpr int I_IN = (DM / 64) * (INW / 32), I_OUT = (DM / 64) * (DM / 32), I_UP = (DM / 64) * (UPW / 32), I_DN = (FFN / 64) * (DM / 32), I_G = 32 * 8;
    constexpr int NITEMS = I_IN + I_OUT + I_UP + I_DN + I_G;
    for (int it = gw; it < NITEMS; it += NGW) {
        int r = it;
        if (r < I_IN) { p0_transpose_item<false, 1>(FIN(F, 4  ), DM, INW, F.WIN_T(), 0, scr, r, F.lane, FIN(F, 3  )); continue; } r -= I_IN;
        if (r < I_OUT) { p0_transpose_item<false, 2>(FIN(F, 16  ), DM, DM, F.WOUT_T(), 0, scr, r, F.lane, FIN(F, 14  ), FIN(F, 15  )); continue; } r -= I_OUT;
        if (r < I_UP) { p0_transpose_item<true>(FIN(F, 19  ), DM, UPW, F.WUP_T(), 0, scr, r, F.lane); continue; } r -= I_UP;
        if (r < I_DN) { p0_transpose_item<false>(FIN(F, 22  ), FFN, DM, F.WDOWN_T(), 0, scr, r, F.lane); continue; } r -= I_DN;
        {
            const int mi = r >> 3, sub = r & 7, gate = mi >> 4, dir = (mi >> 3) & 1, blk = mi & 7;
            const float* W = (gate ? FIN(F, 11  ) : FIN(F, 9  )) + (size_t)(dir * 8 + blk) * 16384;
            bf16* WT = F.WG() + (size_t)((dir * 2 + gate) * 8 + blk) * 16384;
            p0_transpose_item<false>(W, 128, 128, WT, 0, scr, sub, F.lane);
        }
    }
    for (int m = gw; m < NTOK; m += NGW) {
        const float* xr = m < 32768 ? FIN(F, 0  ) + (size_t)m * DM : FIN(F, 1  ) + (size_t)(m - 32768) * DM;
        rms_row_to_bf16(xr, F.XN() + (size_t)m * DM, F.lane, F.R0() + m);
    }
    for (int m = gw; m < 16; m += NGW) rms_row_to_bf16(FIN(F, 2  ) + (size_t)m * DM, F.XNMETA() + (size_t)m * DM, F.lane, nullptr);
    const int gt = F.vcu * 512 + F.tid, NGT = F.G * 512; const v4u z4 = {0u, 0u, 0u, 0u};
    for (int i = gt; i < 12 * 48 * 128; i += NGT) { const int s = i / (48 * 128), rem = i % (48 * 128); ((GAS v4u*)(F.XR() + (size_t)xr_base(s) * 1024))[rem] = z4; }
    for (int i = gt; i < 64 * 128; i += NGT) ((GAS v4u*)(F.XR() + (size_t)XR_ROWS * 1024))[i] = z4;
    for (int i = gt; i < 2048; i += NGT) { ((GAS v4u*)F.KM())[i] = z4; ((GAS v4u*)F.VM())[i] = z4; }
}

template <int R, class Out, bool GMAP = false>
__device__ __forceinline__ void small_gemm(const LAS float* X, int K, const bf16* Wt, int N, int gw, int NGW, int lane, const Out& out) {
    for (int n = gw; n < N; n += NGW) {
        float acc[R];
#pragma unroll
        for (int r = 0; r < R; ++r) acc[r] = 0.f;
        const GAS bf16x8* wrow = (const GAS bf16x8*)(Wt + (size_t)(GMAP ? ((n >> 7) << 8) + (n & 127) : n) * K);
        for (int k8 = lane; k8 < K / 8; k8 += 64) {
            const bf16x8 w = wrow[k8]; float wf[8];
#pragma unroll
            for (int j = 0; j < 8; ++j) wf[j] = bf2f(w[j]);
#pragma unroll
            for (int r = 0; r < R; ++r) { const LAS f32x4* xp = (const LAS f32x4*)(X + r * K + k8 * 8); const f32x4 a = xp[0], b = xp[1];
                acc[r] += (a.x * wf[0] + a.y * wf[1]) + (a.z * wf[2] + a.w * wf[3]) + (b.x * wf[4] + b.y * wf[5]) + (b.z * wf[6] + b.w * wf[7]); }
        }
        float v = 0.f;
#pragma unroll
        for (int r = 0; r < R; ++r) { const float s = wave_sum(acc[r]); v = (lane == r) ? s : v; }
        out(n, lane, v);
    }
}
struct OutMetaZ { float* ZM; bf16* XR;
    __device__ __forceinline__ void operator()(int n, int lane, float v) const {
        if (lane < 16) { ZM[lane * INW + n] = v;
            if (n >= 1536 && n < 2560) { const unsigned short b = (unsigned short)f2bf(v); const int c = n - 1536;
                for (int s = 0; s < 12; ++s) XR[(size_t)(xr_base(s) + 48 + lane) * 1024 + c] = b; } }
    } };
struct OutRows { float* Y; int ld; int R;
    __device__ __forceinline__ void operator()(int n, int lane, float v) const { if (lane < R) Y[(size_t)lane * ld + n] = v; } };

__device__ __forceinline__ void p1_meta_z(Frame& F) {
    LAS float* X = (LAS float*)F.lds;
    for (int i = F.tid; i < 16 * DM / 8; i += 512) { const bf16x8 v = ((const GAS bf16x8*)F.XNMETA())[i];
        ((LAS f32x4*)X)[2 * i] = (f32x4){bf2f(v[0]), bf2f(v[1]), bf2f(v[2]), bf2f(v[3])}; ((LAS f32x4*)X)[2 * i + 1] = (f32x4){bf2f(v[4]), bf2f(v[5]), bf2f(v[6]), bf2f(v[7])}; }
    __syncthreads();
    const OutMetaZ o{F.ZM(), F.XR()};
    small_gemm<16, OutMetaZ>(X, DM, F.WIN_T(), INW, F.vcu * NWAVES + F.wave, F.G * NWAVES, F.lane, o);
    __syncthreads();
}
typedef float f32x16 __attribute__((ext_vector_type(16)));
constexpr int LRU_XC0 = 0, LRU_XC_BUF = 17408, LRU_XC_STRIDE = 272;
constexpr int LRU_CW = 34816;
constexpr int LRU_HF = 37376, LRU_HB = LRU_HF + 32768;
__device__ __forceinline__ int crow16(int r, int hi) { return (r & 3) + 8 * (r >> 2) + 4 * hi; }

template <int DIR>
__device__ __forceinline__ void scan_tile(const float (&a)[16], const float (&u)[16], float& carry, float& ptot, float (&h)[16], bool up) {
    float HL[16], PL[16], As[4], Hs[4];
#pragma unroll
    for (int j = 0; j < 4; ++j) {
        float hl = 0.f, p = 1.f;
#pragma unroll
        for (int ii = 0; ii < 4; ++ii) { const int idx = 4 * j + (DIR == 0 ? ii : 3 - ii); hl = a[idx] * hl + u[idx]; p *= a[idx]; HL[idx] = hl; PL[idx] = p; }
        As[j] = p; Hs[j] = hl;
    }
    float Alo[4], Ahi[4], Hlo[4], Hhi[4];
#pragma unroll
    for (int j = 0; j < 4; ++j) {
        { const unsigned x = __float_as_uint(As[j]); auto rr = __builtin_amdgcn_permlane32_swap(x, x, false, false); Alo[j] = __uint_as_float(rr[0]); Ahi[j] = __uint_as_float(rr[1]); }
        { const unsigned x = __float_as_uint(Hs[j]); auto rr = __builtin_amdgcn_permlane32_swap(x, x, false, false); Hlo[j] = __uint_as_float(rr[0]); Hhi[j] = __uint_as_float(rr[1]); }
    }
    float cin[4]; float c = carry;
    if (DIR == 0) {
#pragma unroll
        for (int j = 0; j < 4; ++j) { const float c_lo = c; c = Alo[j] * c + Hlo[j]; const float c_hi = c; c = Ahi[j] * c + Hhi[j]; cin[j] = up ? c_hi : c_lo; }
    } else {
#pragma unroll
        for (int j = 3; j >= 0; --j) { const float c_hi = c; c = Ahi[j] * c + Hhi[j]; const float c_lo = c; c = Alo[j] * c + Hlo[j]; cin[j] = up ? c_hi : c_lo; }
    }
    carry = c;
#pragma unroll
    for (int j = 0; j < 4; ++j) ptot *= Alo[j] * Ahi[j];
#pragma unroll
    for (int idx = 0; idx < 16; ++idx) h[idx] = HL[idx] + PL[idx] * cin[idx >> 2];
}

__device__ __forceinline__ void lru_decode(int cg, int& seq, int& c) { if (cg < 520) { seq = cg / 65; c = cg - seq * 65; } else { const int c2 = cg - 520; seq = c2 / 129; c = c2 - seq * 129; seq += 8; } }
template <int PASS>
__device__ __forceinline__ void lru_phase(Frame& F, bf16* gout) {
    LAS unsigned char* L = F.lds;
    const int tid = F.tid, lane = F.lane, wave = F.wave;
    const int n = F.vcu & 7, ngrp = F.G >> 3;
    { const float* cw = FIN(F, 7  ); const float* cb = FIN(F, 8  );
      for (int i = tid; i < 640; i += 512) { const int k = i >> 7, ch = i & 127; ((LAS float*)(L + LRU_CW))[i] = k < 4 ? cw[k * 1024 + n * 128 + ch] : cb[n * 128 + ch]; } }
    const int d = wave >> 2, g4 = wave & 3, r32 = lane & 31, hi = lane >> 5, chl = g4 * 32 + r32, chg = n * 128 + chl;
    bf16x8 br[8], bi[8];
    { const bf16* wr_ = F.WG() + (size_t)((d * 2 + 0) * 8 + n) * 16384 + chl * 128 + hi * 8;
      const bf16* wi_ = F.WG() + (size_t)((d * 2 + 1) * 8 + n) * 16384 + chl * 128 + hi * 8;
#pragma unroll
      for (int ks = 0; ks < 8; ++ks) { br[ks] = *(const GAS bf16x8*)(wr_ + ks * 16); bi[ks] = *(const GAS bf16x8*)(wi_ + ks * 16); } }
    constexpr float L2E = 1.4426950408889634f;
    const float nb_r = -L2E * FIN(F, 10  )[d * 1024 + chg], nb_i = -L2E * FIN(F, 12  )[d * 1024 + chg];
    const float spl = 8.f * L2E * log1pf(expf(-FIN(F, 13  )[d * 1024 + chg]));
    const int tau0 = tid >> 4, co = (tid & 15) * 8;
    bf16x8 xv[2][4];
#define LRU_PREFETCH(cgx) do { int s_, c_; lru_decode((cgx), s_, c_); const int xb_ = xr_base(s_); \
        _Pragma("unroll") for (int it_ = 0; it_ < 2; ++it_) _Pragma("unroll") for (int k_ = 0; k_ < 4; ++k_) { int row_ = xb_ + c_ * 64 + tau0 + 32 * it_ + k_ - 2; row_ = row_ < 0 ? 0 : row_; \
            xv[it_][k_] = *(const GAS bf16x8*)(F.XR() + (size_t)row_ * 1024 + n * 128 + co); } } while (0)
    int cg = F.vcu >> 3;
    if (cg < NCHUNK) LRU_PREFETCH(cg);
    __syncthreads();
    for (int ui = 0; cg < NCHUNK; cg += ngrp, ++ui) {
        int seq, c; lru_decode(cg, seq, c);
        LAS unsigned char* XC = L + LRU_XC0 + (ui & 1) * LRU_XC_BUF;
        float carry = 0.f, ptot = 1.f;
        if (PASS == 2) carry = F.CIN()[((size_t)cg * 2 + d) * 1024 + chg];
#pragma unroll
        for (int it = 0; it < 2; ++it) {
            const int tau = tau0 + 32 * it; float xc[8];
            { const LAS f32x4* cb = (const LAS f32x4*)(L + LRU_CW + (4 * 128 + co) * 4); const f32x4 b0 = cb[0], b1 = cb[1];
              xc[0] = b0.x; xc[1] = b0.y; xc[2] = b0.z; xc[3] = b0.w; xc[4] = b1.x; xc[5] = b1.y; xc[6] = b1.z; xc[7] = b1.w; }
#pragma unroll
            for (int k = 0; k < 4; ++k) { const LAS f32x4* wp = (const LAS f32x4*)(L + LRU_CW + (k * 128 + co) * 4); const f32x4 w0 = wp[0], w1 = wp[1]; const bf16x8 v = xv[it][k];
                xc[0] += w0.x * bf2f(v[0]); xc[1] += w0.y * bf2f(v[1]); xc[2] += w0.z * bf2f(v[2]); xc[3] += w0.w * bf2f(v[3]);
                xc[4] += w1.x * bf2f(v[4]); xc[5] += w1.y * bf2f(v[5]); xc[6] += w1.z * bf2f(v[6]); xc[7] += w1.w * bf2f(v[7]); }
            if (c == 0 && tau < 48) {
#pragma unroll
                for (int j = 0; j < 8; ++j) xc[j] = 0.f;
            }
            *(LAS v4u*)(XC + tau * LRU_XC_STRIDE + co * 2) = pack8(xc);
        }
        bf16x8 gv[2];
        const int row0 = seq_first_row(seq) + 64 * (c - 1);
        if (PASS == 2) { if (c > 0) {
#pragma unroll
            for (int it = 0; it < 2; ++it) gv[it] = *(const GAS bf16x8*)(F.QG() + (size_t)(row0 + tau0 + 32 * it) * DM + 1024 + n * 128 + co); } }
        __syncthreads();
        if (cg + ngrp < NCHUNK) LRU_PREFETCH(cg + ngrp);
        f32x16 arT[2], aiT[2];
#pragma unroll
        for (int tt = 0; tt < 2; ++tt) {
            const int tile = d ? 1 - tt : tt;
            f32x16 ar = {}, ai = {};
#pragma unroll
            for (int ks = 0; ks < 8; ++ks) {
                const bf16x8 a = *(const LAS bf16x8*)(XC + (tile * 32 + r32) * LRU_XC_STRIDE + (ks * 16 + hi * 8) * 2);
                ar = __builtin_amdgcn_mfma_f32_32x32x16_bf16(a, br[ks], ar, 0, 0, 0);
                ai = __builtin_amdgcn_mfma_f32_32x32x16_bf16(a, bi[ks], ai, 0, 0, 0);
            }
            arT[tt] = ar; aiT[tt] = ai;
        }
#pragma unroll
        for (int tt = 0; tt < 2; ++tt) {
            const int tile = d ? 1 - tt : tt;
            const f32x16 ar = arT[tt], ai = aiT[tt];
            float av[16], uv[16], hv[16];
            typedef float f32x2 __attribute__((ext_vector_type(2)));
#pragma unroll
            for (int r = 0; r < 16; r += 2) {
                const int tau0_ = tile * 32 + crow16(r, hi);
                const f32x2 xc2 = {bf2f(*(const LAS unsigned short*)(XC + tau0_ * LRU_XC_STRIDE + chl * 2)), bf2f(*(const LAS unsigned short*)(XC + (tau0_ + 1) * LRU_XC_STRIDE + chl * 2))};
                const f32x2 tr = (f32x2){ar[r], ar[r + 1]} * (f32x2){-L2E, -L2E} + (f32x2){nb_r, nb_r};
                const f32x2 ti = (f32x2){ai[r], ai[r + 1]} * (f32x2){-L2E, -L2E} + (f32x2){nb_i, nb_i};
                const f32x2 dr = (f32x2){__builtin_amdgcn_exp2f(tr.x), __builtin_amdgcn_exp2f(tr.y)} + (f32x2){1.f, 1.f};
                const f32x2 di = (f32x2){__builtin_amdgcn_exp2f(ti.x), __builtin_amdgcn_exp2f(ti.y)} + (f32x2){1.f, 1.f};
                const f32x2 rg = {__builtin_amdgcn_rcpf(dr.x), __builtin_amdgcn_rcpf(dr.y)}, ig = {__builtin_amdgcn_rcpf(di.x), __builtin_amdgcn_rcpf(di.y)};
                const f32x2 la = rg * (f32x2){-spl, -spl};
                const f32x2 a = {__builtin_amdgcn_exp2f(la.x), __builtin_amdgcn_exp2f(la.y)};
                const f32x2 t = (f32x2){1.f, 1.f} - a * a;
                const f32x2 m = {__builtin_amdgcn_sqrtf(t.x), __builtin_amdgcn_sqrtf(t.y)};
                const f32x2 u = m * (ig * xc2);
                av[r] = a.x; av[r + 1] = a.y; uv[r] = u.x; uv[r + 1] = u.y;
            }
            if (d == 0) scan_tile<0>(av, uv, carry, ptot, hv, hi != 0); else scan_tile<1>(av, uv, carry, ptot, hv, hi != 0);
            if (PASS == 2) {
#pragma unroll
                for (int r = 0; r < 16; ++r) { const int tau = tile * 32 + crow16(r, hi); *(LAS float*)(L + (d ? LRU_HB : LRU_HF) + (tau * 128 + chl) * 4) = hv[r]; }
            }
        }
        if (PASS == 1) { if (hi == 0) F.CAR()[((size_t)cg * 2 + d) * 1024 + chg] = make_float2(ptot, carry); }
        if (PASS == 2) {
            __syncthreads();
            if (c > 0) {
#pragma unroll
                for (int it = 0; it < 2; ++it) {
                    const int tau = tau0 + 32 * it; const bf16x8 g8 = gv[it];
                    const LAS f32x4* hf = (const LAS f32x4*)(L + LRU_HF + (tau * 128 + co) * 4); const LAS f32x4* hb = (const LAS f32x4*)(L + LRU_HB + (tau * 128 + co) * 4);
                    const f32x4 f0 = hf[0], f1 = hf[1], b0 = hb[0], b1 = hb[1];
                    float o[8];
                    o[0] = (f0.x + b0.x) * gelu_tanh(bf2f(g8[0])); o[1] = (f0.y + b0.y) * gelu_tanh(bf2f(g8[1])); o[2] = (f0.z + b0.z) * gelu_tanh(bf2f(g8[2])); o[3] = (f0.w + b0.w) * gelu_tanh(bf2f(g8[3]));
                    o[4] = (f1.x + b1.x) * gelu_tanh(bf2f(g8[4])); o[5] = (f1.y + b1.y) * gelu_tanh(bf2f(g8[5])); o[6] = (f1.z + b1.z) * gelu_tanh(bf2f(g8[6])); o[7] = (f1.w + b1.w) * gelu_tanh(bf2f(g8[7]));
                    *(GAS v4u*)(gout + (size_t)(row0 + tau) * DM + 1024 + n * 128 + co) = pack8(o);
                    float sq = (o[0] * o[0] + o[1] * o[1]) + (o[2] * o[2] + o[3] * o[3]) + (o[4] * o[4] + o[5] * o[5]) + (o[6] * o[6] + o[7] * o[7]);
                    sq += __shfl_xor(sq, 1); sq += __shfl_xor(sq, 2); sq += __shfl_xor(sq, 4); sq += __shfl_xor(sq, 8);
                    if ((tid & 15) == 0) F.SSQL()[(size_t)(row0 + tau) * 8 + n] = sq;
                }
            } else if (tid < 128) {
                const float hf = *(const LAS float*)(L + LRU_HF + (63 * 128 + tid) * 4), hb = *(const LAS float*)(L + LRU_HB + (63 * 128 + tid) * 4);
                F.LO15()[seq * 1024 + n * 128 + tid] = (hf + hb) * gelu_tanh(F.GY15()[n * 128 + tid]);
            }
        }
    }
    __syncthreads();
#undef LRU_PREFETCH
}
__device__ __forceinline__ void lru_propagate(Frame& F) {
    const int gid = F.vcu * 512 + F.tid;
    if (gid < 12 * 2048) {
        const int s = gid >> 11, d = (gid >> 10) & 1, ch = gid & 1023; const int nch = s < 8 ? 65 : 129, cb = chunk_base(s);
        const float2* car = F.CAR() + (size_t)d * 1024 + ch; float* cinp = F.CIN() + (size_t)d * 1024 + ch;
        float cin = 0.f;
        for (int b0 = 0; b0 < nch; b0 += 16) {
            float2 ph[16];
#pragma unroll
            for (int i = 0; i < 16; ++i) { const int cc = b0 + i; const int c = d ? nch - 1 - cc : cc; if (cc < nch) ph[i] = car[(size_t)(cb + c) * 2048]; }
#pragma unroll
            for (int i = 0; i < 16; ++i) { const int cc = b0 + i; const int c = d ? nch - 1 - cc : cc; if (cc < nch) { cinp[(size_t)(cb + c) * 2048] = cin; cin = ph[i].x * cin + ph[i].y; } }
        }
    }
}

__device__ __forceinline__ void k_rope_pass(Frame& F, bf16* Kout) {
    const int gw = F.vcu * NWAVES + F.wave, NGW = F.G * NWAVES, sub = F.lane >> 4, l16 = F.lane & 15;
    const int c0 = 8 * l16, p = l16 >> 3, half = (l16 >> 2) & 1, i0 = 8 * (l16 & 3);
    float inv[8], gk[8];
#pragma unroll
    for (int j = 0; j < 8; ++j) { inv[j] = __builtin_amdgcn_exp2f(-(float)(i0 + j) * (13.287712379549449f / 32.f)) * 0.15915494309189535f; gk[j] = FIN(F, 6  )[c0 + j]; }
    for (int it = gw; it < NTOK * 2 / 4; it += NGW) {
        const int item = it * 4 + sub, row = item >> 1, hk = item & 1;
        const int s = row_seq(row), t = row - seq_first_row(s); const float pos = (float)(p ? (t & 63) : (t >> 6));
        bf16* kp = F.K() + (size_t)row * 256 + hk * 128 + c0;
        const bf16x8 v = *(const GAS bf16x8*)kp; float x[8]; float ss = 0.f;
#pragma unroll
        for (int j = 0; j < 8; ++j) { x[j] = bf2f(v[j]); ss += x[j] * x[j]; }
        ss += __shfl_xor(ss, 1); ss += __shfl_xor(ss, 2); ss += __shfl_xor(ss, 4); ss += __shfl_xor(ss, 8);
        const float rs = 1.f / sqrtf(ss * (1.f / 128.f) + EPS); float o[8];
#pragma unroll
        for (int j = 0; j < 8; ++j) { x[j] *= rs * gk[j]; const float pr = __shfl_xor(x[j], 4);
            float rev = pos * inv[j]; rev -= floorf(rev); const float sn = __builtin_amdgcn_sinf(rev), cs = __builtin_amdgcn_cosf(rev);
            o[j] = half ? x[j] * cs + pr * sn : x[j] * cs - pr * sn; }
        *(GAS v4u*)(Kout + (size_t)row * 256 + hk * 128 + c0) = pack8(o);
    }
}
__device__ __forceinline__ void p3_meta_job(Frame& F) {
    for (int pr = F.wave; pr < 32; pr += 8) { const int r = pr >> 1, hk = pr & 1; const float* z = F.ZM() + r * INW + 1024 + hk * 128;
        const float a = z[F.lane], b = z[F.lane + 64]; const float rs = 1.f / sqrtf(wave_sum(a * a + b * b) * (1.f / 128.f) + EPS);
        F.KM()[r * 256 + hk * 128 + F.lane] = (bf16)f2bf(a * rs * FIN(F, 6  )[F.lane]); F.KM()[r * 256 + hk * 128 + F.lane + 64] = (bf16)f2bf(b * rs * FIN(F, 6  )[F.lane + 64]); }
    for (int i = F.tid; i < 16 * 256; i += 512) F.VM()[i] = (bf16)f2bf(F.ZM()[(i >> 8) * INW + 1280 + (i & 255)]);
    { const int h = F.wave; const float* z = F.ZM() + 15 * INW + h * 128; const float a = z[F.lane], b = z[F.lane + 64];
      const float rs = 1.f / sqrtf(wave_sum(a * a + b * b) * (1.f / 128.f) + EPS);
      F.Q15()[h * 128 + F.lane] = a * rs * FIN(F, 5  )[F.lane]; F.Q15()[h * 128 + F.lane + 64] = b * rs * FIN(F, 5  )[F.lane + 64]; }
    for (int i = F.tid; i < 1024; i += 512) F.GY15()[i] = F.ZM()[15 * INW + 2560 + i];
}

__device__ __forceinline__ void metaq_item(Frame& F, int it) {
    int s, kvh, j; if (it < 256) { s = it >> 5; kvh = (it >> 4) & 1; j = it & 15; } else { const int t2 = it - 256; s = 8 + (t2 >> 6); kvh = (t2 >> 5) & 1; j = t2 & 31; }
    LAS float* q4 = (LAS float*)F.lds;
    LAS float* sc = q4 + 512;
    LAS float* red = sc + 4 * 288;
    const int tid = F.tid, nk = 256 + (j == 0 ? 16 : 0), row0 = seq_first_row(s) + 256 * j;
    q4[tid] = F.Q15()[kvh * 512 + tid];
    __syncthreads();
    if (tid < nk) {
        const bf16* kp = tid < 256 ? F.K() + (size_t)(row0 + tid) * 256 + kvh * 128 : F.KM() + (tid - 256) * 256 + kvh * 128;
        float d0 = 0.f, d1 = 0.f, d2 = 0.f, d3 = 0.f;
#pragma unroll 4
        for (int cc = 0; cc < 16; ++cc) { const bf16x8 kv = ((const GAS bf16x8*)kp)[cc];
#pragma unroll
            for (int e = 0; e < 8; ++e) { const float kf = bf2f(kv[e]); d0 += kf * q4[cc * 8 + e]; d1 += kf * q4[128 + cc * 8 + e]; d2 += kf * q4[256 + cc * 8 + e]; d3 += kf * q4[384 + cc * 8 + e]; } }
        const float SC = 0.088388347648318440f;
        sc[tid] = d0 * SC; sc[288 + tid] = d1 * SC; sc[576 + tid] = d2 * SC; sc[864 + tid] = d3 * SC;
    }
    __syncthreads();
    if (F.wave < 4) { LAS float* sh = sc + F.wave * 288; float m = -INFINITY;
        for (int k = F.lane; k < nk; k += 64) m = fmaxf(m, sh[k]);
        m = wave_max(m); float l = 0.f;
        for (int k = F.lane; k < nk; k += 64) { const float p = __expf(sh[k] - m); sh[k] = p; l += p; }
        l = wave_sum(l);
        if (F.lane == 0) { red[F.wave * 2] = m; red[F.wave * 2 + 1] = l; } }
    __syncthreads();
    {
        const int kg = tid >> 4, oc = tid & 15; float o[4][8];
#pragma unroll
        for (int h = 0; h < 4; ++h)
#pragma unroll
            for (int e = 0; e < 8; ++e) o[h][e] = 0.f;
        const bf16* vp = F.V() + (size_t)(row0 + kg * 8) * 256 + kvh * 128 + oc * 8;
        bf16x8 vv[8];
#pragma unroll
        for (int k = 0; k < 8; ++k) vv[k] = *(const GAS bf16x8*)(vp + (size_t)k * 256);
#pragma unroll
        for (int k = 0; k < 8; ++k) { const float p0 = sc[kg * 8 + k], p1 = sc[288 + kg * 8 + k], p2 = sc[576 + kg * 8 + k], p3 = sc[864 + kg * 8 + k];
#pragma unroll
            for (int e = 0; e < 8; ++e) { const float vf = bf2f(vv[k][e]); o[0][e] += p0 * vf; o[1][e] += p1 * vf; o[2][e] += p2 * vf; o[3][e] += p3 * vf; } }
        if (j == 0 && kg < 16) { const int k = kg; const bf16x8 v1 = *(const GAS bf16x8*)(F.VM() + k * 256 + kvh * 128 + oc * 8);
            const float p0 = sc[256 + k], p1 = sc[288 + 256 + k], p2 = sc[576 + 256 + k], p3 = sc[864 + 256 + k];
#pragma unroll
            for (int e = 0; e < 8; ++e) { const float vf = bf2f(v1[e]); o[0][e] += p0 * vf; o[1][e] += p1 * vf; o[2][e] += p2 * vf; o[3][e] += p3 * vf; } }
        LAS float* part = sc + 4 * 288 + 16;
#pragma unroll
        for (int h = 0; h < 4; ++h) { LAS f32x4* pp = (LAS f32x4*)(part + (kg * 4 + h) * 128 + oc * 8); pp[0] = (f32x4){o[h][0], o[h][1], o[h][2], o[h][3]}; pp[1] = (f32x4){o[h][4], o[h][5], o[h][6], o[h][7]}; }
        __syncthreads();
        const int h = tid >> 7, d = tid & 127; float os = 0.f;
#pragma unroll 8
        for (int g = 0; g < 32; ++g) os += part[(g * 4 + h) * 128 + d];
        float* dst = F.MQP() + ((size_t)it * 4 + h) * 132; dst[2 + d] = os; if (d == 0) { dst[0] = red[h * 2]; dst[1] = red[h * 2 + 1]; } }
    __syncthreads();
}
__device__ __forceinline__ void attn_phase(Frame& F, char* lds_generic, bf16* obase) {
    for (int r = 0; r < 8; ++r) {
        int s, kvh, hq, qb, S;
        if (F.G == 256) {
            const int x = F.vcu >> 5, i = F.vcu & 31;
            if (r < 4) { const int pair = 2 * x + (r >> 1); s = pair >> 1; kvh = pair & 1; const int u = (r & 1) * 32 + i; hq = u >> 4; qb = u & 15; S = 4096; }
            else { const int pair = x; s = 8 + (pair >> 1); kvh = pair & 1; const int u = (r - 4) * 32 + i; hq = u >> 5; qb = u & 31; S = 8192; }
        } else { s = 0; kvh = 0; hq = 0; qb = 0; S = 0; }
        if (S == 0) continue;
        const int row0 = seq_first_row(s), h = kvh * 4 + hq;
        bf16* qp = F.QG() + (size_t)(row0 + qb * 256) * DM + h * 128;
        attn::attn_unit(qp, F.K() + (size_t)row0 * 256 + kvh * 128, F.V() + (size_t)row0 * 256 + kvh * 128, F.KM() + kvh * 128, F.VM() + kvh * 128, obase + (size_t)(row0 + qb * 256) * DM + h * 128, S / 64 + 1, lds_generic, FIN(F, 5  ), qb * 256, F.SSQA() + (size_t)(row0 + qb * 256) * 8 + h);
    }
}

__device__ __forceinline__ void p5_ratio(Frame& F) {
    for (int row = F.vcu * 512 + F.tid; row < NTOK; row += F.G * 512) {
        const GAS f32x4* pa = (const GAS f32x4*)(F.SSQA() + (size_t)row * 8); const GAS f32x4* pl = (const GAS f32x4*)(F.SSQL() + (size_t)row * 8);
        const f32x4 a0 = pa[0], a1 = pa[1], l0 = pl[0], l1 = pl[1];
        const float sa = ((a0.x + a0.y) + (a0.z + a0.w)) + ((a1.x + a1.y) + (a1.z + a1.w)), sl = ((l0.x + l0.y) + (l0.z + l0.w)) + ((l1.x + l1.y) + (l1.z + l1.w));
        const float qa = sqrtf(sa * (1.f / 1024.f) + EPS), ql = sqrtf(sl * (1.f / 1024.f) + EPS);
        F.RATIO()[row] = ql / qa; F.RL()[row] = 1.f / ql;
    }
}
__device__ __forceinline__ void p5_meta_job(Frame& F, int s) {
    LAS float* buf = (LAS float*)F.lds; LAS float* red = buf + 2048; const int tid = F.tid;
    {
        const int nj = s < 8 ? 16 : 32;
        for (int e = tid; e < 1024; e += 512) { const int h = e >> 7, d = e & 127, kvh = h >> 2, hq = h & 3;
            const int it0 = s < 8 ? s * 32 + kvh * 16 : 256 + (s - 8) * 64 + kvh * 32;
            float M = -INFINITY; for (int j = 0; j < nj; ++j) M = fmaxf(M, F.MQP()[((size_t)(it0 + j) * 4 + hq) * 132]);
            float Ls = 0.f, O = 0.f;
            for (int j = 0; j < nj; ++j) { const float* p = F.MQP() + ((size_t)(it0 + j) * 4 + hq) * 132; const float w = __expf(p[0] - M); Ls += p[1] * w; O += p[2 + d] * w; }
            buf[e] = O / Ls; }
        for (int e = tid; e < 1024; e += 512) buf[1024 + e] = F.LO15()[s * 1024 + e];
        __syncthreads();
        { float ss = 0.f; for (int k = F.lane; k < 256; k += 64) { const float v = buf[F.wave * 256 + k]; ss += v * v; } ss = wave_sum(ss); if (F.lane == 0) red[F.wave] = ss; }
        __syncthreads();
        const float ra = 1.f / sqrtf((red[0] + red[1] + red[2] + red[3]) * (1.f / 1024.f) + EPS), rl = 1.f / sqrtf((red[4] + red[5] + red[6] + red[7]) * (1.f / 1024.f) + EPS);
        for (int e = tid; e < 2048; e += 512) F.MIXED15()[s * 2048 + e] = e < 1024 ? buf[e] * ra : buf[e] * rl;
        __syncthreads();
    }
}
__device__ __forceinline__ void p6_meta_y(Frame& F) {
    LAS float* X = (LAS float*)F.lds;
    for (int i = F.tid; i < 12 * DM / 4; i += 512) ((LAS f32x4*)X)[i] = ((const GAS f32x4*)F.MIXED15())[i];
    __syncthreads();
    const OutRows o{F.Y15(), DM, 12};
    small_gemm<12, OutRows>(X, DM, F.WOUT_T(), DM, F.vcu * NWAVES + F.wave, F.G * NWAVES, F.lane, o);
    __syncthreads();
}

__device__ __forceinline__ void p7_row(Frame& F, int row, int lane) {
    const GAS bf16x8* y = (const GAS bf16x8*)((const bf16*)(F.out + (size_t)row * DM));
    GAS v4u* xn = (GAS v4u*)(F.XN() + (size_t)row * DM);
    const float ir0 = 1.f / F.R0()[row];
    float hv[32]; float ss = 0.f;
#pragma unroll
    for (int i = 0; i < 4; ++i) { const bf16x8 v = y[lane + 64 * i];
#pragma unroll
        for (int j = 0; j < 8; ++j) { hv[8 * i + j] = bf2f(v[j]); ss += hv[8 * i + j] * hv[8 * i + j]; } }
    const float r1 = 1.f / sqrtf(wave_sum(ss) * (1.f / DM) + EPS); float s2 = 0.f;
#pragma unroll
    for (int i = 0; i < 4; ++i) { const int e0 = (lane + 64 * i) * 8;
        const v4u xq = xn[lane + 64 * i]; const GAS f32x4* gp = (const GAS f32x4*)(FIN(F, 17  ) + e0); const f32x4 g0 = gp[0], g1 = gp[1];
        const float xv[8] = {__builtin_bit_cast(float, xq.x << 16), __builtin_bit_cast(float, xq.x & 0xffff0000u), __builtin_bit_cast(float, xq.y << 16), __builtin_bit_cast(float, xq.y & 0xffff0000u),
                             __builtin_bit_cast(float, xq.z << 16), __builtin_bit_cast(float, xq.z & 0xffff0000u), __builtin_bit_cast(float, xq.w << 16), __builtin_bit_cast(float, xq.w & 0xffff0000u)};
        const float gg[8] = {g0.x, g0.y, g0.z, g0.w, g1.x, g1.y, g1.z, g1.w};
        float hb[8];
#pragma unroll
        for (int j = 0; j < 8; ++j) { hb[j] = xv[j] * ir0 + hv[8 * i + j] * r1 * gg[j]; hv[8 * i + j] = hb[j]; s2 += hb[j] * hb[j]; }
        ((GAS v4u*)((bf16*)(F.out + (size_t)row * DM) + DM))[lane + 64 * i] = pack8(hb);
    }
    const float r2 = 1.f / sqrtf(wave_sum(s2) * (1.f / DM) + EPS);
#pragma unroll
    for (int i = 0; i < 4; ++i) { const int e0 = (lane + 64 * i) * 8; const GAS f32x4* gp = (const GAS f32x4*)(FIN(F, 18  ) + e0); const f32x4 g0 = gp[0], g1 = gp[1];
        float t[8]; t[0] = hv[8 * i + 0] * r2 * g0.x; t[1] = hv[8 * i + 1] * r2 * g0.y; t[2] = hv[8 * i + 2] * r2 * g0.z; t[3] = hv[8 * i + 3] * r2 * g0.w;
        t[4] = hv[8 * i + 4] * r2 * g1.x; t[5] = hv[8 * i + 5] * r2 * g1.y; t[6] = hv[8 * i + 6] * r2 * g1.z; t[7] = hv[8 * i + 7] * r2 * g1.w;
        xn[lane + 64 * i] = pack8(t); }
}
__device__ __forceinline__ void p7_meta_g(Frame& F) {
    LAS float* X = (LAS float*)F.lds;
    for (int r = F.wave; r < 12; r += 8) {
        const float* y = F.Y15() + r * DM; const float* xm = FIN(F, 2  ) + 15 * DM;
        float hv[32]; float ss = 0.f;
#pragma unroll
        for (int i = 0; i < 32; ++i) { hv[i] = y[F.lane + 64 * i]; ss += hv[i] * hv[i]; }
        const float r1 = 1.f / sqrtf(wave_sum(ss) * (1.f / DM) + EPS); float s2 = 0.f;
#pragma unroll
        for (int i = 0; i < 32; ++i) { const int e = F.lane + 64 * i; hv[i] = xm[e] + hv[i] * r1 * FIN(F, 17  )[e]; s2 += hv[i] * hv[i]; }
        const float r2 = 1.f / sqrtf(wave_sum(s2) * (1.f / DM) + EPS);
#pragma unroll
        for (int i = 0; i < 32; ++i) { const int e = F.lane + 64 * i; X[r * DM + e] = hv[i] * r2 * FIN(F, 18  )[e]; }
    }
    __syncthreads();
    const OutRows o{F.G15(), FFN, 12};
    small_gemm<12, OutRows, true>(X, DM, F.WUP_T(), FFN, F.vcu * NWAVES + F.wave, F.G * NWAVES, F.lane, o);
    __syncthreads();
}

__device__ __forceinline__ void p9_fix(Frame& F, int h) {
    constexpr int NOCT = FFN / 8; const int total = 512 * 2 * NOCT;
    const float* cw = FIN(F, 20  ); const float* cb = FIN(F, 21  );
    for (int it = F.vcu * 512 + F.tid; it < total; it += F.G * 512) {
        const int bw = it / NOCT, co = (it - bw * NOCT) * 8, which = bw & 1, B = bw >> 1;
        const int lrow = B * 64 + (which ? 63 : 0), row = h * HROWS + lrow, s = row_seq(row), t = row - seq_first_row(s), S = seq_len(s);
        const float* e = F.EDGE() + (size_t)((B * 2 + which) * 3) * FFN + co;
        float inner[8], self[8], uu[8], outer[8], w0[8], w1[8], w2[8], bb[8];
#define LD8F(dst, p) do { const GAS f32x4* p_ = (const GAS f32x4*)(p); const f32x4 a_ = p_[0], b_ = p_[1]; dst[0] = a_.x; dst[1] = a_.y; dst[2] = a_.z; dst[3] = a_.w; dst[4] = b_.x; dst[5] = b_.y; dst[6] = b_.z; dst[7] = b_.w; } while (0)
        LD8F(inner, e); LD8F(self, e + FFN); LD8F(uu, e + 2 * FFN);
        LD8F(w0, cw + co); LD8F(w1, cw + FFN + co); LD8F(w2, cw + 2 * FFN + co); LD8F(bb, cb + co);
        if (which == 0) { if (t == 0) LD8F(outer, F.G15() + (size_t)s * FFN + co); else LD8F(outer, F.EDGE() + (size_t)(((B - 1) * 2 + 1) * 3 + 1) * FFN + co); }
        else { if (t == S - 1) {
#pragma unroll
                for (int j = 0; j < 8; ++j) outer[j] = 0.f; }
            else LD8F(outer, F.EDGE() + (size_t)(((B + 1) * 2 + 0) * 3 + 1) * FFN + co); }
#undef LD8F
        float o[8];
#pragma unroll
        for (int j = 0; j < 8; ++j) { const float x = which == 0 ? bb[j] + w0[j] * outer[j] + w1[j] * self[j] + w2[j] * inner[j] : bb[j] + w0[j] * inner[j] + w1[j] * self[j] + w2[j] * outer[j];
            o[j] = x * sigmoidf_(x) * uu[j]; }
        *(GAS v4u*)(F.ACT() + (size_t)lrow * FFN + co) = pack8(o);
    }
}
__device__ __forceinline__ void p11_row(Frame& F, int row, int lane, float* obase) {
    const GAS bf16x8* f = (const GAS bf16x8*)(F.XN() + (size_t)row * DM);
    const GAS bf16x8* hp = (const GAS bf16x8*)((const bf16*)(F.out + (size_t)row * DM) + DM);
    bf16x8 hv[4], fq[4];
#pragma unroll
    for (int i = 0; i < 4; ++i) { hv[i] = hp[lane + 64 * i]; fq[i] = f[lane + 64 * i]; }
    asm volatile("s_waitcnt vmcnt(0)" ::: "memory");
    float fv[32]; float ss = 0.f;
#pragma unroll
    for (int i = 0; i < 4; ++i)
#pragma unroll
        for (int j = 0; j < 8; ++j) { fv[8 * i + j] = bf2f(fq[i][j]); ss += fv[8 * i + j] * fv[8 * i + j]; }
    const float r1 = 1.f / sqrtf(wave_sum(ss) * (1.f / DM) + EPS);
#pragma unroll
    for (int i = 0; i < 4; ++i) { const int e0 = (lane + 64 * i) * 8;
        const GAS f32x4* gp = (const GAS f32x4*)(FIN(F, 23  ) + e0); const f32x4 g0 = gp[0], g1 = gp[1];
        f32x4 h0, h1;
        h0.x = bf2f(hv[i][0]) + fv[8 * i + 0] * r1 * g0.x; h0.y = bf2f(hv[i][1]) + fv[8 * i + 1] * r1 * g0.y; h0.z = bf2f(hv[i][2]) + fv[8 * i + 2] * r1 * g0.z; h0.w = bf2f(hv[i][3]) + fv[8 * i + 3] * r1 * g0.w;
        h1.x = bf2f(hv[i][4]) + fv[8 * i + 4] * r1 * g1.x; h1.y = bf2f(hv[i][5]) + fv[8 * i + 5] * r1 * g1.y; h1.z = bf2f(hv[i][6]) + fv[8 * i + 6] * r1 * g1.z; h1.w = bf2f(hv[i][7]) + fv[8 * i + 7] * r1 * g1.w;
        GAS f32x4* wp = (GAS f32x4*)(obase + (size_t)row * DM + e0); wp[0] = h0; wp[1] = h1; }
}
struct Args { const float* in[24]; float* out; unsigned char* ws; int ph_lo, ph_hi, q_lo, q_hi, use_bar, dummy; };
constexpr int N_PHASES = 12;
__global__ void __launch_bounds__(NWAVES * 64, 2) mk_fwd(Args args) {
    extern __shared__ __attribute__((aligned(16))) unsigned char lds[];
    Frame F;
    F.lds = (LAS unsigned char*)lds;
    F.MISC = (volatile LAS unsigned*)(F.lds + MISC_OFF);
    F.tid = threadIdx.x; F.lane = F.tid & 63; F.wave = __builtin_amdgcn_readfirstlane(F.tid >> 6);
    F.G = gridDim.x; { const int bx = blockIdx.x; F.vcu = (F.G % 8 == 0) ? (bx % 8) * (F.G / 8) + bx / 8 : bx; }
    unsigned char* ws = args.ws;
    F.ctl = (gu32*)(ws + WS_CTL);
    F.kargs = (const __attribute__((address_space(4))) void*)__builtin_amdgcn_kernarg_segment_ptr(); F.ptag = 0; F.out = args.out;
    F.ws = ws;
    for (int u = F.tid; u < (LDS_BYTES - LDSCTL_OFF) / 4; u += NWAVES * 64) ((LAS unsigned*)(F.lds + LDSCTL_OFF))[u] = 0u;
    __syncthreads();
    XcdBarrier bar; bar.bar = (unsigned*)(F.ctl + CW_BAR); bar.x = 0; bar.st = nullptr;
    if (args.use_bar) bar = xcd_barrier_post((unsigned*)(F.ctl + CW_BAR), F.MISC + 8);
    const int lo = args.ph_lo, hi = args.ph_hi;
    const int dmy_ = MK_MULTI ? args.dummy : 0;
#define IN(k) (((MK_PHASE_MASK >> (k)) & 1) && lo <= (k) && (k) < hi)
#define PH_BEGIN(k) do { F.ptag = (k); int t_ = F.tid; asm volatile("" : "+v"(t_)); F.tid = t_; F.lane = t_ & 63; } while (0)
#define PH_BAR() do { if (args.use_bar) xcd_barrier(bar); } while (0)
    const int gw = F.vcu * NWAVES + F.wave, NGW = F.G * NWAVES;

    if (IN(0)) { PH_BEGIN(0); { p0_prologue(F); PH_BAR(); } }
    if (IN(1)) { PH_BEGIN(1); {
        p1_meta_z(F);
        pg8::Gemm g{F.XN(), F.WIN_T(), NTOK, INW, DM}; pg8::StaticOrder S; S.init(NTOK, INW, F.G, (int)blockIdx.x);
        pg8::EpiRoute E{nullptr, 0, 1, F.QG(), F.K(), F.V(), F.XR()};
        pg8::gemm_phase<pg8::EpiRoute, pg8::StaticOrder, true, true>(F.lds, g, S, E);
        PH_BAR();
    } }
    if (IN(2)) { PH_BEGIN(2); { lru_phase<1>(F, nullptr); PH_BAR(); } }
    if (IN(3)) { PH_BEGIN(3); {
        k_rope_pass(F, dmy_ ? (bf16*)F.out : F.K());
        lru_propagate(F);
        if (F.vcu == F.G - 1) p3_meta_job(F);
        PH_BAR();
    } }
    if (IN(4)) { PH_BEGIN(4); {
        const int dm = dmy_;
        if (dm < 2 || dm == 2) lru_phase<2>(F, dm ? (bf16*)F.out : F.QG());
        if (dm < 2 || dm == 3) for (int it = F.vcu; it < 512; it += F.G) metaq_item(F, it);
        if (dm < 2 || dm == 4) attn_phase(F, (char*)lds, dm ? (bf16*)F.out : F.QG());
        PH_BAR();
    } }
    if (IN(5)) { PH_BEGIN(5); {
        p5_ratio(F);
        if (F.vcu >= F.G - 12) p5_meta_job(F, F.G - 1 - F.vcu);
        PH_BAR();
    } }
    if (IN(6)) { PH_BEGIN(6); {
        p6_meta_y(F);
        pg8::Gemm g{F.QG(), F.WOUT_T(), NTOK, DM, DM}; pg8::StaticOrder S; S.init(NTOK, DM, F.G, (int)blockIdx.x);
        pg8::EpiScaled E{(bf16*)F.out, 2 * DM, F.RATIO(), F.RL(), 16};
        pg8::gemm_phase<pg8::EpiScaled, pg8::StaticOrder, true, true>(F.lds, g, S, E);
        PH_BAR();
    } }
    if (IN(7)) { PH_BEGIN(7); {
        for (int row = gw; row < NTOK; row += NGW) p7_row(F, row, F.lane);
        p7_meta_g(F);
        PH_BAR();
    } }
#if MK_MULTI
    { const int q = args.q_lo;
#else
#pragma unroll
    for (int q = 0; q < 2; ++q) {
#endif
        if (IN(8)) { PH_BEGIN(8); {
            pg8::Gemm g{F.XN() + (size_t)q * HROWS * DM, F.WUP_T(), HROWS, UPW, DM}; pg8::StaticOrder S; S.init(HROWS, UPW, F.G, (int)blockIdx.x);
            pg8::EpiAct E{F.ACT(), F.EDGE(), FIN(F, 20  ), FIN(F, 21  ), FFN};
            pg8::gemm_phase<pg8::EpiAct, pg8::StaticOrder, true, true>(F.lds, g, S, E);
            PH_BAR();
        } }
        if (IN(9)) { PH_BEGIN(9); { p9_fix(F, q); PH_BAR(); } }
        if (IN(10)) { PH_BEGIN(10); {
            pg8::Gemm g{F.ACT(), F.WDOWN_T(), HROWS, DM, FFN}; pg8::ProbeOrder S; S.init(HROWS, DM, F.G, (int)blockIdx.x); S.pmask = dmy_ == 5 ? 7 : -1;
            pg8::EpiRoute E{F.XN() + (size_t)q * HROWS * DM, DM, 0, nullptr, nullptr, nullptr, nullptr};
            pg8::gemm_phase<pg8::EpiRoute, pg8::ProbeOrder, true, true>(F.lds, g, S, E);
            if (q == 0) PH_BAR();
        } }
    }
    if (IN(10) && IN(11)) PH_BAR();
    if (IN(11)) { PH_BEGIN(11); { for (int row = gw; row < NTOK; row += NGW) p11_row(F, row, F.lane, dmy_ ? (float*)(F.ws + WS_B) : F.out); } }
#undef IN
#undef PH_BAR
}

extern "C" void kernel_launch(void* const* d_in, const int* in_sizes, int n_in, void* d_out, int out_size, void* d_ws, size_t ws_size, hipStream_t stream) {
    static int grid = 0;
    if (grid == 0) {
        if (n_in != 24 || out_size != NTOK * DM || ws_size < WS_END) { fprintf(stderr, "kernel_launch: unexpected shapes (n_in %d out %d ws %zu, need ws >= %zu); nothing launched\n", n_in, out_size, ws_size, (size_t)WS_END); grid = -1; return; }
        int dev = 0, cus = 0;
        if (hipGetDevice(&dev) != hipSuccess || hipDeviceGetAttribute(&cus, hipDeviceAttributeMultiprocessorCount, dev) != hipSuccess) { grid = -1; return; }
        if (hipFuncSetAttribute((const void*)mk_fwd, hipFuncAttributeMaxDynamicSharedMemorySize, LDS_BYTES) != hipSuccess) { fprintf(stderr, "kernel_launch: hipFuncSetAttribute failed\n"); grid = -1; return; }
        int per_cu = 0;
        if (hipOccupancyMaxActiveBlocksPerMultiprocessor(&per_cu, (const void*)mk_fwd, NWAVES * 64, LDS_BYTES) != hipSuccess || per_cu < 1) fprintf(stderr, "kernel_launch: occupancy query reports %d\n", per_cu);
        (void)hipGetLastError();
        grid = cus;
    }
    if (grid < 0) return;
    if (hipMemsetAsync((char*)d_ws + WS_CTL, 0, CTL_ZERO_BYTES, stream) != hipSuccess) return;
    Args a{};
    for (int i = 0; i < 24; ++i) a.in[i] = (const float*)d_in[i];
    a.out = (float*)d_out; a.ws = (unsigned char*)d_ws;
#if MK_MULTI
    a.use_bar = 0;
#define LAUNCH_PH(ph, q) do { a.ph_lo = (ph); a.ph_hi = (ph) + 1; a.q_lo = (q); a.q_hi = (q) + 1; \
        if ((MK_REPEAT_MASK >> (ph)) & 1) { a.dummy = MK_DUMMY_MODE; hipLaunchKernelGGL(mk_fwd, dim3(grid), dim3(NWAVES * 64), LDS_BYTES, stream, a); } \
        a.dummy = 0; hipLaunchKernelGGL(mk_fwd, dim3(grid), dim3(NWAVES * 64), LDS_BYTES, stream, a); } while (0)
    for (int ph = 0; ph < 8; ++ph) LAUNCH_PH(ph, 0);
    for (int q = 0; q < 2; ++q) for (int ph = 8; ph < 11; ++ph) LAUNCH_PH(ph, q);
    LAUNCH_PH(11, 0);
#else
    a.use_bar = 1; a.ph_lo = 0; a.ph_hi = N_PHASES; a.q_lo = 0; a.q_hi = 2;
    hipLaunchKernelGGL(mk_fwd, dim3(grid), dim3(NWAVES * 64), LDS_BYTES, stream, a);
#endif
    const hipError_t le = hipPeekAtLastError();
    if (le != hipSuccess) fprintf(stderr, "kernel_launch: launch failed: %s\n", hipGetErrorName(le));
}
```

```cpp
#include <hip/hip_runtime.h>
#include <cstdio>
#include <cstdint>
#include <cmath>
#ifndef MK_PHASE_MASK
#define MK_PHASE_MASK 0xfff
#endif
#ifndef MK_REPEAT_MASK
#define MK_REPEAT_MASK 0
#endif
#ifndef MK_DUMMY_MODE
#define MK_DUMMY_MODE 1
#endif
#ifndef MK_MULTI
#define MK_MULTI 0
#endif
namespace pg8 {
#define PG8_LAS __attribute__((address_space(3)))
typedef unsigned short bf16_t;
typedef short bf16x8 __attribute__((ext_vector_type(8)));
typedef float f32x4 __attribute__((ext_vector_type(4)));
typedef unsigned u32x4 __attribute__((ext_vector_type(4)));
constexpr int BM = 256, BK = 64, HALF = 128, HTB = HALF * BK * 2  , STAGE_BYTES = 8 * HTB, NXCD = 8, WGM = 8;

__host__ __device__ __forceinline__ int lds_byte(int r, int c) { const int st = (r >> 4) * 2 + (c >> 5), rr = r & 15, cc = c & 31, ob = rr * 64 + cc * 2; return st * 1024 + (ob ^ (((ob >> 9) & 1) << 5)); }
__host__ __device__ __forceinline__ void stage_rc(int b, int& R, int& C) { const int st = b / 1024, sb = b % 1024, swz = sb ^ (((sb >> 9) & 1) << 5); R = (st >> 1) * 16 + swz / 64; C = (st & 1) * 32 + (swz % 64) / 2; }
__host__ __device__ __forceinline__ int perm32(int rho) { const int n = rho >> 4, i = rho & 15; return 8 * (i >> 2) + 4 * n + (i & 3); }

struct Unit { int pm, pn; };
struct Gemm { const bf16_t* A; const bf16_t* Bt; int M, N, K; };

struct StaticOrder {
    int nM, nN, nwg, G, c;
    __host__ __device__ void init(int M, int N, int G_, int c_) { nM = M / BM; nN = N / BM; nwg = nM * nN; G = G_; c = c_; }
    __host__ __device__ bool next(int i, Unit& u) const {
        const long L = (long)i * G + c; if (L >= nwg) return false;
        int wgid = (int)L; { const int q = nwg / NXCD, r = nwg % NXCD, xcd = wgid % NXCD, off = wgid / NXCD; wgid = (xcd < r ? xcd * (q + 1) : r * (q + 1) + (xcd - r) * q) + off; }
        const int nig = WGM * nN, gid = wgid / nig, fm = gid * WGM, gsz = (nM - fm) < WGM ? (nM - fm) : WGM;
        u.pm = fm + ((wgid % nig) % gsz); u.pn = (wgid % nig) / gsz; return true;
    }
    __device__ __forceinline__ void a_ready(const Unit&) const {}
    __device__ __forceinline__ void done(const Unit&) const {}
};

__device__ __forceinline__ unsigned cvt_pk_bf16(float lo, float hi) { unsigned r; asm volatile("v_cvt_pk_bf16_f32 %0, %1, %2" : "=v"(r) : "v"(lo), "v"(hi)); return r; }
struct EpiRoute {
    static constexpr bool PERM = true, AFTER_DRAIN = false, MIDK = false;
    bf16_t* O; int ldc; int mode; bf16_t *QGp, *Kp, *Vp, *XRp;
    __device__ __forceinline__ void operator()(const f32x4 (&acc)[2][2][4][2], const Unit& u, int wr, int wc, int fr, int fq) const {
        bf16_t* base = O; int ld = ldc; int colt = u.pn * BM; int rowadd = 0;
        if (mode == 1) {
            const int pn = u.pn;
            if (pn < 4) { base = QGp; ld = 2048; colt = pn * 256; }
            else if (pn == 4) { base = Kp; ld = 256; colt = 0; }
            else if (pn == 5) { base = Vp; ld = 256; colt = 0; }
            else if (pn < 10) { base = XRp; ld = 1024; colt = (pn - 6) * 256; const int seq = u.pm < 128 ? (u.pm >> 4) : 8 + ((u.pm - 128) >> 5); rowadd = 64 * (seq + 1); }
            else { base = QGp; ld = 2048; colt = 1024 + (pn - 10) * 256; }
        }
        const int row0 = u.pm * BM + wr * 64 + fr + rowadd; const int col0 = colt + wc * 32 + 8 * fq;
#pragma unroll
        for (int ai = 0; ai < 2; ++ai)
#pragma unroll
            for (int m = 0; m < 4; ++m) { bf16_t* rowp = base + (size_t)(row0 + ai * HALF + m * 16) * ld + col0;
#pragma unroll
                for (int bj = 0; bj < 2; ++bj) { const f32x4 v0 = acc[ai][bj][m][0], v1 = acc[ai][bj][m][1];
                    u32x4 w; w.x = cvt_pk_bf16(v0[0], v0[1]); w.y = cvt_pk_bf16(v0[2], v0[3]); w.z = cvt_pk_bf16(v1[0], v1[1]); w.w = cvt_pk_bf16(v1[2], v1[3]);
                    *(u32x4*)(rowp + bj * HALF) = w; } }
    }
};

__device__ __forceinline__ float dpp_shr1(float old, float src) { return __builtin_bit_cast(float, __builtin_amdgcn_update_dpp(__builtin_bit_cast(int, old), __builtin_bit_cast(int, src), 0x111, 0xF, 0xF, false)); }
__device__ __forceinline__ float dpp_shl1(float old, float src) { return __builtin_bit_cast(float, __builtin_amdgcn_update_dpp(__builtin_bit_cast(int, old), __builtin_bit_cast(int, src), 0x101, 0xF, 0xF, false)); }
__device__ __forceinline__ float dpp_ror1(float src)  { return __builtin_bit_cast(float, __builtin_amdgcn_update_dpp(0, __builtin_bit_cast(int, src), 0x121, 0xF, 0xF, false)); }
__device__ __forceinline__ float dpp_ror15(float src) { return __builtin_bit_cast(float, __builtin_amdgcn_update_dpp(0, __builtin_bit_cast(int, src), 0x12F, 0xF, 0xF, false)); }
struct EpiAct {
    static constexpr bool PERM = true, AFTER_DRAIN = false, MIDK = false;
    bf16_t* ACT; float* EDGE; const float* cw; const float* cb; int nch;
    __device__ __forceinline__ void operator()(const f32x4 (&acc)[2][2][4][2], const Unit& u, int wr, int wc, int fr, int fq) const {
        const int ch0 = u.pn * 128 + wc * 32 + 8 * fq;
        float w0[8], w1[8], w2[8], bb[8];
        { const f32x4 a0 = *(const f32x4*)(cw + ch0), a1 = *(const f32x4*)(cw + ch0 + 4), b0 = *(const f32x4*)(cw + nch + ch0), b1 = *(const f32x4*)(cw + nch + ch0 + 4),
                      c0 = *(const f32x4*)(cw + 2 * nch + ch0), c1 = *(const f32x4*)(cw + 2 * nch + ch0 + 4), d0 = *(const f32x4*)(cb + ch0), d1 = *(const f32x4*)(cb + ch0 + 4);
#pragma unroll
          for (int k = 0; k < 4; ++k) { w0[k] = a0[k]; w0[4 + k] = a1[k]; w1[k] = b0[k]; w1[4 + k] = b1[k]; w2[k] = c0[k]; w2[4 + k] = c1[k]; bb[k] = d0[k]; bb[4 + k] = d1[k]; } }
        const int rowb = u.pm * BM + wr * 64;
#pragma unroll
        for (int ai = 0; ai < 2; ++ai) {
            float ein0[8], ein1[8];
#pragma unroll
            for (int m = 0; m < 4; ++m) {
                float o[8];
#pragma unroll
                for (int n = 0; n < 2; ++n)
#pragma unroll
                    for (int k = 0; k < 4; ++k) {
                        const int j = 4 * n + k; const float cur = acc[ai][0][m][n][k];
                        float pold = 0.f, nold = 0.f;
                        if (m > 0) pold = dpp_ror1(acc[ai][0][m > 0 ? m - 1 : 0][n][k]);
                        if (m < 3) nold = dpp_ror15(acc[ai][0][m < 3 ? m + 1 : 3][n][k]);
                        const float prv = dpp_shr1(pold, cur), nxt = dpp_shl1(nold, cur);
                        const float x = bb[j] + w0[j] * prv + w1[j] * cur + w2[j] * nxt;
                        o[j] = x * __builtin_amdgcn_rcpf(1.f + __builtin_amdgcn_exp2f(-1.4426950408889634f * x)) * acc[ai][1][m][n][k];
                        if (m == 0) ein0[j] = nxt;
                        if (m == 3) ein1[j] = prv;
                    }
                u32x4 w; w.x = cvt_pk_bf16(o[0], o[1]); w.y = cvt_pk_bf16(o[2], o[3]); w.z = cvt_pk_bf16(o[4], o[5]); w.w = cvt_pk_bf16(o[6], o[7]);
                *(u32x4*)(ACT + (size_t)(rowb + ai * HALF + m * 16 + fr) * nch + ch0) = w;
            }
            const int blk = (rowb + ai * HALF) >> 6;
            if (fr == 0 || fr == 15) {
                const bool last = fr == 15; float* e = EDGE + (size_t)((blk * 2 + (last ? 1 : 0)) * 3) * nch + ch0;
                f32x4 i0v, i1v, s0v, s1v, u0v, u1v;
#pragma unroll
                for (int k = 0; k < 4; ++k) { i0v[k] = last ? ein1[k] : ein0[k]; i1v[k] = last ? ein1[4 + k] : ein0[4 + k];
                    s0v[k] = last ? acc[ai][0][3][0][k] : acc[ai][0][0][0][k]; s1v[k] = last ? acc[ai][0][3][1][k] : acc[ai][0][0][1][k];
                    u0v[k] = last ? acc[ai][1][3][0][k] : acc[ai][1][0][0][k]; u1v[k] = last ? acc[ai][1][3][1][k] : acc[ai][1][0][1][k]; }
                *(f32x4*)(e) = i0v; *(f32x4*)(e + 4) = i1v; *(f32x4*)(e + nch) = s0v; *(f32x4*)(e + nch + 4) = s1v; *(f32x4*)(e + 2 * nch) = u0v; *(f32x4*)(e + 2 * nch + 4) = u1v;
            }
        }
    }
};

struct ProbeOrder : StaticOrder { int pmask;
    __host__ __device__ bool next(int i, Unit& u) const { const bool r = StaticOrder::next(i, u); u.pm &= pmask; return r; } };

struct EpiScaled {
    static constexpr bool PERM = true, AFTER_DRAIN = false, MIDK = true;
    bf16_t* O; int ldc; const float* ratio; const float* rl; int kt;
    __device__ __forceinline__ void midk(f32x4 (&acc)[2][2][4][2], const Unit& u, int wr, int fr) const {
        asm volatile("" ::: "memory");
        const float* rp = ratio + (u.pm * BM + wr * 64 + fr);
        float s[2][4];
#pragma unroll
        for (int ai = 0; ai < 2; ++ai)
#pragma unroll
            for (int m = 0; m < 4; ++m) s[ai][m] = rp[ai * HALF + m * 16];
#pragma unroll
        for (int ai = 0; ai < 2; ++ai)
#pragma unroll
            for (int m = 0; m < 4; ++m)
#pragma unroll
                for (int bj = 0; bj < 2; ++bj)
#pragma unroll
                    for (int n = 0; n < 2; ++n) acc[ai][bj][m][n] = acc[ai][bj][m][n] * s[ai][m];
        asm volatile("" ::: "memory");
    }
    __device__ __forceinline__ void operator()(const f32x4 (&acc)[2][2][4][2], const Unit& u, int wr, int wc, int fr, int fq) const {
        const int row0 = u.pm * BM + wr * 64 + fr, col0 = u.pn * BM + wc * 32 + 8 * fq;
#pragma unroll
        for (int ai = 0; ai < 2; ++ai)
#pragma unroll
            for (int m = 0; m < 4; ++m) { const int row = row0 + ai * HALF + m * 16; const float s = rl[row]; bf16_t* rowp = O + (size_t)row * ldc + col0;
#pragma unroll
                for (int bj = 0; bj < 2; ++bj) { const f32x4 v0 = acc[ai][bj][m][0] * s, v1 = acc[ai][bj][m][1] * s;
                    u32x4 w; w.x = cvt_pk_bf16(v0[0], v0[1]); w.y = cvt_pk_bf16(v0[2], v0[3]); w.z = cvt_pk_bf16(v1[0], v1[1]); w.w = cvt_pk_bf16(v1[2], v1[3]);
                    *(u32x4*)(rowp + bj * HALF) = w; } }
    }
};

template <class Epi, class Sched, bool ALIGN_EPI = false, bool SP2 = false>
__device__ __forceinline__ void gemm_phase(PG8_LAS unsigned char* lds, const Gemm g, const Sched& S, const Epi& E) {
    int tid_ = threadIdx.x; asm volatile("" : "+v"(tid_));
    const int tid = tid_, wid = __builtin_amdgcn_readfirstlane(tid >> 6), lane = tid & 63, wr = wid >> 2, wc = wid & 3, fr = lane & 15, fq = lane >> 4;
    const int K = g.K, nt = K / BK;
    unsigned voffA[2], voffB[2];
#pragma unroll
    for (int i = 0; i < 2; ++i) { int R, C; stage_rc(tid * 16 + i * 8192, R, C); const int Rb = Epi::PERM ? ((R & ~31) + perm32(R & 31)) : R;
        voffA[i] = (unsigned)(R * K + C) * 2u; voffB[i] = (unsigned)(Rb * K + C) * 2u; }
    const size_t kstep = (size_t)(BK * 2);
    const size_t hstep = (size_t)HALF * K * 2;
    const size_t tstep = 2 * hstep;
    const unsigned ldsw = (unsigned)wid * 1024u;
    const int aoff = lds_byte(wr * 64 + fr, fq * 8), boff = lds_byte(wc * 32 + fr, fq * 8);
#define PG8_SA(b, h) (((b) * 2 + (h)) * HTB)
#define PG8_SB(b, h) ((4 + (b) * 2 + (h)) * HTB)
#define PG8_STAGE(bufoff, gbase, voff) do { _Pragma("unroll") for (int _i = 0; _i < 2; ++_i) \
        __builtin_amdgcn_global_load_lds((const unsigned*)((const char*)(gbase) + (voff)[_i]), (PG8_LAS unsigned*)(lds + (bufoff) + ldsw + _i * 8192), 16, 0, 0); } while (0)
#define PG8_LDA(dst, b, h) do { _Pragma("unroll") for (int m = 0; m < 4; ++m) _Pragma("unroll") for (int k = 0; k < 2; ++k) dst[m][k] = *(const PG8_LAS bf16x8*)(lds + PG8_SA(b, h) + aoff + m * 2048 + k * 1024); } while (0)
#define PG8_LDB(dst, b, h) do { _Pragma("unroll") for (int n = 0; n < 2; ++n) _Pragma("unroll") for (int k = 0; k < 2; ++k) dst[n][k] = *(const PG8_LAS bf16x8*)(lds + PG8_SB(b, h) + boff + n * 2048 + k * 1024); } while (0)
#define PG8_MMA(ai, bj, At, Bt) do { __builtin_amdgcn_s_setprio(1); _Pragma("unroll") for (int m = 0; m < 4; ++m) _Pragma("unroll") for (int n = 0; n < 2; ++n) _Pragma("unroll") for (int k = 0; k < 2; ++k) \
        acc[ai][bj][m][n] = __builtin_amdgcn_mfma_f32_16x16x32_bf16(Bt[n][k], At[m][k], acc[ai][bj][m][n], 0, 0, 0); __builtin_amdgcn_s_setprio(0); } while (0)
#define PG8_WAIT_V(n) asm volatile("s_waitcnt vmcnt(" #n ")" ::: "memory")
#define PG8_WAIT_L(n) asm volatile("s_waitcnt lgkmcnt(" #n ")" ::: "memory")
#define PG8_BAR __builtin_amdgcn_s_barrier()
#define PG8_SCHED __builtin_amdgcn_sched_barrier(0)
    Unit cur, nxt; int ui = 0;
    if (!S.next(0, cur)) return;
    f32x4 acc[2][2][4][2];
#pragma unroll
    for (int a = 0; a < 2; ++a)
#pragma unroll
        for (int b = 0; b < 2; ++b)
#pragma unroll
            for (int m = 0; m < 4; ++m)
#pragma unroll
                for (int n = 0; n < 2; ++n) acc[a][b][m][n] = (f32x4){0.f, 0.f, 0.f, 0.f};
    bf16x8 At[4][2], B0[2][2], B1[2][2];
    const char* cA = (const char*)g.A + (size_t)cur.pm * tstep; const char* cB = (const char*)g.Bt + (size_t)cur.pn * tstep;
    S.a_ready(cur);
    if constexpr (SP2) {
        PG8_STAGE(PG8_SB(0, 0), cB, voffB); PG8_STAGE(PG8_SB(0, 1), cB + hstep, voffB); PG8_STAGE(PG8_SA(0, 0), cA, voffA); PG8_STAGE(PG8_SA(0, 1), cA + hstep, voffA);
        if (wr == 1) PG8_BAR;
        PG8_WAIT_V(2); PG8_BAR;
        PG8_STAGE(PG8_SB(1, 0), cB + kstep, voffB); PG8_STAGE(PG8_SA(1, 0), cA + kstep, voffA); PG8_STAGE(PG8_SB(1, 1), cB + hstep + kstep, voffB);
        PG8_WAIT_V(6); PG8_BAR;
    } else {
        PG8_STAGE(PG8_SB(0, 0), cB, voffB); PG8_STAGE(PG8_SA(0, 0), cA, voffA); PG8_STAGE(PG8_SB(0, 1), cB + hstep, voffB); PG8_STAGE(PG8_SA(0, 1), cA + hstep, voffA);
        if (wr == 1) PG8_BAR;
        PG8_WAIT_V(4); PG8_BAR;
        PG8_STAGE(PG8_SB(1, 0), cB + kstep, voffB); PG8_STAGE(PG8_SA(1, 0), cA + kstep, voffA); PG8_STAGE(PG8_SB(1, 1), cB + hstep + kstep, voffB);
        PG8_WAIT_V(6); PG8_BAR;
    }
    for (;;) {
        const bool has_next = S.next(ui + 1, nxt);
        const char* nA = has_next ? (const char*)g.A + (size_t)nxt.pm * tstep : cA; const char* nB = has_next ? (const char*)g.Bt + (size_t)nxt.pn * tstep : cB;
        for (int t = 0; t < nt; t += 2) {
            if constexpr (Epi::MIDK) { if (t == E.kt) E.midk(acc, cur, wr, fr); }
            const bool last = (t == nt - 2);
            const char* a1 = cA + (size_t)(t + 1) * kstep;
            const char* a2 = last ? nA : cA + (size_t)(t + 2) * kstep; const char* b2 = last ? nB : cB + (size_t)(t + 2) * kstep;
            const char* a3 = a2 + kstep; const char* b3 = b2 + kstep;
            if (last && has_next) S.a_ready(nxt);
            if constexpr (SP2) {
            PG8_LDB(B0, 0, 0); PG8_LDB(B1, 0, 1); PG8_SCHED; PG8_LDA(At, 0, 0); PG8_STAGE(PG8_SA(1, 1), a1 + hstep, voffA);
            PG8_WAIT_V(8); PG8_WAIT_L(0); PG8_BAR; PG8_MMA(0, 0, At, B0); PG8_MMA(0, 1, At, B1); PG8_BAR; PG8_SCHED;
            PG8_LDA(At, 0, 1); PG8_STAGE(PG8_SB(0, 0), b2, voffB); PG8_STAGE(PG8_SB(0, 1), b2 + hstep, voffB); PG8_STAGE(PG8_SA(0, 0), a2, voffA);
            PG8_WAIT_V(8); PG8_WAIT_L(0); PG8_BAR; PG8_MMA(1, 0, At, B0); PG8_MMA(1, 1, At, B1); PG8_BAR; PG8_SCHED;
            PG8_LDB(B0, 1, 0); PG8_LDB(B1, 1, 1); PG8_SCHED; PG8_LDA(At, 1, 0); PG8_STAGE(PG8_SA(0, 1), a2 + hstep, voffA);
            PG8_WAIT_V(8); PG8_WAIT_L(0); PG8_BAR; PG8_MMA(0, 0, At, B0); PG8_MMA(0, 1, At, B1); PG8_BAR; PG8_SCHED;
            PG8_LDA(At, 1, 1); PG8_STAGE(PG8_SB(1, 0), b3, voffB); PG8_STAGE(PG8_SB(1, 1), b3 + hstep, voffB); PG8_STAGE(PG8_SA(1, 0), a3, voffA);
            PG8_WAIT_V(8); PG8_WAIT_L(0); PG8_BAR; PG8_MMA(1, 0, At, B0); PG8_MMA(1, 1, At, B1); PG8_BAR; PG8_SCHED;
            } else {
            PG8_LDB(B0, 0, 0); PG8_SCHED; PG8_LDA(At, 0, 0); PG8_STAGE(PG8_SA(1, 1), a1 + hstep, voffA);
            PG8_WAIT_L(8); PG8_BAR; PG8_WAIT_L(0); PG8_MMA(0, 0, At, B0); PG8_BAR; PG8_SCHED;
            PG8_LDB(B1, 0, 1); PG8_STAGE(PG8_SB(0, 0), b2, voffB);
            PG8_BAR; PG8_WAIT_L(0); PG8_MMA(0, 1, At, B1); PG8_BAR;
            PG8_LDA(At, 0, 1); PG8_STAGE(PG8_SA(0, 0), a2, voffA);
            PG8_BAR; PG8_WAIT_L(0); PG8_MMA(1, 0, At, B0); PG8_BAR; PG8_SCHED;
            PG8_STAGE(PG8_SB(0, 1), b2 + hstep, voffB);
            PG8_WAIT_V(6); PG8_BAR; PG8_MMA(1, 1, At, B1); PG8_BAR;
            PG8_LDB(B0, 1, 0); PG8_SCHED; PG8_LDA(At, 1, 0); PG8_STAGE(PG8_SA(0, 1), a2 + hstep, voffA);
            PG8_WAIT_L(8); PG8_BAR; PG8_WAIT_L(0); PG8_MMA(0, 0, At, B0); PG8_BAR; PG8_SCHED;
            PG8_LDB(B1, 1, 1); PG8_STAGE(PG8_SB(1, 0), b3, voffB);
            PG8_BAR; PG8_WAIT_L(0); PG8_MMA(0, 1, At, B1); PG8_BAR;
            PG8_LDA(At, 1, 1); PG8_STAGE(PG8_SA(1, 0), a3, voffA);
            PG8_BAR; PG8_WAIT_L(0); PG8_MMA(1, 0, At, B0); PG8_BAR; PG8_SCHED;
            PG8_STAGE(PG8_SB(1, 1), b3 + hstep, voffB);
            PG8_WAIT_V(6); PG8_BAR; PG8_MMA(1, 1, At, B1); PG8_BAR;
            }
        }
        if constexpr (ALIGN_EPI) { if (wr == 0) PG8_BAR; }
        if constexpr (!Epi::AFTER_DRAIN) { E(acc, cur, wr, wc, fr, fq); S.done(cur); }
        if (!has_next) break;
#pragma unroll
        for (int a = 0; a < 2; ++a)
#pragma unroll
            for (int b = 0; b < 2; ++b)
#pragma unroll
                for (int m = 0; m < 4; ++m)
#pragma unroll
                    for (int n = 0; n < 2; ++n) acc[a][b][m][n] = (f32x4){0.f, 0.f, 0.f, 0.f};
        cur = nxt; cA = nA; cB = nB; ++ui;
        if constexpr (ALIGN_EPI) { if (wr == 1) PG8_BAR; }
    }
    PG8_WAIT_V(0);
    if constexpr (!ALIGN_EPI) { if (wr == 0) PG8_BAR; }
    PG8_BAR;
    if constexpr (Epi::AFTER_DRAIN) { E.fused(acc, cur, wr, wc, fr, fq, lds, wid, lane); S.done(cur); }
#undef PG8_SA
#undef PG8_SB
#undef PG8_STAGE
#undef PG8_LDA
#undef PG8_LDB
#undef PG8_MMA
#undef PG8_WAIT_V
#undef PG8_WAIT_L
#undef PG8_BAR
#undef PG8_SCHED
}
}
namespace attn {
typedef unsigned short bf16r;
constexpr int   D = 128, NW = 8, QBLK = 32, KVBLK = 64;
constexpr float SCALE = 0.088388347648318440f;
constexpr float THR = 8.f;
constexpr int LDQ = 2048, LDK = 256, LDO = 2048;
constexpr size_t SHM_ATTN = 6 * 16384 + NW * 64 * 4;
using bf16x8 = __attribute__((ext_vector_type(8))) short;
using s16x4  = __attribute__((ext_vector_type(4))) short;
using f32x16 = __attribute__((ext_vector_type(16))) float;
using f32x8  = __attribute__((ext_vector_type(8))) float;
using u32x4  = __attribute__((ext_vector_type(4))) unsigned;
#define KSWZ(row, colB) ((row) * 256 + ((colB) ^ (((row) & 7) << 4)))
#define SBAR() __builtin_amdgcn_sched_barrier(0)
__device__ __forceinline__ int crow(int r, int hi) { return (r & 3) + 8 * (r >> 2) + 4 * hi; }
__device__ __forceinline__ unsigned cvtpk(float lo, float hi) {
  unsigned r; asm volatile("v_cvt_pk_bf16_f32 %0, %1, %2" : "=v"(r) : "v"(lo), "v"(hi)); return r;
}
__device__ __forceinline__ void partialSM(f32x16& p0, f32x16& p1, float& m_reg, float& mn, float& alpha) {
  constexpr float C = SCALE * 1.4426950408889634f;
  float pmax = p0[0]; for (int r = 1; r < 16; ++r) pmax = fmaxf(pmax, p0[r]); for (int r = 0; r < 16; ++r) pmax = fmaxf(pmax, p1[r]);
  { auto rr = __builtin_amdgcn_permlane32_swap(__float_as_uint(pmax), __float_as_uint(pmax), false, false);
    pmax = fmaxf(__uint_as_float(rr[0]), __uint_as_float(rr[1])); }
  if (__builtin_expect(__all(pmax - m_reg <= THR / SCALE), 1)) { mn = m_reg; alpha = 1.f; }
  else { mn = fmaxf(m_reg, pmax); alpha = __builtin_amdgcn_exp2f((m_reg - mn) * C); m_reg = mn; }
  float mnC = -mn * C;
  for (int r = 0; r < 16; ++r) p0[r] = fmaf(p0[r], C, mnC); for (int r = 0; r < 16; ++r) p1[r] = fmaf(p1[r], C, mnC);
  for (int r = 0; r < 16; ++r) p0[r] = __builtin_amdgcn_exp2f(p0[r]);
}
__device__ __forceinline__ void finishSM(f32x16& p0, f32x16& p1, float alpha, float& l_reg, bf16x8& pa0, bf16x8& pa1, bf16x8& pa2, bf16x8& pa3) {
  for (int r = 0; r < 16; ++r) p1[r] = __builtin_amdgcn_exp2f(p1[r]);
  float ps = 0; for (int r = 0; r < 16; ++r) ps += p0[r]; for (int r = 0; r < 16; ++r) ps += p1[r];
  { auto rr = __builtin_amdgcn_permlane32_swap(__float_as_uint(ps), __float_as_uint(ps), false, false);
    ps = __uint_as_float(rr[0]) + __uint_as_float(rr[1]); }
  l_reg = l_reg * alpha + ps;
#define PK4(P, BASE, OUT) do { unsigned a0 = cvtpk(P[BASE + 0], P[BASE + 1]), a1 = cvtpk(P[BASE + 2], P[BASE + 3]);   \
    unsigned b0 = cvtpk(P[BASE + 4], P[BASE + 5]), b1 = cvtpk(P[BASE + 6], P[BASE + 7]);                              \
    auto r0 = __builtin_amdgcn_permlane32_swap(a0, b0, false, false); auto r1 = __builtin_amdgcn_permlane32_swap(a1, b1, false, false); \
    u32x4 w = {r0[0], r1[0], r0[1], r1[1]}; OUT = *reinterpret_cast<bf16x8*>(&w); } while (0)
  PK4(p0, 0, pa0); PK4(p0, 8, pa1); PK4(p1, 0, pa2); PK4(p1, 8, pa3);
#undef PK4
}
__device__ __forceinline__ void qkt(f32x16& p0, f32x16& p1, const bf16r* Ks, const bf16x8* qr, int r32, int hi) {
  p0 = f32x16{}; p1 = f32x16{};
  for (int d0 = 0; d0 < 8; ++d0) { int cb = (d0 * 16 + hi * 8) * 2;
    bf16x8 b0 = *reinterpret_cast<const bf16x8*>((const char*)Ks + KSWZ(r32, cb));
    bf16x8 b1 = *reinterpret_cast<const bf16x8*>((const char*)Ks + KSWZ(32 + r32, cb));
    p0 = __builtin_amdgcn_mfma_f32_32x32x16_bf16(b0, qr[d0], p0, 0, 0, 0);
    p1 = __builtin_amdgcn_mfma_f32_32x32x16_bf16(b1, qr[d0], p1, 0, 0, 0); }
}
__device__ __forceinline__ int v_st(int k, int c) { const int kk = (k & ~0xC) | ((k & 4) << 1) | ((k & 8) >> 1); return ((kk >> 3) * 4 + (c >> 5)) * 512 + ((kk & 7) * 32 + (c & 31)) * 2; }
__device__ __forceinline__ int v_rd_base(int lane) { return ((lane & 3) << 3) | (((lane >> 2) & 3) << 6) | (((lane >> 4) & 1) << 5) | (((lane >> 5) & 1) << 8); }
constexpr int v_rd_off(int d0, int ks, int half) { return d0 * 512 + ks * 4096 + half * 2048; }
template <int OFF> __device__ __forceinline__ s16x4 tr_read(int vb) {
  s16x4 r; asm volatile("ds_read_b64_tr_b16 %0, %1 offset:%2" : "=&v"(r) : "v"(vb), "i"(OFF) : "memory"); return r;
}
template <int D0> __device__ __forceinline__ void pv_one(f32x16& od, int vb, bf16x8 pa0, bf16x8 pa1, bf16x8 pa2, bf16x8 pa3) {
  const s16x4 l0 = tr_read<v_rd_off(D0, 0, 0)>(vb), h0 = tr_read<v_rd_off(D0, 0, 1)>(vb), l1 = tr_read<v_rd_off(D0, 1, 0)>(vb), h1 = tr_read<v_rd_off(D0, 1, 1)>(vb);
  const s16x4 l2 = tr_read<v_rd_off(D0, 2, 0)>(vb), h2 = tr_read<v_rd_off(D0, 2, 1)>(vb), l3 = tr_read<v_rd_off(D0, 3, 0)>(vb), h3 = tr_read<v_rd_off(D0, 3, 1)>(vb);
  asm volatile("s_waitcnt lgkmcnt(0)" ::: "memory"); SBAR();
#define PK(L, H) (bf16x8){L[0], L[1], L[2], L[3], H[0], H[1], H[2], H[3]}
  od = __builtin_amdgcn_mfma_f32_32x32x16_bf16(pa0, PK(l0, h0), od, 0, 0, 0);
  od = __builtin_amdgcn_mfma_f32_32x32x16_bf16(pa1, PK(l1, h1), od, 0, 0, 0);
  od = __builtin_amdgcn_mfma_f32_32x32x16_bf16(pa2, PK(l2, h2), od, 0, 0, 0);
  od = __builtin_amdgcn_mfma_f32_32x32x16_bf16(pa3, PK(l3, h3), od, 0, 0, 0);
#undef PK
}
__device__ __forceinline__ void pv_d0(f32x16* o, int vb, bf16x8 pa0, bf16x8 pa1, bf16x8 pa2, bf16x8 pa3) {
  pv_one<0>(o[0], vb, pa0, pa1, pa2, pa3); pv_one<1>(o[1], vb, pa0, pa1, pa2, pa3); pv_one<2>(o[2], vb, pa0, pa1, pa2, pa3); pv_one<3>(o[3], vb, pa0, pa1, pa2, pa3);
}
constexpr float THRL = 8.f;
__device__ __forceinline__ void qkt2(f32x16& p0, f32x16& p1, const bf16r* Ks, const bf16x8* qr, float nm, int r32, int hi) {
  f32x16 negm;
#pragma unroll
  for (int r = 0; r < 16; ++r) negm[r] = nm;
#pragma unroll
  for (int d0 = 0; d0 < 8; ++d0) { int cb = (d0 * 16 + hi * 8) * 2;
    bf16x8 b0 = *reinterpret_cast<const bf16x8*>((const char*)Ks + KSWZ(r32, cb));
    bf16x8 b1 = *reinterpret_cast<const bf16x8*>((const char*)Ks + KSWZ(32 + r32, cb));
    if (d0 == 0) { p1 = __builtin_amdgcn_mfma_f32_32x32x16_bf16(b1, qr[0], negm, 0, 0, 0); p0 = __builtin_amdgcn_mfma_f32_32x32x16_bf16(b0, qr[0], negm, 0, 0, 0); }
    else { p0 = __builtin_amdgcn_mfma_f32_32x32x16_bf16(b0, qr[d0], p0, 0, 0, 0); p1 = __builtin_amdgcn_mfma_f32_32x32x16_bf16(b1, qr[d0], p1, 0, 0, 0); } }
}
__device__ __forceinline__ void partialSM2(f32x16& p0, f32x16& p1, float& mhat, float& alpha, bool first) {
  float a = __builtin_fmaxf(__builtin_fmaxf(p0[0], p0[1]), p1[0]), b = __builtin_fmaxf(__builtin_fmaxf(p0[2], p0[3]), p1[1]); a = __builtin_fmaxf(__builtin_fmaxf(a, p1[2]), p1[3]);
#pragma unroll
  for (int r = 4; r < 16; r += 4) { a = __builtin_fmaxf(__builtin_fmaxf(a, p0[r]), p0[r + 1]); b = __builtin_fmaxf(__builtin_fmaxf(b, p0[r + 2]), p0[r + 3]); a = __builtin_fmaxf(__builtin_fmaxf(a, p1[r]), p1[r + 1]); b = __builtin_fmaxf(__builtin_fmaxf(b, p1[r + 2]), p1[r + 3]); }
  float pmax = __builtin_fmaxf(a, b);
  { auto rr = __builtin_amdgcn_permlane32_swap(__float_as_uint(pmax), __float_as_uint(pmax), false, false); pmax = __builtin_fmaxf(__uint_as_float(rr[0]), __uint_as_float(rr[1])); }
  alpha = 1.f;
  if (first || __builtin_expect(__any(pmax > THRL), 0)) {
    const float dl = first ? pmax : __builtin_fmaxf(pmax, 0.f);
    mhat += dl;
#pragma unroll
    for (int r = 0; r < 16; ++r) { p0[r] -= dl; p1[r] -= dl; }
    if (!first) alpha = __builtin_amdgcn_exp2f(-dl);
  }
#pragma unroll
  for (int r = 0; r < 16; ++r) p0[r] = __builtin_amdgcn_exp2f(p0[r]);
}
__device__ __forceinline__ void mask_meta(f32x16& p0, f32x16& p1) {
  const float NEG = -INFINITY;
#pragma unroll
  for (int r = 8; r < 16; ++r) p0[r] = NEG;
#pragma unroll
  for (int r = 0; r < 16; ++r) p1[r] = NEG;
}
__device__ __forceinline__ unsigned short f2bf_rne(float f) { unsigned u = __builtin_bit_cast(unsigned, f); return (unsigned short)((u + 0x7fffu + ((u >> 16) & 1u)) >> 16); }

__device__ __forceinline__ void attn_unit(const bf16r* Qb, const bf16r* __restrict__ Kh, const bf16r* __restrict__ Vh,
                                          const bf16r* __restrict__ KMh, const bf16r* __restrict__ VMh, bf16r* Ob, int NT, char* lds,
                                          const float* __restrict__ qnorm, int t0, float* ssq) {
  int tid_ = threadIdx.x; asm volatile("" : "+v"(tid_));
  const int tid = tid_, wid = tid >> 6, lane = tid & 63, r32 = lane & 31, hi = lane >> 5;
  float* ws = (float*)(lds + 6 * 16384) + wid * 64; float* li_l = ws; float* al_l = ws + 32;
  float mhat = 0.f, l_reg = 0; f32x16 o[4] = {}; bf16x8 qr[8];
  const bf16r* Qw = Qb + (long)(wid * QBLK + r32) * LDQ + hi * 8;
#pragma unroll
  for (int d0 = 0; d0 < 8; ++d0) qr[d0] = *reinterpret_cast<const bf16x8*>(Qw + d0 * 16);
  {
    float ss = 0.f;
#pragma unroll
    for (int d0 = 0; d0 < 8; ++d0)
#pragma unroll
      for (int j = 0; j < 8; ++j) { const float x = __builtin_bit_cast(float, (unsigned)(unsigned short)qr[d0][j] << 16); ss += x * x; }
    { auto rr = __builtin_amdgcn_permlane32_swap(__float_as_uint(ss), __float_as_uint(ss), false, false); ss = __uint_as_float(rr[0]) + __uint_as_float(rr[1]); }
    const float rs = (SCALE * 1.4426950408889634f) / sqrtf(ss * (1.f / 128.f) + 1e-6f);
    int t = t0 + wid * QBLK + r32; int hio = hi; asm volatile("" : "+v"(t), "+v"(hio));
#pragma unroll
    for (int g = 0; g < 4; ++g) {
      const int p = g >> 1, dd = g & 1, fa = 4 * p + dd, fb = fa + 2; const float pos = (float)(p ? (t & 63) : (t >> 6));
      const float4 ga0 = *reinterpret_cast<const float4*>(qnorm + fa * 16 + hi * 8), ga1 = *reinterpret_cast<const float4*>(qnorm + fa * 16 + hi * 8 + 4);
      const float4 gb0 = *reinterpret_cast<const float4*>(qnorm + fb * 16 + hi * 8), gb1 = *reinterpret_cast<const float4*>(qnorm + fb * 16 + hi * 8 + 4);
      const float gaf[8] = {ga0.x, ga0.y, ga0.z, ga0.w, ga1.x, ga1.y, ga1.z, ga1.w}, gbf[8] = {gb0.x, gb0.y, gb0.z, gb0.w, gb1.x, gb1.y, gb1.z, gb1.w};
      float oa[8], ob[8];
#pragma unroll
      for (int j = 0; j < 8; ++j) { const int i = 16 * dd + 8 * hio + j;
        float rev = pos * __builtin_amdgcn_exp2f(-(float)i * (13.287712379549449f / 32.f)) * 0.15915494309189535f; rev -= floorf(rev);
        const float sn = __builtin_amdgcn_sinf(rev), cs = __builtin_amdgcn_cosf(rev);
        const float x1 = __builtin_bit_cast(float, (unsigned)(unsigned short)qr[fa][j] << 16) * rs * gaf[j], x2 = __builtin_bit_cast(float, (unsigned)(unsigned short)qr[fb][j] << 16) * rs * gbf[j];
        oa[j] = x1 * cs - x2 * sn; ob[j] = x2 * cs + x1 * sn; }
      { u32x4 w = {cvtpk(oa[0], oa[1]), cvtpk(oa[2], oa[3]), cvtpk(oa[4], oa[5]), cvtpk(oa[6], oa[7])}; qr[fa] = *reinterpret_cast<bf16x8*>(&w); }
      { u32x4 w = {cvtpk(ob[0], ob[1]), cvtpk(ob[2], ob[3]), cvtpk(ob[4], ob[5]), cvtpk(ob[6], ob[7])}; qr[fb] = *reinterpret_cast<bf16x8*>(&w); }
      SBAR();
    }
  }
  unsigned kgo0, kgo1, vgo0, vgo1;
  { const int rk0 = 4 * wid + (lane >> 4), rk1 = rk0 + 32; kgo0 = (unsigned)(rk0 * (LDK * 2) + (((lane & 15) << 4) ^ ((rk0 & 7) << 4))); kgo1 = (unsigned)(rk1 * (LDK * 2) + (((lane & 15) << 4) ^ ((rk1 & 7) << 4)));
    const int kklo = (lane & 31) >> 2, cin = (lane & 3) * 8;
    { const int st = 2 * wid + (lane >> 5), kk = (st >> 2) * 8 + kklo, k = (kk & ~0xC) | ((kk & 4) << 1) | ((kk & 8) >> 1); vgo0 = (unsigned)(k * (LDK * 2) + ((st & 3) * 32 + cin) * 2); }
    { const int st = 2 * (wid + 8) + (lane >> 5), kk = (st >> 2) * 8 + kklo, k = (kk & ~0xC) | ((kk & 4) << 1) | ((kk & 8) >> 1); vgo1 = (unsigned)(k * (LDK * 2) + ((st & 3) * 32 + cin) * 2); } }
  typedef __attribute__((address_space(3))) unsigned char* ldsp_t;
  const ldsp_t lds3 = (ldsp_t)lds;
  const int w1k = __builtin_amdgcn_readfirstlane(wid) * 1024;
  constexpr int VRING = 3 * 16384;
#define DMAK(t, soff) do { const char* b_ = (const char*)((t) == 0 ? KMh : Kh + (long)((t) - 1) * KVBLK * LDK); \
    __builtin_amdgcn_global_load_lds((const unsigned*)(b_ + kgo0), (__attribute__((address_space(3))) unsigned*)(lds3 + (soff) + w1k), 16, 0, 0); \
    __builtin_amdgcn_global_load_lds((const unsigned*)(b_ + kgo1), (__attribute__((address_space(3))) unsigned*)(lds3 + (soff) + w1k + 8192), 16, 0, 0); } while (0)
#define DMAV(t, soff) do { const char* b_ = (const char*)((t) == 0 ? VMh : Vh + (long)((t) - 1) * KVBLK * LDK); \
    __builtin_amdgcn_global_load_lds((const unsigned*)(b_ + vgo0), (__attribute__((address_space(3))) unsigned*)(lds3 + VRING + (soff) + w1k), 16, 0, 0); \
    __builtin_amdgcn_global_load_lds((const unsigned*)(b_ + vgo1), (__attribute__((address_space(3))) unsigned*)(lds3 + VRING + (soff) + w1k + 8192), 16, 0, 0); } while (0)
#define WAITBAR(N) asm volatile("s_waitcnt vmcnt(" #N ") lgkmcnt(0)\n\ts_barrier" ::: "memory")
#define ROT() do { const int t_ = sm1; sm1 = sc_; sc_ = sp1; sp1 = t_; } while (0)
#define RESC(a) do { if (__any((a) < 1.f)) { if (hi == 0) al_l[r32] = (a); asm volatile("s_waitcnt lgkmcnt(0)" ::: "memory"); \
    _Pragma("unroll") for (int r = 0; r < 16; ++r) { const float a_ = al_l[crow(r, hi)]; o[0][r] *= a_; o[1][r] *= a_; o[2][r] *= a_; o[3][r] *= a_; asm volatile("" : "+v"(o[0][r]), "+v"(o[1][r]), "+v"(o[2][r]), "+v"(o[3][r])); } } } while (0)
  const int vb0 = (int)(uintptr_t)(lds + VRING) + v_rd_base(lane);
  int sm1 = 32768, sc_ = 0, sp1 = 16384;
  f32x16 pA0, pA1, pB0, pB1; float alA, alB; bf16x8 pa0, pa1, pa2, pa3;
  DMAK(0, 0); DMAV(0, 0); DMAK(1, 16384);
  WAITBAR(2);
  DMAK(2, sm1); DMAV(1, sp1);
  qkt2(pA0, pA1, (const bf16r*)(lds + sc_), qr, -mhat, r32, hi); mask_meta(pA0, pA1); partialSM2(pA0, pA1, mhat, alA, true);
  WAITBAR(4); ROT();
  for (int t = 1; t + 1 < NT; t += 2) {
    if (t + 2 < NT) DMAK(t + 2, sm1); DMAV(t + 1, sp1);
    SBAR(); qkt2(pB0, pB1, (const bf16r*)(lds + sc_), qr, -mhat, r32, hi);
    finishSM(pA0, pA1, alA, l_reg, pa0, pa1, pa2, pa3); SBAR();
    pv_d0(o, vb0 + sm1, pa0, pa1, pa2, pa3); partialSM2(pB0, pB1, mhat, alB, false);
    if (t + 2 < NT) WAITBAR(4); else WAITBAR(2);
    RESC(alB); ROT();
    if (t + 3 < NT) DMAK(t + 3, sm1); if (t + 2 < NT) DMAV(t + 2, sp1);
    SBAR(); qkt2(pA0, pA1, (const bf16r*)(lds + sc_), qr, -mhat, r32, hi);
    finishSM(pB0, pB1, alB, l_reg, pa0, pa1, pa2, pa3); SBAR();
    pv_d0(o, vb0 + sm1, pa0, pa1, pa2, pa3); partialSM2(pA0, pA1, mhat, alA, false);
    if (t + 3 < NT) WAITBAR(4); else if (t + 2 < NT) WAITBAR(2); else WAITBAR(0);
    RESC(alA); ROT();
  }
  finishSM(pA0, pA1, alA, l_reg, pa0, pa1, pa2, pa3); SBAR();
  pv_d0(o, vb0 + sm1, pa0, pa1, pa2, pa3);
  if (hi == 0) li_l[r32] = l_reg; asm volatile("s_waitcnt lgkmcnt(0)" ::: "memory");
  float rli[16];
#pragma unroll
  for (int r = 0; r < 16; ++r) rli[r] = __builtin_amdgcn_rcpf(li_l[crow(r, hi)]);
  bf16r* Ow = Ob + (long)(wid * QBLK) * LDO;
#pragma unroll
  for (int r = 0; r < 16; ++r) { const int orow = crow(r, hi);
    float sq = 0.f;
#pragma unroll
    for (int d0 = 0; d0 < 4; ++d0) { const float v = o[d0][r] * rli[r]; sq += v * v; Ow[(long)orow * LDO + d0 * 32 + r32] = f2bf_rne(v); }
    sq += __shfl_xor(sq, 1); sq += __shfl_xor(sq, 2); sq += __shfl_xor(sq, 4); sq += __shfl_xor(sq, 8); sq += __shfl_xor(sq, 16);
    if (r32 == 0) ssq[(long)(wid * QBLK + orow) * 8] = sq; }
  WAITBAR(0);
#undef DMAK
#undef DMAV
#undef WAITBAR
#undef ROT
#undef RESC
}
#undef KSWZ
#undef SBAR
}

constexpr int NWAVES = 8;
constexpr int DM = 2048, NTOK = 65536, INW = 3584, FFN = 5632, UPW = 2 * FFN;
constexpr float EPS = 1e-6f;
constexpr int XR_ROWS = 8 * 4160 + 4 * 8256;
constexpr int NCHUNK = 8 * 65 + 4 * 129;
constexpr int HROWS = 32768;
__host__ __device__ __forceinline__ int seq_first_row(int s) { return s < 8 ? s * 4096 : 32768 + (s - 8) * 8192; }
__host__ __device__ __forceinline__ int seq_len(int s) { return s < 8 ? 4096 : 8192; }
__host__ __device__ __forceinline__ int xr_base(int s) { return s < 8 ? s * 4160 : 33280 + (s - 8) * 8256; }
__host__ __device__ __forceinline__ int chunk_base(int s) { return s < 8 ? s * 65 : 520 + (s - 8) * 129; }
__host__ __device__ __forceinline__ int row_seq(int row) { return row < 32768 ? (row >> 12) : 8 + ((row - 32768) >> 13); }

constexpr size_t MiB = 1u << 20, KiB = 1u << 10;
constexpr size_t WS_CTL = 0, CTL_ZERO_BYTES = 1 * MiB;
constexpr size_t WS_SMALL = 1 * MiB;
constexpr size_t WS_XNMETA = WS_SMALL + 0, WS_ZM = WS_SMALL + 64 * KiB, WS_KM = WS_SMALL + 320 * KiB, WS_VM = WS_SMALL + 352 * KiB, WS_Q15 = WS_SMALL + 384 * KiB, WS_GY15 = WS_SMALL + 388 * KiB,
                 WS_LO15 = WS_SMALL + 392 * KiB, WS_MIXED15 = WS_SMALL + 448 * KiB, WS_Y15 = WS_SMALL + 544 * KiB, WS_G15 = WS_SMALL + 640 * KiB, WS_MQP = WS_SMALL + 1024 * KiB;
constexpr size_t WS_WIN = 5 * MiB, WS_WOUT = 19 * MiB, WS_WUP = 27 * MiB, WS_WDOWN = 71 * MiB, WS_WG = 93 * MiB;
constexpr size_t WS_CAR = 94 * MiB, WS_CIN = 111 * MiB;
constexpr size_t WS_R0 = 120 * MiB, WS_RATIO = 120 * MiB + 256 * KiB, WS_RL = 120 * MiB + 512 * KiB, WS_SSQA = 121 * MiB, WS_SSQL = 123 * MiB;
constexpr size_t WS_A = 128 * MiB;
constexpr size_t WS_B = 384 * MiB;
constexpr size_t WS_QG = WS_B, WS_K = WS_B + 256 * MiB, WS_V = WS_B + 288 * MiB, WS_XR = WS_B + 320 * MiB;
constexpr size_t WS_ACT = WS_B, WS_EDGE = WS_B + 352 * MiB;
constexpr size_t WS_H1A = WS_B + 420 * MiB;
constexpr size_t WS_END = WS_B + 548 * MiB;
static_assert(WS_ZM + 16 * INW * 4 <= WS_KM && WS_G15 + 12 * FFN * 4 <= WS_MQP && WS_MQP + 512 * 4 * 132 * 4 <= WS_WIN, "small map");
static_assert(WS_WIN + (size_t)INW * DM * 2 <= WS_WOUT && WS_WOUT + (size_t)DM * DM * 2 <= WS_WUP && WS_WUP + (size_t)UPW * DM * 2 <= WS_WDOWN && WS_WDOWN + (size_t)DM * FFN * 2 <= WS_WG && WS_WG + 32 * 16384 * 2 <= WS_CAR, "weights map");
static_assert(WS_CAR + (size_t)NCHUNK * 2 * 1024 * 8 <= WS_CIN && WS_A + (size_t)NTOK * DM * 2 <= WS_B, "carry map");
static_assert(WS_QG + (size_t)NTOK * DM * 2 <= WS_K && WS_XR + (size_t)(XR_ROWS + 64) * 1024 * 2 <= WS_END && WS_EDGE + (size_t)512 * 2 * 3 * FFN * 4 <= WS_H1A && WS_H1A + (size_t)HROWS * DM * 2 <= WS_END && WS_END <= 1024 * MiB && WS_CIN + (size_t)NCHUNK * 2 * 1024 * 4 <= WS_R0 && WS_SSQL + (size_t)NTOK * 8 * 4 <= WS_A && WS_ACT + (size_t)HROWS * FFN * 2 <= WS_EDGE && WS_EDGE + (size_t)512 * 2 * 3 * FFN * 4 <= WS_END, "B map");
constexpr int CW_BAR = 4096;

constexpr int RING_BYTES = 131072;
constexpr int LDSCTL_OFF = RING_BYTES, MISC_OFF = LDSCTL_OFF + 320;
constexpr int LDS_BYTES = 147456;

#define GAS __attribute__((address_space(1)))
#define LAS __attribute__((address_space(3)))
typedef unsigned short bf16;
typedef unsigned v4u __attribute__((ext_vector_type(4)));
typedef float f32x4 __attribute__((ext_vector_type(4)));
typedef short bf16x8 __attribute__((ext_vector_type(8)));
typedef GAS unsigned gu32;
typedef GAS unsigned long long gu64;
#define RLX_AGENT __ATOMIC_RELAXED, __HIP_MEMORY_SCOPE_AGENT
#define LDS_WAIT() asm volatile("s_waitcnt lgkmcnt(0)" ::: "memory")
#define VM_WAIT() asm volatile("s_waitcnt vmcnt(0)" ::: "memory")
__device__ __forceinline__ unsigned long long rt() { return __builtin_amdgcn_s_memrealtime(); }
__device__ __forceinline__ unsigned f2bf(float f) { unsigned u = __builtin_bit_cast(unsigned, f); return (u + 0x7fffu + ((u >> 16) & 1u)) >> 16; }
__device__ __forceinline__ unsigned pk2(float lo, float hi) { return f2bf(lo) | (f2bf(hi) << 16); }

#define XB_TMO      128
#define XB_XCNT(j)  (256  + 64 * (j))
#define XB_XSUB(j)  (1280 + 64 * (j))
#define XB_XGEN(j)  (2304 + 64 * (j))
#define XB_TOP      3328
#define XB_TOPGEN   3392
#define XCD_BAR_WORDS 3456
#define XB_SPIN_CAP (1u << 18)

__device__ __forceinline__ unsigned xb_ld(unsigned* p)              { return __hip_atomic_load(p, __ATOMIC_RELAXED, __HIP_MEMORY_SCOPE_AGENT); }
__device__ __forceinline__ unsigned xb_add(unsigned* p, unsigned v) { return __hip_atomic_fetch_add(p, v, __ATOMIC_RELAXED, __HIP_MEMORY_SCOPE_AGENT); }
__device__ __forceinline__ unsigned xb_xcc_id() { return (unsigned)__builtin_amdgcn_s_getreg((3 << 11) | 20) & 0xFu; }
#define XB_SPIN(cond, bar) do { unsigned _sp = 0; while (cond) { __builtin_amdgcn_s_sleep(1); \
    if ((++_sp & 255u) == 0u) { if (xb_ld(&(bar)[XB_TMO])) break; if (_sp > XB_SPIN_CAP) { atomicAdd(&(bar)[XB_TMO], 1u); break; } } } } while (0)

struct XcdBarrier {
    unsigned* bar; unsigned x;
    volatile LAS unsigned* st;
};

__device__ __forceinline__ XcdBarrier xcd_barrier_post(unsigned* bar, volatile LAS unsigned* st) {
    XcdBarrier b; b.bar = bar; b.x = xb_xcc_id(); b.st = st;
    if (threadIdx.x == 0) (void)xb_add(&bar[XB_XCNT(b.x)], 1u);
    return b;
}
__device__ __forceinline__ void xcd_barrier_complete(unsigned* bar, unsigned x, unsigned& nloc, unsigned& nx) {
    const unsigned G = gridDim.x * gridDim.y * gridDim.z;
    unsigned sum, cnt, mine, sp = 0u;
    for (;;) {
        sum = 0u; cnt = 0u; mine = 0u;
#pragma unroll
        for (unsigned j = 0; j < 16; ++j) { const unsigned c = xb_ld(&bar[XB_XCNT(j)]); sum += c; cnt += (c > 0u) ? 1u : 0u; mine = (j == x) ? c : mine; }
        if (sum == G) break;
        __builtin_amdgcn_s_sleep(1);
        if ((++sp & 255u) == 0u) { if (xb_ld(&bar[XB_TMO])) break; if (sp > XB_SPIN_CAP) { atomicAdd(&bar[XB_TMO], 1u); break; } }
    }
    nloc = mine > 0u ? mine : 1u; nx = cnt > 0u ? cnt : 1u;
}

__device__ __forceinline__ void xcd_barrier(const XcdBarrier& b) {
    asm volatile("s_waitcnt vmcnt(0)" ::: "memory");
    __syncthreads();
    if (threadIdx.x == 0) {
        unsigned* bar = b.bar;
        __builtin_amdgcn_s_waitcnt(0);
        unsigned nloc = b.st[0], nx = b.st[1];
        if (nloc == 0u) { xcd_barrier_complete(bar, b.x, nloc, nx); b.st[0] = nloc; b.st[1] = nx; }
        const unsigned old = xb_add(&bar[XB_XSUB(b.x)], 1u);
        const unsigned gen = old / nloc;
        if (old + 1u == (gen + 1u) * nloc) {
            __builtin_amdgcn_fence(__ATOMIC_RELEASE, "agent");
            asm volatile("s_waitcnt vmcnt(0)" ::: "memory");
            const unsigned og = xb_add(&bar[XB_TOP], 1u);
            const unsigned tg = og / nx;
            if (og + 1u == (tg + 1u) * nx) xb_add(&bar[XB_TOPGEN], 1u);
            else XB_SPIN(xb_ld(&bar[XB_TOPGEN]) == tg, bar);
            __builtin_amdgcn_fence(__ATOMIC_ACQUIRE, "agent");
            xb_add(&bar[XB_XGEN(b.x)], 1u);
            asm volatile("s_waitcnt vmcnt(0)" ::: "memory");
        } else {
            XB_SPIN(xb_ld(&bar[XB_XGEN(b.x)]) == gen, bar);
            __builtin_amdgcn_fence(__ATOMIC_ACQUIRE, "agent");
            asm volatile("s_waitcnt vmcnt(0)" ::: "memory");
        }
    }
    __syncthreads();
}

__device__ __forceinline__ float bf2f(unsigned short b) { return __builtin_bit_cast(float, (unsigned)b << 16); }
__device__ __forceinline__ float bf2f(short b) { return __builtin_bit_cast(float, (unsigned)(unsigned short)b << 16); }
__device__ __forceinline__ float wave_sum(float v) {
#pragma unroll
    for (int o = 1; o < 64; o <<= 1) v += __shfl_xor(v, o);
    return v;
}
__device__ __forceinline__ float wave_max(float v) {
#pragma unroll
    for (int o = 1; o < 64; o <<= 1) v = fmaxf(v, __shfl_xor(v, o));
    return v;
}
__device__ __forceinline__ float fast_exp(float x) { return __builtin_amdgcn_exp2f(x * 1.4426950408889634f); }
__device__ __forceinline__ float sigmoidf_(float x) { return __builtin_amdgcn_rcpf(1.f + fast_exp(-x)); }
__device__ __forceinline__ float gelu_tanh(float x) {
    const float z = 0.7978845608028654f * (x + 0.044715f * x * x * x);
    return x * sigmoidf_(2.f * z);
}
__device__ __forceinline__ float neg_expm1(float x) {
    const float p = x * (1.f + x * (0.5f + x * (0.16666667f + x * (0.041666668f + x * (0.0083333338f + x * 0.0013888889f)))));
    const float e = fast_exp(x) - 1.f;
    return -(fabsf(x) < 0.25f ? p : e);
}
__device__ __forceinline__ v4u pack8(const float (&v)[8]) { v4u o; o.x = pk2(v[0], v[1]); o.y = pk2(v[2], v[3]); o.z = pk2(v[4], v[5]); o.w = pk2(v[6], v[7]); return o; }

#define FIN(F, idx) ({ const __attribute__((address_space(1))) float* p_; asm("s_load_dwordx2 %0, %1, %2 ; tag %3\n\ts_waitcnt lgkmcnt(0)" : "=s"(p_) : "s"((F).kargs), "i"((idx) * 8), "s"((F).ptag)); (const float*)p_; })
struct Frame {
    LAS unsigned char* lds;
    volatile LAS unsigned* MISC;
    gu32* ctl;
    int tid, lane, wave, vcu, G;
    const __attribute__((address_space(4))) void* kargs; int ptag;
    float* out;
    unsigned char* ws;
#define WSP(T, NAME, OFF) __device__ __forceinline__ T* NAME() const { return (T*)(ws + (OFF)); }
    WSP(bf16, WIN_T, WS_WIN) WSP(bf16, WOUT_T, WS_WOUT) WSP(bf16, WUP_T, WS_WUP) WSP(bf16, WDOWN_T, WS_WDOWN) WSP(bf16, WG, WS_WG) WSP(bf16, XN, WS_A) WSP(bf16, QG, WS_QG) WSP(bf16, K, WS_K) WSP(bf16, V, WS_V)
    WSP(bf16, XR, WS_XR) WSP(bf16, ACT, WS_ACT) WSP(bf16, H1A, WS_H1A) WSP(float, EDGE, WS_EDGE) WSP(bf16, XNMETA, WS_XNMETA) WSP(bf16, KM, WS_KM) WSP(bf16, VM, WS_VM)
    WSP(float, ZM, WS_ZM) WSP(float, Q15, WS_Q15) WSP(float, GY15, WS_GY15) WSP(float, LO15, WS_LO15) WSP(float, MIXED15, WS_MIXED15) WSP(float, Y15, WS_Y15) WSP(float, G15, WS_G15) WSP(float, MQP, WS_MQP)
    WSP(float, CIN, WS_CIN) WSP(float2, CAR, WS_CAR) WSP(float, R0, WS_R0) WSP(float, RATIO, WS_RATIO) WSP(float, RL, WS_RL) WSP(float, SSQA, WS_SSQA) WSP(float, SSQL, WS_SSQL)
#undef WSP
};

template <bool UPMAP, int GAIN = 0>
__device__ __forceinline__ void p0_transpose_item(const float* W, int K, int N, bf16* WT, int row_off, LAS float* scr, int item, int lane, const float* g0 = nullptr, const float* g1 = nullptr) {
    const int nblk = N / 32, kb = item / nblk, nb = item % nblk, k0 = 64 * kb, n0 = 32 * nb;
    const int orow0 = UPMAP ? (((n0 % FFN) >> 7) << 8) + 128 * (n0 / FFN) + ((n0 % FFN) & 127) : row_off + n0;
#pragma unroll 8
    for (int i = 0; i < 32; ++i) { const int kk = 2 * i + (lane >> 5); float gv = 1.f; if (GAIN == 1) gv = g0[k0 + kk]; if (GAIN == 2) gv = (k0 + kk) < 1024 ? g0[k0 + kk] : g1[k0 + kk - 1024];
        scr[kk * 33 + (lane & 31)] = W[(size_t)(k0 + kk) * N + n0 + (lane & 31)] * gv; }
    LDS_WAIT(); asm volatile("" ::: "memory");
    const int c = lane & 7;
#pragma unroll
    for (int j = 0; j < 4; ++j) { const int n = (lane >> 3) + 8 * j; const LAS float* s = scr + (8 * c) * 33 + n;
        v4u o; o.x = pk2(s[0 * 33], s[1 * 33]); o.y = pk2(s[2 * 33], s[3 * 33]); o.z = pk2(s[4 * 33], s[5 * 33]); o.w = pk2(s[6 * 33], s[7 * 33]);
        *(GAS v4u*)(WT + (size_t)(orow0 + n) * K + k0 + 8 * c) = o; }
    LDS_WAIT(); asm volatile("" ::: "memory");
}
__device__ __forceinline__ void rms_row_to_bf16(const float* xrow, bf16* orow, int lane, float* rout) {
    const GAS f32x4* xr = (const GAS f32x4*)xrow + lane;
    f32x4 v[8]; float s = 0.f;
#pragma unroll
    for (int j = 0; j < 8; ++j) { v[j] = xr[64 * j]; s += (v[j].x * v[j].x + v[j].y * v[j].y) + (v[j].z * v[j].z + v[j].w * v[j].w); }
    const float r = 1.f / sqrtf(wave_sum(s) * (1.f / DM) + EPS);
    GAS unsigned long long* o8 = (GAS unsigned long long*)orow + lane;
#pragma unroll
    for (int j = 0; j < 8; ++j) o8[64 * j] = (unsigned long long)pk2(v[j].x * r, v[j].y * r) | ((unsigned long long)pk2(v[j].z * r, v[j].w * r) << 32);
    if (rout && lane == 0) *rout = r;
}
__device__ __forceinline__ void p0_prologue(Frame& F) {
    LAS float* scr = (LAS float*)(F.lds + F.wave * 16384);
    const int gw = F.vcu * NWAVES + F.wave, NGW = F.G * NWAVES;
    constexpr int I_IN = (DM / 64) * (INW / 32), I_OUT = (DM / 64) * (DM / 32), I_UP = (DM / 64) * (UPW / 32), I_DN = (FFN / 64) * (DM / 32), I_G = 32 * 8;
    constexpr int NITEMS = I_IN + I_OUT + I_UP + I_DN + I_G;
    for (int it = gw; it < NITEMS; it += NGW) {
        int r = it;
        if (r < I_IN) { p0_transpose_item<false, 1>(FIN(F, 4  ), DM, INW, F.WIN_T(), 0, scr, r, F.lane, FIN(F, 3  )); continue; } r -= I_IN;
        if (r < I_OUT) { p0_transpose_item<false, 2>(FIN(F, 16  ), DM, DM, F.WOUT_T(), 0, scr, r, F.lane, FIN(F, 14  ), FIN(F, 15  )); continue; } r -= I_OUT;
        if (r < I_UP) { p0_transpose_item<true>(FIN(F, 19  ), DM, UPW, F.WUP_T(), 0, scr, r, F.lane); continue; } r -= I_UP;
        if (r < I_DN) { p0_transpose_item<false>(FIN(F, 22  ), FFN, DM, F.WDOWN_T(), 0, scr, r, F.lane); continue; } r -= I_DN;
        {
            const int mi = r >> 3, sub = r & 7, gate = mi >> 4, dir = (mi >> 3) & 1, blk = mi & 7;
            const float* W = (gate ? FIN(F, 11  ) : FIN(F, 9  )) + (size_t)(dir * 8 + blk) * 16384;
            bf16* WT = F.WG() + (size_t)((dir * 2 + gate) * 8 + blk) * 16384;
            p0_transpose_item<false>(W, 128, 128, WT, 0, scr, sub, F.lane);
        }
    }
    for (int m = gw; m < NTOK; m += NGW) {
        const float* xr = m < 32768 ? FIN(F, 0  ) + (size_t)m * DM : FIN(F, 1  ) + (size_t)(m - 32768) * DM;
        rms_row_to_bf16(xr, F.XN() + (size_t)m * DM, F.lane, F.R0() + m);
    }
    for (int m = gw; m < 16; m += NGW) rms_row_to_bf16(FIN(F, 2  ) + (size_t)m * DM, F.XNMETA() + (size_t)m * DM, F.lane, nullptr);
    const int gt = F.vcu * 512 + F.tid, NGT = F.G * 512; const v4u z4 = {0u, 0u, 0u, 0u};
    for (int i = gt; i < 12 * 48 * 128; i += NGT) { const int s = i / (48 * 128), rem = i % (48 * 128); ((GAS v4u*)(F.XR() + (size_t)xr_base(s) * 1024))[rem] = z4; }
    for (int i = gt; i < 64 * 128; i += NGT) ((GAS v4u*)(F.XR() + (size_t)XR_ROWS * 1024))[i] = z4;
    for (int i = gt; i < 2048; i += NGT) { ((GAS v4u*)F.KM())[i] = z4; ((GAS v4u*)F.VM())[i] = z4; }
}

template <int R, class Out, bool GMAP = false>
__device__ __forceinline__ void small_gemm(const LAS float* X, int K, const bf16* Wt, int N, int gw, int NGW, int lane, const Out& out) {
    for (int n = gw; n < N; n += NGW) {
        float acc[R];
#pragma unroll
        for (int r = 0; r < R; ++r) acc[r] = 0.f;
        const GAS bf16x8* wrow = (const GAS bf16x8*)(Wt + (size_t)(GMAP ? ((n >> 7) << 8) + (n & 127) : n) * K);
        for (int k8 = lane; k8 < K / 8; k8 += 64) {
            const bf16x8 w = wrow[k8]; float wf[8];
#pragma unroll
            for (int j = 0; j < 8; ++j) wf[j] = bf2f(w[j]);
#pragma unroll
            for (int r = 0; r < R; ++r) { const LAS f32x4* xp = (const LAS f32x4*)(X + r * K + k8 * 8); const f32x4 a = xp[0], b = xp[1];
                acc[r] += (a.x * wf[0] + a.y * wf[1]) + (a.z * wf[2] + a.w * wf[3]) + (b.x * wf[4] + b.y * wf[5]) + (b.z * wf[6] + b.w * wf[7]); }
        }
        float v = 0.f;
#pragma unroll
        for (int r = 0; r < R; ++r) { const float s = wave_sum(acc[r]); v = (lane == r) ? s : v; }
        out(n, lane, v);
    }
}
struct OutMetaZ { float* ZM; bf16* XR;
    __device__ __forceinline__ void operator()(int n, int lane, float v) const {
        if (lane < 16) { ZM[lane * INW + n] = v;
            if (n >= 1536 && n < 2560) { const unsigned short b = (unsigned short)f2bf(v); const int c = n - 1536;
                for (int s = 0; s < 12; ++s) XR[(size_t)(xr_base(s) + 48 + lane) * 1024 + c] = b; } }
    } };
struct OutRows { float* Y; int ld; int R;
    __device__ __forceinline__ void operator()(int n, int lane, float v) const { if (lane < R) Y[(size_t)lane * ld + n] = v; } };

__device__ __forceinline__ void p1_meta_z(Frame& F) {
    LAS float* X = (LAS float*)F.lds;
    for (int i = F.tid; i < 16 * DM / 8; i += 512) { const bf16x8 v = ((const GAS bf16x8*)F.XNMETA())[i];
        ((LAS f32x4*)X)[2 * i] = (f32x4){bf2f(v[0]), bf2f(v[1]), bf2f(v[2]), bf2f(v[3])}; ((LAS f32x4*)X)[2 * i + 1] = (f32x4){bf2f(v[4]), bf2f(v[5]), bf2f(v[6]), bf2f(v[7])}; }
    __syncthreads();
    const OutMetaZ o{F.ZM(), F.XR()};
    small_gemm<16, OutMetaZ>(X, DM, F.WIN_T(), INW, F.vcu * NWAVES + F.wave, F.G * NWAVES, F.lane, o);
    __syncthreads();
}
typedef float f32x16 __attribute__((ext_vector_type(16)));
constexpr int LRU_XC0 = 0, LRU_XC_BUF = 17408, LRU_XC_STRIDE = 272;
constexpr int LRU_CW = 34816;
constexpr int LRU_HF = 37376, LRU_HB = LRU_HF + 32768;
__device__ __forceinline__ int crow16(int r, int hi) { return (r & 3) + 8 * (r >> 2) + 4 * hi; }

template <int DIR>
__device__ __forceinline__ void scan_tile(const float (&a)[16], const float (&u)[16], float& carry, float& ptot, float (&h)[16], bool up) {
    float HL[16], PL[16], As[4], Hs[4];
#pragma unroll
    for (int j = 0; j < 4; ++j) {
        float hl = 0.f, p = 1.f;
#pragma unroll
        for (int ii = 0; ii < 4; ++ii) { const int idx = 4 * j + (DIR == 0 ? ii : 3 - ii); hl = a[idx] * hl + u[idx]; p *= a[idx]; HL[idx] = hl; PL[idx] = p; }
        As[j] = p; Hs[j] = hl;
    }
    float Alo[4], Ahi[4], Hlo[4], Hhi[4];
#pragma unroll
    for (int j = 0; j < 4; ++j) {
        { const unsigned x = __float_as_uint(As[j]); auto rr = __builtin_amdgcn_permlane32_swap(x, x, false, false); Alo[j] = __uint_as_float(rr[0]); Ahi[j] = __uint_as_float(rr[1]); }
        { const unsigned x = __float_as_uint(Hs[j]); auto rr = __builtin_amdgcn_permlane32_swap(x, x, false, false); Hlo[j] = __uint_as_float(rr[0]); Hhi[j] = __uint_as_float(rr[1]); }
    }
    float cin[4]; float c = carry;
    if (DIR == 0) {
#pragma unroll
        for (int j = 0; j < 4; ++j) { const float c_lo = c; c = Alo[j] * c + Hlo[j]; const float c_hi = c; c = Ahi[j] * c + Hhi[j]; cin[j] = up ? c_hi : c_lo; }
    } else {
#pragma unroll
        for (int j = 3; j >= 0; --j) { const float c_hi = c; c = Ahi[j] * c + Hhi[j]; const float c_lo = c; c = Alo[j] * c + Hlo[j]; cin[j] = up ? c_hi : c_lo; }
    }
    carry = c;
#pragma unroll
    for (int j = 0; j < 4; ++j) ptot *= Alo[j] * Ahi[j];
#pragma unroll
    for (int idx = 0; idx < 16; ++idx) h[idx] = HL[idx] + PL[idx] * cin[idx >> 2];
}

__device__ __forceinline__ void lru_decode(int cg, int& seq, int& c) { if (cg < 520) { seq = cg / 65; c = cg - seq * 65; } else { const int c2 = cg - 520; seq = c2 / 129; c = c2 - seq * 129; seq += 8; } }
template <int PASS>
__device__ __forceinline__ void lru_phase(Frame& F, bf16* gout) {
    LAS unsigned char* L = F.lds;
    const int tid = F.tid, lane = F.lane, wave = F.wave;
    const int n = F.vcu & 7, ngrp = F.G >> 3;
    { const float* cw = FIN(F, 7  ); const float* cb = FIN(F, 8  );
      for (int i = tid; i < 640; i += 512) { const int k = i >> 7, ch = i & 127; ((LAS float*)(L + LRU_CW))[i] = k < 4 ? cw[k * 1024 + n * 128 + ch] : cb[n * 128 + ch]; } }
    const int d = wave >> 2, g4 = wave & 3, r32 = lane & 31, hi = lane >> 5, chl = g4 * 32 + r32, chg = n * 128 + chl;
    bf16x8 br[8], bi[8];
    { const bf16* wr_ = F.WG() + (size_t)((d * 2 + 0) * 8 + n) * 16384 + chl * 128 + hi * 8;
      const bf16* wi_ = F.WG() + (size_t)((d * 2 + 1) * 8 + n) * 16384 + chl * 128 + hi * 8;
#pragma unroll
      for (int ks = 0; ks < 8; ++ks) { br[ks] = *(const GAS bf16x8*)(wr_ + ks * 16); bi[ks] = *(const GAS bf16x8*)(wi_ + ks * 16); } }
    constexpr float L2E = 1.4426950408889634f;
    const float nb_r = -L2E * FIN(F, 10  )[d * 1024 + chg], nb_i = -L2E * FIN(F, 12  )[d * 1024 + chg];
    const float spl = 8.f * L2E * log1pf(expf(-FIN(F, 13  )[d * 1024 + chg]));
    const int tau0 = tid >> 4, co = (tid & 15) * 8;
    bf16x8 xv[2][4];
#define LRU_PREFETCH(cgx) do { int s_, c_; lru_decode((cgx), s_, c_); const int xb_ = xr_base(s_); \
        _Pragma("unroll") for (int it_ = 0; it_ < 2; ++it_) _Pragma("unroll") for (int k_ = 0; k_ < 4; ++k_) { int row_ = xb_ + c_ * 64 + tau0 + 32 * it_ + k_ - 2; row_ = row_ < 0 ? 0 : row_; \
            xv[it_][k_] = *(const GAS bf16x8*)(F.XR() + (size_t)row_ * 1024 + n * 128 + co); } } while (0)
    int cg = F.vcu >> 3;
    if (cg < NCHUNK) LRU_PREFETCH(cg);
    __syncthreads();
    for (int ui = 0; cg < NCHUNK; cg += ngrp, ++ui) {
        int seq, c; lru_decode(cg, seq, c);
        LAS unsigned char* XC = L + LRU_XC0 + (ui & 1) * LRU_XC_BUF;
        float carry = 0.f, ptot = 1.f;
        if (PASS == 2) carry = F.CIN()[((size_t)cg * 2 + d) * 1024 + chg];
#pragma unroll
        for (int it = 0; it < 2; ++it) {
            const int tau = tau0 + 32 * it; float xc[8];
            { const LAS f32x4* cb = (const LAS f32x4*)(L + LRU_CW + (4 * 128 + co) * 4); const f32x4 b0 = cb[0], b1 = cb[1];
              xc[0] = b0.x; xc[1] = b0.y; xc[2] = b0.z; xc[3] = b0.w; xc[4] = b1.x; xc[5] = b1.y; xc[6] = b1.z; xc[7] = b1.w; }
#pragma unroll
            for (int k = 0; k < 4; ++k) { const LAS f32x4* wp = (const LAS f32x4*)(L + LRU_CW + (k * 128 + co) * 4); const f32x4 w0 = wp[0], w1 = wp[1]; const bf16x8 v = xv[it][k];
                xc[0] += w0.x * bf2f(v[0]); xc[1] += w0.y * bf2f(v[1]); xc[2] += w0.z * bf2f(v[2]); xc[3] += w0.w * bf2f(v[3]);
                xc[4] += w1.x * bf2f(v[4]); xc[5] += w1.y * bf2f(v[5]); xc[6] += w1.z * bf2f(v[6]); xc[7] += w1.w * bf2f(v[7]); }
            if (c == 0 && tau < 48) {
#pragma unroll
                for (int j = 0; j < 8; ++j) xc[j] = 0.f;
            }
            *(LAS v4u*)(XC + tau * LRU_XC_STRIDE + co * 2) = pack8(xc);
        }
        bf16x8 gv[2];
        const int row0 = seq_first_row(seq) + 64 * (c - 1);
        if (PASS == 2) { if (c > 0) {
#pragma unroll
            for (int it = 0; it < 2; ++it) gv[it] = *(const GAS bf16x8*)(F.QG() + (size_t)(row0 + tau0 + 32 * it) * DM + 1024 + n * 128 + co); } }
        __syncthreads();
        if (cg + ngrp < NCHUNK) LRU_PREFETCH(cg + ngrp);
        f32x16 arT[2], aiT[2];
#pragma unroll
        for (int tt = 0; tt < 2; ++tt) {
            const int tile = d ? 1 - tt : tt;
            f32x16 ar = {}, ai = {};
#pragma unroll
            for (int ks = 0; ks < 8; ++ks) {
                const bf16x8 a = *(const LAS bf16x8*)(XC + (tile * 32 + r32) * LRU_XC_STRIDE + (ks * 16 + hi * 8) * 2);
                ar = __builtin_amdgcn_mfma_f32_32x32x16_bf16(a, br[ks], ar, 0, 0, 0);
                ai = __builtin_amdgcn_mfma_f32_32x32x16_bf16(a, bi[ks], ai, 0, 0, 0);
            }
            arT[tt] = ar; aiT[tt] = ai;
        }
#pragma unroll
        for (int tt = 0; tt < 2; ++tt) {
            const int tile = d ? 1 - tt : tt;
            const f32x16 ar = arT[tt], ai = aiT[tt];
            float av[16], uv[16], hv[16];
            typedef float f32x2 __attribute__((ext_vector_type(2)));
#pragma unroll
            for (int r = 0; r < 16; r += 2) {
                const int tau0_ = tile * 32 + crow16(r, hi);
                const f32x2 xc2 = {bf2f(*(const LAS unsigned short*)(XC + tau0_ * LRU_XC_STRIDE + chl * 2)), bf2f(*(const LAS unsigned short*)(XC + (tau0_ + 1) * LRU_XC_STRIDE + chl * 2))};
                const f32x2 tr = (f32x2){ar[r], ar[r + 1]} * (f32x2){-L2E, -L2E} + (f32x2){nb_r, nb_r};
                const f32x2 ti = (f32x2){ai[r], ai[r + 1]} * (f32x2){-L2E, -L2E} + (f32x2){nb_i, nb_i};
                const f32x2 dr = (f32x2){__builtin_amdgcn_exp2f(tr.x), __builtin_amdgcn_exp2f(tr.y)} + (f32x2){1.f, 1.f};
                const f32x2 di = (f32x2){__builtin_amdgcn_exp2f(ti.x), __builtin_amdgcn_exp2f(ti.y)} + (f32x2){1.f, 1.f};
                const f32x2 rg = {__builtin_amdgcn_rcpf(dr.x), __builtin_amdgcn_rcpf(dr.y)}, ig = {__builtin_amdgcn_rcpf(di.x), __builtin_amdgcn_rcpf(di.y)};
                const f32x2 la = rg * (f32x2){-spl, -spl};
                const f32x2 a = {__builtin_amdgcn_exp2f(la.x), __builtin_amdgcn_exp2f(la.y)};
                const f32x2 t = (f32x2){1.f, 1.f} - a * a;
                const f32x2 m = {__builtin_amdgcn_sqrtf(t.x), __builtin_amdgcn_sqrtf(t.y)};
                const f32x2 u = m * (ig * xc2);
                av[r] = a.x; av[r + 1] = a.y; uv[r] = u.x; uv[r + 1] = u.y;
            }
            if (d == 0) scan_tile<0>(av, uv, carry, ptot, hv, hi != 0); else scan_tile<1>(av, uv, carry, ptot, hv, hi != 0);
            if (PASS == 2) {
#pragma unroll
                for (int r = 0; r < 16; ++r) { const int tau = tile * 32 + crow16(r, hi); *(LAS float*)(L + (d ? LRU_HB : LRU_HF) + (tau * 128 + chl) * 4) = hv[r]; }
            }
        }
        if (PASS == 1) { if (hi == 0) F.CAR()[((size_t)cg * 2 + d) * 1024 + chg] = make_float2(ptot, carry); }
        if (PASS == 2) {
            __syncthreads();
            if (c > 0) {
#pragma unroll
                for (int it = 0; it < 2; ++it) {
                    const int tau = tau0 + 32 * it; const bf16x8 g8 = gv[it];
                    const LAS f32x4* hf = (const LAS f32x4*)(L + LRU_HF + (tau * 128 + co) * 4); const LAS f32x4* hb = (const LAS f32x4*)(L + LRU_HB + (tau * 128 + co) * 4);
                    const f32x4 f0 = hf[0], f1 = hf[1], b0 = hb[0], b1 = hb[1];
                    float o[8];
                    o[0] = (f0.x + b0.x) * gelu_tanh(bf2f(g8[0])); o[1] = (f0.y + b0.y) * gelu_tanh(bf2f(g8[1])); o[2] = (f0.z + b0.z) * gelu_tanh(bf2f(g8[2])); o[3] = (f0.w + b0.w) * gelu_tanh(bf2f(g8[3]));
                    o[4] = (f1.x + b1.x) * gelu_tanh(bf2f(g8[4])); o[5] = (f1.y + b1.y) * gelu_tanh(bf2f(g8[5])); o[6] = (f1.z + b1.z) * gelu_tanh(bf2f(g8[6])); o[7] = (f1.w + b1.w) * gelu_tanh(bf2f(g8[7]));
                    *(GAS v4u*)(gout + (size_t)(row0 + tau) * DM + 1024 + n * 128 + co) = pack8(o);
                    float sq = (o[0] * o[0] + o[1] * o[1]) + (o[2] * o[2] + o[3] * o[3]) + (o[4] * o[4] + o[5] * o[5]) + (o[6] * o[6] + o[7] * o[7]);
                    sq += __shfl_xor(sq, 1); sq += __shfl_xor(sq, 2); sq += __shfl_xor(sq, 4); sq += __shfl_xor(sq, 8);
                    if ((tid & 15) == 0) F.SSQL()[(size_t)(row0 + tau) * 8 + n] = sq;
                }
            } else if (tid < 128) {
                const float hf = *(const LAS float*)(L + LRU_HF + (63 * 128 + tid) * 4), hb = *(const LAS float*)(L + LRU_HB + (63 * 128 + tid) * 4);
                F.LO15()[seq * 1024 + n * 128 + tid] = (hf + hb) * gelu_tanh(F.GY15()[n * 128 + tid]);
            }
        }
    }
    __syncthreads();
#undef LRU_PREFETCH
}
__device__ __forceinline__ void lru_propagate(Frame& F) {
    const int gid = F.vcu * 512 + F.tid;
    if (gid < 12 * 2048) {
        const int s = gid >> 11, d = (gid >> 10) & 1, ch = gid & 1023; const int nch = s < 8 ? 65 : 129, cb = chunk_base(s);
        const float2* car = F.CAR() + (size_t)d * 1024 + ch; float* cinp = F.CIN() + (size_t)d * 1024 + ch;
        float cin = 0.f;
        for (int b0 = 0; b0 < nch; b0 += 16) {
            float2 ph[16];
#pragma unroll
            for (int i = 0; i < 16; ++i) { const int cc = b0 + i; const int c = d ? nch - 1 - cc : cc; if (cc < nch) ph[i] = car[(size_t)(cb + c) * 2048]; }
#pragma unroll
            for (int i = 0; i < 16; ++i) { const int cc = b0 + i; const int c = d ? nch - 1 - cc : cc; if (cc < nch) { cinp[(size_t)(cb + c) * 2048] = cin; cin = ph[i].x * cin + ph[i].y; } }
        }
    }
}

__device__ __forceinline__ void k_rope_pass(Frame& F, bf16* Kout) {
    const int gw = F.vcu * NWAVES + F.wave, NGW = F.G * NWAVES, sub = F.lane >> 4, l16 = F.lane & 15;
    const int c0 = 8 * l16, p = l16 >> 3, half = (l16 >> 2) & 1, i0 = 8 * (l16 & 3);
    float inv[8], gk[8];
#pragma unroll
    for (int j = 0; j < 8; ++j) { inv[j] = __builtin_amdgcn_exp2f(-(float)(i0 + j) * (13.287712379549449f / 32.f)) * 0.15915494309189535f; gk[j] = FIN(F, 6  )[c0 + j]; }
    for (int it = gw; it < NTOK * 2 / 4; it += NGW) {
        const int item = it * 4 + sub, row = item >> 1, hk = item & 1;
        const int s = row_seq(row), t = row - seq_first_row(s); const float pos = (float)(p ? (t & 63) : (t >> 6));
        bf16* kp = F.K() + (size_t)row * 256 + hk * 128 + c0;
        const bf16x8 v = *(const GAS bf16x8*)kp; float x[8]; float ss = 0.f;
#pragma unroll
        for (int j = 0; j < 8; ++j) { x[j] = bf2f(v[j]); ss += x[j] * x[j]; }
        ss += __shfl_xor(ss, 1); ss += __shfl_xor(ss, 2); ss += __shfl_xor(ss, 4); ss += __shfl_xor(ss, 8);
        const float rs = 1.f / sqrtf(ss * (1.f / 128.f) + EPS); float o[8];
#pragma unroll
        for (int j = 0; j < 8; ++j) { x[j] *= rs * gk[j]; const float pr = __shfl_xor(x[j], 4);
            float rev = pos * inv[j]; rev -= floorf(rev); const float sn = __builtin_amdgcn_sinf(rev), cs = __builtin_amdgcn_cosf(rev);
            o[j] = half ? x[j] * cs + pr * sn : x[j] * cs - pr * sn; }
        *(GAS v4u*)(Kout + (size_t)row * 256 + hk * 128 + c0) = pack8(o);
    }
}
__device__ __forceinline__ void p3_meta_job(Frame& F) {
    for (int pr = F.wave; pr < 32; pr += 8) { const int r = pr >> 1, hk = pr & 1; const float* z = F.ZM() + r * INW + 1024 + hk * 128;
        const float a = z[F.lane], b = z[F.lane + 64]; const float rs = 1.f / sqrtf(wave_sum(a * a + b * b) * (1.f / 128.f) + EPS);
        F.KM()[r * 256 + hk * 128 + F.lane] = (bf16)f2bf(a * rs * FIN(F, 6  )[F.lane]); F.KM()[r * 256 + hk * 128 + F.lane + 64] = (bf16)f2bf(b * rs * FIN(F, 6  )[F.lane + 64]); }
    for (int i = F.tid; i < 16 * 256; i += 512) F.VM()[i] = (bf16)f2bf(F.ZM()[(i >> 8) * INW + 1280 + (i & 255)]);
    { const int h = F.wave; const float* z = F.ZM() + 15 * INW + h * 128; const float a = z[F.lane], b = z[F.lane + 64];
      const float rs = 1.f / sqrtf(wave_sum(a * a + b * b) * (1.f / 128.f) + EPS);
      F.Q15()[h * 128 + F.lane] = a * rs * FIN(F, 5  )[F.lane]; F.Q15()[h * 128 + F.lane + 64] = b * rs * FIN(F, 5  )[F.lane + 64]; }
    for (int i = F.tid; i < 1024; i += 512) F.GY15()[i] = F.ZM()[15 * INW + 2560 + i];
}

__device__ __forceinline__ void metaq_item(Frame& F, int it) {
    int s, kvh, j; if (it < 256) { s = it >> 5; kvh = (it >> 4) & 1; j = it & 15; } else { const int t2 = it - 256; s = 8 + (t2 >> 6); kvh = (t2 >> 5) & 1; j = t2 & 31; }
    LAS float* q4 = (LAS float*)F.lds;
    LAS float* sc = q4 + 512;
    LAS float* red = sc + 4 * 288;
    const int tid = F.tid, nk = 256 + (j == 0 ? 16 : 0), row0 = seq_first_row(s) + 256 * j;
    q4[tid] = F.Q15()[kvh * 512 + tid];
    __syncthreads();
    if (tid < nk) {
        const bf16* kp = tid < 256 ? F.K() + (size_t)(row0 + tid) * 256 + kvh * 128 : F.KM() + (tid - 256) * 256 + kvh * 128;
        float d0 = 0.f, d1 = 0.f, d2 = 0.f, d3 = 0.f;
#pragma unroll 4
        for (int cc = 0; cc < 16; ++cc) { const bf16x8 kv = ((const GAS bf16x8*)kp)[cc];
#pragma unroll
            for (int e = 0; e < 8; ++e) { const float kf = bf2f(kv[e]); d0 += kf * q4[cc * 8 + e]; d1 += kf * q4[128 + cc * 8 + e]; d2 += kf * q4[256 + cc * 8 + e]; d3 += kf * q4[384 + cc * 8 + e]; } }
        const float SC = 0.088388347648318440f;
        sc[tid] = d0 * SC; sc[288 + tid] = d1 * SC; sc[576 + tid] = d2 * SC; sc[864 + tid] = d3 * SC;
    }
    __syncthreads();
    if (F.wave < 4) { LAS float* sh = sc + F.wave * 288; float m = -INFINITY;
        for (int k = F.lane; k < nk; k += 64) m = fmaxf(m, sh[k]);
        m = wave_max(m); float l = 0.f;
        for (int k = F.lane; k < nk; k += 64) { const float p = __expf(sh[k] - m); sh[k] = p; l += p; }
        l = wave_sum(l);
        if (F.lane == 0) { red[F.wave * 2] = m; red[F.wave * 2 + 1] = l; } }
    __syncthreads();
    {
        const int kg = tid >> 4, oc = tid & 15; float o[4][8];
#pragma unroll
        for (int h = 0; h < 4; ++h)
#pragma unroll
            for (int e = 0; e < 8; ++e) o[h][e] = 0.f;
        const bf16* vp = F.V() + (size_t)(row0 + kg * 8) * 256 + kvh * 128 + oc * 8;
        bf16x8 vv[8];
#pragma unroll
        for (int k = 0; k < 8; ++k) vv[k] = *(const GAS bf16x8*)(vp + (size_t)k * 256);
#pragma unroll
        for (int k = 0; k < 8; ++k) { const float p0 = sc[kg * 8 + k], p1 = sc[288 + kg * 8 + k], p2 = sc[576 + kg * 8 + k], p3 = sc[864 + kg * 8 + k];
#pragma unroll
            for (int e = 0; e < 8; ++e) { const float vf = bf2f(vv[k][e]); o[0][e] += p0 * vf; o[1][e] += p1 * vf; o[2][e] += p2 * vf; o[3][e] += p3 * vf; } }
        if (j == 0 && kg < 16) { const int k = kg; const bf16x8 v1 = *(const GAS bf16x8*)(F.VM() + k * 256 + kvh * 128 + oc * 8);
            const float p0 = sc[256 + k], p1 = sc[288 + 256 + k], p2 = sc[576 + 256 + k], p3 = sc[864 + 256 + k];
#pragma unroll
            for (int e = 0; e < 8; ++e) { const float vf = bf2f(v1[e]); o[0][e] += p0 * vf; o[1][e] += p1 * vf; o[2][e] += p2 * vf; o[3][e] += p3 * vf; } }
        LAS float* part = sc + 4 * 288 + 16;
#pragma unroll
        for (int h = 0; h < 4; ++h) { LAS f32x4* pp = (LAS f32x4*)(part + (kg * 4 + h) * 128 + oc * 8); pp[0] = (f32x4){o[h][0], o[h][1], o[h][2], o[h][3]}; pp[1] = (f32x4){o[h][4], o[h][5], o[h][6], o[h][7]}; }
        __syncthreads();
        const int h = tid >> 7, d = tid & 127; float os = 0.f;
#pragma unroll 8
        for (int g = 0; g < 32; ++g) os += part[(g * 4 + h) * 128 + d];
        float* dst = F.MQP() + ((size_t)it * 4 + h) * 132; dst[2 + d] = os; if (d == 0) { dst[0] = red[h * 2]; dst[1] = red[h * 2 + 1]; } }
    __syncthreads();
}
__device__ __forceinline__ void attn_phase(Frame& F, char* lds_generic, bf16* obase) {
    for (int r = 0; r < 8; ++r) {
        int s, kvh, hq, qb, S;
        if (F.G == 256) {
            const int x = F.vcu >> 5, i = F.vcu & 31;
            if (r < 4) { const int pair = 2 * x + (r >> 1); s = pair >> 1; kvh = pair & 1; const int u = (r & 1) * 32 + i; hq = u >> 4; qb = u & 15; S = 4096; }
            else { const int pair = x; s = 8 + (pair >> 1); kvh = pair & 1; const int u = (r - 4) * 32 + i; hq = u >> 5; qb = u & 31; S = 8192; }
        } else { s = 0; kvh = 0; hq = 0; qb = 0; S = 0; }
        if (S == 0) continue;
        const int row0 = seq_first_row(s), h = kvh * 4 + hq;
        bf16* qp = F.QG() + (size_t)(row0 + qb * 256) * DM + h * 128;
        attn::attn_unit(qp, F.K() + (size_t)row0 * 256 + kvh * 128, F.V() + (size_t)row0 * 256 + kvh * 128, F.KM() + kvh * 128, F.VM() + kvh * 128, obase + (size_t)(row0 + qb * 256) * DM + h * 128, S / 64 + 1, lds_generic, FIN(F, 5  ), qb * 256, F.SSQA() + (size_t)(row0 + qb * 256) * 8 + h);
    }
}

__device__ __forceinline__ void p5_ratio(Frame& F) {
    for (int row = F.vcu * 512 + F.tid; row < NTOK; row += F.G * 512) {
        const GAS f32x4* pa = (const GAS f32x4*)(F.SSQA() + (size_t)row * 8); const GAS f32x4* pl = (const GAS f32x4*)(F.SSQL() + (size_t)row * 8);
        const f32x4 a0 = pa[0], a1 = pa[1], l0 = pl[0], l1 = pl[1];
        const float sa = ((a0.x + a0.y) + (a0.z + a0.w)) + ((a1.x + a1.y) + (a1.z + a1.w)), sl = ((l0.x + l0.y) + (l0.z + l0.w)) + ((l1.x + l1.y) + (l1.z + l1.w));
        const float qa = sqrtf(sa * (1.f / 1024.f) + EPS), ql = sqrtf(sl * (1.f / 1024.f) + EPS);
        F.RATIO()[row] = ql / qa; F.RL()[row] = 1.f / ql;
    }
}
__device__ __forceinline__ void p5_meta_job(Frame& F, int s) {
    LAS float* buf = (LAS float*)F.lds; LAS float* red = buf + 2048; const int tid = F.tid;
    {
        const int nj = s < 8 ? 16 : 32;
        for (int e = tid; e < 1024; e += 512) { const int h = e >> 7, d = e & 127, kvh = h >> 2, hq = h & 3;
            const int it0 = s < 8 ? s * 32 + kvh * 16 : 256 + (s - 8) * 64 + kvh * 32;
            float M = -INFINITY; for (int j = 0; j < nj; ++j) M = fmaxf(M, F.MQP()[((size_t)(it0 + j) * 4 + hq) * 132]);
            float Ls = 0.f, O = 0.f;
            for (int j = 0; j < nj; ++j) { const float* p = F.MQP() + ((size_t)(it0 + j) * 4 + hq) * 132; const float w = __expf(p[0] - M); Ls += p[1] * w; O += p[2 + d] * w; }
            buf[e] = O / Ls; }
        for (int e = tid; e < 1024; e += 512) buf[1024 + e] = F.LO15()[s * 1024 + e];
        __syncthreads();
        { float ss = 0.f; for (int k = F.lane; k < 256; k += 64) { const float v = buf[F.wave * 256 + k]; ss += v * v; } ss = wave_sum(ss); if (F.lane == 0) red[F.wave] = ss; }
        __syncthreads();
        const float ra = 1.f / sqrtf((red[0] + red[1] + red[2] + red[3]) * (1.f / 1024.f) + EPS), rl = 1.f / sqrtf((red[4] + red[5] + red[6] + red[7]) * (1.f / 1024.f) + EPS);
        for (int e = tid; e < 2048; e += 512) F.MIXED15()[s * 2048 + e] = e < 1024 ? buf[e] * ra : buf[e] * rl;
        __syncthreads();
    }
}
__device__ __forceinline__ void p6_meta_y(Frame& F) {
    LAS float* X = (LAS float*)F.lds;
    for (int i = F.tid; i < 12 * DM / 4; i += 512) ((LAS f32x4*)X)[i] = ((const GAS f32x4*)F.MIXED15())[i];
    __syncthreads();
    const OutRows o{F.Y15(), DM, 12};
    small_gemm<12, OutRows>(X, DM, F.WOUT_T(), DM, F.vcu * NWAVES + F.wave, F.G * NWAVES, F.lane, o);
    __syncthreads();
}

__device__ __forceinline__ void p7_row(Frame& F, int row, int lane, bf16* h1row) {
    const GAS bf16x8* y = (const GAS bf16x8*)((const bf16*)(F.out + (size_t)row * DM));
    GAS v4u* xn = (GAS v4u*)(F.XN() + (size_t)row * DM);
    const float ir0 = 1.f / F.R0()[row];
    float hv[32]; float ss = 0.f;
#pragma unroll
    for (int i = 0; i < 4; ++i) { const bf16x8 v = y[lane + 64 * i];
#pragma unroll
        for (int j = 0; j < 8; ++j) { hv[8 * i + j] = bf2f(v[j]); ss += hv[8 * i + j] * hv[8 * i + j]; } }
    const float r1 = 1.f / sqrtf(wave_sum(ss) * (1.f / DM) + EPS); float s2 = 0.f;
#pragma unroll
    for (int i = 0; i < 4; ++i) { const int e0 = (lane + 64 * i) * 8;
        const v4u xq = xn[lane + 64 * i]; const GAS f32x4* gp = (const GAS f32x4*)(FIN(F, 17  ) + e0); const f32x4 g0 = gp[0], g1 = gp[1];
        const float xv[8] = {__builtin_bit_cast(float, xq.x << 16), __builtin_bit_cast(float, xq.x & 0xffff0000u), __builtin_bit_cast(float, xq.y << 16), __builtin_bit_cast(float, xq.y & 0xffff0000u),
                             __builtin_bit_cast(float, xq.z << 16), __builtin_bit_cast(float, xq.z & 0xffff0000u), __builtin_bit_cast(float, xq.w << 16), __builtin_bit_cast(float, xq.w & 0xffff0000u)};
        const float gg[8] = {g0.x, g0.y, g0.z, g0.w, g1.x, g1.y, g1.z, g1.w};
        float hb[8];
#pragma unroll
        for (int j = 0; j < 8; ++j) { hb[j] = xv[j] * ir0 + hv[8 * i + j] * r1 * gg[j]; hv[8 * i + j] = hb[j]; s2 += hb[j] * hb[j]; }
        ((GAS v4u*)h1row)[lane + 64 * i] = pack8(hb);
    }
    const float r2 = 1.f / sqrtf(wave_sum(s2) * (1.f / DM) + EPS);
#pragma unroll
    for (int i = 0; i < 4; ++i) { const int e0 = (lane + 64 * i) * 8; const GAS f32x4* gp = (const GAS f32x4*)(FIN(F, 18  ) + e0); const f32x4 g0 = gp[0], g1 = gp[1];
        float t[8]; t[0] = hv[8 * i + 0] * r2 * g0.x; t[1] = hv[8 * i + 1] * r2 * g0.y; t[2] = hv[8 * i + 2] * r2 * g0.z; t[3] = hv[8 * i + 3] * r2 * g0.w;
        t[4] = hv[8 * i + 4] * r2 * g1.x; t[5] = hv[8 * i + 5] * r2 * g1.y; t[6] = hv[8 * i + 6] * r2 * g1.z; t[7] = hv[8 * i + 7] * r2 * g1.w;
        xn[lane + 64 * i] = pack8(t); }
}
__device__ __forceinline__ void p7_meta_g(Frame& F) {
    LAS float* X = (LAS float*)F.lds;
    for (int r = F.wave; r < 12; r += 8) {
        const float* y = F.Y15() + r * DM; const float* xm = FIN(F, 2  ) + 15 * DM;
        float hv[32]; float ss = 0.f;
#pragma unroll
        for (int i = 0; i < 32; ++i) { hv[i] = y[F.lane + 64 * i]; ss += hv[i] * hv[i]; }
        const float r1 = 1.f / sqrtf(wave_sum(ss) * (1.f / DM) + EPS); float s2 = 0.f;
#pragma unroll
        for (int i = 0; i < 32; ++i) { const int e = F.lane + 64 * i; hv[i] = xm[e] + hv[i] * r1 * FIN(F, 17  )[e]; s2 += hv[i] * hv[i]; }
        const float r2 = 1.f / sqrtf(wave_sum(s2) * (1.f / DM) + EPS);
#pragma unroll
        for (int i = 0; i < 32; ++i) { const int e = F.lane + 64 * i; X[r * DM + e] = hv[i] * r2 * FIN(F, 18  )[e]; }
    }
    __syncthreads();
    const OutRows o{F.G15(), FFN, 12};
    small_gemm<12, OutRows, true>(X, DM, F.WUP_T(), FFN, F.vcu * NWAVES + F.wave, F.G * NWAVES, F.lane, o);
    __syncthreads();
}

__device__ __forceinline__ void p9_fix(Frame& F, int h) {
    constexpr int NOCT = FFN / 8; const int total = 512 * 2 * NOCT;
    const float* cw = FIN(F, 20  ); const float* cb = FIN(F, 21  );
    for (int it = F.vcu * 512 + F.tid; it < total; it += F.G * 512) {
        const int bw = it / NOCT, co = (it - bw * NOCT) * 8, which = bw & 1, B = bw >> 1;
        const int lrow = B * 64 + (which ? 63 : 0), row = h * HROWS + lrow, s = row_seq(row), t = row - seq_first_row(s), S = seq_len(s);
        const float* e = F.EDGE() + (size_t)((B * 2 + which) * 3) * FFN + co;
        float inner[8], self[8], uu[8], outer[8], w0[8], w1[8], w2[8], bb[8];
#define LD8F(dst, p) do { const GAS f32x4* p_ = (const GAS f32x4*)(p); const f32x4 a_ = p_[0], b_ = p_[1]; dst[0] = a_.x; dst[1] = a_.y; dst[2] = a_.z; dst[3] = a_.w; dst[4] = b_.x; dst[5] = b_.y; dst[6] = b_.z; dst[7] = b_.w; } while (0)
        LD8F(inner, e); LD8F(self, e + FFN); LD8F(uu, e + 2 * FFN);
        LD8F(w0, cw + co); LD8F(w1, cw + FFN + co); LD8F(w2, cw + 2 * FFN + co); LD8F(bb, cb + co);
        if (which == 0) { if (t == 0) LD8F(outer, F.G15() + (size_t)s * FFN + co); else LD8F(outer, F.EDGE() + (size_t)(((B - 1) * 2 + 1) * 3 + 1) * FFN + co); }
        else { if (t == S - 1) {
#pragma unroll
                for (int j = 0; j < 8; ++j) outer[j] = 0.f; }
            else LD8F(outer, F.EDGE() + (size_t)(((B + 1) * 2 + 0) * 3 + 1) * FFN + co); }
#undef LD8F
        float o[8];
#pragma unroll
        for (int j = 0; j < 8; ++j) { const float x = which == 0 ? bb[j] + w0[j] * outer[j] + w1[j] * self[j] + w2[j] * inner[j] : bb[j] + w0[j] * inner[j] + w1[j] * self[j] + w2[j] * outer[j];
            o[j] = x * sigmoidf_(x) * uu[j]; }
        *(GAS v4u*)(F.ACT() + (size_t)lrow * FFN + co) = pack8(o);
    }
}
__device__ __forceinline__ void p11_row(Frame& F, int row, int lane, float* obase) {
    const GAS bf16x8* f = (const GAS bf16x8*)((const bf16*)(F.out + (size_t)row * DM));
    const GAS bf16x8* hp = (const GAS bf16x8*)(row < HROWS ? F.H1A() + (size_t)row * DM : F.XN() + (size_t)(row - HROWS) * DM);
    bf16x8 hv[4], fq[4];
#pragma unroll
    for (int i = 0; i < 4; ++i) { hv[i] = hp[lane + 64 * i]; fq[i] = f[lane + 64 * i]; }
    asm volatile("s_waitcnt vmcnt(0)" ::: "memory");
    float fv[32]; float ss = 0.f;
#pragma unroll
    for (int i = 0; i < 4; ++i)
#pragma unroll
        for (int j = 0; j < 8; ++j) { fv[8 * i + j] = bf2f(fq[i][j]); ss += fv[8 * i + j] * fv[8 * i + j]; }
    const float r1 = 1.f / sqrtf(wave_sum(ss) * (1.f / DM) + EPS);
#pragma unroll
    for (int i = 0; i < 4; ++i) { const int e0 = (lane + 64 * i) * 8;
        const GAS f32x4* gp = (const GAS f32x4*)(FIN(F, 23  ) + e0); const f32x4 g0 = gp[0], g1 = gp[1];
        f32x4 h0, h1;
        h0.x = bf2f(hv[i][0]) + fv[8 * i + 0] * r1 * g0.x; h0.y = bf2f(hv[i][1]) + fv[8 * i + 1] * r1 * g0.y; h0.z = bf2f(hv[i][2]) + fv[8 * i + 2] * r1 * g0.z; h0.w = bf2f(hv[i][3]) + fv[8 * i + 3] * r1 * g0.w;
        h1.x = bf2f(hv[i][4]) + fv[8 * i + 4] * r1 * g1.x; h1.y = bf2f(hv[i][5]) + fv[8 * i + 5] * r1 * g1.y; h1.z = bf2f(hv[i][6]) + fv[8 * i + 6] * r1 * g1.z; h1.w = bf2f(hv[i][7]) + fv[8 * i + 7] * r1 * g1.w;
        GAS f32x4* wp = (GAS f32x4*)(obase + (size_t)row * DM + e0); wp[0] = h0; wp[1] = h1; }
}
struct Args { const float* in[24]; float* out; unsigned char* ws; int ph_lo, ph_hi, q_lo, q_hi, use_bar, dummy; };
constexpr int N_PHASES = 12;
__global__ void __launch_bounds__(NWAVES * 64, 2) mk_fwd(Args args) {
    extern __shared__ __attribute__((aligned(16))) unsigned char lds[];
    Frame F;
    F.lds = (LAS unsigned char*)lds;
    F.MISC = (volatile LAS unsigned*)(F.lds + MISC_OFF);
    F.tid = threadIdx.x; F.lane = F.tid & 63; F.wave = __builtin_amdgcn_readfirstlane(F.tid >> 6);
    F.G = gridDim.x; { const int bx = blockIdx.x; F.vcu = (F.G % 8 == 0) ? (bx % 8) * (F.G / 8) + bx / 8 : bx; }
    unsigned char* ws = args.ws;
    F.ctl = (gu32*)(ws + WS_CTL);
    F.kargs = (const __attribute__((address_space(4))) void*)__builtin_amdgcn_kernarg_segment_ptr(); F.ptag = 0; F.out = args.out;
    F.ws = ws;
    for (int u = F.tid; u < (LDS_BYTES - LDSCTL_OFF) / 4; u += NWAVES * 64) ((LAS unsigned*)(F.lds + LDSCTL_OFF))[u] = 0u;
    __syncthreads();
    XcdBarrier bar; bar.bar = (unsigned*)(F.ctl + CW_BAR); bar.x = 0; bar.st = nullptr;
    if (args.use_bar) bar = xcd_barrier_post((unsigned*)(F.ctl + CW_BAR), F.MISC + 8);
    const int lo = args.ph_lo, hi = args.ph_hi;
    const int dmy_ = MK_MULTI ? args.dummy : 0;
#define IN(k) (((MK_PHASE_MASK >> (k)) & 1) && lo <= (k) && (k) < hi)
#define PH_BEGIN(k) do { F.ptag = (k); int t_ = F.tid; asm volatile("" : "+v"(t_)); F.tid = t_; F.lane = t_ & 63; } while (0)
#define PH_BAR() do { if (args.use_bar) xcd_barrier(bar); } while (0)
    const int gw = F.vcu * NWAVES + F.wave, NGW = F.G * NWAVES;

    if (IN(0)) { PH_BEGIN(0); { p0_prologue(F); PH_BAR(); } }
    if (IN(1)) { PH_BEGIN(1); {
        p1_meta_z(F);
        pg8::Gemm g{F.XN(), F.WIN_T(), NTOK, INW, DM}; pg8::StaticOrder S; S.init(NTOK, INW, F.G, (int)blockIdx.x);
        pg8::EpiRoute E{nullptr, 0, 1, F.QG(), F.K(), F.V(), F.XR()};
        pg8::gemm_phase<pg8::EpiRoute, pg8::StaticOrder, true, true>(F.lds, g, S, E);
        PH_BAR();
    } }
    if (IN(2)) { PH_BEGIN(2); { lru_phase<1>(F, nullptr); PH_BAR(); } }
    if (IN(3)) { PH_BEGIN(3); {
        k_rope_pass(F, dmy_ ? (bf16*)F.out : F.K());
        lru_propagate(F);
        if (F.vcu == F.G - 1) p3_meta_job(F);
        PH_BAR();
    } }
    if (IN(4)) { PH_BEGIN(4); {
        const int dm = dmy_;
        if (dm < 2 || dm == 2) lru_phase<2>(F, dm ? (bf16*)F.out : F.QG());
        if (dm < 2 || dm == 3) for (int it = F.vcu; it < 512; it += F.G) metaq_item(F, it);
        if (dm < 2 || dm == 4) attn_phase(F, (char*)lds, dm ? (bf16*)F.out : F.QG());
        PH_BAR();
    } }
    if (IN(5)) { PH_BEGIN(5); {
        p5_ratio(F);
        if (F.vcu >= F.G - 12) p5_meta_job(F, F.G - 1 - F.vcu);
        PH_BAR();
    } }
    if (IN(6)) { PH_BEGIN(6); {
        p6_meta_y(F);
        pg8::Gemm g{F.QG(), F.WOUT_T(), NTOK, DM, DM}; pg8::StaticOrder S; S.init(NTOK, DM, F.G, (int)blockIdx.x);
        pg8::EpiScaled E{(bf16*)F.out, 2 * DM, F.RATIO(), F.RL(), 16};
        pg8::gemm_phase<pg8::EpiScaled, pg8::StaticOrder, true, true>(F.lds, g, S, E);
        PH_BAR();
    } }
#if MK_MULTI
    { const int q = args.q_lo;
#else
#pragma unroll
    for (int q = 0; q < 2; ++q) {
#endif
        if (IN(7)) { PH_BEGIN(7); {
            for (int row = q * HROWS + gw; row < (q + 1) * HROWS; row += NGW) p7_row(F, row, F.lane, (q == 0 ? F.H1A() : F.XN()) + (size_t)(row - q * HROWS) * DM);
            if (q == 0) p7_meta_g(F);
            PH_BAR();
        } }
        if (IN(8)) { PH_BEGIN(8); {
            pg8::Gemm g{F.XN() + (size_t)q * HROWS * DM, F.WUP_T(), HROWS, UPW, DM}; pg8::StaticOrder S; S.init(HROWS, UPW, F.G, (int)blockIdx.x);
            pg8::EpiAct E{F.ACT(), F.EDGE(), FIN(F, 20  ), FIN(F, 21  ), FFN};
            pg8::gemm_phase<pg8::EpiAct, pg8::StaticOrder, true, true>(F.lds, g, S, E);
            PH_BAR();
        } }
        if (IN(9)) { PH_BEGIN(9); { p9_fix(F, q); PH_BAR(); } }
        if (IN(10)) { PH_BEGIN(10); {
            pg8::Gemm g{F.ACT(), F.WDOWN_T(), HROWS, DM, FFN}; pg8::ProbeOrder S; S.init(HROWS, DM, F.G, (int)blockIdx.x); S.pmask = dmy_ == 5 ? 7 : -1;
            pg8::EpiRoute E{(bf16*)F.out + (size_t)q * HROWS * 2 * DM, 2 * DM, 0, nullptr, nullptr, nullptr, nullptr};
            pg8::gemm_phase<pg8::EpiRoute, pg8::ProbeOrder, true, true>(F.lds, g, S, E);
            if (q == 0) PH_BAR();
        } }
    }
    if (IN(10) && IN(11)) PH_BAR();
    if (IN(11)) { PH_BEGIN(11); { for (int row = gw; row < NTOK; row += NGW) p11_row(F, row, F.lane, dmy_ ? (float*)(F.ws + WS_B) : F.out); } }
#undef IN
#undef PH_BAR
}

extern "C" void kernel_launch(void* const* d_in, const int* in_sizes, int n_in, void* d_out, int out_size, void* d_ws, size_t ws_size, hipStream_t stream) {
    static int grid = 0;
    if (grid == 0) {
        if (n_in != 24 || out_size != NTOK * DM || ws_size < WS_END) { fprintf(stderr, "kernel_launch: unexpected shapes (n_in %d out %d ws %zu, need ws >= %zu); nothing launched\n", n_in, out_size, ws_size, (size_t)WS_END); grid = -1; return; }
        int dev = 0, cus = 0;
        if (hipGetDevice(&dev) != hipSuccess || hipDeviceGetAttribute(&cus, hipDeviceAttributeMultiprocessorCount, dev) != hipSuccess) { grid = -1; return; }
        if (hipFuncSetAttribute((const void*)mk_fwd, hipFuncAttributeMaxDynamicSharedMemorySize, LDS_BYTES) != hipSuccess) { fprintf(stderr, "kernel_launch: hipFuncSetAttribute failed\n"); grid = -1; return; }
        int per_cu = 0;
        if (hipOccupancyMaxActiveBlocksPerMultiprocessor(&per_cu, (const void*)mk_fwd, NWAVES * 64, LDS_BYTES) != hipSuccess || per_cu < 1) fprintf(stderr, "kernel_launch: occupancy query reports %d\n", per_cu);
        (void)hipGetLastError();
        grid = cus;
    }
    if (grid < 0) return;
    if (hipMemsetAsync((char*)d_ws + WS_CTL, 0, CTL_ZERO_BYTES, stream) != hipSuccess) return;
    Args a{};
    for (int i = 0; i < 24; ++i) a.in[i] = (const float*)d_in[i];
    a.out = (float*)d_out; a.ws = (unsigned char*)d_ws;
#if MK_MULTI
    a.use_bar = 0;
#define LAUNCH_PH(ph, q) do { a.ph_lo = (ph); a.ph_hi = (ph) + 1; a.q_lo = (q); a.q_hi = (q) + 1; \
        if ((MK_REPEAT_MASK >> (ph)) & 1) { a.dummy = MK_DUMMY_MODE; hipLaunchKernelGGL(mk_fwd, dim3(grid), dim3(NWAVES * 64), LDS_BYTES, stream, a); } \
        a.dummy = 0; hipLaunchKernelGGL(mk_fwd, dim3(grid), dim3(NWAVES * 64), LDS_BYTES, stream, a); } while (0)
    for (int ph = 0; ph < 7; ++ph) LAUNCH_PH(ph, 0);
    for (int q = 0; q < 2; ++q) for (int ph = 7; ph < 11; ++ph) LAUNCH_PH(ph, q);
    LAUNCH_PH(11, 0);
#else
    a.use_bar = 1; a.ph_lo = 0; a.ph_hi = N_PHASES; a.q_lo = 0; a.q_hi = 2;
    hipLaunchKernelGGL(mk_fwd, dim3(grid), dim3(NWAVES * 64), LDS_BYTES, stream, a);
#endif
    const hipError_t le = hipPeekAtLastError();
    if (le != hipSuccess) fprintf(stderr, "kernel_launch: launch failed: %s\n", hipGetErrorName(le));
}
```

```cpp
#include <hip/hip_runtime.h>
#include <cstdio>
#include <cstdint>
#include <cmath>
#ifndef MK_PHASE_MASK
#define MK_PHASE_MASK 0xfff
#endif
#ifndef MK_REPEAT_MASK
#define MK_REPEAT_MASK 0
#endif
#ifndef MK_DUMMY_MODE
#define MK_DUMMY_MODE 1
#endif
#ifndef MK_MULTI
#define MK_MULTI 0
#endif
namespace pg8 {
#define PG8_LAS __attribute__((address_space(3)))
typedef unsigned short bf16_t;
typedef short bf16x8 __attribute__((ext_vector_type(8)));
typedef float f32x4 __attribute__((ext_vector_type(4)));
typedef unsigned u32x4 __attribute__((ext_vector_type(4)));
constexpr int BM = 256, BK = 64, HALF = 128, HTB = HALF * BK * 2  , STAGE_BYTES = 8 * HTB, NXCD = 8, WGM = 8;

__host__ __device__ __forceinline__ int lds_byte(int r, int c) { const int st = (r >> 4) * 2 + (c >> 5), rr = r & 15, cc = c & 31, ob = rr * 64 + cc * 2; return st * 1024 + (ob ^ (((ob >> 9) & 1) << 5)); }
__host__ __device__ __forceinline__ void stage_rc(int b, int& R, int& C) { const int st = b / 1024, sb = b % 1024, swz = sb ^ (((sb >> 9) & 1) << 5); R = (st >> 1) * 16 + swz / 64; C = (st & 1) * 32 + (swz % 64) / 2; }
__host__ __device__ __forceinline__ int perm32(int rho) { const int n = rho >> 4, i = rho & 15; return 8 * (i >> 2) + 4 * n + (i & 3); }

struct Unit { int pm, pn; };
struct Gemm { const bf16_t* A; const bf16_t* Bt; int M, N, K; };

struct StaticOrder {
    int nM, nN, nwg, G, c;
    __host__ __device__ void init(int M, int N, int G_, int c_) { nM = M / BM; nN = N / BM; nwg = nM * nN; G = G_; c = c_; }
    __host__ __device__ bool next(int i, Unit& u) const {
        const long L = (long)i * G + c; if (L >= nwg) return false;
        int wgid = (int)L; { const int q = nwg / NXCD, r = nwg % NXCD, xcd = wgid % NXCD, off = wgid / NXCD; wgid = (xcd < r ? xcd * (q + 1) : r * (q + 1) + (xcd - r) * q) + off; }
        const int nig = WGM * nN, gid = wgid / nig, fm = gid * WGM, gsz = (nM - fm) < WGM ? (nM - fm) : WGM;
        u.pm = fm + ((wgid % nig) % gsz); u.pn = (wgid % nig) / gsz; return true;
    }
    __device__ __forceinline__ void a_ready(const Unit&) const {}
    __device__ __forceinline__ void done(const Unit&) const {}
};

__device__ __forceinline__ unsigned cvt_pk_bf16(float lo, float hi) { unsigned r; asm volatile("v_cvt_pk_bf16_f32 %0, %1, %2" : "=v"(r) : "v"(lo), "v"(hi)); return r; }
struct EpiRoute {
    static constexpr bool PERM = true, AFTER_DRAIN = false, MIDK = false;
    bf16_t* O; int ldc; int mode; bf16_t *QGp, *Kp, *Vp, *XRp;
    __device__ __forceinline__ void operator()(const f32x4 (&acc)[2][2][4][2], const Unit& u, int wr, int wc, int fr, int fq) const {
        bf16_t* base = O; int ld = ldc; int colt = u.pn * BM; int rowadd = 0;
        if (mode == 1) {
            const int pn = u.pn;
            if (pn < 4) { base = QGp; ld = 2048; colt = pn * 256; }
            else if (pn == 4) { base = Kp; ld = 256; colt = 0; }
            else if (pn == 5) { base = Vp; ld = 256; colt = 0; }
            else if (pn < 10) { base = XRp; ld = 1024; colt = (pn - 6) * 256; const int seq = u.pm < 128 ? (u.pm >> 4) : 8 + ((u.pm - 128) >> 5); rowadd = 64 * (seq + 1); }
            else { base = QGp; ld = 2048; colt = 1024 + (pn - 10) * 256; }
        }
        const int row0 = u.pm * BM + wr * 64 + fr + rowadd; const int col0 = colt + wc * 32 + 8 * fq;
#pragma unroll
        for (int ai = 0; ai < 2; ++ai)
#pragma unroll
            for (int m = 0; m < 4; ++m) { bf16_t* rowp = base + (size_t)(row0 + ai * HALF + m * 16) * ld + col0;
#pragma unroll
                for (int bj = 0; bj < 2; ++bj) { const f32x4 v0 = acc[ai][bj][m][0], v1 = acc[ai][bj][m][1];
                    u32x4 w; w.x = cvt_pk_bf16(v0[0], v0[1]); w.y = cvt_pk_bf16(v0[2], v0[3]); w.z = cvt_pk_bf16(v1[0], v1[1]); w.w = cvt_pk_bf16(v1[2], v1[3]);
                    *(u32x4*)(rowp + bj * HALF) = w; } }
    }
};

__device__ __forceinline__ float dpp_shr1(float old, float src) { return __builtin_bit_cast(float, __builtin_amdgcn_update_dpp(__builtin_bit_cast(int, old), __builtin_bit_cast(int, src), 0x111, 0xF, 0xF, false)); }
__device__ __forceinline__ float dpp_shl1(float old, float src) { return __builtin_bit_cast(float, __builtin_amdgcn_update_dpp(__builtin_bit_cast(int, old), __builtin_bit_cast(int, src), 0x101, 0xF, 0xF, false)); }
__device__ __forceinline__ float dpp_ror1(float src)  { return __builtin_bit_cast(float, __builtin_amdgcn_update_dpp(0, __builtin_bit_cast(int, src), 0x121, 0xF, 0xF, false)); }
__device__ __forceinline__ float dpp_ror15(float src) { return __builtin_bit_cast(float, __builtin_amdgcn_update_dpp(0, __builtin_bit_cast(int, src), 0x12F, 0xF, 0xF, false)); }
struct EpiAct {
    static constexpr bool PERM = true, AFTER_DRAIN = false, MIDK = false;
    bf16_t* ACT; float* EDGE; const float* cw; const float* cb; int nch;
    __device__ __forceinline__ void operator()(const f32x4 (&acc)[2][2][4][2], const Unit& u, int wr, int wc, int fr, int fq) const {
        const int ch0 = u.pn * 128 + wc * 32 + 8 * fq;
        float w0[8], w1[8], w2[8], bb[8];
        { const f32x4 a0 = *(const f32x4*)(cw + ch0), a1 = *(const f32x4*)(cw + ch0 + 4), b0 = *(const f32x4*)(cw + nch + ch0), b1 = *(const f32x4*)(cw + nch + ch0 + 4),
                      c0 = *(const f32x4*)(cw + 2 * nch + ch0), c1 = *(const f32x4*)(cw + 2 * nch + ch0 + 4), d0 = *(const f32x4*)(cb + ch0), d1 = *(const f32x4*)(cb + ch0 + 4);
#pragma unroll
          for (int k = 0; k < 4; ++k) { w0[k] = a0[k]; w0[4 + k] = a1[k]; w1[k] = b0[k]; w1[4 + k] = b1[k]; w2[k] = c0[k]; w2[4 + k] = c1[k]; bb[k] = d0[k]; bb[4 + k] = d1[k]; } }
        const int rowb = u.pm * BM + wr * 64;
#pragma unroll
        for (int ai = 0; ai < 2; ++ai) {
            float ein0[8], ein1[8];
#pragma unroll
            for (int m = 0; m < 4; ++m) {
                float o[8];
#pragma unroll
                for (int n = 0; n < 2; ++n)
#pragma unroll
                    for (int k = 0; k < 4; ++k) {
                        const int j = 4 * n + k; const float cur = acc[ai][0][m][n][k];
                        float pold = 0.f, nold = 0.f;
                        if (m > 0) pold = dpp_ror1(acc[ai][0][m > 0 ? m - 1 : 0][n][k]);
                        if (m < 3) nold = dpp_ror15(acc[ai][0][m < 3 ? m + 1 : 3][n][k]);
                        const float prv = dpp_shr1(pold, cur), nxt = dpp_shl1(nold, cur);
                        const float x = bb[j] + w0[j] * prv + w1[j] * cur + w2[j] * nxt;
                        o[j] = x * __builtin_amdgcn_rcpf(1.f + __builtin_amdgcn_exp2f(-1.4426950408889634f * x)) * acc[ai][1][m][n][k];
                        if (m == 0) ein0[j] = nxt;
                        if (m == 3) ein1[j] = prv;
                    }
                u32x4 w; w.x = cvt_pk_bf16(o[0], o[1]); w.y = cvt_pk_bf16(o[2], o[3]); w.z = cvt_pk_bf16(o[4], o[5]); w.w = cvt_pk_bf16(o[6], o[7]);
                *(u32x4*)(ACT + (size_t)(rowb + ai * HALF + m * 16 + fr) * nch + ch0) = w;
            }
            const int blk = (rowb + ai * HALF) >> 6;
            if (fr == 0 || fr == 15) {
                const bool last = fr == 15; float* e = EDGE + (size_t)((blk * 2 + (last ? 1 : 0)) * 3) * nch + ch0;
                f32x4 i0v, i1v, s0v, s1v, u0v, u1v;
#pragma unroll
                for (int k = 0; k < 4; ++k) { i0v[k] = last ? ein1[k] : ein0[k]; i1v[k] = last ? ein1[4 + k] : ein0[4 + k];
                    s0v[k] = last ? acc[ai][0][3][0][k] : acc[ai][0][0][0][k]; s1v[k] = last ? acc[ai][0][3][1][k] : acc[ai][0][0][1][k];
                    u0v[k] = last ? acc[ai][1][3][0][k] : acc[ai][1][0][0][k]; u1v[k] = last ? acc[ai][1][3][1][k] : acc[ai][1][0][1][k]; }
                *(f32x4*)(e) = i0v; *(f32x4*)(e + 4) = i1v; *(f32x4*)(e + nch) = s0v; *(f32x4*)(e + nch + 4) = s1v; *(f32x4*)(e + 2 * nch) = u0v; *(f32x4*)(e + 2 * nch + 4) = u1v;
            }
        }
    }
};

struct ProbeOrder : StaticOrder { int pmask;
    __host__ __device__ bool next(int i, Unit& u) const { const bool r = StaticOrder::next(i, u); u.pm &= pmask; return r; } };

struct EpiScaled {
    static constexpr bool PERM = true, AFTER_DRAIN = false, MIDK = true;
    bf16_t* O; int ldc; const float* ratio; const float* rl; int kt;
    __device__ __forceinline__ void midk(f32x4 (&acc)[2][2][4][2], const Unit& u, int wr, int fr) const {
        asm volatile("" ::: "memory");
        const float* rp = ratio + (u.pm * BM + wr * 64 + fr);
        float s[2][4];
#pragma unroll
        for (int ai = 0; ai < 2; ++ai)
#pragma unroll
            for (int m = 0; m < 4; ++m) s[ai][m] = rp[ai * HALF + m * 16];
#pragma unroll
        for (int ai = 0; ai < 2; ++ai)
#pragma unroll
            for (int m = 0; m < 4; ++m)
#pragma unroll
                for (int bj = 0; bj < 2; ++bj)
#pragma unroll
                    for (int n = 0; n < 2; ++n) acc[ai][bj][m][n] = acc[ai][bj][m][n] * s[ai][m];
        asm volatile("" ::: "memory");
    }
    __device__ __forceinline__ void operator()(const f32x4 (&acc)[2][2][4][2], const Unit& u, int wr, int wc, int fr, int fq) const {
        const int row0 = u.pm * BM + wr * 64 + fr, col0 = u.pn * BM + wc * 32 + 8 * fq;
#pragma unroll
        for (int ai = 0; ai < 2; ++ai)
#pragma unroll
            for (int m = 0; m < 4; ++m) { const int row = row0 + ai * HALF + m * 16; const float s = rl[row]; bf16_t* rowp = O + (size_t)row * ldc + col0;
#pragma unroll
                for (int bj = 0; bj < 2; ++bj) { const f32x4 v0 = acc[ai][bj][m][0] * s, v1 = acc[ai][bj][m][1] * s;
                    u32x4 w; w.x = cvt_pk_bf16(v0[0], v0[1]); w.y = cvt_pk_bf16(v0[2], v0[3]); w.z = cvt_pk_bf16(v1[0], v1[1]); w.w = cvt_pk_bf16(v1[2], v1[3]);
                    *(u32x4*)(rowp + bj * HALF) = w; } }
    }
};

template <class Epi, class Sched, bool ALIGN_EPI = false, bool SP2 = false>
__device__ __forceinline__ void gemm_phase(PG8_LAS unsigned char* lds, const Gemm g, const Sched& S, const Epi& E) {
    int tid_ = threadIdx.x; asm volatile("" : "+v"(tid_));
    const int tid = tid_, wid = __builtin_amdgcn_readfirstlane(tid >> 6), lane = tid & 63, wr = wid >> 2, wc = wid & 3, fr = lane & 15, fq = lane >> 4;
    const int K = g.K, nt = K / BK;
    unsigned voffA[2], voffB[2];
#pragma unroll
    for (int i = 0; i < 2; ++i) { int R, C; stage_rc(tid * 16 + i * 8192, R, C); const int Rb = Epi::PERM ? ((R & ~31) + perm32(R & 31)) : R;
        voffA[i] = (unsigned)(R * K + C) * 2u; voffB[i] = (unsigned)(Rb * K + C) * 2u; }
    const size_t kstep = (size_t)(BK * 2);
    const size_t hstep = (size_t)HALF * K * 2;
    const size_t tstep = 2 * hstep;
    const unsigned ldsw = (unsigned)wid * 1024u;
    const int aoff = lds_byte(wr * 64 + fr, fq * 8), boff = lds_byte(wc * 32 + fr, fq * 8);
#define PG8_SA(b, h) (((b) * 2 + (h)) * HTB)
#define PG8_SB(b, h) ((4 + (b) * 2 + (h)) * HTB)
#define PG8_STAGE(bufoff, gbase, voff) do { _Pragma("unroll") for (int _i = 0; _i < 2; ++_i) \
        __builtin_amdgcn_global_load_lds((const unsigned*)((const char*)(gbase) + (voff)[_i]), (PG8_LAS unsigned*)(lds + (bufoff) + ldsw + _i * 8192), 16, 0, 0); } while (0)
#define PG8_LDA(dst, b, h) do { _Pragma("unroll") for (int m = 0; m < 4; ++m) _Pragma("unroll") for (int k = 0; k < 2; ++k) dst[m][k] = *(const PG8_LAS bf16x8*)(lds + PG8_SA(b, h) + aoff + m * 2048 + k * 1024); } while (0)
#define PG8_LDB(dst, b, h) do { _Pragma("unroll") for (int n = 0; n < 2; ++n) _Pragma("unroll") for (int k = 0; k < 2; ++k) dst[n][k] = *(const PG8_LAS bf16x8*)(lds + PG8_SB(b, h) + boff + n * 2048 + k * 1024); } while (0)
#define PG8_MMA(ai, bj, At, Bt) do { __builtin_amdgcn_s_setprio(1); _Pragma("unroll") for (int m = 0; m < 4; ++m) _Pragma("unroll") for (int n = 0; n < 2; ++n) _Pragma("unroll") for (int k = 0; k < 2; ++k) \
        acc[ai][bj][m][n] = __builtin_amdgcn_mfma_f32_16x16x32_bf16(Bt[n][k], At[m][k], acc[ai][bj][m][n], 0, 0, 0); __builtin_amdgcn_s_setprio(0); } while (0)
#define PG8_WAIT_V(n) asm volatile("s_waitcnt vmcnt(" #n ")" ::: "memory")
#define PG8_WAIT_L(n) asm volatile("s_waitcnt lgkmcnt(" #n ")" ::: "memory")
#define PG8_BAR __builtin_amdgcn_s_barrier()
#define PG8_SCHED __builtin_amdgcn_sched_barrier(0)
    Unit cur, nxt; int ui = 0;
    if (!S.next(0, cur)) return;
    f32x4 acc[2][2][4][2];
#pragma unroll
    for (int a = 0; a < 2; ++a)
#pragma unroll
        for (int b = 0; b < 2; ++b)
#pragma unroll
            for (int m = 0; m < 4; ++m)
#pragma unroll
                for (int n = 0; n < 2; ++n) acc[a][b][m][n] = (f32x4){0.f, 0.f, 0.f, 0.f};
    bf16x8 At[4][2], B0[2][2], B1[2][2];
    const char* cA = (const char*)g.A + (size_t)cur.pm * tstep; const char* cB = (const char*)g.Bt + (size_t)cur.pn * tstep;
    S.a_ready(cur);
    if constexpr (SP2) {
        PG8_STAGE(PG8_SB(0, 0), cB, voffB); PG8_STAGE(PG8_SB(0, 1), cB + hstep, voffB); PG8_STAGE(PG8_SA(0, 0), cA, voffA); PG8_STAGE(PG8_SA(0, 1), cA + hstep, voffA);
        if (wr == 1) PG8_BAR;
        PG8_WAIT_V(2); PG8_BAR;
        PG8_STAGE(PG8_SB(1, 0), cB + kstep, voffB); PG8_STAGE(PG8_SA(1, 0), cA + kstep, voffA); PG8_STAGE(PG8_SB(1, 1), cB + hstep + kstep, voffB);
        PG8_WAIT_V(6); PG8_BAR;
    } else {
        PG8_STAGE(PG8_SB(0, 0), cB, voffB); PG8_STAGE(PG8_SA(0, 0), cA, voffA); PG8_STAGE(PG8_SB(0, 1), cB + hstep, voffB); PG8_STAGE(PG8_SA(0, 1), cA + hstep, voffA);
        if (wr == 1) PG8_BAR;
        PG8_WAIT_V(4); PG8_BAR;
        PG8_STAGE(PG8_SB(1, 0), cB + kstep, voffB); PG8_STAGE(PG8_SA(1, 0), cA + kstep, voffA); PG8_STAGE(PG8_SB(1, 1), cB + hstep + kstep, voffB);
        PG8_WAIT_V(6); PG8_BAR;
    }
    for (;;) {
        const bool has_next = S.next(ui + 1, nxt);
        const char* nA = has_next ? (const char*)g.A + (size_t)nxt.pm * tstep : cA; const char* nB = has_next ? (const char*)g.Bt + (size_t)nxt.pn * tstep : cB;
        for (int t = 0; t < nt; t += 2) {
            if constexpr (Epi::MIDK) { if (t == E.kt) E.midk(acc, cur, wr, fr); }
            const bool last = (t == nt - 2);
            const char* a1 = cA + (size_t)(t + 1) * kstep;
            const char* a2 = last ? nA : cA + (size_t)(t + 2) * kstep; const char* b2 = last ? nB : cB + (size_t)(t + 2) * kstep;
            const char* a3 = a2 + kstep; const char* b3 = b2 + kstep;
            if (last && has_next) S.a_ready(nxt);
            if constexpr (SP2) {
            PG8_LDB(B0, 0, 0); PG8_LDB(B1, 0, 1); PG8_SCHED; PG8_LDA(At, 0, 0); PG8_STAGE(PG8_SA(1, 1), a1 + hstep, voffA);
            PG8_WAIT_V(8); PG8_WAIT_L(0); PG8_BAR; PG8_MMA(0, 0, At, B0); PG8_MMA(0, 1, At, B1); PG8_BAR; PG8_SCHED;
            PG8_LDA(At, 0, 1); PG8_STAGE(PG8_SB(0, 0), b2, voffB); PG8_STAGE(PG8_SB(0, 1), b2 + hstep, voffB); PG8_STAGE(PG8_SA(0, 0), a2, voffA);
            PG8_WAIT_V(8); PG8_WAIT_L(0); PG8_BAR; PG8_MMA(1, 0, At, B0); PG8_MMA(1, 1, At, B1); PG8_BAR; PG8_SCHED;
            PG8_LDB(B0, 1, 0); PG8_LDB(B1, 1, 1); PG8_SCHED; PG8_LDA(At, 1, 0); PG8_STAGE(PG8_SA(0, 1), a2 + hstep, voffA);
            PG8_WAIT_V(8); PG8_WAIT_L(0); PG8_BAR; PG8_MMA(0, 0, At, B0); PG8_MMA(0, 1, At, B1); PG8_BAR; PG8_SCHED;
            PG8_LDA(At, 1, 1); PG8_STAGE(PG8_SB(1, 0), b3, voffB); PG8_STAGE(PG8_SB(1, 1), b3 + hstep, voffB); PG8_STAGE(PG8_SA(1, 0), a3, voffA);
            PG8_WAIT_V(8); PG8_WAIT_L(0); PG8_BAR; PG8_MMA(1, 0, At, B0); PG8_MMA(1, 1, At, B1); PG8_BAR; PG8_SCHED;
            } else {
            PG8_LDB(B0, 0, 0); PG8_SCHED; PG8_LDA(At, 0, 0); PG8_STAGE(PG8_SA(1, 1), a1 + hstep, voffA);
            PG8_WAIT_L(8); PG8_BAR; PG8_WAIT_L(0); PG8_MMA(0, 0, At, B0); PG8_BAR; PG8_SCHED;
            PG8_LDB(B1, 0, 1); PG8_STAGE(PG8_SB(0, 0), b2, voffB);
            PG8_BAR; PG8_WAIT_L(0); PG8_MMA(0, 1, At, B1); PG8_BAR;
            PG8_LDA(At, 0, 1); PG8_STAGE(PG8_SA(0, 0), a2, voffA);
            PG8_BAR; PG8_WAIT_L(0); PG8_MMA(1, 0, At, B0); PG8_BAR; PG8_SCHED;
            PG8_STAGE(PG8_SB(0, 1), b2 + hstep, voffB);
            PG8_WAIT_V(6); PG8_BAR; PG8_MMA(1, 1, At, B1); PG8_BAR;
            PG8_LDB(B0, 1, 0); PG8_SCHED; PG8_LDA(At, 1, 0); PG8_STAGE(PG8_SA(0, 1), a2 + hstep, voffA);
            PG8_WAIT_L(8); PG8_BAR; PG8_WAIT_L(0); PG8_MMA(0, 0, At, B0); PG8_BAR; PG8_SCHED;
            PG8_LDB(B1, 1, 1); PG8_STAGE(PG8_SB(1, 0), b3, voffB);
            PG8_BAR; PG8_WAIT_L(0); PG8_MMA(0, 1, At, B1); PG8_BAR;
            PG8_LDA(At, 1, 1); PG8_STAGE(PG8_SA(1, 0), a3, voffA);
            PG8_BAR; PG8_WAIT_L(0); PG8_MMA(1, 0, At, B0); PG8_BAR; PG8_SCHED;
            PG8_STAGE(PG8_SB(1, 1), b3 + hstep, voffB);
            PG8_WAIT_V(6); PG8_BAR; PG8_MMA(1, 1, At, B1); PG8_BAR;
            }
        }
        if constexpr (ALIGN_EPI) { if (wr == 0) PG8_BAR; }
        if constexpr (!Epi::AFTER_DRAIN) { E(acc, cur, wr, wc, fr, fq); S.done(cur); }
        if (!has_next) break;
#pragma unroll
        for (int a = 0; a < 2; ++a)
#pragma unroll
            for (int b = 0; b < 2; ++b)
#pragma unroll
                for (int m = 0; m < 4; ++m)
#pragma unroll
                    for (int n = 0; n < 2; ++n) acc[a][b][m][n] = (f32x4){0.f, 0.f, 0.f, 0.f};
        cur = nxt; cA = nA; cB = nB; ++ui;
        if constexpr (ALIGN_EPI) { if (wr == 1) PG8_BAR; }
    }
    PG8_WAIT_V(0);
    if constexpr (!ALIGN_EPI) { if (wr == 0) PG8_BAR; }
    PG8_BAR;
    if constexpr (Epi::AFTER_DRAIN) { E.fused(acc, cur, wr, wc, fr, fq, lds, wid, lane); S.done(cur); }
#undef PG8_SA
#undef PG8_SB
#undef PG8_STAGE
#undef PG8_LDA
#undef PG8_LDB
#undef PG8_MMA
#undef PG8_WAIT_V
#undef PG8_WAIT_L
#undef PG8_BAR
#undef PG8_SCHED
}
}
namespace attn {
typedef unsigned short bf16r;
constexpr int   D = 128, NW = 8, QBLK = 32, KVBLK = 64;
constexpr float SCALE = 0.088388347648318440f;
constexpr float THR = 8.f;
constexpr int LDQ = 2048, LDK = 256, LDO = 2048;
constexpr size_t SHM_ATTN = 6 * 16384 + NW * 64 * 4;
using bf16x8 = __attribute__((ext_vector_type(8))) short;
using s16x4  = __attribute__((ext_vector_type(4))) short;
using f32x16 = __attribute__((ext_vector_type(16))) float;
using f32x8  = __attribute__((ext_vector_type(8))) float;
using u32x4  = __attribute__((ext_vector_type(4))) unsigned;
#define KSWZ(row, colB) ((row) * 256 + ((colB) ^ (((row) & 7) << 4)))
#define SBAR() __builtin_amdgcn_sched_barrier(0)
__device__ __forceinline__ int crow(int r, int hi) { return (r & 3) + 8 * (r >> 2) + 4 * hi; }
__device__ __forceinline__ unsigned cvtpk(float lo, float hi) {
  unsigned r; asm volatile("v_cvt_pk_bf16_f32 %0, %1, %2" : "=v"(r) : "v"(lo), "v"(hi)); return r;
}
__device__ __forceinline__ void partialSM(f32x16& p0, f32x16& p1, float& m_reg, float& mn, float& alpha) {
  constexpr float C = SCALE * 1.4426950408889634f;
  float pmax = p0[0]; for (int r = 1; r < 16; ++r) pmax = fmaxf(pmax, p0[r]); for (int r = 0; r < 16; ++r) pmax = fmaxf(pmax, p1[r]);
  { auto rr = __builtin_amdgcn_permlane32_swap(__float_as_uint(pmax), __float_as_uint(pmax), false, false);
    pmax = fmaxf(__uint_as_float(rr[0]), __uint_as_float(rr[1])); }
  if (__builtin_expect(__all(pmax - m_reg <= THR / SCALE), 1)) { mn = m_reg; alpha = 1.f; }
  else { mn = fmaxf(m_reg, pmax); alpha = __builtin_amdgcn_exp2f((m_reg - mn) * C); m_reg = mn; }
  float mnC = -mn * C;
  for (int r = 0; r < 16; ++r) p0[r] = fmaf(p0[r], C, mnC); for (int r = 0; r < 16; ++r) p1[r] = fmaf(p1[r], C, mnC);
  for (int r = 0; r < 16; ++r) p0[r] = __builtin_amdgcn_exp2f(p0[r]);
}
__device__ __forceinline__ void finishSM(f32x16& p0, f32x16& p1, float alpha, float& l_reg, bf16x8& pa0, bf16x8& pa1, bf16x8& pa2, bf16x8& pa3) {
  for (int r = 0; r < 16; ++r) p1[r] = __builtin_amdgcn_exp2f(p1[r]);
  float ps = 0; for (int r = 0; r < 16; ++r) ps += p0[r]; for (int r = 0; r < 16; ++r) ps += p1[r];
  { auto rr = __builtin_amdgcn_permlane32_swap(__float_as_uint(ps), __float_as_uint(ps), false, false);
    ps = __uint_as_float(rr[0]) + __uint_as_float(rr[1]); }
  l_reg = l_reg * alpha + ps;
#define PK4(P, BASE, OUT) do { unsigned a0 = cvtpk(P[BASE + 0], P[BASE + 1]), a1 = cvtpk(P[BASE + 2], P[BASE + 3]);   \
    unsigned b0 = cvtpk(P[BASE + 4], P[BASE + 5]), b1 = cvtpk(P[BASE + 6], P[BASE + 7]);                              \
    auto r0 = __builtin_amdgcn_permlane32_swap(a0, b0, false, false); auto r1 = __builtin_amdgcn_permlane32_swap(a1, b1, false, false); \
    u32x4 w = {r0[0], r1[0], r0[1], r1[1]}; OUT = *reinterpret_cast<bf16x8*>(&w); } while (0)
  PK4(p0, 0, pa0); PK4(p0, 8, pa1); PK4(p1, 0, pa2); PK4(p1, 8, pa3);
#undef PK4
}
__device__ __forceinline__ void qkt(f32x16& p0, f32x16& p1, const bf16r* Ks, const bf16x8* qr, int r32, int hi) {
  p0 = f32x16{}; p1 = f32x16{};
  for (int d0 = 0; d0 < 8; ++d0) { int cb = (d0 * 16 + hi * 8) * 2;
    bf16x8 b0 = *reinterpret_cast<const bf16x8*>((const char*)Ks + KSWZ(r32, cb));
    bf16x8 b1 = *reinterpret_cast<const bf16x8*>((const char*)Ks + KSWZ(32 + r32, cb));
    p0 = __builtin_amdgcn_mfma_f32_32x32x16_bf16(b0, qr[d0], p0, 0, 0, 0);
    p1 = __builtin_amdgcn_mfma_f32_32x32x16_bf16(b1, qr[d0], p1, 0, 0, 0); }
}
__device__ __forceinline__ int v_st(int k, int c) { const int kk = (k & ~0xC) | ((k & 4) << 1) | ((k & 8) >> 1); return ((kk >> 3) * 4 + (c >> 5)) * 512 + ((kk & 7) * 32 + (c & 31)) * 2; }
__device__ __forceinline__ int v_rd_base(int lane) { return ((lane & 3) << 3) | (((lane >> 2) & 3) << 6) | (((lane >> 4) & 1) << 5) | (((lane >> 5) & 1) << 8); }
constexpr int v_rd_off(int d0, int ks, int half) { return d0 * 512 + ks * 4096 + half * 2048; }
template <int OFF> __device__ __forceinline__ s16x4 tr_read(int vb) {
  s16x4 r; asm volatile("ds_read_b64_tr_b16 %0, %1 offset:%2" : "=&v"(r) : "v"(vb), "i"(OFF) : "memory"); return r;
}
template <int D0> __device__ __forceinline__ void pv_one(f32x16& od, int vb, bf16x8 pa0, bf16x8 pa1, bf16x8 pa2, bf16x8 pa3) {
  const s16x4 l0 = tr_read<v_rd_off(D0, 0, 0)>(vb), h0 = tr_read<v_rd_off(D0, 0, 1)>(vb), l1 = tr_read<v_rd_off(D0, 1, 0)>(vb), h1 = tr_read<v_rd_off(D0, 1, 1)>(vb);
  const s16x4 l2 = tr_read<v_rd_off(D0, 2, 0)>(vb), h2 = tr_read<v_rd_off(D0, 2, 1)>(vb), l3 = tr_read<v_rd_off(D0, 3, 0)>(vb), h3 = tr_read<v_rd_off(D0, 3, 1)>(vb);
  asm volatile("s_waitcnt lgkmcnt(0)" ::: "memory"); SBAR();
#define PK(L, H) (bf16x8){L[0], L[1], L[2], L[3], H[0], H[1], H[2], H[3]}
  od = __builtin_amdgcn_mfma_f32_32x32x16_bf16(pa0, PK(l0, h0), od, 0, 0, 0);
  od = __builtin_amdgcn_mfma_f32_32x32x16_bf16(pa1, PK(l1, h1), od, 0, 0, 0);
  od = __builtin_amdgcn_mfma_f32_32x32x16_bf16(pa2, PK(l2, h2), od, 0, 0, 0);
  od = __builtin_amdgcn_mfma_f32_32x32x16_bf16(pa3, PK(l3, h3), od, 0, 0, 0);
#undef PK
}
__device__ __forceinline__ void pv_d0(f32x16* o, int vb, bf16x8 pa0, bf16x8 pa1, bf16x8 pa2, bf16x8 pa3) {
  pv_one<0>(o[0], vb, pa0, pa1, pa2, pa3); pv_one<1>(o[1], vb, pa0, pa1, pa2, pa3); pv_one<2>(o[2], vb, pa0, pa1, pa2, pa3); pv_one<3>(o[3], vb, pa0, pa1, pa2, pa3);
}
constexpr float THRL = 8.f;
__device__ __forceinline__ void qkt2(f32x16& p0, f32x16& p1, const bf16r* Ks, const bf16x8* qr, float nm, int r32, int hi) {
  f32x16 negm;
#pragma unroll
  for (int r = 0; r < 16; ++r) negm[r] = nm;
#pragma unroll
  for (int d0 = 0; d0 < 8; ++d0) { int cb = (d0 * 16 + hi * 8) * 2;
    bf16x8 b0 = *reinterpret_cast<const bf16x8*>((const char*)Ks + KSWZ(r32, cb));
    bf16x8 b1 = *reinterpret_cast<const bf16x8*>((const char*)Ks + KSWZ(32 + r32, cb));
    if (d0 == 0) { p1 = __builtin_amdgcn_mfma_f32_32x32x16_bf16(b1, qr[0], negm, 0, 0, 0); p0 = __builtin_amdgcn_mfma_f32_32x32x16_bf16(b0, qr[0], negm, 0, 0, 0); }
    else { p0 = __builtin_amdgcn_mfma_f32_32x32x16_bf16(b0, qr[d0], p0, 0, 0, 0); p1 = __builtin_amdgcn_mfma_f32_32x32x16_bf16(b1, qr[d0], p1, 0, 0, 0); } }
}
__device__ __forceinline__ void partialSM2(f32x16& p0, f32x16& p1, float& mhat, float& alpha, bool first) {
  float a = __builtin_fmaxf(__builtin_fmaxf(p0[0], p0[1]), p1[0]), b = __builtin_fmaxf(__builtin_fmaxf(p0[2], p0[3]), p1[1]); a = __builtin_fmaxf(__builtin_fmaxf(a, p1[2]), p1[3]);
#pragma unroll
  for (int r = 4; r < 16; r += 4) { a = __builtin_fmaxf(__builtin_fmaxf(a, p0[r]), p0[r + 1]); b = __builtin_fmaxf(__builtin_fmaxf(b, p0[r + 2]), p0[r + 3]); a = __builtin_fmaxf(__builtin_fmaxf(a, p1[r]), p1[r + 1]); b = __builtin_fmaxf(__builtin_fmaxf(b, p1[r + 2]), p1[r + 3]); }
  float pmax = __builtin_fmaxf(a, b);
  { auto rr = __builtin_amdgcn_permlane32_swap(__float_as_uint(pmax), __float_as_uint(pmax), false, false); pmax = __builtin_fmaxf(__uint_as_float(rr[0]), __uint_as_float(rr[1])); }
  alpha = 1.f;
  if (first || __builtin_expect(__any(pmax > THRL), 0)) {
    const float dl = first ? pmax : __builtin_fmaxf(pmax, 0.f);
    mhat += dl;
#pragma unroll
    for (int r = 0; r < 16; ++r) { p0[r] -= dl; p1[r] -= dl; }
    if (!first) alpha = __builtin_amdgcn_exp2f(-dl);
  }
#pragma unroll
  for (int r = 0; r < 16; ++r) p0[r] = __builtin_amdgcn_exp2f(p0[r]);
}
__device__ __forceinline__ void mask_meta(f32x16& p0, f32x16& p1) {
  const float NEG = -INFINITY;
#pragma unroll
  for (int r = 8; r < 16; ++r) p0[r] = NEG;
#pragma unroll
  for (int r = 0; r < 16; ++r) p1[r] = NEG;
}
__device__ __forceinline__ unsigned short f2bf_rne(float f) { unsigned u = __builtin_bit_cast(unsigned, f); return (unsigned short)((u + 0x7fffu + ((u >> 16) & 1u)) >> 16); }

__device__ __forceinline__ void attn_unit(const bf16r* Qb, const bf16r* __restrict__ Kh, const bf16r* __restrict__ Vh,
                                          const bf16r* __restrict__ KMh, const bf16r* __restrict__ VMh, bf16r* Ob, int NT, char* lds,
                                          const float* __restrict__ qnorm, int t0, float* ssq) {
  int tid_ = threadIdx.x; asm volatile("" : "+v"(tid_));
  const int tid = tid_, wid = tid >> 6, lane = tid & 63, r32 = lane & 31, hi = lane >> 5;
  float* ws = (float*)(lds + 6 * 16384) + wid * 64; float* li_l = ws; float* al_l = ws + 32;
  float mhat = 0.f, l_reg = 0; f32x16 o[4] = {}; bf16x8 qr[8];
  const bf16r* Qw = Qb + (long)(wid * QBLK + r32) * LDQ + hi * 8;
#pragma unroll
  for (int d0 = 0; d0 < 8; ++d0) qr[d0] = *reinterpret_cast<const bf16x8*>(Qw + d0 * 16);
  {
    float ss = 0.f;
#pragma unroll
    for (int d0 = 0; d0 < 8; ++d0)
#pragma unroll
      for (int j = 0; j < 8; ++j) { const float x = __builtin_bit_cast(float, (unsigned)(unsigned short)qr[d0][j] << 16); ss += x * x; }
    { auto rr = __builtin_amdgcn_permlane32_swap(__float_as_uint(ss), __float_as_uint(ss), false, false); ss = __uint_as_float(rr[0]) + __uint_as_float(rr[1]); }
    const float rs = (SCALE * 1.4426950408889634f) / sqrtf(ss * (1.f / 128.f) + 1e-6f);
    int t = t0 + wid * QBLK + r32; int hio = hi; asm volatile("" : "+v"(t), "+v"(hio));
#pragma unroll
    for (int g = 0; g < 4; ++g) {
      const int p = g >> 1, dd = g & 1, fa = 4 * p + dd, fb = fa + 2; const float pos = (float)(p ? (t & 63) : (t >> 6));
      const float4 ga0 = *reinterpret_cast<const float4*>(qnorm + fa * 16 + hi * 8), ga1 = *reinterpret_cast<const float4*>(qnorm + fa * 16 + hi * 8 + 4);
      const float4 gb0 = *reinterpret_cast<const float4*>(qnorm + fb * 16 + hi * 8), gb1 = *reinterpret_cast<const float4*>(qnorm + fb * 16 + hi * 8 + 4);
      const float gaf[8] = {ga0.x, ga0.y, ga0.z, ga0.w, ga1.x, ga1.y, ga1.z, ga1.w}, gbf[8] = {gb0.x, gb0.y, gb0.z, gb0.w, gb1.x, gb1.y, gb1.z, gb1.w};
      float oa[8], ob[8];
#pragma unroll
      for (int j = 0; j < 8; ++j) { const int i = 16 * dd + 8 * hio + j;
        float rev = pos * __builtin_amdgcn_exp2f(-(float)i * (13.287712379549449f / 32.f)) * 0.15915494309189535f; rev -= floorf(rev);
        const float sn = __builtin_amdgcn_sinf(rev), cs = __builtin_amdgcn_cosf(rev);
        const float x1 = __builtin_bit_cast(float, (unsigned)(unsigned short)qr[fa][j] << 16) * rs * gaf[j], x2 = __builtin_bit_cast(float, (unsigned)(unsigned short)qr[fb][j] << 16) * rs * gbf[j];
        oa[j] = x1 * cs - x2 * sn; ob[j] = x2 * cs + x1 * sn; }
      { u32x4 w = {cvtpk(oa[0], oa[1]), cvtpk(oa[2], oa[3]), cvtpk(oa[4], oa[5]), cvtpk(oa[6], oa[7])}; qr[fa] = *reinterpret_cast<bf16x8*>(&w); }
      { u32x4 w = {cvtpk(ob[0], ob[1]), cvtpk(ob[2], ob[3]), cvtpk(ob[4], ob[5]), cvtpk(ob[6], ob[7])}; qr[fb] = *reinterpret_cast<bf16x8*>(&w); }
      SBAR();
    }
  }
  unsigned kgo0, kgo1, vgo0, vgo1;
  { const int rk0 = 4 * wid + (lane >> 4), rk1 = rk0 + 32; kgo0 = (unsigned)(rk0 * (LDK * 2) + (((lane & 15) << 4) ^ ((rk0 & 7) << 4))); kgo1 = (unsigned)(rk1 * (LDK * 2) + (((lane & 15) << 4) ^ ((rk1 & 7) << 4)));
    const int kklo = (lane & 31) >> 2, cin = (lane & 3) * 8;
    { const int st = 2 * wid + (lane >> 5), kk = (st >> 2) * 8 + kklo, k = (kk & ~0xC) | ((kk & 4) << 1) | ((kk & 8) >> 1); vgo0 = (unsigned)(k * (LDK * 2) + ((st & 3) * 32 + cin) * 2); }
    { const int st = 2 * (wid + 8) + (lane >> 5), kk = (st >> 2) * 8 + kklo, k = (kk & ~0xC) | ((kk & 4) << 1) | ((kk & 8) >> 1); vgo1 = (unsigned)(k * (LDK * 2) + ((st & 3) * 32 + cin) * 2); } }
  typedef __attribute__((address_space(3))) unsigned char* ldsp_t;
  const ldsp_t lds3 = (ldsp_t)lds;
  const int w1k = __builtin_amdgcn_readfirstlane(wid) * 1024;
  constexpr int VRING = 3 * 16384;
#define DMAK(t, soff) do { const char* b_ = (const char*)((t) == 0 ? KMh : Kh + (long)((t) - 1) * KVBLK * LDK); \
    __builtin_amdgcn_global_load_lds((const unsigned*)(b_ + kgo0), (__attribute__((address_space(3))) unsigned*)(lds3 + (soff) + w1k), 16, 0, 0); \
    __builtin_amdgcn_global_load_lds((const unsigned*)(b_ + kgo1), (__attribute__((address_space(3))) unsigned*)(lds3 + (soff) + w1k + 8192), 16, 0, 0); } while (0)
#define DMAV(t, soff) do { const char* b_ = (const char*)((t) == 0 ? VMh : Vh + (long)((t) - 1) * KVBLK * LDK); \
    __builtin_amdgcn_global_load_lds((const unsigned*)(b_ + vgo0), (__attribute__((address_space(3))) unsigned*)(lds3 + VRING + (soff) + w1k), 16, 0, 0); \
    __builtin_amdgcn_global_load_lds((const unsigned*)(b_ + vgo1), (__attribute__((address_space(3))) unsigned*)(lds3 + VRING + (soff) + w1k + 8192), 16, 0, 0); } while (0)
#define WAITBAR(N) asm volatile("s_waitcnt vmcnt(" #N ") lgkmcnt(0)\n\ts_barrier" ::: "memory")
#define ROT() do { const int t_ = sm1; sm1 = sc_; sc_ = sp1; sp1 = t_; } while (0)
#define RESC(a) do { if (__any((a) < 1.f)) { if (hi == 0) al_l[r32] = (a); asm volatile("s_waitcnt lgkmcnt(0)" ::: "memory"); \
    _Pragma("unroll") for (int r = 0; r < 16; ++r) { const float a_ = al_l[crow(r, hi)]; o[0][r] *= a_; o[1][r] *= a_; o[2][r] *= a_; o[3][r] *= a_; asm volatile("" : "+v"(o[0][r]), "+v"(o[1][r]), "+v"(o[2][r]), "+v"(o[3][r])); } } } while (0)
  const int vb0 = (int)(uintptr_t)(lds + VRING) + v_rd_base(lane);
  int sm1 = 32768, sc_ = 0, sp1 = 16384;
  f32x16 pA0, pA1, pB0, pB1; float alA, alB; bf16x8 pa0, pa1, pa2, pa3;
  DMAK(0, 0); DMAV(0, 0); DMAK(1, 16384);
  WAITBAR(2);
  DMAK(2, sm1); DMAV(1, sp1);
  qkt2(pA0, pA1, (const bf16r*)(lds + sc_), qr, -mhat, r32, hi); mask_meta(pA0, pA1); partialSM2(pA0, pA1, mhat, alA, true);
  WAITBAR(4); ROT();
  for (int t = 1; t + 1 < NT; t += 2) {
    if (t + 2 < NT) DMAK(t + 2, sm1); DMAV(t + 1, sp1);
    SBAR(); qkt2(pB0, pB1, (const bf16r*)(lds + sc_), qr, -mhat, r32, hi);
    finishSM(pA0, pA1, alA, l_reg, pa0, pa1, pa2, pa3); SBAR();
    pv_d0(o, vb0 + sm1, pa0, pa1, pa2, pa3); partialSM2(pB0, pB1, mhat, alB, false);
    if (t + 2 < NT) WAITBAR(4); else WAITBAR(2);
    RESC(alB); ROT();
    if (t + 3 < NT) DMAK(t + 3, sm1); if (t + 2 < NT) DMAV(t + 2, sp1);
    SBAR(); qkt2(pA0, pA1, (const bf16r*)(lds + sc_), qr, -mhat, r32, hi);
    finishSM(pB0, pB1, alB, l_reg, pa0, pa1, pa2, pa3); SBAR();
    pv_d0(o, vb0 + sm1, pa0, pa1, pa2, pa3); partialSM2(pA0, pA1, mhat, alA, false);
    if (t + 3 < NT) WAITBAR(4); else if (t + 2 < NT) WAITBAR(2); else WAITBAR(0);
    RESC(alA); ROT();
  }
  finishSM(pA0, pA1, alA, l_reg, pa0, pa1, pa2, pa3); SBAR();
  pv_d0(o, vb0 + sm1, pa0, pa1, pa2, pa3);
  if (hi == 0) li_l[r32] = l_reg; asm volatile("s_waitcnt lgkmcnt(0)" ::: "memory");
  float rli[16];
#pragma unroll
  for (int r = 0; r < 16; ++r) rli[r] = __builtin_amdgcn_rcpf(li_l[crow(r, hi)]);
  bf16r* Ow = Ob + (long)(wid * QBLK) * LDO;
#pragma unroll
  for (int r = 0; r < 16; ++r) { const int orow = crow(r, hi);
    float sq = 0.f;
#pragma unroll
    for (int d0 = 0; d0 < 4; ++d0) { const float v = o[d0][r] * rli[r]; sq += v * v; Ow[(long)orow * LDO + d0 * 32 + r32] = f2bf_rne(v); }
    sq += __shfl_xor(sq, 1); sq += __shfl_xor(sq, 2); sq += __shfl_xor(sq, 4); sq += __shfl_xor(sq, 8); sq += __shfl_xor(sq, 16);
    if (r32 == 0) ssq[(long)(wid * QBLK + orow) * 8] = sq; }
  WAITBAR(0);
#undef DMAK
#undef DMAV
#undef WAITBAR
#undef ROT
#undef RESC
}
#undef KSWZ
#undef SBAR
}

constexpr int NWAVES = 8;
constexpr int DM = 2048, NTOK = 65536, INW = 3584, FFN = 5632, UPW = 2 * FFN;
constexpr float EPS = 1e-6f;
constexpr int XR_ROWS = 8 * 4160 + 4 * 8256;
constexpr int NCHUNK = 8 * 65 + 4 * 129;
constexpr int HROWS = 32768;
__host__ __device__ __forceinline__ int seq_first_row(int s) { return s < 8 ? s * 4096 : 32768 + (s - 8) * 8192; }
__host__ __device__ __forceinline__ int seq_len(int s) { return s < 8 ? 4096 : 8192; }
__host__ __device__ __forceinline__ int xr_base(int s) { return s < 8 ? s * 4160 : 33280 + (s - 8) * 8256; }
__host__ __device__ __forceinline__ int chunk_base(int s) { return s < 8 ? s * 65 : 520 + (s - 8) * 129; }
__host__ __device__ __forceinline__ int row_seq(int row) { return row < 32768 ? (row >> 12) : 8 + ((row - 32768) >> 13); }

constexpr size_t MiB = 1u << 20, KiB = 1u << 10;
constexpr size_t WS_CTL = 0, CTL_ZERO_BYTES = 1 * MiB;
constexpr size_t WS_SMALL = 1 * MiB;
constexpr size_t WS_XNMETA = WS_SMALL + 0, WS_ZM = WS_SMALL + 64 * KiB, WS_KM = WS_SMALL + 320 * KiB, WS_VM = WS_SMALL + 352 * KiB, WS_Q15 = WS_SMALL + 384 * KiB, WS_GY15 = WS_SMALL + 388 * KiB,
                 WS_LO15 = WS_SMALL + 392 * KiB, WS_MIXED15 = WS_SMALL + 448 * KiB, WS_Y15 = WS_SMALL + 544 * KiB, WS_G15 = WS_SMALL + 640 * KiB, WS_MQP = WS_SMALL + 1024 * KiB;
constexpr size_t WS_WIN = 5 * MiB, WS_WOUT = 19 * MiB, WS_WUP = 27 * MiB, WS_WDOWN = 71 * MiB, WS_WG = 93 * MiB;
constexpr size_t WS_CAR = 94 * MiB, WS_CIN = 111 * MiB;
constexpr size_t WS_R0 = 120 * MiB, WS_RATIO = 120 * MiB + 256 * KiB, WS_RL = 120 * MiB + 512 * KiB, WS_SSQA = 121 * MiB, WS_SSQL = 123 * MiB;
constexpr size_t WS_A = 128 * MiB;
constexpr size_t WS_B = 384 * MiB;
constexpr size_t WS_QG = WS_B, WS_K = WS_B + 256 * MiB, WS_V = WS_B + 288 * MiB, WS_XR = WS_B + 320 * MiB;
constexpr size_t WS_ACT = WS_B, WS_EDGE = WS_B + 352 * MiB;
constexpr size_t WS_H1A = WS_B + 420 * MiB;
constexpr size_t WS_END = WS_B + 548 * MiB;
static_assert(WS_ZM + 16 * INW * 4 <= WS_KM && WS_G15 + 12 * FFN * 4 <= WS_MQP && WS_MQP + 512 * 4 * 132 * 4 <= WS_WIN, "small map");
static_assert(WS_WIN + (size_t)INW * DM * 2 <= WS_WOUT && WS_WOUT + (size_t)DM * DM * 2 <= WS_WUP && WS_WUP + (size_t)UPW * DM * 2 <= WS_WDOWN && WS_WDOWN + (size_t)DM * FFN * 2 <= WS_WG && WS_WG + 32 * 16384 * 2 <= WS_CAR, "weights map");
static_assert(WS_CAR + (size_t)NCHUNK * 2 * 1024 * 8 <= WS_CIN && WS_A + (size_t)NTOK * DM * 2 <= WS_B, "carry map");
static_assert(WS_QG + (size_t)NTOK * DM * 2 <= WS_K && WS_XR + (size_t)(XR_ROWS + 64) * 1024 * 2 <= WS_END && WS_EDGE + (size_t)512 * 2 * 3 * FFN * 4 <= WS_H1A && WS_H1A + (size_t)HROWS * DM * 2 <= WS_END && WS_END <= 1024 * MiB && WS_CIN + (size_t)NCHUNK * 2 * 1024 * 4 <= WS_R0 && WS_SSQL + (size_t)NTOK * 8 * 4 <= WS_A && WS_ACT + (size_t)HROWS * FFN * 2 <= WS_EDGE && WS_EDGE + (size_t)512 * 2 * 3 * FFN * 4 <= WS_END, "B map");
constexpr int CW_BAR = 4096;

constexpr int RING_BYTES = 131072;
constexpr int LDSCTL_OFF = RING_BYTES, MISC_OFF = LDSCTL_OFF + 320;
constexpr int LDS_BYTES = 147456;

#define GAS __attribute__((address_space(1)))
#define LAS __attribute__((address_space(3)))
typedef unsigned short bf16;
typedef unsigned v4u __attribute__((ext_vector_type(4)));
typedef float f32x4 __attribute__((ext_vector_type(4)));
typedef short bf16x8 __attribute__((ext_vector_type(8)));
typedef GAS unsigned gu32;
typedef GAS unsigned long long gu64;
#define RLX_AGENT __ATOMIC_RELAXED, __HIP_MEMORY_SCOPE_AGENT
#define LDS_WAIT() asm volatile("s_waitcnt lgkmcnt(0)" ::: "memory")
#define VM_WAIT() asm volatile("s_waitcnt vmcnt(0)" ::: "memory")
__device__ __forceinline__ unsigned long long rt() { return __builtin_amdgcn_s_memrealtime(); }
__device__ __forceinline__ unsigned f2bf(float f) { unsigned u = __builtin_bit_cast(unsigned, f); return (u + 0x7fffu + ((u >> 16) & 1u)) >> 16; }
__device__ __forceinline__ unsigned pk2(float lo, float hi) { return f2bf(lo) | (f2bf(hi) << 16); }

#define XB_TMO      128
#define XB_XCNT(j)  (256  + 64 * (j))
#define XB_XSUB(j)  (1280 + 64 * (j))
#define XB_XGEN(j)  (2304 + 64 * (j))
#define XB_TOP      3328
#define XB_TOPGEN   3392
#define XCD_BAR_WORDS 3456
#define XB_SPIN_CAP (1u << 18)

__device__ __forceinline__ unsigned xb_ld(unsigned* p)              { return __hip_atomic_load(p, __ATOMIC_RELAXED, __HIP_MEMORY_SCOPE_AGENT); }
__device__ __forceinline__ unsigned xb_add(unsigned* p, unsigned v) { return __hip_atomic_fetch_add(p, v, __ATOMIC_RELAXED, __HIP_MEMORY_SCOPE_AGENT); }
__device__ __forceinline__ unsigned xb_xcc_id() { return (unsigned)__builtin_amdgcn_s_getreg((3 << 11) | 20) & 0xFu; }
#define XB_SPIN(cond, bar) do { unsigned _sp = 0; while (cond) { __builtin_amdgcn_s_sleep(1); \
    if ((++_sp & 255u) == 0u) { if (xb_ld(&(bar)[XB_TMO])) break; if (_sp > XB_SPIN_CAP) { atomicAdd(&(bar)[XB_TMO], 1u); break; } } } } while (0)

struct XcdBarrier {
    unsigned* bar; unsigned x;
    volatile LAS unsigned* st;
};

__device__ __forceinline__ XcdBarrier xcd_barrier_post(unsigned* bar, volatile LAS unsigned* st) {
    XcdBarrier b; b.bar = bar; b.x = xb_xcc_id(); b.st = st;
    if (threadIdx.x == 0) (void)xb_add(&bar[XB_XCNT(b.x)], 1u);
    return b;
}
__device__ __forceinline__ void xcd_barrier_complete(unsigned* bar, unsigned x, unsigned& nloc, unsigned& nx) {
    const unsigned G = gridDim.x * gridDim.y * gridDim.z;
    unsigned sum, cnt, mine, sp = 0u;
    for (;;) {
        sum = 0u; cnt = 0u; mine = 0u;
#pragma unroll
        for (unsigned j = 0; j < 16; ++j) { const unsigned c = xb_ld(&bar[XB_XCNT(j)]); sum += c; cnt += (c > 0u) ? 1u : 0u; mine = (j == x) ? c : mine; }
        if (sum == G) break;
        __builtin_amdgcn_s_sleep(1);
        if ((++sp & 255u) == 0u) { if (xb_ld(&bar[XB_TMO])) break; if (sp > XB_SPIN_CAP) { atomicAdd(&bar[XB_TMO], 1u); break; } }
    }
    nloc = mine > 0u ? mine : 1u; nx = cnt > 0u ? cnt : 1u;
}

__device__ __forceinline__ void xcd_barrier(const XcdBarrier& b) {
    asm volatile("s_waitcnt vmcnt(0)" ::: "memory");
    __syncthreads();
    if (threadIdx.x == 0) {
        unsigned* bar = b.bar;
        __builtin_amdgcn_s_waitcnt(0);
        unsigned nloc = b.st[0], nx = b.st[1];
        if (nloc == 0u) { xcd_barrier_complete(bar, b.x, nloc, nx); b.st[0] = nloc; b.st[1] = nx; }
        const unsigned old = xb_add(&bar[XB_XSUB(b.x)], 1u);
        const unsigned gen = old / nloc;
        if (old + 1u == (gen + 1u) * nloc) {
            __builtin_amdgcn_fence(__ATOMIC_RELEASE, "agent");
            asm volatile("s_waitcnt vmcnt(0)" ::: "memory");
            const unsigned og = xb_add(&bar[XB_TOP], 1u);
            const unsigned tg = og / nx;
            if (og + 1u == (tg + 1u) * nx) xb_add(&bar[XB_TOPGEN], 1u);
            else XB_SPIN(xb_ld(&bar[XB_TOPGEN]) == tg, bar);
            __builtin_amdgcn_fence(__ATOMIC_ACQUIRE, "agent");
            xb_add(&bar[XB_XGEN(b.x)], 1u);
            asm volatile("s_waitcnt vmcnt(0)" ::: "memory");
        } else {
            XB_SPIN(xb_ld(&bar[XB_XGEN(b.x)]) == gen, bar);
            __builtin_amdgcn_fence(__ATOMIC_ACQUIRE, "agent");
            asm volatile("s_waitcnt vmcnt(0)" ::: "memory");
        }
    }
    __syncthreads();
}

__device__ __forceinline__ float bf2f(unsigned short b) { return __builtin_bit_cast(float, (unsigned)b << 16); }
__device__ __forceinline__ float bf2f(short b) { return __builtin_bit_cast(float, (unsigned)(unsigned short)b << 16); }
__device__ __forceinline__ float wave_sum(float v) {
#pragma unroll
    for (int o = 1; o < 64; o <<= 1) v += __shfl_xor(v, o);
    return v;
}
__device__ __forceinline__ float wave_max(float v) {
#pragma unroll
    for (int o = 1; o < 64; o <<= 1) v = fmaxf(v, __shfl_xor(v, o));
    return v;
}
__device__ __forceinline__ float fast_exp(float x) { return __builtin_amdgcn_exp2f(x * 1.4426950408889634f); }
__device__ __forceinline__ float sigmoidf_(float x) { return __builtin_amdgcn_rcpf(1.f + fast_exp(-x)); }
__device__ __forceinline__ float gelu_tanh(float x) {
    const float z = 0.7978845608028654f * (x + 0.044715f * x * x * x);
    return x * sigmoidf_(2.f * z);
}
__device__ __forceinline__ float neg_expm1(float x) {
    const float p = x * (1.f + x * (0.5f + x * (0.16666667f + x * (0.041666668f + x * (0.0083333338f + x * 0.0013888889f)))));
    const float e = fast_exp(x) - 1.f;
    return -(fabsf(x) < 0.25f ? p : e);
}
__device__ __forceinline__ v4u pack8(const float (&v)[8]) { v4u o; o.x = pk2(v[0], v[1]); o.y = pk2(v[2], v[3]); o.z = pk2(v[4], v[5]); o.w = pk2(v[6], v[7]); return o; }

#define FIN(F, idx) ({ const __attribute__((address_space(1))) float* p_; asm("s_load_dwordx2 %0, %1, %2 ; tag %3\n\ts_waitcnt lgkmcnt(0)" : "=s"(p_) : "s"((F).kargs), "i"((idx) * 8), "s"((F).ptag)); (const float*)p_; })
struct Frame {
    LAS unsigned char* lds;
    volatile LAS unsigned* MISC;
    gu32* ctl;
    int tid, lane, wave, vcu, G;
    const __attribute__((address_space(4))) void* kargs; int ptag;
    float* out;
    unsigned char* ws;
#define WSP(T, NAME, OFF) __device__ __forceinline__ T* NAME() const { return (T*)(ws + (OFF)); }
    WSP(bf16, WIN_T, WS_WIN) WSP(bf16, WOUT_T, WS_WOUT) WSP(bf16, WUP_T, WS_WUP) WSP(bf16, WDOWN_T, WS_WDOWN) WSP(bf16, WG, WS_WG) WSP(bf16, XN, WS_A) WSP(bf16, QG, WS_QG) WSP(bf16, K, WS_K) WSP(bf16, V, WS_V)
    WSP(bf16, XR, WS_XR) WSP(bf16, ACT, WS_ACT) WSP(bf16, H1A, WS_H1A) WSP(float, EDGE, WS_EDGE) WSP(bf16, XNMETA, WS_XNMETA) WSP(bf16, KM, WS_KM) WSP(bf16, VM, WS_VM)
    WSP(float, ZM, WS_ZM) WSP(float, Q15, WS_Q15) WSP(float, GY15, WS_GY15) WSP(float, LO15, WS_LO15) WSP(float, MIXED15, WS_MIXED15) WSP(float, Y15, WS_Y15) WSP(float, G15, WS_G15) WSP(float, MQP, WS_MQP)
    WSP(float, CIN, WS_CIN) WSP(float2, CAR, WS_CAR) WSP(float, R0, WS_R0) WSP(float, RATIO, WS_RATIO) WSP(float, RL, WS_RL) WSP(float, SSQA, WS_SSQA) WSP(float, SSQL, WS_SSQL)
#undef WSP
};

template <bool UPMAP, int GAIN = 0>
__device__ __forceinline__ void p0_transpose_item(const float* W, int K, int N, bf16* WT, int row_off, LAS float* scr, int item, int lane, const float* g0 = nullptr, const float* g1 = nullptr) {
    const int nblk = N / 32, kb = item / nblk, nb = item % nblk, k0 = 64 * kb, n0 = 32 * nb;
    const int orow0 = UPMAP ? (((n0 % FFN) >> 7) << 8) + 128 * (n0 / FFN) + ((n0 % FFN) & 127) : row_off + n0;
    float wv[32];
#pragma unroll
    for (int i = 0; i < 32; ++i) { const int kk = 2 * i + (lane >> 5); wv[i] = W[(size_t)(k0 + kk) * N + n0 + (lane & 31)]; }
#pragma unroll
    for (int i = 0; i < 32; ++i) { const int kk = 2 * i + (lane >> 5); float gv = 1.f; if (GAIN == 1) gv = g0[k0 + kk]; if (GAIN == 2) gv = (k0 + kk) < 1024 ? g0[k0 + kk] : g1[k0 + kk - 1024];
        scr[kk * 33 + (lane & 31)] = wv[i] * gv; }
    LDS_WAIT(); asm volatile("" ::: "memory");
    const int c = lane & 7;
#pragma unroll
    for (int j = 0; j < 4; ++j) { const int n = (lane >> 3) + 8 * j; const LAS float* s = scr + (8 * c) * 33 + n;
        v4u o; o.x = pk2(s[0 * 33], s[1 * 33]); o.y = pk2(s[2 * 33], s[3 * 33]); o.z = pk2(s[4 * 33], s[5 * 33]); o.w = pk2(s[6 * 33], s[7 * 33]);
        *(GAS v4u*)(WT + (size_t)(orow0 + n) * K + k0 + 8 * c) = o; }
    LDS_WAIT(); asm volatile("" ::: "memory");
}
__device__ __forceinline__ void rms_row_to_bf16(const float* xrow, bf16* orow, int lane, float* rout) {
    const GAS f32x4* xr = (const GAS f32x4*)xrow + lane;
    f32x4 v[8]; float s = 0.f;
#pragma unroll
    for (int j = 0; j < 8; ++j) { v[j] = xr[64 * j]; s += (v[j].x * v[j].x + v[j].y * v[j].y) + (v[j].z * v[j].z + v[j].w * v[j].w); }
    const float r = 1.f / sqrtf(wave_sum(s) * (1.f / DM) + EPS);
    GAS unsigned long long* o8 = (GAS unsigned long long*)orow + lane;
#pragma unroll
    for (int j = 0; j < 8; ++j) o8[64 * j] = (unsigned long long)pk2(v[j].x * r, v[j].y * r) | ((unsigned long long)pk2(v[j].z * r, v[j].w * r) << 32);
    if (rout && lane == 0) *rout = r;
}
__device__ __forceinline__ void p0_prologue(Frame& F) {
    LAS float* scr = (LAS float*)(F.lds + F.wave * 16384);
    const int gw = F.vcu * NWAVES + F.wave, NGW = F.G * NWAVES;
    constexpr int I_IN = (DM / 64) * (INW / 32), I_OUT = (DM / 64) * (DM / 32), I_UP = (DM / 64) * (UPW / 32), I_DN = (FFN / 64) * (DM / 32), I_G = 32 * 8;
    constexpr int NITEMS = I_IN + I_OUT + I_UP + I_DN + I_G;
    for (int it = gw; it < NITEMS; it += NGW) {
        int r = it;
        if (r < I_IN) { p0_transpose_item<false, 1>(FIN(F, 4  ), DM, INW, F.WIN_T(), 0, scr, r, F.lane, FIN(F, 3  )); continue; } r -= I_IN;
        if (r < I_OUT) { p0_transpose_item<false, 2>(FIN(F, 16  ), DM, DM, F.WOUT_T(), 0, scr, r, F.lane, FIN(F, 14  ), FIN(F, 15  )); continue; } r -= I_OUT;
        if (r < I_UP) { p0_transpose_item<true>(FIN(F, 19  ), DM, UPW, F.WUP_T(), 0, scr, r, F.lane); continue; } r -= I_UP;
        if (r < I_DN) { p0_transpose_item<false>(FIN(F, 22  ), FFN, DM, F.WDOWN_T(), 0, scr, r, F.lane); continue; } r -= I_DN;
        {
            const int mi = r >> 3, sub = r & 7, gate = mi >> 4, dir = (mi >> 3) & 1, blk = mi & 7;
            const float* W = (gate ? FIN(F, 11  ) : FIN(F, 9  )) + (size_t)(dir * 8 + blk) * 16384;
            bf16* WT = F.WG() + (size_t)((dir * 2 + gate) * 8 + blk) * 16384;
            p0_transpose_item<false>(W, 128, 128, WT, 0, scr, sub, F.lane);
        }
    }
    for (int m = gw; m < NTOK; m += NGW) {
        const float* xr = m < 32768 ? FIN(F, 0  ) + (size_t)m * DM : FIN(F, 1  ) + (size_t)(m - 32768) * DM;
        rms_row_to_bf16(xr, F.XN() + (size_t)m * DM, F.lane, F.R0() + m);
    }
    for (int m = gw; m < 16; m += NGW) rms_row_to_bf16(FIN(F, 2  ) + (size_t)m * DM, F.XNMETA() + (size_t)m * DM, F.lane, nullptr);
    const int gt = F.vcu * 512 + F.tid, NGT = F.G * 512; const v4u z4 = {0u, 0u, 0u, 0u};
    for (int i = gt; i < 12 * 48 * 128; i += NGT) { const int s = i / (48 * 128), rem = i % (48 * 128); ((GAS v4u*)(F.XR() + (size_t)xr_base(s) * 1024))[rem] = z4; }
    for (int i = gt; i < 64 * 128; i += NGT) ((GAS v4u*)(F.XR() + (size_t)XR_ROWS * 1024))[i] = z4;
    for (int i = gt; i < 2048; i += NGT) { ((GAS v4u*)F.KM())[i] = z4; ((GAS v4u*)F.VM())[i] = z4; }
}

template <int R, class Out, bool GMAP = false>
__device__ __forceinline__ void small_gemm(const LAS float* X, int K, const bf16* Wt, int N, int gw, int NGW, int lane, const Out& out) {
    for (int n = gw; n < N; n += NGW) {
        float acc[R];
#pragma unroll
        for (int r = 0; r < R; ++r) acc[r] = 0.f;
        const GAS bf16x8* wrow = (const GAS bf16x8*)(Wt + (size_t)(GMAP ? ((n >> 7) << 8) + (n & 127) : n) * K);
        for (int k8 = lane; k8 < K / 8; k8 += 64) {
            const bf16x8 w = wrow[k8]; float wf[8];
#pragma unroll
            for (int j = 0; j < 8; ++j) wf[j] = bf2f(w[j]);
#pragma unroll
            for (int r = 0; r < R; ++r) { const LAS f32x4* xp = (const LAS f32x4*)(X + r * K + k8 * 8); const f32x4 a = xp[0], b = xp[1];
                acc[r] += (a.x * wf[0] + a.y * wf[1]) + (a.z * wf[2] + a.w * wf[3]) + (b.x * wf[4] + b.y * wf[5]) + (b.z * wf[6] + b.w * wf[7]); }
        }
        float v = 0.f;
#pragma unroll
        for (int r = 0; r < R; ++r) { const float s = wave_sum(acc[r]); v = (lane == r) ? s : v; }
        out(n, lane, v);
    }
}
struct OutMetaZ { float* ZM; bf16* XR;
    __device__ __forceinline__ void operator()(int n, int lane, float v) const {
        if (lane < 16) { ZM[lane * INW + n] = v;
            if (n >= 1536 && n < 2560) { const unsigned short b = (unsigned short)f2bf(v); const int c = n - 1536;
                for (int s = 0; s < 12; ++s) XR[(size_t)(xr_base(s) + 48 + lane) * 1024 + c] = b; } }
    } };
struct OutRows { float* Y; int ld; int R;
    __device__ __forceinline__ void operator()(int n, int lane, float v) const { if (lane < R) Y[(size_t)lane * ld + n] = v; } };

__device__ __forceinline__ void p1_meta_z(Frame& F) {
    LAS float* X = (LAS float*)F.lds;
    for (int i = F.tid; i < 16 * DM / 8; i += 512) { const bf16x8 v = ((const GAS bf16x8*)F.XNMETA())[i];
        ((LAS f32x4*)X)[2 * i] = (f32x4){bf2f(v[0]), bf2f(v[1]), bf2f(v[2]), bf2f(v[3])}; ((LAS f32x4*)X)[2 * i + 1] = (f32x4){bf2f(v[4]), bf2f(v[5]), bf2f(v[6]), bf2f(v[7])}; }
    __syncthreads();
    const OutMetaZ o{F.ZM(), F.XR()};
    small_gemm<16, OutMetaZ>(X, DM, F.WIN_T(), INW, F.vcu * NWAVES + F.wave, F.G * NWAVES, F.lane, o);
    __syncthreads();
}
typedef float f32x16 __attribute__((ext_vector_type(16)));
constexpr int LRU_XC0 = 0, LRU_XC_BUF = 17408, LRU_XC_STRIDE = 272;
constexpr int LRU_CW = 34816;
constexpr int LRU_HF = 37376, LRU_HB = LRU_HF + 32768;
__device__ __forceinline__ int crow16(int r, int hi) { return (r & 3) + 8 * (r >> 2) + 4 * hi; }

template <int DIR>
__device__ __forceinline__ void scan_tile(const float (&a)[16], const float (&u)[16], float& carry, float& ptot, float (&h)[16], bool up) {
    float HL[16], PL[16], As[4], Hs[4];
#pragma unroll
    for (int j = 0; j < 4; ++j) {
        float hl = 0.f, p = 1.f;
#pragma unroll
        for (int ii = 0; ii < 4; ++ii) { const int idx = 4 * j + (DIR == 0 ? ii : 3 - ii); hl = a[idx] * hl + u[idx]; p *= a[idx]; HL[idx] = hl; PL[idx] = p; }
        As[j] = p; Hs[j] = hl;
    }
    float Alo[4], Ahi[4], Hlo[4], Hhi[4];
#pragma unroll
    for (int j = 0; j < 4; ++j) {
        { const unsigned x = __float_as_uint(As[j]); auto rr = __builtin_amdgcn_permlane32_swap(x, x, false, false); Alo[j] = __uint_as_float(rr[0]); Ahi[j] = __uint_as_float(rr[1]); }
        { const unsigned x = __float_as_uint(Hs[j]); auto rr = __builtin_amdgcn_permlane32_swap(x, x, false, false); Hlo[j] = __uint_as_float(rr[0]); Hhi[j] = __uint_as_float(rr[1]); }
    }
    float cin[4]; float c = carry;
    if (DIR == 0) {
#pragma unroll
        for (int j = 0; j < 4; ++j) { const float c_lo = c; c = Alo[j] * c + Hlo[j]; const float c_hi = c; c = Ahi[j] * c + Hhi[j]; cin[j] = up ? c_hi : c_lo; }
    } else {
#pragma unroll
        for (int j = 3; j >= 0; --j) { const float c_hi = c; c = Ahi[j] * c + Hhi[j]; const float c_lo = c; c = Alo[j] * c + Hlo[j]; cin[j] = up ? c_hi : c_lo; }
    }
    carry = c;
#pragma unroll
    for (int j = 0; j < 4; ++j) ptot *= Alo[j] * Ahi[j];
#pragma unroll
    for (int idx = 0; idx < 16; ++idx) h[idx] = HL[idx] + PL[idx] * cin[idx >> 2];
}

__device__ __forceinline__ void lru_decode(int cg, int& seq, int& c) { if (cg < 520) { seq = cg / 65; c = cg - seq * 65; } else { const int c2 = cg - 520; seq = c2 / 129; c = c2 - seq * 129; seq += 8; } }
template <int PASS>
__device__ __forceinline__ void lru_phase(Frame& F, bf16* gout) {
    LAS unsigned char* L = F.lds;
    const int tid = F.tid, lane = F.lane, wave = F.wave;
    const int n = F.vcu & 7, ngrp = F.G >> 3;
    { const float* cw = FIN(F, 7  ); const float* cb = FIN(F, 8  );
      for (int i = tid; i < 640; i += 512) { const int k = i >> 7, ch = i & 127; ((LAS float*)(L + LRU_CW))[i] = k < 4 ? cw[k * 1024 + n * 128 + ch] : cb[n * 128 + ch]; } }
    const int d = wave >> 2, g4 = wave & 3, r32 = lane & 31, hi = lane >> 5, chl = g4 * 32 + r32, chg = n * 128 + chl;
    bf16x8 br[8], bi[8];
    { const bf16* wr_ = F.WG() + (size_t)((d * 2 + 0) * 8 + n) * 16384 + chl * 128 + hi * 8;
      const bf16* wi_ = F.WG() + (size_t)((d * 2 + 1) * 8 + n) * 16384 + chl * 128 + hi * 8;
#pragma unroll
      for (int ks = 0; ks < 8; ++ks) { br[ks] = *(const GAS bf16x8*)(wr_ + ks * 16); bi[ks] = *(const GAS bf16x8*)(wi_ + ks * 16); } }
    constexpr float L2E = 1.4426950408889634f;
    const float nb_r = -L2E * FIN(F, 10  )[d * 1024 + chg], nb_i = -L2E * FIN(F, 12  )[d * 1024 + chg];
    const float spl = 8.f * L2E * log1pf(expf(-FIN(F, 13  )[d * 1024 + chg]));
    const int tau0 = tid >> 4, co = (tid & 15) * 8;
    bf16x8 xv[2][4];
#define LRU_PREFETCH(cgx) do { int s_, c_; lru_decode((cgx), s_, c_); const int xb_ = xr_base(s_); \
        _Pragma("unroll") for (int it_ = 0; it_ < 2; ++it_) _Pragma("unroll") for (int k_ = 0; k_ < 4; ++k_) { int row_ = xb_ + c_ * 64 + tau0 + 32 * it_ + k_ - 2; row_ = row_ < 0 ? 0 : row_; \
            xv[it_][k_] = *(const GAS bf16x8*)(F.XR() + (size_t)row_ * 1024 + n * 128 + co); } } while (0)
    int cg = F.vcu >> 3;
    if (cg < NCHUNK) LRU_PREFETCH(cg);
    __syncthreads();
    for (int ui = 0; cg < NCHUNK; cg += ngrp, ++ui) {
        int seq, c; lru_decode(cg, seq, c);
        LAS unsigned char* XC = L + LRU_XC0 + (ui & 1) * LRU_XC_BUF;
        float carry = 0.f, ptot = 1.f;
        if (PASS == 2) carry = F.CIN()[((size_t)cg * 2 + d) * 1024 + chg];
#pragma unroll
        for (int it = 0; it < 2; ++it) {
            const int tau = tau0 + 32 * it; float xc[8];
            { const LAS f32x4* cb = (const LAS f32x4*)(L + LRU_CW + (4 * 128 + co) * 4); const f32x4 b0 = cb[0], b1 = cb[1];
              xc[0] = b0.x; xc[1] = b0.y; xc[2] = b0.z; xc[3] = b0.w; xc[4] = b1.x; xc[5] = b1.y; xc[6] = b1.z; xc[7] = b1.w; }
#pragma unroll
            for (int k = 0; k < 4; ++k) { const LAS f32x4* wp = (const LAS f32x4*)(L + LRU_CW + (k * 128 + co) * 4); const f32x4 w0 = wp[0], w1 = wp[1]; const bf16x8 v = xv[it][k];
                xc[0] += w0.x * bf2f(v[0]); xc[1] += w0.y * bf2f(v[1]); xc[2] += w0.z * bf2f(v[2]); xc[3] += w0.w * bf2f(v[3]);
                xc[4] += w1.x * bf2f(v[4]); xc[5] += w1.y * bf2f(v[5]); xc[6] += w1.z * bf2f(v[6]); xc[7] += w1.w * bf2f(v[7]); }
            if (c == 0 && tau < 48) {
#pragma unroll
                for (int j = 0; j < 8; ++j) xc[j] = 0.f;
            }
            *(LAS v4u*)(XC + tau * LRU_XC_STRIDE + co * 2) = pack8(xc);
        }
        bf16x8 gv[2];
        const int row0 = seq_first_row(seq) + 64 * (c - 1);
        if (PASS == 2) { if (c > 0) {
#pragma unroll
            for (int it = 0; it < 2; ++it) gv[it] = *(const GAS bf16x8*)(F.QG() + (size_t)(row0 + tau0 + 32 * it) * DM + 1024 + n * 128 + co); } }
        __syncthreads();
        if (cg + ngrp < NCHUNK) LRU_PREFETCH(cg + ngrp);
        f32x16 arT[2], aiT[2];
#pragma unroll
        for (int tt = 0; tt < 2; ++tt) {
            const int tile = d ? 1 - tt : tt;
            f32x16 ar = {}, ai = {};
#pragma unroll
            for (int ks = 0; ks < 8; ++ks) {
                const bf16x8 a = *(const LAS bf16x8*)(XC + (tile * 32 + r32) * LRU_XC_STRIDE + (ks * 16 + hi * 8) * 2);
                ar = __builtin_amdgcn_mfma_f32_32x32x16_bf16(a, br[ks], ar, 0, 0, 0);
                ai = __builtin_amdgcn_mfma_f32_32x32x16_bf16(a, bi[ks], ai, 0, 0, 0);
            }
            arT[tt] = ar; aiT[tt] = ai;
        }
#pragma unroll
        for (int tt = 0; tt < 2; ++tt) {
            const int tile = d ? 1 - tt : tt;
            const f32x16 ar = arT[tt], ai = aiT[tt];
            float av[16], uv[16], hv[16];
            typedef float f32x2 __attribute__((ext_vector_type(2)));
#pragma unroll
            for (int r = 0; r < 16; r += 2) {
                const int tau0_ = tile * 32 + crow16(r, hi);
                const f32x2 xc2 = {bf2f(*(const LAS unsigned short*)(XC + tau0_ * LRU_XC_STRIDE + chl * 2)), bf2f(*(const LAS unsigned short*)(XC + (tau0_ + 1) * LRU_XC_STRIDE + chl * 2))};
                const f32x2 tr = (f32x2){ar[r], ar[r + 1]} * (f32x2){-L2E, -L2E} + (f32x2){nb_r, nb_r};
                const f32x2 ti = (f32x2){ai[r], ai[r + 1]} * (f32x2){-L2E, -L2E} + (f32x2){nb_i, nb_i};
                const f32x2 dr = (f32x2){__builtin_amdgcn_exp2f(tr.x), __builtin_amdgcn_exp2f(tr.y)} + (f32x2){1.f, 1.f};
                const f32x2 di = (f32x2){__builtin_amdgcn_exp2f(ti.x), __builtin_amdgcn_exp2f(ti.y)} + (f32x2){1.f, 1.f};
                const f32x2 rg = {__builtin_amdgcn_rcpf(dr.x), __builtin_amdgcn_rcpf(dr.y)}, ig = {__builtin_amdgcn_rcpf(di.x), __builtin_amdgcn_rcpf(di.y)};
                const f32x2 la = rg * (f32x2){-spl, -spl};
                const f32x2 a = {__builtin_amdgcn_exp2f(la.x), __builtin_amdgcn_exp2f(la.y)};
                const f32x2 t = (f32x2){1.f, 1.f} - a * a;
                const f32x2 m = {__builtin_amdgcn_sqrtf(t.x), __builtin_amdgcn_sqrtf(t.y)};
                const f32x2 u = m * (ig * xc2);
                av[r] = a.x; av[r + 1] = a.y; uv[r] = u.x; uv[r + 1] = u.y;
            }
            if (d == 0) scan_tile<0>(av, uv, carry, ptot, hv, hi != 0); else scan_tile<1>(av, uv, carry, ptot, hv, hi != 0);
            if (PASS == 2) {
#pragma unroll
                for (int r = 0; r < 16; ++r) { const int tau = tile * 32 + crow16(r, hi); *(LAS float*)(L + (d ? LRU_HB : LRU_HF) + (tau * 128 + chl) * 4) = hv[r]; }
            }
        }
        if (PASS == 1) { if (hi == 0) F.CAR()[((size_t)cg * 2 + d) * 1024 + chg] = make_float2(ptot, carry); }
        if (PASS == 2) {
            __syncthreads();
            if (c > 0) {
#pragma unroll
                for (int it = 0; it < 2; ++it) {
                    const int tau = tau0 + 32 * it; const bf16x8 g8 = gv[it];
                    const LAS f32x4* hf = (const LAS f32x4*)(L + LRU_HF + (tau * 128 + co) * 4); const LAS f32x4* hb = (const LAS f32x4*)(L + LRU_HB + (tau * 128 + co) * 4);
                    const f32x4 f0 = hf[0], f1 = hf[1], b0 = hb[0], b1 = hb[1];
                    float o[8];
                    o[0] = (f0.x + b0.x) * gelu_tanh(bf2f(g8[0])); o[1] = (f0.y + b0.y) * gelu_tanh(bf2f(g8[1])); o[2] = (f0.z + b0.z) * gelu_tanh(bf2f(g8[2])); o[3] = (f0.w + b0.w) * gelu_tanh(bf2f(g8[3]));
                    o[4] = (f1.x + b1.x) * gelu_tanh(bf2f(g8[4])); o[5] = (f1.y + b1.y) * gelu_tanh(bf2f(g8[5])); o[6] = (f1.z + b1.z) * gelu_tanh(bf2f(g8[6])); o[7] = (f1.w + b1.w) * gelu_tanh(bf2f(g8[7]));
                    *(GAS v4u*)(gout + (size_t)(row0 + tau) * DM + 1024 + n * 128 + co) = pack8(o);
                    float sq = (o[0] * o[0] + o[1] * o[1]) + (o[2] * o[2] + o[3] * o[3]) + (o[4] * o[4] + o[5] * o[5]) + (o[6] * o[6] + o[7] * o[7]);
                    sq += __shfl_xor(sq, 1); sq += __shfl_xor(sq, 2); sq += __shfl_xor(sq, 4); sq += __shfl_xor(sq, 8);
                    if ((tid & 15) == 0) F.SSQL()[(size_t)(row0 + tau) * 8 + n] = sq;
                }
            } else if (tid < 128) {
                const float hf = *(const LAS float*)(L + LRU_HF + (63 * 128 + tid) * 4), hb = *(const LAS float*)(L + LRU_HB + (63 * 128 + tid) * 4);
                F.LO15()[seq * 1024 + n * 128 + tid] = (hf + hb) * gelu_tanh(F.GY15()[n * 128 + tid]);
            }
        }
    }
    __syncthreads();
#undef LRU_PREFETCH
}
__device__ __forceinline__ void lru_propagate(Frame& F) {
    const int gid = F.vcu * 512 + F.tid;
    if (gid < 12 * 2048) {
        const int s = gid >> 11, d = (gid >> 10) & 1, ch = gid & 1023; const int nch = s < 8 ? 65 : 129, cb = chunk_base(s);
        const float2* car = F.CAR() + (size_t)d * 1024 + ch; float* cinp = F.CIN() + (size_t)d * 1024 + ch;
        float cin = 0.f;
        for (int b0 = 0; b0 < nch; b0 += 16) {
            float2 ph[16];
#pragma unroll
            for (int i = 0; i < 16; ++i) { const int cc = b0 + i; const int c = d ? nch - 1 - cc : cc; if (cc < nch) ph[i] = car[(size_t)(cb + c) * 2048]; }
#pragma unroll
            for (int i = 0; i < 16; ++i) { const int cc = b0 + i; const int c = d ? nch - 1 - cc : cc; if (cc < nch) { cinp[(size_t)(cb + c) * 2048] = cin; cin = ph[i].x * cin + ph[i].y; } }
        }
    }
}

__device__ __forceinline__ void k_rope_pass(Frame& F, bf16* Kout) {
    const int gw = F.vcu * NWAVES + F.wave, NGW = F.G * NWAVES, sub = F.lane >> 4, l16 = F.lane & 15;
    const int c0 = 8 * l16, p = l16 >> 3, half = (l16 >> 2) & 1, i0 = 8 * (l16 & 3);
    float inv[8], gk[8];
#pragma unroll
    for (int j = 0; j < 8; ++j) { inv[j] = __builtin_amdgcn_exp2f(-(float)(i0 + j) * (13.287712379549449f / 32.f)) * 0.15915494309189535f; gk[j] = FIN(F, 6  )[c0 + j]; }
    for (int it = gw; it < NTOK * 2 / 4; it += NGW) {
        const int item = it * 4 + sub, row = item >> 1, hk = item & 1;
        const int s = row_seq(row), t = row - seq_first_row(s); const float pos = (float)(p ? (t & 63) : (t >> 6));
        bf16* kp = F.K() + (size_t)row * 256 + hk * 128 + c0;
        const bf16x8 v = *(const GAS bf16x8*)kp; float x[8]; float ss = 0.f;
#pragma unroll
        for (int j = 0; j < 8; ++j) { x[j] = bf2f(v[j]); ss += x[j] * x[j]; }
        ss += __shfl_xor(ss, 1); ss += __shfl_xor(ss, 2); ss += __shfl_xor(ss, 4); ss += __shfl_xor(ss, 8);
        const float rs = 1.f / sqrtf(ss * (1.f / 128.f) + EPS); float o[8];
#pragma unroll
        for (int j = 0; j < 8; ++j) { x[j] *= rs * gk[j]; const float pr = __shfl_xor(x[j], 4);
            float rev = pos * inv[j]; rev -= floorf(rev); const float sn = __builtin_amdgcn_sinf(rev), cs = __builtin_amdgcn_cosf(rev);
            o[j] = half ? x[j] * cs + pr * sn : x[j] * cs - pr * sn; }
        *(GAS v4u*)(Kout + (size_t)row * 256 + hk * 128 + c0) = pack8(o);
    }
}
__device__ __forceinline__ void p3_meta_job(Frame& F) {
    for (int pr = F.wave; pr < 32; pr += 8) { const int r = pr >> 1, hk = pr & 1; const float* z = F.ZM() + r * INW + 1024 + hk * 128;
        const float a = z[F.lane], b = z[F.lane + 64]; const float rs = 1.f / sqrtf(wave_sum(a * a + b * b) * (1.f / 128.f) + EPS);
        F.KM()[r * 256 + hk * 128 + F.lane] = (bf16)f2bf(a * rs * FIN(F, 6  )[F.lane]); F.KM()[r * 256 + hk * 128 + F.lane + 64] = (bf16)f2bf(b * rs * FIN(F, 6  )[F.lane + 64]); }
    for (int i = F.tid; i < 16 * 256; i += 512) F.VM()[i] = (bf16)f2bf(F.ZM()[(i >> 8) * INW + 1280 + (i & 255)]);
    { const int h = F.wave; const float* z = F.ZM() + 15 * INW + h * 128; const float a = z[F.lane], b = z[F.lane + 64];
      const float rs = 1.f / sqrtf(wave_sum(a * a + b * b) * (1.f / 128.f) + EPS);
      F.Q15()[h * 128 + F.lane] = a * rs * FIN(F, 5  )[F.lane]; F.Q15()[h * 128 + F.lane + 64] = b * rs * FIN(F, 5  )[F.lane + 64]; }
    for (int i = F.tid; i < 1024; i += 512) F.GY15()[i] = F.ZM()[15 * INW + 2560 + i];
}

__device__ __forceinline__ void metaq_item(Frame& F, int it) {
    int s, kvh, j; if (it < 256) { s = it >> 5; kvh = (it >> 4) & 1; j = it & 15; } else { const int t2 = it - 256; s = 8 + (t2 >> 6); kvh = (t2 >> 5) & 1; j = t2 & 31; }
    LAS float* q4 = (LAS float*)F.lds;
    LAS float* sc = q4 + 512;
    LAS float* red = sc + 4 * 288;
    const int tid = F.tid, nk = 256 + (j == 0 ? 16 : 0), row0 = seq_first_row(s) + 256 * j;
    q4[tid] = F.Q15()[kvh * 512 + tid];
    __syncthreads();
    if (tid < nk) {
        const bf16* kp = tid < 256 ? F.K() + (size_t)(row0 + tid) * 256 + kvh * 128 : F.KM() + (tid - 256) * 256 + kvh * 128;
        float d0 = 0.f, d1 = 0.f, d2 = 0.f, d3 = 0.f;
#pragma unroll 4
        for (int cc = 0; cc < 16; ++cc) { const bf16x8 kv = ((const GAS bf16x8*)kp)[cc];
#pragma unroll
            for (int e = 0; e < 8; ++e) { const float kf = bf2f(kv[e]); d0 += kf * q4[cc * 8 + e]; d1 += kf * q4[128 + cc * 8 + e]; d2 += kf * q4[256 + cc * 8 + e]; d3 += kf * q4[384 + cc * 8 + e]; } }
        const float SC = 0.088388347648318440f;
        sc[tid] = d0 * SC; sc[288 + tid] = d1 * SC; sc[576 + tid] = d2 * SC; sc[864 + tid] = d3 * SC;
    }
    __syncthreads();
    if (F.wave < 4) { LAS float* sh = sc + F.wave * 288; float m = -INFINITY;
        for (int k = F.lane; k < nk; k += 64) m = fmaxf(m, sh[k]);
        m = wave_max(m); float l = 0.f;
        for (int k = F.lane; k < nk; k += 64) { const float p = __expf(sh[k] - m); sh[k] = p; l += p; }
        l = wave_sum(l);
        if (F.lane == 0) { red[F.wave * 2] = m; red[F.wave * 2 + 1] = l; } }
    __syncthreads();
    {
        const int kg = tid >> 4, oc = tid & 15; float o[4][8];
#pragma unroll
        for (int h = 0; h < 4; ++h)
#pragma unroll
            for (int e = 0; e < 8; ++e) o[h][e] = 0.f;
        const bf16* vp = F.V() + (size_t)(row0 + kg * 8) * 256 + kvh * 128 + oc * 8;
        bf16x8 vv[8];
#pragma unroll
        for (int k = 0; k < 8; ++k) vv[k] = *(const GAS bf16x8*)(vp + (size_t)k * 256);
#pragma unroll
        for (int k = 0; k < 8; ++k) { const float p0 = sc[kg * 8 + k], p1 = sc[288 + kg * 8 + k], p2 = sc[576 + kg * 8 + k], p3 = sc[864 + kg * 8 + k];
#pragma unroll
            for (int e = 0; e < 8; ++e) { const float vf = bf2f(vv[k][e]); o[0][e] += p0 * vf; o[1][e] += p1 * vf; o[2][e] += p2 * vf; o[3][e] += p3 * vf; } }
        if (j == 0 && kg < 16) { const int k = kg; const bf16x8 v1 = *(const GAS bf16x8*)(F.VM() + k * 256 + kvh * 128 + oc * 8);
            const float p0 = sc[256 + k], p1 = sc[288 + 256 + k], p2 = sc[576 + 256 + k], p3 = sc[864 + 256 + k];
#pragma unroll
            for (int e = 0; e < 8; ++e) { const float vf = bf2f(v1[e]); o[0][e] += p0 * vf; o[1][e] += p1 * vf; o[2][e] += p2 * vf; o[3][e] += p3 * vf; } }
        LAS float* part = sc + 4 * 288 + 16;
#pragma unroll
        for (int h = 0; h < 4; ++h) { LAS f32x4* pp = (LAS f32x4*)(part + (kg * 4 + h) * 128 + oc * 8); pp[0] = (f32x4){o[h][0], o[h][1], o[h][2], o[h][3]}; pp[1] = (f32x4){o[h][4], o[h][5], o[h][6], o[h][7]}; }
        __syncthreads();
        const int h = tid >> 7, d = tid & 127; float os = 0.f;
#pragma unroll 8
        for (int g = 0; g < 32; ++g) os += part[(g * 4 + h) * 128 + d];
        float* dst = F.MQP() + ((size_t)it * 4 + h) * 132; dst[2 + d] = os; if (d == 0) { dst[0] = red[h * 2]; dst[1] = red[h * 2 + 1]; } }
    __syncthreads();
}
__device__ __forceinline__ void attn_phase(Frame& F, char* lds_generic, bf16* obase) {
    for (int r = 0; r < 8; ++r) {
        int s, kvh, hq, qb, S;
        if (F.G == 256) {
            const int x = F.vcu >> 5, i = F.vcu & 31;
            if (r < 4) { const int pair = 2 * x + (r >> 1); s = pair >> 1; kvh = pair & 1; const int u = (r & 1) * 32 + i; hq = u >> 4; qb = u & 15; S = 4096; }
            else { const int pair = x; s = 8 + (pair >> 1); kvh = pair & 1; const int u = (r - 4) * 32 + i; hq = u >> 5; qb = u & 31; S = 8192; }
        } else { s = 0; kvh = 0; hq = 0; qb = 0; S = 0; }
        if (S == 0) continue;
        const int row0 = seq_first_row(s), h = kvh * 4 + hq;
        bf16* qp = F.QG() + (size_t)(row0 + qb * 256) * DM + h * 128;
        attn::attn_unit(qp, F.K() + (size_t)row0 * 256 + kvh * 128, F.V() + (size_t)row0 * 256 + kvh * 128, F.KM() + kvh * 128, F.VM() + kvh * 128, obase + (size_t)(row0 + qb * 256) * DM + h * 128, S / 64 + 1, lds_generic, FIN(F, 5  ), qb * 256, F.SSQA() + (size_t)(row0 + qb * 256) * 8 + h);
    }
}

__device__ __forceinline__ void p5_ratio(Frame& F) {
    for (int row = F.vcu * 512 + F.tid; row < NTOK; row += F.G * 512) {
        const GAS f32x4* pa = (const GAS f32x4*)(F.SSQA() + (size_t)row * 8); const GAS f32x4* pl = (const GAS f32x4*)(F.SSQL() + (size_t)row * 8);
        const f32x4 a0 = pa[0], a1 = pa[1], l0 = pl[0], l1 = pl[1];
        const float sa = ((a0.x + a0.y) + (a0.z + a0.w)) + ((a1.x + a1.y) + (a1.z + a1.w)), sl = ((l0.x + l0.y) + (l0.z + l0.w)) + ((l1.x + l1.y) + (l1.z + l1.w));
        const float qa = sqrtf(sa * (1.f / 1024.f) + EPS), ql = sqrtf(sl * (1.f / 1024.f) + EPS);
        F.RATIO()[row] = ql / qa; F.RL()[row] = 1.f / ql;
    }
}
__device__ __forceinline__ void p5_meta_job(Frame& F, int s) {
    LAS float* buf = (LAS float*)F.lds; LAS float* red = buf + 2048; const int tid = F.tid;
    {
        const int nj = s < 8 ? 16 : 32;
        for (int e = tid; e < 1024; e += 512) { const int h = e >> 7, d = e & 127, kvh = h >> 2, hq = h & 3;
            const int it0 = s < 8 ? s * 32 + kvh * 16 : 256 + (s - 8) * 64 + kvh * 32;
            float M = -INFINITY; for (int j = 0; j < nj; ++j) M = fmaxf(M, F.MQP()[((size_t)(it0 + j) * 4 + hq) * 132]);
            float Ls = 0.f, O = 0.f;
            for (int j = 0; j < nj; ++j) { const float* p = F.MQP() + ((size_t)(it0 + j) * 4 + hq) * 132; const float w = __expf(p[0] - M); Ls += p[1] * w; O += p[2 + d] * w; }
            buf[e] = O / Ls; }
        for (int e = tid; e < 1024; e += 512) buf[1024 + e] = F.LO15()[s * 1024 + e];
        __syncthreads();
        { float ss = 0.f; for (int k = F.lane; k < 256; k += 64) { const float v = buf[F.wave * 256 + k]; ss += v * v; } ss = wave_sum(ss); if (F.lane == 0) red[F.wave] = ss; }
        __syncthreads();
        const float ra = 1.f / sqrtf((red[0] + red[1] + red[2] + red[3]) * (1.f / 1024.f) + EPS), rl = 1.f / sqrtf((red[4] + red[5] + red[6] + red[7]) * (1.f / 1024.f) + EPS);
        for (int e = tid; e < 2048; e += 512) F.MIXED15()[s * 2048 + e] = e < 1024 ? buf[e] * ra : buf[e] * rl;
        __syncthreads();
    }
}
__device__ __forceinline__ void p6_meta_y(Frame& F) {
    LAS float* X = (LAS float*)F.lds;
    for (int i = F.tid; i < 12 * DM / 4; i += 512) ((LAS f32x4*)X)[i] = ((const GAS f32x4*)F.MIXED15())[i];
    __syncthreads();
    const OutRows o{F.Y15(), DM, 12};
    small_gemm<12, OutRows>(X, DM, F.WOUT_T(), DM, F.vcu * NWAVES + F.wave, F.G * NWAVES, F.lane, o);
    __syncthreads();
}

__device__ __forceinline__ void p7_row(Frame& F, int row, int lane, bf16* h1row) {
    const GAS bf16x8* y = (const GAS bf16x8*)((const bf16*)(F.out + (size_t)row * DM));
    GAS v4u* xn = (GAS v4u*)(F.XN() + (size_t)row * DM);
    const float ir0 = 1.f / F.R0()[row];
    float hv[32]; float ss = 0.f;
#pragma unroll
    for (int i = 0; i < 4; ++i) { const bf16x8 v = y[lane + 64 * i];
#pragma unroll
        for (int j = 0; j < 8; ++j) { hv[8 * i + j] = bf2f(v[j]); ss += hv[8 * i + j] * hv[8 * i + j]; } }
    const float r1 = 1.f / sqrtf(wave_sum(ss) * (1.f / DM) + EPS); float s2 = 0.f;
#pragma unroll
    for (int i = 0; i < 4; ++i) { const int e0 = (lane + 64 * i) * 8;
        const v4u xq = xn[lane + 64 * i]; const GAS f32x4* gp = (const GAS f32x4*)(FIN(F, 17  ) + e0); const f32x4 g0 = gp[0], g1 = gp[1];
        const float xv[8] = {__builtin_bit_cast(float, xq.x << 16), __builtin_bit_cast(float, xq.x & 0xffff0000u), __builtin_bit_cast(float, xq.y << 16), __builtin_bit_cast(float, xq.y & 0xffff0000u),
                             __builtin_bit_cast(float, xq.z << 16), __builtin_bit_cast(float, xq.z & 0xffff0000u), __builtin_bit_cast(float, xq.w << 16), __builtin_bit_cast(float, xq.w & 0xffff0000u)};
        const float gg[8] = {g0.x, g0.y, g0.z, g0.w, g1.x, g1.y, g1.z, g1.w};
        float hb[8];
#pragma unroll
        for (int j = 0; j < 8; ++j) { hb[j] = xv[j] * ir0 + hv[8 * i + j] * r1 * gg[j]; hv[8 * i + j] = hb[j]; s2 += hb[j] * hb[j]; }
        ((GAS v4u*)h1row)[lane + 64 * i] = pack8(hb);
    }
    const float r2 = 1.f / sqrtf(wave_sum(s2) * (1.f / DM) + EPS);
#pragma unroll
    for (int i = 0; i < 4; ++i) { const int e0 = (lane + 64 * i) * 8; const GAS f32x4* gp = (const GAS f32x4*)(FIN(F, 18  ) + e0); const f32x4 g0 = gp[0], g1 = gp[1];
        float t[8]; t[0] = hv[8 * i + 0] * r2 * g0.x; t[1] = hv[8 * i + 1] * r2 * g0.y; t[2] = hv[8 * i + 2] * r2 * g0.z; t[3] = hv[8 * i + 3] * r2 * g0.w;
        t[4] = hv[8 * i + 4] * r2 * g1.x; t[5] = hv[8 * i + 5] * r2 * g1.y; t[6] = hv[8 * i + 6] * r2 * g1.z; t[7] = hv[8 * i + 7] * r2 * g1.w;
        xn[lane + 64 * i] = pack8(t); }
}
__device__ __forceinline__ void p7_meta_g(Frame& F) {
    LAS float* X = (LAS float*)F.lds;
    for (int r = F.wave; r < 12; r += 8) {
        const float* y = F.Y15() + r * DM; const float* xm = FIN(F, 2  ) + 15 * DM;
        float hv[32]; float ss = 0.f;
#pragma unroll
        for (int i = 0; i < 32; ++i) { hv[i] = y[F.lane + 64 * i]; ss += hv[i] * hv[i]; }
        const float r1 = 1.f / sqrtf(wave_sum(ss) * (1.f / DM) + EPS); float s2 = 0.f;
#pragma unroll
        for (int i = 0; i < 32; ++i) { const int e = F.lane + 64 * i; hv[i] = xm[e] + hv[i] * r1 * FIN(F, 17  )[e]; s2 += hv[i] * hv[i]; }
        const float r2 = 1.f / sqrtf(wave_sum(s2) * (1.f / DM) + EPS);
#pragma unroll
        for (int i = 0; i < 32; ++i) { const int e = F.lane + 64 * i; X[r * DM + e] = hv[i] * r2 * FIN(F, 18  )[e]; }
    }
    __syncthreads();
    const OutRows o{F.G15(), FFN, 12};
    small_gemm<12, OutRows, true>(X, DM, F.WUP_T(), FFN, F.vcu * NWAVES + F.wave, F.G * NWAVES, F.lane, o);
    __syncthreads();
}

__device__ __forceinline__ void p9_fix(Frame& F, int h) {
    constexpr int NOCT = FFN / 8; const int total = 512 * 2 * NOCT;
    const float* cw = FIN(F, 20  ); const float* cb = FIN(F, 21  );
    for (int it = F.vcu * 512 + F.tid; it < total; it += F.G * 512) {
        const int bw = it / NOCT, co = (it - bw * NOCT) * 8, which = bw & 1, B = bw >> 1;
        const int lrow = B * 64 + (which ? 63 : 0), row = h * HROWS + lrow, s = row_seq(row), t = row - seq_first_row(s), S = seq_len(s);
        const float* e = F.EDGE() + (size_t)((B * 2 + which) * 3) * FFN + co;
        float inner[8], self[8], uu[8], outer[8], w0[8], w1[8], w2[8], bb[8];
#define LD8F(dst, p) do { const GAS f32x4* p_ = (const GAS f32x4*)(p); const f32x4 a_ = p_[0], b_ = p_[1]; dst[0] = a_.x; dst[1] = a_.y; dst[2] = a_.z; dst[3] = a_.w; dst[4] = b_.x; dst[5] = b_.y; dst[6] = b_.z; dst[7] = b_.w; } while (0)
        LD8F(inner, e); LD8F(self, e + FFN); LD8F(uu, e + 2 * FFN);
        LD8F(w0, cw + co); LD8F(w1, cw + FFN + co); LD8F(w2, cw + 2 * FFN + co); LD8F(bb, cb + co);
        if (which == 0) { if (t == 0) LD8F(outer, F.G15() + (size_t)s * FFN + co); else LD8F(outer, F.EDGE() + (size_t)(((B - 1) * 2 + 1) * 3 + 1) * FFN + co); }
        else { if (t == S - 1) {
#pragma unroll
                for (int j = 0; j < 8; ++j) outer[j] = 0.f; }
            else LD8F(outer, F.EDGE() + (size_t)(((B + 1) * 2 + 0) * 3 + 1) * FFN + co); }
#undef LD8F
        float o[8];
#pragma unroll
        for (int j = 0; j < 8; ++j) { const float x = which == 0 ? bb[j] + w0[j] * outer[j] + w1[j] * self[j] + w2[j] * inner[j] : bb[j] + w0[j] * inner[j] + w1[j] * self[j] + w2[j] * outer[j];
            o[j] = x * sigmoidf_(x) * uu[j]; }
        *(GAS v4u*)(F.ACT() + (size_t)lrow * FFN + co) = pack8(o);
    }
}
__device__ __forceinline__ void p11_row(Frame& F, int row, int lane, float* obase) {
    const GAS bf16x8* f = (const GAS bf16x8*)((const bf16*)(F.out + (size_t)row * DM));
    const GAS bf16x8* hp = (const GAS bf16x8*)(row < HROWS ? F.H1A() + (size_t)row * DM : F.XN() + (size_t)(row - HROWS) * DM);
    bf16x8 hv[4], fq[4];
#pragma unroll
    for (int i = 0; i < 4; ++i) { hv[i] = hp[lane + 64 * i]; fq[i] = f[lane + 64 * i]; }
    asm volatile("s_waitcnt vmcnt(0)" ::: "memory");
    float fv[32]; float ss = 0.f;
#pragma unroll
    for (int i = 0; i < 4; ++i)
#pragma unroll
        for (int j = 0; j < 8; ++j) { fv[8 * i + j] = bf2f(fq[i][j]); ss += fv[8 * i + j] * fv[8 * i + j]; }
    const float r1 = 1.f / sqrtf(wave_sum(ss) * (1.f / DM) + EPS);
#pragma unroll
    for (int i = 0; i < 4; ++i) { const int e0 = (lane + 64 * i) * 8;
        const GAS f32x4* gp = (const GAS f32x4*)(FIN(F, 23  ) + e0); const f32x4 g0 = gp[0], g1 = gp[1];
        f32x4 h0, h1;
        h0.x = bf2f(hv[i][0]) + fv[8 * i + 0] * r1 * g0.x; h0.y = bf2f(hv[i][1]) + fv[8 * i + 1] * r1 * g0.y; h0.z = bf2f(hv[i][2]) + fv[8 * i + 2] * r1 * g0.z; h0.w = bf2f(hv[i][3]) + fv[8 * i + 3] * r1 * g0.w;
        h1.x = bf2f(hv[i][4]) + fv[8 * i + 4] * r1 * g1.x; h1.y = bf2f(hv[i][5]) + fv[8 * i + 5] * r1 * g1.y; h1.z = bf2f(hv[i][6]) + fv[8 * i + 6] * r1 * g1.z; h1.w = bf2f(hv[i][7]) + fv[8 * i + 7] * r1 * g1.w;
        GAS f32x4* wp = (GAS f32x4*)(obase + (size_t)row * DM + e0); wp[0] = h0; wp[1] = h1; }
}
struct Args { const float* in[24]; float* out; unsigned char* ws; int ph_lo, ph_hi, q_lo, q_hi, use_bar, dummy; };
constexpr int N_PHASES = 12;
__global__ void __launch_bounds__(NWAVES * 64, 2) mk_fwd(Args args) {
    extern __shared__ __attribute__((aligned(16))) unsigned char lds[];
    Frame F;
    F.lds = (LAS unsigned char*)lds;
    F.MISC = (volatile LAS unsigned*)(F.lds + MISC_OFF);
    F.tid = threadIdx.x; F.lane = F.tid & 63; F.wave = __builtin_amdgcn_readfirstlane(F.tid >> 6);
    F.G = gridDim.x; { const int bx = blockIdx.x; F.vcu = (F.G % 8 == 0) ? (bx % 8) * (F.G / 8) + bx / 8 : bx; }
    unsigned char* ws = args.ws;
    F.ctl = (gu32*)(ws + WS_CTL);
    F.kargs = (const __attribute__((address_space(4))) void*)__builtin_amdgcn_kernarg_segment_ptr(); F.ptag = 0; F.out = args.out;
    F.ws = ws;
    for (int u = F.tid; u < (LDS_BYTES - LDSCTL_OFF) / 4; u += NWAVES * 64) ((LAS unsigned*)(F.lds + LDSCTL_OFF))[u] = 0u;
    __syncthreads();
    XcdBarrier bar; bar.bar = (unsigned*)(F.ctl + CW_BAR); bar.x = 0; bar.st = nullptr;
    if (args.use_bar) bar = xcd_barrier_post((unsigned*)(F.ctl + CW_BAR), F.MISC + 8);
    const int lo = args.ph_lo, hi = args.ph_hi;
    const int dmy_ = MK_MULTI ? args.dummy : 0;
#define IN(k) (((MK_PHASE_MASK >> (k)) & 1) && lo <= (k) && (k) < hi)
#define PH_BEGIN(k) do { F.ptag = (k); int t_ = F.tid; asm volatile("" : "+v"(t_)); F.tid = t_; F.lane = t_ & 63; } while (0)
#define PH_BAR() do { if (args.use_bar) xcd_barrier(bar); } while (0)
    const int gw = F.vcu * NWAVES + F.wave, NGW = F.G * NWAVES;

    if (IN(0)) { PH_BEGIN(0); { p0_prologue(F); PH_BAR(); } }
    if (IN(1)) { PH_BEGIN(1); {
        p1_meta_z(F);
        pg8::Gemm g{F.XN(), F.WIN_T(), NTOK, INW, DM}; pg8::StaticOrder S; S.init(NTOK, INW, F.G, (int)blockIdx.x);
        pg8::EpiRoute E{nullptr, 0, 1, F.QG(), F.K(), F.V(), F.XR()};
        pg8::gemm_phase<pg8::EpiRoute, pg8::StaticOrder, true, true>(F.lds, g, S, E);
        PH_BAR();
    } }
    if (IN(2)) { PH_BEGIN(2); { lru_phase<1>(F, nullptr); PH_BAR(); } }
    if (IN(3)) { PH_BEGIN(3); {
        k_rope_pass(F, dmy_ ? (bf16*)F.out : F.K());
        lru_propagate(F);
        if (F.vcu == F.G - 1) p3_meta_job(F);
        PH_BAR();
    } }
    if (IN(4)) { PH_BEGIN(4); {
        const int dm = dmy_;
        if (dm < 2 || dm == 2) lru_phase<2>(F, dm ? (bf16*)F.out : F.QG());
        if (dm < 2 || dm == 3) for (int it = F.vcu; it < 512; it += F.G) metaq_item(F, it);
        if (dm < 2 || dm == 4) attn_phase(F, (char*)lds, dm ? (bf16*)F.out : F.QG());
        PH_BAR();
    } }
    if (IN(5)) { PH_BEGIN(5); {
        p5_ratio(F);
        if (F.vcu >= F.G - 12) p5_meta_job(F, F.G - 1 - F.vcu);
        PH_BAR();
    } }
    if (IN(6)) { PH_BEGIN(6); {
        p6_meta_y(F);
        pg8::Gemm g{F.QG(), F.WOUT_T(), NTOK, DM, DM}; pg8::StaticOrder S; S.init(NTOK, DM, F.G, (int)blockIdx.x);
        pg8::EpiScaled E{(bf16*)F.out, 2 * DM, F.RATIO(), F.RL(), 16};
        pg8::gemm_phase<pg8::EpiScaled, pg8::StaticOrder, true, true>(F.lds, g, S, E);
        PH_BAR();
    } }
#if MK_MULTI
    { const int q = args.q_lo;
#else
#pragma unroll
    for (int q = 0; q < 2; ++q) {
#endif
        if (IN(7)) { PH_BEGIN(7); {
            for (int row = q * HROWS + gw; row < (q + 1) * HROWS; row += NGW) p7_row(F, row, F.lane, (q == 0 ? F.H1A() : F.XN()) + (size_t)(row - q * HROWS) * DM);
            if (q == 0) p7_meta_g(F);
            PH_BAR();
        } }
        if (IN(8)) { PH_BEGIN(8); {
            pg8::Gemm g{F.XN() + (size_t)q * HROWS * DM, F.WUP_T(), HROWS, UPW, DM}; pg8::StaticOrder S; S.init(HROWS, UPW, F.G, (int)blockIdx.x);
            pg8::EpiAct E{F.ACT(), F.EDGE(), FIN(F, 20  ), FIN(F, 21  ), FFN};
            pg8::gemm_phase<pg8::EpiAct, pg8::StaticOrder, true, true>(F.lds, g, S, E);
            PH_BAR();
        } }
        if (IN(9)) { PH_BEGIN(9); { p9_fix(F, q); PH_BAR(); } }
        if (IN(10)) { PH_BEGIN(10); {
            pg8::Gemm g{F.ACT(), F.WDOWN_T(), HROWS, DM, FFN}; pg8::ProbeOrder S; S.init(HROWS, DM, F.G, (int)blockIdx.x); S.pmask = dmy_ == 5 ? 7 : -1;
            pg8::EpiRoute E{(bf16*)F.out + (size_t)q * HROWS * 2 * DM, 2 * DM, 0, nullptr, nullptr, nullptr, nullptr};
            pg8::gemm_phase<pg8::EpiRoute, pg8::ProbeOrder, true, true>(F.lds, g, S, E);
            if (q == 0) PH_BAR();
        } }
    }
    if (IN(10) && IN(11)) PH_BAR();
    if (IN(11)) { PH_BEGIN(11); { for (int row = gw; row < NTOK; row += NGW) p11_row(F, row, F.lane, dmy_ ? (float*)(F.ws + WS_B) : F.out); } }
#undef IN
#undef PH_BAR
}

extern "C" void kernel_launch(void* const* d_in, const int* in_sizes, int n_in, void* d_out, int out_size, void* d_ws, size_t ws_size, hipStream_t stream) {
    static int grid = 0;
    if (grid == 0) {
        if (n_in != 24 || out_size != NTOK * DM || ws_size < WS_END) { fprintf(stderr, "kernel_launch: unexpected shapes (n_in %d out %d ws %zu, need ws >= %zu); nothing launched\n", n_in, out_size, ws_size, (size_t)WS_END); grid = -1; return; }
        int dev = 0, cus = 0;
        if (hipGetDevice(&dev) != hipSuccess || hipDeviceGetAttribute(&cus, hipDeviceAttributeMultiprocessorCount, dev) != hipSuccess) { grid = -1; return; }
        if (hipFuncSetAttribute((const void*)mk_fwd, hipFuncAttributeMaxDynamicSharedMemorySize, LDS_BYTES) != hipSuccess) { fprintf(stderr, "kernel_launch: hipFuncSetAttribute failed\n"); grid = -1; return; }
        int per_cu = 0;
        if (hipOccupancyMaxActiveBlocksPerMultiprocessor(&per_cu, (const void*)mk_fwd, NWAVES * 64, LDS_BYTES) != hipSuccess || per_cu < 1) fprintf(stderr, "kernel_launch: occupancy query reports %d\n", per_cu);
        (void)hipGetLastError();
        grid = cus;
    }
    if (grid < 0) return;
    if (hipMemsetAsync((char*)d_ws + WS_CTL, 0, CTL_ZERO_BYTES, stream) != hipSuccess) return;
    Args a{};
    for (int i = 0; i < 24; ++i) a.in[i] = (const float*)d_in[i];
    a.out = (float*)d_out; a.ws = (unsigned char*)d_ws;
#if MK_MULTI
    a.use_bar = 0;
#define LAUNCH_PH(ph, q) do { a.ph_lo = (ph); a.ph_hi = (ph) + 1; a.q_lo = (q); a.q_hi = (q) + 1; \
        if ((MK_REPEAT_MASK >> (ph)) & 1) { a.dummy = MK_DUMMY_MODE; hipLaunchKernelGGL(mk_fwd, dim3(grid), dim3(NWAVES * 64), LDS_BYTES, stream, a); } \
        a.dummy = 0; hipLaunchKernelGGL(mk_fwd, dim3(grid), dim3(NWAVES * 64), LDS_BYTES, stream, a); } while (0)
    for (int ph = 0; ph < 7; ++ph) LAUNCH_PH(ph, 0);
    for (int q = 0; q < 2; ++q) for (int ph = 7; ph < 11; ++ph) LAUNCH_PH(ph, q);
    LAUNCH_PH(11, 0);
#else
    a.use_bar = 1; a.ph_lo = 0; a.ph_hi = N_PHASES; a.q_lo = 0; a.q_hi = 2;
    hipLaunchKernelGGL(mk_fwd, dim3(grid), dim3(NWAVES * 64), LDS_BYTES, stream, a);
#endif
    const hipError_t le = hipPeekAtLastError();
    if (le != hipSuccess) fprintf(stderr, "kernel_launch: launch failed: %s\n", hipGetErrorName(le));
}
```

```cpp
#include <hip/hip_runtime.h>
#include <cstdio>
#include <cstdint>
#include <cmath>
#ifndef MK_PHASE_MASK
#define MK_PHASE_MASK 0xfff
#endif
#ifndef MK_REPEAT_MASK
#define MK_REPEAT_MASK 0
#endif
#ifndef MK_DUMMY_MODE
#define MK_DUMMY_MODE 1
#endif
#ifndef MK_MULTI
#define MK_MULTI 0
#endif
namespace pg8 {
#define PG8_LAS __attribute__((address_space(3)))
typedef unsigned short bf16_t;
typedef short bf16x8 __attribute__((ext_vector_type(8)));
typedef float f32x4 __attribute__((ext_vector_type(4)));
typedef unsigned u32x4 __attribute__((ext_vector_type(4)));
constexpr int BM = 256, BK = 64, HALF = 128, HTB = HALF * BK * 2  , STAGE_BYTES = 8 * HTB, NXCD = 8, WGM = 8;

__host__ __device__ __forceinline__ int lds_byte(int r, int c) { const int st = (r >> 4) * 2 + (c >> 5), rr = r & 15, cc = c & 31, ob = rr * 64 + cc * 2; return st * 1024 + (ob ^ (((ob >> 9) & 1) << 5)); }
__host__ __device__ __forceinline__ void stage_rc(int b, int& R, int& C) { const int st = b / 1024, sb = b % 1024, swz = sb ^ (((sb >> 9) & 1) << 5); R = (st >> 1) * 16 + swz / 64; C = (st & 1) * 32 + (swz % 64) / 2; }
__host__ __device__ __forceinline__ int perm32(int rho) { const int n = rho >> 4, i = rho & 15; return 8 * (i >> 2) + 4 * n + (i & 3); }

struct Unit { int pm, pn; };
struct Gemm { const bf16_t* A; const bf16_t* Bt; int M, N, K; };

struct StaticOrder {
    int nM, nN, nwg, G, c;
    __host__ __device__ void init(int M, int N, int G_, int c_) { nM = M / BM; nN = N / BM; nwg = nM * nN; G = G_; c = c_; }
    __host__ __device__ bool next(int i, Unit& u) const {
        const long L = (long)i * G + c; if (L >= nwg) return false;
        int wgid = (int)L; { const int q = nwg / NXCD, r = nwg % NXCD, xcd = wgid % NXCD, off = wgid / NXCD; wgid = (xcd < r ? xcd * (q + 1) : r * (q + 1) + (xcd - r) * q) + off; }
        const int nig = WGM * nN, gid = wgid / nig, fm = gid * WGM, gsz = (nM - fm) < WGM ? (nM - fm) : WGM;
        u.pm = fm + ((wgid % nig) % gsz); u.pn = (wgid % nig) / gsz; return true;
    }
    __device__ __forceinline__ void a_ready(const Unit&) const {}
    __device__ __forceinline__ void done(const Unit&) const {}
};

__device__ __forceinline__ unsigned cvt_pk_bf16(float lo, float hi) { unsigned r; asm volatile("v_cvt_pk_bf16_f32 %0, %1, %2" : "=v"(r) : "v"(lo), "v"(hi)); return r; }
struct EpiRoute {
    static constexpr bool PERM = true, AFTER_DRAIN = false, MIDK = false;
    bf16_t* O; int ldc; int mode; bf16_t *QGp, *Kp, *Vp, *XRp;
    __device__ __forceinline__ void operator()(const f32x4 (&acc)[2][2][4][2], const Unit& u, int wr, int wc, int fr, int fq) const {
        bf16_t* base = O; int ld = ldc; int colt = u.pn * BM; int rowadd = 0;
        if (mode == 1) {
            const int pn = u.pn;
            if (pn < 4) { base = QGp; ld = 2048; colt = pn * 256; }
            else if (pn == 4) { base = Kp; ld = 256; colt = 0; }
            else if (pn == 5) { base = Vp; ld = 256; colt = 0; }
            else if (pn < 10) { base = XRp; ld = 1024; colt = (pn - 6) * 256; const int seq = u.pm < 128 ? (u.pm >> 4) : 8 + ((u.pm - 128) >> 5); rowadd = 64 * (seq + 1); }
            else { base = QGp; ld = 2048; colt = 1024 + (pn - 10) * 256; }
        }
        const int row0 = u.pm * BM + wr * 64 + fr + rowadd; const int col0 = colt + wc * 32 + 8 * fq;
#pragma unroll
        for (int ai = 0; ai < 2; ++ai)
#pragma unroll
            for (int m = 0; m < 4; ++m) { bf16_t* rowp = base + (size_t)(row0 + ai * HALF + m * 16) * ld + col0;
#pragma unroll
                for (int bj = 0; bj < 2; ++bj) { const f32x4 v0 = acc[ai][bj][m][0], v1 = acc[ai][bj][m][1];
                    u32x4 w; w.x = cvt_pk_bf16(v0[0], v0[1]); w.y = cvt_pk_bf16(v0[2], v0[3]); w.z = cvt_pk_bf16(v1[0], v1[1]); w.w = cvt_pk_bf16(v1[2], v1[3]);
                    *(u32x4*)(rowp + bj * HALF) = w; } }
    }
};

__device__ __forceinline__ float dpp_shr1(float old, float src) { return __builtin_bit_cast(float, __builtin_amdgcn_update_dpp(__builtin_bit_cast(int, old), __builtin_bit_cast(int, src), 0x111, 0xF, 0xF, false)); }
__device__ __forceinline__ float dpp_shl1(float old, float src) { return __builtin_bit_cast(float, __builtin_amdgcn_update_dpp(__builtin_bit_cast(int, old), __builtin_bit_cast(int, src), 0x101, 0xF, 0xF, false)); }
__device__ __forceinline__ float dpp_ror1(float src)  { return __builtin_bit_cast(float, __builtin_amdgcn_update_dpp(0, __builtin_bit_cast(int, src), 0x121, 0xF, 0xF, false)); }
__device__ __forceinline__ float dpp_ror15(float src) { return __builtin_bit_cast(float, __builtin_amdgcn_update_dpp(0, __builtin_bit_cast(int, src), 0x12F, 0xF, 0xF, false)); }
struct EpiAct {
    static constexpr bool PERM = true, AFTER_DRAIN = false, MIDK = false;
    bf16_t* ACT; float* EDGE; const float* cw; const float* cb; int nch;
    __device__ __forceinline__ void operator()(const f32x4 (&acc)[2][2][4][2], const Unit& u, int wr, int wc, int fr, int fq) const {
        const int ch0 = u.pn * 128 + wc * 32 + 8 * fq;
        float w0[8], w1[8], w2[8], bb[8];
        { const f32x4 a0 = *(const f32x4*)(cw + ch0), a1 = *(const f32x4*)(cw + ch0 + 4), b0 = *(const f32x4*)(cw + nch + ch0), b1 = *(const f32x4*)(cw + nch + ch0 + 4),
                      c0 = *(const f32x4*)(cw + 2 * nch + ch0), c1 = *(const f32x4*)(cw + 2 * nch + ch0 + 4), d0 = *(const f32x4*)(cb + ch0), d1 = *(const f32x4*)(cb + ch0 + 4);
#pragma unroll
          for (int k = 0; k < 4; ++k) { w0[k] = a0[k]; w0[4 + k] = a1[k]; w1[k] = b0[k]; w1[4 + k] = b1[k]; w2[k] = c0[k]; w2[4 + k] = c1[k]; bb[k] = d0[k]; bb[4 + k] = d1[k]; } }
        const int rowb = u.pm * BM + wr * 64;
#pragma unroll
        for (int ai = 0; ai < 2; ++ai) {
            float ein0[8], ein1[8];
#pragma unroll
            for (int m = 0; m < 4; ++m) {
                float o[8];
#pragma unroll
                for (int n = 0; n < 2; ++n)
#pragma unroll
                    for (int k = 0; k < 4; ++k) {
                        const int j = 4 * n + k; const float cur = acc[ai][0][m][n][k];
                        float pold = 0.f, nold = 0.f;
                        if (m > 0) pold = dpp_ror1(acc[ai][0][m > 0 ? m - 1 : 0][n][k]);
                        if (m < 3) nold = dpp_ror15(acc[ai][0][m < 3 ? m + 1 : 3][n][k]);
                        const float prv = dpp_shr1(pold, cur), nxt = dpp_shl1(nold, cur);
                        const float x = bb[j] + w0[j] * prv + w1[j] * cur + w2[j] * nxt;
                        o[j] = x * __builtin_amdgcn_rcpf(1.f + __builtin_amdgcn_exp2f(-1.4426950408889634f * x)) * acc[ai][1][m][n][k];
                        if (m == 0) ein0[j] = nxt;
                        if (m == 3) ein1[j] = prv;
                    }
                u32x4 w; w.x = cvt_pk_bf16(o[0], o[1]); w.y = cvt_pk_bf16(o[2], o[3]); w.z = cvt_pk_bf16(o[4], o[5]); w.w = cvt_pk_bf16(o[6], o[7]);
                *(u32x4*)(ACT + (size_t)(rowb + ai * HALF + m * 16 + fr) * nch + ch0) = w;
            }
            const int blk = (rowb + ai * HALF) >> 6;
            if (fr == 0 || fr == 15) {
                const bool last = fr == 15; float* e = EDGE + (size_t)((blk * 2 + (last ? 1 : 0)) * 3) * nch + ch0;
                f32x4 i0v, i1v, s0v, s1v, u0v, u1v;
#pragma unroll
                for (int k = 0; k < 4; ++k) { i0v[k] = last ? ein1[k] : ein0[k]; i1v[k] = last ? ein1[4 + k] : ein0[4 + k];
                    s0v[k] = last ? acc[ai][0][3][0][k] : acc[ai][0][0][0][k]; s1v[k] = last ? acc[ai][0][3][1][k] : acc[ai][0][0][1][k];
                    u0v[k] = last ? acc[ai][1][3][0][k] : acc[ai][1][0][0][k]; u1v[k] = last ? acc[ai][1][3][1][k] : acc[ai][1][0][1][k]; }
                *(f32x4*)(e) = i0v; *(f32x4*)(e + 4) = i1v; *(f32x4*)(e + nch) = s0v; *(f32x4*)(e + nch + 4) = s1v; *(f32x4*)(e + 2 * nch) = u0v; *(f32x4*)(e + 2 * nch + 4) = u1v;
            }
        }
    }
};

struct ProbeOrder : StaticOrder { int pmask;
    __host__ __device__ bool next(int i, Unit& u) const { const bool r = StaticOrder::next(i, u); u.pm &= pmask; return r; } };

struct EpiScaled {
    static constexpr bool PERM = true, AFTER_DRAIN = false, MIDK = true;
    bf16_t* O; int ldc; const float* ratio; const float* rl; int kt;
    __device__ __forceinline__ void midk(f32x4 (&acc)[2][2][4][2], const Unit& u, int wr, int fr) const {
        asm volatile("" ::: "memory");
        const float* rp = ratio + (u.pm * BM + wr * 64 + fr);
        float s[2][4];
#pragma unroll
        for (int ai = 0; ai < 2; ++ai)
#pragma unroll
            for (int m = 0; m < 4; ++m) s[ai][m] = rp[ai * HALF + m * 16];
#pragma unroll
        for (int ai = 0; ai < 2; ++ai)
#pragma unroll
            for (int m = 0; m < 4; ++m)
#pragma unroll
                for (int bj = 0; bj < 2; ++bj)
#pragma unroll
                    for (int n = 0; n < 2; ++n) acc[ai][bj][m][n] = acc[ai][bj][m][n] * s[ai][m];
        asm volatile("" ::: "memory");
    }
    __device__ __forceinline__ void operator()(const f32x4 (&acc)[2][2][4][2], const Unit& u, int wr, int wc, int fr, int fq) const {
        const int row0 = u.pm * BM + wr * 64 + fr, col0 = u.pn * BM + wc * 32 + 8 * fq;
#pragma unroll
        for (int ai = 0; ai < 2; ++ai)
#pragma unroll
            for (int m = 0; m < 4; ++m) { const int row = row0 + ai * HALF + m * 16; const float s = rl[row]; bf16_t* rowp = O + (size_t)row * ldc + col0;
#pragma unroll
                for (int bj = 0; bj < 2; ++bj) { const f32x4 v0 = acc[ai][bj][m][0] * s, v1 = acc[ai][bj][m][1] * s;
                    u32x4 w; w.x = cvt_pk_bf16(v0[0], v0[1]); w.y = cvt_pk_bf16(v0[2], v0[3]); w.z = cvt_pk_bf16(v1[0], v1[1]); w.w = cvt_pk_bf16(v1[2], v1[3]);
                    *(u32x4*)(rowp + bj * HALF) = w; } }
    }
};

template <class Epi, class Sched, bool ALIGN_EPI = false, bool SP2 = false>
__device__ __forceinline__ void gemm_phase(PG8_LAS unsigned char* lds, const Gemm g, const Sched& S, const Epi& E) {
    int tid_ = threadIdx.x; asm volatile("" : "+v"(tid_));
    const int tid = tid_, wid = __builtin_amdgcn_readfirstlane(tid >> 6), lane = tid & 63, wr = wid >> 2, wc = wid & 3, fr = lane & 15, fq = lane >> 4;
    const int K = g.K, nt = K / BK;
    unsigned voffA[2], voffB[2];
#pragma unroll
    for (int i = 0; i < 2; ++i) { int R, C; stage_rc(tid * 16 + i * 8192, R, C); const int Rb = Epi::PERM ? ((R & ~31) + perm32(R & 31)) : R;
        voffA[i] = (unsigned)(R * K + C) * 2u; voffB[i] = (unsigned)(Rb * K + C) * 2u; }
    const size_t kstep = (size_t)(BK * 2);
    const size_t hstep = (size_t)HALF * K * 2;
    const size_t tstep = 2 * hstep;
    const unsigned ldsw = (unsigned)wid * 1024u;
    const int aoff = lds_byte(wr * 64 + fr, fq * 8), boff = lds_byte(wc * 32 + fr, fq * 8);
#define PG8_SA(b, h) (((b) * 2 + (h)) * HTB)
#define PG8_SB(b, h) ((4 + (b) * 2 + (h)) * HTB)
#define PG8_STAGE(bufoff, gbase, voff) do { _Pragma("unroll") for (int _i = 0; _i < 2; ++_i) \
        __builtin_amdgcn_global_load_lds((const unsigned*)((const char*)(gbase) + (voff)[_i]), (PG8_LAS unsigned*)(lds + (bufoff) + ldsw + _i * 8192), 16, 0, 0); } while (0)
#define PG8_LDA(dst, b, h) do { _Pragma("unroll") for (int m = 0; m < 4; ++m) _Pragma("unroll") for (int k = 0; k < 2; ++k) dst[m][k] = *(const PG8_LAS bf16x8*)(lds + PG8_SA(b, h) + aoff + m * 2048 + k * 1024); } while (0)
#define PG8_LDB(dst, b, h) do { _Pragma("unroll") for (int n = 0; n < 2; ++n) _Pragma("unroll") for (int k = 0; k < 2; ++k) dst[n][k] = *(const PG8_LAS bf16x8*)(lds + PG8_SB(b, h) + boff + n * 2048 + k * 1024); } while (0)
#define PG8_MMA(ai, bj, At, Bt) do { __builtin_amdgcn_s_setprio(1); _Pragma("unroll") for (int m = 0; m < 4; ++m) _Pragma("unroll") for (int n = 0; n < 2; ++n) _Pragma("unroll") for (int k = 0; k < 2; ++k) \
        acc[ai][bj][m][n] = __builtin_amdgcn_mfma_f32_16x16x32_bf16(Bt[n][k], At[m][k], acc[ai][bj][m][n], 0, 0, 0); __builtin_amdgcn_s_setprio(0); } while (0)
#define PG8_WAIT_V(n) asm volatile("s_waitcnt vmcnt(" #n ")" ::: "memory")
#define PG8_WAIT_L(n) asm volatile("s_waitcnt lgkmcnt(" #n ")" ::: "memory")
#define PG8_BAR __builtin_amdgcn_s_barrier()
#define PG8_SCHED __builtin_amdgcn_sched_barrier(0)
    Unit cur, nxt; int ui = 0;
    if (!S.next(0, cur)) return;
    f32x4 acc[2][2][4][2];
#pragma unroll
    for (int a = 0; a < 2; ++a)
#pragma unroll
        for (int b = 0; b < 2; ++b)
#pragma unroll
            for (int m = 0; m < 4; ++m)
#pragma unroll
                for (int n = 0; n < 2; ++n) acc[a][b][m][n] = (f32x4){0.f, 0.f, 0.f, 0.f};
    bf16x8 At[4][2], B0[2][2], B1[2][2];
    const char* cA = (const char*)g.A + (size_t)cur.pm * tstep; const char* cB = (const char*)g.Bt + (size_t)cur.pn * tstep;
    S.a_ready(cur);
    if constexpr (SP2) {
        PG8_STAGE(PG8_SB(0, 0), cB, voffB); PG8_STAGE(PG8_SB(0, 1), cB + hstep, voffB); PG8_STAGE(PG8_SA(0, 0), cA, voffA); PG8_STAGE(PG8_SA(0, 1), cA + hstep, voffA);
        if (wr == 1) PG8_BAR;
        PG8_WAIT_V(2); PG8_BAR;
        PG8_STAGE(PG8_SB(1, 0), cB + kstep, voffB); PG8_STAGE(PG8_SA(1, 0), cA + kstep, voffA); PG8_STAGE(PG8_SB(1, 1), cB + hstep + kstep, voffB);
        PG8_WAIT_V(6); PG8_BAR;
    } else {
        PG8_STAGE(PG8_SB(0, 0), cB, voffB); PG8_STAGE(PG8_SA(0, 0), cA, voffA); PG8_STAGE(PG8_SB(0, 1), cB + hstep, voffB); PG8_STAGE(PG8_SA(0, 1), cA + hstep, voffA);
        if (wr == 1) PG8_BAR;
        PG8_WAIT_V(4); PG8_BAR;
        PG8_STAGE(PG8_SB(1, 0), cB + kstep, voffB); PG8_STAGE(PG8_SA(1, 0), cA + kstep, voffA); PG8_STAGE(PG8_SB(1, 1), cB + hstep + kstep, voffB);
        PG8_WAIT_V(6); PG8_BAR;
    }
    for (;;) {
        const bool has_next = S.next(ui + 1, nxt);
        const char* nA = has_next ? (const char*)g.A + (size_t)nxt.pm * tstep : cA; const char* nB = has_next ? (const char*)g.Bt + (size_t)nxt.pn * tstep : cB;
        for (int t = 0; t < nt; t += 2) {
            if constexpr (Epi::MIDK) { if (t == E.kt) E.midk(acc, cur, wr, fr); }
            const bool last = (t == nt - 2);
            const char* a1 = cA + (size_t)(t + 1) * kstep;
            const char* a2 = last ? nA : cA + (size_t)(t + 2) * kstep; const char* b2 = last ? nB : cB + (size_t)(t + 2) * kstep;
            const char* a3 = a2 + kstep; const char* b3 = b2 + kstep;
            if (last && has_next) S.a_ready(nxt);
            if constexpr (SP2) {
            PG8_LDB(B0, 0, 0); PG8_LDB(B1, 0, 1); PG8_SCHED; PG8_LDA(At, 0, 0); PG8_STAGE(PG8_SA(1, 1), a1 + hstep, voffA);
            PG8_WAIT_V(8); PG8_WAIT_L(0); PG8_BAR; PG8_MMA(0, 0, At, B0); PG8_MMA(0, 1, At, B1); PG8_BAR; PG8_SCHED;
            PG8_LDA(At, 0, 1); PG8_STAGE(PG8_SB(0, 0), b2, voffB); PG8_STAGE(PG8_SB(0, 1), b2 + hstep, voffB); PG8_STAGE(PG8_SA(0, 0), a2, voffA);
            PG8_WAIT_V(8); PG8_WAIT_L(0); PG8_BAR; PG8_MMA(1, 0, At, B0); PG8_MMA(1, 1, At, B1); PG8_BAR; PG8_SCHED;
            PG8_LDB(B0, 1, 0); PG8_LDB(B1, 1, 1); PG8_SCHED; PG8_LDA(At, 1, 0); PG8_STAGE(PG8_SA(0, 1), a2 + hstep, voffA);
            PG8_WAIT_V(8); PG8_WAIT_L(0); PG8_BAR; PG8_MMA(0, 0, At, B0); PG8_MMA(0, 1, At, B1); PG8_BAR; PG8_SCHED;
            PG8_LDA(At, 1, 1); PG8_STAGE(PG8_SB(1, 0), b3, voffB); PG8_STAGE(PG8_SB(1, 1), b3 + hstep, voffB); PG8_STAGE(PG8_SA(1, 0), a3, voffA);
            PG8_WAIT_V(8); PG8_WAIT_L(0); PG8_BAR; PG8_MMA(1, 0, At, B0); PG8_MMA(1, 1, At, B1); PG8_BAR; PG8_SCHED;
            } else {
            PG8_LDB(B0, 0, 0); PG8_SCHED; PG8_LDA(At, 0, 0); PG8_STAGE(PG8_SA(1, 1), a1 + hstep, voffA);
            PG8_WAIT_L(8); PG8_BAR; PG8_WAIT_L(0); PG8_MMA(0, 0, At, B0); PG8_BAR; PG8_SCHED;
            PG8_LDB(B1, 0, 1); PG8_STAGE(PG8_SB(0, 0), b2, voffB);
            PG8_BAR; PG8_WAIT_L(0); PG8_MMA(0, 1, At, B1); PG8_BAR;
            PG8_LDA(At, 0, 1); PG8_STAGE(PG8_SA(0, 0), a2, voffA);
            PG8_BAR; PG8_WAIT_L(0); PG8_MMA(1, 0, At, B0); PG8_BAR; PG8_SCHED;
            PG8_STAGE(PG8_SB(0, 1), b2 + hstep, voffB);
            PG8_WAIT_V(6); PG8_BAR; PG8_MMA(1, 1, At, B1); PG8_BAR;
            PG8_LDB(B0, 1, 0); PG8_SCHED; PG8_LDA(At, 1, 0); PG8_STAGE(PG8_SA(0, 1), a2 + hstep, voffA);
            PG8_WAIT_L(8); PG8_BAR; PG8_WAIT_L(0); PG8_MMA(0, 0, At, B0); PG8_BAR; PG8_SCHED;
            PG8_LDB(B1, 1, 1); PG8_STAGE(PG8_SB(1, 0), b3, voffB);
            PG8_BAR; PG8_WAIT_L(0); PG8_MMA(0, 1, At, B1); PG8_BAR;
            PG8_LDA(At, 1, 1); PG8_STAGE(PG8_SA(1, 0), a3, voffA);
            PG8_BAR; PG8_WAIT_L(0); PG8_MMA(1, 0, At, B0); PG8_BAR; PG8_SCHED;
            PG8_STAGE(PG8_SB(1, 1), b3 + hstep, voffB);
            PG8_WAIT_V(6); PG8_BAR; PG8_MMA(1, 1, At, B1); PG8_BAR;
            }
        }
        if constexpr (ALIGN_EPI) { if (wr == 0) PG8_BAR; }
        if constexpr (!Epi::AFTER_DRAIN) { E(acc, cur, wr, wc, fr, fq); S.done(cur); }
        if (!has_next) break;
#pragma unroll
        for (int a = 0; a < 2; ++a)
#pragma unroll
            for (int b = 0; b < 2; ++b)
#pragma unroll
                for (int m = 0; m < 4; ++m)
#pragma unroll
                    for (int n = 0; n < 2; ++n) acc[a][b][m][n] = (f32x4){0.f, 0.f, 0.f, 0.f};
        cur = nxt; cA = nA; cB = nB; ++ui;
        if constexpr (ALIGN_EPI) { if (wr == 1) PG8_BAR; }
    }
    PG8_WAIT_V(0);
    if constexpr (!ALIGN_EPI) { if (wr == 0) PG8_BAR; }
    PG8_BAR;
    if constexpr (Epi::AFTER_DRAIN) { E.fused(acc, cur, wr, wc, fr, fq, lds, wid, lane); S.done(cur); }
#undef PG8_SA
#undef PG8_SB
#undef PG8_STAGE
#undef PG8_LDA
#undef PG8_LDB
#undef PG8_MMA
#undef PG8_WAIT_V
#undef PG8_WAIT_L
#undef PG8_BAR
#undef PG8_SCHED
}
}
namespace attn {
typedef unsigned short bf16r;
constexpr int   D = 128, NW = 8, QBLK = 32, KVBLK = 64;
constexpr float SCALE = 0.088388347648318440f;
constexpr float THR = 8.f;
constexpr int LDQ = 2048, LDK = 256, LDO = 2048;
constexpr size_t SHM_ATTN = 6 * 16384 + NW * 64 * 4;
using bf16x8 = __attribute__((ext_vector_type(8))) short;
using s16x4  = __attribute__((ext_vector_type(4))) short;
using f32x16 = __attribute__((ext_vector_type(16))) float;
using f32x8  = __attribute__((ext_vector_type(8))) float;
using u32x4  = __attribute__((ext_vector_type(4))) unsigned;
#define KSWZ(row, colB) ((row) * 256 + ((colB) ^ (((row) & 7) << 4)))
#define SBAR() __builtin_amdgcn_sched_barrier(0)
__device__ __forceinline__ int crow(int r, int hi) { return (r & 3) + 8 * (r >> 2) + 4 * hi; }
__device__ __forceinline__ unsigned cvtpk(float lo, float hi) {
  unsigned r; asm volatile("v_cvt_pk_bf16_f32 %0, %1, %2" : "=v"(r) : "v"(lo), "v"(hi)); return r;
}
__device__ __forceinline__ void partialSM(f32x16& p0, f32x16& p1, float& m_reg, float& mn, float& alpha) {
  constexpr float C = SCALE * 1.4426950408889634f;
  float pmax = p0[0]; for (int r = 1; r < 16; ++r) pmax = fmaxf(pmax, p0[r]); for (int r = 0; r < 16; ++r) pmax = fmaxf(pmax, p1[r]);
  { auto rr = __builtin_amdgcn_permlane32_swap(__float_as_uint(pmax), __float_as_uint(pmax), false, false);
    pmax = fmaxf(__uint_as_float(rr[0]), __uint_as_float(rr[1])); }
  if (__builtin_expect(__all(pmax - m_reg <= THR / SCALE), 1)) { mn = m_reg; alpha = 1.f; }
  else { mn = fmaxf(m_reg, pmax); alpha = __builtin_amdgcn_exp2f((m_reg - mn) * C); m_reg = mn; }
  float mnC = -mn * C;
  for (int r = 0; r < 16; ++r) p0[r] = fmaf(p0[r], C, mnC); for (int r = 0; r < 16; ++r) p1[r] = fmaf(p1[r], C, mnC);
  for (int r = 0; r < 16; ++r) p0[r] = __builtin_amdgcn_exp2f(p0[r]);
}
__device__ __forceinline__ void finishSM(f32x16& p0, f32x16& p1, float alpha, float& l_reg, bf16x8& pa0, bf16x8& pa1, bf16x8& pa2, bf16x8& pa3) {
  for (int r = 0; r < 16; ++r) p1[r] = __builtin_amdgcn_exp2f(p1[r]);
  float ps = 0; for (int r = 0; r < 16; ++r) ps += p0[r]; for (int r = 0; r < 16; ++r) ps += p1[r];
  { auto rr = __builtin_amdgcn_permlane32_swap(__float_as_uint(ps), __float_as_uint(ps), false, false);
    ps = __uint_as_float(rr[0]) + __uint_as_float(rr[1]); }
  l_reg = l_reg * alpha + ps;
#define PK4(P, BASE, OUT) do { unsigned a0 = cvtpk(P[BASE + 0], P[BASE + 1]), a1 = cvtpk(P[BASE + 2], P[BASE + 3]);   \
    unsigned b0 = cvtpk(P[BASE + 4], P[BASE + 5]), b1 = cvtpk(P[BASE + 6], P[BASE + 7]);                              \
    auto r0 = __builtin_amdgcn_permlane32_swap(a0, b0, false, false); auto r1 = __builtin_amdgcn_permlane32_swap(a1, b1, false, false); \
    u32x4 w = {r0[0], r1[0], r0[1], r1[1]}; OUT = *reinterpret_cast<bf16x8*>(&w); } while (0)
  PK4(p0, 0, pa0); PK4(p0, 8, pa1); PK4(p1, 0, pa2); PK4(p1, 8, pa3);
#undef PK4
}
__device__ __forceinline__ void qkt(f32x16& p0, f32x16& p1, const bf16r* Ks, const bf16x8* qr, int r32, int hi) {
  p0 = f32x16{}; p1 = f32x16{};
  for (int d0 = 0; d0 < 8; ++d0) { int cb = (d0 * 16 + hi * 8) * 2;
    bf16x8 b0 = *reinterpret_cast<const bf16x8*>((const char*)Ks + KSWZ(r32, cb));
    bf16x8 b1 = *reinterpret_cast<const bf16x8*>((const char*)Ks + KSWZ(32 + r32, cb));
    p0 = __builtin_amdgcn_mfma_f32_32x32x16_bf16(b0, qr[d0], p0, 0, 0, 0);
    p1 = __builtin_amdgcn_mfma_f32_32x32x16_bf16(b1, qr[d0], p1, 0, 0, 0); }
}
__device__ __forceinline__ int v_st(int k, int c) { const int kk = (k & ~0xC) | ((k & 4) << 1) | ((k & 8) >> 1); return ((kk >> 3) * 4 + (c >> 5)) * 512 + ((kk & 7) * 32 + (c & 31)) * 2; }
__device__ __forceinline__ int v_rd_base(int lane) { return ((lane & 3) << 3) | (((lane >> 2) & 3) << 6) | (((lane >> 4) & 1) << 5) | (((lane >> 5) & 1) << 8); }
constexpr int v_rd_off(int d0, int ks, int half) { return d0 * 512 + ks * 4096 + half * 2048; }
template <int OFF> __device__ __forceinline__ s16x4 tr_read(int vb) {
  s16x4 r; asm volatile("ds_read_b64_tr_b16 %0, %1 offset:%2" : "=&v"(r) : "v"(vb), "i"(OFF) : "memory"); return r;
}
template <int D0> __device__ __forceinline__ void pv_one(f32x16& od, int vb, bf16x8 pa0, bf16x8 pa1, bf16x8 pa2, bf16x8 pa3) {
  const s16x4 l0 = tr_read<v_rd_off(D0, 0, 0)>(vb), h0 = tr_read<v_rd_off(D0, 0, 1)>(vb), l1 = tr_read<v_rd_off(D0, 1, 0)>(vb), h1 = tr_read<v_rd_off(D0, 1, 1)>(vb);
  const s16x4 l2 = tr_read<v_rd_off(D0, 2, 0)>(vb), h2 = tr_read<v_rd_off(D0, 2, 1)>(vb), l3 = tr_read<v_rd_off(D0, 3, 0)>(vb), h3 = tr_read<v_rd_off(D0, 3, 1)>(vb);
  asm volatile("s_waitcnt lgkmcnt(0)" ::: "memory"); SBAR();
#define PK(L, H) (bf16x8){L[0], L[1], L[2], L[3], H[0], H[1], H[2], H[3]}
  od = __builtin_amdgcn_mfma_f32_32x32x16_bf16(pa0, PK(l0, h0), od, 0, 0, 0);
  od = __builtin_amdgcn_mfma_f32_32x32x16_bf16(pa1, PK(l1, h1), od, 0, 0, 0);
  od = __builtin_amdgcn_mfma_f32_32x32x16_bf16(pa2, PK(l2, h2), od, 0, 0, 0);
  od = __builtin_amdgcn_mfma_f32_32x32x16_bf16(pa3, PK(l3, h3), od, 0, 0, 0);
#undef PK
}
__device__ __forceinline__ void pv_d0(f32x16* o, int vb, bf16x8 pa0, bf16x8 pa1, bf16x8 pa2, bf16x8 pa3) {
  pv_one<0>(o[0], vb, pa0, pa1, pa2, pa3); pv_one<1>(o[1], vb, pa0, pa1, pa2, pa3); pv_one<2>(o[2], vb, pa0, pa1, pa2, pa3); pv_one<3>(o[3], vb, pa0, pa1, pa2, pa3);
}
constexpr float THRL = 8.f;
__device__ __forceinline__ void qkt2(f32x16& p0, f32x16& p1, const bf16r* Ks, const bf16x8* qr, float nm, int r32, int hi) {
  f32x16 negm;
#pragma unroll
  for (int r = 0; r < 16; ++r) negm[r] = nm;
#pragma unroll
  for (int d0 = 0; d0 < 8; ++d0) { int cb = (d0 * 16 + hi * 8) * 2;
    bf16x8 b0 = *reinterpret_cast<const bf16x8*>((const char*)Ks + KSWZ(r32, cb));
    bf16x8 b1 = *reinterpret_cast<const bf16x8*>((const char*)Ks + KSWZ(32 + r32, cb));
    if (d0 == 0) { p1 = __builtin_amdgcn_mfma_f32_32x32x16_bf16(b1, qr[0], negm, 0, 0, 0); p0 = __builtin_amdgcn_mfma_f32_32x32x16_bf16(b0, qr[0], negm, 0, 0, 0); }
    else { p0 = __builtin_amdgcn_mfma_f32_32x32x16_bf16(b0, qr[d0], p0, 0, 0, 0); p1 = __builtin_amdgcn_mfma_f32_32x32x16_bf16(b1, qr[d0], p1, 0, 0, 0); } }
}
__device__ __forceinline__ void partialSM2(f32x16& p0, f32x16& p1, float& mhat, float& alpha, bool first) {
  float a = __builtin_fmaxf(__builtin_fmaxf(p0[0], p0[1]), p1[0]), b = __builtin_fmaxf(__builtin_fmaxf(p0[2], p0[3]), p1[1]); a = __builtin_fmaxf(__builtin_fmaxf(a, p1[2]), p1[3]);
#pragma unroll
  for (int r = 4; r < 16; r += 4) { a = __builtin_fmaxf(__builtin_fmaxf(a, p0[r]), p0[r + 1]); b = __builtin_fmaxf(__builtin_fmaxf(b, p0[r + 2]), p0[r + 3]); a = __builtin_fmaxf(__builtin_fmaxf(a, p1[r]), p1[r + 1]); b = __builtin_fmaxf(__builtin_fmaxf(b, p1[r + 2]), p1[r + 3]); }
  float pmax = __builtin_fmaxf(a, b);
  { auto rr = __builtin_amdgcn_permlane32_swap(__float_as_uint(pmax), __float_as_uint(pmax), false, false); pmax = __builtin_fmaxf(__uint_as_float(rr[0]), __uint_as_float(rr[1])); }
  alpha = 1.f;
  if (first || __builtin_expect(__any(pmax > THRL), 0)) {
    const float dl = first ? pmax : __builtin_fmaxf(pmax, 0.f);
    mhat += dl;
#pragma unroll
    for (int r = 0; r < 16; ++r) { p0[r] -= dl; p1[r] -= dl; }
    if (!first) alpha = __builtin_amdgcn_exp2f(-dl);
  }
#pragma unroll
  for (int r = 0; r < 16; ++r) p0[r] = __builtin_amdgcn_exp2f(p0[r]);
}
__device__ __forceinline__ void mask_meta(f32x16& p0, f32x16& p1) {
  const float NEG = -INFINITY;
#pragma unroll
  for (int r = 8; r < 16; ++r) p0[r] = NEG;
#pragma unroll
  for (int r = 0; r < 16; ++r) p1[r] = NEG;
}
__device__ __forceinline__ unsigned short f2bf_rne(float f) { unsigned u = __builtin_bit_cast(unsigned, f); return (unsigned short)((u + 0x7fffu + ((u >> 16) & 1u)) >> 16); }

__device__ __forceinline__ void attn_unit(const bf16r* Qb, const bf16r* __restrict__ Kh, const bf16r* __restrict__ Vh,
                                          const bf16r* __restrict__ KMh, const bf16r* __restrict__ VMh, bf16r* Ob, int NT, char* lds,
                                          const float* __restrict__ qnorm, int t0, float* ssq) {
  int tid_ = threadIdx.x; asm volatile("" : "+v"(tid_));
  const int tid = tid_, wid = tid >> 6, lane = tid & 63, r32 = lane & 31, hi = lane >> 5;
  float* ws = (float*)(lds + 6 * 16384) + wid * 64; float* li_l = ws; float* al_l = ws + 32;
  float mhat = 0.f, l_reg = 0; f32x16 o[4] = {}; bf16x8 qr[8];
  const bf16r* Qw = Qb + (long)(wid * QBLK + r32) * LDQ + hi * 8;
#pragma unroll
  for (int d0 = 0; d0 < 8; ++d0) qr[d0] = *reinterpret_cast<const bf16x8*>(Qw + d0 * 16);
  {
    float ss = 0.f;
#pragma unroll
    for (int d0 = 0; d0 < 8; ++d0)
#pragma unroll
      for (int j = 0; j < 8; ++j) { const float x = __builtin_bit_cast(float, (unsigned)(unsigned short)qr[d0][j] << 16); ss += x * x; }
    { auto rr = __builtin_amdgcn_permlane32_swap(__float_as_uint(ss), __float_as_uint(ss), false, false); ss = __uint_as_float(rr[0]) + __uint_as_float(rr[1]); }
    const float rs = (SCALE * 1.4426950408889634f) / sqrtf(ss * (1.f / 128.f) + 1e-6f);
    int t = t0 + wid * QBLK + r32; int hio = hi; asm volatile("" : "+v"(t), "+v"(hio));
#pragma unroll
    for (int g = 0; g < 4; ++g) {
      const int p = g >> 1, dd = g & 1, fa = 4 * p + dd, fb = fa + 2; const float pos = (float)(p ? (t & 63) : (t >> 6));
      const float4 ga0 = *reinterpret_cast<const float4*>(qnorm + fa * 16 + hi * 8), ga1 = *reinterpret_cast<const float4*>(qnorm + fa * 16 + hi * 8 + 4);
      const float4 gb0 = *reinterpret_cast<const float4*>(qnorm + fb * 16 + hi * 8), gb1 = *reinterpret_cast<const float4*>(qnorm + fb * 16 + hi * 8 + 4);
      const float gaf[8] = {ga0.x, ga0.y, ga0.z, ga0.w, ga1.x, ga1.y, ga1.z, ga1.w}, gbf[8] = {gb0.x, gb0.y, gb0.z, gb0.w, gb1.x, gb1.y, gb1.z, gb1.w};
      float oa[8], ob[8];
#pragma unroll
      for (int j = 0; j < 8; ++j) { const int i = 16 * dd + 8 * hio + j;
        float rev = pos * __builtin_amdgcn_exp2f(-(float)i * (13.287712379549449f / 32.f)) * 0.15915494309189535f; rev -= floorf(rev);
        const float sn = __builtin_amdgcn_sinf(rev), cs = __builtin_amdgcn_cosf(rev);
        const float x1 = __builtin_bit_cast(float, (unsigned)(unsigned short)qr[fa][j] << 16) * rs * gaf[j], x2 = __builtin_bit_cast(float, (unsigned)(unsigned short)qr[fb][j] << 16) * rs * gbf[j];
        oa[j] = x1 * cs - x2 * sn; ob[j] = x2 * cs + x1 * sn; }
      { u32x4 w = {cvtpk(oa[0], oa[1]), cvtpk(oa[2], oa[3]), cvtpk(oa[4], oa[5]), cvtpk(oa[6], oa[7])}; qr[fa] = *reinterpret_cast<bf16x8*>(&w); }
      { u32x4 w = {cvtpk(ob[0], ob[1]), cvtpk(ob[2], ob[3]), cvtpk(ob[4], ob[5]), cvtpk(ob[6], ob[7])}; qr[fb] = *reinterpret_cast<bf16x8*>(&w); }
      SBAR();
    }
  }
  unsigned kgo0, kgo1, vgo0, vgo1;
  { const int rk0 = 4 * wid + (lane >> 4), rk1 = rk0 + 32; kgo0 = (unsigned)(rk0 * (LDK * 2) + (((lane & 15) << 4) ^ ((rk0 & 7) << 4))); kgo1 = (unsigned)(rk1 * (LDK * 2) + (((lane & 15) << 4) ^ ((rk1 & 7) << 4)));
    const int kklo = (lane & 31) >> 2, cin = (lane & 3) * 8;
    { const int st = 2 * wid + (lane >> 5), kk = (st >> 2) * 8 + kklo, k = (kk & ~0xC) | ((kk & 4) << 1) | ((kk & 8) >> 1); vgo0 = (unsigned)(k * (LDK * 2) + ((st & 3) * 32 + cin) * 2); }
    { const int st = 2 * (wid + 8) + (lane >> 5), kk = (st >> 2) * 8 + kklo, k = (kk & ~0xC) | ((kk & 4) << 1) | ((kk & 8) >> 1); vgo1 = (unsigned)(k * (LDK * 2) + ((st & 3) * 32 + cin) * 2); } }
  typedef __attribute__((address_space(3))) unsigned char* ldsp_t;
  const ldsp_t lds3 = (ldsp_t)lds;
  const int w1k = __builtin_amdgcn_readfirstlane(wid) * 1024;
  constexpr int VRING = 3 * 16384;
#define DMAK(t, soff) do { const char* b_ = (const char*)((t) == 0 ? KMh : Kh + (long)((t) - 1) * KVBLK * LDK); \
    __builtin_amdgcn_global_load_lds((const unsigned*)(b_ + kgo0), (__attribute__((address_space(3))) unsigned*)(lds3 + (soff) + w1k), 16, 0, 0); \
    __builtin_amdgcn_global_load_lds((const unsigned*)(b_ + kgo1), (__attribute__((address_space(3))) unsigned*)(lds3 + (soff) + w1k + 8192), 16, 0, 0); } while (0)
#define DMAV(t, soff) do { const char* b_ = (const char*)((t) == 0 ? VMh : Vh + (long)((t) - 1) * KVBLK * LDK); \
    __builtin_amdgcn_global_load_lds((const unsigned*)(b_ + vgo0), (__attribute__((address_space(3))) unsigned*)(lds3 + VRING + (soff) + w1k), 16, 0, 0); \
    __builtin_amdgcn_global_load_lds((const unsigned*)(b_ + vgo1), (__attribute__((address_space(3))) unsigned*)(lds3 + VRING + (soff) + w1k + 8192), 16, 0, 0); } while (0)
#define WAITBAR(N) asm volatile("s_waitcnt vmcnt(" #N ") lgkmcnt(0)\n\ts_barrier" ::: "memory")
#define ROT() do { const int t_ = sm1; sm1 = sc_; sc_ = sp1; sp1 = t_; } while (0)
#define RESC(a) do { if (__any((a) < 1.f)) { if (hi == 0) al_l[r32] = (a); asm volatile("s_waitcnt lgkmcnt(0)" ::: "memory"); \
    _Pragma("unroll") for (int r = 0; r < 16; ++r) { const float a_ = al_l[crow(r, hi)]; o[0][r] *= a_; o[1][r] *= a_; o[2][r] *= a_; o[3][r] *= a_; asm volatile("" : "+v"(o[0][r]), "+v"(o[1][r]), "+v"(o[2][r]), "+v"(o[3][r])); } } } while (0)
  const int vb0 = (int)(uintptr_t)(lds + VRING) + v_rd_base(lane);
  int sm1 = 32768, sc_ = 0, sp1 = 16384;
  f32x16 pA0, pA1, pB0, pB1; float alA, alB; bf16x8 pa0, pa1, pa2, pa3;
  DMAK(0, 0); DMAV(0, 0); DMAK(1, 16384);
  WAITBAR(2);
  DMAK(2, sm1); DMAV(1, sp1);
  qkt2(pA0, pA1, (const bf16r*)(lds + sc_), qr, -mhat, r32, hi); mask_meta(pA0, pA1); partialSM2(pA0, pA1, mhat, alA, true);
  WAITBAR(4); ROT();
  for (int t = 1; t + 1 < NT; t += 2) {
    if (t + 2 < NT) DMAK(t + 2, sm1); DMAV(t + 1, sp1);
    SBAR(); qkt2(pB0, pB1, (const bf16r*)(lds + sc_), qr, -mhat, r32, hi);
    finishSM(pA0, pA1, alA, l_reg, pa0, pa1, pa2, pa3); SBAR();
    pv_d0(o, vb0 + sm1, pa0, pa1, pa2, pa3); partialSM2(pB0, pB1, mhat, alB, false);
    if (t + 2 < NT) WAITBAR(4); else WAITBAR(2);
    RESC(alB); ROT();
    if (t + 3 < NT) DMAK(t + 3, sm1); if (t + 2 < NT) DMAV(t + 2, sp1);
    SBAR(); qkt2(pA0, pA1, (const bf16r*)(lds + sc_), qr, -mhat, r32, hi);
    finishSM(pB0, pB1, alB, l_reg, pa0, pa1, pa2, pa3); SBAR();
    pv_d0(o, vb0 + sm1, pa0, pa1, pa2, pa3); partialSM2(pA0, pA1, mhat, alA, false);
    if (t + 3 < NT) WAITBAR(4); else if (t + 2 < NT) WAITBAR(2); else WAITBAR(0);
    RESC(alA); ROT();
  }
  finishSM(pA0, pA1, alA, l_reg, pa0, pa1, pa2, pa3); SBAR();
  pv_d0(o, vb0 + sm1, pa0, pa1, pa2, pa3);
  if (hi == 0) li_l[r32] = l_reg; asm volatile("s_waitcnt lgkmcnt(0)" ::: "memory");
  float rli[16];
#pragma unroll
  for (int r = 0; r < 16; ++r) rli[r] = __builtin_amdgcn_rcpf(li_l[crow(r, hi)]);
  bf16r* Ow = Ob + (long)(wid * QBLK) * LDO;
#pragma unroll
  for (int r = 0; r < 16; ++r) { const int orow = crow(r, hi);
    float sq = 0.f;
#pragma unroll
    for (int d0 = 0; d0 < 4; ++d0) { const float v = o[d0][r] * rli[r]; sq += v * v; Ow[(long)orow * LDO + d0 * 32 + r32] = f2bf_rne(v); }
    sq += __shfl_xor(sq, 1); sq += __shfl_xor(sq, 2); sq += __shfl_xor(sq, 4); sq += __shfl_xor(sq, 8); sq += __shfl_xor(sq, 16);
    if (r32 == 0) ssq[(long)(wid * QBLK + orow) * 8] = sq; }
  WAITBAR(0);
#undef DMAK
#undef DMAV
#undef WAITBAR
#undef ROT
#undef RESC
}
#undef KSWZ
#undef SBAR
}

constexpr int NWAVES = 8;
constexpr int DM = 2048, NTOK = 65536, INW = 3584, FFN = 5632, UPW = 2 * FFN;
constexpr float EPS = 1e-6f;
constexpr int XR_ROWS = 8 * 4160 + 4 * 8256;
constexpr int NCHUNK = 8 * 65 + 4 * 129;
constexpr int HROWS = 32768;
__host__ __device__ __forceinline__ int seq_first_row(int s) { return s < 8 ? s * 4096 : 32768 + (s - 8) * 8192; }
__host__ __device__ __forceinline__ int seq_len(int s) { return s < 8 ? 4096 : 8192; }
__host__ __device__ __forceinline__ int xr_base(int s) { return s < 8 ? s * 4160 : 33280 + (s - 8) * 8256; }
__host__ __device__ __forceinline__ int chunk_base(int s) { return s < 8 ? s * 65 : 520 + (s - 8) * 129; }
__host__ __device__ __forceinline__ int row_seq(int row) { return row < 32768 ? (row >> 12) : 8 + ((row - 32768) >> 13); }

constexpr size_t MiB = 1u << 20, KiB = 1u << 10;
constexpr size_t WS_CTL = 0, CTL_ZERO_BYTES = 1 * MiB;
constexpr size_t WS_SMALL = 1 * MiB;
constexpr size_t WS_XNMETA = WS_SMALL + 0, WS_ZM = WS_SMALL + 64 * KiB, WS_KM = WS_SMALL + 320 * KiB, WS_VM = WS_SMALL + 352 * KiB, WS_Q15 = WS_SMALL + 384 * KiB, WS_GY15 = WS_SMALL + 388 * KiB,
                 WS_LO15 = WS_SMALL + 392 * KiB, WS_MIXED15 = WS_SMALL + 448 * KiB, WS_Y15 = WS_SMALL + 544 * KiB, WS_G15 = WS_SMALL + 640 * KiB, WS_MQP = WS_SMALL + 1024 * KiB;
constexpr size_t WS_WIN = 5 * MiB, WS_WOUT = 19 * MiB, WS_WUP = 27 * MiB, WS_WDOWN = 71 * MiB, WS_WG = 93 * MiB;
constexpr size_t WS_CAR = 94 * MiB, WS_CIN = 111 * MiB;
constexpr size_t WS_R0 = 120 * MiB, WS_RATIO = 120 * MiB + 256 * KiB, WS_RL = 120 * MiB + 512 * KiB, WS_SSQA = 121 * MiB, WS_SSQL = 123 * MiB;
constexpr size_t WS_A = 128 * MiB;
constexpr size_t WS_B = 384 * MiB;
constexpr size_t WS_QG = WS_B, WS_K = WS_B + 256 * MiB, WS_V = WS_B + 288 * MiB, WS_XR = WS_B + 320 * MiB;
constexpr size_t WS_ACT = WS_B, WS_EDGE = WS_B + 352 * MiB;
constexpr size_t WS_H1A = WS_B + 420 * MiB;
constexpr size_t WS_END = WS_B + 548 * MiB;
static_assert(WS_ZM + 16 * INW * 4 <= WS_KM && WS_G15 + 12 * FFN * 4 <= WS_MQP && WS_MQP + 512 * 4 * 132 * 4 <= WS_WIN, "small map");
static_assert(WS_WIN + (size_t)INW * DM * 2 <= WS_WOUT && WS_WOUT + (size_t)DM * DM * 2 <= WS_WUP && WS_WUP + (size_t)UPW * DM * 2 <= WS_WDOWN && WS_WDOWN + (size_t)DM * FFN * 2 <= WS_WG && WS_WG + 32 * 16384 * 2 <= WS_CAR, "weights map");
static_assert(WS_CAR + (size_t)NCHUNK * 2 * 1024 * 8 <= WS_CIN && WS_A + (size_t)NTOK * DM * 2 <= WS_B, "carry map");
static_assert(WS_QG + (size_t)NTOK * DM * 2 <= WS_K && WS_XR + (size_t)(XR_ROWS + 64) * 1024 * 2 <= WS_END && WS_EDGE + (size_t)512 * 2 * 3 * FFN * 4 <= WS_H1A && WS_H1A + (size_t)HROWS * DM * 2 <= WS_END && WS_END <= 1024 * MiB && WS_CIN + (size_t)NCHUNK * 2 * 1024 * 4 <= WS_R0 && WS_SSQL + (size_t)NTOK * 8 * 4 <= WS_A && WS_ACT + (size_t)HROWS * FFN * 2 <= WS_EDGE && WS_EDGE + (size_t)512 * 2 * 3 * FFN * 4 <= WS_END, "B map");
constexpr int CW_BAR = 4096;

constexpr int RING_BYTES = 131072;
constexpr int LDSCTL_OFF = RING_BYTES, MISC_OFF = LDSCTL_OFF + 320;
constexpr int LDS_BYTES = 147456;

#define GAS __attribute__((address_space(1)))
#define LAS __attribute__((address_space(3)))
typedef unsigned short bf16;
typedef unsigned v4u __attribute__((ext_vector_type(4)));
typedef float f32x4 __attribute__((ext_vector_type(4)));
typedef short bf16x8 __attribute__((ext_vector_type(8)));
typedef GAS unsigned gu32;
typedef GAS unsigned long long gu64;
#define RLX_AGENT __ATOMIC_RELAXED, __HIP_MEMORY_SCOPE_AGENT
#define LDS_WAIT() asm volatile("s_waitcnt lgkmcnt(0)" ::: "memory")
#define VM_WAIT() asm volatile("s_waitcnt vmcnt(0)" ::: "memory")
__device__ __forceinline__ unsigned long long rt() { return __builtin_amdgcn_s_memrealtime(); }
__device__ __forceinline__ unsigned f2bf(float f) { unsigned u = __builtin_bit_cast(unsigned, f); return (u + 0x7fffu + ((u >> 16) & 1u)) >> 16; }
__device__ __forceinline__ unsigned pk2(float lo, float hi) { return f2bf(lo) | (f2bf(hi) << 16); }

#define XB_TMO      128
#define XB_XCNT(j)  (256  + 64 * (j))
#define XB_XSUB(j)  (1280 + 64 * (j))
#define XB_XGEN(j)  (2304 + 64 * (j))
#define XB_TOP      3328
#define XB_TOPGEN   3392
#define XCD_BAR_WORDS 3456
#define XB_SPIN_CAP (1u << 18)

__device__ __forceinline__ unsigned xb_ld(unsigned* p)              { return __hip_atomic_load(p, __ATOMIC_RELAXED, __HIP_MEMORY_SCOPE_AGENT); }
__device__ __forceinline__ unsigned xb_add(unsigned* p, unsigned v) { return __hip_atomic_fetch_add(p, v, __ATOMIC_RELAXED, __HIP_MEMORY_SCOPE_AGENT); }
__device__ __forceinline__ unsigned xb_xcc_id() { return (unsigned)__builtin_amdgcn_s_getreg((3 << 11) | 20) & 0xFu; }
#define XB_SPIN(cond, bar) do { unsigned _sp = 0; while (cond) { __builtin_amdgcn_s_sleep(1); \
    if ((++_sp & 255u) == 0u) { if (xb_ld(&(bar)[XB_TMO])) break; if (_sp > XB_SPIN_CAP) { atomicAdd(&(bar)[XB_TMO], 1u); break; } } } } while (0)

struct XcdBarrier {
    unsigned* bar; unsigned x;
    volatile LAS unsigned* st;
};

__device__ __forceinline__ XcdBarrier xcd_barrier_post(unsigned* bar, volatile LAS unsigned* st) {
    XcdBarrier b; b.bar = bar; b.x = xb_xcc_id(); b.st = st;
    if (threadIdx.x == 0) (void)xb_add(&bar[XB_XCNT(b.x)], 1u);
    return b;
}
__device__ __forceinline__ void xcd_barrier_complete(unsigned* bar, unsigned x, unsigned& nloc, unsigned& nx) {
    const unsigned G = gridDim.x * gridDim.y * gridDim.z;
    unsigned sum, cnt, mine, sp = 0u;
    for (;;) {
        sum = 0u; cnt = 0u; mine = 0u;
#pragma unroll
        for (unsigned j = 0; j < 16; ++j) { const unsigned c = xb_ld(&bar[XB_XCNT(j)]); sum += c; cnt += (c > 0u) ? 1u : 0u; mine = (j == x) ? c : mine; }
        if (sum == G) break;
        __builtin_amdgcn_s_sleep(1);
        if ((++sp & 255u) == 0u) { if (xb_ld(&bar[XB_TMO])) break; if (sp > XB_SPIN_CAP) { atomicAdd(&bar[XB_TMO], 1u); break; } }
    }
    nloc = mine > 0u ? mine : 1u; nx = cnt > 0u ? cnt : 1u;
}

__device__ __forceinline__ void xcd_barrier(const XcdBarrier& b) {
    asm volatile("s_waitcnt vmcnt(0)" ::: "memory");
    __syncthreads();
    if (threadIdx.x == 0) {
        unsigned* bar = b.bar;
        __builtin_amdgcn_s_waitcnt(0);
        unsigned nloc = b.st[0], nx = b.st[1];
        if (nloc == 0u) { xcd_barrier_complete(bar, b.x, nloc, nx); b.st[0] = nloc; b.st[1] = nx; }
        const unsigned old = xb_add(&bar[XB_XSUB(b.x)], 1u);
        const unsigned gen = old / nloc;
        if (old + 1u == (gen + 1u) * nloc) {
            __builtin_amdgcn_fence(__ATOMIC_RELEASE, "agent");
            asm volatile("s_waitcnt vmcnt(0)" ::: "memory");
            const unsigned og = xb_add(&bar[XB_TOP], 1u);
            const unsigned tg = og / nx;
            if (og + 1u == (tg + 1u) * nx) xb_add(&bar[XB_TOPGEN], 1u);
            else XB_SPIN(xb_ld(&bar[XB_TOPGEN]) == tg, bar);
            __builtin_amdgcn_fence(__ATOMIC_ACQUIRE, "agent");
            xb_add(&bar[XB_XGEN(b.x)], 1u);
            asm volatile("s_waitcnt vmcnt(0)" ::: "memory");
        } else {
            XB_SPIN(xb_ld(&bar[XB_XGEN(b.x)]) == gen, bar);
            __builtin_amdgcn_fence(__ATOMIC_ACQUIRE, "agent");
            asm volatile("s_waitcnt vmcnt(0)" ::: "memory");
        }
    }
    __syncthreads();
}

__device__ __forceinline__ float bf2f(unsigned short b) { return __builtin_bit_cast(float, (unsigned)b << 16); }
__device__ __forceinline__ float bf2f(short b) { return __builtin_bit_cast(float, (unsigned)(unsigned short)b << 16); }
__device__ __forceinline__ float wave_sum(float v) {
#pragma unroll
    for (int o = 1; o < 64; o <<= 1) v += __shfl_xor(v, o);
    return v;
}
__device__ __forceinline__ float wave_max(float v) {
#pragma unroll
    for (int o = 1; o < 64; o <<= 1) v = fmaxf(v, __shfl_xor(v, o));
    return v;
}
__device__ __forceinline__ float fast_exp(float x) { return __builtin_amdgcn_exp2f(x * 1.4426950408889634f); }
__device__ __forceinline__ float sigmoidf_(float x) { return __builtin_amdgcn_rcpf(1.f + fast_exp(-x)); }
__device__ __forceinline__ float gelu_tanh(float x) {
    const float z = 0.7978845608028654f * (x + 0.044715f * x * x * x);
    return x * sigmoidf_(2.f * z);
}
__device__ __forceinline__ float neg_expm1(float x) {
    const float p = x * (1.f + x * (0.5f + x * (0.16666667f + x * (0.041666668f + x * (0.0083333338f + x * 0.0013888889f)))));
    const float e = fast_exp(x) - 1.f;
    return -(fabsf(x) < 0.25f ? p : e);
}
__device__ __forceinline__ v4u pack8(const float (&v)[8]) { v4u o; o.x = pk2(v[0], v[1]); o.y = pk2(v[2], v[3]); o.z = pk2(v[4], v[5]); o.w = pk2(v[6], v[7]); return o; }

#define FIN(F, idx) ({ const __attribute__((address_space(1))) float* p_; asm("s_load_dwordx2 %0, %1, %2 ; tag %3\n\ts_waitcnt lgkmcnt(0)" : "=s"(p_) : "s"((F).kargs), "i"((idx) * 8), "s"((F).ptag)); (const float*)p_; })
struct Frame {
    LAS unsigned char* lds;
    volatile LAS unsigned* MISC;
    gu32* ctl;
    int tid, lane, wave, vcu, G;
    const __attribute__((address_space(4))) void* kargs; int ptag;
    float* out;
    unsigned char* ws;
#define WSP(T, NAME, OFF) __device__ __forceinline__ T* NAME() const { return (T*)(ws + (OFF)); }
    WSP(bf16, WIN_T, WS_WIN) WSP(bf16, WOUT_T, WS_WOUT) WSP(bf16, WUP_T, WS_WUP) WSP(bf16, WDOWN_T, WS_WDOWN) WSP(bf16, WG, WS_WG) WSP(bf16, XN, WS_A) WSP(bf16, QG, WS_QG) WSP(bf16, K, WS_K) WSP(bf16, V, WS_V)
    WSP(bf16, XR, WS_XR) WSP(bf16, ACT, WS_ACT) WSP(bf16, H1A, WS_H1A) WSP(float, EDGE, WS_EDGE) WSP(bf16, XNMETA, WS_XNMETA) WSP(bf16, KM, WS_KM) WSP(bf16, VM, WS_VM)
    WSP(float, ZM, WS_ZM) WSP(float, Q15, WS_Q15) WSP(float, GY15, WS_GY15) WSP(float, LO15, WS_LO15) WSP(float, MIXED15, WS_MIXED15) WSP(float, Y15, WS_Y15) WSP(float, G15, WS_G15) WSP(float, MQP, WS_MQP)
    WSP(float, CIN, WS_CIN) WSP(float2, CAR, WS_CAR) WSP(float, R0, WS_R0) WSP(float, RATIO, WS_RATIO) WSP(float, RL, WS_RL) WSP(float, SSQA, WS_SSQA) WSP(float, SSQL, WS_SSQL)
#undef WSP
};

template <bool UPMAP, int GAIN = 0>
__device__ __forceinline__ void p0_transpose_item(const float* W, int K, int N, bf16* WT, int row_off, LAS float* scr, int item, int lane, const float* g0 = nullptr, const float* g1 = nullptr) {
    const int nblk = N / 32, kb = item / nblk, nb = item % nblk, k0 = 64 * kb, n0 = 32 * nb;
    const int orow0 = UPMAP ? (((n0 % FFN) >> 7) << 8) + 128 * (n0 / FFN) + ((n0 % FFN) & 127) : row_off + n0;
    float wv[32];
#pragma unroll
    for (int i = 0; i < 32; ++i) { const int kk = 2 * i + (lane >> 5); wv[i] = W[(size_t)(k0 + kk) * N + n0 + (lane & 31)]; }
#pragma unroll
    for (int i = 0; i < 32; ++i) { const int kk = 2 * i + (lane >> 5); float gv = 1.f; if (GAIN == 1) gv = g0[k0 + kk]; if (GAIN == 2) gv = (k0 + kk) < 1024 ? g0[k0 + kk] : g1[k0 + kk - 1024];
        scr[kk * 33 + (lane & 31)] = wv[i] * gv; }
    LDS_WAIT(); asm volatile("" ::: "memory");
    const int c = lane & 7;
#pragma unroll
    for (int j = 0; j < 4; ++j) { const int n = (lane >> 3) + 8 * j; const LAS float* s = scr + (8 * c) * 33 + n;
        v4u o; o.x = pk2(s[0 * 33], s[1 * 33]); o.y = pk2(s[2 * 33], s[3 * 33]); o.z = pk2(s[4 * 33], s[5 * 33]); o.w = pk2(s[6 * 33], s[7 * 33]);
        *(GAS v4u*)(WT + (size_t)(orow0 + n) * K + k0 + 8 * c) = o; }
    LDS_WAIT(); asm volatile("" ::: "memory");
}
__device__ __forceinline__ void rms_row_to_bf16(const float* xrow, bf16* orow, int lane, float* rout) {
    const GAS f32x4* xr = (const GAS f32x4*)xrow + lane;
    f32x4 v[8]; float s = 0.f;
#pragma unroll
    for (int j = 0; j < 8; ++j) { v[j] = xr[64 * j]; s += (v[j].x * v[j].x + v[j].y * v[j].y) + (v[j].z * v[j].z + v[j].w * v[j].w); }
    const float r = 1.f / sqrtf(wave_sum(s) * (1.f / DM) + EPS);
    GAS unsigned long long* o8 = (GAS unsigned long long*)orow + lane;
#pragma unroll
    for (int j = 0; j < 8; ++j) o8[64 * j] = (unsigned long long)pk2(v[j].x * r, v[j].y * r) | ((unsigned long long)pk2(v[j].z * r, v[j].w * r) << 32);
    if (rout && lane == 0) *rout = r;
}
__device__ __forceinline__ void p0_prologue(Frame& F) {
    LAS float* scr = (LAS float*)(F.lds + F.wave * 16384);
    const int gw = F.vcu * NWAVES + F.wave, NGW = F.G * NWAVES;
    constexpr int I_IN = (DM / 64) * (INW / 32), I_OUT = (DM / 64) * (DM / 32), I_UP = (DM / 64) * (UPW / 32), I_DN = (FFN / 64) * (DM / 32), I_G = 32 * 8;
    constexpr int NITEMS = I_IN + I_OUT + I_UP + I_DN + I_G;
    for (int it = gw; it < NITEMS; it += NGW) {
        int r = it;
        if (r < I_IN) { p0_transpose_item<false, 1>(FIN(F, 4  ), DM, INW, F.WIN_T(), 0, scr, r, F.lane, FIN(F, 3  )); continue; } r -= I_IN;
        if (r < I_OUT) { p0_transpose_item<false, 2>(FIN(F, 16  ), DM, DM, F.WOUT_T(), 0, scr, r, F.lane, FIN(F, 14  ), FIN(F, 15  )); continue; } r -= I_OUT;
        if (r < I_UP) { p0_transpose_item<true>(FIN(F, 19  ), DM, UPW, F.WUP_T(), 0, scr, r, F.lane); continue; } r -= I_UP;
        if (r < I_DN) { p0_transpose_item<false>(FIN(F, 22  ), FFN, DM, F.WDOWN_T(), 0, scr, r, F.lane); continue; } r -= I_DN;
        {
            const int mi = r >> 3, sub = r & 7, gate = mi >> 4, dir = (mi >> 3) & 1, blk = mi & 7;
            const float* W = (gate ? FIN(F, 11  ) : FIN(F, 9  )) + (size_t)(dir * 8 + blk) * 16384;
            bf16* WT = F.WG() + (size_t)((dir * 2 + gate) * 8 + blk) * 16384;
            p0_transpose_item<false>(W, 128, 128, WT, 0, scr, sub, F.lane);
        }
    }
    for (int m = gw; m < NTOK; m += NGW) {
        const float* xr = m < 32768 ? FIN(F, 0  ) + (size_t)m * DM : FIN(F, 1  ) + (size_t)(m - 32768) * DM;
        rms_row_to_bf16(xr, F.XN() + (size_t)m * DM, F.lane, F.R0() + m);
    }
    for (int m = gw; m < 16; m += NGW) rms_row_to_bf16(FIN(F, 2  ) + (size_t)m * DM, F.XNMETA() + (size_t)m * DM, F.lane, nullptr);
    const int gt = F.vcu * 512 + F.tid, NGT = F.G * 512; const v4u z4 = {0u, 0u, 0u, 0u};
    for (int i = gt; i < 12 * 48 * 128; i += NGT) { const int s = i / (48 * 128), rem = i % (48 * 128); ((GAS v4u*)(F.XR() + (size_t)xr_base(s) * 1024))[rem] = z4; }
    for (int i = gt; i < 64 * 128; i += NGT) ((GAS v4u*)(F.XR() + (size_t)XR_ROWS * 1024))[i] = z4;
    for (int i = gt; i < 2048; i += NGT) { ((GAS v4u*)F.KM())[i] = z4; ((GAS v4u*)F.VM())[i] = z4; }
}

template <int R, class Out, bool GMAP = false>
__device__ __forceinline__ void small_gemm(const LAS float* X, int K, const bf16* Wt, int N, int gw, int NGW, int lane, const Out& out) {
    for (int n = gw; n < N; n += NGW) {
        float acc[R];
#pragma unroll
        for (int r = 0; r < R; ++r) acc[r] = 0.f;
        const GAS bf16x8* wrow = (const GAS bf16x8*)(Wt + (size_t)(GMAP ? ((n >> 7) << 8) + (n & 127) : n) * K);
        for (int k8 = lane; k8 < K / 8; k8 += 64) {
            const bf16x8 w = wrow[k8]; float wf[8];
#pragma unroll
            for (int j = 0; j < 8; ++j) wf[j] = bf2f(w[j]);
#pragma unroll
            for (int r = 0; r < R; ++r) { const LAS f32x4* xp = (const LAS f32x4*)(X + r * K + k8 * 8); const f32x4 a = xp[0], b = xp[1];
                acc[r] += (a.x * wf[0] + a.y * wf[1]) + (a.z * wf[2] + a.w * wf[3]) + (b.x * wf[4] + b.y * wf[5]) + (b.z * wf[6] + b.w * wf[7]); }
        }
        float v = 0.f;
#pragma unroll
        for (int r = 0; r < R; ++r) { const float s = wave_sum(acc[r]); v = (lane == r) ? s : v; }
        out(n, lane, v);
    }
}
struct OutMetaZ { float* ZM; bf16* XR;
    __device__ __forceinline__ void operator()(int n, int lane, float v) const {
        if (lane < 16) { ZM[lane * INW + n] = v;
            if (n >= 1536 && n < 2560) { const unsigned short b = (unsigned short)f2bf(v); const int c = n - 1536;
                for (int s = 0; s < 12; ++s) XR[(size_t)(xr_base(s) + 48 + lane) * 1024 + c] = b; } }
    } };
struct OutRows { float* Y; int ld; int R;
    __device__ __forceinline__ void operator()(int n, int lane, float v) const { if (lane < R) Y[(size_t)lane * ld + n] = v; } };

__device__ __forceinline__ void p1_meta_z(Frame& F) {
    LAS float* X = (LAS float*)F.lds;
    for (int i = F.tid; i < 16 * DM / 8; i += 512) { const bf16x8 v = ((const GAS bf16x8*)F.XNMETA())[i];
        ((LAS f32x4*)X)[2 * i] = (f32x4){bf2f(v[0]), bf2f(v[1]), bf2f(v[2]), bf2f(v[3])}; ((LAS f32x4*)X)[2 * i + 1] = (f32x4){bf2f(v[4]), bf2f(v[5]), bf2f(v[6]), bf2f(v[7])}; }
    __syncthreads();
    const OutMetaZ o{F.ZM(), F.XR()};
    small_gemm<16, OutMetaZ>(X, DM, F.WIN_T(), INW, F.vcu * NWAVES + F.wave, F.G * NWAVES, F.lane, o);
    __syncthreads();
}
typedef float f32x16 __attribute__((ext_vector_type(16)));
constexpr int LRU_XC0 = 0, LRU_XC_BUF = 17408, LRU_XC_STRIDE = 272;
constexpr int LRU_CW = 34816;
constexpr int LRU_HF = 37376, LRU_HB = LRU_HF + 32768;
__device__ __forceinline__ int crow16(int r, int hi) { return (r & 3) + 8 * (r >> 2) + 4 * hi; }

template <int DIR>
__device__ __forceinline__ void scan_tile(const float (&a)[16], const float (&u)[16], float& carry, float& ptot, float (&h)[16], bool up) {
    float HL[16], PL[16], As[4], Hs[4];
#pragma unroll
    for (int j = 0; j < 4; ++j) {
        float hl = 0.f, p = 1.f;
#pragma unroll
        for (int ii = 0; ii < 4; ++ii) { const int idx = 4 * j + (DIR == 0 ? ii : 3 - ii); hl = a[idx] * hl + u[idx]; p *= a[idx]; HL[idx] = hl; PL[idx] = p; }
        As[j] = p; Hs[j] = hl;
    }
    float Alo[4], Ahi[4], Hlo[4], Hhi[4];
#pragma unroll
    for (int j = 0; j < 4; ++j) {
        { const unsigned x = __float_as_uint(As[j]); auto rr = __builtin_amdgcn_permlane32_swap(x, x, false, false); Alo[j] = __uint_as_float(rr[0]); Ahi[j] = __uint_as_float(rr[1]); }
        { const unsigned x = __float_as_uint(Hs[j]); auto rr = __builtin_amdgcn_permlane32_swap(x, x, false, false); Hlo[j] = __uint_as_float(rr[0]); Hhi[j] = __uint_as_float(rr[1]); }
    }
    float cin[4]; float c = carry;
    if (DIR == 0) {
#pragma unroll
        for (int j = 0; j < 4; ++j) { const float c_lo = c; c = Alo[j] * c + Hlo[j]; const float c_hi = c; c = Ahi[j] * c + Hhi[j]; cin[j] = up ? c_hi : c_lo; }
    } else {
#pragma unroll
        for (int j = 3; j >= 0; --j) { const float c_hi = c; c = Ahi[j] * c + Hhi[j]; const float c_lo = c; c = Alo[j] * c + Hlo[j]; cin[j] = up ? c_hi : c_lo; }
    }
    carry = c;
#pragma unroll
    for (int j = 0; j < 4; ++j) ptot *= Alo[j] * Ahi[j];
#pragma unroll
    for (int idx = 0; idx < 16; ++idx) h[idx] = HL[idx] + PL[idx] * cin[idx >> 2];
}

__device__ __forceinline__ void lru_decode(int cg, int& seq, int& c) { if (cg < 520) { seq = cg / 65; c = cg - seq * 65; } else { const int c2 = cg - 520; seq = c2 / 129; c = c2 - seq * 129; seq += 8; } }
template <int PASS>
__device__ __forceinline__ void lru_phase(Frame& F, bf16* gout) {
    LAS unsigned char* L = F.lds;
    const int tid = F.tid, lane = F.lane, wave = F.wave;
    const int n = F.vcu & 7, ngrp = F.G >> 3;
    { const float* cw = FIN(F, 7  ); const float* cb = FIN(F, 8  );
      for (int i = tid; i < 640; i += 512) { const int k = i >> 7, ch = i & 127; ((LAS float*)(L + LRU_CW))[i] = k < 4 ? cw[k * 1024 + n * 128 + ch] : cb[n * 128 + ch]; } }
    const int d = wave >> 2, g4 = wave & 3, r32 = lane & 31, hi = lane >> 5, chl = g4 * 32 + r32, chg = n * 128 + chl;
    bf16x8 br[8], bi[8];
    { const bf16* wr_ = F.WG() + (size_t)((d * 2 + 0) * 8 + n) * 16384 + chl * 128 + hi * 8;
      const bf16* wi_ = F.WG() + (size_t)((d * 2 + 1) * 8 + n) * 16384 + chl * 128 + hi * 8;
#pragma unroll
      for (int ks = 0; ks < 8; ++ks) { br[ks] = *(const GAS bf16x8*)(wr_ + ks * 16); bi[ks] = *(const GAS bf16x8*)(wi_ + ks * 16); } }
    constexpr float L2E = 1.4426950408889634f;
    const float nb_r = -L2E * FIN(F, 10  )[d * 1024 + chg], nb_i = -L2E * FIN(F, 12  )[d * 1024 + chg];
    const float spl = 8.f * L2E * log1pf(expf(-FIN(F, 13  )[d * 1024 + chg]));
    const int tau0 = tid >> 4, co = (tid & 15) * 8;
    bf16x8 xv[2][4];
#define LRU_PREFETCH(cgx) do { int s_, c_; lru_decode((cgx), s_, c_); const int xb_ = xr_base(s_); \
        _Pragma("unroll") for (int it_ = 0; it_ < 2; ++it_) _Pragma("unroll") for (int k_ = 0; k_ < 4; ++k_) { int row_ = xb_ + c_ * 64 + tau0 + 32 * it_ + k_ - 2; row_ = row_ < 0 ? 0 : row_; \
            xv[it_][k_] = *(const GAS bf16x8*)(F.XR() + (size_t)row_ * 1024 + n * 128 + co); } } while (0)
    int cg = F.vcu < 8 * ngrp ? F.vcu >> 3 : NCHUNK;
    if (cg < NCHUNK) LRU_PREFETCH(cg);
    __syncthreads();
    for (int ui = 0; cg < NCHUNK; cg += ngrp, ++ui) {
        int seq, c; lru_decode(cg, seq, c);
        LAS unsigned char* XC = L + LRU_XC0 + (ui & 1) * LRU_XC_BUF;
        float carry = 0.f, ptot = 1.f;
        if (PASS == 2) carry = F.CIN()[((size_t)cg * 2 + d) * 1024 + chg];
#pragma unroll
        for (int it = 0; it < 2; ++it) {
            const int tau = tau0 + 32 * it; float xc[8];
            { const LAS f32x4* cb = (const LAS f32x4*)(L + LRU_CW + (4 * 128 + co) * 4); const f32x4 b0 = cb[0], b1 = cb[1];
              xc[0] = b0.x; xc[1] = b0.y; xc[2] = b0.z; xc[3] = b0.w; xc[4] = b1.x; xc[5] = b1.y; xc[6] = b1.z; xc[7] = b1.w; }
#pragma unroll
            for (int k = 0; k < 4; ++k) { const LAS f32x4* wp = (const LAS f32x4*)(L + LRU_CW + (k * 128 + co) * 4); const f32x4 w0 = wp[0], w1 = wp[1]; const bf16x8 v = xv[it][k];
                xc[0] += w0.x * bf2f(v[0]); xc[1] += w0.y * bf2f(v[1]); xc[2] += w0.z * bf2f(v[2]); xc[3] += w0.w * bf2f(v[3]);
                xc[4] += w1.x * bf2f(v[4]); xc[5] += w1.y * bf2f(v[5]); xc[6] += w1.z * bf2f(v[6]); xc[7] += w1.w * bf2f(v[7]); }
            if (c == 0 && tau < 48) {
#pragma unroll
                for (int j = 0; j < 8; ++j) xc[j] = 0.f;
            }
            *(LAS v4u*)(XC + tau * LRU_XC_STRIDE + co * 2) = pack8(xc);
        }
        bf16x8 gv[2];
        const int row0 = seq_first_row(seq) + 64 * (c - 1);
        if (PASS == 2) { if (c > 0) {
#pragma unroll
            for (int it = 0; it < 2; ++it) gv[it] = *(const GAS bf16x8*)(F.QG() + (size_t)(row0 + tau0 + 32 * it) * DM + 1024 + n * 128 + co); } }
        __syncthreads();
        if (cg + ngrp < NCHUNK) LRU_PREFETCH(cg + ngrp);
        f32x16 arT[2], aiT[2];
#pragma unroll
        for (int tt = 0; tt < 2; ++tt) {
            const int tile = d ? 1 - tt : tt;
            f32x16 ar = {}, ai = {};
#pragma unroll
            for (int ks = 0; ks < 8; ++ks) {
                const bf16x8 a = *(const LAS bf16x8*)(XC + (tile * 32 + r32) * LRU_XC_STRIDE + (ks * 16 + hi * 8) * 2);
                ar = __builtin_amdgcn_mfma_f32_32x32x16_bf16(a, br[ks], ar, 0, 0, 0);
                ai = __builtin_amdgcn_mfma_f32_32x32x16_bf16(a, bi[ks], ai, 0, 0, 0);
            }
            arT[tt] = ar; aiT[tt] = ai;
        }
#pragma unroll
        for (int tt = 0; tt < 2; ++tt) {
            const int tile = d ? 1 - tt : tt;
            const f32x16 ar = arT[tt], ai = aiT[tt];
            float av[16], uv[16], hv[16];
            typedef float f32x2 __attribute__((ext_vector_type(2)));
#pragma unroll
            for (int r = 0; r < 16; r += 2) {
                const int tau0_ = tile * 32 + crow16(r, hi);
                const f32x2 xc2 = {bf2f(*(const LAS unsigned short*)(XC + tau0_ * LRU_XC_STRIDE + chl * 2)), bf2f(*(const LAS unsigned short*)(XC + (tau0_ + 1) * LRU_XC_STRIDE + chl * 2))};
                const f32x2 tr = (f32x2){ar[r], ar[r + 1]} * (f32x2){-L2E, -L2E} + (f32x2){nb_r, nb_r};
                const f32x2 ti = (f32x2){ai[r], ai[r + 1]} * (f32x2){-L2E, -L2E} + (f32x2){nb_i, nb_i};
                const f32x2 dr = (f32x2){__builtin_amdgcn_exp2f(tr.x), __builtin_amdgcn_exp2f(tr.y)} + (f32x2){1.f, 1.f};
                const f32x2 di = (f32x2){__builtin_amdgcn_exp2f(ti.x), __builtin_amdgcn_exp2f(ti.y)} + (f32x2){1.f, 1.f};
                const f32x2 rg = {__builtin_amdgcn_rcpf(dr.x), __builtin_amdgcn_rcpf(dr.y)}, ig = {__builtin_amdgcn_rcpf(di.x), __builtin_amdgcn_rcpf(di.y)};
                const f32x2 la = rg * (f32x2){-spl, -spl};
                const f32x2 a = {__builtin_amdgcn_exp2f(la.x), __builtin_amdgcn_exp2f(la.y)};
                const f32x2 t = (f32x2){1.f, 1.f} - a * a;
                const f32x2 m = {__builtin_amdgcn_sqrtf(t.x), __builtin_amdgcn_sqrtf(t.y)};
                const f32x2 u = m * (ig * xc2);
                av[r] = a.x; av[r + 1] = a.y; uv[r] = u.x; uv[r + 1] = u.y;
            }
            if (d == 0) scan_tile<0>(av, uv, carry, ptot, hv, hi != 0); else scan_tile<1>(av, uv, carry, ptot, hv, hi != 0);
            if (PASS == 2) {
#pragma unroll
                for (int r = 0; r < 16; ++r) { const int tau = tile * 32 + crow16(r, hi); *(LAS float*)(L + (d ? LRU_HB : LRU_HF) + (tau * 128 + chl) * 4) = hv[r]; }
            }
        }
        if (PASS == 1) { if (hi == 0) F.CAR()[((size_t)cg * 2 + d) * 1024 + chg] = make_float2(ptot, carry); }
        if (PASS == 2) {
            __syncthreads();
            if (c > 0) {
#pragma unroll
                for (int it = 0; it < 2; ++it) {
                    const int tau = tau0 + 32 * it; const bf16x8 g8 = gv[it];
                    const LAS f32x4* hf = (const LAS f32x4*)(L + LRU_HF + (tau * 128 + co) * 4); const LAS f32x4* hb = (const LAS f32x4*)(L + LRU_HB + (tau * 128 + co) * 4);
                    const f32x4 f0 = hf[0], f1 = hf[1], b0 = hb[0], b1 = hb[1];
                    float o[8];
                    o[0] = (f0.x + b0.x) * gelu_tanh(bf2f(g8[0])); o[1] = (f0.y + b0.y) * gelu_tanh(bf2f(g8[1])); o[2] = (f0.z + b0.z) * gelu_tanh(bf2f(g8[2])); o[3] = (f0.w + b0.w) * gelu_tanh(bf2f(g8[3]));
                    o[4] = (f1.x + b1.x) * gelu_tanh(bf2f(g8[4])); o[5] = (f1.y + b1.y) * gelu_tanh(bf2f(g8[5])); o[6] = (f1.z + b1.z) * gelu_tanh(bf2f(g8[6])); o[7] = (f1.w + b1.w) * gelu_tanh(bf2f(g8[7]));
                    *(GAS v4u*)(gout + (size_t)(row0 + tau) * DM + 1024 + n * 128 + co) = pack8(o);
                    float sq = (o[0] * o[0] + o[1] * o[1]) + (o[2] * o[2] + o[3] * o[3]) + (o[4] * o[4] + o[5] * o[5]) + (o[6] * o[6] + o[7] * o[7]);
                    sq += __shfl_xor(sq, 1); sq += __shfl_xor(sq, 2); sq += __shfl_xor(sq, 4); sq += __shfl_xor(sq, 8);
                    if ((tid & 15) == 0) F.SSQL()[(size_t)(row0 + tau) * 8 + n] = sq;
                }
            } else if (tid < 128) {
                const float hf = *(const LAS float*)(L + LRU_HF + (63 * 128 + tid) * 4), hb = *(const LAS float*)(L + LRU_HB + (63 * 128 + tid) * 4);
                F.LO15()[seq * 1024 + n * 128 + tid] = (hf + hb) * gelu_tanh(F.GY15()[n * 128 + tid]);
            }
        }
    }
    __syncthreads();
#undef LRU_PREFETCH
}
__device__ __forceinline__ void lru_propagate(Frame& F) {
    const int gid = F.vcu * 512 + F.tid;
    if (gid < 12 * 2048) {
        const int s = gid >> 11, d = (gid >> 10) & 1, ch = gid & 1023; const int nch = s < 8 ? 65 : 129, cb = chunk_base(s);
        const float2* car = F.CAR() + (size_t)d * 1024 + ch; float* cinp = F.CIN() + (size_t)d * 1024 + ch;
        float cin = 0.f;
        for (int b0 = 0; b0 < nch; b0 += 16) {
            float2 ph[16];
#pragma unroll
            for (int i = 0; i < 16; ++i) { const int cc = b0 + i; const int c = d ? nch - 1 - cc : cc; if (cc < nch) ph[i] = car[(size_t)(cb + c) * 2048]; }
#pragma unroll
            for (int i = 0; i < 16; ++i) { const int cc = b0 + i; const int c = d ? nch - 1 - cc : cc; if (cc < nch) { cinp[(size_t)(cb + c) * 2048] = cin; cin = ph[i].x * cin + ph[i].y; } }
        }
    }
}

__device__ __forceinline__ void k_rope_pass(Frame& F, bf16* Kout) {
    const int gw = F.vcu * NWAVES + F.wave, NGW = F.G * NWAVES, sub = F.lane >> 4, l16 = F.lane & 15;
    const int c0 = 8 * l16, p = l16 >> 3, half = (l16 >> 2) & 1, i0 = 8 * (l16 & 3);
    float inv[8], gk[8];
#pragma unroll
    for (int j = 0; j < 8; ++j) { inv[j] = __builtin_amdgcn_exp2f(-(float)(i0 + j) * (13.287712379549449f / 32.f)) * 0.15915494309189535f; gk[j] = FIN(F, 6  )[c0 + j]; }
    for (int it = gw; it < NTOK * 2 / 4; it += NGW) {
        const int item = it * 4 + sub, row = item >> 1, hk = item & 1;
        const int s = row_seq(row), t = row - seq_first_row(s); const float pos = (float)(p ? (t & 63) : (t >> 6));
        bf16* kp = F.K() + (size_t)row * 256 + hk * 128 + c0;
        const bf16x8 v = *(const GAS bf16x8*)kp; float x[8]; float ss = 0.f;
#pragma unroll
        for (int j = 0; j < 8; ++j) { x[j] = bf2f(v[j]); ss += x[j] * x[j]; }
        ss += __shfl_xor(ss, 1); ss += __shfl_xor(ss, 2); ss += __shfl_xor(ss, 4); ss += __shfl_xor(ss, 8);
        const float rs = 1.f / sqrtf(ss * (1.f / 128.f) + EPS); float o[8];
#pragma unroll
        for (int j = 0; j < 8; ++j) { x[j] *= rs * gk[j]; const float pr = __shfl_xor(x[j], 4);
            float rev = pos * inv[j]; rev -= floorf(rev); const float sn = __builtin_amdgcn_sinf(rev), cs = __builtin_amdgcn_cosf(rev);
            o[j] = half ? x[j] * cs + pr * sn : x[j] * cs - pr * sn; }
        *(GAS v4u*)(Kout + (size_t)row * 256 + hk * 128 + c0) = pack8(o);
    }
}
__device__ __forceinline__ void p3_meta_job(Frame& F) {
    for (int pr = F.wave; pr < 32; pr += 8) { const int r = pr >> 1, hk = pr & 1; const float* z = F.ZM() + r * INW + 1024 + hk * 128;
        const float a = z[F.lane], b = z[F.lane + 64]; const float rs = 1.f / sqrtf(wave_sum(a * a + b * b) * (1.f / 128.f) + EPS);
        F.KM()[r * 256 + hk * 128 + F.lane] = (bf16)f2bf(a * rs * FIN(F, 6  )[F.lane]); F.KM()[r * 256 + hk * 128 + F.lane + 64] = (bf16)f2bf(b * rs * FIN(F, 6  )[F.lane + 64]); }
    for (int i = F.tid; i < 16 * 256; i += 512) F.VM()[i] = (bf16)f2bf(F.ZM()[(i >> 8) * INW + 1280 + (i & 255)]);
    { const int h = F.wave; const float* z = F.ZM() + 15 * INW + h * 128; const float a = z[F.lane], b = z[F.lane + 64];
      const float rs = 1.f / sqrtf(wave_sum(a * a + b * b) * (1.f / 128.f) + EPS);
      F.Q15()[h * 128 + F.lane] = a * rs * FIN(F, 5  )[F.lane]; F.Q15()[h * 128 + F.lane + 64] = b * rs * FIN(F, 5  )[F.lane + 64]; }
    for (int i = F.tid; i < 1024; i += 512) F.GY15()[i] = F.ZM()[15 * INW + 2560 + i];
}

__device__ __forceinline__ void metaq_item(Frame& F, int it) {
    int s, kvh, j; if (it < 256) { s = it >> 5; kvh = (it >> 4) & 1; j = it & 15; } else { const int t2 = it - 256; s = 8 + (t2 >> 6); kvh = (t2 >> 5) & 1; j = t2 & 31; }
    LAS float* q4 = (LAS float*)F.lds;
    LAS float* sc = q4 + 512;
    LAS float* red = sc + 4 * 288;
    const int tid = F.tid, nk = 256 + (j == 0 ? 16 : 0), row0 = seq_first_row(s) + 256 * j;
    q4[tid] = F.Q15()[kvh * 512 + tid];
    __syncthreads();
    if (tid < nk) {
        const bf16* kp = tid < 256 ? F.K() + (size_t)(row0 + tid) * 256 + kvh * 128 : F.KM() + (tid - 256) * 256 + kvh * 128;
        float d0 = 0.f, d1 = 0.f, d2 = 0.f, d3 = 0.f;
#pragma unroll 4
        for (int cc = 0; cc < 16; ++cc) { const bf16x8 kv = ((const GAS bf16x8*)kp)[cc];
#pragma unroll
            for (int e = 0; e < 8; ++e) { const float kf = bf2f(kv[e]); d0 += kf * q4[cc * 8 + e]; d1 += kf * q4[128 + cc * 8 + e]; d2 += kf * q4[256 + cc * 8 + e]; d3 += kf * q4[384 + cc * 8 + e]; } }
        const float SC = 0.088388347648318440f;
        sc[tid] = d0 * SC; sc[288 + tid] = d1 * SC; sc[576 + tid] = d2 * SC; sc[864 + tid] = d3 * SC;
    }
    __syncthreads();
    if (F.wave < 4) { LAS float* sh = sc + F.wave * 288; float m = -INFINITY;
        for (int k = F.lane; k < nk; k += 64) m = fmaxf(m, sh[k]);
        m = wave_max(m); float l = 0.f;
        for (int k = F.lane; k < nk; k += 64) { const float p = __expf(sh[k] - m); sh[k] = p; l += p; }
        l = wave_sum(l);
        if (F.lane == 0) { red[F.wave * 2] = m; red[F.wave * 2 + 1] = l; } }
    __syncthreads();
    {
        const int kg = tid >> 4, oc = tid & 15; float o[4][8];
#pragma unroll
        for (int h = 0; h < 4; ++h)
#pragma unroll
            for (int e = 0; e < 8; ++e) o[h][e] = 0.f;
        const bf16* vp = F.V() + (size_t)(row0 + kg * 8) * 256 + kvh * 128 + oc * 8;
        bf16x8 vv[8];
#pragma unroll
        for (int k = 0; k < 8; ++k) vv[k] = *(const GAS bf16x8*)(vp + (size_t)k * 256);
#pragma unroll
        for (int k = 0; k < 8; ++k) { const float p0 = sc[kg * 8 + k], p1 = sc[288 + kg * 8 + k], p2 = sc[576 + kg * 8 + k], p3 = sc[864 + kg * 8 + k];
#pragma unroll
            for (int e = 0; e < 8; ++e) { const float vf = bf2f(vv[k][e]); o[0][e] += p0 * vf; o[1][e] += p1 * vf; o[2][e] += p2 * vf; o[3][e] += p3 * vf; } }
        if (j == 0 && kg < 16) { const int k = kg; const bf16x8 v1 = *(const GAS bf16x8*)(F.VM() + k * 256 + kvh * 128 + oc * 8);
            const float p0 = sc[256 + k], p1 = sc[288 + 256 + k], p2 = sc[576 + 256 + k], p3 = sc[864 + 256 + k];
#pragma unroll
            for (int e = 0; e < 8; ++e) { const float vf = bf2f(v1[e]); o[0][e] += p0 * vf; o[1][e] += p1 * vf; o[2][e] += p2 * vf; o[3][e] += p3 * vf; } }
        LAS float* part = sc + 4 * 288 + 16;
#pragma unroll
        for (int h = 0; h < 4; ++h) { LAS f32x4* pp = (LAS f32x4*)(part + (kg * 4 + h) * 128 + oc * 8); pp[0] = (f32x4){o[h][0], o[h][1], o[h][2], o[h][3]}; pp[1] = (f32x4){o[h][4], o[h][5], o[h][6], o[h][7]}; }
        __syncthreads();
        const int h = tid >> 7, d = tid & 127; float os = 0.f;
#pragma unroll 8
        for (int g = 0; g < 32; ++g) os += part[(g * 4 + h) * 128 + d];
        float* dst = F.MQP() + ((size_t)it * 4 + h) * 132; dst[2 + d] = os; if (d == 0) { dst[0] = red[h * 2]; dst[1] = red[h * 2 + 1]; } }
    __syncthreads();
}
__device__ __forceinline__ void attn_phase(Frame& F, char* lds_generic, bf16* obase) {
    const int nr = F.G == 256 ? 8 : (2048 + F.G - 1) / F.G;
    for (int r = 0; r < nr; ++r) {
        int s, kvh, hq, qb, S;
        if (F.G == 256) {
            const int x = F.vcu >> 5, i = F.vcu & 31;
            if (r < 4) { const int pair = 2 * x + (r >> 1); s = pair >> 1; kvh = pair & 1; const int u = (r & 1) * 32 + i; hq = u >> 4; qb = u & 15; S = 4096; }
            else { const int pair = x; s = 8 + (pair >> 1); kvh = pair & 1; const int u = (r - 4) * 32 + i; hq = u >> 5; qb = u & 31; S = 8192; }
        } else {
            const int U = F.vcu + F.G * r; if (U >= 2048) break;
            if (U < 1024) { const int pair = U >> 6, u = U & 63; s = pair >> 1; kvh = pair & 1; hq = u >> 4; qb = u & 15; S = 4096; }
            else { const int pair = (U - 1024) >> 7, u = (U - 1024) & 127; s = 8 + (pair >> 1); kvh = pair & 1; hq = u >> 5; qb = u & 31; S = 8192; }
        }
        const int row0 = seq_first_row(s), h = kvh * 4 + hq;
        bf16* qp = F.QG() + (size_t)(row0 + qb * 256) * DM + h * 128;
        attn::attn_unit(qp, F.K() + (size_t)row0 * 256 + kvh * 128, F.V() + (size_t)row0 * 256 + kvh * 128, F.KM() + kvh * 128, F.VM() + kvh * 128, obase + (size_t)(row0 + qb * 256) * DM + h * 128, S / 64 + 1, lds_generic, FIN(F, 5  ), qb * 256, F.SSQA() + (size_t)(row0 + qb * 256) * 8 + h);
    }
}

__device__ __forceinline__ void p5_ratio(Frame& F) {
    for (int row = F.vcu * 512 + F.tid; row < NTOK; row += F.G * 512) {
        const GAS f32x4* pa = (const GAS f32x4*)(F.SSQA() + (size_t)row * 8); const GAS f32x4* pl = (const GAS f32x4*)(F.SSQL() + (size_t)row * 8);
        const f32x4 a0 = pa[0], a1 = pa[1], l0 = pl[0], l1 = pl[1];
        const float sa = ((a0.x + a0.y) + (a0.z + a0.w)) + ((a1.x + a1.y) + (a1.z + a1.w)), sl = ((l0.x + l0.y) + (l0.z + l0.w)) + ((l1.x + l1.y) + (l1.z + l1.w));
        const float qa = sqrtf(sa * (1.f / 1024.f) + EPS), ql = sqrtf(sl * (1.f / 1024.f) + EPS);
        F.RATIO()[row] = ql / qa; F.RL()[row] = 1.f / ql;
    }
}
__device__ __forceinline__ void p5_meta_job(Frame& F, int s) {
    LAS float* buf = (LAS float*)F.lds; LAS float* red = buf + 2048; const int tid = F.tid;
    {
        const int nj = s < 8 ? 16 : 32;
        for (int e = tid; e < 1024; e += 512) { const int h = e >> 7, d = e & 127, kvh = h >> 2, hq = h & 3;
            const int it0 = s < 8 ? s * 32 + kvh * 16 : 256 + (s - 8) * 64 + kvh * 32;
            float M = -INFINITY; for (int j = 0; j < nj; ++j) M = fmaxf(M, F.MQP()[((size_t)(it0 + j) * 4 + hq) * 132]);
            float Ls = 0.f, O = 0.f;
            for (int j = 0; j < nj; ++j) { const float* p = F.MQP() + ((size_t)(it0 + j) * 4 + hq) * 132; const float w = __expf(p[0] - M); Ls += p[1] * w; O += p[2 + d] * w; }
            buf[e] = O / Ls; }
        for (int e = tid; e < 1024; e += 512) buf[1024 + e] = F.LO15()[s * 1024 + e];
        __syncthreads();
        { float ss = 0.f; for (int k = F.lane; k < 256; k += 64) { const float v = buf[F.wave * 256 + k]; ss += v * v; } ss = wave_sum(ss); if (F.lane == 0) red[F.wave] = ss; }
        __syncthreads();
        const float ra = 1.f / sqrtf((red[0] + red[1] + red[2] + red[3]) * (1.f / 1024.f) + EPS), rl = 1.f / sqrtf((red[4] + red[5] + red[6] + red[7]) * (1.f / 1024.f) + EPS);
        for (int e = tid; e < 2048; e += 512) F.MIXED15()[s * 2048 + e] = e < 1024 ? buf[e] * ra : buf[e] * rl;
        __syncthreads();
    }
}
__device__ __forceinline__ void p6_meta_y(Frame& F) {
    LAS float* X = (LAS float*)F.lds;
    for (int i = F.tid; i < 12 * DM / 4; i += 512) ((LAS f32x4*)X)[i] = ((const GAS f32x4*)F.MIXED15())[i];
    __syncthreads();
    const OutRows o{F.Y15(), DM, 12};
    small_gemm<12, OutRows>(X, DM, F.WOUT_T(), DM, F.vcu * NWAVES + F.wave, F.G * NWAVES, F.lane, o);
    __syncthreads();
}

__device__ __forceinline__ void p7_row(Frame& F, int row, int lane, bf16* h1row) {
    const GAS bf16x8* y = (const GAS bf16x8*)((const bf16*)(F.out + (size_t)row * DM));
    GAS v4u* xn = (GAS v4u*)(F.XN() + (size_t)row * DM);
    const float ir0 = 1.f / F.R0()[row];
    float hv[32]; float ss = 0.f;
#pragma unroll
    for (int i = 0; i < 4; ++i) { const bf16x8 v = y[lane + 64 * i];
#pragma unroll
        for (int j = 0; j < 8; ++j) { hv[8 * i + j] = bf2f(v[j]); ss += hv[8 * i + j] * hv[8 * i + j]; } }
    const float r1 = 1.f / sqrtf(wave_sum(ss) * (1.f / DM) + EPS); float s2 = 0.f;
#pragma unroll
    for (int i = 0; i < 4; ++i) { const int e0 = (lane + 64 * i) * 8;
        const v4u xq = xn[lane + 64 * i]; const GAS f32x4* gp = (const GAS f32x4*)(FIN(F, 17  ) + e0); const f32x4 g0 = gp[0], g1 = gp[1];
        const float xv[8] = {__builtin_bit_cast(float, xq.x << 16), __builtin_bit_cast(float, xq.x & 0xffff0000u), __builtin_bit_cast(float, xq.y << 16), __builtin_bit_cast(float, xq.y & 0xffff0000u),
                             __builtin_bit_cast(float, xq.z << 16), __builtin_bit_cast(float, xq.z & 0xffff0000u), __builtin_bit_cast(float, xq.w << 16), __builtin_bit_cast(float, xq.w & 0xffff0000u)};
        const float gg[8] = {g0.x, g0.y, g0.z, g0.w, g1.x, g1.y, g1.z, g1.w};
        float hb[8];
#pragma unroll
        for (int j = 0; j < 8; ++j) { hb[j] = xv[j] * ir0 + hv[8 * i + j] * r1 * gg[j]; hv[8 * i + j] = hb[j]; s2 += hb[j] * hb[j]; }
        ((GAS v4u*)h1row)[lane + 64 * i] = pack8(hb);
    }
    const float r2 = 1.f / sqrtf(wave_sum(s2) * (1.f / DM) + EPS);
#pragma unroll
    for (int i = 0; i < 4; ++i) { const int e0 = (lane + 64 * i) * 8; const GAS f32x4* gp = (const GAS f32x4*)(FIN(F, 18  ) + e0); const f32x4 g0 = gp[0], g1 = gp[1];
        float t[8]; t[0] = hv[8 * i + 0] * r2 * g0.x; t[1] = hv[8 * i + 1] * r2 * g0.y; t[2] = hv[8 * i + 2] * r2 * g0.z; t[3] = hv[8 * i + 3] * r2 * g0.w;
        t[4] = hv[8 * i + 4] * r2 * g1.x; t[5] = hv[8 * i + 5] * r2 * g1.y; t[6] = hv[8 * i + 6] * r2 * g1.z; t[7] = hv[8 * i + 7] * r2 * g1.w;
        xn[lane + 64 * i] = pack8(t); }
}
__device__ __forceinline__ void p7_meta_g(Frame& F) {
    LAS float* X = (LAS float*)F.lds;
    for (int r = F.wave; r < 12; r += 8) {
        const float* y = F.Y15() + r * DM; const float* xm = FIN(F, 2  ) + 15 * DM;
        float hv[32]; float ss = 0.f;
#pragma unroll
        for (int i = 0; i < 32; ++i) { hv[i] = y[F.lane + 64 * i]; ss += hv[i] * hv[i]; }
        const float r1 = 1.f / sqrtf(wave_sum(ss) * (1.f / DM) + EPS); float s2 = 0.f;
#pragma unroll
        for (int i = 0; i < 32; ++i) { const int e = F.lane + 64 * i; hv[i] = xm[e] + hv[i] * r1 * FIN(F, 17  )[e]; s2 += hv[i] * hv[i]; }
        const float r2 = 1.f / sqrtf(wave_sum(s2) * (1.f / DM) + EPS);
#pragma unroll
        for (int i = 0; i < 32; ++i) { const int e = F.lane + 64 * i; X[r * DM + e] = hv[i] * r2 * FIN(F, 18  )[e]; }
    }
    __syncthreads();
    const OutRows o{F.G15(), FFN, 12};
    small_gemm<12, OutRows, true>(X, DM, F.WUP_T(), FFN, F.vcu * NWAVES + F.wave, F.G * NWAVES, F.lane, o);
    __syncthreads();
}

__device__ __forceinline__ void p9_fix(Frame& F, int h) {
    constexpr int NOCT = FFN / 8; const int total = 512 * 2 * NOCT;
    const float* cw = FIN(F, 20  ); const float* cb = FIN(F, 21  );
    for (int it = F.vcu * 512 + F.tid; it < total; it += F.G * 512) {
        const int bw = it / NOCT, co = (it - bw * NOCT) * 8, which = bw & 1, B = bw >> 1;
        const int lrow = B * 64 + (which ? 63 : 0), row = h * HROWS + lrow, s = row_seq(row), t = row - seq_first_row(s), S = seq_len(s);
        const float* e = F.EDGE() + (size_t)((B * 2 + which) * 3) * FFN + co;
        float inner[8], self[8], uu[8], outer[8], w0[8], w1[8], w2[8], bb[8];
#define LD8F(dst, p) do { const GAS f32x4* p_ = (const GAS f32x4*)(p); const f32x4 a_ = p_[0], b_ = p_[1]; dst[0] = a_.x; dst[1] = a_.y; dst[2] = a_.z; dst[3] = a_.w; dst[4] = b_.x; dst[5] = b_.y; dst[6] = b_.z; dst[7] = b_.w; } while (0)
        LD8F(inner, e); LD8F(self, e + FFN); LD8F(uu, e + 2 * FFN);
        LD8F(w0, cw + co); LD8F(w1, cw + FFN + co); LD8F(w2, cw + 2 * FFN + co); LD8F(bb, cb + co);
        if (which == 0) { if (t == 0) LD8F(outer, F.G15() + (size_t)s * FFN + co); else LD8F(outer, F.EDGE() + (size_t)(((B - 1) * 2 + 1) * 3 + 1) * FFN + co); }
        else { if (t == S - 1) {
#pragma unroll
                for (int j = 0; j < 8; ++j) outer[j] = 0.f; }
            else LD8F(outer, F.EDGE() + (size_t)(((B + 1) * 2 + 0) * 3 + 1) * FFN + co); }
#undef LD8F
        float o[8];
#pragma unroll
        for (int j = 0; j < 8; ++j) { const float x = which == 0 ? bb[j] + w0[j] * outer[j] + w1[j] * self[j] + w2[j] * inner[j] : bb[j] + w0[j] * inner[j] + w1[j] * self[j] + w2[j] * outer[j];
            o[j] = x * sigmoidf_(x) * uu[j]; }
        *(GAS v4u*)(F.ACT() + (size_t)lrow * FFN + co) = pack8(o);
    }
}
__device__ __forceinline__ void p11_row(Frame& F, int row, int lane, float* obase) {
    const GAS bf16x8* f = (const GAS bf16x8*)((const bf16*)(F.out + (size_t)row * DM));
    const GAS bf16x8* hp = (const GAS bf16x8*)(row < HROWS ? F.H1A() + (size_t)row * DM : F.XN() + (size_t)(row - HROWS) * DM);
    bf16x8 hv[4], fq[4];
#pragma unroll
    for (int i = 0; i < 4; ++i) { hv[i] = hp[lane + 64 * i]; fq[i] = f[lane + 64 * i]; }
    asm volatile("s_waitcnt vmcnt(0)" ::: "memory");
    float fv[32]; float ss = 0.f;
#pragma unroll
    for (int i = 0; i < 4; ++i)
#pragma unroll
        for (int j = 0; j < 8; ++j) { fv[8 * i + j] = bf2f(fq[i][j]); ss += fv[8 * i + j] * fv[8 * i + j]; }
    const float r1 = 1.f / sqrtf(wave_sum(ss) * (1.f / DM) + EPS);
#pragma unroll
    for (int i = 0; i < 4; ++i) { const int e0 = (lane + 64 * i) * 8;
        const GAS f32x4* gp = (const GAS f32x4*)(FIN(F, 23  ) + e0); const f32x4 g0 = gp[0], g1 = gp[1];
        f32x4 h0, h1;
        h0.x = bf2f(hv[i][0]) + fv[8 * i + 0] * r1 * g0.x; h0.y = bf2f(hv[i][1]) + fv[8 * i + 1] * r1 * g0.y; h0.z = bf2f(hv[i][2]) + fv[8 * i + 2] * r1 * g0.z; h0.w = bf2f(hv[i][3]) + fv[8 * i + 3] * r1 * g0.w;
        h1.x = bf2f(hv[i][4]) + fv[8 * i + 4] * r1 * g1.x; h1.y = bf2f(hv[i][5]) + fv[8 * i + 5] * r1 * g1.y; h1.z = bf2f(hv[i][6]) + fv[8 * i + 6] * r1 * g1.z; h1.w = bf2f(hv[i][7]) + fv[8 * i + 7] * r1 * g1.w;
        GAS f32x4* wp = (GAS f32x4*)(obase + (size_t)row * DM + e0); wp[0] = h0; wp[1] = h1; }
}
struct Args { const float* in[24]; float* out; unsigned char* ws; int ph_lo, ph_hi, q_lo, q_hi, use_bar, dummy; };
constexpr int N_PHASES = 12;
__global__ void __launch_bounds__(NWAVES * 64, 2) mk_fwd(Args args) {
    extern __shared__ __attribute__((aligned(16))) unsigned char lds[];
    Frame F;
    F.lds = (LAS unsigned char*)lds;
    F.MISC = (volatile LAS unsigned*)(F.lds + MISC_OFF);
    F.tid = threadIdx.x; F.lane = F.tid & 63; F.wave = __builtin_amdgcn_readfirstlane(F.tid >> 6);
    F.G = gridDim.x; { const int bx = blockIdx.x; F.vcu = (F.G % 8 == 0) ? (bx % 8) * (F.G / 8) + bx / 8 : bx; }
    unsigned char* ws = args.ws;
    F.ctl = (gu32*)(ws + WS_CTL);
    F.kargs = (const __attribute__((address_space(4))) void*)__builtin_amdgcn_kernarg_segment_ptr(); F.ptag = 0; F.out = args.out;
    F.ws = ws;
    for (int u = F.tid; u < (LDS_BYTES - LDSCTL_OFF) / 4; u += NWAVES * 64) ((LAS unsigned*)(F.lds + LDSCTL_OFF))[u] = 0u;
    __syncthreads();
    XcdBarrier bar; bar.bar = (unsigned*)(F.ctl + CW_BAR); bar.x = 0; bar.st = nullptr;
    if (args.use_bar) bar = xcd_barrier_post((unsigned*)(F.ctl + CW_BAR), F.MISC + 8);
    const int lo = args.ph_lo, hi = args.ph_hi;
    const int dmy_ = MK_MULTI ? args.dummy : 0;
#define IN(k) (((MK_PHASE_MASK >> (k)) & 1) && lo <= (k) && (k) < hi)
#define PH_BEGIN(k) do { F.ptag = (k); int t_ = F.tid; asm volatile("" : "+v"(t_)); F.tid = t_; F.lane = t_ & 63; } while (0)
#define PH_BAR() do { if (args.use_bar) xcd_barrier(bar); } while (0)
    const int gw = F.vcu * NWAVES + F.wave, NGW = F.G * NWAVES;

    if (IN(0)) { PH_BEGIN(0); { p0_prologue(F); PH_BAR(); } }
    if (IN(1)) { PH_BEGIN(1); {
        p1_meta_z(F);
        pg8::Gemm g{F.XN(), F.WIN_T(), NTOK, INW, DM}; pg8::ProbeOrder S; S.init(NTOK, INW, F.G, (int)blockIdx.x); S.pmask = dmy_ == 5 ? 7 : -1;
        pg8::EpiRoute E{nullptr, 0, 1, F.QG(), F.K(), F.V(), F.XR()};
        if (dmy_ != 7) pg8::gemm_phase<pg8::EpiRoute, pg8::ProbeOrder, true, true>(F.lds, g, S, E);
        PH_BAR();
    } }
    if (IN(2)) { PH_BEGIN(2); { lru_phase<1>(F, nullptr); PH_BAR(); } }
    if (IN(3)) { PH_BEGIN(3); {
        k_rope_pass(F, dmy_ ? (bf16*)F.out : F.K());
        lru_propagate(F);
        if (F.vcu == F.G - 1) p3_meta_job(F);
        PH_BAR();
    } }
    if (IN(4)) { PH_BEGIN(4); {
        const int dm = dmy_;
        if (dm < 2 || dm == 2) lru_phase<2>(F, dm ? (bf16*)F.out : F.QG());
        if (dm < 2 || dm == 3) for (int it = F.vcu; it < 512; it += F.G) metaq_item(F, it);
        if (dm < 2 || dm == 4) attn_phase(F, (char*)lds, dm ? (bf16*)F.out : F.QG());
        if (dm == 6 && (F.vcu & 1) == 0) attn_phase(F, (char*)lds, (bf16*)F.out);
        PH_BAR();
    } }
    if (IN(5)) { PH_BEGIN(5); {
        p5_ratio(F);
        if (F.vcu >= F.G - 12) p5_meta_job(F, F.G - 1 - F.vcu);
        PH_BAR();
    } }
    if (IN(6)) { PH_BEGIN(6); {
        p6_meta_y(F);
        pg8::Gemm g{F.QG(), F.WOUT_T(), NTOK, DM, DM}; pg8::StaticOrder S; S.init(NTOK, DM, F.G, (int)blockIdx.x);
        pg8::EpiScaled E{(bf16*)F.out, 2 * DM, F.RATIO(), F.RL(), 16};
        pg8::gemm_phase<pg8::EpiScaled, pg8::StaticOrder, true, true>(F.lds, g, S, E);
        PH_BAR();
    } }
#if MK_MULTI
    { const int q = args.q_lo;
#else
#pragma unroll
    for (int q = 0; q < 2; ++q) {
#endif
        if (IN(7)) { PH_BEGIN(7); {
            for (int row = q * HROWS + gw; row < (q + 1) * HROWS; row += NGW) p7_row(F, row, F.lane, (q == 0 ? F.H1A() : F.XN()) + (size_t)(row - q * HROWS) * DM);
            if (q == 0) p7_meta_g(F);
            PH_BAR();
        } }
        if (IN(8)) { PH_BEGIN(8); {
            pg8::Gemm g{F.XN() + (size_t)q * HROWS * DM, F.WUP_T(), HROWS, UPW, DM}; pg8::StaticOrder S; S.init(HROWS, UPW, F.G, (int)blockIdx.x);
            pg8::EpiAct E{F.ACT(), F.EDGE(), FIN(F, 20  ), FIN(F, 21  ), FFN};
            pg8::gemm_phase<pg8::EpiAct, pg8::StaticOrder, true, true>(F.lds, g, S, E);
            PH_BAR();
        } }
        if (IN(9)) { PH_BEGIN(9); { p9_fix(F, q); PH_BAR(); } }
        if (IN(10)) { PH_BEGIN(10); {
            pg8::Gemm g{F.ACT(), F.WDOWN_T(), HROWS, DM, FFN}; pg8::ProbeOrder S; S.init(HROWS, DM, F.G, (int)blockIdx.x); S.pmask = dmy_ == 5 ? 7 : -1;
            pg8::EpiRoute E{(bf16*)F.out + (size_t)q * HROWS * 2 * DM, 2 * DM, 0, nullptr, nullptr, nullptr, nullptr};
            pg8::gemm_phase<pg8::EpiRoute, pg8::ProbeOrder, true, true>(F.lds, g, S, E);
            if (q == 0) PH_BAR();
        } }
    }
    if (IN(10) && IN(11)) PH_BAR();
    if (IN(11)) { PH_BEGIN(11); { for (int row = gw; row < NTOK; row += NGW) p11_row(F, row, F.lane, dmy_ ? (float*)(F.ws + WS_B) : F.out); } }
#undef IN
#undef PH_BAR
}

extern "C" void kernel_launch(void* const* d_in, const int* in_sizes, int n_in, void* d_out, int out_size, void* d_ws, size_t ws_size, hipStream_t stream) {
    static int grid = 0;
    if (grid == 0) {
        if (n_in != 24 || out_size != NTOK * DM || ws_size < WS_END) { fprintf(stderr, "kernel_launch: unexpected shapes (n_in %d out %d ws %zu, need ws >= %zu); nothing launched\n", n_in, out_size, ws_size, (size_t)WS_END); grid = -1; return; }
        int dev = 0, cus = 0;
        if (hipGetDevice(&dev) != hipSuccess || hipDeviceGetAttribute(&cus, hipDeviceAttributeMultiprocessorCount, dev) != hipSuccess) { grid = -1; return; }
        if (hipFuncSetAttribute((const void*)mk_fwd, hipFuncAttributeMaxDynamicSharedMemorySize, LDS_BYTES) != hipSuccess) { fprintf(stderr, "kernel_launch: hipFuncSetAttribute failed\n"); grid = -1; return; }
        int per_cu = 0;
        if (hipOccupancyMaxActiveBlocksPerMultiprocessor(&per_cu, (const void*)mk_fwd, NWAVES * 64, LDS_BYTES) != hipSuccess || per_cu < 1) fprintf(stderr, "kernel_launch: occupancy query reports %d\n", per_cu);
        (void)hipGetLastError();
        grid = cus;
    }
    if (grid < 0) return;
    if (hipMemsetAsync((char*)d_ws + WS_CTL, 0, CTL_ZERO_BYTES, stream) != hipSuccess) return;
    Args a{};
    for (int i = 0; i < 24; ++i) a.in[i] = (const float*)d_in[i];
    a.out = (float*)d_out; a.ws = (unsigned char*)d_ws;
#if MK_MULTI
    a.use_bar = 0;
#define LAUNCH_PH(ph, q) do { a.ph_lo = (ph); a.ph_hi = (ph) + 1; a.q_lo = (q); a.q_hi = (q) + 1; \
        if ((MK_REPEAT_MASK >> (ph)) & 1) { a.dummy = MK_DUMMY_MODE; hipLaunchKernelGGL(mk_fwd, dim3(grid), dim3(NWAVES * 64), LDS_BYTES, stream, a); } \
        a.dummy = 0; hipLaunchKernelGGL(mk_fwd, dim3(grid), dim3(NWAVES * 64), LDS_BYTES, stream, a); } while (0)
    for (int ph = 0; ph < 7; ++ph) LAUNCH_PH(ph, 0);
    for (int q = 0; q < 2; ++q) for (int ph = 7; ph < 11; ++ph) LAUNCH_PH(ph, q);
    LAUNCH_PH(11, 0);
#else
    a.use_bar = 1; a.ph_lo = 0; a.ph_hi = N_PHASES; a.q_lo = 0; a.q_hi = 2;
    hipLaunchKernelGGL(mk_fwd, dim3(grid), dim3(NWAVES * 64), LDS_BYTES, stream, a);
#endif
    const hipError_t le = hipPeekAtLastError();
    if (le != hipSuccess) fprintf(stderr, "kernel_launch: launch failed: %s\n", hipGetErrorName(le));
}
```

```cpp
#include <hip/hip_runtime.h>
#include <cstdio>
#include <cstdint>
#include <cmath>
#ifndef MK_PHASE_MASK
#define MK_PHASE_MASK 0xfff
#endif
#ifndef MK_REPEAT_MASK
#define MK_REPEAT_MASK 0
#endif
#ifndef MK_DUMMY_MODE
#define MK_DUMMY_MODE 1
#endif
#ifndef MK_MULTI
#define MK_MULTI 0
#endif
__device__ __forceinline__ int lane_id_now() { int l; asm volatile("v_mbcnt_lo_u32_b32 %0, -1, 0\n\tv_mbcnt_hi_u32_b32 %0, -1, %0" : "=v"(l)); return l; }
namespace pg8 {
#define PG8_LAS __attribute__((address_space(3)))
typedef unsigned short bf16_t;
typedef short bf16x8 __attribute__((ext_vector_type(8)));
typedef float f32x4 __attribute__((ext_vector_type(4)));
typedef unsigned u32x4 __attribute__((ext_vector_type(4)));
constexpr int BM = 256, BK = 64, HALF = 128, HTB = HALF * BK * 2  , STAGE_BYTES = 8 * HTB, NXCD = 8, WGM = 8;

__host__ __device__ __forceinline__ int lds_byte(int r, int c) { const int st = (r >> 4) * 2 + (c >> 5), rr = r & 15, cc = c & 31, ob = rr * 64 + cc * 2; return st * 1024 + (ob ^ (((ob >> 9) & 1) << 5)); }
__host__ __device__ __forceinline__ void stage_rc(int b, int& R, int& C) { const int st = b / 1024, sb = b % 1024, swz = sb ^ (((sb >> 9) & 1) << 5); R = (st >> 1) * 16 + swz / 64; C = (st & 1) * 32 + (swz % 64) / 2; }
__host__ __device__ __forceinline__ int perm32(int rho) { const int n = rho >> 4, i = rho & 15; return 8 * (i >> 2) + 4 * n + (i & 3); }

struct Unit { int pm, pn; };
struct Gemm { const bf16_t* A; const bf16_t* Bt; int M, N, K; };

struct StaticOrder {
    int nM, nN, nwg, G, c;
    __host__ __device__ void init(int M, int N, int G_, int c_) { nM = M / BM; nN = N / BM; nwg = nM * nN; G = G_; c = c_; }
    __host__ __device__ bool next(int i, Unit& u) const {
        const long L = (long)i * G + c; if (L >= nwg) return false;
        int wgid = (int)L; { const int q = nwg / NXCD, r = nwg % NXCD, xcd = wgid % NXCD, off = wgid / NXCD; wgid = (xcd < r ? xcd * (q + 1) : r * (q + 1) + (xcd - r) * q) + off; }
        const int nig = WGM * nN, gid = wgid / nig, fm = gid * WGM, gsz = (nM - fm) < WGM ? (nM - fm) : WGM;
        u.pm = fm + ((wgid % nig) % gsz); u.pn = (wgid % nig) / gsz; return true;
    }
    __device__ __forceinline__ void a_ready(const Unit&) const {}
    __device__ __forceinline__ void done(const Unit&) const {}
};

__device__ __forceinline__ unsigned cvt_pk_bf16(float lo, float hi) { unsigned r; asm volatile("v_cvt_pk_bf16_f32 %0, %1, %2" : "=v"(r) : "v"(lo), "v"(hi)); return r; }
struct EpiRoute {
    static constexpr bool PERM = true, AFTER_DRAIN = false, MIDK = false;
    bf16_t* O; int ldc; int mode; bf16_t *QGp, *Kp, *Vp, *XRp;
    __device__ __forceinline__ void operator()(const f32x4 (&acc)[2][2][4][2], const Unit& u, int wr, int wc, int fr, int fq) const {
        bf16_t* base = O; int ld = ldc; int colt = u.pn * BM; int rowadd = 0;
        if (mode == 1) {
            const int pn = u.pn;
            if (pn < 4) { base = QGp; ld = 2048; colt = pn * 256; }
            else if (pn == 4) { base = Kp; ld = 256; colt = 0; }
            else if (pn == 5) { base = Vp; ld = 256; colt = 0; }
            else if (pn < 10) { base = XRp; ld = 1024; colt = (pn - 6) * 256; const int seq = u.pm < 128 ? (u.pm >> 4) : 8 + ((u.pm - 128) >> 5); rowadd = 64 * (seq + 1); }
            else { base = QGp; ld = 2048; colt = 1024 + (pn - 10) * 256; }
        }
        const int row0 = u.pm * BM + wr * 64 + fr + rowadd; const int col0 = colt + wc * 32 + 8 * fq;
#pragma unroll
        for (int ai = 0; ai < 2; ++ai)
#pragma unroll
            for (int m = 0; m < 4; ++m) { bf16_t* rowp = base + (size_t)(row0 + ai * HALF + m * 16) * ld + col0;
#pragma unroll
                for (int bj = 0; bj < 2; ++bj) { const f32x4 v0 = acc[ai][bj][m][0], v1 = acc[ai][bj][m][1];
                    u32x4 w; w.x = cvt_pk_bf16(v0[0], v0[1]); w.y = cvt_pk_bf16(v0[2], v0[3]); w.z = cvt_pk_bf16(v1[0], v1[1]); w.w = cvt_pk_bf16(v1[2], v1[3]);
                    *(u32x4*)(rowp + bj * HALF) = w; } }
    }
};

__device__ __forceinline__ float dpp_shr1(float old, float src) { return __builtin_bit_cast(float, __builtin_amdgcn_update_dpp(__builtin_bit_cast(int, old), __builtin_bit_cast(int, src), 0x111, 0xF, 0xF, false)); }
__device__ __forceinline__ float dpp_shl1(float old, float src) { return __builtin_bit_cast(float, __builtin_amdgcn_update_dpp(__builtin_bit_cast(int, old), __builtin_bit_cast(int, src), 0x101, 0xF, 0xF, false)); }
__device__ __forceinline__ float dpp_ror1(float src)  { return __builtin_bit_cast(float, __builtin_amdgcn_update_dpp(0, __builtin_bit_cast(int, src), 0x121, 0xF, 0xF, false)); }
__device__ __forceinline__ float dpp_ror15(float src) { return __builtin_bit_cast(float, __builtin_amdgcn_update_dpp(0, __builtin_bit_cast(int, src), 0x12F, 0xF, 0xF, false)); }
struct EpiAct {
    static constexpr bool PERM = true, AFTER_DRAIN = false, MIDK = false;
    bf16_t* ACT; float* EDGE; const float* cw; const float* cb; int nch;
    __device__ __forceinline__ void operator()(const f32x4 (&acc)[2][2][4][2], const Unit& u, int wr, int wc, int fr, int fq) const {
        const int ch0 = u.pn * 128 + wc * 32 + 8 * fq;
        float w0[8], w1[8], w2[8], bb[8];
        { const f32x4 a0 = *(const f32x4*)(cw + ch0), a1 = *(const f32x4*)(cw + ch0 + 4), b0 = *(const f32x4*)(cw + nch + ch0), b1 = *(const f32x4*)(cw + nch + ch0 + 4),
                      c0 = *(const f32x4*)(cw + 2 * nch + ch0), c1 = *(const f32x4*)(cw + 2 * nch + ch0 + 4), d0 = *(const f32x4*)(cb + ch0), d1 = *(const f32x4*)(cb + ch0 + 4);
#pragma unroll
          for (int k = 0; k < 4; ++k) { w0[k] = a0[k]; w0[4 + k] = a1[k]; w1[k] = b0[k]; w1[4 + k] = b1[k]; w2[k] = c0[k]; w2[4 + k] = c1[k]; bb[k] = d0[k]; bb[4 + k] = d1[k]; } }
        const int rowb = u.pm * BM + wr * 64;
#pragma unroll
        for (int ai = 0; ai < 2; ++ai) {
            float ein0[8], ein1[8];
#pragma unroll
            for (int m = 0; m < 4; ++m) {
                float o[8];
#pragma unroll
                for (int n = 0; n < 2; ++n)
#pragma unroll
                    for (int k = 0; k < 4; ++k) {
                        const int j = 4 * n + k; const float cur = acc[ai][0][m][n][k];
                        float pold = 0.f, nold = 0.f;
                        if (m > 0) pold = dpp_ror1(acc[ai][0][m > 0 ? m - 1 : 0][n][k]);
                        if (m < 3) nold = dpp_ror15(acc[ai][0][m < 3 ? m + 1 : 3][n][k]);
                        const float prv = dpp_shr1(pold, cur), nxt = dpp_shl1(nold, cur);
                        const float x = bb[j] + w0[j] * prv + w1[j] * cur + w2[j] * nxt;
                        o[j] = x * __builtin_amdgcn_rcpf(1.f + __builtin_amdgcn_exp2f(-1.4426950408889634f * x)) * acc[ai][1][m][n][k];
                        if (m == 0) ein0[j] = nxt;
                        if (m == 3) ein1[j] = prv;
                    }
                u32x4 w; w.x = cvt_pk_bf16(o[0], o[1]); w.y = cvt_pk_bf16(o[2], o[3]); w.z = cvt_pk_bf16(o[4], o[5]); w.w = cvt_pk_bf16(o[6], o[7]);
                *(u32x4*)(ACT + (size_t)(rowb + ai * HALF + m * 16 + fr) * nch + ch0) = w;
            }
            const int blk = (rowb + ai * HALF) >> 6;
            if (fr == 0 || fr == 15) {
                const bool last = fr == 15; float* e = EDGE + (size_t)((blk * 2 + (last ? 1 : 0)) * 3) * nch + ch0;
                f32x4 i0v, i1v, s0v, s1v, u0v, u1v;
#pragma unroll
                for (int k = 0; k < 4; ++k) { i0v[k] = last ? ein1[k] : ein0[k]; i1v[k] = last ? ein1[4 + k] : ein0[4 + k];
                    s0v[k] = last ? acc[ai][0][3][0][k] : acc[ai][0][0][0][k]; s1v[k] = last ? acc[ai][0][3][1][k] : acc[ai][0][0][1][k];
                    u0v[k] = last ? acc[ai][1][3][0][k] : acc[ai][1][0][0][k]; u1v[k] = last ? acc[ai][1][3][1][k] : acc[ai][1][0][1][k]; }
                *(f32x4*)(e) = i0v; *(f32x4*)(e + 4) = i1v; *(f32x4*)(e + nch) = s0v; *(f32x4*)(e + nch + 4) = s1v; *(f32x4*)(e + 2 * nch) = u0v; *(f32x4*)(e + 2 * nch + 4) = u1v;
            }
        }
    }
};

struct ProbeOrder : StaticOrder { int pmask;
    __host__ __device__ bool next(int i, Unit& u) const { const bool r = StaticOrder::next(i, u); u.pm &= pmask; return r; } };

struct EpiScaled {
    static constexpr bool PERM = true, AFTER_DRAIN = false, MIDK = true;
    bf16_t* O; int ldc; const float* ratio; const float* rl; int kt;
    __device__ __forceinline__ void midk(f32x4 (&acc)[2][2][4][2], const Unit& u, int wr, int fr) const {
        asm volatile("" ::: "memory");
        const float* rp = ratio + (u.pm * BM + wr * 64 + fr);
        float s[2][4];
#pragma unroll
        for (int ai = 0; ai < 2; ++ai)
#pragma unroll
            for (int m = 0; m < 4; ++m) s[ai][m] = rp[ai * HALF + m * 16];
#pragma unroll
        for (int ai = 0; ai < 2; ++ai)
#pragma unroll
            for (int m = 0; m < 4; ++m)
#pragma unroll
                for (int bj = 0; bj < 2; ++bj)
#pragma unroll
                    for (int n = 0; n < 2; ++n) acc[ai][bj][m][n] = acc[ai][bj][m][n] * s[ai][m];
        asm volatile("" ::: "memory");
    }
    __device__ __forceinline__ void operator()(const f32x4 (&acc)[2][2][4][2], const Unit& u, int wr, int wc, int fr, int fq) const {
        const int row0 = u.pm * BM + wr * 64 + fr, col0 = u.pn * BM + wc * 32 + 8 * fq;
#pragma unroll
        for (int ai = 0; ai < 2; ++ai)
#pragma unroll
            for (int m = 0; m < 4; ++m) { const int row = row0 + ai * HALF + m * 16; const float s = rl[row]; bf16_t* rowp = O + (size_t)row * ldc + col0;
#pragma unroll
                for (int bj = 0; bj < 2; ++bj) { const f32x4 v0 = acc[ai][bj][m][0] * s, v1 = acc[ai][bj][m][1] * s;
                    u32x4 w; w.x = cvt_pk_bf16(v0[0], v0[1]); w.y = cvt_pk_bf16(v0[2], v0[3]); w.z = cvt_pk_bf16(v1[0], v1[1]); w.w = cvt_pk_bf16(v1[2], v1[3]);
                    *(u32x4*)(rowp + bj * HALF) = w; } }
    }
};

template <class Epi, class Sched, bool ALIGN_EPI = false, bool SP2 = false>
__device__ __forceinline__ void gemm_phase(PG8_LAS unsigned char* lds, const Gemm g, const Sched& S, const Epi& E, int wave_id) {
    int tid_ = wave_id * 64 + lane_id_now(); asm volatile("" : "+v"(tid_));
    const int tid = tid_, wid = __builtin_amdgcn_readfirstlane(tid >> 6), lane = tid & 63, wr = wid >> 2, wc = wid & 3, fr = lane & 15, fq = lane >> 4;
    const int K = g.K, nt = K / BK;
    unsigned voffA[2], voffB[2];
#pragma unroll
    for (int i = 0; i < 2; ++i) { int R, C; stage_rc(tid * 16 + i * 8192, R, C); const int Rb = Epi::PERM ? ((R & ~31) + perm32(R & 31)) : R;
        voffA[i] = (unsigned)(R * K + C) * 2u; voffB[i] = (unsigned)(Rb * K + C) * 2u; }
    const size_t kstep = (size_t)(BK * 2);
    const size_t hstep = (size_t)HALF * K * 2;
    const size_t tstep = 2 * hstep;
    const unsigned ldsw = (unsigned)wid * 1024u;
    const int aoff = lds_byte(wr * 64 + fr, fq * 8), boff = lds_byte(wc * 32 + fr, fq * 8);
#define PG8_SA(b, h) (((b) * 2 + (h)) * HTB)
#define PG8_SB(b, h) ((4 + (b) * 2 + (h)) * HTB)
#define PG8_STAGE(bufoff, gbase, voff) do { _Pragma("unroll") for (int _i = 0; _i < 2; ++_i) \
        __builtin_amdgcn_global_load_lds((const unsigned*)((const char*)(gbase) + (voff)[_i]), (PG8_LAS unsigned*)(lds + (bufoff) + ldsw + _i * 8192), 16, 0, 0); } while (0)
#define PG8_LDA(dst, b, h) do { _Pragma("unroll") for (int m = 0; m < 4; ++m) _Pragma("unroll") for (int k = 0; k < 2; ++k) dst[m][k] = *(const PG8_LAS bf16x8*)(lds + PG8_SA(b, h) + aoff + m * 2048 + k * 1024); } while (0)
#define PG8_LDB(dst, b, h) do { _Pragma("unroll") for (int n = 0; n < 2; ++n) _Pragma("unroll") for (int k = 0; k < 2; ++k) dst[n][k] = *(const PG8_LAS bf16x8*)(lds + PG8_SB(b, h) + boff + n * 2048 + k * 1024); } while (0)
#define PG8_MMA(ai, bj, At, Bt) do { __builtin_amdgcn_s_setprio(1); _Pragma("unroll") for (int m = 0; m < 4; ++m) _Pragma("unroll") for (int n = 0; n < 2; ++n) _Pragma("unroll") for (int k = 0; k < 2; ++k) \
        acc[ai][bj][m][n] = __builtin_amdgcn_mfma_f32_16x16x32_bf16(Bt[n][k], At[m][k], acc[ai][bj][m][n], 0, 0, 0); __builtin_amdgcn_s_setprio(0); } while (0)
#define PG8_WAIT_V(n) asm volatile("s_waitcnt vmcnt(" #n ")" ::: "memory")
#define PG8_WAIT_L(n) asm volatile("s_waitcnt lgkmcnt(" #n ")" ::: "memory")
#define PG8_BAR __builtin_amdgcn_s_barrier()
#define PG8_SCHED __builtin_amdgcn_sched_barrier(0)
    Unit cur, nxt; int ui = 0;
    if (!S.next(0, cur)) return;
    f32x4 acc[2][2][4][2];
#pragma unroll
    for (int a = 0; a < 2; ++a)
#pragma unroll
        for (int b = 0; b < 2; ++b)
#pragma unroll
            for (int m = 0; m < 4; ++m)
#pragma unroll
                for (int n = 0; n < 2; ++n) acc[a][b][m][n] = (f32x4){0.f, 0.f, 0.f, 0.f};
    bf16x8 At[4][2], B0[2][2], B1[2][2];
    const char* cA = (const char*)g.A + (size_t)cur.pm * tstep; const char* cB = (const char*)g.Bt + (size_t)cur.pn * tstep;
    S.a_ready(cur);
    if constexpr (SP2) {
        PG8_STAGE(PG8_SB(0, 0), cB, voffB); PG8_STAGE(PG8_SB(0, 1), cB + hstep, voffB); PG8_STAGE(PG8_SA(0, 0), cA, voffA); PG8_STAGE(PG8_SA(0, 1), cA + hstep, voffA);
        if (wr == 1) PG8_BAR;
        PG8_WAIT_V(2); PG8_BAR;
        PG8_STAGE(PG8_SB(1, 0), cB + kstep, voffB); PG8_STAGE(PG8_SA(1, 0), cA + kstep, voffA); PG8_STAGE(PG8_SB(1, 1), cB + hstep + kstep, voffB);
        PG8_WAIT_V(6); PG8_BAR;
    } else {
        PG8_STAGE(PG8_SB(0, 0), cB, voffB); PG8_STAGE(PG8_SA(0, 0), cA, voffA); PG8_STAGE(PG8_SB(0, 1), cB + hstep, voffB); PG8_STAGE(PG8_SA(0, 1), cA + hstep, voffA);
        if (wr == 1) PG8_BAR;
        PG8_WAIT_V(4); PG8_BAR;
        PG8_STAGE(PG8_SB(1, 0), cB + kstep, voffB); PG8_STAGE(PG8_SA(1, 0), cA + kstep, voffA); PG8_STAGE(PG8_SB(1, 1), cB + hstep + kstep, voffB);
        PG8_WAIT_V(6); PG8_BAR;
    }
    for (;;) {
        const bool has_next = S.next(ui + 1, nxt);
        const char* nA = has_next ? (const char*)g.A + (size_t)nxt.pm * tstep : cA; const char* nB = has_next ? (const char*)g.Bt + (size_t)nxt.pn * tstep : cB;
        for (int t = 0; t < nt; t += 2) {
            if constexpr (Epi::MIDK) { if (t == E.kt) E.midk(acc, cur, wr, fr); }
            const bool last = (t == nt - 2);
            const char* a1 = cA + (size_t)(t + 1) * kstep;
            const char* a2 = last ? nA : cA + (size_t)(t + 2) * kstep; const char* b2 = last ? nB : cB + (size_t)(t + 2) * kstep;
            const char* a3 = a2 + kstep; const char* b3 = b2 + kstep;
            if (last && has_next) S.a_ready(nxt);
            if constexpr (SP2) {
            PG8_LDB(B0, 0, 0); PG8_LDB(B1, 0, 1); PG8_SCHED; PG8_LDA(At, 0, 0); PG8_STAGE(PG8_SA(1, 1), a1 + hstep, voffA);
            PG8_WAIT_V(8); PG8_WAIT_L(0); PG8_BAR; PG8_MMA(0, 0, At, B0); PG8_MMA(0, 1, At, B1); PG8_BAR; PG8_SCHED;
            PG8_LDA(At, 0, 1); PG8_STAGE(PG8_SB(0, 0), b2, voffB); PG8_STAGE(PG8_SB(0, 1), b2 + hstep, voffB); PG8_STAGE(PG8_SA(0, 0), a2, voffA);
            PG8_WAIT_V(8); PG8_WAIT_L(0); PG8_BAR; PG8_MMA(1, 0, At, B0); PG8_MMA(1, 1, At, B1); PG8_BAR; PG8_SCHED;
            PG8_LDB(B0, 1, 0); PG8_LDB(B1, 1, 1); PG8_SCHED; PG8_LDA(At, 1, 0); PG8_STAGE(PG8_SA(0, 1), a2 + hstep, voffA);
            PG8_WAIT_V(8); PG8_WAIT_L(0); PG8_BAR; PG8_MMA(0, 0, At, B0); PG8_MMA(0, 1, At, B1); PG8_BAR; PG8_SCHED;
            PG8_LDA(At, 1, 1); PG8_STAGE(PG8_SB(1, 0), b3, voffB); PG8_STAGE(PG8_SB(1, 1), b3 + hstep, voffB); PG8_STAGE(PG8_SA(1, 0), a3, voffA);
            PG8_WAIT_V(8); PG8_WAIT_L(0); PG8_BAR; PG8_MMA(1, 0, At, B0); PG8_MMA(1, 1, At, B1); PG8_BAR; PG8_SCHED;
            } else {
            PG8_LDB(B0, 0, 0); PG8_SCHED; PG8_LDA(At, 0, 0); PG8_STAGE(PG8_SA(1, 1), a1 + hstep, voffA);
            PG8_WAIT_L(8); PG8_BAR; PG8_WAIT_L(0); PG8_MMA(0, 0, At, B0); PG8_BAR; PG8_SCHED;
            PG8_LDB(B1, 0, 1); PG8_STAGE(PG8_SB(0, 0), b2, voffB);
            PG8_BAR; PG8_WAIT_L(0); PG8_MMA(0, 1, At, B1); PG8_BAR;
            PG8_LDA(At, 0, 1); PG8_STAGE(PG8_SA(0, 0), a2, voffA);
            PG8_BAR; PG8_WAIT_L(0); PG8_MMA(1, 0, At, B0); PG8_BAR; PG8_SCHED;
            PG8_STAGE(PG8_SB(0, 1), b2 + hstep, voffB);
            PG8_WAIT_V(6); PG8_BAR; PG8_MMA(1, 1, At, B1); PG8_BAR;
            PG8_LDB(B0, 1, 0); PG8_SCHED; PG8_LDA(At, 1, 0); PG8_STAGE(PG8_SA(0, 1), a2 + hstep, voffA);
            PG8_WAIT_L(8); PG8_BAR; PG8_WAIT_L(0); PG8_MMA(0, 0, At, B0); PG8_BAR; PG8_SCHED;
            PG8_LDB(B1, 1, 1); PG8_STAGE(PG8_SB(1, 0), b3, voffB);
            PG8_BAR; PG8_WAIT_L(0); PG8_MMA(0, 1, At, B1); PG8_BAR;
            PG8_LDA(At, 1, 1); PG8_STAGE(PG8_SA(1, 0), a3, voffA);
            PG8_BAR; PG8_WAIT_L(0); PG8_MMA(1, 0, At, B0); PG8_BAR; PG8_SCHED;
            PG8_STAGE(PG8_SB(1, 1), b3 + hstep, voffB);
            PG8_WAIT_V(6); PG8_BAR; PG8_MMA(1, 1, At, B1); PG8_BAR;
            }
        }
        if constexpr (ALIGN_EPI) { if (wr == 0) PG8_BAR; }
        if constexpr (!Epi::AFTER_DRAIN) { E(acc, cur, wr, wc, fr, fq); S.done(cur); }
        if (!has_next) break;
#pragma unroll
        for (int a = 0; a < 2; ++a)
#pragma unroll
            for (int b = 0; b < 2; ++b)
#pragma unroll
                for (int m = 0; m < 4; ++m)
#pragma unroll
                    for (int n = 0; n < 2; ++n) acc[a][b][m][n] = (f32x4){0.f, 0.f, 0.f, 0.f};
        cur = nxt; cA = nA; cB = nB; ++ui;
        if constexpr (ALIGN_EPI) { if (wr == 1) PG8_BAR; }
    }
    PG8_WAIT_V(0);
    if constexpr (!ALIGN_EPI) { if (wr == 0) PG8_BAR; }
    PG8_BAR;
    if constexpr (Epi::AFTER_DRAIN) { E.fused(acc, cur, wr, wc, fr, fq, lds, wid, lane); S.done(cur); }
#undef PG8_SA
#undef PG8_SB
#undef PG8_STAGE
#undef PG8_LDA
#undef PG8_LDB
#undef PG8_MMA
#undef PG8_WAIT_V
#undef PG8_WAIT_L
#undef PG8_BAR
#undef PG8_SCHED
}
}
namespace attn {
typedef unsigned short bf16r;
using bf16x8 = __attribute__((ext_vector_type(8))) short;
using s16x4  = __attribute__((ext_vector_type(4))) short;
using f32x4  = __attribute__((ext_vector_type(4))) float;
using u32x4  = __attribute__((ext_vector_type(4))) unsigned;
constexpr int   QBLK = 32, KVBLK = 64;
constexpr float SCALE = 0.088388347648318440f;
constexpr float THRL = 8.f;
constexpr int LDQ = 2048, LDK = 256, LDO = 2048;
constexpr size_t SHM_ATTN = 6 * 16384 + 8 * 64 * 4;
#define SBAR() __builtin_amdgcn_sched_barrier(0)
__device__ __forceinline__ unsigned cvtpk(float lo, float hi) { unsigned r; asm volatile("v_cvt_pk_bf16_f32 %0, %1, %2" : "=v"(r) : "v"(lo), "v"(hi)); return r; }
__device__ __forceinline__ unsigned short f2bf_rne(float f) { unsigned u = __builtin_bit_cast(unsigned, f); return (unsigned short)((u + 0x7fffu + ((u >> 16) & 1u)) >> 16); }
__device__ __forceinline__ float bfl(short b) { return __builtin_bit_cast(float, (unsigned)(unsigned short)b << 16); }
template <int OFF> __device__ __forceinline__ s16x4 tr_read(int vb) { s16x4 r; asm volatile("ds_read_b64_tr_b16 %0, %1 offset:%2" : "=&v"(r) : "v"(vb), "i"(OFF) : "memory"); return r; }

__device__ __forceinline__ void qkt16(f32x4 (&S)[4][2], const char* Ks, int kb0, const bf16x8 (&qf)[2][4], float nm0, float nm1) {
  const f32x4 n0 = {nm0, nm0, nm0, nm0}, n1 = {nm1, nm1, nm1, nm1};
#pragma unroll
  for (int kb = 0; kb < 4; ++kb)
#pragma unroll
    for (int ds = 0; ds < 4; ++ds) { const bf16x8 kf = *reinterpret_cast<const bf16x8*>(Ks + kb * 4096 + (kb0 ^ (64 * ds)));
      S[kb][0] = __builtin_amdgcn_mfma_f32_16x16x32_bf16(kf, qf[0][ds], ds == 0 ? n0 : S[kb][0], 0, 0, 0);
      S[kb][1] = __builtin_amdgcn_mfma_f32_16x16x32_bf16(kf, qf[1][ds], ds == 0 ? n1 : S[kb][1], 0, 0, 0); }
}
__device__ __forceinline__ void mask_meta16(f32x4 (&S)[4][2]) {
  const float NEG = -INFINITY;
#pragma unroll
  for (int kb = 1; kb < 4; ++kb)
#pragma unroll
    for (int qb = 0; qb < 2; ++qb) S[kb][qb] = (f32x4){NEG, NEG, NEG, NEG};
}
__device__ __forceinline__ void partial16(f32x4 (&S)[4][2], float (&mhat)[2], float (&alpha)[2], bool first) {
  float pm[2];
#pragma unroll
  for (int qb = 0; qb < 2; ++qb) { float a = __builtin_fmaxf(__builtin_fmaxf(S[0][qb][0], S[0][qb][1]), S[0][qb][2]), b = __builtin_fmaxf(__builtin_fmaxf(S[0][qb][3], S[1][qb][0]), S[1][qb][1]);
    a = __builtin_fmaxf(__builtin_fmaxf(a, S[1][qb][2]), S[1][qb][3]); b = __builtin_fmaxf(__builtin_fmaxf(b, S[2][qb][0]), S[2][qb][1]);
    a = __builtin_fmaxf(__builtin_fmaxf(a, S[2][qb][2]), S[2][qb][3]); b = __builtin_fmaxf(__builtin_fmaxf(b, S[3][qb][0]), S[3][qb][1]);
    a = __builtin_fmaxf(__builtin_fmaxf(a, S[3][qb][2]), S[3][qb][3]); pm[qb] = __builtin_fmaxf(a, b); }
  alpha[0] = 1.f; alpha[1] = 1.f;
  if (first || __builtin_expect(__any(__builtin_fmaxf(pm[0], pm[1]) > THRL), 0)) {
#pragma unroll
    for (int qb = 0; qb < 2; ++qb) { float m = pm[qb]; m = __builtin_fmaxf(m, __shfl_xor(m, 16)); m = __builtin_fmaxf(m, __shfl_xor(m, 32));
      const float dl = first ? m : __builtin_fmaxf(m, 0.f); mhat[qb] += dl;
#pragma unroll
      for (int kb = 0; kb < 4; ++kb) S[kb][qb] = S[kb][qb] - dl;
      if (!first) alpha[qb] = __builtin_amdgcn_exp2f(-dl); }
  }
#pragma unroll
  for (int kb = 0; kb < 2; ++kb)
#pragma unroll
    for (int qb = 0; qb < 2; ++qb)
#pragma unroll
      for (int r = 0; r < 4; ++r) S[kb][qb][r] = __builtin_amdgcn_exp2f(S[kb][qb][r]);
}
__device__ __forceinline__ void finish16(f32x4 (&S)[4][2], const float (&alpha)[2], float (&lsum)[2], bf16x8 (&pa)[2][2]) {
#pragma unroll
  for (int kb = 2; kb < 4; ++kb)
#pragma unroll
    for (int qb = 0; qb < 2; ++qb)
#pragma unroll
      for (int r = 0; r < 4; ++r) S[kb][qb][r] = __builtin_amdgcn_exp2f(S[kb][qb][r]);
#pragma unroll
  for (int qb = 0; qb < 2; ++qb) { float ps = 0.f;
#pragma unroll
    for (int kb = 0; kb < 4; ++kb) ps += (S[kb][qb][0] + S[kb][qb][1]) + (S[kb][qb][2] + S[kb][qb][3]);
    lsum[qb] = lsum[qb] * alpha[qb] + ps;
#pragma unroll
    for (int ks = 0; ks < 2; ++ks) { const f32x4 a = S[2 * ks][qb], b = S[2 * ks + 1][qb];
      u32x4 w = {cvtpk(a[0], a[1]), cvtpk(a[2], a[3]), cvtpk(b[0], b[1]), cvtpk(b[2], b[3])}; pa[qb][ks] = *reinterpret_cast<bf16x8*>(&w); } }
}
template <int KS, int DB> __device__ __forceinline__ void pv_one16(f32x4 (&O)[2][8], int vbA, int vbB, const bf16x8 (&pa)[2][2]) {
  const int vb = DB < 7 ? vbA : vbB;
  const s16x4 lo = tr_read<(8 * KS) * 1024 + 128 * DB>(vb), hi = tr_read<(8 * KS + 4) * 1024 + 128 * DB>(vb);
  asm volatile("s_waitcnt lgkmcnt(0)" ::: "memory"); SBAR();
  const bf16x8 bfr = {lo[0], lo[1], lo[2], lo[3], hi[0], hi[1], hi[2], hi[3]};
  O[0][DB] = __builtin_amdgcn_mfma_f32_16x16x32_bf16(pa[0][KS], bfr, O[0][DB], 0, 0, 0);
  O[1][DB] = __builtin_amdgcn_mfma_f32_16x16x32_bf16(pa[1][KS], bfr, O[1][DB], 0, 0, 0);
}
template <int KS> __device__ __forceinline__ void pv_ks16(f32x4 (&O)[2][8], int vbA, int vbB, const bf16x8 (&pa)[2][2]) {
  pv_one16<KS, 0>(O, vbA, vbB, pa); pv_one16<KS, 1>(O, vbA, vbB, pa); pv_one16<KS, 2>(O, vbA, vbB, pa); pv_one16<KS, 3>(O, vbA, vbB, pa);
  pv_one16<KS, 4>(O, vbA, vbB, pa); pv_one16<KS, 5>(O, vbA, vbB, pa); pv_one16<KS, 6>(O, vbA, vbB, pa); pv_one16<KS, 7>(O, vbA, vbB, pa);
}
__device__ __forceinline__ void pv16(f32x4 (&O)[2][8], int vbA, int vbB, const bf16x8 (&pa)[2][2]) { pv_ks16<0>(O, vbA, vbB, pa); pv_ks16<1>(O, vbA, vbB, pa); }

__device__ __forceinline__ void attn_unit(const bf16r* Qb, const bf16r* __restrict__ Kh, const bf16r* __restrict__ Vh,
                                          const bf16r* __restrict__ KMh, const bf16r* __restrict__ VMh, bf16r* Ob, int NT, char* lds,
                                          const float* __restrict__ qnorm, int t0, float* ssq, int wave_id) {
  int tid_ = wave_id * 64 + lane_id_now(); asm volatile("" : "+v"(tid_));
  const int tid = tid_, wid = tid >> 6, lane = tid & 63, c = lane & 15, g = lane >> 4;
  float* ws = (float*)(lds + 6 * 16384) + wid * 64; float* li_l = ws; float* al_l = ws + 32;
  float mhat[2] = {0.f, 0.f}, lsum[2] = {0.f, 0.f};
  f32x4 O[2][8];
#pragma unroll
  for (int qb = 0; qb < 2; ++qb)
#pragma unroll
    for (int db = 0; db < 8; ++db) O[qb][db] = (f32x4){0.f, 0.f, 0.f, 0.f};
  bf16x8 qf[2][4];
#pragma unroll
  for (int qb = 0; qb < 2; ++qb)
#pragma unroll
    for (int ds = 0; ds < 4; ++ds) qf[qb][ds] = *reinterpret_cast<const bf16x8*>(Qb + (long)(wid * QBLK + 16 * qb + c) * LDQ + 32 * ds + 8 * g);
  {
    int go = g; asm volatile("" : "+v"(go));
#pragma unroll
    for (int qb = 0; qb < 2; ++qb) {
      float ss = 0.f;
#pragma unroll
      for (int ds = 0; ds < 4; ++ds)
#pragma unroll
        for (int j = 0; j < 8; ++j) { const float x = bfl(qf[qb][ds][j]); ss += x * x; }
      ss += __shfl_xor(ss, 16); ss += __shfl_xor(ss, 32);
      const float rs = (SCALE * 1.4426950408889634f) / sqrtf(ss * (1.f / 128.f) + 1e-6f);
      int t = t0 + wid * QBLK + 16 * qb + c; asm volatile("" : "+v"(t));
#pragma unroll
      for (int p = 0; p < 2; ++p) { const float pos = (float)(p ? (t & 63) : (t >> 6)); const int fa = 2 * p, fb = 2 * p + 1;
        const float4 ga0 = *reinterpret_cast<const float4*>(qnorm + 32 * fa + 8 * g), ga1 = *reinterpret_cast<const float4*>(qnorm + 32 * fa + 8 * g + 4);
        const float4 gb0 = *reinterpret_cast<const float4*>(qnorm + 32 * fb + 8 * g), gb1 = *reinterpret_cast<const float4*>(qnorm + 32 * fb + 8 * g + 4);
        const float gaf[8] = {ga0.x, ga0.y, ga0.z, ga0.w, ga1.x, ga1.y, ga1.z, ga1.w}, gbf[8] = {gb0.x, gb0.y, gb0.z, gb0.w, gb1.x, gb1.y, gb1.z, gb1.w};
        float oa[8], ob[8];
#pragma unroll
        for (int j = 0; j < 8; ++j) { const int i = 8 * go + j;
          float rev = pos * __builtin_amdgcn_exp2f(-(float)i * (13.287712379549449f / 32.f)) * 0.15915494309189535f; rev -= floorf(rev);
          const float sn = __builtin_amdgcn_sinf(rev), cs = __builtin_amdgcn_cosf(rev);
          const float x1 = bfl(qf[qb][fa][j]) * rs * gaf[j], x2 = bfl(qf[qb][fb][j]) * rs * gbf[j];
          oa[j] = x1 * cs - x2 * sn; ob[j] = x2 * cs + x1 * sn; }
        { u32x4 w = {cvtpk(oa[0], oa[1]), cvtpk(oa[2], oa[3]), cvtpk(oa[4], oa[5]), cvtpk(oa[6], oa[7])}; qf[qb][fa] = *reinterpret_cast<bf16x8*>(&w); }
        { u32x4 w = {cvtpk(ob[0], ob[1]), cvtpk(ob[2], ob[3]), cvtpk(ob[4], ob[5]), cvtpk(ob[6], ob[7])}; qf[qb][fb] = *reinterpret_cast<bf16x8*>(&w); }
        SBAR(); }
    }
  }
  unsigned kgo0, vgo0;
  { const int k0 = 4 * wid + g; kgo0 = (unsigned)(k0 * (LDK * 2) + ((c << 4) ^ ((k0 & 15) << 4)));
    const int r = (lane >> 1) & 3, half = lane & 1, s8 = lane >> 3;
    { const int p = wid,     db = (s8 - (p & 1)) & 7; vgo0 = (unsigned)((4 * p + r) * (LDK * 2) + (16 * db + 8 * half) * 2); }
 }
  const int kb0 = c * 256 + ((g ^ c) << 4);
  typedef __attribute__((address_space(3))) unsigned char* ldsp_t;
  const ldsp_t lds3 = (ldsp_t)lds;
  const int w1k = __builtin_amdgcn_readfirstlane(wid) * 1024;
  constexpr int VRING = 3 * 16384;
#define DMAK(t, soff) do { const char* b_ = (const char*)((t) == 0 ? KMh : Kh + (long)((t) - 1) * KVBLK * LDK); \
    __builtin_amdgcn_global_load_lds((const unsigned*)(b_ + kgo0), (__attribute__((address_space(3))) unsigned*)(lds3 + (soff) + w1k), 16, 0, 0); \
    __builtin_amdgcn_global_load_lds((const unsigned*)(b_ + kgo0 + 32 * LDK * 2), (__attribute__((address_space(3))) unsigned*)(lds3 + (soff) + w1k + 8192), 16, 0, 0); } while (0)
#define DMAV(t, soff) do { const char* b_ = (const char*)((t) == 0 ? VMh : Vh + (long)((t) - 1) * KVBLK * LDK); \
    __builtin_amdgcn_global_load_lds((const unsigned*)(b_ + vgo0), (__attribute__((address_space(3))) unsigned*)(lds3 + VRING + (soff) + w1k), 16, 0, 0); \
    __builtin_amdgcn_global_load_lds((const unsigned*)(b_ + vgo0 + 32 * LDK * 2), (__attribute__((address_space(3))) unsigned*)(lds3 + VRING + (soff) + w1k + 8192), 16, 0, 0); } while (0)
#define WAITBAR(N) asm volatile("s_waitcnt vmcnt(" #N ") lgkmcnt(0)\n\ts_barrier" ::: "memory")
#define ROT() do { const int t_ = sm1; sm1 = sc_; sc_ = sp1; sp1 = t_; } while (0)
#define RESC(a) do { if (__any(__builtin_fminf((a)[0], (a)[1]) < 1.f)) { if (g == 0) { al_l[c] = (a)[0]; al_l[16 + c] = (a)[1]; } asm volatile("s_waitcnt lgkmcnt(0)" ::: "memory"); \
    _Pragma("unroll") for (int qb_ = 0; qb_ < 2; ++qb_) _Pragma("unroll") for (int r_ = 0; r_ < 4; ++r_) { const float a_ = al_l[16 * qb_ + 4 * g + r_]; \
      _Pragma("unroll") for (int db_ = 0; db_ < 8; ++db_) O[qb_][db_][r_] *= a_; } } } while (0)
  const int vlb = (int)(uintptr_t)(lds + VRING) + g * 1024 + (c >> 2) * 32 + (c & 3) * 8;
  const int vbA0 = vlb + (g & 1) * 128, vbB0 = vlb + (g & 1) * (128 - 1024);
  int sm1 = 32768, sc_ = 0, sp1 = 16384;
  f32x4 S[4][2]; bf16x8 paA[2][2], paB[2][2]; float al[2];
  DMAK(0, 0); DMAV(0, 0); DMAK(1, 16384);
  WAITBAR(2);
  DMAK(2, sm1); DMAV(1, sp1);
  qkt16(S, lds + sc_, kb0, qf, -mhat[0], -mhat[1]); mask_meta16(S); partial16(S, mhat, al, true); finish16(S, al, lsum, paA);
  WAITBAR(4); ROT();
  for (int t = 1; t + 1 < NT; t += 2) {
    if (t + 2 < NT) DMAK(t + 2, sm1); DMAV(t + 1, sp1);
    SBAR(); qkt16(S, lds + sc_, kb0, qf, -mhat[0], -mhat[1]); SBAR();
    pv16(O, vbA0 + sm1, vbB0 + sm1, paA); partial16(S, mhat, al, false); finish16(S, al, lsum, paB);
    if (t + 2 < NT) WAITBAR(4); else WAITBAR(2);
    RESC(al); ROT();
    if (t + 3 < NT) DMAK(t + 3, sm1); if (t + 2 < NT) DMAV(t + 2, sp1);
    SBAR(); qkt16(S, lds + sc_, kb0, qf, -mhat[0], -mhat[1]); SBAR();
    pv16(O, vbA0 + sm1, vbB0 + sm1, paB); partial16(S, mhat, al, false); finish16(S, al, lsum, paA);
    if (t + 3 < NT) WAITBAR(4); else if (t + 2 < NT) WAITBAR(2); else WAITBAR(0);
    RESC(al); ROT();
  }
  pv16(O, vbA0 + sm1, vbB0 + sm1, paA);
#pragma unroll
  for (int qb = 0; qb < 2; ++qb) { float L = lsum[qb]; L += __shfl_xor(L, 16); L += __shfl_xor(L, 32); if (g == 0) li_l[16 * qb + c] = L; }
  asm volatile("s_waitcnt lgkmcnt(0)" ::: "memory");
  bf16r* Ow = Ob + (long)(wid * QBLK) * LDO;
#pragma unroll
  for (int qb = 0; qb < 2; ++qb)
#pragma unroll
    for (int r = 0; r < 4; ++r) { const int orow = 16 * qb + 4 * g + r; const float rl = __builtin_amdgcn_rcpf(li_l[orow]); float sq = 0.f;
#pragma unroll
      for (int db = 0; db < 8; ++db) { const float v = O[qb][db][r] * rl; sq += v * v; Ow[(long)orow * LDO + 16 * db + c] = f2bf_rne(v); }
      sq += __shfl_xor(sq, 1); sq += __shfl_xor(sq, 2); sq += __shfl_xor(sq, 4); sq += __shfl_xor(sq, 8);
      if (c == 0) ssq[(long)(wid * QBLK + orow) * 8] = sq; }
  WAITBAR(0);
#undef DMAK
#undef DMAV
#undef WAITBAR
#undef ROT
#undef RESC
}
#undef SBAR
}

constexpr int NWAVES = 8;
constexpr int DM = 2048, NTOK = 65536, INW = 3584, FFN = 5632, UPW = 2 * FFN;
constexpr float EPS = 1e-6f;
constexpr int XR_ROWS = 8 * 4160 + 4 * 8256;
constexpr int NCHUNK = 8 * 65 + 4 * 129;
constexpr int HROWS = 32768;
__host__ __device__ __forceinline__ int seq_first_row(int s) { return s < 8 ? s * 4096 : 32768 + (s - 8) * 8192; }
__host__ __device__ __forceinline__ int seq_len(int s) { return s < 8 ? 4096 : 8192; }
__host__ __device__ __forceinline__ int xr_base(int s) { return s < 8 ? s * 4160 : 33280 + (s - 8) * 8256; }
__host__ __device__ __forceinline__ int chunk_base(int s) { return s < 8 ? s * 65 : 520 + (s - 8) * 129; }
__host__ __device__ __forceinline__ int row_seq(int row) { return row < 32768 ? (row >> 12) : 8 + ((row - 32768) >> 13); }

constexpr size_t MiB = 1u << 20, KiB = 1u << 10;
constexpr size_t WS_CTL = 0, CTL_ZERO_BYTES = 1 * MiB;
constexpr size_t WS_SMALL = 1 * MiB;
constexpr size_t WS_XNMETA = WS_SMALL + 0, WS_ZM = WS_SMALL + 64 * KiB, WS_KM = WS_SMALL + 320 * KiB, WS_VM = WS_SMALL + 352 * KiB, WS_Q15 = WS_SMALL + 384 * KiB, WS_GY15 = WS_SMALL + 388 * KiB,
                 WS_LO15 = WS_SMALL + 392 * KiB, WS_MIXED15 = WS_SMALL + 448 * KiB, WS_Y15 = WS_SMALL + 544 * KiB, WS_G15 = WS_SMALL + 640 * KiB, WS_MQP = WS_SMALL + 1024 * KiB;
constexpr size_t WS_WIN = 5 * MiB, WS_WOUT = 19 * MiB, WS_WUP = 27 * MiB, WS_WDOWN = 71 * MiB, WS_WG = 93 * MiB;
constexpr size_t WS_CAR = 94 * MiB, WS_CIN = 111 * MiB;
constexpr size_t WS_R0 = 120 * MiB, WS_RATIO = 120 * MiB + 256 * KiB, WS_RL = 120 * MiB + 512 * KiB, WS_SSQA = 121 * MiB, WS_SSQL = 123 * MiB;
constexpr size_t WS_A = 128 * MiB;
constexpr size_t WS_B = 384 * MiB;
constexpr size_t WS_QG = WS_B, WS_K = WS_B + 256 * MiB, WS_V = WS_B + 288 * MiB, WS_XR = WS_B + 320 * MiB;
constexpr size_t WS_ACT = WS_B, WS_EDGE = WS_B + 352 * MiB;
constexpr size_t WS_H1A = WS_B + 420 * MiB;
constexpr size_t WS_END = WS_B + 548 * MiB;
static_assert(WS_ZM + 16 * INW * 4 <= WS_KM && WS_G15 + 12 * FFN * 4 <= WS_MQP && WS_MQP + 512 * 4 * 132 * 4 <= WS_WIN, "small map");
static_assert(WS_WIN + (size_t)INW * DM * 2 <= WS_WOUT && WS_WOUT + (size_t)DM * DM * 2 <= WS_WUP && WS_WUP + (size_t)UPW * DM * 2 <= WS_WDOWN && WS_WDOWN + (size_t)DM * FFN * 2 <= WS_WG && WS_WG + 32 * 16384 * 2 <= WS_CAR, "weights map");
static_assert(WS_CAR + (size_t)NCHUNK * 2 * 1024 * 8 <= WS_CIN && WS_A + (size_t)NTOK * DM * 2 <= WS_B, "carry map");
static_assert(WS_QG + (size_t)NTOK * DM * 2 <= WS_K && WS_XR + (size_t)(XR_ROWS + 64) * 1024 * 2 <= WS_END && WS_EDGE + (size_t)512 * 2 * 3 * FFN * 4 <= WS_H1A && WS_H1A + (size_t)HROWS * DM * 2 <= WS_END && WS_END <= 1024 * MiB && WS_CIN + (size_t)NCHUNK * 2 * 1024 * 4 <= WS_R0 && WS_SSQL + (size_t)NTOK * 8 * 4 <= WS_A && WS_ACT + (size_t)HROWS * FFN * 2 <= WS_EDGE && WS_EDGE + (size_t)512 * 2 * 3 * FFN * 4 <= WS_END, "B map");
constexpr int CW_BAR = 4096;

constexpr int RING_BYTES = 131072;
constexpr int LDSCTL_OFF = RING_BYTES, MISC_OFF = LDSCTL_OFF + 320;
constexpr int LDS_BYTES = 147456;

#define GAS __attribute__((address_space(1)))
#define LAS __attribute__((address_space(3)))
typedef unsigned short bf16;
typedef unsigned v4u __attribute__((ext_vector_type(4)));
typedef float f32x4 __attribute__((ext_vector_type(4)));
typedef short bf16x8 __attribute__((ext_vector_type(8)));
typedef GAS unsigned gu32;
typedef GAS unsigned long long gu64;
#define RLX_AGENT __ATOMIC_RELAXED, __HIP_MEMORY_SCOPE_AGENT
#define LDS_WAIT() asm volatile("s_waitcnt lgkmcnt(0)" ::: "memory")
#define VM_WAIT() asm volatile("s_waitcnt vmcnt(0)" ::: "memory")
__device__ __forceinline__ unsigned long long rt() { return __builtin_amdgcn_s_memrealtime(); }
__device__ __forceinline__ unsigned f2bf(float f) { unsigned u = __builtin_bit_cast(unsigned, f); return (u + 0x7fffu + ((u >> 16) & 1u)) >> 16; }
__device__ __forceinline__ unsigned pk2(float lo, float hi) { return f2bf(lo) | (f2bf(hi) << 16); }

#define XB_TMO      128
#define XB_XCNT(j)  (256  + 64 * (j))
#define XB_XSUB(j)  (1280 + 64 * (j))
#define XB_XGEN(j)  (2304 + 64 * (j))
#define XB_TOP      3328
#define XB_TOPGEN   3392
#define XCD_BAR_WORDS 3456
#define XB_SPIN_CAP (1u << 18)

__device__ __forceinline__ unsigned xb_ld(unsigned* p)              { return __hip_atomic_load(p, __ATOMIC_RELAXED, __HIP_MEMORY_SCOPE_AGENT); }
__device__ __forceinline__ unsigned xb_add(unsigned* p, unsigned v) { return __hip_atomic_fetch_add(p, v, __ATOMIC_RELAXED, __HIP_MEMORY_SCOPE_AGENT); }
__device__ __forceinline__ unsigned xb_xcc_id() { return (unsigned)__builtin_amdgcn_s_getreg((3 << 11) | 20) & 0xFu; }
#define XB_SPIN(cond, bar) do { unsigned _sp = 0; while (cond) { __builtin_amdgcn_s_sleep(1); \
    if ((++_sp & 255u) == 0u) { if (xb_ld(&(bar)[XB_TMO])) break; if (_sp > XB_SPIN_CAP) { atomicAdd(&(bar)[XB_TMO], 1u); break; } } } } while (0)

struct XcdBarrier {
    unsigned* bar; unsigned x;
    volatile LAS unsigned* st;
};

__device__ __forceinline__ XcdBarrier xcd_barrier_post(unsigned* bar, volatile LAS unsigned* st, bool t0  ) {
    XcdBarrier b; b.bar = bar; b.x = xb_xcc_id(); b.st = st;
    if (t0) (void)xb_add(&bar[XB_XCNT(b.x)], 1u);
    return b;
}
__device__ __forceinline__ void xcd_barrier_complete(unsigned* bar, unsigned x, unsigned& nloc, unsigned& nx) {
    const unsigned G = gridDim.x * gridDim.y * gridDim.z;
    unsigned sum, cnt, mine, sp = 0u;
    for (;;) {
        sum = 0u; cnt = 0u; mine = 0u;
#pragma unroll
        for (unsigned j = 0; j < 16; ++j) { const unsigned c = xb_ld(&bar[XB_XCNT(j)]); sum += c; cnt += (c > 0u) ? 1u : 0u; mine = (j == x) ? c : mine; }
        if (sum == G) break;
        __builtin_amdgcn_s_sleep(1);
        if ((++sp & 255u) == 0u) { if (xb_ld(&bar[XB_TMO])) break; if (sp > XB_SPIN_CAP) { atomicAdd(&bar[XB_TMO], 1u); break; } }
    }
    nloc = mine > 0u ? mine : 1u; nx = cnt > 0u ? cnt : 1u;
}

__device__ __forceinline__ void xcd_barrier(const XcdBarrier& b, bool t0  ) {
    asm volatile("s_waitcnt vmcnt(0)" ::: "memory");
    __syncthreads();
    if (t0) {
        unsigned* bar = b.bar;
        __builtin_amdgcn_s_waitcnt(0);
        unsigned nloc = b.st[0], nx = b.st[1];
        if (nloc == 0u) { xcd_barrier_complete(bar, b.x, nloc, nx); b.st[0] = nloc; b.st[1] = nx; }
        const unsigned old = xb_add(&bar[XB_XSUB(b.x)], 1u);
        const unsigned gen = old / nloc;
        if (old + 1u == (gen + 1u) * nloc) {
            __builtin_amdgcn_fence(__ATOMIC_RELEASE, "agent");
            asm volatile("s_waitcnt vmcnt(0)" ::: "memory");
            const unsigned og = xb_add(&bar[XB_TOP], 1u);
            const unsigned tg = og / nx;
            if (og + 1u == (tg + 1u) * nx) xb_add(&bar[XB_TOPGEN], 1u);
            else XB_SPIN(xb_ld(&bar[XB_TOPGEN]) == tg, bar);
            __builtin_amdgcn_fence(__ATOMIC_ACQUIRE, "agent");
            xb_add(&bar[XB_XGEN(b.x)], 1u);
            asm volatile("s_waitcnt vmcnt(0)" ::: "memory");
        } else {
            XB_SPIN(xb_ld(&bar[XB_XGEN(b.x)]) == gen, bar);
            __builtin_amdgcn_fence(__ATOMIC_ACQUIRE, "agent");
            asm volatile("s_waitcnt vmcnt(0)" ::: "memory");
        }
    }
    __syncthreads();
}

__device__ __forceinline__ float bf2f(unsigned short b) { return __builtin_bit_cast(float, (unsigned)b << 16); }
__device__ __forceinline__ float bf2f(short b) { return __builtin_bit_cast(float, (unsigned)(unsigned short)b << 16); }
__device__ __forceinline__ float wave_sum(float v) {
#pragma unroll
    for (int o = 1; o < 64; o <<= 1) v += __shfl_xor(v, o);
    return v;
}
__device__ __forceinline__ float wave_max(float v) {
#pragma unroll
    for (int o = 1; o < 64; o <<= 1) v = fmaxf(v, __shfl_xor(v, o));
    return v;
}
__device__ __forceinline__ float fast_exp(float x) { return __builtin_amdgcn_exp2f(x * 1.4426950408889634f); }
__device__ __forceinline__ float sigmoidf_(float x) { return __builtin_amdgcn_rcpf(1.f + fast_exp(-x)); }
__device__ __forceinline__ float gelu_tanh(float x) {
    const float z = 0.7978845608028654f * (x + 0.044715f * x * x * x);
    return x * sigmoidf_(2.f * z);
}
__device__ __forceinline__ float neg_expm1(float x) {
    const float p = x * (1.f + x * (0.5f + x * (0.16666667f + x * (0.041666668f + x * (0.0083333338f + x * 0.0013888889f)))));
    const float e = fast_exp(x) - 1.f;
    return -(fabsf(x) < 0.25f ? p : e);
}
__device__ __forceinline__ v4u pack8(const float (&v)[8]) { v4u o; o.x = pk2(v[0], v[1]); o.y = pk2(v[2], v[3]); o.z = pk2(v[4], v[5]); o.w = pk2(v[6], v[7]); return o; }

#define FIN(F, idx) ({ const __attribute__((address_space(1))) float* p_; asm("s_load_dwordx2 %0, %1, %2 ; tag %3\n\ts_waitcnt lgkmcnt(0)" : "=s"(p_) : "s"((F).kargs), "i"((idx) * 8), "s"((F).ptag)); (const float*)p_; })
struct Frame {
    LAS unsigned char* lds;
    volatile LAS unsigned* MISC;
    gu32* ctl;
    int tid, lane, wave, vcu, G;
    const __attribute__((address_space(4))) void* kargs; int ptag;
    float* out;
    unsigned char* ws;
#define WSP(T, NAME, OFF) __device__ __forceinline__ T* NAME() const { return (T*)(ws + (OFF)); }
    WSP(bf16, WIN_T, WS_WIN) WSP(bf16, WOUT_T, WS_WOUT) WSP(bf16, WUP_T, WS_WUP) WSP(bf16, WDOWN_T, WS_WDOWN) WSP(bf16, WG, WS_WG) WSP(bf16, XN, WS_A) WSP(bf16, QG, WS_QG) WSP(bf16, K, WS_K) WSP(bf16, V, WS_V)
    WSP(bf16, XR, WS_XR) WSP(bf16, ACT, WS_ACT) WSP(bf16, H1A, WS_H1A) WSP(float, EDGE, WS_EDGE) WSP(bf16, XNMETA, WS_XNMETA) WSP(bf16, KM, WS_KM) WSP(bf16, VM, WS_VM)
    WSP(float, ZM, WS_ZM) WSP(float, Q15, WS_Q15) WSP(float, GY15, WS_GY15) WSP(float, LO15, WS_LO15) WSP(float, MIXED15, WS_MIXED15) WSP(float, Y15, WS_Y15) WSP(float, G15, WS_G15) WSP(float, MQP, WS_MQP)
    WSP(float, CIN, WS_CIN) WSP(float2, CAR, WS_CAR) WSP(float, R0, WS_R0) WSP(float, RATIO, WS_RATIO) WSP(float, RL, WS_RL) WSP(float, SSQA, WS_SSQA) WSP(float, SSQL, WS_SSQL)
#undef WSP
};

template <bool UPMAP, int GAIN = 0>
__device__ __forceinline__ void p0_transpose_item(const float* W, int K, int N, bf16* WT, int row_off, LAS float* scr, int item, int lane, const float* g0 = nullptr, const float* g1 = nullptr) {
    const int nblk = N / 32, kb = item / nblk, nb = item % nblk, k0 = 64 * kb, n0 = 32 * nb;
    const int orow0 = UPMAP ? (((n0 % FFN) >> 7) << 8) + 128 * (n0 / FFN) + ((n0 % FFN) & 127) : row_off + n0;
    float wv[32];
#pragma unroll
    for (int i = 0; i < 32; ++i) { const int kk = 2 * i + (lane >> 5); wv[i] = W[(size_t)(k0 + kk) * N + n0 + (lane & 31)]; }
#pragma unroll
    for (int i = 0; i < 32; ++i) { const int kk = 2 * i + (lane >> 5); float gv = 1.f; if (GAIN == 1) gv = g0[k0 + kk]; if (GAIN == 2) gv = (k0 + kk) < 1024 ? g0[k0 + kk] : g1[k0 + kk - 1024];
        scr[kk * 33 + (lane & 31)] = wv[i] * gv; }
    LDS_WAIT(); asm volatile("" ::: "memory");
    const int c = lane & 7;
#pragma unroll
    for (int j = 0; j < 4; ++j) { const int n = (lane >> 3) + 8 * j; const LAS float* s = scr + (8 * c) * 33 + n;
        v4u o; o.x = pk2(s[0 * 33], s[1 * 33]); o.y = pk2(s[2 * 33], s[3 * 33]); o.z = pk2(s[4 * 33], s[5 * 33]); o.w = pk2(s[6 * 33], s[7 * 33]);
        *(GAS v4u*)(WT + (size_t)(orow0 + n) * K + k0 + 8 * c) = o; }
    LDS_WAIT(); asm volatile("" ::: "memory");
}
__device__ __forceinline__ void rms_row_to_bf16(const float* xrow, bf16* orow, int lane, float* rout) {
    const GAS f32x4* xr = (const GAS f32x4*)xrow + lane;
    f32x4 v[8]; float s = 0.f;
#pragma unroll
    for (int j = 0; j < 8; ++j) { v[j] = xr[64 * j]; s += (v[j].x * v[j].x + v[j].y * v[j].y) + (v[j].z * v[j].z + v[j].w * v[j].w); }
    const float r = 1.f / sqrtf(wave_sum(s) * (1.f / DM) + EPS);
    GAS unsigned long long* o8 = (GAS unsigned long long*)orow + lane;
#pragma unroll
    for (int j = 0; j < 8; ++j) o8[64 * j] = (unsigned long long)pk2(v[j].x * r, v[j].y * r) | ((unsigned long long)pk2(v[j].z * r, v[j].w * r) << 32);
    if (rout && lane == 0) *rout = r;
}
__device__ __forceinline__ void p0_prologue(Frame& F) {
    LAS float* scr = (LAS float*)(F.lds + F.wave * 16384);
    const int gw = F.vcu * NWAVES + F.wave, NGW = F.G * NWAVES;
    constexpr int I_IN = (DM / 64) * (INW / 32), I_OUT = (DM / 64) * (DM / 32), I_UP = (DM / 64) * (UPW / 32), I_DN = (FFN / 64) * (DM / 32), I_G = 32 * 8;
    constexpr int NITEMS = I_IN + I_OUT + I_UP + I_DN + I_G;
    for (int it = gw; it < NITEMS; it += NGW) {
        int r = it;
        if (r < I_IN) { p0_transpose_item<false, 1>(FIN(F, 4  ), DM, INW, F.WIN_T(), 0, scr, r, F.lane, FIN(F, 3  )); continue; } r -= I_IN;
        if (r < I_OUT) { p0_transpose_item<false, 2>(FIN(F, 16  ), DM, DM, F.WOUT_T(), 0, scr, r, F.lane, FIN(F, 14  ), FIN(F, 15  )); continue; } r -= I_OUT;
        if (r < I_UP) { p0_transpose_item<true>(FIN(F, 19  ), DM, UPW, F.WUP_T(), 0, scr, r, F.lane); continue; } r -= I_UP;
        if (r < I_DN) { p0_transpose_item<false>(FIN(F, 22  ), FFN, DM, F.WDOWN_T(), 0, scr, r, F.lane); continue; } r -= I_DN;
        {
            const int mi = r >> 3, sub = r & 7, gate = mi >> 4, dir = (mi >> 3) & 1, blk = mi & 7;
            const float* W = (gate ? FIN(F, 11  ) : FIN(F, 9  )) + (size_t)(dir * 8 + blk) * 16384;
            bf16* WT = F.WG() + (size_t)((dir * 2 + gate) * 8 + blk) * 16384;
            p0_transpose_item<false>(W, 128, 128, WT, 0, scr, sub, F.lane);
        }
    }
    for (int m = gw; m < NTOK; m += NGW) {
        const float* xr = m < 32768 ? FIN(F, 0  ) + (size_t)m * DM : FIN(F, 1  ) + (size_t)(m - 32768) * DM;
        rms_row_to_bf16(xr, F.XN() + (size_t)m * DM, F.lane, F.R0() + m);
    }
    for (int m = gw; m < 16; m += NGW) rms_row_to_bf16(FIN(F, 2  ) + (size_t)m * DM, F.XNMETA() + (size_t)m * DM, F.lane, nullptr);
    const int gt = F.vcu * 512 + F.tid, NGT = F.G * 512; const v4u z4 = {0u, 0u, 0u, 0u};
    for (int i = gt; i < 12 * 48 * 128; i += NGT) { const int s = i / (48 * 128), rem = i % (48 * 128); ((GAS v4u*)(F.XR() + (size_t)xr_base(s) * 1024))[rem] = z4; }
    for (int i = gt; i < 64 * 128; i += NGT) ((GAS v4u*)(F.XR() + (size_t)XR_ROWS * 1024))[i] = z4;
    for (int i = gt; i < 2048; i += NGT) { ((GAS v4u*)F.KM())[i] = z4; ((GAS v4u*)F.VM())[i] = z4; }
}

template <int R, class Out, bool GMAP = false>
__device__ __forceinline__ void small_gemm(const LAS float* X, int K, const bf16* Wt, int N, int gw, int NGW, int lane, const Out& out) {
    for (int n = gw; n < N; n += NGW) {
        float acc[R];
#pragma unroll
        for (int r = 0; r < R; ++r) acc[r] = 0.f;
        const GAS bf16x8* wrow = (const GAS bf16x8*)(Wt + (size_t)(GMAP ? ((n >> 7) << 8) + (n & 127) : n) * K);
        for (int k8 = lane; k8 < K / 8; k8 += 64) {
            const bf16x8 w = wrow[k8]; float wf[8];
#pragma unroll
            for (int j = 0; j < 8; ++j) wf[j] = bf2f(w[j]);
#pragma unroll
            for (int r = 0; r < R; ++r) { const LAS f32x4* xp = (const LAS f32x4*)(X + r * K + k8 * 8); const f32x4 a = xp[0], b = xp[1];
                acc[r] += (a.x * wf[0] + a.y * wf[1]) + (a.z * wf[2] + a.w * wf[3]) + (b.x * wf[4] + b.y * wf[5]) + (b.z * wf[6] + b.w * wf[7]); }
        }
        float v = 0.f;
#pragma unroll
        for (int r = 0; r < R; ++r) { const float s = wave_sum(acc[r]); v = (lane == r) ? s : v; }
        out(n, lane, v);
    }
}
struct OutMetaZ { float* ZM; bf16* XR;
    __device__ __forceinline__ void operator()(int n, int lane, float v) const {
        if (lane < 16) { ZM[lane * INW + n] = v;
            if (n >= 1536 && n < 2560) { const unsigned short b = (unsigned short)f2bf(v); const int c = n - 1536;
                for (int s = 0; s < 12; ++s) XR[(size_t)(xr_base(s) + 48 + lane) * 1024 + c] = b; } }
    } };
struct OutRows { float* Y; int ld; int R;
    __device__ __forceinline__ void operator()(int n, int lane, float v) const { if (lane < R) Y[(size_t)lane * ld + n] = v; } };

__device__ __forceinline__ void p1_meta_z(Frame& F) {
    LAS float* X = (LAS float*)F.lds;
    for (int i = F.tid; i < 16 * DM / 8; i += 512) { const bf16x8 v = ((const GAS bf16x8*)F.XNMETA())[i];
        ((LAS f32x4*)X)[2 * i] = (f32x4){bf2f(v[0]), bf2f(v[1]), bf2f(v[2]), bf2f(v[3])}; ((LAS f32x4*)X)[2 * i + 1] = (f32x4){bf2f(v[4]), bf2f(v[5]), bf2f(v[6]), bf2f(v[7])}; }
    __syncthreads();
    const OutMetaZ o{F.ZM(), F.XR()};
    small_gemm<16, OutMetaZ>(X, DM, F.WIN_T(), INW, F.vcu * NWAVES + F.wave, F.G * NWAVES, F.lane, o);
    __syncthreads();
}
typedef float f32x16 __attribute__((ext_vector_type(16)));
constexpr int LRU_XC0 = 0, LRU_XC_BUF = 17408, LRU_XC_STRIDE = 272;
constexpr int LRU_CW = 34816;
constexpr int LRU_HF = 37376, LRU_HB = LRU_HF + 32768;
__device__ __forceinline__ int crow16(int r, int hi) { return (r & 3) + 8 * (r >> 2) + 4 * hi; }

template <int DIR>
__device__ __forceinline__ void scan_tile(const float (&a)[16], const float (&u)[16], float& carry, float& ptot, float (&h)[16], bool up) {
    float HL[16], PL[16], As[4], Hs[4];
#pragma unroll
    for (int j = 0; j < 4; ++j) {
        float hl = 0.f, p = 1.f;
#pragma unroll
        for (int ii = 0; ii < 4; ++ii) { const int idx = 4 * j + (DIR == 0 ? ii : 3 - ii); hl = a[idx] * hl + u[idx]; p *= a[idx]; HL[idx] = hl; PL[idx] = p; }
        As[j] = p; Hs[j] = hl;
    }
    float Alo[4], Ahi[4], Hlo[4], Hhi[4];
#pragma unroll
    for (int j = 0; j < 4; ++j) {
        { const unsigned x = __float_as_uint(As[j]); auto rr = __builtin_amdgcn_permlane32_swap(x, x, false, false); Alo[j] = __uint_as_float(rr[0]); Ahi[j] = __uint_as_float(rr[1]); }
        { const unsigned x = __float_as_uint(Hs[j]); auto rr = __builtin_amdgcn_permlane32_swap(x, x, false, false); Hlo[j] = __uint_as_float(rr[0]); Hhi[j] = __uint_as_float(rr[1]); }
    }
    float cin[4]; float c = carry;
    if (DIR == 0) {
#pragma unroll
        for (int j = 0; j < 4; ++j) { const float c_lo = c; c = Alo[j] * c + Hlo[j]; const float c_hi = c; c = Ahi[j] * c + Hhi[j]; cin[j] = up ? c_hi : c_lo; }
    } else {
#pragma unroll
        for (int j = 3; j >= 0; --j) { const float c_hi = c; c = Ahi[j] * c + Hhi[j]; const float c_lo = c; c = Alo[j] * c + Hlo[j]; cin[j] = up ? c_hi : c_lo; }
    }
    carry = c;
#pragma unroll
    for (int j = 0; j < 4; ++j) ptot *= Alo[j] * Ahi[j];
#pragma unroll
    for (int idx = 0; idx < 16; ++idx) h[idx] = HL[idx] + PL[idx] * cin[idx >> 2];
}

__device__ __forceinline__ void lru_decode(int cg, int& seq, int& c) { if (cg < 520) { seq = cg / 65; c = cg - seq * 65; } else { const int c2 = cg - 520; seq = c2 / 129; c = c2 - seq * 129; seq += 8; } }
template <int PASS>
__device__ __forceinline__ void lru_phase(Frame& F, bf16* gout) {
    LAS unsigned char* L = F.lds;
    const int tid = F.tid, lane = F.lane, wave = F.wave;
    const int n = F.vcu & 7, ngrp = F.G >> 3;
    { const float* cw = FIN(F, 7  ); const float* cb = FIN(F, 8  );
      for (int i = tid; i < 640; i += 512) { const int k = i >> 7, ch = i & 127; ((LAS float*)(L + LRU_CW))[i] = k < 4 ? cw[k * 1024 + n * 128 + ch] : cb[n * 128 + ch]; } }
    const int d = wave >> 2, g4 = wave & 3, r32 = lane & 31, hi = lane >> 5, chl = g4 * 32 + r32, chg = n * 128 + chl;
    bf16x8 br[8], bi[8];
    { const bf16* wr_ = F.WG() + (size_t)((d * 2 + 0) * 8 + n) * 16384 + chl * 128 + hi * 8;
      const bf16* wi_ = F.WG() + (size_t)((d * 2 + 1) * 8 + n) * 16384 + chl * 128 + hi * 8;
#pragma unroll
      for (int ks = 0; ks < 8; ++ks) { br[ks] = *(const GAS bf16x8*)(wr_ + ks * 16); bi[ks] = *(const GAS bf16x8*)(wi_ + ks * 16); } }
    constexpr float L2E = 1.4426950408889634f;
    const float nb_r = -L2E * FIN(F, 10  )[d * 1024 + chg], nb_i = -L2E * FIN(F, 12  )[d * 1024 + chg];
    const float spl = 8.f * L2E * log1pf(expf(-FIN(F, 13  )[d * 1024 + chg]));
    const int tau0 = tid >> 4, co = (tid & 15) * 8;
    bf16x8 xv[2][4];
#define LRU_PREFETCH(cgx) do { int s_, c_; lru_decode((cgx), s_, c_); const int xb_ = xr_base(s_); \
        _Pragma("unroll") for (int it_ = 0; it_ < 2; ++it_) _Pragma("unroll") for (int k_ = 0; k_ < 4; ++k_) { int row_ = xb_ + c_ * 64 + tau0 + 32 * it_ + k_ - 2; row_ = row_ < 0 ? 0 : row_; \
            xv[it_][k_] = *(const GAS bf16x8*)(F.XR() + (size_t)row_ * 1024 + n * 128 + co); } } while (0)
    int cg = F.vcu < 8 * ngrp ? F.vcu >> 3 : NCHUNK;
    if (cg < NCHUNK) LRU_PREFETCH(cg);
    __syncthreads();
    for (int ui = 0; cg < NCHUNK; cg += ngrp, ++ui) {
        int seq, c; lru_decode(cg, seq, c);
        LAS unsigned char* XC = L + LRU_XC0 + (ui & 1) * LRU_XC_BUF;
        float carry = 0.f, ptot = 1.f;
        if (PASS == 2) carry = F.CIN()[((size_t)cg * 2 + d) * 1024 + chg];
#pragma unroll
        for (int it = 0; it < 2; ++it) {
            const int tau = tau0 + 32 * it; float xc[8];
            { const LAS f32x4* cb = (const LAS f32x4*)(L + LRU_CW + (4 * 128 + co) * 4); const f32x4 b0 = cb[0], b1 = cb[1];
              xc[0] = b0.x; xc[1] = b0.y; xc[2] = b0.z; xc[3] = b0.w; xc[4] = b1.x; xc[5] = b1.y; xc[6] = b1.z; xc[7] = b1.w; }
#pragma unroll
            for (int k = 0; k < 4; ++k) { const LAS f32x4* wp = (const LAS f32x4*)(L + LRU_CW + (k * 128 + co) * 4); const f32x4 w0 = wp[0], w1 = wp[1]; const bf16x8 v = xv[it][k];
                xc[0] += w0.x * bf2f(v[0]); xc[1] += w0.y * bf2f(v[1]); xc[2] += w0.z * bf2f(v[2]); xc[3] += w0.w * bf2f(v[3]);
                xc[4] += w1.x * bf2f(v[4]); xc[5] += w1.y * bf2f(v[5]); xc[6] += w1.z * bf2f(v[6]); xc[7] += w1.w * bf2f(v[7]); }
            if (c == 0 && tau < 48) {
#pragma unroll
                for (int j = 0; j < 8; ++j) xc[j] = 0.f;
            }
            *(LAS v4u*)(XC + tau * LRU_XC_STRIDE + co * 2) = pack8(xc);
        }
        bf16x8 gv[2];
        const int row0 = seq_first_row(seq) + 64 * (c - 1);
        if (PASS == 2) { if (c > 0) {
#pragma unroll
            for (int it = 0; it < 2; ++it) gv[it] = *(const GAS bf16x8*)(F.QG() + (size_t)(row0 + tau0 + 32 * it) * DM + 1024 + n * 128 + co); } }
        __syncthreads();
        if (cg + ngrp < NCHUNK) LRU_PREFETCH(cg + ngrp);
        f32x16 arT[2], aiT[2];
#pragma unroll
        for (int tt = 0; tt < 2; ++tt) {
            const int tile = d ? 1 - tt : tt;
            f32x16 ar = {}, ai = {};
#pragma unroll
            for (int ks = 0; ks < 8; ++ks) {
                const bf16x8 a = *(const LAS bf16x8*)(XC + (tile * 32 + r32) * LRU_XC_STRIDE + (ks * 16 + hi * 8) * 2);
                ar = __builtin_amdgcn_mfma_f32_32x32x16_bf16(a, br[ks], ar, 0, 0, 0);
                ai = __builtin_amdgcn_mfma_f32_32x32x16_bf16(a, bi[ks], ai, 0, 0, 0);
            }
            arT[tt] = ar; aiT[tt] = ai;
        }
#pragma unroll
        for (int tt = 0; tt < 2; ++tt) {
            const int tile = d ? 1 - tt : tt;
            const f32x16 ar = arT[tt], ai = aiT[tt];
            float av[16], uv[16], hv[16];
            typedef float f32x2 __attribute__((ext_vector_type(2)));
#pragma unroll
            for (int r = 0; r < 16; r += 2) {
                const int tau0_ = tile * 32 + crow16(r, hi);
                const f32x2 xc2 = {bf2f(*(const LAS unsigned short*)(XC + tau0_ * LRU_XC_STRIDE + chl * 2)), bf2f(*(const LAS unsigned short*)(XC + (tau0_ + 1) * LRU_XC_STRIDE + chl * 2))};
                const f32x2 tr = (f32x2){ar[r], ar[r + 1]} * (f32x2){-L2E, -L2E} + (f32x2){nb_r, nb_r};
                const f32x2 ti = (f32x2){ai[r], ai[r + 1]} * (f32x2){-L2E, -L2E} + (f32x2){nb_i, nb_i};
                const f32x2 dr = (f32x2){__builtin_amdgcn_exp2f(tr.x), __builtin_amdgcn_exp2f(tr.y)} + (f32x2){1.f, 1.f};
                const f32x2 di = (f32x2){__builtin_amdgcn_exp2f(ti.x), __builtin_amdgcn_exp2f(ti.y)} + (f32x2){1.f, 1.f};
                const f32x2 rg = {__builtin_amdgcn_rcpf(dr.x), __builtin_amdgcn_rcpf(dr.y)}, ig = {__builtin_amdgcn_rcpf(di.x), __builtin_amdgcn_rcpf(di.y)};
                const f32x2 la = rg * (f32x2){-spl, -spl};
                const f32x2 a = {__builtin_amdgcn_exp2f(la.x), __builtin_amdgcn_exp2f(la.y)};
                const f32x2 t = (f32x2){1.f, 1.f} - a * a;
                const f32x2 m = {__builtin_amdgcn_sqrtf(t.x), __builtin_amdgcn_sqrtf(t.y)};
                const f32x2 u = m * (ig * xc2);
                av[r] = a.x; av[r + 1] = a.y; uv[r] = u.x; uv[r + 1] = u.y;
            }
            if (d == 0) scan_tile<0>(av, uv, carry, ptot, hv, hi != 0); else scan_tile<1>(av, uv, carry, ptot, hv, hi != 0);
            if (PASS == 2) {
#pragma unroll
                for (int r = 0; r < 16; ++r) { const int tau = tile * 32 + crow16(r, hi); *(LAS float*)(L + (d ? LRU_HB : LRU_HF) + (tau * 128 + chl) * 4) = hv[r]; }
            }
        }
        if (PASS == 1) { if (hi == 0) F.CAR()[((size_t)cg * 2 + d) * 1024 + chg] = make_float2(ptot, carry); }
        if (PASS == 2) {
            __syncthreads();
            if (c > 0) {
#pragma unroll
                for (int it = 0; it < 2; ++it) {
                    const int tau = tau0 + 32 * it; const bf16x8 g8 = gv[it];
                    const LAS f32x4* hf = (const LAS f32x4*)(L + LRU_HF + (tau * 128 + co) * 4); const LAS f32x4* hb = (const LAS f32x4*)(L + LRU_HB + (tau * 128 + co) * 4);
                    const f32x4 f0 = hf[0], f1 = hf[1], b0 = hb[0], b1 = hb[1];
                    float o[8];
                    o[0] = (f0.x + b0.x) * gelu_tanh(bf2f(g8[0])); o[1] = (f0.y + b0.y) * gelu_tanh(bf2f(g8[1])); o[2] = (f0.z + b0.z) * gelu_tanh(bf2f(g8[2])); o[3] = (f0.w + b0.w) * gelu_tanh(bf2f(g8[3]));
                    o[4] = (f1.x + b1.x) * gelu_tanh(bf2f(g8[4])); o[5] = (f1.y + b1.y) * gelu_tanh(bf2f(g8[5])); o[6] = (f1.z + b1.z) * gelu_tanh(bf2f(g8[6])); o[7] = (f1.w + b1.w) * gelu_tanh(bf2f(g8[7]));
                    *(GAS v4u*)(gout + (size_t)(row0 + tau) * DM + 1024 + n * 128 + co) = pack8(o);
                    float sq = (o[0] * o[0] + o[1] * o[1]) + (o[2] * o[2] + o[3] * o[3]) + (o[4] * o[4] + o[5] * o[5]) + (o[6] * o[6] + o[7] * o[7]);
                    sq += __shfl_xor(sq, 1); sq += __shfl_xor(sq, 2); sq += __shfl_xor(sq, 4); sq += __shfl_xor(sq, 8);
                    if ((tid & 15) == 0) F.SSQL()[(size_t)(row0 + tau) * 8 + n] = sq;
                }
            } else if (tid < 128) {
                const float hf = *(const LAS float*)(L + LRU_HF + (63 * 128 + tid) * 4), hb = *(const LAS float*)(L + LRU_HB + (63 * 128 + tid) * 4);
                F.LO15()[seq * 1024 + n * 128 + tid] = (hf + hb) * gelu_tanh(F.GY15()[n * 128 + tid]);
            }
        }
    }
    __syncthreads();
#undef LRU_PREFETCH
}
__device__ __forceinline__ void lru_propagate(Frame& F) {
    const int gid = F.vcu * 512 + F.tid;
    if (gid < 12 * 2048) {
        const int s = gid >> 11, d = (gid >> 10) & 1, ch = gid & 1023; const int nch = s < 8 ? 65 : 129, cb = chunk_base(s);
        const float2* car = F.CAR() + (size_t)d * 1024 + ch; float* cinp = F.CIN() + (size_t)d * 1024 + ch;
        float cin = 0.f;
        for (int b0 = 0; b0 < nch; b0 += 16) {
            float2 ph[16];
#pragma unroll
            for (int i = 0; i < 16; ++i) { const int cc = b0 + i; const int c = d ? nch - 1 - cc : cc; if (cc < nch) ph[i] = car[(size_t)(cb + c) * 2048]; }
#pragma unroll
            for (int i = 0; i < 16; ++i) { const int cc = b0 + i; const int c = d ? nch - 1 - cc : cc; if (cc < nch) { cinp[(size_t)(cb + c) * 2048] = cin; cin = ph[i].x * cin + ph[i].y; } }
        }
    }
}

__device__ __forceinline__ void k_rope_pass(Frame& F, bf16* Kout) {
    const int gw = F.vcu * NWAVES + F.wave, NGW = F.G * NWAVES, sub = F.lane >> 4, l16 = F.lane & 15;
    const int c0 = 8 * l16, p = l16 >> 3, half = (l16 >> 2) & 1, i0 = 8 * (l16 & 3);
    float inv[8], gk[8];
#pragma unroll
    for (int j = 0; j < 8; ++j) { inv[j] = __builtin_amdgcn_exp2f(-(float)(i0 + j) * (13.287712379549449f / 32.f)) * 0.15915494309189535f; gk[j] = FIN(F, 6  )[c0 + j]; }
    for (int it = gw; it < NTOK * 2 / 4; it += NGW) {
        const int item = it * 4 + sub, row = item >> 1, hk = item & 1;
        const int s = row_seq(row), t = row - seq_first_row(s); const float pos = (float)(p ? (t & 63) : (t >> 6));
        bf16* kp = F.K() + (size_t)row * 256 + hk * 128 + c0;
        const bf16x8 v = *(const GAS bf16x8*)kp; float x[8]; float ss = 0.f;
#pragma unroll
        for (int j = 0; j < 8; ++j) { x[j] = bf2f(v[j]); ss += x[j] * x[j]; }
        ss += __shfl_xor(ss, 1); ss += __shfl_xor(ss, 2); ss += __shfl_xor(ss, 4); ss += __shfl_xor(ss, 8);
        const float rs = 1.f / sqrtf(ss * (1.f / 128.f) + EPS); float o[8];
#pragma unroll
        for (int j = 0; j < 8; ++j) { x[j] *= rs * gk[j]; const float pr = __shfl_xor(x[j], 4);
            float rev = pos * inv[j]; rev -= floorf(rev); const float sn = __builtin_amdgcn_sinf(rev), cs = __builtin_amdgcn_cosf(rev);
            o[j] = half ? x[j] * cs + pr * sn : x[j] * cs - pr * sn; }
        *(GAS v4u*)(Kout + (size_t)row * 256 + hk * 128 + c0) = pack8(o);
    }
}
__device__ __forceinline__ void p3_meta_job(Frame& F) {
    for (int pr = F.wave; pr < 32; pr += 8) { const int r = pr >> 1, hk = pr & 1; const float* z = F.ZM() + r * INW + 1024 + hk * 128;
        const float a = z[F.lane], b = z[F.lane + 64]; const float rs = 1.f / sqrtf(wave_sum(a * a + b * b) * (1.f / 128.f) + EPS);
        F.KM()[r * 256 + hk * 128 + F.lane] = (bf16)f2bf(a * rs * FIN(F, 6  )[F.lane]); F.KM()[r * 256 + hk * 128 + F.lane + 64] = (bf16)f2bf(b * rs * FIN(F, 6  )[F.lane + 64]); }
    for (int i = F.tid; i < 16 * 256; i += 512) F.VM()[i] = (bf16)f2bf(F.ZM()[(i >> 8) * INW + 1280 + (i & 255)]);
    { const int h = F.wave; const float* z = F.ZM() + 15 * INW + h * 128; const float a = z[F.lane], b = z[F.lane + 64];
      const float rs = 1.f / sqrtf(wave_sum(a * a + b * b) * (1.f / 128.f) + EPS);
      F.Q15()[h * 128 + F.lane] = a * rs * FIN(F, 5  )[F.lane]; F.Q15()[h * 128 + F.lane + 64] = b * rs * FIN(F, 5  )[F.lane + 64]; }
    for (int i = F.tid; i < 1024; i += 512) F.GY15()[i] = F.ZM()[15 * INW + 2560 + i];
}

__device__ __forceinline__ void metaq_item(Frame& F, int it) {
    int s, kvh, j; if (it < 256) { s = it >> 5; kvh = (it >> 4) & 1; j = it & 15; } else { const int t2 = it - 256; s = 8 + (t2 >> 6); kvh = (t2 >> 5) & 1; j = t2 & 31; }
    LAS float* q4 = (LAS float*)F.lds;
    LAS float* sc = q4 + 512;
    LAS float* red = sc + 4 * 288;
    const int tid = F.tid, nk = 256 + (j == 0 ? 16 : 0), row0 = seq_first_row(s) + 256 * j;
    q4[tid] = F.Q15()[kvh * 512 + tid];
    __syncthreads();
    if (tid < nk) {
        const bf16* kp = tid < 256 ? F.K() + (size_t)(row0 + tid) * 256 + kvh * 128 : F.KM() + (tid - 256) * 256 + kvh * 128;
        float d0 = 0.f, d1 = 0.f, d2 = 0.f, d3 = 0.f;
#pragma unroll 4
        for (int cc = 0; cc < 16; ++cc) { const bf16x8 kv = ((const GAS bf16x8*)kp)[cc];
#pragma unroll
            for (int e = 0; e < 8; ++e) { const float kf = bf2f(kv[e]); d0 += kf * q4[cc * 8 + e]; d1 += kf * q4[128 + cc * 8 + e]; d2 += kf * q4[256 + cc * 8 + e]; d3 += kf * q4[384 + cc * 8 + e]; } }
        const float SC = 0.088388347648318440f;
        sc[tid] = d0 * SC; sc[288 + tid] = d1 * SC; sc[576 + tid] = d2 * SC; sc[864 + tid] = d3 * SC;
    }
    __syncthreads();
    if (F.wave < 4) { LAS float* sh = sc + F.wave * 288; float m = -INFINITY;
        for (int k = F.lane; k < nk; k += 64) m = fmaxf(m, sh[k]);
        m = wave_max(m); float l = 0.f;
        for (int k = F.lane; k < nk; k += 64) { const float p = __expf(sh[k] - m); sh[k] = p; l += p; }
        l = wave_sum(l);
        if (F.lane == 0) { red[F.wave * 2] = m; red[F.wave * 2 + 1] = l; } }
    __syncthreads();
    {
        const int kg = tid >> 4, oc = tid & 15; float o[4][8];
#pragma unroll
        for (int h = 0; h < 4; ++h)
#pragma unroll
            for (int e = 0; e < 8; ++e) o[h][e] = 0.f;
        const bf16* vp = F.V() + (size_t)(row0 + kg * 8) * 256 + kvh * 128 + oc * 8;
        bf16x8 vv[8];
#pragma unroll
        for (int k = 0; k < 8; ++k) vv[k] = *(const GAS bf16x8*)(vp + (size_t)k * 256);
#pragma unroll
        for (int k = 0; k < 8; ++k) { const float p0 = sc[kg * 8 + k], p1 = sc[288 + kg * 8 + k], p2 = sc[576 + kg * 8 + k], p3 = sc[864 + kg * 8 + k];
#pragma unroll
            for (int e = 0; e < 8; ++e) { const float vf = bf2f(vv[k][e]); o[0][e] += p0 * vf; o[1][e] += p1 * vf; o[2][e] += p2 * vf; o[3][e] += p3 * vf; } }
        if (j == 0 && kg < 16) { const int k = kg; const bf16x8 v1 = *(const GAS bf16x8*)(F.VM() + k * 256 + kvh * 128 + oc * 8);
            const float p0 = sc[256 + k], p1 = sc[288 + 256 + k], p2 = sc[576 + 256 + k], p3 = sc[864 + 256 + k];
#pragma unroll
            for (int e = 0; e < 8; ++e) { const float vf = bf2f(v1[e]); o[0][e] += p0 * vf; o[1][e] += p1 * vf; o[2][e] += p2 * vf; o[3][e] += p3 * vf; } }
        LAS float* part = sc + 4 * 288 + 16;
#pragma unroll
        for (int h = 0; h < 4; ++h) { LAS f32x4* pp = (LAS f32x4*)(part + (kg * 4 + h) * 128 + oc * 8); pp[0] = (f32x4){o[h][0], o[h][1], o[h][2], o[h][3]}; pp[1] = (f32x4){o[h][4], o[h][5], o[h][6], o[h][7]}; }
        __syncthreads();
        const int h = tid >> 7, d = tid & 127; float os = 0.f;
#pragma unroll 8
        for (int g = 0; g < 32; ++g) os += part[(g * 4 + h) * 128 + d];
        float* dst = F.MQP() + ((size_t)it * 4 + h) * 132; dst[2 + d] = os; if (d == 0) { dst[0] = red[h * 2]; dst[1] = red[h * 2 + 1]; } }
    __syncthreads();
}
__device__ __forceinline__ void attn_phase(Frame& F, char* lds_generic, bf16* obase) {
    const int nr = F.G == 256 ? 8 : (2048 + F.G - 1) / F.G;
    for (int r = 0; r < nr; ++r) {
        int s, kvh, hq, qb, S;
        if (F.G == 256) {
            const int x = F.vcu >> 5, i = F.vcu & 31;
            if (r < 4) { const int pair = 2 * x + (r >> 1); s = pair >> 1; kvh = pair & 1; const int u = (r & 1) * 32 + i; hq = u >> 4; qb = u & 15; S = 4096; }
            else { const int pair = x; s = 8 + (pair >> 1); kvh = pair & 1; const int u = (r - 4) * 32 + i; hq = u >> 5; qb = u & 31; S = 8192; }
        } else {
            const int U = F.vcu + F.G * r; if (U >= 2048) break;
            if (U < 1024) { const int pair = U >> 6, u = U & 63; s = pair >> 1; kvh = pair & 1; hq = u >> 4; qb = u & 15; S = 4096; }
            else { const int pair = (U - 1024) >> 7, u = (U - 1024) & 127; s = 8 + (pair >> 1); kvh = pair & 1; hq = u >> 5; qb = u & 31; S = 8192; }
        }
        const int row0 = seq_first_row(s), h = kvh * 4 + hq;
        bf16* qp = F.QG() + (size_t)(row0 + qb * 256) * DM + h * 128;
        attn::attn_unit(qp, F.K() + (size_t)row0 * 256 + kvh * 128, F.V() + (size_t)row0 * 256 + kvh * 128, F.KM() + kvh * 128, F.VM() + kvh * 128, obase + (size_t)(row0 + qb * 256) * DM + h * 128, S / 64 + 1, lds_generic, FIN(F, 5  ), qb * 256, F.SSQA() + (size_t)(row0 + qb * 256) * 8 + h, F.wave);
    }
}

__device__ __forceinline__ void p5_ratio(Frame& F) {
    for (int row = F.vcu * 512 + F.tid; row < NTOK; row += F.G * 512) {
        const GAS f32x4* pa = (const GAS f32x4*)(F.SSQA() + (size_t)row * 8); const GAS f32x4* pl = (const GAS f32x4*)(F.SSQL() + (size_t)row * 8);
        const f32x4 a0 = pa[0], a1 = pa[1], l0 = pl[0], l1 = pl[1];
        const float sa = ((a0.x + a0.y) + (a0.z + a0.w)) + ((a1.x + a1.y) + (a1.z + a1.w)), sl = ((l0.x + l0.y) + (l0.z + l0.w)) + ((l1.x + l1.y) + (l1.z + l1.w));
        const float qa = sqrtf(sa * (1.f / 1024.f) + EPS), ql = sqrtf(sl * (1.f / 1024.f) + EPS);
        F.RATIO()[row] = ql / qa; F.RL()[row] = 1.f / ql;
    }
}
__device__ __forceinline__ void p5_meta_job(Frame& F, int s) {
    LAS float* buf = (LAS float*)F.lds; LAS float* red = buf + 2048; const int tid = F.tid;
    {
        const int nj = s < 8 ? 16 : 32;
        for (int e = tid; e < 1024; e += 512) { const int h = e >> 7, d = e & 127, kvh = h >> 2, hq = h & 3;
            const int it0 = s < 8 ? s * 32 + kvh * 16 : 256 + (s - 8) * 64 + kvh * 32;
            float M = -INFINITY; for (int j = 0; j < nj; ++j) M = fmaxf(M, F.MQP()[((size_t)(it0 + j) * 4 + hq) * 132]);
            float Ls = 0.f, O = 0.f;
            for (int j = 0; j < nj; ++j) { const float* p = F.MQP() + ((size_t)(it0 + j) * 4 + hq) * 132; const float w = __expf(p[0] - M); Ls += p[1] * w; O += p[2 + d] * w; }
            buf[e] = O / Ls; }
        for (int e = tid; e < 1024; e += 512) buf[1024 + e] = F.LO15()[s * 1024 + e];
        __syncthreads();
        { float ss = 0.f; for (int k = F.lane; k < 256; k += 64) { const float v = buf[F.wave * 256 + k]; ss += v * v; } ss = wave_sum(ss); if (F.lane == 0) red[F.wave] = ss; }
        __syncthreads();
        const float ra = 1.f / sqrtf((red[0] + red[1] + red[2] + red[3]) * (1.f / 1024.f) + EPS), rl = 1.f / sqrtf((red[4] + red[5] + red[6] + red[7]) * (1.f / 1024.f) + EPS);
        for (int e = tid; e < 2048; e += 512) F.MIXED15()[s * 2048 + e] = e < 1024 ? buf[e] * ra : buf[e] * rl;
        __syncthreads();
    }
}
__device__ __forceinline__ void p6_meta_y(Frame& F) {
    LAS float* X = (LAS float*)F.lds;
    for (int i = F.tid; i < 12 * DM / 4; i += 512) ((LAS f32x4*)X)[i] = ((const GAS f32x4*)F.MIXED15())[i];
    __syncthreads();
    const OutRows o{F.Y15(), DM, 12};
    small_gemm<12, OutRows>(X, DM, F.WOUT_T(), DM, F.vcu * NWAVES + F.wave, F.G * NWAVES, F.lane, o);
    __syncthreads();
}

__device__ __forceinline__ void p7_row(Frame& F, int row, int lane, bf16* h1row) {
    const GAS bf16x8* y = (const GAS bf16x8*)((const bf16*)(F.out + (size_t)row * DM));
    GAS v4u* xn = (GAS v4u*)(F.XN() + (size_t)row * DM);
    const float ir0 = 1.f / F.R0()[row];
    float hv[32]; float ss = 0.f;
#pragma unroll
    for (int i = 0; i < 4; ++i) { const bf16x8 v = y[lane + 64 * i];
#pragma unroll
        for (int j = 0; j < 8; ++j) { hv[8 * i + j] = bf2f(v[j]); ss += hv[8 * i + j] * hv[8 * i + j]; } }
    const float r1 = 1.f / sqrtf(wave_sum(ss) * (1.f / DM) + EPS); float s2 = 0.f;
#pragma unroll
    for (int i = 0; i < 4; ++i) { const int e0 = (lane + 64 * i) * 8;
        const v4u xq = xn[lane + 64 * i]; const GAS f32x4* gp = (const GAS f32x4*)(FIN(F, 17  ) + e0); const f32x4 g0 = gp[0], g1 = gp[1];
        const float xv[8] = {__builtin_bit_cast(float, xq.x << 16), __builtin_bit_cast(float, xq.x & 0xffff0000u), __builtin_bit_cast(float, xq.y << 16), __builtin_bit_cast(float, xq.y & 0xffff0000u),
                             __builtin_bit_cast(float, xq.z << 16), __builtin_bit_cast(float, xq.z & 0xffff0000u), __builtin_bit_cast(float, xq.w << 16), __builtin_bit_cast(float, xq.w & 0xffff0000u)};
        const float gg[8] = {g0.x, g0.y, g0.z, g0.w, g1.x, g1.y, g1.z, g1.w};
        float hb[8];
#pragma unroll
        for (int j = 0; j < 8; ++j) { hb[j] = xv[j] * ir0 + hv[8 * i + j] * r1 * gg[j]; hv[8 * i + j] = hb[j]; s2 += hb[j] * hb[j]; }
        ((GAS v4u*)h1row)[lane + 64 * i] = pack8(hb);
    }
    const float r2 = 1.f / sqrtf(wave_sum(s2) * (1.f / DM) + EPS);
#pragma unroll
    for (int i = 0; i < 4; ++i) { const int e0 = (lane + 64 * i) * 8; const GAS f32x4* gp = (const GAS f32x4*)(FIN(F, 18  ) + e0); const f32x4 g0 = gp[0], g1 = gp[1];
        float t[8]; t[0] = hv[8 * i + 0] * r2 * g0.x; t[1] = hv[8 * i + 1] * r2 * g0.y; t[2] = hv[8 * i + 2] * r2 * g0.z; t[3] = hv[8 * i + 3] * r2 * g0.w;
        t[4] = hv[8 * i + 4] * r2 * g1.x; t[5] = hv[8 * i + 5] * r2 * g1.y; t[6] = hv[8 * i + 6] * r2 * g1.z; t[7] = hv[8 * i + 7] * r2 * g1.w;
        xn[lane + 64 * i] = pack8(t); }
}
__device__ __forceinline__ void p7_meta_g(Frame& F) {
    LAS float* X = (LAS float*)F.lds;
    for (int r = F.wave; r < 12; r += 8) {
        const float* y = F.Y15() + r * DM; const float* xm = FIN(F, 2  ) + 15 * DM;
        float hv[32]; float ss = 0.f;
#pragma unroll
        for (int i = 0; i < 32; ++i) { hv[i] = y[F.lane + 64 * i]; ss += hv[i] * hv[i]; }
        const float r1 = 1.f / sqrtf(wave_sum(ss) * (1.f / DM) + EPS); float s2 = 0.f;
#pragma unroll
        for (int i = 0; i < 32; ++i) { const int e = F.lane + 64 * i; hv[i] = xm[e] + hv[i] * r1 * FIN(F, 17  )[e]; s2 += hv[i] * hv[i]; }
        const float r2 = 1.f / sqrtf(wave_sum(s2) * (1.f / DM) + EPS);
#pragma unroll
        for (int i = 0; i < 32; ++i) { const int e = F.lane + 64 * i; X[r * DM + e] = hv[i] * r2 * FIN(F, 18  )[e]; }
    }
    __syncthreads();
    const OutRows o{F.G15(), FFN, 12};
    small_gemm<12, OutRows, true>(X, DM, F.WUP_T(), FFN, F.vcu * NWAVES + F.wave, F.G * NWAVES, F.lane, o);
    __syncthreads();
}

__device__ __forceinline__ void p9_fix(Frame& F, int h) {
    constexpr int NOCT = FFN / 8; const int total = 512 * 2 * NOCT;
    const float* cw = FIN(F, 20  ); const float* cb = FIN(F, 21  );
    for (int it = F.vcu * 512 + F.tid; it < total; it += F.G * 512) {
        const int bw = it / NOCT, co = (it - bw * NOCT) * 8, which = bw & 1, B = bw >> 1;
        const int lrow = B * 64 + (which ? 63 : 0), row = h * HROWS + lrow, s = row_seq(row), t = row - seq_first_row(s), S = seq_len(s);
        const float* e = F.EDGE() + (size_t)((B * 2 + which) * 3) * FFN + co;
        float inner[8], self[8], uu[8], outer[8], w0[8], w1[8], w2[8], bb[8];
#define LD8F(dst, p) do { const GAS f32x4* p_ = (const GAS f32x4*)(p); const f32x4 a_ = p_[0], b_ = p_[1]; dst[0] = a_.x; dst[1] = a_.y; dst[2] = a_.z; dst[3] = a_.w; dst[4] = b_.x; dst[5] = b_.y; dst[6] = b_.z; dst[7] = b_.w; } while (0)
        LD8F(inner, e); LD8F(self, e + FFN); LD8F(uu, e + 2 * FFN);
        LD8F(w0, cw + co); LD8F(w1, cw + FFN + co); LD8F(w2, cw + 2 * FFN + co); LD8F(bb, cb + co);
        if (which == 0) { if (t == 0) LD8F(outer, F.G15() + (size_t)s * FFN + co); else LD8F(outer, F.EDGE() + (size_t)(((B - 1) * 2 + 1) * 3 + 1) * FFN + co); }
        else { if (t == S - 1) {
#pragma unroll
                for (int j = 0; j < 8; ++j) outer[j] = 0.f; }
            else LD8F(outer, F.EDGE() + (size_t)(((B + 1) * 2 + 0) * 3 + 1) * FFN + co); }
#undef LD8F
        float o[8];
#pragma unroll
        for (int j = 0; j < 8; ++j) { const float x = which == 0 ? bb[j] + w0[j] * outer[j] + w1[j] * self[j] + w2[j] * inner[j] : bb[j] + w0[j] * inner[j] + w1[j] * self[j] + w2[j] * outer[j];
            o[j] = x * sigmoidf_(x) * uu[j]; }
        *(GAS v4u*)(F.ACT() + (size_t)lrow * FFN + co) = pack8(o);
    }
}
__device__ __forceinline__ void p11_row(Frame& F, int row, int lane, float* obase) {
    const GAS bf16x8* f = (const GAS bf16x8*)((const bf16*)(F.out + (size_t)row * DM));
    const GAS bf16x8* hp = (const GAS bf16x8*)(row < HROWS ? F.H1A() + (size_t)row * DM : F.XN() + (size_t)(row - HROWS) * DM);
    bf16x8 hv[4], fq[4];
#pragma unroll
    for (int i = 0; i < 4; ++i) { hv[i] = hp[lane + 64 * i]; fq[i] = f[lane + 64 * i]; }
    asm volatile("s_waitcnt vmcnt(0)" ::: "memory");
    float fv[32]; float ss = 0.f;
#pragma unroll
    for (int i = 0; i < 4; ++i)
#pragma unroll
        for (int j = 0; j < 8; ++j) { fv[8 * i + j] = bf2f(fq[i][j]); ss += fv[8 * i + j] * fv[8 * i + j]; }
    const float r1 = 1.f / sqrtf(wave_sum(ss) * (1.f / DM) + EPS);
#pragma unroll
    for (int i = 0; i < 4; ++i) { const int e0 = (lane + 64 * i) * 8;
        const GAS f32x4* gp = (const GAS f32x4*)(FIN(F, 23  ) + e0); const f32x4 g0 = gp[0], g1 = gp[1];
        f32x4 h0, h1;
        h0.x = bf2f(hv[i][0]) + fv[8 * i + 0] * r1 * g0.x; h0.y = bf2f(hv[i][1]) + fv[8 * i + 1] * r1 * g0.y; h0.z = bf2f(hv[i][2]) + fv[8 * i + 2] * r1 * g0.z; h0.w = bf2f(hv[i][3]) + fv[8 * i + 3] * r1 * g0.w;
        h1.x = bf2f(hv[i][4]) + fv[8 * i + 4] * r1 * g1.x; h1.y = bf2f(hv[i][5]) + fv[8 * i + 5] * r1 * g1.y; h1.z = bf2f(hv[i][6]) + fv[8 * i + 6] * r1 * g1.z; h1.w = bf2f(hv[i][7]) + fv[8 * i + 7] * r1 * g1.w;
        GAS f32x4* wp = (GAS f32x4*)(obase + (size_t)row * DM + e0); wp[0] = h0; wp[1] = h1; }
}
struct Args { const float* in[24]; float* out; unsigned char* ws; int ph_lo, ph_hi, q_lo, q_hi, use_bar, dummy; };
constexpr int N_PHASES = 12;
__global__ void __launch_bounds__(NWAVES * 64, 2) mk_fwd(Args args) {
    extern __shared__ __attribute__((aligned(16))) unsigned char lds[];
    Frame F;
    F.lds = (LAS unsigned char*)lds;
    F.MISC = (volatile LAS unsigned*)(F.lds + MISC_OFF);
    F.wave = __builtin_amdgcn_readfirstlane((int)threadIdx.x >> 6);
    F.tid = F.wave * 64 + lane_id_now(); F.lane = F.tid & 63;
    F.G = gridDim.x; { const int bx = blockIdx.x; F.vcu = (F.G % 8 == 0) ? (bx % 8) * (F.G / 8) + bx / 8 : bx; }
    unsigned char* ws = args.ws;
    F.ctl = (gu32*)(ws + WS_CTL);
    F.kargs = (const __attribute__((address_space(4))) void*)__builtin_amdgcn_kernarg_segment_ptr(); F.ptag = 0; F.out = args.out;
    F.ws = ws;
    for (int u = F.tid; u < (LDS_BYTES - LDSCTL_OFF) / 4; u += NWAVES * 64) ((LAS unsigned*)(F.lds + LDSCTL_OFF))[u] = 0u;
    __syncthreads();
    XcdBarrier bar; bar.bar = (unsigned*)(F.ctl + CW_BAR); bar.x = 0; bar.st = nullptr;
    if (args.use_bar) bar = xcd_barrier_post((unsigned*)(F.ctl + CW_BAR), F.MISC + 8, F.tid == 0);
    const int lo = args.ph_lo, hi = args.ph_hi;
    const int dmy_ = MK_MULTI ? args.dummy : 0;
#define IN(k) (((MK_PHASE_MASK >> (k)) & 1) && lo <= (k) && (k) < hi)
#define PH_BEGIN(k) do { F.ptag = (k); int t_ = F.wave * 64 + lane_id_now(); asm volatile("" : "+v"(t_)); F.tid = t_; F.lane = t_ & 63; } while (0)
#define PH_BAR() do { if (args.use_bar) xcd_barrier(bar, F.wave == 0 && lane_id_now() == 0); } while (0)
    const int gw = F.vcu * NWAVES + F.wave, NGW = F.G * NWAVES;

    if (IN(0)) { PH_BEGIN(0); { p0_prologue(F); PH_BAR(); } }
    if (IN(1)) { PH_BEGIN(1); {
        p1_meta_z(F);
        pg8::Gemm g{F.XN(), F.WIN_T(), NTOK, INW, DM}; pg8::ProbeOrder S; S.init(NTOK, INW, F.G, (int)blockIdx.x); S.pmask = dmy_ == 5 ? 7 : -1;
        pg8::EpiRoute E{nullptr, 0, 1, F.QG(), F.K(), F.V(), F.XR()};
        if (dmy_ != 7) pg8::gemm_phase<pg8::EpiRoute, pg8::ProbeOrder, true, true>(F.lds, g, S, E, F.wave);
        PH_BAR();
    } }
    if (IN(2)) { PH_BEGIN(2); { lru_phase<1>(F, nullptr); PH_BAR(); } }
    if (IN(3)) { PH_BEGIN(3); {
        k_rope_pass(F, dmy_ ? (bf16*)F.out : F.K());
        lru_propagate(F);
        if (F.vcu == F.G - 1) p3_meta_job(F);
        PH_BAR();
    } }
    if (IN(4)) { PH_BEGIN(4); {
        const int dm = dmy_;
        if (dm < 2 || dm == 2) lru_phase<2>(F, dm ? (bf16*)F.out : F.QG());
        if (dm < 2 || dm == 3) for (int it = F.vcu; it < 512; it += F.G) metaq_item(F, it);
        if (dm < 2 || dm == 4) attn_phase(F, (char*)lds, dm ? (bf16*)F.out : F.QG());
        if (dm == 8 && F.vcu < 128) attn_phase(F, (char*)lds, (bf16*)F.out);
        if (dm == 6 && (F.vcu & 1) == 0) attn_phase(F, (char*)lds, (bf16*)F.out);
        PH_BAR();
    } }
    if (IN(5)) { PH_BEGIN(5); {
        p5_ratio(F);
        if (F.vcu >= F.G - 12) p5_meta_job(F, F.G - 1 - F.vcu);
        PH_BAR();
    } }
    if (IN(6)) { PH_BEGIN(6); {
        p6_meta_y(F);
        pg8::Gemm g{F.QG(), F.WOUT_T(), NTOK, DM, DM}; pg8::StaticOrder S; S.init(NTOK, DM, F.G, (int)blockIdx.x);
        pg8::EpiScaled E{(bf16*)F.out, 2 * DM, F.RATIO(), F.RL(), 16};
        pg8::gemm_phase<pg8::EpiScaled, pg8::StaticOrder, true, true>(F.lds, g, S, E, F.wave);
        PH_BAR();
    } }
#if MK_MULTI
    { const int q = args.q_lo;
#else
#pragma unroll
    for (int q = 0; q < 2; ++q) {
#endif
        if (IN(7)) { PH_BEGIN(7); {
            for (int row = q * HROWS + gw; row < (q + 1) * HROWS; row += NGW) p7_row(F, row, F.lane, (q == 0 ? F.H1A() : F.XN()) + (size_t)(row - q * HROWS) * DM);
            if (q == 0) p7_meta_g(F);
            PH_BAR();
        } }
        if (IN(8)) { PH_BEGIN(8); {
            pg8::Gemm g{F.XN() + (size_t)q * HROWS * DM, F.WUP_T(), HROWS, UPW, DM}; pg8::StaticOrder S; S.init(HROWS, UPW, F.G, (int)blockIdx.x);
            pg8::EpiAct E{F.ACT(), F.EDGE(), FIN(F, 20  ), FIN(F, 21  ), FFN};
            pg8::gemm_phase<pg8::EpiAct, pg8::StaticOrder, true, true>(F.lds, g, S, E, F.wave);
            PH_BAR();
        } }
        if (IN(9)) { PH_BEGIN(9); { p9_fix(F, q); PH_BAR(); } }
        if (IN(10)) { PH_BEGIN(10); {
            pg8::Gemm g{F.ACT(), F.WDOWN_T(), HROWS, DM, FFN}; pg8::ProbeOrder S; S.init(HROWS, DM, F.G, (int)blockIdx.x); S.pmask = dmy_ == 5 ? 7 : -1;
            pg8::EpiRoute E{(bf16*)F.out + (size_t)q * HROWS * 2 * DM, 2 * DM, 0, nullptr, nullptr, nullptr, nullptr};
            pg8::gemm_phase<pg8::EpiRoute, pg8::ProbeOrder, true, true>(F.lds, g, S, E, F.wave);
            if (q == 0) PH_BAR();
        } }
    }
    if (IN(10) && IN(11)) PH_BAR();
    if (IN(11)) { PH_BEGIN(11); { for (int row = gw; row < NTOK; row += NGW) p11_row(F, row, F.lane, dmy_ ? (float*)(F.ws + WS_B) : F.out); } }
#undef IN
#undef PH_BAR
}

extern "C" void kernel_launch(void* const* d_in, const int* in_sizes, int n_in, void* d_out, int out_size, void* d_ws, size_t ws_size, hipStream_t stream) {
    static int grid = 0;
    if (grid == 0) {
        if (n_in != 24 || out_size != NTOK * DM || ws_size < WS_END) { fprintf(stderr, "kernel_launch: unexpected shapes (n_in %d out %d ws %zu, need ws >= %zu); nothing launched\n", n_in, out_size, ws_size, (size_t)WS_END); grid = -1; return; }
        int dev = 0, cus = 0;
        if (hipGetDevice(&dev) != hipSuccess || hipDeviceGetAttribute(&cus, hipDeviceAttributeMultiprocessorCount, dev) != hipSuccess) { grid = -1; return; }
        if (hipFuncSetAttribute((const void*)mk_fwd, hipFuncAttributeMaxDynamicSharedMemorySize, LDS_BYTES) != hipSuccess) { fprintf(stderr, "kernel_launch: hipFuncSetAttribute failed\n"); grid = -1; return; }
        int per_cu = 0;
        if (hipOccupancyMaxActiveBlocksPerMultiprocessor(&per_cu, (const void*)mk_fwd, NWAVES * 64, LDS_BYTES) != hipSuccess || per_cu < 1) fprintf(stderr, "kernel_launch: occupancy query reports %d\n", per_cu);
        (void)hipGetLastError();
        grid = cus;
    }
    if (grid < 0) return;
    if (hipMemsetAsync((char*)d_ws + WS_CTL, 0, CTL_ZERO_BYTES, stream) != hipSuccess) return;
    Args a{};
    for (int i = 0; i < 24; ++i) a.in[i] = (const float*)d_in[i];
    a.out = (float*)d_out; a.ws = (unsigned char*)d_ws;
#if MK_MULTI
    a.use_bar = 0;
#define LAUNCH_PH(ph, q) do { a.ph_lo = (ph); a.ph_hi = (ph) + 1; a.q_lo = (q); a.q_hi = (q) + 1; \
        if ((MK_REPEAT_MASK >> (ph)) & 1) { a.dummy = MK_DUMMY_MODE; hipLaunchKernelGGL(mk_fwd, dim3(grid), dim3(NWAVES * 64), LDS_BYTES, stream, a); } \
        a.dummy = 0; hipLaunchKernelGGL(mk_fwd, dim3(grid), dim3(NWAVES * 64), LDS_BYTES, stream, a); } while (0)
    for (int ph = 0; ph < 7; ++ph) LAUNCH_PH(ph, 0);
    for (int q = 0; q < 2; ++q) for (int ph = 7; ph < 11; ++ph) LAUNCH_PH(ph, q);
    LAUNCH_PH(11, 0);
#else
    a.use_bar = 1; a.ph_lo = 0; a.ph_hi = N_PHASES; a.q_lo = 0; a.q_hi = 2;
    hipLaunchKernelGGL(mk_fwd, dim3(grid), dim3(NWAVES * 64), LDS_BYTES, stream, a);
#endif
    const hipError_t le = hipPeekAtLastError();
    if (le != hipSuccess) fprintf(stderr, "kernel_launch: launch failed: %s\n", hipGetErrorName(le));
}
```

```cpp
#include <hip/hip_runtime.h>
#include <cstdio>
#include <cstdint>
#include <cmath>
#ifndef MK_PHASE_MASK
#define MK_PHASE_MASK 0xfff
#endif
#ifndef MK_REPEAT_MASK
#define MK_REPEAT_MASK 0
#endif
#ifndef MK_DUMMY_MODE
#define MK_DUMMY_MODE 1
#endif
#ifndef MK_MULTI
#define MK_MULTI 0
#endif
__device__ __forceinline__ int lane_id_now() { int l; asm volatile("v_mbcnt_lo_u32_b32 %0, -1, 0\n\tv_mbcnt_hi_u32_b32 %0, -1, %0" : "=v"(l)); return l; }
namespace pg8 {
#define PG8_LAS __attribute__((address_space(3)))
typedef unsigned short bf16_t;
typedef short bf16x8 __attribute__((ext_vector_type(8)));
typedef float f32x4 __attribute__((ext_vector_type(4)));
typedef unsigned u32x4 __attribute__((ext_vector_type(4)));
constexpr int BM = 256, BK = 64, HALF = 128, HTB = HALF * BK * 2  , STAGE_BYTES = 8 * HTB, NXCD = 8, WGM = 8;

__host__ __device__ __forceinline__ int lds_byte(int r, int c) { const int st = (r >> 4) * 2 + (c >> 5), rr = r & 15, cc = c & 31, ob = rr * 64 + cc * 2; return st * 1024 + (ob ^ (((ob >> 9) & 1) << 5)); }
__host__ __device__ __forceinline__ void stage_rc(int b, int& R, int& C) { const int st = b / 1024, sb = b % 1024, swz = sb ^ (((sb >> 9) & 1) << 5); R = (st >> 1) * 16 + swz / 64; C = (st & 1) * 32 + (swz % 64) / 2; }
__host__ __device__ __forceinline__ int perm32(int rho) { const int n = rho >> 4, i = rho & 15; return 8 * (i >> 2) + 4 * n + (i & 3); }

struct Unit { int pm, pn; };
struct Gemm { const bf16_t* A; const bf16_t* Bt; int M, N, K; };

struct StaticOrder {
    int nM, nN, nwg, G, c;
    __host__ __device__ void init(int M, int N, int G_, int c_) { nM = M / BM; nN = N / BM; nwg = nM * nN; G = G_; c = c_; }
    __host__ __device__ bool next(int i, Unit& u) const {
        const long L = (long)i * G + c; if (L >= nwg) return false;
        int wgid = (int)L; { const int q = nwg / NXCD, r = nwg % NXCD, xcd = wgid % NXCD, off = wgid / NXCD; wgid = (xcd < r ? xcd * (q + 1) : r * (q + 1) + (xcd - r) * q) + off; }
        const int nig = WGM * nN, gid = wgid / nig, fm = gid * WGM, gsz = (nM - fm) < WGM ? (nM - fm) : WGM;
        u.pm = fm + ((wgid % nig) % gsz); u.pn = (wgid % nig) / gsz; return true;
    }
    __device__ __forceinline__ void a_ready(const Unit&) const {}
    __device__ __forceinline__ void done(const Unit&) const {}
};

__device__ __forceinline__ unsigned cvt_pk_bf16(float lo, float hi) { unsigned r; asm volatile("v_cvt_pk_bf16_f32 %0, %1, %2" : "=v"(r) : "v"(lo), "v"(hi)); return r; }
struct EpiRoute {
    static constexpr bool PERM = true, AFTER_DRAIN = false, MIDK = false;
    bf16_t* O; int ldc; int mode; bf16_t *QGp, *Kp, *Vp, *XRp;
    __device__ __forceinline__ void operator()(const f32x4 (&acc)[2][2][4][2], const Unit& u, int wr, int wc, int fr, int fq) const {
        bf16_t* base = O; int ld = ldc; int colt = u.pn * BM; int rowadd = 0;
        if (mode == 1) {
            const int pn = u.pn;
            if (pn < 4) { base = QGp; ld = 2048; colt = pn * 256; }
            else if (pn == 4) { base = Kp; ld = 256; colt = 0; }
            else if (pn == 5) { base = Vp; ld = 256; colt = 0; }
            else if (pn < 10) { base = XRp; ld = 1024; colt = (pn - 6) * 256; const int seq = u.pm < 128 ? (u.pm >> 4) : 8 + ((u.pm - 128) >> 5); rowadd = 64 * (seq + 1); }
            else { base = QGp; ld = 2048; colt = 1024 + (pn - 10) * 256; }
        }
        const int row0 = u.pm * BM + wr * 64 + fr + rowadd; const int col0 = colt + wc * 32 + 8 * fq;
#pragma unroll
        for (int ai = 0; ai < 2; ++ai)
#pragma unroll
            for (int m = 0; m < 4; ++m) { bf16_t* rowp = base + (size_t)(row0 + ai * HALF + m * 16) * ld + col0;
#pragma unroll
                for (int bj = 0; bj < 2; ++bj) { const f32x4 v0 = acc[ai][bj][m][0], v1 = acc[ai][bj][m][1];
                    u32x4 w; w.x = cvt_pk_bf16(v0[0], v0[1]); w.y = cvt_pk_bf16(v0[2], v0[3]); w.z = cvt_pk_bf16(v1[0], v1[1]); w.w = cvt_pk_bf16(v1[2], v1[3]);
                    *(u32x4*)(rowp + bj * HALF) = w; } }
    }
};

__device__ __forceinline__ float dpp_shr1(float old, float src) { return __builtin_bit_cast(float, __builtin_amdgcn_update_dpp(__builtin_bit_cast(int, old), __builtin_bit_cast(int, src), 0x111, 0xF, 0xF, false)); }
__device__ __forceinline__ float dpp_shl1(float old, float src) { return __builtin_bit_cast(float, __builtin_amdgcn_update_dpp(__builtin_bit_cast(int, old), __builtin_bit_cast(int, src), 0x101, 0xF, 0xF, false)); }
__device__ __forceinline__ float dpp_ror1(float src)  { return __builtin_bit_cast(float, __builtin_amdgcn_update_dpp(0, __builtin_bit_cast(int, src), 0x121, 0xF, 0xF, false)); }
__device__ __forceinline__ float dpp_ror15(float src) { return __builtin_bit_cast(float, __builtin_amdgcn_update_dpp(0, __builtin_bit_cast(int, src), 0x12F, 0xF, 0xF, false)); }
struct EpiAct {
    static constexpr bool PERM = true, AFTER_DRAIN = false, MIDK = false;
    bf16_t* ACT; float* EDGE; const float* cw; const float* cb; int nch;
    __device__ __forceinline__ void operator()(const f32x4 (&acc)[2][2][4][2], const Unit& u, int wr, int wc, int fr, int fq) const {
        const int ch0 = u.pn * 128 + wc * 32 + 8 * fq;
        float w0[8], w1[8], w2[8], bb[8];
        { const f32x4 a0 = *(const f32x4*)(cw + ch0), a1 = *(const f32x4*)(cw + ch0 + 4), b0 = *(const f32x4*)(cw + nch + ch0), b1 = *(const f32x4*)(cw + nch + ch0 + 4),
                      c0 = *(const f32x4*)(cw + 2 * nch + ch0), c1 = *(const f32x4*)(cw + 2 * nch + ch0 + 4), d0 = *(const f32x4*)(cb + ch0), d1 = *(const f32x4*)(cb + ch0 + 4);
#pragma unroll
          for (int k = 0; k < 4; ++k) { w0[k] = a0[k]; w0[4 + k] = a1[k]; w1[k] = b0[k]; w1[4 + k] = b1[k]; w2[k] = c0[k]; w2[4 + k] = c1[k]; bb[k] = d0[k]; bb[4 + k] = d1[k]; } }
        const int rowb = u.pm * BM + wr * 64;
#pragma unroll
        for (int ai = 0; ai < 2; ++ai) {
            float ein0[8], ein1[8];
#pragma unroll
            for (int m = 0; m < 4; ++m) {
                float o[8];
#pragma unroll
                for (int n = 0; n < 2; ++n)
#pragma unroll
                    for (int k = 0; k < 4; ++k) {
                        const int j = 4 * n + k; const float cur = acc[ai][0][m][n][k];
                        float pold = 0.f, nold = 0.f;
                        if (m > 0) pold = dpp_ror1(acc[ai][0][m > 0 ? m - 1 : 0][n][k]);
                        if (m < 3) nold = dpp_ror15(acc[ai][0][m < 3 ? m + 1 : 3][n][k]);
                        const float prv = dpp_shr1(pold, cur), nxt = dpp_shl1(nold, cur);
                        const float x = bb[j] + w0[j] * prv + w1[j] * cur + w2[j] * nxt;
                        o[j] = x * __builtin_amdgcn_rcpf(1.f + __builtin_amdgcn_exp2f(-1.4426950408889634f * x)) * acc[ai][1][m][n][k];
                        if (m == 0) ein0[j] = nxt;
                        if (m == 3) ein1[j] = prv;
                    }
                u32x4 w; w.x = cvt_pk_bf16(o[0], o[1]); w.y = cvt_pk_bf16(o[2], o[3]); w.z = cvt_pk_bf16(o[4], o[5]); w.w = cvt_pk_bf16(o[6], o[7]);
                *(u32x4*)(ACT + (size_t)(rowb + ai * HALF + m * 16 + fr) * nch + ch0) = w;
            }
            const int blk = (rowb + ai * HALF) >> 6;
            if (fr == 0 || fr == 15) {
                const bool last = fr == 15; float* e = EDGE + (size_t)((blk * 2 + (last ? 1 : 0)) * 3) * nch + ch0;
                f32x4 i0v, i1v, s0v, s1v, u0v, u1v;
#pragma unroll
                for (int k = 0; k < 4; ++k) { i0v[k] = last ? ein1[k] : ein0[k]; i1v[k] = last ? ein1[4 + k] : ein0[4 + k];
                    s0v[k] = last ? acc[ai][0][3][0][k] : acc[ai][0][0][0][k]; s1v[k] = last ? acc[ai][0][3][1][k] : acc[ai][0][0][1][k];
                    u0v[k] = last ? acc[ai][1][3][0][k] : acc[ai][1][0][0][k]; u1v[k] = last ? acc[ai][1][3][1][k] : acc[ai][1][0][1][k]; }
                *(f32x4*)(e) = i0v; *(f32x4*)(e + 4) = i1v; *(f32x4*)(e + nch) = s0v; *(f32x4*)(e + nch + 4) = s1v; *(f32x4*)(e + 2 * nch) = u0v; *(f32x4*)(e + 2 * nch + 4) = u1v;
            }
        }
    }
};

struct ProbeOrder : StaticOrder { int pmask;
    __host__ __device__ bool next(int i, Unit& u) const { const bool r = StaticOrder::next(i, u); u.pm &= pmask; return r; } };

struct EpiScaled {
    static constexpr bool PERM = true, AFTER_DRAIN = false, MIDK = true;
    bf16_t* O; int ldc; const float* ratio; const float* rl; int kt;
    __device__ __forceinline__ void midk(f32x4 (&acc)[2][2][4][2], const Unit& u, int wr, int fr) const {
        asm volatile("" ::: "memory");
        const float* rp = ratio + (u.pm * BM + wr * 64 + fr);
        float s[2][4];
#pragma unroll
        for (int ai = 0; ai < 2; ++ai)
#pragma unroll
            for (int m = 0; m < 4; ++m) s[ai][m] = rp[ai * HALF + m * 16];
#pragma unroll
        for (int ai = 0; ai < 2; ++ai)
#pragma unroll
            for (int m = 0; m < 4; ++m)
#pragma unroll
                for (int bj = 0; bj < 2; ++bj)
#pragma unroll
                    for (int n = 0; n < 2; ++n) acc[ai][bj][m][n] = acc[ai][bj][m][n] * s[ai][m];
        asm volatile("" ::: "memory");
    }
    __device__ __forceinline__ void operator()(const f32x4 (&acc)[2][2][4][2], const Unit& u, int wr, int wc, int fr, int fq) const {
        const int row0 = u.pm * BM + wr * 64 + fr, col0 = u.pn * BM + wc * 32 + 8 * fq;
#pragma unroll
        for (int ai = 0; ai < 2; ++ai)
#pragma unroll
            for (int m = 0; m < 4; ++m) { const int row = row0 + ai * HALF + m * 16; const float s = rl[row]; bf16_t* rowp = O + (size_t)row * ldc + col0;
#pragma unroll
                for (int bj = 0; bj < 2; ++bj) { const f32x4 v0 = acc[ai][bj][m][0] * s, v1 = acc[ai][bj][m][1] * s;
                    u32x4 w; w.x = cvt_pk_bf16(v0[0], v0[1]); w.y = cvt_pk_bf16(v0[2], v0[3]); w.z = cvt_pk_bf16(v1[0], v1[1]); w.w = cvt_pk_bf16(v1[2], v1[3]);
                    *(u32x4*)(rowp + bj * HALF) = w; } }
    }
};

template <class Epi, class Sched, bool ALIGN_EPI = false, bool SP2 = false>
__device__ __forceinline__ void gemm_phase(PG8_LAS unsigned char* lds, const Gemm g, const Sched& S, const Epi& E, int wave_id) {
    int tid_ = wave_id * 64 + lane_id_now(); asm volatile("" : "+v"(tid_));
    const int tid = tid_, wid = __builtin_amdgcn_readfirstlane(tid >> 6), lane = tid & 63, wr = wid >> 2, wc = wid & 3, fr = lane & 15, fq = lane >> 4;
    const int K = g.K, nt = K / BK;
    unsigned voffA[2], voffB[2];
#pragma unroll
    for (int i = 0; i < 2; ++i) { int R, C; stage_rc(tid * 16 + i * 8192, R, C); const int Rb = Epi::PERM ? ((R & ~31) + perm32(R & 31)) : R;
        voffA[i] = (unsigned)(R * K + C) * 2u; voffB[i] = (unsigned)(Rb * K + C) * 2u; }
    const size_t kstep = (size_t)(BK * 2);
    const size_t hstep = (size_t)HALF * K * 2;
    const size_t tstep = 2 * hstep;
    const unsigned ldsw = (unsigned)wid * 1024u;
    const int aoff = lds_byte(wr * 64 + fr, fq * 8), boff = lds_byte(wc * 32 + fr, fq * 8);
#define PG8_SA(b, h) (((b) * 2 + (h)) * HTB)
#define PG8_SB(b, h) ((4 + (b) * 2 + (h)) * HTB)
#define PG8_STAGE(bufoff, gbase, voff) do { _Pragma("unroll") for (int _i = 0; _i < 2; ++_i) \
        __builtin_amdgcn_global_load_lds((const unsigned*)((const char*)(gbase) + (voff)[_i]), (PG8_LAS unsigned*)(lds + (bufoff) + ldsw + _i * 8192), 16, 0, 0); } while (0)
#define PG8_LDA(dst, b, h) do { _Pragma("unroll") for (int m = 0; m < 4; ++m) _Pragma("unroll") for (int k = 0; k < 2; ++k) dst[m][k] = *(const PG8_LAS bf16x8*)(lds + PG8_SA(b, h) + aoff + m * 2048 + k * 1024); } while (0)
#define PG8_LDB(dst, b, h) do { _Pragma("unroll") for (int n = 0; n < 2; ++n) _Pragma("unroll") for (int k = 0; k < 2; ++k) dst[n][k] = *(const PG8_LAS bf16x8*)(lds + PG8_SB(b, h) + boff + n * 2048 + k * 1024); } while (0)
#define PG8_MMA(ai, bj, At, Bt) do { __builtin_amdgcn_s_setprio(1); _Pragma("unroll") for (int m = 0; m < 4; ++m) _Pragma("unroll") for (int n = 0; n < 2; ++n) _Pragma("unroll") for (int k = 0; k < 2; ++k) \
        acc[ai][bj][m][n] = __builtin_amdgcn_mfma_f32_16x16x32_bf16(Bt[n][k], At[m][k], acc[ai][bj][m][n], 0, 0, 0); __builtin_amdgcn_s_setprio(0); } while (0)
#define PG8_WAIT_V(n) asm volatile("s_waitcnt vmcnt(" #n ")" ::: "memory")
#define PG8_WAIT_L(n) asm volatile("s_waitcnt lgkmcnt(" #n ")" ::: "memory")
#define PG8_BAR __builtin_amdgcn_s_barrier()
#define PG8_SCHED __builtin_amdgcn_sched_barrier(0)
    Unit cur, nxt; int ui = 0;
    if (!S.next(0, cur)) return;
    f32x4 acc[2][2][4][2];
#pragma unroll
    for (int a = 0; a < 2; ++a)
#pragma unroll
        for (int b = 0; b < 2; ++b)
#pragma unroll
            for (int m = 0; m < 4; ++m)
#pragma unroll
                for (int n = 0; n < 2; ++n) acc[a][b][m][n] = (f32x4){0.f, 0.f, 0.f, 0.f};
    bf16x8 At[4][2], B0[2][2], B1[2][2];
    const char* cA = (const char*)g.A + (size_t)cur.pm * tstep; const char* cB = (const char*)g.Bt + (size_t)cur.pn * tstep;
    S.a_ready(cur);
    if constexpr (SP2) {
        PG8_STAGE(PG8_SB(0, 0), cB, voffB); PG8_STAGE(PG8_SB(0, 1), cB + hstep, voffB); PG8_STAGE(PG8_SA(0, 0), cA, voffA); PG8_STAGE(PG8_SA(0, 1), cA + hstep, voffA);
        if (wr == 1) PG8_BAR;
        PG8_WAIT_V(2); PG8_BAR;
        PG8_STAGE(PG8_SB(1, 0), cB + kstep, voffB); PG8_STAGE(PG8_SA(1, 0), cA + kstep, voffA); PG8_STAGE(PG8_SB(1, 1), cB + hstep + kstep, voffB);
        PG8_WAIT_V(6); PG8_BAR;
    } else {
        PG8_STAGE(PG8_SB(0, 0), cB, voffB); PG8_STAGE(PG8_SA(0, 0), cA, voffA); PG8_STAGE(PG8_SB(0, 1), cB + hstep, voffB); PG8_STAGE(PG8_SA(0, 1), cA + hstep, voffA);
        if (wr == 1) PG8_BAR;
        PG8_WAIT_V(4); PG8_BAR;
        PG8_STAGE(PG8_SB(1, 0), cB + kstep, voffB); PG8_STAGE(PG8_SA(1, 0), cA + kstep, voffA); PG8_STAGE(PG8_SB(1, 1), cB + hstep + kstep, voffB);
        PG8_WAIT_V(6); PG8_BAR;
    }
    for (;;) {
        const bool has_next = S.next(ui + 1, nxt);
        const char* nA = has_next ? (const char*)g.A + (size_t)nxt.pm * tstep : cA; const char* nB = has_next ? (const char*)g.Bt + (size_t)nxt.pn * tstep : cB;
        for (int t = 0; t < nt; t += 2) {
            if constexpr (Epi::MIDK) { if (t == E.kt) E.midk(acc, cur, wr, fr); }
            const bool last = (t == nt - 2);
            const char* a1 = cA + (size_t)(t + 1) * kstep;
            const char* a2 = last ? nA : cA + (size_t)(t + 2) * kstep; const char* b2 = last ? nB : cB + (size_t)(t + 2) * kstep;
            const char* a3 = a2 + kstep; const char* b3 = b2 + kstep;
            if (last && has_next) S.a_ready(nxt);
            if constexpr (SP2) {
            PG8_LDB(B0, 0, 0); PG8_LDB(B1, 0, 1); PG8_SCHED; PG8_LDA(At, 0, 0); PG8_STAGE(PG8_SA(1, 1), a1 + hstep, voffA);
            PG8_WAIT_V(8); PG8_WAIT_L(0); PG8_BAR; PG8_MMA(0, 0, At, B0); PG8_MMA(0, 1, At, B1); PG8_BAR; PG8_SCHED;
            PG8_LDA(At, 0, 1); PG8_STAGE(PG8_SB(0, 0), b2, voffB); PG8_STAGE(PG8_SB(0, 1), b2 + hstep, voffB); PG8_STAGE(PG8_SA(0, 0), a2, voffA);
            PG8_WAIT_V(8); PG8_WAIT_L(0); PG8_BAR; PG8_MMA(1, 0, At, B0); PG8_MMA(1, 1, At, B1); PG8_BAR; PG8_SCHED;
            PG8_LDB(B0, 1, 0); PG8_LDB(B1, 1, 1); PG8_SCHED; PG8_LDA(At, 1, 0); PG8_STAGE(PG8_SA(0, 1), a2 + hstep, voffA);
            PG8_WAIT_V(8); PG8_WAIT_L(0); PG8_BAR; PG8_MMA(0, 0, At, B0); PG8_MMA(0, 1, At, B1); PG8_BAR; PG8_SCHED;
            PG8_LDA(At, 1, 1); PG8_STAGE(PG8_SB(1, 0), b3, voffB); PG8_STAGE(PG8_SB(1, 1), b3 + hstep, voffB); PG8_STAGE(PG8_SA(1, 0), a3, voffA);
            PG8_WAIT_V(8); PG8_WAIT_L(0); PG8_BAR; PG8_MMA(1, 0, At, B0); PG8_MMA(1, 1, At, B1); PG8_BAR; PG8_SCHED;
            } else {
            PG8_LDB(B0, 0, 0); PG8_SCHED; PG8_LDA(At, 0, 0); PG8_STAGE(PG8_SA(1, 1), a1 + hstep, voffA);
            PG8_WAIT_L(8); PG8_BAR; PG8_WAIT_L(0); PG8_MMA(0, 0, At, B0); PG8_BAR; PG8_SCHED;
            PG8_LDB(B1, 0, 1); PG8_STAGE(PG8_SB(0, 0), b2, voffB);
            PG8_BAR; PG8_WAIT_L(0); PG8_MMA(0, 1, At, B1); PG8_BAR;
            PG8_LDA(At, 0, 1); PG8_STAGE(PG8_SA(0, 0), a2, voffA);
            PG8_BAR; PG8_WAIT_L(0); PG8_MMA(1, 0, At, B0); PG8_BAR; PG8_SCHED;
            PG8_STAGE(PG8_SB(0, 1), b2 + hstep, voffB);
            PG8_WAIT_V(6); PG8_BAR; PG8_MMA(1, 1, At, B1); PG8_BAR;
            PG8_LDB(B0, 1, 0); PG8_SCHED; PG8_LDA(At, 1, 0); PG8_STAGE(PG8_SA(0, 1), a2 + hstep, voffA);
            PG8_WAIT_L(8); PG8_BAR; PG8_WAIT_L(0); PG8_MMA(0, 0, At, B0); PG8_BAR; PG8_SCHED;
            PG8_LDB(B1, 1, 1); PG8_STAGE(PG8_SB(1, 0), b3, voffB);
            PG8_BAR; PG8_WAIT_L(0); PG8_MMA(0, 1, At, B1); PG8_BAR;
            PG8_LDA(At, 1, 1); PG8_STAGE(PG8_SA(1, 0), a3, voffA);
            PG8_BAR; PG8_WAIT_L(0); PG8_MMA(1, 0, At, B0); PG8_BAR; PG8_SCHED;
            PG8_STAGE(PG8_SB(1, 1), b3 + hstep, voffB);
            PG8_WAIT_V(6); PG8_BAR; PG8_MMA(1, 1, At, B1); PG8_BAR;
            }
        }
        if constexpr (ALIGN_EPI) { if (wr == 0) PG8_BAR; }
        if constexpr (!Epi::AFTER_DRAIN) { E(acc, cur, wr, wc, fr, fq); S.done(cur); }
        if (!has_next) break;
#pragma unroll
        for (int a = 0; a < 2; ++a)
#pragma unroll
            for (int b = 0; b < 2; ++b)
#pragma unroll
                for (int m = 0; m < 4; ++m)
#pragma unroll
                    for (int n = 0; n < 2; ++n) acc[a][b][m][n] = (f32x4){0.f, 0.f, 0.f, 0.f};
        cur = nxt; cA = nA; cB = nB; ++ui;
        if constexpr (ALIGN_EPI) { if (wr == 1) PG8_BAR; }
    }
    PG8_WAIT_V(0);
    if constexpr (!ALIGN_EPI) { if (wr == 0) PG8_BAR; }
    PG8_BAR;
    if constexpr (Epi::AFTER_DRAIN) { E.fused(acc, cur, wr, wc, fr, fq, lds, wid, lane); S.done(cur); }
#undef PG8_SA
#undef PG8_SB
#undef PG8_STAGE
#undef PG8_LDA
#undef PG8_LDB
#undef PG8_MMA
#undef PG8_WAIT_V
#undef PG8_WAIT_L
#undef PG8_BAR
#undef PG8_SCHED
}
}
namespace attn {
typedef unsigned short bf16r;
using bf16x8 = __attribute__((ext_vector_type(8))) short;
using s16x4  = __attribute__((ext_vector_type(4))) short;
using f32x4  = __attribute__((ext_vector_type(4))) float;
using u32x4  = __attribute__((ext_vector_type(4))) unsigned;
constexpr int   QBLK = 32, KVBLK = 64;
constexpr float SCALE = 0.088388347648318440f;
constexpr float THRL = 8.f;
constexpr int LDQ = 2048, LDK = 256, LDO = 2048;
constexpr size_t SHM_ATTN = 6 * 16384 + 8 * 64 * 4;
#define SBAR() __builtin_amdgcn_sched_barrier(0)
__device__ __forceinline__ unsigned cvtpk(float lo, float hi) { unsigned r; asm volatile("v_cvt_pk_bf16_f32 %0, %1, %2" : "=v"(r) : "v"(lo), "v"(hi)); return r; }
__device__ __forceinline__ unsigned short f2bf_rne(float f) { unsigned u = __builtin_bit_cast(unsigned, f); return (unsigned short)((u + 0x7fffu + ((u >> 16) & 1u)) >> 16); }
__device__ __forceinline__ float bfl(short b) { return __builtin_bit_cast(float, (unsigned)(unsigned short)b << 16); }
template <int OFF> __device__ __forceinline__ s16x4 tr_read(int vb) { s16x4 r; asm volatile("ds_read_b64_tr_b16 %0, %1 offset:%2" : "=&v"(r) : "v"(vb), "i"(OFF) : "memory"); return r; }

__device__ __forceinline__ void qkt16(f32x4 (&S)[4][2], const char* Ks, int kb0, const bf16x8 (&qf)[2][4], float nm0, float nm1) {
  const f32x4 n0 = {nm0, nm0, nm0, nm0}, n1 = {nm1, nm1, nm1, nm1};
#pragma unroll
  for (int kb = 0; kb < 4; ++kb)
#pragma unroll
    for (int ds = 0; ds < 4; ++ds) { const bf16x8 kf = *reinterpret_cast<const bf16x8*>(Ks + kb * 4096 + (kb0 ^ (64 * ds)));
      S[kb][0] = __builtin_amdgcn_mfma_f32_16x16x32_bf16(kf, qf[0][ds], ds == 0 ? n0 : S[kb][0], 0, 0, 0);
      S[kb][1] = __builtin_amdgcn_mfma_f32_16x16x32_bf16(kf, qf[1][ds], ds == 0 ? n1 : S[kb][1], 0, 0, 0); }
}
__device__ __forceinline__ void mask_meta16(f32x4 (&S)[4][2]) {
  const float NEG = -INFINITY;
#pragma unroll
  for (int kb = 1; kb < 4; ++kb)
#pragma unroll
    for (int qb = 0; qb < 2; ++qb) S[kb][qb] = (f32x4){NEG, NEG, NEG, NEG};
}
__device__ __forceinline__ void partial16(f32x4 (&S)[4][2], float (&mhat)[2], float (&alpha)[2], bool first) {
  float pm[2];
#pragma unroll
  for (int qb = 0; qb < 2; ++qb) { float a = __builtin_fmaxf(__builtin_fmaxf(S[0][qb][0], S[0][qb][1]), S[0][qb][2]), b = __builtin_fmaxf(__builtin_fmaxf(S[0][qb][3], S[1][qb][0]), S[1][qb][1]);
    a = __builtin_fmaxf(__builtin_fmaxf(a, S[1][qb][2]), S[1][qb][3]); b = __builtin_fmaxf(__builtin_fmaxf(b, S[2][qb][0]), S[2][qb][1]);
    a = __builtin_fmaxf(__builtin_fmaxf(a, S[2][qb][2]), S[2][qb][3]); b = __builtin_fmaxf(__builtin_fmaxf(b, S[3][qb][0]), S[3][qb][1]);
    a = __builtin_fmaxf(__builtin_fmaxf(a, S[3][qb][2]), S[3][qb][3]); pm[qb] = __builtin_fmaxf(a, b); }
  alpha[0] = 1.f; alpha[1] = 1.f;
  if (first || __builtin_expect(__any(__builtin_fmaxf(pm[0], pm[1]) > THRL), 0)) {
#pragma unroll
    for (int qb = 0; qb < 2; ++qb) { float m = pm[qb]; m = __builtin_fmaxf(m, __shfl_xor(m, 16)); m = __builtin_fmaxf(m, __shfl_xor(m, 32));
      const float dl = first ? m : __builtin_fmaxf(m, 0.f); mhat[qb] += dl;
#pragma unroll
      for (int kb = 0; kb < 4; ++kb) S[kb][qb] = S[kb][qb] - dl;
      if (!first) alpha[qb] = __builtin_amdgcn_exp2f(-dl); }
  }
#pragma unroll
  for (int kb = 0; kb < 2; ++kb)
#pragma unroll
    for (int qb = 0; qb < 2; ++qb)
#pragma unroll
      for (int r = 0; r < 4; ++r) S[kb][qb][r] = __builtin_amdgcn_exp2f(S[kb][qb][r]);
}
__device__ __forceinline__ void finish16(f32x4 (&S)[4][2], const float (&alpha)[2], float (&lsum)[2], bf16x8 (&pa)[2][2]) {
#pragma unroll
  for (int kb = 2; kb < 4; ++kb)
#pragma unroll
    for (int qb = 0; qb < 2; ++qb)
#pragma unroll
      for (int r = 0; r < 4; ++r) S[kb][qb][r] = __builtin_amdgcn_exp2f(S[kb][qb][r]);
#pragma unroll
  for (int qb = 0; qb < 2; ++qb) { float ps = 0.f;
#pragma unroll
    for (int kb = 0; kb < 4; ++kb) ps += (S[kb][qb][0] + S[kb][qb][1]) + (S[kb][qb][2] + S[kb][qb][3]);
    lsum[qb] = lsum[qb] * alpha[qb] + ps;
#pragma unroll
    for (int ks = 0; ks < 2; ++ks) { const f32x4 a = S[2 * ks][qb], b = S[2 * ks + 1][qb];
      u32x4 w = {cvtpk(a[0], a[1]), cvtpk(a[2], a[3]), cvtpk(b[0], b[1]), cvtpk(b[2], b[3])}; pa[qb][ks] = *reinterpret_cast<bf16x8*>(&w); } }
}
template <int KS, int DB> __device__ __forceinline__ void pv_one16(f32x4 (&O)[2][8], int vbA, int vbB, const bf16x8 (&pa)[2][2]) {
  const int vb = DB < 7 ? vbA : vbB;
  const s16x4 lo = tr_read<(8 * KS) * 1024 + 128 * DB>(vb), hi = tr_read<(8 * KS + 4) * 1024 + 128 * DB>(vb);
  asm volatile("s_waitcnt lgkmcnt(0)" ::: "memory"); SBAR();
  const bf16x8 bfr = {lo[0], lo[1], lo[2], lo[3], hi[0], hi[1], hi[2], hi[3]};
  O[0][DB] = __builtin_amdgcn_mfma_f32_16x16x32_bf16(pa[0][KS], bfr, O[0][DB], 0, 0, 0);
  O[1][DB] = __builtin_amdgcn_mfma_f32_16x16x32_bf16(pa[1][KS], bfr, O[1][DB], 0, 0, 0);
}
template <int KS> __device__ __forceinline__ void pv_ks16(f32x4 (&O)[2][8], int vbA, int vbB, const bf16x8 (&pa)[2][2]) {
  pv_one16<KS, 0>(O, vbA, vbB, pa); pv_one16<KS, 1>(O, vbA, vbB, pa); pv_one16<KS, 2>(O, vbA, vbB, pa); pv_one16<KS, 3>(O, vbA, vbB, pa);
  pv_one16<KS, 4>(O, vbA, vbB, pa); pv_one16<KS, 5>(O, vbA, vbB, pa); pv_one16<KS, 6>(O, vbA, vbB, pa); pv_one16<KS, 7>(O, vbA, vbB, pa);
}
__device__ __forceinline__ void pv16(f32x4 (&O)[2][8], int vbA, int vbB, const bf16x8 (&pa)[2][2]) { pv_ks16<0>(O, vbA, vbB, pa); pv_ks16<1>(O, vbA, vbB, pa); }

__device__ __forceinline__ void attn_unit(const bf16r* Qb, const bf16r* __restrict__ Kh, const bf16r* __restrict__ Vh,
                                          const bf16r* __restrict__ KMh, const bf16r* __restrict__ VMh, bf16r* Ob, int NT, char* lds,
                                          const float* __restrict__ qnorm, int t0, float* ssq, int wave_id) {
  int tid_ = wave_id * 64 + lane_id_now(); asm volatile("" : "+v"(tid_));
  const int tid = tid_, wid = tid >> 6, lane = tid & 63, c = lane & 15, g = lane >> 4;
  float* ws = (float*)(lds + 6 * 16384) + wid * 64; float* li_l = ws; float* al_l = ws + 32;
  float mhat[2] = {0.f, 0.f}, lsum[2] = {0.f, 0.f};
  f32x4 O[2][8];
#pragma unroll
  for (int qb = 0; qb < 2; ++qb)
#pragma unroll
    for (int db = 0; db < 8; ++db) O[qb][db] = (f32x4){0.f, 0.f, 0.f, 0.f};
  bf16x8 qf[2][4];
#pragma unroll
  for (int qb = 0; qb < 2; ++qb)
#pragma unroll
    for (int ds = 0; ds < 4; ++ds) qf[qb][ds] = *reinterpret_cast<const bf16x8*>(Qb + (long)(wid * QBLK + 16 * qb + c) * LDQ + 32 * ds + 8 * g);
  {
    int go = g; asm volatile("" : "+v"(go));
#pragma unroll
    for (int qb = 0; qb < 2; ++qb) {
      float ss = 0.f;
#pragma unroll
      for (int ds = 0; ds < 4; ++ds)
#pragma unroll
        for (int j = 0; j < 8; ++j) { const float x = bfl(qf[qb][ds][j]); ss += x * x; }
      ss += __shfl_xor(ss, 16); ss += __shfl_xor(ss, 32);
      const float rs = (SCALE * 1.4426950408889634f) / sqrtf(ss * (1.f / 128.f) + 1e-6f);
      int t = t0 + wid * QBLK + 16 * qb + c; asm volatile("" : "+v"(t));
#pragma unroll
      for (int p = 0; p < 2; ++p) { const float pos = (float)(p ? (t & 63) : (t >> 6)); const int fa = 2 * p, fb = 2 * p + 1;
        const float4 ga0 = *reinterpret_cast<const float4*>(qnorm + 32 * fa + 8 * g), ga1 = *reinterpret_cast<const float4*>(qnorm + 32 * fa + 8 * g + 4);
        const float4 gb0 = *reinterpret_cast<const float4*>(qnorm + 32 * fb + 8 * g), gb1 = *reinterpret_cast<const float4*>(qnorm + 32 * fb + 8 * g + 4);
        const float gaf[8] = {ga0.x, ga0.y, ga0.z, ga0.w, ga1.x, ga1.y, ga1.z, ga1.w}, gbf[8] = {gb0.x, gb0.y, gb0.z, gb0.w, gb1.x, gb1.y, gb1.z, gb1.w};
        float oa[8], ob[8];
#pragma unroll
        for (int j = 0; j < 8; ++j) { const int i = 8 * go + j;
          float rev = pos * __builtin_amdgcn_exp2f(-(float)i * (13.287712379549449f / 32.f)) * 0.15915494309189535f; rev -= floorf(rev);
          const float sn = __builtin_amdgcn_sinf(rev), cs = __builtin_amdgcn_cosf(rev);
          const float x1 = bfl(qf[qb][fa][j]) * rs * gaf[j], x2 = bfl(qf[qb][fb][j]) * rs * gbf[j];
          oa[j] = x1 * cs - x2 * sn; ob[j] = x2 * cs + x1 * sn; }
        { u32x4 w = {cvtpk(oa[0], oa[1]), cvtpk(oa[2], oa[3]), cvtpk(oa[4], oa[5]), cvtpk(oa[6], oa[7])}; qf[qb][fa] = *reinterpret_cast<bf16x8*>(&w); }
        { u32x4 w = {cvtpk(ob[0], ob[1]), cvtpk(ob[2], ob[3]), cvtpk(ob[4], ob[5]), cvtpk(ob[6], ob[7])}; qf[qb][fb] = *reinterpret_cast<bf16x8*>(&w); }
        SBAR(); }
    }
  }
  unsigned kgo0, vgo0;
  { const int k0 = 4 * wid + g; kgo0 = (unsigned)(k0 * (LDK * 2) + ((c << 4) ^ ((k0 & 15) << 4)));
    const int r = (lane >> 1) & 3, half = lane & 1, s8 = lane >> 3;
    { const int p = wid,     db = (s8 - (p & 1)) & 7; vgo0 = (unsigned)((4 * p + r) * (LDK * 2) + (16 * db + 8 * half) * 2); }
 }
  const int kb0 = c * 256 + ((g ^ c) << 4);
  typedef __attribute__((address_space(3))) unsigned char* ldsp_t;
  const ldsp_t lds3 = (ldsp_t)lds;
  const int w1k = __builtin_amdgcn_readfirstlane(wid) * 1024;
  constexpr int VRING = 3 * 16384;
#define DMAK(t, soff) do { const char* b_ = (const char*)((t) == 0 ? KMh : Kh + (long)((t) - 1) * KVBLK * LDK); \
    __builtin_amdgcn_global_load_lds((const unsigned*)(b_ + kgo0), (__attribute__((address_space(3))) unsigned*)(lds3 + (soff) + w1k), 16, 0, 0); \
    __builtin_amdgcn_global_load_lds((const unsigned*)(b_ + kgo0 + 32 * LDK * 2), (__attribute__((address_space(3))) unsigned*)(lds3 + (soff) + w1k + 8192), 16, 0, 0); } while (0)
#define DMAV(t, soff) do { const char* b_ = (const char*)((t) == 0 ? VMh : Vh + (long)((t) - 1) * KVBLK * LDK); \
    __builtin_amdgcn_global_load_lds((const unsigned*)(b_ + vgo0), (__attribute__((address_space(3))) unsigned*)(lds3 + VRING + (soff) + w1k), 16, 0, 0); \
    __builtin_amdgcn_global_load_lds((const unsigned*)(b_ + vgo0 + 32 * LDK * 2), (__attribute__((address_space(3))) unsigned*)(lds3 + VRING + (soff) + w1k + 8192), 16, 0, 0); } while (0)
#define WAITBAR(N) asm volatile("s_waitcnt vmcnt(" #N ") lgkmcnt(0)\n\ts_barrier" ::: "memory")
#define ROT() do { const int t_ = sm1; sm1 = sc_; sc_ = sp1; sp1 = t_; } while (0)
#define RESC(a) do { if (__any(__builtin_fminf((a)[0], (a)[1]) < 1.f)) { if (g == 0) { al_l[c] = (a)[0]; al_l[16 + c] = (a)[1]; } asm volatile("s_waitcnt lgkmcnt(0)" ::: "memory"); \
    _Pragma("unroll") for (int qb_ = 0; qb_ < 2; ++qb_) _Pragma("unroll") for (int r_ = 0; r_ < 4; ++r_) { const float a_ = al_l[16 * qb_ + 4 * g + r_]; \
      _Pragma("unroll") for (int db_ = 0; db_ < 8; ++db_) O[qb_][db_][r_] *= a_; } } } while (0)
  const int vlb = (int)(uintptr_t)(lds + VRING) + g * 1024 + (c >> 2) * 32 + (c & 3) * 8;
  const int vbA0 = vlb + (g & 1) * 128, vbB0 = vlb + (g & 1) * (128 - 1024);
  int sm1 = 32768, sc_ = 0, sp1 = 16384;
  f32x4 S[4][2]; bf16x8 paA[2][2], paB[2][2]; float al[2];
  DMAK(0, 0); DMAV(0, 0); DMAK(1, 16384);
  WAITBAR(2);
  DMAK(2, sm1); DMAV(1, sp1);
  qkt16(S, lds + sc_, kb0, qf, -mhat[0], -mhat[1]); mask_meta16(S); partial16(S, mhat, al, true); finish16(S, al, lsum, paA);
  WAITBAR(4); ROT();
  for (int t = 1; t + 1 < NT; t += 2) {
    if (t + 2 < NT) DMAK(t + 2, sm1); DMAV(t + 1, sp1);
    SBAR(); qkt16(S, lds + sc_, kb0, qf, -mhat[0], -mhat[1]); SBAR();
    pv16(O, vbA0 + sm1, vbB0 + sm1, paA); partial16(S, mhat, al, false); finish16(S, al, lsum, paB);
    if (t + 2 < NT) WAITBAR(4); else WAITBAR(2);
    RESC(al); ROT();
    if (t + 3 < NT) DMAK(t + 3, sm1); if (t + 2 < NT) DMAV(t + 2, sp1);
    SBAR(); qkt16(S, lds + sc_, kb0, qf, -mhat[0], -mhat[1]); SBAR();
    pv16(O, vbA0 + sm1, vbB0 + sm1, paB); partial16(S, mhat, al, false); finish16(S, al, lsum, paA);
    if (t + 3 < NT) WAITBAR(4); else if (t + 2 < NT) WAITBAR(2); else WAITBAR(0);
    RESC(al); ROT();
  }
  pv16(O, vbA0 + sm1, vbB0 + sm1, paA);
#pragma unroll
  for (int qb = 0; qb < 2; ++qb) { float L = lsum[qb]; L += __shfl_xor(L, 16); L += __shfl_xor(L, 32); if (g == 0) li_l[16 * qb + c] = L; }
  asm volatile("s_waitcnt lgkmcnt(0)" ::: "memory");
  bf16r* Ow = Ob + (long)(wid * QBLK) * LDO;
#pragma unroll
  for (int qb = 0; qb < 2; ++qb)
#pragma unroll
    for (int r = 0; r < 4; ++r) { const int orow = 16 * qb + 4 * g + r; const float rl = __builtin_amdgcn_rcpf(li_l[orow]); float sq = 0.f;
#pragma unroll
      for (int db = 0; db < 8; ++db) { const float v = O[qb][db][r] * rl; sq += v * v; Ow[(long)orow * LDO + 16 * db + c] = f2bf_rne(v); }
      sq += __shfl_xor(sq, 1); sq += __shfl_xor(sq, 2); sq += __shfl_xor(sq, 4); sq += __shfl_xor(sq, 8);
      if (c == 0) ssq[(long)(wid * QBLK + orow) * 8] = sq; }
  WAITBAR(0);
#undef DMAK
#undef DMAV
#undef WAITBAR
#undef ROT
#undef RESC
}
#undef SBAR
}

constexpr int NWAVES = 8;
constexpr int DM = 2048, NTOK = 65536, INW = 3584, FFN = 5632, UPW = 2 * FFN;
constexpr float EPS = 1e-6f;
constexpr int XR_ROWS = 8 * 4160 + 4 * 8256;
constexpr int NCHUNK = 8 * 65 + 4 * 129;
constexpr int HROWS = 32768;
__host__ __device__ __forceinline__ int seq_first_row(int s) { return s < 8 ? s * 4096 : 32768 + (s - 8) * 8192; }
__host__ __device__ __forceinline__ int seq_len(int s) { return s < 8 ? 4096 : 8192; }
__host__ __device__ __forceinline__ int xr_base(int s) { return s < 8 ? s * 4160 : 33280 + (s - 8) * 8256; }
__host__ __device__ __forceinline__ int chunk_base(int s) { return s < 8 ? s * 65 : 520 + (s - 8) * 129; }
__host__ __device__ __forceinline__ int row_seq(int row) { return row < 32768 ? (row >> 12) : 8 + ((row - 32768) >> 13); }

constexpr size_t MiB = 1u << 20, KiB = 1u << 10;
constexpr size_t WS_CTL = 0, CTL_ZERO_BYTES = 1 * MiB;
constexpr size_t WS_SMALL = 1 * MiB;
constexpr size_t WS_XNMETA = WS_SMALL + 0, WS_ZM = WS_SMALL + 64 * KiB, WS_KM = WS_SMALL + 320 * KiB, WS_VM = WS_SMALL + 352 * KiB, WS_Q15 = WS_SMALL + 384 * KiB, WS_GY15 = WS_SMALL + 388 * KiB,
                 WS_LO15 = WS_SMALL + 392 * KiB, WS_MIXED15 = WS_SMALL + 448 * KiB, WS_Y15 = WS_SMALL + 544 * KiB, WS_G15 = WS_SMALL + 640 * KiB, WS_MQP = WS_SMALL + 1024 * KiB;
constexpr size_t WS_WIN = 5 * MiB, WS_WOUT = 19 * MiB, WS_WUP = 27 * MiB, WS_WDOWN = 71 * MiB, WS_WG = 93 * MiB;
constexpr size_t WS_CAR = 94 * MiB, WS_CIN = 111 * MiB;
constexpr size_t WS_R0 = 120 * MiB, WS_RATIO = 120 * MiB + 256 * KiB, WS_RL = 120 * MiB + 512 * KiB, WS_SSQA = 121 * MiB, WS_SSQL = 123 * MiB;
constexpr size_t WS_A = 128 * MiB;
constexpr size_t WS_B = 384 * MiB;
constexpr size_t WS_QG = WS_B, WS_K = WS_B + 256 * MiB, WS_V = WS_B + 288 * MiB, WS_XR = WS_B + 320 * MiB;
constexpr size_t WS_ACT = WS_B, WS_EDGE = WS_B + 352 * MiB;
constexpr size_t WS_H1A = WS_B + 420 * MiB;
constexpr size_t WS_END = WS_B + 548 * MiB;
static_assert(WS_ZM + 16 * INW * 4 <= WS_KM && WS_G15 + 12 * FFN * 4 <= WS_MQP && WS_MQP + 512 * 4 * 132 * 4 <= WS_WIN, "small map");
static_assert(WS_WIN + (size_t)INW * DM * 2 <= WS_WOUT && WS_WOUT + (size_t)DM * DM * 2 <= WS_WUP && WS_WUP + (size_t)UPW * DM * 2 <= WS_WDOWN && WS_WDOWN + (size_t)DM * FFN * 2 <= WS_WG && WS_WG + 32 * 16384 * 2 <= WS_CAR, "weights map");
static_assert(WS_CAR + (size_t)NCHUNK * 2 * 1024 * 8 <= WS_CIN && WS_A + (size_t)NTOK * DM * 2 <= WS_B, "carry map");
static_assert(WS_QG + (size_t)NTOK * DM * 2 <= WS_K && WS_XR + (size_t)(XR_ROWS + 64) * 1024 * 2 <= WS_END && WS_EDGE + (size_t)512 * 2 * 3 * FFN * 4 <= WS_H1A && WS_H1A + (size_t)HROWS * DM * 2 <= WS_END && WS_END <= 1024 * MiB && WS_CIN + (size_t)NCHUNK * 2 * 1024 * 4 <= WS_R0 && WS_SSQL + (size_t)NTOK * 8 * 4 <= WS_A && WS_ACT + (size_t)HROWS * FFN * 2 <= WS_EDGE && WS_EDGE + (size_t)512 * 2 * 3 * FFN * 4 <= WS_END, "B map");
constexpr int CW_BAR = 4096;

constexpr int RING_BYTES = 131072;
constexpr int LDSCTL_OFF = RING_BYTES, MISC_OFF = LDSCTL_OFF + 320;
constexpr int LDS_BYTES = 147456;

#define GAS __attribute__((address_space(1)))
#define LAS __attribute__((address_space(3)))
typedef unsigned short bf16;
typedef unsigned v4u __attribute__((ext_vector_type(4)));
typedef float f32x4 __attribute__((ext_vector_type(4)));
typedef short bf16x8 __attribute__((ext_vector_type(8)));
typedef GAS unsigned gu32;
typedef GAS unsigned long long gu64;
#define RLX_AGENT __ATOMIC_RELAXED, __HIP_MEMORY_SCOPE_AGENT
#define LDS_WAIT() asm volatile("s_waitcnt lgkmcnt(0)" ::: "memory")
#define VM_WAIT() asm volatile("s_waitcnt vmcnt(0)" ::: "memory")
__device__ __forceinline__ unsigned long long rt() { return __builtin_amdgcn_s_memrealtime(); }
__device__ __forceinline__ unsigned f2bf(float f) { unsigned u = __builtin_bit_cast(unsigned, f); return (u + 0x7fffu + ((u >> 16) & 1u)) >> 16; }
__device__ __forceinline__ unsigned pk2(float lo, float hi) { return f2bf(lo) | (f2bf(hi) << 16); }

#define XB_TMO      128
#define XB_XCNT(j)  (256  + 64 * (j))
#define XB_XSUB(j)  (1280 + 64 * (j))
#define XB_XGEN(j)  (2304 + 64 * (j))
#define XB_TOP      3328
#define XB_TOPGEN   3392
#define XCD_BAR_WORDS 3456
#define XB_SPIN_CAP (1u << 18)

__device__ __forceinline__ unsigned xb_ld(unsigned* p)              { return __hip_atomic_load(p, __ATOMIC_RELAXED, __HIP_MEMORY_SCOPE_AGENT); }
__device__ __forceinline__ unsigned xb_add(unsigned* p, unsigned v) { return __hip_atomic_fetch_add(p, v, __ATOMIC_RELAXED, __HIP_MEMORY_SCOPE_AGENT); }
__device__ __forceinline__ unsigned xb_xcc_id() { return (unsigned)__builtin_amdgcn_s_getreg((3 << 11) | 20) & 0xFu; }
#define XB_SPIN(cond, bar) do { unsigned _sp = 0; while (cond) { __builtin_amdgcn_s_sleep(1); \
    if ((++_sp & 255u) == 0u) { if (xb_ld(&(bar)[XB_TMO])) break; if (_sp > XB_SPIN_CAP) { atomicAdd(&(bar)[XB_TMO], 1u); break; } } } } while (0)

struct XcdBarrier {
    unsigned* bar; unsigned x;
    volatile LAS unsigned* st;
};

__device__ __forceinline__ XcdBarrier xcd_barrier_post(unsigned* bar, volatile LAS unsigned* st, bool t0  ) {
    XcdBarrier b; b.bar = bar; b.x = xb_xcc_id(); b.st = st;
    if (t0) (void)xb_add(&bar[XB_XCNT(b.x)], 1u);
    return b;
}
__device__ __forceinline__ void xcd_barrier_complete(unsigned* bar, unsigned x, unsigned& nloc, unsigned& nx) {
    const unsigned G = gridDim.x * gridDim.y * gridDim.z;
    unsigned sum, cnt, mine, sp = 0u;
    for (;;) {
        sum = 0u; cnt = 0u; mine = 0u;
#pragma unroll
        for (unsigned j = 0; j < 16; ++j) { const unsigned c = xb_ld(&bar[XB_XCNT(j)]); sum += c; cnt += (c > 0u) ? 1u : 0u; mine = (j == x) ? c : mine; }
        if (sum == G) break;
        __builtin_amdgcn_s_sleep(1);
        if ((++sp & 255u) == 0u) { if (xb_ld(&bar[XB_TMO])) break; if (sp > XB_SPIN_CAP) { atomicAdd(&bar[XB_TMO], 1u); break; } }
    }
    nloc = mine > 0u ? mine : 1u; nx = cnt > 0u ? cnt : 1u;
}

__device__ __forceinline__ void xcd_barrier(const XcdBarrier& b, bool t0  ) {
    asm volatile("s_waitcnt vmcnt(0)" ::: "memory");
    __syncthreads();
    if (t0) {
        unsigned* bar = b.bar;
        __builtin_amdgcn_s_waitcnt(0);
        unsigned nloc = b.st[0], nx = b.st[1];
        if (nloc == 0u) { xcd_barrier_complete(bar, b.x, nloc, nx); b.st[0] = nloc; b.st[1] = nx; }
        const unsigned old = xb_add(&bar[XB_XSUB(b.x)], 1u);
        const unsigned gen = old / nloc;
        if (old + 1u == (gen + 1u) * nloc) {
            __builtin_amdgcn_fence(__ATOMIC_RELEASE, "agent");
            asm volatile("s_waitcnt vmcnt(0)" ::: "memory");
            const unsigned og = xb_add(&bar[XB_TOP], 1u);
            const unsigned tg = og / nx;
            if (og + 1u == (tg + 1u) * nx) xb_add(&bar[XB_TOPGEN], 1u);
            else XB_SPIN(xb_ld(&bar[XB_TOPGEN]) == tg, bar);
            __builtin_amdgcn_fence(__ATOMIC_ACQUIRE, "agent");
            xb_add(&bar[XB_XGEN(b.x)], 1u);
            asm volatile("s_waitcnt vmcnt(0)" ::: "memory");
        } else {
            XB_SPIN(xb_ld(&bar[XB_XGEN(b.x)]) == gen, bar);
            __builtin_amdgcn_fence(__ATOMIC_ACQUIRE, "agent");
            asm volatile("s_waitcnt vmcnt(0)" ::: "memory");
        }
    }
    __syncthreads();
}

__device__ __forceinline__ float bf2f(unsigned short b) { return __builtin_bit_cast(float, (unsigned)b << 16); }
__device__ __forceinline__ float bf2f(short b) { return __builtin_bit_cast(float, (unsigned)(unsigned short)b << 16); }
__device__ __forceinline__ float wave_sum(float v) {
#pragma unroll
    for (int o = 1; o < 64; o <<= 1) v += __shfl_xor(v, o);
    return v;
}
__device__ __forceinline__ float wave_max(float v) {
#pragma unroll
    for (int o = 1; o < 64; o <<= 1) v = fmaxf(v, __shfl_xor(v, o));
    return v;
}
__device__ __forceinline__ float fast_exp(float x) { return __builtin_amdgcn_exp2f(x * 1.4426950408889634f); }
__device__ __forceinline__ float sigmoidf_(float x) { return __builtin_amdgcn_rcpf(1.f + fast_exp(-x)); }
__device__ __forceinline__ float gelu_tanh(float x) {
    const float z = 0.7978845608028654f * (x + 0.044715f * x * x * x);
    return x * sigmoidf_(2.f * z);
}
__device__ __forceinline__ float neg_expm1(float x) {
    const float p = x * (1.f + x * (0.5f + x * (0.16666667f + x * (0.041666668f + x * (0.0083333338f + x * 0.0013888889f)))));
    const float e = fast_exp(x) - 1.f;
    return -(fabsf(x) < 0.25f ? p : e);
}
__device__ __forceinline__ v4u pack8(const float (&v)[8]) { v4u o; o.x = pk2(v[0], v[1]); o.y = pk2(v[2], v[3]); o.z = pk2(v[4], v[5]); o.w = pk2(v[6], v[7]); return o; }

#define FIN(F, idx) ({ const __attribute__((address_space(1))) float* p_; asm("s_load_dwordx2 %0, %1, %2 ; tag %3\n\ts_waitcnt lgkmcnt(0)" : "=s"(p_) : "s"((F).kargs), "i"((idx) * 8), "s"((F).ptag)); (const float*)p_; })
struct Frame {
    LAS unsigned char* lds;
    volatile LAS unsigned* MISC;
    gu32* ctl;
    int tid, lane, wave, vcu, G;
    const __attribute__((address_space(4))) void* kargs; int ptag;
    float* out;
    unsigned char* ws;
#define WSP(T, NAME, OFF) __device__ __forceinline__ T* NAME() const { return (T*)(ws + (OFF)); }
    WSP(bf16, WIN_T, WS_WIN) WSP(bf16, WOUT_T, WS_WOUT) WSP(bf16, WUP_T, WS_WUP) WSP(bf16, WDOWN_T, WS_WDOWN) WSP(bf16, WG, WS_WG) WSP(bf16, XN, WS_A) WSP(bf16, QG, WS_QG) WSP(bf16, K, WS_K) WSP(bf16, V, WS_V)
    WSP(bf16, XR, WS_XR) WSP(bf16, ACT, WS_ACT) WSP(bf16, H1A, WS_H1A) WSP(float, EDGE, WS_EDGE) WSP(bf16, XNMETA, WS_XNMETA) WSP(bf16, KM, WS_KM) WSP(bf16, VM, WS_VM)
    WSP(float, ZM, WS_ZM) WSP(float, Q15, WS_Q15) WSP(float, GY15, WS_GY15) WSP(float, LO15, WS_LO15) WSP(float, MIXED15, WS_MIXED15) WSP(float, Y15, WS_Y15) WSP(float, G15, WS_G15) WSP(float, MQP, WS_MQP)
    WSP(float, CIN, WS_CIN) WSP(float2, CAR, WS_CAR) WSP(float, R0, WS_R0) WSP(float, RATIO, WS_RATIO) WSP(float, RL, WS_RL) WSP(float, SSQA, WS_SSQA) WSP(float, SSQL, WS_SSQL)
#undef WSP
};

template <bool UPMAP, int GAIN = 0>
__device__ __forceinline__ void p0_transpose_item(const float* W, int K, int N, bf16* WT, int row_off, LAS float* scr, int item, int lane, const float* g0 = nullptr, const float* g1 = nullptr) {
    const int nblk = N / 32, kb = item / nblk, nb = item % nblk, k0 = 64 * kb, n0 = 32 * nb;
    const int orow0 = UPMAP ? (((n0 % FFN) >> 7) << 8) + 128 * (n0 / FFN) + ((n0 % FFN) & 127) : row_off + n0;
    float wv[32];
#pragma unroll
    for (int i = 0; i < 32; ++i) { const int kk = 2 * i + (lane >> 5); wv[i] = W[(size_t)(k0 + kk) * N + n0 + (lane & 31)]; }
#pragma unroll
    for (int i = 0; i < 32; ++i) { const int kk = 2 * i + (lane >> 5); float gv = 1.f; if (GAIN == 1) gv = g0[k0 + kk]; if (GAIN == 2) gv = (k0 + kk) < 1024 ? g0[k0 + kk] : g1[k0 + kk - 1024];
        scr[kk * 33 + (lane & 31)] = wv[i] * gv; }
    LDS_WAIT(); asm volatile("" ::: "memory");
    const int c = lane & 7;
#pragma unroll
    for (int j = 0; j < 4; ++j) { const int n = (lane >> 3) + 8 * j; const LAS float* s = scr + (8 * c) * 33 + n;
        v4u o; o.x = pk2(s[0 * 33], s[1 * 33]); o.y = pk2(s[2 * 33], s[3 * 33]); o.z = pk2(s[4 * 33], s[5 * 33]); o.w = pk2(s[6 * 33], s[7 * 33]);
        *(GAS v4u*)(WT + (size_t)(orow0 + n) * K + k0 + 8 * c) = o; }
    LDS_WAIT(); asm volatile("" ::: "memory");
}
__device__ __forceinline__ void rms_row_to_bf16(const float* xrow, bf16* orow, int lane, float* rout) {
    const GAS f32x4* xr = (const GAS f32x4*)xrow + lane;
    f32x4 v[8]; float s = 0.f;
#pragma unroll
    for (int j = 0; j < 8; ++j) { v[j] = xr[64 * j]; s += (v[j].x * v[j].x + v[j].y * v[j].y) + (v[j].z * v[j].z + v[j].w * v[j].w); }
    const float r = 1.f / sqrtf(wave_sum(s) * (1.f / DM) + EPS);
    GAS unsigned long long* o8 = (GAS unsigned long long*)orow + lane;
#pragma unroll
    for (int j = 0; j < 8; ++j) o8[64 * j] = (unsigned long long)pk2(v[j].x * r, v[j].y * r) | ((unsigned long long)pk2(v[j].z * r, v[j].w * r) << 32);
    if (rout && lane == 0) *rout = r;
}
__device__ __forceinline__ void p0_prologue(Frame& F) {
    LAS float* scr = (LAS float*)(F.lds + F.wave * 16384);
    const int gw = F.vcu * NWAVES + F.wave, NGW = F.G * NWAVES;
    constexpr int I_IN = (DM / 64) * (INW / 32), I_OUT = (DM / 64) * (DM / 32), I_UP = (DM / 64) * (UPW / 32), I_DN = (FFN / 64) * (DM / 32), I_G = 32 * 8;
    constexpr int NITEMS = I_IN + I_OUT + I_UP + I_DN + I_G;
    for (int it = gw; it < NITEMS; it += NGW) {
        int r = it;
        if (r < I_IN) { p0_transpose_item<false, 1>(FIN(F, 4  ), DM, INW, F.WIN_T(), 0, scr, r, F.lane, FIN(F, 3  )); continue; } r -= I_IN;
        if (r < I_OUT) { p0_transpose_item<false, 2>(FIN(F, 16  ), DM, DM, F.WOUT_T(), 0, scr, r, F.lane, FIN(F, 14  ), FIN(F, 15  )); continue; } r -= I_OUT;
        if (r < I_UP) { p0_transpose_item<true>(FIN(F, 19  ), DM, UPW, F.WUP_T(), 0, scr, r, F.lane); continue; } r -= I_UP;
        if (r < I_DN) { p0_transpose_item<false>(FIN(F, 22  ), FFN, DM, F.WDOWN_T(), 0, scr, r, F.lane); continue; } r -= I_DN;
        {
            const int mi = r >> 3, sub = r & 7, gate = mi >> 4, dir = (mi >> 3) & 1, blk = mi & 7;
            const float* W = (gate ? FIN(F, 11  ) : FIN(F, 9  )) + (size_t)(dir * 8 + blk) * 16384;
            bf16* WT = F.WG() + (size_t)((dir * 2 + gate) * 8 + blk) * 16384;
            p0_transpose_item<false>(W, 128, 128, WT, 0, scr, sub, F.lane);
        }
    }
    {
        const float* xp = FIN(F, 0  ); const float* xs = FIN(F, 1  ); const int lane = F.lane;
        f32x4 v[8], vn[8];
#define P0_LOAD(M, V) do { const GAS f32x4* xr_ = (const GAS f32x4*)((M) < 32768 ? xp + (size_t)(M) * DM : xs + (size_t)((M) - 32768) * DM) + lane; \
            _Pragma("unroll") for (int j_ = 0; j_ < 8; ++j_) V[j_] = xr_[64 * j_]; } while (0)
        int m = gw;
        if (m < NTOK) P0_LOAD(m, v);
        for (; m < NTOK; m += NGW) {
            const int mn = m + NGW < NTOK ? m + NGW : m;
            P0_LOAD(mn, vn);
            float s = 0.f;
#pragma unroll
            for (int j = 0; j < 8; ++j) s += (v[j].x * v[j].x + v[j].y * v[j].y) + (v[j].z * v[j].z + v[j].w * v[j].w);
            const float r = 1.f / sqrtf(wave_sum(s) * (1.f / DM) + EPS);
            GAS unsigned long long* o8 = (GAS unsigned long long*)(F.XN() + (size_t)m * DM) + lane;
#pragma unroll
            for (int j = 0; j < 8; ++j) o8[64 * j] = (unsigned long long)pk2(v[j].x * r, v[j].y * r) | ((unsigned long long)pk2(v[j].z * r, v[j].w * r) << 32);
            if (lane == 0) F.R0()[m] = r;
#pragma unroll
            for (int j = 0; j < 8; ++j) v[j] = vn[j];
        }
#undef P0_LOAD
    }
    for (int m = gw; m < 16; m += NGW) rms_row_to_bf16(FIN(F, 2  ) + (size_t)m * DM, F.XNMETA() + (size_t)m * DM, F.lane, nullptr);
    const int gt = F.vcu * 512 + F.tid, NGT = F.G * 512; const v4u z4 = {0u, 0u, 0u, 0u};
    for (int i = gt; i < 12 * 48 * 128; i += NGT) { const int s = i / (48 * 128), rem = i % (48 * 128); ((GAS v4u*)(F.XR() + (size_t)xr_base(s) * 1024))[rem] = z4; }
    for (int i = gt; i < 64 * 128; i += NGT) ((GAS v4u*)(F.XR() + (size_t)XR_ROWS * 1024))[i] = z4;
    for (int i = gt; i < 2048; i += NGT) { ((GAS v4u*)F.KM())[i] = z4; ((GAS v4u*)F.VM())[i] = z4; }
}

template <int R, class Out, bool GMAP = false>
__device__ __forceinline__ void small_gemm(const LAS float* X, int K, const bf16* Wt, int N, int gw, int NGW, int lane, const Out& out) {
    for (int n = gw; n < N; n += NGW) {
        float acc[R];
#pragma unroll
        for (int r = 0; r < R; ++r) acc[r] = 0.f;
        const GAS bf16x8* wrow = (const GAS bf16x8*)(Wt + (size_t)(GMAP ? ((n >> 7) << 8) + (n & 127) : n) * K);
        for (int k8 = lane; k8 < K / 8; k8 += 64) {
            const bf16x8 w = wrow[k8]; float wf[8];
#pragma unroll
            for (int j = 0; j < 8; ++j) wf[j] = bf2f(w[j]);
#pragma unroll
            for (int r = 0; r < R; ++r) { const LAS f32x4* xp = (const LAS f32x4*)(X + r * K + k8 * 8); const f32x4 a = xp[0], b = xp[1];
                acc[r] += (a.x * wf[0] + a.y * wf[1]) + (a.z * wf[2] + a.w * wf[3]) + (b.x * wf[4] + b.y * wf[5]) + (b.z * wf[6] + b.w * wf[7]); }
        }
        float v = 0.f;
#pragma unroll
        for (int r = 0; r < R; ++r) { const float s = wave_sum(acc[r]); v = (lane == r) ? s : v; }
        out(n, lane, v);
    }
}
struct OutMetaZ { float* ZM; bf16* XR;
    __device__ __forceinline__ void operator()(int n, int lane, float v) const {
        if (lane < 16) { ZM[lane * INW + n] = v;
            if (n >= 1536 && n < 2560) { const unsigned short b = (unsigned short)f2bf(v); const int c = n - 1536;
                for (int s = 0; s < 12; ++s) XR[(size_t)(xr_base(s) + 48 + lane) * 1024 + c] = b; } }
    } };
struct OutRows { float* Y; int ld; int R;
    __device__ __forceinline__ void operator()(int n, int lane, float v) const { if (lane < R) Y[(size_t)lane * ld + n] = v; } };

__device__ __forceinline__ void p1_meta_z(Frame& F) {
    LAS float* X = (LAS float*)F.lds;
    for (int i = F.tid; i < 16 * DM / 8; i += 512) { const bf16x8 v = ((const GAS bf16x8*)F.XNMETA())[i];
        ((LAS f32x4*)X)[2 * i] = (f32x4){bf2f(v[0]), bf2f(v[1]), bf2f(v[2]), bf2f(v[3])}; ((LAS f32x4*)X)[2 * i + 1] = (f32x4){bf2f(v[4]), bf2f(v[5]), bf2f(v[6]), bf2f(v[7])}; }
    __syncthreads();
    const OutMetaZ o{F.ZM(), F.XR()};
    small_gemm<16, OutMetaZ>(X, DM, F.WIN_T(), INW, F.vcu * NWAVES + F.wave, F.G * NWAVES, F.lane, o);
    __syncthreads();
}
typedef float f32x16 __attribute__((ext_vector_type(16)));
constexpr int LRU_XC0 = 0, LRU_XC_BUF = 17408, LRU_XC_STRIDE = 272;
constexpr int LRU_CW = 34816;
constexpr int LRU_HF = 37376, LRU_HB = LRU_HF + 32768;
__device__ __forceinline__ int crow16(int r, int hi) { return (r & 3) + 8 * (r >> 2) + 4 * hi; }

template <int DIR>
__device__ __forceinline__ void scan_tile(const float (&a)[16], const float (&u)[16], float& carry, float& ptot, float (&h)[16], bool up) {
    float HL[16], PL[16], As[4], Hs[4];
#pragma unroll
    for (int j = 0; j < 4; ++j) {
        float hl = 0.f, p = 1.f;
#pragma unroll
        for (int ii = 0; ii < 4; ++ii) { const int idx = 4 * j + (DIR == 0 ? ii : 3 - ii); hl = a[idx] * hl + u[idx]; p *= a[idx]; HL[idx] = hl; PL[idx] = p; }
        As[j] = p; Hs[j] = hl;
    }
    float Alo[4], Ahi[4], Hlo[4], Hhi[4];
#pragma unroll
    for (int j = 0; j < 4; ++j) {
        { const unsigned x = __float_as_uint(As[j]); auto rr = __builtin_amdgcn_permlane32_swap(x, x, false, false); Alo[j] = __uint_as_float(rr[0]); Ahi[j] = __uint_as_float(rr[1]); }
        { const unsigned x = __float_as_uint(Hs[j]); auto rr = __builtin_amdgcn_permlane32_swap(x, x, false, false); Hlo[j] = __uint_as_float(rr[0]); Hhi[j] = __uint_as_float(rr[1]); }
    }
    float cin[4]; float c = carry;
    if (DIR == 0) {
#pragma unroll
        for (int j = 0; j < 4; ++j) { const float c_lo = c; c = Alo[j] * c + Hlo[j]; const float c_hi = c; c = Ahi[j] * c + Hhi[j]; cin[j] = up ? c_hi : c_lo; }
    } else {
#pragma unroll
        for (int j = 3; j >= 0; --j) { const float c_hi = c; c = Ahi[j] * c + Hhi[j]; const float c_lo = c; c = Alo[j] * c + Hlo[j]; cin[j] = up ? c_hi : c_lo; }
    }
    carry = c;
#pragma unroll
    for (int j = 0; j < 4; ++j) ptot *= Alo[j] * Ahi[j];
#pragma unroll
    for (int idx = 0; idx < 16; ++idx) h[idx] = HL[idx] + PL[idx] * cin[idx >> 2];
}

__device__ __forceinline__ void lru_decode(int cg, int& seq, int& c) { if (cg < 520) { seq = cg / 65; c = cg - seq * 65; } else { const int c2 = cg - 520; seq = c2 / 129; c = c2 - seq * 129; seq += 8; } }
template <int PASS>
__device__ __forceinline__ void lru_phase(Frame& F, bf16* gout) {
    LAS unsigned char* L = F.lds;
    const int tid = F.tid, lane = F.lane, wave = F.wave;
    const int n = F.vcu & 7, ngrp = F.G >> 3;
    { const float* cw = FIN(F, 7  ); const float* cb = FIN(F, 8  );
      for (int i = tid; i < 640; i += 512) { const int k = i >> 7, ch = i & 127; ((LAS float*)(L + LRU_CW))[i] = k < 4 ? cw[k * 1024 + n * 128 + ch] : cb[n * 128 + ch]; } }
    const int d = wave >> 2, g4 = wave & 3, r32 = lane & 31, hi = lane >> 5, chl = g4 * 32 + r32, chg = n * 128 + chl;
    bf16x8 br[8], bi[8];
    { const bf16* wr_ = F.WG() + (size_t)((d * 2 + 0) * 8 + n) * 16384 + chl * 128 + hi * 8;
      const bf16* wi_ = F.WG() + (size_t)((d * 2 + 1) * 8 + n) * 16384 + chl * 128 + hi * 8;
#pragma unroll
      for (int ks = 0; ks < 8; ++ks) { br[ks] = *(const GAS bf16x8*)(wr_ + ks * 16); bi[ks] = *(const GAS bf16x8*)(wi_ + ks * 16); } }
    constexpr float L2E = 1.4426950408889634f;
    const float nb_r = -L2E * FIN(F, 10  )[d * 1024 + chg], nb_i = -L2E * FIN(F, 12  )[d * 1024 + chg];
    const float spl = 8.f * L2E * log1pf(expf(-FIN(F, 13  )[d * 1024 + chg]));
    const int tau0 = tid >> 4, co = (tid & 15) * 8;
    bf16x8 xv[2][4];
#define LRU_PREFETCH(cgx) do { int s_, c_; lru_decode((cgx), s_, c_); const int xb_ = xr_base(s_); \
        _Pragma("unroll") for (int it_ = 0; it_ < 2; ++it_) _Pragma("unroll") for (int k_ = 0; k_ < 4; ++k_) { int row_ = xb_ + c_ * 64 + tau0 + 32 * it_ + k_ - 2; row_ = row_ < 0 ? 0 : row_; \
            xv[it_][k_] = *(const GAS bf16x8*)(F.XR() + (size_t)row_ * 1024 + n * 128 + co); } } while (0)
    int cg = F.vcu < 8 * ngrp ? F.vcu >> 3 : NCHUNK;
    if (cg < NCHUNK) LRU_PREFETCH(cg);
    __syncthreads();
    for (int ui = 0; cg < NCHUNK; cg += ngrp, ++ui) {
        int seq, c; lru_decode(cg, seq, c);
        LAS unsigned char* XC = L + LRU_XC0 + (ui & 1) * LRU_XC_BUF;
        float carry = 0.f, ptot = 1.f;
        if (PASS == 2) carry = F.CIN()[((size_t)cg * 2 + d) * 1024 + chg];
#pragma unroll
        for (int it = 0; it < 2; ++it) {
            const int tau = tau0 + 32 * it; float xc[8];
            { const LAS f32x4* cb = (const LAS f32x4*)(L + LRU_CW + (4 * 128 + co) * 4); const f32x4 b0 = cb[0], b1 = cb[1];
              xc[0] = b0.x; xc[1] = b0.y; xc[2] = b0.z; xc[3] = b0.w; xc[4] = b1.x; xc[5] = b1.y; xc[6] = b1.z; xc[7] = b1.w; }
#pragma unroll
            for (int k = 0; k < 4; ++k) { const LAS f32x4* wp = (const LAS f32x4*)(L + LRU_CW + (k * 128 + co) * 4); const f32x4 w0 = wp[0], w1 = wp[1]; const bf16x8 v = xv[it][k];
                xc[0] += w0.x * bf2f(v[0]); xc[1] += w0.y * bf2f(v[1]); xc[2] += w0.z * bf2f(v[2]); xc[3] += w0.w * bf2f(v[3]);
                xc[4] += w1.x * bf2f(v[4]); xc[5] += w1.y * bf2f(v[5]); xc[6] += w1.z * bf2f(v[6]); xc[7] += w1.w * bf2f(v[7]); }
            if (c == 0 && tau < 48) {
#pragma unroll
                for (int j = 0; j < 8; ++j) xc[j] = 0.f;
            }
            *(LAS v4u*)(XC + tau * LRU_XC_STRIDE + co * 2) = pack8(xc);
        }
        bf16x8 gv[2];
        const int row0 = seq_first_row(seq) + 64 * (c - 1);
        if (PASS == 2) { if (c > 0) {
#pragma unroll
            for (int it = 0; it < 2; ++it) gv[it] = *(const GAS bf16x8*)(F.QG() + (size_t)(row0 + tau0 + 32 * it) * DM + 1024 + n * 128 + co); } }
        __syncthreads();
        if (cg + ngrp < NCHUNK) LRU_PREFETCH(cg + ngrp);
        f32x16 arT[2], aiT[2];
#pragma unroll
        for (int tt = 0; tt < 2; ++tt) {
            const int tile = d ? 1 - tt : tt;
            f32x16 ar = {}, ai = {};
#pragma unroll
            for (int ks = 0; ks < 8; ++ks) {
                const bf16x8 a = *(const LAS bf16x8*)(XC + (tile * 32 + r32) * LRU_XC_STRIDE + (ks * 16 + hi * 8) * 2);
                ar = __builtin_amdgcn_mfma_f32_32x32x16_bf16(a, br[ks], ar, 0, 0, 0);
                ai = __builtin_amdgcn_mfma_f32_32x32x16_bf16(a, bi[ks], ai, 0, 0, 0);
            }
            arT[tt] = ar; aiT[tt] = ai;
        }
#pragma unroll
        for (int tt = 0; tt < 2; ++tt) {
            const int tile = d ? 1 - tt : tt;
            const f32x16 ar = arT[tt], ai = aiT[tt];
            float av[16], uv[16], hv[16];
            typedef float f32x2 __attribute__((ext_vector_type(2)));
#pragma unroll
            for (int r = 0; r < 16; r += 2) {
                const int tau0_ = tile * 32 + crow16(r, hi);
                const f32x2 xc2 = {bf2f(*(const LAS unsigned short*)(XC + tau0_ * LRU_XC_STRIDE + chl * 2)), bf2f(*(const LAS unsigned short*)(XC + (tau0_ + 1) * LRU_XC_STRIDE + chl * 2))};
                const f32x2 tr = (f32x2){ar[r], ar[r + 1]} * (f32x2){-L2E, -L2E} + (f32x2){nb_r, nb_r};
                const f32x2 ti = (f32x2){ai[r], ai[r + 1]} * (f32x2){-L2E, -L2E} + (f32x2){nb_i, nb_i};
                const f32x2 dr = (f32x2){__builtin_amdgcn_exp2f(tr.x), __builtin_amdgcn_exp2f(tr.y)} + (f32x2){1.f, 1.f};
                const f32x2 di = (f32x2){__builtin_amdgcn_exp2f(ti.x), __builtin_amdgcn_exp2f(ti.y)} + (f32x2){1.f, 1.f};
                const f32x2 rg = {__builtin_amdgcn_rcpf(dr.x), __builtin_amdgcn_rcpf(dr.y)}, ig = {__builtin_amdgcn_rcpf(di.x), __builtin_amdgcn_rcpf(di.y)};
                const f32x2 la = rg * (f32x2){-spl, -spl};
                const f32x2 a = {__builtin_amdgcn_exp2f(la.x), __builtin_amdgcn_exp2f(la.y)};
                const f32x2 t = (f32x2){1.f, 1.f} - a * a;
                const f32x2 m = {__builtin_amdgcn_sqrtf(t.x), __builtin_amdgcn_sqrtf(t.y)};
                const f32x2 u = m * (ig * xc2);
                av[r] = a.x; av[r + 1] = a.y; uv[r] = u.x; uv[r + 1] = u.y;
            }
            if (d == 0) scan_tile<0>(av, uv, carry, ptot, hv, hi != 0); else scan_tile<1>(av, uv, carry, ptot, hv, hi != 0);
            if (PASS == 2) {
#pragma unroll
                for (int r = 0; r < 16; ++r) { const int tau = tile * 32 + crow16(r, hi); *(LAS float*)(L + (d ? LRU_HB : LRU_HF) + (tau * 128 + chl) * 4) = hv[r]; }
            }
        }
        if (PASS == 1) { if (hi == 0) F.CAR()[((size_t)cg * 2 + d) * 1024 + chg] = make_float2(ptot, carry); }
        if (PASS == 2) {
            __syncthreads();
            if (c > 0) {
#pragma unroll
                for (int it = 0; it < 2; ++it) {
                    const int tau = tau0 + 32 * it; const bf16x8 g8 = gv[it];
                    const LAS f32x4* hf = (const LAS f32x4*)(L + LRU_HF + (tau * 128 + co) * 4); const LAS f32x4* hb = (const LAS f32x4*)(L + LRU_HB + (tau * 128 + co) * 4);
                    const f32x4 f0 = hf[0], f1 = hf[1], b0 = hb[0], b1 = hb[1];
                    float o[8];
                    o[0] = (f0.x + b0.x) * gelu_tanh(bf2f(g8[0])); o[1] = (f0.y + b0.y) * gelu_tanh(bf2f(g8[1])); o[2] = (f0.z + b0.z) * gelu_tanh(bf2f(g8[2])); o[3] = (f0.w + b0.w) * gelu_tanh(bf2f(g8[3]));
                    o[4] = (f1.x + b1.x) * gelu_tanh(bf2f(g8[4])); o[5] = (f1.y + b1.y) * gelu_tanh(bf2f(g8[5])); o[6] = (f1.z + b1.z) * gelu_tanh(bf2f(g8[6])); o[7] = (f1.w + b1.w) * gelu_tanh(bf2f(g8[7]));
                    *(GAS v4u*)(gout + (size_t)(row0 + tau) * DM + 1024 + n * 128 + co) = pack8(o);
                    float sq = (o[0] * o[0] + o[1] * o[1]) + (o[2] * o[2] + o[3] * o[3]) + (o[4] * o[4] + o[5] * o[5]) + (o[6] * o[6] + o[7] * o[7]);
                    sq += __shfl_xor(sq, 1); sq += __shfl_xor(sq, 2); sq += __shfl_xor(sq, 4); sq += __shfl_xor(sq, 8);
                    if ((tid & 15) == 0) F.SSQL()[(size_t)(row0 + tau) * 8 + n] = sq;
                }
            } else if (tid < 128) {
                const float hf = *(const LAS float*)(L + LRU_HF + (63 * 128 + tid) * 4), hb = *(const LAS float*)(L + LRU_HB + (63 * 128 + tid) * 4);
                F.LO15()[seq * 1024 + n * 128 + tid] = (hf + hb) * gelu_tanh(F.GY15()[n * 128 + tid]);
            }
        }
    }
    __syncthreads();
#undef LRU_PREFETCH
}
__device__ __forceinline__ void lru_propagate(Frame& F) {
    const int gid = F.vcu * 512 + F.tid;
    if (gid < 12 * 2048) {
        const int s = gid >> 11, d = (gid >> 10) & 1, ch = gid & 1023; const int nch = s < 8 ? 65 : 129, cb = chunk_base(s);
        const float2* car = F.CAR() + (size_t)d * 1024 + ch; float* cinp = F.CIN() + (size_t)d * 1024 + ch;
        float cin = 0.f;
        for (int b0 = 0; b0 < nch; b0 += 16) {
            float2 ph[16];
#pragma unroll
            for (int i = 0; i < 16; ++i) { const int cc = b0 + i; const int c = d ? nch - 1 - cc : cc; if (cc < nch) ph[i] = car[(size_t)(cb + c) * 2048]; }
#pragma unroll
            for (int i = 0; i < 16; ++i) { const int cc = b0 + i; const int c = d ? nch - 1 - cc : cc; if (cc < nch) { cinp[(size_t)(cb + c) * 2048] = cin; cin = ph[i].x * cin + ph[i].y; } }
        }
    }
}

__device__ __forceinline__ void k_rope_pass(Frame& F, bf16* Kout) {
    const int gw = F.vcu * NWAVES + F.wave, NGW = F.G * NWAVES, sub = F.lane >> 4, l16 = F.lane & 15;
    const int c0 = 8 * l16, p = l16 >> 3, half = (l16 >> 2) & 1, i0 = 8 * (l16 & 3);
    float inv[8], gk[8];
#pragma unroll
    for (int j = 0; j < 8; ++j) { inv[j] = __builtin_amdgcn_exp2f(-(float)(i0 + j) * (13.287712379549449f / 32.f)) * 0.15915494309189535f; gk[j] = FIN(F, 6  )[c0 + j]; }
    for (int it = gw; it < NTOK * 2 / 4; it += NGW) {
        const int item = it * 4 + sub, row = item >> 1, hk = item & 1;
        const int s = row_seq(row), t = row - seq_first_row(s); const float pos = (float)(p ? (t & 63) : (t >> 6));
        bf16* kp = F.K() + (size_t)row * 256 + hk * 128 + c0;
        const bf16x8 v = *(const GAS bf16x8*)kp; float x[8]; float ss = 0.f;
#pragma unroll
        for (int j = 0; j < 8; ++j) { x[j] = bf2f(v[j]); ss += x[j] * x[j]; }
        ss += __shfl_xor(ss, 1); ss += __shfl_xor(ss, 2); ss += __shfl_xor(ss, 4); ss += __shfl_xor(ss, 8);
        const float rs = 1.f / sqrtf(ss * (1.f / 128.f) + EPS); float o[8];
#pragma unroll
        for (int j = 0; j < 8; ++j) { x[j] *= rs * gk[j]; const float pr = __shfl_xor(x[j], 4);
            float rev = pos * inv[j]; rev -= floorf(rev); const float sn = __builtin_amdgcn_sinf(rev), cs = __builtin_amdgcn_cosf(rev);
            o[j] = half ? x[j] * cs + pr * sn : x[j] * cs - pr * sn; }
        *(GAS v4u*)(Kout + (size_t)row * 256 + hk * 128 + c0) = pack8(o);
    }
}
__device__ __forceinline__ void p3_meta_job(Frame& F) {
    for (int pr = F.wave; pr < 32; pr += 8) { const int r = pr >> 1, hk = pr & 1; const float* z = F.ZM() + r * INW + 1024 + hk * 128;
        const float a = z[F.lane], b = z[F.lane + 64]; const float rs = 1.f / sqrtf(wave_sum(a * a + b * b) * (1.f / 128.f) + EPS);
        F.KM()[r * 256 + hk * 128 + F.lane] = (bf16)f2bf(a * rs * FIN(F, 6  )[F.lane]); F.KM()[r * 256 + hk * 128 + F.lane + 64] = (bf16)f2bf(b * rs * FIN(F, 6  )[F.lane + 64]); }
    for (int i = F.tid; i < 16 * 256; i += 512) F.VM()[i] = (bf16)f2bf(F.ZM()[(i >> 8) * INW + 1280 + (i & 255)]);
    { const int h = F.wave; const float* z = F.ZM() + 15 * INW + h * 128; const float a = z[F.lane], b = z[F.lane + 64];
      const float rs = 1.f / sqrtf(wave_sum(a * a + b * b) * (1.f / 128.f) + EPS);
      F.Q15()[h * 128 + F.lane] = a * rs * FIN(F, 5  )[F.lane]; F.Q15()[h * 128 + F.lane + 64] = b * rs * FIN(F, 5  )[F.lane + 64]; }
    for (int i = F.tid; i < 1024; i += 512) F.GY15()[i] = F.ZM()[15 * INW + 2560 + i];
}

__device__ __forceinline__ void metaq_item(Frame& F, int it) {
    int s, kvh, j; if (it < 256) { s = it >> 5; kvh = (it >> 4) & 1; j = it & 15; } else { const int t2 = it - 256; s = 8 + (t2 >> 6); kvh = (t2 >> 5) & 1; j = t2 & 31; }
    LAS float* q4 = (LAS float*)F.lds;
    LAS float* sc = q4 + 512;
    LAS float* red = sc + 4 * 288;
    const int tid = F.tid, nk = 256 + (j == 0 ? 16 : 0), row0 = seq_first_row(s) + 256 * j;
    q4[tid] = F.Q15()[kvh * 512 + tid];
    __syncthreads();
    if (tid < nk) {
        const bf16* kp = tid < 256 ? F.K() + (size_t)(row0 + tid) * 256 + kvh * 128 : F.KM() + (tid - 256) * 256 + kvh * 128;
        float d0 = 0.f, d1 = 0.f, d2 = 0.f, d3 = 0.f;
#pragma unroll 4
        for (int cc = 0; cc < 16; ++cc) { const bf16x8 kv = ((const GAS bf16x8*)kp)[cc];
#pragma unroll
            for (int e = 0; e < 8; ++e) { const float kf = bf2f(kv[e]); d0 += kf * q4[cc * 8 + e]; d1 += kf * q4[128 + cc * 8 + e]; d2 += kf * q4[256 + cc * 8 + e]; d3 += kf * q4[384 + cc * 8 + e]; } }
        const float SC = 0.088388347648318440f;
        sc[tid] = d0 * SC; sc[288 + tid] = d1 * SC; sc[576 + tid] = d2 * SC; sc[864 + tid] = d3 * SC;
    }
    __syncthreads();
    if (F.wave < 4) { LAS float* sh = sc + F.wave * 288; float m = -INFINITY;
        for (int k = F.lane; k < nk; k += 64) m = fmaxf(m, sh[k]);
        m = wave_max(m); float l = 0.f;
        for (int k = F.lane; k < nk; k += 64) { const float p = __expf(sh[k] - m); sh[k] = p; l += p; }
        l = wave_sum(l);
        if (F.lane == 0) { red[F.wave * 2] = m; red[F.wave * 2 + 1] = l; } }
    __syncthreads();
    {
        const int kg = tid >> 4, oc = tid & 15; float o[4][8];
#pragma unroll
        for (int h = 0; h < 4; ++h)
#pragma unroll
            for (int e = 0; e < 8; ++e) o[h][e] = 0.f;
        const bf16* vp = F.V() + (size_t)(row0 + kg * 8) * 256 + kvh * 128 + oc * 8;
        bf16x8 vv[8];
#pragma unroll
        for (int k = 0; k < 8; ++k) vv[k] = *(const GAS bf16x8*)(vp + (size_t)k * 256);
#pragma unroll
        for (int k = 0; k < 8; ++k) { const float p0 = sc[kg * 8 + k], p1 = sc[288 + kg * 8 + k], p2 = sc[576 + kg * 8 + k], p3 = sc[864 + kg * 8 + k];
#pragma unroll
            for (int e = 0; e < 8; ++e) { const float vf = bf2f(vv[k][e]); o[0][e] += p0 * vf; o[1][e] += p1 * vf; o[2][e] += p2 * vf; o[3][e] += p3 * vf; } }
        if (j == 0 && kg < 16) { const int k = kg; const bf16x8 v1 = *(const GAS bf16x8*)(F.VM() + k * 256 + kvh * 128 + oc * 8);
            const float p0 = sc[256 + k], p1 = sc[288 + 256 + k], p2 = sc[576 + 256 + k], p3 = sc[864 + 256 + k];
#pragma unroll
            for (int e = 0; e < 8; ++e) { const float vf = bf2f(v1[e]); o[0][e] += p0 * vf; o[1][e] += p1 * vf; o[2][e] += p2 * vf; o[3][e] += p3 * vf; } }
        LAS float* part = sc + 4 * 288 + 16;
#pragma unroll
        for (int h = 0; h < 4; ++h) { LAS f32x4* pp = (LAS f32x4*)(part + (kg * 4 + h) * 128 + oc * 8); pp[0] = (f32x4){o[h][0], o[h][1], o[h][2], o[h][3]}; pp[1] = (f32x4){o[h][4], o[h][5], o[h][6], o[h][7]}; }
        __syncthreads();
        const int h = tid >> 7, d = tid & 127; float os = 0.f;
#pragma unroll 8
        for (int g = 0; g < 32; ++g) os += part[(g * 4 + h) * 128 + d];
        float* dst = F.MQP() + ((size_t)it * 4 + h) * 132; dst[2 + d] = os; if (d == 0) { dst[0] = red[h * 2]; dst[1] = red[h * 2 + 1]; } }
    __syncthreads();
}
__device__ __forceinline__ void attn_phase(Frame& F, char* lds_generic, bf16* obase) {
    const int nr = F.G == 256 ? 8 : (2048 + F.G - 1) / F.G;
    for (int r = 0; r < nr; ++r) {
        int s, kvh, hq, qb, S;
        if (F.G == 256) {
            const int x = F.vcu >> 5, i = F.vcu & 31;
            if (r < 4) { const int pair = 2 * x + (r >> 1); s = pair >> 1; kvh = pair & 1; const int u = (r & 1) * 32 + i; hq = u >> 4; qb = u & 15; S = 4096; }
            else { const int pair = x; s = 8 + (pair >> 1); kvh = pair & 1; const int u = (r - 4) * 32 + i; hq = u >> 5; qb = u & 31; S = 8192; }
        } else {
            const int U = F.vcu + F.G * r; if (U >= 2048) break;
            if (U < 1024) { const int pair = U >> 6, u = U & 63; s = pair >> 1; kvh = pair & 1; hq = u >> 4; qb = u & 15; S = 4096; }
            else { const int pair = (U - 1024) >> 7, u = (U - 1024) & 127; s = 8 + (pair >> 1); kvh = pair & 1; hq = u >> 5; qb = u & 31; S = 8192; }
        }
        const int row0 = seq_first_row(s), h = kvh * 4 + hq;
        bf16* qp = F.QG() + (size_t)(row0 + qb * 256) * DM + h * 128;
        attn::attn_unit(qp, F.K() + (size_t)row0 * 256 + kvh * 128, F.V() + (size_t)row0 * 256 + kvh * 128, F.KM() + kvh * 128, F.VM() + kvh * 128, obase + (size_t)(row0 + qb * 256) * DM + h * 128, S / 64 + 1, lds_generic, FIN(F, 5  ), qb * 256, F.SSQA() + (size_t)(row0 + qb * 256) * 8 + h, F.wave);
    }
}

__device__ __forceinline__ void p5_ratio(Frame& F) {
    for (int row = F.vcu * 512 + F.tid; row < NTOK; row += F.G * 512) {
        const GAS f32x4* pa = (const GAS f32x4*)(F.SSQA() + (size_t)row * 8); const GAS f32x4* pl = (const GAS f32x4*)(F.SSQL() + (size_t)row * 8);
        const f32x4 a0 = pa[0], a1 = pa[1], l0 = pl[0], l1 = pl[1];
        const float sa = ((a0.x + a0.y) + (a0.z + a0.w)) + ((a1.x + a1.y) + (a1.z + a1.w)), sl = ((l0.x + l0.y) + (l0.z + l0.w)) + ((l1.x + l1.y) + (l1.z + l1.w));
        const float qa = sqrtf(sa * (1.f / 1024.f) + EPS), ql = sqrtf(sl * (1.f / 1024.f) + EPS);
        F.RATIO()[row] = ql / qa; F.RL()[row] = 1.f / ql;
    }
}
__device__ __forceinline__ void p5_meta_job(Frame& F, int s) {
    LAS float* buf = (LAS float*)F.lds; LAS float* red = buf + 2048; const int tid = F.tid;
    {
        const int nj = s < 8 ? 16 : 32;
        for (int e = tid; e < 1024; e += 512) { const int h = e >> 7, d = e & 127, kvh = h >> 2, hq = h & 3;
            const int it0 = s < 8 ? s * 32 + kvh * 16 : 256 + (s - 8) * 64 + kvh * 32;
            float M = -INFINITY; for (int j = 0; j < nj; ++j) M = fmaxf(M, F.MQP()[((size_t)(it0 + j) * 4 + hq) * 132]);
            float Ls = 0.f, O = 0.f;
            for (int j = 0; j < nj; ++j) { const float* p = F.MQP() + ((size_t)(it0 + j) * 4 + hq) * 132; const float w = __expf(p[0] - M); Ls += p[1] * w; O += p[2 + d] * w; }
            buf[e] = O / Ls; }
        for (int e = tid; e < 1024; e += 512) buf[1024 + e] = F.LO15()[s * 1024 + e];
        __syncthreads();
        { float ss = 0.f; for (int k = F.lane; k < 256; k += 64) { const float v = buf[F.wave * 256 + k]; ss += v * v; } ss = wave_sum(ss); if (F.lane == 0) red[F.wave] = ss; }
        __syncthreads();
        const float ra = 1.f / sqrtf((red[0] + red[1] + red[2] + red[3]) * (1.f / 1024.f) + EPS), rl = 1.f / sqrtf((red[4] + red[5] + red[6] + red[7]) * (1.f / 1024.f) + EPS);
        for (int e = tid; e < 2048; e += 512) F.MIXED15()[s * 2048 + e] = e < 1024 ? buf[e] * ra : buf[e] * rl;
        __syncthreads();
    }
}
__device__ __forceinline__ void p6_meta_y(Frame& F) {
    LAS float* X = (LAS float*)F.lds;
    for (int i = F.tid; i < 12 * DM / 4; i += 512) ((LAS f32x4*)X)[i] = ((const GAS f32x4*)F.MIXED15())[i];
    __syncthreads();
    const OutRows o{F.Y15(), DM, 12};
    small_gemm<12, OutRows>(X, DM, F.WOUT_T(), DM, F.vcu * NWAVES + F.wave, F.G * NWAVES, F.lane, o);
    __syncthreads();
}

__device__ __forceinline__ void p7_rows(Frame& F, int q, int gw, int NGW) {
    const int lane = F.lane;
    f32x4 gm[8], gf[8];
    { const float* a = FIN(F, 17  ); const float* b = FIN(F, 18  );
#pragma unroll
      for (int i = 0; i < 4; ++i) { const int e0 = (lane + 64 * i) * 8; gm[2 * i] = *(const GAS f32x4*)(a + e0); gm[2 * i + 1] = *(const GAS f32x4*)(a + e0 + 4); gf[2 * i] = *(const GAS f32x4*)(b + e0); gf[2 * i + 1] = *(const GAS f32x4*)(b + e0 + 4); } }
    bf16* h1base = q == 0 ? F.H1A() : F.XN();
    bf16x8 yv[4], yn[4]; v4u xv[4], xw[4]; float r0c = 1.f, r0n = 1.f;
    const int rend = (q + 1) * HROWS;
    int row = q * HROWS + gw;
#define P7_LOAD(R, Y, X, RV) do { const GAS bf16x8* y_ = (const GAS bf16x8*)((const bf16*)(F.out + (size_t)(R) * DM)); const GAS v4u* x_ = (const GAS v4u*)(F.XN() + (size_t)(R) * DM); \
        _Pragma("unroll") for (int i_ = 0; i_ < 4; ++i_) { Y[i_] = y_[lane + 64 * i_]; X[i_] = x_[lane + 64 * i_]; } RV = F.R0()[(R)]; } while (0)
    if (row < rend) P7_LOAD(row, yv, xv, r0c);
    for (; row < rend; row += NGW) {
        const int nrow = row + NGW < rend ? row + NGW : row;
        P7_LOAD(nrow, yn, xw, r0n);
        GAS v4u* xn = (GAS v4u*)(F.XN() + (size_t)row * DM);
        GAS v4u* h1row = (GAS v4u*)(h1base + (size_t)(row - q * HROWS) * DM);
        const float ir0 = 1.f / r0c;
        float hv[32]; float ss = 0.f;
#pragma unroll
        for (int i = 0; i < 4; ++i)
#pragma unroll
            for (int j = 0; j < 8; ++j) { hv[8 * i + j] = bf2f(yv[i][j]); ss += hv[8 * i + j] * hv[8 * i + j]; }
        const float r1 = 1.f / sqrtf(wave_sum(ss) * (1.f / DM) + EPS); float s2 = 0.f;
#pragma unroll
        for (int i = 0; i < 4; ++i) {
            const v4u xq = xv[i]; const f32x4 g0 = gm[2 * i], g1 = gm[2 * i + 1];
            const float xf[8] = {__builtin_bit_cast(float, xq.x << 16), __builtin_bit_cast(float, xq.x & 0xffff0000u), __builtin_bit_cast(float, xq.y << 16), __builtin_bit_cast(float, xq.y & 0xffff0000u),
                                 __builtin_bit_cast(float, xq.z << 16), __builtin_bit_cast(float, xq.z & 0xffff0000u), __builtin_bit_cast(float, xq.w << 16), __builtin_bit_cast(float, xq.w & 0xffff0000u)};
            const float gg[8] = {g0.x, g0.y, g0.z, g0.w, g1.x, g1.y, g1.z, g1.w};
            float hb[8];
#pragma unroll
            for (int j = 0; j < 8; ++j) { hb[j] = xf[j] * ir0 + hv[8 * i + j] * r1 * gg[j]; hv[8 * i + j] = hb[j]; s2 += hb[j] * hb[j]; }
            h1row[lane + 64 * i] = pack8(hb);
        }
        const float r2 = 1.f / sqrtf(wave_sum(s2) * (1.f / DM) + EPS);
#pragma unroll
        for (int i = 0; i < 4; ++i) { const f32x4 g0 = gf[2 * i], g1 = gf[2 * i + 1];
            float t[8]; t[0] = hv[8 * i + 0] * r2 * g0.x; t[1] = hv[8 * i + 1] * r2 * g0.y; t[2] = hv[8 * i + 2] * r2 * g0.z; t[3] = hv[8 * i + 3] * r2 * g0.w;
            t[4] = hv[8 * i + 4] * r2 * g1.x; t[5] = hv[8 * i + 5] * r2 * g1.y; t[6] = hv[8 * i + 6] * r2 * g1.z; t[7] = hv[8 * i + 7] * r2 * g1.w;
            xn[lane + 64 * i] = pack8(t); }
#pragma unroll
        for (int i = 0; i < 4; ++i) { yv[i] = yn[i]; xv[i] = xw[i]; }
        r0c = r0n;
    }
#undef P7_LOAD
}
__device__ __forceinline__ void p7_meta_g(Frame& F) {
    LAS float* X = (LAS float*)F.lds;
    for (int r = F.wave; r < 12; r += 8) {
        const float* y = F.Y15() + r * DM; const float* xm = FIN(F, 2  ) + 15 * DM;
        float hv[32]; float ss = 0.f;
#pragma unroll
        for (int i = 0; i < 32; ++i) { hv[i] = y[F.lane + 64 * i]; ss += hv[i] * hv[i]; }
        const float r1 = 1.f / sqrtf(wave_sum(ss) * (1.f / DM) + EPS); float s2 = 0.f;
#pragma unroll
        for (int i = 0; i < 32; ++i) { const int e = F.lane + 64 * i; hv[i] = xm[e] + hv[i] * r1 * FIN(F, 17  )[e]; s2 += hv[i] * hv[i]; }
        const float r2 = 1.f / sqrtf(wave_sum(s2) * (1.f / DM) + EPS);
#pragma unroll
        for (int i = 0; i < 32; ++i) { const int e = F.lane + 64 * i; X[r * DM + e] = hv[i] * r2 * FIN(F, 18  )[e]; }
    }
    __syncthreads();
    const OutRows o{F.G15(), FFN, 12};
    small_gemm<12, OutRows, true>(X, DM, F.WUP_T(), FFN, F.vcu * NWAVES + F.wave, F.G * NWAVES, F.lane, o);
    __syncthreads();
}

__device__ __forceinline__ void p9_fix(Frame& F, int h) {
    constexpr int NOCT = FFN / 8; const int total = 512 * 2 * NOCT;
    const float* cw = FIN(F, 20  ); const float* cb = FIN(F, 21  );
    for (int it = F.vcu * 512 + F.tid; it < total; it += F.G * 512) {
        const int bw = it / NOCT, co = (it - bw * NOCT) * 8, which = bw & 1, B = bw >> 1;
        const int lrow = B * 64 + (which ? 63 : 0), row = h * HROWS + lrow, s = row_seq(row), t = row - seq_first_row(s), S = seq_len(s);
        const float* e = F.EDGE() + (size_t)((B * 2 + which) * 3) * FFN + co;
        float inner[8], self[8], uu[8], outer[8], w0[8], w1[8], w2[8], bb[8];
#define LD8F(dst, p) do { const GAS f32x4* p_ = (const GAS f32x4*)(p); const f32x4 a_ = p_[0], b_ = p_[1]; dst[0] = a_.x; dst[1] = a_.y; dst[2] = a_.z; dst[3] = a_.w; dst[4] = b_.x; dst[5] = b_.y; dst[6] = b_.z; dst[7] = b_.w; } while (0)
        LD8F(inner, e); LD8F(self, e + FFN); LD8F(uu, e + 2 * FFN);
        LD8F(w0, cw + co); LD8F(w1, cw + FFN + co); LD8F(w2, cw + 2 * FFN + co); LD8F(bb, cb + co);
        if (which == 0) { if (t == 0) LD8F(outer, F.G15() + (size_t)s * FFN + co); else LD8F(outer, F.EDGE() + (size_t)(((B - 1) * 2 + 1) * 3 + 1) * FFN + co); }
        else { if (t == S - 1) {
#pragma unroll
                for (int j = 0; j < 8; ++j) outer[j] = 0.f; }
            else LD8F(outer, F.EDGE() + (size_t)(((B + 1) * 2 + 0) * 3 + 1) * FFN + co); }
#undef LD8F
        float o[8];
#pragma unroll
        for (int j = 0; j < 8; ++j) { const float x = which == 0 ? bb[j] + w0[j] * outer[j] + w1[j] * self[j] + w2[j] * inner[j] : bb[j] + w0[j] * inner[j] + w1[j] * self[j] + w2[j] * outer[j];
            o[j] = x * sigmoidf_(x) * uu[j]; }
        *(GAS v4u*)(F.ACT() + (size_t)lrow * FFN + co) = pack8(o);
    }
}
__device__ __forceinline__ void p11_rows(Frame& F, int gw, int NGW, float* obase) {
    const int lane = F.lane;
    f32x4 gg[8];
    { const float* a = FIN(F, 23  );
#pragma unroll
      for (int i = 0; i < 4; ++i) { const int e0 = (lane + 64 * i) * 8; gg[2 * i] = *(const GAS f32x4*)(a + e0); gg[2 * i + 1] = *(const GAS f32x4*)(a + e0 + 4); } }
    bf16x8 hv[4], fq[4], hn[4], fn[4];
#define P11_LOAD(R, H, Q) do { const GAS bf16x8* f_ = (const GAS bf16x8*)((const bf16*)(F.out + (size_t)(R) * DM)); \
        const GAS bf16x8* h_ = (const GAS bf16x8*)((R) < HROWS ? F.H1A() + (size_t)(R) * DM : F.XN() + (size_t)((R) - HROWS) * DM); \
        _Pragma("unroll") for (int i_ = 0; i_ < 4; ++i_) { H[i_] = h_[lane + 64 * i_]; Q[i_] = f_[lane + 64 * i_]; } } while (0)
    int row = gw;
    if (row < NTOK) P11_LOAD(row, hv, fq);
    for (; row < NTOK; row += NGW) {
        const int nrow = row + NGW < NTOK ? row + NGW : row;
        P11_LOAD(nrow, hn, fn);
        float fv[32]; float ss = 0.f;
#pragma unroll
        for (int i = 0; i < 4; ++i)
#pragma unroll
            for (int j = 0; j < 8; ++j) { fv[8 * i + j] = bf2f(fq[i][j]); ss += fv[8 * i + j] * fv[8 * i + j]; }
        const float r1 = 1.f / sqrtf(wave_sum(ss) * (1.f / DM) + EPS);
#pragma unroll
        for (int i = 0; i < 4; ++i) { const int e0 = (lane + 64 * i) * 8; const f32x4 g0 = gg[2 * i], g1 = gg[2 * i + 1];
            f32x4 h0, h1;
            h0.x = bf2f(hv[i][0]) + fv[8 * i + 0] * r1 * g0.x; h0.y = bf2f(hv[i][1]) + fv[8 * i + 1] * r1 * g0.y; h0.z = bf2f(hv[i][2]) + fv[8 * i + 2] * r1 * g0.z; h0.w = bf2f(hv[i][3]) + fv[8 * i + 3] * r1 * g0.w;
            h1.x = bf2f(hv[i][4]) + fv[8 * i + 4] * r1 * g1.x; h1.y = bf2f(hv[i][5]) + fv[8 * i + 5] * r1 * g1.y; h1.z = bf2f(hv[i][6]) + fv[8 * i + 6] * r1 * g1.z; h1.w = bf2f(hv[i][7]) + fv[8 * i + 7] * r1 * g1.w;
            GAS f32x4* wp = (GAS f32x4*)(obase + (size_t)row * DM + e0); wp[0] = h0; wp[1] = h1; }
#pragma unroll
        for (int i = 0; i < 4; ++i) { hv[i] = hn[i]; fq[i] = fn[i]; }
    }
#undef P11_LOAD
}
struct Args { const float* in[24]; float* out; unsigned char* ws; int ph_lo, ph_hi, q_lo, q_hi, use_bar, dummy; };
constexpr int N_PHASES = 12;
__global__ void __launch_bounds__(NWAVES * 64, 2) mk_fwd(Args args) {
    extern __shared__ __attribute__((aligned(16))) unsigned char lds[];
    Frame F;
    F.lds = (LAS unsigned char*)lds;
    F.MISC = (volatile LAS unsigned*)(F.lds + MISC_OFF);
    F.wave = __builtin_amdgcn_readfirstlane((int)threadIdx.x >> 6);
    F.tid = F.wave * 64 + lane_id_now(); F.lane = F.tid & 63;
    F.G = gridDim.x; { const int bx = blockIdx.x; F.vcu = (F.G % 8 == 0) ? (bx % 8) * (F.G / 8) + bx / 8 : bx; }
    unsigned char* ws = args.ws;
    F.ctl = (gu32*)(ws + WS_CTL);
    F.kargs = (const __attribute__((address_space(4))) void*)__builtin_amdgcn_kernarg_segment_ptr(); F.ptag = 0; F.out = args.out;
    F.ws = ws;
    for (int u = F.tid; u < (LDS_BYTES - LDSCTL_OFF) / 4; u += NWAVES * 64) ((LAS unsigned*)(F.lds + LDSCTL_OFF))[u] = 0u;
    __syncthreads();
    XcdBarrier bar; bar.bar = (unsigned*)(F.ctl + CW_BAR); bar.x = 0; bar.st = nullptr;
    if (args.use_bar) bar = xcd_barrier_post((unsigned*)(F.ctl + CW_BAR), F.MISC + 8, F.tid == 0);
    const int lo = args.ph_lo, hi = args.ph_hi;
    const int dmy_ = MK_MULTI ? args.dummy : 0;
#define IN(k) (((MK_PHASE_MASK >> (k)) & 1) && lo <= (k) && (k) < hi)
#define PH_BEGIN(k) do { F.ptag = (k); int t_ = F.wave * 64 + lane_id_now(); asm volatile("" : "+v"(t_)); F.tid = t_; F.lane = t_ & 63; } while (0)
#define PH_BAR() do { if (args.use_bar) xcd_barrier(bar, F.wave == 0 && lane_id_now() == 0); } while (0)
    const int gw = F.vcu * NWAVES + F.wave, NGW = F.G * NWAVES;

    if (IN(0)) { PH_BEGIN(0); { p0_prologue(F); PH_BAR(); } }
    if (IN(1)) { PH_BEGIN(1); {
        p1_meta_z(F);
        pg8::Gemm g{F.XN(), F.WIN_T(), NTOK, INW, DM}; pg8::ProbeOrder S; S.init(NTOK, INW, F.G, (int)blockIdx.x); S.pmask = dmy_ == 5 ? 7 : -1;
        pg8::EpiRoute E{nullptr, 0, 1, F.QG(), F.K(), F.V(), F.XR()};
        if (dmy_ != 7) pg8::gemm_phase<pg8::EpiRoute, pg8::ProbeOrder, true, true>(F.lds, g, S, E, F.wave);
        PH_BAR();
    } }
    if (IN(2)) { PH_BEGIN(2); { lru_phase<1>(F, nullptr); PH_BAR(); } }
    if (IN(3)) { PH_BEGIN(3); {
        k_rope_pass(F, dmy_ ? (bf16*)F.out : F.K());
        lru_propagate(F);
        if (F.vcu == F.G - 1) p3_meta_job(F);
        PH_BAR();
    } }
    if (IN(4)) { PH_BEGIN(4); {
        const int dm = dmy_;
        if (dm < 2 || dm == 2) lru_phase<2>(F, dm ? (bf16*)F.out : F.QG());
        if (dm < 2 || dm == 3) for (int it = F.vcu; it < 512; it += F.G) metaq_item(F, it);
        if (dm < 2 || dm == 4) attn_phase(F, (char*)lds, dm ? (bf16*)F.out : F.QG());
        if (dm == 8 && F.vcu < 128) attn_phase(F, (char*)lds, (bf16*)F.out);
        if (dm == 6 && (F.vcu & 1) == 0) attn_phase(F, (char*)lds, (bf16*)F.out);
        PH_BAR();
    } }
    if (IN(5)) { PH_BEGIN(5); {
        p5_ratio(F);
        if (F.vcu >= F.G - 12) p5_meta_job(F, F.G - 1 - F.vcu);
        PH_BAR();
    } }
    if (IN(6)) { PH_BEGIN(6); {
        p6_meta_y(F);
        pg8::Gemm g{F.QG(), F.WOUT_T(), NTOK, DM, DM}; pg8::StaticOrder S; S.init(NTOK, DM, F.G, (int)blockIdx.x);
        pg8::EpiScaled E{(bf16*)F.out, 2 * DM, F.RATIO(), F.RL(), 16};
        pg8::gemm_phase<pg8::EpiScaled, pg8::StaticOrder, true, true>(F.lds, g, S, E, F.wave);
        PH_BAR();
    } }
#if MK_MULTI
    { const int q = args.q_lo;
#else
#pragma unroll
    for (int q = 0; q < 2; ++q) {
#endif
        if (IN(7)) { PH_BEGIN(7); {
            p7_rows(F, q, gw, NGW);
            if (q == 0) p7_meta_g(F);
            PH_BAR();
        } }
        if (IN(8)) { PH_BEGIN(8); {
            pg8::Gemm g{F.XN() + (size_t)q * HROWS * DM, F.WUP_T(), HROWS, UPW, DM}; pg8::StaticOrder S; S.init(HROWS, UPW, F.G, (int)blockIdx.x);
            pg8::EpiAct E{F.ACT(), F.EDGE(), FIN(F, 20  ), FIN(F, 21  ), FFN};
            pg8::gemm_phase<pg8::EpiAct, pg8::StaticOrder, true, true>(F.lds, g, S, E, F.wave);
            PH_BAR();
        } }
        if (IN(9)) { PH_BEGIN(9); { p9_fix(F, q); PH_BAR(); } }
        if (IN(10)) { PH_BEGIN(10); {
            pg8::Gemm g{F.ACT(), F.WDOWN_T(), HROWS, DM, FFN}; pg8::ProbeOrder S; S.init(HROWS, DM, F.G, (int)blockIdx.x); S.pmask = dmy_ == 5 ? 7 : -1;
            pg8::EpiRoute E{(bf16*)F.out + (size_t)q * HROWS * 2 * DM, 2 * DM, 0, nullptr, nullptr, nullptr, nullptr};
            pg8::gemm_phase<pg8::EpiRoute, pg8::ProbeOrder, true, true>(F.lds, g, S, E, F.wave);
            if (q == 0) PH_BAR();
        } }
    }
    if (IN(10) && IN(11)) PH_BAR();
    if (IN(11)) { PH_BEGIN(11); { p11_rows(F, gw, NGW, dmy_ ? (float*)(F.ws + WS_B) : F.out); } }
#undef IN
#undef PH_BAR
}

extern "C" void kernel_launch(void* const* d_in, const int* in_sizes, int n_in, void* d_out, int out_size, void* d_ws, size_t ws_size, hipStream_t stream) {
    static int grid = 0;
    if (grid == 0) {
        if (n_in != 24 || out_size != NTOK * DM || ws_size < WS_END) { fprintf(stderr, "kernel_launch: unexpected shapes (n_in %d out %d ws %zu, need ws >= %zu); nothing launched\n", n_in, out_size, ws_size, (size_t)WS_END); grid = -1; return; }
        int dev = 0, cus = 0;
        if (hipGetDevice(&dev) != hipSuccess || hipDeviceGetAttribute(&cus, hipDeviceAttributeMultiprocessorCount, dev) != hipSuccess) { grid = -1; return; }
        if (hipFuncSetAttribute((const void*)mk_fwd, hipFuncAttributeMaxDynamicSharedMemorySize, LDS_BYTES) != hipSuccess) { fprintf(stderr, "kernel_launch: hipFuncSetAttribute failed\n"); grid = -1; return; }
        int per_cu = 0;
        if (hipOccupancyMaxActiveBlocksPerMultiprocessor(&per_cu, (const void*)mk_fwd, NWAVES * 64, LDS_BYTES) != hipSuccess || per_cu < 1) fprintf(stderr, "kernel_launch: occupancy query reports %d\n", per_cu);
        (void)hipGetLastError();
        grid = cus;
    }
    if (grid < 0) return;
    if (hipMemsetAsync((char*)d_ws + WS_CTL, 0, CTL_ZERO_BYTES, stream) != hipSuccess) return;
    Args a{};
    for (int i = 0; i < 24; ++i) a.in[i] = (const float*)d_in[i];
    a.out = (float*)d_out; a.ws = (unsigned char*)d_ws;
#if MK_MULTI
    a.use_bar = 0;
#define LAUNCH_PH(ph, q) do { a.ph_lo = (ph); a.ph_hi = (ph) + 1; a.q_lo = (q); a.q_hi = (q) + 1; \
        if ((MK_REPEAT_MASK >> (ph)) & 1) { a.dummy = MK_DUMMY_MODE; hipLaunchKernelGGL(mk_fwd, dim3(grid), dim3(NWAVES * 64), LDS_BYTES, stream, a); } \
        a.dummy = 0; hipLaunchKernelGGL(mk_fwd, dim3(grid), dim3(NWAVES * 64), LDS_BYTES, stream, a); } while (0)
    for (int ph = 0; ph < 7; ++ph) LAUNCH_PH(ph, 0);
    for (int q = 0; q < 2; ++q) for (int ph = 7; ph < 11; ++ph) LAUNCH_PH(ph, q);
    LAUNCH_PH(11, 0);
#else
    a.use_bar = 1; a.ph_lo = 0; a.ph_hi = N_PHASES; a.q_lo = 0; a.q_hi = 2;
    hipLaunchKernelGGL(mk_fwd, dim3(grid), dim3(NWAVES * 64), LDS_BYTES, stream, a);
#endif
    const hipError_t le = hipPeekAtLastError();
    if (le != hipSuccess) fprintf(stderr, "kernel_launch: launch failed: %s\n", hipGetErrorName(le));
}
```

```cpp
#include <hip/hip_runtime.h>
#include <cstdio>
#include <cstdint>
#include <cmath>
#ifndef MK_PHASE_MASK
#define MK_PHASE_MASK 0xfff
#endif
#ifndef MK_REPEAT_MASK
#define MK_REPEAT_MASK 0
#endif
#ifndef MK_DUMMY_MODE
#define MK_DUMMY_MODE 1
#endif
#ifndef MK_MULTI
#define MK_MULTI 0
#endif
__device__ __forceinline__ int lane_id_now() { int l; asm volatile("v_mbcnt_lo_u32_b32 %0, -1, 0\n\tv_mbcnt_hi_u32_b32 %0, -1, %0" : "=v"(l)); return l; }
namespace pg8 {
#define PG8_LAS __attribute__((address_space(3)))
typedef unsigned short bf16_t;
typedef short bf16x8 __attribute__((ext_vector_type(8)));
typedef float f32x4 __attribute__((ext_vector_type(4)));
typedef unsigned u32x4 __attribute__((ext_vector_type(4)));
constexpr int BM = 256, BK = 64, HALF = 128, HTB = HALF * BK * 2  , STAGE_BYTES = 8 * HTB, NXCD = 8, WGM = 8;

__host__ __device__ __forceinline__ int lds_byte(int r, int c) { const int st = (r >> 4) * 2 + (c >> 5), rr = r & 15, cc = c & 31, ob = rr * 64 + cc * 2; return st * 1024 + (ob ^ (((ob >> 9) & 1) << 5)); }
__host__ __device__ __forceinline__ void stage_rc(int b, int& R, int& C) { const int st = b / 1024, sb = b % 1024, swz = sb ^ (((sb >> 9) & 1) << 5); R = (st >> 1) * 16 + swz / 64; C = (st & 1) * 32 + (swz % 64) / 2; }
__host__ __device__ __forceinline__ int perm32(int rho) { const int n = rho >> 4, i = rho & 15; return 8 * (i >> 2) + 4 * n + (i & 3); }

struct Unit { int pm, pn; };
struct Gemm { const bf16_t* A; const bf16_t* Bt; int M, N, K; };

struct StaticOrder {
    int nM, nN, nwg, G, c;
    __host__ __device__ void init(int M, int N, int G_, int c_) { nM = M / BM; nN = N / BM; nwg = nM * nN; G = G_; c = c_; }
    __host__ __device__ bool next(int i, Unit& u) const {
        const long L = (long)i * G + c; if (L >= nwg) return false;
        int wgid = (int)L; { const int q = nwg / NXCD, r = nwg % NXCD, xcd = wgid % NXCD, off = wgid / NXCD; wgid = (xcd < r ? xcd * (q + 1) : r * (q + 1) + (xcd - r) * q) + off; }
        const int nig = WGM * nN, gid = wgid / nig, fm = gid * WGM, gsz = (nM - fm) < WGM ? (nM - fm) : WGM;
        u.pm = fm + ((wgid % nig) % gsz); u.pn = (wgid % nig) / gsz; return true;
    }
    __device__ __forceinline__ void a_ready(const Unit&) const {}
    __device__ __forceinline__ void done(const Unit&) const {}
};

__device__ __forceinline__ unsigned cvt_pk_bf16(float lo, float hi) { unsigned r; asm volatile("v_cvt_pk_bf16_f32 %0, %1, %2" : "=v"(r) : "v"(lo), "v"(hi)); return r; }
struct EpiRoute {
    static constexpr bool PERM = true, AFTER_DRAIN = false, MIDK = false;
    bf16_t* O; int ldc; int mode; bf16_t *QGp, *Kp, *Vp, *XRp;
    __device__ __forceinline__ void operator()(const f32x4 (&acc)[2][2][4][2], const Unit& u, int wr, int wc, int fr, int fq) const {
        bf16_t* base = O; int ld = ldc; int colt = u.pn * BM; int rowadd = 0;
        if (mode == 1) {
            const int pn = u.pn;
            if (pn < 4) { base = QGp; ld = 2048; colt = pn * 256; }
            else if (pn == 4) { base = Kp; ld = 256; colt = 0; }
            else if (pn == 5) { base = Vp; ld = 256; colt = 0; }
            else if (pn < 10) { base = XRp; ld = 1024; colt = (pn - 6) * 256; const int seq = u.pm < 128 ? (u.pm >> 4) : 8 + ((u.pm - 128) >> 5); rowadd = 64 * (seq + 1); }
            else { base = QGp; ld = 2048; colt = 1024 + (pn - 10) * 256; }
        }
        const int row0 = u.pm * BM + wr * 64 + fr + rowadd; const int col0 = colt + wc * 32 + 8 * fq;
#pragma unroll
        for (int ai = 0; ai < 2; ++ai)
#pragma unroll
            for (int m = 0; m < 4; ++m) { bf16_t* rowp = base + (size_t)(row0 + ai * HALF + m * 16) * ld + col0;
#pragma unroll
                for (int bj = 0; bj < 2; ++bj) { const f32x4 v0 = acc[ai][bj][m][0], v1 = acc[ai][bj][m][1];
                    u32x4 w; w.x = cvt_pk_bf16(v0[0], v0[1]); w.y = cvt_pk_bf16(v0[2], v0[3]); w.z = cvt_pk_bf16(v1[0], v1[1]); w.w = cvt_pk_bf16(v1[2], v1[3]);
                    *(u32x4*)(rowp + bj * HALF) = w; } }
    }
};

__device__ __forceinline__ float dpp_shr1(float old, float src) { return __builtin_bit_cast(float, __builtin_amdgcn_update_dpp(__builtin_bit_cast(int, old), __builtin_bit_cast(int, src), 0x111, 0xF, 0xF, false)); }
__device__ __forceinline__ float dpp_shl1(float old, float src) { return __builtin_bit_cast(float, __builtin_amdgcn_update_dpp(__builtin_bit_cast(int, old), __builtin_bit_cast(int, src), 0x101, 0xF, 0xF, false)); }
__device__ __forceinline__ float dpp_ror1(float src)  { return __builtin_bit_cast(float, __builtin_amdgcn_update_dpp(0, __builtin_bit_cast(int, src), 0x121, 0xF, 0xF, false)); }
__device__ __forceinline__ float dpp_ror15(float src) { return __builtin_bit_cast(float, __builtin_amdgcn_update_dpp(0, __builtin_bit_cast(int, src), 0x12F, 0xF, 0xF, false)); }
struct EpiAct {
    static constexpr bool PERM = true, AFTER_DRAIN = false, MIDK = false;
    bf16_t* ACT; float* EDGE; const float* cw; const float* cb; int nch;
    __device__ __forceinline__ void operator()(const f32x4 (&acc)[2][2][4][2], const Unit& u, int wr, int wc, int fr, int fq) const {
        const int ch0 = u.pn * 128 + wc * 32 + 8 * fq;
        float w0[8], w1[8], w2[8], bb[8];
        { const f32x4 a0 = *(const f32x4*)(cw + ch0), a1 = *(const f32x4*)(cw + ch0 + 4), b0 = *(const f32x4*)(cw + nch + ch0), b1 = *(const f32x4*)(cw + nch + ch0 + 4),
                      c0 = *(const f32x4*)(cw + 2 * nch + ch0), c1 = *(const f32x4*)(cw + 2 * nch + ch0 + 4), d0 = *(const f32x4*)(cb + ch0), d1 = *(const f32x4*)(cb + ch0 + 4);
#pragma unroll
          for (int k = 0; k < 4; ++k) { w0[k] = a0[k]; w0[4 + k] = a1[k]; w1[k] = b0[k]; w1[4 + k] = b1[k]; w2[k] = c0[k]; w2[4 + k] = c1[k]; bb[k] = d0[k]; bb[4 + k] = d1[k]; } }
        const int rowb = u.pm * BM + wr * 64;
#pragma unroll
        for (int ai = 0; ai < 2; ++ai) {
            float ein0[8], ein1[8];
#pragma unroll
            for (int m = 0; m < 4; ++m) {
                float o[8];
#pragma unroll
                for (int n = 0; n < 2; ++n)
#pragma unroll
                    for (int k = 0; k < 4; ++k) {
                        const int j = 4 * n + k; const float cur = acc[ai][0][m][n][k];
                        float pold = 0.f, nold = 0.f;
                        if (m > 0) pold = dpp_ror1(acc[ai][0][m > 0 ? m - 1 : 0][n][k]);
                        if (m < 3) nold = dpp_ror15(acc[ai][0][m < 3 ? m + 1 : 3][n][k]);
                        const float prv = dpp_shr1(pold, cur), nxt = dpp_shl1(nold, cur);
                        const float x = bb[j] + w0[j] * prv + w1[j] * cur + w2[j] * nxt;
                        o[j] = x * __builtin_amdgcn_rcpf(1.f + __builtin_amdgcn_exp2f(-1.4426950408889634f * x)) * acc[ai][1][m][n][k];
                        if (m == 0) ein0[j] = nxt;
                        if (m == 3) ein1[j] = prv;
                    }
                u32x4 w; w.x = cvt_pk_bf16(o[0], o[1]); w.y = cvt_pk_bf16(o[2], o[3]); w.z = cvt_pk_bf16(o[4], o[5]); w.w = cvt_pk_bf16(o[6], o[7]);
                *(u32x4*)(ACT + (size_t)(rowb + ai * HALF + m * 16 + fr) * nch + ch0) = w;
            }
            const int blk = (rowb + ai * HALF) >> 6;
            if (fr == 0 || fr == 15) {
                const bool last = fr == 15; float* e = EDGE + (size_t)((blk * 2 + (last ? 1 : 0)) * 3) * nch + ch0;
                f32x4 i0v, i1v, s0v, s1v, u0v, u1v;
#pragma unroll
                for (int k = 0; k < 4; ++k) { i0v[k] = last ? ein1[k] : ein0[k]; i1v[k] = last ? ein1[4 + k] : ein0[4 + k];
                    s0v[k] = last ? acc[ai][0][3][0][k] : acc[ai][0][0][0][k]; s1v[k] = last ? acc[ai][0][3][1][k] : acc[ai][0][0][1][k];
                    u0v[k] = last ? acc[ai][1][3][0][k] : acc[ai][1][0][0][k]; u1v[k] = last ? acc[ai][1][3][1][k] : acc[ai][1][0][1][k]; }
                *(f32x4*)(e) = i0v; *(f32x4*)(e + 4) = i1v; *(f32x4*)(e + nch) = s0v; *(f32x4*)(e + nch + 4) = s1v; *(f32x4*)(e + 2 * nch) = u0v; *(f32x4*)(e + 2 * nch + 4) = u1v;
            }
        }
    }
};

struct ProbeOrder : StaticOrder { int pmask;
    __host__ __device__ bool next(int i, Unit& u) const { const bool r = StaticOrder::next(i, u); u.pm &= pmask; return r; } };

struct EpiScaled {
    static constexpr bool PERM = true, AFTER_DRAIN = false, MIDK = true;
    bf16_t* O; int ldc; const float* ratio; const float* rl; int kt;
    __device__ __forceinline__ void midk(f32x4 (&acc)[2][2][4][2], const Unit& u, int wr, int fr) const {
        asm volatile("" ::: "memory");
        const float* rp = ratio + (u.pm * BM + wr * 64 + fr);
        float s[2][4];
#pragma unroll
        for (int ai = 0; ai < 2; ++ai)
#pragma unroll
            for (int m = 0; m < 4; ++m) s[ai][m] = rp[ai * HALF + m * 16];
#pragma unroll
        for (int ai = 0; ai < 2; ++ai)
#pragma unroll
            for (int m = 0; m < 4; ++m)
#pragma unroll
                for (int bj = 0; bj < 2; ++bj)
#pragma unroll
                    for (int n = 0; n < 2; ++n) acc[ai][bj][m][n] = acc[ai][bj][m][n] * s[ai][m];
        asm volatile("" ::: "memory");
    }
    __device__ __forceinline__ void operator()(const f32x4 (&acc)[2][2][4][2], const Unit& u, int wr, int wc, int fr, int fq) const {
        const int row0 = u.pm * BM + wr * 64 + fr, col0 = u.pn * BM + wc * 32 + 8 * fq;
#pragma unroll
        for (int ai = 0; ai < 2; ++ai)
#pragma unroll
            for (int m = 0; m < 4; ++m) { const int row = row0 + ai * HALF + m * 16; const float s = rl[row]; bf16_t* rowp = O + (size_t)row * ldc + col0;
#pragma unroll
                for (int bj = 0; bj < 2; ++bj) { const f32x4 v0 = acc[ai][bj][m][0] * s, v1 = acc[ai][bj][m][1] * s;
                    u32x4 w; w.x = cvt_pk_bf16(v0[0], v0[1]); w.y = cvt_pk_bf16(v0[2], v0[3]); w.z = cvt_pk_bf16(v1[0], v1[1]); w.w = cvt_pk_bf16(v1[2], v1[3]);
                    *(u32x4*)(rowp + bj * HALF) = w; } }
    }
};

template <class Epi, class Sched, bool ALIGN_EPI = false, bool SP2 = false>
__device__ __forceinline__ void gemm_phase(PG8_LAS unsigned char* lds, const Gemm g, const Sched& S, const Epi& E, int wave_id) {
    int tid_ = wave_id * 64 + lane_id_now(); asm volatile("" : "+v"(tid_));
    const int tid = tid_, wid = __builtin_amdgcn_readfirstlane(tid >> 6), lane = tid & 63, wr = wid >> 2, wc = wid & 3, fr = lane & 15, fq = lane >> 4;
    const int K = g.K, nt = K / BK;
    unsigned voffA[2], voffB[2];
#pragma unroll
    for (int i = 0; i < 2; ++i) { int R, C; stage_rc(tid * 16 + i * 8192, R, C); const int Rb = Epi::PERM ? ((R & ~31) + perm32(R & 31)) : R;
        voffA[i] = (unsigned)(R * K + C) * 2u; voffB[i] = (unsigned)(Rb * K + C) * 2u; }
    const size_t kstep = (size_t)(BK * 2);
    const size_t hstep = (size_t)HALF * K * 2;
    const size_t tstep = 2 * hstep;
    const unsigned ldsw = (unsigned)wid * 1024u;
    const int aoff = lds_byte(wr * 64 + fr, fq * 8), boff = lds_byte(wc * 32 + fr, fq * 8);
#define PG8_SA(b, h) (((b) * 2 + (h)) * HTB)
#define PG8_SB(b, h) ((4 + (b) * 2 + (h)) * HTB)
#define PG8_STAGE(bufoff, gbase, voff) do { _Pragma("unroll") for (int _i = 0; _i < 2; ++_i) \
        __builtin_amdgcn_global_load_lds((const unsigned*)((const char*)(gbase) + (voff)[_i]), (PG8_LAS unsigned*)(lds + (bufoff) + ldsw + _i * 8192), 16, 0, 0); } while (0)
#define PG8_LDA(dst, b, h) do { _Pragma("unroll") for (int m = 0; m < 4; ++m) _Pragma("unroll") for (int k = 0; k < 2; ++k) dst[m][k] = *(const PG8_LAS bf16x8*)(lds + PG8_SA(b, h) + aoff + m * 2048 + k * 1024); } while (0)
#define PG8_LDB(dst, b, h) do { _Pragma("unroll") for (int n = 0; n < 2; ++n) _Pragma("unroll") for (int k = 0; k < 2; ++k) dst[n][k] = *(const PG8_LAS bf16x8*)(lds + PG8_SB(b, h) + boff + n * 2048 + k * 1024); } while (0)
#define PG8_MMA(ai, bj, At, Bt) do { __builtin_amdgcn_s_setprio(1); _Pragma("unroll") for (int m = 0; m < 4; ++m) _Pragma("unroll") for (int n = 0; n < 2; ++n) _Pragma("unroll") for (int k = 0; k < 2; ++k) \
        acc[ai][bj][m][n] = __builtin_amdgcn_mfma_f32_16x16x32_bf16(Bt[n][k], At[m][k], acc[ai][bj][m][n], 0, 0, 0); __builtin_amdgcn_s_setprio(0); } while (0)
#define PG8_WAIT_V(n) asm volatile("s_waitcnt vmcnt(" #n ")" ::: "memory")
#define PG8_WAIT_L(n) asm volatile("s_waitcnt lgkmcnt(" #n ")" ::: "memory")
#define PG8_BAR __builtin_amdgcn_s_barrier()
#define PG8_SCHED __builtin_amdgcn_sched_barrier(0)
    Unit cur, nxt; int ui = 0;
    if (!S.next(0, cur)) return;
    f32x4 acc[2][2][4][2];
#pragma unroll
    for (int a = 0; a < 2; ++a)
#pragma unroll
        for (int b = 0; b < 2; ++b)
#pragma unroll
            for (int m = 0; m < 4; ++m)
#pragma unroll
                for (int n = 0; n < 2; ++n) acc[a][b][m][n] = (f32x4){0.f, 0.f, 0.f, 0.f};
    bf16x8 At[4][2], B0[2][2], B1[2][2];
    const char* cA = (const char*)g.A + (size_t)cur.pm * tstep; const char* cB = (const char*)g.Bt + (size_t)cur.pn * tstep;
    S.a_ready(cur);
    if constexpr (SP2) {
        PG8_STAGE(PG8_SB(0, 0), cB, voffB); PG8_STAGE(PG8_SB(0, 1), cB + hstep, voffB); PG8_STAGE(PG8_SA(0, 0), cA, voffA); PG8_STAGE(PG8_SA(0, 1), cA + hstep, voffA);
        if (wr == 1) PG8_BAR;
        PG8_WAIT_V(2); PG8_BAR;
        PG8_STAGE(PG8_SB(1, 0), cB + kstep, voffB); PG8_STAGE(PG8_SA(1, 0), cA + kstep, voffA); PG8_STAGE(PG8_SB(1, 1), cB + hstep + kstep, voffB);
        PG8_WAIT_V(6); PG8_BAR;
    } else {
        PG8_STAGE(PG8_SB(0, 0), cB, voffB); PG8_STAGE(PG8_SA(0, 0), cA, voffA); PG8_STAGE(PG8_SB(0, 1), cB + hstep, voffB); PG8_STAGE(PG8_SA(0, 1), cA + hstep, voffA);
        if (wr == 1) PG8_BAR;
        PG8_WAIT_V(4); PG8_BAR;
        PG8_STAGE(PG8_SB(1, 0), cB + kstep, voffB); PG8_STAGE(PG8_SA(1, 0), cA + kstep, voffA); PG8_STAGE(PG8_SB(1, 1), cB + hstep + kstep, voffB);
        PG8_WAIT_V(6); PG8_BAR;
    }
    for (;;) {
        const bool has_next = S.next(ui + 1, nxt);
        const char* nA = has_next ? (const char*)g.A + (size_t)nxt.pm * tstep : cA; const char* nB = has_next ? (const char*)g.Bt + (size_t)nxt.pn * tstep : cB;
        for (int t = 0; t < nt; t += 2) {
            if constexpr (Epi::MIDK) { if (t == E.kt) E.midk(acc, cur, wr, fr); }
            const bool last = (t == nt - 2);
            const char* a1 = cA + (size_t)(t + 1) * kstep;
            const char* a2 = last ? nA : cA + (size_t)(t + 2) * kstep; const char* b2 = last ? nB : cB + (size_t)(t + 2) * kstep;
            const char* a3 = a2 + kstep; const char* b3 = b2 + kstep;
            if (last && has_next) S.a_ready(nxt);
            if constexpr (SP2) {
            PG8_LDB(B0, 0, 0); PG8_LDB(B1, 0, 1); PG8_SCHED; PG8_LDA(At, 0, 0); PG8_STAGE(PG8_SA(1, 1), a1 + hstep, voffA);
            PG8_WAIT_V(8); PG8_WAIT_L(0); PG8_BAR; PG8_MMA(0, 0, At, B0); PG8_MMA(0, 1, At, B1); PG8_BAR; PG8_SCHED;
            PG8_LDA(At, 0, 1); PG8_STAGE(PG8_SB(0, 0), b2, voffB); PG8_STAGE(PG8_SB(0, 1), b2 + hstep, voffB); PG8_STAGE(PG8_SA(0, 0), a2, voffA);
            PG8_WAIT_V(8); PG8_WAIT_L(0); PG8_BAR; PG8_MMA(1, 0, At, B0); PG8_MMA(1, 1, At, B1); PG8_BAR; PG8_SCHED;
            PG8_LDB(B0, 1, 0); PG8_LDB(B1, 1, 1); PG8_SCHED; PG8_LDA(At, 1, 0); PG8_STAGE(PG8_SA(0, 1), a2 + hstep, voffA);
            PG8_WAIT_V(8); PG8_WAIT_L(0); PG8_BAR; PG8_MMA(0, 0, At, B0); PG8_MMA(0, 1, At, B1); PG8_BAR; PG8_SCHED;
            PG8_LDA(At, 1, 1); PG8_STAGE(PG8_SB(1, 0), b3, voffB); PG8_STAGE(PG8_SB(1, 1), b3 + hstep, voffB); PG8_STAGE(PG8_SA(1, 0), a3, voffA);
            PG8_WAIT_V(8); PG8_WAIT_L(0); PG8_BAR; PG8_MMA(1, 0, At, B0); PG8_MMA(1, 1, At, B1); PG8_BAR; PG8_SCHED;
            } else {
            PG8_LDB(B0, 0, 0); PG8_SCHED; PG8_LDA(At, 0, 0); PG8_STAGE(PG8_SA(1, 1), a1 + hstep, voffA);
            PG8_WAIT_L(8); PG8_BAR; PG8_WAIT_L(0); PG8_MMA(0, 0, At, B0); PG8_BAR; PG8_SCHED;
            PG8_LDB(B1, 0, 1); PG8_STAGE(PG8_SB(0, 0), b2, voffB);
            PG8_BAR; PG8_WAIT_L(0); PG8_MMA(0, 1, At, B1); PG8_BAR;
            PG8_LDA(At, 0, 1); PG8_STAGE(PG8_SA(0, 0), a2, voffA);
            PG8_BAR; PG8_WAIT_L(0); PG8_MMA(1, 0, At, B0); PG8_BAR; PG8_SCHED;
            PG8_STAGE(PG8_SB(0, 1), b2 + hstep, voffB);
            PG8_WAIT_V(6); PG8_BAR; PG8_MMA(1, 1, At, B1); PG8_BAR;
            PG8_LDB(B0, 1, 0); PG8_SCHED; PG8_LDA(At, 1, 0); PG8_STAGE(PG8_SA(0, 1), a2 + hstep, voffA);
            PG8_WAIT_L(8); PG8_BAR; PG8_WAIT_L(0); PG8_MMA(0, 0, At, B0); PG8_BAR; PG8_SCHED;
            PG8_LDB(B1, 1, 1); PG8_STAGE(PG8_SB(1, 0), b3, voffB);
            PG8_BAR; PG8_WAIT_L(0); PG8_MMA(0, 1, At, B1); PG8_BAR;
            PG8_LDA(At, 1, 1); PG8_STAGE(PG8_SA(1, 0), a3, voffA);
            PG8_BAR; PG8_WAIT_L(0); PG8_MMA(1, 0, At, B0); PG8_BAR; PG8_SCHED;
            PG8_STAGE(PG8_SB(1, 1), b3 + hstep, voffB);
            PG8_WAIT_V(6); PG8_BAR; PG8_MMA(1, 1, At, B1); PG8_BAR;
            }
        }
        if constexpr (ALIGN_EPI) { if (wr == 0) PG8_BAR; }
        if constexpr (!Epi::AFTER_DRAIN) { E(acc, cur, wr, wc, fr, fq); S.done(cur); }
        if (!has_next) break;
#pragma unroll
        for (int a = 0; a < 2; ++a)
#pragma unroll
            for (int b = 0; b < 2; ++b)
#pragma unroll
                for (int m = 0; m < 4; ++m)
#pragma unroll
                    for (int n = 0; n < 2; ++n) acc[a][b][m][n] = (f32x4){0.f, 0.f, 0.f, 0.f};
        cur = nxt; cA = nA; cB = nB; ++ui;
        if constexpr (ALIGN_EPI) { if (wr == 1) PG8_BAR; }
    }
    PG8_WAIT_V(0);
    if constexpr (!ALIGN_EPI) { if (wr == 0) PG8_BAR; }
    PG8_BAR;
    if constexpr (Epi::AFTER_DRAIN) { E.fused(acc, cur, wr, wc, fr, fq, lds, wid, lane); S.done(cur); }
#undef PG8_SA
#undef PG8_SB
#undef PG8_STAGE
#undef PG8_LDA
#undef PG8_LDB
#undef PG8_MMA
#undef PG8_WAIT_V
#undef PG8_WAIT_L
#undef PG8_BAR
#undef PG8_SCHED
}
}
namespace attn {
typedef unsigned short bf16r;
using bf16x8 = __attribute__((ext_vector_type(8))) short;
using s16x4  = __attribute__((ext_vector_type(4))) short;
using f32x4  = __attribute__((ext_vector_type(4))) float;
using u32x4  = __attribute__((ext_vector_type(4))) unsigned;
constexpr int   QBLK = 32, KVBLK = 64;
constexpr float SCALE = 0.088388347648318440f;
constexpr float THRL = 8.f;
constexpr int LDQ = 2048, LDK = 256, LDO = 2048;
constexpr size_t SHM_ATTN = 6 * 16384 + 8 * 64 * 4;
#define SBAR() __builtin_amdgcn_sched_barrier(0)
__device__ __forceinline__ unsigned cvtpk(float lo, float hi) { unsigned r; asm volatile("v_cvt_pk_bf16_f32 %0, %1, %2" : "=v"(r) : "v"(lo), "v"(hi)); return r; }
__device__ __forceinline__ unsigned short f2bf_rne(float f) { unsigned u = __builtin_bit_cast(unsigned, f); return (unsigned short)((u + 0x7fffu + ((u >> 16) & 1u)) >> 16); }
__device__ __forceinline__ float bfl(short b) { return __builtin_bit_cast(float, (unsigned)(unsigned short)b << 16); }
template <int OFF> __device__ __forceinline__ s16x4 tr_read(int vb) { s16x4 r; asm volatile("ds_read_b64_tr_b16 %0, %1 offset:%2" : "=&v"(r) : "v"(vb), "i"(OFF) : "memory"); return r; }

__device__ __forceinline__ void qkt16(f32x4 (&S)[4][2], const char* Ks, int kb0, const bf16x8 (&qf)[2][4], float nm0, float nm1) {
  const f32x4 n0 = {nm0, nm0, nm0, nm0}, n1 = {nm1, nm1, nm1, nm1};
#pragma unroll
  for (int kb = 0; kb < 4; ++kb)
#pragma unroll
    for (int ds = 0; ds < 4; ++ds) { const bf16x8 kf = *reinterpret_cast<const bf16x8*>(Ks + kb * 4096 + (kb0 ^ (64 * ds)));
      S[kb][0] = __builtin_amdgcn_mfma_f32_16x16x32_bf16(kf, qf[0][ds], ds == 0 ? n0 : S[kb][0], 0, 0, 0);
      S[kb][1] = __builtin_amdgcn_mfma_f32_16x16x32_bf16(kf, qf[1][ds], ds == 0 ? n1 : S[kb][1], 0, 0, 0); }
}
__device__ __forceinline__ void mask_meta16(f32x4 (&S)[4][2]) {
  const float NEG = -INFINITY;
#pragma unroll
  for (int kb = 1; kb < 4; ++kb)
#pragma unroll
    for (int qb = 0; qb < 2; ++qb) S[kb][qb] = (f32x4){NEG, NEG, NEG, NEG};
}
__device__ __forceinline__ void partial16(f32x4 (&S)[4][2], float (&mhat)[2], float (&alpha)[2], bool first) {
  float pm[2];
#pragma unroll
  for (int qb = 0; qb < 2; ++qb) { float a = __builtin_fmaxf(__builtin_fmaxf(S[0][qb][0], S[0][qb][1]), S[0][qb][2]), b = __builtin_fmaxf(__builtin_fmaxf(S[0][qb][3], S[1][qb][0]), S[1][qb][1]);
    a = __builtin_fmaxf(__builtin_fmaxf(a, S[1][qb][2]), S[1][qb][3]); b = __builtin_fmaxf(__builtin_fmaxf(b, S[2][qb][0]), S[2][qb][1]);
    a = __builtin_fmaxf(__builtin_fmaxf(a, S[2][qb][2]), S[2][qb][3]); b = __builtin_fmaxf(__builtin_fmaxf(b, S[3][qb][0]), S[3][qb][1]);
    a = __builtin_fmaxf(__builtin_fmaxf(a, S[3][qb][2]), S[3][qb][3]); pm[qb] = __builtin_fmaxf(a, b); }
  alpha[0] = 1.f; alpha[1] = 1.f;
  if (first || __builtin_expect(__any(__builtin_fmaxf(pm[0], pm[1]) > THRL), 0)) {
#pragma unroll
    for (int qb = 0; qb < 2; ++qb) { float m = pm[qb]; m = __builtin_fmaxf(m, __shfl_xor(m, 16)); m = __builtin_fmaxf(m, __shfl_xor(m, 32));
      const float dl = first ? m : __builtin_fmaxf(m, 0.f); mhat[qb] += dl;
#pragma unroll
      for (int kb = 0; kb < 4; ++kb) S[kb][qb] = S[kb][qb] - dl;
      if (!first) alpha[qb] = __builtin_amdgcn_exp2f(-dl); }
  }
#pragma unroll
  for (int kb = 0; kb < 2; ++kb)
#pragma unroll
    for (int qb = 0; qb < 2; ++qb)
#pragma unroll
      for (int r = 0; r < 4; ++r) S[kb][qb][r] = __builtin_amdgcn_exp2f(S[kb][qb][r]);
}
__device__ __forceinline__ void finish16(f32x4 (&S)[4][2], const float (&alpha)[2], float (&lsum)[2], bf16x8 (&pa)[2][2]) {
#pragma unroll
  for (int kb = 2; kb < 4; ++kb)
#pragma unroll
    for (int qb = 0; qb < 2; ++qb)
#pragma unroll
      for (int r = 0; r < 4; ++r) S[kb][qb][r] = __builtin_amdgcn_exp2f(S[kb][qb][r]);
#pragma unroll
  for (int qb = 0; qb < 2; ++qb) { float ps = 0.f;
#pragma unroll
    for (int kb = 0; kb < 4; ++kb) ps += (S[kb][qb][0] + S[kb][qb][1]) + (S[kb][qb][2] + S[kb][qb][3]);
    lsum[qb] = lsum[qb] * alpha[qb] + ps;
#pragma unroll
    for (int ks = 0; ks < 2; ++ks) { const f32x4 a = S[2 * ks][qb], b = S[2 * ks + 1][qb];
      u32x4 w = {cvtpk(a[0], a[1]), cvtpk(a[2], a[3]), cvtpk(b[0], b[1]), cvtpk(b[2], b[3])}; pa[qb][ks] = *reinterpret_cast<bf16x8*>(&w); } }
}
template <int KS, int DB> __device__ __forceinline__ void pv_one16(f32x4 (&O)[2][8], int vbA, int vbB, const bf16x8 (&pa)[2][2]) {
  const int vb = DB < 7 ? vbA : vbB;
  const s16x4 lo = tr_read<(8 * KS) * 1024 + 128 * DB>(vb), hi = tr_read<(8 * KS + 4) * 1024 + 128 * DB>(vb);
  asm volatile("s_waitcnt lgkmcnt(0)" ::: "memory"); SBAR();
  const bf16x8 bfr = {lo[0], lo[1], lo[2], lo[3], hi[0], hi[1], hi[2], hi[3]};
  O[0][DB] = __builtin_amdgcn_mfma_f32_16x16x32_bf16(pa[0][KS], bfr, O[0][DB], 0, 0, 0);
  O[1][DB] = __builtin_amdgcn_mfma_f32_16x16x32_bf16(pa[1][KS], bfr, O[1][DB], 0, 0, 0);
}
template <int KS> __device__ __forceinline__ void pv_ks16(f32x4 (&O)[2][8], int vbA, int vbB, const bf16x8 (&pa)[2][2]) {
  pv_one16<KS, 0>(O, vbA, vbB, pa); pv_one16<KS, 1>(O, vbA, vbB, pa); pv_one16<KS, 2>(O, vbA, vbB, pa); pv_one16<KS, 3>(O, vbA, vbB, pa);
  pv_one16<KS, 4>(O, vbA, vbB, pa); pv_one16<KS, 5>(O, vbA, vbB, pa); pv_one16<KS, 6>(O, vbA, vbB, pa); pv_one16<KS, 7>(O, vbA, vbB, pa);
}
__device__ __forceinline__ void pv16(f32x4 (&O)[2][8], int vbA, int vbB, const bf16x8 (&pa)[2][2]) { pv_ks16<0>(O, vbA, vbB, pa); pv_ks16<1>(O, vbA, vbB, pa); }

__device__ __forceinline__ void attn_unit(const bf16r* Qb, const bf16r* __restrict__ Kh, const bf16r* __restrict__ Vh,
                                          const bf16r* __restrict__ KMh, const bf16r* __restrict__ VMh, bf16r* Ob, int NT, char* lds,
                                          const float* __restrict__ qnorm, int t0, float* ssq, int wave_id) {
  int tid_ = wave_id * 64 + lane_id_now(); asm volatile("" : "+v"(tid_));
  const int tid = tid_, wid = tid >> 6, lane = tid & 63, c = lane & 15, g = lane >> 4;
  float* ws = (float*)(lds + 6 * 16384) + wid * 64; float* li_l = ws; float* al_l = ws + 32;
  float mhat[2] = {0.f, 0.f}, lsum[2] = {0.f, 0.f};
  f32x4 O[2][8];
#pragma unroll
  for (int qb = 0; qb < 2; ++qb)
#pragma unroll
    for (int db = 0; db < 8; ++db) O[qb][db] = (f32x4){0.f, 0.f, 0.f, 0.f};
  unsigned kgo0, vgo0;
  { const int k0 = 4 * wid + g; kgo0 = (unsigned)(k0 * (LDK * 2) + ((c << 4) ^ ((k0 & 15) << 4)));
    const int r = (lane >> 1) & 3, half = lane & 1, s8 = lane >> 3;
    { const int p = wid,     db = (s8 - (p & 1)) & 7; vgo0 = (unsigned)((4 * p + r) * (LDK * 2) + (16 * db + 8 * half) * 2); }
 }
  const int kb0 = c * 256 + ((g ^ c) << 4);
  typedef __attribute__((address_space(3))) unsigned char* ldsp_t;
  const ldsp_t lds3 = (ldsp_t)lds;
  const int w1k = __builtin_amdgcn_readfirstlane(wid) * 1024;
  constexpr int VRING = 3 * 16384;
#define DMAK(t, soff) do { const char* b_ = (const char*)((t) == 0 ? KMh : Kh + (long)((t) - 1) * KVBLK * LDK); \
    __builtin_amdgcn_global_load_lds((const unsigned*)(b_ + kgo0), (__attribute__((address_space(3))) unsigned*)(lds3 + (soff) + w1k), 16, 0, 0); \
    __builtin_amdgcn_global_load_lds((const unsigned*)(b_ + kgo0 + 32 * LDK * 2), (__attribute__((address_space(3))) unsigned*)(lds3 + (soff) + w1k + 8192), 16, 0, 0); } while (0)
#define DMAV(t, soff) do { const char* b_ = (const char*)((t) == 0 ? VMh : Vh + (long)((t) - 1) * KVBLK * LDK); \
    __builtin_amdgcn_global_load_lds((const unsigned*)(b_ + vgo0), (__attribute__((address_space(3))) unsigned*)(lds3 + VRING + (soff) + w1k), 16, 0, 0); \
    __builtin_amdgcn_global_load_lds((const unsigned*)(b_ + vgo0 + 32 * LDK * 2), (__attribute__((address_space(3))) unsigned*)(lds3 + VRING + (soff) + w1k + 8192), 16, 0, 0); } while (0)
#define WAITBAR(N) asm volatile("s_waitcnt vmcnt(" #N ") lgkmcnt(0)\n\ts_barrier" ::: "memory")
#define ROT() do { const int t_ = sm1; sm1 = sc_; sc_ = sp1; sp1 = t_; } while (0)
#define RESC(a) do { if (__any(__builtin_fminf((a)[0], (a)[1]) < 1.f)) { if (g == 0) { al_l[c] = (a)[0]; al_l[16 + c] = (a)[1]; } asm volatile("s_waitcnt lgkmcnt(0)" ::: "memory"); \
    _Pragma("unroll") for (int qb_ = 0; qb_ < 2; ++qb_) _Pragma("unroll") for (int r_ = 0; r_ < 4; ++r_) { const float a_ = al_l[16 * qb_ + 4 * g + r_]; \
      _Pragma("unroll") for (int db_ = 0; db_ < 8; ++db_) O[qb_][db_][r_] *= a_; } } } while (0)
  DMAK(0, 0); DMAV(0, 0); DMAK(1, 16384);
  bf16x8 qf[2][4];
#pragma unroll
  for (int qb = 0; qb < 2; ++qb)
#pragma unroll
    for (int ds = 0; ds < 4; ++ds) qf[qb][ds] = *reinterpret_cast<const bf16x8*>(Qb + (long)(wid * QBLK + 16 * qb + c) * LDQ + 32 * ds + 8 * g);
  {
    int go = g; asm volatile("" : "+v"(go));
#pragma unroll
    for (int qb = 0; qb < 2; ++qb) {
      float ss = 0.f;
#pragma unroll
      for (int ds = 0; ds < 4; ++ds)
#pragma unroll
        for (int j = 0; j < 8; ++j) { const float x = bfl(qf[qb][ds][j]); ss += x * x; }
      ss += __shfl_xor(ss, 16); ss += __shfl_xor(ss, 32);
      const float rs = (SCALE * 1.4426950408889634f) / sqrtf(ss * (1.f / 128.f) + 1e-6f);
      int t = t0 + wid * QBLK + 16 * qb + c; asm volatile("" : "+v"(t));
#pragma unroll
      for (int p = 0; p < 2; ++p) { const float pos = (float)(p ? (t & 63) : (t >> 6)); const int fa = 2 * p, fb = 2 * p + 1;
        const float4 ga0 = *reinterpret_cast<const float4*>(qnorm + 32 * fa + 8 * g), ga1 = *reinterpret_cast<const float4*>(qnorm + 32 * fa + 8 * g + 4);
        const float4 gb0 = *reinterpret_cast<const float4*>(qnorm + 32 * fb + 8 * g), gb1 = *reinterpret_cast<const float4*>(qnorm + 32 * fb + 8 * g + 4);
        const float gaf[8] = {ga0.x, ga0.y, ga0.z, ga0.w, ga1.x, ga1.y, ga1.z, ga1.w}, gbf[8] = {gb0.x, gb0.y, gb0.z, gb0.w, gb1.x, gb1.y, gb1.z, gb1.w};
        float oa[8], ob[8];
#pragma unroll
        for (int j = 0; j < 8; ++j) { const int i = 8 * go + j;
          float rev = pos * __builtin_amdgcn_exp2f(-(float)i * (13.287712379549449f / 32.f)) * 0.15915494309189535f; rev -= floorf(rev);
          const float sn = __builtin_amdgcn_sinf(rev), cs = __builtin_amdgcn_cosf(rev);
          const float x1 = bfl(qf[qb][fa][j]) * rs * gaf[j], x2 = bfl(qf[qb][fb][j]) * rs * gbf[j];
          oa[j] = x1 * cs - x2 * sn; ob[j] = x2 * cs + x1 * sn; }
        { u32x4 w = {cvtpk(oa[0], oa[1]), cvtpk(oa[2], oa[3]), cvtpk(oa[4], oa[5]), cvtpk(oa[6], oa[7])}; qf[qb][fa] = *reinterpret_cast<bf16x8*>(&w); }
        { u32x4 w = {cvtpk(ob[0], ob[1]), cvtpk(ob[2], ob[3]), cvtpk(ob[4], ob[5]), cvtpk(ob[6], ob[7])}; qf[qb][fb] = *reinterpret_cast<bf16x8*>(&w); }
        SBAR(); }
    }
  }
  const int vlb = (int)(uintptr_t)(lds + VRING) + g * 1024 + (c >> 2) * 32 + (c & 3) * 8;
  const int vbA0 = vlb + (g & 1) * 128, vbB0 = vlb + (g & 1) * (128 - 1024);
  int sm1 = 32768, sc_ = 0, sp1 = 16384;
  f32x4 S[4][2]; bf16x8 paA[2][2], paB[2][2]; float al[2];
  WAITBAR(2);
  DMAK(2, sm1); DMAV(1, sp1);
  qkt16(S, lds + sc_, kb0, qf, -mhat[0], -mhat[1]); mask_meta16(S); partial16(S, mhat, al, true); finish16(S, al, lsum, paA);
  WAITBAR(4); ROT();
  for (int t = 1; t + 1 < NT; t += 2) {
    if (t + 2 < NT) DMAK(t + 2, sm1); DMAV(t + 1, sp1);
    SBAR(); qkt16(S, lds + sc_, kb0, qf, -mhat[0], -mhat[1]); SBAR();
    pv16(O, vbA0 + sm1, vbB0 + sm1, paA); partial16(S, mhat, al, false); finish16(S, al, lsum, paB);
    if (t + 2 < NT) WAITBAR(4); else WAITBAR(2);
    RESC(al); ROT();
    if (t + 3 < NT) DMAK(t + 3, sm1); if (t + 2 < NT) DMAV(t + 2, sp1);
    SBAR(); qkt16(S, lds + sc_, kb0, qf, -mhat[0], -mhat[1]); SBAR();
    pv16(O, vbA0 + sm1, vbB0 + sm1, paB); partial16(S, mhat, al, false); finish16(S, al, lsum, paA);
    if (t + 3 < NT) WAITBAR(4); else if (t + 2 < NT) WAITBAR(2); else WAITBAR(0);
    RESC(al); ROT();
  }
  pv16(O, vbA0 + sm1, vbB0 + sm1, paA);
#pragma unroll
  for (int qb = 0; qb < 2; ++qb) { float L = lsum[qb]; L += __shfl_xor(L, 16); L += __shfl_xor(L, 32); if (g == 0) li_l[16 * qb + c] = L; }
  asm volatile("s_waitcnt lgkmcnt(0)" ::: "memory");
  bf16r* Ow = Ob + (long)(wid * QBLK) * LDO;
#pragma unroll
  for (int qb = 0; qb < 2; ++qb)
#pragma unroll
    for (int r = 0; r < 4; ++r) { const int orow = 16 * qb + 4 * g + r; const float rl = __builtin_amdgcn_rcpf(li_l[orow]); float sq = 0.f;
#pragma unroll
      for (int db = 0; db < 8; ++db) { const float v = O[qb][db][r] * rl; sq += v * v; Ow[(long)orow * LDO + 16 * db + c] = f2bf_rne(v); }
      sq += __shfl_xor(sq, 1); sq += __shfl_xor(sq, 2); sq += __shfl_xor(sq, 4); sq += __shfl_xor(sq, 8);
      if (c == 0) ssq[(long)(wid * QBLK + orow) * 8] = sq; }
  asm volatile("s_waitcnt lgkmcnt(0)\n\ts_barrier" ::: "memory");
#undef DMAK
#undef DMAV
#undef WAITBAR
#undef ROT
#undef RESC
}
#undef SBAR
}

constexpr int NWAVES = 8;
constexpr int DM = 2048, NTOK = 65536, INW = 3584, FFN = 5632, UPW = 2 * FFN;
constexpr float EPS = 1e-6f;
constexpr int XR_ROWS = 8 * 4160 + 4 * 8256;
constexpr int NCHUNK = 8 * 65 + 4 * 129;
constexpr int HROWS = 32768;
__host__ __device__ __forceinline__ int seq_first_row(int s) { return s < 8 ? s * 4096 : 32768 + (s - 8) * 8192; }
__host__ __device__ __forceinline__ int seq_len(int s) { return s < 8 ? 4096 : 8192; }
__host__ __device__ __forceinline__ int xr_base(int s) { return s < 8 ? s * 4160 : 33280 + (s - 8) * 8256; }
__host__ __device__ __forceinline__ int chunk_base(int s) { return s < 8 ? s * 65 : 520 + (s - 8) * 129; }
__host__ __device__ __forceinline__ int row_seq(int row) { return row < 32768 ? (row >> 12) : 8 + ((row - 32768) >> 13); }

constexpr size_t MiB = 1u << 20, KiB = 1u << 10;
constexpr size_t WS_CTL = 0, CTL_ZERO_BYTES = 1 * MiB;
constexpr size_t WS_SMALL = 1 * MiB;
constexpr size_t WS_XNMETA = WS_SMALL + 0, WS_ZM = WS_SMALL + 64 * KiB, WS_KM = WS_SMALL + 320 * KiB, WS_VM = WS_SMALL + 352 * KiB, WS_Q15 = WS_SMALL + 384 * KiB, WS_GY15 = WS_SMALL + 388 * KiB,
                 WS_LO15 = WS_SMALL + 392 * KiB, WS_MIXED15 = WS_SMALL + 448 * KiB, WS_Y15 = WS_SMALL + 544 * KiB, WS_G15 = WS_SMALL + 640 * KiB, WS_MQP = WS_SMALL + 1024 * KiB;
constexpr size_t WS_WIN = 5 * MiB, WS_WOUT = 19 * MiB, WS_WUP = 27 * MiB, WS_WDOWN = 71 * MiB, WS_WG = 93 * MiB;
constexpr size_t WS_CAR = 94 * MiB, WS_CIN = 111 * MiB;
constexpr size_t WS_R0 = 120 * MiB, WS_RATIO = 120 * MiB + 256 * KiB, WS_RL = 120 * MiB + 512 * KiB, WS_SSQA = 121 * MiB, WS_SSQL = 123 * MiB;
constexpr size_t WS_A = 128 * MiB;
constexpr size_t WS_B = 384 * MiB;
constexpr size_t WS_QG = WS_B, WS_K = WS_B + 256 * MiB, WS_V = WS_B + 288 * MiB, WS_XR = WS_B + 320 * MiB;
constexpr size_t WS_ACT = WS_B, WS_EDGE = WS_B + 352 * MiB;
constexpr size_t WS_H1A = WS_B + 420 * MiB;
constexpr size_t WS_END = WS_B + 548 * MiB;
static_assert(WS_ZM + 16 * INW * 4 <= WS_KM && WS_G15 + 12 * FFN * 4 <= WS_MQP && WS_MQP + 512 * 4 * 132 * 4 <= WS_WIN, "small map");
static_assert(WS_WIN + (size_t)INW * DM * 2 <= WS_WOUT && WS_WOUT + (size_t)DM * DM * 2 <= WS_WUP && WS_WUP + (size_t)UPW * DM * 2 <= WS_WDOWN && WS_WDOWN + (size_t)DM * FFN * 2 <= WS_WG && WS_WG + 32 * 16384 * 2 <= WS_CAR, "weights map");
static_assert(WS_CAR + (size_t)NCHUNK * 2 * 1024 * 8 <= WS_CIN && WS_A + (size_t)NTOK * DM * 2 <= WS_B, "carry map");
static_assert(WS_QG + (size_t)NTOK * DM * 2 <= WS_K && WS_XR + (size_t)(XR_ROWS + 64) * 1024 * 2 <= WS_END && WS_EDGE + (size_t)512 * 2 * 3 * FFN * 4 <= WS_H1A && WS_H1A + (size_t)HROWS * DM * 2 <= WS_END && WS_END <= 1024 * MiB && WS_CIN + (size_t)NCHUNK * 2 * 1024 * 4 <= WS_R0 && WS_SSQL + (size_t)NTOK * 8 * 4 <= WS_A && WS_ACT + (size_t)HROWS * FFN * 2 <= WS_EDGE && WS_EDGE + (size_t)512 * 2 * 3 * FFN * 4 <= WS_END, "B map");
constexpr int CW_BAR = 4096;

constexpr int RING_BYTES = 131072;
constexpr int LDSCTL_OFF = RING_BYTES, MISC_OFF = LDSCTL_OFF + 320;
constexpr int LDS_BYTES = 147456;

#define GAS __attribute__((address_space(1)))
#define LAS __attribute__((address_space(3)))
typedef unsigned short bf16;
typedef unsigned v4u __attribute__((ext_vector_type(4)));
typedef float f32x4 __attribute__((ext_vector_type(4)));
typedef short bf16x8 __attribute__((ext_vector_type(8)));
typedef GAS unsigned gu32;
typedef GAS unsigned long long gu64;
#define RLX_AGENT __ATOMIC_RELAXED, __HIP_MEMORY_SCOPE_AGENT
#define LDS_WAIT() asm volatile("s_waitcnt lgkmcnt(0)" ::: "memory")
#define VM_WAIT() asm volatile("s_waitcnt vmcnt(0)" ::: "memory")
__device__ __forceinline__ unsigned long long rt() { return __builtin_amdgcn_s_memrealtime(); }
__device__ __forceinline__ unsigned f2bf(float f) { unsigned u = __builtin_bit_cast(unsigned, f); return (u + 0x7fffu + ((u >> 16) & 1u)) >> 16; }
__device__ __forceinline__ unsigned pk2(float lo, float hi) { return f2bf(lo) | (f2bf(hi) << 16); }

#define XB_TMO      128
#define XB_XCNT(j)  (256  + 64 * (j))
#define XB_XSUB(j)  (1280 + 64 * (j))
#define XB_XGEN(j)  (2304 + 64 * (j))
#define XB_TOP      3328
#define XB_TOPGEN   3392
#define XCD_BAR_WORDS 3456
#define XB_SPIN_CAP (1u << 18)

__device__ __forceinline__ unsigned xb_ld(unsigned* p)              { return __hip_atomic_load(p, __ATOMIC_RELAXED, __HIP_MEMORY_SCOPE_AGENT); }
__device__ __forceinline__ unsigned xb_add(unsigned* p, unsigned v) { return __hip_atomic_fetch_add(p, v, __ATOMIC_RELAXED, __HIP_MEMORY_SCOPE_AGENT); }
__device__ __forceinline__ unsigned xb_xcc_id() { return (unsigned)__builtin_amdgcn_s_getreg((3 << 11) | 20) & 0xFu; }
#define XB_SPIN(cond, bar) do { unsigned _sp = 0; while (cond) { __builtin_amdgcn_s_sleep(1); \
    if ((++_sp & 255u) == 0u) { if (xb_ld(&(bar)[XB_TMO])) break; if (_sp > XB_SPIN_CAP) { atomicAdd(&(bar)[XB_TMO], 1u); break; } } } } while (0)

struct XcdBarrier {
    unsigned* bar; unsigned x;
    volatile LAS unsigned* st;
};

__device__ __forceinline__ XcdBarrier xcd_barrier_post(unsigned* bar, volatile LAS unsigned* st, bool t0  ) {
    XcdBarrier b; b.bar = bar; b.x = xb_xcc_id(); b.st = st;
    if (t0) (void)xb_add(&bar[XB_XCNT(b.x)], 1u);
    return b;
}
__device__ __forceinline__ void xcd_barrier_complete(unsigned* bar, unsigned x, unsigned& nloc, unsigned& nx) {
    const unsigned G = gridDim.x * gridDim.y * gridDim.z;
    unsigned sum, cnt, mine, sp = 0u;
    for (;;) {
        sum = 0u; cnt = 0u; mine = 0u;
#pragma unroll
        for (unsigned j = 0; j < 16; ++j) { const unsigned c = xb_ld(&bar[XB_XCNT(j)]); sum += c; cnt += (c > 0u) ? 1u : 0u; mine = (j == x) ? c : mine; }
        if (sum == G) break;
        __builtin_amdgcn_s_sleep(1);
        if ((++sp & 255u) == 0u) { if (xb_ld(&bar[XB_TMO])) break; if (sp > XB_SPIN_CAP) { atomicAdd(&bar[XB_TMO], 1u); break; } }
    }
    nloc = mine > 0u ? mine : 1u; nx = cnt > 0u ? cnt : 1u;
}

__device__ __forceinline__ void xcd_barrier(const XcdBarrier& b, bool t0  ) {
    asm volatile("s_waitcnt vmcnt(0)" ::: "memory");
    __syncthreads();
    if (t0) {
        unsigned* bar = b.bar;
        __builtin_amdgcn_s_waitcnt(0);
        unsigned nloc = b.st[0], nx = b.st[1];
        if (nloc == 0u) { xcd_barrier_complete(bar, b.x, nloc, nx); b.st[0] = nloc; b.st[1] = nx; }
        const unsigned old = xb_add(&bar[XB_XSUB(b.x)], 1u);
        const unsigned gen = old / nloc;
        if (old + 1u == (gen + 1u) * nloc) {
            __builtin_amdgcn_fence(__ATOMIC_RELEASE, "agent");
            asm volatile("s_waitcnt vmcnt(0)" ::: "memory");
            const unsigned og = xb_add(&bar[XB_TOP], 1u);
            const unsigned tg = og / nx;
            if (og + 1u == (tg + 1u) * nx) xb_add(&bar[XB_TOPGEN], 1u);
            else XB_SPIN(xb_ld(&bar[XB_TOPGEN]) == tg, bar);
            __builtin_amdgcn_fence(__ATOMIC_ACQUIRE, "agent");
            xb_add(&bar[XB_XGEN(b.x)], 1u);
            asm volatile("s_waitcnt vmcnt(0)" ::: "memory");
        } else {
            XB_SPIN(xb_ld(&bar[XB_XGEN(b.x)]) == gen, bar);
            __builtin_amdgcn_fence(__ATOMIC_ACQUIRE, "agent");
            asm volatile("s_waitcnt vmcnt(0)" ::: "memory");
        }
    }
    __syncthreads();
}

__device__ __forceinline__ float bf2f(unsigned short b) { return __builtin_bit_cast(float, (unsigned)b << 16); }
__device__ __forceinline__ float bf2f(short b) { return __builtin_bit_cast(float, (unsigned)(unsigned short)b << 16); }
__device__ __forceinline__ float wave_sum(float v) {
#pragma unroll
    for (int o = 1; o < 64; o <<= 1) v += __shfl_xor(v, o);
    return v;
}
__device__ __forceinline__ float wave_max(float v) {
#pragma unroll
    for (int o = 1; o < 64; o <<= 1) v = fmaxf(v, __shfl_xor(v, o));
    return v;
}
__device__ __forceinline__ float fast_exp(float x) { return __builtin_amdgcn_exp2f(x * 1.4426950408889634f); }
__device__ __forceinline__ float sigmoidf_(float x) { return __builtin_amdgcn_rcpf(1.f + fast_exp(-x)); }
__device__ __forceinline__ float gelu_tanh(float x) {
    const float z = 0.7978845608028654f * (x + 0.044715f * x * x * x);
    return x * sigmoidf_(2.f * z);
}
__device__ __forceinline__ float neg_expm1(float x) {
    const float p = x * (1.f + x * (0.5f + x * (0.16666667f + x * (0.041666668f + x * (0.0083333338f + x * 0.0013888889f)))));
    const float e = fast_exp(x) - 1.f;
    return -(fabsf(x) < 0.25f ? p : e);
}
__device__ __forceinline__ v4u pack8(const float (&v)[8]) { v4u o; o.x = pk2(v[0], v[1]); o.y = pk2(v[2], v[3]); o.z = pk2(v[4], v[5]); o.w = pk2(v[6], v[7]); return o; }

#define FIN(F, idx) ({ const __attribute__((address_space(1))) float* p_; asm("s_load_dwordx2 %0, %1, %2 ; tag %3\n\ts_waitcnt lgkmcnt(0)" : "=s"(p_) : "s"((F).kargs), "i"((idx) * 8), "s"((F).ptag)); (const float*)p_; })
struct Frame {
    LAS unsigned char* lds;
    volatile LAS unsigned* MISC;
    gu32* ctl;
    int tid, lane, wave, vcu, G;
    const __attribute__((address_space(4))) void* kargs; int ptag;
    float* out;
    unsigned char* ws;
#define WSP(T, NAME, OFF) __device__ __forceinline__ T* NAME() const { return (T*)(ws + (OFF)); }
    WSP(bf16, WIN_T, WS_WIN) WSP(bf16, WOUT_T, WS_WOUT) WSP(bf16, WUP_T, WS_WUP) WSP(bf16, WDOWN_T, WS_WDOWN) WSP(bf16, WG, WS_WG) WSP(bf16, XN, WS_A) WSP(bf16, QG, WS_QG) WSP(bf16, K, WS_K) WSP(bf16, V, WS_V)
    WSP(bf16, XR, WS_XR) WSP(bf16, ACT, WS_ACT) WSP(bf16, H1A, WS_H1A) WSP(float, EDGE, WS_EDGE) WSP(bf16, XNMETA, WS_XNMETA) WSP(bf16, KM, WS_KM) WSP(bf16, VM, WS_VM)
    WSP(float, ZM, WS_ZM) WSP(float, Q15, WS_Q15) WSP(float, GY15, WS_GY15) WSP(float, LO15, WS_LO15) WSP(float, MIXED15, WS_MIXED15) WSP(float, Y15, WS_Y15) WSP(float, G15, WS_G15) WSP(float, MQP, WS_MQP)
    WSP(float, CIN, WS_CIN) WSP(float2, CAR, WS_CAR) WSP(float, R0, WS_R0) WSP(float, RATIO, WS_RATIO) WSP(float, RL, WS_RL) WSP(float, SSQA, WS_SSQA) WSP(float, SSQL, WS_SSQL)
#undef WSP
};

template <bool UPMAP, int GAIN = 0>
__device__ __forceinline__ void p0_transpose_item(const float* W, int K, int N, bf16* WT, int row_off, LAS float* scr, int item, int lane, const float* g0 = nullptr, const float* g1 = nullptr) {
    const int nblk = N / 32, kb = item / nblk, nb = item % nblk, k0 = 64 * kb, n0 = 32 * nb;
    const int orow0 = UPMAP ? (((n0 % FFN) >> 7) << 8) + 128 * (n0 / FFN) + ((n0 % FFN) & 127) : row_off + n0;
    float wv[32];
#pragma unroll
    for (int i = 0; i < 32; ++i) { const int kk = 2 * i + (lane >> 5); wv[i] = W[(size_t)(k0 + kk) * N + n0 + (lane & 31)]; }
#pragma unroll
    for (int i = 0; i < 32; ++i) { const int kk = 2 * i + (lane >> 5); float gv = 1.f; if (GAIN == 1) gv = g0[k0 + kk]; if (GAIN == 2) gv = (k0 + kk) < 1024 ? g0[k0 + kk] : g1[k0 + kk - 1024];
        scr[kk * 33 + (lane & 31)] = wv[i] * gv; }
    LDS_WAIT(); asm volatile("" ::: "memory");
    const int c = lane & 7;
#pragma unroll
    for (int j = 0; j < 4; ++j) { const int n = (lane >> 3) + 8 * j; const LAS float* s = scr + (8 * c) * 33 + n;
        v4u o; o.x = pk2(s[0 * 33], s[1 * 33]); o.y = pk2(s[2 * 33], s[3 * 33]); o.z = pk2(s[4 * 33], s[5 * 33]); o.w = pk2(s[6 * 33], s[7 * 33]);
        *(GAS v4u*)(WT + (size_t)(orow0 + n) * K + k0 + 8 * c) = o; }
    LDS_WAIT(); asm volatile("" ::: "memory");
}
__device__ __forceinline__ void rms_row_to_bf16(const float* xrow, bf16* orow, int lane, float* rout) {
    const GAS f32x4* xr = (const GAS f32x4*)xrow + lane;
    f32x4 v[8]; float s = 0.f;
#pragma unroll
    for (int j = 0; j < 8; ++j) { v[j] = xr[64 * j]; s += (v[j].x * v[j].x + v[j].y * v[j].y) + (v[j].z * v[j].z + v[j].w * v[j].w); }
    const float r = 1.f / sqrtf(wave_sum(s) * (1.f / DM) + EPS);
    GAS unsigned long long* o8 = (GAS unsigned long long*)orow + lane;
#pragma unroll
    for (int j = 0; j < 8; ++j) o8[64 * j] = (unsigned long long)pk2(v[j].x * r, v[j].y * r) | ((unsigned long long)pk2(v[j].z * r, v[j].w * r) << 32);
    if (rout && lane == 0) *rout = r;
}
__device__ __forceinline__ void p0_prologue(Frame& F) {
    LAS float* scr = (LAS float*)(F.lds + F.wave * 16384);
    const int gw = F.vcu * NWAVES + F.wave, NGW = F.G * NWAVES;
    constexpr int I_IN = (DM / 64) * (INW / 32), I_OUT = (DM / 64) * (DM / 32), I_UP = (DM / 64) * (UPW / 32), I_DN = (FFN / 64) * (DM / 32), I_G = 32 * 8;
    constexpr int NITEMS = I_IN + I_OUT + I_UP + I_DN + I_G;
    for (int it = gw; it < NITEMS; it += NGW) {
        int r = it;
        if (r < I_IN) { p0_transpose_item<false, 1>(FIN(F, 4  ), DM, INW, F.WIN_T(), 0, scr, r, F.lane, FIN(F, 3  )); continue; } r -= I_IN;
        if (r < I_OUT) { p0_transpose_item<false, 2>(FIN(F, 16  ), DM, DM, F.WOUT_T(), 0, scr, r, F.lane, FIN(F, 14  ), FIN(F, 15  )); continue; } r -= I_OUT;
        if (r < I_UP) { p0_transpose_item<true>(FIN(F, 19  ), DM, UPW, F.WUP_T(), 0, scr, r, F.lane); continue; } r -= I_UP;
        if (r < I_DN) { p0_transpose_item<false>(FIN(F, 22  ), FFN, DM, F.WDOWN_T(), 0, scr, r, F.lane); continue; } r -= I_DN;
        {
            const int mi = r >> 3, sub = r & 7, gate = mi >> 4, dir = (mi >> 3) & 1, blk = mi & 7;
            const float* W = (gate ? FIN(F, 11  ) : FIN(F, 9  )) + (size_t)(dir * 8 + blk) * 16384;
            bf16* WT = F.WG() + (size_t)((dir * 2 + gate) * 8 + blk) * 16384;
            p0_transpose_item<false>(W, 128, 128, WT, 0, scr, sub, F.lane);
        }
    }
    {
        const float* xp = FIN(F, 0  ); const float* xs = FIN(F, 1  ); const int lane = F.lane;
        f32x4 v[8], vn[8];
#define P0_LOAD(M, V) do { const GAS f32x4* xr_ = (const GAS f32x4*)((M) < 32768 ? xp + (size_t)(M) * DM : xs + (size_t)((M) - 32768) * DM) + lane; \
            _Pragma("unroll") for (int j_ = 0; j_ < 8; ++j_) V[j_] = xr_[64 * j_]; } while (0)
        int m = gw;
        if (m < NTOK) P0_LOAD(m, v);
        for (; m < NTOK; m += NGW) {
            const int mn = m + NGW < NTOK ? m + NGW : m;
            P0_LOAD(mn, vn);
            float s = 0.f;
#pragma unroll
            for (int j = 0; j < 8; ++j) s += (v[j].x * v[j].x + v[j].y * v[j].y) + (v[j].z * v[j].z + v[j].w * v[j].w);
            const float r = 1.f / sqrtf(wave_sum(s) * (1.f / DM) + EPS);
            GAS unsigned long long* o8 = (GAS unsigned long long*)(F.XN() + (size_t)m * DM) + lane;
#pragma unroll
            for (int j = 0; j < 8; ++j) o8[64 * j] = (unsigned long long)pk2(v[j].x * r, v[j].y * r) | ((unsigned long long)pk2(v[j].z * r, v[j].w * r) << 32);
            if (lane == 0) F.R0()[m] = r;
#pragma unroll
            for (int j = 0; j < 8; ++j) v[j] = vn[j];
        }
#undef P0_LOAD
    }
    for (int m = gw; m < 16; m += NGW) rms_row_to_bf16(FIN(F, 2  ) + (size_t)m * DM, F.XNMETA() + (size_t)m * DM, F.lane, nullptr);
    const int gt = F.vcu * 512 + F.tid, NGT = F.G * 512; const v4u z4 = {0u, 0u, 0u, 0u};
    for (int i = gt; i < 12 * 48 * 128; i += NGT) { const int s = i / (48 * 128), rem = i % (48 * 128); ((GAS v4u*)(F.XR() + (size_t)xr_base(s) * 1024))[rem] = z4; }
    for (int i = gt; i < 64 * 128; i += NGT) ((GAS v4u*)(F.XR() + (size_t)XR_ROWS * 1024))[i] = z4;
    for (int i = gt; i < 2048; i += NGT) { ((GAS v4u*)F.KM())[i] = z4; ((GAS v4u*)F.VM())[i] = z4; }
}

template <int R, class Out, bool GMAP = false>
__device__ __forceinline__ void small_gemm(const LAS float* X, int K, const bf16* Wt, int N, int gw, int NGW, int lane, const Out& out) {
    for (int n = gw; n < N; n += NGW) {
        float acc[R];
#pragma unroll
        for (int r = 0; r < R; ++r) acc[r] = 0.f;
        const GAS bf16x8* wrow = (const GAS bf16x8*)(Wt + (size_t)(GMAP ? ((n >> 7) << 8) + (n & 127) : n) * K);
        for (int k8 = lane; k8 < K / 8; k8 += 64) {
            const bf16x8 w = wrow[k8]; float wf[8];
#pragma unroll
            for (int j = 0; j < 8; ++j) wf[j] = bf2f(w[j]);
#pragma unroll
            for (int r = 0; r < R; ++r) { const LAS f32x4* xp = (const LAS f32x4*)(X + r * K + k8 * 8); const f32x4 a = xp[0], b = xp[1];
                acc[r] += (a.x * wf[0] + a.y * wf[1]) + (a.z * wf[2] + a.w * wf[3]) + (b.x * wf[4] + b.y * wf[5]) + (b.z * wf[6] + b.w * wf[7]); }
        }
        float v = 0.f;
#pragma unroll
        for (int r = 0; r < R; ++r) { const float s = wave_sum(acc[r]); v = (lane == r) ? s : v; }
        out(n, lane, v);
    }
}
struct OutMetaZ { float* ZM; bf16* XR;
    __device__ __forceinline__ void operator()(int n, int lane, float v) const {
        if (lane < 16) { ZM[lane * INW + n] = v;
            if (n >= 1536 && n < 2560) { const unsigned short b = (unsigned short)f2bf(v); const int c = n - 1536;
                for (int s = 0; s < 12; ++s) XR[(size_t)(xr_base(s) + 48 + lane) * 1024 + c] = b; } }
    } };
struct OutRows { float* Y; int ld; int R;
    __device__ __forceinline__ void operator()(int n, int lane, float v) const { if (lane < R) Y[(size_t)lane * ld + n] = v; } };

__device__ __forceinline__ void p1_meta_z(Frame& F) {
    LAS float* X = (LAS float*)F.lds;
    for (int i = F.tid; i < 16 * DM / 8; i += 512) { const bf16x8 v = ((const GAS bf16x8*)F.XNMETA())[i];
        ((LAS f32x4*)X)[2 * i] = (f32x4){bf2f(v[0]), bf2f(v[1]), bf2f(v[2]), bf2f(v[3])}; ((LAS f32x4*)X)[2 * i + 1] = (f32x4){bf2f(v[4]), bf2f(v[5]), bf2f(v[6]), bf2f(v[7])}; }
    __syncthreads();
    const OutMetaZ o{F.ZM(), F.XR()};
    small_gemm<16, OutMetaZ>(X, DM, F.WIN_T(), INW, F.vcu * NWAVES + F.wave, F.G * NWAVES, F.lane, o);
    __syncthreads();
}
typedef float f32x16 __attribute__((ext_vector_type(16)));
constexpr int LRU_XC0 = 0, LRU_XC_BUF = 17408, LRU_XC_STRIDE = 272;
constexpr int LRU_CW = 34816;
constexpr int LRU_HF = 37376, LRU_HB = LRU_HF + 32768;
__device__ __forceinline__ int crow16(int r, int hi) { return (r & 3) + 8 * (r >> 2) + 4 * hi; }

template <int DIR>
__device__ __forceinline__ void scan_tile(const float (&a)[16], const float (&u)[16], float& carry, float& ptot, float (&h)[16], bool up) {
    float HL[16], PL[16], As[4], Hs[4];
#pragma unroll
    for (int j = 0; j < 4; ++j) {
        float hl = 0.f, p = 1.f;
#pragma unroll
        for (int ii = 0; ii < 4; ++ii) { const int idx = 4 * j + (DIR == 0 ? ii : 3 - ii); hl = a[idx] * hl + u[idx]; p *= a[idx]; HL[idx] = hl; PL[idx] = p; }
        As[j] = p; Hs[j] = hl;
    }
    float Alo[4], Ahi[4], Hlo[4], Hhi[4];
#pragma unroll
    for (int j = 0; j < 4; ++j) {
        { const unsigned x = __float_as_uint(As[j]); auto rr = __builtin_amdgcn_permlane32_swap(x, x, false, false); Alo[j] = __uint_as_float(rr[0]); Ahi[j] = __uint_as_float(rr[1]); }
        { const unsigned x = __float_as_uint(Hs[j]); auto rr = __builtin_amdgcn_permlane32_swap(x, x, false, false); Hlo[j] = __uint_as_float(rr[0]); Hhi[j] = __uint_as_float(rr[1]); }
    }
    float cin[4]; float c = carry;
    if (DIR == 0) {
#pragma unroll
        for (int j = 0; j < 4; ++j) { const float c_lo = c; c = Alo[j] * c + Hlo[j]; const float c_hi = c; c = Ahi[j] * c + Hhi[j]; cin[j] = up ? c_hi : c_lo; }
    } else {
#pragma unroll
        for (int j = 3; j >= 0; --j) { const float c_hi = c; c = Ahi[j] * c + Hhi[j]; const float c_lo = c; c = Alo[j] * c + Hlo[j]; cin[j] = up ? c_hi : c_lo; }
    }
    carry = c;
#pragma unroll
    for (int j = 0; j < 4; ++j) ptot *= Alo[j] * Ahi[j];
#pragma unroll
    for (int idx = 0; idx < 16; ++idx) h[idx] = HL[idx] + PL[idx] * cin[idx >> 2];
}

__device__ __forceinline__ void lru_decode(int cg, int& seq, int& c) { if (cg < 520) { seq = cg / 65; c = cg - seq * 65; } else { const int c2 = cg - 520; seq = c2 / 129; c = c2 - seq * 129; seq += 8; } }
template <int PASS>
__device__ __forceinline__ void lru_phase(Frame& F, bf16* gout) {
    LAS unsigned char* L = F.lds;
    const int tid = F.tid, lane = F.lane, wave = F.wave;
    const int n = F.vcu & 7, ngrp = F.G >> 3;
    { const float* cw = FIN(F, 7  ); const float* cb = FIN(F, 8  );
      for (int i = tid; i < 640; i += 512) { const int k = i >> 7, ch = i & 127; ((LAS float*)(L + LRU_CW))[i] = k < 4 ? cw[k * 1024 + n * 128 + ch] : cb[n * 128 + ch]; } }
    const int d = wave >> 2, g4 = wave & 3, r32 = lane & 31, hi = lane >> 5, chl = g4 * 32 + r32, chg = n * 128 + chl;
    bf16x8 br[8], bi[8];
    { const bf16* wr_ = F.WG() + (size_t)((d * 2 + 0) * 8 + n) * 16384 + chl * 128 + hi * 8;
      const bf16* wi_ = F.WG() + (size_t)((d * 2 + 1) * 8 + n) * 16384 + chl * 128 + hi * 8;
#pragma unroll
      for (int ks = 0; ks < 8; ++ks) { br[ks] = *(const GAS bf16x8*)(wr_ + ks * 16); bi[ks] = *(const GAS bf16x8*)(wi_ + ks * 16); } }
    constexpr float L2E = 1.4426950408889634f;
    const float nb_r = -L2E * FIN(F, 10  )[d * 1024 + chg], nb_i = -L2E * FIN(F, 12  )[d * 1024 + chg];
    const float spl = 8.f * L2E * log1pf(expf(-FIN(F, 13  )[d * 1024 + chg]));
    const int tau0 = tid >> 4, co = (tid & 15) * 8;
    bf16x8 xv[2][4];
#define LRU_PREFETCH(cgx) do { int s_, c_; lru_decode((cgx), s_, c_); const int xb_ = xr_base(s_); \
        _Pragma("unroll") for (int it_ = 0; it_ < 2; ++it_) _Pragma("unroll") for (int k_ = 0; k_ < 4; ++k_) { int row_ = xb_ + c_ * 64 + tau0 + 32 * it_ + k_ - 2; row_ = row_ < 0 ? 0 : row_; \
            xv[it_][k_] = *(const GAS bf16x8*)(F.XR() + (size_t)row_ * 1024 + n * 128 + co); } } while (0)
    int cg = F.vcu < 8 * ngrp ? F.vcu >> 3 : NCHUNK;
    if (cg < NCHUNK) LRU_PREFETCH(cg);
    __syncthreads();
    for (int ui = 0; cg < NCHUNK; cg += ngrp, ++ui) {
        int seq, c; lru_decode(cg, seq, c);
        LAS unsigned char* XC = L + LRU_XC0 + (ui & 1) * LRU_XC_BUF;
        float carry = 0.f, ptot = 1.f;
        if (PASS == 2) carry = F.CIN()[((size_t)cg * 2 + d) * 1024 + chg];
#pragma unroll
        for (int it = 0; it < 2; ++it) {
            const int tau = tau0 + 32 * it; float xc[8];
            { const LAS f32x4* cb = (const LAS f32x4*)(L + LRU_CW + (4 * 128 + co) * 4); const f32x4 b0 = cb[0], b1 = cb[1];
              xc[0] = b0.x; xc[1] = b0.y; xc[2] = b0.z; xc[3] = b0.w; xc[4] = b1.x; xc[5] = b1.y; xc[6] = b1.z; xc[7] = b1.w; }
#pragma unroll
            for (int k = 0; k < 4; ++k) { const LAS f32x4* wp = (const LAS f32x4*)(L + LRU_CW + (k * 128 + co) * 4); const f32x4 w0 = wp[0], w1 = wp[1]; const bf16x8 v = xv[it][k];
                xc[0] += w0.x * bf2f(v[0]); xc[1] += w0.y * bf2f(v[1]); xc[2] += w0.z * bf2f(v[2]); xc[3] += w0.w * bf2f(v[3]);
                xc[4] += w1.x * bf2f(v[4]); xc[5] += w1.y * bf2f(v[5]); xc[6] += w1.z * bf2f(v[6]); xc[7] += w1.w * bf2f(v[7]); }
            if (c == 0 && tau < 48) {
#pragma unroll
                for (int j = 0; j < 8; ++j) xc[j] = 0.f;
            }
            *(LAS v4u*)(XC + tau * LRU_XC_STRIDE + co * 2) = pack8(xc);
        }
        bf16x8 gv[2];
        const int row0 = seq_first_row(seq) + 64 * (c - 1);
        if (PASS == 2) { if (c > 0) {
#pragma unroll
            for (int it = 0; it < 2; ++it) gv[it] = *(const GAS bf16x8*)(F.QG() + (size_t)(row0 + tau0 + 32 * it) * DM + 1024 + n * 128 + co); } }
        __syncthreads();
        if (cg + ngrp < NCHUNK) LRU_PREFETCH(cg + ngrp);
        f32x16 arT[2], aiT[2];
#pragma unroll
        for (int tt = 0; tt < 2; ++tt) {
            const int tile = d ? 1 - tt : tt;
            f32x16 ar = {}, ai = {};
#pragma unroll
            for (int ks = 0; ks < 8; ++ks) {
                const bf16x8 a = *(const LAS bf16x8*)(XC + (tile * 32 + r32) * LRU_XC_STRIDE + (ks * 16 + hi * 8) * 2);
                ar = __builtin_amdgcn_mfma_f32_32x32x16_bf16(a, br[ks], ar, 0, 0, 0);
                ai = __builtin_amdgcn_mfma_f32_32x32x16_bf16(a, bi[ks], ai, 0, 0, 0);
            }
            arT[tt] = ar; aiT[tt] = ai;
        }
#pragma unroll
        for (int tt = 0; tt < 2; ++tt) {
            const int tile = d ? 1 - tt : tt;
            const f32x16 ar = arT[tt], ai = aiT[tt];
            float av[16], uv[16], hv[16];
            typedef float f32x2 __attribute__((ext_vector_type(2)));
#pragma unroll
            for (int r = 0; r < 16; r += 2) {
                const int tau0_ = tile * 32 + crow16(r, hi);
                const f32x2 xc2 = {bf2f(*(const LAS unsigned short*)(XC + tau0_ * LRU_XC_STRIDE + chl * 2)), bf2f(*(const LAS unsigned short*)(XC + (tau0_ + 1) * LRU_XC_STRIDE + chl * 2))};
                const f32x2 tr = (f32x2){ar[r], ar[r + 1]} * (f32x2){-L2E, -L2E} + (f32x2){nb_r, nb_r};
                const f32x2 ti = (f32x2){ai[r], ai[r + 1]} * (f32x2){-L2E, -L2E} + (f32x2){nb_i, nb_i};
                const f32x2 dr = (f32x2){__builtin_amdgcn_exp2f(tr.x), __builtin_amdgcn_exp2f(tr.y)} + (f32x2){1.f, 1.f};
                const f32x2 di = (f32x2){__builtin_amdgcn_exp2f(ti.x), __builtin_amdgcn_exp2f(ti.y)} + (f32x2){1.f, 1.f};
                const f32x2 rg = {__builtin_amdgcn_rcpf(dr.x), __builtin_amdgcn_rcpf(dr.y)}, ig = {__builtin_amdgcn_rcpf(di.x), __builtin_amdgcn_rcpf(di.y)};
                const f32x2 la = rg * (f32x2){-spl, -spl};
                const f32x2 a = {__builtin_amdgcn_exp2f(la.x), __builtin_amdgcn_exp2f(la.y)};
                const f32x2 t = (f32x2){1.f, 1.f} - a * a;
                const f32x2 m = {__builtin_amdgcn_sqrtf(t.x), __builtin_amdgcn_sqrtf(t.y)};
                const f32x2 u = m * (ig * xc2);
                av[r] = a.x; av[r + 1] = a.y; uv[r] = u.x; uv[r + 1] = u.y;
            }
            if (d == 0) scan_tile<0>(av, uv, carry, ptot, hv, hi != 0); else scan_tile<1>(av, uv, carry, ptot, hv, hi != 0);
            if (PASS == 2) {
#pragma unroll
                for (int r = 0; r < 16; ++r) { const int tau = tile * 32 + crow16(r, hi); *(LAS float*)(L + (d ? LRU_HB : LRU_HF) + (tau * 128 + chl) * 4) = hv[r]; }
            }
        }
        if (PASS == 1) { if (hi == 0) F.CAR()[((size_t)cg * 2 + d) * 1024 + chg] = make_float2(ptot, carry); }
        if (PASS == 2) {
            __syncthreads();
            if (c > 0) {
#pragma unroll
                for (int it = 0; it < 2; ++it) {
                    const int tau = tau0 + 32 * it; const bf16x8 g8 = gv[it];
                    const LAS f32x4* hf = (const LAS f32x4*)(L + LRU_HF + (tau * 128 + co) * 4); const LAS f32x4* hb = (const LAS f32x4*)(L + LRU_HB + (tau * 128 + co) * 4);
                    const f32x4 f0 = hf[0], f1 = hf[1], b0 = hb[0], b1 = hb[1];
                    float o[8];
                    o[0] = (f0.x + b0.x) * gelu_tanh(bf2f(g8[0])); o[1] = (f0.y + b0.y) * gelu_tanh(bf2f(g8[1])); o[2] = (f0.z + b0.z) * gelu_tanh(bf2f(g8[2])); o[3] = (f0.w + b0.w) * gelu_tanh(bf2f(g8[3]));
                    o[4] = (f1.x + b1.x) * gelu_tanh(bf2f(g8[4])); o[5] = (f1.y + b1.y) * gelu_tanh(bf2f(g8[5])); o[6] = (f1.z + b1.z) * gelu_tanh(bf2f(g8[6])); o[7] = (f1.w + b1.w) * gelu_tanh(bf2f(g8[7]));
                    *(GAS v4u*)(gout + (size_t)(row0 + tau) * DM + 1024 + n * 128 + co) = pack8(o);
                    float sq = (o[0] * o[0] + o[1] * o[1]) + (o[2] * o[2] + o[3] * o[3]) + (o[4] * o[4] + o[5] * o[5]) + (o[6] * o[6] + o[7] * o[7]);
                    sq += __shfl_xor(sq, 1); sq += __shfl_xor(sq, 2); sq += __shfl_xor(sq, 4); sq += __shfl_xor(sq, 8);
                    if ((tid & 15) == 0) F.SSQL()[(size_t)(row0 + tau) * 8 + n] = sq;
                }
            } else if (tid < 128) {
                const float hf = *(const LAS float*)(L + LRU_HF + (63 * 128 + tid) * 4), hb = *(const LAS float*)(L + LRU_HB + (63 * 128 + tid) * 4);
                F.LO15()[seq * 1024 + n * 128 + tid] = (hf + hb) * gelu_tanh(F.GY15()[n * 128 + tid]);
            }
        }
    }
    __syncthreads();
#undef LRU_PREFETCH
}
__device__ __forceinline__ void lru_propagate(Frame& F) {
    const int gid = F.vcu * 512 + F.tid;
    if (gid < 12 * 2048) {
        const int s = gid >> 11, d = (gid >> 10) & 1, ch = gid & 1023; const int nch = s < 8 ? 65 : 129, cb = chunk_base(s);
        const float2* car = F.CAR() + (size_t)d * 1024 + ch; float* cinp = F.CIN() + (size_t)d * 1024 + ch;
        float cin = 0.f;
        float2 pa[16], pb[16];
#define PRP_LOAD(P, B0) do { _Pragma("unroll") for (int i = 0; i < 16; ++i) { int cc = (B0) + i; cc = cc < nch ? cc : nch - 1; const int c = d ? nch - 1 - cc : cc; P[i] = car[(size_t)(cb + c) * 2048]; } } while (0)
#define PRP_RUN(P, B0) do { _Pragma("unroll") for (int i = 0; i < 16; ++i) { const int cc = (B0) + i; const int c = d ? nch - 1 - cc : cc; if (cc < nch) { cinp[(size_t)(cb + c) * 2048] = cin; cin = P[i].x * cin + P[i].y; } } } while (0)
        PRP_LOAD(pa, 0);
        for (int b0 = 0; b0 < nch; b0 += 32) {
            PRP_LOAD(pb, b0 + 16);
            PRP_RUN(pa, b0);
            PRP_LOAD(pa, b0 + 32);
            PRP_RUN(pb, b0 + 16);
        }
#undef PRP_LOAD
#undef PRP_RUN
    }
}

__device__ __forceinline__ void k_rope_pass(Frame& F, bf16* Kout) {
    const int gw = F.vcu * NWAVES + F.wave, NGW = F.G * NWAVES, sub = F.lane >> 4, l16 = F.lane & 15;
    const int c0 = 8 * l16, p = l16 >> 3, half = (l16 >> 2) & 1, i0 = 8 * (l16 & 3);
    float inv[8], gk[8];
#pragma unroll
    for (int j = 0; j < 8; ++j) { inv[j] = __builtin_amdgcn_exp2f(-(float)(i0 + j) * (13.287712379549449f / 32.f)) * 0.15915494309189535f; gk[j] = FIN(F, 6  )[c0 + j]; }
    constexpr int NIT = NTOK * 2 / 4;
    bf16x8 v, vn;
    if (gw < NIT) { const int item = gw * 4 + sub; v = *(const GAS bf16x8*)(F.K() + (size_t)(item >> 1) * 256 + (item & 1) * 128 + c0); }
    for (int it = gw; it < NIT; it += NGW) {
        const int item = it * 4 + sub, row = item >> 1, hk = item & 1;
        { const int nit = it + NGW < NIT ? it + NGW : it; const int ni = nit * 4 + sub; vn = *(const GAS bf16x8*)(F.K() + (size_t)(ni >> 1) * 256 + (ni & 1) * 128 + c0); }
        const int s = row_seq(row), t = row - seq_first_row(s); const float pos = (float)(p ? (t & 63) : (t >> 6));
        float x[8]; float ss = 0.f;
#pragma unroll
        for (int j = 0; j < 8; ++j) { x[j] = bf2f(v[j]); ss += x[j] * x[j]; }
        ss += __shfl_xor(ss, 1); ss += __shfl_xor(ss, 2); ss += __shfl_xor(ss, 4); ss += __shfl_xor(ss, 8);
        const float rs = 1.f / sqrtf(ss * (1.f / 128.f) + EPS); float o[8];
#pragma unroll
        for (int j = 0; j < 8; ++j) { x[j] *= rs * gk[j]; const float pr = __shfl_xor(x[j], 4);
            float rev = pos * inv[j]; rev -= floorf(rev); const float sn = __builtin_amdgcn_sinf(rev), cs = __builtin_amdgcn_cosf(rev);
            o[j] = half ? x[j] * cs + pr * sn : x[j] * cs - pr * sn; }
        *(GAS v4u*)(Kout + (size_t)row * 256 + hk * 128 + c0) = pack8(o);
        v = vn;
    }
}
__device__ __forceinline__ void p3_meta_job(Frame& F) {
    for (int pr = F.wave; pr < 32; pr += 8) { const int r = pr >> 1, hk = pr & 1; const float* z = F.ZM() + r * INW + 1024 + hk * 128;
        const float a = z[F.lane], b = z[F.lane + 64]; const float rs = 1.f / sqrtf(wave_sum(a * a + b * b) * (1.f / 128.f) + EPS);
        F.KM()[r * 256 + hk * 128 + F.lane] = (bf16)f2bf(a * rs * FIN(F, 6  )[F.lane]); F.KM()[r * 256 + hk * 128 + F.lane + 64] = (bf16)f2bf(b * rs * FIN(F, 6  )[F.lane + 64]); }
    for (int i = F.tid; i < 16 * 256; i += 512) F.VM()[i] = (bf16)f2bf(F.ZM()[(i >> 8) * INW + 1280 + (i & 255)]);
    { const int h = F.wave; const float* z = F.ZM() + 15 * INW + h * 128; const float a = z[F.lane], b = z[F.lane + 64];
      const float rs = 1.f / sqrtf(wave_sum(a * a + b * b) * (1.f / 128.f) + EPS);
      F.Q15()[h * 128 + F.lane] = a * rs * FIN(F, 5  )[F.lane]; F.Q15()[h * 128 + F.lane + 64] = b * rs * FIN(F, 5  )[F.lane + 64]; }
    for (int i = F.tid; i < 1024; i += 512) F.GY15()[i] = F.ZM()[15 * INW + 2560 + i];
}

__device__ __forceinline__ void metaq_item(Frame& F, int it) {
    int s, kvh, j; if (it < 256) { s = it >> 5; kvh = (it >> 4) & 1; j = it & 15; } else { const int t2 = it - 256; s = 8 + (t2 >> 6); kvh = (t2 >> 5) & 1; j = t2 & 31; }
    LAS float* q4 = (LAS float*)F.lds;
    LAS float* sc = q4 + 512;
    LAS float* red = sc + 4 * 288;
    const int tid = F.tid, nk = 256 + (j == 0 ? 16 : 0), row0 = seq_first_row(s) + 256 * j;
    q4[tid] = F.Q15()[kvh * 512 + tid];
    __syncthreads();
    if (tid < nk) {
        const bf16* kp = tid < 256 ? F.K() + (size_t)(row0 + tid) * 256 + kvh * 128 : F.KM() + (tid - 256) * 256 + kvh * 128;
        float d0 = 0.f, d1 = 0.f, d2 = 0.f, d3 = 0.f;
#pragma unroll 4
        for (int cc = 0; cc < 16; ++cc) { const bf16x8 kv = ((const GAS bf16x8*)kp)[cc];
#pragma unroll
            for (int e = 0; e < 8; ++e) { const float kf = bf2f(kv[e]); d0 += kf * q4[cc * 8 + e]; d1 += kf * q4[128 + cc * 8 + e]; d2 += kf * q4[256 + cc * 8 + e]; d3 += kf * q4[384 + cc * 8 + e]; } }
        const float SC = 0.088388347648318440f;
        sc[tid] = d0 * SC; sc[288 + tid] = d1 * SC; sc[576 + tid] = d2 * SC; sc[864 + tid] = d3 * SC;
    }
    __syncthreads();
    if (F.wave < 4) { LAS float* sh = sc + F.wave * 288; float m = -INFINITY;
        for (int k = F.lane; k < nk; k += 64) m = fmaxf(m, sh[k]);
        m = wave_max(m); float l = 0.f;
        for (int k = F.lane; k < nk; k += 64) { const float p = __expf(sh[k] - m); sh[k] = p; l += p; }
        l = wave_sum(l);
        if (F.lane == 0) { red[F.wave * 2] = m; red[F.wave * 2 + 1] = l; } }
    __syncthreads();
    {
        const int kg = tid >> 4, oc = tid & 15; float o[4][8];
#pragma unroll
        for (int h = 0; h < 4; ++h)
#pragma unroll
            for (int e = 0; e < 8; ++e) o[h][e] = 0.f;
        const bf16* vp = F.V() + (size_t)(row0 + kg * 8) * 256 + kvh * 128 + oc * 8;
        bf16x8 vv[8];
#pragma unroll
        for (int k = 0; k < 8; ++k) vv[k] = *(const GAS bf16x8*)(vp + (size_t)k * 256);
#pragma unroll
        for (int k = 0; k < 8; ++k) { const float p0 = sc[kg * 8 + k], p1 = sc[288 + kg * 8 + k], p2 = sc[576 + kg * 8 + k], p3 = sc[864 + kg * 8 + k];
#pragma unroll
            for (int e = 0; e < 8; ++e) { const float vf = bf2f(vv[k][e]); o[0][e] += p0 * vf; o[1][e] += p1 * vf; o[2][e] += p2 * vf; o[3][e] += p3 * vf; } }
        if (j == 0 && kg < 16) { const int k = kg; const bf16x8 v1 = *(const GAS bf16x8*)(F.VM() + k * 256 + kvh * 128 + oc * 8);
            const float p0 = sc[256 + k], p1 = sc[288 + 256 + k], p2 = sc[576 + 256 + k], p3 = sc[864 + 256 + k];
#pragma unroll
            for (int e = 0; e < 8; ++e) { const float vf = bf2f(v1[e]); o[0][e] += p0 * vf; o[1][e] += p1 * vf; o[2][e] += p2 * vf; o[3][e] += p3 * vf; } }
        LAS float* part = sc + 4 * 288 + 16;
#pragma unroll
        for (int h = 0; h < 4; ++h) { LAS f32x4* pp = (LAS f32x4*)(part + (kg * 4 + h) * 128 + oc * 8); pp[0] = (f32x4){o[h][0], o[h][1], o[h][2], o[h][3]}; pp[1] = (f32x4){o[h][4], o[h][5], o[h][6], o[h][7]}; }
        __syncthreads();
        const int h = tid >> 7, d = tid & 127; float os = 0.f;
#pragma unroll 8
        for (int g = 0; g < 32; ++g) os += part[(g * 4 + h) * 128 + d];
        float* dst = F.MQP() + ((size_t)it * 4 + h) * 132; dst[2 + d] = os; if (d == 0) { dst[0] = red[h * 2]; dst[1] = red[h * 2 + 1]; } }
    __syncthreads();
}
__device__ __forceinline__ void attn_phase(Frame& F, char* lds_generic, bf16* obase) {
    const int nr = F.G == 256 ? 8 : (2048 + F.G - 1) / F.G;
    for (int r = 0; r < nr; ++r) {
        int s, kvh, hq, qb, S;
        if (F.G == 256) {
            const int x = F.vcu >> 5, i = F.vcu & 31;
            if (r < 4) { const int pair = 2 * x + (r >> 1); s = pair >> 1; kvh = pair & 1; const int u = (r & 1) * 32 + i; hq = u >> 4; qb = u & 15; S = 4096; }
            else { const int pair = x; s = 8 + (pair >> 1); kvh = pair & 1; const int u = (r - 4) * 32 + i; hq = u >> 5; qb = u & 31; S = 8192; }
        } else {
            const int U = F.vcu + F.G * r; if (U >= 2048) break;
            if (U < 1024) { const int pair = U >> 6, u = U & 63; s = pair >> 1; kvh = pair & 1; hq = u >> 4; qb = u & 15; S = 4096; }
            else { const int pair = (U - 1024) >> 7, u = (U - 1024) & 127; s = 8 + (pair >> 1); kvh = pair & 1; hq = u >> 5; qb = u & 31; S = 8192; }
        }
        const int row0 = seq_first_row(s), h = kvh * 4 + hq;
        bf16* qp = F.QG() + (size_t)(row0 + qb * 256) * DM + h * 128;
        attn::attn_unit(qp, F.K() + (size_t)row0 * 256 + kvh * 128, F.V() + (size_t)row0 * 256 + kvh * 128, F.KM() + kvh * 128, F.VM() + kvh * 128, obase + (size_t)(row0 + qb * 256) * DM + h * 128, S / 64 + 1, lds_generic, FIN(F, 5  ), qb * 256, F.SSQA() + (size_t)(row0 + qb * 256) * 8 + h, F.wave);
    }
}

__device__ __forceinline__ void p5_ratio(Frame& F) {
    for (int row = F.vcu * 512 + F.tid; row < NTOK; row += F.G * 512) {
        const GAS f32x4* pa = (const GAS f32x4*)(F.SSQA() + (size_t)row * 8); const GAS f32x4* pl = (const GAS f32x4*)(F.SSQL() + (size_t)row * 8);
        const f32x4 a0 = pa[0], a1 = pa[1], l0 = pl[0], l1 = pl[1];
        const float sa = ((a0.x + a0.y) + (a0.z + a0.w)) + ((a1.x + a1.y) + (a1.z + a1.w)), sl = ((l0.x + l0.y) + (l0.z + l0.w)) + ((l1.x + l1.y) + (l1.z + l1.w));
        const float qa = sqrtf(sa * (1.f / 1024.f) + EPS), ql = sqrtf(sl * (1.f / 1024.f) + EPS);
        F.RATIO()[row] = ql / qa; F.RL()[row] = 1.f / ql;
    }
}
__device__ __forceinline__ void p5_meta_job(Frame& F, int s) {
    LAS float* buf = (LAS float*)F.lds; LAS float* red = buf + 2048; const int tid = F.tid;
    {
        const int nj = s < 8 ? 16 : 32;
        for (int e = tid; e < 1024; e += 512) { const int h = e >> 7, d = e & 127, kvh = h >> 2, hq = h & 3;
            const int it0 = s < 8 ? s * 32 + kvh * 16 : 256 + (s - 8) * 64 + kvh * 32;
            float M = -INFINITY;
#pragma unroll 16
            for (int j = 0; j < nj; ++j) M = fmaxf(M, F.MQP()[((size_t)(it0 + j) * 4 + hq) * 132]);
            float Ls = 0.f, O = 0.f;
#pragma unroll 16
            for (int j = 0; j < nj; ++j) { const float* p = F.MQP() + ((size_t)(it0 + j) * 4 + hq) * 132; const float w = __expf(p[0] - M); Ls += p[1] * w; O += p[2 + d] * w; }
            buf[e] = O / Ls; }
        for (int e = tid; e < 1024; e += 512) buf[1024 + e] = F.LO15()[s * 1024 + e];
        __syncthreads();
        { float ss = 0.f; for (int k = F.lane; k < 256; k += 64) { const float v = buf[F.wave * 256 + k]; ss += v * v; } ss = wave_sum(ss); if (F.lane == 0) red[F.wave] = ss; }
        __syncthreads();
        const float ra = 1.f / sqrtf((red[0] + red[1] + red[2] + red[3]) * (1.f / 1024.f) + EPS), rl = 1.f / sqrtf((red[4] + red[5] + red[6] + red[7]) * (1.f / 1024.f) + EPS);
        for (int e = tid; e < 2048; e += 512) F.MIXED15()[s * 2048 + e] = e < 1024 ? buf[e] * ra : buf[e] * rl;
        __syncthreads();
    }
}
__device__ __forceinline__ void p6_meta_y(Frame& F) {
    LAS float* X = (LAS float*)F.lds;
    for (int i = F.tid; i < 12 * DM / 4; i += 512) ((LAS f32x4*)X)[i] = ((const GAS f32x4*)F.MIXED15())[i];
    __syncthreads();
    const OutRows o{F.Y15(), DM, 12};
    small_gemm<12, OutRows>(X, DM, F.WOUT_T(), DM, F.vcu * NWAVES + F.wave, F.G * NWAVES, F.lane, o);
    __syncthreads();
}

__device__ __forceinline__ void p7_rows(Frame& F, int q, int gw, int NGW) {
    const int lane = F.lane;
    f32x4 gm[8], gf[8];
    { const float* a = FIN(F, 17  ); const float* b = FIN(F, 18  );
#pragma unroll
      for (int i = 0; i < 4; ++i) { const int e0 = (lane + 64 * i) * 8; gm[2 * i] = *(const GAS f32x4*)(a + e0); gm[2 * i + 1] = *(const GAS f32x4*)(a + e0 + 4); gf[2 * i] = *(const GAS f32x4*)(b + e0); gf[2 * i + 1] = *(const GAS f32x4*)(b + e0 + 4); } }
    bf16* h1base = q == 0 ? F.H1A() : F.XN();
    bf16x8 yv[4], yn[4]; v4u xv[4], xw[4]; float r0c = 1.f, r0n = 1.f;
    const int rend = (q + 1) * HROWS;
    int row = q * HROWS + gw;
#define P7_LOAD(R, Y, X, RV) do { const GAS bf16x8* y_ = (const GAS bf16x8*)((const bf16*)(F.out + (size_t)(R) * DM)); const GAS v4u* x_ = (const GAS v4u*)(F.XN() + (size_t)(R) * DM); \
        _Pragma("unroll") for (int i_ = 0; i_ < 4; ++i_) { Y[i_] = y_[lane + 64 * i_]; X[i_] = x_[lane + 64 * i_]; } RV = F.R0()[(R)]; } while (0)
    if (row < rend) P7_LOAD(row, yv, xv, r0c);
    for (; row < rend; row += NGW) {
        const int nrow = row + NGW < rend ? row + NGW : row;
        P7_LOAD(nrow, yn, xw, r0n);
        GAS v4u* xn = (GAS v4u*)(F.XN() + (size_t)row * DM);
        GAS v4u* h1row = (GAS v4u*)(h1base + (size_t)(row - q * HROWS) * DM);
        const float ir0 = 1.f / r0c;
        float hv[32]; float ss = 0.f;
#pragma unroll
        for (int i = 0; i < 4; ++i)
#pragma unroll
            for (int j = 0; j < 8; ++j) { hv[8 * i + j] = bf2f(yv[i][j]); ss += hv[8 * i + j] * hv[8 * i + j]; }
        const float r1 = 1.f / sqrtf(wave_sum(ss) * (1.f / DM) + EPS); float s2 = 0.f;
#pragma unroll
        for (int i = 0; i < 4; ++i) {
            const v4u xq = xv[i]; const f32x4 g0 = gm[2 * i], g1 = gm[2 * i + 1];
            const float xf[8] = {__builtin_bit_cast(float, xq.x << 16), __builtin_bit_cast(float, xq.x & 0xffff0000u), __builtin_bit_cast(float, xq.y << 16), __builtin_bit_cast(float, xq.y & 0xffff0000u),
                                 __builtin_bit_cast(float, xq.z << 16), __builtin_bit_cast(float, xq.z & 0xffff0000u), __builtin_bit_cast(float, xq.w << 16), __builtin_bit_cast(float, xq.w & 0xffff0000u)};
            const float gg[8] = {g0.x, g0.y, g0.z, g0.w, g1.x, g1.y, g1.z, g1.w};
            float hb[8];
#pragma unroll
            for (int j = 0; j < 8; ++j) { hb[j] = xf[j] * ir0 + hv[8 * i + j] * r1 * gg[j]; hv[8 * i + j] = hb[j]; s2 += hb[j] * hb[j]; }
            h1row[lane + 64 * i] = pack8(hb);
        }
        const float r2 = 1.f / sqrtf(wave_sum(s2) * (1.f / DM) + EPS);
#pragma unroll
        for (int i = 0; i < 4; ++i) { const f32x4 g0 = gf[2 * i], g1 = gf[2 * i + 1];
            float t[8]; t[0] = hv[8 * i + 0] * r2 * g0.x; t[1] = hv[8 * i + 1] * r2 * g0.y; t[2] = hv[8 * i + 2] * r2 * g0.z; t[3] = hv[8 * i + 3] * r2 * g0.w;
            t[4] = hv[8 * i + 4] * r2 * g1.x; t[5] = hv[8 * i + 5] * r2 * g1.y; t[6] = hv[8 * i + 6] * r2 * g1.z; t[7] = hv[8 * i + 7] * r2 * g1.w;
            xn[lane + 64 * i] = pack8(t); }
#pragma unroll
        for (int i = 0; i < 4; ++i) { yv[i] = yn[i]; xv[i] = xw[i]; }
        r0c = r0n;
    }
#undef P7_LOAD
}
__device__ __forceinline__ void p7_meta_g(Frame& F) {
    LAS float* X = (LAS float*)F.lds;
    for (int r = F.wave; r < 12; r += 8) {
        const float* y = F.Y15() + r * DM; const float* xm = FIN(F, 2  ) + 15 * DM;
        float hv[32]; float ss = 0.f;
#pragma unroll
        for (int i = 0; i < 32; ++i) { hv[i] = y[F.lane + 64 * i]; ss += hv[i] * hv[i]; }
        const float r1 = 1.f / sqrtf(wave_sum(ss) * (1.f / DM) + EPS); float s2 = 0.f;
#pragma unroll
        for (int i = 0; i < 32; ++i) { const int e = F.lane + 64 * i; hv[i] = xm[e] + hv[i] * r1 * FIN(F, 17  )[e]; s2 += hv[i] * hv[i]; }
        const float r2 = 1.f / sqrtf(wave_sum(s2) * (1.f / DM) + EPS);
#pragma unroll
        for (int i = 0; i < 32; ++i) { const int e = F.lane + 64 * i; X[r * DM + e] = hv[i] * r2 * FIN(F, 18  )[e]; }
    }
    __syncthreads();
    const OutRows o{F.G15(), FFN, 12};
    small_gemm<12, OutRows, true>(X, DM, F.WUP_T(), FFN, F.vcu * NWAVES + F.wave, F.G * NWAVES, F.lane, o);
    __syncthreads();
}

__device__ __forceinline__ void p9_fix(Frame& F, int h) {
    constexpr int NOCT = FFN / 8, NBW = 512 * 2;
    const int gid = F.vcu * 512 + F.tid, oct = gid % NOCT, grp = gid / NOCT, NGRP = (F.G * 512) / NOCT;
    if (grp >= NGRP) return;
    const int co = oct * 8;
    const float* cw = FIN(F, 20  ); const float* cb = FIN(F, 21  );
    float w0[8], w1[8], w2[8], bb[8];
#define LD8F(dst, p) do { const GAS f32x4* p_ = (const GAS f32x4*)(p); const f32x4 a_ = p_[0], b_ = p_[1]; dst[0] = a_.x; dst[1] = a_.y; dst[2] = a_.z; dst[3] = a_.w; dst[4] = b_.x; dst[5] = b_.y; dst[6] = b_.z; dst[7] = b_.w; } while (0)
    LD8F(w0, cw + co); LD8F(w1, cw + FFN + co); LD8F(w2, cw + 2 * FFN + co); LD8F(bb, cb + co);
#define P9_PTRS(BW, E_, O_, Z_) do { const int which_ = (BW) & 1, B_ = (BW) >> 1; const int row_ = h * HROWS + B_ * 64 + (which_ ? 63 : 0), s_ = row_seq(row_), t_ = row_ - seq_first_row(s_); \
        E_ = F.EDGE() + (size_t)((B_ * 2 + which_) * 3) * FFN + co; Z_ = which_ && t_ == seq_len(s_) - 1; \
        O_ = which_ == 0 ? (t_ == 0 ? F.G15() + (size_t)s_ * FFN + co : F.EDGE() + (size_t)(((B_ - 1) * 2 + 1) * 3 + 1) * FFN + co) : (Z_ ? E_ : F.EDGE() + (size_t)(((B_ + 1) * 2 + 0) * 3 + 1) * FFN + co); } while (0)
#define P9_LOAD(E_, O_, I, S, U, X) do { const GAS f32x4* e_ = (const GAS f32x4*)(E_); const GAS f32x4* o_ = (const GAS f32x4*)(O_); I[0] = e_[0]; I[1] = e_[1]; \
        const GAS f32x4* e1_ = (const GAS f32x4*)((E_) + FFN); S[0] = e1_[0]; S[1] = e1_[1]; const GAS f32x4* e2_ = (const GAS f32x4*)((E_) + 2 * FFN); U[0] = e2_[0]; U[1] = e2_[1]; X[0] = o_[0]; X[1] = o_[1]; } while (0)
    f32x4 in_[2], se_[2], uu_[2], ou_[2], inN[2], seN[2], uuN[2], ouN[2];
    int bw = grp; const float* e; const float* o; bool z;
    P9_PTRS(bw, e, o, z); P9_LOAD(e, o, in_, se_, uu_, ou_);
    for (; bw < NBW; bw += NGRP) {
        const int nbw = bw + NGRP < NBW ? bw + NGRP : bw; const float* en; const float* on; bool zn;
        P9_PTRS(nbw, en, on, zn); P9_LOAD(en, on, inN, seN, uuN, ouN);
        const int which = bw & 1, lrow = (bw >> 1) * 64 + (which ? 63 : 0);
        float ov[8];
#pragma unroll
        for (int j = 0; j < 8; ++j) { const float inner = in_[j >> 2][j & 3], self = se_[j >> 2][j & 3], outer = z ? 0.f : ou_[j >> 2][j & 3];
            const float x = which == 0 ? bb[j] + w0[j] * outer + w1[j] * self + w2[j] * inner : bb[j] + w0[j] * inner + w1[j] * self + w2[j] * outer;
            ov[j] = x * sigmoidf_(x) * uu_[j >> 2][j & 3]; }
        *(GAS v4u*)(F.ACT() + (size_t)lrow * FFN + co) = pack8(ov);
#pragma unroll
        for (int k = 0; k < 2; ++k) { in_[k] = inN[k]; se_[k] = seN[k]; uu_[k] = uuN[k]; ou_[k] = ouN[k]; }
        z = zn;
    }
#undef P9_LOAD
#undef P9_PTRS
#undef LD8F
}
__device__ __forceinline__ void p11_rows(Frame& F, int gw, int NGW, float* obase) {
    const int lane = F.lane;
    f32x4 gg[8];
    { const float* a = FIN(F, 23  );
#pragma unroll
      for (int i = 0; i < 4; ++i) { const int e0 = (lane + 64 * i) * 8; gg[2 * i] = *(const GAS f32x4*)(a + e0); gg[2 * i + 1] = *(const GAS f32x4*)(a + e0 + 4); } }
    bf16x8 hv[4], fq[4], hn[4], fn[4];
#define P11_LOAD(R, H, Q) do { const GAS bf16x8* f_ = (const GAS bf16x8*)((const bf16*)(F.out + (size_t)(R) * DM)); \
        const GAS bf16x8* h_ = (const GAS bf16x8*)((R) < HROWS ? F.H1A() + (size_t)(R) * DM : F.XN() + (size_t)((R) - HROWS) * DM); \
        _Pragma("unroll") for (int i_ = 0; i_ < 4; ++i_) { H[i_] = h_[lane + 64 * i_]; Q[i_] = f_[lane + 64 * i_]; } } while (0)
    int row = gw;
    if (row < NTOK) P11_LOAD(row, hv, fq);
    for (; row < NTOK; row += NGW) {
        const int nrow = row + NGW < NTOK ? row + NGW : row;
        P11_LOAD(nrow, hn, fn);
        float fv[32]; float ss = 0.f;
#pragma unroll
        for (int i = 0; i < 4; ++i)
#pragma unroll
            for (int j = 0; j < 8; ++j) { fv[8 * i + j] = bf2f(fq[i][j]); ss += fv[8 * i + j] * fv[8 * i + j]; }
        const float r1 = 1.f / sqrtf(wave_sum(ss) * (1.f / DM) + EPS);
#pragma unroll
        for (int i = 0; i < 4; ++i) { const int e0 = (lane + 64 * i) * 8; const f32x4 g0 = gg[2 * i], g1 = gg[2 * i + 1];
            f32x4 h0, h1;
            h0.x = bf2f(hv[i][0]) + fv[8 * i + 0] * r1 * g0.x; h0.y = bf2f(hv[i][1]) + fv[8 * i + 1] * r1 * g0.y; h0.z = bf2f(hv[i][2]) + fv[8 * i + 2] * r1 * g0.z; h0.w = bf2f(hv[i][3]) + fv[8 * i + 3] * r1 * g0.w;
            h1.x = bf2f(hv[i][4]) + fv[8 * i + 4] * r1 * g1.x; h1.y = bf2f(hv[i][5]) + fv[8 * i + 5] * r1 * g1.y; h1.z = bf2f(hv[i][6]) + fv[8 * i + 6] * r1 * g1.z; h1.w = bf2f(hv[i][7]) + fv[8 * i + 7] * r1 * g1.w;
            GAS f32x4* wp = (GAS f32x4*)(obase + (size_t)row * DM + e0); wp[0] = h0; wp[1] = h1; }
#pragma unroll
        for (int i = 0; i < 4; ++i) { hv[i] = hn[i]; fq[i] = fn[i]; }
    }
#undef P11_LOAD
}
struct Args { const float* in[24]; float* out; unsigned char* ws; int ph_lo, ph_hi, q_lo, q_hi, use_bar, dummy; };
constexpr int N_PHASES = 12;
__global__ void __launch_bounds__(NWAVES * 64, 2) mk_fwd(Args args) {
    extern __shared__ __attribute__((aligned(16))) unsigned char lds[];
    Frame F;
    F.lds = (LAS unsigned char*)lds;
    F.MISC = (volatile LAS unsigned*)(F.lds + MISC_OFF);
    F.wave = __builtin_amdgcn_readfirstlane((int)threadIdx.x >> 6);
    F.tid = F.wave * 64 + lane_id_now(); F.lane = F.tid & 63;
    F.G = gridDim.x; { const int bx = blockIdx.x; F.vcu = (F.G % 8 == 0) ? (bx % 8) * (F.G / 8) + bx / 8 : bx; }
    unsigned char* ws = args.ws;
    F.ctl = (gu32*)(ws + WS_CTL);
    F.kargs = (const __attribute__((address_space(4))) void*)__builtin_amdgcn_kernarg_segment_ptr(); F.ptag = 0; F.out = args.out;
    F.ws = ws;
    for (int u = F.tid; u < (LDS_BYTES - LDSCTL_OFF) / 4; u += NWAVES * 64) ((LAS unsigned*)(F.lds + LDSCTL_OFF))[u] = 0u;
    __syncthreads();
    XcdBarrier bar; bar.bar = (unsigned*)(F.ctl + CW_BAR); bar.x = 0; bar.st = nullptr;
    if (args.use_bar) bar = xcd_barrier_post((unsigned*)(F.ctl + CW_BAR), F.MISC + 8, F.tid == 0);
    const int lo = args.ph_lo, hi = args.ph_hi;
    const int dmy_ = MK_MULTI ? args.dummy : 0;
#define IN(k) (((MK_PHASE_MASK >> (k)) & 1) && lo <= (k) && (k) < hi)
#define PH_BEGIN(k) do { F.ptag = (k); int t_ = F.wave * 64 + lane_id_now(); asm volatile("" : "+v"(t_)); F.tid = t_; F.lane = t_ & 63; } while (0)
#define PH_BAR() do { if (args.use_bar) xcd_barrier(bar, F.wave == 0 && lane_id_now() == 0); } while (0)
    const int gw = F.vcu * NWAVES + F.wave, NGW = F.G * NWAVES;

    if (IN(0)) { PH_BEGIN(0); { p0_prologue(F); PH_BAR(); } }
    if (IN(1)) { PH_BEGIN(1); {
        p1_meta_z(F);
        pg8::Gemm g{F.XN(), F.WIN_T(), NTOK, INW, DM}; pg8::ProbeOrder S; S.init(NTOK, INW, F.G, (int)blockIdx.x); S.pmask = dmy_ == 5 ? 7 : -1;
        pg8::EpiRoute E{nullptr, 0, 1, F.QG(), F.K(), F.V(), F.XR()};
        if (dmy_ != 7) pg8::gemm_phase<pg8::EpiRoute, pg8::ProbeOrder, true, true>(F.lds, g, S, E, F.wave);
        PH_BAR();
    } }
    if (IN(2)) { PH_BEGIN(2); { lru_phase<1>(F, nullptr); PH_BAR(); } }
    if (IN(3)) { PH_BEGIN(3); {
        k_rope_pass(F, dmy_ ? (bf16*)F.out : F.K());
        lru_propagate(F);
        if (F.vcu == F.G - 1) p3_meta_job(F);
        PH_BAR();
    } }
    if (IN(4)) { PH_BEGIN(4); {
        const int dm = dmy_;
        if (dm < 2 || dm == 2) lru_phase<2>(F, dm ? (bf16*)F.out : F.QG());
        if (dm < 2 || dm == 3) for (int it = F.vcu; it < 512; it += F.G) metaq_item(F, it);
        if (dm < 2 || dm == 4) attn_phase(F, (char*)lds, dm ? (bf16*)F.out : F.QG());
        if (dm == 8 && F.vcu < 128) attn_phase(F, (char*)lds, (bf16*)F.out);
        if (dm == 6 && (F.vcu & 1) == 0) attn_phase(F, (char*)lds, (bf16*)F.out);
        PH_BAR();
    } }
    if (IN(5)) { PH_BEGIN(5); {
        p5_ratio(F);
        if (F.vcu >= F.G - 12) p5_meta_job(F, F.G - 1 - F.vcu);
        PH_BAR();
    } }
    if (IN(6)) { PH_BEGIN(6); {
        p6_meta_y(F);
        pg8::Gemm g{F.QG(), F.WOUT_T(), NTOK, DM, DM}; pg8::StaticOrder S; S.init(NTOK, DM, F.G, (int)blockIdx.x);
        pg8::EpiScaled E{(bf16*)F.out, 2 * DM, F.RATIO(), F.RL(), 16};
        pg8::gemm_phase<pg8::EpiScaled, pg8::StaticOrder, true, true>(F.lds, g, S, E, F.wave);
        PH_BAR();
    } }
#if MK_MULTI
    { const int q = args.q_lo;
#else
#pragma unroll
    for (int q = 0; q < 2; ++q) {
#endif
        if (IN(7)) { PH_BEGIN(7); {
            p7_rows(F, q, gw, NGW);
            if (q == 0) p7_meta_g(F);
            PH_BAR();
        } }
        if (IN(8)) { PH_BEGIN(8); {
            pg8::Gemm g{F.XN() + (size_t)q * HROWS * DM, F.WUP_T(), HROWS, UPW, DM}; pg8::StaticOrder S; S.init(HROWS, UPW, F.G, (int)blockIdx.x);
            pg8::EpiAct E{F.ACT(), F.EDGE(), FIN(F, 20  ), FIN(F, 21  ), FFN};
            pg8::gemm_phase<pg8::EpiAct, pg8::StaticOrder, true, true>(F.lds, g, S, E, F.wave);
            PH_BAR();
        } }
        if (IN(9)) { PH_BEGIN(9); { p9_fix(F, q); PH_BAR(); } }
        if (IN(10)) { PH_BEGIN(10); {
            pg8::Gemm g{F.ACT(), F.WDOWN_T(), HROWS, DM, FFN}; pg8::ProbeOrder S; S.init(HROWS, DM, F.G, (int)blockIdx.x); S.pmask = dmy_ == 5 ? 7 : -1;
            pg8::EpiRoute E{(bf16*)F.out + (size_t)q * HROWS * 2 * DM, 2 * DM, 0, nullptr, nullptr, nullptr, nullptr};
            pg8::gemm_phase<pg8::EpiRoute, pg8::ProbeOrder, true, true>(F.lds, g, S, E, F.wave);
            if (q == 0) PH_BAR();
        } }
    }
    if (IN(10) && IN(11)) PH_BAR();
    if (IN(11)) { PH_BEGIN(11); { p11_rows(F, gw, NGW, dmy_ ? (float*)(F.ws + WS_B) : F.out); } }
#undef IN
#undef PH_BAR
}

extern "C" void kernel_launch(void* const* d_in, const int* in_sizes, int n_in, void* d_out, int out_size, void* d_ws, size_t ws_size, hipStream_t stream) {
    static int grid = 0;
    if (grid == 0) {
        if (n_in != 24 || out_size != NTOK * DM || ws_size < WS_END) { fprintf(stderr, "kernel_launch: unexpected shapes (n_in %d out %d ws %zu, need ws >= %zu); nothing launched\n", n_in, out_size, ws_size, (size_t)WS_END); grid = -1; return; }
        int dev = 0, cus = 0;
        if (hipGetDevice(&dev) != hipSuccess || hipDeviceGetAttribute(&cus, hipDeviceAttributeMultiprocessorCount, dev) != hipSuccess) { grid = -1; return; }
        if (hipFuncSetAttribute((const void*)mk_fwd, hipFuncAttributeMaxDynamicSharedMemorySize, LDS_BYTES) != hipSuccess) { fprintf(stderr, "kernel_launch: hipFuncSetAttribute failed\n"); grid = -1; return; }
        int per_cu = 0;
        if (hipOccupancyMaxActiveBlocksPerMultiprocessor(&per_cu, (const void*)mk_fwd, NWAVES * 64, LDS_BYTES) != hipSuccess || per_cu < 1) fprintf(stderr, "kernel_launch: occupancy query reports %d\n", per_cu);
        (void)hipGetLastError();
        grid = cus;
    }
    if (grid < 0) return;
    if (hipMemsetAsync((char*)d_ws + WS_CTL, 0, CTL_ZERO_BYTES, stream) != hipSuccess) return;
    Args a{};
    for (int i = 0; i < 24; ++i) a.in[i] = (const float*)d_in[i];
    a.out = (float*)d_out; a.ws = (unsigned char*)d_ws;
#if MK_MULTI
    a.use_bar = 0;
#define LAUNCH_PH(ph, q) do { a.ph_lo = (ph); a.ph_hi = (ph) + 1; a.q_lo = (q); a.q_hi = (q) + 1; \
        if ((MK_REPEAT_MASK >> (ph)) & 1) { a.dummy = MK_DUMMY_MODE; hipLaunchKernelGGL(mk_fwd, dim3(grid), dim3(NWAVES * 64), LDS_BYTES, stream, a); } \
        a.dummy = 0; hipLaunchKernelGGL(mk_fwd, dim3(grid), dim3(NWAVES * 64), LDS_BYTES, stream, a); } while (0)
    for (int ph = 0; ph < 7; ++ph) LAUNCH_PH(ph, 0);
    for (int q = 0; q < 2; ++q) for (int ph = 7; ph < 11; ++ph) LAUNCH_PH(ph, q);
    LAUNCH_PH(11, 0);
#else
    a.use_bar = 1; a.ph_lo = 0; a.ph_hi = N_PHASES; a.q_lo = 0; a.q_hi = 2;
    hipLaunchKernelGGL(mk_fwd, dim3(grid), dim3(NWAVES * 64), LDS_BYTES, stream, a);
#endif
    const hipError_t le = hipPeekAtLastError();
    if (le != hipSuccess) fprintf(stderr, "kernel_launch: launch failed: %s\n", hipGetErrorName(le));
}
```

```cpp
#include <hip/hip_runtime.h>
#include <cstdio>
#include <cstdint>
#include <cmath>
#ifndef MK_PHASE_MASK
#define MK_PHASE_MASK 0xfff
#endif
#ifndef MK_REPEAT_MASK
#define MK_REPEAT_MASK 0
#endif
#ifndef MK_DUMMY_MODE
#define MK_DUMMY_MODE 1
#endif
#ifndef MK_MULTI
#define MK_MULTI 0
#endif
__device__ __forceinline__ int lane_id_now() { int l; asm volatile("v_mbcnt_lo_u32_b32 %0, -1, 0\n\tv_mbcnt_hi_u32_b32 %0, -1, %0" : "=v"(l)); return l; }
namespace pg8 {
#define PG8_LAS __attribute__((address_space(3)))
typedef unsigned short bf16_t;
typedef short bf16x8 __attribute__((ext_vector_type(8)));
typedef float f32x4 __attribute__((ext_vector_type(4)));
typedef unsigned u32x4 __attribute__((ext_vector_type(4)));
constexpr int BM = 256, BK = 64, HALF = 128, HTB = HALF * BK * 2  , STAGE_BYTES = 8 * HTB, NXCD = 8, WGM = 8;

__host__ __device__ __forceinline__ int lds_byte(int r, int c) { const int st = (r >> 4) * 2 + (c >> 5), rr = r & 15, cc = c & 31, ob = rr * 64 + cc * 2; return st * 1024 + (ob ^ (((ob >> 9) & 1) << 5)); }
__host__ __device__ __forceinline__ void stage_rc(int b, int& R, int& C) { const int st = b / 1024, sb = b % 1024, swz = sb ^ (((sb >> 9) & 1) << 5); R = (st >> 1) * 16 + swz / 64; C = (st & 1) * 32 + (swz % 64) / 2; }
__host__ __device__ __forceinline__ int perm32(int rho) { const int n = rho >> 4, i = rho & 15; return 8 * (i >> 2) + 4 * n + (i & 3); }

struct Unit { int pm, pn; };
struct Gemm { const bf16_t* A; const bf16_t* Bt; int M, N, K; };

struct StaticOrder {
    int nM, nN, nwg, G, c;
    __host__ __device__ void init(int M, int N, int G_, int c_) { nM = M / BM; nN = N / BM; nwg = nM * nN; G = G_; c = c_; }
    __host__ __device__ bool next(int i, Unit& u) const {
        const long L = (long)i * G + c; if (L >= nwg) return false;
        int wgid = (int)L; { const int q = nwg / NXCD, r = nwg % NXCD, xcd = wgid % NXCD, off = wgid / NXCD; wgid = (xcd < r ? xcd * (q + 1) : r * (q + 1) + (xcd - r) * q) + off; }
        const int nig = WGM * nN, gid = wgid / nig, fm = gid * WGM, gsz = (nM - fm) < WGM ? (nM - fm) : WGM;
        u.pm = fm + ((wgid % nig) % gsz); u.pn = (wgid % nig) / gsz; return true;
    }
    __device__ __forceinline__ void a_ready(const Unit&) const {}
    __device__ __forceinline__ void done(const Unit&) const {}
};

__device__ __forceinline__ unsigned cvt_pk_bf16(float lo, float hi) { unsigned r; asm volatile("v_cvt_pk_bf16_f32 %0, %1, %2" : "=v"(r) : "v"(lo), "v"(hi)); return r; }
struct EpiRoute {
    static constexpr bool PERM = true, AFTER_DRAIN = false, MIDK = false;
    bf16_t* O; int ldc; int mode; bf16_t *QGp, *Kp, *Vp, *XRp;
    __device__ __forceinline__ void operator()(const f32x4 (&acc)[2][2][4][2], const Unit& u, int wr, int wc, int fr, int fq) const {
        bf16_t* base = O; int ld = ldc; int colt = u.pn * BM; int rowadd = 0;
        if (mode == 1) {
            const int pn = u.pn;
            if (pn < 4) { base = QGp; ld = 2048; colt = pn * 256; }
            else if (pn == 4) { base = Kp; ld = 256; colt = 0; }
            else if (pn == 5) { base = Vp; ld = 256; colt = 0; }
            else if (pn < 10) { base = XRp; ld = 1024; colt = (pn - 6) * 256; const int seq = u.pm < 128 ? (u.pm >> 4) : 8 + ((u.pm - 128) >> 5); rowadd = 64 * (seq + 1); }
            else { base = QGp; ld = 2048; colt = 1024 + (pn - 10) * 256; }
        }
        const int row0 = u.pm * BM + wr * 64 + fr + rowadd; const int col0 = colt + wc * 32 + 8 * fq;
#pragma unroll
        for (int ai = 0; ai < 2; ++ai)
#pragma unroll
            for (int m = 0; m < 4; ++m) { bf16_t* rowp = base + (size_t)(row0 + ai * HALF + m * 16) * ld + col0;
#pragma unroll
                for (int bj = 0; bj < 2; ++bj) { const f32x4 v0 = acc[ai][bj][m][0], v1 = acc[ai][bj][m][1];
                    u32x4 w; w.x = cvt_pk_bf16(v0[0], v0[1]); w.y = cvt_pk_bf16(v0[2], v0[3]); w.z = cvt_pk_bf16(v1[0], v1[1]); w.w = cvt_pk_bf16(v1[2], v1[3]);
                    *(u32x4*)(rowp + bj * HALF) = w; } }
    }
};

__device__ __forceinline__ float dpp_shr1(float old, float src) { return __builtin_bit_cast(float, __builtin_amdgcn_update_dpp(__builtin_bit_cast(int, old), __builtin_bit_cast(int, src), 0x111, 0xF, 0xF, false)); }
__device__ __forceinline__ float dpp_shl1(float old, float src) { return __builtin_bit_cast(float, __builtin_amdgcn_update_dpp(__builtin_bit_cast(int, old), __builtin_bit_cast(int, src), 0x101, 0xF, 0xF, false)); }
__device__ __forceinline__ float dpp_ror1(float src)  { return __builtin_bit_cast(float, __builtin_amdgcn_update_dpp(0, __builtin_bit_cast(int, src), 0x121, 0xF, 0xF, false)); }
__device__ __forceinline__ float dpp_ror15(float src) { return __builtin_bit_cast(float, __builtin_amdgcn_update_dpp(0, __builtin_bit_cast(int, src), 0x12F, 0xF, 0xF, false)); }
struct EpiAct {
    static constexpr bool PERM = true, AFTER_DRAIN = false, MIDK = false;
    bf16_t* ACT; float* EDGE; const float* cw; const float* cb; int nch;
    __device__ __forceinline__ void operator()(const f32x4 (&acc)[2][2][4][2], const Unit& u, int wr, int wc, int fr, int fq) const {
        const int ch0 = u.pn * 128 + wc * 32 + 8 * fq;
        float w0[8], w1[8], w2[8], bb[8];
        { const f32x4 a0 = *(const f32x4*)(cw + ch0), a1 = *(const f32x4*)(cw + ch0 + 4), b0 = *(const f32x4*)(cw + nch + ch0), b1 = *(const f32x4*)(cw + nch + ch0 + 4),
                      c0 = *(const f32x4*)(cw + 2 * nch + ch0), c1 = *(const f32x4*)(cw + 2 * nch + ch0 + 4), d0 = *(const f32x4*)(cb + ch0), d1 = *(const f32x4*)(cb + ch0 + 4);
#pragma unroll
          for (int k = 0; k < 4; ++k) { w0[k] = a0[k]; w0[4 + k] = a1[k]; w1[k] = b0[k]; w1[4 + k] = b1[k]; w2[k] = c0[k]; w2[4 + k] = c1[k]; bb[k] = d0[k]; bb[4 + k] = d1[k]; } }
        const int rowb = u.pm * BM + wr * 64;
#pragma unroll
        for (int ai = 0; ai < 2; ++ai) {
            float ein0[8], ein1[8];
#pragma unroll
            for (int m = 0; m < 4; ++m) {
                float o[8];
#pragma unroll
                for (int n = 0; n < 2; ++n)
#pragma unroll
                    for (int k = 0; k < 4; ++k) {
                        const int j = 4 * n + k; const float cur = acc[ai][0][m][n][k];
                        float pold = 0.f, nold = 0.f;
                        if (m > 0) pold = dpp_ror1(acc[ai][0][m > 0 ? m - 1 : 0][n][k]);
                        if (m < 3) nold = dpp_ror15(acc[ai][0][m < 3 ? m + 1 : 3][n][k]);
                        const float prv = dpp_shr1(pold, cur), nxt = dpp_shl1(nold, cur);
                        const float x = bb[j] + w0[j] * prv + w1[j] * cur + w2[j] * nxt;
                        o[j] = x * __builtin_amdgcn_rcpf(1.f + __builtin_amdgcn_exp2f(-1.4426950408889634f * x)) * acc[ai][1][m][n][k];
                        if (m == 0) ein0[j] = nxt;
                        if (m == 3) ein1[j] = prv;
                    }
                u32x4 w; w.x = cvt_pk_bf16(o[0], o[1]); w.y = cvt_pk_bf16(o[2], o[3]); w.z = cvt_pk_bf16(o[4], o[5]); w.w = cvt_pk_bf16(o[6], o[7]);
                *(u32x4*)(ACT + (size_t)(rowb + ai * HALF + m * 16 + fr) * nch + ch0) = w;
            }
            const int blk = (rowb + ai * HALF) >> 6;
            if (fr == 0 || fr == 15) {
                const bool last = fr == 15; float* e = EDGE + (size_t)((blk * 2 + (last ? 1 : 0)) * 3) * nch + ch0;
                f32x4 i0v, i1v, s0v, s1v, u0v, u1v;
#pragma unroll
                for (int k = 0; k < 4; ++k) { i0v[k] = last ? ein1[k] : ein0[k]; i1v[k] = last ? ein1[4 + k] : ein0[4 + k];
                    s0v[k] = last ? acc[ai][0][3][0][k] : acc[ai][0][0][0][k]; s1v[k] = last ? acc[ai][0][3][1][k] : acc[ai][0][0][1][k];
                    u0v[k] = last ? acc[ai][1][3][0][k] : acc[ai][1][0][0][k]; u1v[k] = last ? acc[ai][1][3][1][k] : acc[ai][1][0][1][k]; }
                *(f32x4*)(e) = i0v; *(f32x4*)(e + 4) = i1v; *(f32x4*)(e + nch) = s0v; *(f32x4*)(e + nch + 4) = s1v; *(f32x4*)(e + 2 * nch) = u0v; *(f32x4*)(e + 2 * nch + 4) = u1v;
            }
        }
    }
};

struct ProbeOrder : StaticOrder { int pmask;
    __host__ __device__ bool next(int i, Unit& u) const { const bool r = StaticOrder::next(i, u); u.pm &= pmask; return r; } };

struct EpiScaled {
    static constexpr bool PERM = true, AFTER_DRAIN = false, MIDK = true;
    bf16_t* O; int ldc; const float* ratio; const float* rl; int kt;
    __device__ __forceinline__ void midk(f32x4 (&acc)[2][2][4][2], const Unit& u, int wr, int fr) const {
        asm volatile("" ::: "memory");
        const float* rp = ratio + (u.pm * BM + wr * 64 + fr);
        float s[2][4];
#pragma unroll
        for (int ai = 0; ai < 2; ++ai)
#pragma unroll
            for (int m = 0; m < 4; ++m) s[ai][m] = rp[ai * HALF + m * 16];
#pragma unroll
        for (int ai = 0; ai < 2; ++ai)
#pragma unroll
            for (int m = 0; m < 4; ++m)
#pragma unroll
                for (int bj = 0; bj < 2; ++bj)
#pragma unroll
                    for (int n = 0; n < 2; ++n) acc[ai][bj][m][n] = acc[ai][bj][m][n] * s[ai][m];
        asm volatile("" ::: "memory");
    }
    __device__ __forceinline__ void operator()(const f32x4 (&acc)[2][2][4][2], const Unit& u, int wr, int wc, int fr, int fq) const {
        const int row0 = u.pm * BM + wr * 64 + fr, col0 = u.pn * BM + wc * 32 + 8 * fq;
#pragma unroll
        for (int ai = 0; ai < 2; ++ai)
#pragma unroll
            for (int m = 0; m < 4; ++m) { const int row = row0 + ai * HALF + m * 16; const float s = rl[row]; bf16_t* rowp = O + (size_t)row * ldc + col0;
#pragma unroll
                for (int bj = 0; bj < 2; ++bj) { const f32x4 v0 = acc[ai][bj][m][0] * s, v1 = acc[ai][bj][m][1] * s;
                    u32x4 w; w.x = cvt_pk_bf16(v0[0], v0[1]); w.y = cvt_pk_bf16(v0[2], v0[3]); w.z = cvt_pk_bf16(v1[0], v1[1]); w.w = cvt_pk_bf16(v1[2], v1[3]);
                    *(u32x4*)(rowp + bj * HALF) = w; } }
    }
};

template <class Epi, class Sched, bool ALIGN_EPI = false, bool SP2 = false>
__device__ __forceinline__ void gemm_phase(PG8_LAS unsigned char* lds, const Gemm g, const Sched& S, const Epi& E, int wave_id) {
    int tid_ = wave_id * 64 + lane_id_now(); asm volatile("" : "+v"(tid_));
    const int tid = tid_, wid = __builtin_amdgcn_readfirstlane(tid >> 6), lane = tid & 63, wr = wid >> 2, wc = wid & 3, fr = lane & 15, fq = lane >> 4;
    const int K = g.K, nt = K / BK;
    unsigned voffA[2], voffB[2];
#pragma unroll
    for (int i = 0; i < 2; ++i) { int R, C; stage_rc(tid * 16 + i * 8192, R, C); const int Rb = Epi::PERM ? ((R & ~31) + perm32(R & 31)) : R;
        voffA[i] = (unsigned)(R * K + C) * 2u; voffB[i] = (unsigned)(Rb * K + C) * 2u; }
    const size_t kstep = (size_t)(BK * 2);
    const size_t hstep = (size_t)HALF * K * 2;
    const size_t tstep = 2 * hstep;
    const unsigned ldsw = (unsigned)wid * 1024u;
    const int aoff = lds_byte(wr * 64 + fr, fq * 8), boff = lds_byte(wc * 32 + fr, fq * 8);
#define PG8_SA(b, h) (((b) * 2 + (h)) * HTB)
#define PG8_SB(b, h) ((4 + (b) * 2 + (h)) * HTB)
#define PG8_STAGE(bufoff, gbase, voff) do { _Pragma("unroll") for (int _i = 0; _i < 2; ++_i) \
        __builtin_amdgcn_global_load_lds((const unsigned*)((const char*)(gbase) + (voff)[_i]), (PG8_LAS unsigned*)(lds + (bufoff) + ldsw + _i * 8192), 16, 0, 0); } while (0)
#define PG8_LDA(dst, b, h) do { _Pragma("unroll") for (int m = 0; m < 4; ++m) _Pragma("unroll") for (int k = 0; k < 2; ++k) dst[m][k] = *(const PG8_LAS bf16x8*)(lds + PG8_SA(b, h) + aoff + m * 2048 + k * 1024); } while (0)
#define PG8_LDB(dst, b, h) do { _Pragma("unroll") for (int n = 0; n < 2; ++n) _Pragma("unroll") for (int k = 0; k < 2; ++k) dst[n][k] = *(const PG8_LAS bf16x8*)(lds + PG8_SB(b, h) + boff + n * 2048 + k * 1024); } while (0)
#define PG8_MMA(ai, bj, At, Bt) do { __builtin_amdgcn_s_setprio(1); _Pragma("unroll") for (int m = 0; m < 4; ++m) _Pragma("unroll") for (int n = 0; n < 2; ++n) _Pragma("unroll") for (int k = 0; k < 2; ++k) \
        acc[ai][bj][m][n] = __builtin_amdgcn_mfma_f32_16x16x32_bf16(Bt[n][k], At[m][k], acc[ai][bj][m][n], 0, 0, 0); __builtin_amdgcn_s_setprio(0); } while (0)
#define PG8_WAIT_V(n) asm volatile("s_waitcnt vmcnt(" #n ")" ::: "memory")
#define PG8_WAIT_L(n) asm volatile("s_waitcnt lgkmcnt(" #n ")" ::: "memory")
#define PG8_BAR __builtin_amdgcn_s_barrier()
#define PG8_SCHED __builtin_amdgcn_sched_barrier(0)
    Unit cur, nxt; int ui = 0;
    if (!S.next(0, cur)) return;
    f32x4 acc[2][2][4][2];
#pragma unroll
    for (int a = 0; a < 2; ++a)
#pragma unroll
        for (int b = 0; b < 2; ++b)
#pragma unroll
            for (int m = 0; m < 4; ++m)
#pragma unroll
                for (int n = 0; n < 2; ++n) acc[a][b][m][n] = (f32x4){0.f, 0.f, 0.f, 0.f};
    bf16x8 At[4][2], B0[2][2], B1[2][2];
    const char* cA = (const char*)g.A + (size_t)cur.pm * tstep; const char* cB = (const char*)g.Bt + (size_t)cur.pn * tstep;
    S.a_ready(cur);
    if constexpr (SP2) {
        PG8_STAGE(PG8_SB(0, 0), cB, voffB); PG8_STAGE(PG8_SB(0, 1), cB + hstep, voffB); PG8_STAGE(PG8_SA(0, 0), cA, voffA); PG8_STAGE(PG8_SA(0, 1), cA + hstep, voffA);
        if (wr == 1) PG8_BAR;
        PG8_WAIT_V(2); PG8_BAR;
        PG8_STAGE(PG8_SB(1, 0), cB + kstep, voffB); PG8_STAGE(PG8_SA(1, 0), cA + kstep, voffA); PG8_STAGE(PG8_SB(1, 1), cB + hstep + kstep, voffB);
        PG8_WAIT_V(6); PG8_BAR;
    } else {
        PG8_STAGE(PG8_SB(0, 0), cB, voffB); PG8_STAGE(PG8_SA(0, 0), cA, voffA); PG8_STAGE(PG8_SB(0, 1), cB + hstep, voffB); PG8_STAGE(PG8_SA(0, 1), cA + hstep, voffA);
        if (wr == 1) PG8_BAR;
        PG8_WAIT_V(4); PG8_BAR;
        PG8_STAGE(PG8_SB(1, 0), cB + kstep, voffB); PG8_STAGE(PG8_SA(1, 0), cA + kstep, voffA); PG8_STAGE(PG8_SB(1, 1), cB + hstep + kstep, voffB);
        PG8_WAIT_V(6); PG8_BAR;
    }
    for (;;) {
        const bool has_next = S.next(ui + 1, nxt);
        const char* nA = has_next ? (const char*)g.A + (size_t)nxt.pm * tstep : cA; const char* nB = has_next ? (const char*)g.Bt + (size_t)nxt.pn * tstep : cB;
        for (int t = 0; t < nt; t += 2) {
            if constexpr (Epi::MIDK) { if (t == E.kt) E.midk(acc, cur, wr, fr); }
            const bool last = (t == nt - 2);
            const char* a1 = cA + (size_t)(t + 1) * kstep;
            const char* a2 = last ? nA : cA + (size_t)(t + 2) * kstep; const char* b2 = last ? nB : cB + (size_t)(t + 2) * kstep;
            const char* a3 = a2 + kstep; const char* b3 = b2 + kstep;
            if (last && has_next) S.a_ready(nxt);
            if constexpr (SP2) {
            PG8_LDB(B0, 0, 0); PG8_LDB(B1, 0, 1); PG8_SCHED; PG8_LDA(At, 0, 0); PG8_STAGE(PG8_SA(1, 1), a1 + hstep, voffA);
            PG8_WAIT_V(8); PG8_WAIT_L(0); PG8_BAR; PG8_MMA(0, 0, At, B0); PG8_MMA(0, 1, At, B1); PG8_BAR; PG8_SCHED;
            PG8_LDA(At, 0, 1); PG8_STAGE(PG8_SB(0, 0), b2, voffB); PG8_STAGE(PG8_SB(0, 1), b2 + hstep, voffB); PG8_STAGE(PG8_SA(0, 0), a2, voffA);
            PG8_WAIT_V(8); PG8_WAIT_L(0); PG8_BAR; PG8_MMA(1, 0, At, B0); PG8_MMA(1, 1, At, B1); PG8_BAR; PG8_SCHED;
            PG8_LDB(B0, 1, 0); PG8_LDB(B1, 1, 1); PG8_SCHED; PG8_LDA(At, 1, 0); PG8_STAGE(PG8_SA(0, 1), a2 + hstep, voffA);
            PG8_WAIT_V(8); PG8_WAIT_L(0); PG8_BAR; PG8_MMA(0, 0, At, B0); PG8_MMA(0, 1, At, B1); PG8_BAR; PG8_SCHED;
            PG8_LDA(At, 1, 1); PG8_STAGE(PG8_SB(1, 0), b3, voffB); PG8_STAGE(PG8_SB(1, 1), b3 + hstep, voffB); PG8_STAGE(PG8_SA(1, 0), a3, voffA);
            PG8_WAIT_V(8); PG8_WAIT_L(0); PG8_BAR; PG8_MMA(1, 0, At, B0); PG8_MMA(1, 1, At, B1); PG8_BAR; PG8_SCHED;
            } else {
            PG8_LDB(B0, 0, 0); PG8_SCHED; PG8_LDA(At, 0, 0); PG8_STAGE(PG8_SA(1, 1), a1 + hstep, voffA);
            PG8_WAIT_L(8); PG8_BAR; PG8_WAIT_L(0); PG8_MMA(0, 0, At, B0); PG8_BAR; PG8_SCHED;
            PG8_LDB(B1, 0, 1); PG8_STAGE(PG8_SB(0, 0), b2, voffB);
            PG8_BAR; PG8_WAIT_L(0); PG8_MMA(0, 1, At, B1); PG8_BAR;
            PG8_LDA(At, 0, 1); PG8_STAGE(PG8_SA(0, 0), a2, voffA);
            PG8_BAR; PG8_WAIT_L(0); PG8_MMA(1, 0, At, B0); PG8_BAR; PG8_SCHED;
            PG8_STAGE(PG8_SB(0, 1), b2 + hstep, voffB);
            PG8_WAIT_V(6); PG8_BAR; PG8_MMA(1, 1, At, B1); PG8_BAR;
            PG8_LDB(B0, 1, 0); PG8_SCHED; PG8_LDA(At, 1, 0); PG8_STAGE(PG8_SA(0, 1), a2 + hstep, voffA);
            PG8_WAIT_L(8); PG8_BAR; PG8_WAIT_L(0); PG8_MMA(0, 0, At, B0); PG8_BAR; PG8_SCHED;
            PG8_LDB(B1, 1, 1); PG8_STAGE(PG8_SB(1, 0), b3, voffB);
            PG8_BAR; PG8_WAIT_L(0); PG8_MMA(0, 1, At, B1); PG8_BAR;
            PG8_LDA(At, 1, 1); PG8_STAGE(PG8_SA(1, 0), a3, voffA);
            PG8_BAR; PG8_WAIT_L(0); PG8_MMA(1, 0, At, B0); PG8_BAR; PG8_SCHED;
            PG8_STAGE(PG8_SB(1, 1), b3 + hstep, voffB);
            PG8_WAIT_V(6); PG8_BAR; PG8_MMA(1, 1, At, B1); PG8_BAR;
            }
        }
        if constexpr (ALIGN_EPI) { if (wr == 0) PG8_BAR; }
        if constexpr (!Epi::AFTER_DRAIN) { E(acc, cur, wr, wc, fr, fq); S.done(cur); }
        if (!has_next) break;
#pragma unroll
        for (int a = 0; a < 2; ++a)
#pragma unroll
            for (int b = 0; b < 2; ++b)
#pragma unroll
                for (int m = 0; m < 4; ++m)
#pragma unroll
                    for (int n = 0; n < 2; ++n) acc[a][b][m][n] = (f32x4){0.f, 0.f, 0.f, 0.f};
        cur = nxt; cA = nA; cB = nB; ++ui;
        if constexpr (ALIGN_EPI) { if (wr == 1) PG8_BAR; }
    }
    PG8_WAIT_V(0);
    if constexpr (!ALIGN_EPI) { if (wr == 0) PG8_BAR; }
    PG8_BAR;
    if constexpr (Epi::AFTER_DRAIN) { E.fused(acc, cur, wr, wc, fr, fq, lds, wid, lane); S.done(cur); }
#undef PG8_SA
#undef PG8_SB
#undef PG8_STAGE
#undef PG8_LDA
#undef PG8_LDB
#undef PG8_MMA
#undef PG8_WAIT_V
#undef PG8_WAIT_L
#undef PG8_BAR
#undef PG8_SCHED
}
}
namespace attn {
typedef unsigned short bf16r;
using bf16x8 = __attribute__((ext_vector_type(8))) short;
using s16x4  = __attribute__((ext_vector_type(4))) short;
using f32x4  = __attribute__((ext_vector_type(4))) float;
using u32x4  = __attribute__((ext_vector_type(4))) unsigned;
constexpr int   QBLK = 32, KVBLK = 64;
constexpr float SCALE = 0.088388347648318440f;
constexpr float THRL = 8.f;
constexpr int LDQ = 2048, LDK = 256, LDO = 2048;
constexpr size_t SHM_ATTN = 6 * 16384 + 8 * 64 * 4;
#define SBAR() __builtin_amdgcn_sched_barrier(0)
__device__ __forceinline__ unsigned cvtpk(float lo, float hi) { unsigned r; asm volatile("v_cvt_pk_bf16_f32 %0, %1, %2" : "=v"(r) : "v"(lo), "v"(hi)); return r; }
__device__ __forceinline__ unsigned short f2bf_rne(float f) { unsigned u = __builtin_bit_cast(unsigned, f); return (unsigned short)((u + 0x7fffu + ((u >> 16) & 1u)) >> 16); }
__device__ __forceinline__ float bfl(short b) { return __builtin_bit_cast(float, (unsigned)(unsigned short)b << 16); }
template <int OFF> __device__ __forceinline__ s16x4 tr_read(int vb) { s16x4 r; asm volatile("ds_read_b64_tr_b16 %0, %1 offset:%2" : "=&v"(r) : "v"(vb), "i"(OFF) : "memory"); return r; }

__device__ __forceinline__ void qkt16(f32x4 (&S)[4][2], const char* Ks, int kb0, const bf16x8 (&qf)[2][4], float nm0, float nm1) {
  const f32x4 n0 = {nm0, nm0, nm0, nm0}, n1 = {nm1, nm1, nm1, nm1};
#pragma unroll
  for (int kb = 0; kb < 4; ++kb)
#pragma unroll
    for (int ds = 0; ds < 4; ++ds) { const bf16x8 kf = *reinterpret_cast<const bf16x8*>(Ks + kb * 4096 + (kb0 ^ (64 * ds)));
      S[kb][0] = __builtin_amdgcn_mfma_f32_16x16x32_bf16(kf, qf[0][ds], ds == 0 ? n0 : S[kb][0], 0, 0, 0);
      S[kb][1] = __builtin_amdgcn_mfma_f32_16x16x32_bf16(kf, qf[1][ds], ds == 0 ? n1 : S[kb][1], 0, 0, 0); }
}
__device__ __forceinline__ void mask_meta16(f32x4 (&S)[4][2]) {
  const float NEG = -INFINITY;
#pragma unroll
  for (int kb = 1; kb < 4; ++kb)
#pragma unroll
    for (int qb = 0; qb < 2; ++qb) S[kb][qb] = (f32x4){NEG, NEG, NEG, NEG};
}
__device__ __forceinline__ void partial16(f32x4 (&S)[4][2], float (&mhat)[2], float (&alpha)[2], bool first) {
  float pm[2];
#pragma unroll
  for (int qb = 0; qb < 2; ++qb) { float a = __builtin_fmaxf(__builtin_fmaxf(S[0][qb][0], S[0][qb][1]), S[0][qb][2]), b = __builtin_fmaxf(__builtin_fmaxf(S[0][qb][3], S[1][qb][0]), S[1][qb][1]);
    a = __builtin_fmaxf(__builtin_fmaxf(a, S[1][qb][2]), S[1][qb][3]); b = __builtin_fmaxf(__builtin_fmaxf(b, S[2][qb][0]), S[2][qb][1]);
    a = __builtin_fmaxf(__builtin_fmaxf(a, S[2][qb][2]), S[2][qb][3]); b = __builtin_fmaxf(__builtin_fmaxf(b, S[3][qb][0]), S[3][qb][1]);
    a = __builtin_fmaxf(__builtin_fmaxf(a, S[3][qb][2]), S[3][qb][3]); pm[qb] = __builtin_fmaxf(a, b); }
  alpha[0] = 1.f; alpha[1] = 1.f;
  if (first || __builtin_expect(__any(__builtin_fmaxf(pm[0], pm[1]) > THRL), 0)) {
#pragma unroll
    for (int qb = 0; qb < 2; ++qb) { float m = pm[qb]; m = __builtin_fmaxf(m, __shfl_xor(m, 16)); m = __builtin_fmaxf(m, __shfl_xor(m, 32));
      const float dl = first ? m : __builtin_fmaxf(m, 0.f); mhat[qb] += dl;
#pragma unroll
      for (int kb = 0; kb < 4; ++kb) S[kb][qb] = S[kb][qb] - dl;
      if (!first) alpha[qb] = __builtin_amdgcn_exp2f(-dl); }
  }
#pragma unroll
  for (int kb = 0; kb < 2; ++kb)
#pragma unroll
    for (int qb = 0; qb < 2; ++qb)
#pragma unroll
      for (int r = 0; r < 4; ++r) S[kb][qb][r] = __builtin_amdgcn_exp2f(S[kb][qb][r]);
}
__device__ __forceinline__ void finish16(f32x4 (&S)[4][2], const float (&alpha)[2], float (&lsum)[2], bf16x8 (&pa)[2][2]) {
#pragma unroll
  for (int kb = 2; kb < 4; ++kb)
#pragma unroll
    for (int qb = 0; qb < 2; ++qb)
#pragma unroll
      for (int r = 0; r < 4; ++r) S[kb][qb][r] = __builtin_amdgcn_exp2f(S[kb][qb][r]);
#pragma unroll
  for (int qb = 0; qb < 2; ++qb) { float ps = 0.f;
#pragma unroll
    for (int kb = 0; kb < 4; ++kb) ps += (S[kb][qb][0] + S[kb][qb][1]) + (S[kb][qb][2] + S[kb][qb][3]);
    lsum[qb] = lsum[qb] * alpha[qb] + ps;
#pragma unroll
    for (int ks = 0; ks < 2; ++ks) { const f32x4 a = S[2 * ks][qb], b = S[2 * ks + 1][qb];
      u32x4 w = {cvtpk(a[0], a[1]), cvtpk(a[2], a[3]), cvtpk(b[0], b[1]), cvtpk(b[2], b[3])}; pa[qb][ks] = *reinterpret_cast<bf16x8*>(&w); } }
}
template <int KS, int DB> __device__ __forceinline__ void pv_one16(f32x4 (&O)[2][8], int vbA, int vbB, const bf16x8 (&pa)[2][2]) {
  const int vb = DB < 7 ? vbA : vbB;
  const s16x4 lo = tr_read<(8 * KS) * 1024 + 128 * DB>(vb), hi = tr_read<(8 * KS + 4) * 1024 + 128 * DB>(vb);
  asm volatile("s_waitcnt lgkmcnt(0)" ::: "memory"); SBAR();
  const bf16x8 bfr = {lo[0], lo[1], lo[2], lo[3], hi[0], hi[1], hi[2], hi[3]};
  O[0][DB] = __builtin_amdgcn_mfma_f32_16x16x32_bf16(pa[0][KS], bfr, O[0][DB], 0, 0, 0);
  O[1][DB] = __builtin_amdgcn_mfma_f32_16x16x32_bf16(pa[1][KS], bfr, O[1][DB], 0, 0, 0);
}
template <int KS> __device__ __forceinline__ void pv_ks16(f32x4 (&O)[2][8], int vbA, int vbB, const bf16x8 (&pa)[2][2]) {
  pv_one16<KS, 0>(O, vbA, vbB, pa); pv_one16<KS, 1>(O, vbA, vbB, pa); pv_one16<KS, 2>(O, vbA, vbB, pa); pv_one16<KS, 3>(O, vbA, vbB, pa);
  pv_one16<KS, 4>(O, vbA, vbB, pa); pv_one16<KS, 5>(O, vbA, vbB, pa); pv_one16<KS, 6>(O, vbA, vbB, pa); pv_one16<KS, 7>(O, vbA, vbB, pa);
}
__device__ __forceinline__ void pv16(f32x4 (&O)[2][8], int vbA, int vbB, const bf16x8 (&pa)[2][2]) { pv_ks16<0>(O, vbA, vbB, pa); pv_ks16<1>(O, vbA, vbB, pa); }

__device__ __forceinline__ void attn_unit(const bf16r* Qb, const bf16r* __restrict__ Kh, const bf16r* __restrict__ Vh,
                                          const bf16r* __restrict__ KMh, const bf16r* __restrict__ VMh, bf16r* Ob, int NT, char* lds,
                                          const float* __restrict__ qnorm, int t0, float* ssq, int wave_id) {
  int tid_ = wave_id * 64 + lane_id_now(); asm volatile("" : "+v"(tid_));
  const int tid = tid_, wid = tid >> 6, lane = tid & 63, c = lane & 15, g = lane >> 4;
  float* ws = (float*)(lds + 6 * 16384) + wid * 64; float* li_l = ws; float* al_l = ws + 32;
  float mhat[2] = {0.f, 0.f}, lsum[2] = {0.f, 0.f};
  f32x4 O[2][8];
#pragma unroll
  for (int qb = 0; qb < 2; ++qb)
#pragma unroll
    for (int db = 0; db < 8; ++db) O[qb][db] = (f32x4){0.f, 0.f, 0.f, 0.f};
  unsigned kgo0, vgo0;
  { const int k0 = 4 * wid + g; kgo0 = (unsigned)(k0 * (LDK * 2) + ((c << 4) ^ ((k0 & 15) << 4)));
    const int r = (lane >> 1) & 3, half = lane & 1, s8 = lane >> 3;
    { const int p = wid,     db = (s8 - (p & 1)) & 7; vgo0 = (unsigned)((4 * p + r) * (LDK * 2) + (16 * db + 8 * half) * 2); }
 }
  const int kb0 = c * 256 + ((g ^ c) << 4);
  typedef __attribute__((address_space(3))) unsigned char* ldsp_t;
  const ldsp_t lds3 = (ldsp_t)lds;
  const int w1k = __builtin_amdgcn_readfirstlane(wid) * 1024;
  constexpr int VRING = 3 * 16384;
#define DMAK(t, soff) do { const char* b_ = (const char*)((t) == 0 ? KMh : Kh + (long)((t) - 1) * KVBLK * LDK); \
    __builtin_amdgcn_global_load_lds((const unsigned*)(b_ + kgo0), (__attribute__((address_space(3))) unsigned*)(lds3 + (soff) + w1k), 16, 0, 0); \
    __builtin_amdgcn_global_load_lds((const unsigned*)(b_ + kgo0 + 32 * LDK * 2), (__attribute__((address_space(3))) unsigned*)(lds3 + (soff) + w1k + 8192), 16, 0, 0); } while (0)
#define DMAV(t, soff) do { const char* b_ = (const char*)((t) == 0 ? VMh : Vh + (long)((t) - 1) * KVBLK * LDK); \
    __builtin_amdgcn_global_load_lds((const unsigned*)(b_ + vgo0), (__attribute__((address_space(3))) unsigned*)(lds3 + VRING + (soff) + w1k), 16, 0, 0); \
    __builtin_amdgcn_global_load_lds((const unsigned*)(b_ + vgo0 + 32 * LDK * 2), (__attribute__((address_space(3))) unsigned*)(lds3 + VRING + (soff) + w1k + 8192), 16, 0, 0); } while (0)
#define WAITBAR(N) asm volatile("s_waitcnt vmcnt(" #N ") lgkmcnt(0)\n\ts_barrier" ::: "memory")
#define ROT() do { const int t_ = sm1; sm1 = sc_; sc_ = sp1; sp1 = t_; } while (0)
#define RESC(a) do { if (__any(__builtin_fminf((a)[0], (a)[1]) < 1.f)) { if (g == 0) { al_l[c] = (a)[0]; al_l[16 + c] = (a)[1]; } asm volatile("s_waitcnt lgkmcnt(0)" ::: "memory"); \
    _Pragma("unroll") for (int qb_ = 0; qb_ < 2; ++qb_) _Pragma("unroll") for (int r_ = 0; r_ < 4; ++r_) { const float a_ = al_l[16 * qb_ + 4 * g + r_]; \
      _Pragma("unroll") for (int db_ = 0; db_ < 8; ++db_) O[qb_][db_][r_] *= a_; } } } while (0)
  DMAK(0, 0); DMAV(0, 0); DMAK(1, 16384);
  bf16x8 qf[2][4];
#pragma unroll
  for (int qb = 0; qb < 2; ++qb)
#pragma unroll
    for (int ds = 0; ds < 4; ++ds) qf[qb][ds] = *reinterpret_cast<const bf16x8*>(Qb + (long)(wid * QBLK + 16 * qb + c) * LDQ + 32 * ds + 8 * g);
  {
    int go = g; asm volatile("" : "+v"(go));
#pragma unroll
    for (int qb = 0; qb < 2; ++qb) {
      float ss = 0.f;
#pragma unroll
      for (int ds = 0; ds < 4; ++ds)
#pragma unroll
        for (int j = 0; j < 8; ++j) { const float x = bfl(qf[qb][ds][j]); ss += x * x; }
      ss += __shfl_xor(ss, 16); ss += __shfl_xor(ss, 32);
      const float rs = (SCALE * 1.4426950408889634f) / sqrtf(ss * (1.f / 128.f) + 1e-6f);
      int t = t0 + wid * QBLK + 16 * qb + c; asm volatile("" : "+v"(t));
#pragma unroll
      for (int p = 0; p < 2; ++p) { const float pos = (float)(p ? (t & 63) : (t >> 6)); const int fa = 2 * p, fb = 2 * p + 1;
        const float4 ga0 = *reinterpret_cast<const float4*>(qnorm + 32 * fa + 8 * g), ga1 = *reinterpret_cast<const float4*>(qnorm + 32 * fa + 8 * g + 4);
        const float4 gb0 = *reinterpret_cast<const float4*>(qnorm + 32 * fb + 8 * g), gb1 = *reinterpret_cast<const float4*>(qnorm + 32 * fb + 8 * g + 4);
        const float gaf[8] = {ga0.x, ga0.y, ga0.z, ga0.w, ga1.x, ga1.y, ga1.z, ga1.w}, gbf[8] = {gb0.x, gb0.y, gb0.z, gb0.w, gb1.x, gb1.y, gb1.z, gb1.w};
        float oa[8], ob[8];
#pragma unroll
        for (int j = 0; j < 8; ++j) { const int i = 8 * go + j;
          float rev = pos * __builtin_amdgcn_exp2f(-(float)i * (13.287712379549449f / 32.f)) * 0.15915494309189535f; rev -= floorf(rev);
          const float sn = __builtin_amdgcn_sinf(rev), cs = __builtin_amdgcn_cosf(rev);
          const float x1 = bfl(qf[qb][fa][j]) * rs * gaf[j], x2 = bfl(qf[qb][fb][j]) * rs * gbf[j];
          oa[j] = x1 * cs - x2 * sn; ob[j] = x2 * cs + x1 * sn; }
        { u32x4 w = {cvtpk(oa[0], oa[1]), cvtpk(oa[2], oa[3]), cvtpk(oa[4], oa[5]), cvtpk(oa[6], oa[7])}; qf[qb][fa] = *reinterpret_cast<bf16x8*>(&w); }
        { u32x4 w = {cvtpk(ob[0], ob[1]), cvtpk(ob[2], ob[3]), cvtpk(ob[4], ob[5]), cvtpk(ob[6], ob[7])}; qf[qb][fb] = *reinterpret_cast<bf16x8*>(&w); }
        SBAR(); }
    }
  }
  const int vlb = (int)(uintptr_t)(lds + VRING) + g * 1024 + (c >> 2) * 32 + (c & 3) * 8;
  const int vbA0 = vlb + (g & 1) * 128, vbB0 = vlb + (g & 1) * (128 - 1024);
  int sm1 = 32768, sc_ = 0, sp1 = 16384;
  f32x4 S[4][2]; bf16x8 paA[2][2], paB[2][2]; float al[2];
  WAITBAR(2);
  DMAK(2, sm1); DMAV(1, sp1);
  qkt16(S, lds + sc_, kb0, qf, -mhat[0], -mhat[1]); mask_meta16(S); partial16(S, mhat, al, true); finish16(S, al, lsum, paA);
  WAITBAR(4); ROT();
  for (int t = 1; t + 1 < NT; t += 2) {
    if (t + 2 < NT) DMAK(t + 2, sm1); DMAV(t + 1, sp1);
    SBAR(); qkt16(S, lds + sc_, kb0, qf, -mhat[0], -mhat[1]); SBAR();
    pv16(O, vbA0 + sm1, vbB0 + sm1, paA); partial16(S, mhat, al, false); finish16(S, al, lsum, paB);
    if (t + 2 < NT) WAITBAR(4); else WAITBAR(2);
    RESC(al); ROT();
    if (t + 3 < NT) DMAK(t + 3, sm1); if (t + 2 < NT) DMAV(t + 2, sp1);
    SBAR(); qkt16(S, lds + sc_, kb0, qf, -mhat[0], -mhat[1]); SBAR();
    pv16(O, vbA0 + sm1, vbB0 + sm1, paB); partial16(S, mhat, al, false); finish16(S, al, lsum, paA);
    if (t + 3 < NT) WAITBAR(4); else if (t + 2 < NT) WAITBAR(2); else WAITBAR(0);
    RESC(al); ROT();
  }
  pv16(O, vbA0 + sm1, vbB0 + sm1, paA);
#pragma unroll
  for (int qb = 0; qb < 2; ++qb) { float L = lsum[qb]; L += __shfl_xor(L, 16); L += __shfl_xor(L, 32); if (g == 0) li_l[16 * qb + c] = L; }
  asm volatile("s_waitcnt lgkmcnt(0)" ::: "memory");
  bf16r* Ow = Ob + (long)(wid * QBLK) * LDO;
#pragma unroll
  for (int qb = 0; qb < 2; ++qb)
#pragma unroll
    for (int r = 0; r < 4; ++r) { const int orow = 16 * qb + 4 * g + r; const float rl = __builtin_amdgcn_rcpf(li_l[orow]); float sq = 0.f;
#pragma unroll
      for (int db = 0; db < 8; ++db) { const float v = O[qb][db][r] * rl; sq += v * v; Ow[(long)orow * LDO + 16 * db + c] = f2bf_rne(v); }
      sq += __shfl_xor(sq, 1); sq += __shfl_xor(sq, 2); sq += __shfl_xor(sq, 4); sq += __shfl_xor(sq, 8);
      if (c == 0) ssq[(long)(wid * QBLK + orow) * 8] = sq; }
  asm volatile("s_waitcnt lgkmcnt(0)\n\ts_barrier" ::: "memory");
#undef DMAK
#undef DMAV
#undef WAITBAR
#undef ROT
#undef RESC
}
#undef SBAR
}

constexpr int NWAVES = 8;
constexpr int DM = 2048, NTOK = 65536, INW = 3584, FFN = 5632, UPW = 2 * FFN;
constexpr float EPS = 1e-6f;
constexpr int XR_ROWS = 8 * 4160 + 4 * 8256;
constexpr int NCHUNK = 8 * 65 + 4 * 129;
constexpr int HROWS = 32768;
__host__ __device__ __forceinline__ int seq_first_row(int s) { return s < 8 ? s * 4096 : 32768 + (s - 8) * 8192; }
__host__ __device__ __forceinline__ int seq_len(int s) { return s < 8 ? 4096 : 8192; }
__host__ __device__ __forceinline__ int xr_base(int s) { return s < 8 ? s * 4160 : 33280 + (s - 8) * 8256; }
__host__ __device__ __forceinline__ int chunk_base(int s) { return s < 8 ? s * 65 : 520 + (s - 8) * 129; }
__host__ __device__ __forceinline__ int row_seq(int row) { return row < 32768 ? (row >> 12) : 8 + ((row - 32768) >> 13); }

constexpr size_t MiB = 1u << 20, KiB = 1u << 10;
constexpr size_t WS_CTL = 0, CTL_ZERO_BYTES = 1 * MiB;
constexpr size_t WS_SMALL = 1 * MiB;
constexpr size_t WS_XNMETA = WS_SMALL + 0, WS_ZM = WS_SMALL + 64 * KiB, WS_KM = WS_SMALL + 320 * KiB, WS_VM = WS_SMALL + 352 * KiB, WS_Q15 = WS_SMALL + 384 * KiB, WS_GY15 = WS_SMALL + 388 * KiB,
                 WS_LO15 = WS_SMALL + 392 * KiB, WS_MIXED15 = WS_SMALL + 448 * KiB, WS_Y15 = WS_SMALL + 544 * KiB, WS_G15 = WS_SMALL + 640 * KiB, WS_MQP = WS_SMALL + 1024 * KiB;
constexpr size_t WS_WIN = 5 * MiB, WS_WOUT = 19 * MiB, WS_WUP = 27 * MiB, WS_WDOWN = 71 * MiB, WS_WG = 93 * MiB;
constexpr size_t WS_CAR = 94 * MiB, WS_CIN = 111 * MiB;
constexpr size_t WS_R0 = 120 * MiB, WS_RATIO = 120 * MiB + 256 * KiB, WS_RL = 120 * MiB + 512 * KiB, WS_SSQA = 121 * MiB, WS_SSQL = 123 * MiB;
constexpr size_t WS_A = 128 * MiB;
constexpr size_t WS_B = 384 * MiB;
constexpr size_t WS_QG = WS_B, WS_K = WS_B + 256 * MiB, WS_V = WS_B + 288 * MiB, WS_XR = WS_B + 320 * MiB;
constexpr size_t WS_ACT = WS_B, WS_EDGE = WS_B + 352 * MiB;
constexpr size_t WS_H1A = WS_B + 420 * MiB;
constexpr size_t WS_END = WS_B + 548 * MiB;
static_assert(WS_ZM + 16 * INW * 4 <= WS_KM && WS_G15 + 12 * FFN * 4 <= WS_MQP && WS_MQP + 512 * 4 * 132 * 4 <= WS_WIN, "small map");
static_assert(WS_WIN + (size_t)INW * DM * 2 <= WS_WOUT && WS_WOUT + (size_t)DM * DM * 2 <= WS_WUP && WS_WUP + (size_t)UPW * DM * 2 <= WS_WDOWN && WS_WDOWN + (size_t)DM * FFN * 2 <= WS_WG && WS_WG + 32 * 16384 * 2 <= WS_CAR, "weights map");
static_assert(WS_CAR + (size_t)NCHUNK * 2 * 1024 * 8 <= WS_CIN && WS_A + (size_t)NTOK * DM * 2 <= WS_B, "carry map");
static_assert(WS_QG + (size_t)NTOK * DM * 2 <= WS_K && WS_XR + (size_t)(XR_ROWS + 64) * 1024 * 2 <= WS_END && WS_EDGE + (size_t)512 * 2 * 3 * FFN * 4 <= WS_H1A && WS_H1A + (size_t)HROWS * DM * 2 <= WS_END && WS_END <= 1024 * MiB && WS_CIN + (size_t)NCHUNK * 2 * 1024 * 4 <= WS_R0 && WS_SSQL + (size_t)NTOK * 8 * 4 <= WS_A && WS_ACT + (size_t)HROWS * FFN * 2 <= WS_EDGE && WS_EDGE + (size_t)512 * 2 * 3 * FFN * 4 <= WS_END, "B map");
constexpr int CW_BAR = 4096;

constexpr int RING_BYTES = 131072;
constexpr int LDSCTL_OFF = RING_BYTES, MISC_OFF = LDSCTL_OFF + 320;
constexpr int LDS_BYTES = 147456;

#define GAS __attribute__((address_space(1)))
#define LAS __attribute__((address_space(3)))
typedef unsigned short bf16;
typedef unsigned v4u __attribute__((ext_vector_type(4)));
typedef float f32x4 __attribute__((ext_vector_type(4)));
typedef short bf16x8 __attribute__((ext_vector_type(8)));
typedef GAS unsigned gu32;
typedef GAS unsigned long long gu64;
#define RLX_AGENT __ATOMIC_RELAXED, __HIP_MEMORY_SCOPE_AGENT
#define LDS_WAIT() asm volatile("s_waitcnt lgkmcnt(0)" ::: "memory")
#define VM_WAIT() asm volatile("s_waitcnt vmcnt(0)" ::: "memory")
__device__ __forceinline__ unsigned long long rt() { return __builtin_amdgcn_s_memrealtime(); }
__device__ __forceinline__ unsigned f2bf(float f) { unsigned u = __builtin_bit_cast(unsigned, f); return (u + 0x7fffu + ((u >> 16) & 1u)) >> 16; }
__device__ __forceinline__ unsigned pk2(float lo, float hi) { return f2bf(lo) | (f2bf(hi) << 16); }

#define XB_TMO      128
#define XB_XCNT(j)  (256  + 64 * (j))
#define XB_XSUB(j)  (1280 + 64 * (j))
#define XB_XGEN(j)  (2304 + 64 * (j))
#define XB_TOP      3328
#define XB_TOPGEN   3392
#define XCD_BAR_WORDS 3456
#define XB_SPIN_CAP (1u << 18)

__device__ __forceinline__ unsigned xb_ld(unsigned* p)              { return __hip_atomic_load(p, __ATOMIC_RELAXED, __HIP_MEMORY_SCOPE_AGENT); }
__device__ __forceinline__ unsigned xb_add(unsigned* p, unsigned v) { return __hip_atomic_fetch_add(p, v, __ATOMIC_RELAXED, __HIP_MEMORY_SCOPE_AGENT); }
__device__ __forceinline__ unsigned xb_xcc_id() { return (unsigned)__builtin_amdgcn_s_getreg((3 << 11) | 20) & 0xFu; }
#define XB_SPIN(cond, bar) do { unsigned _sp = 0; while (cond) { __builtin_amdgcn_s_sleep(1); \
    if ((++_sp & 255u) == 0u) { if (xb_ld(&(bar)[XB_TMO])) break; if (_sp > XB_SPIN_CAP) { atomicAdd(&(bar)[XB_TMO], 1u); break; } } } } while (0)

struct XcdBarrier {
    unsigned* bar; unsigned x;
    volatile LAS unsigned* st;
};

__device__ __forceinline__ XcdBarrier xcd_barrier_post(unsigned* bar, volatile LAS unsigned* st, bool t0  ) {
    XcdBarrier b; b.bar = bar; b.x = xb_xcc_id(); b.st = st;
    if (t0) (void)xb_add(&bar[XB_XCNT(b.x)], 1u);
    return b;
}
__device__ __forceinline__ void xcd_barrier_complete(unsigned* bar, unsigned x, unsigned& nloc, unsigned& nx) {
    const unsigned G = gridDim.x * gridDim.y * gridDim.z;
    unsigned sum, cnt, mine, sp = 0u;
    for (;;) {
        sum = 0u; cnt = 0u; mine = 0u;
#pragma unroll
        for (unsigned j = 0; j < 16; ++j) { const unsigned c = xb_ld(&bar[XB_XCNT(j)]); sum += c; cnt += (c > 0u) ? 1u : 0u; mine = (j == x) ? c : mine; }
        if (sum == G) break;
        __builtin_amdgcn_s_sleep(1);
        if ((++sp & 255u) == 0u) { if (xb_ld(&bar[XB_TMO])) break; if (sp > XB_SPIN_CAP) { atomicAdd(&bar[XB_TMO], 1u); break; } }
    }
    nloc = mine > 0u ? mine : 1u; nx = cnt > 0u ? cnt : 1u;
}

__device__ __forceinline__ void xcd_barrier(const XcdBarrier& b, bool t0  ) {
    asm volatile("s_waitcnt vmcnt(0)" ::: "memory");
    __syncthreads();
    if (t0) {
        unsigned* bar = b.bar;
        __builtin_amdgcn_s_waitcnt(0);
        unsigned nloc = b.st[0], nx = b.st[1];
        if (nloc == 0u) { xcd_barrier_complete(bar, b.x, nloc, nx); b.st[0] = nloc; b.st[1] = nx; }
        const unsigned old = xb_add(&bar[XB_XSUB(b.x)], 1u);
        const unsigned gen = old / nloc;
        if (old + 1u == (gen + 1u) * nloc) {
            __builtin_amdgcn_fence(__ATOMIC_RELEASE, "agent");
            asm volatile("s_waitcnt vmcnt(0)" ::: "memory");
            const unsigned og = xb_add(&bar[XB_TOP], 1u);
            const unsigned tg = og / nx;
            if (og + 1u == (tg + 1u) * nx) xb_add(&bar[XB_TOPGEN], 1u);
            else XB_SPIN(xb_ld(&bar[XB_TOPGEN]) == tg, bar);
            __builtin_amdgcn_fence(__ATOMIC_ACQUIRE, "agent");
            xb_add(&bar[XB_XGEN(b.x)], 1u);
            asm volatile("s_waitcnt vmcnt(0)" ::: "memory");
        } else {
            XB_SPIN(xb_ld(&bar[XB_XGEN(b.x)]) == gen, bar);
            __builtin_amdgcn_fence(__ATOMIC_ACQUIRE, "agent");
            asm volatile("s_waitcnt vmcnt(0)" ::: "memory");
        }
    }
    __syncthreads();
}

__device__ __forceinline__ float bf2f(unsigned short b) { return __builtin_bit_cast(float, (unsigned)b << 16); }
__device__ __forceinline__ float bf2f(short b) { return __builtin_bit_cast(float, (unsigned)(unsigned short)b << 16); }
__device__ __forceinline__ float wave_sum(float v) {
#pragma unroll
    for (int o = 1; o < 64; o <<= 1) v += __shfl_xor(v, o);
    return v;
}
__device__ __forceinline__ float wave_max(float v) {
#pragma unroll
    for (int o = 1; o < 64; o <<= 1) v = fmaxf(v, __shfl_xor(v, o));
    return v;
}
__device__ __forceinline__ float fast_exp(float x) { return __builtin_amdgcn_exp2f(x * 1.4426950408889634f); }
__device__ __forceinline__ float sigmoidf_(float x) { return __builtin_amdgcn_rcpf(1.f + fast_exp(-x)); }
__device__ __forceinline__ float gelu_tanh(float x) {
    const float z = 0.7978845608028654f * (x + 0.044715f * x * x * x);
    return x * sigmoidf_(2.f * z);
}
__device__ __forceinline__ float neg_expm1(float x) {
    const float p = x * (1.f + x * (0.5f + x * (0.16666667f + x * (0.041666668f + x * (0.0083333338f + x * 0.0013888889f)))));
    const float e = fast_exp(x) - 1.f;
    return -(fabsf(x) < 0.25f ? p : e);
}
__device__ __forceinline__ v4u pack8(const float (&v)[8]) { v4u o; o.x = pk2(v[0], v[1]); o.y = pk2(v[2], v[3]); o.z = pk2(v[4], v[5]); o.w = pk2(v[6], v[7]); return o; }

#define FIN(F, idx) ({ const __attribute__((address_space(1))) float* p_; asm("s_load_dwordx2 %0, %1, %2 ; tag %3\n\ts_waitcnt lgkmcnt(0)" : "=s"(p_) : "s"((F).kargs), "i"((idx) * 8), "s"((F).ptag)); (const float*)p_; })
struct Frame {
    LAS unsigned char* lds;
    volatile LAS unsigned* MISC;
    gu32* ctl;
    int tid, lane, wave, vcu, G;
    const __attribute__((address_space(4))) void* kargs; int ptag;
    float* out;
    unsigned char* ws;
#define WSP(T, NAME, OFF) __device__ __forceinline__ T* NAME() const { return (T*)(ws + (OFF)); }
    WSP(bf16, WIN_T, WS_WIN) WSP(bf16, WOUT_T, WS_WOUT) WSP(bf16, WUP_T, WS_WUP) WSP(bf16, WDOWN_T, WS_WDOWN) WSP(bf16, WG, WS_WG) WSP(bf16, XN, WS_A) WSP(bf16, QG, WS_QG) WSP(bf16, K, WS_K) WSP(bf16, V, WS_V)
    WSP(bf16, XR, WS_XR) WSP(bf16, ACT, WS_ACT) WSP(bf16, H1A, WS_H1A) WSP(float, EDGE, WS_EDGE) WSP(bf16, XNMETA, WS_XNMETA) WSP(bf16, KM, WS_KM) WSP(bf16, VM, WS_VM)
    WSP(float, ZM, WS_ZM) WSP(float, Q15, WS_Q15) WSP(float, GY15, WS_GY15) WSP(float, LO15, WS_LO15) WSP(float, MIXED15, WS_MIXED15) WSP(float, Y15, WS_Y15) WSP(float, G15, WS_G15) WSP(float, MQP, WS_MQP)
    WSP(float, CIN, WS_CIN) WSP(float2, CAR, WS_CAR) WSP(float, R0, WS_R0) WSP(float, RATIO, WS_RATIO) WSP(float, RL, WS_RL) WSP(float, SSQA, WS_SSQA) WSP(float, SSQL, WS_SSQL)
#undef WSP
};

template <bool UPMAP, int GAIN = 0>
__device__ __forceinline__ void p0_transpose_item(const float* W, int K, int N, bf16* WT, int row_off, LAS float* scr, int item, int lane, const float* g0 = nullptr, const float* g1 = nullptr) {
    const int nblk = N / 32, kb = item / nblk, nb = item % nblk, k0 = 64 * kb, n0 = 32 * nb;
    const int orow0 = UPMAP ? (((n0 % FFN) >> 7) << 8) + 128 * (n0 / FFN) + ((n0 % FFN) & 127) : row_off + n0;
    float wv[32];
#pragma unroll
    for (int i = 0; i < 32; ++i) { const int kk = 2 * i + (lane >> 5); wv[i] = W[(size_t)(k0 + kk) * N + n0 + (lane & 31)]; }
#pragma unroll
    for (int i = 0; i < 32; ++i) { const int kk = 2 * i + (lane >> 5); float gv = 1.f; if (GAIN == 1) gv = g0[k0 + kk]; if (GAIN == 2) gv = (k0 + kk) < 1024 ? g0[k0 + kk] : g1[k0 + kk - 1024];
        scr[kk * 33 + (lane & 31)] = wv[i] * gv; }
    LDS_WAIT(); asm volatile("" ::: "memory");
    const int c = lane & 7;
#pragma unroll
    for (int j = 0; j < 4; ++j) { const int n = (lane >> 3) + 8 * j; const LAS float* s = scr + (8 * c) * 33 + n;
        v4u o; o.x = pk2(s[0 * 33], s[1 * 33]); o.y = pk2(s[2 * 33], s[3 * 33]); o.z = pk2(s[4 * 33], s[5 * 33]); o.w = pk2(s[6 * 33], s[7 * 33]);
        *(GAS v4u*)(WT + (size_t)(orow0 + n) * K + k0 + 8 * c) = o; }
    LDS_WAIT(); asm volatile("" ::: "memory");
}
__device__ __forceinline__ void rms_row_to_bf16(const float* xrow, bf16* orow, int lane, float* rout) {
    const GAS f32x4* xr = (const GAS f32x4*)xrow + lane;
    f32x4 v[8]; float s = 0.f;
#pragma unroll
    for (int j = 0; j < 8; ++j) { v[j] = xr[64 * j]; s += (v[j].x * v[j].x + v[j].y * v[j].y) + (v[j].z * v[j].z + v[j].w * v[j].w); }
    const float r = 1.f / sqrtf(wave_sum(s) * (1.f / DM) + EPS);
    GAS unsigned long long* o8 = (GAS unsigned long long*)orow + lane;
#pragma unroll
    for (int j = 0; j < 8; ++j) o8[64 * j] = (unsigned long long)pk2(v[j].x * r, v[j].y * r) | ((unsigned long long)pk2(v[j].z * r, v[j].w * r) << 32);
    if (rout && lane == 0) *rout = r;
}
constexpr int WT_I_IN = (DM / 64) * (INW / 32), WT_I_OUT = (DM / 64) * (DM / 32), WT_I_UP = (DM / 64) * (UPW / 32), WT_I_DN = (FFN / 64) * (DM / 32), WT_I_G = 32 * 8;
constexpr int WT_O_OUT = WT_I_IN, WT_O_UP = WT_O_OUT + WT_I_OUT, WT_O_DN = WT_O_UP + WT_I_UP, WT_O_G = WT_O_DN + WT_I_DN, WT_NITEMS = WT_O_G + WT_I_G;
__device__ __forceinline__ void wt_items(Frame& F, int it0, int it1, int gw, int NGW) {
    LAS float* scr = (LAS float*)(F.lds + F.wave * 16384);
    for (int it = it0 + gw; it < it1; it += NGW) {
        int r = it;
        if (r < WT_I_IN) { p0_transpose_item<false, 1>(FIN(F, 4  ), DM, INW, F.WIN_T(), 0, scr, r, F.lane, FIN(F, 3  )); continue; } r -= WT_I_IN;
        if (r < WT_I_OUT) { p0_transpose_item<false, 2>(FIN(F, 16  ), DM, DM, F.WOUT_T(), 0, scr, r, F.lane, FIN(F, 14  ), FIN(F, 15  )); continue; } r -= WT_I_OUT;
        if (r < WT_I_UP) { p0_transpose_item<true>(FIN(F, 19  ), DM, UPW, F.WUP_T(), 0, scr, r, F.lane); continue; } r -= WT_I_UP;
        if (r < WT_I_DN) { p0_transpose_item<false>(FIN(F, 22  ), FFN, DM, F.WDOWN_T(), 0, scr, r, F.lane); continue; } r -= WT_I_DN;
        {
            const int mi = r >> 3, sub = r & 7, gate = mi >> 4, dir = (mi >> 3) & 1, blk = mi & 7;
            const float* W = (gate ? FIN(F, 11  ) : FIN(F, 9  )) + (size_t)(dir * 8 + blk) * 16384;
            bf16* WT = F.WG() + (size_t)((dir * 2 + gate) * 8 + blk) * 16384;
            p0_transpose_item<false>(W, 128, 128, WT, 0, scr, sub, F.lane);
        }
    }
}
__device__ __forceinline__ void p0_prologue(Frame& F) {
    const int gw = F.vcu * NWAVES + F.wave, NGW = F.G * NWAVES;
    wt_items(F, 0, WT_O_OUT, gw, NGW);
    wt_items(F, WT_O_G, WT_NITEMS, gw, NGW);
    {
        const float* xp = FIN(F, 0  ); const float* xs = FIN(F, 1  ); const int lane = F.lane;
        f32x4 v[8], vn[8];
#define P0_LOAD(M, V) do { const GAS f32x4* xr_ = (const GAS f32x4*)((M) < 32768 ? xp + (size_t)(M) * DM : xs + (size_t)((M) - 32768) * DM) + lane; \
            _Pragma("unroll") for (int j_ = 0; j_ < 8; ++j_) V[j_] = xr_[64 * j_]; } while (0)
        int m = gw;
        if (m < NTOK) P0_LOAD(m, v);
        for (; m < NTOK; m += NGW) {
            const int mn = m + NGW < NTOK ? m + NGW : m;
            P0_LOAD(mn, vn);
            float s = 0.f;
#pragma unroll
            for (int j = 0; j < 8; ++j) s += (v[j].x * v[j].x + v[j].y * v[j].y) + (v[j].z * v[j].z + v[j].w * v[j].w);
            const float r = 1.f / sqrtf(wave_sum(s) * (1.f / DM) + EPS);
            GAS unsigned long long* o8 = (GAS unsigned long long*)(F.XN() + (size_t)m * DM) + lane;
#pragma unroll
            for (int j = 0; j < 8; ++j) o8[64 * j] = (unsigned long long)pk2(v[j].x * r, v[j].y * r) | ((unsigned long long)pk2(v[j].z * r, v[j].w * r) << 32);
            if (lane == 0) F.R0()[m] = r;
#pragma unroll
            for (int j = 0; j < 8; ++j) v[j] = vn[j];
        }
#undef P0_LOAD
    }
    for (int m = gw; m < 16; m += NGW) rms_row_to_bf16(FIN(F, 2  ) + (size_t)m * DM, F.XNMETA() + (size_t)m * DM, F.lane, nullptr);
    const int gt = F.vcu * 512 + F.tid, NGT = F.G * 512; const v4u z4 = {0u, 0u, 0u, 0u};
    for (int i = gt; i < 12 * 48 * 128; i += NGT) { const int s = i / (48 * 128), rem = i % (48 * 128); ((GAS v4u*)(F.XR() + (size_t)xr_base(s) * 1024))[rem] = z4; }
    for (int i = gt; i < 64 * 128; i += NGT) ((GAS v4u*)(F.XR() + (size_t)XR_ROWS * 1024))[i] = z4;
    for (int i = gt; i < 2048; i += NGT) { ((GAS v4u*)F.KM())[i] = z4; ((GAS v4u*)F.VM())[i] = z4; }
}

template <int R, class Out, bool GMAP = false>
__device__ __forceinline__ void small_gemm(const LAS float* X, int K, const bf16* Wt, int N, int gw, int NGW, int lane, const Out& out) {
    for (int n = gw; n < N; n += NGW) {
        float acc[R];
#pragma unroll
        for (int r = 0; r < R; ++r) acc[r] = 0.f;
        const GAS bf16x8* wrow = (const GAS bf16x8*)(Wt + (size_t)(GMAP ? ((n >> 7) << 8) + (n & 127) : n) * K);
        bf16x8 wq[4];
#pragma unroll
        for (int q = 0; q < 4; ++q) wq[q] = wrow[lane + 64 * q];
#pragma unroll
        for (int q = 0; q < 4; ++q) { const int k8 = lane + 64 * q;
            asm volatile("" ::: "memory");
            const bf16x8 w = wq[q]; float wf[8];
#pragma unroll
            for (int j = 0; j < 8; ++j) wf[j] = bf2f(w[j]);
#pragma unroll
            for (int r = 0; r < R; ++r) { const LAS f32x4* xp = (const LAS f32x4*)(X + r * K + k8 * 8); const f32x4 a = xp[0], b = xp[1];
                acc[r] += (a.x * wf[0] + a.y * wf[1]) + (a.z * wf[2] + a.w * wf[3]) + (b.x * wf[4] + b.y * wf[5]) + (b.z * wf[6] + b.w * wf[7]); }
        }
        float v = 0.f;
#pragma unroll
        for (int r = 0; r < R; ++r) { const float s = wave_sum(acc[r]); v = (lane == r) ? s : v; }
        out(n, lane, v);
    }
}
struct OutMetaZ { float* ZM; bf16* XR;
    __device__ __forceinline__ void operator()(int n, int lane, float v) const {
        if (lane < 16) { ZM[lane * INW + n] = v;
            if (n >= 1536 && n < 2560) { const unsigned short b = (unsigned short)f2bf(v); const int c = n - 1536;
                for (int s = 0; s < 12; ++s) XR[(size_t)(xr_base(s) + 48 + lane) * 1024 + c] = b; } }
    } };
struct OutRows { float* Y; int ld; int R;
    __device__ __forceinline__ void operator()(int n, int lane, float v) const { if (lane < R) Y[(size_t)lane * ld + n] = v; } };

__device__ __forceinline__ void p1_meta_z(Frame& F) {
    LAS float* X = (LAS float*)F.lds;
    for (int i = F.tid; i < 16 * DM / 8; i += 512) { const bf16x8 v = ((const GAS bf16x8*)F.XNMETA())[i];
        ((LAS f32x4*)X)[2 * i] = (f32x4){bf2f(v[0]), bf2f(v[1]), bf2f(v[2]), bf2f(v[3])}; ((LAS f32x4*)X)[2 * i + 1] = (f32x4){bf2f(v[4]), bf2f(v[5]), bf2f(v[6]), bf2f(v[7])}; }
    __syncthreads();
    const OutMetaZ o{F.ZM(), F.XR()};
    small_gemm<16, OutMetaZ>(X, DM, F.WIN_T(), INW, F.vcu * NWAVES + F.wave, F.G * NWAVES, F.lane, o);
    __syncthreads();
}
typedef float f32x16 __attribute__((ext_vector_type(16)));
constexpr int LRU_XC0 = 0, LRU_XC_BUF = 17408, LRU_XC_STRIDE = 272;
constexpr int LRU_CW = 34816;
constexpr int LRU_HF = 37376, LRU_HB = LRU_HF + 32768;
__device__ __forceinline__ int crow16(int r, int hi) { return (r & 3) + 8 * (r >> 2) + 4 * hi; }

template <int DIR>
__device__ __forceinline__ void scan_tile(const float (&a)[16], const float (&u)[16], float& carry, float& ptot, float (&h)[16], bool up) {
    float HL[16], PL[16], As[4], Hs[4];
#pragma unroll
    for (int j = 0; j < 4; ++j) {
        float hl = 0.f, p = 1.f;
#pragma unroll
        for (int ii = 0; ii < 4; ++ii) { const int idx = 4 * j + (DIR == 0 ? ii : 3 - ii); hl = a[idx] * hl + u[idx]; p *= a[idx]; HL[idx] = hl; PL[idx] = p; }
        As[j] = p; Hs[j] = hl;
    }
    float Alo[4], Ahi[4], Hlo[4], Hhi[4];
#pragma unroll
    for (int j = 0; j < 4; ++j) {
        { const unsigned x = __float_as_uint(As[j]); auto rr = __builtin_amdgcn_permlane32_swap(x, x, false, false); Alo[j] = __uint_as_float(rr[0]); Ahi[j] = __uint_as_float(rr[1]); }
        { const unsigned x = __float_as_uint(Hs[j]); auto rr = __builtin_amdgcn_permlane32_swap(x, x, false, false); Hlo[j] = __uint_as_float(rr[0]); Hhi[j] = __uint_as_float(rr[1]); }
    }
    float cin[4]; float c = carry;
    if (DIR == 0) {
#pragma unroll
        for (int j = 0; j < 4; ++j) { const float c_lo = c; c = Alo[j] * c + Hlo[j]; const float c_hi = c; c = Ahi[j] * c + Hhi[j]; cin[j] = up ? c_hi : c_lo; }
    } else {
#pragma unroll
        for (int j = 3; j >= 0; --j) { const float c_hi = c; c = Ahi[j] * c + Hhi[j]; const float c_lo = c; c = Alo[j] * c + Hlo[j]; cin[j] = up ? c_hi : c_lo; }
    }
    carry = c;
#pragma unroll
    for (int j = 0; j < 4; ++j) ptot *= Alo[j] * Ahi[j];
#pragma unroll
    for (int idx = 0; idx < 16; ++idx) h[idx] = HL[idx] + PL[idx] * cin[idx >> 2];
}

__device__ __forceinline__ void lru_decode(int cg, int& seq, int& c) { if (cg < 520) { seq = cg / 65; c = cg - seq * 65; } else { const int c2 = cg - 520; seq = c2 / 129; c = c2 - seq * 129; seq += 8; } }
template <int PASS>
__device__ __forceinline__ void lru_phase(Frame& F, bf16* gout) {
    LAS unsigned char* L = F.lds;
    const int tid = F.tid, lane = F.lane, wave = F.wave;
    const int n = F.vcu & 7, ngrp = F.G >> 3;
    { const float* cw = FIN(F, 7  ); const float* cb = FIN(F, 8  );
      for (int i = tid; i < 640; i += 512) { const int k = i >> 7, ch = i & 127; ((LAS float*)(L + LRU_CW))[i] = k < 4 ? cw[k * 1024 + n * 128 + ch] : cb[n * 128 + ch]; } }
    const int d = wave >> 2, g4 = wave & 3, r32 = lane & 31, hi = lane >> 5, chl = g4 * 32 + r32, chg = n * 128 + chl;
    bf16x8 br[8], bi[8];
    { const bf16* wr_ = F.WG() + (size_t)((d * 2 + 0) * 8 + n) * 16384 + chl * 128 + hi * 8;
      const bf16* wi_ = F.WG() + (size_t)((d * 2 + 1) * 8 + n) * 16384 + chl * 128 + hi * 8;
#pragma unroll
      for (int ks = 0; ks < 8; ++ks) { br[ks] = *(const GAS bf16x8*)(wr_ + ks * 16); bi[ks] = *(const GAS bf16x8*)(wi_ + ks * 16); } }
    constexpr float L2E = 1.4426950408889634f;
    const float nb_r = -L2E * FIN(F, 10  )[d * 1024 + chg], nb_i = -L2E * FIN(F, 12  )[d * 1024 + chg];
    const float spl = 8.f * L2E * log1pf(expf(-FIN(F, 13  )[d * 1024 + chg]));
    const int tau0 = tid >> 4, co = (tid & 15) * 8;
    bf16x8 xv[2][4];
#define LRU_PREFETCH(cgx) do { int s_, c_; lru_decode((cgx), s_, c_); const int xb_ = xr_base(s_); \
        _Pragma("unroll") for (int it_ = 0; it_ < 2; ++it_) _Pragma("unroll") for (int k_ = 0; k_ < 4; ++k_) { int row_ = xb_ + c_ * 64 + tau0 + 32 * it_ + k_ - 2; row_ = row_ < 0 ? 0 : row_; \
            xv[it_][k_] = *(const GAS bf16x8*)(F.XR() + (size_t)row_ * 1024 + n * 128 + co); } } while (0)
    int cg = F.vcu < 8 * ngrp ? F.vcu >> 3 : NCHUNK;
    if (cg < NCHUNK) LRU_PREFETCH(cg);
    __syncthreads();
    for (int ui = 0; cg < NCHUNK; cg += ngrp, ++ui) {
        int seq, c; lru_decode(cg, seq, c);
        LAS unsigned char* XC = L + LRU_XC0 + (ui & 1) * LRU_XC_BUF;
        float carry = 0.f, ptot = 1.f;
        if (PASS == 2) carry = F.CIN()[((size_t)cg * 2 + d) * 1024 + chg];
#pragma unroll
        for (int it = 0; it < 2; ++it) {
            const int tau = tau0 + 32 * it; float xc[8];
            { const LAS f32x4* cb = (const LAS f32x4*)(L + LRU_CW + (4 * 128 + co) * 4); const f32x4 b0 = cb[0], b1 = cb[1];
              xc[0] = b0.x; xc[1] = b0.y; xc[2] = b0.z; xc[3] = b0.w; xc[4] = b1.x; xc[5] = b1.y; xc[6] = b1.z; xc[7] = b1.w; }
#pragma unroll
            for (int k = 0; k < 4; ++k) { const LAS f32x4* wp = (const LAS f32x4*)(L + LRU_CW + (k * 128 + co) * 4); const f32x4 w0 = wp[0], w1 = wp[1]; const bf16x8 v = xv[it][k];
                xc[0] += w0.x * bf2f(v[0]); xc[1] += w0.y * bf2f(v[1]); xc[2] += w0.z * bf2f(v[2]); xc[3] += w0.w * bf2f(v[3]);
                xc[4] += w1.x * bf2f(v[4]); xc[5] += w1.y * bf2f(v[5]); xc[6] += w1.z * bf2f(v[6]); xc[7] += w1.w * bf2f(v[7]); }
            if (c == 0 && tau < 48) {
#pragma unroll
                for (int j = 0; j < 8; ++j) xc[j] = 0.f;
            }
            *(LAS v4u*)(XC + tau * LRU_XC_STRIDE + co * 2) = pack8(xc);
        }
        bf16x8 gv[2];
        const int row0 = seq_first_row(seq) + 64 * (c - 1);
        if (PASS == 2) { if (c > 0) {
#pragma unroll
            for (int it = 0; it < 2; ++it) gv[it] = *(const GAS bf16x8*)(F.QG() + (size_t)(row0 + tau0 + 32 * it) * DM + 1024 + n * 128 + co); } }
        __syncthreads();
        if (cg + ngrp < NCHUNK) LRU_PREFETCH(cg + ngrp);
        f32x16 arT[2], aiT[2];
#pragma unroll
        for (int tt = 0; tt < 2; ++tt) {
            const int tile = d ? 1 - tt : tt;
            f32x16 ar = {}, ai = {};
#pragma unroll
            for (int ks = 0; ks < 8; ++ks) {
                const bf16x8 a = *(const LAS bf16x8*)(XC + (tile * 32 + r32) * LRU_XC_STRIDE + (ks * 16 + hi * 8) * 2);
                ar = __builtin_amdgcn_mfma_f32_32x32x16_bf16(a, br[ks], ar, 0, 0, 0);
                ai = __builtin_amdgcn_mfma_f32_32x32x16_bf16(a, bi[ks], ai, 0, 0, 0);
            }
            arT[tt] = ar; aiT[tt] = ai;
        }
#pragma unroll
        for (int tt = 0; tt < 2; ++tt) {
            const int tile = d ? 1 - tt : tt;
            const f32x16 ar = arT[tt], ai = aiT[tt];
            float av[16], uv[16], hv[16];
            typedef float f32x2 __attribute__((ext_vector_type(2)));
#pragma unroll
            for (int r = 0; r < 16; r += 2) {
                const int tau0_ = tile * 32 + crow16(r, hi);
                const f32x2 xc2 = {bf2f(*(const LAS unsigned short*)(XC + tau0_ * LRU_XC_STRIDE + chl * 2)), bf2f(*(const LAS unsigned short*)(XC + (tau0_ + 1) * LRU_XC_STRIDE + chl * 2))};
                const f32x2 tr = (f32x2){ar[r], ar[r + 1]} * (f32x2){-L2E, -L2E} + (f32x2){nb_r, nb_r};
                const f32x2 ti = (f32x2){ai[r], ai[r + 1]} * (f32x2){-L2E, -L2E} + (f32x2){nb_i, nb_i};
                const f32x2 dr = (f32x2){__builtin_amdgcn_exp2f(tr.x), __builtin_amdgcn_exp2f(tr.y)} + (f32x2){1.f, 1.f};
                const f32x2 di = (f32x2){__builtin_amdgcn_exp2f(ti.x), __builtin_amdgcn_exp2f(ti.y)} + (f32x2){1.f, 1.f};
                const f32x2 rg = {__builtin_amdgcn_rcpf(dr.x), __builtin_amdgcn_rcpf(dr.y)}, ig = {__builtin_amdgcn_rcpf(di.x), __builtin_amdgcn_rcpf(di.y)};
                const f32x2 la = rg * (f32x2){-spl, -spl};
                const f32x2 a = {__builtin_amdgcn_exp2f(la.x), __builtin_amdgcn_exp2f(la.y)};
                const f32x2 t = (f32x2){1.f, 1.f} - a * a;
                const f32x2 m = {__builtin_amdgcn_sqrtf(t.x), __builtin_amdgcn_sqrtf(t.y)};
                const f32x2 u = m * (ig * xc2);
                av[r] = a.x; av[r + 1] = a.y; uv[r] = u.x; uv[r + 1] = u.y;
            }
            if (d == 0) scan_tile<0>(av, uv, carry, ptot, hv, hi != 0); else scan_tile<1>(av, uv, carry, ptot, hv, hi != 0);
            if (PASS == 2) {
#pragma unroll
                for (int r = 0; r < 16; ++r) { const int tau = tile * 32 + crow16(r, hi); *(LAS float*)(L + (d ? LRU_HB : LRU_HF) + (tau * 128 + chl) * 4) = hv[r]; }
            }
        }
        if (PASS == 1) { if (hi == 0) F.CAR()[((size_t)cg * 2 + d) * 1024 + chg] = make_float2(ptot, carry); }
        if (PASS == 2) {
            __syncthreads();
            if (c > 0) {
#pragma unroll
                for (int it = 0; it < 2; ++it) {
                    const int tau = tau0 + 32 * it; const bf16x8 g8 = gv[it];
                    const LAS f32x4* hf = (const LAS f32x4*)(L + LRU_HF + (tau * 128 + co) * 4); const LAS f32x4* hb = (const LAS f32x4*)(L + LRU_HB + (tau * 128 + co) * 4);
                    const f32x4 f0 = hf[0], f1 = hf[1], b0 = hb[0], b1 = hb[1];
                    float o[8];
                    o[0] = (f0.x + b0.x) * gelu_tanh(bf2f(g8[0])); o[1] = (f0.y + b0.y) * gelu_tanh(bf2f(g8[1])); o[2] = (f0.z + b0.z) * gelu_tanh(bf2f(g8[2])); o[3] = (f0.w + b0.w) * gelu_tanh(bf2f(g8[3]));
                    o[4] = (f1.x + b1.x) * gelu_tanh(bf2f(g8[4])); o[5] = (f1.y + b1.y) * gelu_tanh(bf2f(g8[5])); o[6] = (f1.z + b1.z) * gelu_tanh(bf2f(g8[6])); o[7] = (f1.w + b1.w) * gelu_tanh(bf2f(g8[7]));
                    *(GAS v4u*)(gout + (size_t)(row0 + tau) * DM + 1024 + n * 128 + co) = pack8(o);
                    float sq = (o[0] * o[0] + o[1] * o[1]) + (o[2] * o[2] + o[3] * o[3]) + (o[4] * o[4] + o[5] * o[5]) + (o[6] * o[6] + o[7] * o[7]);
                    sq += __shfl_xor(sq, 1); sq += __shfl_xor(sq, 2); sq += __shfl_xor(sq, 4); sq += __shfl_xor(sq, 8);
                    if ((tid & 15) == 0) F.SSQL()[(size_t)(row0 + tau) * 8 + n] = sq;
                }
            } else if (tid < 128) {
                const float hf = *(const LAS float*)(L + LRU_HF + (63 * 128 + tid) * 4), hb = *(const LAS float*)(L + LRU_HB + (63 * 128 + tid) * 4);
                F.LO15()[seq * 1024 + n * 128 + tid] = (hf + hb) * gelu_tanh(F.GY15()[n * 128 + tid]);
            }
        }
    }
    __syncthreads();
#undef LRU_PREFETCH
}
__device__ __forceinline__ void lru_propagate(Frame& F) {
    const int gid = F.vcu * 512 + F.tid;
    if (gid < 12 * 2048) {
        const int s = gid >> 11, d = (gid >> 10) & 1, ch = gid & 1023; const int nch = s < 8 ? 65 : 129, cb = chunk_base(s);
        const float2* car = F.CAR() + (size_t)d * 1024 + ch; float* cinp = F.CIN() + (size_t)d * 1024 + ch;
        float cin = 0.f;
        float2 pa[16], pb[16];
#define PRP_LOAD(P, B0) do { _Pragma("unroll") for (int i = 0; i < 16; ++i) { int cc = (B0) + i; cc = cc < nch ? cc : nch - 1; const int c = d ? nch - 1 - cc : cc; P[i] = car[(size_t)(cb + c) * 2048]; } } while (0)
#define PRP_RUN(P, B0) do { _Pragma("unroll") for (int i = 0; i < 16; ++i) { const int cc = (B0) + i; const int c = d ? nch - 1 - cc : cc; if (cc < nch) { cinp[(size_t)(cb + c) * 2048] = cin; cin = P[i].x * cin + P[i].y; } } } while (0)
        PRP_LOAD(pa, 0);
        for (int b0 = 0; b0 < nch; b0 += 32) {
            PRP_LOAD(pb, b0 + 16);
            PRP_RUN(pa, b0);
            PRP_LOAD(pa, b0 + 32);
            PRP_RUN(pb, b0 + 16);
        }
#undef PRP_LOAD
#undef PRP_RUN
    }
}

__device__ __forceinline__ void k_rope_pass(Frame& F, bf16* Kout, int gw, int NGW) {
    const int sub = F.lane >> 4, l16 = F.lane & 15;
    const int c0 = 8 * l16, p = l16 >> 3, half = (l16 >> 2) & 1, i0 = 8 * (l16 & 3);
    float inv[8], gk[8];
#pragma unroll
    for (int j = 0; j < 8; ++j) { inv[j] = __builtin_amdgcn_exp2f(-(float)(i0 + j) * (13.287712379549449f / 32.f)) * 0.15915494309189535f; gk[j] = FIN(F, 6  )[c0 + j]; }
    constexpr int NIT = NTOK * 2 / 4;
    bf16x8 v, vn;
    if (gw < NIT) { const int item = gw * 4 + sub; v = *(const GAS bf16x8*)(F.K() + (size_t)(item >> 1) * 256 + (item & 1) * 128 + c0); }
    for (int it = gw; it < NIT; it += NGW) {
        const int item = it * 4 + sub, row = item >> 1, hk = item & 1;
        { const int nit = it + NGW < NIT ? it + NGW : it; const int ni = nit * 4 + sub; vn = *(const GAS bf16x8*)(F.K() + (size_t)(ni >> 1) * 256 + (ni & 1) * 128 + c0); }
        const int s = row_seq(row), t = row - seq_first_row(s); const float pos = (float)(p ? (t & 63) : (t >> 6));
        float x[8]; float ss = 0.f;
#pragma unroll
        for (int j = 0; j < 8; ++j) { x[j] = bf2f(v[j]); ss += x[j] * x[j]; }
        ss += __shfl_xor(ss, 1); ss += __shfl_xor(ss, 2); ss += __shfl_xor(ss, 4); ss += __shfl_xor(ss, 8);
        const float rs = 1.f / sqrtf(ss * (1.f / 128.f) + EPS); float o[8];
#pragma unroll
        for (int j = 0; j < 8; ++j) { x[j] *= rs * gk[j]; const float pr = __shfl_xor(x[j], 4);
            float rev = pos * inv[j]; rev -= floorf(rev); const float sn = __builtin_amdgcn_sinf(rev), cs = __builtin_amdgcn_cosf(rev);
            o[j] = half ? x[j] * cs + pr * sn : x[j] * cs - pr * sn; }
        *(GAS v4u*)(Kout + (size_t)row * 256 + hk * 128 + c0) = pack8(o);
        v = vn;
    }
}
__device__ __forceinline__ void p3_meta_job(Frame& F) {
    for (int pr = F.wave; pr < 32; pr += 8) { const int r = pr >> 1, hk = pr & 1; const float* z = F.ZM() + r * INW + 1024 + hk * 128;
        const float a = z[F.lane], b = z[F.lane + 64]; const float rs = 1.f / sqrtf(wave_sum(a * a + b * b) * (1.f / 128.f) + EPS);
        F.KM()[r * 256 + hk * 128 + F.lane] = (bf16)f2bf(a * rs * FIN(F, 6  )[F.lane]); F.KM()[r * 256 + hk * 128 + F.lane + 64] = (bf16)f2bf(b * rs * FIN(F, 6  )[F.lane + 64]); }
    for (int i = F.tid; i < 16 * 256; i += 512) F.VM()[i] = (bf16)f2bf(F.ZM()[(i >> 8) * INW + 1280 + (i & 255)]);
    { const int h = F.wave; const float* z = F.ZM() + 15 * INW + h * 128; const float a = z[F.lane], b = z[F.lane + 64];
      const float rs = 1.f / sqrtf(wave_sum(a * a + b * b) * (1.f / 128.f) + EPS);
      F.Q15()[h * 128 + F.lane] = a * rs * FIN(F, 5  )[F.lane]; F.Q15()[h * 128 + F.lane + 64] = b * rs * FIN(F, 5  )[F.lane + 64]; }
    for (int i = F.tid; i < 1024; i += 512) F.GY15()[i] = F.ZM()[15 * INW + 2560 + i];
}

__device__ __forceinline__ void metaq_item(Frame& F, int it) {
    int s, kvh, j; if (it < 256) { s = it >> 5; kvh = (it >> 4) & 1; j = it & 15; } else { const int t2 = it - 256; s = 8 + (t2 >> 6); kvh = (t2 >> 5) & 1; j = t2 & 31; }
    LAS float* q4 = (LAS float*)F.lds;
    LAS float* sc = q4 + 512;
    LAS float* red = sc + 4 * 288;
    const int tid = F.tid, nk = 256 + (j == 0 ? 16 : 0), row0 = seq_first_row(s) + 256 * j;
    q4[tid] = F.Q15()[kvh * 512 + tid];
    __syncthreads();
    if (tid < nk) {
        const bf16* kp = tid < 256 ? F.K() + (size_t)(row0 + tid) * 256 + kvh * 128 : F.KM() + (tid - 256) * 256 + kvh * 128;
        float d0 = 0.f, d1 = 0.f, d2 = 0.f, d3 = 0.f;
#pragma unroll 4
        for (int cc = 0; cc < 16; ++cc) { const bf16x8 kv = ((const GAS bf16x8*)kp)[cc];
#pragma unroll
            for (int e = 0; e < 8; ++e) { const float kf = bf2f(kv[e]); d0 += kf * q4[cc * 8 + e]; d1 += kf * q4[128 + cc * 8 + e]; d2 += kf * q4[256 + cc * 8 + e]; d3 += kf * q4[384 + cc * 8 + e]; } }
        const float SC = 0.088388347648318440f;
        sc[tid] = d0 * SC; sc[288 + tid] = d1 * SC; sc[576 + tid] = d2 * SC; sc[864 + tid] = d3 * SC;
    }
    __syncthreads();
    if (F.wave < 4) { LAS float* sh = sc + F.wave * 288; float m = -INFINITY;
        for (int k = F.lane; k < nk; k += 64) m = fmaxf(m, sh[k]);
        m = wave_max(m); float l = 0.f;
        for (int k = F.lane; k < nk; k += 64) { const float p = __expf(sh[k] - m); sh[k] = p; l += p; }
        l = wave_sum(l);
        if (F.lane == 0) { red[F.wave * 2] = m; red[F.wave * 2 + 1] = l; } }
    __syncthreads();
    {
        const int kg = tid >> 4, oc = tid & 15; float o[4][8];
#pragma unroll
        for (int h = 0; h < 4; ++h)
#pragma unroll
            for (int e = 0; e < 8; ++e) o[h][e] = 0.f;
        const bf16* vp = F.V() + (size_t)(row0 + kg * 8) * 256 + kvh * 128 + oc * 8;
        bf16x8 vv[8];
#pragma unroll
        for (int k = 0; k < 8; ++k) vv[k] = *(const GAS bf16x8*)(vp + (size_t)k * 256);
#pragma unroll
        for (int k = 0; k < 8; ++k) { const float p0 = sc[kg * 8 + k], p1 = sc[288 + kg * 8 + k], p2 = sc[576 + kg * 8 + k], p3 = sc[864 + kg * 8 + k];
#pragma unroll
            for (int e = 0; e < 8; ++e) { const float vf = bf2f(vv[k][e]); o[0][e] += p0 * vf; o[1][e] += p1 * vf; o[2][e] += p2 * vf; o[3][e] += p3 * vf; } }
        if (j == 0 && kg < 16) { const int k = kg; const bf16x8 v1 = *(const GAS bf16x8*)(F.VM() + k * 256 + kvh * 128 + oc * 8);
            const float p0 = sc[256 + k], p1 = sc[288 + 256 + k], p2 = sc[576 + 256 + k], p3 = sc[864 + 256 + k];
#pragma unroll
            for (int e = 0; e < 8; ++e) { const float vf = bf2f(v1[e]); o[0][e] += p0 * vf; o[1][e] += p1 * vf; o[2][e] += p2 * vf; o[3][e] += p3 * vf; } }
        LAS float* part = sc + 4 * 288 + 16;
#pragma unroll
        for (int h = 0; h < 4; ++h) { LAS f32x4* pp = (LAS f32x4*)(part + (kg * 4 + h) * 128 + oc * 8); pp[0] = (f32x4){o[h][0], o[h][1], o[h][2], o[h][3]}; pp[1] = (f32x4){o[h][4], o[h][5], o[h][6], o[h][7]}; }
        __syncthreads();
        const int h = tid >> 7, d = tid & 127; float os = 0.f;
#pragma unroll 8
        for (int g = 0; g < 32; ++g) os += part[(g * 4 + h) * 128 + d];
        float* dst = F.MQP() + ((size_t)it * 4 + h) * 132; dst[2 + d] = os; if (d == 0) { dst[0] = red[h * 2]; dst[1] = red[h * 2 + 1]; } }
    __syncthreads();
}
__device__ __forceinline__ void attn_phase(Frame& F, char* lds_generic, bf16* obase) {
    const int nr = F.G == 256 ? 8 : (2048 + F.G - 1) / F.G;
    for (int r = 0; r < nr; ++r) {
        int s, kvh, hq, qb, S;
        if (F.G == 256) {
            const int x = F.vcu >> 5, i = F.vcu & 31;
            if (r < 4) { const int pair = 2 * x + (r >> 1); s = pair >> 1; kvh = pair & 1; const int u = (r & 1) * 32 + i; hq = u >> 4; qb = u & 15; S = 4096; }
            else { const int pair = x; s = 8 + (pair >> 1); kvh = pair & 1; const int u = (r - 4) * 32 + i; hq = u >> 5; qb = u & 31; S = 8192; }
        } else {
            const int U = F.vcu + F.G * r; if (U >= 2048) break;
            if (U < 1024) { const int pair = U >> 6, u = U & 63; s = pair >> 1; kvh = pair & 1; hq = u >> 4; qb = u & 15; S = 4096; }
            else { const int pair = (U - 1024) >> 7, u = (U - 1024) & 127; s = 8 + (pair >> 1); kvh = pair & 1; hq = u >> 5; qb = u & 31; S = 8192; }
        }
        const int row0 = seq_first_row(s), h = kvh * 4 + hq;
        bf16* qp = F.QG() + (size_t)(row0 + qb * 256) * DM + h * 128;
        attn::attn_unit(qp, F.K() + (size_t)row0 * 256 + kvh * 128, F.V() + (size_t)row0 * 256 + kvh * 128, F.KM() + kvh * 128, F.VM() + kvh * 128, obase + (size_t)(row0 + qb * 256) * DM + h * 128, S / 64 + 1, lds_generic, FIN(F, 5  ), qb * 256, F.SSQA() + (size_t)(row0 + qb * 256) * 8 + h, F.wave);
    }
}

__device__ __forceinline__ void p5_ratio(Frame& F) {
    for (int row = F.vcu * 512 + F.tid; row < NTOK; row += F.G * 512) {
        const GAS f32x4* pa = (const GAS f32x4*)(F.SSQA() + (size_t)row * 8); const GAS f32x4* pl = (const GAS f32x4*)(F.SSQL() + (size_t)row * 8);
        const f32x4 a0 = pa[0], a1 = pa[1], l0 = pl[0], l1 = pl[1];
        const float sa = ((a0.x + a0.y) + (a0.z + a0.w)) + ((a1.x + a1.y) + (a1.z + a1.w)), sl = ((l0.x + l0.y) + (l0.z + l0.w)) + ((l1.x + l1.y) + (l1.z + l1.w));
        const float qa = sqrtf(sa * (1.f / 1024.f) + EPS), ql = sqrtf(sl * (1.f / 1024.f) + EPS);
        F.RATIO()[row] = ql / qa; F.RL()[row] = 1.f / ql;
    }
}
__device__ __forceinline__ void p5_meta_job(Frame& F, int s) {
    LAS float* buf = (LAS float*)F.lds; LAS float* red = buf + 2048; const int tid = F.tid;
    {
        const int nj = s < 8 ? 16 : 32;
        for (int e = tid; e < 1024; e += 512) { const int h = e >> 7, d = e & 127, kvh = h >> 2, hq = h & 3;
            const int it0 = s < 8 ? s * 32 + kvh * 16 : 256 + (s - 8) * 64 + kvh * 32;
            float M = -INFINITY;
#pragma unroll 16
            for (int j = 0; j < nj; ++j) M = fmaxf(M, F.MQP()[((size_t)(it0 + j) * 4 + hq) * 132]);
            float Ls = 0.f, O = 0.f;
#pragma unroll 16
            for (int j = 0; j < nj; ++j) { const float* p = F.MQP() + ((size_t)(it0 + j) * 4 + hq) * 132; const float w = __expf(p[0] - M); Ls += p[1] * w; O += p[2 + d] * w; }
            buf[e] = O / Ls; }
        for (int e = tid; e < 1024; e += 512) buf[1024 + e] = F.LO15()[s * 1024 + e];
        __syncthreads();
        { float ss = 0.f; for (int k = F.lane; k < 256; k += 64) { const float v = buf[F.wave * 256 + k]; ss += v * v; } ss = wave_sum(ss); if (F.lane == 0) red[F.wave] = ss; }
        __syncthreads();
        const float ra = 1.f / sqrtf((red[0] + red[1] + red[2] + red[3]) * (1.f / 1024.f) + EPS), rl = 1.f / sqrtf((red[4] + red[5] + red[6] + red[7]) * (1.f / 1024.f) + EPS);
        for (int e = tid; e < 2048; e += 512) F.MIXED15()[s * 2048 + e] = e < 1024 ? buf[e] * ra : buf[e] * rl;
        __syncthreads();
    }
}
__device__ __forceinline__ void p6_meta_y(Frame& F) {
    LAS float* X = (LAS float*)F.lds;
    for (int i = F.tid; i < 12 * DM / 4; i += 512) ((LAS f32x4*)X)[i] = ((const GAS f32x4*)F.MIXED15())[i];
    __syncthreads();
    const OutRows o{F.Y15(), DM, 12};
    small_gemm<12, OutRows>(X, DM, F.WOUT_T(), DM, F.vcu * NWAVES + F.wave, F.G * NWAVES, F.lane, o);
    __syncthreads();
}

__device__ __forceinline__ void p7_rows(Frame& F, int q, int gw, int NGW) {
    const int lane = F.lane;
    f32x4 gm[8], gf[8];
    { const float* a = FIN(F, 17  ); const float* b = FIN(F, 18  );
#pragma unroll
      for (int i = 0; i < 4; ++i) { const int e0 = (lane + 64 * i) * 8; gm[2 * i] = *(const GAS f32x4*)(a + e0); gm[2 * i + 1] = *(const GAS f32x4*)(a + e0 + 4); gf[2 * i] = *(const GAS f32x4*)(b + e0); gf[2 * i + 1] = *(const GAS f32x4*)(b + e0 + 4); } }
    bf16* h1base = q == 0 ? F.H1A() : F.XN();
    bf16x8 yv[4], yn[4]; v4u xv[4], xw[4]; float r0c = 1.f, r0n = 1.f;
    const int rend = (q + 1) * HROWS;
    int row = q * HROWS + gw;
#define P7_LOAD(R, Y, X, RV) do { const GAS bf16x8* y_ = (const GAS bf16x8*)((const bf16*)(F.out + (size_t)(R) * DM)); const GAS v4u* x_ = (const GAS v4u*)(F.XN() + (size_t)(R) * DM); \
        _Pragma("unroll") for (int i_ = 0; i_ < 4; ++i_) { Y[i_] = y_[lane + 64 * i_]; X[i_] = x_[lane + 64 * i_]; } RV = F.R0()[(R)]; } while (0)
    if (row < rend) P7_LOAD(row, yv, xv, r0c);
    for (; row < rend; row += NGW) {
        const int nrow = row + NGW < rend ? row + NGW : row;
        P7_LOAD(nrow, yn, xw, r0n);
        GAS v4u* xn = (GAS v4u*)(F.XN() + (size_t)row * DM);
        GAS v4u* h1row = (GAS v4u*)(h1base + (size_t)(row - q * HROWS) * DM);
        const float ir0 = 1.f / r0c;
        float hv[32]; float ss = 0.f;
#pragma unroll
        for (int i = 0; i < 4; ++i)
#pragma unroll
            for (int j = 0; j < 8; ++j) { hv[8 * i + j] = bf2f(yv[i][j]); ss += hv[8 * i + j] * hv[8 * i + j]; }
        const float r1 = 1.f / sqrtf(wave_sum(ss) * (1.f / DM) + EPS); float s2 = 0.f;
#pragma unroll
        for (int i = 0; i < 4; ++i) {
            const v4u xq = xv[i]; const f32x4 g0 = gm[2 * i], g1 = gm[2 * i + 1];
            const float xf[8] = {__builtin_bit_cast(float, xq.x << 16), __builtin_bit_cast(float, xq.x & 0xffff0000u), __builtin_bit_cast(float, xq.y << 16), __builtin_bit_cast(float, xq.y & 0xffff0000u),
                                 __builtin_bit_cast(float, xq.z << 16), __builtin_bit_cast(float, xq.z & 0xffff0000u), __builtin_bit_cast(float, xq.w << 16), __builtin_bit_cast(float, xq.w & 0xffff0000u)};
            const float gg[8] = {g0.x, g0.y, g0.z, g0.w, g1.x, g1.y, g1.z, g1.w};
            float hb[8];
#pragma unroll
            for (int j = 0; j < 8; ++j) { hb[j] = xf[j] * ir0 + hv[8 * i + j] * r1 * gg[j]; hv[8 * i + j] = hb[j]; s2 += hb[j] * hb[j]; }
            h1row[lane + 64 * i] = pack8(hb);
        }
        const float r2 = 1.f / sqrtf(wave_sum(s2) * (1.f / DM) + EPS);
#pragma unroll
        for (int i = 0; i < 4; ++i) { const f32x4 g0 = gf[2 * i], g1 = gf[2 * i + 1];
            float t[8]; t[0] = hv[8 * i + 0] * r2 * g0.x; t[1] = hv[8 * i + 1] * r2 * g0.y; t[2] = hv[8 * i + 2] * r2 * g0.z; t[3] = hv[8 * i + 3] * r2 * g0.w;
            t[4] = hv[8 * i + 4] * r2 * g1.x; t[5] = hv[8 * i + 5] * r2 * g1.y; t[6] = hv[8 * i + 6] * r2 * g1.z; t[7] = hv[8 * i + 7] * r2 * g1.w;
            xn[lane + 64 * i] = pack8(t); }
#pragma unroll
        for (int i = 0; i < 4; ++i) { yv[i] = yn[i]; xv[i] = xw[i]; }
        r0c = r0n;
    }
#undef P7_LOAD
}
__device__ __forceinline__ void p7_meta_g(Frame& F) {
    LAS float* X = (LAS float*)F.lds;
    for (int r = F.wave; r < 12; r += 8) {
        const float* y = F.Y15() + r * DM; const float* xm = FIN(F, 2  ) + 15 * DM;
        float hv[32]; float ss = 0.f;
#pragma unroll
        for (int i = 0; i < 32; ++i) { hv[i] = y[F.lane + 64 * i]; ss += hv[i] * hv[i]; }
        const float r1 = 1.f / sqrtf(wave_sum(ss) * (1.f / DM) + EPS); float s2 = 0.f;
#pragma unroll
        for (int i = 0; i < 32; ++i) { const int e = F.lane + 64 * i; hv[i] = xm[e] + hv[i] * r1 * FIN(F, 17  )[e]; s2 += hv[i] * hv[i]; }
        const float r2 = 1.f / sqrtf(wave_sum(s2) * (1.f / DM) + EPS);
#pragma unroll
        for (int i = 0; i < 32; ++i) { const int e = F.lane + 64 * i; X[r * DM + e] = hv[i] * r2 * FIN(F, 18  )[e]; }
    }
    __syncthreads();
    const OutRows o{F.G15(), FFN, 12};
    small_gemm<12, OutRows, true>(X, DM, F.WUP_T(), FFN, F.vcu * NWAVES + F.wave, F.G * NWAVES, F.lane, o);
    __syncthreads();
}

__device__ __forceinline__ void p9_fix(Frame& F, int h) {
    constexpr int NOCT = FFN / 8, NBW = 512 * 2;
    const int gid = F.vcu * 512 + F.tid, oct = gid % NOCT, grp = gid / NOCT, NGRP = (F.G * 512) / NOCT;
    if (grp >= NGRP) return;
    const int co = oct * 8;
    const float* cw = FIN(F, 20  ); const float* cb = FIN(F, 21  );
    float w0[8], w1[8], w2[8], bb[8];
#define LD8F(dst, p) do { const GAS f32x4* p_ = (const GAS f32x4*)(p); const f32x4 a_ = p_[0], b_ = p_[1]; dst[0] = a_.x; dst[1] = a_.y; dst[2] = a_.z; dst[3] = a_.w; dst[4] = b_.x; dst[5] = b_.y; dst[6] = b_.z; dst[7] = b_.w; } while (0)
    LD8F(w0, cw + co); LD8F(w1, cw + FFN + co); LD8F(w2, cw + 2 * FFN + co); LD8F(bb, cb + co);
#define P9_PTRS(BW, E_, O_, Z_) do { const int which_ = (BW) & 1, B_ = (BW) >> 1; const int row_ = h * HROWS + B_ * 64 + (which_ ? 63 : 0), s_ = row_seq(row_), t_ = row_ - seq_first_row(s_); \
        E_ = F.EDGE() + (size_t)((B_ * 2 + which_) * 3) * FFN + co; Z_ = which_ && t_ == seq_len(s_) - 1; \
        O_ = which_ == 0 ? (t_ == 0 ? F.G15() + (size_t)s_ * FFN + co : F.EDGE() + (size_t)(((B_ - 1) * 2 + 1) * 3 + 1) * FFN + co) : (Z_ ? E_ : F.EDGE() + (size_t)(((B_ + 1) * 2 + 0) * 3 + 1) * FFN + co); } while (0)
#define P9_LOAD(E_, O_, I, S, U, X) do { const GAS f32x4* e_ = (const GAS f32x4*)(E_); const GAS f32x4* o_ = (const GAS f32x4*)(O_); I[0] = e_[0]; I[1] = e_[1]; \
        const GAS f32x4* e1_ = (const GAS f32x4*)((E_) + FFN); S[0] = e1_[0]; S[1] = e1_[1]; const GAS f32x4* e2_ = (const GAS f32x4*)((E_) + 2 * FFN); U[0] = e2_[0]; U[1] = e2_[1]; X[0] = o_[0]; X[1] = o_[1]; } while (0)
    f32x4 in_[2], se_[2], uu_[2], ou_[2], inN[2], seN[2], uuN[2], ouN[2];
    int bw = grp; const float* e; const float* o; bool z;
    P9_PTRS(bw, e, o, z); P9_LOAD(e, o, in_, se_, uu_, ou_);
    for (; bw < NBW; bw += NGRP) {
        const int nbw = bw + NGRP < NBW ? bw + NGRP : bw; const float* en; const float* on; bool zn;
        P9_PTRS(nbw, en, on, zn); P9_LOAD(en, on, inN, seN, uuN, ouN);
        const int which = bw & 1, lrow = (bw >> 1) * 64 + (which ? 63 : 0);
        float ov[8];
#pragma unroll
        for (int j = 0; j < 8; ++j) { const float inner = in_[j >> 2][j & 3], self = se_[j >> 2][j & 3], outer = z ? 0.f : ou_[j >> 2][j & 3];
            const float x = which == 0 ? bb[j] + w0[j] * outer + w1[j] * self + w2[j] * inner : bb[j] + w0[j] * inner + w1[j] * self + w2[j] * outer;
            ov[j] = x * sigmoidf_(x) * uu_[j >> 2][j & 3]; }
        *(GAS v4u*)(F.ACT() + (size_t)lrow * FFN + co) = pack8(ov);
#pragma unroll
        for (int k = 0; k < 2; ++k) { in_[k] = inN[k]; se_[k] = seN[k]; uu_[k] = uuN[k]; ou_[k] = ouN[k]; }
        z = zn;
    }
#undef P9_LOAD
#undef P9_PTRS
#undef LD8F
}
__device__ __forceinline__ void p11_rows(Frame& F, int gw, int NGW, float* obase) {
    const int lane = F.lane;
    f32x4 gg[8];
    { const float* a = FIN(F, 23  );
#pragma unroll
      for (int i = 0; i < 4; ++i) { const int e0 = (lane + 64 * i) * 8; gg[2 * i] = *(const GAS f32x4*)(a + e0); gg[2 * i + 1] = *(const GAS f32x4*)(a + e0 + 4); } }
    bf16x8 hv[4], fq[4], hn[4], fn[4];
#define P11_LOAD(R, H, Q) do { const GAS bf16x8* f_ = (const GAS bf16x8*)((const bf16*)(F.out + (size_t)(R) * DM)); \
        const GAS bf16x8* h_ = (const GAS bf16x8*)((R) < HROWS ? F.H1A() + (size_t)(R) * DM : F.XN() + (size_t)((R) - HROWS) * DM); \
        _Pragma("unroll") for (int i_ = 0; i_ < 4; ++i_) { H[i_] = h_[lane + 64 * i_]; Q[i_] = f_[lane + 64 * i_]; } } while (0)
    int row = gw;
    if (row < NTOK) P11_LOAD(row, hv, fq);
    for (; row < NTOK; row += NGW) {
        const int nrow = row + NGW < NTOK ? row + NGW : row;
        P11_LOAD(nrow, hn, fn);
        float fv[32]; float ss = 0.f;
#pragma unroll
        for (int i = 0; i < 4; ++i)
#pragma unroll
            for (int j = 0; j < 8; ++j) { fv[8 * i + j] = bf2f(fq[i][j]); ss += fv[8 * i + j] * fv[8 * i + j]; }
        const float r1 = 1.f / sqrtf(wave_sum(ss) * (1.f / DM) + EPS);
#pragma unroll
        for (int i = 0; i < 4; ++i) { const int e0 = (lane + 64 * i) * 8; const f32x4 g0 = gg[2 * i], g1 = gg[2 * i + 1];
            f32x4 h0, h1;
            h0.x = bf2f(hv[i][0]) + fv[8 * i + 0] * r1 * g0.x; h0.y = bf2f(hv[i][1]) + fv[8 * i + 1] * r1 * g0.y; h0.z = bf2f(hv[i][2]) + fv[8 * i + 2] * r1 * g0.z; h0.w = bf2f(hv[i][3]) + fv[8 * i + 3] * r1 * g0.w;
            h1.x = bf2f(hv[i][4]) + fv[8 * i + 4] * r1 * g1.x; h1.y = bf2f(hv[i][5]) + fv[8 * i + 5] * r1 * g1.y; h1.z = bf2f(hv[i][6]) + fv[8 * i + 6] * r1 * g1.z; h1.w = bf2f(hv[i][7]) + fv[8 * i + 7] * r1 * g1.w;
            GAS f32x4* wp = (GAS f32x4*)(obase + (size_t)row * DM + e0); wp[0] = h0; wp[1] = h1; }
#pragma unroll
        for (int i = 0; i < 4; ++i) { hv[i] = hn[i]; fq[i] = fn[i]; }
    }
#undef P11_LOAD
}
struct Args { const float* in[24]; float* out; unsigned char* ws; int ph_lo, ph_hi, q_lo, q_hi, use_bar, dummy; };
constexpr int N_PHASES = 12;
__global__ void __launch_bounds__(NWAVES * 64, 2) mk_fwd(Args args) {
    extern __shared__ __attribute__((aligned(16))) unsigned char lds[];
    Frame F;
    F.lds = (LAS unsigned char*)lds;
    F.MISC = (volatile LAS unsigned*)(F.lds + MISC_OFF);
    F.wave = __builtin_amdgcn_readfirstlane((int)threadIdx.x >> 6);
    F.tid = F.wave * 64 + lane_id_now(); F.lane = F.tid & 63;
    F.G = gridDim.x; { const int bx = blockIdx.x; F.vcu = (F.G % 8 == 0) ? (bx % 8) * (F.G / 8) + bx / 8 : bx; }
    unsigned char* ws = args.ws;
    F.ctl = (gu32*)(ws + WS_CTL);
    F.kargs = (const __attribute__((address_space(4))) void*)__builtin_amdgcn_kernarg_segment_ptr(); F.ptag = 0; F.out = args.out;
    F.ws = ws;
    for (int u = F.tid; u < (LDS_BYTES - LDSCTL_OFF) / 4; u += NWAVES * 64) ((LAS unsigned*)(F.lds + LDSCTL_OFF))[u] = 0u;
    __syncthreads();
    XcdBarrier bar; bar.bar = (unsigned*)(F.ctl + CW_BAR); bar.x = 0; bar.st = nullptr;
    if (args.use_bar) bar = xcd_barrier_post((unsigned*)(F.ctl + CW_BAR), F.MISC + 8, F.tid == 0);
    const int lo = args.ph_lo, hi = args.ph_hi;
    const int dmy_ = MK_MULTI ? args.dummy : 0;
#define IN(k) (((MK_PHASE_MASK >> (k)) & 1) && lo <= (k) && (k) < hi)
#define PH_BEGIN(k) do { F.ptag = (k); int t_ = F.wave * 64 + lane_id_now(); asm volatile("" : "+v"(t_)); F.tid = t_; F.lane = t_ & 63; } while (0)
#define PH_BAR() do { if (args.use_bar) xcd_barrier(bar, F.wave == 0 && lane_id_now() == 0); } while (0)
    const int gw = F.vcu * NWAVES + F.wave, NGW = F.G * NWAVES;

    if (IN(0)) { PH_BEGIN(0); { p0_prologue(F); PH_BAR(); } }
    if (IN(1)) { PH_BEGIN(1); {
        p1_meta_z(F);
        pg8::Gemm g{F.XN(), F.WIN_T(), NTOK, INW, DM}; pg8::ProbeOrder S; S.init(NTOK, INW, F.G, (int)blockIdx.x); S.pmask = dmy_ == 5 ? 7 : -1;
        pg8::EpiRoute E{nullptr, 0, 1, F.QG(), F.K(), F.V(), F.XR()};
        if (dmy_ != 7) pg8::gemm_phase<pg8::EpiRoute, pg8::ProbeOrder, true, true>(F.lds, g, S, E, F.wave);
        PH_BAR();
    } }
    if (IN(2)) { PH_BEGIN(2); { lru_phase<1>(F, nullptr); PH_BAR(); } }
    if (IN(3)) { PH_BEGIN(3); {
        constexpr int NPW = (12 * 2048 + 511) / 512;
        if (F.G >= 2 * NPW) {
            if (F.vcu < NPW) lru_propagate(F);
            else { const int gw2 = (F.vcu - NPW) * NWAVES + F.wave, NGW2 = (F.G - NPW) * NWAVES;
                k_rope_pass(F, dmy_ ? (bf16*)F.out : F.K(), gw2, NGW2);
                wt_items(F, WT_O_OUT, WT_O_UP, gw2, NGW2); wt_items(F, WT_O_DN, WT_O_G, gw2, NGW2); }
        } else {
            k_rope_pass(F, dmy_ ? (bf16*)F.out : F.K(), gw, NGW);
            lru_propagate(F);
            wt_items(F, WT_O_OUT, WT_O_UP, gw, NGW); wt_items(F, WT_O_DN, WT_O_G, gw, NGW);
        }
        if (F.vcu == F.G - 1) p3_meta_job(F);
        PH_BAR();
    } }
    if (IN(4)) { PH_BEGIN(4); {
        const int dm = dmy_;
        if (dm < 2 || dm == 2) lru_phase<2>(F, dm ? (bf16*)F.out : F.QG());
        if (dm < 2 || dm == 3) for (int it = F.vcu; it < 512; it += F.G) metaq_item(F, it);
        if (dm < 2 || dm == 4) attn_phase(F, (char*)lds, dm ? (bf16*)F.out : F.QG());
        if (dm == 8 && F.vcu < 128) attn_phase(F, (char*)lds, (bf16*)F.out);
        if (dm == 6 && (F.vcu & 1) == 0) attn_phase(F, (char*)lds, (bf16*)F.out);
        PH_BAR();
    } }
    if (IN(5)) { PH_BEGIN(5); {
        p5_ratio(F);
        if (F.G > 24) {
            if (F.vcu >= F.G - 12) p5_meta_job(F, F.G - 1 - F.vcu);
            else wt_items(F, WT_O_UP, WT_O_DN, F.vcu * NWAVES + F.wave, (F.G - 12) * NWAVES);
        } else {
            wt_items(F, WT_O_UP, WT_O_DN, gw, NGW);
            __syncthreads();
            if (F.vcu >= F.G - 12) p5_meta_job(F, F.G - 1 - F.vcu);
        }
        PH_BAR();
    } }
    if (IN(6)) { PH_BEGIN(6); {
        p6_meta_y(F);
        pg8::Gemm g{F.QG(), F.WOUT_T(), NTOK, DM, DM}; pg8::StaticOrder S; S.init(NTOK, DM, F.G, (int)blockIdx.x);
        pg8::EpiScaled E{(bf16*)F.out, 2 * DM, F.RATIO(), F.RL(), 16};
        pg8::gemm_phase<pg8::EpiScaled, pg8::StaticOrder, true, true>(F.lds, g, S, E, F.wave);
        PH_BAR();
    } }
#if MK_MULTI
    { const int q = args.q_lo;
#else
#pragma unroll
    for (int q = 0; q < 2; ++q) {
#endif
        if (IN(7)) { PH_BEGIN(7); {
            p7_rows(F, q, gw, NGW);
            if (q == 0) p7_meta_g(F);
            PH_BAR();
        } }
        if (IN(8)) { PH_BEGIN(8); {
            pg8::Gemm g{F.XN() + (size_t)q * HROWS * DM, F.WUP_T(), HROWS, UPW, DM}; pg8::StaticOrder S; S.init(HROWS, UPW, F.G, (int)blockIdx.x);
            pg8::EpiAct E{F.ACT(), F.EDGE(), FIN(F, 20  ), FIN(F, 21  ), FFN};
            pg8::gemm_phase<pg8::EpiAct, pg8::StaticOrder, true, true>(F.lds, g, S, E, F.wave);
            PH_BAR();
        } }
        if (IN(9)) { PH_BEGIN(9); { p9_fix(F, q); PH_BAR(); } }
        if (IN(10)) { PH_BEGIN(10); {
            pg8::Gemm g{F.ACT(), F.WDOWN_T(), HROWS, DM, FFN}; pg8::ProbeOrder S; S.init(HROWS, DM, F.G, (int)blockIdx.x); S.pmask = dmy_ == 5 ? 7 : -1;
            pg8::EpiRoute E{(bf16*)F.out + (size_t)q * HROWS * 2 * DM, 2 * DM, 0, nullptr, nullptr, nullptr, nullptr};
            pg8::gemm_phase<pg8::EpiRoute, pg8::ProbeOrder, true, true>(F.lds, g, S, E, F.wave);
        } }
    }
    if (IN(10) && IN(11)) PH_BAR();
    if (IN(11)) { PH_BEGIN(11); { p11_rows(F, gw, NGW, dmy_ ? (float*)(F.ws + WS_B) : F.out); } }
#undef IN
#undef PH_BAR
}

extern "C" void kernel_launch(void* const* d_in, const int* in_sizes, int n_in, void* d_out, int out_size, void* d_ws, size_t ws_size, hipStream_t stream) {
    static int grid = 0;
    if (grid == 0) {
        if (n_in != 24 || out_size != NTOK * DM || ws_size < WS_END) { fprintf(stderr, "kernel_launch: unexpected shapes (n_in %d out %d ws %zu, need ws >= %zu); nothing launched\n", n_in, out_size, ws_size, (size_t)WS_END); grid = -1; return; }
        int dev = 0, cus = 0;
        if (hipGetDevice(&dev) != hipSuccess || hipDeviceGetAttribute(&cus, hipDeviceAttributeMultiprocessorCount, dev) != hipSuccess) { grid = -1; return; }
        if (hipFuncSetAttribute((const void*)mk_fwd, hipFuncAttributeMaxDynamicSharedMemorySize, LDS_BYTES) != hipSuccess) { fprintf(stderr, "kernel_launch: hipFuncSetAttribute failed\n"); grid = -1; return; }
        int per_cu = 0;
        if (hipOccupancyMaxActiveBlocksPerMultiprocessor(&per_cu, (const void*)mk_fwd, NWAVES * 64, LDS_BYTES) != hipSuccess || per_cu < 1) fprintf(stderr, "kernel_launch: occupancy query reports %d\n", per_cu);
        (void)hipGetLastError();
        grid = cus;
    }
    if (grid < 0) return;
    if (hipMemsetAsync((char*)d_ws + WS_CTL, 0, CTL_ZERO_BYTES, stream) != hipSuccess) return;
    Args a{};
    for (int i = 0; i < 24; ++i) a.in[i] = (const float*)d_in[i];
    a.out = (float*)d_out; a.ws = (unsigned char*)d_ws;
#if MK_MULTI
    a.use_bar = 0;
#define LAUNCH_PH(ph, q) do { a.ph_lo = (ph); a.ph_hi = (ph) + 1; a.q_lo = (q); a.q_hi = (q) + 1; \
        if ((MK_REPEAT_MASK >> (ph)) & 1) { a.dummy = MK_DUMMY_MODE; hipLaunchKernelGGL(mk_fwd, dim3(grid), dim3(NWAVES * 64), LDS_BYTES, stream, a); } \
        a.dummy = 0; hipLaunchKernelGGL(mk_fwd, dim3(grid), dim3(NWAVES * 64), LDS_BYTES, stream, a); } while (0)
    for (int ph = 0; ph < 7; ++ph) LAUNCH_PH(ph, 0);
    for (int q = 0; q < 2; ++q) for (int ph = 7; ph < 11; ++ph) LAUNCH_PH(ph, q);
    LAUNCH_PH(11, 0);
#else
    a.use_bar = 1; a.ph_lo = 0; a.ph_hi = N_PHASES; a.q_lo = 0; a.q_hi = 2;
    hipLaunchKernelGGL(mk_fwd, dim3(grid), dim3(NWAVES * 64), LDS_BYTES, stream, a);
#endif
    const hipError_t le = hipPeekAtLastError();
    if (le != hipSuccess) fprintf(stderr, "kernel_launch: launch failed: %s\n", hipGetErrorName(le));
}
```

```cpp
#include <hip/hip_runtime.h>
#include <cstdio>
#include <cstdint>
#include <cmath>
#ifndef MK_PHASE_MASK
#define MK_PHASE_MASK 0xfff
#endif
#ifndef MK_REPEAT_MASK
#define MK_REPEAT_MASK 0
#endif
#ifndef MK_DUMMY_MODE
#define MK_DUMMY_MODE 1
#endif
#ifndef MK_MULTI
#define MK_MULTI 0
#endif
__device__ __forceinline__ int lane_id_now() { int l; asm volatile("v_mbcnt_lo_u32_b32 %0, -1, 0\n\tv_mbcnt_hi_u32_b32 %0, -1, %0" : "=v"(l)); return l; }
namespace pg8 {
#define PG8_LAS __attribute__((address_space(3)))
typedef unsigned short bf16_t;
typedef short bf16x8 __attribute__((ext_vector_type(8)));
typedef float f32x4 __attribute__((ext_vector_type(4)));
typedef unsigned u32x4 __attribute__((ext_vector_type(4)));
constexpr int BM = 256, BK = 64, HALF = 128, HTB = HALF * BK * 2  , STAGE_BYTES = 8 * HTB, NXCD = 8, WGM = 8;

__host__ __device__ __forceinline__ int lds_byte(int r, int c) { const int st = (r >> 4) * 2 + (c >> 5), rr = r & 15, cc = c & 31, ob = rr * 64 + cc * 2; return st * 1024 + (ob ^ (((ob >> 9) & 1) << 5)); }
__host__ __device__ __forceinline__ void stage_rc(int b, int& R, int& C) { const int st = b / 1024, sb = b % 1024, swz = sb ^ (((sb >> 9) & 1) << 5); R = (st >> 1) * 16 + swz / 64; C = (st & 1) * 32 + (swz % 64) / 2; }
__host__ __device__ __forceinline__ int perm32(int rho) { const int n = rho >> 4, i = rho & 15; return 8 * (i >> 2) + 4 * n + (i & 3); }

struct Unit { int pm, pn; };
struct Gemm { const bf16_t* A; const bf16_t* Bt; int M, N, K; };

struct StaticOrder {
    int nM, nN, nwg, G, c;
    __host__ __device__ void init(int M, int N, int G_, int c_) { nM = M / BM; nN = N / BM; nwg = nM * nN; G = G_; c = c_; }
    __host__ __device__ bool next(int i, Unit& u) const {
        const long L = (long)i * G + c; if (L >= nwg) return false;
        int wgid = (int)L; { const int q = nwg / NXCD, r = nwg % NXCD, xcd = wgid % NXCD, off = wgid / NXCD; wgid = (xcd < r ? xcd * (q + 1) : r * (q + 1) + (xcd - r) * q) + off; }
        const int nig = WGM * nN, gid = wgid / nig, fm = gid * WGM, gsz = (nM - fm) < WGM ? (nM - fm) : WGM;
        u.pm = fm + ((wgid % nig) % gsz); u.pn = (wgid % nig) / gsz; return true;
    }
    __device__ __forceinline__ void a_ready(const Unit&) const {}
    __device__ __forceinline__ void done(const Unit&) const {}
};

__device__ __forceinline__ unsigned cvt_pk_bf16(float lo, float hi) { unsigned r; asm volatile("v_cvt_pk_bf16_f32 %0, %1, %2" : "=v"(r) : "v"(lo), "v"(hi)); return r; }
struct EpiRoute {
    static constexpr bool PERM = true, AFTER_DRAIN = false, MIDK = false;
    bf16_t* O; int ldc; int mode; bf16_t *QGp, *Kp, *Vp, *XRp;
    __device__ __forceinline__ void operator()(const f32x4 (&acc)[2][2][4][2], const Unit& u, int wr, int wc, int fr, int fq) const {
        bf16_t* base = O; int ld = ldc; int colt = u.pn * BM; int rowadd = 0;
        if (mode == 1) {
            const int pn = u.pn;
            if (pn < 4) { base = QGp; ld = 2048; colt = pn * 256; }
            else if (pn == 4) { base = Kp; ld = 256; colt = 0; }
            else if (pn == 5) { base = Vp; ld = 256; colt = 0; }
            else if (pn < 10) { base = XRp; ld = 1024; colt = (pn - 6) * 256; const int seq = u.pm < 128 ? (u.pm >> 4) : 8 + ((u.pm - 128) >> 5); rowadd = 64 * (seq + 1); }
            else { base = QGp; ld = 2048; colt = 1024 + (pn - 10) * 256; }
        }
        const int row0 = u.pm * BM + wr * 64 + fr + rowadd; const int col0 = colt + wc * 32 + 8 * fq;
#pragma unroll
        for (int ai = 0; ai < 2; ++ai)
#pragma unroll
            for (int m = 0; m < 4; ++m) { bf16_t* rowp = base + (size_t)(row0 + ai * HALF + m * 16) * ld + col0;
#pragma unroll
                for (int bj = 0; bj < 2; ++bj) { const f32x4 v0 = acc[ai][bj][m][0], v1 = acc[ai][bj][m][1];
                    u32x4 w; w.x = cvt_pk_bf16(v0[0], v0[1]); w.y = cvt_pk_bf16(v0[2], v0[3]); w.z = cvt_pk_bf16(v1[0], v1[1]); w.w = cvt_pk_bf16(v1[2], v1[3]);
                    *(u32x4*)(rowp + bj * HALF) = w; } }
    }
};

__device__ __forceinline__ float dpp_shr1(float old, float src) { return __builtin_bit_cast(float, __builtin_amdgcn_update_dpp(__builtin_bit_cast(int, old), __builtin_bit_cast(int, src), 0x111, 0xF, 0xF, false)); }
__device__ __forceinline__ float dpp_shl1(float old, float src) { return __builtin_bit_cast(float, __builtin_amdgcn_update_dpp(__builtin_bit_cast(int, old), __builtin_bit_cast(int, src), 0x101, 0xF, 0xF, false)); }
__device__ __forceinline__ float dpp_ror1(float src)  { return __builtin_bit_cast(float, __builtin_amdgcn_update_dpp(0, __builtin_bit_cast(int, src), 0x121, 0xF, 0xF, false)); }
__device__ __forceinline__ float dpp_ror15(float src) { return __builtin_bit_cast(float, __builtin_amdgcn_update_dpp(0, __builtin_bit_cast(int, src), 0x12F, 0xF, 0xF, false)); }
struct EpiAct {
    static constexpr bool PERM = true, AFTER_DRAIN = false, MIDK = false;
    bf16_t* ACT; bf16_t* EDGE; const float* cw; const float* cb; int nch;
    __device__ __forceinline__ void operator()(const f32x4 (&acc)[2][2][4][2], const Unit& u, int wr, int wc, int fr, int fq) const {
        const int ch0 = u.pn * 128 + wc * 32 + 8 * fq;
        float w0[8], w1[8], w2[8], bb[8];
        { const f32x4 a0 = *(const f32x4*)(cw + ch0), a1 = *(const f32x4*)(cw + ch0 + 4), b0 = *(const f32x4*)(cw + nch + ch0), b1 = *(const f32x4*)(cw + nch + ch0 + 4),
                      c0 = *(const f32x4*)(cw + 2 * nch + ch0), c1 = *(const f32x4*)(cw + 2 * nch + ch0 + 4), d0 = *(const f32x4*)(cb + ch0), d1 = *(const f32x4*)(cb + ch0 + 4);
#pragma unroll
          for (int k = 0; k < 4; ++k) { w0[k] = a0[k]; w0[4 + k] = a1[k]; w1[k] = b0[k]; w1[4 + k] = b1[k]; w2[k] = c0[k]; w2[4 + k] = c1[k]; bb[k] = d0[k]; bb[4 + k] = d1[k]; } }
        const int rowb = u.pm * BM + wr * 64;
#pragma unroll
        for (int ai = 0; ai < 2; ++ai) {
            float ein0[8], ein1[8];
#pragma unroll
            for (int m = 0; m < 4; ++m) {
                float o[8];
#pragma unroll
                for (int n = 0; n < 2; ++n)
#pragma unroll
                    for (int k = 0; k < 4; ++k) {
                        const int j = 4 * n + k; const float cur = acc[ai][0][m][n][k];
                        float pold = 0.f, nold = 0.f;
                        if (m > 0) pold = dpp_ror1(acc[ai][0][m > 0 ? m - 1 : 0][n][k]);
                        if (m < 3) nold = dpp_ror15(acc[ai][0][m < 3 ? m + 1 : 3][n][k]);
                        const float prv = dpp_shr1(pold, cur), nxt = dpp_shl1(nold, cur);
                        const float x = bb[j] + w0[j] * prv + w1[j] * cur + w2[j] * nxt;
                        o[j] = x * __builtin_amdgcn_rcpf(1.f + __builtin_amdgcn_exp2f(-1.4426950408889634f * x)) * acc[ai][1][m][n][k];
                        if (m == 0) ein0[j] = nxt;
                        if (m == 3) ein1[j] = prv;
                    }
                u32x4 w; w.x = cvt_pk_bf16(o[0], o[1]); w.y = cvt_pk_bf16(o[2], o[3]); w.z = cvt_pk_bf16(o[4], o[5]); w.w = cvt_pk_bf16(o[6], o[7]);
                *(u32x4*)(ACT + (size_t)(rowb + ai * HALF + m * 16 + fr) * nch + ch0) = w;
            }
            const int blk = (rowb + ai * HALF) >> 6;
            if (fr == 0 || fr == 15) {
                const bool last = fr == 15; bf16_t* e = EDGE + (size_t)((blk * 2 + (last ? 1 : 0)) * 3) * nch + ch0;
                float iv[8], sv[8], uv[8];
#pragma unroll
                for (int k = 0; k < 4; ++k) { iv[k] = last ? ein1[k] : ein0[k]; iv[4 + k] = last ? ein1[4 + k] : ein0[4 + k];
                    sv[k] = last ? acc[ai][0][3][0][k] : acc[ai][0][0][0][k]; sv[4 + k] = last ? acc[ai][0][3][1][k] : acc[ai][0][0][1][k];
                    uv[k] = last ? acc[ai][1][3][0][k] : acc[ai][1][0][0][k]; uv[4 + k] = last ? acc[ai][1][3][1][k] : acc[ai][1][0][1][k]; }
                u32x4 a, b, c;
                a.x = cvt_pk_bf16(iv[0], iv[1]); a.y = cvt_pk_bf16(iv[2], iv[3]); a.z = cvt_pk_bf16(iv[4], iv[5]); a.w = cvt_pk_bf16(iv[6], iv[7]);
                b.x = cvt_pk_bf16(sv[0], sv[1]); b.y = cvt_pk_bf16(sv[2], sv[3]); b.z = cvt_pk_bf16(sv[4], sv[5]); b.w = cvt_pk_bf16(sv[6], sv[7]);
                c.x = cvt_pk_bf16(uv[0], uv[1]); c.y = cvt_pk_bf16(uv[2], uv[3]); c.z = cvt_pk_bf16(uv[4], uv[5]); c.w = cvt_pk_bf16(uv[6], uv[7]);
                *(u32x4*)(e) = a; *(u32x4*)(e + nch) = b; *(u32x4*)(e + 2 * nch) = c;
            }
        }
    }
};

struct ProbeOrder : StaticOrder { int pmask;
    __host__ __device__ bool next(int i, Unit& u) const { const bool r = StaticOrder::next(i, u); u.pm &= pmask; return r; } };

struct EpiScaled {
    static constexpr bool PERM = true, AFTER_DRAIN = false, MIDK = true;
    bf16_t* O; int ldc; const float* ratio; const float* rl; int kt;
    __device__ __forceinline__ void midk(f32x4 (&acc)[2][2][4][2], const Unit& u, int wr, int fr) const {
        asm volatile("" ::: "memory");
        const float* rp = ratio + (u.pm * BM + wr * 64 + fr);
        float s[2][4];
#pragma unroll
        for (int ai = 0; ai < 2; ++ai)
#pragma unroll
            for (int m = 0; m < 4; ++m) s[ai][m] = rp[ai * HALF + m * 16];
#pragma unroll
        for (int ai = 0; ai < 2; ++ai)
#pragma unroll
            for (int m = 0; m < 4; ++m)
#pragma unroll
                for (int bj = 0; bj < 2; ++bj)
#pragma unroll
                    for (int n = 0; n < 2; ++n) acc[ai][bj][m][n] = acc[ai][bj][m][n] * s[ai][m];
        asm volatile("" ::: "memory");
    }
    __device__ __forceinline__ void operator()(const f32x4 (&acc)[2][2][4][2], const Unit& u, int wr, int wc, int fr, int fq) const {
        const int row0 = u.pm * BM + wr * 64 + fr, col0 = u.pn * BM + wc * 32 + 8 * fq;
#pragma unroll
        for (int ai = 0; ai < 2; ++ai)
#pragma unroll
            for (int m = 0; m < 4; ++m) { const int row = row0 + ai * HALF + m * 16; const float s = rl[row]; bf16_t* rowp = O + (size_t)row * ldc + col0;
#pragma unroll
                for (int bj = 0; bj < 2; ++bj) { const f32x4 v0 = acc[ai][bj][m][0] * s, v1 = acc[ai][bj][m][1] * s;
                    u32x4 w; w.x = cvt_pk_bf16(v0[0], v0[1]); w.y = cvt_pk_bf16(v0[2], v0[3]); w.z = cvt_pk_bf16(v1[0], v1[1]); w.w = cvt_pk_bf16(v1[2], v1[3]);
                    *(u32x4*)(rowp + bj * HALF) = w; } }
    }
};

template <class Epi, class Sched, bool ALIGN_EPI = false, bool SP2 = false>
__device__ __forceinline__ void gemm_phase(PG8_LAS unsigned char* lds, const Gemm g, const Sched& S, const Epi& E, int wave_id) {
    int tid_ = wave_id * 64 + lane_id_now(); asm volatile("" : "+v"(tid_));
    const int tid = tid_, wid = __builtin_amdgcn_readfirstlane(tid >> 6), lane = tid & 63, wr = wid >> 2, wc = wid & 3, fr = lane & 15, fq = lane >> 4;
    const int K = g.K, nt = K / BK;
    unsigned voffA[2], voffB[2];
#pragma unroll
    for (int i = 0; i < 2; ++i) { int R, C; stage_rc(tid * 16 + i * 8192, R, C); const int Rb = Epi::PERM ? ((R & ~31) + perm32(R & 31)) : R;
        voffA[i] = (unsigned)(R * K + C) * 2u; voffB[i] = (unsigned)(Rb * K + C) * 2u; }
    const size_t kstep = (size_t)(BK * 2);
    const size_t hstep = (size_t)HALF * K * 2;
    const size_t tstep = 2 * hstep;
    const unsigned ldsw = (unsigned)wid * 1024u;
    const int aoff = lds_byte(wr * 64 + fr, fq * 8), boff = lds_byte(wc * 32 + fr, fq * 8);
#define PG8_SA(b, h) (((b) * 2 + (h)) * HTB)
#define PG8_SB(b, h) ((4 + (b) * 2 + (h)) * HTB)
#define PG8_STAGE(bufoff, gbase, voff) do { _Pragma("unroll") for (int _i = 0; _i < 2; ++_i) \
        __builtin_amdgcn_global_load_lds((const unsigned*)((const char*)(gbase) + (voff)[_i]), (PG8_LAS unsigned*)(lds + (bufoff) + ldsw + _i * 8192), 16, 0, 0); } while (0)
#define PG8_LDA(dst, b, h) do { _Pragma("unroll") for (int m = 0; m < 4; ++m) _Pragma("unroll") for (int k = 0; k < 2; ++k) dst[m][k] = *(const PG8_LAS bf16x8*)(lds + PG8_SA(b, h) + aoff + m * 2048 + k * 1024); } while (0)
#define PG8_LDB(dst, b, h) do { _Pragma("unroll") for (int n = 0; n < 2; ++n) _Pragma("unroll") for (int k = 0; k < 2; ++k) dst[n][k] = *(const PG8_LAS bf16x8*)(lds + PG8_SB(b, h) + boff + n * 2048 + k * 1024); } while (0)
#define PG8_MMA(ai, bj, At, Bt) do { __builtin_amdgcn_s_setprio(1); _Pragma("unroll") for (int m = 0; m < 4; ++m) _Pragma("unroll") for (int n = 0; n < 2; ++n) _Pragma("unroll") for (int k = 0; k < 2; ++k) \
        acc[ai][bj][m][n] = __builtin_amdgcn_mfma_f32_16x16x32_bf16(Bt[n][k], At[m][k], acc[ai][bj][m][n], 0, 0, 0); __builtin_amdgcn_s_setprio(0); } while (0)
#define PG8_WAIT_V(n) asm volatile("s_waitcnt vmcnt(" #n ")" ::: "memory")
#define PG8_WAIT_L(n) asm volatile("s_waitcnt lgkmcnt(" #n ")" ::: "memory")
#define PG8_BAR __builtin_amdgcn_s_barrier()
#define PG8_SCHED __builtin_amdgcn_sched_barrier(0)
    Unit cur, nxt; int ui = 0;
    if (!S.next(0, cur)) return;
    f32x4 acc[2][2][4][2];
#pragma unroll
    for (int a = 0; a < 2; ++a)
#pragma unroll
        for (int b = 0; b < 2; ++b)
#pragma unroll
            for (int m = 0; m < 4; ++m)
#pragma unroll
                for (int n = 0; n < 2; ++n) acc[a][b][m][n] = (f32x4){0.f, 0.f, 0.f, 0.f};
    bf16x8 At[4][2], B0[2][2], B1[2][2];
    const char* cA = (const char*)g.A + (size_t)cur.pm * tstep; const char* cB = (const char*)g.Bt + (size_t)cur.pn * tstep;
    S.a_ready(cur);
    if constexpr (SP2) {
        PG8_STAGE(PG8_SB(0, 0), cB, voffB); PG8_STAGE(PG8_SB(0, 1), cB + hstep, voffB); PG8_STAGE(PG8_SA(0, 0), cA, voffA); PG8_STAGE(PG8_SA(0, 1), cA + hstep, voffA);
        if (wr == 1) PG8_BAR;
        PG8_WAIT_V(2); PG8_BAR;
        PG8_STAGE(PG8_SB(1, 0), cB + kstep, voffB); PG8_STAGE(PG8_SA(1, 0), cA + kstep, voffA); PG8_STAGE(PG8_SB(1, 1), cB + hstep + kstep, voffB);
        PG8_WAIT_V(6); PG8_BAR;
    } else {
        PG8_STAGE(PG8_SB(0, 0), cB, voffB); PG8_STAGE(PG8_SA(0, 0), cA, voffA); PG8_STAGE(PG8_SB(0, 1), cB + hstep, voffB); PG8_STAGE(PG8_SA(0, 1), cA + hstep, voffA);
        if (wr == 1) PG8_BAR;
        PG8_WAIT_V(4); PG8_BAR;
        PG8_STAGE(PG8_SB(1, 0), cB + kstep, voffB); PG8_STAGE(PG8_SA(1, 0), cA + kstep, voffA); PG8_STAGE(PG8_SB(1, 1), cB + hstep + kstep, voffB);
        PG8_WAIT_V(6); PG8_BAR;
    }
    for (;;) {
        const bool has_next = S.next(ui + 1, nxt);
        const char* nA = has_next ? (const char*)g.A + (size_t)nxt.pm * tstep : cA; const char* nB = has_next ? (const char*)g.Bt + (size_t)nxt.pn * tstep : cB;
        for (int t = 0; t < nt; t += 2) {
            if constexpr (Epi::MIDK) { if (t == E.kt) E.midk(acc, cur, wr, fr); }
            const bool last = (t == nt - 2);
            const char* a1 = cA + (size_t)(t + 1) * kstep;
            const char* a2 = last ? nA : cA + (size_t)(t + 2) * kstep; const char* b2 = last ? nB : cB + (size_t)(t + 2) * kstep;
            const char* a3 = a2 + kstep; const char* b3 = b2 + kstep;
            if (last && has_next) S.a_ready(nxt);
            if constexpr (SP2) {
            PG8_LDB(B0, 0, 0); PG8_LDB(B1, 0, 1); PG8_SCHED; PG8_LDA(At, 0, 0); PG8_STAGE(PG8_SA(1, 1), a1 + hstep, voffA);
            PG8_WAIT_V(8); PG8_WAIT_L(0); PG8_BAR; PG8_MMA(0, 0, At, B0); PG8_MMA(0, 1, At, B1); PG8_BAR; PG8_SCHED;
            PG8_LDA(At, 0, 1); PG8_STAGE(PG8_SB(0, 0), b2, voffB); PG8_STAGE(PG8_SB(0, 1), b2 + hstep, voffB); PG8_STAGE(PG8_SA(0, 0), a2, voffA);
            PG8_WAIT_V(8); PG8_WAIT_L(0); PG8_BAR; PG8_MMA(1, 0, At, B0); PG8_MMA(1, 1, At, B1); PG8_BAR; PG8_SCHED;
            PG8_LDB(B0, 1, 0); PG8_LDB(B1, 1, 1); PG8_SCHED; PG8_LDA(At, 1, 0); PG8_STAGE(PG8_SA(0, 1), a2 + hstep, voffA);
            PG8_WAIT_V(8); PG8_WAIT_L(0); PG8_BAR; PG8_MMA(0, 0, At, B0); PG8_MMA(0, 1, At, B1); PG8_BAR; PG8_SCHED;
            PG8_LDA(At, 1, 1); PG8_STAGE(PG8_SB(1, 0), b3, voffB); PG8_STAGE(PG8_SB(1, 1), b3 + hstep, voffB); PG8_STAGE(PG8_SA(1, 0), a3, voffA);
            PG8_WAIT_V(8); PG8_WAIT_L(0); PG8_BAR; PG8_MMA(1, 0, At, B0); PG8_MMA(1, 1, At, B1); PG8_BAR; PG8_SCHED;
            } else {
            PG8_LDB(B0, 0, 0); PG8_SCHED; PG8_LDA(At, 0, 0); PG8_STAGE(PG8_SA(1, 1), a1 + hstep, voffA);
            PG8_WAIT_L(8); PG8_BAR; PG8_WAIT_L(0); PG8_MMA(0, 0, At, B0); PG8_BAR; PG8_SCHED;
            PG8_LDB(B1, 0, 1); PG8_STAGE(PG8_SB(0, 0), b2, voffB);
            PG8_BAR; PG8_WAIT_L(0); PG8_MMA(0, 1, At, B1); PG8_BAR;
            PG8_LDA(At, 0, 1); PG8_STAGE(PG8_SA(0, 0), a2, voffA);
            PG8_BAR; PG8_WAIT_L(0); PG8_MMA(1, 0, At, B0); PG8_BAR; PG8_SCHED;
            PG8_STAGE(PG8_SB(0, 1), b2 + hstep, voffB);
            PG8_WAIT_V(6); PG8_BAR; PG8_MMA(1, 1, At, B1); PG8_BAR;
            PG8_LDB(B0, 1, 0); PG8_SCHED; PG8_LDA(At, 1, 0); PG8_STAGE(PG8_SA(0, 1), a2 + hstep, voffA);
            PG8_WAIT_L(8); PG8_BAR; PG8_WAIT_L(0); PG8_MMA(0, 0, At, B0); PG8_BAR; PG8_SCHED;
            PG8_LDB(B1, 1, 1); PG8_STAGE(PG8_SB(1, 0), b3, voffB);
            PG8_BAR; PG8_WAIT_L(0); PG8_MMA(0, 1, At, B1); PG8_BAR;
            PG8_LDA(At, 1, 1); PG8_STAGE(PG8_SA(1, 0), a3, voffA);
            PG8_BAR; PG8_WAIT_L(0); PG8_MMA(1, 0, At, B0); PG8_BAR; PG8_SCHED;
            PG8_STAGE(PG8_SB(1, 1), b3 + hstep, voffB);
            PG8_WAIT_V(6); PG8_BAR; PG8_MMA(1, 1, At, B1); PG8_BAR;
            }
        }
        if constexpr (ALIGN_EPI) { if (wr == 0) PG8_BAR; }
        if constexpr (!Epi::AFTER_DRAIN) { E(acc, cur, wr, wc, fr, fq); S.done(cur); }
        if (!has_next) break;
#pragma unroll
        for (int a = 0; a < 2; ++a)
#pragma unroll
            for (int b = 0; b < 2; ++b)
#pragma unroll
                for (int m = 0; m < 4; ++m)
#pragma unroll
                    for (int n = 0; n < 2; ++n) acc[a][b][m][n] = (f32x4){0.f, 0.f, 0.f, 0.f};
        cur = nxt; cA = nA; cB = nB; ++ui;
        if constexpr (ALIGN_EPI) { if (wr == 1) PG8_BAR; }
    }
    PG8_WAIT_V(0);
    if constexpr (!ALIGN_EPI) { if (wr == 0) PG8_BAR; }
    PG8_BAR;
    if constexpr (Epi::AFTER_DRAIN) { E.fused(acc, cur, wr, wc, fr, fq, lds, wid, lane); S.done(cur); }
#undef PG8_SA
#undef PG8_SB
#undef PG8_STAGE
#undef PG8_LDA
#undef PG8_LDB
#undef PG8_MMA
#undef PG8_WAIT_V
#undef PG8_WAIT_L
#undef PG8_BAR
#undef PG8_SCHED
}
}
namespace attn {
typedef unsigned short bf16r;
using bf16x8 = __attribute__((ext_vector_type(8))) short;
using s16x4  = __attribute__((ext_vector_type(4))) short;
using f32x4  = __attribute__((ext_vector_type(4))) float;
using u32x4  = __attribute__((ext_vector_type(4))) unsigned;
constexpr int   QBLK = 32, KVBLK = 64;
constexpr float SCALE = 0.088388347648318440f;
constexpr float THRL = 8.f;
constexpr int LDQ = 2048, LDK = 256, LDO = 2048;
constexpr size_t SHM_ATTN = 6 * 16384 + 8 * 64 * 4;
#define SBAR() __builtin_amdgcn_sched_barrier(0)
__device__ __forceinline__ unsigned cvtpk(float lo, float hi) { unsigned r; asm volatile("v_cvt_pk_bf16_f32 %0, %1, %2" : "=v"(r) : "v"(lo), "v"(hi)); return r; }
__device__ __forceinline__ unsigned short f2bf_rne(float f) { unsigned u = __builtin_bit_cast(unsigned, f); return (unsigned short)((u + 0x7fffu + ((u >> 16) & 1u)) >> 16); }
__device__ __forceinline__ float bfl(short b) { return __builtin_bit_cast(float, (unsigned)(unsigned short)b << 16); }
template <int OFF> __device__ __forceinline__ s16x4 tr_read(int vb) { s16x4 r; asm volatile("ds_read_b64_tr_b16 %0, %1 offset:%2" : "=&v"(r) : "v"(vb), "i"(OFF) : "memory"); return r; }

__device__ __forceinline__ void qkt16(f32x4 (&S)[4][2], const char* Ks, int kb0, const bf16x8 (&qf)[2][4], float nm0, float nm1) {
  const f32x4 n0 = {nm0, nm0, nm0, nm0}, n1 = {nm1, nm1, nm1, nm1};
#pragma unroll
  for (int kb = 0; kb < 4; ++kb)
#pragma unroll
    for (int ds = 0; ds < 4; ++ds) { const bf16x8 kf = *reinterpret_cast<const bf16x8*>(Ks + kb * 4096 + (kb0 ^ (64 * ds)));
      S[kb][0] = __builtin_amdgcn_mfma_f32_16x16x32_bf16(kf, qf[0][ds], ds == 0 ? n0 : S[kb][0], 0, 0, 0);
      S[kb][1] = __builtin_amdgcn_mfma_f32_16x16x32_bf16(kf, qf[1][ds], ds == 0 ? n1 : S[kb][1], 0, 0, 0); }
}
__device__ __forceinline__ void mask_meta16(f32x4 (&S)[4][2]) {
  const float NEG = -INFINITY;
#pragma unroll
  for (int kb = 1; kb < 4; ++kb)
#pragma unroll
    for (int qb = 0; qb < 2; ++qb) S[kb][qb] = (f32x4){NEG, NEG, NEG, NEG};
}
__device__ __forceinline__ void partial16(f32x4 (&S)[4][2], float (&mhat)[2], float (&alpha)[2], bool first) {
  float pm[2];
#pragma unroll
  for (int qb = 0; qb < 2; ++qb) { float a = __builtin_fmaxf(__builtin_fmaxf(S[0][qb][0], S[0][qb][1]), S[0][qb][2]), b = __builtin_fmaxf(__builtin_fmaxf(S[0][qb][3], S[1][qb][0]), S[1][qb][1]);
    a = __builtin_fmaxf(__builtin_fmaxf(a, S[1][qb][2]), S[1][qb][3]); b = __builtin_fmaxf(__builtin_fmaxf(b, S[2][qb][0]), S[2][qb][1]);
    a = __builtin_fmaxf(__builtin_fmaxf(a, S[2][qb][2]), S[2][qb][3]); b = __builtin_fmaxf(__builtin_fmaxf(b, S[3][qb][0]), S[3][qb][1]);
    a = __builtin_fmaxf(__builtin_fmaxf(a, S[3][qb][2]), S[3][qb][3]); pm[qb] = __builtin_fmaxf(a, b); }
  alpha[0] = 1.f; alpha[1] = 1.f;
  if (first || __builtin_expect(__any(__builtin_fmaxf(pm[0], pm[1]) > THRL), 0)) {
#pragma unroll
    for (int qb = 0; qb < 2; ++qb) { float m = pm[qb]; m = __builtin_fmaxf(m, __shfl_xor(m, 16)); m = __builtin_fmaxf(m, __shfl_xor(m, 32));
      const float dl = first ? m : __builtin_fmaxf(m, 0.f); mhat[qb] += dl;
#pragma unroll
      for (int kb = 0; kb < 4; ++kb) S[kb][qb] = S[kb][qb] - dl;
      if (!first) alpha[qb] = __builtin_amdgcn_exp2f(-dl); }
  }
#pragma unroll
  for (int kb = 0; kb < 2; ++kb)
#pragma unroll
    for (int qb = 0; qb < 2; ++qb)
#pragma unroll
      for (int r = 0; r < 4; ++r) S[kb][qb][r] = __builtin_amdgcn_exp2f(S[kb][qb][r]);
}
__device__ __forceinline__ void finish16(f32x4 (&S)[4][2], const float (&alpha)[2], float (&lsum)[2], bf16x8 (&pa)[2][2]) {
#pragma unroll
  for (int kb = 2; kb < 4; ++kb)
#pragma unroll
    for (int qb = 0; qb < 2; ++qb)
#pragma unroll
      for (int r = 0; r < 4; ++r) S[kb][qb][r] = __builtin_amdgcn_exp2f(S[kb][qb][r]);
#pragma unroll
  for (int qb = 0; qb < 2; ++qb) { float ps = 0.f;
#pragma unroll
    for (int kb = 0; kb < 4; ++kb) ps += (S[kb][qb][0] + S[kb][qb][1]) + (S[kb][qb][2] + S[kb][qb][3]);
    lsum[qb] = lsum[qb] * alpha[qb] + ps;
#pragma unroll
    for (int ks = 0; ks < 2; ++ks) { const f32x4 a = S[2 * ks][qb], b = S[2 * ks + 1][qb];
      u32x4 w = {cvtpk(a[0], a[1]), cvtpk(a[2], a[3]), cvtpk(b[0], b[1]), cvtpk(b[2], b[3])}; pa[qb][ks] = *reinterpret_cast<bf16x8*>(&w); } }
}
template <int KS, int DB> __device__ __forceinline__ void pv_one16(f32x4 (&O)[2][8], int vbA, int vbB, const bf16x8 (&pa)[2][2]) {
  const int vb = DB < 7 ? vbA : vbB;
  const s16x4 lo = tr_read<(8 * KS) * 1024 + 128 * DB>(vb), hi = tr_read<(8 * KS + 4) * 1024 + 128 * DB>(vb);
  asm volatile("s_waitcnt lgkmcnt(0)" ::: "memory"); SBAR();
  const bf16x8 bfr = {lo[0], lo[1], lo[2], lo[3], hi[0], hi[1], hi[2], hi[3]};
  O[0][DB] = __builtin_amdgcn_mfma_f32_16x16x32_bf16(pa[0][KS], bfr, O[0][DB], 0, 0, 0);
  O[1][DB] = __builtin_amdgcn_mfma_f32_16x16x32_bf16(pa[1][KS], bfr, O[1][DB], 0, 0, 0);
}
template <int KS> __device__ __forceinline__ void pv_ks16(f32x4 (&O)[2][8], int vbA, int vbB, const bf16x8 (&pa)[2][2]) {
  pv_one16<KS, 0>(O, vbA, vbB, pa); pv_one16<KS, 1>(O, vbA, vbB, pa); pv_one16<KS, 2>(O, vbA, vbB, pa); pv_one16<KS, 3>(O, vbA, vbB, pa);
  pv_one16<KS, 4>(O, vbA, vbB, pa); pv_one16<KS, 5>(O, vbA, vbB, pa); pv_one16<KS, 6>(O, vbA, vbB, pa); pv_one16<KS, 7>(O, vbA, vbB, pa);
}
__device__ __forceinline__ void pv16(f32x4 (&O)[2][8], int vbA, int vbB, const bf16x8 (&pa)[2][2]) { pv_ks16<0>(O, vbA, vbB, pa); pv_ks16<1>(O, vbA, vbB, pa); }

__device__ __forceinline__ void attn_unit(const bf16r* Qb, const bf16r* __restrict__ Kh, const bf16r* __restrict__ Vh,
                                          const bf16r* __restrict__ KMh, const bf16r* __restrict__ VMh, bf16r* Ob, int NT, char* lds,
                                          const float* __restrict__ qnorm, int t0, float* ssq, int wave_id) {
  int tid_ = wave_id * 64 + lane_id_now(); asm volatile("" : "+v"(tid_));
  const int tid = tid_, wid = tid >> 6, lane = tid & 63, c = lane & 15, g = lane >> 4;
  float* ws = (float*)(lds + 6 * 16384) + wid * 64; float* li_l = ws; float* al_l = ws + 32;
  float mhat[2] = {0.f, 0.f}, lsum[2] = {0.f, 0.f};
  f32x4 O[2][8];
#pragma unroll
  for (int qb = 0; qb < 2; ++qb)
#pragma unroll
    for (int db = 0; db < 8; ++db) O[qb][db] = (f32x4){0.f, 0.f, 0.f, 0.f};
  unsigned kgo0, vgo0;
  { const int k0 = 4 * wid + g; kgo0 = (unsigned)(k0 * (LDK * 2) + ((c << 4) ^ ((k0 & 15) << 4)));
    const int r = (lane >> 1) & 3, half = lane & 1, s8 = lane >> 3;
    { const int p = wid,     db = (s8 - (p & 1)) & 7; vgo0 = (unsigned)((4 * p + r) * (LDK * 2) + (16 * db + 8 * half) * 2); }
 }
  const int kb0 = c * 256 + ((g ^ c) << 4);
  typedef __attribute__((address_space(3))) unsigned char* ldsp_t;
  const ldsp_t lds3 = (ldsp_t)lds;
  const int w1k = __builtin_amdgcn_readfirstlane(wid) * 1024;
  constexpr int VRING = 3 * 16384;
#define DMAK(t, soff) do { const char* b_ = (const char*)((t) == 0 ? KMh : Kh + (long)((t) - 1) * KVBLK * LDK); \
    __builtin_amdgcn_global_load_lds((const unsigned*)(b_ + kgo0), (__attribute__((address_space(3))) unsigned*)(lds3 + (soff) + w1k), 16, 0, 0); \
    __builtin_amdgcn_global_load_lds((const unsigned*)(b_ + kgo0 + 32 * LDK * 2), (__attribute__((address_space(3))) unsigned*)(lds3 + (soff) + w1k + 8192), 16, 0, 0); } while (0)
#define DMAV(t, soff) do { const char* b_ = (const char*)((t) == 0 ? VMh : Vh + (long)((t) - 1) * KVBLK * LDK); \
    __builtin_amdgcn_global_load_lds((const unsigned*)(b_ + vgo0), (__attribute__((address_space(3))) unsigned*)(lds3 + VRING + (soff) + w1k), 16, 0, 0); \
    __builtin_amdgcn_global_load_lds((const unsigned*)(b_ + vgo0 + 32 * LDK * 2), (__attribute__((address_space(3))) unsigned*)(lds3 + VRING + (soff) + w1k + 8192), 16, 0, 0); } while (0)
#define WAITBAR(N) asm volatile("s_waitcnt vmcnt(" #N ") lgkmcnt(0)\n\ts_barrier" ::: "memory")
#define ROT() do { const int t_ = sm1; sm1 = sc_; sc_ = sp1; sp1 = t_; } while (0)
#define RESC(a) do { if (__any(__builtin_fminf((a)[0], (a)[1]) < 1.f)) { if (g == 0) { al_l[c] = (a)[0]; al_l[16 + c] = (a)[1]; } asm volatile("s_waitcnt lgkmcnt(0)" ::: "memory"); \
    _Pragma("unroll") for (int qb_ = 0; qb_ < 2; ++qb_) _Pragma("unroll") for (int r_ = 0; r_ < 4; ++r_) { const float a_ = al_l[16 * qb_ + 4 * g + r_]; \
      _Pragma("unroll") for (int db_ = 0; db_ < 8; ++db_) O[qb_][db_][r_] *= a_; } } } while (0)
  DMAK(0, 0); DMAV(0, 0); DMAK(1, 16384);
  bf16x8 qf[2][4];
#pragma unroll
  for (int qb = 0; qb < 2; ++qb)
#pragma unroll
    for (int ds = 0; ds < 4; ++ds) qf[qb][ds] = *reinterpret_cast<const bf16x8*>(Qb + (long)(wid * QBLK + 16 * qb + c) * LDQ + 32 * ds + 8 * g);
  {
    int go = g; asm volatile("" : "+v"(go));
#pragma unroll
    for (int qb = 0; qb < 2; ++qb) {
      float ss = 0.f;
#pragma unroll
      for (int ds = 0; ds < 4; ++ds)
#pragma unroll
        for (int j = 0; j < 8; ++j) { const float x = bfl(qf[qb][ds][j]); ss += x * x; }
      ss += __shfl_xor(ss, 16); ss += __shfl_xor(ss, 32);
      const float rs = (SCALE * 1.4426950408889634f) / sqrtf(ss * (1.f / 128.f) + 1e-6f);
      int t = t0 + wid * QBLK + 16 * qb + c; asm volatile("" : "+v"(t));
#pragma unroll
      for (int p = 0; p < 2; ++p) { const float pos = (float)(p ? (t & 63) : (t >> 6)); const int fa = 2 * p, fb = 2 * p + 1;
        const float4 ga0 = *reinterpret_cast<const float4*>(qnorm + 32 * fa + 8 * g), ga1 = *reinterpret_cast<const float4*>(qnorm + 32 * fa + 8 * g + 4);
        const float4 gb0 = *reinterpret_cast<const float4*>(qnorm + 32 * fb + 8 * g), gb1 = *reinterpret_cast<const float4*>(qnorm + 32 * fb + 8 * g + 4);
        const float gaf[8] = {ga0.x, ga0.y, ga0.z, ga0.w, ga1.x, ga1.y, ga1.z, ga1.w}, gbf[8] = {gb0.x, gb0.y, gb0.z, gb0.w, gb1.x, gb1.y, gb1.z, gb1.w};
        float oa[8], ob[8];
#pragma unroll
        for (int j = 0; j < 8; ++j) { const int i = 8 * go + j;
          float rev = pos * __builtin_amdgcn_exp2f(-(float)i * (13.287712379549449f / 32.f)) * 0.15915494309189535f; rev -= floorf(rev);
          const float sn = __builtin_amdgcn_sinf(rev), cs = __builtin_amdgcn_cosf(rev);
          const float x1 = bfl(qf[qb][fa][j]) * rs * gaf[j], x2 = bfl(qf[qb][fb][j]) * rs * gbf[j];
          oa[j] = x1 * cs - x2 * sn; ob[j] = x2 * cs + x1 * sn; }
        { u32x4 w = {cvtpk(oa[0], oa[1]), cvtpk(oa[2], oa[3]), cvtpk(oa[4], oa[5]), cvtpk(oa[6], oa[7])}; qf[qb][fa] = *reinterpret_cast<bf16x8*>(&w); }
        { u32x4 w = {cvtpk(ob[0], ob[1]), cvtpk(ob[2], ob[3]), cvtpk(ob[4], ob[5]), cvtpk(ob[6], ob[7])}; qf[qb][fb] = *reinterpret_cast<bf16x8*>(&w); }
        SBAR(); }
    }
  }
  const int vlb = (int)(uintptr_t)(lds + VRING) + g * 1024 + (c >> 2) * 32 + (c & 3) * 8;
  const int vbA0 = vlb + (g & 1) * 128, vbB0 = vlb + (g & 1) * (128 - 1024);
  int sm1 = 32768, sc_ = 0, sp1 = 16384;
  f32x4 S[4][2]; bf16x8 paA[2][2], paB[2][2]; float al[2];
  WAITBAR(2);
  DMAK(2, sm1); DMAV(1, sp1);
  qkt16(S, lds + sc_, kb0, qf, -mhat[0], -mhat[1]); mask_meta16(S); partial16(S, mhat, al, true); finish16(S, al, lsum, paA);
  WAITBAR(4); ROT();
  for (int t = 1; t + 1 < NT; t += 2) {
    if (t + 2 < NT) DMAK(t + 2, sm1); DMAV(t + 1, sp1);
    SBAR(); qkt16(S, lds + sc_, kb0, qf, -mhat[0], -mhat[1]); SBAR();
    pv16(O, vbA0 + sm1, vbB0 + sm1, paA); partial16(S, mhat, al, false); finish16(S, al, lsum, paB);
    if (t + 2 < NT) WAITBAR(4); else WAITBAR(2);
    RESC(al); ROT();
    if (t + 3 < NT) DMAK(t + 3, sm1); if (t + 2 < NT) DMAV(t + 2, sp1);
    SBAR(); qkt16(S, lds + sc_, kb0, qf, -mhat[0], -mhat[1]); SBAR();
    pv16(O, vbA0 + sm1, vbB0 + sm1, paB); partial16(S, mhat, al, false); finish16(S, al, lsum, paA);
    if (t + 3 < NT) WAITBAR(4); else if (t + 2 < NT) WAITBAR(2); else WAITBAR(0);
    RESC(al); ROT();
  }
  pv16(O, vbA0 + sm1, vbB0 + sm1, paA);
#pragma unroll
  for (int qb = 0; qb < 2; ++qb) { float L = lsum[qb]; L += __shfl_xor(L, 16); L += __shfl_xor(L, 32); if (g == 0) li_l[16 * qb + c] = L; }
  asm volatile("s_waitcnt lgkmcnt(0)" ::: "memory");
  bf16r* Ow = Ob + (long)(wid * QBLK) * LDO;
#pragma unroll
  for (int qb = 0; qb < 2; ++qb)
#pragma unroll
    for (int r = 0; r < 4; ++r) { const int orow = 16 * qb + 4 * g + r; const float rl = __builtin_amdgcn_rcpf(li_l[orow]); float sq = 0.f;
#pragma unroll
      for (int db = 0; db < 8; ++db) { const float v = O[qb][db][r] * rl; sq += v * v; Ow[(long)orow * LDO + 16 * db + c] = f2bf_rne(v); }
      sq += __shfl_xor(sq, 1); sq += __shfl_xor(sq, 2); sq += __shfl_xor(sq, 4); sq += __shfl_xor(sq, 8);
      if (c == 0) ssq[(long)(wid * QBLK + orow) * 8] = sq; }
  asm volatile("s_waitcnt lgkmcnt(0)\n\ts_barrier" ::: "memory");
#undef DMAK
#undef DMAV
#undef WAITBAR
#undef ROT
#undef RESC
}
#undef SBAR
}

constexpr int NWAVES = 8;
constexpr int DM = 2048, NTOK = 65536, INW = 3584, FFN = 5632, UPW = 2 * FFN;
constexpr float EPS = 1e-6f;
constexpr int XR_ROWS = 8 * 4160 + 4 * 8256;
constexpr int NCHUNK = 8 * 65 + 4 * 129;
constexpr int HROWS = 32768;
__host__ __device__ __forceinline__ int seq_first_row(int s) { return s < 8 ? s * 4096 : 32768 + (s - 8) * 8192; }
__host__ __device__ __forceinline__ int seq_len(int s) { return s < 8 ? 4096 : 8192; }
__host__ __device__ __forceinline__ int xr_base(int s) { return s < 8 ? s * 4160 : 33280 + (s - 8) * 8256; }
__host__ __device__ __forceinline__ int chunk_base(int s) { return s < 8 ? s * 65 : 520 + (s - 8) * 129; }
__host__ __device__ __forceinline__ int row_seq(int row) { return row < 32768 ? (row >> 12) : 8 + ((row - 32768) >> 13); }

constexpr size_t MiB = 1u << 20, KiB = 1u << 10;
constexpr size_t WS_CTL = 0, CTL_ZERO_BYTES = 1 * MiB;
constexpr size_t WS_SMALL = 1 * MiB;
constexpr size_t WS_XNMETA = WS_SMALL + 0, WS_ZM = WS_SMALL + 64 * KiB, WS_KM = WS_SMALL + 320 * KiB, WS_VM = WS_SMALL + 352 * KiB, WS_Q15 = WS_SMALL + 384 * KiB, WS_GY15 = WS_SMALL + 388 * KiB,
                 WS_LO15 = WS_SMALL + 392 * KiB, WS_MIXED15 = WS_SMALL + 448 * KiB, WS_Y15 = WS_SMALL + 544 * KiB, WS_G15 = WS_SMALL + 640 * KiB, WS_MQP = WS_SMALL + 1024 * KiB;
constexpr size_t WS_WIN = 5 * MiB, WS_WOUT = 19 * MiB, WS_WUP = 27 * MiB, WS_WDOWN = 71 * MiB, WS_WG = 93 * MiB;
constexpr size_t WS_CAR = 94 * MiB, WS_CIN = 111 * MiB;
constexpr size_t WS_R0 = 120 * MiB, WS_RATIO = 120 * MiB + 256 * KiB, WS_RL = 120 * MiB + 512 * KiB, WS_SSQA = 121 * MiB, WS_SSQL = 123 * MiB;
constexpr size_t WS_A = 128 * MiB;
constexpr size_t WS_B = 384 * MiB;
constexpr size_t WS_QG = WS_B, WS_K = WS_B + 256 * MiB, WS_V = WS_B + 288 * MiB, WS_XR = WS_B + 320 * MiB;
constexpr size_t WS_ACT = WS_B, WS_EDGE = WS_B + 352 * MiB;
constexpr size_t WS_H1A = WS_B + 420 * MiB;
constexpr size_t WS_END = WS_B + 548 * MiB;
static_assert(WS_ZM + 16 * INW * 4 <= WS_KM && WS_G15 + 12 * FFN * 4 <= WS_MQP && WS_MQP + 512 * 4 * 132 * 4 <= WS_WIN, "small map");
static_assert(WS_WIN + (size_t)INW * DM * 2 <= WS_WOUT && WS_WOUT + (size_t)DM * DM * 2 <= WS_WUP && WS_WUP + (size_t)UPW * DM * 2 <= WS_WDOWN && WS_WDOWN + (size_t)DM * FFN * 2 <= WS_WG && WS_WG + 32 * 16384 * 2 <= WS_CAR, "weights map");
static_assert(WS_CAR + (size_t)NCHUNK * 2 * 1024 * 8 <= WS_CIN && WS_A + (size_t)NTOK * DM * 2 <= WS_B, "carry map");
static_assert(WS_QG + (size_t)NTOK * DM * 2 <= WS_K && WS_XR + (size_t)(XR_ROWS + 64) * 1024 * 2 <= WS_END && WS_EDGE + (size_t)512 * 2 * 3 * FFN * 4 <= WS_H1A && WS_H1A + (size_t)HROWS * DM * 2 <= WS_END && WS_END <= 1024 * MiB && WS_CIN + (size_t)NCHUNK * 2 * 1024 * 4 <= WS_R0 && WS_SSQL + (size_t)NTOK * 8 * 4 <= WS_A && WS_ACT + (size_t)HROWS * FFN * 2 <= WS_EDGE && WS_EDGE + (size_t)512 * 2 * 3 * FFN * 4 <= WS_END, "B map");
constexpr int CW_BAR = 4096;

constexpr int RING_BYTES = 131072;
constexpr int LDSCTL_OFF = RING_BYTES, MISC_OFF = LDSCTL_OFF + 320;
constexpr int LDS_BYTES = 147456;

#define GAS __attribute__((address_space(1)))
#define LAS __attribute__((address_space(3)))
typedef unsigned short bf16;
typedef unsigned v4u __attribute__((ext_vector_type(4)));
typedef float f32x4 __attribute__((ext_vector_type(4)));
typedef short bf16x8 __attribute__((ext_vector_type(8)));
typedef GAS unsigned gu32;
typedef GAS unsigned long long gu64;
#define RLX_AGENT __ATOMIC_RELAXED, __HIP_MEMORY_SCOPE_AGENT
#define LDS_WAIT() asm volatile("s_waitcnt lgkmcnt(0)" ::: "memory")
#define VM_WAIT() asm volatile("s_waitcnt vmcnt(0)" ::: "memory")
__device__ __forceinline__ unsigned long long rt() { return __builtin_amdgcn_s_memrealtime(); }
__device__ __forceinline__ unsigned f2bf(float f) { unsigned u = __builtin_bit_cast(unsigned, f); return (u + 0x7fffu + ((u >> 16) & 1u)) >> 16; }
__device__ __forceinline__ unsigned pk2(float lo, float hi) { return f2bf(lo) | (f2bf(hi) << 16); }

#define XB_TMO      128
#define XB_XCNT(j)  (256  + 64 * (j))
#define XB_XSUB(j)  (1280 + 64 * (j))
#define XB_XGEN(j)  (2304 + 64 * (j))
#define XB_TOP      3328
#define XB_TOPGEN   3392
#define XCD_BAR_WORDS 3456
#define XB_SPIN_CAP (1u << 18)

__device__ __forceinline__ unsigned xb_ld(unsigned* p)              { return __hip_atomic_load(p, __ATOMIC_RELAXED, __HIP_MEMORY_SCOPE_AGENT); }
__device__ __forceinline__ unsigned xb_add(unsigned* p, unsigned v) { return __hip_atomic_fetch_add(p, v, __ATOMIC_RELAXED, __HIP_MEMORY_SCOPE_AGENT); }
__device__ __forceinline__ unsigned xb_xcc_id() { return (unsigned)__builtin_amdgcn_s_getreg((3 << 11) | 20) & 0xFu; }
#define XB_SPIN(cond, bar) do { unsigned _sp = 0; while (cond) { __builtin_amdgcn_s_sleep(1); \
    if ((++_sp & 255u) == 0u) { if (xb_ld(&(bar)[XB_TMO])) break; if (_sp > XB_SPIN_CAP) { atomicAdd(&(bar)[XB_TMO], 1u); break; } } } } while (0)

struct XcdBarrier {
    unsigned* bar; unsigned x;
    volatile LAS unsigned* st;
};

__device__ __forceinline__ XcdBarrier xcd_barrier_post(unsigned* bar, volatile LAS unsigned* st, bool t0  ) {
    XcdBarrier b; b.bar = bar; b.x = xb_xcc_id(); b.st = st;
    if (t0) (void)xb_add(&bar[XB_XCNT(b.x)], 1u);
    return b;
}
__device__ __forceinline__ void xcd_barrier_complete(unsigned* bar, unsigned x, unsigned& nloc, unsigned& nx) {
    const unsigned G = gridDim.x * gridDim.y * gridDim.z;
    unsigned sum, cnt, mine, sp = 0u;
    for (;;) {
        sum = 0u; cnt = 0u; mine = 0u;
#pragma unroll
        for (unsigned j = 0; j < 16; ++j) { const unsigned c = xb_ld(&bar[XB_XCNT(j)]); sum += c; cnt += (c > 0u) ? 1u : 0u; mine = (j == x) ? c : mine; }
        if (sum == G) break;
        __builtin_amdgcn_s_sleep(1);
        if ((++sp & 255u) == 0u) { if (xb_ld(&bar[XB_TMO])) break; if (sp > XB_SPIN_CAP) { atomicAdd(&bar[XB_TMO], 1u); break; } }
    }
    nloc = mine > 0u ? mine : 1u; nx = cnt > 0u ? cnt : 1u;
}

__device__ __forceinline__ void xcd_barrier(const XcdBarrier& b, bool t0  ) {
    asm volatile("s_waitcnt vmcnt(0)" ::: "memory");
    __syncthreads();
    if (t0) {
        unsigned* bar = b.bar;
        __builtin_amdgcn_s_waitcnt(0);
        unsigned nloc = b.st[0], nx = b.st[1];
        if (nloc == 0u) { xcd_barrier_complete(bar, b.x, nloc, nx); b.st[0] = nloc; b.st[1] = nx; }
        const unsigned old = xb_add(&bar[XB_XSUB(b.x)], 1u);
        const unsigned gen = old / nloc;
        if (old + 1u == (gen + 1u) * nloc) {
            __builtin_amdgcn_fence(__ATOMIC_RELEASE, "agent");
            asm volatile("s_waitcnt vmcnt(0)" ::: "memory");
            const unsigned og = xb_add(&bar[XB_TOP], 1u);
            const unsigned tg = og / nx;
            if (og + 1u == (tg + 1u) * nx) xb_add(&bar[XB_TOPGEN], 1u);
            else XB_SPIN(xb_ld(&bar[XB_TOPGEN]) == tg, bar);
            __builtin_amdgcn_fence(__ATOMIC_ACQUIRE, "agent");
            xb_add(&bar[XB_XGEN(b.x)], 1u);
            asm volatile("s_waitcnt vmcnt(0)" ::: "memory");
        } else {
            XB_SPIN(xb_ld(&bar[XB_XGEN(b.x)]) == gen, bar);
            __builtin_amdgcn_fence(__ATOMIC_ACQUIRE, "agent");
            asm volatile("s_waitcnt vmcnt(0)" ::: "memory");
        }
    }
    __syncthreads();
}

__device__ __forceinline__ float bf2f(unsigned short b) { return __builtin_bit_cast(float, (unsigned)b << 16); }
__device__ __forceinline__ float bf2f(short b) { return __builtin_bit_cast(float, (unsigned)(unsigned short)b << 16); }
__device__ __forceinline__ float wave_sum(float v) {
#pragma unroll
    for (int o = 1; o < 64; o <<= 1) v += __shfl_xor(v, o);
    return v;
}
__device__ __forceinline__ float wave_max(float v) {
#pragma unroll
    for (int o = 1; o < 64; o <<= 1) v = fmaxf(v, __shfl_xor(v, o));
    return v;
}
__device__ __forceinline__ float fast_exp(float x) { return __builtin_amdgcn_exp2f(x * 1.4426950408889634f); }
__device__ __forceinline__ float sigmoidf_(float x) { return __builtin_amdgcn_rcpf(1.f + fast_exp(-x)); }
__device__ __forceinline__ float gelu_tanh(float x) {
    const float z = 0.7978845608028654f * (x + 0.044715f * x * x * x);
    return x * sigmoidf_(2.f * z);
}
__device__ __forceinline__ float neg_expm1(float x) {
    const float p = x * (1.f + x * (0.5f + x * (0.16666667f + x * (0.041666668f + x * (0.0083333338f + x * 0.0013888889f)))));
    const float e = fast_exp(x) - 1.f;
    return -(fabsf(x) < 0.25f ? p : e);
}
__device__ __forceinline__ v4u pack8(const float (&v)[8]) { v4u o; o.x = pk2(v[0], v[1]); o.y = pk2(v[2], v[3]); o.z = pk2(v[4], v[5]); o.w = pk2(v[6], v[7]); return o; }

#define FIN(F, idx) ({ const __attribute__((address_space(1))) float* p_; asm("s_load_dwordx2 %0, %1, %2 ; tag %3\n\ts_waitcnt lgkmcnt(0)" : "=s"(p_) : "s"((F).kargs), "i"((idx) * 8), "s"((F).ptag)); (const float*)p_; })
struct Frame {
    LAS unsigned char* lds;
    volatile LAS unsigned* MISC;
    gu32* ctl;
    int tid, lane, wave, vcu, G;
    const __attribute__((address_space(4))) void* kargs; int ptag;
    float* out;
    unsigned char* ws;
#define WSP(T, NAME, OFF) __device__ __forceinline__ T* NAME() const { return (T*)(ws + (OFF)); }
    WSP(bf16, WIN_T, WS_WIN) WSP(bf16, WOUT_T, WS_WOUT) WSP(bf16, WUP_T, WS_WUP) WSP(bf16, WDOWN_T, WS_WDOWN) WSP(bf16, WG, WS_WG) WSP(bf16, XN, WS_A) WSP(bf16, QG, WS_QG) WSP(bf16, K, WS_K) WSP(bf16, V, WS_V)
    WSP(bf16, XR, WS_XR) WSP(bf16, ACT, WS_ACT) WSP(bf16, H1A, WS_H1A) WSP(bf16, EDGE, WS_EDGE) WSP(bf16, XNMETA, WS_XNMETA) WSP(bf16, KM, WS_KM) WSP(bf16, VM, WS_VM)
    WSP(float, ZM, WS_ZM) WSP(float, Q15, WS_Q15) WSP(float, GY15, WS_GY15) WSP(float, LO15, WS_LO15) WSP(float, MIXED15, WS_MIXED15) WSP(float, Y15, WS_Y15) WSP(bf16, G15, WS_G15) WSP(float, MQP, WS_MQP)
    WSP(float, CIN, WS_CIN) WSP(float2, CAR, WS_CAR) WSP(float, R0, WS_R0) WSP(float, RATIO, WS_RATIO) WSP(float, RL, WS_RL) WSP(float, SSQA, WS_SSQA) WSP(float, SSQL, WS_SSQL)
#undef WSP
};

template <bool UPMAP, int GAIN = 0>
__device__ __forceinline__ void p0_transpose_item(const float* W, int K, int N, bf16* WT, int row_off, LAS float* scr, int item, int lane, const float* g0 = nullptr, const float* g1 = nullptr) {
    const int nblk = N / 32, kb = item / nblk, nb = item % nblk, k0 = 64 * kb, n0 = 32 * nb;
    const int orow0 = UPMAP ? (((n0 % FFN) >> 7) << 8) + 128 * (n0 / FFN) + ((n0 % FFN) & 127) : row_off + n0;
    float wv[32];
#pragma unroll
    for (int i = 0; i < 32; ++i) { const int kk = 2 * i + (lane >> 5); wv[i] = W[(size_t)(k0 + kk) * N + n0 + (lane & 31)]; }
#pragma unroll
    for (int i = 0; i < 32; ++i) { const int kk = 2 * i + (lane >> 5); float gv = 1.f; if (GAIN == 1) gv = g0[k0 + kk]; if (GAIN == 2) gv = (k0 + kk) < 1024 ? g0[k0 + kk] : g1[k0 + kk - 1024];
        scr[kk * 33 + (lane & 31)] = wv[i] * gv; }
    LDS_WAIT(); asm volatile("" ::: "memory");
    const int c = lane & 7;
#pragma unroll
    for (int j = 0; j < 4; ++j) { const int n = (lane >> 3) + 8 * j; const LAS float* s = scr + (8 * c) * 33 + n;
        v4u o; o.x = pk2(s[0 * 33], s[1 * 33]); o.y = pk2(s[2 * 33], s[3 * 33]); o.z = pk2(s[4 * 33], s[5 * 33]); o.w = pk2(s[6 * 33], s[7 * 33]);
        *(GAS v4u*)(WT + (size_t)(orow0 + n) * K + k0 + 8 * c) = o; }
    LDS_WAIT(); asm volatile("" ::: "memory");
}
__device__ __forceinline__ void rms_row_to_bf16(const float* xrow, bf16* orow, int lane, float* rout) {
    const GAS f32x4* xr = (const GAS f32x4*)xrow + lane;
    f32x4 v[8]; float s = 0.f;
#pragma unroll
    for (int j = 0; j < 8; ++j) { v[j] = xr[64 * j]; s += (v[j].x * v[j].x + v[j].y * v[j].y) + (v[j].z * v[j].z + v[j].w * v[j].w); }
    const float r = 1.f / sqrtf(wave_sum(s) * (1.f / DM) + EPS);
    GAS unsigned long long* o8 = (GAS unsigned long long*)orow + lane;
#pragma unroll
    for (int j = 0; j < 8; ++j) o8[64 * j] = (unsigned long long)pk2(v[j].x * r, v[j].y * r) | ((unsigned long long)pk2(v[j].z * r, v[j].w * r) << 32);
    if (rout && lane == 0) *rout = r;
}
constexpr int WT_I_IN = (DM / 64) * (INW / 32), WT_I_OUT = (DM / 64) * (DM / 32), WT_I_UP = (DM / 64) * (UPW / 32), WT_I_DN = (FFN / 64) * (DM / 32), WT_I_G = 32 * 8;
constexpr int WT_O_OUT = WT_I_IN, WT_O_UP = WT_O_OUT + WT_I_OUT, WT_O_DN = WT_O_UP + WT_I_UP, WT_O_G = WT_O_DN + WT_I_DN, WT_NITEMS = WT_O_G + WT_I_G;
__device__ __forceinline__ void wt_items(Frame& F, int it0, int it1, int gw, int NGW) {
    LAS float* scr = (LAS float*)(F.lds + F.wave * 16384);
    for (int it = it0 + gw; it < it1; it += NGW) {
        int r = it;
        if (r < WT_I_IN) { p0_transpose_item<false, 1>(FIN(F, 4  ), DM, INW, F.WIN_T(), 0, scr, r, F.lane, FIN(F, 3  )); continue; } r -= WT_I_IN;
        if (r < WT_I_OUT) { p0_transpose_item<false, 2>(FIN(F, 16  ), DM, DM, F.WOUT_T(), 0, scr, r, F.lane, FIN(F, 14  ), FIN(F, 15  )); continue; } r -= WT_I_OUT;
        if (r < WT_I_UP) { p0_transpose_item<true>(FIN(F, 19  ), DM, UPW, F.WUP_T(), 0, scr, r, F.lane); continue; } r -= WT_I_UP;
        if (r < WT_I_DN) { p0_transpose_item<false>(FIN(F, 22  ), FFN, DM, F.WDOWN_T(), 0, scr, r, F.lane); continue; } r -= WT_I_DN;
        {
            const int mi = r >> 3, sub = r & 7, gate = mi >> 4, dir = (mi >> 3) & 1, blk = mi & 7;
            const float* W = (gate ? FIN(F, 11  ) : FIN(F, 9  )) + (size_t)(dir * 8 + blk) * 16384;
            bf16* WT = F.WG() + (size_t)((dir * 2 + gate) * 8 + blk) * 16384;
            p0_transpose_item<false>(W, 128, 128, WT, 0, scr, sub, F.lane);
        }
    }
}
__device__ __forceinline__ void p0_prologue(Frame& F) {
    const int gw = F.vcu * NWAVES + F.wave, NGW = F.G * NWAVES;
    wt_items(F, 0, WT_O_OUT, gw, NGW);
    wt_items(F, WT_O_G, WT_NITEMS, gw, NGW);
    {
        const float* xp = FIN(F, 0  ); const float* xs = FIN(F, 1  ); const int lane = F.lane;
        f32x4 v[8], vn[8];
#define P0_LOAD(M, V) do { const GAS f32x4* xr_ = (const GAS f32x4*)((M) < 32768 ? xp + (size_t)(M) * DM : xs + (size_t)((M) - 32768) * DM) + lane; \
            _Pragma("unroll") for (int j_ = 0; j_ < 8; ++j_) V[j_] = xr_[64 * j_]; } while (0)
        int m = gw;
        if (m < NTOK) P0_LOAD(m, v);
        for (; m < NTOK; m += NGW) {
            const int mn = m + NGW < NTOK ? m + NGW : m;
            P0_LOAD(mn, vn);
            float s = 0.f;
#pragma unroll
            for (int j = 0; j < 8; ++j) s += (v[j].x * v[j].x + v[j].y * v[j].y) + (v[j].z * v[j].z + v[j].w * v[j].w);
            const float r = 1.f / sqrtf(wave_sum(s) * (1.f / DM) + EPS);
            GAS unsigned long long* o8 = (GAS unsigned long long*)(F.XN() + (size_t)m * DM) + lane;
#pragma unroll
            for (int j = 0; j < 8; ++j) o8[64 * j] = (unsigned long long)pk2(v[j].x * r, v[j].y * r) | ((unsigned long long)pk2(v[j].z * r, v[j].w * r) << 32);
            if (lane == 0) F.R0()[m] = r;
#pragma unroll
            for (int j = 0; j < 8; ++j) v[j] = vn[j];
        }
#undef P0_LOAD
    }
    for (int m = gw; m < 16; m += NGW) rms_row_to_bf16(FIN(F, 2  ) + (size_t)m * DM, F.XNMETA() + (size_t)m * DM, F.lane, nullptr);
    const int gt = F.vcu * 512 + F.tid, NGT = F.G * 512; const v4u z4 = {0u, 0u, 0u, 0u};
    for (int i = gt; i < 12 * 48 * 128; i += NGT) { const int s = i / (48 * 128), rem = i % (48 * 128); ((GAS v4u*)(F.XR() + (size_t)xr_base(s) * 1024))[rem] = z4; }
    for (int i = gt; i < 64 * 128; i += NGT) ((GAS v4u*)(F.XR() + (size_t)XR_ROWS * 1024))[i] = z4;
    for (int i = gt; i < 2048; i += NGT) { ((GAS v4u*)F.KM())[i] = z4; ((GAS v4u*)F.VM())[i] = z4; }
}

template <int R, class Out, bool GMAP = false>
__device__ __forceinline__ void small_gemm(const LAS float* X, int K, const bf16* Wt, int N, int gw, int NGW, int lane, const Out& out) {
    for (int n = gw; n < N; n += NGW) {
        float acc[R];
#pragma unroll
        for (int r = 0; r < R; ++r) acc[r] = 0.f;
        const GAS bf16x8* wrow = (const GAS bf16x8*)(Wt + (size_t)(GMAP ? ((n >> 7) << 8) + (n & 127) : n) * K);
        bf16x8 wq[4];
#pragma unroll
        for (int q = 0; q < 4; ++q) wq[q] = wrow[lane + 64 * q];
#pragma unroll
        for (int q = 0; q < 4; ++q) { const int k8 = lane + 64 * q;
            asm volatile("" ::: "memory");
            const bf16x8 w = wq[q]; float wf[8];
#pragma unroll
            for (int j = 0; j < 8; ++j) wf[j] = bf2f(w[j]);
#pragma unroll
            for (int r = 0; r < R; ++r) { const LAS f32x4* xp = (const LAS f32x4*)(X + r * K + k8 * 8); const f32x4 a = xp[0], b = xp[1];
                acc[r] += (a.x * wf[0] + a.y * wf[1]) + (a.z * wf[2] + a.w * wf[3]) + (b.x * wf[4] + b.y * wf[5]) + (b.z * wf[6] + b.w * wf[7]); }
        }
        float v = 0.f;
#pragma unroll
        for (int r = 0; r < R; ++r) { const float s = wave_sum(acc[r]); v = (lane == r) ? s : v; }
        out(n, lane, v);
    }
}
struct OutMetaZ { float* ZM; bf16* XR;
    __device__ __forceinline__ void operator()(int n, int lane, float v) const {
        if (lane < 16) { ZM[lane * INW + n] = v;
            if (n >= 1536 && n < 2560) { const unsigned short b = (unsigned short)f2bf(v); const int c = n - 1536;
                for (int s = 0; s < 12; ++s) XR[(size_t)(xr_base(s) + 48 + lane) * 1024 + c] = b; } }
    } };
struct OutRows { float* Y; int ld; int R;
    __device__ __forceinline__ void operator()(int n, int lane, float v) const { if (lane < R) Y[(size_t)lane * ld + n] = v; } };
struct OutRowsB { bf16* Y; int ld; int R;
    __device__ __forceinline__ void operator()(int n, int lane, float v) const { if (lane < R) Y[(size_t)lane * ld + n] = (bf16)f2bf(v); } };

__device__ __forceinline__ void p1_meta_z(Frame& F) {
    LAS float* X = (LAS float*)F.lds;
    for (int i = F.tid; i < 16 * DM / 8; i += 512) { const bf16x8 v = ((const GAS bf16x8*)F.XNMETA())[i];
        ((LAS f32x4*)X)[2 * i] = (f32x4){bf2f(v[0]), bf2f(v[1]), bf2f(v[2]), bf2f(v[3])}; ((LAS f32x4*)X)[2 * i + 1] = (f32x4){bf2f(v[4]), bf2f(v[5]), bf2f(v[6]), bf2f(v[7])}; }
    __syncthreads();
    const OutMetaZ o{F.ZM(), F.XR()};
    small_gemm<16, OutMetaZ>(X, DM, F.WIN_T(), INW, F.vcu * NWAVES + F.wave, F.G * NWAVES, F.lane, o);
    __syncthreads();
}
typedef float f32x16 __attribute__((ext_vector_type(16)));
constexpr int LRU_XC0 = 0, LRU_XC_BUF = 17408, LRU_XC_STRIDE = 272;
constexpr int LRU_CW = 34816;
constexpr int LRU_HF = 37376, LRU_HB = LRU_HF + 32768;
__device__ __forceinline__ int crow16(int r, int hi) { return (r & 3) + 8 * (r >> 2) + 4 * hi; }

template <int DIR>
__device__ __forceinline__ void scan_tile(const float (&a)[16], const float (&u)[16], float& carry, float& ptot, float (&h)[16], bool up) {
    float HL[16], PL[16], As[4], Hs[4];
#pragma unroll
    for (int j = 0; j < 4; ++j) {
        float hl = 0.f, p = 1.f;
#pragma unroll
        for (int ii = 0; ii < 4; ++ii) { const int idx = 4 * j + (DIR == 0 ? ii : 3 - ii); hl = a[idx] * hl + u[idx]; p *= a[idx]; HL[idx] = hl; PL[idx] = p; }
        As[j] = p; Hs[j] = hl;
    }
    float Alo[4], Ahi[4], Hlo[4], Hhi[4];
#pragma unroll
    for (int j = 0; j < 4; ++j) {
        { const unsigned x = __float_as_uint(As[j]); auto rr = __builtin_amdgcn_permlane32_swap(x, x, false, false); Alo[j] = __uint_as_float(rr[0]); Ahi[j] = __uint_as_float(rr[1]); }
        { const unsigned x = __float_as_uint(Hs[j]); auto rr = __builtin_amdgcn_permlane32_swap(x, x, false, false); Hlo[j] = __uint_as_float(rr[0]); Hhi[j] = __uint_as_float(rr[1]); }
    }
    float cin[4]; float c = carry;
    if (DIR == 0) {
#pragma unroll
        for (int j = 0; j < 4; ++j) { const float c_lo = c; c = Alo[j] * c + Hlo[j]; const float c_hi = c; c = Ahi[j] * c + Hhi[j]; cin[j] = up ? c_hi : c_lo; }
    } else {
#pragma unroll
        for (int j = 3; j >= 0; --j) { const float c_hi = c; c = Ahi[j] * c + Hhi[j]; const float c_lo = c; c = Alo[j] * c + Hlo[j]; cin[j] = up ? c_hi : c_lo; }
    }
    carry = c;
#pragma unroll
    for (int j = 0; j < 4; ++j) ptot *= Alo[j] * Ahi[j];
#pragma unroll
    for (int idx = 0; idx < 16; ++idx) h[idx] = HL[idx] + PL[idx] * cin[idx >> 2];
}

__device__ __forceinline__ void lru_decode(int cg, int& seq, int& c) { if (cg < 520) { seq = cg / 65; c = cg - seq * 65; } else { const int c2 = cg - 520; seq = c2 / 129; c = c2 - seq * 129; seq += 8; } }
template <int PASS>
__device__ __forceinline__ void lru_phase(Frame& F, bf16* gout) {
    LAS unsigned char* L = F.lds;
    const int tid = F.tid, lane = F.lane, wave = F.wave;
    const int n = F.vcu & 7, ngrp = F.G >> 3;
    { const float* cw = FIN(F, 7  ); const float* cb = FIN(F, 8  );
      for (int i = tid; i < 640; i += 512) { const int k = i >> 7, ch = i & 127; ((LAS float*)(L + LRU_CW))[i] = k < 4 ? cw[k * 1024 + n * 128 + ch] : cb[n * 128 + ch]; } }
    const int d = wave >> 2, g4 = wave & 3, r32 = lane & 31, hi = lane >> 5, chl = g4 * 32 + r32, chg = n * 128 + chl;
    bf16x8 br[8], bi[8];
    { const bf16* wr_ = F.WG() + (size_t)((d * 2 + 0) * 8 + n) * 16384 + chl * 128 + hi * 8;
      const bf16* wi_ = F.WG() + (size_t)((d * 2 + 1) * 8 + n) * 16384 + chl * 128 + hi * 8;
#pragma unroll
      for (int ks = 0; ks < 8; ++ks) { br[ks] = *(const GAS bf16x8*)(wr_ + ks * 16); bi[ks] = *(const GAS bf16x8*)(wi_ + ks * 16); } }
    constexpr float L2E = 1.4426950408889634f;
    const float nb_r = -L2E * FIN(F, 10  )[d * 1024 + chg], nb_i = -L2E * FIN(F, 12  )[d * 1024 + chg];
    const float spl = 8.f * L2E * log1pf(expf(-FIN(F, 13  )[d * 1024 + chg]));
    const int tau0 = tid >> 4, co = (tid & 15) * 8;
    bf16x8 xv[2][4];
#define LRU_PREFETCH(cgx) do { int s_, c_; lru_decode((cgx), s_, c_); const int xb_ = xr_base(s_); \
        _Pragma("unroll") for (int it_ = 0; it_ < 2; ++it_) _Pragma("unroll") for (int k_ = 0; k_ < 4; ++k_) { int row_ = xb_ + c_ * 64 + tau0 + 32 * it_ + k_ - 2; row_ = row_ < 0 ? 0 : row_; \
            xv[it_][k_] = *(const GAS bf16x8*)(F.XR() + (size_t)row_ * 1024 + n * 128 + co); } } while (0)
    int cg = F.vcu < 8 * ngrp ? F.vcu >> 3 : NCHUNK;
    if (cg < NCHUNK) LRU_PREFETCH(cg);
    __syncthreads();
    for (int ui = 0; cg < NCHUNK; cg += ngrp, ++ui) {
        int seq, c; lru_decode(cg, seq, c);
        LAS unsigned char* XC = L + LRU_XC0 + (ui & 1) * LRU_XC_BUF;
        float carry = 0.f, ptot = 1.f;
        if (PASS == 2) carry = F.CIN()[((size_t)cg * 2 + d) * 1024 + chg];
#pragma unroll
        for (int it = 0; it < 2; ++it) {
            const int tau = tau0 + 32 * it; float xc[8];
            { const LAS f32x4* cb = (const LAS f32x4*)(L + LRU_CW + (4 * 128 + co) * 4); const f32x4 b0 = cb[0], b1 = cb[1];
              xc[0] = b0.x; xc[1] = b0.y; xc[2] = b0.z; xc[3] = b0.w; xc[4] = b1.x; xc[5] = b1.y; xc[6] = b1.z; xc[7] = b1.w; }
#pragma unroll
            for (int k = 0; k < 4; ++k) { const LAS f32x4* wp = (const LAS f32x4*)(L + LRU_CW + (k * 128 + co) * 4); const f32x4 w0 = wp[0], w1 = wp[1]; const bf16x8 v = xv[it][k];
                xc[0] += w0.x * bf2f(v[0]); xc[1] += w0.y * bf2f(v[1]); xc[2] += w0.z * bf2f(v[2]); xc[3] += w0.w * bf2f(v[3]);
                xc[4] += w1.x * bf2f(v[4]); xc[5] += w1.y * bf2f(v[5]); xc[6] += w1.z * bf2f(v[6]); xc[7] += w1.w * bf2f(v[7]); }
            if (c == 0 && tau < 48) {
#pragma unroll
                for (int j = 0; j < 8; ++j) xc[j] = 0.f;
            }
            *(LAS v4u*)(XC + tau * LRU_XC_STRIDE + co * 2) = pack8(xc);
        }
        bf16x8 gv[2];
        const int row0 = seq_first_row(seq) + 64 * (c - 1);
        if (PASS == 2) { if (c > 0) {
#pragma unroll
            for (int it = 0; it < 2; ++it) gv[it] = *(const GAS bf16x8*)(F.QG() + (size_t)(row0 + tau0 + 32 * it) * DM + 1024 + n * 128 + co); } }
        __syncthreads();
        if (cg + ngrp < NCHUNK) LRU_PREFETCH(cg + ngrp);
        f32x16 arT[2], aiT[2];
#pragma unroll
        for (int tt = 0; tt < 2; ++tt) {
            const int tile = d ? 1 - tt : tt;
            f32x16 ar = {}, ai = {};
#pragma unroll
            for (int ks = 0; ks < 8; ++ks) {
                const bf16x8 a = *(const LAS bf16x8*)(XC + (tile * 32 + r32) * LRU_XC_STRIDE + (ks * 16 + hi * 8) * 2);
                ar = __builtin_amdgcn_mfma_f32_32x32x16_bf16(a, br[ks], ar, 0, 0, 0);
                ai = __builtin_amdgcn_mfma_f32_32x32x16_bf16(a, bi[ks], ai, 0, 0, 0);
            }
            arT[tt] = ar; aiT[tt] = ai;
        }
#pragma unroll
        for (int tt = 0; tt < 2; ++tt) {
            const int tile = d ? 1 - tt : tt;
            const f32x16 ar = arT[tt], ai = aiT[tt];
            float av[16], uv[16], hv[16];
            typedef float f32x2 __attribute__((ext_vector_type(2)));
#pragma unroll
            for (int r = 0; r < 16; r += 2) {
                const int tau0_ = tile * 32 + crow16(r, hi);
                const f32x2 xc2 = {bf2f(*(const LAS unsigned short*)(XC + tau0_ * LRU_XC_STRIDE + chl * 2)), bf2f(*(const LAS unsigned short*)(XC + (tau0_ + 1) * LRU_XC_STRIDE + chl * 2))};
                const f32x2 tr = (f32x2){ar[r], ar[r + 1]} * (f32x2){-L2E, -L2E} + (f32x2){nb_r, nb_r};
                const f32x2 ti = (f32x2){ai[r], ai[r + 1]} * (f32x2){-L2E, -L2E} + (f32x2){nb_i, nb_i};
                const f32x2 dr = (f32x2){__builtin_amdgcn_exp2f(tr.x), __builtin_amdgcn_exp2f(tr.y)} + (f32x2){1.f, 1.f};
                const f32x2 di = (f32x2){__builtin_amdgcn_exp2f(ti.x), __builtin_amdgcn_exp2f(ti.y)} + (f32x2){1.f, 1.f};
                const f32x2 rg = {__builtin_amdgcn_rcpf(dr.x), __builtin_amdgcn_rcpf(dr.y)}, ig = {__builtin_amdgcn_rcpf(di.x), __builtin_amdgcn_rcpf(di.y)};
                const f32x2 la = rg * (f32x2){-spl, -spl};
                const f32x2 a = {__builtin_amdgcn_exp2f(la.x), __builtin_amdgcn_exp2f(la.y)};
                const f32x2 t = (f32x2){1.f, 1.f} - a * a;
                const f32x2 m = {__builtin_amdgcn_sqrtf(t.x), __builtin_amdgcn_sqrtf(t.y)};
                const f32x2 u = m * (ig * xc2);
                av[r] = a.x; av[r + 1] = a.y; uv[r] = u.x; uv[r + 1] = u.y;
            }
            if (d == 0) scan_tile<0>(av, uv, carry, ptot, hv, hi != 0); else scan_tile<1>(av, uv, carry, ptot, hv, hi != 0);
            if (PASS == 2) {
#pragma unroll
                for (int r = 0; r < 16; ++r) { const int tau = tile * 32 + crow16(r, hi); *(LAS float*)(L + (d ? LRU_HB : LRU_HF) + (tau * 128 + chl) * 4) = hv[r]; }
            }
        }
        if (PASS == 1) { if (hi == 0) F.CAR()[((size_t)cg * 2 + d) * 1024 + chg] = make_float2(ptot, carry); }
        if (PASS == 2) {
            __syncthreads();
            if (c > 0) {
#pragma unroll
                for (int it = 0; it < 2; ++it) {
                    const int tau = tau0 + 32 * it; const bf16x8 g8 = gv[it];
                    const LAS f32x4* hf = (const LAS f32x4*)(L + LRU_HF + (tau * 128 + co) * 4); const LAS f32x4* hb = (const LAS f32x4*)(L + LRU_HB + (tau * 128 + co) * 4);
                    const f32x4 f0 = hf[0], f1 = hf[1], b0 = hb[0], b1 = hb[1];
                    float o[8];
                    o[0] = (f0.x + b0.x) * gelu_tanh(bf2f(g8[0])); o[1] = (f0.y + b0.y) * gelu_tanh(bf2f(g8[1])); o[2] = (f0.z + b0.z) * gelu_tanh(bf2f(g8[2])); o[3] = (f0.w + b0.w) * gelu_tanh(bf2f(g8[3]));
                    o[4] = (f1.x + b1.x) * gelu_tanh(bf2f(g8[4])); o[5] = (f1.y + b1.y) * gelu_tanh(bf2f(g8[5])); o[6] = (f1.z + b1.z) * gelu_tanh(bf2f(g8[6])); o[7] = (f1.w + b1.w) * gelu_tanh(bf2f(g8[7]));
                    *(GAS v4u*)(gout + (size_t)(row0 + tau) * DM + 1024 + n * 128 + co) = pack8(o);
                    float sq = (o[0] * o[0] + o[1] * o[1]) + (o[2] * o[2] + o[3] * o[3]) + (o[4] * o[4] + o[5] * o[5]) + (o[6] * o[6] + o[7] * o[7]);
                    sq += __shfl_xor(sq, 1); sq += __shfl_xor(sq, 2); sq += __shfl_xor(sq, 4); sq += __shfl_xor(sq, 8);
                    if ((tid & 15) == 0) F.SSQL()[(size_t)(row0 + tau) * 8 + n] = sq;
                }
            } else if (tid < 128) {
                const float hf = *(const LAS float*)(L + LRU_HF + (63 * 128 + tid) * 4), hb = *(const LAS float*)(L + LRU_HB + (63 * 128 + tid) * 4);
                F.LO15()[seq * 1024 + n * 128 + tid] = (hf + hb) * gelu_tanh(F.GY15()[n * 128 + tid]);
            }
        }
    }
    __syncthreads();
#undef LRU_PREFETCH
}
__device__ __forceinline__ void lru_propagate(Frame& F) {
    const int gid = F.vcu * 512 + F.tid;
    if (gid < 12 * 2048) {
        const int s = gid >> 11, d = (gid >> 10) & 1, ch = gid & 1023; const int nch = s < 8 ? 65 : 129, cb = chunk_base(s);
        const float2* car = F.CAR() + (size_t)d * 1024 + ch; float* cinp = F.CIN() + (size_t)d * 1024 + ch;
        float cin = 0.f;
        float2 pa[16], pb[16];
#define PRP_LOAD(P, B0) do { _Pragma("unroll") for (int i = 0; i < 16; ++i) { int cc = (B0) + i; cc = cc < nch ? cc : nch - 1; const int c = d ? nch - 1 - cc : cc; P[i] = car[(size_t)(cb + c) * 2048]; } } while (0)
#define PRP_RUN(P, B0) do { _Pragma("unroll") for (int i = 0; i < 16; ++i) { const int cc = (B0) + i; const int c = d ? nch - 1 - cc : cc; if (cc < nch) { cinp[(size_t)(cb + c) * 2048] = cin; cin = P[i].x * cin + P[i].y; } } } while (0)
        PRP_LOAD(pa, 0);
        for (int b0 = 0; b0 < nch; b0 += 32) {
            PRP_LOAD(pb, b0 + 16);
            PRP_RUN(pa, b0);
            PRP_LOAD(pa, b0 + 32);
            PRP_RUN(pb, b0 + 16);
        }
#undef PRP_LOAD
#undef PRP_RUN
    }
}

__device__ __forceinline__ void k_rope_pass(Frame& F, bf16* Kout, int gw, int NGW) {
    const int sub = F.lane >> 4, l16 = F.lane & 15;
    const int c0 = 8 * l16, p = l16 >> 3, half = (l16 >> 2) & 1, i0 = 8 * (l16 & 3);
    float inv[8], gk[8];
#pragma unroll
    for (int j = 0; j < 8; ++j) { inv[j] = __builtin_amdgcn_exp2f(-(float)(i0 + j) * (13.287712379549449f / 32.f)) * 0.15915494309189535f; gk[j] = FIN(F, 6  )[c0 + j]; }
    constexpr int NIT = NTOK * 2 / 4;
    bf16x8 v, vn;
    if (gw < NIT) { const int item = gw * 4 + sub; v = *(const GAS bf16x8*)(F.K() + (size_t)(item >> 1) * 256 + (item & 1) * 128 + c0); }
    for (int it = gw; it < NIT; it += NGW) {
        const int item = it * 4 + sub, row = item >> 1, hk = item & 1;
        { const int nit = it + NGW < NIT ? it + NGW : it; const int ni = nit * 4 + sub; vn = *(const GAS bf16x8*)(F.K() + (size_t)(ni >> 1) * 256 + (ni & 1) * 128 + c0); }
        const int s = row_seq(row), t = row - seq_first_row(s); const float pos = (float)(p ? (t & 63) : (t >> 6));
        float x[8]; float ss = 0.f;
#pragma unroll
        for (int j = 0; j < 8; ++j) { x[j] = bf2f(v[j]); ss += x[j] * x[j]; }
        ss += __shfl_xor(ss, 1); ss += __shfl_xor(ss, 2); ss += __shfl_xor(ss, 4); ss += __shfl_xor(ss, 8);
        const float rs = 1.f / sqrtf(ss * (1.f / 128.f) + EPS); float o[8];
#pragma unroll
        for (int j = 0; j < 8; ++j) { x[j] *= rs * gk[j]; const float pr = __shfl_xor(x[j], 4);
            float rev = pos * inv[j]; rev -= floorf(rev); const float sn = __builtin_amdgcn_sinf(rev), cs = __builtin_amdgcn_cosf(rev);
            o[j] = half ? x[j] * cs + pr * sn : x[j] * cs - pr * sn; }
        *(GAS v4u*)(Kout + (size_t)row * 256 + hk * 128 + c0) = pack8(o);
        v = vn;
    }
}
__device__ __forceinline__ void p3_meta_job(Frame& F) {
    for (int pr = F.wave; pr < 32; pr += 8) { const int r = pr >> 1, hk = pr & 1; const float* z = F.ZM() + r * INW + 1024 + hk * 128;
        const float a = z[F.lane], b = z[F.lane + 64]; const float rs = 1.f / sqrtf(wave_sum(a * a + b * b) * (1.f / 128.f) + EPS);
        F.KM()[r * 256 + hk * 128 + F.lane] = (bf16)f2bf(a * rs * FIN(F, 6  )[F.lane]); F.KM()[r * 256 + hk * 128 + F.lane + 64] = (bf16)f2bf(b * rs * FIN(F, 6  )[F.lane + 64]); }
    for (int i = F.tid; i < 16 * 256; i += 512) F.VM()[i] = (bf16)f2bf(F.ZM()[(i >> 8) * INW + 1280 + (i & 255)]);
    { const int h = F.wave; const float* z = F.ZM() + 15 * INW + h * 128; const float a = z[F.lane], b = z[F.lane + 64];
      const float rs = 1.f / sqrtf(wave_sum(a * a + b * b) * (1.f / 128.f) + EPS);
      F.Q15()[h * 128 + F.lane] = a * rs * FIN(F, 5  )[F.lane]; F.Q15()[h * 128 + F.lane + 64] = b * rs * FIN(F, 5  )[F.lane + 64]; }
    for (int i = F.tid; i < 1024; i += 512) F.GY15()[i] = F.ZM()[15 * INW + 2560 + i];
}

__device__ __forceinline__ void metaq_item(Frame& F, int it) {
    int s, kvh, j; if (it < 256) { s = it >> 5; kvh = (it >> 4) & 1; j = it & 15; } else { const int t2 = it - 256; s = 8 + (t2 >> 6); kvh = (t2 >> 5) & 1; j = t2 & 31; }
    LAS float* q4 = (LAS float*)F.lds;
    LAS float* sc = q4 + 512;
    LAS float* red = sc + 4 * 288;
    const int tid = F.tid, nk = 256 + (j == 0 ? 16 : 0), row0 = seq_first_row(s) + 256 * j;
    q4[tid] = F.Q15()[kvh * 512 + tid];
    __syncthreads();
    if (tid < nk) {
        const bf16* kp = tid < 256 ? F.K() + (size_t)(row0 + tid) * 256 + kvh * 128 : F.KM() + (tid - 256) * 256 + kvh * 128;
        float d0 = 0.f, d1 = 0.f, d2 = 0.f, d3 = 0.f;
        bf16x8 kq[16];
#pragma unroll
        for (int cc = 0; cc < 16; ++cc) kq[cc] = ((const GAS bf16x8*)kp)[cc];
#pragma unroll
        for (int cc = 0; cc < 16; ++cc) { const bf16x8 kv = kq[cc];
#pragma unroll
            for (int e = 0; e < 8; ++e) { const float kf = bf2f(kv[e]); d0 += kf * q4[cc * 8 + e]; d1 += kf * q4[128 + cc * 8 + e]; d2 += kf * q4[256 + cc * 8 + e]; d3 += kf * q4[384 + cc * 8 + e]; } }
        const float SC = 0.088388347648318440f;
        sc[tid] = d0 * SC; sc[288 + tid] = d1 * SC; sc[576 + tid] = d2 * SC; sc[864 + tid] = d3 * SC;
    }
    __syncthreads();
    if (F.wave < 4) { LAS float* sh = sc + F.wave * 288; float m = -INFINITY;
        for (int k = F.lane; k < nk; k += 64) m = fmaxf(m, sh[k]);
        m = wave_max(m); float l = 0.f;
        for (int k = F.lane; k < nk; k += 64) { const float p = __expf(sh[k] - m); sh[k] = p; l += p; }
        l = wave_sum(l);
        if (F.lane == 0) { red[F.wave * 2] = m; red[F.wave * 2 + 1] = l; } }
    __syncthreads();
    {
        const int kg = tid >> 4, oc = tid & 15; float o[4][8];
#pragma unroll
        for (int h = 0; h < 4; ++h)
#pragma unroll
            for (int e = 0; e < 8; ++e) o[h][e] = 0.f;
        const bf16* vp = F.V() + (size_t)(row0 + kg * 8) * 256 + kvh * 128 + oc * 8;
        bf16x8 vv[8];
#pragma unroll
        for (int k = 0; k < 8; ++k) vv[k] = *(const GAS bf16x8*)(vp + (size_t)k * 256);
#pragma unroll
        for (int k = 0; k < 8; ++k) { const float p0 = sc[kg * 8 + k], p1 = sc[288 + kg * 8 + k], p2 = sc[576 + kg * 8 + k], p3 = sc[864 + kg * 8 + k];
#pragma unroll
            for (int e = 0; e < 8; ++e) { const float vf = bf2f(vv[k][e]); o[0][e] += p0 * vf; o[1][e] += p1 * vf; o[2][e] += p2 * vf; o[3][e] += p3 * vf; } }
        if (j == 0 && kg < 16) { const int k = kg; const bf16x8 v1 = *(const GAS bf16x8*)(F.VM() + k * 256 + kvh * 128 + oc * 8);
            const float p0 = sc[256 + k], p1 = sc[288 + 256 + k], p2 = sc[576 + 256 + k], p3 = sc[864 + 256 + k];
#pragma unroll
            for (int e = 0; e < 8; ++e) { const float vf = bf2f(v1[e]); o[0][e] += p0 * vf; o[1][e] += p1 * vf; o[2][e] += p2 * vf; o[3][e] += p3 * vf; } }
        LAS float* part = sc + 4 * 288 + 16;
#pragma unroll
        for (int h = 0; h < 4; ++h) { LAS f32x4* pp = (LAS f32x4*)(part + (kg * 4 + h) * 128 + oc * 8); pp[0] = (f32x4){o[h][0], o[h][1], o[h][2], o[h][3]}; pp[1] = (f32x4){o[h][4], o[h][5], o[h][6], o[h][7]}; }
        __syncthreads();
        const int h = tid >> 7, d = tid & 127; float os = 0.f;
#pragma unroll 8
        for (int g = 0; g < 32; ++g) os += part[(g * 4 + h) * 128 + d];
        float* dst = F.MQP() + ((size_t)it * 4 + h) * 132; dst[2 + d] = os; if (d == 0) { dst[0] = red[h * 2]; dst[1] = red[h * 2 + 1]; } }
    __syncthreads();
}
__device__ __forceinline__ void attn_phase(Frame& F, char* lds_generic, bf16* obase) {
    const int nr = F.G == 256 ? 8 : (2048 + F.G - 1) / F.G;
    for (int r = 0; r < nr; ++r) {
        int s, kvh, hq, qb, S;
        if (F.G == 256) {
            const int x = F.vcu >> 5, i = F.vcu & 31;
            if (r < 4) { const int pair = 2 * x + (r >> 1); s = pair >> 1; kvh = pair & 1; const int u = (r & 1) * 32 + i; hq = u >> 4; qb = u & 15; S = 4096; }
            else { const int pair = x; s = 8 + (pair >> 1); kvh = pair & 1; const int u = (r - 4) * 32 + i; hq = u >> 5; qb = u & 31; S = 8192; }
        } else {
            const int U = F.vcu + F.G * r; if (U >= 2048) break;
            if (U < 1024) { const int pair = U >> 6, u = U & 63; s = pair >> 1; kvh = pair & 1; hq = u >> 4; qb = u & 15; S = 4096; }
            else { const int pair = (U - 1024) >> 7, u = (U - 1024) & 127; s = 8 + (pair >> 1); kvh = pair & 1; hq = u >> 5; qb = u & 31; S = 8192; }
        }
        const int row0 = seq_first_row(s), h = kvh * 4 + hq;
        bf16* qp = F.QG() + (size_t)(row0 + qb * 256) * DM + h * 128;
        attn::attn_unit(qp, F.K() + (size_t)row0 * 256 + kvh * 128, F.V() + (size_t)row0 * 256 + kvh * 128, F.KM() + kvh * 128, F.VM() + kvh * 128, obase + (size_t)(row0 + qb * 256) * DM + h * 128, S / 64 + 1, lds_generic, FIN(F, 5  ), qb * 256, F.SSQA() + (size_t)(row0 + qb * 256) * 8 + h, F.wave);
    }
}

__device__ __forceinline__ void p5_ratio(Frame& F) {
    for (int row = F.vcu * 512 + F.tid; row < NTOK; row += F.G * 512) {
        const GAS f32x4* pa = (const GAS f32x4*)(F.SSQA() + (size_t)row * 8); const GAS f32x4* pl = (const GAS f32x4*)(F.SSQL() + (size_t)row * 8);
        const f32x4 a0 = pa[0], a1 = pa[1], l0 = pl[0], l1 = pl[1];
        const float sa = ((a0.x + a0.y) + (a0.z + a0.w)) + ((a1.x + a1.y) + (a1.z + a1.w)), sl = ((l0.x + l0.y) + (l0.z + l0.w)) + ((l1.x + l1.y) + (l1.z + l1.w));
        const float qa = sqrtf(sa * (1.f / 1024.f) + EPS), ql = sqrtf(sl * (1.f / 1024.f) + EPS);
        F.RATIO()[row] = ql / qa; F.RL()[row] = 1.f / ql;
    }
}
__device__ __forceinline__ void p5_meta_job(Frame& F, int s) {
    LAS float* buf = (LAS float*)F.lds; LAS float* red = buf + 2048; const int tid = F.tid;
    {
        const int nj = s < 8 ? 16 : 32;
        for (int e = tid; e < 1024; e += 512) { const int h = e >> 7, d = e & 127, kvh = h >> 2, hq = h & 3;
            const int it0 = s < 8 ? s * 32 + kvh * 16 : 256 + (s - 8) * 64 + kvh * 32;
            float M = -INFINITY;
#pragma unroll 16
            for (int j = 0; j < nj; ++j) M = fmaxf(M, F.MQP()[((size_t)(it0 + j) * 4 + hq) * 132]);
            float Ls = 0.f, O = 0.f;
#pragma unroll 16
            for (int j = 0; j < nj; ++j) { const float* p = F.MQP() + ((size_t)(it0 + j) * 4 + hq) * 132; const float w = __expf(p[0] - M); Ls += p[1] * w; O += p[2 + d] * w; }
            buf[e] = O / Ls; }
        for (int e = tid; e < 1024; e += 512) buf[1024 + e] = F.LO15()[s * 1024 + e];
        __syncthreads();
        { float ss = 0.f; for (int k = F.lane; k < 256; k += 64) { const float v = buf[F.wave * 256 + k]; ss += v * v; } ss = wave_sum(ss); if (F.lane == 0) red[F.wave] = ss; }
        __syncthreads();
        const float ra = 1.f / sqrtf((red[0] + red[1] + red[2] + red[3]) * (1.f / 1024.f) + EPS), rl = 1.f / sqrtf((red[4] + red[5] + red[6] + red[7]) * (1.f / 1024.f) + EPS);
        for (int e = tid; e < 2048; e += 512) F.MIXED15()[s * 2048 + e] = e < 1024 ? buf[e] * ra : buf[e] * rl;
        __syncthreads();
    }
}
__device__ __forceinline__ void p6_meta_y(Frame& F) {
    LAS float* X = (LAS float*)F.lds;
    for (int i = F.tid; i < 12 * DM / 4; i += 512) ((LAS f32x4*)X)[i] = ((const GAS f32x4*)F.MIXED15())[i];
    __syncthreads();
    const OutRows o{F.Y15(), DM, 12};
    small_gemm<12, OutRows>(X, DM, F.WOUT_T(), DM, F.vcu * NWAVES + F.wave, F.G * NWAVES, F.lane, o);
    __syncthreads();
}

__device__ __forceinline__ void p7_rows(Frame& F, int q, int gw, int NGW) {
    const int lane = F.lane;
    f32x4 gm[8], gf[8];
    { const float* a = FIN(F, 17  ); const float* b = FIN(F, 18  );
#pragma unroll
      for (int i = 0; i < 4; ++i) { const int e0 = (lane + 64 * i) * 8; gm[2 * i] = *(const GAS f32x4*)(a + e0); gm[2 * i + 1] = *(const GAS f32x4*)(a + e0 + 4); gf[2 * i] = *(const GAS f32x4*)(b + e0); gf[2 * i + 1] = *(const GAS f32x4*)(b + e0 + 4); } }
    bf16* h1base = q == 0 ? F.H1A() : F.XN();
    bf16x8 yv[4], yn[4]; v4u xv[4], xw[4]; float r0c = 1.f, r0n = 1.f;
    const int rend = (q + 1) * HROWS;
    int row = q * HROWS + gw;
#define P7_LOAD(R, Y, X, RV) do { const GAS bf16x8* y_ = (const GAS bf16x8*)((const bf16*)(F.out + (size_t)(R) * DM)); const GAS v4u* x_ = (const GAS v4u*)(F.XN() + (size_t)(R) * DM); \
        _Pragma("unroll") for (int i_ = 0; i_ < 4; ++i_) { Y[i_] = y_[lane + 64 * i_]; X[i_] = x_[lane + 64 * i_]; } RV = F.R0()[(R)]; } while (0)
    if (row < rend) P7_LOAD(row, yv, xv, r0c);
    for (; row < rend; row += NGW) {
        const int nrow = row + NGW < rend ? row + NGW : row;
        P7_LOAD(nrow, yn, xw, r0n);
        GAS v4u* xn = (GAS v4u*)(F.XN() + (size_t)row * DM);
        GAS v4u* h1row = (GAS v4u*)(h1base + (size_t)(row - q * HROWS) * DM);
        const float ir0 = 1.f / r0c;
        float hv[32]; float ss = 0.f;
#pragma unroll
        for (int i = 0; i < 4; ++i)
#pragma unroll
            for (int j = 0; j < 8; ++j) { hv[8 * i + j] = bf2f(yv[i][j]); ss += hv[8 * i + j] * hv[8 * i + j]; }
        const float r1 = 1.f / sqrtf(wave_sum(ss) * (1.f / DM) + EPS); float s2 = 0.f;
#pragma unroll
        for (int i = 0; i < 4; ++i) {
            const v4u xq = xv[i]; const f32x4 g0 = gm[2 * i], g1 = gm[2 * i + 1];
            const float xf[8] = {__builtin_bit_cast(float, xq.x << 16), __builtin_bit_cast(float, xq.x & 0xffff0000u), __builtin_bit_cast(float, xq.y << 16), __builtin_bit_cast(float, xq.y & 0xffff0000u),
                                 __builtin_bit_cast(float, xq.z << 16), __builtin_bit_cast(float, xq.z & 0xffff0000u), __builtin_bit_cast(float, xq.w << 16), __builtin_bit_cast(float, xq.w & 0xffff0000u)};
            const float gg[8] = {g0.x, g0.y, g0.z, g0.w, g1.x, g1.y, g1.z, g1.w};
            float hb[8];
#pragma unroll
            for (int j = 0; j < 8; ++j) { hb[j] = xf[j] * ir0 + hv[8 * i + j] * r1 * gg[j]; hv[8 * i + j] = hb[j]; s2 += hb[j] * hb[j]; }
            h1row[lane + 64 * i] = pack8(hb);
        }
        const float r2 = 1.f / sqrtf(wave_sum(s2) * (1.f / DM) + EPS);
#pragma unroll
        for (int i = 0; i < 4; ++i) { const f32x4 g0 = gf[2 * i], g1 = gf[2 * i + 1];
            float t[8]; t[0] = hv[8 * i + 0] * r2 * g0.x; t[1] = hv[8 * i + 1] * r2 * g0.y; t[2] = hv[8 * i + 2] * r2 * g0.z; t[3] = hv[8 * i + 3] * r2 * g0.w;
            t[4] = hv[8 * i + 4] * r2 * g1.x; t[5] = hv[8 * i + 5] * r2 * g1.y; t[6] = hv[8 * i + 6] * r2 * g1.z; t[7] = hv[8 * i + 7] * r2 * g1.w;
            xn[lane + 64 * i] = pack8(t); }
#pragma unroll
        for (int i = 0; i < 4; ++i) { yv[i] = yn[i]; xv[i] = xw[i]; }
        r0c = r0n;
    }
#undef P7_LOAD
}
__device__ __forceinline__ void p7_meta_g(Frame& F) {
    LAS float* X = (LAS float*)F.lds;
    for (int r = F.wave; r < 12; r += 8) {
        const float* y = F.Y15() + r * DM; const float* xm = FIN(F, 2  ) + 15 * DM;
        float hv[32]; float ss = 0.f;
#pragma unroll
        for (int i = 0; i < 32; ++i) { hv[i] = y[F.lane + 64 * i]; ss += hv[i] * hv[i]; }
        const float r1 = 1.f / sqrtf(wave_sum(ss) * (1.f / DM) + EPS); float s2 = 0.f;
#pragma unroll
        for (int i = 0; i < 32; ++i) { const int e = F.lane + 64 * i; hv[i] = xm[e] + hv[i] * r1 * FIN(F, 17  )[e]; s2 += hv[i] * hv[i]; }
        const float r2 = 1.f / sqrtf(wave_sum(s2) * (1.f / DM) + EPS);
#pragma unroll
        for (int i = 0; i < 32; ++i) { const int e = F.lane + 64 * i; X[r * DM + e] = hv[i] * r2 * FIN(F, 18  )[e]; }
    }
    __syncthreads();
    const OutRowsB o{F.G15(), FFN, 12};
    small_gemm<12, OutRowsB, true>(X, DM, F.WUP_T(), FFN, F.vcu * NWAVES + F.wave, F.G * NWAVES, F.lane, o);
    __syncthreads();
}

__device__ __forceinline__ void p9_fix(Frame& F, int h) {
    constexpr int NOCT = FFN / 8, NBW = 512 * 2;
    const int gid = F.vcu * 512 + F.tid, oct = gid % NOCT, grp = gid / NOCT, NGRP = (F.G * 512) / NOCT;
    if (grp >= NGRP) return;
    const int co = oct * 8;
    const float* cw = FIN(F, 20  ); const float* cb = FIN(F, 21  );
    float w0[8], w1[8], w2[8], bb[8];
#define LD8F(dst, p) do { const GAS f32x4* p_ = (const GAS f32x4*)(p); const f32x4 a_ = p_[0], b_ = p_[1]; dst[0] = a_.x; dst[1] = a_.y; dst[2] = a_.z; dst[3] = a_.w; dst[4] = b_.x; dst[5] = b_.y; dst[6] = b_.z; dst[7] = b_.w; } while (0)
    LD8F(w0, cw + co); LD8F(w1, cw + FFN + co); LD8F(w2, cw + 2 * FFN + co); LD8F(bb, cb + co);
#define P9_PTRS(BW, E_, O_, Z_) do { const int which_ = (BW) & 1, B_ = (BW) >> 1; const int row_ = h * HROWS + B_ * 64 + (which_ ? 63 : 0), s_ = row_seq(row_), t_ = row_ - seq_first_row(s_); \
        E_ = F.EDGE() + (size_t)((B_ * 2 + which_) * 3) * FFN + co; Z_ = which_ && t_ == seq_len(s_) - 1; \
        O_ = which_ == 0 ? (t_ == 0 ? F.G15() + (size_t)s_ * FFN + co : F.EDGE() + (size_t)(((B_ - 1) * 2 + 1) * 3 + 1) * FFN + co) : (Z_ ? E_ : F.EDGE() + (size_t)(((B_ + 1) * 2 + 0) * 3 + 1) * FFN + co); } while (0)
#define P9_LOAD(E_, O_, I, S, U, X) do { I = *(const GAS bf16x8*)(E_); S = *(const GAS bf16x8*)((E_) + FFN); U = *(const GAS bf16x8*)((E_) + 2 * FFN); X = *(const GAS bf16x8*)(O_); } while (0)
    bf16x8 in_, se_, uu_, ou_, inN, seN, uuN, ouN;
    int bw = grp; const bf16* e; const bf16* o; bool z;
    P9_PTRS(bw, e, o, z); P9_LOAD(e, o, in_, se_, uu_, ou_);
    for (; bw < NBW; bw += NGRP) {
        const int nbw = bw + NGRP < NBW ? bw + NGRP : bw; const bf16* en; const bf16* on; bool zn;
        P9_PTRS(nbw, en, on, zn); P9_LOAD(en, on, inN, seN, uuN, ouN);
        const int which = bw & 1, lrow = (bw >> 1) * 64 + (which ? 63 : 0);
        float ov[8];
#pragma unroll
        for (int j = 0; j < 8; ++j) { const float inner = bf2f(in_[j]), self = bf2f(se_[j]), outer = z ? 0.f : bf2f(ou_[j]);
            const float x = which == 0 ? bb[j] + w0[j] * outer + w1[j] * self + w2[j] * inner : bb[j] + w0[j] * inner + w1[j] * self + w2[j] * outer;
            ov[j] = x * sigmoidf_(x) * bf2f(uu_[j]); }
        *(GAS v4u*)(F.ACT() + (size_t)lrow * FFN + co) = pack8(ov);
        in_ = inN; se_ = seN; uu_ = uuN; ou_ = ouN;
        z = zn;
    }
#undef P9_LOAD
#undef P9_PTRS
#undef LD8F
}
__device__ __forceinline__ void p11_rows(Frame& F, int gw, int NGW, float* obase) {
    const int lane = F.lane;
    f32x4 gg[8];
    { const float* a = FIN(F, 23  );
#pragma unroll
      for (int i = 0; i < 4; ++i) { const int e0 = (lane + 64 * i) * 8; gg[2 * i] = *(const GAS f32x4*)(a + e0); gg[2 * i + 1] = *(const GAS f32x4*)(a + e0 + 4); } }
    bf16x8 hv[4], fq[4], hn[4], fn[4];
#define P11_LOAD(R, H, Q) do { const GAS bf16x8* f_ = (const GAS bf16x8*)((const bf16*)(F.out + (size_t)(R) * DM)); \
        const GAS bf16x8* h_ = (const GAS bf16x8*)((R) < HROWS ? F.H1A() + (size_t)(R) * DM : F.XN() + (size_t)((R) - HROWS) * DM); \
        _Pragma("unroll") for (int i_ = 0; i_ < 4; ++i_) { H[i_] = h_[lane + 64 * i_]; Q[i_] = f_[lane + 64 * i_]; } } while (0)
    int row = gw;
    if (row < NTOK) P11_LOAD(row, hv, fq);
    for (; row < NTOK; row += NGW) {
        const int nrow = row + NGW < NTOK ? row + NGW : row;
        P11_LOAD(nrow, hn, fn);
        float fv[32]; float ss = 0.f;
#pragma unroll
        for (int i = 0; i < 4; ++i)
#pragma unroll
            for (int j = 0; j < 8; ++j) { fv[8 * i + j] = bf2f(fq[i][j]); ss += fv[8 * i + j] * fv[8 * i + j]; }
        const float r1 = 1.f / sqrtf(wave_sum(ss) * (1.f / DM) + EPS);
#pragma unroll
        for (int i = 0; i < 4; ++i) { const int e0 = (lane + 64 * i) * 8; const f32x4 g0 = gg[2 * i], g1 = gg[2 * i + 1];
            f32x4 h0, h1;
            h0.x = bf2f(hv[i][0]) + fv[8 * i + 0] * r1 * g0.x; h0.y = bf2f(hv[i][1]) + fv[8 * i + 1] * r1 * g0.y; h0.z = bf2f(hv[i][2]) + fv[8 * i + 2] * r1 * g0.z; h0.w = bf2f(hv[i][3]) + fv[8 * i + 3] * r1 * g0.w;
            h1.x = bf2f(hv[i][4]) + fv[8 * i + 4] * r1 * g1.x; h1.y = bf2f(hv[i][5]) + fv[8 * i + 5] * r1 * g1.y; h1.z = bf2f(hv[i][6]) + fv[8 * i + 6] * r1 * g1.z; h1.w = bf2f(hv[i][7]) + fv[8 * i + 7] * r1 * g1.w;
            GAS f32x4* wp = (GAS f32x4*)(obase + (size_t)row * DM + e0); wp[0] = h0; wp[1] = h1; }
#pragma unroll
        for (int i = 0; i < 4; ++i) { hv[i] = hn[i]; fq[i] = fn[i]; }
    }
#undef P11_LOAD
}
struct Args { const float* in[24]; float* out; unsigned char* ws; int ph_lo, ph_hi, q_lo, q_hi, use_bar, dummy; };
constexpr int N_PHASES = 12;
__global__ void __launch_bounds__(NWAVES * 64, 2) mk_fwd(Args args) {
    extern __shared__ __attribute__((aligned(16))) unsigned char lds[];
    Frame F;
    F.lds = (LAS unsigned char*)lds;
    F.MISC = (volatile LAS unsigned*)(F.lds + MISC_OFF);
    F.wave = __builtin_amdgcn_readfirstlane((int)threadIdx.x >> 6);
    F.tid = F.wave * 64 + lane_id_now(); F.lane = F.tid & 63;
    F.G = gridDim.x; { const int bx = blockIdx.x; F.vcu = (F.G % 8 == 0) ? (bx % 8) * (F.G / 8) + bx / 8 : bx; }
    unsigned char* ws = args.ws;
    F.ctl = (gu32*)(ws + WS_CTL);
    F.kargs = (const __attribute__((address_space(4))) void*)__builtin_amdgcn_kernarg_segment_ptr(); F.ptag = 0; F.out = args.out;
    F.ws = ws;
    for (int u = F.tid; u < (LDS_BYTES - LDSCTL_OFF) / 4; u += NWAVES * 64) ((LAS unsigned*)(F.lds + LDSCTL_OFF))[u] = 0u;
    __syncthreads();
    XcdBarrier bar; bar.bar = (unsigned*)(F.ctl + CW_BAR); bar.x = 0; bar.st = nullptr;
    if (args.use_bar) bar = xcd_barrier_post((unsigned*)(F.ctl + CW_BAR), F.MISC + 8, F.tid == 0);
    const int lo = args.ph_lo, hi = args.ph_hi;
    const int dmy_ = MK_MULTI ? args.dummy : 0;
#define IN(k) (((MK_PHASE_MASK >> (k)) & 1) && lo <= (k) && (k) < hi)
#define PH_BEGIN(k) do { F.ptag = (k); int t_ = F.wave * 64 + lane_id_now(); asm volatile("" : "+v"(t_)); F.tid = t_; F.lane = t_ & 63; } while (0)
#define PH_BAR() do { if (args.use_bar) xcd_barrier(bar, F.wave == 0 && lane_id_now() == 0); } while (0)
    const int gw = F.vcu * NWAVES + F.wave, NGW = F.G * NWAVES;

    if (IN(0)) { PH_BEGIN(0); { p0_prologue(F); PH_BAR(); } }
    if (IN(1)) { PH_BEGIN(1); {
        p1_meta_z(F);
        pg8::Gemm g{F.XN(), F.WIN_T(), NTOK, INW, DM}; pg8::ProbeOrder S; S.init(NTOK, INW, F.G, (int)blockIdx.x); S.pmask = dmy_ == 5 ? 7 : -1;
        pg8::EpiRoute E{nullptr, 0, 1, F.QG(), F.K(), F.V(), F.XR()};
        if (dmy_ != 7) pg8::gemm_phase<pg8::EpiRoute, pg8::ProbeOrder, true, true>(F.lds, g, S, E, F.wave);
        PH_BAR();
    } }
    if (IN(2)) { PH_BEGIN(2); { lru_phase<1>(F, nullptr); PH_BAR(); } }
    if (IN(3)) { PH_BEGIN(3); {
        constexpr int NPW = (12 * 2048 + 511) / 512;
        if (F.G >= 2 * NPW) {
            if (F.vcu < NPW) lru_propagate(F);
            else { const int gw2 = (F.vcu - NPW) * NWAVES + F.wave, NGW2 = (F.G - NPW) * NWAVES;
                k_rope_pass(F, dmy_ ? (bf16*)F.out : F.K(), gw2, NGW2);
                wt_items(F, WT_O_OUT, WT_O_UP, gw2, NGW2); wt_items(F, WT_O_DN, WT_O_G, gw2, NGW2); }
        } else {
            k_rope_pass(F, dmy_ ? (bf16*)F.out : F.K(), gw, NGW);
            lru_propagate(F);
            wt_items(F, WT_O_OUT, WT_O_UP, gw, NGW); wt_items(F, WT_O_DN, WT_O_G, gw, NGW);
        }
        if (F.vcu == F.G - 1) p3_meta_job(F);
        PH_BAR();
    } }
    if (IN(4)) { PH_BEGIN(4); {
        const int dm = dmy_;
        if (dm < 2 || dm == 2) lru_phase<2>(F, dm ? (bf16*)F.out : F.QG());
        if (dm < 2 || dm == 3) for (int it = F.vcu; it < 512; it += F.G) metaq_item(F, it);
        if (dm < 2 || dm == 4) attn_phase(F, (char*)lds, dm ? (bf16*)F.out : F.QG());
        if (dm == 8 && F.vcu < 128) attn_phase(F, (char*)lds, (bf16*)F.out);
        if (dm == 6 && (F.vcu & 1) == 0) attn_phase(F, (char*)lds, (bf16*)F.out);
        PH_BAR();
    } }
    if (IN(5)) { PH_BEGIN(5); {
        p5_ratio(F);
        if (F.G > 24) {
            if (F.vcu >= F.G - 12) p5_meta_job(F, F.G - 1 - F.vcu);
            else wt_items(F, WT_O_UP, WT_O_DN, F.vcu * NWAVES + F.wave, (F.G - 12) * NWAVES);
        } else {
            wt_items(F, WT_O_UP, WT_O_DN, gw, NGW);
            __syncthreads();
            if (F.vcu >= F.G - 12) p5_meta_job(F, F.G - 1 - F.vcu);
        }
        PH_BAR();
    } }
    if (IN(6)) { PH_BEGIN(6); {
        p6_meta_y(F);
        pg8::Gemm g{F.QG(), F.WOUT_T(), NTOK, DM, DM}; pg8::StaticOrder S; S.init(NTOK, DM, F.G, (int)blockIdx.x);
        pg8::EpiScaled E{(bf16*)F.out, 2 * DM, F.RATIO(), F.RL(), 16};
        pg8::gemm_phase<pg8::EpiScaled, pg8::StaticOrder, true, true>(F.lds, g, S, E, F.wave);
        PH_BAR();
    } }
#if MK_MULTI
    { const int q = args.q_lo;
#else
#pragma unroll
    for (int q = 0; q < 2; ++q) {
#endif
        if (IN(7)) { PH_BEGIN(7); {
            p7_rows(F, q, gw, NGW);
            if (q == 0) p7_meta_g(F);
            PH_BAR();
        } }
        if (IN(8)) { PH_BEGIN(8); {
            pg8::Gemm g{F.XN() + (size_t)q * HROWS * DM, F.WUP_T(), HROWS, UPW, DM}; pg8::StaticOrder S; S.init(HROWS, UPW, F.G, (int)blockIdx.x);
            pg8::EpiAct E{F.ACT(), F.EDGE(), FIN(F, 20  ), FIN(F, 21  ), FFN};
            pg8::gemm_phase<pg8::EpiAct, pg8::StaticOrder, true, true>(F.lds, g, S, E, F.wave);
            PH_BAR();
        } }
        if (IN(9)) { PH_BEGIN(9); { p9_fix(F, q); PH_BAR(); } }
        if (IN(10)) { PH_BEGIN(10); {
            pg8::Gemm g{F.ACT(), F.WDOWN_T(), HROWS, DM, FFN}; pg8::ProbeOrder S; S.init(HROWS, DM, F.G, (int)blockIdx.x); S.pmask = dmy_ == 5 ? 7 : -1;
            pg8::EpiRoute E{(bf16*)F.out + (size_t)q * HROWS * 2 * DM, 2 * DM, 0, nullptr, nullptr, nullptr, nullptr};
            pg8::gemm_phase<pg8::EpiRoute, pg8::ProbeOrder, true, true>(F.lds, g, S, E, F.wave);
        } }
    }
    if (IN(10) && IN(11)) PH_BAR();
    if (IN(11)) { PH_BEGIN(11); { p11_rows(F, gw, NGW, dmy_ ? (float*)(F.ws + WS_B) : F.out); } }
#undef IN
#undef PH_BAR
}

extern "C" void kernel_launch(void* const* d_in, const int* in_sizes, int n_in, void* d_out, int out_size, void* d_ws, size_t ws_size, hipStream_t stream) {
    static int grid = 0;
    if (grid == 0) {
        if (n_in != 24 || out_size != NTOK * DM || ws_size < WS_END) { fprintf(stderr, "kernel_launch: unexpected shapes (n_in %d out %d ws %zu, need ws >= %zu); nothing launched\n", n_in, out_size, ws_size, (size_t)WS_END); grid = -1; return; }
        int dev = 0, cus = 0;
        if (hipGetDevice(&dev) != hipSuccess || hipDeviceGetAttribute(&cus, hipDeviceAttributeMultiprocessorCount, dev) != hipSuccess) { grid = -1; return; }
        if (hipFuncSetAttribute((const void*)mk_fwd, hipFuncAttributeMaxDynamicSharedMemorySize, LDS_BYTES) != hipSuccess) { fprintf(stderr, "kernel_launch: hipFuncSetAttribute failed\n"); grid = -1; return; }
        int per_cu = 0;
        if (hipOccupancyMaxActiveBlocksPerMultiprocessor(&per_cu, (const void*)mk_fwd, NWAVES * 64, LDS_BYTES) != hipSuccess || per_cu < 1) fprintf(stderr, "kernel_launch: occupancy query reports %d\n", per_cu);
        (void)hipGetLastError();
        grid = cus;
    }
    if (grid < 0) return;
    if (hipMemsetAsync((char*)d_ws + WS_CTL, 0, CTL_ZERO_BYTES, stream) != hipSuccess) return;
    Args a{};
    for (int i = 0; i < 24; ++i) a.in[i] = (const float*)d_in[i];
    a.out = (float*)d_out; a.ws = (unsigned char*)d_ws;
#if MK_MULTI
    a.use_bar = 0;
#define LAUNCH_PH(ph, q) do { a.ph_lo = (ph); a.ph_hi = (ph) + 1; a.q_lo = (q); a.q_hi = (q) + 1; \
        if ((MK_REPEAT_MASK >> (ph)) & 1) { a.dummy = MK_DUMMY_MODE; hipLaunchKernelGGL(mk_fwd, dim3(grid), dim3(NWAVES * 64), LDS_BYTES, stream, a); } \
        a.dummy = 0; hipLaunchKernelGGL(mk_fwd, dim3(grid), dim3(NWAVES * 64), LDS_BYTES, stream, a); } while (0)
    for (int ph = 0; ph < 7; ++ph) LAUNCH_PH(ph, 0);
    for (int q = 0; q < 2; ++q) for (int ph = 7; ph < 11; ++ph) LAUNCH_PH(ph, q);
    LAUNCH_PH(11, 0);
#else
    a.use_bar = 1; a.ph_lo = 0; a.ph_hi = N_PHASES; a.q_lo = 0; a.q_hi = 2;
    hipLaunchKernelGGL(mk_fwd, dim3(grid), dim3(NWAVES * 64), LDS_BYTES, stream, a);
#endif
    const hipError_t le = hipPeekAtLastError();
    if (le != hipSuccess) fprintf(stderr, "kernel_launch: launch failed: %s\n", hipGetErrorName(le));
}
```

```cpp
#include <hip/hip_runtime.h>
#include <cstdio>
#include <cstdint>
#include <cmath>
#ifndef MK_PHASE_MASK
#define MK_PHASE_MASK 0xfff
#endif
#ifndef MK_REPEAT_MASK
#define MK_REPEAT_MASK 0
#endif
#ifndef MK_DUMMY_MODE
#define MK_DUMMY_MODE 1
#endif
#ifndef MK_MULTI
#define MK_MULTI 0
#endif
__device__ __forceinline__ int lane_id_now() { int l; asm volatile("v_mbcnt_lo_u32_b32 %0, -1, 0\n\tv_mbcnt_hi_u32_b32 %0, -1, %0" : "=v"(l)); return l; }
namespace pg8 {
#define PG8_LAS __attribute__((address_space(3)))
typedef unsigned short bf16_t;
typedef short bf16x8 __attribute__((ext_vector_type(8)));
typedef float f32x4 __attribute__((ext_vector_type(4)));
typedef unsigned u32x4 __attribute__((ext_vector_type(4)));
constexpr int BM = 256, BK = 64, HALF = 128, HTB = HALF * BK * 2  , STAGE_BYTES = 8 * HTB, NXCD = 8, WGM = 8;

__host__ __device__ __forceinline__ int lds_byte(int r, int c) { const int st = (r >> 4) * 2 + (c >> 5), rr = r & 15, cc = c & 31, ob = rr * 64 + cc * 2; return st * 1024 + (ob ^ (((ob >> 9) & 1) << 5)); }
__host__ __device__ __forceinline__ void stage_rc(int b, int& R, int& C) { const int st = b / 1024, sb = b % 1024, swz = sb ^ (((sb >> 9) & 1) << 5); R = (st >> 1) * 16 + swz / 64; C = (st & 1) * 32 + (swz % 64) / 2; }
__host__ __device__ __forceinline__ int perm32(int rho) { const int n = rho >> 4, i = rho & 15; return 8 * (i >> 2) + 4 * n + (i & 3); }

struct Unit { int pm, pn; };
struct Gemm { const bf16_t* A; const bf16_t* Bt; int M, N, K; };

struct StaticOrder {
    int nM, nN, nwg, G, c;
    __host__ __device__ void init(int M, int N, int G_, int c_) { nM = M / BM; nN = N / BM; nwg = nM * nN; G = G_; c = c_; }
    __host__ __device__ bool next(int i, Unit& u) const {
        const long L = (long)i * G + c; if (L >= nwg) return false;
        int wgid = (int)L; { const int q = nwg / NXCD, r = nwg % NXCD, xcd = wgid % NXCD, off = wgid / NXCD; wgid = (xcd < r ? xcd * (q + 1) : r * (q + 1) + (xcd - r) * q) + off; }
        const int nig = WGM * nN, gid = wgid / nig, fm = gid * WGM, gsz = (nM - fm) < WGM ? (nM - fm) : WGM;
        u.pm = fm + ((wgid % nig) % gsz); u.pn = (wgid % nig) / gsz; return true;
    }
    __device__ __forceinline__ void a_ready(const Unit&) const {}
    __device__ __forceinline__ void done(const Unit&) const {}
};

__device__ __forceinline__ unsigned cvt_pk_bf16(float lo, float hi) { unsigned r; asm volatile("v_cvt_pk_bf16_f32 %0, %1, %2" : "=v"(r) : "v"(lo), "v"(hi)); return r; }
struct EpiRoute {
    static constexpr bool PERM = true, AFTER_DRAIN = false, MIDK = false;
    bf16_t* O; int ldc; int mode; bf16_t *QGp, *Kp, *Vp, *XRp;
    __device__ __forceinline__ void operator()(const f32x4 (&acc)[2][2][4][2], const Unit& u, int wr, int wc, int fr, int fq) const {
        bf16_t* base = O; int ld = ldc; int colt = u.pn * BM; int rowadd = 0;
        if (mode == 1) {
            const int pn = u.pn;
            if (pn < 4) { base = QGp; ld = 2048; colt = pn * 256; }
            else if (pn == 4) { base = Kp; ld = 256; colt = 0; }
            else if (pn == 5) { base = Vp; ld = 256; colt = 0; }
            else if (pn < 10) { base = XRp; ld = 1024; colt = (pn - 6) * 256; const int seq = u.pm < 128 ? (u.pm >> 4) : 8 + ((u.pm - 128) >> 5); rowadd = 64 * (seq + 1); }
            else { base = QGp; ld = 2048; colt = 1024 + (pn - 10) * 256; }
        }
        const int row0 = u.pm * BM + wr * 64 + fr + rowadd; const int col0 = colt + wc * 32 + 8 * fq;
#pragma unroll
        for (int ai = 0; ai < 2; ++ai)
#pragma unroll
            for (int m = 0; m < 4; ++m) { bf16_t* rowp = base + (size_t)(row0 + ai * HALF + m * 16) * ld + col0;
#pragma unroll
                for (int bj = 0; bj < 2; ++bj) { const f32x4 v0 = acc[ai][bj][m][0], v1 = acc[ai][bj][m][1];
                    u32x4 w; w.x = cvt_pk_bf16(v0[0], v0[1]); w.y = cvt_pk_bf16(v0[2], v0[3]); w.z = cvt_pk_bf16(v1[0], v1[1]); w.w = cvt_pk_bf16(v1[2], v1[3]);
                    *(u32x4*)(rowp + bj * HALF) = w; } }
    }
};

__device__ __forceinline__ float dpp_shr1(float old, float src) { return __builtin_bit_cast(float, __builtin_amdgcn_update_dpp(__builtin_bit_cast(int, old), __builtin_bit_cast(int, src), 0x111, 0xF, 0xF, false)); }
__device__ __forceinline__ float dpp_shl1(float old, float src) { return __builtin_bit_cast(float, __builtin_amdgcn_update_dpp(__builtin_bit_cast(int, old), __builtin_bit_cast(int, src), 0x101, 0xF, 0xF, false)); }
__device__ __forceinline__ float dpp_ror1(float src)  { return __builtin_bit_cast(float, __builtin_amdgcn_mov_dpp(__builtin_bit_cast(int, src), 0x121, 0xF, 0xF, false)); }
__device__ __forceinline__ float dpp_ror15(float src) { return __builtin_bit_cast(float, __builtin_amdgcn_mov_dpp(__builtin_bit_cast(int, src), 0x12F, 0xF, 0xF, false)); }
struct EpiAct {
    static constexpr bool PERM = true, AFTER_DRAIN = false, MIDK = false;
    bf16_t* ACT; bf16_t* EDGE; const float* cw; const float* cb; int nch;
    __device__ __forceinline__ void operator()(const f32x4 (&acc)[2][2][4][2], const Unit& u, int wr, int wc, int fr, int fq) const {
        const int ch0 = u.pn * 128 + wc * 32 + 8 * fq;
        typedef float f32x2 __attribute__((ext_vector_type(2)));
        f32x2 W0[4], W1[4], W2[4], BB[4];
        { const f32x4 a0 = *(const f32x4*)(cw + ch0), a1 = *(const f32x4*)(cw + ch0 + 4), b0 = *(const f32x4*)(cw + nch + ch0), b1 = *(const f32x4*)(cw + nch + ch0 + 4),
                      c0 = *(const f32x4*)(cw + 2 * nch + ch0), c1 = *(const f32x4*)(cw + 2 * nch + ch0 + 4), d0 = *(const f32x4*)(cb + ch0), d1 = *(const f32x4*)(cb + ch0 + 4);
          W0[0] = (f32x2){a0[0], a0[1]}; W0[1] = (f32x2){a0[2], a0[3]}; W0[2] = (f32x2){a1[0], a1[1]}; W0[3] = (f32x2){a1[2], a1[3]};
          W1[0] = (f32x2){b0[0], b0[1]}; W1[1] = (f32x2){b0[2], b0[3]}; W1[2] = (f32x2){b1[0], b1[1]}; W1[3] = (f32x2){b1[2], b1[3]};
          W2[0] = (f32x2){c0[0], c0[1]}; W2[1] = (f32x2){c0[2], c0[3]}; W2[2] = (f32x2){c1[0], c1[1]}; W2[3] = (f32x2){c1[2], c1[3]};
          BB[0] = (f32x2){d0[0], d0[1]}; BB[1] = (f32x2){d0[2], d0[3]}; BB[2] = (f32x2){d1[0], d1[1]}; BB[3] = (f32x2){d1[2], d1[3]}; }
        const int rowb = u.pm * BM + wr * 64;
#pragma unroll
        for (int ai = 0; ai < 2; ++ai) {
            float ein0[8], ein1[8];
#pragma unroll
            for (int m = 0; m < 4; ++m) {
                unsigned ow[4];
#pragma unroll
                for (int n = 0; n < 2; ++n)
#pragma unroll
                    for (int kp = 0; kp < 4; kp += 2) {
                        const int jp = 2 * n + (kp >> 1);
                        const f32x2 cur = {acc[ai][0][m][n][kp], acc[ai][0][m][n][kp + 1]};
                        float pa = 0.f, pb = 0.f, na = 0.f, nb = 0.f;
                        if (m > 0) { pa = dpp_ror1(acc[ai][0][m > 0 ? m - 1 : 0][n][kp]); pb = dpp_ror1(acc[ai][0][m > 0 ? m - 1 : 0][n][kp + 1]); }
                        if (m < 3) { na = dpp_ror15(acc[ai][0][m < 3 ? m + 1 : 3][n][kp]); nb = dpp_ror15(acc[ai][0][m < 3 ? m + 1 : 3][n][kp + 1]); }
                        const f32x2 prv = {dpp_shr1(pa, cur.x), dpp_shr1(pb, cur.y)}, nxt = {dpp_shl1(na, cur.x), dpp_shl1(nb, cur.y)};
                        f32x2 x = W0[jp] * prv + BB[jp]; x = W1[jp] * cur + x; x = W2[jp] * nxt + x;
                        const f32x2 t = x * (f32x2){-1.4426950408889634f, -1.4426950408889634f};
                        const f32x2 dn = (f32x2){__builtin_amdgcn_exp2f(t.x), __builtin_amdgcn_exp2f(t.y)} + (f32x2){1.f, 1.f};
                        const f32x2 rc = {__builtin_amdgcn_rcpf(dn.x), __builtin_amdgcn_rcpf(dn.y)};
                        const f32x2 o2 = (x * rc) * (f32x2){acc[ai][1][m][n][kp], acc[ai][1][m][n][kp + 1]};
                        ow[jp] = cvt_pk_bf16(o2.x, o2.y);
                        if (m == 0) { ein0[2 * jp] = nxt.x; ein0[2 * jp + 1] = nxt.y; }
                        if (m == 3) { ein1[2 * jp] = prv.x; ein1[2 * jp + 1] = prv.y; }
                    }
                u32x4 w; w.x = ow[0]; w.y = ow[1]; w.z = ow[2]; w.w = ow[3];
                *(u32x4*)(ACT + (size_t)(rowb + ai * HALF + m * 16 + fr) * nch + ch0) = w;
            }
            const int blk = (rowb + ai * HALF) >> 6;
            if (fr == 0 || fr == 15) {
                const bool last = fr == 15; bf16_t* e = EDGE + (size_t)((blk * 2 + (last ? 1 : 0)) * 3) * nch + ch0;
                float iv[8], sv[8], uv[8];
#pragma unroll
                for (int k = 0; k < 4; ++k) { iv[k] = last ? ein1[k] : ein0[k]; iv[4 + k] = last ? ein1[4 + k] : ein0[4 + k];
                    sv[k] = last ? acc[ai][0][3][0][k] : acc[ai][0][0][0][k]; sv[4 + k] = last ? acc[ai][0][3][1][k] : acc[ai][0][0][1][k];
                    uv[k] = last ? acc[ai][1][3][0][k] : acc[ai][1][0][0][k]; uv[4 + k] = last ? acc[ai][1][3][1][k] : acc[ai][1][0][1][k]; }
                u32x4 a, b, c;
                a.x = cvt_pk_bf16(iv[0], iv[1]); a.y = cvt_pk_bf16(iv[2], iv[3]); a.z = cvt_pk_bf16(iv[4], iv[5]); a.w = cvt_pk_bf16(iv[6], iv[7]);
                b.x = cvt_pk_bf16(sv[0], sv[1]); b.y = cvt_pk_bf16(sv[2], sv[3]); b.z = cvt_pk_bf16(sv[4], sv[5]); b.w = cvt_pk_bf16(sv[6], sv[7]);
                c.x = cvt_pk_bf16(uv[0], uv[1]); c.y = cvt_pk_bf16(uv[2], uv[3]); c.z = cvt_pk_bf16(uv[4], uv[5]); c.w = cvt_pk_bf16(uv[6], uv[7]);
                *(u32x4*)(e) = a; *(u32x4*)(e + nch) = b; *(u32x4*)(e + 2 * nch) = c;
            }
        }
    }
};

struct ProbeOrder : StaticOrder { int pmask;
    __host__ __device__ bool next(int i, Unit& u) const { const bool r = StaticOrder::next(i, u); u.pm &= pmask; return r; } };

struct EpiScaled {
    static constexpr bool PERM = true, AFTER_DRAIN = false, MIDK = true;
    bf16_t* O; int ldc; const float* ratio; const float* rl; int kt;
    __device__ __forceinline__ void midk(f32x4 (&acc)[2][2][4][2], const Unit& u, int wr, int fr) const {
        asm volatile("" ::: "memory");
        const float* rp = ratio + (u.pm * BM + wr * 64 + fr);
        float s[2][4];
#pragma unroll
        for (int ai = 0; ai < 2; ++ai)
#pragma unroll
            for (int m = 0; m < 4; ++m) s[ai][m] = rp[ai * HALF + m * 16];
#pragma unroll
        for (int ai = 0; ai < 2; ++ai)
#pragma unroll
            for (int m = 0; m < 4; ++m)
#pragma unroll
                for (int bj = 0; bj < 2; ++bj)
#pragma unroll
                    for (int n = 0; n < 2; ++n) acc[ai][bj][m][n] = acc[ai][bj][m][n] * s[ai][m];
        asm volatile("" ::: "memory");
    }
    __device__ __forceinline__ void operator()(const f32x4 (&acc)[2][2][4][2], const Unit& u, int wr, int wc, int fr, int fq) const {
        const int row0 = u.pm * BM + wr * 64 + fr, col0 = u.pn * BM + wc * 32 + 8 * fq;
#pragma unroll
        for (int ai = 0; ai < 2; ++ai)
#pragma unroll
            for (int m = 0; m < 4; ++m) { const int row = row0 + ai * HALF + m * 16; const float s = rl[row]; bf16_t* rowp = O + (size_t)row * ldc + col0;
#pragma unroll
                for (int bj = 0; bj < 2; ++bj) { const f32x4 v0 = acc[ai][bj][m][0] * s, v1 = acc[ai][bj][m][1] * s;
                    u32x4 w; w.x = cvt_pk_bf16(v0[0], v0[1]); w.y = cvt_pk_bf16(v0[2], v0[3]); w.z = cvt_pk_bf16(v1[0], v1[1]); w.w = cvt_pk_bf16(v1[2], v1[3]);
                    *(u32x4*)(rowp + bj * HALF) = w; } }
    }
};

template <class Epi, class Sched, bool ALIGN_EPI = false, bool SP2 = false>
__device__ __forceinline__ void gemm_phase(PG8_LAS unsigned char* lds, const Gemm g, const Sched& S, const Epi& E, int wave_id) {
    int tid_ = wave_id * 64 + lane_id_now(); asm volatile("" : "+v"(tid_));
    const int tid = tid_, wid = __builtin_amdgcn_readfirstlane(tid >> 6), lane = tid & 63, wr = wid >> 2, wc = wid & 3, fr = lane & 15, fq = lane >> 4;
    const int K = g.K, nt = K / BK;
    unsigned voffA[2], voffB[2];
#pragma unroll
    for (int i = 0; i < 2; ++i) { int R, C; stage_rc(tid * 16 + i * 8192, R, C); const int Rb = Epi::PERM ? ((R & ~31) + perm32(R & 31)) : R;
        voffA[i] = (unsigned)(R * K + C) * 2u; voffB[i] = (unsigned)(Rb * K + C) * 2u; }
    const size_t kstep = (size_t)(BK * 2);
    const size_t hstep = (size_t)HALF * K * 2;
    const size_t tstep = 2 * hstep;
    const unsigned ldsw = (unsigned)wid * 1024u;
    const int aoff = lds_byte(wr * 64 + fr, fq * 8), boff = lds_byte(wc * 32 + fr, fq * 8);
#define PG8_SA(b, h) (((b) * 2 + (h)) * HTB)
#define PG8_SB(b, h) ((4 + (b) * 2 + (h)) * HTB)
#define PG8_STAGE(bufoff, gbase, voff) do { _Pragma("unroll") for (int _i = 0; _i < 2; ++_i) \
        __builtin_amdgcn_global_load_lds((const unsigned*)((const char*)(gbase) + (voff)[_i]), (PG8_LAS unsigned*)(lds + (bufoff) + ldsw + _i * 8192), 16, 0, 0); } while (0)
#define PG8_LDA(dst, b, h) do { _Pragma("unroll") for (int m = 0; m < 4; ++m) _Pragma("unroll") for (int k = 0; k < 2; ++k) dst[m][k] = *(const PG8_LAS bf16x8*)(lds + PG8_SA(b, h) + aoff + m * 2048 + k * 1024); } while (0)
#define PG8_LDB(dst, b, h) do { _Pragma("unroll") for (int n = 0; n < 2; ++n) _Pragma("unroll") for (int k = 0; k < 2; ++k) dst[n][k] = *(const PG8_LAS bf16x8*)(lds + PG8_SB(b, h) + boff + n * 2048 + k * 1024); } while (0)
#define PG8_MMA(ai, bj, At, Bt) do { __builtin_amdgcn_s_setprio(1); _Pragma("unroll") for (int m = 0; m < 4; ++m) _Pragma("unroll") for (int n = 0; n < 2; ++n) _Pragma("unroll") for (int k = 0; k < 2; ++k) \
        acc[ai][bj][m][n] = __builtin_amdgcn_mfma_f32_16x16x32_bf16(Bt[n][k], At[m][k], acc[ai][bj][m][n], 0, 0, 0); __builtin_amdgcn_s_setprio(0); } while (0)
#define PG8_WAIT_V(n) asm volatile("s_waitcnt vmcnt(" #n ")" ::: "memory")
#define PG8_WAIT_L(n) asm volatile("s_waitcnt lgkmcnt(" #n ")" ::: "memory")
#define PG8_BAR __builtin_amdgcn_s_barrier()
#define PG8_SCHED __builtin_amdgcn_sched_barrier(0)
    Unit cur, nxt; int ui = 0;
    if (!S.next(0, cur)) return;
    f32x4 acc[2][2][4][2];
#pragma unroll
    for (int a = 0; a < 2; ++a)
#pragma unroll
        for (int b = 0; b < 2; ++b)
#pragma unroll
            for (int m = 0; m < 4; ++m)
#pragma unroll
                for (int n = 0; n < 2; ++n) acc[a][b][m][n] = (f32x4){0.f, 0.f, 0.f, 0.f};
    bf16x8 At[4][2], B0[2][2], B1[2][2];
    const char* cA = (const char*)g.A + (size_t)cur.pm * tstep; const char* cB = (const char*)g.Bt + (size_t)cur.pn * tstep;
    S.a_ready(cur);
    if constexpr (SP2) {
        PG8_STAGE(PG8_SB(0, 0), cB, voffB); PG8_STAGE(PG8_SB(0, 1), cB + hstep, voffB); PG8_STAGE(PG8_SA(0, 0), cA, voffA); PG8_STAGE(PG8_SA(0, 1), cA + hstep, voffA);
        if (wr == 1) PG8_BAR;
        PG8_WAIT_V(2); PG8_BAR;
        PG8_STAGE(PG8_SB(1, 0), cB + kstep, voffB); PG8_STAGE(PG8_SA(1, 0), cA + kstep, voffA); PG8_STAGE(PG8_SB(1, 1), cB + hstep + kstep, voffB);
        PG8_WAIT_V(6); PG8_BAR;
    } else {
        PG8_STAGE(PG8_SB(0, 0), cB, voffB); PG8_STAGE(PG8_SA(0, 0), cA, voffA); PG8_STAGE(PG8_SB(0, 1), cB + hstep, voffB); PG8_STAGE(PG8_SA(0, 1), cA + hstep, voffA);
        if (wr == 1) PG8_BAR;
        PG8_WAIT_V(4); PG8_BAR;
        PG8_STAGE(PG8_SB(1, 0), cB + kstep, voffB); PG8_STAGE(PG8_SA(1, 0), cA + kstep, voffA); PG8_STAGE(PG8_SB(1, 1), cB + hstep + kstep, voffB);
        PG8_WAIT_V(6); PG8_BAR;
    }
    for (;;) {
        const bool has_next = S.next(ui + 1, nxt);
        const char* nA = has_next ? (const char*)g.A + (size_t)nxt.pm * tstep : cA; const char* nB = has_next ? (const char*)g.Bt + (size_t)nxt.pn * tstep : cB;
        for (int t = 0; t < nt; t += 2) {
            if constexpr (Epi::MIDK) { if (t == E.kt) E.midk(acc, cur, wr, fr); }
            const bool last = (t == nt - 2);
            const char* a1 = cA + (size_t)(t + 1) * kstep;
            const char* a2 = last ? nA : cA + (size_t)(t + 2) * kstep; const char* b2 = last ? nB : cB + (size_t)(t + 2) * kstep;
            const char* a3 = a2 + kstep; const char* b3 = b2 + kstep;
            if (last && has_next) S.a_ready(nxt);
            if constexpr (SP2) {
            PG8_LDB(B0, 0, 0); PG8_LDB(B1, 0, 1); PG8_SCHED; PG8_LDA(At, 0, 0); PG8_STAGE(PG8_SA(1, 1), a1 + hstep, voffA);
            PG8_WAIT_V(8); PG8_WAIT_L(0); PG8_BAR; PG8_MMA(0, 0, At, B0); PG8_MMA(0, 1, At, B1); PG8_BAR; PG8_SCHED;
            PG8_LDA(At, 0, 1); PG8_STAGE(PG8_SB(0, 0), b2, voffB); PG8_STAGE(PG8_SB(0, 1), b2 + hstep, voffB); PG8_STAGE(PG8_SA(0, 0), a2, voffA);
            PG8_WAIT_V(8); PG8_WAIT_L(0); PG8_BAR; PG8_MMA(1, 0, At, B0); PG8_MMA(1, 1, At, B1); PG8_BAR; PG8_SCHED;
            PG8_LDB(B0, 1, 0); PG8_LDB(B1, 1, 1); PG8_SCHED; PG8_LDA(At, 1, 0); PG8_STAGE(PG8_SA(0, 1), a2 + hstep, voffA);
            PG8_WAIT_V(8); PG8_WAIT_L(0); PG8_BAR; PG8_MMA(0, 0, At, B0); PG8_MMA(0, 1, At, B1); PG8_BAR; PG8_SCHED;
            PG8_LDA(At, 1, 1); PG8_STAGE(PG8_SB(1, 0), b3, voffB); PG8_STAGE(PG8_SB(1, 1), b3 + hstep, voffB); PG8_STAGE(PG8_SA(1, 0), a3, voffA);
            PG8_WAIT_V(8); PG8_WAIT_L(0); PG8_BAR; PG8_MMA(1, 0, At, B0); PG8_MMA(1, 1, At, B1); PG8_BAR; PG8_SCHED;
            } else {
            PG8_LDB(B0, 0, 0); PG8_SCHED; PG8_LDA(At, 0, 0); PG8_STAGE(PG8_SA(1, 1), a1 + hstep, voffA);
            PG8_WAIT_L(8); PG8_BAR; PG8_WAIT_L(0); PG8_MMA(0, 0, At, B0); PG8_BAR; PG8_SCHED;
            PG8_LDB(B1, 0, 1); PG8_STAGE(PG8_SB(0, 0), b2, voffB);
            PG8_BAR; PG8_WAIT_L(0); PG8_MMA(0, 1, At, B1); PG8_BAR;
            PG8_LDA(At, 0, 1); PG8_STAGE(PG8_SA(0, 0), a2, voffA);
            PG8_BAR; PG8_WAIT_L(0); PG8_MMA(1, 0, At, B0); PG8_BAR; PG8_SCHED;
            PG8_STAGE(PG8_SB(0, 1), b2 + hstep, voffB);
            PG8_WAIT_V(6); PG8_BAR; PG8_MMA(1, 1, At, B1); PG8_BAR;
            PG8_LDB(B0, 1, 0); PG8_SCHED; PG8_LDA(At, 1, 0); PG8_STAGE(PG8_SA(0, 1), a2 + hstep, voffA);
            PG8_WAIT_L(8); PG8_BAR; PG8_WAIT_L(0); PG8_MMA(0, 0, At, B0); PG8_BAR; PG8_SCHED;
            PG8_LDB(B1, 1, 1); PG8_STAGE(PG8_SB(1, 0), b3, voffB);
            PG8_BAR; PG8_WAIT_L(0); PG8_MMA(0, 1, At, B1); PG8_BAR;
            PG8_LDA(At, 1, 1); PG8_STAGE(PG8_SA(1, 0), a3, voffA);
            PG8_BAR; PG8_WAIT_L(0); PG8_MMA(1, 0, At, B0); PG8_BAR; PG8_SCHED;
            PG8_STAGE(PG8_SB(1, 1), b3 + hstep, voffB);
            PG8_WAIT_V(6); PG8_BAR; PG8_MMA(1, 1, At, B1); PG8_BAR;
            }
        }
        if constexpr (ALIGN_EPI) { if (wr == 0) PG8_BAR; }
        if constexpr (!Epi::AFTER_DRAIN) { E(acc, cur, wr, wc, fr, fq); S.done(cur); }
        if (!has_next) break;
#pragma unroll
        for (int a = 0; a < 2; ++a)
#pragma unroll
            for (int b = 0; b < 2; ++b)
#pragma unroll
                for (int m = 0; m < 4; ++m)
#pragma unroll
                    for (int n = 0; n < 2; ++n) acc[a][b][m][n] = (f32x4){0.f, 0.f, 0.f, 0.f};
        cur = nxt; cA = nA; cB = nB; ++ui;
        if constexpr (ALIGN_EPI) { if (wr == 1) PG8_BAR; }
    }
    PG8_WAIT_V(0);
    if constexpr (!ALIGN_EPI) { if (wr == 0) PG8_BAR; }
    PG8_BAR;
    if constexpr (Epi::AFTER_DRAIN) { E.fused(acc, cur, wr, wc, fr, fq, lds, wid, lane); S.done(cur); }
#undef PG8_SA
#undef PG8_SB
#undef PG8_STAGE
#undef PG8_LDA
#undef PG8_LDB
#undef PG8_MMA
#undef PG8_WAIT_V
#undef PG8_WAIT_L
#undef PG8_BAR
#undef PG8_SCHED
}
}
namespace attn {
typedef unsigned short bf16r;
using bf16x8 = __attribute__((ext_vector_type(8))) short;
using s16x4  = __attribute__((ext_vector_type(4))) short;
using f32x4  = __attribute__((ext_vector_type(4))) float;
using u32x4  = __attribute__((ext_vector_type(4))) unsigned;
constexpr int   QBLK = 32, KVBLK = 64;
constexpr float SCALE = 0.088388347648318440f;
constexpr float THRL = 8.f;
constexpr int LDQ = 2048, LDK = 256, LDO = 2048;
constexpr size_t SHM_ATTN = 6 * 16384 + 8 * 64 * 4;
#define SBAR() __builtin_amdgcn_sched_barrier(0)
__device__ __forceinline__ unsigned cvtpk(float lo, float hi) { unsigned r; asm volatile("v_cvt_pk_bf16_f32 %0, %1, %2" : "=v"(r) : "v"(lo), "v"(hi)); return r; }
__device__ __forceinline__ unsigned short f2bf_rne(float f) { unsigned u = __builtin_bit_cast(unsigned, f); return (unsigned short)((u + 0x7fffu + ((u >> 16) & 1u)) >> 16); }
__device__ __forceinline__ float bfl(short b) { return __builtin_bit_cast(float, (unsigned)(unsigned short)b << 16); }
template <int OFF> __device__ __forceinline__ s16x4 tr_read(int vb) { s16x4 r; asm volatile("ds_read_b64_tr_b16 %0, %1 offset:%2" : "=&v"(r) : "v"(vb), "i"(OFF) : "memory"); return r; }

__device__ __forceinline__ void qkt16(f32x4 (&S)[4][2], const char* Ks, int kb0, const bf16x8 (&qf)[2][4], float nm0, float nm1) {
  const f32x4 n0 = {nm0, nm0, nm0, nm0}, n1 = {nm1, nm1, nm1, nm1};
  bf16x8 kf[16];
  kf[0] = *reinterpret_cast<const bf16x8*>(Ks + 0*4096 + (kb0 ^ 0));
  kf[1] = *reinterpret_cast<const bf16x8*>(Ks + 0*4096 + (kb0 ^ 64));
  kf[2] = *reinterpret_cast<const bf16x8*>(Ks + 0*4096 + (kb0 ^ 128));
  kf[3] = *reinterpret_cast<const bf16x8*>(Ks + 0*4096 + (kb0 ^ 192));
  SBAR();
  kf[4] = *reinterpret_cast<const bf16x8*>(Ks + 1*4096 + (kb0 ^ 0));
  S[0][0] = __builtin_amdgcn_mfma_f32_16x16x32_bf16(kf[0], qf[0][0], n0, 0, 0, 0); S[0][1] = __builtin_amdgcn_mfma_f32_16x16x32_bf16(kf[0], qf[1][0], n1, 0, 0, 0);
  SBAR();
  kf[5] = *reinterpret_cast<const bf16x8*>(Ks + 1*4096 + (kb0 ^ 64));
  S[0][0] = __builtin_amdgcn_mfma_f32_16x16x32_bf16(kf[1], qf[0][1], S[0][0], 0, 0, 0); S[0][1] = __builtin_amdgcn_mfma_f32_16x16x32_bf16(kf[1], qf[1][1], S[0][1], 0, 0, 0);
  SBAR();
  kf[6] = *reinterpret_cast<const bf16x8*>(Ks + 1*4096 + (kb0 ^ 128));
  S[0][0] = __builtin_amdgcn_mfma_f32_16x16x32_bf16(kf[2], qf[0][2], S[0][0], 0, 0, 0); S[0][1] = __builtin_amdgcn_mfma_f32_16x16x32_bf16(kf[2], qf[1][2], S[0][1], 0, 0, 0);
  SBAR();
  kf[7] = *reinterpret_cast<const bf16x8*>(Ks + 1*4096 + (kb0 ^ 192));
  S[0][0] = __builtin_amdgcn_mfma_f32_16x16x32_bf16(kf[3], qf[0][3], S[0][0], 0, 0, 0); S[0][1] = __builtin_amdgcn_mfma_f32_16x16x32_bf16(kf[3], qf[1][3], S[0][1], 0, 0, 0);
  SBAR();
  kf[8] = *reinterpret_cast<const bf16x8*>(Ks + 2*4096 + (kb0 ^ 0));
  S[1][0] = __builtin_amdgcn_mfma_f32_16x16x32_bf16(kf[4], qf[0][0], n0, 0, 0, 0); S[1][1] = __builtin_amdgcn_mfma_f32_16x16x32_bf16(kf[4], qf[1][0], n1, 0, 0, 0);
  SBAR();
  kf[9] = *reinterpret_cast<const bf16x8*>(Ks + 2*4096 + (kb0 ^ 64));
  S[1][0] = __builtin_amdgcn_mfma_f32_16x16x32_bf16(kf[5], qf[0][1], S[1][0], 0, 0, 0); S[1][1] = __builtin_amdgcn_mfma_f32_16x16x32_bf16(kf[5], qf[1][1], S[1][1], 0, 0, 0);
  SBAR();
  kf[10] = *reinterpret_cast<const bf16x8*>(Ks + 2*4096 + (kb0 ^ 128));
  S[1][0] = __builtin_amdgcn_mfma_f32_16x16x32_bf16(kf[6], qf[0][2], S[1][0], 0, 0, 0); S[1][1] = __builtin_amdgcn_mfma_f32_16x16x32_bf16(kf[6], qf[1][2], S[1][1], 0, 0, 0);
  SBAR();
  kf[11] = *reinterpret_cast<const bf16x8*>(Ks + 2*4096 + (kb0 ^ 192));
  S[1][0] = __builtin_amdgcn_mfma_f32_16x16x32_bf16(kf[7], qf[0][3], S[1][0], 0, 0, 0); S[1][1] = __builtin_amdgcn_mfma_f32_16x16x32_bf16(kf[7], qf[1][3], S[1][1], 0, 0, 0);
  SBAR();
  kf[12] = *reinterpret_cast<const bf16x8*>(Ks + 3*4096 + (kb0 ^ 0));
  S[2][0] = __builtin_amdgcn_mfma_f32_16x16x32_bf16(kf[8], qf[0][0], n0, 0, 0, 0); S[2][1] = __builtin_amdgcn_mfma_f32_16x16x32_bf16(kf[8], qf[1][0], n1, 0, 0, 0);
  SBAR();
  kf[13] = *reinterpret_cast<const bf16x8*>(Ks + 3*4096 + (kb0 ^ 64));
  S[2][0] = __builtin_amdgcn_mfma_f32_16x16x32_bf16(kf[9], qf[0][1], S[2][0], 0, 0, 0); S[2][1] = __builtin_amdgcn_mfma_f32_16x16x32_bf16(kf[9], qf[1][1], S[2][1], 0, 0, 0);
  SBAR();
  kf[14] = *reinterpret_cast<const bf16x8*>(Ks + 3*4096 + (kb0 ^ 128));
  S[2][0] = __builtin_amdgcn_mfma_f32_16x16x32_bf16(kf[10], qf[0][2], S[2][0], 0, 0, 0); S[2][1] = __builtin_amdgcn_mfma_f32_16x16x32_bf16(kf[10], qf[1][2], S[2][1], 0, 0, 0);
  SBAR();
  kf[15] = *reinterpret_cast<const bf16x8*>(Ks + 3*4096 + (kb0 ^ 192));
  S[2][0] = __builtin_amdgcn_mfma_f32_16x16x32_bf16(kf[11], qf[0][3], S[2][0], 0, 0, 0); S[2][1] = __builtin_amdgcn_mfma_f32_16x16x32_bf16(kf[11], qf[1][3], S[2][1], 0, 0, 0);
  SBAR();
  S[3][0] = __builtin_amdgcn_mfma_f32_16x16x32_bf16(kf[12], qf[0][0], n0, 0, 0, 0); S[3][1] = __builtin_amdgcn_mfma_f32_16x16x32_bf16(kf[12], qf[1][0], n1, 0, 0, 0);
  SBAR();
  S[3][0] = __builtin_amdgcn_mfma_f32_16x16x32_bf16(kf[13], qf[0][1], S[3][0], 0, 0, 0); S[3][1] = __builtin_amdgcn_mfma_f32_16x16x32_bf16(kf[13], qf[1][1], S[3][1], 0, 0, 0);
  SBAR();
  S[3][0] = __builtin_amdgcn_mfma_f32_16x16x32_bf16(kf[14], qf[0][2], S[3][0], 0, 0, 0); S[3][1] = __builtin_amdgcn_mfma_f32_16x16x32_bf16(kf[14], qf[1][2], S[3][1], 0, 0, 0);
  SBAR();
  S[3][0] = __builtin_amdgcn_mfma_f32_16x16x32_bf16(kf[15], qf[0][3], S[3][0], 0, 0, 0); S[3][1] = __builtin_amdgcn_mfma_f32_16x16x32_bf16(kf[15], qf[1][3], S[3][1], 0, 0, 0);
  SBAR();
}
__device__ __forceinline__ void mask_meta16(f32x4 (&S)[4][2]) {
  const float NEG = -INFINITY;
#pragma unroll
  for (int kb = 1; kb < 4; ++kb)
#pragma unroll
    for (int qb = 0; qb < 2; ++qb) S[kb][qb] = (f32x4){NEG, NEG, NEG, NEG};
}
__device__ __forceinline__ void partial16(f32x4 (&S)[4][2], float (&mhat)[2], float (&alpha)[2], bool first) {
  float pm[2];
#pragma unroll
  for (int qb = 0; qb < 2; ++qb) { float a = __builtin_fmaxf(__builtin_fmaxf(S[0][qb][0], S[0][qb][1]), S[0][qb][2]), b = __builtin_fmaxf(__builtin_fmaxf(S[0][qb][3], S[1][qb][0]), S[1][qb][1]);
    a = __builtin_fmaxf(__builtin_fmaxf(a, S[1][qb][2]), S[1][qb][3]); b = __builtin_fmaxf(__builtin_fmaxf(b, S[2][qb][0]), S[2][qb][1]);
    a = __builtin_fmaxf(__builtin_fmaxf(a, S[2][qb][2]), S[2][qb][3]); b = __builtin_fmaxf(__builtin_fmaxf(b, S[3][qb][0]), S[3][qb][1]);
    a = __builtin_fmaxf(__builtin_fmaxf(a, S[3][qb][2]), S[3][qb][3]); pm[qb] = __builtin_fmaxf(a, b); }
  alpha[0] = 1.f; alpha[1] = 1.f;
  if (first || __builtin_expect(__any(__builtin_fmaxf(pm[0], pm[1]) > THRL), 0)) {
#pragma unroll
    for (int qb = 0; qb < 2; ++qb) { float m = pm[qb]; m = __builtin_fmaxf(m, __shfl_xor(m, 16)); m = __builtin_fmaxf(m, __shfl_xor(m, 32));
      const float dl = first ? m : __builtin_fmaxf(m, 0.f); mhat[qb] += dl;
#pragma unroll
      for (int kb = 0; kb < 4; ++kb) S[kb][qb] = S[kb][qb] - dl;
      if (!first) alpha[qb] = __builtin_amdgcn_exp2f(-dl); }
  }
#pragma unroll
  for (int kb = 0; kb < 2; ++kb)
#pragma unroll
    for (int qb = 0; qb < 2; ++qb)
#pragma unroll
      for (int r = 0; r < 4; ++r) S[kb][qb][r] = __builtin_amdgcn_exp2f(S[kb][qb][r]);
}
__device__ __forceinline__ void finish16(f32x4 (&S)[4][2], const float (&alpha)[2], float (&lsum)[2], bf16x8 (&pa)[2][2]) {
#pragma unroll
  for (int kb = 2; kb < 4; ++kb)
#pragma unroll
    for (int qb = 0; qb < 2; ++qb)
#pragma unroll
      for (int r = 0; r < 4; ++r) S[kb][qb][r] = __builtin_amdgcn_exp2f(S[kb][qb][r]);
#pragma unroll
  for (int qb = 0; qb < 2; ++qb) { float ps = 0.f;
#pragma unroll
    for (int kb = 0; kb < 4; ++kb) ps += (S[kb][qb][0] + S[kb][qb][1]) + (S[kb][qb][2] + S[kb][qb][3]);
    lsum[qb] = lsum[qb] * alpha[qb] + ps;
#pragma unroll
    for (int ks = 0; ks < 2; ++ks) { const f32x4 a = S[2 * ks][qb], b = S[2 * ks + 1][qb];
      u32x4 w = {cvtpk(a[0], a[1]), cvtpk(a[2], a[3]), cvtpk(b[0], b[1]), cvtpk(b[2], b[3])}; pa[qb][ks] = *reinterpret_cast<bf16x8*>(&w); } }
}
template <int OFF> __device__ __forceinline__ s16x4 tr_ld(int vb) { typedef __attribute__((address_space(3))) s16x4* lp_t; return __builtin_amdgcn_ds_read_tr16_b64_v4i16((lp_t)(unsigned)(vb + OFF)); }
__device__ __forceinline__ void pv16(f32x4 (&O)[2][8], int vbA, int vbB, const bf16x8 (&pa)[2][2]) {
  s16x4 lo[16], hi[16];
  lo[0] = tr_ld<0*1024 + 128*0>(vbA); hi[0] = tr_ld<4*1024 + 128*0>(vbA);
  lo[1] = tr_ld<0*1024 + 128*1>(vbA); hi[1] = tr_ld<4*1024 + 128*1>(vbA);
  lo[2] = tr_ld<0*1024 + 128*2>(vbA); hi[2] = tr_ld<4*1024 + 128*2>(vbA);
  lo[3] = tr_ld<0*1024 + 128*3>(vbA); hi[3] = tr_ld<4*1024 + 128*3>(vbA);
  SBAR();
  lo[4] = tr_ld<0*1024 + 128*4>(vbA); hi[4] = tr_ld<4*1024 + 128*4>(vbA);
  { const bf16x8 bfr = {lo[0][0], lo[0][1], lo[0][2], lo[0][3], hi[0][0], hi[0][1], hi[0][2], hi[0][3]};
    O[0][0] = __builtin_amdgcn_mfma_f32_16x16x32_bf16(pa[0][0], bfr, O[0][0], 0, 0, 0); O[1][0] = __builtin_amdgcn_mfma_f32_16x16x32_bf16(pa[1][0], bfr, O[1][0], 0, 0, 0); }
  SBAR();
  lo[5] = tr_ld<0*1024 + 128*5>(vbA); hi[5] = tr_ld<4*1024 + 128*5>(vbA);
  { const bf16x8 bfr = {lo[1][0], lo[1][1], lo[1][2], lo[1][3], hi[1][0], hi[1][1], hi[1][2], hi[1][3]};
    O[0][1] = __builtin_amdgcn_mfma_f32_16x16x32_bf16(pa[0][0], bfr, O[0][1], 0, 0, 0); O[1][1] = __builtin_amdgcn_mfma_f32_16x16x32_bf16(pa[1][0], bfr, O[1][1], 0, 0, 0); }
  SBAR();
  lo[6] = tr_ld<0*1024 + 128*6>(vbA); hi[6] = tr_ld<4*1024 + 128*6>(vbA);
  { const bf16x8 bfr = {lo[2][0], lo[2][1], lo[2][2], lo[2][3], hi[2][0], hi[2][1], hi[2][2], hi[2][3]};
    O[0][2] = __builtin_amdgcn_mfma_f32_16x16x32_bf16(pa[0][0], bfr, O[0][2], 0, 0, 0); O[1][2] = __builtin_amdgcn_mfma_f32_16x16x32_bf16(pa[1][0], bfr, O[1][2], 0, 0, 0); }
  SBAR();
  lo[7] = tr_ld<0*1024 + 128*7>(vbB); hi[7] = tr_ld<4*1024 + 128*7>(vbB);
  { const bf16x8 bfr = {lo[3][0], lo[3][1], lo[3][2], lo[3][3], hi[3][0], hi[3][1], hi[3][2], hi[3][3]};
    O[0][3] = __builtin_amdgcn_mfma_f32_16x16x32_bf16(pa[0][0], bfr, O[0][3], 0, 0, 0); O[1][3] = __builtin_amdgcn_mfma_f32_16x16x32_bf16(pa[1][0], bfr, O[1][3], 0, 0, 0); }
  SBAR();
  lo[8] = tr_ld<8*1024 + 128*0>(vbA); hi[8] = tr_ld<12*1024 + 128*0>(vbA);
  { const bf16x8 bfr = {lo[4][0], lo[4][1], lo[4][2], lo[4][3], hi[4][0], hi[4][1], hi[4][2], hi[4][3]};
    O[0][4] = __builtin_amdgcn_mfma_f32_16x16x32_bf16(pa[0][0], bfr, O[0][4], 0, 0, 0); O[1][4] = __builtin_amdgcn_mfma_f32_16x16x32_bf16(pa[1][0], bfr, O[1][4], 0, 0, 0); }
  SBAR();
  lo[9] = tr_ld<8*1024 + 128*1>(vbA); hi[9] = tr_ld<12*1024 + 128*1>(vbA);
  { const bf16x8 bfr = {lo[5][0], lo[5][1], lo[5][2], lo[5][3], hi[5][0], hi[5][1], hi[5][2], hi[5][3]};
    O[0][5] = __builtin_amdgcn_mfma_f32_16x16x32_bf16(pa[0][0], bfr, O[0][5], 0, 0, 0); O[1][5] = __builtin_amdgcn_mfma_f32_16x16x32_bf16(pa[1][0], bfr, O[1][5], 0, 0, 0); }
  SBAR();
  lo[10] = tr_ld<8*1024 + 128*2>(vbA); hi[10] = tr_ld<12*1024 + 128*2>(vbA);
  { const bf16x8 bfr = {lo[6][0], lo[6][1], lo[6][2], lo[6][3], hi[6][0], hi[6][1], hi[6][2], hi[6][3]};
    O[0][6] = __builtin_amdgcn_mfma_f32_16x16x32_bf16(pa[0][0], bfr, O[0][6], 0, 0, 0); O[1][6] = __builtin_amdgcn_mfma_f32_16x16x32_bf16(pa[1][0], bfr, O[1][6], 0, 0, 0); }
  SBAR();
  lo[11] = tr_ld<8*1024 + 128*3>(vbA); hi[11] = tr_ld<12*1024 + 128*3>(vbA);
  { const bf16x8 bfr = {lo[7][0], lo[7][1], lo[7][2], lo[7][3], hi[7][0], hi[7][1], hi[7][2], hi[7][3]};
    O[0][7] = __builtin_amdgcn_mfma_f32_16x16x32_bf16(pa[0][0], bfr, O[0][7], 0, 0, 0); O[1][7] = __builtin_amdgcn_mfma_f32_16x16x32_bf16(pa[1][0], bfr, O[1][7], 0, 0, 0); }
  SBAR();
  lo[12] = tr_ld<8*1024 + 128*4>(vbA); hi[12] = tr_ld<12*1024 + 128*4>(vbA);
  { const bf16x8 bfr = {lo[8][0], lo[8][1], lo[8][2], lo[8][3], hi[8][0], hi[8][1], hi[8][2], hi[8][3]};
    O[0][0] = __builtin_amdgcn_mfma_f32_16x16x32_bf16(pa[0][1], bfr, O[0][0], 0, 0, 0); O[1][0] = __builtin_amdgcn_mfma_f32_16x16x32_bf16(pa[1][1], bfr, O[1][0], 0, 0, 0); }
  SBAR();
  lo[13] = tr_ld<8*1024 + 128*5>(vbA); hi[13] = tr_ld<12*1024 + 128*5>(vbA);
  { const bf16x8 bfr = {lo[9][0], lo[9][1], lo[9][2], lo[9][3], hi[9][0], hi[9][1], hi[9][2], hi[9][3]};
    O[0][1] = __builtin_amdgcn_mfma_f32_16x16x32_bf16(pa[0][1], bfr, O[0][1], 0, 0, 0); O[1][1] = __builtin_amdgcn_mfma_f32_16x16x32_bf16(pa[1][1], bfr, O[1][1], 0, 0, 0); }
  SBAR();
  lo[14] = tr_ld<8*1024 + 128*6>(vbA); hi[14] = tr_ld<12*1024 + 128*6>(vbA);
  { const bf16x8 bfr = {lo[10][0], lo[10][1], lo[10][2], lo[10][3], hi[10][0], hi[10][1], hi[10][2], hi[10][3]};
    O[0][2] = __builtin_amdgcn_mfma_f32_16x16x32_bf16(pa[0][1], bfr, O[0][2], 0, 0, 0); O[1][2] = __builtin_amdgcn_mfma_f32_16x16x32_bf16(pa[1][1], bfr, O[1][2], 0, 0, 0); }
  SBAR();
  lo[15] = tr_ld<8*1024 + 128*7>(vbB); hi[15] = tr_ld<12*1024 + 128*7>(vbB);
  { const bf16x8 bfr = {lo[11][0], lo[11][1], lo[11][2], lo[11][3], hi[11][0], hi[11][1], hi[11][2], hi[11][3]};
    O[0][3] = __builtin_amdgcn_mfma_f32_16x16x32_bf16(pa[0][1], bfr, O[0][3], 0, 0, 0); O[1][3] = __builtin_amdgcn_mfma_f32_16x16x32_bf16(pa[1][1], bfr, O[1][3], 0, 0, 0); }
  SBAR();
  { const bf16x8 bfr = {lo[12][0], lo[12][1], lo[12][2], lo[12][3], hi[12][0], hi[12][1], hi[12][2], hi[12][3]};
    O[0][4] = __builtin_amdgcn_mfma_f32_16x16x32_bf16(pa[0][1], bfr, O[0][4], 0, 0, 0); O[1][4] = __builtin_amdgcn_mfma_f32_16x16x32_bf16(pa[1][1], bfr, O[1][4], 0, 0, 0); }
  SBAR();
  { const bf16x8 bfr = {lo[13][0], lo[13][1], lo[13][2], lo[13][3], hi[13][0], hi[13][1], hi[13][2], hi[13][3]};
    O[0][5] = __builtin_amdgcn_mfma_f32_16x16x32_bf16(pa[0][1], bfr, O[0][5], 0, 0, 0); O[1][5] = __builtin_amdgcn_mfma_f32_16x16x32_bf16(pa[1][1], bfr, O[1][5], 0, 0, 0); }
  SBAR();
  { const bf16x8 bfr = {lo[14][0], lo[14][1], lo[14][2], lo[14][3], hi[14][0], hi[14][1], hi[14][2], hi[14][3]};
    O[0][6] = __builtin_amdgcn_mfma_f32_16x16x32_bf16(pa[0][1], bfr, O[0][6], 0, 0, 0); O[1][6] = __builtin_amdgcn_mfma_f32_16x16x32_bf16(pa[1][1], bfr, O[1][6], 0, 0, 0); }
  SBAR();
  { const bf16x8 bfr = {lo[15][0], lo[15][1], lo[15][2], lo[15][3], hi[15][0], hi[15][1], hi[15][2], hi[15][3]};
    O[0][7] = __builtin_amdgcn_mfma_f32_16x16x32_bf16(pa[0][1], bfr, O[0][7], 0, 0, 0); O[1][7] = __builtin_amdgcn_mfma_f32_16x16x32_bf16(pa[1][1], bfr, O[1][7], 0, 0, 0); }
  SBAR();
}
__device__ __forceinline__ void qk_pv16(f32x4 (&S)[4][2], const char* Ks, int kb0, const bf16x8 (&qf)[2][4], float nm0, float nm1, f32x4 (&O)[2][8], int vbA, int vbB, const bf16x8 (&pa)[2][2]) {
  const f32x4 n0 = {nm0, nm0, nm0, nm0}, n1 = {nm1, nm1, nm1, nm1};
  bf16x8 kf[16]; s16x4 lo[16], hi[16];
  kf[0] = *reinterpret_cast<const bf16x8*>(Ks + 0*4096 + (kb0 ^ 0));
  kf[1] = *reinterpret_cast<const bf16x8*>(Ks + 0*4096 + (kb0 ^ 64));
  kf[2] = *reinterpret_cast<const bf16x8*>(Ks + 0*4096 + (kb0 ^ 128));
  kf[3] = *reinterpret_cast<const bf16x8*>(Ks + 0*4096 + (kb0 ^ 192));
  SBAR();
  kf[4] = *reinterpret_cast<const bf16x8*>(Ks + 1*4096 + (kb0 ^ 0));
  S[0][0] = __builtin_amdgcn_mfma_f32_16x16x32_bf16(kf[0], qf[0][0], n0, 0, 0, 0); S[0][1] = __builtin_amdgcn_mfma_f32_16x16x32_bf16(kf[0], qf[1][0], n1, 0, 0, 0);
  SBAR();
  kf[5] = *reinterpret_cast<const bf16x8*>(Ks + 1*4096 + (kb0 ^ 64));
  S[0][0] = __builtin_amdgcn_mfma_f32_16x16x32_bf16(kf[1], qf[0][1], S[0][0], 0, 0, 0); S[0][1] = __builtin_amdgcn_mfma_f32_16x16x32_bf16(kf[1], qf[1][1], S[0][1], 0, 0, 0);
  SBAR();
  kf[6] = *reinterpret_cast<const bf16x8*>(Ks + 1*4096 + (kb0 ^ 128));
  S[0][0] = __builtin_amdgcn_mfma_f32_16x16x32_bf16(kf[2], qf[0][2], S[0][0], 0, 0, 0); S[0][1] = __builtin_amdgcn_mfma_f32_16x16x32_bf16(kf[2], qf[1][2], S[0][1], 0, 0, 0);
  SBAR();
  kf[7] = *reinterpret_cast<const bf16x8*>(Ks + 1*4096 + (kb0 ^ 192));
  S[0][0] = __builtin_amdgcn_mfma_f32_16x16x32_bf16(kf[3], qf[0][3], S[0][0], 0, 0, 0); S[0][1] = __builtin_amdgcn_mfma_f32_16x16x32_bf16(kf[3], qf[1][3], S[0][1], 0, 0, 0);
  SBAR();
  kf[8] = *reinterpret_cast<const bf16x8*>(Ks + 2*4096 + (kb0 ^ 0));
  S[1][0] = __builtin_amdgcn_mfma_f32_16x16x32_bf16(kf[4], qf[0][0], n0, 0, 0, 0); S[1][1] = __builtin_amdgcn_mfma_f32_16x16x32_bf16(kf[4], qf[1][0], n1, 0, 0, 0);
  SBAR();
  kf[9] = *reinterpret_cast<const bf16x8*>(Ks + 2*4096 + (kb0 ^ 64));
  S[1][0] = __builtin_amdgcn_mfma_f32_16x16x32_bf16(kf[5], qf[0][1], S[1][0], 0, 0, 0); S[1][1] = __builtin_amdgcn_mfma_f32_16x16x32_bf16(kf[5], qf[1][1], S[1][1], 0, 0, 0);
  SBAR();
  kf[10] = *reinterpret_cast<const bf16x8*>(Ks + 2*4096 + (kb0 ^ 128));
  S[1][0] = __builtin_amdgcn_mfma_f32_16x16x32_bf16(kf[6], qf[0][2], S[1][0], 0, 0, 0); S[1][1] = __builtin_amdgcn_mfma_f32_16x16x32_bf16(kf[6], qf[1][2], S[1][1], 0, 0, 0);
  SBAR();
  kf[11] = *reinterpret_cast<const bf16x8*>(Ks + 2*4096 + (kb0 ^ 192));
  S[1][0] = __builtin_amdgcn_mfma_f32_16x16x32_bf16(kf[7], qf[0][3], S[1][0], 0, 0, 0); S[1][1] = __builtin_amdgcn_mfma_f32_16x16x32_bf16(kf[7], qf[1][3], S[1][1], 0, 0, 0);
  SBAR();
  kf[12] = *reinterpret_cast<const bf16x8*>(Ks + 3*4096 + (kb0 ^ 0));
  S[2][0] = __builtin_amdgcn_mfma_f32_16x16x32_bf16(kf[8], qf[0][0], n0, 0, 0, 0); S[2][1] = __builtin_amdgcn_mfma_f32_16x16x32_bf16(kf[8], qf[1][0], n1, 0, 0, 0);
  SBAR();
  kf[13] = *reinterpret_cast<const bf16x8*>(Ks + 3*4096 + (kb0 ^ 64));
  S[2][0] = __builtin_amdgcn_mfma_f32_16x16x32_bf16(kf[9], qf[0][1], S[2][0], 0, 0, 0); S[2][1] = __builtin_amdgcn_mfma_f32_16x16x32_bf16(kf[9], qf[1][1], S[2][1], 0, 0, 0);
  SBAR();
  kf[14] = *reinterpret_cast<const bf16x8*>(Ks + 3*4096 + (kb0 ^ 128));
  S[2][0] = __builtin_amdgcn_mfma_f32_16x16x32_bf16(kf[10], qf[0][2], S[2][0], 0, 0, 0); S[2][1] = __builtin_amdgcn_mfma_f32_16x16x32_bf16(kf[10], qf[1][2], S[2][1], 0, 0, 0);
  SBAR();
  kf[15] = *reinterpret_cast<const bf16x8*>(Ks + 3*4096 + (kb0 ^ 192));
  S[2][0] = __builtin_amdgcn_mfma_f32_16x16x32_bf16(kf[11], qf[0][3], S[2][0], 0, 0, 0); S[2][1] = __builtin_amdgcn_mfma_f32_16x16x32_bf16(kf[11], qf[1][3], S[2][1], 0, 0, 0);
  SBAR();
  S[3][0] = __builtin_amdgcn_mfma_f32_16x16x32_bf16(kf[12], qf[0][0], n0, 0, 0, 0); S[3][1] = __builtin_amdgcn_mfma_f32_16x16x32_bf16(kf[12], qf[1][0], n1, 0, 0, 0);
  lo[0] = tr_ld<0*1024 + 128*0>(vbA); hi[0] = tr_ld<4*1024 + 128*0>(vbA);
  lo[1] = tr_ld<0*1024 + 128*1>(vbA); hi[1] = tr_ld<4*1024 + 128*1>(vbA);
  lo[2] = tr_ld<0*1024 + 128*2>(vbA); hi[2] = tr_ld<4*1024 + 128*2>(vbA);
  lo[3] = tr_ld<0*1024 + 128*3>(vbA); hi[3] = tr_ld<4*1024 + 128*3>(vbA);
  SBAR();
  S[3][0] = __builtin_amdgcn_mfma_f32_16x16x32_bf16(kf[13], qf[0][1], S[3][0], 0, 0, 0); S[3][1] = __builtin_amdgcn_mfma_f32_16x16x32_bf16(kf[13], qf[1][1], S[3][1], 0, 0, 0);
  SBAR();
  S[3][0] = __builtin_amdgcn_mfma_f32_16x16x32_bf16(kf[14], qf[0][2], S[3][0], 0, 0, 0); S[3][1] = __builtin_amdgcn_mfma_f32_16x16x32_bf16(kf[14], qf[1][2], S[3][1], 0, 0, 0);
  SBAR();
  S[3][0] = __builtin_amdgcn_mfma_f32_16x16x32_bf16(kf[15], qf[0][3], S[3][0], 0, 0, 0); S[3][1] = __builtin_amdgcn_mfma_f32_16x16x32_bf16(kf[15], qf[1][3], S[3][1], 0, 0, 0);
  SBAR();
  lo[4] = tr_ld<0*1024 + 128*4>(vbA); hi[4] = tr_ld<4*1024 + 128*4>(vbA);
  { const bf16x8 bfr = {lo[0][0], lo[0][1], lo[0][2], lo[0][3], hi[0][0], hi[0][1], hi[0][2], hi[0][3]};
    O[0][0] = __builtin_amdgcn_mfma_f32_16x16x32_bf16(pa[0][0], bfr, O[0][0], 0, 0, 0); O[1][0] = __builtin_amdgcn_mfma_f32_16x16x32_bf16(pa[1][0], bfr, O[1][0], 0, 0, 0); }
  SBAR();
  lo[5] = tr_ld<0*1024 + 128*5>(vbA); hi[5] = tr_ld<4*1024 + 128*5>(vbA);
  { const bf16x8 bfr = {lo[1][0], lo[1][1], lo[1][2], lo[1][3], hi[1][0], hi[1][1], hi[1][2], hi[1][3]};
    O[0][1] = __builtin_amdgcn_mfma_f32_16x16x32_bf16(pa[0][0], bfr, O[0][1], 0, 0, 0); O[1][1] = __builtin_amdgcn_mfma_f32_16x16x32_bf16(pa[1][0], bfr, O[1][1], 0, 0, 0); }
  SBAR();
  lo[6] = tr_ld<0*1024 + 128*6>(vbA); hi[6] = tr_ld<4*1024 + 128*6>(vbA);
  { const bf16x8 bfr = {lo[2][0], lo[2][1], lo[2][2], lo[2][3], hi[2][0], hi[2][1], hi[2][2], hi[2][3]};
    O[0][2] = __builtin_amdgcn_mfma_f32_16x16x32_bf16(pa[0][0], bfr, O[0][2], 0, 0, 0); O[1][2] = __builtin_amdgcn_mfma_f32_16x16x32_bf16(pa[1][0], bfr, O[1][2], 0, 0, 0); }
  SBAR();
  lo[7] = tr_ld<0*1024 + 128*7>(vbB); hi[7] = tr_ld<4*1024 + 128*7>(vbB);
  { const bf16x8 bfr = {lo[3][0], lo[3][1], lo[3][2], lo[3][3], hi[3][0], hi[3][1], hi[3][2], hi[3][3]};
    O[0][3] = __builtin_amdgcn_mfma_f32_16x16x32_bf16(pa[0][0], bfr, O[0][3], 0, 0, 0); O[1][3] = __builtin_amdgcn_mfma_f32_16x16x32_bf16(pa[1][0], bfr, O[1][3], 0, 0, 0); }
  SBAR();
  lo[8] = tr_ld<8*1024 + 128*0>(vbA); hi[8] = tr_ld<12*1024 + 128*0>(vbA);
  { const bf16x8 bfr = {lo[4][0], lo[4][1], lo[4][2], lo[4][3], hi[4][0], hi[4][1], hi[4][2], hi[4][3]};
    O[0][4] = __builtin_amdgcn_mfma_f32_16x16x32_bf16(pa[0][0], bfr, O[0][4], 0, 0, 0); O[1][4] = __builtin_amdgcn_mfma_f32_16x16x32_bf16(pa[1][0], bfr, O[1][4], 0, 0, 0); }
  SBAR();
  lo[9] = tr_ld<8*1024 + 128*1>(vbA); hi[9] = tr_ld<12*1024 + 128*1>(vbA);
  { const bf16x8 bfr = {lo[5][0], lo[5][1], lo[5][2], lo[5][3], hi[5][0], hi[5][1], hi[5][2], hi[5][3]};
    O[0][5] = __builtin_amdgcn_mfma_f32_16x16x32_bf16(pa[0][0], bfr, O[0][5], 0, 0, 0); O[1][5] = __builtin_amdgcn_mfma_f32_16x16x32_bf16(pa[1][0], bfr, O[1][5], 0, 0, 0); }
  SBAR();
  lo[10] = tr_ld<8*1024 + 128*2>(vbA); hi[10] = tr_ld<12*1024 + 128*2>(vbA);
  { const bf16x8 bfr = {lo[6][0], lo[6][1], lo[6][2], lo[6][3], hi[6][0], hi[6][1], hi[6][2], hi[6][3]};
    O[0][6] = __builtin_amdgcn_mfma_f32_16x16x32_bf16(pa[0][0], bfr, O[0][6], 0, 0, 0); O[1][6] = __builtin_amdgcn_mfma_f32_16x16x32_bf16(pa[1][0], bfr, O[1][6], 0, 0, 0); }
  SBAR();
  lo[11] = tr_ld<8*1024 + 128*3>(vbA); hi[11] = tr_ld<12*1024 + 128*3>(vbA);
  { const bf16x8 bfr = {lo[7][0], lo[7][1], lo[7][2], lo[7][3], hi[7][0], hi[7][1], hi[7][2], hi[7][3]};
    O[0][7] = __builtin_amdgcn_mfma_f32_16x16x32_bf16(pa[0][0], bfr, O[0][7], 0, 0, 0); O[1][7] = __builtin_amdgcn_mfma_f32_16x16x32_bf16(pa[1][0], bfr, O[1][7], 0, 0, 0); }
  SBAR();
  lo[12] = tr_ld<8*1024 + 128*4>(vbA); hi[12] = tr_ld<12*1024 + 128*4>(vbA);
  { const bf16x8 bfr = {lo[8][0], lo[8][1], lo[8][2], lo[8][3], hi[8][0], hi[8][1], hi[8][2], hi[8][3]};
    O[0][0] = __builtin_amdgcn_mfma_f32_16x16x32_bf16(pa[0][1], bfr, O[0][0], 0, 0, 0); O[1][0] = __builtin_amdgcn_mfma_f32_16x16x32_bf16(pa[1][1], bfr, O[1][0], 0, 0, 0); }
  SBAR();
  lo[13] = tr_ld<8*1024 + 128*5>(vbA); hi[13] = tr_ld<12*1024 + 128*5>(vbA);
  { const bf16x8 bfr = {lo[9][0], lo[9][1], lo[9][2], lo[9][3], hi[9][0], hi[9][1], hi[9][2], hi[9][3]};
    O[0][1] = __builtin_amdgcn_mfma_f32_16x16x32_bf16(pa[0][1], bfr, O[0][1], 0, 0, 0); O[1][1] = __builtin_amdgcn_mfma_f32_16x16x32_bf16(pa[1][1], bfr, O[1][1], 0, 0, 0); }
  SBAR();
  lo[14] = tr_ld<8*1024 + 128*6>(vbA); hi[14] = tr_ld<12*1024 + 128*6>(vbA);
  { const bf16x8 bfr = {lo[10][0], lo[10][1], lo[10][2], lo[10][3], hi[10][0], hi[10][1], hi[10][2], hi[10][3]};
    O[0][2] = __builtin_amdgcn_mfma_f32_16x16x32_bf16(pa[0][1], bfr, O[0][2], 0, 0, 0); O[1][2] = __builtin_amdgcn_mfma_f32_16x16x32_bf16(pa[1][1], bfr, O[1][2], 0, 0, 0); }
  SBAR();
  lo[15] = tr_ld<8*1024 + 128*7>(vbB); hi[15] = tr_ld<12*1024 + 128*7>(vbB);
  { const bf16x8 bfr = {lo[11][0], lo[11][1], lo[11][2], lo[11][3], hi[11][0], hi[11][1], hi[11][2], hi[11][3]};
    O[0][3] = __builtin_amdgcn_mfma_f32_16x16x32_bf16(pa[0][1], bfr, O[0][3], 0, 0, 0); O[1][3] = __builtin_amdgcn_mfma_f32_16x16x32_bf16(pa[1][1], bfr, O[1][3], 0, 0, 0); }
  SBAR();
  { const bf16x8 bfr = {lo[12][0], lo[12][1], lo[12][2], lo[12][3], hi[12][0], hi[12][1], hi[12][2], hi[12][3]};
    O[0][4] = __builtin_amdgcn_mfma_f32_16x16x32_bf16(pa[0][1], bfr, O[0][4], 0, 0, 0); O[1][4] = __builtin_amdgcn_mfma_f32_16x16x32_bf16(pa[1][1], bfr, O[1][4], 0, 0, 0); }
  SBAR();
  { const bf16x8 bfr = {lo[13][0], lo[13][1], lo[13][2], lo[13][3], hi[13][0], hi[13][1], hi[13][2], hi[13][3]};
    O[0][5] = __builtin_amdgcn_mfma_f32_16x16x32_bf16(pa[0][1], bfr, O[0][5], 0, 0, 0); O[1][5] = __builtin_amdgcn_mfma_f32_16x16x32_bf16(pa[1][1], bfr, O[1][5], 0, 0, 0); }
  SBAR();
  { const bf16x8 bfr = {lo[14][0], lo[14][1], lo[14][2], lo[14][3], hi[14][0], hi[14][1], hi[14][2], hi[14][3]};
    O[0][6] = __builtin_amdgcn_mfma_f32_16x16x32_bf16(pa[0][1], bfr, O[0][6], 0, 0, 0); O[1][6] = __builtin_amdgcn_mfma_f32_16x16x32_bf16(pa[1][1], bfr, O[1][6], 0, 0, 0); }
  SBAR();
  { const bf16x8 bfr = {lo[15][0], lo[15][1], lo[15][2], lo[15][3], hi[15][0], hi[15][1], hi[15][2], hi[15][3]};
    O[0][7] = __builtin_amdgcn_mfma_f32_16x16x32_bf16(pa[0][1], bfr, O[0][7], 0, 0, 0); O[1][7] = __builtin_amdgcn_mfma_f32_16x16x32_bf16(pa[1][1], bfr, O[1][7], 0, 0, 0); }
  SBAR();
}

__device__ __forceinline__ void attn_unit(const bf16r* Qb, const bf16r* __restrict__ Kh, const bf16r* __restrict__ Vh,
                                          const bf16r* __restrict__ KMh, const bf16r* __restrict__ VMh, bf16r* Ob, int NT, char* lds,
                                          const float* __restrict__ qnorm, int t0, float* ssq, int wave_id) {
  int tid_ = wave_id * 64 + lane_id_now(); asm volatile("" : "+v"(tid_));
  const int tid = tid_, wid = tid >> 6, lane = tid & 63, c = lane & 15, g = lane >> 4;
  float* ws = (float*)(lds + 6 * 16384) + wid * 64; float* li_l = ws; float* al_l = ws + 32;
  float mhat[2] = {0.f, 0.f}, lsum[2] = {0.f, 0.f};
  f32x4 O[2][8];
#pragma unroll
  for (int qb = 0; qb < 2; ++qb)
#pragma unroll
    for (int db = 0; db < 8; ++db) O[qb][db] = (f32x4){0.f, 0.f, 0.f, 0.f};
  unsigned kgo0, vgo0;
  { const int k0 = 4 * wid + g; kgo0 = (unsigned)(k0 * (LDK * 2) + ((c << 4) ^ ((k0 & 15) << 4)));
    const int r = (lane >> 1) & 3, half = lane & 1, s8 = lane >> 3;
    { const int p = wid,     db = (s8 - (p & 1)) & 7; vgo0 = (unsigned)((4 * p + r) * (LDK * 2) + (16 * db + 8 * half) * 2); }
 }
  const int kb0 = c * 256 + ((g ^ c) << 4);
  typedef __attribute__((address_space(3))) unsigned char* ldsp_t;
  const ldsp_t lds3 = (ldsp_t)lds;
  const int w1k = __builtin_amdgcn_readfirstlane(wid) * 1024;
  constexpr int VRING = 3 * 16384;
#define DMAK(t, soff) do { const char* b_ = (const char*)((t) == 0 ? KMh : Kh + (long)((t) - 1) * KVBLK * LDK); \
    __builtin_amdgcn_global_load_lds((const unsigned*)(b_ + kgo0), (__attribute__((address_space(3))) unsigned*)(lds3 + (soff) + w1k), 16, 0, 0); \
    __builtin_amdgcn_global_load_lds((const unsigned*)(b_ + kgo0 + 32 * LDK * 2), (__attribute__((address_space(3))) unsigned*)(lds3 + (soff) + w1k + 8192), 16, 0, 0); } while (0)
#define DMAV(t, soff) do { const char* b_ = (const char*)((t) == 0 ? VMh : Vh + (long)((t) - 1) * KVBLK * LDK); \
    __builtin_amdgcn_global_load_lds((const unsigned*)(b_ + vgo0), (__attribute__((address_space(3))) unsigned*)(lds3 + VRING + (soff) + w1k), 16, 0, 0); \
    __builtin_amdgcn_global_load_lds((const unsigned*)(b_ + vgo0 + 32 * LDK * 2), (__attribute__((address_space(3))) unsigned*)(lds3 + VRING + (soff) + w1k + 8192), 16, 0, 0); } while (0)
#define WAITBAR(N) asm volatile("s_waitcnt vmcnt(" #N ") lgkmcnt(0)\n\ts_barrier" ::: "memory")
#define ROT() do { const int t_ = sm1; sm1 = sc_; sc_ = sp1; sp1 = t_; } while (0)
#define RESC(a) do { if (__any(__builtin_fminf((a)[0], (a)[1]) < 1.f)) { if (g == 0) { al_l[c] = (a)[0]; al_l[16 + c] = (a)[1]; } asm volatile("s_waitcnt lgkmcnt(0)" ::: "memory"); \
    _Pragma("unroll") for (int qb_ = 0; qb_ < 2; ++qb_) _Pragma("unroll") for (int r_ = 0; r_ < 4; ++r_) { const float a_ = al_l[16 * qb_ + 4 * g + r_]; \
      _Pragma("unroll") for (int db_ = 0; db_ < 8; ++db_) O[qb_][db_][r_] *= a_; } } } while (0)
  DMAK(0, 0); DMAV(0, 0); DMAK(1, 16384);
  bf16x8 qf[2][4];
#pragma unroll
  for (int qb = 0; qb < 2; ++qb)
#pragma unroll
    for (int ds = 0; ds < 4; ++ds) qf[qb][ds] = *reinterpret_cast<const bf16x8*>(Qb + (long)(wid * QBLK + 16 * qb + c) * LDQ + 32 * ds + 8 * g);
  {
    int go = g; asm volatile("" : "+v"(go));
#pragma unroll
    for (int qb = 0; qb < 2; ++qb) {
      float ss = 0.f;
#pragma unroll
      for (int ds = 0; ds < 4; ++ds)
#pragma unroll
        for (int j = 0; j < 8; ++j) { const float x = bfl(qf[qb][ds][j]); ss += x * x; }
      ss += __shfl_xor(ss, 16); ss += __shfl_xor(ss, 32);
      const float rs = (SCALE * 1.4426950408889634f) / sqrtf(ss * (1.f / 128.f) + 1e-6f);
      int t = t0 + wid * QBLK + 16 * qb + c; asm volatile("" : "+v"(t));
#pragma unroll
      for (int p = 0; p < 2; ++p) { const float pos = (float)(p ? (t & 63) : (t >> 6)); const int fa = 2 * p, fb = 2 * p + 1;
        const float4 ga0 = *reinterpret_cast<const float4*>(qnorm + 32 * fa + 8 * g), ga1 = *reinterpret_cast<const float4*>(qnorm + 32 * fa + 8 * g + 4);
        const float4 gb0 = *reinterpret_cast<const float4*>(qnorm + 32 * fb + 8 * g), gb1 = *reinterpret_cast<const float4*>(qnorm + 32 * fb + 8 * g + 4);
        const float gaf[8] = {ga0.x, ga0.y, ga0.z, ga0.w, ga1.x, ga1.y, ga1.z, ga1.w}, gbf[8] = {gb0.x, gb0.y, gb0.z, gb0.w, gb1.x, gb1.y, gb1.z, gb1.w};
        float oa[8], ob[8];
#pragma unroll
        for (int j = 0; j < 8; ++j) { const int i = 8 * go + j;
          float rev = pos * __builtin_amdgcn_exp2f(-(float)i * (13.287712379549449f / 32.f)) * 0.15915494309189535f; rev -= floorf(rev);
          const float sn = __builtin_amdgcn_sinf(rev), cs = __builtin_amdgcn_cosf(rev);
          const float x1 = bfl(qf[qb][fa][j]) * rs * gaf[j], x2 = bfl(qf[qb][fb][j]) * rs * gbf[j];
          oa[j] = x1 * cs - x2 * sn; ob[j] = x2 * cs + x1 * sn; }
        { u32x4 w = {cvtpk(oa[0], oa[1]), cvtpk(oa[2], oa[3]), cvtpk(oa[4], oa[5]), cvtpk(oa[6], oa[7])}; qf[qb][fa] = *reinterpret_cast<bf16x8*>(&w); }
        { u32x4 w = {cvtpk(ob[0], ob[1]), cvtpk(ob[2], ob[3]), cvtpk(ob[4], ob[5]), cvtpk(ob[6], ob[7])}; qf[qb][fb] = *reinterpret_cast<bf16x8*>(&w); }
        SBAR(); }
    }
  }
  const int vlb = (int)(uintptr_t)(lds + VRING) + g * 1024 + (c >> 2) * 32 + (c & 3) * 8;
  const int vbA0 = vlb + (g & 1) * 128, vbB0 = vlb + (g & 1) * (128 - 1024);
  int sm1 = 32768, sc_ = 0, sp1 = 16384;
  f32x4 S[4][2]; bf16x8 paA[2][2], paB[2][2]; float al[2];
  WAITBAR(2);
  DMAK(2, sm1); DMAV(1, sp1);
  qkt16(S, lds + sc_, kb0, qf, -mhat[0], -mhat[1]); mask_meta16(S); partial16(S, mhat, al, true); finish16(S, al, lsum, paA);
  WAITBAR(4); ROT();
  for (int t = 1; t + 1 < NT; t += 2) {
    if (t + 2 < NT) DMAK(t + 2, sm1); DMAV(t + 1, sp1);
    SBAR(); qk_pv16(S, lds + sc_, kb0, qf, -mhat[0], -mhat[1], O, vbA0 + sm1, vbB0 + sm1, paA); SBAR();
    partial16(S, mhat, al, false); finish16(S, al, lsum, paB);
    if (t + 2 < NT) WAITBAR(4); else WAITBAR(2);
    RESC(al); ROT();
    if (t + 3 < NT) DMAK(t + 3, sm1); if (t + 2 < NT) DMAV(t + 2, sp1);
    SBAR(); qk_pv16(S, lds + sc_, kb0, qf, -mhat[0], -mhat[1], O, vbA0 + sm1, vbB0 + sm1, paB); SBAR();
    partial16(S, mhat, al, false); finish16(S, al, lsum, paA);
    if (t + 3 < NT) WAITBAR(4); else if (t + 2 < NT) WAITBAR(2); else WAITBAR(0);
    RESC(al); ROT();
  }
  pv16(O, vbA0 + sm1, vbB0 + sm1, paA);
#pragma unroll
  for (int qb = 0; qb < 2; ++qb) { float L = lsum[qb]; L += __shfl_xor(L, 16); L += __shfl_xor(L, 32); if (g == 0) li_l[16 * qb + c] = L; }
  asm volatile("s_waitcnt lgkmcnt(0)" ::: "memory");
  bf16r* Ow = Ob + (long)(wid * QBLK) * LDO;
#pragma unroll
  for (int qb = 0; qb < 2; ++qb)
#pragma unroll
    for (int r = 0; r < 4; ++r) { const int orow = 16 * qb + 4 * g + r; const float rl = __builtin_amdgcn_rcpf(li_l[orow]); float sq = 0.f;
#pragma unroll
      for (int db = 0; db < 8; ++db) { const float v = O[qb][db][r] * rl; sq += v * v; Ow[(long)orow * LDO + 16 * db + c] = f2bf_rne(v); }
      sq += __shfl_xor(sq, 1); sq += __shfl_xor(sq, 2); sq += __shfl_xor(sq, 4); sq += __shfl_xor(sq, 8);
      if (c == 0) ssq[(long)(wid * QBLK + orow) * 8] = sq; }
  asm volatile("s_waitcnt lgkmcnt(0)\n\ts_barrier" ::: "memory");
#undef DMAK
#undef DMAV
#undef WAITBAR
#undef ROT
#undef RESC
}
#undef SBAR
}

constexpr int NWAVES = 8;
constexpr int DM = 2048, NTOK = 65536, INW = 3584, FFN = 5632, UPW = 2 * FFN;
constexpr float EPS = 1e-6f;
constexpr int XR_ROWS = 8 * 4160 + 4 * 8256;
constexpr int NCHUNK = 8 * 65 + 4 * 129;
constexpr int HROWS = 32768;
__host__ __device__ __forceinline__ int seq_first_row(int s) { return s < 8 ? s * 4096 : 32768 + (s - 8) * 8192; }
__host__ __device__ __forceinline__ int seq_len(int s) { return s < 8 ? 4096 : 8192; }
__host__ __device__ __forceinline__ int xr_base(int s) { return s < 8 ? s * 4160 : 33280 + (s - 8) * 8256; }
__host__ __device__ __forceinline__ int chunk_base(int s) { return s < 8 ? s * 65 : 520 + (s - 8) * 129; }
__host__ __device__ __forceinline__ int row_seq(int row) { return row < 32768 ? (row >> 12) : 8 + ((row - 32768) >> 13); }

constexpr size_t MiB = 1u << 20, KiB = 1u << 10;
constexpr size_t WS_CTL = 0, CTL_ZERO_BYTES = 1 * MiB;
constexpr size_t WS_SMALL = 1 * MiB;
constexpr size_t WS_XNMETA = WS_SMALL + 0, WS_ZM = WS_SMALL + 64 * KiB, WS_KM = WS_SMALL + 320 * KiB, WS_VM = WS_SMALL + 352 * KiB, WS_Q15 = WS_SMALL + 384 * KiB, WS_GY15 = WS_SMALL + 388 * KiB,
                 WS_LO15 = WS_SMALL + 392 * KiB, WS_MIXED15 = WS_SMALL + 448 * KiB, WS_Y15 = WS_SMALL + 544 * KiB, WS_G15 = WS_SMALL + 640 * KiB, WS_MQP = WS_SMALL + 1024 * KiB;
constexpr size_t WS_WIN = 5 * MiB, WS_WOUT = 19 * MiB, WS_WUP = 27 * MiB, WS_WDOWN = 71 * MiB, WS_WG = 93 * MiB;
constexpr size_t WS_CAR = 94 * MiB, WS_CIN = 111 * MiB;
constexpr size_t WS_R0 = 120 * MiB, WS_RATIO = 120 * MiB + 256 * KiB, WS_RL = 120 * MiB + 512 * KiB, WS_SSQA = 121 * MiB, WS_SSQL = 123 * MiB;
constexpr size_t WS_A = 128 * MiB;
constexpr size_t WS_B = 384 * MiB;
constexpr size_t WS_QG = WS_B, WS_K = WS_B + 256 * MiB, WS_V = WS_B + 288 * MiB, WS_XR = WS_B + 320 * MiB;
constexpr size_t WS_ACT = WS_B, WS_EDGE = WS_B + 352 * MiB;
constexpr size_t WS_H1A = WS_B + 420 * MiB;
constexpr size_t WS_END = WS_B + 548 * MiB;
static_assert(WS_ZM + 16 * INW * 4 <= WS_KM && WS_G15 + 12 * FFN * 4 <= WS_MQP && WS_MQP + 512 * 4 * 132 * 4 <= WS_WIN, "small map");
static_assert(WS_WIN + (size_t)INW * DM * 2 <= WS_WOUT && WS_WOUT + (size_t)DM * DM * 2 <= WS_WUP && WS_WUP + (size_t)UPW * DM * 2 <= WS_WDOWN && WS_WDOWN + (size_t)DM * FFN * 2 <= WS_WG && WS_WG + 32 * 16384 * 2 <= WS_CAR, "weights map");
static_assert(WS_CAR + (size_t)NCHUNK * 2 * 1024 * 8 <= WS_CIN && WS_A + (size_t)NTOK * DM * 2 <= WS_B, "carry map");
static_assert(WS_QG + (size_t)NTOK * DM * 2 <= WS_K && WS_XR + (size_t)(XR_ROWS + 64) * 1024 * 2 <= WS_END && WS_EDGE + (size_t)512 * 2 * 3 * FFN * 4 <= WS_H1A && WS_H1A + (size_t)HROWS * DM * 2 <= WS_END && WS_END <= 1024 * MiB && WS_CIN + (size_t)NCHUNK * 2 * 1024 * 4 <= WS_R0 && WS_SSQL + (size_t)NTOK * 8 * 4 <= WS_A && WS_ACT + (size_t)HROWS * FFN * 2 <= WS_EDGE && WS_EDGE + (size_t)512 * 2 * 3 * FFN * 4 <= WS_END, "B map");
constexpr int CW_BAR = 4096;

constexpr int RING_BYTES = 131072;
constexpr int LDSCTL_OFF = RING_BYTES, MISC_OFF = LDSCTL_OFF + 320;
constexpr int LDS_BYTES = 147456;

#define GAS __attribute__((address_space(1)))
#define LAS __attribute__((address_space(3)))
typedef unsigned short bf16;
typedef unsigned v4u __attribute__((ext_vector_type(4)));
typedef float f32x4 __attribute__((ext_vector_type(4)));
typedef short bf16x8 __attribute__((ext_vector_type(8)));
typedef GAS unsigned gu32;
typedef GAS unsigned long long gu64;
#define RLX_AGENT __ATOMIC_RELAXED, __HIP_MEMORY_SCOPE_AGENT
#define LDS_WAIT() asm volatile("s_waitcnt lgkmcnt(0)" ::: "memory")
#define VM_WAIT() asm volatile("s_waitcnt vmcnt(0)" ::: "memory")
__device__ __forceinline__ unsigned long long rt() { return __builtin_amdgcn_s_memrealtime(); }
__device__ __forceinline__ unsigned f2bf(float f) { unsigned u = __builtin_bit_cast(unsigned, f); return (u + 0x7fffu + ((u >> 16) & 1u)) >> 16; }
__device__ __forceinline__ unsigned pk2(float lo, float hi) { unsigned r; asm("v_cvt_pk_bf16_f32 %0, %1, %2" : "=v"(r) : "v"(lo), "v"(hi)); return r; }

#define XB_TMO      128
#define XB_XCNT(j)  (256  + 64 * (j))
#define XB_XSUB(j)  (1280 + 64 * (j))
#define XB_XGEN(j)  (2304 + 64 * (j))
#define XB_TOP      3328
#define XB_TOPGEN   3392
#define XCD_BAR_WORDS 3456
#define XB_SPIN_CAP (1u << 18)

__device__ __forceinline__ unsigned xb_ld(unsigned* p)              { return __hip_atomic_load(p, __ATOMIC_RELAXED, __HIP_MEMORY_SCOPE_AGENT); }
__device__ __forceinline__ unsigned xb_add(unsigned* p, unsigned v) { return __hip_atomic_fetch_add(p, v, __ATOMIC_RELAXED, __HIP_MEMORY_SCOPE_AGENT); }
__device__ __forceinline__ unsigned xb_xcc_id() { return (unsigned)__builtin_amdgcn_s_getreg((3 << 11) | 20) & 0xFu; }
#define XB_SPIN(cond, bar) do { unsigned _sp = 0; while (cond) { __builtin_amdgcn_s_sleep(1); \
    if ((++_sp & 255u) == 0u) { if (xb_ld(&(bar)[XB_TMO])) break; if (_sp > XB_SPIN_CAP) { atomicAdd(&(bar)[XB_TMO], 1u); break; } } } } while (0)

struct XcdBarrier {
    unsigned* bar; unsigned x;
    volatile LAS unsigned* st;
};

__device__ __forceinline__ XcdBarrier xcd_barrier_post(unsigned* bar, volatile LAS unsigned* st, bool t0  ) {
    XcdBarrier b; b.bar = bar; b.x = xb_xcc_id(); b.st = st;
    if (t0) (void)xb_add(&bar[XB_XCNT(b.x)], 1u);
    return b;
}
__device__ __forceinline__ void xcd_barrier_complete(unsigned* bar, unsigned x, unsigned& nloc, unsigned& nx) {
    const unsigned G = gridDim.x * gridDim.y * gridDim.z;
    unsigned sum, cnt, mine, sp = 0u;
    for (;;) {
        sum = 0u; cnt = 0u; mine = 0u;
#pragma unroll
        for (unsigned j = 0; j < 16; ++j) { const unsigned c = xb_ld(&bar[XB_XCNT(j)]); sum += c; cnt += (c > 0u) ? 1u : 0u; mine = (j == x) ? c : mine; }
        if (sum == G) break;
        __builtin_amdgcn_s_sleep(1);
        if ((++sp & 255u) == 0u) { if (xb_ld(&bar[XB_TMO])) break; if (sp > XB_SPIN_CAP) { atomicAdd(&bar[XB_TMO], 1u); break; } }
    }
    nloc = mine > 0u ? mine : 1u; nx = cnt > 0u ? cnt : 1u;
}

__device__ __forceinline__ void xcd_barrier(const XcdBarrier& b, bool t0  ) {
    asm volatile("s_waitcnt vmcnt(0)" ::: "memory");
    __syncthreads();
    if (t0) {
        unsigned* bar = b.bar;
        __builtin_amdgcn_s_waitcnt(0);
        unsigned nloc = b.st[0], nx = b.st[1];
        if (nloc == 0u) { xcd_barrier_complete(bar, b.x, nloc, nx); b.st[0] = nloc; b.st[1] = nx; }
        const unsigned old = xb_add(&bar[XB_XSUB(b.x)], 1u);
        const unsigned gen = old / nloc;
        if (old + 1u == (gen + 1u) * nloc) {
            __builtin_amdgcn_fence(__ATOMIC_RELEASE, "agent");
            asm volatile("s_waitcnt vmcnt(0)" ::: "memory");
            const unsigned og = xb_add(&bar[XB_TOP], 1u);
            const unsigned tg = og / nx;
            if (og + 1u == (tg + 1u) * nx) xb_add(&bar[XB_TOPGEN], 1u);
            else XB_SPIN(xb_ld(&bar[XB_TOPGEN]) == tg, bar);
            __builtin_amdgcn_fence(__ATOMIC_ACQUIRE, "agent");
            xb_add(&bar[XB_XGEN(b.x)], 1u);
            asm volatile("s_waitcnt vmcnt(0)" ::: "memory");
        } else {
            XB_SPIN(xb_ld(&bar[XB_XGEN(b.x)]) == gen, bar);
            __builtin_amdgcn_fence(__ATOMIC_ACQUIRE, "agent");
            asm volatile("s_waitcnt vmcnt(0)" ::: "memory");
        }
    }
    __syncthreads();
}

__device__ __forceinline__ float bf2f(unsigned short b) { return __builtin_bit_cast(float, (unsigned)b << 16); }
__device__ __forceinline__ float bf2f(short b) { return __builtin_bit_cast(float, (unsigned)(unsigned short)b << 16); }
template <int CTRL> __device__ __forceinline__ float dpp_perm(float v) { return __builtin_bit_cast(float, __builtin_amdgcn_update_dpp(0, __builtin_bit_cast(int, v), CTRL, 0xF, 0xF, true)); }
__device__ __forceinline__ float row16_sum(float v) {
    v += dpp_perm<0xB1>(v); v += dpp_perm<0x4E>(v); v += dpp_perm<0x141>(v); v += dpp_perm<0x140>(v); return v;
}
__device__ __forceinline__ float wave_sum(float v) {
    v += dpp_perm<0xB1>(v);
    v += dpp_perm<0x4E>(v);
    v += dpp_perm<0x141>(v);
    v += dpp_perm<0x140>(v);
    const int b = __builtin_bit_cast(int, v);
    const float s0 = __builtin_bit_cast(float, __builtin_amdgcn_readlane(b, 0)), s1 = __builtin_bit_cast(float, __builtin_amdgcn_readlane(b, 16)),
                s2 = __builtin_bit_cast(float, __builtin_amdgcn_readlane(b, 32)), s3 = __builtin_bit_cast(float, __builtin_amdgcn_readlane(b, 48));
    return (s0 + s1) + (s2 + s3);
}
__device__ __forceinline__ float wave_max(float v) {
#pragma unroll
    for (int o = 1; o < 64; o <<= 1) v = fmaxf(v, __shfl_xor(v, o));
    return v;
}
__device__ __forceinline__ float fast_exp(float x) { return __builtin_amdgcn_exp2f(x * 1.4426950408889634f); }
__device__ __forceinline__ float sigmoidf_(float x) { return __builtin_amdgcn_rcpf(1.f + fast_exp(-x)); }
__device__ __forceinline__ float gelu_tanh(float x) {
    const float z = 0.7978845608028654f * (x + 0.044715f * x * x * x);
    return x * sigmoidf_(2.f * z);
}
__device__ __forceinline__ float neg_expm1(float x) {
    const float p = x * (1.f + x * (0.5f + x * (0.16666667f + x * (0.041666668f + x * (0.0083333338f + x * 0.0013888889f)))));
    const float e = fast_exp(x) - 1.f;
    return -(fabsf(x) < 0.25f ? p : e);
}
__device__ __forceinline__ v4u pack8(const float (&v)[8]) { v4u o; o.x = pk2(v[0], v[1]); o.y = pk2(v[2], v[3]); o.z = pk2(v[4], v[5]); o.w = pk2(v[6], v[7]); return o; }

#define FIN(F, idx) ({ const __attribute__((address_space(1))) float* p_; asm("s_load_dwordx2 %0, %1, %2 ; tag %3\n\ts_waitcnt lgkmcnt(0)" : "=s"(p_) : "s"((F).kargs), "i"((idx) * 8), "s"((F).ptag)); (const float*)p_; })
struct Frame {
    LAS unsigned char* lds;
    volatile LAS unsigned* MISC;
    gu32* ctl;
    int tid, lane, wave, vcu, G;
    const __attribute__((address_space(4))) void* kargs; int ptag;
    float* out;
    unsigned char* ws;
#define WSP(T, NAME, OFF) __device__ __forceinline__ T* NAME() const { return (T*)(ws + (OFF)); }
    WSP(bf16, WIN_T, WS_WIN) WSP(bf16, WOUT_T, WS_WOUT) WSP(bf16, WUP_T, WS_WUP) WSP(bf16, WDOWN_T, WS_WDOWN) WSP(bf16, WG, WS_WG) WSP(bf16, XN, WS_A) WSP(bf16, QG, WS_QG) WSP(bf16, K, WS_K) WSP(bf16, V, WS_V)
    WSP(bf16, XR, WS_XR) WSP(bf16, ACT, WS_ACT) WSP(bf16, H1A, WS_H1A) WSP(bf16, EDGE, WS_EDGE) WSP(bf16, XNMETA, WS_XNMETA) WSP(bf16, KM, WS_KM) WSP(bf16, VM, WS_VM)
    WSP(float, ZM, WS_ZM) WSP(float, Q15, WS_Q15) WSP(float, GY15, WS_GY15) WSP(float, LO15, WS_LO15) WSP(float, MIXED15, WS_MIXED15) WSP(float, Y15, WS_Y15) WSP(bf16, G15, WS_G15) WSP(float, MQP, WS_MQP)
    WSP(float, CIN, WS_CIN) WSP(float2, CAR, WS_CAR) WSP(float, R0, WS_R0) WSP(float, RATIO, WS_RATIO) WSP(float, RL, WS_RL) WSP(float, SSQA, WS_SSQA) WSP(float, SSQL, WS_SSQL)
#undef WSP
};

template <bool UPMAP, int GAIN = 0>
__device__ __forceinline__ void p0_transpose_item(const float* W, int K, int N, bf16* WT, int row_off, LAS float* scr, int item, int lane, const float* g0 = nullptr, const float* g1 = nullptr) {
    const int nblk = N / 32, kb = item / nblk, nb = item % nblk, k0 = 64 * kb, n0 = 32 * nb;
    const int orow0 = UPMAP ? (((n0 % FFN) >> 7) << 8) + 128 * (n0 / FFN) + ((n0 % FFN) & 127) : row_off + n0;
    float wv[32];
#pragma unroll
    for (int i = 0; i < 32; ++i) { const int kk = 2 * i + (lane >> 5); wv[i] = W[(size_t)(k0 + kk) * N + n0 + (lane & 31)]; }
#pragma unroll
    for (int i = 0; i < 32; ++i) { const int kk = 2 * i + (lane >> 5); float gv = 1.f; if (GAIN == 1) gv = g0[k0 + kk]; if (GAIN == 2) gv = (k0 + kk) < 1024 ? g0[k0 + kk] : g1[k0 + kk - 1024];
        scr[kk * 33 + (lane & 31)] = wv[i] * gv; }
    LDS_WAIT(); asm volatile("" ::: "memory");
    const int c = lane & 7;
#pragma unroll
    for (int j = 0; j < 4; ++j) { const int n = (lane >> 3) + 8 * j; const LAS float* s = scr + (8 * c) * 33 + n;
        v4u o; o.x = pk2(s[0 * 33], s[1 * 33]); o.y = pk2(s[2 * 33], s[3 * 33]); o.z = pk2(s[4 * 33], s[5 * 33]); o.w = pk2(s[6 * 33], s[7 * 33]);
        *(GAS v4u*)(WT + (size_t)(orow0 + n) * K + k0 + 8 * c) = o; }
    LDS_WAIT(); asm volatile("" ::: "memory");
}
__device__ __forceinline__ void rms_row_to_bf16(const float* xrow, bf16* orow, int lane, float* rout) {
    const GAS f32x4* xr = (const GAS f32x4*)xrow + lane;
    f32x4 v[8]; float s = 0.f;
#pragma unroll
    for (int j = 0; j < 8; ++j) { v[j] = xr[64 * j]; s += (v[j].x * v[j].x + v[j].y * v[j].y) + (v[j].z * v[j].z + v[j].w * v[j].w); }
    const float r = 1.f / sqrtf(wave_sum(s) * (1.f / DM) + EPS);
    GAS unsigned long long* o8 = (GAS unsigned long long*)orow + lane;
#pragma unroll
    for (int j = 0; j < 8; ++j) o8[64 * j] = (unsigned long long)pk2(v[j].x * r, v[j].y * r) | ((unsigned long long)pk2(v[j].z * r, v[j].w * r) << 32);
    if (rout && lane == 0) *rout = r;
}
constexpr int WT_I_IN = (DM / 64) * (INW / 32), WT_I_OUT = (DM / 64) * (DM / 32), WT_I_UP = (DM / 64) * (UPW / 32), WT_I_DN = (FFN / 64) * (DM / 32), WT_I_G = 32 * 8;
constexpr int WT_O_OUT = WT_I_IN, WT_O_UP = WT_O_OUT + WT_I_OUT, WT_O_DN = WT_O_UP + WT_I_UP, WT_O_G = WT_O_DN + WT_I_DN, WT_NITEMS = WT_O_G + WT_I_G;
__device__ __forceinline__ void wt_items(Frame& F, int it0, int it1, int gw, int NGW) {
    LAS float* scr = (LAS float*)(F.lds + F.wave * 16384);
    for (int it = it0 + gw; it < it1; it += NGW) {
        int r = it;
        if (r < WT_I_IN) { p0_transpose_item<false, 1>(FIN(F, 4  ), DM, INW, F.WIN_T(), 0, scr, r, F.lane, FIN(F, 3  )); continue; } r -= WT_I_IN;
        if (r < WT_I_OUT) { p0_transpose_item<false, 2>(FIN(F, 16  ), DM, DM, F.WOUT_T(), 0, scr, r, F.lane, FIN(F, 14  ), FIN(F, 15  )); continue; } r -= WT_I_OUT;
        if (r < WT_I_UP) { p0_transpose_item<true>(FIN(F, 19  ), DM, UPW, F.WUP_T(), 0, scr, r, F.lane); continue; } r -= WT_I_UP;
        if (r < WT_I_DN) { p0_transpose_item<false>(FIN(F, 22  ), FFN, DM, F.WDOWN_T(), 0, scr, r, F.lane); continue; } r -= WT_I_DN;
        {
            const int mi = r >> 3, sub = r & 7, gate = mi >> 4, dir = (mi >> 3) & 1, blk = mi & 7;
            const float* W = (gate ? FIN(F, 11  ) : FIN(F, 9  )) + (size_t)(dir * 8 + blk) * 16384;
            bf16* WT = F.WG() + (size_t)((dir * 2 + gate) * 8 + blk) * 16384;
            p0_transpose_item<false>(W, 128, 128, WT, 0, scr, sub, F.lane);
        }
    }
}
__device__ __forceinline__ void p0_prologue(Frame& F) {
    const int gw = F.vcu * NWAVES + F.wave, NGW = F.G * NWAVES;
    wt_items(F, 0, WT_O_OUT, gw, NGW);
    wt_items(F, WT_O_G, WT_NITEMS, gw, NGW);
    {
        const float* xp = FIN(F, 0  ); const float* xs = FIN(F, 1  ); const int lane = F.lane;
        f32x4 v[8], vn[8];
#define P0_LOAD(M, V) do { const GAS f32x4* xr_ = (const GAS f32x4*)((M) < 32768 ? xp + (size_t)(M) * DM : xs + (size_t)((M) - 32768) * DM) + lane; \
            _Pragma("unroll") for (int j_ = 0; j_ < 8; ++j_) V[j_] = xr_[64 * j_]; } while (0)
        int m = gw;
        if (m < NTOK) P0_LOAD(m, v);
        asm volatile("" : "+v"(v[0]), "+v"(v[1]), "+v"(v[2]), "+v"(v[3]), "+v"(v[4]), "+v"(v[5]), "+v"(v[6]), "+v"(v[7]) :: "memory");
        for (; m < NTOK; m += NGW) {
            const int mn = m + NGW < NTOK ? m + NGW : m;
            P0_LOAD(mn, vn);
            float s = 0.f;
#pragma unroll
            for (int j = 0; j < 8; ++j) s += (v[j].x * v[j].x + v[j].y * v[j].y) + (v[j].z * v[j].z + v[j].w * v[j].w);
            const float r = __builtin_amdgcn_rsqf(wave_sum(s) * (1.f / DM) + EPS);
            GAS unsigned long long* o8 = (GAS unsigned long long*)(F.XN() + (size_t)m * DM) + lane;
#pragma unroll
            for (int j = 0; j < 8; ++j) o8[64 * j] = (unsigned long long)pk2(v[j].x * r, v[j].y * r) | ((unsigned long long)pk2(v[j].z * r, v[j].w * r) << 32);
            if (lane == 0) F.R0()[m] = r;
            asm volatile("" : "+v"(vn[0]), "+v"(vn[1]), "+v"(vn[2]), "+v"(vn[3]), "+v"(vn[4]), "+v"(vn[5]), "+v"(vn[6]), "+v"(vn[7]) :: "memory");
#pragma unroll
            for (int j = 0; j < 8; ++j) v[j] = vn[j];
        }
#undef P0_LOAD
    }
    for (int m = gw; m < 16; m += NGW) rms_row_to_bf16(FIN(F, 2  ) + (size_t)m * DM, F.XNMETA() + (size_t)m * DM, F.lane, nullptr);
    const int gt = F.vcu * 512 + F.tid, NGT = F.G * 512; const v4u z4 = {0u, 0u, 0u, 0u};
    for (int i = gt; i < 12 * 48 * 128; i += NGT) { const int s = i / (48 * 128), rem = i % (48 * 128); ((GAS v4u*)(F.XR() + (size_t)xr_base(s) * 1024))[rem] = z4; }
    for (int i = gt; i < 64 * 128; i += NGT) ((GAS v4u*)(F.XR() + (size_t)XR_ROWS * 1024))[i] = z4;
    for (int i = gt; i < 2048; i += NGT) { ((GAS v4u*)F.KM())[i] = z4; ((GAS v4u*)F.VM())[i] = z4; }
}

template <int R, class Out, bool GMAP = false>
__device__ __forceinline__ void small_gemm(const LAS float* X, int K, const bf16* Wt, int N, int gw, int NGW, int lane, const Out& out) {
    for (int n = gw; n < N; n += NGW) {
        float acc[R];
#pragma unroll
        for (int r = 0; r < R; ++r) acc[r] = 0.f;
        const GAS bf16x8* wrow = (const GAS bf16x8*)(Wt + (size_t)(GMAP ? ((n >> 7) << 8) + (n & 127) : n) * K);
        bf16x8 wq[4];
#pragma unroll
        for (int q = 0; q < 4; ++q) wq[q] = wrow[lane + 64 * q];
#pragma unroll
        for (int q = 0; q < 4; ++q) { const int k8 = lane + 64 * q;
            asm volatile("" ::: "memory");
            const bf16x8 w = wq[q]; float wf[8];
#pragma unroll
            for (int j = 0; j < 8; ++j) wf[j] = bf2f(w[j]);
#pragma unroll
            for (int r = 0; r < R; ++r) { const LAS f32x4* xp = (const LAS f32x4*)(X + r * K + k8 * 8); const f32x4 a = xp[0], b = xp[1];
                acc[r] += (a.x * wf[0] + a.y * wf[1]) + (a.z * wf[2] + a.w * wf[3]) + (b.x * wf[4] + b.y * wf[5]) + (b.z * wf[6] + b.w * wf[7]); }
        }
        float v = 0.f;
#pragma unroll
        for (int r = 0; r < R; ++r) { const float s = wave_sum(acc[r]); v = (lane == r) ? s : v; }
        out(n, lane, v);
    }
}
struct OutMetaZ { float* ZM; bf16* XR;
    __device__ __forceinline__ void operator()(int n, int lane, float v) const {
        if (lane < 16) { ZM[lane * INW + n] = v;
            if (n >= 1536 && n < 2560) { const unsigned short b = (unsigned short)f2bf(v); const int c = n - 1536;
                for (int s = 0; s < 12; ++s) XR[(size_t)(xr_base(s) + 48 + lane) * 1024 + c] = b; } }
    } };
struct OutRows { float* Y; int ld; int R;
    __device__ __forceinline__ void operator()(int n, int lane, float v) const { if (lane < R) Y[(size_t)lane * ld + n] = v; } };
struct OutRowsB { bf16* Y; int ld; int R;
    __device__ __forceinline__ void operator()(int n, int lane, float v) const { if (lane < R) Y[(size_t)lane * ld + n] = (bf16)f2bf(v); } };

template <bool GMAP, class XF, class Out>
__device__ __forceinline__ void side_gemm16(Frame& F, const XF& xf, const bf16* Wt, int ntiles, LAS float* part, const Out& out) {
    const int lane = F.lane, c = lane & 15, g = lane >> 4, w = F.wave, tid = F.tid;
    for (int t = F.vcu; t < ntiles; t += F.G) {
        const int n0 = t * 16, wrow = GMAP ? ((n0 >> 7) << 8) + (n0 & 127) : n0;
        const bf16* wp = Wt + (size_t)(wrow + c) * DM + w * 256 + 8 * g;
        bf16x8 bq[8], aq[8];
#pragma unroll
        for (int ks = 0; ks < 8; ++ks) { bq[ks] = *(const GAS bf16x8*)(wp + 32 * ks); aq[ks] = xf(c, w * 256 + 32 * ks + 8 * g); }
        f32x4 acc = {0.f, 0.f, 0.f, 0.f};
#pragma unroll
        for (int ks = 0; ks < 8; ++ks) acc = __builtin_amdgcn_mfma_f32_16x16x32_bf16(aq[ks], bq[ks], acc, 0, 0, 0);
        *(LAS f32x4*)(part + (w * 64 + lane) * 4) = acc;
        __syncthreads();
        if (tid < 256) { const int row = tid >> 4, n = tid & 15; float v = 0.f;
#pragma unroll
            for (int ww = 0; ww < 8; ++ww) v += part[(ww * 64 + (row >> 2) * 16 + n) * 4 + (row & 3)];
            out(n0 + n, row, v); }
        __syncthreads();
    }
}
__device__ __forceinline__ void p1_meta_z(Frame& F) {
    const bf16* xm = F.XNMETA();
    const auto xf = [xm](int c, int k) { return *(const GAS bf16x8*)(xm + c * DM + k); };
    const OutMetaZ o{F.ZM(), F.XR()};
    side_gemm16<false>(F, xf, F.WIN_T(), INW / 16, (LAS float*)F.lds, o);
}
typedef float f32x16 __attribute__((ext_vector_type(16)));
typedef float f32x2 __attribute__((ext_vector_type(2)));
constexpr int LRU_XC0 = 0, LRU_XC_BUF = 17408, LRU_XC_STRIDE = 272;
constexpr int LRU_CW = 34816;
constexpr int LRU_HF = 37376, LRU_HB = LRU_HF + 32768;
__device__ __forceinline__ int crow16(int r, int hi) { return (r & 3) + 8 * (r >> 2) + 4 * hi; }

template <int DIR>
__device__ __forceinline__ void scan_tile(const float (&a)[16], const float (&u)[16], float& carry, float& ptot, float (&h)[16], bool up) {
    float HL[16], PL[16], As[4], Hs[4];
#pragma unroll
    for (int j = 0; j < 4; ++j) {
        float hl = 0.f, p = 1.f;
#pragma unroll
        for (int ii = 0; ii < 4; ++ii) { const int idx = 4 * j + (DIR == 0 ? ii : 3 - ii); hl = a[idx] * hl + u[idx]; p *= a[idx]; HL[idx] = hl; PL[idx] = p; }
        As[j] = p; Hs[j] = hl;
    }
    float Alo[4], Ahi[4], Hlo[4], Hhi[4];
#pragma unroll
    for (int j = 0; j < 4; ++j) {
        { const unsigned x = __float_as_uint(As[j]); auto rr = __builtin_amdgcn_permlane32_swap(x, x, false, false); Alo[j] = __uint_as_float(rr[0]); Ahi[j] = __uint_as_float(rr[1]); }
        { const unsigned x = __float_as_uint(Hs[j]); auto rr = __builtin_amdgcn_permlane32_swap(x, x, false, false); Hlo[j] = __uint_as_float(rr[0]); Hhi[j] = __uint_as_float(rr[1]); }
    }
    float cin[4]; float c = carry;
    if (DIR == 0) {
#pragma unroll
        for (int j = 0; j < 4; ++j) { const float c_lo = c; c = Alo[j] * c + Hlo[j]; const float c_hi = c; c = Ahi[j] * c + Hhi[j]; cin[j] = up ? c_hi : c_lo; }
    } else {
#pragma unroll
        for (int j = 3; j >= 0; --j) { const float c_hi = c; c = Ahi[j] * c + Hhi[j]; const float c_lo = c; c = Alo[j] * c + Hlo[j]; cin[j] = up ? c_hi : c_lo; }
    }
    carry = c;
#pragma unroll
    for (int j = 0; j < 4; ++j) ptot *= Alo[j] * Ahi[j];
#pragma unroll
    for (int idx = 0; idx < 16; ++idx) h[idx] = HL[idx] + PL[idx] * cin[idx >> 2];
}

__device__ __forceinline__ void lru_decode(int cg, int& seq, int& c) { if (cg < 520) { seq = cg / 65; c = cg - seq * 65; } else { const int c2 = cg - 520; seq = c2 / 129; c = c2 - seq * 129; seq += 8; } }
template <int PASS>
__device__ __forceinline__ void lru_phase(Frame& F, bf16* gout) {
    LAS unsigned char* L = F.lds;
    const int tid = F.tid, lane = F.lane, wave = F.wave;
    const int n = F.vcu & 7, ngrp = F.G >> 3;
    { const float* cw = FIN(F, 7  ); const float* cb = FIN(F, 8  );
      for (int i = tid; i < 640; i += 512) { const int k = i >> 7, ch = i & 127; ((LAS float*)(L + LRU_CW))[i] = k < 4 ? cw[k * 1024 + n * 128 + ch] : cb[n * 128 + ch]; } }
    const int d = wave >> 2, g4 = wave & 3, r32 = lane & 31, hi = lane >> 5, chl = g4 * 32 + r32, chg = n * 128 + chl;
    bf16x8 br[8], bi[8];
    { const bf16* wr_ = F.WG() + (size_t)((d * 2 + 0) * 8 + n) * 16384 + chl * 128 + hi * 8;
      const bf16* wi_ = F.WG() + (size_t)((d * 2 + 1) * 8 + n) * 16384 + chl * 128 + hi * 8;
#pragma unroll
      for (int ks = 0; ks < 8; ++ks) { br[ks] = *(const GAS bf16x8*)(wr_ + ks * 16); bi[ks] = *(const GAS bf16x8*)(wi_ + ks * 16); } }
    constexpr float L2E = 1.4426950408889634f;
    const float nb_r = -L2E * FIN(F, 10  )[d * 1024 + chg], nb_i = -L2E * FIN(F, 12  )[d * 1024 + chg];
    const float spl = 8.f * L2E * log1pf(expf(-FIN(F, 13  )[d * 1024 + chg]));
    const int tau0 = tid >> 4, co = (tid & 15) * 8;
    bf16x8 xv[2][4];
#define LRU_PREFETCH(cgx) do { int s_, c_; lru_decode((cgx), s_, c_); const int xb_ = xr_base(s_); \
        _Pragma("unroll") for (int it_ = 0; it_ < 2; ++it_) _Pragma("unroll") for (int k_ = 0; k_ < 4; ++k_) { int row_ = xb_ + c_ * 64 + tau0 + 32 * it_ + k_ - 2; row_ = row_ < 0 ? 0 : row_; \
            xv[it_][k_] = *(const GAS bf16x8*)(F.XR() + (size_t)row_ * 1024 + n * 128 + co); } } while (0)
    int cg = F.vcu < 8 * ngrp ? F.vcu >> 3 : NCHUNK;
    if (cg < NCHUNK) LRU_PREFETCH(cg);
    __syncthreads();
    for (int ui = 0; cg < NCHUNK; cg += ngrp, ++ui) {
        int seq, c; lru_decode(cg, seq, c);
        LAS unsigned char* XC = L + LRU_XC0 + (ui & 1) * LRU_XC_BUF;
        float carry = 0.f, ptot = 1.f;
        if (PASS == 2) carry = F.CIN()[((size_t)cg * 2 + d) * 1024 + chg];
#pragma unroll
        for (int it = 0; it < 2; ++it) {
            const int tau = tau0 + 32 * it; float xc[8];
            { const LAS f32x4* cb = (const LAS f32x4*)(L + LRU_CW + (4 * 128 + co) * 4); const f32x4 b0 = cb[0], b1 = cb[1];
              xc[0] = b0.x; xc[1] = b0.y; xc[2] = b0.z; xc[3] = b0.w; xc[4] = b1.x; xc[5] = b1.y; xc[6] = b1.z; xc[7] = b1.w; }
#pragma unroll
            for (int k = 0; k < 4; ++k) { const LAS f32x4* wp = (const LAS f32x4*)(L + LRU_CW + (k * 128 + co) * 4); const f32x4 w0 = wp[0], w1 = wp[1]; const bf16x8 v = xv[it][k];
                xc[0] += w0.x * bf2f(v[0]); xc[1] += w0.y * bf2f(v[1]); xc[2] += w0.z * bf2f(v[2]); xc[3] += w0.w * bf2f(v[3]);
                xc[4] += w1.x * bf2f(v[4]); xc[5] += w1.y * bf2f(v[5]); xc[6] += w1.z * bf2f(v[6]); xc[7] += w1.w * bf2f(v[7]); }
            if (c == 0 && tau < 48) {
#pragma unroll
                for (int j = 0; j < 8; ++j) xc[j] = 0.f;
            }
            *(LAS v4u*)(XC + tau * LRU_XC_STRIDE + co * 2) = pack8(xc);
        }
        bf16x8 gv[2];
        const int row0 = seq_first_row(seq) + 64 * (c - 1);
        if (PASS == 2) { if (c > 0) {
#pragma unroll
            for (int it = 0; it < 2; ++it) gv[it] = *(const GAS bf16x8*)(F.QG() + (size_t)(row0 + tau0 + 32 * it) * DM + 1024 + n * 128 + co); } }
        __syncthreads();
        if (cg + ngrp < NCHUNK) LRU_PREFETCH(cg + ngrp);
        f32x16 arT[2], aiT[2];
#pragma unroll
        for (int tt = 0; tt < 2; ++tt) {
            const int tile = d ? 1 - tt : tt;
            f32x16 ar = {}, ai = {};
#pragma unroll
            for (int ks = 0; ks < 8; ++ks) {
                const bf16x8 a = *(const LAS bf16x8*)(XC + (tile * 32 + r32) * LRU_XC_STRIDE + (ks * 16 + hi * 8) * 2);
                ar = __builtin_amdgcn_mfma_f32_32x32x16_bf16(a, br[ks], ar, 0, 0, 0);
                ai = __builtin_amdgcn_mfma_f32_32x32x16_bf16(a, bi[ks], ai, 0, 0, 0);
            }
            arT[tt] = ar; aiT[tt] = ai;
        }
#pragma unroll
        for (int tt = 0; tt < 2; ++tt) {
            const int tile = d ? 1 - tt : tt;
            const f32x16 ar = arT[tt], ai = aiT[tt];
            float av[16], uv[16], hv[16];
#pragma unroll
            for (int r = 0; r < 16; r += 2) {
                const int tau0_ = tile * 32 + crow16(r, hi);
                const f32x2 xc2 = {bf2f(*(const LAS unsigned short*)(XC + tau0_ * LRU_XC_STRIDE + chl * 2)), bf2f(*(const LAS unsigned short*)(XC + (tau0_ + 1) * LRU_XC_STRIDE + chl * 2))};
                const f32x2 tr = (f32x2){ar[r], ar[r + 1]} * (f32x2){-L2E, -L2E} + (f32x2){nb_r, nb_r};
                const f32x2 ti = (f32x2){ai[r], ai[r + 1]} * (f32x2){-L2E, -L2E} + (f32x2){nb_i, nb_i};
                const f32x2 dr = (f32x2){__builtin_amdgcn_exp2f(tr.x), __builtin_amdgcn_exp2f(tr.y)} + (f32x2){1.f, 1.f};
                const f32x2 di = (f32x2){__builtin_amdgcn_exp2f(ti.x), __builtin_amdgcn_exp2f(ti.y)} + (f32x2){1.f, 1.f};
                const f32x2 rg = {__builtin_amdgcn_rcpf(dr.x), __builtin_amdgcn_rcpf(dr.y)}, ig = {__builtin_amdgcn_rcpf(di.x), __builtin_amdgcn_rcpf(di.y)};
                const f32x2 la = rg * (f32x2){-spl, -spl};
                const f32x2 a = {__builtin_amdgcn_exp2f(la.x), __builtin_amdgcn_exp2f(la.y)};
                const f32x2 t = (f32x2){1.f, 1.f} - a * a;
                const f32x2 m = {__builtin_amdgcn_sqrtf(t.x), __builtin_amdgcn_sqrtf(t.y)};
                const f32x2 u = m * (ig * xc2);
                av[r] = a.x; av[r + 1] = a.y; uv[r] = u.x; uv[r + 1] = u.y;
            }
            if (d == 0) scan_tile<0>(av, uv, carry, ptot, hv, hi != 0); else scan_tile<1>(av, uv, carry, ptot, hv, hi != 0);
            if (PASS == 2) {
#pragma unroll
                for (int r = 0; r < 16; ++r) { const int tau = tile * 32 + crow16(r, hi); *(LAS float*)(L + (d ? LRU_HB : LRU_HF) + (tau * 128 + chl) * 4) = hv[r]; }
            }
        }
        if (PASS == 1) { if (hi == 0) F.CAR()[((size_t)cg * 2 + d) * 1024 + chg] = make_float2(ptot, carry); }
        if (PASS == 2) {
            __syncthreads();
            if (c > 0) {
#pragma unroll
                for (int it = 0; it < 2; ++it) {
                    const int tau = tau0 + 32 * it; const v4u gq = __builtin_bit_cast(v4u, gv[it]);
                    const LAS f32x4* hf = (const LAS f32x4*)(L + LRU_HF + (tau * 128 + co) * 4); const LAS f32x4* hb = (const LAS f32x4*)(L + LRU_HB + (tau * 128 + co) * 4);
                    const f32x4 f0 = hf[0], f1 = hf[1], b0 = hb[0], b1 = hb[1];
                    const f32x2 hs[4] = {(f32x2){f0.x, f0.y} + (f32x2){b0.x, b0.y}, (f32x2){f0.z, f0.w} + (f32x2){b0.z, b0.w}, (f32x2){f1.x, f1.y} + (f32x2){b1.x, b1.y}, (f32x2){f1.z, f1.w} + (f32x2){b1.z, b1.w}};
                    const unsigned gw_[4] = {gq.x, gq.y, gq.z, gq.w};
                    const f32x2 C1 = {-2.302208198f, -2.302208198f}, C2 = {-0.1029432452f, -0.1029432452f};
                    unsigned ow[4]; f32x2 sq2 = {0.f, 0.f};
#pragma unroll
                    for (int pp = 0; pp < 4; ++pp) { const f32x2 x2 = {__builtin_bit_cast(float, gw_[pp] << 16), __builtin_bit_cast(float, gw_[pp] & 0xffff0000u)};
                        const f32x2 a2 = x2 * ((x2 * x2) * C2 + C1);
                        const f32x2 d2 = (f32x2){__builtin_amdgcn_exp2f(a2.x), __builtin_amdgcn_exp2f(a2.y)} + (f32x2){1.f, 1.f};
                        const f32x2 o2 = hs[pp] * (x2 * (f32x2){__builtin_amdgcn_rcpf(d2.x), __builtin_amdgcn_rcpf(d2.y)});
                        ow[pp] = pk2(o2.x, o2.y); sq2 = o2 * o2 + sq2; }
                    v4u ov; ov.x = ow[0]; ov.y = ow[1]; ov.z = ow[2]; ov.w = ow[3];
                    *(GAS v4u*)(gout + (size_t)(row0 + tau) * DM + 1024 + n * 128 + co) = ov;
                    float sq = sq2.x + sq2.y;
                    sq = row16_sum(sq);
                    if ((tid & 15) == 0) F.SSQL()[(size_t)(row0 + tau) * 8 + n] = sq;
                }
            } else if (tid < 128) {
                const float hf = *(const LAS float*)(L + LRU_HF + (63 * 128 + tid) * 4), hb = *(const LAS float*)(L + LRU_HB + (63 * 128 + tid) * 4);
                F.LO15()[seq * 1024 + n * 128 + tid] = (hf + hb) * gelu_tanh(F.GY15()[n * 128 + tid]);
            }
        }
    }
    __syncthreads();
#undef LRU_PREFETCH
}
__device__ __forceinline__ void lru_propagate(Frame& F) {
    const int gid = F.vcu * 512 + F.tid;
    if (gid < 12 * 2048) {
        const int s = gid >> 11, d = (gid >> 10) & 1, ch = gid & 1023; const int nch = s < 8 ? 65 : 129, cb = chunk_base(s);
        const float2* car = F.CAR() + (size_t)d * 1024 + ch; float* cinp = F.CIN() + (size_t)d * 1024 + ch;
        float cin = 0.f;
        float2 pa[16], pb[16];
#define PRP_LOAD(P, B0) do { _Pragma("unroll") for (int i = 0; i < 16; ++i) { int cc = (B0) + i; cc = cc < nch ? cc : nch - 1; const int c = d ? nch - 1 - cc : cc; P[i] = car[(size_t)(cb + c) * 2048]; } } while (0)
#define PRP_RUN(P, B0) do { _Pragma("unroll") for (int i = 0; i < 16; ++i) { const int cc = (B0) + i; const int c = d ? nch - 1 - cc : cc; if (cc < nch) { cinp[(size_t)(cb + c) * 2048] = cin; cin = P[i].x * cin + P[i].y; } } } while (0)
        PRP_LOAD(pa, 0);
        for (int b0 = 0; b0 < nch; b0 += 32) {
            PRP_LOAD(pb, b0 + 16);
            PRP_RUN(pa, b0);
            PRP_LOAD(pa, b0 + 32);
            PRP_RUN(pb, b0 + 16);
        }
#undef PRP_LOAD
#undef PRP_RUN
    }
}

__device__ __forceinline__ void k_rope_pass(Frame& F, bf16* Kout, int gw, int NGW) {
    const int sub = F.lane >> 4, l16 = F.lane & 15;
    const int c0 = 8 * l16, p = l16 >> 3, half = (l16 >> 2) & 1, i0 = 8 * (l16 & 3);
    float inv[8], gk[8];
#pragma unroll
    for (int j = 0; j < 8; ++j) { inv[j] = __builtin_amdgcn_exp2f(-(float)(i0 + j) * (13.287712379549449f / 32.f)) * 0.15915494309189535f; gk[j] = FIN(F, 6  )[c0 + j]; }
    constexpr int NIT = NTOK * 2 / 4;
    bf16x8 v, vn;
    if (gw < NIT) { const int item = gw * 4 + sub; v = *(const GAS bf16x8*)(F.K() + (size_t)(item >> 1) * 256 + (item & 1) * 128 + c0); }
    for (int it = gw; it < NIT; it += NGW) {
        const int item = it * 4 + sub, row = item >> 1, hk = item & 1;
        { const int nit = it + NGW < NIT ? it + NGW : it; const int ni = nit * 4 + sub; vn = *(const GAS bf16x8*)(F.K() + (size_t)(ni >> 1) * 256 + (ni & 1) * 128 + c0); }
        const int s = row_seq(row), t = row - seq_first_row(s); const float pos = (float)(p ? (t & 63) : (t >> 6));
        float x[8]; float ss = 0.f;
#pragma unroll
        for (int j = 0; j < 8; ++j) { x[j] = bf2f(v[j]); ss += x[j] * x[j]; }
        ss = row16_sum(ss);
        const float rs = __builtin_amdgcn_rsqf(ss * (1.f / 128.f) + EPS); float o[8];
#pragma unroll
        for (int j = 0; j < 8; ++j) { x[j] *= rs * gk[j]; const float pr = __shfl_xor(x[j], 4);
            float rev = pos * inv[j]; rev -= floorf(rev); const float sn = __builtin_amdgcn_sinf(rev), cs = __builtin_amdgcn_cosf(rev);
            o[j] = half ? x[j] * cs + pr * sn : x[j] * cs - pr * sn; }
        *(GAS v4u*)(Kout + (size_t)row * 256 + hk * 128 + c0) = pack8(o);
        v = vn;
    }
}
__device__ __forceinline__ void p3_meta_job(Frame& F) {
    for (int pr = F.wave; pr < 32; pr += 8) { const int r = pr >> 1, hk = pr & 1; const float* z = F.ZM() + r * INW + 1024 + hk * 128;
        const float a = z[F.lane], b = z[F.lane + 64]; const float rs = 1.f / sqrtf(wave_sum(a * a + b * b) * (1.f / 128.f) + EPS);
        F.KM()[r * 256 + hk * 128 + F.lane] = (bf16)f2bf(a * rs * FIN(F, 6  )[F.lane]); F.KM()[r * 256 + hk * 128 + F.lane + 64] = (bf16)f2bf(b * rs * FIN(F, 6  )[F.lane + 64]); }
    for (int i = F.tid; i < 16 * 256; i += 512) F.VM()[i] = (bf16)f2bf(F.ZM()[(i >> 8) * INW + 1280 + (i & 255)]);
    { const int h = F.wave; const float* z = F.ZM() + 15 * INW + h * 128; const float a = z[F.lane], b = z[F.lane + 64];
      const float rs = 1.f / sqrtf(wave_sum(a * a + b * b) * (1.f / 128.f) + EPS);
      F.Q15()[h * 128 + F.lane] = a * rs * FIN(F, 5  )[F.lane]; F.Q15()[h * 128 + F.lane + 64] = b * rs * FIN(F, 5  )[F.lane + 64]; }
    for (int i = F.tid; i < 1024; i += 512) F.GY15()[i] = F.ZM()[15 * INW + 2560 + i];
}

__device__ __forceinline__ void metaq_item(Frame& F, int it) {
    int s, kvh, j; if (it < 256) { s = it >> 5; kvh = (it >> 4) & 1; j = it & 15; } else { const int t2 = it - 256; s = 8 + (t2 >> 6); kvh = (t2 >> 5) & 1; j = t2 & 31; }
    LAS float* q4 = (LAS float*)F.lds;
    LAS float* sc = q4 + 512;
    LAS float* red = sc + 4 * 288;
    const int tid = F.tid, nk = 256 + (j == 0 ? 16 : 0), row0 = seq_first_row(s) + 256 * j;
    q4[tid] = F.Q15()[kvh * 512 + tid];
    __syncthreads();
    if (tid < nk) {
        const bf16* kp = tid < 256 ? F.K() + (size_t)(row0 + tid) * 256 + kvh * 128 : F.KM() + (tid - 256) * 256 + kvh * 128;
        float d0 = 0.f, d1 = 0.f, d2 = 0.f, d3 = 0.f;
        bf16x8 kq[16];
#pragma unroll
        for (int cc = 0; cc < 16; ++cc) kq[cc] = ((const GAS bf16x8*)kp)[cc];
#pragma unroll
        for (int cc = 0; cc < 16; ++cc) { const bf16x8 kv = kq[cc];
#pragma unroll
            for (int e = 0; e < 8; ++e) { const float kf = bf2f(kv[e]); d0 += kf * q4[cc * 8 + e]; d1 += kf * q4[128 + cc * 8 + e]; d2 += kf * q4[256 + cc * 8 + e]; d3 += kf * q4[384 + cc * 8 + e]; } }
        const float SC = 0.088388347648318440f;
        sc[tid] = d0 * SC; sc[288 + tid] = d1 * SC; sc[576 + tid] = d2 * SC; sc[864 + tid] = d3 * SC;
    }
    __syncthreads();
    if (F.wave < 4) { LAS float* sh = sc + F.wave * 288; float m = -INFINITY;
        for (int k = F.lane; k < nk; k += 64) m = fmaxf(m, sh[k]);
        m = wave_max(m); float l = 0.f;
        for (int k = F.lane; k < nk; k += 64) { const float p = __expf(sh[k] - m); sh[k] = p; l += p; }
        l = wave_sum(l);
        if (F.lane == 0) { red[F.wave * 2] = m; red[F.wave * 2 + 1] = l; } }
    __syncthreads();
    {
        const int kg = tid >> 4, oc = tid & 15; float o[4][8];
#pragma unroll
        for (int h = 0; h < 4; ++h)
#pragma unroll
            for (int e = 0; e < 8; ++e) o[h][e] = 0.f;
        const bf16* vp = F.V() + (size_t)(row0 + kg * 8) * 256 + kvh * 128 + oc * 8;
        bf16x8 vv[8];
#pragma unroll
        for (int k = 0; k < 8; ++k) vv[k] = *(const GAS bf16x8*)(vp + (size_t)k * 256);
#pragma unroll
        for (int k = 0; k < 8; ++k) { const float p0 = sc[kg * 8 + k], p1 = sc[288 + kg * 8 + k], p2 = sc[576 + kg * 8 + k], p3 = sc[864 + kg * 8 + k];
#pragma unroll
            for (int e = 0; e < 8; ++e) { const float vf = bf2f(vv[k][e]); o[0][e] += p0 * vf; o[1][e] += p1 * vf; o[2][e] += p2 * vf; o[3][e] += p3 * vf; } }
        if (j == 0 && kg < 16) { const int k = kg; const bf16x8 v1 = *(const GAS bf16x8*)(F.VM() + k * 256 + kvh * 128 + oc * 8);
            const float p0 = sc[256 + k], p1 = sc[288 + 256 + k], p2 = sc[576 + 256 + k], p3 = sc[864 + 256 + k];
#pragma unroll
            for (int e = 0; e < 8; ++e) { const float vf = bf2f(v1[e]); o[0][e] += p0 * vf; o[1][e] += p1 * vf; o[2][e] += p2 * vf; o[3][e] += p3 * vf; } }
        LAS float* part = sc + 4 * 288 + 16;
#pragma unroll
        for (int h = 0; h < 4; ++h) { LAS f32x4* pp = (LAS f32x4*)(part + (kg * 4 + h) * 128 + oc * 8); pp[0] = (f32x4){o[h][0], o[h][1], o[h][2], o[h][3]}; pp[1] = (f32x4){o[h][4], o[h][5], o[h][6], o[h][7]}; }
        __syncthreads();
        const int h = tid >> 7, d = tid & 127; float os = 0.f;
#pragma unroll 8
        for (int g = 0; g < 32; ++g) os += part[(g * 4 + h) * 128 + d];
        float* dst = F.MQP() + ((size_t)it * 4 + h) * 132; dst[2 + d] = os; if (d == 0) { dst[0] = red[h * 2]; dst[1] = red[h * 2 + 1]; } }
    __syncthreads();
}
__device__ __forceinline__ void attn_phase(Frame& F, char* lds_generic, bf16* obase) {
    const int nr = F.G == 256 ? 8 : (2048 + F.G - 1) / F.G;
    for (int r = 0; r < nr; ++r) {
        int s, kvh, hq, qb, S;
        if (F.G == 256) {
            const int x = F.vcu >> 5, i = F.vcu & 31;
            if (r < 4) { const int pair = 2 * x + (r >> 1); s = pair >> 1; kvh = pair & 1; const int u = (r & 1) * 32 + i; hq = u >> 4; qb = u & 15; S = 4096; }
            else { const int pair = x; s = 8 + (pair >> 1); kvh = pair & 1; const int u = (r - 4) * 32 + i; hq = u >> 5; qb = u & 31; S = 8192; }
        } else {
            const int U = F.vcu + F.G * r; if (U >= 2048) break;
            if (U < 1024) { const int pair = U >> 6, u = U & 63; s = pair >> 1; kvh = pair & 1; hq = u >> 4; qb = u & 15; S = 4096; }
            else { const int pair = (U - 1024) >> 7, u = (U - 1024) & 127; s = 8 + (pair >> 1); kvh = pair & 1; hq = u >> 5; qb = u & 31; S = 8192; }
        }
        const int row0 = seq_first_row(s), h = kvh * 4 + hq;
        bf16* qp = F.QG() + (size_t)(row0 + qb * 256) * DM + h * 128;
        attn::attn_unit(qp, F.K() + (size_t)row0 * 256 + kvh * 128, F.V() + (size_t)row0 * 256 + kvh * 128, F.KM() + kvh * 128, F.VM() + kvh * 128, obase + (size_t)(row0 + qb * 256) * DM + h * 128, S / 64 + 1, lds_generic, FIN(F, 5  ), qb * 256, F.SSQA() + (size_t)(row0 + qb * 256) * 8 + h, F.wave);
    }
}

__device__ __forceinline__ void p5_ratio(Frame& F) {
    for (int row = F.vcu * 512 + F.tid; row < NTOK; row += F.G * 512) {
        const GAS f32x4* pa = (const GAS f32x4*)(F.SSQA() + (size_t)row * 8); const GAS f32x4* pl = (const GAS f32x4*)(F.SSQL() + (size_t)row * 8);
        const f32x4 a0 = pa[0], a1 = pa[1], l0 = pl[0], l1 = pl[1];
        const float sa = ((a0.x + a0.y) + (a0.z + a0.w)) + ((a1.x + a1.y) + (a1.z + a1.w)), sl = ((l0.x + l0.y) + (l0.z + l0.w)) + ((l1.x + l1.y) + (l1.z + l1.w));
        const float qa = sqrtf(sa * (1.f / 1024.f) + EPS), ql = sqrtf(sl * (1.f / 1024.f) + EPS);
        F.RATIO()[row] = ql / qa; F.RL()[row] = 1.f / ql;
    }
}
__device__ __forceinline__ void p5_meta_job(Frame& F, int s) {
    LAS float* buf = (LAS float*)F.lds; LAS float* red = buf + 2048; const int tid = F.tid;
    {
        const int nj = s < 8 ? 16 : 32;
        for (int e = tid; e < 1024; e += 512) { const int h = e >> 7, d = e & 127, kvh = h >> 2, hq = h & 3;
            const int it0 = s < 8 ? s * 32 + kvh * 16 : 256 + (s - 8) * 64 + kvh * 32;
            float M = -INFINITY;
#pragma unroll 16
            for (int j = 0; j < nj; ++j) M = fmaxf(M, F.MQP()[((size_t)(it0 + j) * 4 + hq) * 132]);
            float Ls = 0.f, O = 0.f;
#pragma unroll 16
            for (int j = 0; j < nj; ++j) { const float* p = F.MQP() + ((size_t)(it0 + j) * 4 + hq) * 132; const float w = __expf(p[0] - M); Ls += p[1] * w; O += p[2 + d] * w; }
            buf[e] = O / Ls; }
        for (int e = tid; e < 1024; e += 512) buf[1024 + e] = F.LO15()[s * 1024 + e];
        __syncthreads();
        { float ss = 0.f; for (int k = F.lane; k < 256; k += 64) { const float v = buf[F.wave * 256 + k]; ss += v * v; } ss = wave_sum(ss); if (F.lane == 0) red[F.wave] = ss; }
        __syncthreads();
        const float ra = 1.f / sqrtf((red[0] + red[1] + red[2] + red[3]) * (1.f / 1024.f) + EPS), rl = 1.f / sqrtf((red[4] + red[5] + red[6] + red[7]) * (1.f / 1024.f) + EPS);
        for (int e = tid; e < 2048; e += 512) F.MIXED15()[s * 2048 + e] = e < 1024 ? buf[e] * ra : buf[e] * rl;
        __syncthreads();
    }
}
__device__ __forceinline__ void p6_meta_y(Frame& F) {
    const float* mx = F.MIXED15();
    const auto xf = [mx](int c, int k) { const GAS f32x4* p_ = (const GAS f32x4*)(mx + (c < 12 ? c : 11) * DM + k); const f32x4 a = p_[0], b = p_[1];
        v4u w_; w_.x = pk2(a.x, a.y); w_.y = pk2(a.z, a.w); w_.z = pk2(b.x, b.y); w_.w = pk2(b.z, b.w); return __builtin_bit_cast(bf16x8, w_); };
    const OutRows o{F.Y15(), DM, 12};
    side_gemm16<false>(F, xf, F.WOUT_T(), DM / 16, (LAS float*)F.lds, o);
}

__device__ __forceinline__ void p7_rows(Frame& F, int q, int gw, int NGW) {
    const int lane = F.lane;
    f32x4 gm[8], gf[8];
    { const float* a = FIN(F, 17  ); const float* b = FIN(F, 18  );
#pragma unroll
      for (int i = 0; i < 4; ++i) { const int e0 = (lane + 64 * i) * 8; gm[2 * i] = *(const GAS f32x4*)(a + e0); gm[2 * i + 1] = *(const GAS f32x4*)(a + e0 + 4); gf[2 * i] = *(const GAS f32x4*)(b + e0); gf[2 * i + 1] = *(const GAS f32x4*)(b + e0 + 4); } }
    bf16* h1base = q == 0 ? F.H1A() : F.XN();
    bf16x8 yv[4], yn[4]; v4u xv[4], xw[4]; float r0c = 1.f, r0n = 1.f;
    const int rend = (q + 1) * HROWS;
    int row = q * HROWS + gw;
#define P7_LOAD(R, Y, X, RV) do { const GAS bf16x8* y_ = (const GAS bf16x8*)((const bf16*)(F.out + (size_t)(R) * DM)); const GAS v4u* x_ = (const GAS v4u*)(F.XN() + (size_t)(R) * DM); \
        _Pragma("unroll") for (int i_ = 0; i_ < 4; ++i_) { Y[i_] = y_[lane + 64 * i_]; X[i_] = x_[lane + 64 * i_]; } RV = F.R0()[(R)]; } while (0)
    if (row < rend) P7_LOAD(row, yv, xv, r0c);
    asm volatile("" : "+v"(r0c) :: "memory");
    for (; row < rend; row += NGW) {
        const int nrow = row + NGW < rend ? row + NGW : row;
        P7_LOAD(nrow, yn, xw, r0n);
        GAS v4u* xn = (GAS v4u*)(F.XN() + (size_t)row * DM);
        GAS v4u* h1row = (GAS v4u*)(h1base + (size_t)(row - q * HROWS) * DM);
        const float ir0 = __builtin_amdgcn_rcpf(r0c);
        float hv[32]; float ss = 0.f;
#pragma unroll
        for (int i = 0; i < 4; ++i)
#pragma unroll
            for (int j = 0; j < 8; ++j) { hv[8 * i + j] = bf2f(yv[i][j]); ss += hv[8 * i + j] * hv[8 * i + j]; }
        const float r1 = __builtin_amdgcn_rsqf(wave_sum(ss) * (1.f / DM) + EPS); float s2 = 0.f;
#pragma unroll
        for (int i = 0; i < 4; ++i) {
            const v4u xq = xv[i]; const f32x4 g0 = gm[2 * i], g1 = gm[2 * i + 1];
            const float xf[8] = {__builtin_bit_cast(float, xq.x << 16), __builtin_bit_cast(float, xq.x & 0xffff0000u), __builtin_bit_cast(float, xq.y << 16), __builtin_bit_cast(float, xq.y & 0xffff0000u),
                                 __builtin_bit_cast(float, xq.z << 16), __builtin_bit_cast(float, xq.z & 0xffff0000u), __builtin_bit_cast(float, xq.w << 16), __builtin_bit_cast(float, xq.w & 0xffff0000u)};
            const float gg[8] = {g0.x, g0.y, g0.z, g0.w, g1.x, g1.y, g1.z, g1.w};
            float hb[8];
#pragma unroll
            for (int j = 0; j < 8; ++j) { hb[j] = xf[j] * ir0 + hv[8 * i + j] * r1 * gg[j]; hv[8 * i + j] = hb[j]; s2 += hb[j] * hb[j]; }
            h1row[lane + 64 * i] = pack8(hb);
        }
        const float r2 = __builtin_amdgcn_rsqf(wave_sum(s2) * (1.f / DM) + EPS);
#pragma unroll
        for (int i = 0; i < 4; ++i) { const f32x4 g0 = gf[2 * i], g1 = gf[2 * i + 1];
            float t[8]; t[0] = hv[8 * i + 0] * r2 * g0.x; t[1] = hv[8 * i + 1] * r2 * g0.y; t[2] = hv[8 * i + 2] * r2 * g0.z; t[3] = hv[8 * i + 3] * r2 * g0.w;
            t[4] = hv[8 * i + 4] * r2 * g1.x; t[5] = hv[8 * i + 5] * r2 * g1.y; t[6] = hv[8 * i + 6] * r2 * g1.z; t[7] = hv[8 * i + 7] * r2 * g1.w;
            xn[lane + 64 * i] = pack8(t); }
        asm volatile("" : "+v"(r0n) :: "memory");
#pragma unroll
        for (int i = 0; i < 4; ++i) { yv[i] = yn[i]; xv[i] = xw[i]; }
        r0c = r0n;
    }
#undef P7_LOAD
}
constexpr int XS15 = DM + 8;
__device__ __forceinline__ void p7_meta_g(Frame& F) {
    LAS float* X = (LAS float*)F.lds;
    for (int r = F.wave; r < 12; r += 8) {
        const float* y = F.Y15() + r * DM; const float* xm = FIN(F, 2  ) + 15 * DM;
        float hv[32]; float ss = 0.f;
#pragma unroll
        for (int i = 0; i < 32; ++i) { hv[i] = y[F.lane + 64 * i]; ss += hv[i] * hv[i]; }
        const float r1 = 1.f / sqrtf(wave_sum(ss) * (1.f / DM) + EPS); float s2 = 0.f;
#pragma unroll
        for (int i = 0; i < 32; ++i) { const int e = F.lane + 64 * i; hv[i] = xm[e] + hv[i] * r1 * FIN(F, 17  )[e]; s2 += hv[i] * hv[i]; }
        const float r2 = 1.f / sqrtf(wave_sum(s2) * (1.f / DM) + EPS);
#pragma unroll
        for (int i = 0; i < 32; ++i) { const int e = F.lane + 64 * i; X[r * XS15 + e] = hv[i] * r2 * FIN(F, 18  )[e]; }
    }
    __syncthreads();
    const OutRowsB o{F.G15(), FFN, 12};
    const auto xf = [X](int c, int k) { const LAS f32x4* p_ = (const LAS f32x4*)(X + (c < 12 ? c : 11) * XS15 + k); const f32x4 a = p_[0], b = p_[1];
        v4u w_; w_.x = pk2(a.x, a.y); w_.y = pk2(a.z, a.w); w_.z = pk2(b.x, b.y); w_.w = pk2(b.z, b.w); return __builtin_bit_cast(bf16x8, w_); };
    side_gemm16<true>(F, xf, F.WUP_T(), FFN / 16, (LAS float*)(F.lds + 12 * XS15 * 4), o);
}

__device__ __forceinline__ void p9_fix(Frame& F, int h) {
    constexpr int NOCT = FFN / 8, NBW = 512 * 2;
    const int gid = F.vcu * 512 + F.tid, oct = gid % NOCT, grp = gid / NOCT, NGRP = (F.G * 512) / NOCT;
    if (grp >= NGRP) return;
    const int co = oct * 8;
    const float* cw = FIN(F, 20  ); const float* cb = FIN(F, 21  );
    float w0[8], w1[8], w2[8], bb[8];
#define LD8F(dst, p) do { const GAS f32x4* p_ = (const GAS f32x4*)(p); const f32x4 a_ = p_[0], b_ = p_[1]; dst[0] = a_.x; dst[1] = a_.y; dst[2] = a_.z; dst[3] = a_.w; dst[4] = b_.x; dst[5] = b_.y; dst[6] = b_.z; dst[7] = b_.w; } while (0)
    LD8F(w0, cw + co); LD8F(w1, cw + FFN + co); LD8F(w2, cw + 2 * FFN + co); LD8F(bb, cb + co);
#define P9_PTRS(BW, E_, O_, Z_) do { const int which_ = (BW) & 1, B_ = (BW) >> 1; const int row_ = h * HROWS + B_ * 64 + (which_ ? 63 : 0), s_ = row_seq(row_), t_ = row_ - seq_first_row(s_); \
        E_ = F.EDGE() + (size_t)((B_ * 2 + which_) * 3) * FFN + co; Z_ = which_ && t_ == seq_len(s_) - 1; \
        O_ = which_ == 0 ? (t_ == 0 ? F.G15() + (size_t)s_ * FFN + co : F.EDGE() + (size_t)(((B_ - 1) * 2 + 1) * 3 + 1) * FFN + co) : (Z_ ? E_ : F.EDGE() + (size_t)(((B_ + 1) * 2 + 0) * 3 + 1) * FFN + co); } while (0)
#define P9_LOAD(E_, O_, I, S, U, X) do { I = *(const GAS bf16x8*)(E_); S = *(const GAS bf16x8*)((E_) + FFN); U = *(const GAS bf16x8*)((E_) + 2 * FFN); X = *(const GAS bf16x8*)(O_); } while (0)
    bf16x8 in_, se_, uu_, ou_, inN, seN, uuN, ouN;
    int bw = grp; const bf16* e; const bf16* o; bool z;
    P9_PTRS(bw, e, o, z); P9_LOAD(e, o, in_, se_, uu_, ou_);
    for (; bw < NBW; bw += NGRP) {
        const int nbw = bw + NGRP < NBW ? bw + NGRP : bw; const bf16* en; const bf16* on; bool zn;
        P9_PTRS(nbw, en, on, zn); P9_LOAD(en, on, inN, seN, uuN, ouN);
        const int which = bw & 1, lrow = (bw >> 1) * 64 + (which ? 63 : 0);
        float ov[8];
#pragma unroll
        for (int j = 0; j < 8; ++j) { const float inner = bf2f(in_[j]), self = bf2f(se_[j]), outer = z ? 0.f : bf2f(ou_[j]);
            const float x = which == 0 ? bb[j] + w0[j] * outer + w1[j] * self + w2[j] * inner : bb[j] + w0[j] * inner + w1[j] * self + w2[j] * outer;
            ov[j] = x * sigmoidf_(x) * bf2f(uu_[j]); }
        *(GAS v4u*)(F.ACT() + (size_t)lrow * FFN + co) = pack8(ov);
        in_ = inN; se_ = seN; uu_ = uuN; ou_ = ouN;
        z = zn;
    }
#undef P9_LOAD
#undef P9_PTRS
#undef LD8F
}
__device__ __forceinline__ void p11_rows(Frame& F, int gw, int NGW, float* obase) {
    const int lane = F.lane;
    f32x4 gg[8];
    { const float* a = FIN(F, 23  );
#pragma unroll
      for (int i = 0; i < 4; ++i) { const int e0 = (lane + 64 * i) * 8; gg[2 * i] = *(const GAS f32x4*)(a + e0); gg[2 * i + 1] = *(const GAS f32x4*)(a + e0 + 4); } }
    bf16x8 hv[4], fq[4], hn[4], fn[4];
#define P11_LOAD(R, H, Q) do { const GAS bf16x8* f_ = (const GAS bf16x8*)((const bf16*)(F.out + (size_t)(R) * DM)); \
        const GAS bf16x8* h_ = (const GAS bf16x8*)((R) < HROWS ? F.H1A() + (size_t)(R) * DM : F.XN() + (size_t)((R) - HROWS) * DM); \
        _Pragma("unroll") for (int i_ = 0; i_ < 4; ++i_) { H[i_] = h_[lane + 64 * i_]; Q[i_] = f_[lane + 64 * i_]; } } while (0)
    int row = gw;
    if (row < NTOK) P11_LOAD(row, hv, fq);
    asm volatile("" : "+v"(hv[0]), "+v"(hv[1]), "+v"(hv[2]), "+v"(hv[3]), "+v"(fq[0]), "+v"(fq[1]), "+v"(fq[2]), "+v"(fq[3]) :: "memory");
    for (; row < NTOK; row += NGW) {
        const int nrow = row + NGW < NTOK ? row + NGW : row;
        P11_LOAD(nrow, hn, fn);
        float fv[32]; float ss = 0.f;
#pragma unroll
        for (int i = 0; i < 4; ++i)
#pragma unroll
            for (int j = 0; j < 8; ++j) { fv[8 * i + j] = bf2f(fq[i][j]); ss += fv[8 * i + j] * fv[8 * i + j]; }
        const float r1 = __builtin_amdgcn_rsqf(wave_sum(ss) * (1.f / DM) + EPS);
#pragma unroll
        for (int i = 0; i < 4; ++i) { const int e0 = (lane + 64 * i) * 8; const f32x4 g0 = gg[2 * i], g1 = gg[2 * i + 1];
            f32x4 h0, h1;
            h0.x = bf2f(hv[i][0]) + fv[8 * i + 0] * r1 * g0.x; h0.y = bf2f(hv[i][1]) + fv[8 * i + 1] * r1 * g0.y; h0.z = bf2f(hv[i][2]) + fv[8 * i + 2] * r1 * g0.z; h0.w = bf2f(hv[i][3]) + fv[8 * i + 3] * r1 * g0.w;
            h1.x = bf2f(hv[i][4]) + fv[8 * i + 4] * r1 * g1.x; h1.y = bf2f(hv[i][5]) + fv[8 * i + 5] * r1 * g1.y; h1.z = bf2f(hv[i][6]) + fv[8 * i + 6] * r1 * g1.z; h1.w = bf2f(hv[i][7]) + fv[8 * i + 7] * r1 * g1.w;
            GAS f32x4* wp = (GAS f32x4*)(obase + (size_t)row * DM + e0); wp[0] = h0; wp[1] = h1; }
        asm volatile("" : "+v"(hn[0]), "+v"(hn[1]), "+v"(hn[2]), "+v"(hn[3]), "+v"(fn[0]), "+v"(fn[1]), "+v"(fn[2]), "+v"(fn[3]) :: "memory");
#pragma unroll
        for (int i = 0; i < 4; ++i) { hv[i] = hn[i]; fq[i] = fn[i]; }
    }
#undef P11_LOAD
}
struct Args { const float* in[24]; float* out; unsigned char* ws; int ph_lo, ph_hi, q_lo, q_hi, use_bar, dummy; };
constexpr int N_PHASES = 12;
__global__ void __launch_bounds__(NWAVES * 64, 2) mk_fwd(Args args) {
    extern __shared__ __attribute__((aligned(16))) unsigned char lds[];
    Frame F;
    F.lds = (LAS unsigned char*)lds;
    F.MISC = (volatile LAS unsigned*)(F.lds + MISC_OFF);
    F.wave = __builtin_amdgcn_readfirstlane((int)threadIdx.x >> 6);
    F.tid = F.wave * 64 + lane_id_now(); F.lane = F.tid & 63;
    F.G = gridDim.x; { const int bx = blockIdx.x; F.vcu = (F.G % 8 == 0) ? (bx % 8) * (F.G / 8) + bx / 8 : bx; }
    unsigned char* ws = args.ws;
    F.ctl = (gu32*)(ws + WS_CTL);
    F.kargs = (const __attribute__((address_space(4))) void*)__builtin_amdgcn_kernarg_segment_ptr(); F.ptag = 0; F.out = args.out;
    F.ws = ws;
    for (int u = F.tid; u < (LDS_BYTES - LDSCTL_OFF) / 4; u += NWAVES * 64) ((LAS unsigned*)(F.lds + LDSCTL_OFF))[u] = 0u;
    __syncthreads();
    XcdBarrier bar; bar.bar = (unsigned*)(F.ctl + CW_BAR); bar.x = 0; bar.st = nullptr;
    if (args.use_bar) bar = xcd_barrier_post((unsigned*)(F.ctl + CW_BAR), F.MISC + 8, F.tid == 0);
    const int lo = args.ph_lo, hi = args.ph_hi;
    const int dmy_ = MK_MULTI ? args.dummy : 0;
#define IN(k) (((MK_PHASE_MASK >> (k)) & 1) && lo <= (k) && (k) < hi)
#define PH_BEGIN(k) do { F.ptag = (k); int t_ = F.wave * 64 + lane_id_now(); asm volatile("" : "+v"(t_)); F.tid = t_; F.lane = t_ & 63; } while (0)
#define PH_BAR() do { if (args.use_bar) xcd_barrier(bar, F.wave == 0 && lane_id_now() == 0); } while (0)
    const int gw = F.vcu * NWAVES + F.wave, NGW = F.G * NWAVES;

    if (IN(0)) { PH_BEGIN(0); { p0_prologue(F); PH_BAR(); } }
    if (IN(1)) { PH_BEGIN(1); {
        p1_meta_z(F);
        pg8::Gemm g{F.XN(), F.WIN_T(), NTOK, INW, DM}; pg8::ProbeOrder S; S.init(NTOK, INW, F.G, (int)blockIdx.x); S.pmask = dmy_ == 5 ? 7 : -1;
        pg8::EpiRoute E{nullptr, 0, 1, F.QG(), F.K(), F.V(), F.XR()};
        if (dmy_ != 7) pg8::gemm_phase<pg8::EpiRoute, pg8::ProbeOrder, true, true>(F.lds, g, S, E, F.wave);
        PH_BAR();
    } }
    if (IN(2)) { PH_BEGIN(2); { lru_phase<1>(F, nullptr); PH_BAR(); } }
    if (IN(3)) { PH_BEGIN(3); {
        constexpr int NPW = (12 * 2048 + 511) / 512;
        if (F.G >= 2 * NPW) {
            if (F.vcu < NPW) lru_propagate(F);
            else { const int gw2 = (F.vcu - NPW) * NWAVES + F.wave, NGW2 = (F.G - NPW) * NWAVES;
                k_rope_pass(F, dmy_ ? (bf16*)F.out : F.K(), gw2, NGW2);
                wt_items(F, WT_O_OUT, WT_O_UP, gw2, NGW2); wt_items(F, WT_O_DN, WT_O_G, gw2, NGW2); }
        } else {
            k_rope_pass(F, dmy_ ? (bf16*)F.out : F.K(), gw, NGW);
            lru_propagate(F);
            wt_items(F, WT_O_OUT, WT_O_UP, gw, NGW); wt_items(F, WT_O_DN, WT_O_G, gw, NGW);
        }
        if (F.vcu == F.G - 1) p3_meta_job(F);
        PH_BAR();
    } }
    if (IN(4)) { PH_BEGIN(4); {
        const int dm = dmy_;
        if (dm < 2 || dm == 2) lru_phase<2>(F, dm ? (bf16*)F.out : F.QG());
        if (dm < 2 || dm == 3) for (int it = F.vcu; it < 512; it += F.G) metaq_item(F, it);
        if (dm < 2 || dm == 4) attn_phase(F, (char*)lds, dm ? (bf16*)F.out : F.QG());
        if (dm == 8 && F.vcu < 128) attn_phase(F, (char*)lds, (bf16*)F.out);
        if (dm == 6 && (F.vcu & 1) == 0) attn_phase(F, (char*)lds, (bf16*)F.out);
        PH_BAR();
    } }
    if (IN(5)) { PH_BEGIN(5); {
        p5_ratio(F);
        if (F.G > 24) {
            if (F.vcu >= F.G - 12) p5_meta_job(F, F.G - 1 - F.vcu);
            else wt_items(F, WT_O_UP, WT_O_DN, F.vcu * NWAVES + F.wave, (F.G - 12) * NWAVES);
        } else {
            wt_items(F, WT_O_UP, WT_O_DN, gw, NGW);
            __syncthreads();
            if (F.vcu >= F.G - 12) p5_meta_job(F, F.G - 1 - F.vcu);
        }
        PH_BAR();
    } }
    if (IN(6)) { PH_BEGIN(6); {
        p6_meta_y(F);
        pg8::Gemm g{F.QG(), F.WOUT_T(), NTOK, DM, DM}; pg8::StaticOrder S; S.init(NTOK, DM, F.G, (int)blockIdx.x);
        pg8::EpiScaled E{(bf16*)F.out, 2 * DM, F.RATIO(), F.RL(), 16};
        pg8::gemm_phase<pg8::EpiScaled, pg8::StaticOrder, true, true>(F.lds, g, S, E, F.wave);
        PH_BAR();
    } }
#if MK_MULTI
    { const int q = args.q_lo;
#else
#pragma unroll
    for (int q = 0; q < 2; ++q) {
#endif
        if (IN(7)) { PH_BEGIN(7); {
            p7_rows(F, q, gw, NGW);
            if (q == 0) p7_meta_g(F);
            PH_BAR();
        } }
        if (IN(8)) { PH_BEGIN(8); {
            pg8::Gemm g{F.XN() + (size_t)q * HROWS * DM, F.WUP_T(), HROWS, UPW, DM}; pg8::StaticOrder S; S.init(HROWS, UPW, F.G, (int)blockIdx.x);
            pg8::EpiAct E{F.ACT(), F.EDGE(), FIN(F, 20  ), FIN(F, 21  ), FFN};
            pg8::gemm_phase<pg8::EpiAct, pg8::StaticOrder, true, true>(F.lds, g, S, E, F.wave);
            PH_BAR();
        } }
        if (IN(9)) { PH_BEGIN(9); { p9_fix(F, q); PH_BAR(); } }
        if (IN(10)) { PH_BEGIN(10); {
            pg8::Gemm g{F.ACT(), F.WDOWN_T(), HROWS, DM, FFN}; pg8::ProbeOrder S; S.init(HROWS, DM, F.G, (int)blockIdx.x); S.pmask = dmy_ == 5 ? 7 : -1;
            pg8::EpiRoute E{(bf16*)F.out + (size_t)q * HROWS * 2 * DM, 2 * DM, 0, nullptr, nullptr, nullptr, nullptr};
            pg8::gemm_phase<pg8::EpiRoute, pg8::ProbeOrder, true, true>(F.lds, g, S, E, F.wave);
        } }
    }
    if (IN(10) && IN(11)) PH_BAR();
    if (IN(11)) { PH_BEGIN(11); { p11_rows(F, gw, NGW, dmy_ ? (float*)(F.ws + WS_B) : F.out); } }
#undef IN
#undef PH_BAR
}

extern "C" void kernel_launch(void* const* d_in, const int* in_sizes, int n_in, void* d_out, int out_size, void* d_ws, size_t ws_size, hipStream_t stream) {
    static int grid = 0;
    if (grid == 0) {
        if (n_in != 24 || out_size != NTOK * DM || ws_size < WS_END) { fprintf(stderr, "kernel_launch: unexpected shapes (n_in %d out %d ws %zu, need ws >= %zu); nothing launched\n", n_in, out_size, ws_size, (size_t)WS_END); grid = -1; return; }
        int dev = 0, cus = 0;
        if (hipGetDevice(&dev) != hipSuccess || hipDeviceGetAttribute(&cus, hipDeviceAttributeMultiprocessorCount, dev) != hipSuccess) { grid = -1; return; }
        if (hipFuncSetAttribute((const void*)mk_fwd, hipFuncAttributeMaxDynamicSharedMemorySize, LDS_BYTES) != hipSuccess) { fprintf(stderr, "kernel_launch: hipFuncSetAttribute failed\n"); grid = -1; return; }
        int per_cu = 0;
        if (hipOccupancyMaxActiveBlocksPerMultiprocessor(&per_cu, (const void*)mk_fwd, NWAVES * 64, LDS_BYTES) != hipSuccess || per_cu < 1) fprintf(stderr, "kernel_launch: occupancy query reports %d\n", per_cu);
        (void)hipGetLastError();
        grid = cus;
    }
    if (grid < 0) return;
    if (hipMemsetAsync((char*)d_ws + WS_CTL, 0, CTL_ZERO_BYTES, stream) != hipSuccess) return;
    Args a{};
    for (int i = 0; i < 24; ++i) a.in[i] = (const float*)d_in[i];
    a.out = (float*)d_out; a.ws = (unsigned char*)d_ws;
#if MK_MULTI
    a.use_bar = 0;
#define LAUNCH_PH(ph, q) do { a.ph_lo = (ph); a.ph_hi = (ph) + 1; a.q_lo = (q); a.q_hi = (q) + 1; \
        if ((MK_REPEAT_MASK >> (ph)) & 1) { a.dummy = MK_DUMMY_MODE; hipLaunchKernelGGL(mk_fwd, dim3(grid), dim3(NWAVES * 64), LDS_BYTES, stream, a); } \
        a.dummy = 0; hipLaunchKernelGGL(mk_fwd, dim3(grid), dim3(NWAVES * 64), LDS_BYTES, stream, a); } while (0)
    for (int ph = 0; ph < 7; ++ph) LAUNCH_PH(ph, 0);
    for (int q = 0; q < 2; ++q) for (int ph = 7; ph < 11; ++ph) LAUNCH_PH(ph, q);
    LAUNCH_PH(11, 0);
#else
    a.use_bar = 1; a.ph_lo = 0; a.ph_hi = N_PHASES; a.q_lo = 0; a.q_hi = 2;
    hipLaunchKernelGGL(mk_fwd, dim3(grid), dim3(NWAVES * 64), LDS_BYTES, stream, a);
#endif
    const hipError_t le = hipPeekAtLastError();
    if (le != hipSuccess) fprintf(stderr, "kernel_launch: launch failed: %s\n", hipGetErrorName(le));
}
```

```cpp
#include <hip/hip_runtime.h>
#include <cstdio>
#include <cstdint>
#include <cmath>
#ifndef MK_PHASE_MASK
#define MK_PHASE_MASK 0xfff
#endif
#ifndef MK_REPEAT_MASK
#define MK_REPEAT_MASK 0
#endif
#ifndef MK_DUMMY_MODE
#define MK_DUMMY_MODE 1
#endif
#ifndef MK_MULTI
#define MK_MULTI 0
#endif
__device__ __forceinline__ int lane_id_now() { int l; asm volatile("v_mbcnt_lo_u32_b32 %0, -1, 0\n\tv_mbcnt_hi_u32_b32 %0, -1, %0" : "=v"(l)); return l; }
namespace pg8 {
#define PG8_LAS __attribute__((address_space(3)))
typedef unsigned short bf16_t;
typedef short bf16x8 __attribute__((ext_vector_type(8)));
typedef float f32x4 __attribute__((ext_vector_type(4)));
typedef unsigned u32x4 __attribute__((ext_vector_type(4)));
constexpr int BM = 256, BK = 64, HALF = 128, HTB = HALF * BK * 2  , STAGE_BYTES = 8 * HTB, NXCD = 8, WGM = 8;

__host__ __device__ __forceinline__ int lds_byte(int r, int c) { const int st = (r >> 4) * 2 + (c >> 5), rr = r & 15, cc = c & 31, ob = rr * 64 + cc * 2; return st * 1024 + (ob ^ (((ob >> 9) & 1) << 5)); }
__host__ __device__ __forceinline__ void stage_rc(int b, int& R, int& C) { const int st = b / 1024, sb = b % 1024, swz = sb ^ (((sb >> 9) & 1) << 5); R = (st >> 1) * 16 + swz / 64; C = (st & 1) * 32 + (swz % 64) / 2; }
__host__ __device__ __forceinline__ int perm32(int rho) { const int n = rho >> 4, i = rho & 15; return 8 * (i >> 2) + 4 * n + (i & 3); }

struct Unit { int pm, pn; };
struct Gemm { const bf16_t* A; const bf16_t* Bt; int M, N, K; };

struct StaticOrder {
    int nM, nN, nwg, G, c;
    __host__ __device__ void init(int M, int N, int G_, int c_) { nM = M / BM; nN = N / BM; nwg = nM * nN; G = G_; c = c_; }
    __host__ __device__ bool next(int i, Unit& u) const {
        const long L = (long)i * G + c; if (L >= nwg) return false;
        int wgid = (int)L; { const int q = nwg / NXCD, r = nwg % NXCD, xcd = wgid % NXCD, off = wgid / NXCD; wgid = (xcd < r ? xcd * (q + 1) : r * (q + 1) + (xcd - r) * q) + off; }
        const int nig = WGM * nN, gid = wgid / nig, fm = gid * WGM, gsz = (nM - fm) < WGM ? (nM - fm) : WGM;
        u.pm = fm + ((wgid % nig) % gsz); u.pn = (wgid % nig) / gsz; return true;
    }
    __device__ __forceinline__ void a_ready(const Unit&) const {}
    __device__ __forceinline__ void done(const Unit&) const {}
};

__device__ __forceinline__ unsigned cvt_pk_bf16(float lo, float hi) { unsigned r; asm volatile("v_cvt_pk_bf16_f32 %0, %1, %2" : "=v"(r) : "v"(lo), "v"(hi)); return r; }
struct EpiRoute {
    static constexpr bool PERM = true, AFTER_DRAIN = false, MIDK = false;
    bf16_t* O; int ldc; int mode; bf16_t *QGp, *Kp, *Vp, *XRp;
    __device__ __forceinline__ void operator()(const f32x4 (&acc)[2][2][4][2], const Unit& u, int wr, int wc, int fr, int fq) const {
        bf16_t* base = O; int ld = ldc; int colt = u.pn * BM; int rowadd = 0;
        if (mode == 1) {
            const int pn = u.pn;
            if (pn < 4) { base = QGp; ld = 2048; colt = pn * 256; }
            else if (pn == 4) { base = Kp; ld = 256; colt = 0; }
            else if (pn == 5) { base = Vp; ld = 256; colt = 0; }
            else if (pn < 10) { base = XRp; ld = 1024; colt = (pn - 6) * 256; const int seq = u.pm < 128 ? (u.pm >> 4) : 8 + ((u.pm - 128) >> 5); rowadd = 64 * (seq + 1); }
            else { base = QGp; ld = 2048; colt = 1024 + (pn - 10) * 256; }
        }
        const int row0 = u.pm * BM + wr * 64 + fr + rowadd; const int col0 = colt + wc * 32 + 8 * fq;
#pragma unroll
        for (int ai = 0; ai < 2; ++ai)
#pragma unroll
            for (int m = 0; m < 4; ++m) { bf16_t* rowp = base + (size_t)(row0 + ai * HALF + m * 16) * ld + col0;
#pragma unroll
                for (int bj = 0; bj < 2; ++bj) { const f32x4 v0 = acc[ai][bj][m][0], v1 = acc[ai][bj][m][1];
                    u32x4 w; w.x = cvt_pk_bf16(v0[0], v0[1]); w.y = cvt_pk_bf16(v0[2], v0[3]); w.z = cvt_pk_bf16(v1[0], v1[1]); w.w = cvt_pk_bf16(v1[2], v1[3]);
                    *(u32x4*)(rowp + bj * HALF) = w; } }
    }
};

__device__ __forceinline__ float dpp_shr1(float old, float src) { return __builtin_bit_cast(float, __builtin_amdgcn_update_dpp(__builtin_bit_cast(int, old), __builtin_bit_cast(int, src), 0x111, 0xF, 0xF, false)); }
__device__ __forceinline__ float dpp_shl1(float old, float src) { return __builtin_bit_cast(float, __builtin_amdgcn_update_dpp(__builtin_bit_cast(int, old), __builtin_bit_cast(int, src), 0x101, 0xF, 0xF, false)); }
__device__ __forceinline__ float dpp_ror1(float src)  { return __builtin_bit_cast(float, __builtin_amdgcn_mov_dpp(__builtin_bit_cast(int, src), 0x121, 0xF, 0xF, false)); }
__device__ __forceinline__ float dpp_ror15(float src) { return __builtin_bit_cast(float, __builtin_amdgcn_mov_dpp(__builtin_bit_cast(int, src), 0x12F, 0xF, 0xF, false)); }
struct EpiAct {
    static constexpr bool PERM = true, AFTER_DRAIN = false, MIDK = false;
    bf16_t* ACT; bf16_t* EDGE; const float* cw; const float* cb; int nch;
    __device__ __forceinline__ void operator()(const f32x4 (&acc)[2][2][4][2], const Unit& u, int wr, int wc, int fr, int fq) const {
        const int ch0 = u.pn * 128 + wc * 32 + 8 * fq;
        typedef float f32x2 __attribute__((ext_vector_type(2)));
        f32x2 W0[4], W1[4], W2[4], BB[4];
        { const f32x4 a0 = *(const f32x4*)(cw + ch0), a1 = *(const f32x4*)(cw + ch0 + 4), b0 = *(const f32x4*)(cw + nch + ch0), b1 = *(const f32x4*)(cw + nch + ch0 + 4),
                      c0 = *(const f32x4*)(cw + 2 * nch + ch0), c1 = *(const f32x4*)(cw + 2 * nch + ch0 + 4), d0 = *(const f32x4*)(cb + ch0), d1 = *(const f32x4*)(cb + ch0 + 4);
          W0[0] = (f32x2){a0[0], a0[1]}; W0[1] = (f32x2){a0[2], a0[3]}; W0[2] = (f32x2){a1[0], a1[1]}; W0[3] = (f32x2){a1[2], a1[3]};
          W1[0] = (f32x2){b0[0], b0[1]}; W1[1] = (f32x2){b0[2], b0[3]}; W1[2] = (f32x2){b1[0], b1[1]}; W1[3] = (f32x2){b1[2], b1[3]};
          W2[0] = (f32x2){c0[0], c0[1]}; W2[1] = (f32x2){c0[2], c0[3]}; W2[2] = (f32x2){c1[0], c1[1]}; W2[3] = (f32x2){c1[2], c1[3]};
          BB[0] = (f32x2){d0[0], d0[1]}; BB[1] = (f32x2){d0[2], d0[3]}; BB[2] = (f32x2){d1[0], d1[1]}; BB[3] = (f32x2){d1[2], d1[3]}; }
        const int rowb = u.pm * BM + wr * 64;
#pragma unroll
        for (int ai = 0; ai < 2; ++ai) {
            float ein0[8], ein1[8];
#pragma unroll
            for (int m = 0; m < 4; ++m) {
                unsigned ow[4];
#pragma unroll
                for (int n = 0; n < 2; ++n)
#pragma unroll
                    for (int kp = 0; kp < 4; kp += 2) {
                        const int jp = 2 * n + (kp >> 1);
                        const f32x2 cur = {acc[ai][0][m][n][kp], acc[ai][0][m][n][kp + 1]};
                        float pa = 0.f, pb = 0.f, na = 0.f, nb = 0.f;
                        if (m > 0) { pa = dpp_ror1(acc[ai][0][m > 0 ? m - 1 : 0][n][kp]); pb = dpp_ror1(acc[ai][0][m > 0 ? m - 1 : 0][n][kp + 1]); }
                        if (m < 3) { na = dpp_ror15(acc[ai][0][m < 3 ? m + 1 : 3][n][kp]); nb = dpp_ror15(acc[ai][0][m < 3 ? m + 1 : 3][n][kp + 1]); }
                        const f32x2 prv = {dpp_shr1(pa, cur.x), dpp_shr1(pb, cur.y)}, nxt = {dpp_shl1(na, cur.x), dpp_shl1(nb, cur.y)};
                        f32x2 x = W0[jp] * prv + BB[jp]; x = W1[jp] * cur + x; x = W2[jp] * nxt + x;
                        const f32x2 t = x * (f32x2){-1.4426950408889634f, -1.4426950408889634f};
                        const f32x2 dn = (f32x2){__builtin_amdgcn_exp2f(t.x), __builtin_amdgcn_exp2f(t.y)} + (f32x2){1.f, 1.f};
                        const f32x2 rc = {__builtin_amdgcn_rcpf(dn.x), __builtin_amdgcn_rcpf(dn.y)};
                        const f32x2 o2 = (x * rc) * (f32x2){acc[ai][1][m][n][kp], acc[ai][1][m][n][kp + 1]};
                        ow[jp] = cvt_pk_bf16(o2.x, o2.y);
                        if (m == 0) { ein0[2 * jp] = nxt.x; ein0[2 * jp + 1] = nxt.y; }
                        if (m == 3) { ein1[2 * jp] = prv.x; ein1[2 * jp + 1] = prv.y; }
                    }
                u32x4 w; w.x = ow[0]; w.y = ow[1]; w.z = ow[2]; w.w = ow[3];
                *(u32x4*)(ACT + (size_t)(rowb + ai * HALF + m * 16 + fr) * nch + ch0) = w;
            }
            const int blk = (rowb + ai * HALF) >> 6;
            if (fr == 0 || fr == 15) {
                const bool last = fr == 15; bf16_t* e = EDGE + (size_t)((blk * 2 + (last ? 1 : 0)) * 3) * nch + ch0;
                float iv[8], sv[8], uv[8];
#pragma unroll
                for (int k = 0; k < 4; ++k) { iv[k] = last ? ein1[k] : ein0[k]; iv[4 + k] = last ? ein1[4 + k] : ein0[4 + k];
                    sv[k] = last ? acc[ai][0][3][0][k] : acc[ai][0][0][0][k]; sv[4 + k] = last ? acc[ai][0][3][1][k] : acc[ai][0][0][1][k];
                    uv[k] = last ? acc[ai][1][3][0][k] : acc[ai][1][0][0][k]; uv[4 + k] = last ? acc[ai][1][3][1][k] : acc[ai][1][0][1][k]; }
                u32x4 a, b, c;
                a.x = cvt_pk_bf16(iv[0], iv[1]); a.y = cvt_pk_bf16(iv[2], iv[3]); a.z = cvt_pk_bf16(iv[4], iv[5]); a.w = cvt_pk_bf16(iv[6], iv[7]);
                b.x = cvt_pk_bf16(sv[0], sv[1]); b.y = cvt_pk_bf16(sv[2], sv[3]); b.z = cvt_pk_bf16(sv[4], sv[5]); b.w = cvt_pk_bf16(sv[6], sv[7]);
                c.x = cvt_pk_bf16(uv[0], uv[1]); c.y = cvt_pk_bf16(uv[2], uv[3]); c.z = cvt_pk_bf16(uv[4], uv[5]); c.w = cvt_pk_bf16(uv[6], uv[7]);
                *(u32x4*)(e) = a; *(u32x4*)(e + nch) = b; *(u32x4*)(e + 2 * nch) = c;
            }
        }
    }
};

struct ProbeOrder : StaticOrder { int pmask;
    __host__ __device__ bool next(int i, Unit& u) const { const bool r = StaticOrder::next(i, u); u.pm &= pmask; return r; } };

struct EpiScaled {
    static constexpr bool PERM = true, AFTER_DRAIN = false, MIDK = true;
    bf16_t* O; int ldc; const float* ratio; const float* rl; int kt;
    __device__ __forceinline__ void midk(f32x4 (&acc)[2][2][4][2], const Unit& u, int wr, int fr) const {
        asm volatile("" ::: "memory");
        const float* rp = ratio + (u.pm * BM + wr * 64 + fr);
        float s[2][4];
#pragma unroll
        for (int ai = 0; ai < 2; ++ai)
#pragma unroll
            for (int m = 0; m < 4; ++m) s[ai][m] = rp[ai * HALF + m * 16];
#pragma unroll
        for (int ai = 0; ai < 2; ++ai)
#pragma unroll
            for (int m = 0; m < 4; ++m)
#pragma unroll
                for (int bj = 0; bj < 2; ++bj)
#pragma unroll
                    for (int n = 0; n < 2; ++n) acc[ai][bj][m][n] = acc[ai][bj][m][n] * s[ai][m];
        asm volatile("" ::: "memory");
    }
    __device__ __forceinline__ void operator()(const f32x4 (&acc)[2][2][4][2], const Unit& u, int wr, int wc, int fr, int fq) const {
        const int row0 = u.pm * BM + wr * 64 + fr, col0 = u.pn * BM + wc * 32 + 8 * fq;
#pragma unroll
        for (int ai = 0; ai < 2; ++ai)
#pragma unroll
            for (int m = 0; m < 4; ++m) { const int row = row0 + ai * HALF + m * 16; const float s = rl[row]; bf16_t* rowp = O + (size_t)row * ldc + col0;
#pragma unroll
                for (int bj = 0; bj < 2; ++bj) { const f32x4 v0 = acc[ai][bj][m][0] * s, v1 = acc[ai][bj][m][1] * s;
                    u32x4 w; w.x = cvt_pk_bf16(v0[0], v0[1]); w.y = cvt_pk_bf16(v0[2], v0[3]); w.z = cvt_pk_bf16(v1[0], v1[1]); w.w = cvt_pk_bf16(v1[2], v1[3]);
                    *(u32x4*)(rowp + bj * HALF) = w; } }
    }
};

template <class Epi, class Sched, bool ALIGN_EPI = false, bool SP2 = false>
__device__ __forceinline__ void gemm_phase(PG8_LAS unsigned char* lds, const Gemm g, const Sched& S, const Epi& E, int wave_id) {
    int tid_ = wave_id * 64 + lane_id_now(); asm volatile("" : "+v"(tid_));
    const int tid = tid_, wid = __builtin_amdgcn_readfirstlane(tid >> 6), lane = tid & 63, wr = wid >> 2, wc = wid & 3, fr = lane & 15, fq = lane >> 4;
    const int K = g.K, nt = K / BK;
    unsigned voffA[2], voffB[2];
#pragma unroll
    for (int i = 0; i < 2; ++i) { int R, C; stage_rc(tid * 16 + i * 8192, R, C); const int Rb = Epi::PERM ? ((R & ~31) + perm32(R & 31)) : R;
        voffA[i] = (unsigned)(R * K + C) * 2u; voffB[i] = (unsigned)(Rb * K + C) * 2u; }
    const size_t kstep = (size_t)(BK * 2);
    const size_t hstep = (size_t)HALF * K * 2;
    const size_t tstep = 2 * hstep;
    const unsigned ldsw = (unsigned)wid * 1024u;
    const int aoff = lds_byte(wr * 64 + fr, fq * 8), boff = lds_byte(wc * 32 + fr, fq * 8);
#define PG8_SA(b, h) (((b) * 2 + (h)) * HTB)
#define PG8_SB(b, h) ((4 + (b) * 2 + (h)) * HTB)
#define PG8_STAGE(bufoff, gbase, voff) do { _Pragma("unroll") for (int _i = 0; _i < 2; ++_i) \
        __builtin_amdgcn_global_load_lds((const unsigned*)((const char*)(gbase) + (voff)[_i]), (PG8_LAS unsigned*)(lds + (bufoff) + ldsw + _i * 8192), 16, 0, 0); } while (0)
#define PG8_LDA(dst, b, h) do { _Pragma("unroll") for (int m = 0; m < 4; ++m) _Pragma("unroll") for (int k = 0; k < 2; ++k) dst[m][k] = *(const PG8_LAS bf16x8*)(lds + PG8_SA(b, h) + aoff + m * 2048 + k * 1024); } while (0)
#define PG8_LDB(dst, b, h) do { _Pragma("unroll") for (int n = 0; n < 2; ++n) _Pragma("unroll") for (int k = 0; k < 2; ++k) dst[n][k] = *(const PG8_LAS bf16x8*)(lds + PG8_SB(b, h) + boff + n * 2048 + k * 1024); } while (0)
#define PG8_MMA(ai, bj, At, Bt) do { __builtin_amdgcn_s_setprio(1); _Pragma("unroll") for (int m = 0; m < 4; ++m) _Pragma("unroll") for (int n = 0; n < 2; ++n) _Pragma("unroll") for (int k = 0; k < 2; ++k) \
        acc[ai][bj][m][n] = __builtin_amdgcn_mfma_f32_16x16x32_bf16(Bt[n][k], At[m][k], acc[ai][bj][m][n], 0, 0, 0); __builtin_amdgcn_s_setprio(0); } while (0)
#define PG8_WAIT_V(n) asm volatile("s_waitcnt vmcnt(" #n ")" ::: "memory")
#define PG8_WAIT_L(n) asm volatile("s_waitcnt lgkmcnt(" #n ")" ::: "memory")
#define PG8_BAR __builtin_amdgcn_s_barrier()
#define PG8_SCHED __builtin_amdgcn_sched_barrier(0)
    Unit cur, nxt; int ui = 0;
    if (!S.next(0, cur)) return;
    f32x4 acc[2][2][4][2];
#pragma unroll
    for (int a = 0; a < 2; ++a)
#pragma unroll
        for (int b = 0; b < 2; ++b)
#pragma unroll
            for (int m = 0; m < 4; ++m)
#pragma unroll
                for (int n = 0; n < 2; ++n) acc[a][b][m][n] = (f32x4){0.f, 0.f, 0.f, 0.f};
    bf16x8 At[4][2], B0[2][2], B1[2][2];
    const char* cA = (const char*)g.A + (size_t)cur.pm * tstep; const char* cB = (const char*)g.Bt + (size_t)cur.pn * tstep;
    S.a_ready(cur);
    if constexpr (SP2) {
        PG8_STAGE(PG8_SB(0, 0), cB, voffB); PG8_STAGE(PG8_SB(0, 1), cB + hstep, voffB); PG8_STAGE(PG8_SA(0, 0), cA, voffA); PG8_STAGE(PG8_SA(0, 1), cA + hstep, voffA);
        if (wr == 1) PG8_BAR;
        PG8_WAIT_V(2); PG8_BAR;
        PG8_STAGE(PG8_SB(1, 0), cB + kstep, voffB); PG8_STAGE(PG8_SA(1, 0), cA + kstep, voffA); PG8_STAGE(PG8_SB(1, 1), cB + hstep + kstep, voffB);
        PG8_WAIT_V(6); PG8_BAR;
    } else {
        PG8_STAGE(PG8_SB(0, 0), cB, voffB); PG8_STAGE(PG8_SA(0, 0), cA, voffA); PG8_STAGE(PG8_SB(0, 1), cB + hstep, voffB); PG8_STAGE(PG8_SA(0, 1), cA + hstep, voffA);
        if (wr == 1) PG8_BAR;
        PG8_WAIT_V(4); PG8_BAR;
        PG8_STAGE(PG8_SB(1, 0), cB + kstep, voffB); PG8_STAGE(PG8_SA(1, 0), cA + kstep, voffA); PG8_STAGE(PG8_SB(1, 1), cB + hstep + kstep, voffB);
        PG8_WAIT_V(6); PG8_BAR;
    }
    for (;;) {
        const bool has_next = S.next(ui + 1, nxt);
        const char* nA = has_next ? (const char*)g.A + (size_t)nxt.pm * tstep : cA; const char* nB = has_next ? (const char*)g.Bt + (size_t)nxt.pn * tstep : cB;
        for (int t = 0; t < nt; t += 2) {
            if constexpr (Epi::MIDK) { if (t == E.kt) E.midk(acc, cur, wr, fr); }
            const bool last = (t == nt - 2);
            const char* a1 = cA + (size_t)(t + 1) * kstep;
            const char* a2 = last ? nA : cA + (size_t)(t + 2) * kstep; const char* b2 = last ? nB : cB + (size_t)(t + 2) * kstep;
            const char* a3 = a2 + kstep; const char* b3 = b2 + kstep;
            if (last && has_next) S.a_ready(nxt);
            if constexpr (SP2) {
            PG8_LDB(B0, 0, 0); PG8_LDB(B1, 0, 1); PG8_SCHED; PG8_LDA(At, 0, 0); PG8_STAGE(PG8_SA(1, 1), a1 + hstep, voffA);
            PG8_WAIT_V(8); PG8_WAIT_L(0); PG8_BAR; PG8_MMA(0, 0, At, B0); PG8_MMA(0, 1, At, B1); PG8_BAR; PG8_SCHED;
            PG8_LDA(At, 0, 1); PG8_STAGE(PG8_SB(0, 0), b2, voffB); PG8_STAGE(PG8_SB(0, 1), b2 + hstep, voffB); PG8_STAGE(PG8_SA(0, 0), a2, voffA);
            PG8_WAIT_V(8); PG8_WAIT_L(0); PG8_BAR; PG8_MMA(1, 0, At, B0); PG8_MMA(1, 1, At, B1); PG8_BAR; PG8_SCHED;
            PG8_LDB(B0, 1, 0); PG8_LDB(B1, 1, 1); PG8_SCHED; PG8_LDA(At, 1, 0); PG8_STAGE(PG8_SA(0, 1), a2 + hstep, voffA);
            PG8_WAIT_V(8); PG8_WAIT_L(0); PG8_BAR; PG8_MMA(0, 0, At, B0); PG8_MMA(0, 1, At, B1); PG8_BAR; PG8_SCHED;
            PG8_LDA(At, 1, 1); PG8_STAGE(PG8_SB(1, 0), b3, voffB); PG8_STAGE(PG8_SB(1, 1), b3 + hstep, voffB); PG8_STAGE(PG8_SA(1, 0), a3, voffA);
            PG8_WAIT_V(8); PG8_WAIT_L(0); PG8_BAR; PG8_MMA(1, 0, At, B0); PG8_MMA(1, 1, At, B1); PG8_BAR; PG8_SCHED;
            } else {
            PG8_LDB(B0, 0, 0); PG8_SCHED; PG8_LDA(At, 0, 0); PG8_STAGE(PG8_SA(1, 1), a1 + hstep, voffA);
            PG8_WAIT_L(8); PG8_BAR; PG8_WAIT_L(0); PG8_MMA(0, 0, At, B0); PG8_BAR; PG8_SCHED;
            PG8_LDB(B1, 0, 1); PG8_STAGE(PG8_SB(0, 0), b2, voffB);
            PG8_BAR; PG8_WAIT_L(0); PG8_MMA(0, 1, At, B1); PG8_BAR;
            PG8_LDA(At, 0, 1); PG8_STAGE(PG8_SA(0, 0), a2, voffA);
            PG8_BAR; PG8_WAIT_L(0); PG8_MMA(1, 0, At, B0); PG8_BAR; PG8_SCHED;
            PG8_STAGE(PG8_SB(0, 1), b2 + hstep, voffB);
            PG8_WAIT_V(6); PG8_BAR; PG8_MMA(1, 1, At, B1); PG8_BAR;
            PG8_LDB(B0, 1, 0); PG8_SCHED; PG8_LDA(At, 1, 0); PG8_STAGE(PG8_SA(0, 1), a2 + hstep, voffA);
            PG8_WAIT_L(8); PG8_BAR; PG8_WAIT_L(0); PG8_MMA(0, 0, At, B0); PG8_BAR; PG8_SCHED;
            PG8_LDB(B1, 1, 1); PG8_STAGE(PG8_SB(1, 0), b3, voffB);
            PG8_BAR; PG8_WAIT_L(0); PG8_MMA(0, 1, At, B1); PG8_BAR;
            PG8_LDA(At, 1, 1); PG8_STAGE(PG8_SA(1, 0), a3, voffA);
            PG8_BAR; PG8_WAIT_L(0); PG8_MMA(1, 0, At, B0); PG8_BAR; PG8_SCHED;
            PG8_STAGE(PG8_SB(1, 1), b3 + hstep, voffB);
            PG8_WAIT_V(6); PG8_BAR; PG8_MMA(1, 1, At, B1); PG8_BAR;
            }
        }
        if constexpr (ALIGN_EPI) { if (wr == 0) PG8_BAR; }
        if constexpr (!Epi::AFTER_DRAIN) { E(acc, cur, wr, wc, fr, fq); S.done(cur); }
        if (!has_next) break;
#pragma unroll
        for (int a = 0; a < 2; ++a)
#pragma unroll
            for (int b = 0; b < 2; ++b)
#pragma unroll
                for (int m = 0; m < 4; ++m)
#pragma unroll
                    for (int n = 0; n < 2; ++n) acc[a][b][m][n] = (f32x4){0.f, 0.f, 0.f, 0.f};
        cur = nxt; cA = nA; cB = nB; ++ui;
        if constexpr (ALIGN_EPI) { if (wr == 1) PG8_BAR; }
    }
    PG8_WAIT_V(0);
    if constexpr (!ALIGN_EPI) { if (wr == 0) PG8_BAR; }
    PG8_BAR;
    if constexpr (Epi::AFTER_DRAIN) { E.fused(acc, cur, wr, wc, fr, fq, lds, wid, lane); S.done(cur); }
#undef PG8_SA
#undef PG8_SB
#undef PG8_STAGE
#undef PG8_LDA
#undef PG8_LDB
#undef PG8_MMA
#undef PG8_WAIT_V
#undef PG8_WAIT_L
#undef PG8_BAR
#undef PG8_SCHED
}
}
namespace attn {
typedef unsigned short bf16r;
using bf16x8 = __attribute__((ext_vector_type(8))) short;
using s16x4  = __attribute__((ext_vector_type(4))) short;
using f32x4  = __attribute__((ext_vector_type(4))) float;
using u32x4  = __attribute__((ext_vector_type(4))) unsigned;
constexpr int   QBLK = 32, KVBLK = 64;
constexpr float SCALE = 0.088388347648318440f;
constexpr float THRL = 8.f;
constexpr int LDQ = 2048, LDK = 256, LDO = 2048;
constexpr size_t SHM_ATTN = 8 * 16384 + 4096 + 8 * 64 * 4;
#define SBAR() __builtin_amdgcn_sched_barrier(0)
__device__ __forceinline__ unsigned cvtpk(float lo, float hi) { unsigned r; asm volatile("v_cvt_pk_bf16_f32 %0, %1, %2" : "=v"(r) : "v"(lo), "v"(hi)); return r; }
__device__ __forceinline__ unsigned short f2bf_rne(float f) { unsigned u = __builtin_bit_cast(unsigned, f); return (unsigned short)((u + 0x7fffu + ((u >> 16) & 1u)) >> 16); }
__device__ __forceinline__ float bfl(short b) { return __builtin_bit_cast(float, (unsigned)(unsigned short)b << 16); }
template <int OFF> __device__ __forceinline__ s16x4 tr_read(int vb) { s16x4 r; asm volatile("ds_read_b64_tr_b16 %0, %1 offset:%2" : "=&v"(r) : "v"(vb), "i"(OFF) : "memory"); return r; }

__device__ __forceinline__ void qkt16(f32x4 (&S)[4][2], const char* Ks, int kb0, const bf16x8 (&qf)[2][4], float nm0, float nm1) {
  const f32x4 n0 = {nm0, nm0, nm0, nm0}, n1 = {nm1, nm1, nm1, nm1};
  bf16x8 kf[16];
  kf[0] = *reinterpret_cast<const bf16x8*>(Ks + 0*4096 + (kb0 ^ 0));
  kf[1] = *reinterpret_cast<const bf16x8*>(Ks + 0*4096 + (kb0 ^ 64));
  kf[2] = *reinterpret_cast<const bf16x8*>(Ks + 0*4096 + (kb0 ^ 128));
  kf[3] = *reinterpret_cast<const bf16x8*>(Ks + 0*4096 + (kb0 ^ 192));
  SBAR();
  kf[4] = *reinterpret_cast<const bf16x8*>(Ks + 1*4096 + (kb0 ^ 0));
  S[0][0] = __builtin_amdgcn_mfma_f32_16x16x32_bf16(kf[0], qf[0][0], n0, 0, 0, 0); S[0][1] = __builtin_amdgcn_mfma_f32_16x16x32_bf16(kf[0], qf[1][0], n1, 0, 0, 0);
  SBAR();
  kf[5] = *reinterpret_cast<const bf16x8*>(Ks + 1*4096 + (kb0 ^ 64));
  S[0][0] = __builtin_amdgcn_mfma_f32_16x16x32_bf16(kf[1], qf[0][1], S[0][0], 0, 0, 0); S[0][1] = __builtin_amdgcn_mfma_f32_16x16x32_bf16(kf[1], qf[1][1], S[0][1], 0, 0, 0);
  SBAR();
  kf[6] = *reinterpret_cast<const bf16x8*>(Ks + 1*4096 + (kb0 ^ 128));
  S[0][0] = __builtin_amdgcn_mfma_f32_16x16x32_bf16(kf[2], qf[0][2], S[0][0], 0, 0, 0); S[0][1] = __builtin_amdgcn_mfma_f32_16x16x32_bf16(kf[2], qf[1][2], S[0][1], 0, 0, 0);
  SBAR();
  kf[7] = *reinterpret_cast<const bf16x8*>(Ks + 1*4096 + (kb0 ^ 192));
  S[0][0] = __builtin_amdgcn_mfma_f32_16x16x32_bf16(kf[3], qf[0][3], S[0][0], 0, 0, 0); S[0][1] = __builtin_amdgcn_mfma_f32_16x16x32_bf16(kf[3], qf[1][3], S[0][1], 0, 0, 0);
  SBAR();
  kf[8] = *reinterpret_cast<const bf16x8*>(Ks + 2*4096 + (kb0 ^ 0));
  S[1][0] = __builtin_amdgcn_mfma_f32_16x16x32_bf16(kf[4], qf[0][0], n0, 0, 0, 0); S[1][1] = __builtin_amdgcn_mfma_f32_16x16x32_bf16(kf[4], qf[1][0], n1, 0, 0, 0);
  SBAR();
  kf[9] = *reinterpret_cast<const bf16x8*>(Ks + 2*4096 + (kb0 ^ 64));
  S[1][0] = __builtin_amdgcn_mfma_f32_16x16x32_bf16(kf[5], qf[0][1], S[1][0], 0, 0, 0); S[1][1] = __builtin_amdgcn_mfma_f32_16x16x32_bf16(kf[5], qf[1][1], S[1][1], 0, 0, 0);
  SBAR();
  kf[10] = *reinterpret_cast<const bf16x8*>(Ks + 2*4096 + (kb0 ^ 128));
  S[1][0] = __builtin_amdgcn_mfma_f32_16x16x32_bf16(kf[6], qf[0][2], S[1][0], 0, 0, 0); S[1][1] = __builtin_amdgcn_mfma_f32_16x16x32_bf16(kf[6], qf[1][2], S[1][1], 0, 0, 0);
  SBAR();
  kf[11] = *reinterpret_cast<const bf16x8*>(Ks + 2*4096 + (kb0 ^ 192));
  S[1][0] = __builtin_amdgcn_mfma_f32_16x16x32_bf16(kf[7], qf[0][3], S[1][0], 0, 0, 0); S[1][1] = __builtin_amdgcn_mfma_f32_16x16x32_bf16(kf[7], qf[1][3], S[1][1], 0, 0, 0);
  SBAR();
  kf[12] = *reinterpret_cast<const bf16x8*>(Ks + 3*4096 + (kb0 ^ 0));
  S[2][0] = __builtin_amdgcn_mfma_f32_16x16x32_bf16(kf[8], qf[0][0], n0, 0, 0, 0); S[2][1] = __builtin_amdgcn_mfma_f32_16x16x32_bf16(kf[8], qf[1][0], n1, 0, 0, 0);
  SBAR();
  kf[13] = *reinterpret_cast<const bf16x8*>(Ks + 3*4096 + (kb0 ^ 64));
  S[2][0] = __builtin_amdgcn_mfma_f32_16x16x32_bf16(kf[9], qf[0][1], S[2][0], 0, 0, 0); S[2][1] = __builtin_amdgcn_mfma_f32_16x16x32_bf16(kf[9], qf[1][1], S[2][1], 0, 0, 0);
  SBAR();
  kf[14] = *reinterpret_cast<const bf16x8*>(Ks + 3*4096 + (kb0 ^ 128));
  S[2][0] = __builtin_amdgcn_mfma_f32_16x16x32_bf16(kf[10], qf[0][2], S[2][0], 0, 0, 0); S[2][1] = __builtin_amdgcn_mfma_f32_16x16x32_bf16(kf[10], qf[1][2], S[2][1], 0, 0, 0);
  SBAR();
  kf[15] = *reinterpret_cast<const bf16x8*>(Ks + 3*4096 + (kb0 ^ 192));
  S[2][0] = __builtin_amdgcn_mfma_f32_16x16x32_bf16(kf[11], qf[0][3], S[2][0], 0, 0, 0); S[2][1] = __builtin_amdgcn_mfma_f32_16x16x32_bf16(kf[11], qf[1][3], S[2][1], 0, 0, 0);
  SBAR();
  S[3][0] = __builtin_amdgcn_mfma_f32_16x16x32_bf16(kf[12], qf[0][0], n0, 0, 0, 0); S[3][1] = __builtin_amdgcn_mfma_f32_16x16x32_bf16(kf[12], qf[1][0], n1, 0, 0, 0);
  SBAR();
  S[3][0] = __builtin_amdgcn_mfma_f32_16x16x32_bf16(kf[13], qf[0][1], S[3][0], 0, 0, 0); S[3][1] = __builtin_amdgcn_mfma_f32_16x16x32_bf16(kf[13], qf[1][1], S[3][1], 0, 0, 0);
  SBAR();
  S[3][0] = __builtin_amdgcn_mfma_f32_16x16x32_bf16(kf[14], qf[0][2], S[3][0], 0, 0, 0); S[3][1] = __builtin_amdgcn_mfma_f32_16x16x32_bf16(kf[14], qf[1][2], S[3][1], 0, 0, 0);
  SBAR();
  S[3][0] = __builtin_amdgcn_mfma_f32_16x16x32_bf16(kf[15], qf[0][3], S[3][0], 0, 0, 0); S[3][1] = __builtin_amdgcn_mfma_f32_16x16x32_bf16(kf[15], qf[1][3], S[3][1], 0, 0, 0);
  SBAR();
}
__device__ __forceinline__ void mask_meta16(f32x4 (&S)[4][2]) {
  const float NEG = -INFINITY;
#pragma unroll
  for (int kb = 1; kb < 4; ++kb)
#pragma unroll
    for (int qb = 0; qb < 2; ++qb) S[kb][qb] = (f32x4){NEG, NEG, NEG, NEG};
}
__device__ __forceinline__ float max3f(float a, float b, float c) { float r; asm("v_max3_f32 %0, %1, %2, %3" : "=v"(r) : "v"(a), "v"(b), "v"(c)); return r; }
__device__ __forceinline__ float min2f(float a, float b) { float r; asm("v_min_f32 %0, %1, %2" : "=v"(r) : "v"(a), "v"(b)); return r; }
__device__ __forceinline__ float max2f(float a, float b) { float r; asm("v_max_f32 %0, %1, %2" : "=v"(r) : "v"(a), "v"(b)); return r; }
__device__ __forceinline__ void partial16(f32x4 (&S)[4][2], float (&mhat)[2], float (&alpha)[2], bool first) {
  float pm[2];
#pragma unroll
  for (int qb = 0; qb < 2; ++qb) { float a, b;
    asm("v_max3_f32 %0, %2, %3, %4\n\tv_max3_f32 %1, %5, %6, %7\n\tv_max3_f32 %0, %0, %8, %9\n\tv_max3_f32 %1, %1, %10, %11\n\t"
        "v_max3_f32 %0, %0, %12, %13\n\tv_max3_f32 %1, %1, %14, %15\n\tv_max3_f32 %0, %0, %16, %17\n\tv_max_f32 %0, %0, %1"
        : "=&v"(a), "=&v"(b)
        : "v"(S[0][qb][0]), "v"(S[0][qb][1]), "v"(S[0][qb][2]), "v"(S[0][qb][3]), "v"(S[1][qb][0]), "v"(S[1][qb][1]), "v"(S[1][qb][2]), "v"(S[1][qb][3]),
          "v"(S[2][qb][0]), "v"(S[2][qb][1]), "v"(S[2][qb][2]), "v"(S[2][qb][3]), "v"(S[3][qb][0]), "v"(S[3][qb][1]), "v"(S[3][qb][2]), "v"(S[3][qb][3]));
    pm[qb] = a; }
  alpha[0] = 1.f; alpha[1] = 1.f;
  if (first || __builtin_expect(__any(max2f(pm[0], pm[1]) > THRL), 0)) {
#pragma unroll
    for (int qb = 0; qb < 2; ++qb) { float m = pm[qb]; m = __builtin_fmaxf(m, __shfl_xor(m, 16)); m = __builtin_fmaxf(m, __shfl_xor(m, 32));
      const float dl = first ? m : __builtin_fmaxf(m, 0.f); mhat[qb] += dl;
#pragma unroll
      for (int kb = 0; kb < 4; ++kb) S[kb][qb] = S[kb][qb] - dl;
      if (!first) alpha[qb] = __builtin_amdgcn_exp2f(-dl); }
  }
#pragma unroll
  for (int kb = 0; kb < 2; ++kb)
#pragma unroll
    for (int qb = 0; qb < 2; ++qb)
#pragma unroll
      for (int r = 0; r < 4; ++r) S[kb][qb][r] = __builtin_amdgcn_exp2f(S[kb][qb][r]);
}
__device__ __forceinline__ void finish16(f32x4 (&S)[4][2], const float (&alpha)[2], float (&lsum)[2], bf16x8 (&pa)[2][2]) {
#pragma unroll
  for (int kb = 2; kb < 4; ++kb)
#pragma unroll
    for (int qb = 0; qb < 2; ++qb)
#pragma unroll
      for (int r = 0; r < 4; ++r) S[kb][qb][r] = __builtin_amdgcn_exp2f(S[kb][qb][r]);
#pragma unroll
  for (int qb = 0; qb < 2; ++qb) { float ps = 0.f;
#pragma unroll
    for (int kb = 0; kb < 4; ++kb) ps += (S[kb][qb][0] + S[kb][qb][1]) + (S[kb][qb][2] + S[kb][qb][3]);
    lsum[qb] = lsum[qb] * alpha[qb] + ps;
#pragma unroll
    for (int ks = 0; ks < 2; ++ks) { const f32x4 a = S[2 * ks][qb], b = S[2 * ks + 1][qb];
      u32x4 w = {cvtpk(a[0], a[1]), cvtpk(a[2], a[3]), cvtpk(b[0], b[1]), cvtpk(b[2], b[3])}; pa[qb][ks] = *reinterpret_cast<bf16x8*>(&w); } }
}
template <int OFF> __device__ __forceinline__ s16x4 tr_ld(int vb) { typedef __attribute__((address_space(3))) s16x4* lp_t; return __builtin_amdgcn_ds_read_tr16_b64_v4i16((lp_t)(unsigned)(vb + OFF)); }
__device__ __forceinline__ void pv16(f32x4 (&O)[2][8], int vbA, int vbB, const bf16x8 (&pa)[2][2]) {
  s16x4 lo[16], hi[16];
  lo[0] = tr_ld<0*1024 + 128*0>(vbA); hi[0] = tr_ld<4*1024 + 128*0>(vbA);
  lo[1] = tr_ld<0*1024 + 128*1>(vbA); hi[1] = tr_ld<4*1024 + 128*1>(vbA);
  lo[2] = tr_ld<0*1024 + 128*2>(vbA); hi[2] = tr_ld<4*1024 + 128*2>(vbA);
  lo[3] = tr_ld<0*1024 + 128*3>(vbA); hi[3] = tr_ld<4*1024 + 128*3>(vbA);
  SBAR();
  lo[4] = tr_ld<0*1024 + 128*4>(vbA); hi[4] = tr_ld<4*1024 + 128*4>(vbA);
  { const bf16x8 bfr = {lo[0][0], lo[0][1], lo[0][2], lo[0][3], hi[0][0], hi[0][1], hi[0][2], hi[0][3]};
    O[0][0] = __builtin_amdgcn_mfma_f32_16x16x32_bf16(pa[0][0], bfr, O[0][0], 0, 0, 0); O[1][0] = __builtin_amdgcn_mfma_f32_16x16x32_bf16(pa[1][0], bfr, O[1][0], 0, 0, 0); }
  SBAR();
  lo[5] = tr_ld<0*1024 + 128*5>(vbA); hi[5] = tr_ld<4*1024 + 128*5>(vbA);
  { const bf16x8 bfr = {lo[1][0], lo[1][1], lo[1][2], lo[1][3], hi[1][0], hi[1][1], hi[1][2], hi[1][3]};
    O[0][1] = __builtin_amdgcn_mfma_f32_16x16x32_bf16(pa[0][0], bfr, O[0][1], 0, 0, 0); O[1][1] = __builtin_amdgcn_mfma_f32_16x16x32_bf16(pa[1][0], bfr, O[1][1], 0, 0, 0); }
  SBAR();
  lo[6] = tr_ld<0*1024 + 128*6>(vbA); hi[6] = tr_ld<4*1024 + 128*6>(vbA);
  { const bf16x8 bfr = {lo[2][0], lo[2][1], lo[2][2], lo[2][3], hi[2][0], hi[2][1], hi[2][2], hi[2][3]};
    O[0][2] = __builtin_amdgcn_mfma_f32_16x16x32_bf16(pa[0][0], bfr, O[0][2], 0, 0, 0); O[1][2] = __builtin_amdgcn_mfma_f32_16x16x32_bf16(pa[1][0], bfr, O[1][2], 0, 0, 0); }
  SBAR();
  lo[7] = tr_ld<0*1024 + 128*7>(vbB); hi[7] = tr_ld<4*1024 + 128*7>(vbB);
  { const bf16x8 bfr = {lo[3][0], lo[3][1], lo[3][2], lo[3][3], hi[3][0], hi[3][1], hi[3][2], hi[3][3]};
    O[0][3] = __builtin_amdgcn_mfma_f32_16x16x32_bf16(pa[0][0], bfr, O[0][3], 0, 0, 0); O[1][3] = __builtin_amdgcn_mfma_f32_16x16x32_bf16(pa[1][0], bfr, O[1][3], 0, 0, 0); }
  SBAR();
  lo[8] = tr_ld<8*1024 + 128*0>(vbA); hi[8] = tr_ld<12*1024 + 128*0>(vbA);
  { const bf16x8 bfr = {lo[4][0], lo[4][1], lo[4][2], lo[4][3], hi[4][0], hi[4][1], hi[4][2], hi[4][3]};
    O[0][4] = __builtin_amdgcn_mfma_f32_16x16x32_bf16(pa[0][0], bfr, O[0][4], 0, 0, 0); O[1][4] = __builtin_amdgcn_mfma_f32_16x16x32_bf16(pa[1][0], bfr, O[1][4], 0, 0, 0); }
  SBAR();
  lo[9] = tr_ld<8*1024 + 128*1>(vbA); hi[9] = tr_ld<12*1024 + 128*1>(vbA);
  { const bf16x8 bfr = {lo[5][0], lo[5][1], lo[5][2], lo[5][3], hi[5][0], hi[5][1], hi[5][2], hi[5][3]};
    O[0][5] = __builtin_amdgcn_mfma_f32_16x16x32_bf16(pa[0][0], bfr, O[0][5], 0, 0, 0); O[1][5] = __builtin_amdgcn_mfma_f32_16x16x32_bf16(pa[1][0], bfr, O[1][5], 0, 0, 0); }
  SBAR();
  lo[10] = tr_ld<8*1024 + 128*2>(vbA); hi[10] = tr_ld<12*1024 + 128*2>(vbA);
  { const bf16x8 bfr = {lo[6][0], lo[6][1], lo[6][2], lo[6][3], hi[6][0], hi[6][1], hi[6][2], hi[6][3]};
    O[0][6] = __builtin_amdgcn_mfma_f32_16x16x32_bf16(pa[0][0], bfr, O[0][6], 0, 0, 0); O[1][6] = __builtin_amdgcn_mfma_f32_16x16x32_bf16(pa[1][0], bfr, O[1][6], 0, 0, 0); }
  SBAR();
  lo[11] = tr_ld<8*1024 + 128*3>(vbA); hi[11] = tr_ld<12*1024 + 128*3>(vbA);
  { const bf16x8 bfr = {lo[7][0], lo[7][1], lo[7][2], lo[7][3], hi[7][0], hi[7][1], hi[7][2], hi[7][3]};
    O[0][7] = __builtin_amdgcn_mfma_f32_16x16x32_bf16(pa[0][0], bfr, O[0][7], 0, 0, 0); O[1][7] = __builtin_amdgcn_mfma_f32_16x16x32_bf16(pa[1][0], bfr, O[1][7], 0, 0, 0); }
  SBAR();
  lo[12] = tr_ld<8*1024 + 128*4>(vbA); hi[12] = tr_ld<12*1024 + 128*4>(vbA);
  { const bf16x8 bfr = {lo[8][0], lo[8][1], lo[8][2], lo[8][3], hi[8][0], hi[8][1], hi[8][2], hi[8][3]};
    O[0][0] = __builtin_amdgcn_mfma_f32_16x16x32_bf16(pa[0][1], bfr, O[0][0], 0, 0, 0); O[1][0] = __builtin_amdgcn_mfma_f32_16x16x32_bf16(pa[1][1], bfr, O[1][0], 0, 0, 0); }
  SBAR();
  lo[13] = tr_ld<8*1024 + 128*5>(vbA); hi[13] = tr_ld<12*1024 + 128*5>(vbA);
  { const bf16x8 bfr = {lo[9][0], lo[9][1], lo[9][2], lo[9][3], hi[9][0], hi[9][1], hi[9][2], hi[9][3]};
    O[0][1] = __builtin_amdgcn_mfma_f32_16x16x32_bf16(pa[0][1], bfr, O[0][1], 0, 0, 0); O[1][1] = __builtin_amdgcn_mfma_f32_16x16x32_bf16(pa[1][1], bfr, O[1][1], 0, 0, 0); }
  SBAR();
  lo[14] = tr_ld<8*1024 + 128*6>(vbA); hi[14] = tr_ld<12*1024 + 128*6>(vbA);
  { const bf16x8 bfr = {lo[10][0], lo[10][1], lo[10][2], lo[10][3], hi[10][0], hi[10][1], hi[10][2], hi[10][3]};
    O[0][2] = __builtin_amdgcn_mfma_f32_16x16x32_bf16(pa[0][1], bfr, O[0][2], 0, 0, 0); O[1][2] = __builtin_amdgcn_mfma_f32_16x16x32_bf16(pa[1][1], bfr, O[1][2], 0, 0, 0); }
  SBAR();
  lo[15] = tr_ld<8*1024 + 128*7>(vbB); hi[15] = tr_ld<12*1024 + 128*7>(vbB);
  { const bf16x8 bfr = {lo[11][0], lo[11][1], lo[11][2], lo[11][3], hi[11][0], hi[11][1], hi[11][2], hi[11][3]};
    O[0][3] = __builtin_amdgcn_mfma_f32_16x16x32_bf16(pa[0][1], bfr, O[0][3], 0, 0, 0); O[1][3] = __builtin_amdgcn_mfma_f32_16x16x32_bf16(pa[1][1], bfr, O[1][3], 0, 0, 0); }
  SBAR();
  { const bf16x8 bfr = {lo[12][0], lo[12][1], lo[12][2], lo[12][3], hi[12][0], hi[12][1], hi[12][2], hi[12][3]};
    O[0][4] = __builtin_amdgcn_mfma_f32_16x16x32_bf16(pa[0][1], bfr, O[0][4], 0, 0, 0); O[1][4] = __builtin_amdgcn_mfma_f32_16x16x32_bf16(pa[1][1], bfr, O[1][4], 0, 0, 0); }
  SBAR();
  { const bf16x8 bfr = {lo[13][0], lo[13][1], lo[13][2], lo[13][3], hi[13][0], hi[13][1], hi[13][2], hi[13][3]};
    O[0][5] = __builtin_amdgcn_mfma_f32_16x16x32_bf16(pa[0][1], bfr, O[0][5], 0, 0, 0); O[1][5] = __builtin_amdgcn_mfma_f32_16x16x32_bf16(pa[1][1], bfr, O[1][5], 0, 0, 0); }
  SBAR();
  { const bf16x8 bfr = {lo[14][0], lo[14][1], lo[14][2], lo[14][3], hi[14][0], hi[14][1], hi[14][2], hi[14][3]};
    O[0][6] = __builtin_amdgcn_mfma_f32_16x16x32_bf16(pa[0][1], bfr, O[0][6], 0, 0, 0); O[1][6] = __builtin_amdgcn_mfma_f32_16x16x32_bf16(pa[1][1], bfr, O[1][6], 0, 0, 0); }
  SBAR();
  { const bf16x8 bfr = {lo[15][0], lo[15][1], lo[15][2], lo[15][3], hi[15][0], hi[15][1], hi[15][2], hi[15][3]};
    O[0][7] = __builtin_amdgcn_mfma_f32_16x16x32_bf16(pa[0][1], bfr, O[0][7], 0, 0, 0); O[1][7] = __builtin_amdgcn_mfma_f32_16x16x32_bf16(pa[1][1], bfr, O[1][7], 0, 0, 0); }
  SBAR();
}
__device__ __forceinline__ void qk_pv16(f32x4 (&S)[4][2], const char* Ks, int kb0, const bf16x8 (&qf)[2][4], float nm0, float nm1, f32x4 (&O)[2][8], int vbA, int vbB, const bf16x8 (&pa)[2][2]) {
  const f32x4 n0 = {nm0, nm0, nm0, nm0}, n1 = {nm1, nm1, nm1, nm1};
  bf16x8 kf[16]; s16x4 lo[16], hi[16];
  kf[0] = *reinterpret_cast<const bf16x8*>(Ks + 0*4096 + (kb0 ^ 0));
  kf[1] = *reinterpret_cast<const bf16x8*>(Ks + 0*4096 + (kb0 ^ 64));
  kf[2] = *reinterpret_cast<const bf16x8*>(Ks + 0*4096 + (kb0 ^ 128));
  kf[3] = *reinterpret_cast<const bf16x8*>(Ks + 0*4096 + (kb0 ^ 192));
  SBAR();
  kf[4] = *reinterpret_cast<const bf16x8*>(Ks + 1*4096 + (kb0 ^ 0));
  S[0][0] = __builtin_amdgcn_mfma_f32_16x16x32_bf16(kf[0], qf[0][0], n0, 0, 0, 0); S[0][1] = __builtin_amdgcn_mfma_f32_16x16x32_bf16(kf[0], qf[1][0], n1, 0, 0, 0);
  SBAR();
  kf[5] = *reinterpret_cast<const bf16x8*>(Ks + 1*4096 + (kb0 ^ 64));
  S[0][0] = __builtin_amdgcn_mfma_f32_16x16x32_bf16(kf[1], qf[0][1], S[0][0], 0, 0, 0); S[0][1] = __builtin_amdgcn_mfma_f32_16x16x32_bf16(kf[1], qf[1][1], S[0][1], 0, 0, 0);
  SBAR();
  kf[6] = *reinterpret_cast<const bf16x8*>(Ks + 1*4096 + (kb0 ^ 128));
  S[0][0] = __builtin_amdgcn_mfma_f32_16x16x32_bf16(kf[2], qf[0][2], S[0][0], 0, 0, 0); S[0][1] = __builtin_amdgcn_mfma_f32_16x16x32_bf16(kf[2], qf[1][2], S[0][1], 0, 0, 0);
  SBAR();
  kf[7] = *reinterpret_cast<const bf16x8*>(Ks + 1*4096 + (kb0 ^ 192));
  S[0][0] = __builtin_amdgcn_mfma_f32_16x16x32_bf16(kf[3], qf[0][3], S[0][0], 0, 0, 0); S[0][1] = __builtin_amdgcn_mfma_f32_16x16x32_bf16(kf[3], qf[1][3], S[0][1], 0, 0, 0);
  SBAR();
  kf[8] = *reinterpret_cast<const bf16x8*>(Ks + 2*4096 + (kb0 ^ 0));
  S[1][0] = __builtin_amdgcn_mfma_f32_16x16x32_bf16(kf[4], qf[0][0], n0, 0, 0, 0); S[1][1] = __builtin_amdgcn_mfma_f32_16x16x32_bf16(kf[4], qf[1][0], n1, 0, 0, 0);
  SBAR();
  kf[9] = *reinterpret_cast<const bf16x8*>(Ks + 2*4096 + (kb0 ^ 64));
  S[1][0] = __builtin_amdgcn_mfma_f32_16x16x32_bf16(kf[5], qf[0][1], S[1][0], 0, 0, 0); S[1][1] = __builtin_amdgcn_mfma_f32_16x16x32_bf16(kf[5], qf[1][1], S[1][1], 0, 0, 0);
  SBAR();
  kf[10] = *reinterpret_cast<const bf16x8*>(Ks + 2*4096 + (kb0 ^ 128));
  S[1][0] = __builtin_amdgcn_mfma_f32_16x16x32_bf16(kf[6], qf[0][2], S[1][0], 0, 0, 0); S[1][1] = __builtin_amdgcn_mfma_f32_16x16x32_bf16(kf[6], qf[1][2], S[1][1], 0, 0, 0);
  SBAR();
  kf[11] = *reinterpret_cast<const bf16x8*>(Ks + 2*4096 + (kb0 ^ 192));
  S[1][0] = __builtin_amdgcn_mfma_f32_16x16x32_bf16(kf[7], qf[0][3], S[1][0], 0, 0, 0); S[1][1] = __builtin_amdgcn_mfma_f32_16x16x32_bf16(kf[7], qf[1][3], S[1][1], 0, 0, 0);
  SBAR();
  kf[12] = *reinterpret_cast<const bf16x8*>(Ks + 3*4096 + (kb0 ^ 0));
  S[2][0] = __builtin_amdgcn_mfma_f32_16x16x32_bf16(kf[8], qf[0][0], n0, 0, 0, 0); S[2][1] = __builtin_amdgcn_mfma_f32_16x16x32_bf16(kf[8], qf[1][0], n1, 0, 0, 0);
  SBAR();
  kf[13] = *reinterpret_cast<const bf16x8*>(Ks + 3*4096 + (kb0 ^ 64));
  S[2][0] = __builtin_amdgcn_mfma_f32_16x16x32_bf16(kf[9], qf[0][1], S[2][0], 0, 0, 0); S[2][1] = __builtin_amdgcn_mfma_f32_16x16x32_bf16(kf[9], qf[1][1], S[2][1], 0, 0, 0);
  SBAR();
  kf[14] = *reinterpret_cast<const bf16x8*>(Ks + 3*4096 + (kb0 ^ 128));
  S[2][0] = __builtin_amdgcn_mfma_f32_16x16x32_bf16(kf[10], qf[0][2], S[2][0], 0, 0, 0); S[2][1] = __builtin_amdgcn_mfma_f32_16x16x32_bf16(kf[10], qf[1][2], S[2][1], 0, 0, 0);
  SBAR();
  kf[15] = *reinterpret_cast<const bf16x8*>(Ks + 3*4096 + (kb0 ^ 192));
  S[2][0] = __builtin_amdgcn_mfma_f32_16x16x32_bf16(kf[11], qf[0][3], S[2][0], 0, 0, 0); S[2][1] = __builtin_amdgcn_mfma_f32_16x16x32_bf16(kf[11], qf[1][3], S[2][1], 0, 0, 0);
  SBAR();
  S[3][0] = __builtin_amdgcn_mfma_f32_16x16x32_bf16(kf[12], qf[0][0], n0, 0, 0, 0); S[3][1] = __builtin_amdgcn_mfma_f32_16x16x32_bf16(kf[12], qf[1][0], n1, 0, 0, 0);
  lo[0] = tr_ld<0*1024 + 128*0>(vbA); hi[0] = tr_ld<4*1024 + 128*0>(vbA);
  lo[1] = tr_ld<0*1024 + 128*1>(vbA); hi[1] = tr_ld<4*1024 + 128*1>(vbA);
  lo[2] = tr_ld<0*1024 + 128*2>(vbA); hi[2] = tr_ld<4*1024 + 128*2>(vbA);
  lo[3] = tr_ld<0*1024 + 128*3>(vbA); hi[3] = tr_ld<4*1024 + 128*3>(vbA);
  SBAR();
  S[3][0] = __builtin_amdgcn_mfma_f32_16x16x32_bf16(kf[13], qf[0][1], S[3][0], 0, 0, 0); S[3][1] = __builtin_amdgcn_mfma_f32_16x16x32_bf16(kf[13], qf[1][1], S[3][1], 0, 0, 0);
  SBAR();
  S[3][0] = __builtin_amdgcn_mfma_f32_16x16x32_bf16(kf[14], qf[0][2], S[3][0], 0, 0, 0); S[3][1] = __builtin_amdgcn_mfma_f32_16x16x32_bf16(kf[14], qf[1][2], S[3][1], 0, 0, 0);
  SBAR();
  S[3][0] = __builtin_amdgcn_mfma_f32_16x16x32_bf16(kf[15], qf[0][3], S[3][0], 0, 0, 0); S[3][1] = __builtin_amdgcn_mfma_f32_16x16x32_bf16(kf[15], qf[1][3], S[3][1], 0, 0, 0);
  SBAR();
  lo[4] = tr_ld<0*1024 + 128*4>(vbA); hi[4] = tr_ld<4*1024 + 128*4>(vbA);
  { const bf16x8 bfr = {lo[0][0], lo[0][1], lo[0][2], lo[0][3], hi[0][0], hi[0][1], hi[0][2], hi[0][3]};
    O[0][0] = __builtin_amdgcn_mfma_f32_16x16x32_bf16(pa[0][0], bfr, O[0][0], 0, 0, 0); O[1][0] = __builtin_amdgcn_mfma_f32_16x16x32_bf16(pa[1][0], bfr, O[1][0], 0, 0, 0); }
  SBAR();
  lo[5] = tr_ld<0*1024 + 128*5>(vbA); hi[5] = tr_ld<4*1024 + 128*5>(vbA);
  { const bf16x8 bfr = {lo[1][0], lo[1][1], lo[1][2], lo[1][3], hi[1][0], hi[1][1], hi[1][2], hi[1][3]};
    O[0][1] = __builtin_amdgcn_mfma_f32_16x16x32_bf16(pa[0][0], bfr, O[0][1], 0, 0, 0); O[1][1] = __builtin_amdgcn_mfma_f32_16x16x32_bf16(pa[1][0], bfr, O[1][1], 0, 0, 0); }
  SBAR();
  lo[6] = tr_ld<0*1024 + 128*6>(vbA); hi[6] = tr_ld<4*1024 + 128*6>(vbA);
  { const bf16x8 bfr = {lo[2][0], lo[2][1], lo[2][2], lo[2][3], hi[2][0], hi[2][1], hi[2][2], hi[2][3]};
    O[0][2] = __builtin_amdgcn_mfma_f32_16x16x32_bf16(pa[0][0], bfr, O[0][2], 0, 0, 0); O[1][2] = __builtin_amdgcn_mfma_f32_16x16x32_bf16(pa[1][0], bfr, O[1][2], 0, 0, 0); }
  SBAR();
  lo[7] = tr_ld<0*1024 + 128*7>(vbB); hi[7] = tr_ld<4*1024 + 128*7>(vbB);
  { const bf16x8 bfr = {lo[3][0], lo[3][1], lo[3][2], lo[3][3], hi[3][0], hi[3][1], hi[3][2], hi[3][3]};
    O[0][3] = __builtin_amdgcn_mfma_f32_16x16x32_bf16(pa[0][0], bfr, O[0][3], 0, 0, 0); O[1][3] = __builtin_amdgcn_mfma_f32_16x16x32_bf16(pa[1][0], bfr, O[1][3], 0, 0, 0); }
  SBAR();
  lo[8] = tr_ld<8*1024 + 128*0>(vbA); hi[8] = tr_ld<12*1024 + 128*0>(vbA);
  { const bf16x8 bfr = {lo[4][0], lo[4][1], lo[4][2], lo[4][3], hi[4][0], hi[4][1], hi[4][2], hi[4][3]};
    O[0][4] = __builtin_amdgcn_mfma_f32_16x16x32_bf16(pa[0][0], bfr, O[0][4], 0, 0, 0); O[1][4] = __builtin_amdgcn_mfma_f32_16x16x32_bf16(pa[1][0], bfr, O[1][4], 0, 0, 0); }
  SBAR();
  lo[9] = tr_ld<8*1024 + 128*1>(vbA); hi[9] = tr_ld<12*1024 + 128*1>(vbA);
  { const bf16x8 bfr = {lo[5][0], lo[5][1], lo[5][2], lo[5][3], hi[5][0], hi[5][1], hi[5][2], hi[5][3]};
    O[0][5] = __builtin_amdgcn_mfma_f32_16x16x32_bf16(pa[0][0], bfr, O[0][5], 0, 0, 0); O[1][5] = __builtin_amdgcn_mfma_f32_16x16x32_bf16(pa[1][0], bfr, O[1][5], 0, 0, 0); }
  SBAR();
  lo[10] = tr_ld<8*1024 + 128*2>(vbA); hi[10] = tr_ld<12*1024 + 128*2>(vbA);
  { const bf16x8 bfr = {lo[6][0], lo[6][1], lo[6][2], lo[6][3], hi[6][0], hi[6][1], hi[6][2], hi[6][3]};
    O[0][6] = __builtin_amdgcn_mfma_f32_16x16x32_bf16(pa[0][0], bfr, O[0][6], 0, 0, 0); O[1][6] = __builtin_amdgcn_mfma_f32_16x16x32_bf16(pa[1][0], bfr, O[1][6], 0, 0, 0); }
  SBAR();
  lo[11] = tr_ld<8*1024 + 128*3>(vbA); hi[11] = tr_ld<12*1024 + 128*3>(vbA);
  { const bf16x8 bfr = {lo[7][0], lo[7][1], lo[7][2], lo[7][3], hi[7][0], hi[7][1], hi[7][2], hi[7][3]};
    O[0][7] = __builtin_amdgcn_mfma_f32_16x16x32_bf16(pa[0][0], bfr, O[0][7], 0, 0, 0); O[1][7] = __builtin_amdgcn_mfma_f32_16x16x32_bf16(pa[1][0], bfr, O[1][7], 0, 0, 0); }
  SBAR();
  lo[12] = tr_ld<8*1024 + 128*4>(vbA); hi[12] = tr_ld<12*1024 + 128*4>(vbA);
  { const bf16x8 bfr = {lo[8][0], lo[8][1], lo[8][2], lo[8][3], hi[8][0], hi[8][1], hi[8][2], hi[8][3]};
    O[0][0] = __builtin_amdgcn_mfma_f32_16x16x32_bf16(pa[0][1], bfr, O[0][0], 0, 0, 0); O[1][0] = __builtin_amdgcn_mfma_f32_16x16x32_bf16(pa[1][1], bfr, O[1][0], 0, 0, 0); }
  SBAR();
  lo[13] = tr_ld<8*1024 + 128*5>(vbA); hi[13] = tr_ld<12*1024 + 128*5>(vbA);
  { const bf16x8 bfr = {lo[9][0], lo[9][1], lo[9][2], lo[9][3], hi[9][0], hi[9][1], hi[9][2], hi[9][3]};
    O[0][1] = __builtin_amdgcn_mfma_f32_16x16x32_bf16(pa[0][1], bfr, O[0][1], 0, 0, 0); O[1][1] = __builtin_amdgcn_mfma_f32_16x16x32_bf16(pa[1][1], bfr, O[1][1], 0, 0, 0); }
  SBAR();
  lo[14] = tr_ld<8*1024 + 128*6>(vbA); hi[14] = tr_ld<12*1024 + 128*6>(vbA);
  { const bf16x8 bfr = {lo[10][0], lo[10][1], lo[10][2], lo[10][3], hi[10][0], hi[10][1], hi[10][2], hi[10][3]};
    O[0][2] = __builtin_amdgcn_mfma_f32_16x16x32_bf16(pa[0][1], bfr, O[0][2], 0, 0, 0); O[1][2] = __builtin_amdgcn_mfma_f32_16x16x32_bf16(pa[1][1], bfr, O[1][2], 0, 0, 0); }
  SBAR();
  lo[15] = tr_ld<8*1024 + 128*7>(vbB); hi[15] = tr_ld<12*1024 + 128*7>(vbB);
  { const bf16x8 bfr = {lo[11][0], lo[11][1], lo[11][2], lo[11][3], hi[11][0], hi[11][1], hi[11][2], hi[11][3]};
    O[0][3] = __builtin_amdgcn_mfma_f32_16x16x32_bf16(pa[0][1], bfr, O[0][3], 0, 0, 0); O[1][3] = __builtin_amdgcn_mfma_f32_16x16x32_bf16(pa[1][1], bfr, O[1][3], 0, 0, 0); }
  SBAR();
  { const bf16x8 bfr = {lo[12][0], lo[12][1], lo[12][2], lo[12][3], hi[12][0], hi[12][1], hi[12][2], hi[12][3]};
    O[0][4] = __builtin_amdgcn_mfma_f32_16x16x32_bf16(pa[0][1], bfr, O[0][4], 0, 0, 0); O[1][4] = __builtin_amdgcn_mfma_f32_16x16x32_bf16(pa[1][1], bfr, O[1][4], 0, 0, 0); }
  SBAR();
  { const bf16x8 bfr = {lo[13][0], lo[13][1], lo[13][2], lo[13][3], hi[13][0], hi[13][1], hi[13][2], hi[13][3]};
    O[0][5] = __builtin_amdgcn_mfma_f32_16x16x32_bf16(pa[0][1], bfr, O[0][5], 0, 0, 0); O[1][5] = __builtin_amdgcn_mfma_f32_16x16x32_bf16(pa[1][1], bfr, O[1][5], 0, 0, 0); }
  SBAR();
  { const bf16x8 bfr = {lo[14][0], lo[14][1], lo[14][2], lo[14][3], hi[14][0], hi[14][1], hi[14][2], hi[14][3]};
    O[0][6] = __builtin_amdgcn_mfma_f32_16x16x32_bf16(pa[0][1], bfr, O[0][6], 0, 0, 0); O[1][6] = __builtin_amdgcn_mfma_f32_16x16x32_bf16(pa[1][1], bfr, O[1][6], 0, 0, 0); }
  SBAR();
  { const bf16x8 bfr = {lo[15][0], lo[15][1], lo[15][2], lo[15][3], hi[15][0], hi[15][1], hi[15][2], hi[15][3]};
    O[0][7] = __builtin_amdgcn_mfma_f32_16x16x32_bf16(pa[0][1], bfr, O[0][7], 0, 0, 0); O[1][7] = __builtin_amdgcn_mfma_f32_16x16x32_bf16(pa[1][1], bfr, O[1][7], 0, 0, 0); }
  SBAR();
}

__device__ __forceinline__ void attn_unit(const bf16r* Qb, const bf16r* __restrict__ Kh, const bf16r* __restrict__ Vh,
                                          const bf16r* __restrict__ KMh, const bf16r* __restrict__ VMh, bf16r* Ob, int NT, char* lds,
                                          const float* __restrict__ qnorm, int t0, float* ssq, int wave_id) {
  int tid_ = wave_id * 64 + lane_id_now(); asm volatile("" : "+v"(tid_));
  const int tid = tid_, wid = tid >> 6, lane = tid & 63, c = lane & 15, g = lane >> 4;
  float* ws = (float*)(lds + 8 * 16384 + 4096) + wid * 64; float* li_l = ws; float* al_l = ws + 32;
  float mhat[2] = {0.f, 0.f}, lsum[2] = {0.f, 0.f};
  f32x4 O[2][8];
#pragma unroll
  for (int qb = 0; qb < 2; ++qb)
#pragma unroll
    for (int db = 0; db < 8; ++db) O[qb][db] = (f32x4){0.f, 0.f, 0.f, 0.f};
  unsigned kgo0, vgo0;
  { const int k0 = 4 * wid + g; kgo0 = (unsigned)(k0 * (LDK * 2) + ((c << 4) ^ ((k0 & 15) << 4)));
    const int r = (lane >> 1) & 3, half = lane & 1, s8 = lane >> 3;
    { const int p = wid,     db = (s8 - (p & 1)) & 7; vgo0 = (unsigned)((4 * p + r) * (LDK * 2) + (16 * db + 8 * half) * 2); }
 }
  const int kb0 = c * 256 + ((g ^ c) << 4);
  typedef __attribute__((address_space(3))) unsigned char* ldsp_t;
  const ldsp_t lds3 = (ldsp_t)lds;
  const int w1k = __builtin_amdgcn_readfirstlane(wid) * 1024;
  constexpr int VRING = 4 * 16384;
#define DMA16(gp, la) do { const unsigned la_ = __builtin_amdgcn_readfirstlane((unsigned)(uintptr_t)(la)); \
    asm volatile("s_mov_b32 m0, %1\n\ts_nop 0\n\tglobal_load_lds_dwordx4 %0, off" :: "v"(gp), "s"(la_) : "memory", "m0"); } while (0)
#define DMAK(t, soff) do { const char* b_ = (const char*)((t) == 0 ? KMh : Kh + (long)((t) - 1) * KVBLK * LDK); \
    DMA16(b_ + kgo0, lds3 + (soff) + w1k); DMA16(b_ + kgo0 + 32 * LDK * 2, lds3 + (soff) + w1k + 8192); } while (0)
#define DMAV(t, soff) do { const char* b_ = (const char*)((t) == 0 ? VMh : Vh + (long)((t) - 1) * KVBLK * LDK); \
    DMA16(b_ + vgo0, lds3 + VRING + (soff) + w1k); DMA16(b_ + vgo0 + 32 * LDK * 2, lds3 + VRING + (soff) + w1k + 8192); } while (0)
#define WAITBAR(N) asm volatile("s_waitcnt vmcnt(" #N ") lgkmcnt(0)\n\ts_barrier" ::: "memory")
#define RESC(a) do { if (__any(min2f((a)[0], (a)[1]) < 1.f)) { if (g == 0) { al_l[c] = (a)[0]; al_l[16 + c] = (a)[1]; } asm volatile("s_waitcnt lgkmcnt(0)" ::: "memory"); \
    _Pragma("unroll") for (int qb_ = 0; qb_ < 2; ++qb_) _Pragma("unroll") for (int r_ = 0; r_ < 4; ++r_) { const float a_ = al_l[16 * qb_ + 4 * g + r_]; \
      _Pragma("unroll") for (int db_ = 0; db_ < 8; ++db_) O[qb_][db_][r_] *= a_; } } } while (0)
#define SLOT(t) (((t) & 3) * 16384)
  DMAK(0, SLOT(0)); DMAV(0, SLOT(0)); DMAK(1, SLOT(1)); DMAK(2, SLOT(2)); DMAV(1, SLOT(1));
  bf16x8 qf[2][4];
#pragma unroll
  for (int qb = 0; qb < 2; ++qb)
#pragma unroll
    for (int ds = 0; ds < 4; ++ds) qf[qb][ds] = *reinterpret_cast<const bf16x8*>(Qb + (long)(wid * QBLK + 16 * qb + c) * LDQ + 32 * ds + 8 * g);
  {
    int go = g; asm volatile("" : "+v"(go));
#pragma unroll
    for (int qb = 0; qb < 2; ++qb) {
      float ss = 0.f;
#pragma unroll
      for (int ds = 0; ds < 4; ++ds)
#pragma unroll
        for (int j = 0; j < 8; ++j) { const float x = bfl(qf[qb][ds][j]); ss += x * x; }
      ss += __shfl_xor(ss, 16); ss += __shfl_xor(ss, 32);
      const float rs = (SCALE * 1.4426950408889634f) / sqrtf(ss * (1.f / 128.f) + 1e-6f);
      int t = t0 + wid * QBLK + 16 * qb + c; asm volatile("" : "+v"(t));
#pragma unroll
      for (int p = 0; p < 2; ++p) { const float pos = (float)(p ? (t & 63) : (t >> 6)); const int fa = 2 * p, fb = 2 * p + 1;
        const float4 ga0 = *reinterpret_cast<const float4*>(qnorm + 32 * fa + 8 * g), ga1 = *reinterpret_cast<const float4*>(qnorm + 32 * fa + 8 * g + 4);
        const float4 gb0 = *reinterpret_cast<const float4*>(qnorm + 32 * fb + 8 * g), gb1 = *reinterpret_cast<const float4*>(qnorm + 32 * fb + 8 * g + 4);
        const float gaf[8] = {ga0.x, ga0.y, ga0.z, ga0.w, ga1.x, ga1.y, ga1.z, ga1.w}, gbf[8] = {gb0.x, gb0.y, gb0.z, gb0.w, gb1.x, gb1.y, gb1.z, gb1.w};
        float oa[8], ob[8];
#pragma unroll
        for (int j = 0; j < 8; ++j) { const int i = 8 * go + j;
          float rev = pos * __builtin_amdgcn_exp2f(-(float)i * (13.287712379549449f / 32.f)) * 0.15915494309189535f; rev -= floorf(rev);
          const float sn = __builtin_amdgcn_sinf(rev), cs = __builtin_amdgcn_cosf(rev);
          const float x1 = bfl(qf[qb][fa][j]) * rs * gaf[j], x2 = bfl(qf[qb][fb][j]) * rs * gbf[j];
          oa[j] = x1 * cs - x2 * sn; ob[j] = x2 * cs + x1 * sn; }
        { u32x4 w = {cvtpk(oa[0], oa[1]), cvtpk(oa[2], oa[3]), cvtpk(oa[4], oa[5]), cvtpk(oa[6], oa[7])}; qf[qb][fa] = *reinterpret_cast<bf16x8*>(&w); }
        { u32x4 w = {cvtpk(ob[0], ob[1]), cvtpk(ob[2], ob[3]), cvtpk(ob[4], ob[5]), cvtpk(ob[6], ob[7])}; qf[qb][fb] = *reinterpret_cast<bf16x8*>(&w); }
        SBAR(); }
    }
  }
  const int vlb = (int)(uintptr_t)(lds + VRING) + g * 1024 + (c >> 2) * 32 + (c & 3) * 8;
  const int vbA0 = vlb + (g & 1) * 128, vbB0 = vlb + (g & 1) * (128 - 1024);
  f32x4 S[4][2]; bf16x8 paA[2][2], paB[2][2]; float al[2];
  WAITBAR(0);
  qkt16(S, lds + SLOT(0), kb0, qf, -mhat[0], -mhat[1]); mask_meta16(S); partial16(S, mhat, al, true); finish16(S, al, lsum, paA);
  WAITBAR(0);
  for (int t = 1; t + 1 < NT; t += 2) {
    if (t + 2 < NT) DMAK(t + 2, SLOT(t + 2)); if (t + 3 < NT) DMAK(t + 3, SLOT(t + 3)); DMAV(t + 1, SLOT(t + 1)); if (t + 2 < NT) DMAV(t + 2, SLOT(t + 2));
    SBAR(); qk_pv16(S, lds + SLOT(t), kb0, qf, -mhat[0], -mhat[1], O, vbA0 + SLOT(t - 1), vbB0 + SLOT(t - 1), paA); SBAR();
    partial16(S, mhat, al, false); finish16(S, al, lsum, paB);
    RESC(al);
    SBAR(); qk_pv16(S, lds + SLOT(t + 1), kb0, qf, -mhat[0], -mhat[1], O, vbA0 + SLOT(t), vbB0 + SLOT(t), paB); SBAR();
    partial16(S, mhat, al, false); finish16(S, al, lsum, paA);
    WAITBAR(0);
    RESC(al);
  }
  pv16(O, vbA0 + SLOT(NT - 1), vbB0 + SLOT(NT - 1), paA);
#pragma unroll
  for (int qb = 0; qb < 2; ++qb) { float L = lsum[qb]; L += __shfl_xor(L, 16); L += __shfl_xor(L, 32); if (g == 0) li_l[16 * qb + c] = L; }
  asm volatile("s_waitcnt lgkmcnt(0)" ::: "memory");
  bf16r* Ow = Ob + (long)(wid * QBLK) * LDO;
#pragma unroll
  for (int qb = 0; qb < 2; ++qb)
#pragma unroll
    for (int r = 0; r < 4; ++r) { const int orow = 16 * qb + 4 * g + r; const float rl = __builtin_amdgcn_rcpf(li_l[orow]); float sq = 0.f;
#pragma unroll
      for (int db = 0; db < 8; ++db) { const float v = O[qb][db][r] * rl; sq += v * v; Ow[(long)orow * LDO + 16 * db + c] = f2bf_rne(v); }
      sq += __shfl_xor(sq, 1); sq += __shfl_xor(sq, 2); sq += __shfl_xor(sq, 4); sq += __shfl_xor(sq, 8);
      if (c == 0) ssq[(long)(wid * QBLK + orow) * 8] = sq; }
  asm volatile("s_waitcnt lgkmcnt(0)\n\ts_barrier" ::: "memory");
#undef DMAK
#undef DMA16
#undef DMAV
#undef WAITBAR
#undef SLOT
#undef RESC
}
#undef SBAR
}

constexpr int NWAVES = 8;
constexpr int DM = 2048, NTOK = 65536, INW = 3584, FFN = 5632, UPW = 2 * FFN;
constexpr float EPS = 1e-6f;
constexpr int XR_ROWS = 8 * 4160 + 4 * 8256;
constexpr int NCHUNK = 8 * 65 + 4 * 129;
constexpr int HROWS = 32768;
__host__ __device__ __forceinline__ int seq_first_row(int s) { return s < 8 ? s * 4096 : 32768 + (s - 8) * 8192; }
__host__ __device__ __forceinline__ int seq_len(int s) { return s < 8 ? 4096 : 8192; }
__host__ __device__ __forceinline__ int xr_base(int s) { return s < 8 ? s * 4160 : 33280 + (s - 8) * 8256; }
__host__ __device__ __forceinline__ int chunk_base(int s) { return s < 8 ? s * 65 : 520 + (s - 8) * 129; }
__host__ __device__ __forceinline__ int row_seq(int row) { return row < 32768 ? (row >> 12) : 8 + ((row - 32768) >> 13); }

constexpr size_t MiB = 1u << 20, KiB = 1u << 10;
constexpr size_t WS_CTL = 0, CTL_ZERO_BYTES = 1 * MiB;
constexpr size_t WS_SMALL = 1 * MiB;
constexpr size_t WS_XNMETA = WS_SMALL + 0, WS_ZM = WS_SMALL + 64 * KiB, WS_KM = WS_SMALL + 320 * KiB, WS_VM = WS_SMALL + 352 * KiB, WS_Q15 = WS_SMALL + 384 * KiB, WS_GY15 = WS_SMALL + 388 * KiB,
                 WS_LO15 = WS_SMALL + 392 * KiB, WS_MIXED15 = WS_SMALL + 448 * KiB, WS_Y15 = WS_SMALL + 544 * KiB, WS_G15 = WS_SMALL + 640 * KiB, WS_MQP = WS_SMALL + 1024 * KiB;
constexpr size_t WS_WIN = 5 * MiB, WS_WOUT = 19 * MiB, WS_WUP = 27 * MiB, WS_WDOWN = 71 * MiB, WS_WG = 93 * MiB;
constexpr size_t WS_CAR = 94 * MiB, WS_CIN = 111 * MiB;
constexpr size_t WS_R0 = 120 * MiB, WS_RATIO = 120 * MiB + 256 * KiB, WS_RL = 120 * MiB + 512 * KiB, WS_SSQA = 121 * MiB, WS_SSQL = 123 * MiB;
constexpr size_t WS_A = 128 * MiB;
constexpr size_t WS_B = 384 * MiB;
constexpr size_t WS_QG = WS_B, WS_K = WS_B + 256 * MiB, WS_V = WS_B + 288 * MiB, WS_XR = WS_B + 320 * MiB;
constexpr size_t WS_ACT = WS_B, WS_EDGE = WS_B + 352 * MiB;
constexpr size_t WS_H1A = WS_B + 420 * MiB;
constexpr size_t WS_END = WS_B + 548 * MiB;
static_assert(WS_ZM + 16 * INW * 4 <= WS_KM && WS_G15 + 12 * FFN * 4 <= WS_MQP && WS_MQP + 512 * 4 * 132 * 4 <= WS_WIN, "small map");
static_assert(WS_WIN + (size_t)INW * DM * 2 <= WS_WOUT && WS_WOUT + (size_t)DM * DM * 2 <= WS_WUP && WS_WUP + (size_t)UPW * DM * 2 <= WS_WDOWN && WS_WDOWN + (size_t)DM * FFN * 2 <= WS_WG && WS_WG + 32 * 16384 * 2 <= WS_CAR, "weights map");
static_assert(WS_CAR + (size_t)NCHUNK * 2 * 1024 * 8 <= WS_CIN && WS_A + (size_t)NTOK * DM * 2 <= WS_B, "carry map");
static_assert(WS_QG + (size_t)NTOK * DM * 2 <= WS_K && WS_XR + (size_t)(XR_ROWS + 64) * 1024 * 2 <= WS_END && WS_EDGE + (size_t)512 * 2 * 3 * FFN * 4 <= WS_H1A && WS_H1A + (size_t)HROWS * DM * 2 <= WS_END && WS_END <= 1024 * MiB && WS_CIN + (size_t)NCHUNK * 2 * 1024 * 4 <= WS_R0 && WS_SSQL + (size_t)NTOK * 8 * 4 <= WS_A && WS_ACT + (size_t)HROWS * FFN * 2 <= WS_EDGE && WS_EDGE + (size_t)512 * 2 * 3 * FFN * 4 <= WS_END, "B map");
constexpr int CW_BAR = 4096;

constexpr int RING_BYTES = 131072;
constexpr int LDSCTL_OFF = RING_BYTES, MISC_OFF = LDSCTL_OFF + 320;
constexpr int LDS_BYTES = 147456;

#define GAS __attribute__((address_space(1)))
#define LAS __attribute__((address_space(3)))
typedef unsigned short bf16;
typedef unsigned v4u __attribute__((ext_vector_type(4)));
typedef float f32x4 __attribute__((ext_vector_type(4)));
typedef short bf16x8 __attribute__((ext_vector_type(8)));
typedef GAS unsigned gu32;
typedef GAS unsigned long long gu64;
#define RLX_AGENT __ATOMIC_RELAXED, __HIP_MEMORY_SCOPE_AGENT
#define LDS_WAIT() asm volatile("s_waitcnt lgkmcnt(0)" ::: "memory")
#define VM_WAIT() asm volatile("s_waitcnt vmcnt(0)" ::: "memory")
__device__ __forceinline__ unsigned long long rt() { return __builtin_amdgcn_s_memrealtime(); }
__device__ __forceinline__ unsigned f2bf(float f) { unsigned u = __builtin_bit_cast(unsigned, f); return (u + 0x7fffu + ((u >> 16) & 1u)) >> 16; }
__device__ __forceinline__ unsigned pk2(float lo, float hi) { unsigned r; asm("v_cvt_pk_bf16_f32 %0, %1, %2" : "=v"(r) : "v"(lo), "v"(hi)); return r; }

#define XB_TMO      128
#define XB_XCNT(j)  (256  + 64 * (j))
#define XB_XSUB(j)  (1280 + 64 * (j))
#define XB_XGEN(j)  (2304 + 64 * (j))
#define XB_TOP      3328
#define XB_TOPGEN   3392
#define XCD_BAR_WORDS 3456
#define XB_SPIN_CAP (1u << 18)

__device__ __forceinline__ unsigned xb_ld(unsigned* p)              { return __hip_atomic_load(p, __ATOMIC_RELAXED, __HIP_MEMORY_SCOPE_AGENT); }
__device__ __forceinline__ unsigned xb_add(unsigned* p, unsigned v) { return __hip_atomic_fetch_add(p, v, __ATOMIC_RELAXED, __HIP_MEMORY_SCOPE_AGENT); }
__device__ __forceinline__ unsigned xb_xcc_id() { return (unsigned)__builtin_amdgcn_s_getreg((3 << 11) | 20) & 0xFu; }
#define XB_SPIN(cond, bar) do { unsigned _sp = 0; while (cond) { __builtin_amdgcn_s_sleep(1); \
    if ((++_sp & 255u) == 0u) { if (xb_ld(&(bar)[XB_TMO])) break; if (_sp > XB_SPIN_CAP) { atomicAdd(&(bar)[XB_TMO], 1u); break; } } } } while (0)

struct XcdBarrier {
    unsigned* bar; unsigned x;
    volatile LAS unsigned* st;
};

__device__ __forceinline__ XcdBarrier xcd_barrier_post(unsigned* bar, volatile LAS unsigned* st, bool t0  ) {
    XcdBarrier b; b.bar = bar; b.x = xb_xcc_id(); b.st = st;
    if (t0) (void)xb_add(&bar[XB_XCNT(b.x)], 1u);
    return b;
}
__device__ __forceinline__ void xcd_barrier_complete(unsigned* bar, unsigned x, unsigned& nloc, unsigned& nx) {
    const unsigned G = gridDim.x * gridDim.y * gridDim.z;
    unsigned sum, cnt, mine, sp = 0u;
    for (;;) {
        sum = 0u; cnt = 0u; mine = 0u;
#pragma unroll
        for (unsigned j = 0; j < 16; ++j) { const unsigned c = xb_ld(&bar[XB_XCNT(j)]); sum += c; cnt += (c > 0u) ? 1u : 0u; mine = (j == x) ? c : mine; }
        if (sum == G) break;
        __builtin_amdgcn_s_sleep(1);
        if ((++sp & 255u) == 0u) { if (xb_ld(&bar[XB_TMO])) break; if (sp > XB_SPIN_CAP) { atomicAdd(&bar[XB_TMO], 1u); break; } }
    }
    nloc = mine > 0u ? mine : 1u; nx = cnt > 0u ? cnt : 1u;
}

__device__ __forceinline__ void xcd_barrier(const XcdBarrier& b, bool t0  ) {
    asm volatile("s_waitcnt vmcnt(0)" ::: "memory");
    __syncthreads();
    if (t0) {
        unsigned* bar = b.bar;
        __builtin_amdgcn_s_waitcnt(0);
        unsigned nloc = b.st[0], nx = b.st[1];
        if (nloc == 0u) { xcd_barrier_complete(bar, b.x, nloc, nx); b.st[0] = nloc; b.st[1] = nx; }
        const unsigned old = xb_add(&bar[XB_XSUB(b.x)], 1u);
        const unsigned gen = old / nloc;
        if (old + 1u == (gen + 1u) * nloc) {
            __builtin_amdgcn_fence(__ATOMIC_RELEASE, "agent");
            asm volatile("s_waitcnt vmcnt(0)" ::: "memory");
            const unsigned og = xb_add(&bar[XB_TOP], 1u);
            const unsigned tg = og / nx;
            if (og + 1u == (tg + 1u) * nx) xb_add(&bar[XB_TOPGEN], 1u);
            else XB_SPIN(xb_ld(&bar[XB_TOPGEN]) == tg, bar);
            __builtin_amdgcn_fence(__ATOMIC_ACQUIRE, "agent");
            xb_add(&bar[XB_XGEN(b.x)], 1u);
            asm volatile("s_waitcnt vmcnt(0)" ::: "memory");
        } else {
            XB_SPIN(xb_ld(&bar[XB_XGEN(b.x)]) == gen, bar);
            __builtin_amdgcn_fence(__ATOMIC_ACQUIRE, "agent");
            asm volatile("s_waitcnt vmcnt(0)" ::: "memory");
        }
    }
    __syncthreads();
}

__device__ __forceinline__ float bf2f(unsigned short b) { return __builtin_bit_cast(float, (unsigned)b << 16); }
__device__ __forceinline__ float bf2f(short b) { return __builtin_bit_cast(float, (unsigned)(unsigned short)b << 16); }
template <int CTRL> __device__ __forceinline__ float dpp_perm(float v) { return __builtin_bit_cast(float, __builtin_amdgcn_update_dpp(0, __builtin_bit_cast(int, v), CTRL, 0xF, 0xF, true)); }
__device__ __forceinline__ float row16_sum(float v) {
    v += dpp_perm<0xB1>(v); v += dpp_perm<0x4E>(v); v += dpp_perm<0x141>(v); v += dpp_perm<0x140>(v); return v;
}
__device__ __forceinline__ float wave_sum(float v) {
    v += dpp_perm<0xB1>(v);
    v += dpp_perm<0x4E>(v);
    v += dpp_perm<0x141>(v);
    v += dpp_perm<0x140>(v);
    const int b = __builtin_bit_cast(int, v);
    const float s0 = __builtin_bit_cast(float, __builtin_amdgcn_readlane(b, 0)), s1 = __builtin_bit_cast(float, __builtin_amdgcn_readlane(b, 16)),
                s2 = __builtin_bit_cast(float, __builtin_amdgcn_readlane(b, 32)), s3 = __builtin_bit_cast(float, __builtin_amdgcn_readlane(b, 48));
    return (s0 + s1) + (s2 + s3);
}
__device__ __forceinline__ float wave_max(float v) {
#pragma unroll
    for (int o = 1; o < 64; o <<= 1) v = fmaxf(v, __shfl_xor(v, o));
    return v;
}
__device__ __forceinline__ float fast_exp(float x) { return __builtin_amdgcn_exp2f(x * 1.4426950408889634f); }
__device__ __forceinline__ float sigmoidf_(float x) { return __builtin_amdgcn_rcpf(1.f + fast_exp(-x)); }
__device__ __forceinline__ float gelu_tanh(float x) {
    const float z = 0.7978845608028654f * (x + 0.044715f * x * x * x);
    return x * sigmoidf_(2.f * z);
}
__device__ __forceinline__ float neg_expm1(float x) {
    const float p = x * (1.f + x * (0.5f + x * (0.16666667f + x * (0.041666668f + x * (0.0083333338f + x * 0.0013888889f)))));
    const float e = fast_exp(x) - 1.f;
    return -(fabsf(x) < 0.25f ? p : e);
}
__device__ __forceinline__ v4u pack8(const float (&v)[8]) { v4u o; o.x = pk2(v[0], v[1]); o.y = pk2(v[2], v[3]); o.z = pk2(v[4], v[5]); o.w = pk2(v[6], v[7]); return o; }

#define FIN(F, idx) ({ const __attribute__((address_space(1))) float* p_; asm("s_load_dwordx2 %0, %1, %2 ; tag %3\n\ts_waitcnt lgkmcnt(0)" : "=s"(p_) : "s"((F).kargs), "i"((idx) * 8), "s"((F).ptag)); (const float*)p_; })
struct Frame {
    LAS unsigned char* lds;
    volatile LAS unsigned* MISC;
    gu32* ctl;
    int tid, lane, wave, vcu, G;
    const __attribute__((address_space(4))) void* kargs; int ptag;
    float* out;
    unsigned char* ws;
#define WSP(T, NAME, OFF) __device__ __forceinline__ T* NAME() const { return (T*)(ws + (OFF)); }
    WSP(bf16, WIN_T, WS_WIN) WSP(bf16, WOUT_T, WS_WOUT) WSP(bf16, WUP_T, WS_WUP) WSP(bf16, WDOWN_T, WS_WDOWN) WSP(bf16, WG, WS_WG) WSP(bf16, XN, WS_A) WSP(bf16, QG, WS_QG) WSP(bf16, K, WS_K) WSP(bf16, V, WS_V)
    WSP(bf16, XR, WS_XR) WSP(bf16, ACT, WS_ACT) WSP(bf16, H1A, WS_H1A) WSP(bf16, EDGE, WS_EDGE) WSP(bf16, XNMETA, WS_XNMETA) WSP(bf16, KM, WS_KM) WSP(bf16, VM, WS_VM)
    WSP(float, ZM, WS_ZM) WSP(float, Q15, WS_Q15) WSP(float, GY15, WS_GY15) WSP(float, LO15, WS_LO15) WSP(float, MIXED15, WS_MIXED15) WSP(float, Y15, WS_Y15) WSP(bf16, G15, WS_G15) WSP(float, MQP, WS_MQP)
    WSP(float, CIN, WS_CIN) WSP(float2, CAR, WS_CAR) WSP(float, R0, WS_R0) WSP(float, RATIO, WS_RATIO) WSP(float, RL, WS_RL) WSP(float, SSQA, WS_SSQA) WSP(float, SSQL, WS_SSQL)
#undef WSP
};

template <bool UPMAP, int GAIN = 0>
__device__ __forceinline__ void p0_transpose_item(const float* W, int K, int N, bf16* WT, int row_off, LAS float* scr, int item, int lane, const float* g0 = nullptr, const float* g1 = nullptr) {
    const int nblk = N / 32, kb = item / nblk, nb = item % nblk, k0 = 64 * kb, n0 = 32 * nb;
    const int orow0 = UPMAP ? (((n0 % FFN) >> 7) << 8) + 128 * (n0 / FFN) + ((n0 % FFN) & 127) : row_off + n0;
    float wv[32];
#pragma unroll
    for (int i = 0; i < 32; ++i) { const int kk = 2 * i + (lane >> 5); wv[i] = W[(size_t)(k0 + kk) * N + n0 + (lane & 31)]; }
#pragma unroll
    for (int i = 0; i < 32; ++i) { const int kk = 2 * i + (lane >> 5); float gv = 1.f; if (GAIN == 1) gv = g0[k0 + kk]; if (GAIN == 2) gv = (k0 + kk) < 1024 ? g0[k0 + kk] : g1[k0 + kk - 1024];
        scr[kk * 33 + (lane & 31)] = wv[i] * gv; }
    LDS_WAIT(); asm volatile("" ::: "memory");
    const int c = lane & 7;
#pragma unroll
    for (int j = 0; j < 4; ++j) { const int n = (lane >> 3) + 8 * j; const LAS float* s = scr + (8 * c) * 33 + n;
        v4u o; o.x = pk2(s[0 * 33], s[1 * 33]); o.y = pk2(s[2 * 33], s[3 * 33]); o.z = pk2(s[4 * 33], s[5 * 33]); o.w = pk2(s[6 * 33], s[7 * 33]);
        *(GAS v4u*)(WT + (size_t)(orow0 + n) * K + k0 + 8 * c) = o; }
    LDS_WAIT(); asm volatile("" ::: "memory");
}
__device__ __forceinline__ void rms_row_to_bf16(const float* xrow, bf16* orow, int lane, float* rout) {
    const GAS f32x4* xr = (const GAS f32x4*)xrow + lane;
    f32x4 v[8]; float s = 0.f;
#pragma unroll
    for (int j = 0; j < 8; ++j) { v[j] = xr[64 * j]; s += (v[j].x * v[j].x + v[j].y * v[j].y) + (v[j].z * v[j].z + v[j].w * v[j].w); }
    const float r = 1.f / sqrtf(wave_sum(s) * (1.f / DM) + EPS);
    GAS unsigned long long* o8 = (GAS unsigned long long*)orow + lane;
#pragma unroll
    for (int j = 0; j < 8; ++j) o8[64 * j] = (unsigned long long)pk2(v[j].x * r, v[j].y * r) | ((unsigned long long)pk2(v[j].z * r, v[j].w * r) << 32);
    if (rout && lane == 0) *rout = r;
}
constexpr int WT_I_IN = (DM / 64) * (INW / 32), WT_I_OUT = (DM / 64) * (DM / 32), WT_I_UP = (DM / 64) * (UPW / 32), WT_I_DN = (FFN / 64) * (DM / 32), WT_I_G = 32 * 8;
constexpr int WT_O_OUT = WT_I_IN, WT_O_UP = WT_O_OUT + WT_I_OUT, WT_O_DN = WT_O_UP + WT_I_UP, WT_O_G = WT_O_DN + WT_I_DN, WT_NITEMS = WT_O_G + WT_I_G;
__device__ __forceinline__ void wt_items(Frame& F, int it0, int it1, int gw, int NGW) {
    LAS float* scr = (LAS float*)(F.lds + F.wave * 16384);
    for (int it = it0 + gw; it < it1; it += NGW) {
        int r = it;
        if (r < WT_I_IN) { p0_transpose_item<false, 1>(FIN(F, 4  ), DM, INW, F.WIN_T(), 0, scr, r, F.lane, FIN(F, 3  )); continue; } r -= WT_I_IN;
        if (r < WT_I_OUT) { p0_transpose_item<false, 2>(FIN(F, 16  ), DM, DM, F.WOUT_T(), 0, scr, r, F.lane, FIN(F, 14  ), FIN(F, 15  )); continue; } r -= WT_I_OUT;
        if (r < WT_I_UP) { p0_transpose_item<true>(FIN(F, 19  ), DM, UPW, F.WUP_T(), 0, scr, r, F.lane); continue; } r -= WT_I_UP;
        if (r < WT_I_DN) { p0_transpose_item<false>(FIN(F, 22  ), FFN, DM, F.WDOWN_T(), 0, scr, r, F.lane); continue; } r -= WT_I_DN;
        {
            const int mi = r >> 3, sub = r & 7, gate = mi >> 4, dir = (mi >> 3) & 1, blk = mi & 7;
            const float* W = (gate ? FIN(F, 11  ) : FIN(F, 9  )) + (size_t)(dir * 8 + blk) * 16384;
            bf16* WT = F.WG() + (size_t)((dir * 2 + gate) * 8 + blk) * 16384;
            p0_transpose_item<false>(W, 128, 128, WT, 0, scr, sub, F.lane);
        }
    }
}
__device__ __forceinline__ void p0_prologue(Frame& F) {
    const int gw = F.vcu * NWAVES + F.wave, NGW = F.G * NWAVES;
    wt_items(F, 0, WT_O_OUT, gw, NGW);
    wt_items(F, WT_O_G, WT_NITEMS, gw, NGW);
    {
        const float* xp = FIN(F, 0  ); const float* xs = FIN(F, 1  ); const int lane = F.lane;
        f32x4 v[8], vn[8];
#define P0_LOAD(M, V) do { const GAS f32x4* xr_ = (const GAS f32x4*)((M) < 32768 ? xp + (size_t)(M) * DM : xs + (size_t)((M) - 32768) * DM) + lane; \
            _Pragma("unroll") for (int j_ = 0; j_ < 8; ++j_) V[j_] = xr_[64 * j_]; } while (0)
        int m = gw;
        if (m < NTOK) P0_LOAD(m, v);
        asm volatile("" : "+v"(v[0]), "+v"(v[1]), "+v"(v[2]), "+v"(v[3]), "+v"(v[4]), "+v"(v[5]), "+v"(v[6]), "+v"(v[7]) :: "memory");
        for (; m < NTOK; m += NGW) {
            const int mn = m + NGW < NTOK ? m + NGW : m;
            P0_LOAD(mn, vn);
            float s = 0.f;
#pragma unroll
            for (int j = 0; j < 8; ++j) s += (v[j].x * v[j].x + v[j].y * v[j].y) + (v[j].z * v[j].z + v[j].w * v[j].w);
            const float r = __builtin_amdgcn_rsqf(wave_sum(s) * (1.f / DM) + EPS);
            GAS unsigned long long* o8 = (GAS unsigned long long*)(F.XN() + (size_t)m * DM) + lane;
#pragma unroll
            for (int j = 0; j < 8; ++j) o8[64 * j] = (unsigned long long)pk2(v[j].x * r, v[j].y * r) | ((unsigned long long)pk2(v[j].z * r, v[j].w * r) << 32);
            if (lane == 0) F.R0()[m] = r;
            asm volatile("" : "+v"(vn[0]), "+v"(vn[1]), "+v"(vn[2]), "+v"(vn[3]), "+v"(vn[4]), "+v"(vn[5]), "+v"(vn[6]), "+v"(vn[7]) :: "memory");
#pragma unroll
            for (int j = 0; j < 8; ++j) v[j] = vn[j];
        }
#undef P0_LOAD
    }
    for (int m = gw; m < 16; m += NGW) rms_row_to_bf16(FIN(F, 2  ) + (size_t)m * DM, F.XNMETA() + (size_t)m * DM, F.lane, nullptr);
    const int gt = F.vcu * 512 + F.tid, NGT = F.G * 512; const v4u z4 = {0u, 0u, 0u, 0u};
    for (int i = gt; i < 12 * 48 * 128; i += NGT) { const int s = i / (48 * 128), rem = i % (48 * 128); ((GAS v4u*)(F.XR() + (size_t)xr_base(s) * 1024))[rem] = z4; }
    for (int i = gt; i < 64 * 128; i += NGT) ((GAS v4u*)(F.XR() + (size_t)XR_ROWS * 1024))[i] = z4;
    for (int i = gt; i < 2048; i += NGT) { ((GAS v4u*)F.KM())[i] = z4; ((GAS v4u*)F.VM())[i] = z4; }
}

template <int R, class Out, bool GMAP = false>
__device__ __forceinline__ void small_gemm(const LAS float* X, int K, const bf16* Wt, int N, int gw, int NGW, int lane, const Out& out) {
    for (int n = gw; n < N; n += NGW) {
        float acc[R];
#pragma unroll
        for (int r = 0; r < R; ++r) acc[r] = 0.f;
        const GAS bf16x8* wrow = (const GAS bf16x8*)(Wt + (size_t)(GMAP ? ((n >> 7) << 8) + (n & 127) : n) * K);
        bf16x8 wq[4];
#pragma unroll
        for (int q = 0; q < 4; ++q) wq[q] = wrow[lane + 64 * q];
#pragma unroll
        for (int q = 0; q < 4; ++q) { const int k8 = lane + 64 * q;
            asm volatile("" ::: "memory");
            const bf16x8 w = wq[q]; float wf[8];
#pragma unroll
            for (int j = 0; j < 8; ++j) wf[j] = bf2f(w[j]);
#pragma unroll
            for (int r = 0; r < R; ++r) { const LAS f32x4* xp = (const LAS f32x4*)(X + r * K + k8 * 8); const f32x4 a = xp[0], b = xp[1];
                acc[r] += (a.x * wf[0] + a.y * wf[1]) + (a.z * wf[2] + a.w * wf[3]) + (b.x * wf[4] + b.y * wf[5]) + (b.z * wf[6] + b.w * wf[7]); }
        }
        float v = 0.f;
#pragma unroll
        for (int r = 0; r < R; ++r) { const float s = wave_sum(acc[r]); v = (lane == r) ? s : v; }
        out(n, lane, v);
    }
}
struct OutMetaZ { float* ZM; bf16* XR;
    __device__ __forceinline__ void operator()(int n, int lane, float v) const {
        if (lane < 16) { ZM[lane * INW + n] = v;
            if (n >= 1536 && n < 2560) { const unsigned short b = (unsigned short)f2bf(v); const int c = n - 1536;
                for (int s = 0; s < 12; ++s) XR[(size_t)(xr_base(s) + 48 + lane) * 1024 + c] = b; } }
    } };
struct OutRows { float* Y; int ld; int R;
    __device__ __forceinline__ void operator()(int n, int lane, float v) const { if (lane < R) Y[(size_t)lane * ld + n] = v; } };
struct OutRowsB { bf16* Y; int ld; int R;
    __device__ __forceinline__ void operator()(int n, int lane, float v) const { if (lane < R) Y[(size_t)lane * ld + n] = (bf16)f2bf(v); } };

template <bool GMAP, class XF, class Out>
__device__ __forceinline__ void side_gemm16(Frame& F, const XF& xf, const bf16* Wt, int ntiles, LAS float* part, const Out& out) {
    const int lane = F.lane, c = lane & 15, g = lane >> 4, w = F.wave, tid = F.tid;
    for (int t = F.vcu; t < ntiles; t += F.G) {
        const int n0 = t * 16, wrow = GMAP ? ((n0 >> 7) << 8) + (n0 & 127) : n0;
        const bf16* wp = Wt + (size_t)(wrow + c) * DM + w * 256 + 8 * g;
        bf16x8 bq[8], aq[8];
#pragma unroll
        for (int ks = 0; ks < 8; ++ks) { bq[ks] = *(const GAS bf16x8*)(wp + 32 * ks); aq[ks] = xf(c, w * 256 + 32 * ks + 8 * g); }
        f32x4 acc = {0.f, 0.f, 0.f, 0.f};
#pragma unroll
        for (int ks = 0; ks < 8; ++ks) acc = __builtin_amdgcn_mfma_f32_16x16x32_bf16(aq[ks], bq[ks], acc, 0, 0, 0);
        *(LAS f32x4*)(part + (w * 64 + lane) * 4) = acc;
        __syncthreads();
        if (tid < 256) { const int row = tid >> 4, n = tid & 15; float v = 0.f;
#pragma unroll
            for (int ww = 0; ww < 8; ++ww) v += part[(ww * 64 + (row >> 2) * 16 + n) * 4 + (row & 3)];
            out(n0 + n, row, v); }
        __syncthreads();
    }
}
__device__ __forceinline__ void p1_meta_z(Frame& F) {
    const bf16* xm = F.XNMETA();
    const auto xf = [xm](int c, int k) { return *(const GAS bf16x8*)(xm + c * DM + k); };
    const OutMetaZ o{F.ZM(), F.XR()};
    side_gemm16<false>(F, xf, F.WIN_T(), INW / 16, (LAS float*)F.lds, o);
}
typedef float f32x16 __attribute__((ext_vector_type(16)));
typedef float f32x2 __attribute__((ext_vector_type(2)));
constexpr int LRU_XC0 = 0, LRU_XC_BUF = 17408, LRU_XC_STRIDE = 272;
constexpr int LRU_CW = 34816;
constexpr int LRU_HF = 37376, LRU_HB = LRU_HF + 32768;
__device__ __forceinline__ int crow16(int r, int hi) { return (r & 3) + 8 * (r >> 2) + 4 * hi; }

template <int DIR>
__device__ __forceinline__ void scan_tile(const float (&a)[16], const float (&u)[16], float& carry, float& ptot, float (&h)[16], bool up) {
    float HL[16], PL[16], As[4], Hs[4];
#pragma unroll
    for (int j = 0; j < 4; ++j) {
        float hl = 0.f, p = 1.f;
#pragma unroll
        for (int ii = 0; ii < 4; ++ii) { const int idx = 4 * j + (DIR == 0 ? ii : 3 - ii); hl = a[idx] * hl + u[idx]; p *= a[idx]; HL[idx] = hl; PL[idx] = p; }
        As[j] = p; Hs[j] = hl;
    }
    float Alo[4], Ahi[4], Hlo[4], Hhi[4];
#pragma unroll
    for (int j = 0; j < 4; ++j) {
        { const unsigned x = __float_as_uint(As[j]); auto rr = __builtin_amdgcn_permlane32_swap(x, x, false, false); Alo[j] = __uint_as_float(rr[0]); Ahi[j] = __uint_as_float(rr[1]); }
        { const unsigned x = __float_as_uint(Hs[j]); auto rr = __builtin_amdgcn_permlane32_swap(x, x, false, false); Hlo[j] = __uint_as_float(rr[0]); Hhi[j] = __uint_as_float(rr[1]); }
    }
    float cin[4]; float c = carry;
    if (DIR == 0) {
#pragma unroll
        for (int j = 0; j < 4; ++j) { const float c_lo = c; c = Alo[j] * c + Hlo[j]; const float c_hi = c; c = Ahi[j] * c + Hhi[j]; cin[j] = up ? c_hi : c_lo; }
    } else {
#pragma unroll
        for (int j = 3; j >= 0; --j) { const float c_hi = c; c = Ahi[j] * c + Hhi[j]; const float c_lo = c; c = Alo[j] * c + Hlo[j]; cin[j] = up ? c_hi : c_lo; }
    }
    carry = c;
#pragma unroll
    for (int j = 0; j < 4; ++j) ptot *= Alo[j] * Ahi[j];
#pragma unroll
    for (int idx = 0; idx < 16; ++idx) h[idx] = HL[idx] + PL[idx] * cin[idx >> 2];
}

__device__ __forceinline__ void lru_decode(int cg, int& seq, int& c) { if (cg < 520) { seq = cg / 65; c = cg - seq * 65; } else { const int c2 = cg - 520; seq = c2 / 129; c = c2 - seq * 129; seq += 8; } }
template <int PASS>
__device__ __forceinline__ void lru_phase(Frame& F, bf16* gout) {
    LAS unsigned char* L = F.lds;
    const int tid = F.tid, lane = F.lane, wave = F.wave;
    const int n = F.vcu & 7, ngrp = F.G >> 3;
    { const float* cw = FIN(F, 7  ); const float* cb = FIN(F, 8  );
      for (int i = tid; i < 640; i += 512) { const int k = i >> 7, ch = i & 127; ((LAS float*)(L + LRU_CW))[i] = k < 4 ? cw[k * 1024 + n * 128 + ch] : cb[n * 128 + ch]; } }
    const int d = wave >> 2, g4 = wave & 3, r32 = lane & 31, hi = lane >> 5, chl = g4 * 32 + r32, chg = n * 128 + chl;
    bf16x8 br[8], bi[8];
    { const bf16* wr_ = F.WG() + (size_t)((d * 2 + 0) * 8 + n) * 16384 + chl * 128 + hi * 8;
      const bf16* wi_ = F.WG() + (size_t)((d * 2 + 1) * 8 + n) * 16384 + chl * 128 + hi * 8;
#pragma unroll
      for (int ks = 0; ks < 8; ++ks) { br[ks] = *(const GAS bf16x8*)(wr_ + ks * 16); bi[ks] = *(const GAS bf16x8*)(wi_ + ks * 16); } }
    constexpr float L2E = 1.4426950408889634f;
    const float nb_r = -L2E * FIN(F, 10  )[d * 1024 + chg], nb_i = -L2E * FIN(F, 12  )[d * 1024 + chg];
    const float spl = 8.f * L2E * log1pf(expf(-FIN(F, 13  )[d * 1024 + chg]));
    const int tau0 = tid >> 4, co = (tid & 15) * 8;
    bf16x8 xv[2][4];
#define LRU_PREFETCH(cgx) do { int s_, c_; lru_decode((cgx), s_, c_); const int xb_ = xr_base(s_); \
        _Pragma("unroll") for (int it_ = 0; it_ < 2; ++it_) _Pragma("unroll") for (int k_ = 0; k_ < 4; ++k_) { int row_ = xb_ + c_ * 64 + tau0 + 32 * it_ + k_ - 2; row_ = row_ < 0 ? 0 : row_; \
            xv[it_][k_] = *(const GAS bf16x8*)(F.XR() + (size_t)row_ * 1024 + n * 128 + co); } } while (0)
    int cg = F.vcu < 8 * ngrp ? F.vcu >> 3 : NCHUNK;
    if (cg < NCHUNK) LRU_PREFETCH(cg);
    __syncthreads();
    for (int ui = 0; cg < NCHUNK; cg += ngrp, ++ui) {
        int seq, c; lru_decode(cg, seq, c);
        LAS unsigned char* XC = L + LRU_XC0 + (ui & 1) * LRU_XC_BUF;
        float carry = 0.f, ptot = 1.f;
        if (PASS == 2) carry = F.CIN()[((size_t)cg * 2 + d) * 1024 + chg];
#pragma unroll
        for (int it = 0; it < 2; ++it) {
            const int tau = tau0 + 32 * it; float xc[8];
            { const LAS f32x4* cb = (const LAS f32x4*)(L + LRU_CW + (4 * 128 + co) * 4); const f32x4 b0 = cb[0], b1 = cb[1];
              xc[0] = b0.x; xc[1] = b0.y; xc[2] = b0.z; xc[3] = b0.w; xc[4] = b1.x; xc[5] = b1.y; xc[6] = b1.z; xc[7] = b1.w; }
#pragma unroll
            for (int k = 0; k < 4; ++k) { const LAS f32x4* wp = (const LAS f32x4*)(L + LRU_CW + (k * 128 + co) * 4); const f32x4 w0 = wp[0], w1 = wp[1]; const bf16x8 v = xv[it][k];
                xc[0] += w0.x * bf2f(v[0]); xc[1] += w0.y * bf2f(v[1]); xc[2] += w0.z * bf2f(v[2]); xc[3] += w0.w * bf2f(v[3]);
                xc[4] += w1.x * bf2f(v[4]); xc[5] += w1.y * bf2f(v[5]); xc[6] += w1.z * bf2f(v[6]); xc[7] += w1.w * bf2f(v[7]); }
            if (c == 0 && tau < 48) {
#pragma unroll
                for (int j = 0; j < 8; ++j) xc[j] = 0.f;
            }
            *(LAS v4u*)(XC + tau * LRU_XC_STRIDE + co * 2) = pack8(xc);
        }
        bf16x8 gv[2];
        const int row0 = seq_first_row(seq) + 64 * (c - 1);
        if (PASS == 2) { if (c > 0) {
#pragma unroll
            for (int it = 0; it < 2; ++it) gv[it] = *(const GAS bf16x8*)(F.QG() + (size_t)(row0 + tau0 + 32 * it) * DM + 1024 + n * 128 + co); } }
        __syncthreads();
        if (cg + ngrp < NCHUNK) LRU_PREFETCH(cg + ngrp);
        f32x16 arT[2], aiT[2];
#pragma unroll
        for (int tt = 0; tt < 2; ++tt) {
            const int tile = d ? 1 - tt : tt;
            f32x16 ar = {}, ai = {};
#pragma unroll
            for (int ks = 0; ks < 8; ++ks) {
                const bf16x8 a = *(const LAS bf16x8*)(XC + (tile * 32 + r32) * LRU_XC_STRIDE + (ks * 16 + hi * 8) * 2);
                ar = __builtin_amdgcn_mfma_f32_32x32x16_bf16(a, br[ks], ar, 0, 0, 0);
                ai = __builtin_amdgcn_mfma_f32_32x32x16_bf16(a, bi[ks], ai, 0, 0, 0);
            }
            arT[tt] = ar; aiT[tt] = ai;
        }
#pragma unroll
        for (int tt = 0; tt < 2; ++tt) {
            const int tile = d ? 1 - tt : tt;
            const f32x16 ar = arT[tt], ai = aiT[tt];
            float av[16], uv[16], hv[16];
#pragma unroll
            for (int r = 0; r < 16; r += 2) {
                const int tau0_ = tile * 32 + crow16(r, hi);
                const f32x2 xc2 = {bf2f(*(const LAS unsigned short*)(XC + tau0_ * LRU_XC_STRIDE + chl * 2)), bf2f(*(const LAS unsigned short*)(XC + (tau0_ + 1) * LRU_XC_STRIDE + chl * 2))};
                const f32x2 tr = (f32x2){ar[r], ar[r + 1]} * (f32x2){-L2E, -L2E} + (f32x2){nb_r, nb_r};
                const f32x2 ti = (f32x2){ai[r], ai[r + 1]} * (f32x2){-L2E, -L2E} + (f32x2){nb_i, nb_i};
                const f32x2 dr = (f32x2){__builtin_amdgcn_exp2f(tr.x), __builtin_amdgcn_exp2f(tr.y)} + (f32x2){1.f, 1.f};
                const f32x2 di = (f32x2){__builtin_amdgcn_exp2f(ti.x), __builtin_amdgcn_exp2f(ti.y)} + (f32x2){1.f, 1.f};
                const f32x2 rg = {__builtin_amdgcn_rcpf(dr.x), __builtin_amdgcn_rcpf(dr.y)}, ig = {__builtin_amdgcn_rcpf(di.x), __builtin_amdgcn_rcpf(di.y)};
                const f32x2 la = rg * (f32x2){-spl, -spl};
                const f32x2 a = {__builtin_amdgcn_exp2f(la.x), __builtin_amdgcn_exp2f(la.y)};
                const f32x2 t = (f32x2){1.f, 1.f} - a * a;
                const f32x2 m = {__builtin_amdgcn_sqrtf(t.x), __builtin_amdgcn_sqrtf(t.y)};
                const f32x2 u = m * (ig * xc2);
                av[r] = a.x; av[r + 1] = a.y; uv[r] = u.x; uv[r + 1] = u.y;
            }
            if (d == 0) scan_tile<0>(av, uv, carry, ptot, hv, hi != 0); else scan_tile<1>(av, uv, carry, ptot, hv, hi != 0);
            if (PASS == 2) {
#pragma unroll
                for (int r = 0; r < 16; ++r) { const int tau = tile * 32 + crow16(r, hi); *(LAS float*)(L + (d ? LRU_HB : LRU_HF) + (tau * 128 + chl) * 4) = hv[r]; }
            }
        }
        if (PASS == 1) { if (hi == 0) F.CAR()[((size_t)cg * 2 + d) * 1024 + chg] = make_float2(ptot, carry); }
        if (PASS == 2) {
            __syncthreads();
            if (c > 0) {
#pragma unroll
                for (int it = 0; it < 2; ++it) {
                    const int tau = tau0 + 32 * it; const v4u gq = __builtin_bit_cast(v4u, gv[it]);
                    const LAS f32x4* hf = (const LAS f32x4*)(L + LRU_HF + (tau * 128 + co) * 4); const LAS f32x4* hb = (const LAS f32x4*)(L + LRU_HB + (tau * 128 + co) * 4);
                    const f32x4 f0 = hf[0], f1 = hf[1], b0 = hb[0], b1 = hb[1];
                    const f32x2 hs[4] = {(f32x2){f0.x, f0.y} + (f32x2){b0.x, b0.y}, (f32x2){f0.z, f0.w} + (f32x2){b0.z, b0.w}, (f32x2){f1.x, f1.y} + (f32x2){b1.x, b1.y}, (f32x2){f1.z, f1.w} + (f32x2){b1.z, b1.w}};
                    const unsigned gw_[4] = {gq.x, gq.y, gq.z, gq.w};
                    const f32x2 C1 = {-2.302208198f, -2.302208198f}, C2 = {-0.1029432452f, -0.1029432452f};
                    unsigned ow[4]; f32x2 sq2 = {0.f, 0.f};
#pragma unroll
                    for (int pp = 0; pp < 4; ++pp) { const f32x2 x2 = {__builtin_bit_cast(float, gw_[pp] << 16), __builtin_bit_cast(float, gw_[pp] & 0xffff0000u)};
                        const f32x2 a2 = x2 * ((x2 * x2) * C2 + C1);
                        const f32x2 d2 = (f32x2){__builtin_amdgcn_exp2f(a2.x), __builtin_amdgcn_exp2f(a2.y)} + (f32x2){1.f, 1.f};
                        const f32x2 o2 = hs[pp] * (x2 * (f32x2){__builtin_amdgcn_rcpf(d2.x), __builtin_amdgcn_rcpf(d2.y)});
                        ow[pp] = pk2(o2.x, o2.y); sq2 = o2 * o2 + sq2; }
                    v4u ov; ov.x = ow[0]; ov.y = ow[1]; ov.z = ow[2]; ov.w = ow[3];
                    *(GAS v4u*)(gout + (size_t)(row0 + tau) * DM + 1024 + n * 128 + co) = ov;
                    float sq = sq2.x + sq2.y;
                    sq = row16_sum(sq);
                    if ((tid & 15) == 0) F.SSQL()[(size_t)(row0 + tau) * 8 + n] = sq;
                }
            } else if (tid < 128) {
                const float hf = *(const LAS float*)(L + LRU_HF + (63 * 128 + tid) * 4), hb = *(const LAS float*)(L + LRU_HB + (63 * 128 + tid) * 4);
                F.LO15()[seq * 1024 + n * 128 + tid] = (hf + hb) * gelu_tanh(F.GY15()[n * 128 + tid]);
            }
        }
    }
    __syncthreads();
#undef LRU_PREFETCH
}
__device__ __forceinline__ void lru_propagate(Frame& F) {
    const int gid = F.vcu * 512 + F.tid;
    if (gid < 12 * 2048) {
        const int s = gid >> 11, d = (gid >> 10) & 1, ch = gid & 1023; const int nch = s < 8 ? 65 : 129, cb = chunk_base(s);
        const float2* car = F.CAR() + (size_t)d * 1024 + ch; float* cinp = F.CIN() + (size_t)d * 1024 + ch;
        float cin = 0.f;
        float2 pa[16], pb[16];
#define PRP_LOAD(P, B0) do { _Pragma("unroll") for (int i = 0; i < 16; ++i) { int cc = (B0) + i; cc = cc < nch ? cc : nch - 1; const int c = d ? nch - 1 - cc : cc; P[i] = car[(size_t)(cb + c) * 2048]; } } while (0)
#define PRP_RUN(P, B0) do { _Pragma("unroll") for (int i = 0; i < 16; ++i) { const int cc = (B0) + i; const int c = d ? nch - 1 - cc : cc; if (cc < nch) { cinp[(size_t)(cb + c) * 2048] = cin; cin = P[i].x * cin + P[i].y; } } } while (0)
        PRP_LOAD(pa, 0);
        for (int b0 = 0; b0 < nch; b0 += 32) {
            PRP_LOAD(pb, b0 + 16);
            PRP_RUN(pa, b0);
            PRP_LOAD(pa, b0 + 32);
            PRP_RUN(pb, b0 + 16);
        }
#undef PRP_LOAD
#undef PRP_RUN
    }
}

__device__ __forceinline__ void k_rope_pass(Frame& F, bf16* Kout, int gw, int NGW) {
    const int sub = F.lane >> 4, l16 = F.lane & 15;
    const int c0 = 8 * l16, p = l16 >> 3, half = (l16 >> 2) & 1, i0 = 8 * (l16 & 3);
    float inv[8], gk[8];
#pragma unroll
    for (int j = 0; j < 8; ++j) { inv[j] = __builtin_amdgcn_exp2f(-(float)(i0 + j) * (13.287712379549449f / 32.f)) * 0.15915494309189535f; gk[j] = FIN(F, 6  )[c0 + j]; }
    constexpr int NIT = NTOK * 2 / 4;
    bf16x8 v, vn;
    if (gw < NIT) { const int item = gw * 4 + sub; v = *(const GAS bf16x8*)(F.K() + (size_t)(item >> 1) * 256 + (item & 1) * 128 + c0); }
    for (int it = gw; it < NIT; it += NGW) {
        const int item = it * 4 + sub, row = item >> 1, hk = item & 1;
        { const int nit = it + NGW < NIT ? it + NGW : it; const int ni = nit * 4 + sub; vn = *(const GAS bf16x8*)(F.K() + (size_t)(ni >> 1) * 256 + (ni & 1) * 128 + c0); }
        const int s = row_seq(row), t = row - seq_first_row(s); const float pos = (float)(p ? (t & 63) : (t >> 6));
        float x[8]; float ss = 0.f;
#pragma unroll
        for (int j = 0; j < 8; ++j) { x[j] = bf2f(v[j]); ss += x[j] * x[j]; }
        ss = row16_sum(ss);
        const float rs = __builtin_amdgcn_rsqf(ss * (1.f / 128.f) + EPS); float o[8];
#pragma unroll
        for (int j = 0; j < 8; ++j) { x[j] *= rs * gk[j]; const float pr = __shfl_xor(x[j], 4);
            float rev = pos * inv[j]; rev -= floorf(rev); const float sn = __builtin_amdgcn_sinf(rev), cs = __builtin_amdgcn_cosf(rev);
            o[j] = half ? x[j] * cs + pr * sn : x[j] * cs - pr * sn; }
        *(GAS v4u*)(Kout + (size_t)row * 256 + hk * 128 + c0) = pack8(o);
        v = vn;
    }
}
__device__ __forceinline__ void p3_meta_job(Frame& F) {
    for (int pr = F.wave; pr < 32; pr += 8) { const int r = pr >> 1, hk = pr & 1; const float* z = F.ZM() + r * INW + 1024 + hk * 128;
        const float a = z[F.lane], b = z[F.lane + 64]; const float rs = 1.f / sqrtf(wave_sum(a * a + b * b) * (1.f / 128.f) + EPS);
        F.KM()[r * 256 + hk * 128 + F.lane] = (bf16)f2bf(a * rs * FIN(F, 6  )[F.lane]); F.KM()[r * 256 + hk * 128 + F.lane + 64] = (bf16)f2bf(b * rs * FIN(F, 6  )[F.lane + 64]); }
    for (int i = F.tid; i < 16 * 256; i += 512) F.VM()[i] = (bf16)f2bf(F.ZM()[(i >> 8) * INW + 1280 + (i & 255)]);
    { const int h = F.wave; const float* z = F.ZM() + 15 * INW + h * 128; const float a = z[F.lane], b = z[F.lane + 64];
      const float rs = 1.f / sqrtf(wave_sum(a * a + b * b) * (1.f / 128.f) + EPS);
      F.Q15()[h * 128 + F.lane] = a * rs * FIN(F, 5  )[F.lane]; F.Q15()[h * 128 + F.lane + 64] = b * rs * FIN(F, 5  )[F.lane + 64]; }
    for (int i = F.tid; i < 1024; i += 512) F.GY15()[i] = F.ZM()[15 * INW + 2560 + i];
}

__device__ __forceinline__ void metaq_item(Frame& F, int it) {
    int s, kvh, j; if (it < 256) { s = it >> 5; kvh = (it >> 4) & 1; j = it & 15; } else { const int t2 = it - 256; s = 8 + (t2 >> 6); kvh = (t2 >> 5) & 1; j = t2 & 31; }
    LAS float* q4 = (LAS float*)F.lds;
    LAS float* sc = q4 + 512;
    LAS float* red = sc + 4 * 288;
    const int tid = F.tid, nk = 256 + (j == 0 ? 16 : 0), row0 = seq_first_row(s) + 256 * j;
    q4[tid] = F.Q15()[kvh * 512 + tid];
    __syncthreads();
    if (tid < nk) {
        const bf16* kp = tid < 256 ? F.K() + (size_t)(row0 + tid) * 256 + kvh * 128 : F.KM() + (tid - 256) * 256 + kvh * 128;
        float d0 = 0.f, d1 = 0.f, d2 = 0.f, d3 = 0.f;
        bf16x8 kq[16];
#pragma unroll
        for (int cc = 0; cc < 16; ++cc) kq[cc] = ((const GAS bf16x8*)kp)[cc];
#pragma unroll
        for (int cc = 0; cc < 16; ++cc) { const bf16x8 kv = kq[cc];
#pragma unroll
            for (int e = 0; e < 8; ++e) { const float kf = bf2f(kv[e]); d0 += kf * q4[cc * 8 + e]; d1 += kf * q4[128 + cc * 8 + e]; d2 += kf * q4[256 + cc * 8 + e]; d3 += kf * q4[384 + cc * 8 + e]; } }
        const float SC = 0.088388347648318440f;
        sc[tid] = d0 * SC; sc[288 + tid] = d1 * SC; sc[576 + tid] = d2 * SC; sc[864 + tid] = d3 * SC;
    }
    __syncthreads();
    if (F.wave < 4) { LAS float* sh = sc + F.wave * 288; float m = -INFINITY;
        for (int k = F.lane; k < nk; k += 64) m = fmaxf(m, sh[k]);
        m = wave_max(m); float l = 0.f;
        for (int k = F.lane; k < nk; k += 64) { const float p = __expf(sh[k] - m); sh[k] = p; l += p; }
        l = wave_sum(l);
        if (F.lane == 0) { red[F.wave * 2] = m; red[F.wave * 2 + 1] = l; } }
    __syncthreads();
    {
        const int kg = tid >> 4, oc = tid & 15; float o[4][8];
#pragma unroll
        for (int h = 0; h < 4; ++h)
#pragma unroll
            for (int e = 0; e < 8; ++e) o[h][e] = 0.f;
        const bf16* vp = F.V() + (size_t)(row0 + kg * 8) * 256 + kvh * 128 + oc * 8;
        bf16x8 vv[8];
#pragma unroll
        for (int k = 0; k < 8; ++k) vv[k] = *(const GAS bf16x8*)(vp + (size_t)k * 256);
#pragma unroll
        for (int k = 0; k < 8; ++k) { const float p0 = sc[kg * 8 + k], p1 = sc[288 + kg * 8 + k], p2 = sc[576 + kg * 8 + k], p3 = sc[864 + kg * 8 + k];
#pragma unroll
            for (int e = 0; e < 8; ++e) { const float vf = bf2f(vv[k][e]); o[0][e] += p0 * vf; o[1][e] += p1 * vf; o[2][e] += p2 * vf; o[3][e] += p3 * vf; } }
        if (j == 0 && kg < 16) { const int k = kg; const bf16x8 v1 = *(const GAS bf16x8*)(F.VM() + k * 256 + kvh * 128 + oc * 8);
            const float p0 = sc[256 + k], p1 = sc[288 + 256 + k], p2 = sc[576 + 256 + k], p3 = sc[864 + 256 + k];
#pragma unroll
            for (int e = 0; e < 8; ++e) { const float vf = bf2f(v1[e]); o[0][e] += p0 * vf; o[1][e] += p1 * vf; o[2][e] += p2 * vf; o[3][e] += p3 * vf; } }
        LAS float* part = sc + 4 * 288 + 16;
#pragma unroll
        for (int h = 0; h < 4; ++h) { LAS f32x4* pp = (LAS f32x4*)(part + (kg * 4 + h) * 128 + oc * 8); pp[0] = (f32x4){o[h][0], o[h][1], o[h][2], o[h][3]}; pp[1] = (f32x4){o[h][4], o[h][5], o[h][6], o[h][7]}; }
        __syncthreads();
        const int h = tid >> 7, d = tid & 127; float os = 0.f;
#pragma unroll 8
        for (int g = 0; g < 32; ++g) os += part[(g * 4 + h) * 128 + d];
        float* dst = F.MQP() + ((size_t)it * 4 + h) * 132; dst[2 + d] = os; if (d == 0) { dst[0] = red[h * 2]; dst[1] = red[h * 2 + 1]; } }
    __syncthreads();
}
__device__ __forceinline__ void attn_phase(Frame& F, char* lds_generic, bf16* obase) {
    const int nr = F.G == 256 ? 8 : (2048 + F.G - 1) / F.G;
    for (int r = 0; r < nr; ++r) {
        int s, kvh, hq, qb, S;
        if (F.G == 256) {
            const int x = F.vcu >> 5, i = F.vcu & 31;
            if (r < 4) { const int pair = 2 * x + (r >> 1); s = pair >> 1; kvh = pair & 1; const int u = (r & 1) * 32 + i; hq = u >> 4; qb = u & 15; S = 4096; }
            else { const int pair = x; s = 8 + (pair >> 1); kvh = pair & 1; const int u = (r - 4) * 32 + i; hq = u >> 5; qb = u & 31; S = 8192; }
        } else {
            const int U = F.vcu + F.G * r; if (U >= 2048) break;
            if (U < 1024) { const int pair = U >> 6, u = U & 63; s = pair >> 1; kvh = pair & 1; hq = u >> 4; qb = u & 15; S = 4096; }
            else { const int pair = (U - 1024) >> 7, u = (U - 1024) & 127; s = 8 + (pair >> 1); kvh = pair & 1; hq = u >> 5; qb = u & 31; S = 8192; }
        }
        const int row0 = seq_first_row(s), h = kvh * 4 + hq;
        bf16* qp = F.QG() + (size_t)(row0 + qb * 256) * DM + h * 128;
        attn::attn_unit(qp, F.K() + (size_t)row0 * 256 + kvh * 128, F.V() + (size_t)row0 * 256 + kvh * 128, F.KM() + kvh * 128, F.VM() + kvh * 128, obase + (size_t)(row0 + qb * 256) * DM + h * 128, S / 64 + 1, lds_generic, FIN(F, 5  ), qb * 256, F.SSQA() + (size_t)(row0 + qb * 256) * 8 + h, F.wave);
    }
}

__device__ __forceinline__ void p5_ratio(Frame& F) {
    for (int row = F.vcu * 512 + F.tid; row < NTOK; row += F.G * 512) {
        const GAS f32x4* pa = (const GAS f32x4*)(F.SSQA() + (size_t)row * 8); const GAS f32x4* pl = (const GAS f32x4*)(F.SSQL() + (size_t)row * 8);
        const f32x4 a0 = pa[0], a1 = pa[1], l0 = pl[0], l1 = pl[1];
        const float sa = ((a0.x + a0.y) + (a0.z + a0.w)) + ((a1.x + a1.y) + (a1.z + a1.w)), sl = ((l0.x + l0.y) + (l0.z + l0.w)) + ((l1.x + l1.y) + (l1.z + l1.w));
        const float qa = sqrtf(sa * (1.f / 1024.f) + EPS), ql = sqrtf(sl * (1.f / 1024.f) + EPS);
        F.RATIO()[row] = ql / qa; F.RL()[row] = 1.f / ql;
    }
}
__device__ __forceinline__ void p5_meta_job(Frame& F, int s) {
    LAS float* buf = (LAS float*)F.lds; LAS float* red = buf + 2048; const int tid = F.tid;
    {
        const int nj = s < 8 ? 16 : 32;
        for (int e = tid; e < 1024; e += 512) { const int h = e >> 7, d = e & 127, kvh = h >> 2, hq = h & 3;
            const int it0 = s < 8 ? s * 32 + kvh * 16 : 256 + (s - 8) * 64 + kvh * 32;
            float M = -INFINITY;
#pragma unroll 16
            for (int j = 0; j < nj; ++j) M = fmaxf(M, F.MQP()[((size_t)(it0 + j) * 4 + hq) * 132]);
            float Ls = 0.f, O = 0.f;
#pragma unroll 16
            for (int j = 0; j < nj; ++j) { const float* p = F.MQP() + ((size_t)(it0 + j) * 4 + hq) * 132; const float w = __expf(p[0] - M); Ls += p[1] * w; O += p[2 + d] * w; }
            buf[e] = O / Ls; }
        for (int e = tid; e < 1024; e += 512) buf[1024 + e] = F.LO15()[s * 1024 + e];
        __syncthreads();
        { float ss = 0.f; for (int k = F.lane; k < 256; k += 64) { const float v = buf[F.wave * 256 + k]; ss += v * v; } ss = wave_sum(ss); if (F.lane == 0) red[F.wave] = ss; }
        __syncthreads();
        const float ra = 1.f / sqrtf((red[0] + red[1] + red[2] + red[3]) * (1.f / 1024.f) + EPS), rl = 1.f / sqrtf((red[4] + red[5] + red[6] + red[7]) * (1.f / 1024.f) + EPS);
        for (int e = tid; e < 2048; e += 512) F.MIXED15()[s * 2048 + e] = e < 1024 ? buf[e] * ra : buf[e] * rl;
        __syncthreads();
    }
}
__device__ __forceinline__ void p6_meta_y(Frame& F) {
    const float* mx = F.MIXED15();
    const auto xf = [mx](int c, int k) { const GAS f32x4* p_ = (const GAS f32x4*)(mx + (c < 12 ? c : 11) * DM + k); const f32x4 a = p_[0], b = p_[1];
        v4u w_; w_.x = pk2(a.x, a.y); w_.y = pk2(a.z, a.w); w_.z = pk2(b.x, b.y); w_.w = pk2(b.z, b.w); return __builtin_bit_cast(bf16x8, w_); };
    const OutRows o{F.Y15(), DM, 12};
    side_gemm16<false>(F, xf, F.WOUT_T(), DM / 16, (LAS float*)F.lds, o);
}

__device__ __forceinline__ void p7_rows(Frame& F, int q, int gw, int NGW) {
    const int lane = F.lane;
    f32x4 gm[8], gf[8];
    { const float* a = FIN(F, 17  ); const float* b = FIN(F, 18  );
#pragma unroll
      for (int i = 0; i < 4; ++i) { const int e0 = (lane + 64 * i) * 8; gm[2 * i] = *(const GAS f32x4*)(a + e0); gm[2 * i + 1] = *(const GAS f32x4*)(a + e0 + 4); gf[2 * i] = *(const GAS f32x4*)(b + e0); gf[2 * i + 1] = *(const GAS f32x4*)(b + e0 + 4); } }
    bf16x8 yv[4], yn[4]; v4u xv[4], xw[4]; float r0c = 1.f, r0n = 1.f;
    const int rend = (q + 1) * HROWS;
    int row = q * HROWS + gw;
#define P7_LOAD(R, Y, X, RV) do { const GAS bf16x8* y_ = (const GAS bf16x8*)((const bf16*)(F.out + (size_t)(R) * DM)); const GAS v4u* x_ = (const GAS v4u*)(F.XN() + (size_t)(R) * DM); \
        _Pragma("unroll") for (int i_ = 0; i_ < 4; ++i_) { Y[i_] = y_[lane + 64 * i_]; X[i_] = x_[lane + 64 * i_]; } RV = F.R0()[(R)]; } while (0)
    if (row < rend) P7_LOAD(row, yv, xv, r0c);
    asm volatile("" : "+v"(r0c) :: "memory");
    for (; row < rend; row += NGW) {
        const int nrow = row + NGW < rend ? row + NGW : row;
        P7_LOAD(nrow, yn, xw, r0n);
        GAS v4u* xn = (GAS v4u*)(F.XN() + (size_t)row * DM);
        GAS v4u* h1row = (GAS v4u*)((bf16*)(F.out + (size_t)row * DM) + DM);
        const float ir0 = __builtin_amdgcn_rcpf(r0c);
        float hv[32]; float ss = 0.f;
#pragma unroll
        for (int i = 0; i < 4; ++i)
#pragma unroll
            for (int j = 0; j < 8; ++j) { hv[8 * i + j] = bf2f(yv[i][j]); ss += hv[8 * i + j] * hv[8 * i + j]; }
        const float r1 = __builtin_amdgcn_rsqf(wave_sum(ss) * (1.f / DM) + EPS); float s2 = 0.f;
#pragma unroll
        for (int i = 0; i < 4; ++i) {
            const v4u xq = xv[i]; const f32x4 g0 = gm[2 * i], g1 = gm[2 * i + 1];
            const float xf[8] = {__builtin_bit_cast(float, xq.x << 16), __builtin_bit_cast(float, xq.x & 0xffff0000u), __builtin_bit_cast(float, xq.y << 16), __builtin_bit_cast(float, xq.y & 0xffff0000u),
                                 __builtin_bit_cast(float, xq.z << 16), __builtin_bit_cast(float, xq.z & 0xffff0000u), __builtin_bit_cast(float, xq.w << 16), __builtin_bit_cast(float, xq.w & 0xffff0000u)};
            const float gg[8] = {g0.x, g0.y, g0.z, g0.w, g1.x, g1.y, g1.z, g1.w};
            float hb[8];
#pragma unroll
            for (int j = 0; j < 8; ++j) { hb[j] = xf[j] * ir0 + hv[8 * i + j] * r1 * gg[j]; hv[8 * i + j] = hb[j]; s2 += hb[j] * hb[j]; }
            h1row[lane + 64 * i] = pack8(hb);
        }
        const float r2 = __builtin_amdgcn_rsqf(wave_sum(s2) * (1.f / DM) + EPS);
#pragma unroll
        for (int i = 0; i < 4; ++i) { const f32x4 g0 = gf[2 * i], g1 = gf[2 * i + 1];
            float t[8]; t[0] = hv[8 * i + 0] * r2 * g0.x; t[1] = hv[8 * i + 1] * r2 * g0.y; t[2] = hv[8 * i + 2] * r2 * g0.z; t[3] = hv[8 * i + 3] * r2 * g0.w;
            t[4] = hv[8 * i + 4] * r2 * g1.x; t[5] = hv[8 * i + 5] * r2 * g1.y; t[6] = hv[8 * i + 6] * r2 * g1.z; t[7] = hv[8 * i + 7] * r2 * g1.w;
            xn[lane + 64 * i] = pack8(t); }
        asm volatile("" : "+v"(r0n) :: "memory");
#pragma unroll
        for (int i = 0; i < 4; ++i) { yv[i] = yn[i]; xv[i] = xw[i]; }
        r0c = r0n;
    }
#undef P7_LOAD
}
constexpr int XS15 = DM + 8;
__device__ __forceinline__ void p7_meta_g(Frame& F) {
    LAS float* X = (LAS float*)F.lds;
    for (int r = F.wave; r < 12; r += 8) {
        const float* y = F.Y15() + r * DM; const float* xm = FIN(F, 2  ) + 15 * DM;
        float hv[32]; float ss = 0.f;
#pragma unroll
        for (int i = 0; i < 32; ++i) { hv[i] = y[F.lane + 64 * i]; ss += hv[i] * hv[i]; }
        const float r1 = 1.f / sqrtf(wave_sum(ss) * (1.f / DM) + EPS); float s2 = 0.f;
#pragma unroll
        for (int i = 0; i < 32; ++i) { const int e = F.lane + 64 * i; hv[i] = xm[e] + hv[i] * r1 * FIN(F, 17  )[e]; s2 += hv[i] * hv[i]; }
        const float r2 = 1.f / sqrtf(wave_sum(s2) * (1.f / DM) + EPS);
#pragma unroll
        for (int i = 0; i < 32; ++i) { const int e = F.lane + 64 * i; X[r * XS15 + e] = hv[i] * r2 * FIN(F, 18  )[e]; }
    }
    __syncthreads();
    const OutRowsB o{F.G15(), FFN, 12};
    const auto xf = [X](int c, int k) { const LAS f32x4* p_ = (const LAS f32x4*)(X + (c < 12 ? c : 11) * XS15 + k); const f32x4 a = p_[0], b = p_[1];
        v4u w_; w_.x = pk2(a.x, a.y); w_.y = pk2(a.z, a.w); w_.z = pk2(b.x, b.y); w_.w = pk2(b.z, b.w); return __builtin_bit_cast(bf16x8, w_); };
    side_gemm16<true>(F, xf, F.WUP_T(), FFN / 16, (LAS float*)(F.lds + 12 * XS15 * 4), o);
}

__device__ __forceinline__ void p9_fix(Frame& F, int h) {
    constexpr int NOCT = FFN / 8, NBW = 512 * 2;
    const int gid = F.vcu * 512 + F.tid, oct = gid % NOCT, grp = gid / NOCT, NGRP = (F.G * 512) / NOCT;
    if (grp >= NGRP) return;
    const int co = oct * 8;
    const float* cw = FIN(F, 20  ); const float* cb = FIN(F, 21  );
    float w0[8], w1[8], w2[8], bb[8];
#define LD8F(dst, p) do { const GAS f32x4* p_ = (const GAS f32x4*)(p); const f32x4 a_ = p_[0], b_ = p_[1]; dst[0] = a_.x; dst[1] = a_.y; dst[2] = a_.z; dst[3] = a_.w; dst[4] = b_.x; dst[5] = b_.y; dst[6] = b_.z; dst[7] = b_.w; } while (0)
    LD8F(w0, cw + co); LD8F(w1, cw + FFN + co); LD8F(w2, cw + 2 * FFN + co); LD8F(bb, cb + co);
#define P9_PTRS(BW, E_, O_, Z_) do { const int which_ = (BW) & 1, B_ = (BW) >> 1; const int row_ = h * HROWS + B_ * 64 + (which_ ? 63 : 0), s_ = row_seq(row_), t_ = row_ - seq_first_row(s_); \
        E_ = F.EDGE() + (size_t)((B_ * 2 + which_) * 3) * FFN + co; Z_ = which_ && t_ == seq_len(s_) - 1; \
        O_ = which_ == 0 ? (t_ == 0 ? F.G15() + (size_t)s_ * FFN + co : F.EDGE() + (size_t)(((B_ - 1) * 2 + 1) * 3 + 1) * FFN + co) : (Z_ ? E_ : F.EDGE() + (size_t)(((B_ + 1) * 2 + 0) * 3 + 1) * FFN + co); } while (0)
#define P9_LOAD(E_, O_, I, S, U, X) do { I = *(const GAS bf16x8*)(E_); S = *(const GAS bf16x8*)((E_) + FFN); U = *(const GAS bf16x8*)((E_) + 2 * FFN); X = *(const GAS bf16x8*)(O_); } while (0)
    bf16x8 in_, se_, uu_, ou_, inN, seN, uuN, ouN;
    int bw = grp; const bf16* e; const bf16* o; bool z;
    P9_PTRS(bw, e, o, z); P9_LOAD(e, o, in_, se_, uu_, ou_);
    for (; bw < NBW; bw += NGRP) {
        const int nbw = bw + NGRP < NBW ? bw + NGRP : bw; const bf16* en; const bf16* on; bool zn;
        P9_PTRS(nbw, en, on, zn); P9_LOAD(en, on, inN, seN, uuN, ouN);
        const int which = bw & 1, lrow = (bw >> 1) * 64 + (which ? 63 : 0);
        float ov[8];
#pragma unroll
        for (int j = 0; j < 8; ++j) { const float inner = bf2f(in_[j]), self = bf2f(se_[j]), outer = z ? 0.f : bf2f(ou_[j]);
            const float x = which == 0 ? bb[j] + w0[j] * outer + w1[j] * self + w2[j] * inner : bb[j] + w0[j] * inner + w1[j] * self + w2[j] * outer;
            ov[j] = x * sigmoidf_(x) * bf2f(uu_[j]); }
        *(GAS v4u*)(F.ACT() + (size_t)lrow * FFN + co) = pack8(ov);
        in_ = inN; se_ = seN; uu_ = uuN; ou_ = ouN;
        z = zn;
    }
#undef P9_LOAD
#undef P9_PTRS
#undef LD8F
}
__device__ __forceinline__ void p11_rows(Frame& F, int gw, int NGW, float* obase) {
    const int lane = F.lane;
    f32x4 gg[8];
    { const float* a = FIN(F, 23  );
#pragma unroll
      for (int i = 0; i < 4; ++i) { const int e0 = (lane + 64 * i) * 8; gg[2 * i] = *(const GAS f32x4*)(a + e0); gg[2 * i + 1] = *(const GAS f32x4*)(a + e0 + 4); } }
    bf16x8 hv[4], fq[4], hn[4], fn[4];
#define P11_LOAD(R, H, Q) do { const GAS bf16x8* f_ = (const GAS bf16x8*)((const bf16*)(F.out + (size_t)(R) * DM)); \
        const GAS bf16x8* h_ = (const GAS bf16x8*)((const bf16*)(F.out + (size_t)(R) * DM) + DM);        \
        _Pragma("unroll") for (int i_ = 0; i_ < 4; ++i_) { H[i_] = h_[lane + 64 * i_]; Q[i_] = f_[lane + 64 * i_]; } } while (0)
    int row = gw;
    if (row < NTOK) P11_LOAD(row, hv, fq);
    asm volatile("" : "+v"(hv[0]), "+v"(hv[1]), "+v"(hv[2]), "+v"(hv[3]), "+v"(fq[0]), "+v"(fq[1]), "+v"(fq[2]), "+v"(fq[3]) :: "memory");
    for (; row < NTOK; row += NGW) {
        const int nrow = row + NGW < NTOK ? row + NGW : row;
        P11_LOAD(nrow, hn, fn);
        float fv[32]; float ss = 0.f;
#pragma unroll
        for (int i = 0; i < 4; ++i)
#pragma unroll
            for (int j = 0; j < 8; ++j) { fv[8 * i + j] = bf2f(fq[i][j]); ss += fv[8 * i + j] * fv[8 * i + j]; }
        const float r1 = __builtin_amdgcn_rsqf(wave_sum(ss) * (1.f / DM) + EPS);
#pragma unroll
        for (int i = 0; i < 4; ++i) { const int e0 = (lane + 64 * i) * 8; const f32x4 g0 = gg[2 * i], g1 = gg[2 * i + 1];
            f32x4 h0, h1;
            h0.x = bf2f(hv[i][0]) + fv[8 * i + 0] * r1 * g0.x; h0.y = bf2f(hv[i][1]) + fv[8 * i + 1] * r1 * g0.y; h0.z = bf2f(hv[i][2]) + fv[8 * i + 2] * r1 * g0.z; h0.w = bf2f(hv[i][3]) + fv[8 * i + 3] * r1 * g0.w;
            h1.x = bf2f(hv[i][4]) + fv[8 * i + 4] * r1 * g1.x; h1.y = bf2f(hv[i][5]) + fv[8 * i + 5] * r1 * g1.y; h1.z = bf2f(hv[i][6]) + fv[8 * i + 6] * r1 * g1.z; h1.w = bf2f(hv[i][7]) + fv[8 * i + 7] * r1 * g1.w;
            GAS f32x4* wp = (GAS f32x4*)(obase + (size_t)row * DM + e0); wp[0] = h0; wp[1] = h1; }
        asm volatile("" : "+v"(hn[0]), "+v"(hn[1]), "+v"(hn[2]), "+v"(hn[3]), "+v"(fn[0]), "+v"(fn[1]), "+v"(fn[2]), "+v"(fn[3]) :: "memory");
#pragma unroll
        for (int i = 0; i < 4; ++i) { hv[i] = hn[i]; fq[i] = fn[i]; }
    }
#undef P11_LOAD
}
struct Args { const float* in[24]; float* out; unsigned char* ws; int ph_lo, ph_hi, q_lo, q_hi, use_bar, dummy; };
constexpr int N_PHASES = 12;
__global__ void __launch_bounds__(NWAVES * 64, 2) mk_fwd(Args args) {
    extern __shared__ __attribute__((aligned(16))) unsigned char lds[];
    Frame F;
    F.lds = (LAS unsigned char*)lds;
    F.MISC = (volatile LAS unsigned*)(F.lds + MISC_OFF);
    F.wave = __builtin_amdgcn_readfirstlane((int)threadIdx.x >> 6);
    F.tid = F.wave * 64 + lane_id_now(); F.lane = F.tid & 63;
    F.G = gridDim.x; { const int bx = blockIdx.x; F.vcu = (F.G % 8 == 0) ? (bx % 8) * (F.G / 8) + bx / 8 : bx; }
    unsigned char* ws = args.ws;
    F.ctl = (gu32*)(ws + WS_CTL);
    F.kargs = (const __attribute__((address_space(4))) void*)__builtin_amdgcn_kernarg_segment_ptr(); F.ptag = 0; F.out = args.out;
    F.ws = ws;
    for (int u = F.tid; u < (LDS_BYTES - LDSCTL_OFF) / 4; u += NWAVES * 64) ((LAS unsigned*)(F.lds + LDSCTL_OFF))[u] = 0u;
    __syncthreads();
    XcdBarrier bar; bar.bar = (unsigned*)(F.ctl + CW_BAR); bar.x = 0; bar.st = nullptr;
    if (args.use_bar) bar = xcd_barrier_post((unsigned*)(F.ctl + CW_BAR), F.MISC + 8, F.tid == 0);
    const int lo = args.ph_lo, hi = args.ph_hi;
    const int dmy_ = MK_MULTI ? args.dummy : 0;
#define IN(k) (((MK_PHASE_MASK >> (k)) & 1) && lo <= (k) && (k) < hi)
#define PH_BEGIN(k) do { F.ptag = (k); int t_ = F.wave * 64 + lane_id_now(); asm volatile("" : "+v"(t_)); F.tid = t_; F.lane = t_ & 63; } while (0)
#define PH_BAR() do { if (args.use_bar) xcd_barrier(bar, F.wave == 0 && lane_id_now() == 0); } while (0)
    const int gw = F.vcu * NWAVES + F.wave, NGW = F.G * NWAVES;

    if (IN(0)) { PH_BEGIN(0); { p0_prologue(F); PH_BAR(); } }
    if (IN(1)) { PH_BEGIN(1); {
        p1_meta_z(F);
        pg8::Gemm g{F.XN(), F.WIN_T(), NTOK, INW, DM}; pg8::ProbeOrder S; S.init(NTOK, INW, F.G, (int)blockIdx.x); S.pmask = dmy_ == 5 ? 7 : -1;
        pg8::EpiRoute E{nullptr, 0, 1, F.QG(), F.K(), F.V(), F.XR()};
        if (dmy_ != 7) pg8::gemm_phase<pg8::EpiRoute, pg8::ProbeOrder, true, true>(F.lds, g, S, E, F.wave);
        PH_BAR();
    } }
    if (IN(2)) { PH_BEGIN(2); { lru_phase<1>(F, nullptr); PH_BAR(); } }
    if (IN(3)) { PH_BEGIN(3); {
        constexpr int NPW = (12 * 2048 + 511) / 512;
        if (F.G >= 2 * NPW) {
            if (F.vcu < NPW) lru_propagate(F);
            else { const int gw2 = (F.vcu - NPW) * NWAVES + F.wave, NGW2 = (F.G - NPW) * NWAVES;
                k_rope_pass(F, dmy_ ? (bf16*)F.out : F.K(), gw2, NGW2);
                wt_items(F, WT_O_OUT, WT_O_UP, gw2, NGW2); wt_items(F, WT_O_DN, WT_O_G, gw2, NGW2); }
        } else {
            k_rope_pass(F, dmy_ ? (bf16*)F.out : F.K(), gw, NGW);
            lru_propagate(F);
            wt_items(F, WT_O_OUT, WT_O_UP, gw, NGW); wt_items(F, WT_O_DN, WT_O_G, gw, NGW);
        }
        if (F.vcu == F.G - 1) p3_meta_job(F);
        PH_BAR();
    } }
    if (IN(4)) { PH_BEGIN(4); {
        const int dm = dmy_;
        if (dm < 2 || dm == 2) lru_phase<2>(F, dm ? (bf16*)F.out : F.QG());
        if (dm < 2 || dm == 3) for (int it = F.vcu; it < 512; it += F.G) metaq_item(F, it);
        if (dm < 2 || dm == 4) attn_phase(F, (char*)lds, dm ? (bf16*)F.out : F.QG());
        if (dm == 8 && F.vcu < 128) attn_phase(F, (char*)lds, (bf16*)F.out);
        if (dm == 6 && (F.vcu & 1) == 0) attn_phase(F, (char*)lds, (bf16*)F.out);
        PH_BAR();
    } }
    if (IN(5)) { PH_BEGIN(5); {
        p5_ratio(F);
        if (F.G > 24) {
            if (F.vcu >= F.G - 12) p5_meta_job(F, F.G - 1 - F.vcu);
            else wt_items(F, WT_O_UP, WT_O_DN, F.vcu * NWAVES + F.wave, (F.G - 12) * NWAVES);
        } else {
            wt_items(F, WT_O_UP, WT_O_DN, gw, NGW);
            __syncthreads();
            if (F.vcu >= F.G - 12) p5_meta_job(F, F.G - 1 - F.vcu);
        }
        PH_BAR();
    } }
    if (IN(6)) { PH_BEGIN(6); {
        p6_meta_y(F);
        pg8::Gemm g{F.QG(), F.WOUT_T(), NTOK, DM, DM}; pg8::StaticOrder S; S.init(NTOK, DM, F.G, (int)blockIdx.x);
        pg8::EpiScaled E{(bf16*)F.out, 2 * DM, F.RATIO(), F.RL(), 16};
        pg8::gemm_phase<pg8::EpiScaled, pg8::StaticOrder, true, true>(F.lds, g, S, E, F.wave);
        PH_BAR();
    } }
#if MK_MULTI
    { const int q = args.q_lo;
#else
#pragma unroll
    for (int q = 0; q < 2; ++q) {
#endif
        if (IN(7)) { PH_BEGIN(7); {
            p7_rows(F, q, gw, NGW);
            if (q == 0) p7_meta_g(F);
            PH_BAR();
        } }
        if (IN(8)) { PH_BEGIN(8); {
            pg8::Gemm g{F.XN() + (size_t)q * HROWS * DM, F.WUP_T(), HROWS, UPW, DM}; pg8::StaticOrder S; S.init(HROWS, UPW, F.G, (int)blockIdx.x);
            pg8::EpiAct E{F.ACT(), F.EDGE(), FIN(F, 20  ), FIN(F, 21  ), FFN};
            pg8::gemm_phase<pg8::EpiAct, pg8::StaticOrder, true, true>(F.lds, g, S, E, F.wave);
            PH_BAR();
        } }
        if (IN(9)) { PH_BEGIN(9); { p9_fix(F, q); PH_BAR(); } }
        if (IN(10)) { PH_BEGIN(10); {
            pg8::Gemm g{F.ACT(), F.WDOWN_T(), HROWS, DM, FFN}; pg8::ProbeOrder S; S.init(HROWS, DM, F.G, (int)blockIdx.x); S.pmask = dmy_ == 5 ? 7 : -1;
            pg8::EpiRoute E{(bf16*)F.out + (size_t)q * HROWS * 2 * DM, 2 * DM, 0, nullptr, nullptr, nullptr, nullptr};
            pg8::gemm_phase<pg8::EpiRoute, pg8::ProbeOrder, true, true>(F.lds, g, S, E, F.wave);
        } }
    }
    if (IN(10) && IN(11)) PH_BAR();
    if (IN(11)) { PH_BEGIN(11); { p11_rows(F, gw, NGW, dmy_ ? (float*)(F.ws + WS_B) : F.out); } }
#undef IN
#undef PH_BAR
}

extern "C" void kernel_launch(void* const* d_in, const int* in_sizes, int n_in, void* d_out, int out_size, void* d_ws, size_t ws_size, hipStream_t stream) {
    static int grid = 0;
    if (grid == 0) {
        if (n_in != 24 || out_size != NTOK * DM || ws_size < WS_END) { fprintf(stderr, "kernel_launch: unexpected shapes (n_in %d out %d ws %zu, need ws >= %zu); nothing launched\n", n_in, out_size, ws_size, (size_t)WS_END); grid = -1; return; }
        int dev = 0, cus = 0;
        if (hipGetDevice(&dev) != hipSuccess || hipDeviceGetAttribute(&cus, hipDeviceAttributeMultiprocessorCount, dev) != hipSuccess) { grid = -1; return; }
        if (hipFuncSetAttribute((const void*)mk_fwd, hipFuncAttributeMaxDynamicSharedMemorySize, LDS_BYTES) != hipSuccess) { fprintf(stderr, "kernel_launch: hipFuncSetAttribute failed\n"); grid = -1; return; }
        int per_cu = 0;
        if (hipOccupancyMaxActiveBlocksPerMultiprocessor(&per_cu, (const void*)mk_fwd, NWAVES * 64, LDS_BYTES) != hipSuccess || per_cu < 1) fprintf(stderr, "kernel_launch: occupancy query reports %d\n", per_cu);
        (void)hipGetLastError();
        grid = cus;
    }
    if (grid < 0) return;
    if (hipMemsetAsync((char*)d_ws + WS_CTL, 0, CTL_ZERO_BYTES, stream) != hipSuccess) return;
    Args a{};
    for (int i = 0; i < 24; ++i) a.in[i] = (const float*)d_in[i];
    a.out = (float*)d_out; a.ws = (unsigned char*)d_ws;
#if MK_MULTI
    a.use_bar = 0;
#define LAUNCH_PH(ph, q) do { a.ph_lo = (ph); a.ph_hi = (ph) + 1; a.q_lo = (q); a.q_hi = (q) + 1; \
        if ((MK_REPEAT_MASK >> (ph)) & 1) { a.dummy = MK_DUMMY_MODE; hipLaunchKernelGGL(mk_fwd, dim3(grid), dim3(NWAVES * 64), LDS_BYTES, stream, a); } \
        a.dummy = 0; hipLaunchKernelGGL(mk_fwd, dim3(grid), dim3(NWAVES * 64), LDS_BYTES, stream, a); } while (0)
    for (int ph = 0; ph < 7; ++ph) LAUNCH_PH(ph, 0);
    for (int q = 0; q < 2; ++q) for (int ph = 7; ph < 11; ++ph) LAUNCH_PH(ph, q);
    LAUNCH_PH(11, 0);
#else
    a.use_bar = 1; a.ph_lo = 0; a.ph_hi = N_PHASES; a.q_lo = 0; a.q_hi = 2;
    hipLaunchKernelGGL(mk_fwd, dim3(grid), dim3(NWAVES * 64), LDS_BYTES, stream, a);
#endif
    const hipError_t le = hipPeekAtLastError();
    if (le != hipSuccess) fprintf(stderr, "kernel_launch: launch failed: %s\n", hipGetErrorName(le));
}
```
